# Optimizing an MI355X kernel written in HIP

```python
import math
import jax, jax.numpy as jnp
from jax import lax
import numpy as np

D_MODEL = 1024
BATCH = 8
SEQ = 4096
DEPTH = 2

GRID_W = 64
CTX_LEN = 256
CONV_W = 3

HY_WIDTH = 256
HY_BANDS = 16
HY_EMB = 1 + 2 * HY_BANDS
HY_HIDDEN = 64

SC_WIDTH = 256

HG_HEADS = 4
HG_DK = 64
HG_DV = 64
HG_KEY = HG_HEADS * HG_DK
HG_VAL = HG_HEADS * HG_DV
HG_CHUNK = 16

SSD_HEADS = 4
SSD_HEADDIM = 64
SSD_INNER = SSD_HEADS * SSD_HEADDIM
SSD_STATE = 64
SSD_GROUPS = 2
SSD_CHUNK = 64
SSD_XBC = SSD_INNER + 2 * SSD_GROUPS * SSD_STATE

N_BRANCH = 4
BRANCH_W = 256

HY_COLS = 3 * HY_WIDTH
SC_COLS = 3 * SC_WIDTH
HG_COLS = 3 * HG_KEY + 2 * HG_VAL
SSD_COLS = SSD_INNER + SSD_XBC + 2 * SSD_HEADS
IN_COLS = HY_COLS + SC_COLS + HG_COLS + SSD_COLS
IN_SPLITS = (HY_COLS, HY_COLS + SC_COLS, HY_COLS + SC_COLS + HG_COLS)

N_EXPERTS = 16
N_EXPERT_GROUPS = 4
TOP_K = 2
D_FF_EXPERT = 512

DEEPNORM_ALPHA = (2 * DEPTH) ** 0.25
DEEPNORM_BETA = (8 * DEPTH) ** -0.25
LN_EPS = 1e-5
RMS_EPS = 1e-6

kernel_name = 'hybrid_dit_hyena_conv_hgrn2_ssd_moe'


def _layernorm(x, g, b):
    xf = x.astype(jnp.float32)
    mu = jnp.mean(xf, -1, keepdims=True)
    var = jnp.mean(jnp.square(xf - mu), -1, keepdims=True)
    return ((xf - mu) * lax.rsqrt(var + LN_EPS) * g + b).astype(x.dtype)


def _rmsnorm(x, g):
    xf = x.astype(jnp.float32)
    return (xf * lax.rsqrt(jnp.mean(jnp.square(xf), -1, keepdims=True) + RMS_EPS) * g).astype(x.dtype)


def _dwconv(u, w, b=None):
    L = u.shape[1]
    pad = CONV_W // 2
    up = jnp.pad(u, ((0, 0), (pad, pad), (0, 0)))
    y = sum(up[:, k:k + L] * w[k] for k in range(CONV_W))
    return y if b is None else y + b


def _sincos_1d(pos, dim):
    omega = 1.0 / (10000.0 ** (jnp.arange(dim // 2, dtype=jnp.float32) / (dim // 2)))
    ang = pos.astype(jnp.float32)[:, None] * omega[None]
    return jnp.concatenate([jnp.sin(ang), jnp.cos(ang)], -1)


def _grid_pos_embed(rows):
    row = jnp.repeat(jnp.arange(rows), GRID_W)
    col = jnp.tile(jnp.arange(GRID_W), rows)
    return jnp.concatenate([_sincos_1d(row, D_MODEL // 2), _sincos_1d(col, D_MODEL // 2)], -1)


def _hyena_filter(L, lp):
    t = jnp.linspace(0.0, 1.0, L, dtype=jnp.float32)[:, None]
    bands = jnp.linspace(1e-4, HY_BANDS - 1, HY_BANDS, dtype=jnp.float32)
    ang = (2.0 * math.pi / L) * jnp.arange(L, dtype=jnp.float32)[:, None] * bands[None]
    feat = jnp.concatenate([t, jnp.cos(ang), -jnp.sin(ang)], -1)
    h = jnp.sin(lp['hy_freq1'] * (feat @ lp['hy_w1'] + lp['hy_b1']))
    h = jnp.sin(lp['hy_freq2'] * (h @ lp['hy_w2'] + lp['hy_b2']))
    h = (h @ lp['hy_w3']).astype(jnp.float32)
    window = jnp.exp(-t * jnp.abs(lp['hy_decay'].astype(jnp.float32)))
    h_fwd = h[:, :HY_WIDTH] * window
    h_bwd = h[:, HY_WIDTH:] * window
    filt = jnp.concatenate([h_fwd, jnp.zeros((1, HY_WIDTH), jnp.float32), h_bwd[:0:-1]], 0)
    return filt / jnp.sum(jnp.abs(filt), 0, keepdims=True)


def _fftconv(u, filt, bias):
    L = u.shape[1]
    uf = u.astype(jnp.float32)
    spec = jnp.fft.rfft(uf, n=2 * L, axis=1) * jnp.fft.rfft(filt, n=2 * L, axis=0)[None]
    y = jnp.fft.irfft(spec, n=2 * L, axis=1)[:, :L]
    return (y + uf * bias.astype(jnp.float32)).astype(u.dtype)


def _hyena_branch(u, lp):
    u = _dwconv(u, lp['hy_conv_w'], lp['hy_conv_b'])
    x0, x1, v = jnp.split(u, 3, -1)
    filt = _hyena_filter(u.shape[1], lp)
    return x0 * _fftconv(x1 * v, filt, lp['hy_bias'])


def _shortconv_branch(u, conv_w):
    bg, cg, xs = jnp.split(u, 3, -1)
    return bg * _dwconv(cg * xs, conv_w)


def _gla_chunked(q, k, v, logf, s0):
    Bsz, L, H, DK = q.shape
    DV = v.shape[-1]
    n = L // HG_CHUNK
    blk = lambda t: t.astype(jnp.float32).reshape(Bsz, n, HG_CHUNK, H, t.shape[-1])
    q, k, v, logf = blk(q), blk(k), blk(v), blk(logf)
    b = jnp.cumsum(logf, axis=2)
    b_last = b[:, :, -1]
    q_dec = q * jnp.exp(b)
    k_inv = k * jnp.exp(-b)
    k_end = k * jnp.exp(b_last[:, :, None] - b)
    causal = jnp.tril(jnp.ones((HG_CHUNK, HG_CHUNK), bool))
    scores = jnp.where(causal, jnp.einsum('bnthd,bnshd->bnhts', q_dec, k_inv), 0.0)
    o_intra = jnp.einsum('bnhts,bnshv->bnthv', scores, v)

    def step(S, inp):
        qd, ke, vc, bl = inp
        o = jnp.einsum('bthd,bhdv->bthv', qd, S)
        S = jnp.exp(bl)[..., None] * S + jnp.einsum('bshd,bshv->bhdv', ke, vc)
        return S, o

    mv = lambda t: jnp.moveaxis(t, 1, 0)
    s_final, o_inter = lax.scan(step, s0, (mv(q_dec), mv(k_end), mv(v), mv(b_last)))
    o = o_intra + jnp.moveaxis(o_inter, 0, 1)
    return o.reshape(Bsz, L, H, DV), s_final


def _hgrn_lower_bounds(logits):
    p = jax.nn.softmax(logits.astype(jnp.float32), axis=1)
    return jnp.cumsum(p, axis=1) - p[:, :1]


def _hgrn_prep(u, lb):
    Bsz, L = u.shape[:2]
    q, f_f, f_b, i, g = jnp.split(u, (HG_KEY, 2 * HG_KEY, 3 * HG_KEY, 3 * HG_KEY + HG_VAL), -1)
    heads = lambda t: t.reshape(Bsz, L, HG_HEADS, -1)
    logf = [heads(jnp.log(lb[d] + (1.0 - lb[d]) * jax.nn.sigmoid(f.astype(jnp.float32))))
            for d, f in enumerate((f_f, f_b))]
    return heads(q.astype(jnp.float32)) * HG_DK ** -0.5, logf, heads(i), g


def _hgrn_bidir(q, logf, v, s_f, s_b):
    flip = lambda t: jnp.flip(t, axis=1)
    o_f, s_f = _gla_chunked(q, -jnp.expm1(logf[0]), v, logf[0], s_f)
    o_b, s_b = _gla_chunked(flip(q), flip(-jnp.expm1(logf[1])), flip(v), flip(logf[1]), s_b)
    return o_f + flip(o_b), s_f, s_b


def _hgrn_readout(o, g, norm_g):
    o = _rmsnorm(o, norm_g).reshape(g.shape)
    return (o * jax.nn.silu(g.astype(jnp.float32))).astype(g.dtype)


def _hgrn_branch(u_ctx, u_lat, lb, norm_g, ctx_out):
    s0 = jnp.zeros((u_lat.shape[0], HG_HEADS, HG_DK, HG_DV), jnp.float32)
    q_c, lf_c, v_c, g_c = _hgrn_prep(u_ctx, lb)
    q_l, lf_l, v_l, g_l = _hgrn_prep(u_lat, lb)
    o_c, s_f, s_b = _hgrn_bidir(q_c, lf_c, v_c, s0, s0)
    o_l, _, _ = _hgrn_bidir(q_l, lf_l, v_l, s_f, s_b)
    y_l = _hgrn_readout(o_l, g_l, norm_g)
    y_c = _hgrn_readout(o_c, g_c, norm_g) if ctx_out else None
    return y_c, y_l


def _ssd_chunked(x, a, bm, cm, s0):
    Bsz, L, H, P = x.shape
    n = L // SSD_CHUNK
    blk = lambda t: t.astype(jnp.float32).reshape((Bsz, n, SSD_CHUNK) + t.shape[2:])
    x, a, bm, cm = blk(x), blk(a), blk(bm), blk(cm)
    cum = jnp.cumsum(a, axis=2)
    causal = jnp.tril(jnp.ones((SSD_CHUNK, SSD_CHUNK), bool))[:, :, None]
    decay = jnp.exp(jnp.where(causal, cum[:, :, :, None, :] - cum[:, :, None, :, :], -jnp.inf))
    scores = jnp.einsum('bcthn,bcshn->bctsh', cm, bm) * decay
    y_diag = jnp.einsum('bctsh,bcshp->bcthp', scores, x)
    states = jnp.einsum('bcshn,bcshp->bchpn', bm * jnp.exp(cum[:, :, -1:] - cum)[..., None], x)
    c_dec = cm * jnp.exp(cum)[..., None]
    total = jnp.exp(cum[:, :, -1])

    def step(S, inp):
        cd, st, tot = inp
        y = jnp.einsum('bthn,bhpn->bthp', cd, S)
        return tot[:, :, None, None] * S + st, y

    mv = lambda t: jnp.moveaxis(t, 1, 0)
    s_final, y_off = lax.scan(step, s0, (mv(c_dec), mv(states), mv(total)))
    y = y_diag + jnp.moveaxis(y_off, 0, 1)
    return y.reshape(Bsz, L, H, P), s_final


def _ssd_prep(u, lp):
    Bsz, L = u.shape[:2]
    z, xbc, dt = jnp.split(u, (SSD_INNER, SSD_INNER + SSD_XBC), -1)
    xbc = jax.nn.silu(_dwconv(xbc, lp['ssd_conv_w'], lp['ssd_conv_b']))
    xs, bm, cm = jnp.split(xbc, (SSD_INNER, SSD_INNER + SSD_GROUPS * SSD_STATE), -1)
    rep = SSD_HEADS // SSD_GROUPS
    xs = xs.reshape(Bsz, L, SSD_HEADS, SSD_HEADDIM)
    bm = jnp.repeat(bm.reshape(Bsz, L, SSD_GROUPS, SSD_STATE), rep, axis=2)
    cm = jnp.repeat(cm.reshape(Bsz, L, SSD_GROUPS, SSD_STATE), rep, axis=2)
    dt = jax.nn.softplus(dt.astype(jnp.float32).reshape(Bsz, L, 2, SSD_HEADS) + lp['ssd_dt_bias'])
    a = -jnp.exp(lp['ssd_a_log'].astype(jnp.float32)) * dt
    return z, xs, bm, cm, dt, a


def _ssd_bidir(xs, bm, cm, dt, a, d_skip, s_f, s_b):
    flip = lambda t: jnp.flip(t, axis=1)
    xf = xs.astype(jnp.float32)
    y_f, s_f = _ssd_chunked(xf * dt[:, :, 0, :, None], a[:, :, 0], bm, cm, s_f)
    y_b, s_b = _ssd_chunked(flip(xf * dt[:, :, 1, :, None]), flip(a[:, :, 1]), flip(bm), flip(cm), s_b)
    y = y_f + flip(y_b) + xf * d_skip.astype(jnp.float32)[:, None]
    return y, s_f, s_b


def _ssd_readout(y, z, norm_g):
    y = y.reshape(z.shape)
    return _rmsnorm(y * jax.nn.silu(z.astype(jnp.float32)), norm_g).astype(z.dtype)


def _ssd_branch(u_ctx, u_lat, lp, ctx_out):
    s0 = jnp.zeros((u_lat.shape[0], SSD_HEADS, SSD_HEADDIM, SSD_STATE), jnp.float32)
    z_c, *rest_c = _ssd_prep(u_ctx, lp)
    z_l, *rest_l = _ssd_prep(u_lat, lp)
    y_c, s_f, s_b = _ssd_bidir(*rest_c, lp['ssd_d'], s0, s0)
    y_l, _, _ = _ssd_bidir(*rest_l, lp['ssd_d'], s_f, s_b)
    out_l = _ssd_readout(y_l, z_l, lp['ssd_norm_g'])
    out_c = _ssd_readout(y_c, z_c, lp['ssd_norm_g']) if ctx_out else None
    return out_c, out_l


def _merge(h, branches, lp):
    gates = jnp.split(jax.nn.sigmoid(h @ lp['w_gate'] + lp['b_gate']), N_BRANCH, -1)
    y = sum(g * (br @ lp['w_br'][k]) for k, (g, br) in enumerate(zip(gates, branches)))
    return y @ lp['w_o']


def _token_mixer(h_lat, h_ctx, lp, lb, ctx_out):
    u_lat = h_lat @ lp['w_in']
    u_ctx = h_ctx @ lp['w_in']
    hy_l, sc_l, hg_l, ssd_l = jnp.split(u_lat, IN_SPLITS, -1)
    hy_c, sc_c, hg_c, ssd_c = jnp.split(u_ctx, IN_SPLITS, -1)
    hg_y_c, hg_y_l = _hgrn_branch(hg_c, hg_l, lb, lp['hg_norm_g'], ctx_out)
    ssd_y_c, ssd_y_l = _ssd_branch(ssd_c, ssd_l, lp, ctx_out)
    y_lat = _merge(h_lat, (_hyena_branch(hy_l, lp), _shortconv_branch(sc_l, lp['sc_conv_w']), hg_y_l, ssd_y_l), lp)
    y_ctx = None
    if ctx_out:
        y_ctx = _merge(h_ctx, (_hyena_branch(hy_c, lp), _shortconv_branch(sc_c, lp['sc_conv_w']), hg_y_c, ssd_y_c), lp)
    return y_lat, y_ctx


def _moe(h, w_router, b_router, w1, w3, w2):
    scores = jax.nn.softmax((h @ w_router).astype(jnp.float32), -1)
    sel = scores + b_router.astype(jnp.float32)
    grp = sel.reshape(sel.shape[:-1] + (N_EXPERT_GROUPS, N_EXPERTS // N_EXPERT_GROUPS))
    grp_score = jnp.sum(lax.top_k(grp, TOP_K)[0], -1)
    in_grp = jax.nn.one_hot(jnp.argmax(grp_score, -1), N_EXPERT_GROUPS, dtype=bool)[..., None]
    masked = jnp.where(in_grp, grp, -jnp.inf).reshape(sel.shape)
    _, idx = lax.top_k(masked, TOP_K)
    w = jnp.take_along_axis(scores, idx, -1)
    w = w / jnp.sum(w, -1, keepdims=True)
    gate = jnp.sum(jax.nn.one_hot(idx, N_EXPERTS, dtype=jnp.float32) * w[..., None], -2).astype(h.dtype)
    out = 0
    for e in range(N_EXPERTS):
        ye = (jax.nn.silu(h @ w1[e]) * (h @ w3[e])) @ w2[e]
        out = out + gate[..., e:e + 1] * ye
    return out


def setup_inputs(seed: int = 0) -> dict:
    key = jax.random.key(seed)
    ks = iter(jax.random.split(key, 48))
    nrm = lambda shape, s: s * jax.random.normal(next(ks), shape, jnp.float32)
    D = D_MODEL
    dt0 = jnp.exp(jax.random.uniform(next(ks), (DEPTH, 2, SSD_HEADS), jnp.float32, math.log(1e-3), math.log(1e-1)))
    decay0 = jnp.abs(jnp.linspace(math.log(1e-2) / 0.3, math.log(1e-2) / 1.5, HY_WIDTH, dtype=jnp.float32))
    return {
        'x': nrm((BATCH, SEQ, D), 1.0),
        'c': nrm((BATCH, D), 1.0),
        'ctx': nrm((BATCH, CTX_LEN, D), 1.0),
        'c_ctx': nrm((D,), 1.0),
        'w_ada': nrm((DEPTH, D, 6 * D), 0.5 * D ** -0.5),
        'b_ada': nrm((DEPTH, 6 * D), 0.02),
        'w_in': nrm((DEPTH, D, IN_COLS), D ** -0.5),
        'hy_conv_w': nrm((DEPTH, CONV_W, HY_COLS), CONV_W ** -0.5),
        'hy_conv_b': nrm((DEPTH, HY_COLS), 0.02),
        'hy_w1': nrm((DEPTH, HY_EMB, HY_HIDDEN), HY_EMB ** -0.5),
        'hy_b1': nrm((DEPTH, HY_HIDDEN), 0.1),
        'hy_freq1': 1.0 + nrm((DEPTH, HY_HIDDEN), 0.1),
        'hy_w2': nrm((DEPTH, HY_HIDDEN, HY_HIDDEN), HY_HIDDEN ** -0.5),
        'hy_b2': nrm((DEPTH, HY_HIDDEN), 0.1),
        'hy_freq2': 1.0 + nrm((DEPTH, HY_HIDDEN), 0.1),
        'hy_w3': nrm((DEPTH, HY_HIDDEN, 2 * HY_WIDTH), HY_HIDDEN ** -0.5),
        'hy_decay': decay0[None] * (1.0 + nrm((DEPTH, HY_WIDTH), 0.05)),
        'hy_bias': nrm((DEPTH, HY_WIDTH), 0.1),
        'sc_conv_w': nrm((DEPTH, CONV_W, SC_WIDTH), CONV_W ** -0.5),
        'hg_lb_logits': nrm((2, DEPTH, HG_KEY), 0.5),
        'hg_norm_g': 1.0 + nrm((DEPTH, HG_DV), 0.02),
        'ssd_conv_w': nrm((DEPTH, CONV_W, SSD_XBC), CONV_W ** -0.5),
        'ssd_conv_b': nrm((DEPTH, SSD_XBC), 0.02),
        'ssd_a_log': jnp.log(jax.random.uniform(next(ks), (DEPTH, 2, SSD_HEADS), jnp.float32, 1.0, 16.0)),
        'ssd_dt_bias': dt0 + jnp.log(-jnp.expm1(-dt0)),
        'ssd_d': 1.0 + nrm((DEPTH, SSD_HEADS), 0.1),
        'ssd_norm_g': 1.0 + nrm((DEPTH, SSD_INNER), 0.02),
        'w_gate': nrm((DEPTH, D, N_BRANCH * D), D ** -0.5),
        'b_gate': nrm((DEPTH, N_BRANCH * D), 0.02),
        'w_br': nrm((DEPTH, N_BRANCH, BRANCH_W, D), BRANCH_W ** -0.5),
        'w_o': nrm((DEPTH, D, D), DEEPNORM_BETA * D ** -0.5),
        'ln1_g': 1.0 + nrm((DEPTH, D), 0.02),
        'ln1_b': nrm((DEPTH, D), 0.02),
        'ln2_g': 1.0 + nrm((DEPTH, D), 0.02),
        'ln2_b': nrm((DEPTH, D), 0.02),
        'w_router': nrm((D, N_EXPERTS), D ** -0.5),
        'b_router': nrm((N_EXPERTS,), 0.01),
        'w_e1': nrm((DEPTH, N_EXPERTS, D, D_FF_EXPERT), D ** -0.5),
        'w_e3': nrm((DEPTH, N_EXPERTS, D, D_FF_EXPERT), D ** -0.5),
        'w_e2': nrm((DEPTH, N_EXPERTS, D_FF_EXPERT, D), DEEPNORM_BETA * D_FF_EXPERT ** -0.5),
    }


def reference(x, c, ctx, c_ctx, w_ada, b_ada, w_in, hy_conv_w, hy_conv_b, hy_w1, hy_b1, hy_freq1,
              hy_w2, hy_b2, hy_freq2, hy_w3, hy_decay, hy_bias, sc_conv_w, hg_lb_logits, hg_norm_g,
              ssd_conv_w, ssd_conv_b, ssd_a_log, ssd_dt_bias, ssd_d, ssd_norm_g, w_gate, b_gate, w_br,
              w_o, ln1_g, ln1_b, ln2_g, ln2_b, w_router, b_router, w_e1, w_e3, w_e2):
    ROWS = x.shape[1] // GRID_W
    lat = x + _grid_pos_embed(ROWS).astype(x.dtype)[None]
    cx = ctx
    lower_bounds = _hgrn_lower_bounds(hg_lb_logits)
    for l in range(DEPTH):
        ctx_out = l < DEPTH - 1
        lp = dict(w_in=w_in[l], hy_conv_w=hy_conv_w[l], hy_conv_b=hy_conv_b[l], hy_w1=hy_w1[l],
                  hy_b1=hy_b1[l], hy_freq1=hy_freq1[l], hy_w2=hy_w2[l], hy_b2=hy_b2[l],
                  hy_freq2=hy_freq2[l], hy_w3=hy_w3[l], hy_decay=hy_decay[l], hy_bias=hy_bias[l],
                  sc_conv_w=sc_conv_w[l], hg_norm_g=hg_norm_g[l], ssd_conv_w=ssd_conv_w[l],
                  ssd_conv_b=ssd_conv_b[l], ssd_a_log=ssd_a_log[l], ssd_dt_bias=ssd_dt_bias[l],
                  ssd_d=ssd_d[l], ssd_norm_g=ssd_norm_g[l], w_gate=w_gate[l], b_gate=b_gate[l],
                  w_br=w_br[l], w_o=w_o[l])
        mod = jax.nn.silu(c) @ w_ada[l] + b_ada[l]
        mod_c = jax.nn.silu(c_ctx) @ w_ada[l] + b_ada[l]
        sh1, sc1, g1, sh2, sc2, g2 = jnp.split(mod[:, None, :], 6, -1)
        csh1, csc1, cg1, csh2, csc2, cg2 = jnp.split(mod_c, 6, -1)
        y_lat, y_ctx = _token_mixer(lat * (1 + sc1) + sh1, cx * (1 + csc1) + csh1, lp, lower_bounds[:, l], ctx_out)
        moe = lambda h: _moe(h, w_router, b_router, w_e1[l], w_e3[l], w_e2[l])
        lat = _layernorm(DEEPNORM_ALPHA * lat + g1 * y_lat, ln1_g[l], ln1_b[l])
        lat = _layernorm(DEEPNORM_ALPHA * lat + g2 * moe(lat * (1 + sc2) + sh2), ln2_g[l], ln2_b[l])
        if ctx_out:
            cx = _layernorm(DEEPNORM_ALPHA * cx + cg1 * y_ctx, ln1_g[l], ln1_b[l])
            cx = _layernorm(DEEPNORM_ALPHA * cx + cg2 * moe(cx * (1 + csc2) + csh2), ln2_g[l], ln2_b[l])
    return lat
```

```cpp
#include <hip/hip_runtime.h>
#include <cstdio>
#include <cstdint>

#ifndef N_LAUNCH_MODE
#define N_LAUNCH_MODE 1
#endif

namespace {
typedef unsigned short bf16_t;
typedef short bf16x8 __attribute__((ext_vector_type(8)));
typedef float f32x4 __attribute__((ext_vector_type(4)));
typedef unsigned u32x2 __attribute__((ext_vector_type(2)));
typedef unsigned u32x4 __attribute__((ext_vector_type(4)));
#define LAS __attribute__((address_space(3)))

constexpr int D = 1024, NB = 8, SEQ = 4096, CTXL = 256, NLAT = NB * SEQ, NCTX = NB * CTXL, T = NLAT + NCTX;
constexpr int NLAYER = 2;
constexpr int UC = 3584;
constexpr int INC = 3592;
constexpr int NE = 16;
constexpr float ALPHA = 1.41421356237309515f;
constexpr float LN_EPS = 1e-5f, RMS_EPS = 1e-6f;
constexpr int MAXTILES = 288;

enum { I_X = 0, I_C, I_CTX, I_CCTX, I_WADA, I_BADA, I_WIN, I_HYCW, I_HYCB, I_HYW1, I_HYB1, I_HYF1, I_HYW2, I_HYB2, I_HYF2, I_HYW3, I_HYDEC, I_HYBIAS,
       I_SCCW, I_HGLB, I_HGNG, I_SSDCW, I_SSDCB, I_SSDALOG, I_SSDDTB, I_SSDD, I_SSDNG, I_WGATE, I_BGATE, I_WBR, I_WO, I_LN1G, I_LN1B, I_LN2G, I_LN2B,
       I_WROUTER, I_BROUTER, I_WE1, I_WE3, I_WE2, N_IN };

constexpr size_t al256(size_t x) { return (x + 255) & ~(size_t)255; }
constexpr size_t WS_CTL = 0;
constexpr size_t CTL_BYTES = 65536;
constexpr size_t CTL_CNT = 16384;
constexpr size_t WS_MOD = WS_CTL + CTL_BYTES;
constexpr size_t WS_LB = WS_MOD + al256((size_t)NLAYER * 9 * 6144 * 4);
constexpr size_t WS_TW = WS_LB + 4096;
constexpr size_t WS_H2TAB = WS_TW + 65536;
constexpr size_t WS_PART = WS_H2TAB + (size_t)8448 * 64 * 4;
constexpr size_t WS_FILT = WS_PART + (size_t)3 * 64 * 512 * 4;
constexpr size_t WS_FILTC = WS_FILT + (size_t)2 * 8192 * 256 * 4;
constexpr size_t WS_CX32 = WS_FILTC + (size_t)512 * 256 * 4;
constexpr size_t WS_DT = WS_CX32 + (size_t)NCTX * D * 4;
constexpr size_t WS_SSQ = WS_DT + (size_t)T * 8 * 4;
constexpr size_t WS_TOKE = WS_SSQ + (size_t)T * 4 * 4;
constexpr size_t WS_TOKW = WS_TOKE + (size_t)T * 2 * 4;
constexpr size_t WS_TOKS = WS_TOKW + (size_t)T * 2 * 4;
constexpr size_t WS_LIST = WS_TOKS + (size_t)T * 2 * 4;
constexpr size_t WS_BGP = WS_LIST + (size_t)NE * T * 4;
constexpr size_t WS_WIN = WS_BGP + 16384;
constexpr size_t WS_WG = WS_WIN + (size_t)UC * D * 2;
constexpr size_t WS_WBR = WS_WG + (size_t)4096 * D * 2;
constexpr size_t WS_WO = WS_WBR + (size_t)4096 * 256 * 2;
constexpr size_t WS_HBUF = WS_WO + (size_t)D * D * 2;
constexpr size_t WS_BR = WS_HBUF + (size_t)T * D * 2;
constexpr size_t WS_BIG = WS_BR + (size_t)T * D * 2;
constexpr size_t BIG_U = 0;
constexpr size_t BIG_HGO = BIG_U + (size_t)T * UC * 2;
constexpr size_t BIG_SSY = BIG_HGO + (size_t)T * 256 * 4;
constexpr size_t BIG_WT = BIG_SSY + (size_t)T * 256 * 4;
constexpr size_t BIG_END1 = BIG_WT + (size_t)T * 256 * 2;
constexpr size_t BIG_P = 0;
constexpr size_t BIG_HID = 0;
constexpr size_t BIG_YE = BIG_HID + (size_t)MAXTILES * 256 * 512 * 2;
constexpr size_t BIG_W13 = BIG_YE + (size_t)MAXTILES * 256 * 1024 * 2;
constexpr size_t BIG_W2 = BIG_W13 + (size_t)NE * 1024 * 1024 * 2;
constexpr size_t BIG_END3 = BIG_W2 + (size_t)NE * 1024 * 512 * 2;
constexpr size_t BIG_BYTES = BIG_END1 > BIG_END3 ? BIG_END1 : BIG_END3;
constexpr size_t WS_END = WS_BIG + BIG_BYTES;
static_assert((size_t)T * 4096 * 2 <= BIG_BYTES, "P fits");
static_assert(WS_END <= (size_t)536870912, "workspace budget");

constexpr int LDS_BYTES = 147456;
constexpr int LDS_MISC = 147456 - 256;

struct Args { const float* in[N_IN]; float* out; unsigned char* ws; int ph_lo, ph_hi; };

#define XB_TMO      128
#define XB_XCNT(j)  (256  + 64 * (j))
#define XB_XSUB(j)  (1280 + 64 * (j))
#define XB_XGEN(j)  (2304 + 64 * (j))
#define XB_TOP      3328
#define XB_TOPGEN   3392
#define XCD_BAR_WORDS 3456
#define XB_SPIN_CAP (1u << 18)
__device__ __forceinline__ unsigned xb_ld(unsigned* p)              { return __hip_atomic_load(p, __ATOMIC_RELAXED, __HIP_MEMORY_SCOPE_AGENT); }
__device__ __forceinline__ unsigned xb_add(unsigned* p, unsigned v) { return __hip_atomic_fetch_add(p, v, __ATOMIC_RELAXED, __HIP_MEMORY_SCOPE_AGENT); }
__device__ __forceinline__ unsigned xb_xcc_id() { return (unsigned)__builtin_amdgcn_s_getreg((3 << 11) | 20) & 0xFu; }
#define XB_SPIN(cond, bar) do { unsigned _sp = 0; while (cond) { __builtin_amdgcn_s_sleep(1); \
    if ((++_sp & 255u) == 0u) { if (xb_ld(&(bar)[XB_TMO])) break; if (_sp > XB_SPIN_CAP) { atomicAdd(&(bar)[XB_TMO], 1u); break; } } } } while (0)
struct XcdBarrier { unsigned* bar; unsigned x; volatile LAS unsigned* st; };
__device__ __forceinline__ int lane_id() { return (int)__builtin_amdgcn_mbcnt_hi(~0u, __builtin_amdgcn_mbcnt_lo(~0u, 0u)); }
__device__ __forceinline__ bool is_thread0(int wave_s) { return wave_s == 0 && lane_id() == 0; }
__device__ __forceinline__ XcdBarrier xcd_barrier_post(unsigned* bar, volatile LAS unsigned* st, int wave_s) {
    XcdBarrier b; b.bar = bar; b.x = xb_xcc_id(); b.st = st;
    if (is_thread0(wave_s)) (void)xb_add(&bar[XB_XCNT(b.x)], 1u);
    return b;
}
__device__ __forceinline__ void xcd_barrier_complete(unsigned* bar, unsigned x, unsigned& nloc, unsigned& nx) {
    const unsigned G = gridDim.x * gridDim.y * gridDim.z;
    unsigned sum, cnt, mine, sp = 0u;
    for (;;) {
        sum = 0u; cnt = 0u; mine = 0u;
#pragma unroll
        for (unsigned j = 0; j < 16; ++j) { const unsigned c = xb_ld(&bar[XB_XCNT(j)]); sum += c; cnt += (c > 0u) ? 1u : 0u; mine = (j == x) ? c : mine; }
        if (sum == G) break;
        __builtin_amdgcn_s_sleep(1);
        if ((++sp & 255u) == 0u) { if (xb_ld(&bar[XB_TMO])) break; if (sp > XB_SPIN_CAP) { atomicAdd(&bar[XB_TMO], 1u); break; } }
    }
    nloc = mine > 0u ? mine : 1u; nx = cnt > 0u ? cnt : 1u;
}
__device__ __forceinline__ void xcd_barrier(const XcdBarrier& b, int wave_s) {
    asm volatile("s_waitcnt vmcnt(0)" ::: "memory");
    __syncthreads();
    if (is_thread0(wave_s)) {
        unsigned* bar = b.bar;
        __builtin_amdgcn_s_waitcnt(0);
        unsigned nloc = b.st[0], nx = b.st[1];
        if (nloc == 0u) { xcd_barrier_complete(bar, b.x, nloc, nx); b.st[0] = nloc; b.st[1] = nx; }
        const unsigned old = xb_add(&bar[XB_XSUB(b.x)], 1u);
        const unsigned gen = old / nloc;
        if (old + 1u == (gen + 1u) * nloc) {
            __builtin_amdgcn_fence(__ATOMIC_RELEASE, "agent");
            asm volatile("s_waitcnt vmcnt(0)" ::: "memory");
            const unsigned og = xb_add(&bar[XB_TOP], 1u);
            const unsigned tg = og / nx;
            if (og + 1u == (tg + 1u) * nx) xb_add(&bar[XB_TOPGEN], 1u);
            else XB_SPIN(xb_ld(&bar[XB_TOPGEN]) == tg, bar);
            __builtin_amdgcn_fence(__ATOMIC_ACQUIRE, "agent");
            xb_add(&bar[XB_XGEN(b.x)], 1u);
            asm volatile("s_waitcnt vmcnt(0)" ::: "memory");
        } else {
            XB_SPIN(xb_ld(&bar[XB_XGEN(b.x)]) == gen, bar);
            __builtin_amdgcn_fence(__ATOMIC_ACQUIRE, "agent");
            asm volatile("s_waitcnt vmcnt(0)" ::: "memory");
        }
    }
    __syncthreads();
}

__device__ __forceinline__ float bf2f(bf16_t b) { return __uint_as_float(((unsigned)b) << 16); }
__device__ __forceinline__ bf16_t f2bf(float f) { unsigned u = __float_as_uint(f); u += 0x7FFFu + ((u >> 16) & 1u); return (bf16_t)(u >> 16); }
__device__ __forceinline__ unsigned pack2(float lo, float hi) { return (unsigned)f2bf(lo) | ((unsigned)f2bf(hi) << 16); }
__device__ __forceinline__ float sigmoidf_(float x) { return 1.0f / (1.0f + __expf(-x)); }
__device__ __forceinline__ float siluf_(float x) { return x * sigmoidf_(x); }
__device__ __forceinline__ float wave_sum(float v) {
#pragma unroll
    for (int o = 32; o >= 1; o >>= 1) v += __shfl_xor(v, o);
    return v;
}
__device__ __forceinline__ int row_modidx(int r) { return r < NLAT ? (r >> 12) : 8; }
__device__ __forceinline__ bool row_has_prev(int r) { return r < NLAT ? ((r & 4095) != 0) : (((r - NLAT) & 255) != 0); }
__device__ __forceinline__ bool row_has_next(int r) { return r < NLAT ? ((r & 4095) != 4095) : (((r - NLAT) & 255) != 255); }

struct Ptrs {
    const float* const* inq; float* out; unsigned char* ws; int tid, bid, G;
    __device__ __forceinline__ const float* inp(int i) const { asm volatile("" : "+s"(i)); return inq[i]; }
    __device__ __forceinline__ float* latrow(int r) const { return r < NLAT ? out + (size_t)r * D : (float*)(ws + WS_CX32) + (size_t)(r - NLAT) * D; }
    __device__ __forceinline__ float* mod(int l, int ridx) const { return (float*)(ws + WS_MOD) + ((size_t)l * 9 + ridx) * 6144; }
};

__device__ __forceinline__ float conv3_u(const bf16_t* U, int row, int col, const float* w, int ncol, int wcol) {
    float acc = bf2f(U[(size_t)row * UC + col]) * w[ncol + wcol];
    if (row_has_prev(row)) acc += bf2f(U[(size_t)(row - 1) * UC + col]) * w[wcol];
    if (row_has_next(row)) acc += bf2f(U[(size_t)(row + 1) * UC + col]) * w[2 * ncol + wcol];
    return acc;
}

struct Unit { int pm, pn, e, aux; };
__host__ __device__ __forceinline__ int perm32(int rho) { const int n = rho >> 4, i = rho & 15; return 8 * (i >> 2) + 4 * n + (i & 3); }

template <class RowMap, class Epi>
__device__ __forceinline__ void sgemm_unit(int tid_, const bf16_t* __restrict__ A, int lda, const bf16_t* __restrict__ Bt, int ldb, int K, const Unit& u, const RowMap& RM, const Epi& E) {
    const int tid = tid_, wid = tid >> 6, lane = tid & 63, wr = wid >> 2, wc = wid & 3, fr = lane & 15, fq = lane >> 4;
    f32x4 acc[2][2][4][2];
#pragma unroll
    for (int a = 0; a < 2; ++a)
#pragma unroll
        for (int b = 0; b < 2; ++b)
#pragma unroll
            for (int m = 0; m < 4; ++m)
#pragma unroll
                for (int n = 0; n < 2; ++n) acc[a][b][m][n] = (f32x4){0.f, 0.f, 0.f, 0.f};
    unsigned ap[2][4], bp[2][2];
#pragma unroll
    for (int a = 0; a < 2; ++a)
#pragma unroll
        for (int m = 0; m < 4; ++m) ap[a][m] = (unsigned)RM(u, 128 * a + 64 * wr + 16 * m + fr) * (unsigned)lda + fq * 8;
#pragma unroll
    for (int b = 0; b < 2; ++b)
#pragma unroll
        for (int n = 0; n < 2; ++n) { const int rho = 16 * n + fr; const int col = Epi::PERM ? perm32(rho) : rho;
            bp[b][n] = (unsigned)(u.pn * 256 + 128 * b + 32 * wc + col) * (unsigned)ldb + fq * 8; }
    for (int k = 0; k < K; k += 32) {
        bf16x8 bfr[2][2];
#pragma unroll
        for (int b = 0; b < 2; ++b)
#pragma unroll
            for (int n = 0; n < 2; ++n) bfr[b][n] = *(const bf16x8*)(Bt + (bp[b][n] + k));
#pragma unroll
        for (int a = 0; a < 2; ++a) {
            bf16x8 af[4];
#pragma unroll
            for (int m = 0; m < 4; ++m) af[m] = *(const bf16x8*)(A + (ap[a][m] + k));
#pragma unroll
            for (int b = 0; b < 2; ++b)
#pragma unroll
                for (int m = 0; m < 4; ++m)
#pragma unroll
                    for (int n = 0; n < 2; ++n) acc[a][b][m][n] = __builtin_amdgcn_mfma_f32_16x16x32_bf16(bfr[b][n], af[m], acc[a][b][m][n], 0, 0, 0);
        }
    }
    E(acc, u, wr, wc, fr, fq);
}

struct RowIdent { __device__ __forceinline__ int operator()(const Unit& u, int R) const { return u.pm * 256 + R; } };
struct RowStackK { int rows; __device__ __forceinline__ int operator()(const Unit& u, int R) const { return u.e * rows + u.pm * 256 + R; } };
struct RowGather { const int* list; const unsigned* cnt; __device__ __forceinline__ int operator()(const Unit& u, int R) const {
    const int idx = u.aux * 256 + R; const int* l = list + (size_t)u.e * T; return idx < (int)cnt[u.e] ? l[idx] : l[0]; } };

struct EpiBf16Plain {
    static constexpr bool PERM = true;
    bf16_t* O; int ldc; int coltile_mask;
    __device__ __forceinline__ void operator()(const f32x4 (&acc)[2][2][4][2], const Unit& u, int wr, int wc, int fr, int fq) const {
        const int row0 = u.pm * 256 + wr * 64 + fr, col0 = (u.pn & coltile_mask) * 256 + wc * 32 + 8 * fq;
#pragma unroll
        for (int ai = 0; ai < 2; ++ai)
#pragma unroll
            for (int m = 0; m < 4; ++m) { bf16_t* rowp = O + (size_t)(row0 + ai * 128 + m * 16) * ldc + col0;
#pragma unroll
                for (int bj = 0; bj < 2; ++bj) { const f32x4 v0 = acc[ai][bj][m][0], v1 = acc[ai][bj][m][1];
                    u32x4 w; w.x = pack2(v0[0], v0[1]); w.y = pack2(v0[2], v0[3]); w.z = pack2(v1[0], v1[1]); w.w = pack2(v1[2], v1[3]);
                    *(u32x4*)(rowp + bj * 128) = w; } }
    }
};
struct EpiP {
    static constexpr bool PERM = true;
    bf16_t* P; const float* ssq;
    __device__ __forceinline__ void operator()(const f32x4 (&acc)[2][2][4][2], const Unit& u, int wr, int wc, int fr, int fq) const {
        const int k = u.e;
        const unsigned c00 = (unsigned)(u.aux * 256 + wc * 32 + 8 * fq);
        const unsigned base = (unsigned)u.pm * (16u * 256u * 256u) + (unsigned)k * 64u;
#pragma unroll
        for (int ai = 0; ai < 2; ++ai)
#pragma unroll
            for (int m = 0; m < 4; ++m) { const int r = ai * 128 + wr * 64 + m * 16 + fr; float sc = 1.0f;
                if (k == 3) { const f32x4 q = *(const f32x4*)(ssq + (size_t)(u.pm * 256 + r) * 4); sc = rsqrtf((q[0] + q[1] + q[2] + q[3]) * (1.0f / 256.0f) + RMS_EPS); }
#pragma unroll
                for (int bj = 0; bj < 2; ++bj) { const unsigned c0 = c00 + bj * 128; const unsigned s = c0 >> 6, wi = c0 & 63;
                    const f32x4 v0 = acc[ai][bj][m][0] * sc, v1 = acc[ai][bj][m][1] * sc;
                    u32x4 w; w.x = pack2(v0[0], v0[1]); w.y = pack2(v0[2], v0[3]); w.z = pack2(v1[0], v1[1]); w.w = pack2(v1[2], v1[3]);
                    *(u32x4*)(P + (base + (s * 256u + (unsigned)r) * 256u + wi)) = w; }
                asm volatile("" ::: "memory"); }
    }
};
struct EpiMerge {
    static constexpr bool PERM = false;
    const bf16_t* P; const float* bgp; bf16_t* Y;
    __device__ __forceinline__ void operator()(const f32x4 (&acc)[2][2][4][2], const Unit& u, int wr, int wc, int fr, int fq) const {
        const int s = u.pn;
        f32x4 bv[2][2];
#pragma unroll
        for (int bj = 0; bj < 2; ++bj)
#pragma unroll
            for (int n = 0; n < 2; ++n) bv[bj][n] = *(const f32x4*)(bgp + s * 256 + bj * 128 + wc * 32 + n * 16 + 4 * fq);
#pragma unroll
        for (int ai = 0; ai < 2; ++ai)
#pragma unroll
            for (int m = 0; m < 4; ++m) { const int r = ai * 128 + wr * 64 + m * 16 + fr;
                const bf16_t* pp = P + (((size_t)u.pm * 16 + s) * 256 + r) * 256 + wc * 16 + 4 * fq;
                f32x4 y = (f32x4){0.f, 0.f, 0.f, 0.f};
#pragma unroll
                for (int bj = 0; bj < 2; ++bj)
#pragma unroll
                    for (int n = 0; n < 2; ++n) { const int k = 2 * bj + n; const u32x2 pw = *(const u32x2*)(pp + k * 64);
                        const f32x4 g = acc[ai][bj][m][n] + bv[bj][n];
                        y[0] += sigmoidf_(g[0]) * __uint_as_float(pw.x << 16); y[1] += sigmoidf_(g[1]) * __uint_as_float(pw.x & 0xffff0000u);
                        y[2] += sigmoidf_(g[2]) * __uint_as_float(pw.y << 16); y[3] += sigmoidf_(g[3]) * __uint_as_float(pw.y & 0xffff0000u); }
                u32x2 w; w.x = pack2(y[0], y[1]); w.y = pack2(y[2], y[3]);
                *(u32x2*)(Y + (size_t)(u.pm * 256 + r) * D + s * 64 + wc * 16 + 4 * fq) = w; }
    }
};
struct EpiWo {
    static constexpr bool PERM = false;
    Ptrs P; int layer;
    __device__ __forceinline__ void operator()(const f32x4 (&acc)[2][2][4][2], const Unit& u, int wr, int wc, int fr, int fq) const {
        const int col0 = u.pn * 256 + wc * 32 + 4 * fq;
#pragma unroll
        for (int ai = 0; ai < 2; ++ai)
#pragma unroll
            for (int m = 0; m < 4; ++m) { const int row = u.pm * 256 + ai * 128 + wr * 64 + m * 16 + fr;
                float* lp = P.latrow(row) + col0; const float* g1 = P.mod(layer, row_modidx(row)) + 2048 + col0;
#pragma unroll
                for (int bj = 0; bj < 2; ++bj)
#pragma unroll
                    for (int n = 0; n < 2; ++n) { const f32x4 x = *(const f32x4*)(lp + bj * 128 + n * 16); const f32x4 g = *(const f32x4*)(g1 + bj * 128 + n * 16);
                        *(f32x4*)(lp + bj * 128 + n * 16) = x * ALPHA + g * acc[ai][bj][m][n]; } }
    }
};
struct EpiFfn1 {
    static constexpr bool PERM = false;
    bf16_t* H;
    __device__ __forceinline__ void operator()(const f32x4 (&acc)[2][2][4][2], const Unit& u, int wr, int wc, int fr, int fq) const {
        const int pnn = u.pn & 3;
#pragma unroll
        for (int ai = 0; ai < 2; ++ai)
#pragma unroll
            for (int m = 0; m < 4; ++m) { const int pos = u.pm * 256 + ai * 128 + wr * 64 + m * 16 + fr;
#pragma unroll
                for (int bj = 0; bj < 2; ++bj) { const f32x4 a = acc[ai][bj][m][0], b = acc[ai][bj][m][1];
                    u32x2 w; w.x = pack2(siluf_(a[0]) * b[0], siluf_(a[1]) * b[1]); w.y = pack2(siluf_(a[2]) * b[2], siluf_(a[3]) * b[3]);
                    *(u32x2*)(H + (size_t)pos * 512 + pnn * 128 + bj * 64 + wc * 16 + 4 * fq) = w; } }
    }
};

template <class SrcFn>
__device__ __forceinline__ void conv_tile(int tid, LAS float* tile  , bf16_t* dst, int ldd, int n0, int k0, const SrcFn& src) {
#pragma unroll
    for (int i = 0; i < 8; ++i) { const int kk = (tid >> 6) + 8 * i, j = tid & 63; tile[kk * 65 + j] = src(k0 + kk, n0 + j); }
    __syncthreads();
    { const int jj = tid >> 3, kq = tid & 7; float v[8];
#pragma unroll
      for (int i = 0; i < 8; ++i) v[i] = tile[(8 * kq + i) * 65 + jj];
      u32x4 w; w.x = pack2(v[0], v[1]); w.y = pack2(v[2], v[3]); w.z = pack2(v[4], v[5]); w.w = pack2(v[6], v[7]);
      *(u32x4*)(dst + (size_t)(n0 + jj) * ldd + k0 + 8 * kq) = w; }
    __syncthreads();
}
constexpr int NCONV_NE = 56 * 16 + 64 * 16 + 64 * 4 + 16 * 16;
constexpr int NCONV_EX = NE * (16 * 16 + 16 * 8);
__device__ __forceinline__ int gate_srccol(int np) { const int s = np >> 8, bj = (np >> 7) & 1, wc = (np >> 5) & 3, n = (np >> 4) & 1, fqe = np & 15; return (2 * bj + n) * 1024 + 64 * s + 16 * wc + fqe; }
__device__ void conv_unit_ne(const Ptrs P, int l, int t, LAS float* tile) {
    unsigned char* ws = P.ws;
    if (t < 896) { const int nt = t >> 4, kt = t & 15; const float* src = P.inp(I_WIN) + (size_t)l * D * INC;
        conv_tile(P.tid, tile, (bf16_t*)(ws + WS_WIN), D, nt * 64, kt * 64, [=](int k, int n) { return src[(size_t)k * INC + n]; });
    } else if (t < 896 + 1024) { t -= 896; const int nt = t >> 4, kt = t & 15; const float* src = P.inp(I_WGATE) + (size_t)l * D * 4096;
        conv_tile(P.tid, tile, (bf16_t*)(ws + WS_WG), D, nt * 64, kt * 64, [=](int k, int n) { return src[(size_t)k * 4096 + gate_srccol(n)]; });
        if (kt == 0 && P.tid < 64) { const int np = nt * 64 + P.tid; ((float*)(ws + WS_BGP))[np] = P.inp(I_BGATE)[(size_t)l * 4096 + gate_srccol(np)]; }
    } else if (t < 896 + 1024 + 256) { t -= 1920; const int nt = t >> 2, kt = t & 3; const int kb = nt >> 4;
        const float* src = P.inp(I_WBR) + ((size_t)l * 4 + kb) * 256 * 1024; const float* ng = P.inp(I_SSDNG) + l * 256; const bool sc = (kb == 3);
        conv_tile(P.tid, tile, (bf16_t*)(ws + WS_WBR), 256, nt * 64, kt * 64, [=](int k, int n) { const float v = src[(size_t)k * 1024 + (n & 1023)]; return sc ? v * ng[k] : v; });
    } else { t -= 2176; const int nt = t >> 4, kt = t & 15; const float* src = P.inp(I_WO) + (size_t)l * D * D;
        conv_tile(P.tid, tile, (bf16_t*)(ws + WS_WO), D, nt * 64, kt * 64, [=](int k, int n) { return src[(size_t)k * D + n]; });
    }
}
__device__ void conv_unit_ex(const Ptrs P, int l, int t, LAS float* tile) {
    unsigned char* ws = P.ws;
    const int e = t / 384; t -= e * 384;
    if (t < 256) { const int nt = t >> 4, kt = t & 15;
        const float* s1 = P.inp(I_WE1) + ((size_t)l * NE + e) * 1024 * 512; const float* s3 = P.inp(I_WE3) + ((size_t)l * NE + e) * 1024 * 512;
        conv_tile(P.tid, tile, (bf16_t*)(ws + WS_BIG + BIG_W13) + (size_t)e * 1024 * 1024, 1024, nt * 64, kt * 64, [=](int k, int n) {
            const int pn = n >> 8, bj = (n >> 7) & 1, wc = (n >> 5) & 3, nn = (n >> 4) & 1, fqe = n & 15; const int ch = 128 * pn + 64 * bj + 16 * wc + fqe;
            return (nn ? s3 : s1)[(size_t)k * 512 + ch]; });
    } else { t -= 256; const int nt = t >> 3, kt = t & 7; const float* src = P.inp(I_WE2) + ((size_t)l * NE + e) * 512 * 1024;
        conv_tile(P.tid, tile, (bf16_t*)(ws + WS_BIG + BIG_W2) + (size_t)e * 1024 * 512, 512, nt * 64, kt * 64, [=](int k, int n) { return src[(size_t)k * 1024 + n]; });
    }
}

struct RowV { f32x4 v[4]; };
__device__ __forceinline__ void row_load(RowV& r, const float* p, int lane) {
#pragma unroll
    for (int i = 0; i < 4; ++i) r.v[i] = *(const f32x4*)(p + i * 256 + lane * 4);
}
__device__ __forceinline__ void row_store(const RowV& r, float* p, int lane) {
#pragma unroll
    for (int i = 0; i < 4; ++i) *(f32x4*)(p + i * 256 + lane * 4) = r.v[i];
}
__device__ __forceinline__ void row_layernorm(RowV& r, const float* g, const float* b, int lane) {
    float s = 0.f;
#pragma unroll
    for (int i = 0; i < 4; ++i) s += r.v[i][0] + r.v[i][1] + r.v[i][2] + r.v[i][3];
    const float mu = wave_sum(s) * (1.0f / 1024.0f);
    float q = 0.f;
#pragma unroll
    for (int i = 0; i < 4; ++i) { const f32x4 d = r.v[i] - mu; q += d[0] * d[0] + d[1] * d[1] + d[2] * d[2] + d[3] * d[3]; }
    const float rstd = rsqrtf(wave_sum(q) * (1.0f / 1024.0f) + LN_EPS);
#pragma unroll
    for (int i = 0; i < 4; ++i) { const f32x4 gg = *(const f32x4*)(g + i * 256 + lane * 4), bb = *(const f32x4*)(b + i * 256 + lane * 4); r.v[i] = (r.v[i] - mu) * rstd * gg + bb; }
}
__device__ __forceinline__ void row_modulate(const RowV& r, RowV& h, const float* sh, const float* sc, int lane) {
#pragma unroll
    for (int i = 0; i < 4; ++i) { const f32x4 a = *(const f32x4*)(sc + i * 256 + lane * 4), b = *(const f32x4*)(sh + i * 256 + lane * 4); h.v[i] = r.v[i] * (a + 1.0f) + b; }
}
__device__ __forceinline__ void row_store_bf16(const RowV& h, bf16_t* p, int lane) {
#pragma unroll
    for (int i = 0; i < 4; ++i) { u32x2 w; w.x = pack2(h.v[i][0], h.v[i][1]); w.y = pack2(h.v[i][2], h.v[i][3]); *(u32x2*)(p + i * 256 + lane * 4) = w; }
}
__device__ __forceinline__ void row_dt(const RowV& h, const LAS float* wdt, float* dtout, int lane) {
    float a[8];
#pragma unroll
    for (int j = 0; j < 8; ++j) a[j] = 0.f;
#pragma unroll
    for (int i = 0; i < 4; ++i)
#pragma unroll
        for (int e = 0; e < 4; ++e) { const int k = i * 256 + lane * 4 + e; const float hv = h.v[i][e];
            const f32x4 w0 = *(const LAS f32x4*)(wdt + k * 8), w1 = *(const LAS f32x4*)(wdt + k * 8 + 4);
            a[0] += hv * w0[0]; a[1] += hv * w0[1]; a[2] += hv * w0[2]; a[3] += hv * w0[3]; a[4] += hv * w1[0]; a[5] += hv * w1[1]; a[6] += hv * w1[2]; a[7] += hv * w1[3]; }
#pragma unroll
    for (int j = 0; j < 8; ++j) a[j] = wave_sum(a[j]);
    if (lane == 0) { *(f32x4*)dtout = (f32x4){a[0], a[1], a[2], a[3]}; *(f32x4*)(dtout + 4) = (f32x4){a[4], a[5], a[6], a[7]}; }
}
__device__ __forceinline__ void load_wdt(const Ptrs P, int l, LAS float* wdt) {
    const float* src = P.inp(I_WIN) + (size_t)l * D * INC + UC;
    for (int i = P.tid; i < 1024 * 8; i += 512) wdt[i] = src[(size_t)(i >> 3) * INC + (i & 7)];
    __syncthreads();
}

__device__ __forceinline__ void phase_pa(const Ptrs P, LAS unsigned char* lds) {
    const int tid = P.tid, wid = tid >> 6, lane = tid & 63, G = P.G;
    const int NU_MOD = 2 * 96, NU_H2 = 8448 / 8, NU_LB = 1;
    const int NU = NU_MOD + NU_H2 + NU_LB + NCONV_NE;
    for (int u = P.bid; u < NU; u += G) {
        if (u < NU_MOD) {
            const int l = u / 96, cb = u % 96;
            LAS float* sc = (LAS float*)lds; LAS float* red = sc + 9 * 1024;
            for (int i = tid; i < 9 * 1024; i += 512) { const int r = i >> 10, k = i & 1023; const float v = r < 8 ? P.inp(I_C)[r * 1024 + k] : P.inp(I_CCTX)[k]; sc[i] = v / (1.0f + expf(-v)); }
            __syncthreads();
            const int col = cb * 64 + lane; const float* w = P.inp(I_WADA) + (size_t)l * D * 6144 + col;
            float acc[9];
#pragma unroll
            for (int r = 0; r < 9; ++r) acc[r] = 0.f;
            for (int k = wid * 128; k < wid * 128 + 128; ++k) { const float wv = w[(size_t)k * 6144];
#pragma unroll
                for (int r = 0; r < 9; ++r) acc[r] += sc[r * 1024 + k] * wv; }
#pragma unroll
            for (int r = 0; r < 9; ++r) red[(wid * 9 + r) * 64 + lane] = acc[r];
            __syncthreads();
            for (int i = tid; i < 9 * 64; i += 512) { const int r = i >> 6, c = i & 63; float s = P.inp(I_BADA)[(size_t)l * 6144 + cb * 64 + c];
#pragma unroll
                for (int w8 = 0; w8 < 8; ++w8) s += red[(w8 * 9 + r) * 64 + c];
                P.mod(l, r)[cb * 64 + c] = s; }
            __syncthreads();
        } else if (u < NU_MOD + NU_H2) {
            const int rho = (u - NU_MOD) * 8 + wid;
            const int l = (rho >= 4096 && rho < 8192) ? 1 : 0; const int L = rho < 8192 ? 4096 : 256; const int i = rho < 8192 ? (rho & 4095) : (rho - 8192);
            float featv = 0.f;
            if (lane == 0) featv = (float)((double)i / (double)(L - 1));
            else if (lane < 33) { const int j = (lane - 1) & 15; const double band = 1e-4 + (double)j * ((15.0 - 1e-4) / 15.0);
                const double ang = (2.0 * 3.14159265358979323846 / (double)L) * (double)i * band; featv = lane < 17 ? (float)cos(ang) : (float)(-sin(ang)); }
            float z1 = P.inp(I_HYB1)[l * 64 + lane];
            for (int m = 0; m < 33; ++m) z1 += __shfl(featv, m) * P.inp(I_HYW1)[((size_t)l * 33 + m) * 64 + lane];
            const float h1 = sinf(P.inp(I_HYF1)[l * 64 + lane] * z1);
            float z2 = P.inp(I_HYB2)[l * 64 + lane];
            for (int m = 0; m < 64; ++m) z2 += __shfl(h1, m) * P.inp(I_HYW2)[((size_t)l * 64 + m) * 64 + lane];
            ((float*)(P.ws + WS_H2TAB))[(size_t)rho * 64 + lane] = sinf(P.inp(I_HYF2)[l * 64 + lane] * z2);
        } else if (u < NU_MOD + NU_H2 + NU_LB) {
            for (int i = tid; i < 1024; i += 512) { const int d = i >> 9, l = (i >> 8) & 1, c = i & 255;
                const float l0 = P.inp(I_HGLB)[d * 512 + c], l1 = P.inp(I_HGLB)[d * 512 + 256 + c];
                ((float*)(P.ws + WS_LB))[i] = l == 0 ? 0.0f : 1.0f / (1.0f + expf(l0 - l1)); }
        } else {
            conv_unit_ne(P, 0, u - (NU_MOD + NU_H2 + NU_LB), (LAS float*)lds);
        }
    }
}

__device__ __forceinline__ void emit_rows_init(const Ptrs P, LAS float* wdt);
__device__ __forceinline__ void phase_pb(const Ptrs P, LAS unsigned char* lds) {
    const int tid = P.tid, G = P.G;
    for (int u = P.bid; u < 132; u += G) {
        const int tab = u < 64 ? 0 : (u < 128 ? 1 : 2); const int ib = tab == 0 ? u : (tab == 1 ? u - 64 : u - 128);
        const int l = tab == 1 ? 1 : 0; const int L = tab == 2 ? 256 : 4096; const int rho0 = (tab == 0 ? 0 : (tab == 1 ? 4096 : 8192)) + ib * 64;
        LAS float* h2 = (LAS float*)lds;
        for (int i = tid; i < 64 * 64; i += 512) h2[i] = ((const float*)(P.ws + WS_H2TAB))[(size_t)rho0 * 64 + i];
        __syncthreads();
        const int o = tid, c = tid & 255, dir = tid >> 8;
        float w3[64];
#pragma unroll
        for (int j = 0; j < 64; ++j) w3[j] = P.inp(I_HYW3)[((size_t)l * 64 + j) * 512 + o];
        const float dec = fabsf(P.inp(I_HYDEC)[l * 256 + c]);
        float* filt = tab == 2 ? (float*)(P.ws + WS_FILTC) : (float*)(P.ws + WS_FILT) + (size_t)l * 8192 * 256;
        const int L2 = 2 * L; float part = 0.f;
        for (int r = 0; r < 64; ++r) { const int i = ib * 64 + r; float s = 0.f;
#pragma unroll
            for (int j = 0; j < 64; ++j) s += h2[r * 64 + j] * w3[j];
            const float t = (float)i / (float)(L - 1); s *= expf(-t * dec);
            if (dir == 0) { filt[(size_t)i * 256 + c] = s; part += fabsf(s); }
            else if (i == 0) filt[(size_t)L * 256 + c] = 0.f;
            else { filt[(size_t)(L2 - i) * 256 + c] = s; part += fabsf(s); } }
        ((float*)(P.ws + WS_PART))[((size_t)tab * 64 + ib) * 512 + o] = part;
        __syncthreads();
    }
    emit_rows_init(P, (LAS float*)(lds + 32768));
}
__device__ __forceinline__ float hy_norm(const Ptrs P, int tab, int c) {
    const float* part = (const float*)(P.ws + WS_PART) + (size_t)tab * 64 * 512; const int nb = tab == 2 ? 4 : 64; float s = 0.f;
    for (int b = 0; b < nb; ++b) s += part[b * 512 + c] + part[b * 512 + 256 + c];
    return s;
}

__device__ __forceinline__ void emit_rows_init(const Ptrs P, LAS float* wdt) {
    const int tid = P.tid, wid = tid >> 6, lane = tid & 63, G = P.G;
    load_wdt(P, 0, wdt);
    for (int u = P.bid; u < T / 8; u += G) {
        const int row = u * 8 + wid; RowV r;
        if (row < NLAT) { row_load(r, P.inp(I_X) + (size_t)row * D, lane);
            const int t = row & 4095; const float prow = (float)(t >> 6), pcol = (float)(t & 63);
#pragma unroll
            for (int i = 0; i < 4; ++i)
#pragma unroll
                for (int e = 0; e < 4; ++e) { const int idx = i * 256 + lane * 4 + e; const int f = idx & 511, ii = f & 255; const float pos = (idx >> 9) ? pcol : prow;
                    const float om = expf(-9.210340371976184f * (float)ii * (1.0f / 256.0f)); const float a = pos * om; r.v[i][e] += (f < 256) ? sinf(a) : cosf(a); }
        } else row_load(r, P.inp(I_CTX) + (size_t)(row - NLAT) * D, lane);
        row_store(r, P.latrow(row), lane);
        const float* m = P.mod(0, row_modidx(row)); RowV h; row_modulate(r, h, m, m + 1024, lane);
        row_store_bf16(h, (bf16_t*)(P.ws + WS_HBUF) + (size_t)row * D, lane);
        row_dt(h, wdt, (float*)(P.ws + WS_DT) + (size_t)row * 8, lane);
    }
}

__device__ __forceinline__ void phase_g1(const Ptrs P) {
    const bf16_t* A = (const bf16_t*)(P.ws + WS_HBUF); const bf16_t* Bt = (const bf16_t*)(P.ws + WS_WIN);
    EpiBf16Plain E{(bf16_t*)(P.ws + WS_BIG + BIG_U), UC, 0xffff};
    const int NU = (T / 256) * 14;
    for (int L = P.bid; L < NU; L += P.G) { Unit u{L / 14, L % 14, 0, 0}; sgemm_unit(P.tid, A, D, Bt, D, D, u, RowIdent{}, E); }
}

__device__ __forceinline__ void phase_m1(const Ptrs P, int l) {
    const int tid = P.tid, G = P.G;
    const bf16_t* U = (const bf16_t*)(P.ws + WS_BIG + BIG_U);
    bf16_t* WT = (bf16_t*)(P.ws + WS_BIG + BIG_WT); bf16_t* XACT = (bf16_t*)(P.ws + WS_BR);
    const float* hcw = P.inp(I_HYCW) + (size_t)l * 3 * 768; const float* hcb = P.inp(I_HYCB) + l * 768;
    const float* scw = P.inp(I_SSDCW) + (size_t)l * 3 * 512; const float* scb = P.inp(I_SSDCB) + l * 512;
    const int NU = 2 * (T / 64);
    for (int u = P.bid; u < NU; u += G) {
        if (u < T / 64) {
            const int c = tid & 255;
            for (int rr = tid >> 8; rr < 64; rr += 2) { const int row = u * 64 + rr;
                const float x1 = conv3_u(U, row, 256 + c, hcw, 768, 256 + c) + hcb[256 + c]; const float v = conv3_u(U, row, 512 + c, hcw, 768, 512 + c) + hcb[512 + c];
                WT[(size_t)row * 256 + c] = f2bf(x1 * v); }
        } else {
            const int u2 = u - T / 64;
            for (int rr = 0; rr < 64; ++rr) { const int row = u2 * 64 + rr; const float v = conv3_u(U, row, 3072 + tid, scw, 512, tid) + scb[tid]; XACT[(size_t)row * 512 + tid] = f2bf(siluf_(v)); }
        }
    }
}

__device__ __forceinline__ void phase_m2(const Ptrs P, int l, LAS unsigned char* lds) {
    const int tid = P.tid, G = P.G;
    const bf16_t* U = (const bf16_t*)(P.ws + WS_BIG + BIG_U); const bf16_t* XACT = (const bf16_t*)(P.ws + WS_BR);
    float* HGO = (float*)(P.ws + WS_BIG + BIG_HGO); float* SSY = (float*)(P.ws + WS_BIG + BIG_SSY); const float* DT = (const float*)(P.ws + WS_DT);
    LAS float* red = (LAS float*)lds;
    for (int u = P.bid; u < 64; u += G) {
        const int kind = u >> 5, b = (u >> 2) & 7, h = u & 3;
        const int lo = tid & 63, hi = tid >> 6;
        if (kind == 0) {
            for (int dir = 0; dir < 2; ++dir) {
                float S[8], lbv[8];
#pragma unroll
                for (int j = 0; j < 8; ++j) { S[j] = 0.f; lbv[j] = ((const float*)(P.ws + WS_LB))[(dir * 2 + l) * 256 + h * 64 + hi * 8 + j]; }
                for (int seg = 0; seg < 2; ++seg) { const int len = seg == 0 ? CTXL : SEQ; const int base = seg == 0 ? NLAT + b * CTXL : b * SEQ;
                    for (int step = 0; step < len; ++step) { const int row = base + (dir == 0 ? step : len - 1 - step); const bf16_t* ur = U + (size_t)row * UC;
                        const float v = bf2f(ur[2304 + h * 64 + lo]); float part = 0.f;
                        const bf16x8 fv = *(const bf16x8*)(ur + 1792 + dir * 256 + h * 64 + hi * 8), qv = *(const bf16x8*)(ur + 1536 + h * 64 + hi * 8);
#pragma unroll
                        for (int j = 0; j < 8; ++j) { const float f = lbv[j] + (1.0f - lbv[j]) * sigmoidf_(bf2f((bf16_t)fv[j])); const float q = bf2f((bf16_t)qv[j]) * 0.125f;
                            S[j] = f * S[j] + (1.0f - f) * v; part += S[j] * q; }
                        red[hi * 64 + lo] = part; __syncthreads();
                        if (tid < 64) { float o = 0.f;
#pragma unroll
                            for (int g = 0; g < 8; ++g) o += red[g * 64 + tid];
                            float* p = HGO + (size_t)row * 256 + h * 64 + tid; if (dir == 0) *p = o; else *p += o; }
                        __syncthreads(); } }
            }
        } else {
            const int g = h >> 1;
            for (int dir = 0; dir < 2; ++dir) {
                float hs[8];
#pragma unroll
                for (int j = 0; j < 8; ++j) hs[j] = 0.f;
                const float Aneg = -expf(P.inp(I_SSDALOG)[(l * 2 + dir) * 4 + h]); const float dtb = P.inp(I_SSDDTB)[(l * 2 + dir) * 4 + h];
                for (int seg = 0; seg < 2; ++seg) { const int len = seg == 0 ? CTXL : SEQ; const int base = seg == 0 ? NLAT + b * CTXL : b * SEQ;
                    for (int step = 0; step < len; ++step) { const int row = base + (dir == 0 ? step : len - 1 - step); const bf16_t* xr = XACT + (size_t)row * 512;
                        const float dr = DT[(size_t)row * 8 + dir * 4 + h] + dtb; const float dtv = dr > 20.f ? dr : log1pf(expf(dr)); const float dA = expf(Aneg * dtv);
                        const float x = bf2f(xr[h * 64 + lo]) * dtv; float part = 0.f;
                        const bf16x8 Bv = *(const bf16x8*)(xr + 256 + g * 64 + hi * 8), Cv = *(const bf16x8*)(xr + 384 + g * 64 + hi * 8);
#pragma unroll
                        for (int j = 0; j < 8; ++j) { hs[j] = dA * hs[j] + x * bf2f((bf16_t)Bv[j]); part += hs[j] * bf2f((bf16_t)Cv[j]); }
                        red[hi * 64 + lo] = part; __syncthreads();
                        if (tid < 64) { float y = 0.f;
#pragma unroll
                            for (int gg = 0; gg < 8; ++gg) y += red[gg * 64 + tid];
                            float* p = SSY + (size_t)row * 256 + h * 64 + tid; if (dir == 0) *p = y; else *p += y; }
                        __syncthreads(); } }
            }
        }
    }
}

__device__ __forceinline__ void phase_m3(const Ptrs P, int l) {
    const int tid = P.tid, wid = tid >> 6, lane = tid & 63, G = P.G;
    const int rows_l = (l == NLAYER - 1) ? NLAT : T;
    const bf16_t* U = (const bf16_t*)(P.ws + WS_BIG + BIG_U); const bf16_t* WT = (const bf16_t*)(P.ws + WS_BIG + BIG_WT);
    bf16_t* BR = (bf16_t*)(P.ws + WS_BR);
    const float* hcw = P.inp(I_HYCW) + (size_t)l * 3 * 768; const float* hcb = P.inp(I_HYCB) + l * 768;
    const int NU_HL = NB * 256, NU_HC = (l == 0) ? NB * 16 : 0, NU_R = rows_l / 64;
    const int NU = NU_HL + NU_HC + 3 * NU_R;
    for (int u = P.bid; u < NU; u += G) {
        if (u < NU_HL + NU_HC) {
            const bool isc = u >= NU_HL; const int uu = isc ? u - NU_HL : u; const int L = isc ? CTXL : SEQ; const int msk = 2 * L - 1;
            const int b = isc ? (uu >> 4) : (uu >> 8); const int t0 = (isc ? (uu & 15) : (uu & 255)) * 16 + (tid >> 8) * 8; const int c = tid & 255;
            const int base = isc ? NLAT + b * CTXL : b * SEQ;
            const float* filt = isc ? (const float*)(P.ws + WS_FILTC) : (const float*)(P.ws + WS_FILT) + (size_t)l * 8192 * 256;
            float acc[8], fw[8];
#pragma unroll
            for (int j = 0; j < 8; ++j) { acc[j] = 0.f; fw[j] = filt[(size_t)((t0 + j) & msk) * 256 + c]; }
            for (int s = 0; s < L; ++s) { const float w = bf2f(WT[(size_t)(base + s) * 256 + c]);
#pragma unroll
                for (int j = 0; j < 8; ++j) acc[j] += fw[j] * w;
#pragma unroll
                for (int j = 7; j > 0; --j) fw[j] = fw[j - 1];
                fw[0] = filt[(size_t)((t0 - s - 1) & msk) * 256 + c]; }
            const float inv = 1.0f / hy_norm(P, isc ? 2 : l, c); const float bias = P.inp(I_HYBIAS)[l * 256 + c];
#pragma unroll
            for (int j = 0; j < 8; ++j) { const int row = base + t0 + j; const float x0 = conv3_u(U, row, c, hcw, 768, c) + hcb[c]; const float w = bf2f(WT[(size_t)row * 256 + c]);
                BR[(size_t)row * 256 + c] = f2bf(x0 * (acc[j] * inv + w * bias)); }
        } else {
            const int v = u - NU_HL - NU_HC; const int kind = v / NU_R, rb = v % NU_R;
            if (kind == 0) {
                const float* cw = P.inp(I_SCCW) + (size_t)l * 3 * 256; const int c = tid & 255;
                for (int rr = tid >> 8; rr < 64; rr += 2) { const int row = rb * 64 + rr; float acc = 0.f;
#pragma unroll
                    for (int k = 0; k < 3; ++k) { const int r2 = row + k - 1; const bool ok = (k == 1) || (k == 0 ? row_has_prev(row) : row_has_next(row));
                        if (ok) acc += bf2f(U[(size_t)r2 * UC + 1024 + c]) * bf2f(U[(size_t)r2 * UC + 1280 + c]) * cw[k * 256 + c]; }
                    BR[(size_t)T * 256 + (size_t)row * 256 + c] = f2bf(bf2f(U[(size_t)row * UC + 768 + c]) * acc); }
            } else if (kind == 1) {
                const float* HGO = (const float*)(P.ws + WS_BIG + BIG_HGO); const float ng = P.inp(I_HGNG)[l * 64 + lane];
                for (int rr = wid; rr < 64; rr += 8) { const int row = rb * 64 + rr;
#pragma unroll
                    for (int h = 0; h < 4; ++h) { const float o = HGO[(size_t)row * 256 + h * 64 + lane]; const float ms = wave_sum(o * o) * (1.0f / 64.0f);
                        const float gt = bf2f(U[(size_t)row * UC + 2560 + h * 64 + lane]);
                        BR[(size_t)2 * T * 256 + (size_t)row * 256 + h * 64 + lane] = f2bf(o * rsqrtf(ms + RMS_EPS) * ng * siluf_(gt)); } }
            } else {
                const float* SSY = (const float*)(P.ws + WS_BIG + BIG_SSY); float* SSQ = (float*)(P.ws + WS_SSQ);
                const float* scw = P.inp(I_SSDCW) + (size_t)l * 3 * 512; const float* scb = P.inp(I_SSDCB) + l * 512;
                for (int rr = wid; rr < 64; rr += 8) { const int row = rb * 64 + rr;
#pragma unroll
                    for (int h = 0; h < 4; ++h) { const int c = h * 64 + lane; const float xs = siluf_(conv3_u(U, row, 3072 + c, scw, 512, c) + scb[c]);
                        const float y = SSY[(size_t)row * 256 + c] + xs * P.inp(I_SSDD)[l * 4 + h]; const float z = bf2f(U[(size_t)row * UC + 2816 + c]);
                        const float vv = y * siluf_(z); const float q = wave_sum(vv * vv);
                        if (lane == 0) SSQ[(size_t)row * 4 + h] = q;
                        BR[(size_t)3 * T * 256 + (size_t)row * 256 + c] = f2bf(vv); } }
            }
        }
    }
}

__device__ __forceinline__ void phase_g2(const Ptrs P, int l) {
    const int MT = ((l == NLAYER - 1) ? NLAT : T) / 256;
    const bf16_t* A = (const bf16_t*)(P.ws + WS_BR); const bf16_t* Bt = (const bf16_t*)(P.ws + WS_WBR);
    EpiP E{(bf16_t*)(P.ws + WS_BIG + BIG_P), (const float*)(P.ws + WS_SSQ)};
    const int NU = 4 * MT * 4;
    for (int L = P.bid; L < NU; L += P.G) { const int k = L / (MT * 4), rem = L % (MT * 4); Unit u{rem >> 2, k * 4 + (rem & 3), k, rem & 3}; sgemm_unit(P.tid, A, 256, Bt, 256, 256, u, RowStackK{T}, E); }
}
__device__ __forceinline__ void phase_g3(const Ptrs P, int l) {
    const int MT = ((l == NLAYER - 1) ? NLAT : T) / 256;
    const bf16_t* A = (const bf16_t*)(P.ws + WS_HBUF); const bf16_t* Bt = (const bf16_t*)(P.ws + WS_WG);
    EpiMerge E{(const bf16_t*)(P.ws + WS_BIG + BIG_P), (const float*)(P.ws + WS_BGP), (bf16_t*)(P.ws + WS_BR)};
    const int NU = MT * 16;
    for (int L = P.bid; L < NU; L += P.G) { Unit u{L >> 4, L & 15, 0, 0}; sgemm_unit(P.tid, A, D, Bt, D, D, u, RowIdent{}, E); }
}
__device__ __forceinline__ void phase_g4(const Ptrs P, int l) {
    const int MT = ((l == NLAYER - 1) ? NLAT : T) / 256;
    const bf16_t* A = (const bf16_t*)(P.ws + WS_BR); const bf16_t* Bt = (const bf16_t*)(P.ws + WS_WO);
    EpiWo E{P, l};
    const int NU = MT * 4;
    for (int L = P.bid; L < NU; L += P.G) { Unit u{L >> 2, L & 3, 0, 0}; sgemm_unit(P.tid, A, D, Bt, D, D, u, RowIdent{}, E); }
}

__device__ __forceinline__ void phase_e5(const Ptrs P, int l, LAS unsigned char* lds) {
    const int tid = P.tid, wid = tid >> 6, lane = tid & 63, G = P.G;
    const int rows_l = (l == NLAYER - 1) ? NLAT : T;
    LAS float* wrT = (LAS float*)lds;
    LAS float* tile = (LAS float*)(lds + 65536);
    for (int i = tid; i < 1024 * 16; i += 512) wrT[(i & 15) * 1024 + (i >> 4)] = P.inp(I_WROUTER)[i];
    __syncthreads();
    unsigned* cnt = (unsigned*)(P.ws + WS_CTL + CTL_CNT) + l * 16;
    int* toke = (int*)(P.ws + WS_TOKE); float* tokw = (float*)(P.ws + WS_TOKW); int* toks = (int*)(P.ws + WS_TOKS); int* list = (int*)(P.ws + WS_LIST);
    const float* g = P.inp(I_LN1G) + l * D; const float* bta = P.inp(I_LN1B) + l * D;
    const int NU_R = rows_l / 8; const int NU = NU_R + NCONV_EX;
    for (int u = P.bid; u < NU; u += G) {
        if (u >= NU_R) { conv_unit_ex(P, l, u - NU_R, tile); continue; }
        const int row = u * 8 + wid; RowV r; float* lp = P.latrow(row);
        row_load(r, lp, lane); row_layernorm(r, g, bta, lane); row_store(r, lp, lane);
        const float* m = P.mod(l, row_modidx(row)); RowV h; row_modulate(r, h, m + 3072, m + 4096, lane);
        row_store_bf16(h, (bf16_t*)(P.ws + WS_HBUF) + (size_t)row * D, lane);
        float lg[16];
#pragma unroll
        for (int e = 0; e < 16; ++e) { float s = 0.f;
#pragma unroll
            for (int i = 0; i < 4; ++i) { const f32x4 w = *(const LAS f32x4*)(wrT + e * 1024 + i * 256 + lane * 4); s += h.v[i][0] * w[0] + h.v[i][1] * w[1] + h.v[i][2] * w[2] + h.v[i][3] * w[3]; }
            lg[e] = wave_sum(s); }
        float mx = lg[0];
#pragma unroll
        for (int e = 1; e < 16; ++e) mx = fmaxf(mx, lg[e]);
        float sc[16], sel[16], ssum = 0.f;
#pragma unroll
        for (int e = 0; e < 16; ++e) { sc[e] = expf(lg[e] - mx); ssum += sc[e]; }
        const float inv = 1.0f / ssum;
#pragma unroll
        for (int e = 0; e < 16; ++e) { sc[e] *= inv; sel[e] = sc[e] + P.inp(I_BROUTER)[e]; }
        int bestg = 0; float bestgs = -3.0e38f;
#pragma unroll
        for (int gq = 0; gq < 4; ++gq) { float m1 = -3.0e38f, m2 = -3.0e38f;
#pragma unroll
            for (int j = 0; j < 4; ++j) { const float v = sel[gq * 4 + j]; if (v > m1) { m2 = m1; m1 = v; } else if (v > m2) m2 = v; }
            const float gs = m1 + m2; if (gs > bestgs) { bestgs = gs; bestg = gq; } }
        int i1 = 0, i2 = 0; float v1 = -3.0e38f, v2 = -3.0e38f, w1 = 0.f, w2 = 0.f;
#pragma unroll
        for (int e = 0; e < 16; ++e) { if ((e >> 2) == bestg && sel[e] > v1) { v1 = sel[e]; i1 = e; w1 = sc[e]; } }
#pragma unroll
        for (int e = 0; e < 16; ++e) { if ((e >> 2) == bestg && e != i1 && sel[e] > v2) { v2 = sel[e]; i2 = e; w2 = sc[e]; } }
        if (lane == 0) { const float ws_ = 1.0f / (w1 + w2);
            const int s1 = (int)__hip_atomic_fetch_add(cnt + i1, 1u, __ATOMIC_RELAXED, __HIP_MEMORY_SCOPE_AGENT);
            const int s2 = (int)__hip_atomic_fetch_add(cnt + i2, 1u, __ATOMIC_RELAXED, __HIP_MEMORY_SCOPE_AGENT);
            list[(size_t)i1 * T + s1] = row; list[(size_t)i2 * T + s2] = row;
            toke[row * 2] = i1; toke[row * 2 + 1] = i2; tokw[row * 2] = w1 * ws_; tokw[row * 2 + 1] = w2 * ws_; toks[row * 2] = s1; toks[row * 2 + 1] = s2; }
    }
}

struct MoeSeg { int toff[17]; };
__device__ __forceinline__ void moe_seg(const unsigned* cnt, MoeSeg& S) { int a = 0;
#pragma unroll
    for (int e = 0; e < 16; ++e) { S.toff[e] = a; a += ((int)cnt[e] + 255) >> 8; }
    S.toff[16] = a; }
__device__ __forceinline__ int moe_find(const MoeSeg& S, int tg, int& off) { int e = 0; off = 0;
#pragma unroll
    for (int j = 1; j < 16; ++j) { const bool ge = (tg >= S.toff[j]); e += ge ? 1 : 0; off = ge ? S.toff[j] : off; }
    return e; }

__device__ __forceinline__ void phase_g5(const Ptrs P, int l) {
    const unsigned* cnt = (const unsigned*)(P.ws + WS_CTL + CTL_CNT) + l * 16; MoeSeg S; moe_seg(cnt, S);
    const bf16_t* A = (const bf16_t*)(P.ws + WS_HBUF); const bf16_t* Bt = (const bf16_t*)(P.ws + WS_BIG + BIG_W13);
    EpiFfn1 E{(bf16_t*)(P.ws + WS_BIG + BIG_HID)}; RowGather RG{(const int*)(P.ws + WS_LIST), cnt};
    const int NU = S.toff[16] * 4;
    for (int L = P.bid; L < NU; L += P.G) { const int tg = L >> 2, pnn = L & 3; int off; const int e = moe_find(S, tg, off);
        Unit u{tg, e * 4 + pnn, e, tg - off}; sgemm_unit(P.tid, A, D, Bt, D, D, u, RG, E); }
}
__device__ __forceinline__ void phase_g6(const Ptrs P, int l) {
    const unsigned* cnt = (const unsigned*)(P.ws + WS_CTL + CTL_CNT) + l * 16; MoeSeg S; moe_seg(cnt, S);
    const bf16_t* A = (const bf16_t*)(P.ws + WS_BIG + BIG_HID); const bf16_t* Bt = (const bf16_t*)(P.ws + WS_BIG + BIG_W2);
    EpiBf16Plain E{(bf16_t*)(P.ws + WS_BIG + BIG_YE), 1024, 3};
    const int NU = S.toff[16] * 4;
    for (int L = P.bid; L < NU; L += P.G) { const int tg = L >> 2, pn = L & 3; int off; const int e = moe_find(S, tg, off);
        Unit u{tg, e * 4 + pn, e, 0}; sgemm_unit(P.tid, A, 512, Bt, 512, 512, u, RowIdent{}, E); }
}

__device__ __forceinline__ void phase_e8(const Ptrs P, int l, LAS unsigned char* lds) {
    const int tid = P.tid, wid = tid >> 6, lane = tid & 63, G = P.G;
    const bool last = (l == NLAYER - 1); const int rows_l = last ? NLAT : T;
    LAS float* wdt = (LAS float*)lds; LAS float* tile = (LAS float*)(lds + 65536);
    if (!last) load_wdt(P, l + 1, wdt);
    const unsigned* cnt = (const unsigned*)(P.ws + WS_CTL + CTL_CNT) + l * 16; MoeSeg S; moe_seg(cnt, S);
    const int* toke = (const int*)(P.ws + WS_TOKE); const float* tokw = (const float*)(P.ws + WS_TOKW); const int* toks = (const int*)(P.ws + WS_TOKS);
    const bf16_t* YE = (const bf16_t*)(P.ws + WS_BIG + BIG_YE);
    const float* g = P.inp(I_LN2G) + l * D; const float* bta = P.inp(I_LN2B) + l * D;
    const int NU_R = rows_l / 8; const int NU = NU_R + (last ? 0 : NCONV_NE);
    for (int u = P.bid; u < NU; u += G) {
        if (u >= NU_R) { conv_unit_ne(P, l + 1, u - NU_R, tile); continue; }
        const int row = u * 8 + wid; RowV r; float* lp = P.latrow(row); row_load(r, lp, lane);
        const int e1 = toke[row * 2], e2 = toke[row * 2 + 1]; const float w1 = tokw[row * 2], w2 = tokw[row * 2 + 1];
        int o1 = 0, o2 = 0;
#pragma unroll
        for (int e = 0; e < 16; ++e) { o1 = (e == e1) ? S.toff[e] : o1; o2 = (e == e2) ? S.toff[e] : o2; }
        const bf16_t* y1 = YE + ((size_t)o1 * 256 + toks[row * 2]) * 1024; const bf16_t* y2 = YE + ((size_t)o2 * 256 + toks[row * 2 + 1]) * 1024;
        const float* m = P.mod(l, row_modidx(row));
#pragma unroll
        for (int i = 0; i < 4; ++i) { const u32x2 a = *(const u32x2*)(y1 + i * 256 + lane * 4), b = *(const u32x2*)(y2 + i * 256 + lane * 4);
            const f32x4 g2 = *(const f32x4*)(m + 5120 + i * 256 + lane * 4);
            f32x4 mo; mo[0] = w1 * __uint_as_float(a.x << 16) + w2 * __uint_as_float(b.x << 16); mo[1] = w1 * __uint_as_float(a.x & 0xffff0000u) + w2 * __uint_as_float(b.x & 0xffff0000u);
            mo[2] = w1 * __uint_as_float(a.y << 16) + w2 * __uint_as_float(b.y << 16); mo[3] = w1 * __uint_as_float(a.y & 0xffff0000u) + w2 * __uint_as_float(b.y & 0xffff0000u);
            r.v[i] = r.v[i] * ALPHA + g2 * mo; }
        row_layernorm(r, g, bta, lane);
        row_store(r, lp, lane);
        if (!last) { const float* m2 = P.mod(l + 1, row_modidx(row)); RowV h; row_modulate(r, h, m2, m2 + 1024, lane);
            row_store_bf16(h, (bf16_t*)(P.ws + WS_HBUF) + (size_t)row * D, lane); row_dt(h, wdt, (float*)(P.ws + WS_DT) + (size_t)row * 8, lane); }
    }
}

constexpr int NPH_LAYER = 11, NPH = 2 + NLAYER * NPH_LAYER;
__global__ void __launch_bounds__(512, 2) fwd_kernel(Args a) {
    extern __shared__ __attribute__((aligned(16))) unsigned char lds_raw[];
    LAS unsigned char* lds = (LAS unsigned char*)lds_raw;
    Ptrs P; P.inq = a.in; P.out = a.out; P.ws = a.ws;
    const int lo = a.ph_lo, hi = a.ph_hi;
    volatile LAS unsigned* xbw = (volatile LAS unsigned*)(lds + LDS_MISC);
    const int wave_s = __builtin_amdgcn_readfirstlane((int)threadIdx.x >> 6);
    if (threadIdx.x < 4) xbw[threadIdx.x] = 0u;
    __syncthreads();
    XcdBarrier bar; bar.bar = (unsigned*)(a.ws + WS_CTL); bar.x = 0; bar.st = xbw;
    if (hi - lo > 1) bar = xcd_barrier_post((unsigned*)(a.ws + WS_CTL), xbw, wave_s);
#ifndef PH_MASK
#define PH_MASK 0xFFFFFFFFu
#endif
#define PH_ON(id) (((PH_MASK) >> (id)) & 1u)
#define IN(k) (lo <= (k) && (k) < hi)
#define FRESH() Ptrs Pq; { float* o_ = a.out; unsigned char* w_ = a.ws; int l_ = lcur; asm volatile("" : "+s"(o_), "+s"(w_), "+s"(l_) :: "memory"); Pq.inq = a.in; Pq.out = o_; Pq.ws = w_; lq = l_; int ws_ = wave_s, b_ = blockIdx.x, g_ = gridDim.x; asm volatile("" : "+s"(ws_), "+s"(b_), "+s"(g_)); int ln_ = lane_id(); asm volatile("" : "+v"(ln_)); int t_ = ws_ * 64 + ln_; Pq.tid = t_; Pq.bid = b_; Pq.G = g_; }
#define SEAM(k) do { if (IN(k) && IN((k) + 1)) xcd_barrier(bar, wave_s); } while (0)
    int lcur = 0, lq = 0;
    if (PH_ON(0) && IN(0)) { FRESH(); phase_pa(Pq, lds); } SEAM(0);
    if (PH_ON(1) && IN(1)) { FRESH(); phase_pb(Pq, lds); } SEAM(1);
    for (int l = 0; l < NLAYER; ++l) {
        const int b = 2 + l * NPH_LAYER; lcur = l;
        if (PH_ON(2) && IN(b + 0)) { FRESH(); phase_g1(Pq); } SEAM(b + 0);
        if (PH_ON(3) && IN(b + 1)) { FRESH(); phase_m1(Pq, lq); } SEAM(b + 1);
        if (PH_ON(4) && IN(b + 2)) { FRESH(); phase_m2(Pq, lq, lds); } SEAM(b + 2);
        if (PH_ON(5) && IN(b + 3)) { FRESH(); phase_m3(Pq, lq); } SEAM(b + 3);
        if (PH_ON(6) && IN(b + 4)) { FRESH(); phase_g2(Pq, lq); } SEAM(b + 4);
        if (PH_ON(7) && IN(b + 5)) { FRESH(); phase_g3(Pq, lq); } SEAM(b + 5);
        if (PH_ON(8) && IN(b + 6)) { FRESH(); phase_g4(Pq, lq); } SEAM(b + 6);
        if (PH_ON(9) && IN(b + 7)) { FRESH(); phase_e5(Pq, lq, lds); } SEAM(b + 7);
        if (PH_ON(10) && IN(b + 8)) { FRESH(); phase_g5(Pq, lq); } SEAM(b + 8);
        if (PH_ON(11) && IN(b + 9)) { FRESH(); phase_g6(Pq, lq); } SEAM(b + 9);
        if (PH_ON(12) && IN(b + 10)) { FRESH(); phase_e8(Pq, lq, lds); } SEAM(b + 10);
    }
#undef IN
#undef SEAM
}
}

extern "C" void kernel_launch(void* const* d_in, const int* in_sizes, int n_in, void* d_out, int out_size, void* d_ws, size_t ws_size, hipStream_t stream) {
    static int grid = 0;
    if (grid == 0) {
        if (n_in != N_IN || out_size != NLAT * D || ws_size < WS_END) { fprintf(stderr, "kernel_launch: unexpected shapes / workspace (%d inputs, out %d, ws %zu < %zu)\n", n_in, out_size, ws_size, (size_t)WS_END); grid = -1; return; }
        int dev = 0, cus = 0, per_cu = 0;
        if (hipGetDevice(&dev) != hipSuccess || hipDeviceGetAttribute(&cus, hipDeviceAttributeMultiprocessorCount, dev) != hipSuccess) { grid = -1; return; }
        if (hipFuncSetAttribute((const void*)fwd_kernel, hipFuncAttributeMaxDynamicSharedMemorySize, LDS_BYTES) != hipSuccess) { fprintf(stderr, "kernel_launch: hipFuncSetAttribute failed\n"); grid = -1; return; }
        if (hipOccupancyMaxActiveBlocksPerMultiprocessor(&per_cu, (const void*)fwd_kernel, 512, LDS_BYTES) != hipSuccess || per_cu < 1) { fprintf(stderr, "kernel_launch: occupancy query says %d\n", per_cu); }
        (void)hipGetLastError();
        grid = cus;
    }
    if (grid < 0) return;
    (void)hipMemsetAsync((char*)d_ws + WS_CTL, 0, CTL_BYTES, stream);
    Args a{};
    for (int i = 0; i < N_IN; ++i) a.in[i] = (const float*)d_in[i];
    a.out = (float*)d_out; a.ws = (unsigned char*)d_ws;
#if N_LAUNCH_MODE == 1
    a.ph_lo = 0; a.ph_hi = NPH;
    hipLaunchKernelGGL(fwd_kernel, dim3(grid), dim3(512), LDS_BYTES, stream, a);
#else
    for (int p = 0; p < NPH; ++p) { a.ph_lo = p; a.ph_hi = p + 1; hipLaunchKernelGGL(fwd_kernel, dim3(grid), dim3(512), LDS_BYTES, stream, a); }
#endif
}
```

```cpp
#include <hip/hip_runtime.h>
#include <cstdio>
#include <cstdint>

#ifndef N_LAUNCH_MODE
#define N_LAUNCH_MODE 1
#endif

namespace {
typedef unsigned short bf16_t;
typedef short bf16x8 __attribute__((ext_vector_type(8)));
typedef float f32x4 __attribute__((ext_vector_type(4)));
typedef unsigned u32x2 __attribute__((ext_vector_type(2)));
typedef unsigned u32x4 __attribute__((ext_vector_type(4)));
#define LAS __attribute__((address_space(3)))

constexpr int D = 1024, NB = 8, SEQ = 4096, CTXL = 256, NLAT = NB * SEQ, NCTX = NB * CTXL, T = NLAT + NCTX;
constexpr int NLAYER = 2;
constexpr int UC = 3584;
constexpr int INC = 3592;
constexpr int NE = 16;
constexpr float ALPHA = 1.41421356237309515f;
constexpr float LN_EPS = 1e-5f, RMS_EPS = 1e-6f;
constexpr int MAXTILES = 288;

enum { I_X = 0, I_C, I_CTX, I_CCTX, I_WADA, I_BADA, I_WIN, I_HYCW, I_HYCB, I_HYW1, I_HYB1, I_HYF1, I_HYW2, I_HYB2, I_HYF2, I_HYW3, I_HYDEC, I_HYBIAS,
       I_SCCW, I_HGLB, I_HGNG, I_SSDCW, I_SSDCB, I_SSDALOG, I_SSDDTB, I_SSDD, I_SSDNG, I_WGATE, I_BGATE, I_WBR, I_WO, I_LN1G, I_LN1B, I_LN2G, I_LN2B,
       I_WROUTER, I_BROUTER, I_WE1, I_WE3, I_WE2, N_IN };

constexpr size_t al256(size_t x) { return (x + 255) & ~(size_t)255; }
constexpr size_t WS_CTL = 0;
constexpr size_t CTL_BYTES = 65536;
constexpr size_t CTL_CNT = 16384;
constexpr size_t WS_MOD = WS_CTL + CTL_BYTES;
constexpr size_t WS_LB = WS_MOD + al256((size_t)NLAYER * 9 * 6144 * 4);
constexpr size_t WS_TW = WS_LB + 4096;
constexpr size_t WS_H2TAB = WS_TW + 65536;
constexpr size_t WS_PART = WS_H2TAB + (size_t)8448 * 64 * 4;
constexpr size_t WS_FILT = WS_PART + (size_t)3 * 64 * 512 * 4;
constexpr size_t WS_FILTC = WS_FILT + (size_t)2 * 8192 * 256 * 4;
constexpr size_t WS_CX32 = WS_FILTC + (size_t)512 * 256 * 4;
constexpr size_t WS_DT = WS_CX32 + (size_t)NCTX * D * 4;
constexpr size_t WS_SSQ = WS_DT + (size_t)T * 8 * 4;
constexpr size_t WS_TOKE = WS_SSQ + (size_t)T * 4 * 4;
constexpr size_t WS_TOKW = WS_TOKE + (size_t)T * 2 * 4;
constexpr size_t WS_TOKS = WS_TOKW + (size_t)T * 2 * 4;
constexpr size_t WS_LIST = WS_TOKS + (size_t)T * 2 * 4;
constexpr size_t WS_BGP = WS_LIST + (size_t)NE * T * 4;
constexpr size_t WS_DEC = WS_BGP + 16384;
constexpr size_t WS_WIN = WS_DEC + (size_t)4352 * 64 * 4;
constexpr size_t WS_WG = WS_WIN + (size_t)UC * D * 2;
constexpr size_t WS_WBR = WS_WG + (size_t)4096 * D * 2;
constexpr size_t WS_WO = WS_WBR + (size_t)4096 * 256 * 2;
constexpr size_t WS_HBUF = WS_WO + (size_t)D * D * 2;
constexpr size_t WS_BR = WS_HBUF + (size_t)T * D * 2;
constexpr size_t WS_BIG = WS_BR + (size_t)T * D * 2;
constexpr size_t BIG_U = 0;
constexpr size_t BIG_HGO = BIG_U + (size_t)T * UC * 2;
constexpr size_t BIG_STATE = BIG_HGO;
constexpr size_t BIG_SSY = BIG_HGO + (size_t)T * 256 * 4;
constexpr size_t BIG_WT = BIG_SSY + (size_t)T * 256 * 4;
constexpr size_t BIG_END1 = BIG_WT + (size_t)T * 256 * 2;
constexpr size_t BIG_P = 0;
constexpr size_t BIG_HID = 0;
constexpr size_t BIG_YE = BIG_HID + (size_t)MAXTILES * 256 * 512 * 2;
constexpr size_t BIG_W13 = BIG_YE + (size_t)MAXTILES * 256 * 1024 * 2;
constexpr size_t BIG_W2 = BIG_W13 + (size_t)NE * 1024 * 1024 * 2;
constexpr size_t BIG_END3 = BIG_W2 + (size_t)NE * 1024 * 512 * 2;
constexpr size_t BIG_BYTES = BIG_END1 > BIG_END3 ? BIG_END1 : BIG_END3;
constexpr size_t WS_END = WS_BIG + BIG_BYTES;
static_assert((size_t)T * 4096 * 2 <= BIG_BYTES, "P fits");
static_assert(WS_END <= (size_t)536870912, "workspace budget");

constexpr int LDS_BYTES = 147456;
constexpr int LDS_MISC = 147456 - 256;

struct Args { const float* in[N_IN]; float* out; unsigned char* ws; int ph_lo, ph_hi; };

#define XB_TMO      128
#define XB_XCNT(j)  (256  + 64 * (j))
#define XB_XSUB(j)  (1280 + 64 * (j))
#define XB_XGEN(j)  (2304 + 64 * (j))
#define XB_TOP      3328
#define XB_TOPGEN   3392
#define XCD_BAR_WORDS 3456
#define XB_SPIN_CAP (1u << 18)
__device__ __forceinline__ unsigned xb_ld(unsigned* p)              { return __hip_atomic_load(p, __ATOMIC_RELAXED, __HIP_MEMORY_SCOPE_AGENT); }
__device__ __forceinline__ unsigned xb_add(unsigned* p, unsigned v) { return __hip_atomic_fetch_add(p, v, __ATOMIC_RELAXED, __HIP_MEMORY_SCOPE_AGENT); }
__device__ __forceinline__ unsigned xb_xcc_id() { return (unsigned)__builtin_amdgcn_s_getreg((3 << 11) | 20) & 0xFu; }
#define XB_SPIN(cond, bar) do { unsigned _sp = 0; while (cond) { __builtin_amdgcn_s_sleep(1); \
    if ((++_sp & 255u) == 0u) { if (xb_ld(&(bar)[XB_TMO])) break; if (_sp > XB_SPIN_CAP) { atomicAdd(&(bar)[XB_TMO], 1u); break; } } } } while (0)
struct XcdBarrier { unsigned* bar; unsigned x; volatile LAS unsigned* st; };
__device__ __forceinline__ int lane_id() { unsigned z = 0u; asm volatile("" : "+v"(z)); return (int)__builtin_amdgcn_mbcnt_hi(~0u, __builtin_amdgcn_mbcnt_lo(~0u, z)); }
__device__ __forceinline__ bool is_thread0(int wave_s) { return wave_s == 0 && lane_id() == 0; }
__device__ __forceinline__ XcdBarrier xcd_barrier_post(unsigned* bar, volatile LAS unsigned* st, int wave_s) {
    XcdBarrier b; b.bar = bar; b.x = xb_xcc_id(); b.st = st;
    if (is_thread0(wave_s)) (void)xb_add(&bar[XB_XCNT(b.x)], 1u);
    return b;
}
__device__ __forceinline__ void xcd_barrier_complete(unsigned* bar, unsigned x, unsigned& nloc, unsigned& nx) {
    const unsigned G = gridDim.x * gridDim.y * gridDim.z;
    unsigned sum, cnt, mine, sp = 0u;
    for (;;) {
        sum = 0u; cnt = 0u; mine = 0u;
#pragma unroll
        for (unsigned j = 0; j < 16; ++j) { const unsigned c = xb_ld(&bar[XB_XCNT(j)]); sum += c; cnt += (c > 0u) ? 1u : 0u; mine = (j == x) ? c : mine; }
        if (sum == G) break;
        __builtin_amdgcn_s_sleep(1);
        if ((++sp & 255u) == 0u) { if (xb_ld(&bar[XB_TMO])) break; if (sp > XB_SPIN_CAP) { atomicAdd(&bar[XB_TMO], 1u); break; } }
    }
    nloc = mine > 0u ? mine : 1u; nx = cnt > 0u ? cnt : 1u;
}
__device__ __forceinline__ void xcd_barrier(const XcdBarrier& b, int wave_s) {
    asm volatile("s_waitcnt vmcnt(0)" ::: "memory");
    __syncthreads();
    if (is_thread0(wave_s)) {
        unsigned* bar = b.bar;
        __builtin_amdgcn_s_waitcnt(0);
        unsigned nloc = b.st[0], nx = b.st[1];
        if (nloc == 0u) { xcd_barrier_complete(bar, b.x, nloc, nx); b.st[0] = nloc; b.st[1] = nx; }
        const unsigned old = xb_add(&bar[XB_XSUB(b.x)], 1u);
        const unsigned gen = old / nloc;
        if (old + 1u == (gen + 1u) * nloc) {
            __builtin_amdgcn_fence(__ATOMIC_RELEASE, "agent");
            asm volatile("s_waitcnt vmcnt(0)" ::: "memory");
            const unsigned og = xb_add(&bar[XB_TOP], 1u);
            const unsigned tg = og / nx;
            if (og + 1u == (tg + 1u) * nx) xb_add(&bar[XB_TOPGEN], 1u);
            else XB_SPIN(xb_ld(&bar[XB_TOPGEN]) == tg, bar);
            __builtin_amdgcn_fence(__ATOMIC_ACQUIRE, "agent");
            xb_add(&bar[XB_XGEN(b.x)], 1u);
            asm volatile("s_waitcnt vmcnt(0)" ::: "memory");
        } else {
            XB_SPIN(xb_ld(&bar[XB_XGEN(b.x)]) == gen, bar);
            __builtin_amdgcn_fence(__ATOMIC_ACQUIRE, "agent");
            asm volatile("s_waitcnt vmcnt(0)" ::: "memory");
        }
    }
    __syncthreads();
}

__device__ __forceinline__ float bf2f(bf16_t b) { return __uint_as_float(((unsigned)b) << 16); }
__device__ __forceinline__ bf16_t f2bf(float f) { unsigned u = __float_as_uint(f); u += 0x7FFFu + ((u >> 16) & 1u); return (bf16_t)(u >> 16); }
__device__ __forceinline__ unsigned pack2(float lo, float hi) { return (unsigned)f2bf(lo) | ((unsigned)f2bf(hi) << 16); }
__device__ __forceinline__ float sigmoidf_(float x) { return 1.0f / (1.0f + __expf(-x)); }
__device__ __forceinline__ float siluf_(float x) { return x * sigmoidf_(x); }
__device__ __forceinline__ float wave_sum(float v) {
#pragma unroll
    for (int o = 32; o >= 1; o >>= 1) v += __shfl_xor(v, o);
    return v;
}
__device__ __forceinline__ int row_modidx(int r) { return r < NLAT ? (r >> 12) : 8; }
__device__ __forceinline__ bool row_has_prev(int r) { return r < NLAT ? ((r & 4095) != 0) : (((r - NLAT) & 255) != 0); }
__device__ __forceinline__ bool row_has_next(int r) { return r < NLAT ? ((r & 4095) != 4095) : (((r - NLAT) & 255) != 255); }

struct Ptrs {
    float* out; unsigned char* ws; int tid, bid, G;
    __device__ __forceinline__ const float* inp(int i) const { asm volatile("" : "+s"(i));
        const __attribute__((address_space(4))) char* ka = (const __attribute__((address_space(4))) char*)__builtin_amdgcn_kernarg_segment_ptr();
        return *(const float* const __attribute__((address_space(4)))*)(ka + 8 * i); }
    __device__ __forceinline__ float* latrow(int r) const { return r < NLAT ? out + (size_t)r * D : (float*)(ws + WS_CX32) + (size_t)(r - NLAT) * D; }
    __device__ __forceinline__ float* mod(int l, int ridx) const { return (float*)(ws + WS_MOD) + ((size_t)l * 9 + ridx) * 6144; }
};

__device__ __forceinline__ float conv3_u(const bf16_t* U, int row, int col, const float* w, int ncol, int wcol) {
    float acc = bf2f(U[(size_t)row * UC + col]) * w[ncol + wcol];
    if (row_has_prev(row)) acc += bf2f(U[(size_t)(row - 1) * UC + col]) * w[wcol];
    if (row_has_next(row)) acc += bf2f(U[(size_t)(row + 1) * UC + col]) * w[2 * ncol + wcol];
    return acc;
}

struct Unit { int pm, pn, e, aux; };
__host__ __device__ __forceinline__ int perm32(int rho) { const int n = rho >> 4, i = rho & 15; return 8 * (i >> 2) + 4 * n + (i & 3); }

template <class RowMap, class Epi>
__device__ __forceinline__ void sgemm_unit(int tid_, const bf16_t* __restrict__ A, int lda, const bf16_t* __restrict__ Bt, int ldb, int K, const Unit& u, const RowMap& RM, const Epi& E) {
    const int tid = tid_, wid = tid >> 6, lane = tid & 63, wr = wid >> 2, wc = wid & 3, fr = lane & 15, fq = lane >> 4;
    f32x4 acc[2][2][4][2];
#pragma unroll
    for (int a = 0; a < 2; ++a)
#pragma unroll
        for (int b = 0; b < 2; ++b)
#pragma unroll
            for (int m = 0; m < 4; ++m)
#pragma unroll
                for (int n = 0; n < 2; ++n) acc[a][b][m][n] = (f32x4){0.f, 0.f, 0.f, 0.f};
    unsigned ap[2][4], bp[2][2];
#pragma unroll
    for (int a = 0; a < 2; ++a)
#pragma unroll
        for (int m = 0; m < 4; ++m) ap[a][m] = (unsigned)RM(u, 128 * a + 64 * wr + 16 * m + fr) * (unsigned)lda + fq * 8;
#pragma unroll
    for (int b = 0; b < 2; ++b)
#pragma unroll
        for (int n = 0; n < 2; ++n) { const int rho = 16 * n + fr; const int col = Epi::PERM ? perm32(rho) : rho;
            bp[b][n] = (unsigned)(u.pn * 256 + 128 * b + 32 * wc + col) * (unsigned)ldb + fq * 8; }
    for (int k = 0; k < K; k += 32) {
        bf16x8 bfr[2][2];
#pragma unroll
        for (int b = 0; b < 2; ++b)
#pragma unroll
            for (int n = 0; n < 2; ++n) bfr[b][n] = *(const bf16x8*)(Bt + (bp[b][n] + k));
#pragma unroll
        for (int a = 0; a < 2; ++a) {
            bf16x8 af[4];
#pragma unroll
            for (int m = 0; m < 4; ++m) af[m] = *(const bf16x8*)(A + (ap[a][m] + k));
#pragma unroll
            for (int b = 0; b < 2; ++b)
#pragma unroll
                for (int m = 0; m < 4; ++m)
#pragma unroll
                    for (int n = 0; n < 2; ++n) acc[a][b][m][n] = __builtin_amdgcn_mfma_f32_16x16x32_bf16(bfr[b][n], af[m], acc[a][b][m][n], 0, 0, 0);
        }
    }
    E(acc, u, wr, wc, fr, fq);
}

struct RowIdent { __device__ __forceinline__ int operator()(const Unit& u, int R) const { return u.pm * 256 + R; } };
struct RowStackK { int rows; __device__ __forceinline__ int operator()(const Unit& u, int R) const { return u.e * rows + u.pm * 256 + R; } };
struct RowGather { const int* list; const unsigned* cnt; __device__ __forceinline__ int operator()(const Unit& u, int R) const {
    const int idx = u.aux * 256 + R; const int* l = list + (size_t)u.e * T; return idx < (int)cnt[u.e] ? l[idx] : l[0]; } };


namespace pg8 {
constexpr int BM = 256, BK = 64, HALF = 128, HTB = HALF * BK * 2, STAGE_BYTES = 8 * HTB;
__host__ __device__ __forceinline__ int lds_byte(int r, int c) { const int st = (r >> 4) * 2 + (c >> 5), rr = r & 15, cc = c & 31, ob = rr * 64 + cc * 2; return st * 1024 + (ob ^ (((ob >> 9) & 1) << 5)); }
__host__ __device__ __forceinline__ void stage_rc(int b, int& R, int& C) { const int st = b / 1024, sb = b % 1024, swz = sb ^ (((sb >> 9) & 1) << 5); R = (st >> 1) * 16 + swz / 64; C = (st & 1) * 32 + (swz % 64) / 2; }
struct Gemm { const bf16_t* A; const bf16_t* Bt; int K; };

template <class Epi, class Sched, bool GATHER>
__device__ __forceinline__ void gemm_phase(int tid, LAS unsigned char* lds, const Gemm g, const Sched& S, const Epi& E) {
    const int wid = __builtin_amdgcn_readfirstlane(tid >> 6), lane = tid & 63, wr = wid >> 2, wc = wid & 3, fr = lane & 15, fq = lane >> 4;
    const int K = g.K, nt = K / BK;
    int RA[2], CA[2]; unsigned voffB[2];
    unsigned vA[2][2], vAn[2][2];
#pragma unroll
    for (int i = 0; i < 2; ++i) { int R, C; stage_rc(tid * 16 + i * 8192, R, C); RA[i] = R; CA[i] = C; const int Rb = Epi::PERM ? ((R & ~31) + perm32(R & 31)) : R; voffB[i] = (unsigned)(Rb * K + C) * 2u; }
    const size_t kstep = (size_t)(BK * 2);
    const size_t hstep = (size_t)HALF * K * 2;
    const size_t tstep = 2 * hstep;
    const unsigned ldsw = (unsigned)wid * 1024u;
    const int aoff = lds_byte(wr * 64 + fr, fq * 8), boff = lds_byte(wc * 32 + fr, fq * 8);
#define PG8_SA(b, h) (((b) * 2 + (h)) * HTB)
#define PG8_SB(b, h) ((4 + (b) * 2 + (h)) * HTB)
#define PG8_STAGE(bufoff, gbase, voff) do { _Pragma("unroll") for (int _i = 0; _i < 2; ++_i) \
        __builtin_amdgcn_global_load_lds((const unsigned*)((const char*)(gbase) + (voff)[_i]), (LAS unsigned*)(lds + (bufoff) + ldsw + _i * 8192), 16, 0, 0); } while (0)
#define PG8_STAGE2(bufoff, gbase, v0, v1) do { \
        __builtin_amdgcn_global_load_lds((const unsigned*)((const char*)(gbase) + (v0)), (LAS unsigned*)(lds + (bufoff) + ldsw), 16, 0, 0); \
        __builtin_amdgcn_global_load_lds((const unsigned*)((const char*)(gbase) + (v1)), (LAS unsigned*)(lds + (bufoff) + ldsw + 8192), 16, 0, 0); } while (0)
#define PG8_LDA(dst, b, h) do { _Pragma("unroll") for (int m = 0; m < 4; ++m) _Pragma("unroll") for (int k = 0; k < 2; ++k) dst[m][k] = *(const LAS bf16x8*)(lds + PG8_SA(b, h) + aoff + m * 2048 + k * 1024); } while (0)
#define PG8_LDB(dst, b, h) do { _Pragma("unroll") for (int n = 0; n < 2; ++n) _Pragma("unroll") for (int k = 0; k < 2; ++k) dst[n][k] = *(const LAS bf16x8*)(lds + PG8_SB(b, h) + boff + n * 2048 + k * 1024); } while (0)
#define PG8_MMA(ai, bj, At, Bt) do { __builtin_amdgcn_s_setprio(1); _Pragma("unroll") for (int m = 0; m < 4; ++m) _Pragma("unroll") for (int n = 0; n < 2; ++n) _Pragma("unroll") for (int k = 0; k < 2; ++k) \
        acc[ai][bj][m][n] = __builtin_amdgcn_mfma_f32_16x16x32_bf16(Bt[n][k], At[m][k], acc[ai][bj][m][n], 0, 0, 0); __builtin_amdgcn_s_setprio(0); } while (0)
#define PG8_WAIT_V(n) asm volatile("s_waitcnt vmcnt(" #n ")" ::: "memory")
#define PG8_WAIT_L(n) asm volatile("s_waitcnt lgkmcnt(" #n ")" ::: "memory")
#define PG8_BAR __builtin_amdgcn_s_barrier()
#define PG8_SCHED __builtin_amdgcn_sched_barrier(0)
#define PG8_AOFFS(dst, unit) do { _Pragma("unroll") for (int _h = 0; _h < 2; ++_h) _Pragma("unroll") for (int _i = 0; _i < 2; ++_i) \
        dst[_h][_i] = GATHER ? ((unsigned)S.arow(unit, _h * HALF + RA[_i]) * (unsigned)K + (unsigned)CA[_i]) * 2u : ((unsigned)(_h * HALF + RA[_i]) * (unsigned)K + (unsigned)CA[_i]) * 2u; } while (0)
    Unit cur, nxt; int ui = 0;
    if (!S.next(0, cur)) return;
    f32x4 acc[2][2][4][2];
#pragma unroll
    for (int a = 0; a < 2; ++a)
#pragma unroll
        for (int b = 0; b < 2; ++b)
#pragma unroll
            for (int m = 0; m < 4; ++m)
#pragma unroll
                for (int n = 0; n < 2; ++n) acc[a][b][m][n] = (f32x4){0.f, 0.f, 0.f, 0.f};
    bf16x8 At[4][2], B0[2][2], B1[2][2];
    const char* cA = GATHER ? (const char*)g.A : (const char*)g.A + (size_t)cur.pm * tstep; const char* cB = (const char*)g.Bt + (size_t)cur.pn * tstep;
    PG8_AOFFS(vA, cur);
    PG8_STAGE(PG8_SB(0, 0), cB, voffB); PG8_STAGE(PG8_SB(0, 1), cB + hstep, voffB); PG8_STAGE2(PG8_SA(0, 0), cA, vA[0][0], vA[0][1]); PG8_STAGE2(PG8_SA(0, 1), cA, vA[1][0], vA[1][1]);
    if (wr == 1) PG8_BAR;
    PG8_WAIT_V(2); PG8_BAR;
    PG8_STAGE(PG8_SB(1, 0), cB + kstep, voffB); PG8_STAGE2(PG8_SA(1, 0), cA + kstep, vA[0][0], vA[0][1]); PG8_STAGE(PG8_SB(1, 1), cB + hstep + kstep, voffB);
    PG8_WAIT_V(6); PG8_BAR;
    for (;;) {
        const bool has_next = S.next(ui + 1, nxt);
        const char* nA = GATHER ? (const char*)g.A : (has_next ? (const char*)g.A + (size_t)nxt.pm * tstep : cA); const char* nB = has_next ? (const char*)g.Bt + (size_t)nxt.pn * tstep : cB;
        if (has_next) { PG8_AOFFS(vAn, nxt); } else {
#pragma unroll
            for (int _h = 0; _h < 2; ++_h)
#pragma unroll
                for (int _i = 0; _i < 2; ++_i) vAn[_h][_i] = vA[_h][_i]; }
#pragma unroll 1
        for (int t = 0; t < nt; t += 2) {
            const bool last = (t == nt - 2);
            const char* a1 = cA + (size_t)(t + 1) * kstep;
            const char* a2 = last ? nA : cA + (size_t)(t + 2) * kstep; const char* b2 = last ? nB : cB + (size_t)(t + 2) * kstep;
            const char* a3 = a2 + kstep; const char* b3 = b2 + kstep;
            const unsigned x00 = last ? vAn[0][0] : vA[0][0], x01 = last ? vAn[0][1] : vA[0][1], x10 = last ? vAn[1][0] : vA[1][0], x11 = last ? vAn[1][1] : vA[1][1];
            PG8_LDB(B0, 0, 0); PG8_LDB(B1, 0, 1); PG8_SCHED; PG8_LDA(At, 0, 0); PG8_STAGE2(PG8_SA(1, 1), a1, vA[1][0], vA[1][1]);
            PG8_WAIT_V(8); PG8_WAIT_L(0); PG8_BAR; PG8_MMA(0, 0, At, B0); PG8_MMA(0, 1, At, B1); PG8_BAR; PG8_SCHED;
            PG8_LDA(At, 0, 1); PG8_STAGE(PG8_SB(0, 0), b2, voffB); PG8_STAGE(PG8_SB(0, 1), b2 + hstep, voffB); PG8_STAGE2(PG8_SA(0, 0), a2, x00, x01);
            PG8_WAIT_V(8); PG8_WAIT_L(0); PG8_BAR; PG8_MMA(1, 0, At, B0); PG8_MMA(1, 1, At, B1); PG8_BAR; PG8_SCHED;
            PG8_LDB(B0, 1, 0); PG8_LDB(B1, 1, 1); PG8_SCHED; PG8_LDA(At, 1, 0); PG8_STAGE2(PG8_SA(0, 1), a2, x10, x11);
            PG8_WAIT_V(8); PG8_WAIT_L(0); PG8_BAR; PG8_MMA(0, 0, At, B0); PG8_MMA(0, 1, At, B1); PG8_BAR; PG8_SCHED;
            PG8_LDA(At, 1, 1); PG8_STAGE(PG8_SB(1, 0), b3, voffB); PG8_STAGE(PG8_SB(1, 1), b3 + hstep, voffB); PG8_STAGE2(PG8_SA(1, 0), a3, x00, x01);
            PG8_WAIT_V(8); PG8_WAIT_L(0); PG8_BAR; PG8_MMA(1, 0, At, B0); PG8_MMA(1, 1, At, B1); PG8_BAR; PG8_SCHED;
        }
        if (wr == 0) PG8_BAR;
        E(acc, cur, wr, wc, fr, fq);
        if (!has_next) break;
#pragma unroll
        for (int a = 0; a < 2; ++a)
#pragma unroll
            for (int b = 0; b < 2; ++b)
#pragma unroll
                for (int m = 0; m < 4; ++m)
#pragma unroll
                    for (int n = 0; n < 2; ++n) acc[a][b][m][n] = (f32x4){0.f, 0.f, 0.f, 0.f};
        cur = nxt; cA = nA; cB = nB; ++ui;
#pragma unroll
        for (int _h = 0; _h < 2; ++_h)
#pragma unroll
            for (int _i = 0; _i < 2; ++_i) vA[_h][_i] = vAn[_h][_i];
        if (wr == 1) PG8_BAR;
    }
    PG8_WAIT_V(0);
    PG8_BAR;
#undef PG8_SA
#undef PG8_SB
#undef PG8_STAGE
#undef PG8_STAGE2
#undef PG8_LDA
#undef PG8_LDB
#undef PG8_MMA
#undef PG8_WAIT_V
#undef PG8_WAIT_L
#undef PG8_BAR
#undef PG8_SCHED
#undef PG8_AOFFS
}
}

struct SchedG1 { int G, c; __device__ __forceinline__ bool next(int i, Unit& u) const { const int L = i * G + c; if (L >= (T / 256) * 14) return false; u.pm = L / 14; u.pn = L % 14; u.e = 0; u.aux = 0; return true; }
    __device__ __forceinline__ int arow(const Unit&, int) const { return 0; } };
struct SchedG2 { int G, c, MT; __device__ __forceinline__ bool next(int i, Unit& u) const { const int L = i * G + c; if (L >= 16 * MT) return false; const int k = L / (MT * 4), rem = L % (MT * 4);
        u.pm = k * (T / 256) + (rem >> 2); u.pn = k * 4 + (rem & 3); u.e = k; u.aux = rem & 3; return true; }
    __device__ __forceinline__ int arow(const Unit&, int) const { return 0; } };
struct SchedMN { int G, c, MT, NT; __device__ __forceinline__ bool next(int i, Unit& u) const { const int L = i * G + c; if (L >= MT * NT) return false; u.pm = L / NT; u.pn = L % NT; u.e = 0; u.aux = 0; return true; }
    __device__ __forceinline__ int arow(const Unit&, int) const { return 0; } };

struct EpiBf16Plain {
    static constexpr bool PERM = true;
    bf16_t* O; int ldc; int coltile_mask;
    __device__ __forceinline__ void operator()(const f32x4 (&acc)[2][2][4][2], const Unit& u, int wr, int wc, int fr, int fq) const {
        const int row0 = u.pm * 256 + wr * 64 + fr, col0 = (u.pn & coltile_mask) * 256 + wc * 32 + 8 * fq;
#pragma unroll
        for (int ai = 0; ai < 2; ++ai)
#pragma unroll
            for (int m = 0; m < 4; ++m) { bf16_t* rowp = O + (size_t)(row0 + ai * 128 + m * 16) * ldc + col0;
#pragma unroll
                for (int bj = 0; bj < 2; ++bj) { const f32x4 v0 = acc[ai][bj][m][0], v1 = acc[ai][bj][m][1];
                    u32x4 w; w.x = pack2(v0[0], v0[1]); w.y = pack2(v0[2], v0[3]); w.z = pack2(v1[0], v1[1]); w.w = pack2(v1[2], v1[3]);
                    *(u32x4*)(rowp + bj * 128) = w; } }
    }
};
struct EpiP {
    static constexpr bool PERM = true;
    bf16_t* P; const float* ssq;
    __device__ __forceinline__ void operator()(const f32x4 (&acc)[2][2][4][2], const Unit& u, int wr, int wc, int fr, int fq) const {
        const int k = u.e; const int pmt = u.pm - k * (T / 256);
        const unsigned c00 = (unsigned)(u.aux * 256 + wc * 32 + 8 * fq);
        const unsigned base = (unsigned)pmt * (16u * 256u * 256u) + (unsigned)k * 64u;
#pragma unroll
        for (int ai = 0; ai < 2; ++ai)
#pragma unroll
            for (int m = 0; m < 4; ++m) { const int r = ai * 128 + wr * 64 + m * 16 + fr; float sc = 1.0f;
                if (k == 3) { const float* qp = ssq + (size_t)(pmt * 256 + r) * 4; sc = rsqrtf((qp[0] + qp[1] + qp[2] + qp[3]) * (1.0f / 256.0f) + RMS_EPS); }
#pragma unroll
                for (int bj = 0; bj < 2; ++bj) { const unsigned c0 = c00 + bj * 128; const unsigned s = c0 >> 6, wi = c0 & 63;
                    const f32x4 v0 = acc[ai][bj][m][0] * sc, v1 = acc[ai][bj][m][1] * sc;
                    u32x4 w; w.x = pack2(v0[0], v0[1]); w.y = pack2(v0[2], v0[3]); w.z = pack2(v1[0], v1[1]); w.w = pack2(v1[2], v1[3]);
                    *(u32x4*)(P + (base + (s * 256u + (unsigned)r) * 256u + wi)) = w; }
                asm volatile("" ::: "memory"); }
    }
};
struct EpiMerge {
    static constexpr bool PERM = false;
    const bf16_t* P; const float* bgp; bf16_t* Y;
    __device__ __forceinline__ void operator()(const f32x4 (&acc)[2][2][4][2], const Unit& u, int wr, int wc, int fr, int fq) const {
        const int s = u.pn;
        f32x4 bv[2][2];
#pragma unroll
        for (int bj = 0; bj < 2; ++bj)
#pragma unroll
            for (int n = 0; n < 2; ++n) bv[bj][n] = *(const f32x4*)(bgp + s * 256 + bj * 128 + wc * 32 + n * 16 + 4 * fq);
#pragma unroll
        for (int ai = 0; ai < 2; ++ai)
#pragma unroll
            for (int m = 0; m < 4; ++m) { const int r = ai * 128 + wr * 64 + m * 16 + fr;
                const bf16_t* pp = P + (((size_t)u.pm * 16 + s) * 256 + r) * 256 + wc * 16 + 4 * fq;
                f32x4 y = (f32x4){0.f, 0.f, 0.f, 0.f};
#pragma unroll
                for (int bj = 0; bj < 2; ++bj)
#pragma unroll
                    for (int n = 0; n < 2; ++n) { const int k = 2 * bj + n; const u32x2 pw = *(const u32x2*)(pp + k * 64);
                        const f32x4 g = acc[ai][bj][m][n] + bv[bj][n];
                        y[0] += sigmoidf_(g[0]) * __uint_as_float(pw.x << 16); y[1] += sigmoidf_(g[1]) * __uint_as_float(pw.x & 0xffff0000u);
                        y[2] += sigmoidf_(g[2]) * __uint_as_float(pw.y << 16); y[3] += sigmoidf_(g[3]) * __uint_as_float(pw.y & 0xffff0000u); }
                u32x2 w; w.x = pack2(y[0], y[1]); w.y = pack2(y[2], y[3]);
                *(u32x2*)(Y + (size_t)(u.pm * 256 + r) * D + s * 64 + wc * 16 + 4 * fq) = w; }
    }
};
struct EpiWo {
    static constexpr bool PERM = false;
    Ptrs P; int layer;
    __device__ __forceinline__ void operator()(const f32x4 (&acc)[2][2][4][2], const Unit& u, int wr, int wc, int fr, int fq) const {
        const int col0 = u.pn * 256 + wc * 32 + 4 * fq;
#pragma unroll
        for (int ai = 0; ai < 2; ++ai)
#pragma unroll
            for (int m = 0; m < 4; ++m) { const int row = u.pm * 256 + ai * 128 + wr * 64 + m * 16 + fr;
                float* lp = P.latrow(row) + col0; const float* g1 = P.mod(layer, row_modidx(row)) + 2048 + col0;
#pragma unroll
                for (int bj = 0; bj < 2; ++bj)
#pragma unroll
                    for (int n = 0; n < 2; ++n) { const f32x4 x = *(const f32x4*)(lp + bj * 128 + n * 16); const f32x4 g = *(const f32x4*)(g1 + bj * 128 + n * 16);
                        *(f32x4*)(lp + bj * 128 + n * 16) = x * ALPHA + g * acc[ai][bj][m][n]; } }
    }
};
struct EpiFfn1 {
    static constexpr bool PERM = false;
    bf16_t* H;
    __device__ __forceinline__ void operator()(const f32x4 (&acc)[2][2][4][2], const Unit& u, int wr, int wc, int fr, int fq) const {
        const int pnn = u.pn & 3;
#pragma unroll
        for (int ai = 0; ai < 2; ++ai)
#pragma unroll
            for (int m = 0; m < 4; ++m) { const int pos = u.pm * 256 + ai * 128 + wr * 64 + m * 16 + fr;
#pragma unroll
                for (int bj = 0; bj < 2; ++bj) { const f32x4 a = acc[ai][bj][m][0], b = acc[ai][bj][m][1];
                    u32x2 w; w.x = pack2(siluf_(a[0]) * b[0], siluf_(a[1]) * b[1]); w.y = pack2(siluf_(a[2]) * b[2], siluf_(a[3]) * b[3]);
                    *(u32x2*)(H + (size_t)pos * 512 + pnn * 128 + bj * 64 + wc * 16 + 4 * fq) = w; } }
    }
};

template <class SrcFn>
__device__ __forceinline__ void conv_tile(int tid, LAS float* tile  , bf16_t* dst, int ldd, int n0, int k0, const SrcFn& src) {
#pragma unroll
    for (int i = 0; i < 8; ++i) { const int kk = (tid >> 6) + 8 * i, j = tid & 63; tile[kk * 65 + j] = src(k0 + kk, n0 + j); }
    __syncthreads();
    { const int jj = tid >> 3, kq = tid & 7; float v[8];
#pragma unroll
      for (int i = 0; i < 8; ++i) v[i] = tile[(8 * kq + i) * 65 + jj];
      u32x4 w; w.x = pack2(v[0], v[1]); w.y = pack2(v[2], v[3]); w.z = pack2(v[4], v[5]); w.w = pack2(v[6], v[7]);
      *(u32x4*)(dst + (size_t)(n0 + jj) * ldd + k0 + 8 * kq) = w; }
    __syncthreads();
}
constexpr int NCONV_NE = 56 * 16 + 64 * 16 + 64 * 4 + 16 * 16;
constexpr int NCONV_EX = NE * (16 * 16 + 16 * 8);
__device__ __forceinline__ int gate_srccol(int np) { const int s = np >> 8, bj = (np >> 7) & 1, wc = (np >> 5) & 3, n = (np >> 4) & 1, fqe = np & 15; return (2 * bj + n) * 1024 + 64 * s + 16 * wc + fqe; }
__device__ __forceinline__ void conv_unit_ne(const Ptrs P, int l, int t, LAS float* tile) {
    unsigned char* ws = P.ws;
    if (t < 896) { const int nt = t >> 4, kt = t & 15; const float* src = P.inp(I_WIN) + (size_t)l * D * INC;
        conv_tile(P.tid, tile, (bf16_t*)(ws + WS_WIN), D, nt * 64, kt * 64, [=](int k, int n) { return src[(size_t)k * INC + n]; });
    } else if (t < 896 + 1024) { t -= 896; const int nt = t >> 4, kt = t & 15; const float* src = P.inp(I_WGATE) + (size_t)l * D * 4096;
        conv_tile(P.tid, tile, (bf16_t*)(ws + WS_WG), D, nt * 64, kt * 64, [=](int k, int n) { return src[(size_t)k * 4096 + gate_srccol(n)]; });
        if (kt == 0 && P.tid < 64) { const int np = nt * 64 + P.tid; ((float*)(ws + WS_BGP))[np] = P.inp(I_BGATE)[(size_t)l * 4096 + gate_srccol(np)]; }
    } else if (t < 896 + 1024 + 256) { t -= 1920; const int nt = t >> 2, kt = t & 3; const int kb = nt >> 4;
        const float* src = P.inp(I_WBR) + ((size_t)l * 4 + kb) * 256 * 1024; const float* ng = P.inp(I_SSDNG) + l * 256; const bool sc = (kb == 3);
        conv_tile(P.tid, tile, (bf16_t*)(ws + WS_WBR), 256, nt * 64, kt * 64, [=](int k, int n) { const float v = src[(size_t)k * 1024 + (n & 1023)]; return sc ? v * ng[k] : v; });
    } else { t -= 2176; const int nt = t >> 4, kt = t & 15; const float* src = P.inp(I_WO) + (size_t)l * D * D;
        conv_tile(P.tid, tile, (bf16_t*)(ws + WS_WO), D, nt * 64, kt * 64, [=](int k, int n) { return src[(size_t)k * D + n]; });
    }
}
__device__ __forceinline__ void conv_unit_ex(const Ptrs P, int l, int t, LAS float* tile) {
    unsigned char* ws = P.ws;
    const int e = t / 384; t -= e * 384;
    if (t < 256) { const int nt = t >> 4, kt = t & 15;
        const float* s1 = P.inp(I_WE1) + ((size_t)l * NE + e) * 1024 * 512; const float* s3 = P.inp(I_WE3) + ((size_t)l * NE + e) * 1024 * 512;
        conv_tile(P.tid, tile, (bf16_t*)(ws + WS_BIG + BIG_W13) + (size_t)e * 1024 * 1024, 1024, nt * 64, kt * 64, [=](int k, int n) {
            const int pn = n >> 8, bj = (n >> 7) & 1, wc = (n >> 5) & 3, nn = (n >> 4) & 1, fqe = n & 15; const int ch = 128 * pn + 64 * bj + 16 * wc + fqe;
            return (nn ? s3 : s1)[(size_t)k * 512 + ch]; });
    } else { t -= 256; const int nt = t >> 3, kt = t & 7; const float* src = P.inp(I_WE2) + ((size_t)l * NE + e) * 512 * 1024;
        conv_tile(P.tid, tile, (bf16_t*)(ws + WS_BIG + BIG_W2) + (size_t)e * 1024 * 512, 512, nt * 64, kt * 64, [=](int k, int n) { return src[(size_t)k * 1024 + n]; });
    }
}

struct RowV { f32x4 v[4]; };
__device__ __forceinline__ void row_load(RowV& r, const float* p, int lane) {
#pragma unroll
    for (int i = 0; i < 4; ++i) r.v[i] = *(const f32x4*)(p + i * 256 + lane * 4);
}
__device__ __forceinline__ void row_store(const RowV& r, float* p, int lane) {
#pragma unroll
    for (int i = 0; i < 4; ++i) *(f32x4*)(p + i * 256 + lane * 4) = r.v[i];
}
__device__ __forceinline__ void row_layernorm(RowV& r, const float* g, const float* b, int lane) {
    float s = 0.f;
#pragma unroll
    for (int i = 0; i < 4; ++i) s += r.v[i][0] + r.v[i][1] + r.v[i][2] + r.v[i][3];
    const float mu = wave_sum(s) * (1.0f / 1024.0f);
    float q = 0.f;
#pragma unroll
    for (int i = 0; i < 4; ++i) { const f32x4 d = r.v[i] - mu; q += d[0] * d[0] + d[1] * d[1] + d[2] * d[2] + d[3] * d[3]; }
    const float rstd = rsqrtf(wave_sum(q) * (1.0f / 1024.0f) + LN_EPS);
#pragma unroll
    for (int i = 0; i < 4; ++i) { const f32x4 gg = *(const f32x4*)(g + i * 256 + lane * 4), bb = *(const f32x4*)(b + i * 256 + lane * 4); r.v[i] = (r.v[i] - mu) * rstd * gg + bb; }
}
__device__ __forceinline__ void row_modulate(const RowV& r, RowV& h, const float* sh, const float* sc, int lane) {
#pragma unroll
    for (int i = 0; i < 4; ++i) { const f32x4 a = *(const f32x4*)(sc + i * 256 + lane * 4), b = *(const f32x4*)(sh + i * 256 + lane * 4); h.v[i] = r.v[i] * (a + 1.0f) + b; }
}
__device__ __forceinline__ void row_store_bf16(const RowV& h, bf16_t* p, int lane) {
#pragma unroll
    for (int i = 0; i < 4; ++i) { u32x2 w; w.x = pack2(h.v[i][0], h.v[i][1]); w.y = pack2(h.v[i][2], h.v[i][3]); *(u32x2*)(p + i * 256 + lane * 4) = w; }
}
__device__ __forceinline__ void row_dt(const RowV& h, const LAS float* wdt, float* dtout, int lane) {
    float a[8];
#pragma unroll
    for (int j = 0; j < 8; ++j) a[j] = 0.f;
#pragma unroll
    for (int i = 0; i < 4; ++i)
#pragma unroll
        for (int e = 0; e < 4; ++e) { const int k = i * 256 + lane * 4 + e; const float hv = h.v[i][e];
            const f32x4 w0 = *(const LAS f32x4*)(wdt + k * 8), w1 = *(const LAS f32x4*)(wdt + k * 8 + 4);
            a[0] += hv * w0[0]; a[1] += hv * w0[1]; a[2] += hv * w0[2]; a[3] += hv * w0[3]; a[4] += hv * w1[0]; a[5] += hv * w1[1]; a[6] += hv * w1[2]; a[7] += hv * w1[3]; }
#pragma unroll
    for (int j = 0; j < 8; ++j) a[j] = wave_sum(a[j]);
    if (lane == 0) { *(f32x4*)dtout = (f32x4){a[0], a[1], a[2], a[3]}; *(f32x4*)(dtout + 4) = (f32x4){a[4], a[5], a[6], a[7]}; }
}
__device__ __forceinline__ void load_wdt(const Ptrs P, int l, LAS float* wdt) {
    const float* src = P.inp(I_WIN) + (size_t)l * D * INC + UC;
    for (int i = P.tid; i < 1024 * 8; i += 512) wdt[i] = src[(size_t)(i >> 3) * INC + (i & 7)];
    __syncthreads();
}

__device__ __forceinline__ void phase_pa(const Ptrs P, LAS unsigned char* lds) {
    const int tid = P.tid, wid = tid >> 6, lane = tid & 63, G = P.G;
    const int NU_MOD = 2 * 96, NU_H2 = 8448 / 8, NU_LB = 1;
    const int NU = NU_MOD + NU_H2 + NU_LB + NCONV_NE;
    for (int u = P.bid; u < NU; u += G) {
        if (u < NU_MOD) {
            const int l = u / 96, cb = u % 96;
            LAS float* sc = (LAS float*)lds; LAS float* red = sc + 9 * 1024;
            for (int i = tid; i < 9 * 1024; i += 512) { const int r = i >> 10, k = i & 1023; const float v = r < 8 ? P.inp(I_C)[r * 1024 + k] : P.inp(I_CCTX)[k]; sc[i] = v / (1.0f + expf(-v)); }
            __syncthreads();
            const int col = cb * 64 + lane; const float* w = P.inp(I_WADA) + (size_t)l * D * 6144 + col;
            float acc[9];
#pragma unroll
            for (int r = 0; r < 9; ++r) acc[r] = 0.f;
            for (int k = wid * 128; k < wid * 128 + 128; ++k) { const float wv = w[(size_t)k * 6144];
#pragma unroll
                for (int r = 0; r < 9; ++r) acc[r] += sc[r * 1024 + k] * wv; }
#pragma unroll
            for (int r = 0; r < 9; ++r) red[(wid * 9 + r) * 64 + lane] = acc[r];
            __syncthreads();
            for (int i = tid; i < 9 * 64; i += 512) { const int r = i >> 6, c = i & 63; float s = P.inp(I_BADA)[(size_t)l * 6144 + cb * 64 + c];
#pragma unroll
                for (int w8 = 0; w8 < 8; ++w8) s += red[(w8 * 9 + r) * 64 + c];
                P.mod(l, r)[cb * 64 + c] = s; }
            __syncthreads();
        } else if (u < NU_MOD + NU_H2) {
            const int rho = (u - NU_MOD) * 8 + wid;
            const int l = (rho >= 4096 && rho < 8192) ? 1 : 0; const int L = rho < 8192 ? 4096 : 256; const int i = rho < 8192 ? (rho & 4095) : (rho - 8192);
            float featv = 0.f;
            if (lane == 0) featv = (float)((double)i / (double)(L - 1));
            else if (lane < 33) { const int j = (lane - 1) & 15; const double band = 1e-4 + (double)j * ((15.0 - 1e-4) / 15.0);
                const double ang = (2.0 * 3.14159265358979323846 / (double)L) * (double)i * band; featv = lane < 17 ? (float)cos(ang) : (float)(-sin(ang)); }
            float z1 = P.inp(I_HYB1)[l * 64 + lane];
            for (int m = 0; m < 33; ++m) z1 += __shfl(featv, m) * P.inp(I_HYW1)[((size_t)l * 33 + m) * 64 + lane];
            const float h1 = sinf(P.inp(I_HYF1)[l * 64 + lane] * z1);
            float z2 = P.inp(I_HYB2)[l * 64 + lane];
            for (int m = 0; m < 64; ++m) z2 += __shfl(h1, m) * P.inp(I_HYW2)[((size_t)l * 64 + m) * 64 + lane];
            ((float*)(P.ws + WS_H2TAB))[(size_t)rho * 64 + lane] = sinf(P.inp(I_HYF2)[l * 64 + lane] * z2);
        } else if (u < NU_MOD + NU_H2 + NU_LB) {
            for (int i = tid; i < 1024; i += 512) { const int d = i >> 9, l = (i >> 8) & 1, c = i & 255;
                const float l0 = P.inp(I_HGLB)[d * 512 + c], l1 = P.inp(I_HGLB)[d * 512 + 256 + c];
                ((float*)(P.ws + WS_LB))[i] = l == 0 ? 0.0f : 1.0f / (1.0f + expf(l0 - l1)); }
        } else {
            conv_unit_ne(P, 0, u - (NU_MOD + NU_H2 + NU_LB), (LAS float*)lds);
        }
    }
}

__device__ __forceinline__ void emit_rows_init(const Ptrs P, LAS float* wdt);
__device__ __forceinline__ void phase_pb(const Ptrs P, LAS unsigned char* lds) {
    const int tid = P.tid, G = P.G;
    for (int u = P.bid; u < 132; u += G) {
        const int tab = u < 64 ? 0 : (u < 128 ? 1 : 2); const int ib = tab == 0 ? u : (tab == 1 ? u - 64 : u - 128);
        const int l = tab == 1 ? 1 : 0; const int L = tab == 2 ? 256 : 4096; const int rho0 = (tab == 0 ? 0 : (tab == 1 ? 4096 : 8192)) + ib * 64;
        LAS float* h2 = (LAS float*)lds;
        for (int i = tid; i < 64 * 64; i += 512) h2[i] = ((const float*)(P.ws + WS_H2TAB))[(size_t)rho0 * 64 + i];
        __syncthreads();
        const int o = tid, c = tid & 255, dir = tid >> 8;
        float w3[64];
#pragma unroll
        for (int j = 0; j < 64; ++j) w3[j] = P.inp(I_HYW3)[((size_t)l * 64 + j) * 512 + o];
        const float dec = fabsf(P.inp(I_HYDEC)[l * 256 + c]);
        float* filt = tab == 2 ? (float*)(P.ws + WS_FILTC) : (float*)(P.ws + WS_FILT) + (size_t)l * 8192 * 256;
        const int L2 = 2 * L; float part = 0.f;
        for (int r = 0; r < 64; ++r) { const int i = ib * 64 + r; float s = 0.f;
#pragma unroll
            for (int j = 0; j < 64; ++j) s += h2[r * 64 + j] * w3[j];
            const float t = (float)i / (float)(L - 1); s *= expf(-t * dec);
            if (dir == 0) { filt[(size_t)i * 256 + c] = s; part += fabsf(s); }
            else if (i == 0) filt[(size_t)L * 256 + c] = 0.f;
            else { filt[(size_t)(L2 - i) * 256 + c] = s; part += fabsf(s); } }
        ((float*)(P.ws + WS_PART))[((size_t)tab * 64 + ib) * 512 + o] = part;
        __syncthreads();
    }
    emit_rows_init(P, (LAS float*)(lds + 32768));
}
__device__ __forceinline__ float hy_norm(const Ptrs P, int tab, int c) {
    const float* part = (const float*)(P.ws + WS_PART) + (size_t)tab * 64 * 512; const int nb = tab == 2 ? 4 : 64; float s = 0.f;
    for (int b = 0; b < nb; ++b) s += part[b * 512 + c] + part[b * 512 + 256 + c];
    return s;
}

__device__ __forceinline__ void emit_rows_init(const Ptrs P, LAS float* wdt) {
    const int tid = P.tid, wid = tid >> 6, lane = tid & 63, G = P.G;
    load_wdt(P, 0, wdt);
    for (int u = P.bid; u < T / 8; u += G) {
        const int row = u * 8 + wid; RowV r;
        if (row < NLAT) { row_load(r, P.inp(I_X) + (size_t)row * D, lane);
            const int t = row & 4095; const float prow = (float)(t >> 6), pcol = (float)(t & 63);
#pragma unroll
            for (int i = 0; i < 4; ++i)
#pragma unroll
                for (int e = 0; e < 4; ++e) { const int idx = i * 256 + lane * 4 + e; const int f = idx & 511, ii = f & 255; const float pos = (idx >> 9) ? pcol : prow;
                    const float om = expf(-9.210340371976184f * (float)ii * (1.0f / 256.0f)); const float a = pos * om; r.v[i][e] += (f < 256) ? sinf(a) : cosf(a); }
        } else row_load(r, P.inp(I_CTX) + (size_t)(row - NLAT) * D, lane);
        row_store(r, P.latrow(row), lane);
        const float* m = P.mod(0, row_modidx(row)); RowV h; row_modulate(r, h, m, m + 1024, lane);
        row_store_bf16(h, (bf16_t*)(P.ws + WS_HBUF) + (size_t)row * D, lane);
        row_dt(h, wdt, (float*)(P.ws + WS_DT) + (size_t)row * 8, lane);
    }
}

__device__ __forceinline__ void phase_g1(const Ptrs P, LAS unsigned char* lds) {
    pg8::Gemm g{(const bf16_t*)(P.ws + WS_HBUF), (const bf16_t*)(P.ws + WS_WIN), D};
    EpiBf16Plain E{(bf16_t*)(P.ws + WS_BIG + BIG_U), UC, 0xffff};
    SchedG1 S{P.G, P.bid};
    pg8::gemm_phase<EpiBf16Plain, SchedG1, false>(P.tid, lds, g, S, E);
}

constexpr int NCHK = 34;
__device__ __forceinline__ int chunk_row0(int b, int pc) { return pc < 2 ? NLAT + b * CTXL + pc * 128 : b * SEQ + (pc - 2) * 128; }
__device__ __forceinline__ int chunk_at(int dir, int q) { return dir == 0 ? q : (q < 2 ? 1 - q : 35 - q); }
__device__ __forceinline__ int sidx(int kind, int b, int h, int dir, int pc) { return (((kind * 8 + b) * 4 + h) * 2 + dir) * NCHK + pc; }
__device__ __forceinline__ bf16x8 pack8(const float (&v)[8]) { u32x4 w; w.x = pack2(v[0], v[1]); w.y = pack2(v[2], v[3]); w.z = pack2(v[4], v[5]); w.w = pack2(v[6], v[7]); return __builtin_bit_cast(bf16x8, w); }
__device__ __forceinline__ float zero_f() { float z = 0.f; asm volatile("" : "+v"(z)); return z; }
__device__ __forceinline__ float softplusf_(float x) { return x > 20.f ? x : log1pf(__expf(x)); }
__device__ __forceinline__ float wave_incl_scan(float v, int lane) {
#pragma unroll
    for (int d = 1; d < 64; d <<= 1) { const float t = __shfl_up(v, d); if (lane >= d) v += t; }
    return v;
}

__device__ __forceinline__ void conv3_silu8(const bf16_t* U, int row, int col0, const float* w, int ncol, int wcol0, const float* bias, float (&out)[8]) {
    const bool hp = row_has_prev(row), hn = row_has_next(row);
    const bf16x8 c = *(const bf16x8*)(U + (size_t)row * UC + col0);
    bf16x8 p = c, n = c; if (hp) p = *(const bf16x8*)(U + (size_t)(row - 1) * UC + col0); if (hn) n = *(const bf16x8*)(U + (size_t)(row + 1) * UC + col0);
    const float mp = hp ? 1.0f : 0.0f, mn = hn ? 1.0f : 0.0f;
#pragma unroll
    for (int h4 = 0; h4 < 2; ++h4) { const f32x4 w0 = *(const f32x4*)(w + wcol0 + 4 * h4), w1 = *(const f32x4*)(w + ncol + wcol0 + 4 * h4), w2 = *(const f32x4*)(w + 2 * ncol + wcol0 + 4 * h4), bb = *(const f32x4*)(bias + wcol0 + 4 * h4);
#pragma unroll
        for (int e = 0; e < 4; ++e) { const int i = 4 * h4 + e; const float v = bf2f((bf16_t)c[i]) * w1[e] + mp * bf2f((bf16_t)p[i]) * w0[e] + mn * bf2f((bf16_t)n[i]) * w2[e] + bb[e]; out[i] = siluf_(v); } }
}

__device__ __forceinline__ void hgrn_pass1(const Ptrs P, int l, int unit, LAS unsigned char* lds) {
    const int tid = P.tid, lane = tid & 63, wid = tid >> 6, fr = lane & 15, fq = lane >> 4;
    const int pc = unit % NCHK; int r_ = unit / NCHK; const int dir = r_ & 1; r_ >>= 1; const int h = r_ & 3; const int b = r_ >> 2;
    const int row0 = chunk_row0(b, pc); const int si = sidx(0, b, h, dir, pc);
    const bf16_t* U = (const bf16_t*)(P.ws + WS_BIG + BIG_U);
    LAS bf16_t* KT = (LAS bf16_t*)lds; LAS bf16_t* VT = KT + 64 * 136; LAS float* segtot = (LAS float*)(VT + 64 * 136);
    const int ch = lane, seg = wid;
    const float lbv = ((const float*)(P.ws + WS_LB))[(dir * 2 + l) * 256 + h * 64 + ch];
    float c[16], kk[16]; unsigned vb[16]; float run = 0.f;
#pragma unroll
    for (int j = 0; j < 16; ++j) { const int tau = 16 * seg + j; const int p = dir ? 127 - tau : tau; const bf16_t* ur = U + (size_t)(row0 + p) * UC;
        const float f = lbv + (1.0f - lbv) * sigmoidf_(bf2f(ur[1792 + dir * 256 + h * 64 + ch])); run += __logf(f); c[j] = run; kk[j] = 1.0f - f; vb[j] = ur[2304 + h * 64 + ch]; }
    segtot[seg * 64 + ch] = run; __syncthreads();
    float off = 0.f, tot = 0.f;
#pragma unroll
    for (int s = 0; s < 8; ++s) { const float v = segtot[s * 64 + ch]; tot += v; off += (s < seg) ? v : 0.f; }
    { u32x4 w0, w1, v0, v1;
      w0.x = pack2(kk[0] * __expf(tot - off - c[0]), kk[1] * __expf(tot - off - c[1])); w0.y = pack2(kk[2] * __expf(tot - off - c[2]), kk[3] * __expf(tot - off - c[3]));
      w0.z = pack2(kk[4] * __expf(tot - off - c[4]), kk[5] * __expf(tot - off - c[5])); w0.w = pack2(kk[6] * __expf(tot - off - c[6]), kk[7] * __expf(tot - off - c[7]));
      w1.x = pack2(kk[8] * __expf(tot - off - c[8]), kk[9] * __expf(tot - off - c[9])); w1.y = pack2(kk[10] * __expf(tot - off - c[10]), kk[11] * __expf(tot - off - c[11]));
      w1.z = pack2(kk[12] * __expf(tot - off - c[12]), kk[13] * __expf(tot - off - c[13])); w1.w = pack2(kk[14] * __expf(tot - off - c[14]), kk[15] * __expf(tot - off - c[15]));
      v0.x = vb[0] | (vb[1] << 16); v0.y = vb[2] | (vb[3] << 16); v0.z = vb[4] | (vb[5] << 16); v0.w = vb[6] | (vb[7] << 16);
      v1.x = vb[8] | (vb[9] << 16); v1.y = vb[10] | (vb[11] << 16); v1.z = vb[12] | (vb[13] << 16); v1.w = vb[14] | (vb[15] << 16);
      *(LAS u32x4*)(KT + ch * 136 + 16 * seg) = w0; *(LAS u32x4*)(KT + ch * 136 + 16 * seg + 8) = w1;
      *(LAS u32x4*)(VT + ch * 136 + 16 * seg) = v0; *(LAS u32x4*)(VT + ch * 136 + 16 * seg + 8) = v1; }
    if (seg == 0) ((float*)(P.ws + WS_DEC))[(size_t)si * 64 + ch] = __expf(tot);
    __syncthreads();
    const int mt = wid >> 1, nt0 = (wid & 1) * 2;
    f32x4 acc[2]; acc[0] = (f32x4){0.f, 0.f, 0.f, 0.f}; acc[1] = acc[0];
#pragma unroll
    for (int ks = 0; ks < 4; ++ks) { const bf16x8 a = *(const LAS bf16x8*)(KT + (16 * mt + fr) * 136 + 32 * ks + 8 * fq);
#pragma unroll
        for (int n = 0; n < 2; ++n) { const bf16x8 bb = *(const LAS bf16x8*)(VT + (16 * (nt0 + n) + fr) * 136 + 32 * ks + 8 * fq); acc[n] = __builtin_amdgcn_mfma_f32_16x16x32_bf16(a, bb, acc[n], 0, 0, 0); } }
    float* S = (float*)(P.ws + WS_BIG + BIG_STATE) + (size_t)si * 4096;
#pragma unroll
    for (int n = 0; n < 2; ++n)
#pragma unroll
        for (int r = 0; r < 4; ++r) S[(16 * mt + 4 * fq + r) * 64 + 16 * (nt0 + n) + fr] = acc[n][r];
    __syncthreads();
}

__device__ __forceinline__ void ssd_dt_cum(const Ptrs P, int l, int row0, int dir, int h, int wid, int lane, LAS float* cum, LAS float* dtv) {
    if (wid == 0) {
        const float Aneg = -__expf(P.inp(I_SSDALOG)[(l * 2 + dir) * 4 + h]); const float dtb = P.inp(I_SSDDTB)[(l * 2 + dir) * 4 + h]; const float* DT = (const float*)(P.ws + WS_DT);
        const int t0 = 2 * lane, p0 = dir ? 127 - t0 : t0, p1 = dir ? 126 - t0 : t0 + 1;
        const float d0 = softplusf_(DT[(size_t)(row0 + p0) * 8 + dir * 4 + h] + dtb), d1 = softplusf_(DT[(size_t)(row0 + p1) * 8 + dir * 4 + h] + dtb);
        const float a0 = Aneg * d0, a1 = Aneg * d1; const float inc = wave_incl_scan(a0 + a1, lane);
        cum[t0] = inc - a1; cum[t0 + 1] = inc; dtv[t0] = d0; dtv[t0 + 1] = d1;
    }
}

__device__ __forceinline__ void ssd_pass1(const Ptrs P, int l, int unit, LAS unsigned char* lds) {
    const int tid = P.tid, lane = tid & 63, wid = tid >> 6, fr = lane & 15, fq = lane >> 4;
    const int pc = unit % NCHK; int r_ = unit / NCHK; const int dir = r_ & 1; r_ >>= 1; const int h = r_ & 3; const int b = r_ >> 2; const int g = h >> 1;
    const int row0 = chunk_row0(b, pc); const int si = sidx(1, b, h, dir, pc);
    const bf16_t* U = (const bf16_t*)(P.ws + WS_BIG + BIG_U);
    const float* scw = P.inp(I_SSDCW) + (size_t)l * 3 * 512; const float* scb = P.inp(I_SSDCB) + l * 512;
    LAS bf16_t* XT = (LAS bf16_t*)lds; LAS bf16_t* BT = XT + 64 * 136; LAS float* cum = (LAS float*)(BT + 64 * 136); LAS float* dtv = cum + 128;
    ssd_dt_cum(P, l, row0, dir, h, wid, lane, cum, dtv);
    __syncthreads();
    const float tot = cum[127]; const int ch = lane, seg = wid;
    { float xv[16], bv[16]; const float xb = scb[h * 64 + ch], bb_ = scb[256 + g * 64 + ch];
#pragma unroll
      for (int j = 0; j < 16; ++j) { const int tau = 16 * seg + j; const int row = row0 + (dir ? 127 - tau : tau);
          xv[j] = siluf_(conv3_u(U, row, 3072 + h * 64 + ch, scw, 512, h * 64 + ch) + xb) * dtv[tau] * __expf(tot - cum[tau]);
          bv[j] = siluf_(conv3_u(U, row, 3072 + 256 + g * 64 + ch, scw, 512, 256 + g * 64 + ch) + bb_); }
      u32x4 w0, w1, v0, v1;
      w0.x = pack2(xv[0], xv[1]); w0.y = pack2(xv[2], xv[3]); w0.z = pack2(xv[4], xv[5]); w0.w = pack2(xv[6], xv[7]); w1.x = pack2(xv[8], xv[9]); w1.y = pack2(xv[10], xv[11]); w1.z = pack2(xv[12], xv[13]); w1.w = pack2(xv[14], xv[15]);
      v0.x = pack2(bv[0], bv[1]); v0.y = pack2(bv[2], bv[3]); v0.z = pack2(bv[4], bv[5]); v0.w = pack2(bv[6], bv[7]); v1.x = pack2(bv[8], bv[9]); v1.y = pack2(bv[10], bv[11]); v1.z = pack2(bv[12], bv[13]); v1.w = pack2(bv[14], bv[15]);
      *(LAS u32x4*)(XT + ch * 136 + 16 * seg) = w0; *(LAS u32x4*)(XT + ch * 136 + 16 * seg + 8) = w1;
      *(LAS u32x4*)(BT + ch * 136 + 16 * seg) = v0; *(LAS u32x4*)(BT + ch * 136 + 16 * seg + 8) = v1; }
    if (tid == 0) ((float*)(P.ws + WS_DEC))[(size_t)si * 64] = __expf(tot);
    __syncthreads();
    const int mt = wid >> 1, nt0 = (wid & 1) * 2;
    f32x4 acc[2]; acc[0] = (f32x4){0.f, 0.f, 0.f, 0.f}; acc[1] = acc[0];
#pragma unroll
    for (int ks = 0; ks < 4; ++ks) { const bf16x8 a = *(const LAS bf16x8*)(XT + (16 * mt + fr) * 136 + 32 * ks + 8 * fq);
#pragma unroll
        for (int n = 0; n < 2; ++n) { const bf16x8 bb = *(const LAS bf16x8*)(BT + (16 * (nt0 + n) + fr) * 136 + 32 * ks + 8 * fq); acc[n] = __builtin_amdgcn_mfma_f32_16x16x32_bf16(a, bb, acc[n], 0, 0, 0); } }
    float* S = (float*)(P.ws + WS_BIG + BIG_STATE) + (size_t)si * 4096;
#pragma unroll
    for (int n = 0; n < 2; ++n)
#pragma unroll
        for (int r = 0; r < 4; ++r) S[(16 * mt + 4 * fq + r) * 64 + 16 * (nt0 + n) + fr] = acc[n][r];
    __syncthreads();
}

__device__ __forceinline__ void scan_pass2(const Ptrs P, int unit) {
    const int seq = unit >> 1, half = unit & 1; const int kind = seq >> 6, b = (seq >> 3) & 7, h = (seq >> 1) & 3, dir = seq & 1;
    const int e0 = half * 2048 + P.tid * 4; const int base = sidx(kind, b, h, dir, 0);
    float* ST = (float*)(P.ws + WS_BIG + BIG_STATE); const float* DEC = (const float*)(P.ws + WS_DEC);
    const float zf = zero_f(); f32x4 run = (f32x4){zf, zf, zf, zf};
    for (int q = 0; q < NCHK; ++q) { const int pc = chunk_at(dir, q); float* S = ST + (size_t)(base + pc) * 4096 + e0;
        const f32x4 loc = *(const f32x4*)S; const float d = DEC[(size_t)(base + pc) * 64 + (kind == 0 ? (e0 >> 6) : 0)];
        *(f32x4*)S = run; run = run * d + loc; }
}

__device__ __forceinline__ void hgrn_pass3(const Ptrs P, int l, int unit, LAS unsigned char* lds) {
    const int tid = P.tid, lane = tid & 63, wid = tid >> 6, fr = lane & 15, fq = lane >> 4;
    const int pc = unit % NCHK; const int r_ = unit / NCHK; const int h = r_ & 3; const int b = r_ >> 2;
    const int row0 = chunk_row0(b, pc);
    const bf16_t* U = (const bf16_t*)(P.ws + WS_BIG + BIG_U);
    LAS bf16_t* QH = (LAS bf16_t*)lds; LAS bf16_t* KT2 = QH + 128 * 72; LAS bf16_t* VT = KT2 + 128 * 72; LAS bf16_t* ST = VT + 64 * 136;
    LAS float* EE = (LAS float*)(ST + 64 * 72); LAS float* ET = EE + 512; LAS bf16_t* PW = (LAS bf16_t*)(ET + 512); LAS float* BH = (LAS float*)PW; LAS float* OUT = (LAS float*)(PW + 8 * 16 * 136);
    for (int dir = 0; dir < 2; ++dir) {
        {
            const int ch = lane, seg = wid; const float lbv = ((const float*)(P.ws + WS_LB))[(dir * 2 + l) * 256 + h * 64 + ch]; float run = 0.f; unsigned vb[16];
#pragma unroll
            for (int j = 0; j < 16; ++j) { const int tau = 16 * seg + j; const int p = dir ? 127 - tau : tau; const bf16_t* ur = U + (size_t)(row0 + p) * UC;
                const float f = lbv + (1.0f - lbv) * sigmoidf_(bf2f(ur[1792 + dir * 256 + h * 64 + ch])); run += __logf(f); BH[tau * 64 + ch] = run; vb[j] = ur[2304 + h * 64 + ch]; }
            ET[seg * 64 + ch] = run;
            u32x4 v0, v1; v0.x = vb[0] | (vb[1] << 16); v0.y = vb[2] | (vb[3] << 16); v0.z = vb[4] | (vb[5] << 16); v0.w = vb[6] | (vb[7] << 16);
            v1.x = vb[8] | (vb[9] << 16); v1.y = vb[10] | (vb[11] << 16); v1.z = vb[12] | (vb[13] << 16); v1.w = vb[14] | (vb[15] << 16);
            *(LAS u32x4*)(VT + ch * 136 + 16 * seg) = v0; *(LAS u32x4*)(VT + ch * 136 + 16 * seg + 8) = v1;
            const float* S = (const float*)(P.ws + WS_BIG + BIG_STATE) + (size_t)sidx(0, b, h, dir, pc) * 4096;
            for (int idx = tid; idx < 4096; idx += 512) ST[(idx & 63) * 72 + (idx >> 6)] = f2bf(S[idx]);
        }
        __syncthreads();
        if (tid < 64) { float e = 0.f;
#pragma unroll
            for (int i = 0; i < 8; ++i) { e += ET[i * 64 + tid]; EE[i * 64 + tid] = e; } }
        {
            const int tau = tid >> 2, qd = tid & 3, sb = tau >> 4; const int p = dir ? 127 - tau : tau; const bf16_t* ur = U + (size_t)(row0 + p) * UC + 1536 + h * 64 + 16 * qd;
#pragma unroll 1
            for (int hf = 0; hf < 2; ++hf) { const bf16x8 q8 = *(const bf16x8*)(ur + 8 * hf); float qh[8], kt[8];
#pragma unroll
                for (int e4 = 0; e4 < 2; ++e4) { const int c0 = 16 * qd + 8 * hf + 4 * e4; const f32x4 bh = *(const LAS f32x4*)(BH + tau * 64 + c0);
                    f32x4 bp = (f32x4){0.f, 0.f, 0.f, 0.f}; if (tau & 15) bp = *(const LAS f32x4*)(BH + (tau - 1) * 64 + c0);
                    const f32x4 et = *(const LAS f32x4*)(ET + sb * 64 + c0);
#pragma unroll
                    for (int e = 0; e < 4; ++e) { const int ee = 4 * e4 + e; const float qv = bf2f((bf16_t)q8[ee]);
                        qh[ee] = qv * 0.125f * __expf(bh[e]); kt[ee] = (1.0f - __expf(bh[e] - bp[e])) * __expf(et[e] - bh[e]); } }
                *(LAS bf16x8*)(QH + tau * 72 + 16 * qd + 8 * hf) = pack8(qh); *(LAS bf16x8*)(KT2 + tau * 72 + 16 * qd + 8 * hf) = pack8(kt); }
        }
        __syncthreads();
        {
            const int i = wid; LAS bf16_t* pw = PW + wid * 16 * 136;
            bf16x8 qf[2]; float em1[2][8];
#pragma unroll
            for (int ks = 0; ks < 2; ++ks) { qf[ks] = *(const LAS bf16x8*)(QH + (16 * i + fr) * 72 + 32 * ks + 8 * fq);
#pragma unroll
                for (int e = 0; e < 8; ++e) em1[ks][e] = (i > 0) ? EE[(i - 1) * 64 + 32 * ks + 8 * fq + e] : 0.f; }
            for (int j = 0; j <= i; ++j) {
                f32x4 d = (f32x4){0.f, 0.f, 0.f, 0.f};
#pragma unroll
                for (int ks = 0; ks < 2; ++ks) { float a8[8];
#pragma unroll
                    for (int e = 0; e < 8; ++e) a8[e] = bf2f((bf16_t)qf[ks][e]) * __expf(em1[ks][e] - EE[j * 64 + 32 * ks + 8 * fq + e]);
                    const bf16x8 kf = *(const LAS bf16x8*)(KT2 + (16 * j + fr) * 72 + 32 * ks + 8 * fq);
                    d = __builtin_amdgcn_mfma_f32_16x16x32_bf16(kf, pack8(a8), d, 0, 0, 0); }
                if (j == i) {
#pragma unroll
                    for (int r = 0; r < 4; ++r) d[r] = (4 * fq + r <= fr) ? d[r] : 0.f; }
                u32x2 w; w.x = pack2(d[0], d[1]); w.y = pack2(d[2], d[3]); *(LAS u32x2*)(pw + fr * 136 + 16 * j + 4 * fq) = w;
            }
            if ((i & 1) == 0) { u32x2 z; z.x = __float_as_uint(zero_f()); z.y = z.x; *(LAS u32x2*)(pw + fr * 136 + 16 * (i + 1) + 4 * fq) = z; }
            f32x4 o[4];
#pragma unroll
            for (int nt = 0; nt < 4; ++nt) o[nt] = (f32x4){0.f, 0.f, 0.f, 0.f};
            const int nks = (i >> 1) + 1;
            for (int ks = 0; ks < nks; ++ks) { const bf16x8 pa = *(const LAS bf16x8*)(pw + fr * 136 + 32 * ks + 8 * fq);
#pragma unroll
                for (int nt = 0; nt < 4; ++nt) { const bf16x8 vf = *(const LAS bf16x8*)(VT + (16 * nt + fr) * 136 + 32 * ks + 8 * fq); o[nt] = __builtin_amdgcn_mfma_f32_16x16x32_bf16(pa, vf, o[nt], 0, 0, 0); } }
#pragma unroll
            for (int ks = 0; ks < 2; ++ks) { float a8[8];
#pragma unroll
                for (int e = 0; e < 8; ++e) a8[e] = bf2f((bf16_t)qf[ks][e]) * __expf(em1[ks][e]);
                const bf16x8 qa = pack8(a8);
#pragma unroll
                for (int nt = 0; nt < 4; ++nt) { const bf16x8 sf = *(const LAS bf16x8*)(ST + (16 * nt + fr) * 72 + 32 * ks + 8 * fq); o[nt] = __builtin_amdgcn_mfma_f32_16x16x32_bf16(qa, sf, o[nt], 0, 0, 0); } }
#pragma unroll
            for (int nt = 0; nt < 4; ++nt)
#pragma unroll
                for (int r = 0; r < 4; ++r) { const int tau = 16 * i + 4 * fq + r; const int pos = dir ? 127 - tau : tau; LAS float* op = OUT + pos * 64 + 16 * nt + fr; if (dir == 0) *op = o[nt][r]; else *op += o[nt][r]; }
        }
        __syncthreads();
    }
    {
        const float ng = P.inp(I_HGNG)[l * 64 + lane]; bf16_t* BR2 = (bf16_t*)(P.ws + WS_BR) + (size_t)2 * T * 256;
        for (int rr = 0; rr < 16; ++rr) { const int pos = 16 * wid + rr; const int row = row0 + pos; const float o = OUT[pos * 64 + lane]; const float ms = wave_sum(o * o) * (1.0f / 64.0f);
            const float gt = bf2f(U[(size_t)row * UC + 2560 + h * 64 + lane]);
            BR2[(size_t)row * 256 + h * 64 + lane] = f2bf(o * rsqrtf(ms + RMS_EPS) * ng * siluf_(gt)); }
    }
    __syncthreads();
}

__device__ __forceinline__ void ssd_pass3(const Ptrs P, int l, int unit, LAS unsigned char* lds) {
    const int tid = P.tid, lane = tid & 63, wid = tid >> 6, fr = lane & 15, fq = lane >> 4;
    const int pc = unit % NCHK; const int r_ = unit / NCHK; const int h = r_ & 3; const int b = r_ >> 2; const int g = h >> 1;
    const int row0 = chunk_row0(b, pc);
    const bf16_t* U = (const bf16_t*)(P.ws + WS_BIG + BIG_U);
    const float* scw = P.inp(I_SSDCW) + (size_t)l * 3 * 512; const float* scb = P.inp(I_SSDCB) + l * 512;
    LAS bf16_t* CM = (LAS bf16_t*)lds; LAS bf16_t* BM = CM + 128 * 72; LAS bf16_t* XT = BM + 128 * 72; LAS bf16_t* ST = XT + 64 * 136;
    LAS float* cum = (LAS float*)(ST + 64 * 72); LAS float* dtv = cum + 128; LAS bf16_t* PW = (LAS bf16_t*)(dtv + 128); LAS float* OUT = (LAS float*)(PW + 8 * 16 * 136);
    for (int dir = 0; dir < 2; ++dir) {
        ssd_dt_cum(P, l, row0, dir, h, wid, lane, cum, dtv);
        {
            const int tau = tid >> 2, qd = tid & 3; const int row = row0 + (dir ? 127 - tau : tau);
#pragma unroll 1
            for (int pcs = 0; pcs < 4; ++pcs) { const int isb = pcs >> 1, hf = pcs & 1; const int cc = (isb ? 256 : 384) + g * 64 + 16 * qd + 8 * hf; float t8[8];
                conv3_silu8(U, row, 3072 + cc, scw, 512, cc, scb, t8);
                *(LAS bf16x8*)((isb ? BM : CM) + tau * 72 + 16 * qd + 8 * hf) = pack8(t8); }
        }
        {
            const int ch = lane, seg = wid; float xv[16]; const float xb = scb[h * 64 + ch];
#pragma unroll
            for (int j = 0; j < 16; ++j) { const int tau = 16 * seg + j; const int row = row0 + (dir ? 127 - tau : tau); xv[j] = siluf_(conv3_u(U, row, 3072 + h * 64 + ch, scw, 512, h * 64 + ch) + xb); }
            float t8[8];
#pragma unroll
            for (int e = 0; e < 8; ++e) t8[e] = xv[e];
            *(LAS bf16x8*)(XT + ch * 136 + 16 * seg) = pack8(t8);
#pragma unroll
            for (int e = 0; e < 8; ++e) t8[e] = xv[8 + e];
            *(LAS bf16x8*)(XT + ch * 136 + 16 * seg + 8) = pack8(t8);
            const float* S = (const float*)(P.ws + WS_BIG + BIG_STATE) + (size_t)sidx(1, b, h, dir, pc) * 4096;
            for (int idx = tid; idx < 4096; idx += 512) ST[(idx >> 6) * 72 + (idx & 63)] = f2bf(S[idx]);
        }
        __syncthreads();
        {
            const int i = wid; LAS bf16_t* pw = PW + wid * 16 * 136;
            bf16x8 cf[2];
#pragma unroll
            for (int ks = 0; ks < 2; ++ks) cf[ks] = *(const LAS bf16x8*)(CM + (16 * i + fr) * 72 + 32 * ks + 8 * fq);
            const float cum_t = cum[16 * i + fr];
            for (int j = 0; j <= i; ++j) {
                f32x4 d = (f32x4){0.f, 0.f, 0.f, 0.f};
#pragma unroll
                for (int ks = 0; ks < 2; ++ks) { const bf16x8 bf_ = *(const LAS bf16x8*)(BM + (16 * j + fr) * 72 + 32 * ks + 8 * fq); d = __builtin_amdgcn_mfma_f32_16x16x32_bf16(bf_, cf[ks], d, 0, 0, 0); }
                const f32x4 cs = *(const LAS f32x4*)(cum + 16 * j + 4 * fq), ds = *(const LAS f32x4*)(dtv + 16 * j + 4 * fq);
#pragma unroll
                for (int r = 0; r < 4; ++r) { const bool keep = (j < i) || (4 * fq + r <= fr); d[r] = keep ? d[r] * __expf(cum_t - cs[r]) * ds[r] : 0.f; }
                u32x2 w; w.x = pack2(d[0], d[1]); w.y = pack2(d[2], d[3]); *(LAS u32x2*)(pw + fr * 136 + 16 * j + 4 * fq) = w;
            }
            if ((i & 1) == 0) { u32x2 z; z.x = __float_as_uint(zero_f()); z.y = z.x; *(LAS u32x2*)(pw + fr * 136 + 16 * (i + 1) + 4 * fq) = z; }
            f32x4 o[4], o2[4];
#pragma unroll
            for (int nt = 0; nt < 4; ++nt) { o[nt] = (f32x4){0.f, 0.f, 0.f, 0.f}; o2[nt] = o[nt]; }
            const int nks = (i >> 1) + 1;
            for (int ks = 0; ks < nks; ++ks) { const bf16x8 pa = *(const LAS bf16x8*)(pw + fr * 136 + 32 * ks + 8 * fq);
#pragma unroll
                for (int nt = 0; nt < 4; ++nt) { const bf16x8 xf = *(const LAS bf16x8*)(XT + (16 * nt + fr) * 136 + 32 * ks + 8 * fq); o[nt] = __builtin_amdgcn_mfma_f32_16x16x32_bf16(pa, xf, o[nt], 0, 0, 0); } }
#pragma unroll
            for (int ks = 0; ks < 2; ++ks)
#pragma unroll
                for (int nt = 0; nt < 4; ++nt) { const bf16x8 sf = *(const LAS bf16x8*)(ST + (16 * nt + fr) * 72 + 32 * ks + 8 * fq); o2[nt] = __builtin_amdgcn_mfma_f32_16x16x32_bf16(cf[ks], sf, o2[nt], 0, 0, 0); }
            const f32x4 ct = *(const LAS f32x4*)(cum + 16 * i + 4 * fq);
#pragma unroll
            for (int nt = 0; nt < 4; ++nt)
#pragma unroll
                for (int r = 0; r < 4; ++r) { const int tau = 16 * i + 4 * fq + r; const int pos = dir ? 127 - tau : tau; const float v = o[nt][r] + __expf(ct[r]) * o2[nt][r];
                    LAS float* op = OUT + pos * 64 + 16 * nt + fr; if (dir == 0) *op = v; else *op += v; }
        }
        __syncthreads();
    }
    {
        const float Dh = P.inp(I_SSDD)[l * 4 + h]; const float xb = scb[h * 64 + lane]; bf16_t* BR3 = (bf16_t*)(P.ws + WS_BR) + (size_t)3 * T * 256; float* SSQ = (float*)(P.ws + WS_SSQ);
        for (int rr = 0; rr < 16; ++rr) { const int pos = 16 * wid + rr; const int row = row0 + pos; const int c = h * 64 + lane;
            const float xs = siluf_(conv3_u(U, row, 3072 + c, scw, 512, c) + xb); const float y = OUT[pos * 64 + lane] + xs * Dh; const float z = bf2f(U[(size_t)row * UC + 2816 + c]);
            const float vv = y * siluf_(z); const float q = wave_sum(vv * vv); if (lane == 0) SSQ[(size_t)row * 4 + h] = q;
            BR3[(size_t)row * 256 + c] = f2bf(vv); }
    }
    __syncthreads();
}

__device__ __forceinline__ void phase_m1(const Ptrs P, int l, LAS unsigned char* lds) {
    const int tid = P.tid, G = P.G;
    const bf16_t* U = (const bf16_t*)(P.ws + WS_BIG + BIG_U); bf16_t* WT = (bf16_t*)(P.ws + WS_BIG + BIG_WT);
    const float* hcw = P.inp(I_HYCW) + (size_t)l * 3 * 768; const float* hcb = P.inp(I_HYCB) + l * 768;
    const int NS = NB * 4 * 2 * NCHK;
    const int NU = 2 * NS + T / 64;
    for (int u = P.bid; u < NU; u += G) {
        if (u < NS) hgrn_pass1(P, l, u, lds);
        else if (u < 2 * NS) ssd_pass1(P, l, u - NS, lds);
        else { const int ub = u - 2 * NS; const int c = tid & 255;
            for (int rr = tid >> 8; rr < 64; rr += 2) { const int row = ub * 64 + rr;
                const float x1 = conv3_u(U, row, 256 + c, hcw, 768, 256 + c) + hcb[256 + c]; const float v = conv3_u(U, row, 512 + c, hcw, 768, 512 + c) + hcb[512 + c];
                WT[(size_t)row * 256 + c] = f2bf(x1 * v); } }
    }
}

__device__ __forceinline__ void phase_m2(const Ptrs P, int l, LAS unsigned char* lds) {
    const int tid = P.tid, G = P.G;
    const bf16_t* U = (const bf16_t*)(P.ws + WS_BIG + BIG_U); const bf16_t* WT = (const bf16_t*)(P.ws + WS_BIG + BIG_WT); bf16_t* BR = (bf16_t*)(P.ws + WS_BR);
    const float* hcw = P.inp(I_HYCW) + (size_t)l * 3 * 768; const float* hcb = P.inp(I_HYCB) + l * 768;
    const int NU_P2 = 256, NU_HL = NB * 256, NU_HC = (l == 0) ? NB * 16 : 0;
    const int NU = NU_P2 + NU_HL + NU_HC;
    for (int u = P.bid; u < NU; u += G) {
        if (u < NU_P2) { scan_pass2(P, u); continue; }
        const int v = u - NU_P2;
        const bool isc = v >= NU_HL; const int uu = isc ? v - NU_HL : v; const int L = isc ? CTXL : SEQ; const int msk = 2 * L - 1;
        const int b = isc ? (uu >> 4) : (uu >> 8); const int t0 = (isc ? (uu & 15) : (uu & 255)) * 16 + (tid >> 8) * 8; const int c = tid & 255;
        const int base = isc ? NLAT + b * CTXL : b * SEQ;
        const float* filt = isc ? (const float*)(P.ws + WS_FILTC) : (const float*)(P.ws + WS_FILT) + (size_t)l * 8192 * 256;
        float acc[8], fw[8];
#pragma unroll
        for (int j = 0; j < 8; ++j) { acc[j] = 0.f; fw[j] = filt[(size_t)((t0 + j) & msk) * 256 + c]; }
        for (int s = 0; s < L; ++s) { const float w = bf2f(WT[(size_t)(base + s) * 256 + c]);
#pragma unroll
            for (int j = 0; j < 8; ++j) acc[j] += fw[j] * w;
#pragma unroll
            for (int j = 7; j > 0; --j) fw[j] = fw[j - 1];
            fw[0] = filt[(size_t)((t0 - s - 1) & msk) * 256 + c]; }
        const float inv = 1.0f / hy_norm(P, isc ? 2 : l, c); const float bias = P.inp(I_HYBIAS)[l * 256 + c];
#pragma unroll
        for (int j = 0; j < 8; ++j) { const int row = base + t0 + j; const float x0 = conv3_u(U, row, c, hcw, 768, c) + hcb[c]; const float w = bf2f(WT[(size_t)row * 256 + c]);
            BR[(size_t)row * 256 + c] = f2bf(x0 * (acc[j] * inv + w * bias)); }
    }
}

__device__ __forceinline__ void phase_m3(const Ptrs P, int l, LAS unsigned char* lds) {
    const int tid = P.tid, G = P.G;
    const bool last = (l == NLAYER - 1); const int rows_l = last ? NLAT : T;
    const bf16_t* U = (const bf16_t*)(P.ws + WS_BIG + BIG_U); bf16_t* BR = (bf16_t*)(P.ws + WS_BR);
    const int NS3 = NB * 4 * NCHK;
    const int NU = 2 * NS3 + rows_l / 64;
    for (int u = P.bid; u < NU; u += G) {
        if (u < 2 * NS3) { const int uu = u < NS3 ? u : u - NS3; if (last && (uu % NCHK) < 2) continue;
            if (u < NS3) hgrn_pass3(P, l, uu, lds); else ssd_pass3(P, l, uu, lds); }
        else { const int rb = u - 2 * NS3; const float* cw = P.inp(I_SCCW) + (size_t)l * 3 * 256; const int c = tid & 255;
            for (int rr = tid >> 8; rr < 64; rr += 2) { const int row = rb * 64 + rr; float acc = 0.f;
#pragma unroll
                for (int k = 0; k < 3; ++k) { const int r2 = row + k - 1; const bool ok = (k == 1) || (k == 0 ? row_has_prev(row) : row_has_next(row));
                    if (ok) acc += bf2f(U[(size_t)r2 * UC + 1024 + c]) * bf2f(U[(size_t)r2 * UC + 1280 + c]) * cw[k * 256 + c]; }
                BR[(size_t)T * 256 + (size_t)row * 256 + c] = f2bf(bf2f(U[(size_t)row * UC + 768 + c]) * acc); } }
    }
}

__device__ __forceinline__ void phase_g2(const Ptrs P, int l, LAS unsigned char* lds) {
    const int MT = ((l == NLAYER - 1) ? NLAT : T) / 256;
    pg8::Gemm g{(const bf16_t*)(P.ws + WS_BR), (const bf16_t*)(P.ws + WS_WBR), 256};
    EpiP E{(bf16_t*)(P.ws + WS_BIG + BIG_P), (const float*)(P.ws + WS_SSQ)};
    SchedG2 S{P.G, P.bid, MT};
    pg8::gemm_phase<EpiP, SchedG2, false>(P.tid, lds, g, S, E);
}
__device__ __forceinline__ void phase_g3(const Ptrs P, int l, LAS unsigned char* lds) {
    const int MT = ((l == NLAYER - 1) ? NLAT : T) / 256;
    pg8::Gemm g{(const bf16_t*)(P.ws + WS_HBUF), (const bf16_t*)(P.ws + WS_WG), D};
    EpiMerge E{(const bf16_t*)(P.ws + WS_BIG + BIG_P), (const float*)(P.ws + WS_BGP), (bf16_t*)(P.ws + WS_BR)};
    SchedMN S{P.G, P.bid, MT, 16};
    pg8::gemm_phase<EpiMerge, SchedMN, false>(P.tid, lds, g, S, E);
}
__device__ __forceinline__ void phase_g4(const Ptrs P, int l, LAS unsigned char* lds) {
    const int MT = ((l == NLAYER - 1) ? NLAT : T) / 256;
    pg8::Gemm g{(const bf16_t*)(P.ws + WS_BR), (const bf16_t*)(P.ws + WS_WO), D};
    EpiWo E{P, l};
    SchedMN S{P.G, P.bid, MT, 4};
    pg8::gemm_phase<EpiWo, SchedMN, false>(P.tid, lds, g, S, E);
}

__device__ __forceinline__ void phase_e5(const Ptrs P, int l, LAS unsigned char* lds) {
    const int tid = P.tid, wid = tid >> 6, lane = tid & 63, G = P.G;
    const int rows_l = (l == NLAYER - 1) ? NLAT : T;
    LAS float* wrT = (LAS float*)lds;
    LAS float* tile = (LAS float*)(lds + 65536);
    for (int i = tid; i < 1024 * 16; i += 512) wrT[(i & 15) * 1024 + (i >> 4)] = P.inp(I_WROUTER)[i];
    __syncthreads();
    unsigned* cnt = (unsigned*)(P.ws + WS_CTL + CTL_CNT) + l * 16;
    int* toke = (int*)(P.ws + WS_TOKE); float* tokw = (float*)(P.ws + WS_TOKW); int* toks = (int*)(P.ws + WS_TOKS); int* list = (int*)(P.ws + WS_LIST);
    const float* g = P.inp(I_LN1G) + l * D; const float* bta = P.inp(I_LN1B) + l * D;
    const int NU_R = rows_l / 8; const int NU = NU_R + NCONV_EX;
    for (int u = P.bid; u < NU; u += G) {
        if (u >= NU_R) { conv_unit_ex(P, l, u - NU_R, tile); continue; }
        const int row = u * 8 + wid; RowV r; float* lp = P.latrow(row);
        row_load(r, lp, lane); row_layernorm(r, g, bta, lane); row_store(r, lp, lane);
        const float* m = P.mod(l, row_modidx(row)); RowV h; row_modulate(r, h, m + 3072, m + 4096, lane);
        row_store_bf16(h, (bf16_t*)(P.ws + WS_HBUF) + (size_t)row * D, lane);
        float lg[16];
#pragma unroll
        for (int e = 0; e < 16; ++e) { float s = 0.f;
#pragma unroll
            for (int i = 0; i < 4; ++i) { const f32x4 w = *(const LAS f32x4*)(wrT + e * 1024 + i * 256 + lane * 4); s += h.v[i][0] * w[0] + h.v[i][1] * w[1] + h.v[i][2] * w[2] + h.v[i][3] * w[3]; }
            lg[e] = wave_sum(s); }
        float mx = lg[0];
#pragma unroll
        for (int e = 1; e < 16; ++e) mx = fmaxf(mx, lg[e]);
        float sc[16], sel[16], ssum = 0.f;
#pragma unroll
        for (int e = 0; e < 16; ++e) { sc[e] = expf(lg[e] - mx); ssum += sc[e]; }
        const float inv = 1.0f / ssum;
#pragma unroll
        for (int e = 0; e < 16; ++e) { sc[e] *= inv; sel[e] = sc[e] + P.inp(I_BROUTER)[e]; }
        int bestg = 0; float bestgs = -3.0e38f;
#pragma unroll
        for (int gq = 0; gq < 4; ++gq) { float m1 = -3.0e38f, m2 = -3.0e38f;
#pragma unroll
            for (int j = 0; j < 4; ++j) { const float v = sel[gq * 4 + j]; if (v > m1) { m2 = m1; m1 = v; } else if (v > m2) m2 = v; }
            const float gs = m1 + m2; if (gs > bestgs) { bestgs = gs; bestg = gq; } }
        int i1 = 0, i2 = 0; float v1 = -3.0e38f, v2 = -3.0e38f, w1 = 0.f, w2 = 0.f;
#pragma unroll
        for (int e = 0; e < 16; ++e) { if ((e >> 2) == bestg && sel[e] > v1) { v1 = sel[e]; i1 = e; w1 = sc[e]; } }
#pragma unroll
        for (int e = 0; e < 16; ++e) { if ((e >> 2) == bestg && e != i1 && sel[e] > v2) { v2 = sel[e]; i2 = e; w2 = sc[e]; } }
        if (lane == 0) { const float ws_ = 1.0f / (w1 + w2);
            const int s1 = (int)__hip_atomic_fetch_add(cnt + i1, 1u, __ATOMIC_RELAXED, __HIP_MEMORY_SCOPE_AGENT);
            const int s2 = (int)__hip_atomic_fetch_add(cnt + i2, 1u, __ATOMIC_RELAXED, __HIP_MEMORY_SCOPE_AGENT);
            list[(size_t)i1 * T + s1] = row; list[(size_t)i2 * T + s2] = row;
            toke[row * 2] = i1; toke[row * 2 + 1] = i2; tokw[row * 2] = w1 * ws_; tokw[row * 2 + 1] = w2 * ws_; toks[row * 2] = s1; toks[row * 2 + 1] = s2; }
    }
}

struct MoeSeg { int toff[17]; };
__device__ __forceinline__ void moe_seg(const unsigned* cnt, MoeSeg& S) { int a = 0;
#pragma unroll
    for (int e = 0; e < 16; ++e) { S.toff[e] = a; a += __builtin_amdgcn_readfirstlane(((int)cnt[e] + 255) >> 8); }
    S.toff[16] = a; }
__device__ __forceinline__ int moe_find(const MoeSeg& S, int tg, int& off) { int e = 0; off = 0;
#pragma unroll
    for (int j = 1; j < 16; ++j) { const bool ge = (tg >= S.toff[j]); e += ge ? 1 : 0; off = ge ? S.toff[j] : off; }
    return e; }

struct SchedMoe { int G, c; MoeSeg S; const int* list; const unsigned* cnt;
    __device__ __forceinline__ bool next(int i, Unit& u) const { const int L = i * G + c; if (L >= S.toff[16] * 4) return false; const int tg = L >> 2, pnn = L & 3; int off; const int e = moe_find(S, tg, off);
        u.pm = tg; u.pn = e * 4 + pnn; u.e = e; u.aux = tg - off; return true; }
    __device__ __forceinline__ int arow(const Unit& u, int R) const { const int idx = u.aux * 256 + R; const int* l = list + (size_t)u.e * T; return idx < (int)cnt[u.e] ? l[idx] : l[0]; } };
__device__ __forceinline__ void phase_g5(const Ptrs P, int l, LAS unsigned char* lds) {
    const unsigned* cnt = (const unsigned*)(P.ws + WS_CTL + CTL_CNT) + l * 16;
    SchedMoe S; S.G = P.G; S.c = P.bid; moe_seg(cnt, S.S); S.list = (const int*)(P.ws + WS_LIST); S.cnt = cnt;
    pg8::Gemm g{(const bf16_t*)(P.ws + WS_HBUF), (const bf16_t*)(P.ws + WS_BIG + BIG_W13), D};
    EpiFfn1 E{(bf16_t*)(P.ws + WS_BIG + BIG_HID)};
    pg8::gemm_phase<EpiFfn1, SchedMoe, true>(P.tid, lds, g, S, E);
}
__device__ __forceinline__ void phase_g6(const Ptrs P, int l, LAS unsigned char* lds) {
    const unsigned* cnt = (const unsigned*)(P.ws + WS_CTL + CTL_CNT) + l * 16;
    SchedMoe S; S.G = P.G; S.c = P.bid; moe_seg(cnt, S.S); S.list = (const int*)(P.ws + WS_LIST); S.cnt = cnt;
    pg8::Gemm g{(const bf16_t*)(P.ws + WS_BIG + BIG_HID), (const bf16_t*)(P.ws + WS_BIG + BIG_W2), 512};
    EpiBf16Plain E{(bf16_t*)(P.ws + WS_BIG + BIG_YE), 1024, 3};
    pg8::gemm_phase<EpiBf16Plain, SchedMoe, false>(P.tid, lds, g, S, E);
}

__device__ __forceinline__ void phase_e8(const Ptrs P, int l, LAS unsigned char* lds) {
    const int tid = P.tid, wid = tid >> 6, lane = tid & 63, G = P.G;
    const bool last = (l == NLAYER - 1); const int rows_l = last ? NLAT : T;
    LAS float* wdt = (LAS float*)lds; LAS float* tile = (LAS float*)(lds + 65536);
    if (!last) load_wdt(P, l + 1, wdt);
    const unsigned* cnt = (const unsigned*)(P.ws + WS_CTL + CTL_CNT) + l * 16; MoeSeg S; moe_seg(cnt, S);
    const int* toke = (const int*)(P.ws + WS_TOKE); const float* tokw = (const float*)(P.ws + WS_TOKW); const int* toks = (const int*)(P.ws + WS_TOKS);
    const bf16_t* YE = (const bf16_t*)(P.ws + WS_BIG + BIG_YE);
    const float* g = P.inp(I_LN2G) + l * D; const float* bta = P.inp(I_LN2B) + l * D;
    const int NU_R = rows_l / 8; const int NU = NU_R + (last ? 0 : NCONV_NE);
    for (int u = P.bid; u < NU; u += G) {
        if (u >= NU_R) { conv_unit_ne(P, l + 1, u - NU_R, tile); continue; }
        const int row = u * 8 + wid; RowV r; float* lp = P.latrow(row); row_load(r, lp, lane);
        const int e1 = toke[row * 2], e2 = toke[row * 2 + 1]; const float w1 = tokw[row * 2], w2 = tokw[row * 2 + 1];
        int o1 = 0, o2 = 0;
#pragma unroll
        for (int e = 0; e < 16; ++e) { o1 = (e == e1) ? S.toff[e] : o1; o2 = (e == e2) ? S.toff[e] : o2; }
        const bf16_t* y1 = YE + ((size_t)o1 * 256 + toks[row * 2]) * 1024; const bf16_t* y2 = YE + ((size_t)o2 * 256 + toks[row * 2 + 1]) * 1024;
        const float* m = P.mod(l, row_modidx(row));
#pragma unroll
        for (int i = 0; i < 4; ++i) { const u32x2 a = *(const u32x2*)(y1 + i * 256 + lane * 4), b = *(const u32x2*)(y2 + i * 256 + lane * 4);
            const f32x4 g2 = *(const f32x4*)(m + 5120 + i * 256 + lane * 4);
            f32x4 mo; mo[0] = w1 * __uint_as_float(a.x << 16) + w2 * __uint_as_float(b.x << 16); mo[1] = w1 * __uint_as_float(a.x & 0xffff0000u) + w2 * __uint_as_float(b.x & 0xffff0000u);
            mo[2] = w1 * __uint_as_float(a.y << 16) + w2 * __uint_as_float(b.y << 16); mo[3] = w1 * __uint_as_float(a.y & 0xffff0000u) + w2 * __uint_as_float(b.y & 0xffff0000u);
            r.v[i] = r.v[i] * ALPHA + g2 * mo; }
        row_layernorm(r, g, bta, lane);
        row_store(r, lp, lane);
        if (!last) { const float* m2 = P.mod(l + 1, row_modidx(row)); RowV h; row_modulate(r, h, m2, m2 + 1024, lane);
            row_store_bf16(h, (bf16_t*)(P.ws + WS_HBUF) + (size_t)row * D, lane); row_dt(h, wdt, (float*)(P.ws + WS_DT) + (size_t)row * 8, lane); }
    }
}

constexpr int NPH_LAYER = 11, NPH = 2 + NLAYER * NPH_LAYER;
__global__ void __launch_bounds__(512, 2) fwd_kernel(Args a) {
    extern __shared__ __attribute__((aligned(16))) unsigned char lds_raw[];
    LAS unsigned char* lds = (LAS unsigned char*)lds_raw;
    const int lo = a.ph_lo, hi = a.ph_hi;
    volatile LAS unsigned* xbw = (volatile LAS unsigned*)(lds + LDS_MISC);
    const int wave_s = __builtin_amdgcn_readfirstlane((int)threadIdx.x >> 6);
    if (threadIdx.x < 4) xbw[threadIdx.x] = 0u;
    __syncthreads();
    XcdBarrier bar; bar.bar = (unsigned*)(a.ws + WS_CTL); bar.x = 0; bar.st = xbw;
    if (hi - lo > 1) bar = xcd_barrier_post((unsigned*)(a.ws + WS_CTL), xbw, wave_s);
#ifndef PH_MASK
#define PH_MASK 0xFFFFFFFFu
#endif
#define PH_ON(id) (((PH_MASK) >> (id)) & 1u)
#define IN(k) (lo <= (k) && (k) < hi)
#define FRESH() Ptrs Pq; { float* o_ = a.out; unsigned char* w_ = a.ws; int l_ = lcur; asm volatile("" : "+s"(o_), "+s"(w_), "+s"(l_) :: "memory"); Pq.out = o_; Pq.ws = w_; lq = l_; int ws_ = wave_s, b_ = blockIdx.x, g_ = gridDim.x; asm volatile("" : "+s"(ws_), "+s"(b_), "+s"(g_)); int ln_ = lane_id(); asm volatile("" : "+v"(ln_)); int t_ = ws_ * 64 + ln_; Pq.tid = t_; Pq.bid = b_; Pq.G = g_; }
#define SEAM(k) do { if (IN(k) && IN((k) + 1)) xcd_barrier(bar, wave_s); } while (0)
    int lcur = 0, lq = 0;
    if (PH_ON(0) && IN(0)) { FRESH(); phase_pa(Pq, lds); } SEAM(0);
    if (PH_ON(1) && IN(1)) { FRESH(); phase_pb(Pq, lds); } SEAM(1);
    for (int l = 0; l < NLAYER; ++l) {
        const int b = 2 + l * NPH_LAYER; lcur = l;
        if (PH_ON(2) && IN(b + 0)) { FRESH(); phase_g1(Pq, lds); } SEAM(b + 0);
        if (PH_ON(3) && IN(b + 1)) { FRESH(); phase_m1(Pq, lq, lds); } SEAM(b + 1);
        if (PH_ON(4) && IN(b + 2)) { FRESH(); phase_m2(Pq, lq, lds); } SEAM(b + 2);
        if (PH_ON(5) && IN(b + 3)) { FRESH(); phase_m3(Pq, lq, lds); } SEAM(b + 3);
        if (PH_ON(6) && IN(b + 4)) { FRESH(); phase_g2(Pq, lq, lds); } SEAM(b + 4);
        if (PH_ON(7) && IN(b + 5)) { FRESH(); phase_g3(Pq, lq, lds); } SEAM(b + 5);
        if (PH_ON(8) && IN(b + 6)) { FRESH(); phase_g4(Pq, lq, lds); } SEAM(b + 6);
        if (PH_ON(9) && IN(b + 7)) { FRESH(); phase_e5(Pq, lq, lds); } SEAM(b + 7);
        if (PH_ON(10) && IN(b + 8)) { FRESH(); phase_g5(Pq, lq, lds); } SEAM(b + 8);
        if (PH_ON(11) && IN(b + 9)) { FRESH(); phase_g6(Pq, lq, lds); } SEAM(b + 9);
        if (PH_ON(12) && IN(b + 10)) { FRESH(); phase_e8(Pq, lq, lds); } SEAM(b + 10);
    }
#undef IN
#undef SEAM
}
}

extern "C" void kernel_launch(void* const* d_in, const int* in_sizes, int n_in, void* d_out, int out_size, void* d_ws, size_t ws_size, hipStream_t stream) {
    static int grid = 0;
    if (grid == 0) {
        if (n_in != N_IN || out_size != NLAT * D || ws_size < WS_END) { fprintf(stderr, "kernel_launch: unexpected shapes / workspace (%d inputs, out %d, ws %zu < %zu)\n", n_in, out_size, ws_size, (size_t)WS_END); grid = -1; return; }
        int dev = 0, cus = 0, per_cu = 0;
        if (hipGetDevice(&dev) != hipSuccess || hipDeviceGetAttribute(&cus, hipDeviceAttributeMultiprocessorCount, dev) != hipSuccess) { grid = -1; return; }
        if (hipFuncSetAttribute((const void*)fwd_kernel, hipFuncAttributeMaxDynamicSharedMemorySize, LDS_BYTES) != hipSuccess) { fprintf(stderr, "kernel_launch: hipFuncSetAttribute failed\n"); grid = -1; return; }
        if (hipOccupancyMaxActiveBlocksPerMultiprocessor(&per_cu, (const void*)fwd_kernel, 512, LDS_BYTES) != hipSuccess || per_cu < 1) { fprintf(stderr, "kernel_launch: occupancy query says %d\n", per_cu); }
        (void)hipGetLastError();
        grid = cus;
    }
    if (grid < 0) return;
    (void)hipMemsetAsync((char*)d_ws + WS_CTL, 0, CTL_BYTES, stream);
    Args a{};
    for (int i = 0; i < N_IN; ++i) a.in[i] = (const float*)d_in[i];
    a.out = (float*)d_out; a.ws = (unsigned char*)d_ws;
#if N_LAUNCH_MODE == 1
    a.ph_lo = 0; a.ph_hi = NPH;
    hipLaunchKernelGGL(fwd_kernel, dim3(grid), dim3(512), LDS_BYTES, stream, a);
#else
    for (int p = 0; p < NPH; ++p) { a.ph_lo = p; a.ph_hi = p + 1; hipLaunchKernelGGL(fwd_kernel, dim3(grid), dim3(512), LDS_BYTES, stream, a); }
#endif
}
```

```cpp
#include <hip/hip_runtime.h>
#include <cstdio>
#include <cstdint>

#ifndef N_LAUNCH_MODE
#define N_LAUNCH_MODE 1
#endif

namespace {
typedef unsigned short bf16_t;
typedef short bf16x8 __attribute__((ext_vector_type(8)));
typedef float f32x4 __attribute__((ext_vector_type(4)));
typedef unsigned u32x2 __attribute__((ext_vector_type(2)));
typedef unsigned u32x4 __attribute__((ext_vector_type(4)));
#define LAS __attribute__((address_space(3)))

constexpr int D = 1024, NB = 8, SEQ = 4096, CTXL = 256, NLAT = NB * SEQ, NCTX = NB * CTXL, T = NLAT + NCTX;
constexpr int NLAYER = 2;
constexpr int UC = 3584;
constexpr int INC = 3592;
constexpr int NE = 16;
constexpr float ALPHA = 1.41421356237309515f;
constexpr float LN_EPS = 1e-5f, RMS_EPS = 1e-6f;
constexpr int MAXTILES = 288;

enum { I_X = 0, I_C, I_CTX, I_CCTX, I_WADA, I_BADA, I_WIN, I_HYCW, I_HYCB, I_HYW1, I_HYB1, I_HYF1, I_HYW2, I_HYB2, I_HYF2, I_HYW3, I_HYDEC, I_HYBIAS,
       I_SCCW, I_HGLB, I_HGNG, I_SSDCW, I_SSDCB, I_SSDALOG, I_SSDDTB, I_SSDD, I_SSDNG, I_WGATE, I_BGATE, I_WBR, I_WO, I_LN1G, I_LN1B, I_LN2G, I_LN2B,
       I_WROUTER, I_BROUTER, I_WE1, I_WE3, I_WE2, N_IN };

constexpr size_t al256(size_t x) { return (x + 255) & ~(size_t)255; }
constexpr size_t WS_CTL = 0;
constexpr size_t CTL_BYTES = 65536;
constexpr size_t CTL_CNT = 16384;
constexpr size_t WS_MOD = WS_CTL + CTL_BYTES;
constexpr size_t WS_LB = WS_MOD + al256((size_t)NLAYER * 9 * 6144 * 4);
constexpr size_t WS_TW = WS_LB + 4096;
constexpr size_t WS_H2TAB = WS_TW + 65536;
constexpr size_t WS_PART = WS_H2TAB + (size_t)8448 * 64 * 4;
constexpr size_t WS_FILT = WS_PART + (size_t)3 * 64 * 512 * 4;
constexpr size_t WS_FILTC = WS_FILT + (size_t)2 * 8192 * 256 * 4;
constexpr size_t WS_CX32 = WS_FILTC + (size_t)512 * 256 * 4;
constexpr size_t WS_DT = WS_CX32 + (size_t)NCTX * D * 4;
constexpr size_t WS_SSQ = WS_DT + (size_t)T * 8 * 4;
constexpr size_t WS_TOKE = WS_SSQ + (size_t)T * 4 * 4;
constexpr size_t WS_TOKW = WS_TOKE + (size_t)T * 2 * 4;
constexpr size_t WS_TOKS = WS_TOKW + (size_t)T * 2 * 4;
constexpr size_t WS_LIST = WS_TOKS + (size_t)T * 2 * 4;
constexpr size_t WS_BGP = WS_LIST + (size_t)NE * T * 4;
constexpr size_t WS_DEC = WS_BGP + 16384;
constexpr size_t WS_WIN = WS_DEC + (size_t)4352 * 64 * 4;
constexpr size_t WS_WG = WS_WIN + (size_t)UC * D * 2;
constexpr size_t WS_WBR = WS_WG + (size_t)4096 * D * 2;
constexpr size_t WS_WO = WS_WBR + (size_t)4096 * 256 * 2;
constexpr size_t WS_HBUF = WS_WO + (size_t)D * D * 2;
constexpr size_t WS_BR = WS_HBUF + (size_t)T * D * 2;
constexpr size_t WS_BIG = WS_BR + (size_t)T * D * 2;
constexpr size_t BIG_U = 0;
constexpr size_t BIG_HGO = BIG_U + (size_t)T * UC * 2;
constexpr size_t BIG_STATE = BIG_HGO;
constexpr size_t BIG_SSY = BIG_HGO + (size_t)T * 256 * 4;
constexpr size_t BIG_WT = BIG_SSY + (size_t)T * 256 * 4;
constexpr size_t BIG_END1 = BIG_WT + (size_t)T * 256 * 2;
constexpr size_t BIG_P = 0;
constexpr size_t BIG_HID = 0;
constexpr size_t BIG_YE = BIG_HID + (size_t)MAXTILES * 256 * 512 * 2;
constexpr size_t BIG_W13 = BIG_YE + (size_t)MAXTILES * 256 * 1024 * 2;
constexpr size_t BIG_W2 = BIG_W13 + (size_t)NE * 1024 * 1024 * 2;
constexpr size_t BIG_END3 = BIG_W2 + (size_t)NE * 1024 * 512 * 2;
constexpr size_t BIG_BYTES = BIG_END1 > BIG_END3 ? BIG_END1 : BIG_END3;
constexpr size_t WS_END = WS_BIG + BIG_BYTES;
static_assert((size_t)T * 4096 * 2 <= BIG_BYTES, "P fits");
static_assert(WS_END <= (size_t)536870912, "workspace budget");

constexpr int LDS_BYTES = 147456;
constexpr int LDS_MISC = 147456 - 256;

struct Args { const float* in[N_IN]; float* out; unsigned char* ws; int ph_lo, ph_hi; };

#define XB_TMO      128
#define XB_XCNT(j)  (256  + 64 * (j))
#define XB_XSUB(j)  (1280 + 64 * (j))
#define XB_XGEN(j)  (2304 + 64 * (j))
#define XB_TOP      3328
#define XB_TOPGEN   3392
#define XCD_BAR_WORDS 3456
#define XB_SPIN_CAP (1u << 18)
__device__ __forceinline__ unsigned xb_ld(unsigned* p)              { return __hip_atomic_load(p, __ATOMIC_RELAXED, __HIP_MEMORY_SCOPE_AGENT); }
__device__ __forceinline__ unsigned xb_add(unsigned* p, unsigned v) { return __hip_atomic_fetch_add(p, v, __ATOMIC_RELAXED, __HIP_MEMORY_SCOPE_AGENT); }
__device__ __forceinline__ unsigned xb_xcc_id() { return (unsigned)__builtin_amdgcn_s_getreg((3 << 11) | 20) & 0xFu; }
#define XB_SPIN(cond, bar) do { unsigned _sp = 0; while (cond) { __builtin_amdgcn_s_sleep(1); \
    if ((++_sp & 255u) == 0u) { if (xb_ld(&(bar)[XB_TMO])) break; if (_sp > XB_SPIN_CAP) { atomicAdd(&(bar)[XB_TMO], 1u); break; } } } } while (0)
struct XcdBarrier { unsigned* bar; unsigned x; volatile LAS unsigned* st; };
__device__ __forceinline__ int lane_id() { unsigned z = 0u; asm volatile("" : "+v"(z)); return (int)__builtin_amdgcn_mbcnt_hi(~0u, __builtin_amdgcn_mbcnt_lo(~0u, z)); }
__device__ __forceinline__ bool is_thread0(int wave_s) { return wave_s == 0 && lane_id() == 0; }
__device__ __forceinline__ XcdBarrier xcd_barrier_post(unsigned* bar, volatile LAS unsigned* st, int wave_s) {
    XcdBarrier b; b.bar = bar; b.x = xb_xcc_id(); b.st = st;
    if (is_thread0(wave_s)) (void)xb_add(&bar[XB_XCNT(b.x)], 1u);
    return b;
}
__device__ __forceinline__ void xcd_barrier_complete(unsigned* bar, unsigned x, unsigned& nloc, unsigned& nx) {
    const unsigned G = gridDim.x * gridDim.y * gridDim.z;
    unsigned sum, cnt, mine, sp = 0u;
    for (;;) {
        sum = 0u; cnt = 0u; mine = 0u;
#pragma unroll
        for (unsigned j = 0; j < 16; ++j) { const unsigned c = xb_ld(&bar[XB_XCNT(j)]); sum += c; cnt += (c > 0u) ? 1u : 0u; mine = (j == x) ? c : mine; }
        if (sum == G) break;
        __builtin_amdgcn_s_sleep(1);
        if ((++sp & 255u) == 0u) { if (xb_ld(&bar[XB_TMO])) break; if (sp > XB_SPIN_CAP) { atomicAdd(&bar[XB_TMO], 1u); break; } }
    }
    nloc = mine > 0u ? mine : 1u; nx = cnt > 0u ? cnt : 1u;
}
__device__ __forceinline__ void xcd_barrier(const XcdBarrier& b, int wave_s) {
    asm volatile("s_waitcnt vmcnt(0)" ::: "memory");
    __syncthreads();
    if (is_thread0(wave_s)) {
        unsigned* bar = b.bar;
        __builtin_amdgcn_s_waitcnt(0);
        unsigned nloc = b.st[0], nx = b.st[1];
        if (nloc == 0u) { xcd_barrier_complete(bar, b.x, nloc, nx); b.st[0] = nloc; b.st[1] = nx; }
        const unsigned old = xb_add(&bar[XB_XSUB(b.x)], 1u);
        const unsigned gen = old / nloc;
        if (old + 1u == (gen + 1u) * nloc) {
            __builtin_amdgcn_fence(__ATOMIC_RELEASE, "agent");
            asm volatile("s_waitcnt vmcnt(0)" ::: "memory");
            const unsigned og = xb_add(&bar[XB_TOP], 1u);
            const unsigned tg = og / nx;
            if (og + 1u == (tg + 1u) * nx) xb_add(&bar[XB_TOPGEN], 1u);
            else XB_SPIN(xb_ld(&bar[XB_TOPGEN]) == tg, bar);
            __builtin_amdgcn_fence(__ATOMIC_ACQUIRE, "agent");
            xb_add(&bar[XB_XGEN(b.x)], 1u);
            asm volatile("s_waitcnt vmcnt(0)" ::: "memory");
        } else {
            XB_SPIN(xb_ld(&bar[XB_XGEN(b.x)]) == gen, bar);
            __builtin_amdgcn_fence(__ATOMIC_ACQUIRE, "agent");
            asm volatile("s_waitcnt vmcnt(0)" ::: "memory");
        }
    }
    __syncthreads();
}

__device__ __forceinline__ float bf2f(bf16_t b) { return __uint_as_float(((unsigned)b) << 16); }
__device__ __forceinline__ bf16_t f2bf(float f) { unsigned u = __float_as_uint(f); u += 0x7FFFu + ((u >> 16) & 1u); return (bf16_t)(u >> 16); }
__device__ __forceinline__ unsigned pack2(float lo, float hi) { return (unsigned)f2bf(lo) | ((unsigned)f2bf(hi) << 16); }
__device__ __forceinline__ float sigmoidf_(float x) { return 1.0f / (1.0f + __expf(-x)); }
__device__ __forceinline__ float siluf_(float x) { return x * sigmoidf_(x); }
__device__ __forceinline__ float wave_sum(float v) {
#pragma unroll
    for (int o = 32; o >= 1; o >>= 1) v += __shfl_xor(v, o);
    return v;
}
__device__ __forceinline__ int row_modidx(int r) { return r < NLAT ? (r >> 12) : 8; }
__device__ __forceinline__ bool row_has_prev(int r) { return r < NLAT ? ((r & 4095) != 0) : (((r - NLAT) & 255) != 0); }
__device__ __forceinline__ bool row_has_next(int r) { return r < NLAT ? ((r & 4095) != 4095) : (((r - NLAT) & 255) != 255); }

struct Ptrs {
    float* out; unsigned char* ws; int tid, bid, G;
    __device__ __forceinline__ const float* inp(int i) const { asm volatile("" : "+s"(i));
        const __attribute__((address_space(4))) char* ka = (const __attribute__((address_space(4))) char*)__builtin_amdgcn_kernarg_segment_ptr();
        return *(const float* const __attribute__((address_space(4)))*)(ka + 8 * i); }
    __device__ __forceinline__ float* latrow(int r) const { return r < NLAT ? out + (size_t)r * D : (float*)(ws + WS_CX32) + (size_t)(r - NLAT) * D; }
    __device__ __forceinline__ float* mod(int l, int ridx) const { return (float*)(ws + WS_MOD) + ((size_t)l * 9 + ridx) * 6144; }
};

__device__ __forceinline__ float conv3_u(const bf16_t* U, int row, int col, const float* w, int ncol, int wcol) {
    float acc = bf2f(U[(size_t)row * UC + col]) * w[ncol + wcol];
    if (row_has_prev(row)) acc += bf2f(U[(size_t)(row - 1) * UC + col]) * w[wcol];
    if (row_has_next(row)) acc += bf2f(U[(size_t)(row + 1) * UC + col]) * w[2 * ncol + wcol];
    return acc;
}

struct Unit { int pm, pn, e, aux; };
__host__ __device__ __forceinline__ int perm32(int rho) { const int n = rho >> 4, i = rho & 15; return 8 * (i >> 2) + 4 * n + (i & 3); }

template <class RowMap, class Epi>
__device__ __forceinline__ void sgemm_unit(int tid_, const bf16_t* __restrict__ A, int lda, const bf16_t* __restrict__ Bt, int ldb, int K, const Unit& u, const RowMap& RM, const Epi& E) {
    const int tid = tid_, wid = tid >> 6, lane = tid & 63, wr = wid >> 2, wc = wid & 3, fr = lane & 15, fq = lane >> 4;
    f32x4 acc[2][2][4][2];
#pragma unroll
    for (int a = 0; a < 2; ++a)
#pragma unroll
        for (int b = 0; b < 2; ++b)
#pragma unroll
            for (int m = 0; m < 4; ++m)
#pragma unroll
                for (int n = 0; n < 2; ++n) acc[a][b][m][n] = (f32x4){0.f, 0.f, 0.f, 0.f};
    unsigned ap[2][4], bp[2][2];
#pragma unroll
    for (int a = 0; a < 2; ++a)
#pragma unroll
        for (int m = 0; m < 4; ++m) ap[a][m] = (unsigned)RM(u, 128 * a + 64 * wr + 16 * m + fr) * (unsigned)lda + fq * 8;
#pragma unroll
    for (int b = 0; b < 2; ++b)
#pragma unroll
        for (int n = 0; n < 2; ++n) { const int rho = 16 * n + fr; const int col = Epi::PERM ? perm32(rho) : rho;
            bp[b][n] = (unsigned)(u.pn * 256 + 128 * b + 32 * wc + col) * (unsigned)ldb + fq * 8; }
    for (int k = 0; k < K; k += 32) {
        bf16x8 bfr[2][2];
#pragma unroll
        for (int b = 0; b < 2; ++b)
#pragma unroll
            for (int n = 0; n < 2; ++n) bfr[b][n] = *(const bf16x8*)(Bt + (bp[b][n] + k));
#pragma unroll
        for (int a = 0; a < 2; ++a) {
            bf16x8 af[4];
#pragma unroll
            for (int m = 0; m < 4; ++m) af[m] = *(const bf16x8*)(A + (ap[a][m] + k));
#pragma unroll
            for (int b = 0; b < 2; ++b)
#pragma unroll
                for (int m = 0; m < 4; ++m)
#pragma unroll
                    for (int n = 0; n < 2; ++n) acc[a][b][m][n] = __builtin_amdgcn_mfma_f32_16x16x32_bf16(bfr[b][n], af[m], acc[a][b][m][n], 0, 0, 0);
        }
    }
    E(acc, u, wr, wc, fr, fq);
}

struct RowIdent { __device__ __forceinline__ int operator()(const Unit& u, int R) const { return u.pm * 256 + R; } };
struct RowStackK { int rows; __device__ __forceinline__ int operator()(const Unit& u, int R) const { return u.e * rows + u.pm * 256 + R; } };
struct RowGather { const int* list; const unsigned* cnt; __device__ __forceinline__ int operator()(const Unit& u, int R) const {
    const int idx = u.aux * 256 + R; const int* l = list + (size_t)u.e * T; return idx < (int)cnt[u.e] ? l[idx] : l[0]; } };


namespace pg8 {
constexpr int BM = 256, BK = 64, HALF = 128, HTB = HALF * BK * 2, STAGE_BYTES = 8 * HTB;
__host__ __device__ __forceinline__ int lds_byte(int r, int c) { const int st = (r >> 4) * 2 + (c >> 5), rr = r & 15, cc = c & 31, ob = rr * 64 + cc * 2; return st * 1024 + (ob ^ (((ob >> 9) & 1) << 5)); }
__host__ __device__ __forceinline__ void stage_rc(int b, int& R, int& C) { const int st = b / 1024, sb = b % 1024, swz = sb ^ (((sb >> 9) & 1) << 5); R = (st >> 1) * 16 + swz / 64; C = (st & 1) * 32 + (swz % 64) / 2; }
struct Gemm { const bf16_t* A; const bf16_t* Bt; int K; };

template <class Epi, class Sched, bool GATHER>
__device__ __forceinline__ void gemm_phase(int tid, LAS unsigned char* lds, const Gemm g, const Sched& S, const Epi& E) {
    const int wid = __builtin_amdgcn_readfirstlane(tid >> 6), lane = tid & 63, wr = wid >> 2, wc = wid & 3, fr = lane & 15, fq = lane >> 4;
    const int K = g.K, nt = K / BK;
    int RA[2], CA[2]; unsigned voffB[2];
    unsigned vA[2][2], vAn[2][2];
#pragma unroll
    for (int i = 0; i < 2; ++i) { int R, C; stage_rc(tid * 16 + i * 8192, R, C); RA[i] = R; CA[i] = C; const int Rb = Epi::PERM ? ((R & ~31) + perm32(R & 31)) : R; voffB[i] = (unsigned)(Rb * K + C) * 2u; }
    const size_t kstep = (size_t)(BK * 2);
    const size_t hstep = (size_t)HALF * K * 2;
    const size_t tstep = 2 * hstep;
    const unsigned ldsw = (unsigned)wid * 1024u;
    const int aoff = lds_byte(wr * 64 + fr, fq * 8), boff = lds_byte(wc * 32 + fr, fq * 8);
#define PG8_SA(b, h) (((b) * 2 + (h)) * HTB)
#define PG8_SB(b, h) ((4 + (b) * 2 + (h)) * HTB)
#define PG8_STAGE(bufoff, gbase, voff) do { _Pragma("unroll") for (int _i = 0; _i < 2; ++_i) \
        __builtin_amdgcn_global_load_lds((const unsigned*)((const char*)(gbase) + (voff)[_i]), (LAS unsigned*)(lds + (bufoff) + ldsw + _i * 8192), 16, 0, 0); } while (0)
#define PG8_STAGE2(bufoff, gbase, v0, v1) do { \
        __builtin_amdgcn_global_load_lds((const unsigned*)((const char*)(gbase) + (v0)), (LAS unsigned*)(lds + (bufoff) + ldsw), 16, 0, 0); \
        __builtin_amdgcn_global_load_lds((const unsigned*)((const char*)(gbase) + (v1)), (LAS unsigned*)(lds + (bufoff) + ldsw + 8192), 16, 0, 0); } while (0)
#define PG8_LDA(dst, b, h) do { _Pragma("unroll") for (int m = 0; m < 4; ++m) _Pragma("unroll") for (int k = 0; k < 2; ++k) dst[m][k] = *(const LAS bf16x8*)(lds + PG8_SA(b, h) + aoff + m * 2048 + k * 1024); } while (0)
#define PG8_LDB(dst, b, h) do { _Pragma("unroll") for (int n = 0; n < 2; ++n) _Pragma("unroll") for (int k = 0; k < 2; ++k) dst[n][k] = *(const LAS bf16x8*)(lds + PG8_SB(b, h) + boff + n * 2048 + k * 1024); } while (0)
#define PG8_MMA(ai, bj, At, Bt) do { __builtin_amdgcn_s_setprio(1); _Pragma("unroll") for (int m = 0; m < 4; ++m) _Pragma("unroll") for (int n = 0; n < 2; ++n) _Pragma("unroll") for (int k = 0; k < 2; ++k) \
        acc[ai][bj][m][n] = __builtin_amdgcn_mfma_f32_16x16x32_bf16(Bt[n][k], At[m][k], acc[ai][bj][m][n], 0, 0, 0); __builtin_amdgcn_s_setprio(0); } while (0)
#define PG8_WAIT_V(n) asm volatile("s_waitcnt vmcnt(" #n ")" ::: "memory")
#define PG8_WAIT_L(n) asm volatile("s_waitcnt lgkmcnt(" #n ")" ::: "memory")
#define PG8_BAR __builtin_amdgcn_s_barrier()
#define PG8_SCHED __builtin_amdgcn_sched_barrier(0)
#define PG8_AOFFS(dst, unit) do { _Pragma("unroll") for (int _h = 0; _h < 2; ++_h) _Pragma("unroll") for (int _i = 0; _i < 2; ++_i) \
        dst[_h][_i] = GATHER ? ((unsigned)S.arow(unit, _h * HALF + RA[_i]) * (unsigned)K + (unsigned)CA[_i]) * 2u : ((unsigned)(_h * HALF + RA[_i]) * (unsigned)K + (unsigned)CA[_i]) * 2u; } while (0)
    Unit cur, nxt; int ui = 0;
    if (!S.next(0, cur)) return;
    f32x4 acc[2][2][4][2];
#pragma unroll
    for (int a = 0; a < 2; ++a)
#pragma unroll
        for (int b = 0; b < 2; ++b)
#pragma unroll
            for (int m = 0; m < 4; ++m)
#pragma unroll
                for (int n = 0; n < 2; ++n) acc[a][b][m][n] = (f32x4){0.f, 0.f, 0.f, 0.f};
    bf16x8 At[4][2], B0[2][2], B1[2][2];
    const char* cA = GATHER ? (const char*)g.A : (const char*)g.A + (size_t)cur.pm * tstep; const char* cB = (const char*)g.Bt + (size_t)cur.pn * tstep;
    PG8_AOFFS(vA, cur);
    PG8_STAGE(PG8_SB(0, 0), cB, voffB); PG8_STAGE(PG8_SB(0, 1), cB + hstep, voffB); PG8_STAGE2(PG8_SA(0, 0), cA, vA[0][0], vA[0][1]); PG8_STAGE2(PG8_SA(0, 1), cA, vA[1][0], vA[1][1]);
    if (wr == 1) PG8_BAR;
    PG8_WAIT_V(2); PG8_BAR;
    PG8_STAGE(PG8_SB(1, 0), cB + kstep, voffB); PG8_STAGE2(PG8_SA(1, 0), cA + kstep, vA[0][0], vA[0][1]); PG8_STAGE(PG8_SB(1, 1), cB + hstep + kstep, voffB);
    PG8_WAIT_V(6); PG8_BAR;
    for (;;) {
        const bool has_next = S.next(ui + 1, nxt);
        const char* nA = GATHER ? (const char*)g.A : (has_next ? (const char*)g.A + (size_t)nxt.pm * tstep : cA); const char* nB = has_next ? (const char*)g.Bt + (size_t)nxt.pn * tstep : cB;
        if (has_next) { PG8_AOFFS(vAn, nxt); } else {
#pragma unroll
            for (int _h = 0; _h < 2; ++_h)
#pragma unroll
                for (int _i = 0; _i < 2; ++_i) vAn[_h][_i] = vA[_h][_i]; }
#pragma unroll 1
        for (int t = 0; t < nt; t += 2) {
            const bool last = (t == nt - 2);
            const char* a1 = cA + (size_t)(t + 1) * kstep;
            const char* a2 = last ? nA : cA + (size_t)(t + 2) * kstep; const char* b2 = last ? nB : cB + (size_t)(t + 2) * kstep;
            const char* a3 = a2 + kstep; const char* b3 = b2 + kstep;
            const unsigned x00 = last ? vAn[0][0] : vA[0][0], x01 = last ? vAn[0][1] : vA[0][1], x10 = last ? vAn[1][0] : vA[1][0], x11 = last ? vAn[1][1] : vA[1][1];
            PG8_LDB(B0, 0, 0); PG8_LDB(B1, 0, 1); PG8_SCHED; PG8_LDA(At, 0, 0); PG8_STAGE2(PG8_SA(1, 1), a1, vA[1][0], vA[1][1]);
            PG8_WAIT_V(8); PG8_WAIT_L(0); PG8_BAR; PG8_MMA(0, 0, At, B0); PG8_MMA(0, 1, At, B1); PG8_BAR; PG8_SCHED;
            PG8_LDA(At, 0, 1); PG8_STAGE(PG8_SB(0, 0), b2, voffB); PG8_STAGE(PG8_SB(0, 1), b2 + hstep, voffB); PG8_STAGE2(PG8_SA(0, 0), a2, x00, x01);
            PG8_WAIT_V(8); PG8_WAIT_L(0); PG8_BAR; PG8_MMA(1, 0, At, B0); PG8_MMA(1, 1, At, B1); PG8_BAR; PG8_SCHED;
            PG8_LDB(B0, 1, 0); PG8_LDB(B1, 1, 1); PG8_SCHED; PG8_LDA(At, 1, 0); PG8_STAGE2(PG8_SA(0, 1), a2, x10, x11);
            PG8_WAIT_V(8); PG8_WAIT_L(0); PG8_BAR; PG8_MMA(0, 0, At, B0); PG8_MMA(0, 1, At, B1); PG8_BAR; PG8_SCHED;
            PG8_LDA(At, 1, 1); PG8_STAGE(PG8_SB(1, 0), b3, voffB); PG8_STAGE(PG8_SB(1, 1), b3 + hstep, voffB); PG8_STAGE2(PG8_SA(1, 0), a3, x00, x01);
            PG8_WAIT_V(8); PG8_WAIT_L(0); PG8_BAR; PG8_MMA(1, 0, At, B0); PG8_MMA(1, 1, At, B1); PG8_BAR; PG8_SCHED;
        }
        if (wr == 0) PG8_BAR;
        E(acc, cur, wr, wc, fr, fq);
        if (!has_next) break;
#pragma unroll
        for (int a = 0; a < 2; ++a)
#pragma unroll
            for (int b = 0; b < 2; ++b)
#pragma unroll
                for (int m = 0; m < 4; ++m)
#pragma unroll
                    for (int n = 0; n < 2; ++n) acc[a][b][m][n] = (f32x4){0.f, 0.f, 0.f, 0.f};
        cur = nxt; cA = nA; cB = nB; ++ui;
#pragma unroll
        for (int _h = 0; _h < 2; ++_h)
#pragma unroll
            for (int _i = 0; _i < 2; ++_i) vA[_h][_i] = vAn[_h][_i];
        if (wr == 1) PG8_BAR;
    }
    PG8_WAIT_V(0);
    PG8_BAR;
#undef PG8_SA
#undef PG8_SB
#undef PG8_STAGE
#undef PG8_STAGE2
#undef PG8_LDA
#undef PG8_LDB
#undef PG8_MMA
#undef PG8_WAIT_V
#undef PG8_WAIT_L
#undef PG8_BAR
#undef PG8_SCHED
#undef PG8_AOFFS
}
}

struct SchedG1 { int G, c; __device__ __forceinline__ bool next(int i, Unit& u) const { const int L = i * G + c; if (L >= (T / 256) * 14) return false; u.pm = L / 14; u.pn = L % 14; u.e = 0; u.aux = 0; return true; }
    __device__ __forceinline__ int arow(const Unit&, int) const { return 0; } };
struct SchedG2 { int G, c, MT; __device__ __forceinline__ bool next(int i, Unit& u) const { const int L = i * G + c; if (L >= 16 * MT) return false; const int k = L / (MT * 4), rem = L % (MT * 4);
        u.pm = k * (T / 256) + (rem >> 2); u.pn = k * 4 + (rem & 3); u.e = k; u.aux = rem & 3; return true; }
    __device__ __forceinline__ int arow(const Unit&, int) const { return 0; } };
struct SchedMN { int G, c, MT, NT; __device__ __forceinline__ bool next(int i, Unit& u) const { const int L = i * G + c; if (L >= MT * NT) return false; u.pm = L / NT; u.pn = L % NT; u.e = 0; u.aux = 0; return true; }
    __device__ __forceinline__ int arow(const Unit&, int) const { return 0; } };

struct EpiBf16Plain {
    static constexpr bool PERM = true;
    bf16_t* O; int ldc; int coltile_mask;
    __device__ __forceinline__ void operator()(const f32x4 (&acc)[2][2][4][2], const Unit& u, int wr, int wc, int fr, int fq) const {
        const int row0 = u.pm * 256 + wr * 64 + fr, col0 = (u.pn & coltile_mask) * 256 + wc * 32 + 8 * fq;
#pragma unroll
        for (int ai = 0; ai < 2; ++ai)
#pragma unroll
            for (int m = 0; m < 4; ++m) { bf16_t* rowp = O + (size_t)(row0 + ai * 128 + m * 16) * ldc + col0;
#pragma unroll
                for (int bj = 0; bj < 2; ++bj) { const f32x4 v0 = acc[ai][bj][m][0], v1 = acc[ai][bj][m][1];
                    u32x4 w; w.x = pack2(v0[0], v0[1]); w.y = pack2(v0[2], v0[3]); w.z = pack2(v1[0], v1[1]); w.w = pack2(v1[2], v1[3]);
                    *(u32x4*)(rowp + bj * 128) = w; } }
    }
};
struct EpiP {
    static constexpr bool PERM = true;
    bf16_t* P; const float* ssq;
    __device__ __forceinline__ void operator()(const f32x4 (&acc)[2][2][4][2], const Unit& u, int wr, int wc, int fr, int fq) const {
        const int k = u.e; const int pmt = u.pm - k * (T / 256);
        const unsigned c00 = (unsigned)(u.aux * 256 + wc * 32 + 8 * fq);
        const unsigned base = (unsigned)pmt * (16u * 256u * 256u) + (unsigned)k * 64u;
#pragma unroll
        for (int ai = 0; ai < 2; ++ai)
#pragma unroll
            for (int m = 0; m < 4; ++m) { const int r = ai * 128 + wr * 64 + m * 16 + fr; float sc = 1.0f;
                if (k == 3) { const float* qp = ssq + (size_t)(pmt * 256 + r) * 4; sc = rsqrtf((qp[0] + qp[1] + qp[2] + qp[3]) * (1.0f / 256.0f) + RMS_EPS); }
#pragma unroll
                for (int bj = 0; bj < 2; ++bj) { const unsigned c0 = c00 + bj * 128; const unsigned s = c0 >> 6, wi = c0 & 63;
                    const f32x4 v0 = acc[ai][bj][m][0] * sc, v1 = acc[ai][bj][m][1] * sc;
                    u32x4 w; w.x = pack2(v0[0], v0[1]); w.y = pack2(v0[2], v0[3]); w.z = pack2(v1[0], v1[1]); w.w = pack2(v1[2], v1[3]);
                    *(u32x4*)(P + (base + (s * 256u + (unsigned)r) * 256u + wi)) = w; }
                asm volatile("" ::: "memory"); }
    }
};
struct EpiMerge {
    static constexpr bool PERM = false;
    const bf16_t* P; const float* bgp; bf16_t* Y;
    __device__ __forceinline__ void operator()(const f32x4 (&acc)[2][2][4][2], const Unit& u, int wr, int wc, int fr, int fq) const {
        const int s = u.pn;
        f32x4 bv[2][2];
#pragma unroll
        for (int bj = 0; bj < 2; ++bj)
#pragma unroll
            for (int n = 0; n < 2; ++n) bv[bj][n] = *(const f32x4*)(bgp + s * 256 + bj * 128 + wc * 32 + n * 16 + 4 * fq);
#pragma unroll
        for (int ai = 0; ai < 2; ++ai)
#pragma unroll
            for (int m = 0; m < 4; ++m) { const int r = ai * 128 + wr * 64 + m * 16 + fr;
                const bf16_t* pp = P + (((size_t)u.pm * 16 + s) * 256 + r) * 256 + wc * 16 + 4 * fq;
                f32x4 y = (f32x4){0.f, 0.f, 0.f, 0.f};
#pragma unroll
                for (int bj = 0; bj < 2; ++bj)
#pragma unroll
                    for (int n = 0; n < 2; ++n) { const int k = 2 * bj + n; const u32x2 pw = *(const u32x2*)(pp + k * 64);
                        const f32x4 g = acc[ai][bj][m][n] + bv[bj][n];
                        y[0] += sigmoidf_(g[0]) * __uint_as_float(pw.x << 16); y[1] += sigmoidf_(g[1]) * __uint_as_float(pw.x & 0xffff0000u);
                        y[2] += sigmoidf_(g[2]) * __uint_as_float(pw.y << 16); y[3] += sigmoidf_(g[3]) * __uint_as_float(pw.y & 0xffff0000u); }
                u32x2 w; w.x = pack2(y[0], y[1]); w.y = pack2(y[2], y[3]);
                *(u32x2*)(Y + (size_t)(u.pm * 256 + r) * D + s * 64 + wc * 16 + 4 * fq) = w; }
    }
};
struct EpiWo {
    static constexpr bool PERM = false;
    Ptrs P; int layer;
    __device__ __forceinline__ void operator()(const f32x4 (&acc)[2][2][4][2], const Unit& u, int wr, int wc, int fr, int fq) const {
        const int col0 = u.pn * 256 + wc * 32 + 4 * fq;
#pragma unroll
        for (int ai = 0; ai < 2; ++ai)
#pragma unroll
            for (int m = 0; m < 4; ++m) { const int row = u.pm * 256 + ai * 128 + wr * 64 + m * 16 + fr;
                float* lp = P.latrow(row) + col0; const float* g1 = P.mod(layer, row_modidx(row)) + 2048 + col0;
#pragma unroll
                for (int bj = 0; bj < 2; ++bj)
#pragma unroll
                    for (int n = 0; n < 2; ++n) { const f32x4 x = *(const f32x4*)(lp + bj * 128 + n * 16); const f32x4 g = *(const f32x4*)(g1 + bj * 128 + n * 16);
                        *(f32x4*)(lp + bj * 128 + n * 16) = x * ALPHA + g * acc[ai][bj][m][n]; } }
    }
};
struct EpiFfn1 {
    static constexpr bool PERM = false;
    bf16_t* H;
    __device__ __forceinline__ void operator()(const f32x4 (&acc)[2][2][4][2], const Unit& u, int wr, int wc, int fr, int fq) const {
        const int pnn = u.pn & 3;
#pragma unroll
        for (int ai = 0; ai < 2; ++ai)
#pragma unroll
            for (int m = 0; m < 4; ++m) { const int pos = u.pm * 256 + ai * 128 + wr * 64 + m * 16 + fr;
#pragma unroll
                for (int bj = 0; bj < 2; ++bj) { const f32x4 a = acc[ai][bj][m][0], b = acc[ai][bj][m][1];
                    u32x2 w; w.x = pack2(siluf_(a[0]) * b[0], siluf_(a[1]) * b[1]); w.y = pack2(siluf_(a[2]) * b[2], siluf_(a[3]) * b[3]);
                    *(u32x2*)(H + (size_t)pos * 512 + pnn * 128 + bj * 64 + wc * 16 + 4 * fq) = w; } }
    }
};

template <class SrcFn>
__device__ __forceinline__ void conv_tile(int tid, LAS float* tile  , bf16_t* dst, int ldd, int n0, int k0, const SrcFn& src) {
#pragma unroll
    for (int i = 0; i < 8; ++i) { const int kk = (tid >> 6) + 8 * i, j = tid & 63; tile[kk * 65 + j] = src(k0 + kk, n0 + j); }
    __syncthreads();
    { const int jj = tid >> 3, kq = tid & 7; float v[8];
#pragma unroll
      for (int i = 0; i < 8; ++i) v[i] = tile[(8 * kq + i) * 65 + jj];
      u32x4 w; w.x = pack2(v[0], v[1]); w.y = pack2(v[2], v[3]); w.z = pack2(v[4], v[5]); w.w = pack2(v[6], v[7]);
      *(u32x4*)(dst + (size_t)(n0 + jj) * ldd + k0 + 8 * kq) = w; }
    __syncthreads();
}
constexpr int NCONV_NE = 56 * 16 + 64 * 16 + 64 * 4 + 16 * 16;
constexpr int NCONV_EX = NE * (16 * 16 + 16 * 8);
__device__ __forceinline__ int gate_srccol(int np) { const int s = np >> 8, bj = (np >> 7) & 1, wc = (np >> 5) & 3, n = (np >> 4) & 1, fqe = np & 15; return (2 * bj + n) * 1024 + 64 * s + 16 * wc + fqe; }
__device__ __forceinline__ void conv_unit_ne(const Ptrs P, int l, int t, LAS float* tile) {
    unsigned char* ws = P.ws;
    if (t < 896) { const int nt = t >> 4, kt = t & 15; const float* src = P.inp(I_WIN) + (size_t)l * D * INC;
        conv_tile(P.tid, tile, (bf16_t*)(ws + WS_WIN), D, nt * 64, kt * 64, [=](int k, int n) { return src[(size_t)k * INC + n]; });
    } else if (t < 896 + 1024) { t -= 896; const int nt = t >> 4, kt = t & 15; const float* src = P.inp(I_WGATE) + (size_t)l * D * 4096;
        conv_tile(P.tid, tile, (bf16_t*)(ws + WS_WG), D, nt * 64, kt * 64, [=](int k, int n) { return src[(size_t)k * 4096 + gate_srccol(n)]; });
        if (kt == 0 && P.tid < 64) { const int np = nt * 64 + P.tid; ((float*)(ws + WS_BGP))[np] = P.inp(I_BGATE)[(size_t)l * 4096 + gate_srccol(np)]; }
    } else if (t < 896 + 1024 + 256) { t -= 1920; const int nt = t >> 2, kt = t & 3; const int kb = nt >> 4;
        const float* src = P.inp(I_WBR) + ((size_t)l * 4 + kb) * 256 * 1024; const float* ng = P.inp(I_SSDNG) + l * 256; const bool sc = (kb == 3);
        conv_tile(P.tid, tile, (bf16_t*)(ws + WS_WBR), 256, nt * 64, kt * 64, [=](int k, int n) { const float v = src[(size_t)k * 1024 + (n & 1023)]; return sc ? v * ng[k] : v; });
    } else { t -= 2176; const int nt = t >> 4, kt = t & 15; const float* src = P.inp(I_WO) + (size_t)l * D * D;
        conv_tile(P.tid, tile, (bf16_t*)(ws + WS_WO), D, nt * 64, kt * 64, [=](int k, int n) { return src[(size_t)k * D + n]; });
    }
}
__device__ __forceinline__ void conv_unit_ex(const Ptrs P, int l, int t, LAS float* tile) {
    unsigned char* ws = P.ws;
    const int e = t / 384; t -= e * 384;
    if (t < 256) { const int nt = t >> 4, kt = t & 15;
        const float* s1 = P.inp(I_WE1) + ((size_t)l * NE + e) * 1024 * 512; const float* s3 = P.inp(I_WE3) + ((size_t)l * NE + e) * 1024 * 512;
        conv_tile(P.tid, tile, (bf16_t*)(ws + WS_BIG + BIG_W13) + (size_t)e * 1024 * 1024, 1024, nt * 64, kt * 64, [=](int k, int n) {
            const int pn = n >> 8, bj = (n >> 7) & 1, wc = (n >> 5) & 3, nn = (n >> 4) & 1, fqe = n & 15; const int ch = 128 * pn + 64 * bj + 16 * wc + fqe;
            return (nn ? s3 : s1)[(size_t)k * 512 + ch]; });
    } else { t -= 256; const int nt = t >> 3, kt = t & 7; const float* src = P.inp(I_WE2) + ((size_t)l * NE + e) * 512 * 1024;
        conv_tile(P.tid, tile, (bf16_t*)(ws + WS_BIG + BIG_W2) + (size_t)e * 1024 * 512, 512, nt * 64, kt * 64, [=](int k, int n) { return src[(size_t)k * 1024 + n]; });
    }
}

struct RowV { f32x4 v[4]; };
__device__ __forceinline__ void row_load(RowV& r, const float* p, int lane) {
#pragma unroll
    for (int i = 0; i < 4; ++i) r.v[i] = *(const f32x4*)(p + i * 256 + lane * 4);
}
__device__ __forceinline__ void row_store(const RowV& r, float* p, int lane) {
#pragma unroll
    for (int i = 0; i < 4; ++i) *(f32x4*)(p + i * 256 + lane * 4) = r.v[i];
}
__device__ __forceinline__ void row_layernorm(RowV& r, const float* g, const float* b, int lane) {
    float s = 0.f;
#pragma unroll
    for (int i = 0; i < 4; ++i) s += r.v[i][0] + r.v[i][1] + r.v[i][2] + r.v[i][3];
    const float mu = wave_sum(s) * (1.0f / 1024.0f);
    float q = 0.f;
#pragma unroll
    for (int i = 0; i < 4; ++i) { const f32x4 d = r.v[i] - mu; q += d[0] * d[0] + d[1] * d[1] + d[2] * d[2] + d[3] * d[3]; }
    const float rstd = rsqrtf(wave_sum(q) * (1.0f / 1024.0f) + LN_EPS);
#pragma unroll
    for (int i = 0; i < 4; ++i) { const f32x4 gg = *(const f32x4*)(g + i * 256 + lane * 4), bb = *(const f32x4*)(b + i * 256 + lane * 4); r.v[i] = (r.v[i] - mu) * rstd * gg + bb; }
}
__device__ __forceinline__ void row_modulate(const RowV& r, RowV& h, const float* sh, const float* sc, int lane) {
#pragma unroll
    for (int i = 0; i < 4; ++i) { const f32x4 a = *(const f32x4*)(sc + i * 256 + lane * 4), b = *(const f32x4*)(sh + i * 256 + lane * 4); h.v[i] = r.v[i] * (a + 1.0f) + b; }
}
__device__ __forceinline__ void row_store_bf16(const RowV& h, bf16_t* p, int lane) {
#pragma unroll
    for (int i = 0; i < 4; ++i) { u32x2 w; w.x = pack2(h.v[i][0], h.v[i][1]); w.y = pack2(h.v[i][2], h.v[i][3]); *(u32x2*)(p + i * 256 + lane * 4) = w; }
}
__device__ __forceinline__ void row_dt(const RowV& h, const LAS float* wdt, float* dtout, int lane) {
    float a[8];
#pragma unroll
    for (int j = 0; j < 8; ++j) a[j] = 0.f;
#pragma unroll
    for (int i = 0; i < 4; ++i)
#pragma unroll
        for (int e = 0; e < 4; ++e) { const int k = i * 256 + lane * 4 + e; const float hv = h.v[i][e];
            const f32x4 w0 = *(const LAS f32x4*)(wdt + k * 8), w1 = *(const LAS f32x4*)(wdt + k * 8 + 4);
            a[0] += hv * w0[0]; a[1] += hv * w0[1]; a[2] += hv * w0[2]; a[3] += hv * w0[3]; a[4] += hv * w1[0]; a[5] += hv * w1[1]; a[6] += hv * w1[2]; a[7] += hv * w1[3]; }
#pragma unroll
    for (int j = 0; j < 8; ++j) a[j] = wave_sum(a[j]);
    if (lane == 0) { *(f32x4*)dtout = (f32x4){a[0], a[1], a[2], a[3]}; *(f32x4*)(dtout + 4) = (f32x4){a[4], a[5], a[6], a[7]}; }
}
__device__ __forceinline__ void load_wdt(const Ptrs P, int l, LAS float* wdt) {
    const float* src = P.inp(I_WIN) + (size_t)l * D * INC + UC;
    for (int i = P.tid; i < 1024 * 8; i += 512) wdt[i] = src[(size_t)(i >> 3) * INC + (i & 7)];
    __syncthreads();
}

__device__ __forceinline__ void phase_pa(const Ptrs P, LAS unsigned char* lds) {
    const int tid = P.tid, wid = tid >> 6, lane = tid & 63, G = P.G;
    const int NU_MOD = 2 * 96, NU_H2 = 8448 / 8, NU_LB = 1;
    const int NU = NU_MOD + NU_H2 + NU_LB + NCONV_NE;
    for (int u = P.bid; u < NU; u += G) {
        if (u < NU_MOD) {
            const int l = u / 96, cb = u % 96;
            LAS float* sc = (LAS float*)lds; LAS float* red = sc + 9 * 1024;
            for (int i = tid; i < 9 * 1024; i += 512) { const int r = i >> 10, k = i & 1023; const float v = r < 8 ? P.inp(I_C)[r * 1024 + k] : P.inp(I_CCTX)[k]; sc[i] = v / (1.0f + expf(-v)); }
            __syncthreads();
            const int col = cb * 64 + lane; const float* w = P.inp(I_WADA) + (size_t)l * D * 6144 + col;
            float acc[9];
#pragma unroll
            for (int r = 0; r < 9; ++r) acc[r] = 0.f;
            for (int k = wid * 128; k < wid * 128 + 128; ++k) { const float wv = w[(size_t)k * 6144];
#pragma unroll
                for (int r = 0; r < 9; ++r) acc[r] += sc[r * 1024 + k] * wv; }
#pragma unroll
            for (int r = 0; r < 9; ++r) red[(wid * 9 + r) * 64 + lane] = acc[r];
            __syncthreads();
            for (int i = tid; i < 9 * 64; i += 512) { const int r = i >> 6, c = i & 63; float s = P.inp(I_BADA)[(size_t)l * 6144 + cb * 64 + c];
#pragma unroll
                for (int w8 = 0; w8 < 8; ++w8) s += red[(w8 * 9 + r) * 64 + c];
                P.mod(l, r)[cb * 64 + c] = s; }
            __syncthreads();
        } else if (u < NU_MOD + NU_H2) {
            const int rho = (u - NU_MOD) * 8 + wid;
            const int l = (rho >= 4096 && rho < 8192) ? 1 : 0; const int L = rho < 8192 ? 4096 : 256; const int i = rho < 8192 ? (rho & 4095) : (rho - 8192);
            float featv = 0.f;
            if (lane == 0) featv = (float)((double)i / (double)(L - 1));
            else if (lane < 33) { const int j = (lane - 1) & 15; const double band = 1e-4 + (double)j * ((15.0 - 1e-4) / 15.0);
                const double ang = (2.0 * 3.14159265358979323846 / (double)L) * (double)i * band; featv = lane < 17 ? (float)cos(ang) : (float)(-sin(ang)); }
            float z1 = P.inp(I_HYB1)[l * 64 + lane];
            for (int m = 0; m < 33; ++m) z1 += __shfl(featv, m) * P.inp(I_HYW1)[((size_t)l * 33 + m) * 64 + lane];
            const float h1 = sinf(P.inp(I_HYF1)[l * 64 + lane] * z1);
            float z2 = P.inp(I_HYB2)[l * 64 + lane];
            for (int m = 0; m < 64; ++m) z2 += __shfl(h1, m) * P.inp(I_HYW2)[((size_t)l * 64 + m) * 64 + lane];
            ((float*)(P.ws + WS_H2TAB))[(size_t)rho * 64 + lane] = sinf(P.inp(I_HYF2)[l * 64 + lane] * z2);
        } else if (u < NU_MOD + NU_H2 + NU_LB) {
            for (int i = tid; i < 4096; i += 512) { const double a = -2.0 * 3.14159265358979323846 * (double)i / 8192.0; ((float*)(P.ws + WS_TW))[2 * i] = (float)cos(a); ((float*)(P.ws + WS_TW))[2 * i + 1] = (float)sin(a); }
            for (int i = tid; i < 1024; i += 512) { const int d = i >> 9, l = (i >> 8) & 1, c = i & 255;
                const float l0 = P.inp(I_HGLB)[d * 512 + c], l1 = P.inp(I_HGLB)[d * 512 + 256 + c];
                ((float*)(P.ws + WS_LB))[i] = l == 0 ? 0.0f : 1.0f / (1.0f + expf(l0 - l1)); }
        } else {
            conv_unit_ne(P, 0, u - (NU_MOD + NU_H2 + NU_LB), (LAS float*)lds);
        }
    }
}

__device__ __forceinline__ void emit_rows_init(const Ptrs P, LAS float* wdt);
__device__ __forceinline__ void phase_pb(const Ptrs P, LAS unsigned char* lds) {
    const int tid = P.tid, G = P.G;
    for (int u = P.bid; u < 132; u += G) {
        const int tab = u < 64 ? 0 : (u < 128 ? 1 : 2); const int ib = tab == 0 ? u : (tab == 1 ? u - 64 : u - 128);
        const int l = tab == 1 ? 1 : 0; const int L = tab == 2 ? 256 : 4096; const int rho0 = (tab == 0 ? 0 : (tab == 1 ? 4096 : 8192)) + ib * 64;
        LAS float* h2 = (LAS float*)lds;
        for (int i = tid; i < 64 * 64; i += 512) h2[i] = ((const float*)(P.ws + WS_H2TAB))[(size_t)rho0 * 64 + i];
        __syncthreads();
        const int o = tid, c = tid & 255, dir = tid >> 8;
        float w3[64];
#pragma unroll
        for (int j = 0; j < 64; ++j) w3[j] = P.inp(I_HYW3)[((size_t)l * 64 + j) * 512 + o];
        const float dec = fabsf(P.inp(I_HYDEC)[l * 256 + c]);
        float* filt = tab == 2 ? (float*)(P.ws + WS_FILTC) : (float*)(P.ws + WS_FILT) + (size_t)l * 8192 * 256;
        const int L2 = 2 * L; float part = 0.f;
        for (int r = 0; r < 64; ++r) { const int i = ib * 64 + r; float s = 0.f;
#pragma unroll
            for (int j = 0; j < 64; ++j) s += h2[r * 64 + j] * w3[j];
            const float t = (float)i / (float)(L - 1); s *= expf(-t * dec);
            if (dir == 0) { filt[(size_t)i * 256 + c] = s; part += fabsf(s); }
            else if (i == 0) filt[(size_t)L * 256 + c] = 0.f;
            else { filt[(size_t)(L2 - i) * 256 + c] = s; part += fabsf(s); } }
        ((float*)(P.ws + WS_PART))[((size_t)tab * 64 + ib) * 512 + o] = part;
        __syncthreads();
    }
    emit_rows_init(P, (LAS float*)(lds + 32768));
}
__device__ __forceinline__ float hy_norm(const Ptrs P, int tab, int c) {
    const float* part = (const float*)(P.ws + WS_PART) + (size_t)tab * 64 * 512; const int nb = tab == 2 ? 4 : 64; float s = 0.f;
    for (int b = 0; b < nb; ++b) s += part[b * 512 + c] + part[b * 512 + 256 + c];
    return s;
}

__device__ __forceinline__ void emit_rows_init(const Ptrs P, LAS float* wdt) {
    const int tid = P.tid, wid = tid >> 6, lane = tid & 63, G = P.G;
    load_wdt(P, 0, wdt);
    for (int u = P.bid; u < T / 8; u += G) {
        const int row = u * 8 + wid; RowV r;
        if (row < NLAT) { row_load(r, P.inp(I_X) + (size_t)row * D, lane);
            const int t = row & 4095; const float prow = (float)(t >> 6), pcol = (float)(t & 63);
#pragma unroll
            for (int i = 0; i < 4; ++i)
#pragma unroll
                for (int e = 0; e < 4; ++e) { const int idx = i * 256 + lane * 4 + e; const int f = idx & 511, ii = f & 255; const float pos = (idx >> 9) ? pcol : prow;
                    const float om = expf(-9.210340371976184f * (float)ii * (1.0f / 256.0f)); const float a = pos * om; r.v[i][e] += (f < 256) ? sinf(a) : cosf(a); }
        } else row_load(r, P.inp(I_CTX) + (size_t)(row - NLAT) * D, lane);
        row_store(r, P.latrow(row), lane);
        const float* m = P.mod(0, row_modidx(row)); RowV h; row_modulate(r, h, m, m + 1024, lane);
        row_store_bf16(h, (bf16_t*)(P.ws + WS_HBUF) + (size_t)row * D, lane);
        row_dt(h, wdt, (float*)(P.ws + WS_DT) + (size_t)row * 8, lane);
    }
}

__device__ __forceinline__ void phase_g1(const Ptrs P, LAS unsigned char* lds) {
    pg8::Gemm g{(const bf16_t*)(P.ws + WS_HBUF), (const bf16_t*)(P.ws + WS_WIN), D};
    EpiBf16Plain E{(bf16_t*)(P.ws + WS_BIG + BIG_U), UC, 0xffff};
    SchedG1 S{P.G, P.bid};
    pg8::gemm_phase<EpiBf16Plain, SchedG1, false>(P.tid, lds, g, S, E);
}

constexpr int NCHK = 34;
__device__ __forceinline__ int chunk_row0(int b, int pc) { return pc < 2 ? NLAT + b * CTXL + pc * 128 : b * SEQ + (pc - 2) * 128; }
__device__ __forceinline__ int chunk_at(int dir, int q) { return dir == 0 ? q : (q < 2 ? 1 - q : 35 - q); }
__device__ __forceinline__ int sidx(int kind, int b, int h, int dir, int pc) { return (((kind * 8 + b) * 4 + h) * 2 + dir) * NCHK + pc; }
__device__ __forceinline__ bf16x8 pack8(const float (&v)[8]) { u32x4 w; w.x = pack2(v[0], v[1]); w.y = pack2(v[2], v[3]); w.z = pack2(v[4], v[5]); w.w = pack2(v[6], v[7]); return __builtin_bit_cast(bf16x8, w); }
__device__ __forceinline__ float zero_f() { float z = 0.f; asm volatile("" : "+v"(z)); return z; }
__device__ __forceinline__ float softplusf_(float x) { return x > 20.f ? x : log1pf(__expf(x)); }
__device__ __forceinline__ float wave_incl_scan(float v, int lane) {
#pragma unroll
    for (int d = 1; d < 64; d <<= 1) { const float t = __shfl_up(v, d); if (lane >= d) v += t; }
    return v;
}

__device__ __forceinline__ void conv3_silu8(const bf16_t* U, int row, int col0, const float* w, int ncol, int wcol0, const float* bias, float (&out)[8]) {
    const bool hp = row_has_prev(row), hn = row_has_next(row);
    const bf16x8 c = *(const bf16x8*)(U + (size_t)row * UC + col0);
    bf16x8 p = c, n = c; if (hp) p = *(const bf16x8*)(U + (size_t)(row - 1) * UC + col0); if (hn) n = *(const bf16x8*)(U + (size_t)(row + 1) * UC + col0);
    const float mp = hp ? 1.0f : 0.0f, mn = hn ? 1.0f : 0.0f;
#pragma unroll
    for (int h4 = 0; h4 < 2; ++h4) { const f32x4 w0 = *(const f32x4*)(w + wcol0 + 4 * h4), w1 = *(const f32x4*)(w + ncol + wcol0 + 4 * h4), w2 = *(const f32x4*)(w + 2 * ncol + wcol0 + 4 * h4), bb = *(const f32x4*)(bias + wcol0 + 4 * h4);
#pragma unroll
        for (int e = 0; e < 4; ++e) { const int i = 4 * h4 + e; const float v = bf2f((bf16_t)c[i]) * w1[e] + mp * bf2f((bf16_t)p[i]) * w0[e] + mn * bf2f((bf16_t)n[i]) * w2[e] + bb[e]; out[i] = siluf_(v); } }
}

__device__ __forceinline__ void hgrn_pass1(const Ptrs P, int l, int unit, LAS unsigned char* lds) {
    const int tid = P.tid, lane = tid & 63, wid = tid >> 6, fr = lane & 15, fq = lane >> 4;
    const int pc = unit % NCHK; int r_ = unit / NCHK; const int dir = r_ & 1; r_ >>= 1; const int h = r_ & 3; const int b = r_ >> 2;
    const int row0 = chunk_row0(b, pc); const int si = sidx(0, b, h, dir, pc);
    const bf16_t* U = (const bf16_t*)(P.ws + WS_BIG + BIG_U);
    LAS bf16_t* KT = (LAS bf16_t*)lds; LAS bf16_t* VT = KT + 64 * 136; LAS float* segtot = (LAS float*)(VT + 64 * 136);
    const int ch = lane, seg = wid;
    const float lbv = ((const float*)(P.ws + WS_LB))[(dir * 2 + l) * 256 + h * 64 + ch];
    float c[16], kk[16]; unsigned vb[16]; float run = 0.f;
#pragma unroll
    for (int j = 0; j < 16; ++j) { const int tau = 16 * seg + j; const int p = dir ? 127 - tau : tau; const bf16_t* ur = U + (size_t)(row0 + p) * UC;
        const float f = lbv + (1.0f - lbv) * sigmoidf_(bf2f(ur[1792 + dir * 256 + h * 64 + ch])); run += __logf(f); c[j] = run; kk[j] = 1.0f - f; vb[j] = ur[2304 + h * 64 + ch]; }
    segtot[seg * 64 + ch] = run; __syncthreads();
    float off = 0.f, tot = 0.f;
#pragma unroll
    for (int s = 0; s < 8; ++s) { const float v = segtot[s * 64 + ch]; tot += v; off += (s < seg) ? v : 0.f; }
    { u32x4 w0, w1, v0, v1;
      w0.x = pack2(kk[0] * __expf(tot - off - c[0]), kk[1] * __expf(tot - off - c[1])); w0.y = pack2(kk[2] * __expf(tot - off - c[2]), kk[3] * __expf(tot - off - c[3]));
      w0.z = pack2(kk[4] * __expf(tot - off - c[4]), kk[5] * __expf(tot - off - c[5])); w0.w = pack2(kk[6] * __expf(tot - off - c[6]), kk[7] * __expf(tot - off - c[7]));
      w1.x = pack2(kk[8] * __expf(tot - off - c[8]), kk[9] * __expf(tot - off - c[9])); w1.y = pack2(kk[10] * __expf(tot - off - c[10]), kk[11] * __expf(tot - off - c[11]));
      w1.z = pack2(kk[12] * __expf(tot - off - c[12]), kk[13] * __expf(tot - off - c[13])); w1.w = pack2(kk[14] * __expf(tot - off - c[14]), kk[15] * __expf(tot - off - c[15]));
      v0.x = vb[0] | (vb[1] << 16); v0.y = vb[2] | (vb[3] << 16); v0.z = vb[4] | (vb[5] << 16); v0.w = vb[6] | (vb[7] << 16);
      v1.x = vb[8] | (vb[9] << 16); v1.y = vb[10] | (vb[11] << 16); v1.z = vb[12] | (vb[13] << 16); v1.w = vb[14] | (vb[15] << 16);
      *(LAS u32x4*)(KT + ch * 136 + 16 * seg) = w0; *(LAS u32x4*)(KT + ch * 136 + 16 * seg + 8) = w1;
      *(LAS u32x4*)(VT + ch * 136 + 16 * seg) = v0; *(LAS u32x4*)(VT + ch * 136 + 16 * seg + 8) = v1; }
    if (seg == 0) ((float*)(P.ws + WS_DEC))[(size_t)si * 64 + ch] = __expf(tot);
    __syncthreads();
    const int mt = wid >> 1, nt0 = (wid & 1) * 2;
    f32x4 acc[2]; acc[0] = (f32x4){0.f, 0.f, 0.f, 0.f}; acc[1] = acc[0];
#pragma unroll
    for (int ks = 0; ks < 4; ++ks) { const bf16x8 a = *(const LAS bf16x8*)(KT + (16 * mt + fr) * 136 + 32 * ks + 8 * fq);
#pragma unroll
        for (int n = 0; n < 2; ++n) { const bf16x8 bb = *(const LAS bf16x8*)(VT + (16 * (nt0 + n) + fr) * 136 + 32 * ks + 8 * fq); acc[n] = __builtin_amdgcn_mfma_f32_16x16x32_bf16(a, bb, acc[n], 0, 0, 0); } }
    float* S = (float*)(P.ws + WS_BIG + BIG_STATE) + (size_t)si * 4096;
#pragma unroll
    for (int n = 0; n < 2; ++n)
#pragma unroll
        for (int r = 0; r < 4; ++r) S[(16 * mt + 4 * fq + r) * 64 + 16 * (nt0 + n) + fr] = acc[n][r];
    __syncthreads();
}

__device__ __forceinline__ void ssd_dt_cum(const Ptrs P, int l, int row0, int dir, int h, int wid, int lane, LAS float* cum, LAS float* dtv) {
    if (wid == 0) {
        const float Aneg = -__expf(P.inp(I_SSDALOG)[(l * 2 + dir) * 4 + h]); const float dtb = P.inp(I_SSDDTB)[(l * 2 + dir) * 4 + h]; const float* DT = (const float*)(P.ws + WS_DT);
        const int t0 = 2 * lane, p0 = dir ? 127 - t0 : t0, p1 = dir ? 126 - t0 : t0 + 1;
        const float d0 = softplusf_(DT[(size_t)(row0 + p0) * 8 + dir * 4 + h] + dtb), d1 = softplusf_(DT[(size_t)(row0 + p1) * 8 + dir * 4 + h] + dtb);
        const float a0 = Aneg * d0, a1 = Aneg * d1; const float inc = wave_incl_scan(a0 + a1, lane);
        cum[t0] = inc - a1; cum[t0 + 1] = inc; dtv[t0] = d0; dtv[t0 + 1] = d1;
    }
}

__device__ __forceinline__ void ssd_pass1(const Ptrs P, int l, int unit, LAS unsigned char* lds) {
    const int tid = P.tid, lane = tid & 63, wid = tid >> 6, fr = lane & 15, fq = lane >> 4;
    const int pc = unit % NCHK; int r_ = unit / NCHK; const int dir = r_ & 1; r_ >>= 1; const int h = r_ & 3; const int b = r_ >> 2; const int g = h >> 1;
    const int row0 = chunk_row0(b, pc); const int si = sidx(1, b, h, dir, pc);
    const bf16_t* U = (const bf16_t*)(P.ws + WS_BIG + BIG_U);
    const float* scw = P.inp(I_SSDCW) + (size_t)l * 3 * 512; const float* scb = P.inp(I_SSDCB) + l * 512;
    LAS bf16_t* XT = (LAS bf16_t*)lds; LAS bf16_t* BT = XT + 64 * 136; LAS float* cum = (LAS float*)(BT + 64 * 136); LAS float* dtv = cum + 128;
    ssd_dt_cum(P, l, row0, dir, h, wid, lane, cum, dtv);
    __syncthreads();
    const float tot = cum[127]; const int ch = lane, seg = wid;
    { float xv[16], bv[16]; const float xb = scb[h * 64 + ch], bb_ = scb[256 + g * 64 + ch];
#pragma unroll
      for (int j = 0; j < 16; ++j) { const int tau = 16 * seg + j; const int row = row0 + (dir ? 127 - tau : tau);
          xv[j] = siluf_(conv3_u(U, row, 3072 + h * 64 + ch, scw, 512, h * 64 + ch) + xb) * dtv[tau] * __expf(tot - cum[tau]);
          bv[j] = siluf_(conv3_u(U, row, 3072 + 256 + g * 64 + ch, scw, 512, 256 + g * 64 + ch) + bb_); }
      u32x4 w0, w1, v0, v1;
      w0.x = pack2(xv[0], xv[1]); w0.y = pack2(xv[2], xv[3]); w0.z = pack2(xv[4], xv[5]); w0.w = pack2(xv[6], xv[7]); w1.x = pack2(xv[8], xv[9]); w1.y = pack2(xv[10], xv[11]); w1.z = pack2(xv[12], xv[13]); w1.w = pack2(xv[14], xv[15]);
      v0.x = pack2(bv[0], bv[1]); v0.y = pack2(bv[2], bv[3]); v0.z = pack2(bv[4], bv[5]); v0.w = pack2(bv[6], bv[7]); v1.x = pack2(bv[8], bv[9]); v1.y = pack2(bv[10], bv[11]); v1.z = pack2(bv[12], bv[13]); v1.w = pack2(bv[14], bv[15]);
      *(LAS u32x4*)(XT + ch * 136 + 16 * seg) = w0; *(LAS u32x4*)(XT + ch * 136 + 16 * seg + 8) = w1;
      *(LAS u32x4*)(BT + ch * 136 + 16 * seg) = v0; *(LAS u32x4*)(BT + ch * 136 + 16 * seg + 8) = v1; }
    if (tid == 0) ((float*)(P.ws + WS_DEC))[(size_t)si * 64] = __expf(tot);
    __syncthreads();
    const int mt = wid >> 1, nt0 = (wid & 1) * 2;
    f32x4 acc[2]; acc[0] = (f32x4){0.f, 0.f, 0.f, 0.f}; acc[1] = acc[0];
#pragma unroll
    for (int ks = 0; ks < 4; ++ks) { const bf16x8 a = *(const LAS bf16x8*)(XT + (16 * mt + fr) * 136 + 32 * ks + 8 * fq);
#pragma unroll
        for (int n = 0; n < 2; ++n) { const bf16x8 bb = *(const LAS bf16x8*)(BT + (16 * (nt0 + n) + fr) * 136 + 32 * ks + 8 * fq); acc[n] = __builtin_amdgcn_mfma_f32_16x16x32_bf16(a, bb, acc[n], 0, 0, 0); } }
    float* S = (float*)(P.ws + WS_BIG + BIG_STATE) + (size_t)si * 4096;
#pragma unroll
    for (int n = 0; n < 2; ++n)
#pragma unroll
        for (int r = 0; r < 4; ++r) S[(16 * mt + 4 * fq + r) * 64 + 16 * (nt0 + n) + fr] = acc[n][r];
    __syncthreads();
}

__device__ __forceinline__ void scan_pass2(const Ptrs P, int unit) {
    const int seq = unit >> 1, half = unit & 1; const int kind = seq >> 6, b = (seq >> 3) & 7, h = (seq >> 1) & 3, dir = seq & 1;
    const int e0 = half * 2048 + P.tid * 4; const int base = sidx(kind, b, h, dir, 0);
    float* ST = (float*)(P.ws + WS_BIG + BIG_STATE); const float* DEC = (const float*)(P.ws + WS_DEC);
    const float zf = zero_f(); f32x4 run = (f32x4){zf, zf, zf, zf};
    for (int q = 0; q < NCHK; ++q) { const int pc = chunk_at(dir, q); float* S = ST + (size_t)(base + pc) * 4096 + e0;
        const f32x4 loc = *(const f32x4*)S; const float d = DEC[(size_t)(base + pc) * 64 + (kind == 0 ? (e0 >> 6) : 0)];
        *(f32x4*)S = run; run = run * d + loc; }
}

__device__ __forceinline__ void hgrn_pass3(const Ptrs P, int l, int unit, LAS unsigned char* lds) {
    const int tid = P.tid, lane = tid & 63, wid = tid >> 6, fr = lane & 15, fq = lane >> 4;
    const int pc = unit % NCHK; const int r_ = unit / NCHK; const int h = r_ & 3; const int b = r_ >> 2;
    const int row0 = chunk_row0(b, pc);
    const bf16_t* U = (const bf16_t*)(P.ws + WS_BIG + BIG_U);
    LAS bf16_t* QH = (LAS bf16_t*)lds; LAS bf16_t* KT2 = QH + 128 * 72; LAS bf16_t* VT = KT2 + 128 * 72; LAS bf16_t* ST = VT + 64 * 136;
    LAS float* EE = (LAS float*)(ST + 64 * 72); LAS float* ET = EE + 512; LAS bf16_t* PW = (LAS bf16_t*)(ET + 512); LAS float* BH = (LAS float*)PW; LAS float* OUT = (LAS float*)(PW + 8 * 16 * 136);
    for (int dir = 0; dir < 2; ++dir) {
        {
            const int ch = lane, seg = wid; const float lbv = ((const float*)(P.ws + WS_LB))[(dir * 2 + l) * 256 + h * 64 + ch]; float run = 0.f; unsigned vb[16];
#pragma unroll
            for (int j = 0; j < 16; ++j) { const int tau = 16 * seg + j; const int p = dir ? 127 - tau : tau; const bf16_t* ur = U + (size_t)(row0 + p) * UC;
                const float f = lbv + (1.0f - lbv) * sigmoidf_(bf2f(ur[1792 + dir * 256 + h * 64 + ch])); run += __logf(f); BH[tau * 64 + ch] = run; vb[j] = ur[2304 + h * 64 + ch]; }
            ET[seg * 64 + ch] = run;
            u32x4 v0, v1; v0.x = vb[0] | (vb[1] << 16); v0.y = vb[2] | (vb[3] << 16); v0.z = vb[4] | (vb[5] << 16); v0.w = vb[6] | (vb[7] << 16);
            v1.x = vb[8] | (vb[9] << 16); v1.y = vb[10] | (vb[11] << 16); v1.z = vb[12] | (vb[13] << 16); v1.w = vb[14] | (vb[15] << 16);
            *(LAS u32x4*)(VT + ch * 136 + 16 * seg) = v0; *(LAS u32x4*)(VT + ch * 136 + 16 * seg + 8) = v1;
            const float* S = (const float*)(P.ws + WS_BIG + BIG_STATE) + (size_t)sidx(0, b, h, dir, pc) * 4096;
            for (int idx = tid; idx < 4096; idx += 512) ST[(idx & 63) * 72 + (idx >> 6)] = f2bf(S[idx]);
        }
        __syncthreads();
        if (tid < 64) { float e = 0.f;
#pragma unroll
            for (int i = 0; i < 8; ++i) { e += ET[i * 64 + tid]; EE[i * 64 + tid] = e; } }
        {
            const int tau = tid >> 2, qd = tid & 3, sb = tau >> 4; const int p = dir ? 127 - tau : tau; const bf16_t* ur = U + (size_t)(row0 + p) * UC + 1536 + h * 64 + 16 * qd;
#pragma unroll 1
            for (int hf = 0; hf < 2; ++hf) { const bf16x8 q8 = *(const bf16x8*)(ur + 8 * hf); float qh[8], kt[8];
#pragma unroll
                for (int e4 = 0; e4 < 2; ++e4) { const int c0 = 16 * qd + 8 * hf + 4 * e4; const f32x4 bh = *(const LAS f32x4*)(BH + tau * 64 + c0);
                    f32x4 bp = (f32x4){0.f, 0.f, 0.f, 0.f}; if (tau & 15) bp = *(const LAS f32x4*)(BH + (tau - 1) * 64 + c0);
                    const f32x4 et = *(const LAS f32x4*)(ET + sb * 64 + c0);
#pragma unroll
                    for (int e = 0; e < 4; ++e) { const int ee = 4 * e4 + e; const float qv = bf2f((bf16_t)q8[ee]);
                        qh[ee] = qv * 0.125f * __expf(bh[e]); kt[ee] = (1.0f - __expf(bh[e] - bp[e])) * __expf(et[e] - bh[e]); } }
                *(LAS bf16x8*)(QH + tau * 72 + 16 * qd + 8 * hf) = pack8(qh); *(LAS bf16x8*)(KT2 + tau * 72 + 16 * qd + 8 * hf) = pack8(kt); }
        }
        __syncthreads();
        {
            const int i = wid; LAS bf16_t* pw = PW + wid * 16 * 136;
            bf16x8 qf[2]; float em1[2][8];
#pragma unroll
            for (int ks = 0; ks < 2; ++ks) { qf[ks] = *(const LAS bf16x8*)(QH + (16 * i + fr) * 72 + 32 * ks + 8 * fq);
#pragma unroll
                for (int e = 0; e < 8; ++e) em1[ks][e] = (i > 0) ? EE[(i - 1) * 64 + 32 * ks + 8 * fq + e] : 0.f; }
            for (int j = 0; j <= i; ++j) {
                f32x4 d = (f32x4){0.f, 0.f, 0.f, 0.f};
#pragma unroll
                for (int ks = 0; ks < 2; ++ks) { float a8[8];
#pragma unroll
                    for (int e = 0; e < 8; ++e) a8[e] = bf2f((bf16_t)qf[ks][e]) * __expf(em1[ks][e] - EE[j * 64 + 32 * ks + 8 * fq + e]);
                    const bf16x8 kf = *(const LAS bf16x8*)(KT2 + (16 * j + fr) * 72 + 32 * ks + 8 * fq);
                    d = __builtin_amdgcn_mfma_f32_16x16x32_bf16(kf, pack8(a8), d, 0, 0, 0); }
                if (j == i) {
#pragma unroll
                    for (int r = 0; r < 4; ++r) d[r] = (4 * fq + r <= fr) ? d[r] : 0.f; }
                u32x2 w; w.x = pack2(d[0], d[1]); w.y = pack2(d[2], d[3]); *(LAS u32x2*)(pw + fr * 136 + 16 * j + 4 * fq) = w;
            }
            if ((i & 1) == 0) { u32x2 z; z.x = __float_as_uint(zero_f()); z.y = z.x; *(LAS u32x2*)(pw + fr * 136 + 16 * (i + 1) + 4 * fq) = z; }
            f32x4 o[4];
#pragma unroll
            for (int nt = 0; nt < 4; ++nt) o[nt] = (f32x4){0.f, 0.f, 0.f, 0.f};
            const int nks = (i >> 1) + 1;
            for (int ks = 0; ks < nks; ++ks) { const bf16x8 pa = *(const LAS bf16x8*)(pw + fr * 136 + 32 * ks + 8 * fq);
#pragma unroll
                for (int nt = 0; nt < 4; ++nt) { const bf16x8 vf = *(const LAS bf16x8*)(VT + (16 * nt + fr) * 136 + 32 * ks + 8 * fq); o[nt] = __builtin_amdgcn_mfma_f32_16x16x32_bf16(pa, vf, o[nt], 0, 0, 0); } }
#pragma unroll
            for (int ks = 0; ks < 2; ++ks) { float a8[8];
#pragma unroll
                for (int e = 0; e < 8; ++e) a8[e] = bf2f((bf16_t)qf[ks][e]) * __expf(em1[ks][e]);
                const bf16x8 qa = pack8(a8);
#pragma unroll
                for (int nt = 0; nt < 4; ++nt) { const bf16x8 sf = *(const LAS bf16x8*)(ST + (16 * nt + fr) * 72 + 32 * ks + 8 * fq); o[nt] = __builtin_amdgcn_mfma_f32_16x16x32_bf16(qa, sf, o[nt], 0, 0, 0); } }
#pragma unroll
            for (int nt = 0; nt < 4; ++nt)
#pragma unroll
                for (int r = 0; r < 4; ++r) { const int tau = 16 * i + 4 * fq + r; const int pos = dir ? 127 - tau : tau; LAS float* op = OUT + pos * 64 + 16 * nt + fr; if (dir == 0) *op = o[nt][r]; else *op += o[nt][r]; }
        }
        __syncthreads();
    }
    {
        const float ng = P.inp(I_HGNG)[l * 64 + lane]; bf16_t* BR2 = (bf16_t*)(P.ws + WS_BR) + (size_t)2 * T * 256;
        for (int rr = 0; rr < 16; ++rr) { const int pos = 16 * wid + rr; const int row = row0 + pos; const float o = OUT[pos * 64 + lane]; const float ms = wave_sum(o * o) * (1.0f / 64.0f);
            const float gt = bf2f(U[(size_t)row * UC + 2560 + h * 64 + lane]);
            BR2[(size_t)row * 256 + h * 64 + lane] = f2bf(o * rsqrtf(ms + RMS_EPS) * ng * siluf_(gt)); }
    }
    __syncthreads();
}

__device__ __forceinline__ void ssd_pass3(const Ptrs P, int l, int unit, LAS unsigned char* lds) {
    const int tid = P.tid, lane = tid & 63, wid = tid >> 6, fr = lane & 15, fq = lane >> 4;
    const int pc = unit % NCHK; const int r_ = unit / NCHK; const int h = r_ & 3; const int b = r_ >> 2; const int g = h >> 1;
    const int row0 = chunk_row0(b, pc);
    const bf16_t* U = (const bf16_t*)(P.ws + WS_BIG + BIG_U);
    const float* scw = P.inp(I_SSDCW) + (size_t)l * 3 * 512; const float* scb = P.inp(I_SSDCB) + l * 512;
    LAS bf16_t* CM = (LAS bf16_t*)lds; LAS bf16_t* BM = CM + 128 * 72; LAS bf16_t* XT = BM + 128 * 72; LAS bf16_t* ST = XT + 64 * 136;
    LAS float* cum = (LAS float*)(ST + 64 * 72); LAS float* dtv = cum + 128; LAS bf16_t* PW = (LAS bf16_t*)(dtv + 128); LAS float* OUT = (LAS float*)(PW + 8 * 16 * 136);
    for (int dir = 0; dir < 2; ++dir) {
        ssd_dt_cum(P, l, row0, dir, h, wid, lane, cum, dtv);
        {
            const int tau = tid >> 2, qd = tid & 3; const int row = row0 + (dir ? 127 - tau : tau);
#pragma unroll 1
            for (int pcs = 0; pcs < 4; ++pcs) { const int isb = pcs >> 1, hf = pcs & 1; const int cc = (isb ? 256 : 384) + g * 64 + 16 * qd + 8 * hf; float t8[8];
                conv3_silu8(U, row, 3072 + cc, scw, 512, cc, scb, t8);
                *(LAS bf16x8*)((isb ? BM : CM) + tau * 72 + 16 * qd + 8 * hf) = pack8(t8); }
        }
        {
            const int ch = lane, seg = wid; float xv[16]; const float xb = scb[h * 64 + ch];
#pragma unroll
            for (int j = 0; j < 16; ++j) { const int tau = 16 * seg + j; const int row = row0 + (dir ? 127 - tau : tau); xv[j] = siluf_(conv3_u(U, row, 3072 + h * 64 + ch, scw, 512, h * 64 + ch) + xb); }
            float t8[8];
#pragma unroll
            for (int e = 0; e < 8; ++e) t8[e] = xv[e];
            *(LAS bf16x8*)(XT + ch * 136 + 16 * seg) = pack8(t8);
#pragma unroll
            for (int e = 0; e < 8; ++e) t8[e] = xv[8 + e];
            *(LAS bf16x8*)(XT + ch * 136 + 16 * seg + 8) = pack8(t8);
            const float* S = (const float*)(P.ws + WS_BIG + BIG_STATE) + (size_t)sidx(1, b, h, dir, pc) * 4096;
            for (int idx = tid; idx < 4096; idx += 512) ST[(idx >> 6) * 72 + (idx & 63)] = f2bf(S[idx]);
        }
        __syncthreads();
        {
            const int i = wid; LAS bf16_t* pw = PW + wid * 16 * 136;
            bf16x8 cf[2];
#pragma unroll
            for (int ks = 0; ks < 2; ++ks) cf[ks] = *(const LAS bf16x8*)(CM + (16 * i + fr) * 72 + 32 * ks + 8 * fq);
            const float cum_t = cum[16 * i + fr];
            for (int j = 0; j <= i; ++j) {
                f32x4 d = (f32x4){0.f, 0.f, 0.f, 0.f};
#pragma unroll
                for (int ks = 0; ks < 2; ++ks) { const bf16x8 bf_ = *(const LAS bf16x8*)(BM + (16 * j + fr) * 72 + 32 * ks + 8 * fq); d = __builtin_amdgcn_mfma_f32_16x16x32_bf16(bf_, cf[ks], d, 0, 0, 0); }
                const f32x4 cs = *(const LAS f32x4*)(cum + 16 * j + 4 * fq), ds = *(const LAS f32x4*)(dtv + 16 * j + 4 * fq);
#pragma unroll
                for (int r = 0; r < 4; ++r) { const bool keep = (j < i) || (4 * fq + r <= fr); d[r] = keep ? d[r] * __expf(cum_t - cs[r]) * ds[r] : 0.f; }
                u32x2 w; w.x = pack2(d[0], d[1]); w.y = pack2(d[2], d[3]); *(LAS u32x2*)(pw + fr * 136 + 16 * j + 4 * fq) = w;
            }
            if ((i & 1) == 0) { u32x2 z; z.x = __float_as_uint(zero_f()); z.y = z.x; *(LAS u32x2*)(pw + fr * 136 + 16 * (i + 1) + 4 * fq) = z; }
            f32x4 o[4], o2[4];
#pragma unroll
            for (int nt = 0; nt < 4; ++nt) { o[nt] = (f32x4){0.f, 0.f, 0.f, 0.f}; o2[nt] = o[nt]; }
            const int nks = (i >> 1) + 1;
            for (int ks = 0; ks < nks; ++ks) { const bf16x8 pa = *(const LAS bf16x8*)(pw + fr * 136 + 32 * ks + 8 * fq);
#pragma unroll
                for (int nt = 0; nt < 4; ++nt) { const bf16x8 xf = *(const LAS bf16x8*)(XT + (16 * nt + fr) * 136 + 32 * ks + 8 * fq); o[nt] = __builtin_amdgcn_mfma_f32_16x16x32_bf16(pa, xf, o[nt], 0, 0, 0); } }
#pragma unroll
            for (int ks = 0; ks < 2; ++ks)
#pragma unroll
                for (int nt = 0; nt < 4; ++nt) { const bf16x8 sf = *(const LAS bf16x8*)(ST + (16 * nt + fr) * 72 + 32 * ks + 8 * fq); o2[nt] = __builtin_amdgcn_mfma_f32_16x16x32_bf16(cf[ks], sf, o2[nt], 0, 0, 0); }
            const f32x4 ct = *(const LAS f32x4*)(cum + 16 * i + 4 * fq);
#pragma unroll
            for (int nt = 0; nt < 4; ++nt)
#pragma unroll
                for (int r = 0; r < 4; ++r) { const int tau = 16 * i + 4 * fq + r; const int pos = dir ? 127 - tau : tau; const float v = o[nt][r] + __expf(ct[r]) * o2[nt][r];
                    LAS float* op = OUT + pos * 64 + 16 * nt + fr; if (dir == 0) *op = v; else *op += v; }
        }
        __syncthreads();
    }
    {
        const float Dh = P.inp(I_SSDD)[l * 4 + h]; const float xb = scb[h * 64 + lane]; bf16_t* BR3 = (bf16_t*)(P.ws + WS_BR) + (size_t)3 * T * 256; float* SSQ = (float*)(P.ws + WS_SSQ);
        for (int rr = 0; rr < 16; ++rr) { const int pos = 16 * wid + rr; const int row = row0 + pos; const int c = h * 64 + lane;
            const float xs = siluf_(conv3_u(U, row, 3072 + c, scw, 512, c) + xb); const float y = OUT[pos * 64 + lane] + xs * Dh; const float z = bf2f(U[(size_t)row * UC + 2816 + c]);
            const float vv = y * siluf_(z); const float q = wave_sum(vv * vv); if (lane == 0) SSQ[(size_t)row * 4 + h] = q;
            BR3[(size_t)row * 256 + c] = f2bf(vv); }
    }
    __syncthreads();
}

typedef float f32x2 __attribute__((ext_vector_type(2)));
__device__ __forceinline__ f32x2 cmul(f32x2 a, f32x2 b) { return (f32x2){a.x * b.x - a.y * b.y, a.x * b.y + a.y * b.x}; }
__device__ __forceinline__ f32x2 cmulc(f32x2 a, f32x2 b) { return (f32x2){a.x * b.x + a.y * b.y, a.y * b.x - a.x * b.y}; }
__device__ __forceinline__ int fphys(int i) { return i + (i >> 4); }
template <int LO, int NST, bool INV>
__device__ __forceinline__ void fft_pass(LAS f32x2* X, const LAS f32x2* TW, int tid) {
    const int low = tid & ((1 << LO) - 1), high = tid >> LO; const int base = low | (high << (LO + 4));
    f32x2 x[16];
#pragma unroll
    for (int j = 0; j < 16; ++j) { const int i = base | (j << LO); x[j] = X[fphys(i)]; }
#pragma unroll
    for (int mm = 0; mm < NST; ++mm) { const int m = INV ? mm : NST - 1 - mm; const int s = LO + m;
#pragma unroll
        for (int j = 0; j < 16; ++j) { if (j & (1 << m)) continue; const int j2 = j | (1 << m);
            const int k = ((j & ((1 << m) - 1)) << LO) | low; const f32x2 tw = TW[k << (12 - s)];
            const f32x2 a = x[j], b = x[j2];
            if (!INV) { x[j] = a + b; x[j2] = cmul(a - b, tw); } else { const f32x2 bt = cmulc(b, tw); x[j] = a + bt; x[j2] = a - bt; } } }
#pragma unroll
    for (int j = 0; j < 16; ++j) { const int i = base | (j << LO); X[fphys(i)] = x[j]; }
}
__device__ __forceinline__ void fft_fwd(LAS f32x2* X, const LAS f32x2* TW, int tid) {
    fft_pass<9, 4, false>(X, TW, tid); __syncthreads(); fft_pass<5, 4, false>(X, TW, tid); __syncthreads(); fft_pass<2, 3, false>(X, TW, tid); __syncthreads(); fft_pass<0, 2, false>(X, TW, tid); __syncthreads();
}
__device__ __forceinline__ void fft_inv(LAS f32x2* X, const LAS f32x2* TW, int tid) {
    fft_pass<0, 2, true>(X, TW, tid); __syncthreads(); fft_pass<2, 3, true>(X, TW, tid); __syncthreads(); fft_pass<5, 4, true>(X, TW, tid); __syncthreads(); fft_pass<9, 4, true>(X, TW, tid); __syncthreads();
}
__device__ __forceinline__ void hyena_fft_unit(const Ptrs P, int l, int c, LAS unsigned char* lds) {
    const int tid = P.tid, lane = tid & 63;
    LAS f32x2* X = (LAS f32x2*)lds; LAS f32x2* TW = X + 8704;
    const f32x2* TWg = (const f32x2*)(P.ws + WS_TW);
    for (int i = tid; i < 4096; i += 512) TW[i] = TWg[i];
    float nrm; { const float* part = (const float*)(P.ws + WS_PART) + (size_t)l * 64 * 512; nrm = wave_sum(part[lane * 512 + c] + part[lane * 512 + 256 + c]); }
    const float inv = 1.0f / nrm; const float* filt = (const float*)(P.ws + WS_FILT) + (size_t)l * 8192 * 256 + c;
    for (int i = tid; i < 8192; i += 512) X[fphys(i)] = (f32x2){filt[(size_t)i * 256] * inv, 0.f};
    __syncthreads();
    fft_fwd(X, TW, tid);
    f32x2* Fg = (f32x2*)(P.ws + WS_BR) + (size_t)P.bid * 8192;
    for (int i = tid; i < 8192; i += 512) Fg[i] = X[fphys(i)];
    unsigned* WTt = (unsigned*)(P.ws + WS_BIG + BIG_WT); const float bias = P.inp(I_HYBIAS)[l * 256 + c];
    for (int p = 0; p < 4; ++p) {
        unsigned* wp = WTt + ((size_t)c * 4 + p) * 4096;
        __syncthreads();
        for (int i = tid; i < 8192; i += 512) { f32x2 v = (f32x2){0.f, 0.f}; if (i < 4096) { const unsigned w = wp[i]; v.x = __uint_as_float(w << 16); v.y = __uint_as_float(w & 0xffff0000u); } X[fphys(i)] = v; }
        __syncthreads();
        fft_fwd(X, TW, tid);
        for (int i = tid; i < 8192; i += 512) { const int q = fphys(i); X[q] = cmul(X[q], Fg[i]); }
        __syncthreads();
        fft_inv(X, TW, tid);
        for (int i = tid; i < 4096; i += 512) { const unsigned w = wp[i]; const f32x2 y = X[fphys(i)] * (1.0f / 8192.0f);
            wp[i] = pack2(y.x + __uint_as_float(w << 16) * bias, y.y + __uint_as_float(w & 0xffff0000u) * bias); }
    }
    __syncthreads();
}

__device__ __forceinline__ void phase_m1(const Ptrs P, int l, LAS unsigned char* lds) {
    const int tid = P.tid, G = P.G;
    const bf16_t* U = (const bf16_t*)(P.ws + WS_BIG + BIG_U); bf16_t* WT = (bf16_t*)(P.ws + WS_BIG + BIG_WT);
    const float* hcw = P.inp(I_HYCW) + (size_t)l * 3 * 768; const float* hcb = P.inp(I_HYCB) + l * 768;
    const int NS = NB * 4 * 2 * NCHK;
    const int NU = 2 * NS + 256 + NCTX / 64;
    for (int u = P.bid; u < NU; u += G) {
        if (u < NS) hgrn_pass1(P, l, u, lds);
        else if (u < 2 * NS) ssd_pass1(P, l, u - NS, lds);
        else if (u < 2 * NS + 256) {
            const int ub = u - 2 * NS; const int p = ub >> 6, tb = ub & 63; const int c = tid & 255; LAS unsigned* tile = (LAS unsigned*)lds;
            for (int rr = tid >> 8; rr < 64; rr += 2) { float w2[2];
#pragma unroll
                for (int b2 = 0; b2 < 2; ++b2) { const int row = (2 * p + b2) * SEQ + tb * 64 + rr;
                    const float x1 = conv3_u(U, row, 256 + c, hcw, 768, 256 + c) + hcb[256 + c]; const float v = conv3_u(U, row, 512 + c, hcw, 768, 512 + c) + hcb[512 + c]; w2[b2] = x1 * v; }
                tile[c * 65 + rr] = pack2(w2[0], w2[1]); }
            __syncthreads();
            { unsigned* WTt = (unsigned*)(P.ws + WS_BIG + BIG_WT); const int t = tid & 63;
              for (int cc = tid >> 6; cc < 256; cc += 8) WTt[((size_t)cc * 4 + p) * 4096 + tb * 64 + t] = tile[cc * 65 + t]; }
            __syncthreads();
        } else {
            const int ub = u - 2 * NS - 256; const int c = tid & 255; bf16_t* WTC = (bf16_t*)(P.ws + WS_BIG + BIG_WT) + (size_t)NLAT * 256;
            for (int rr = tid >> 8; rr < 64; rr += 2) { const int row = NLAT + ub * 64 + rr;
                const float x1 = conv3_u(U, row, 256 + c, hcw, 768, 256 + c) + hcb[256 + c]; const float v = conv3_u(U, row, 512 + c, hcw, 768, 512 + c) + hcb[512 + c];
                WTC[(size_t)(row - NLAT) * 256 + c] = f2bf(x1 * v); } }
    }
}

__device__ __forceinline__ void phase_m2(const Ptrs P, int l, LAS unsigned char* lds) {
    const int tid = P.tid, G = P.G;
    const bf16_t* U = (const bf16_t*)(P.ws + WS_BIG + BIG_U); bf16_t* BR = (bf16_t*)(P.ws + WS_BR);
    const float* hcw = P.inp(I_HYCW) + (size_t)l * 3 * 768; const float* hcb = P.inp(I_HYCB) + l * 768;
    const int NU_F = 256, NU_P2 = 256, NU_HC = (l == 0) ? NB * 16 : 0;
    const int NU = NU_F + NU_P2 + NU_HC;
    for (int u = P.bid; u < NU; u += G) {
        if (u < NU_F) { hyena_fft_unit(P, l, u, lds); continue; }
        if (u < NU_F + NU_P2) { scan_pass2(P, u - NU_F); continue; }
        const int uu = u - NU_F - NU_P2; const int L = CTXL; const int msk = 2 * L - 1;
        const int b = uu >> 4; const int t0 = (uu & 15) * 16 + (tid >> 8) * 8; const int c = tid & 255;
        const int base = NLAT + b * CTXL; const bf16_t* WTC = (const bf16_t*)(P.ws + WS_BIG + BIG_WT) + (size_t)NLAT * 256 + (size_t)b * CTXL * 256;
        const float* filt = (const float*)(P.ws + WS_FILTC);
        float acc[8], fw[8];
#pragma unroll
        for (int j = 0; j < 8; ++j) { acc[j] = 0.f; fw[j] = filt[(size_t)((t0 + j) & msk) * 256 + c]; }
        for (int s = 0; s < L; ++s) { const float w = bf2f(WTC[(size_t)s * 256 + c]);
#pragma unroll
            for (int j = 0; j < 8; ++j) acc[j] += fw[j] * w;
#pragma unroll
            for (int j = 7; j > 0; --j) fw[j] = fw[j - 1];
            fw[0] = filt[(size_t)((t0 - s - 1) & msk) * 256 + c]; }
        const float inv = 1.0f / hy_norm(P, 2, c); const float bias = P.inp(I_HYBIAS)[l * 256 + c];
#pragma unroll
        for (int j = 0; j < 8; ++j) { const int row = base + t0 + j; const float x0 = conv3_u(U, row, c, hcw, 768, c) + hcb[c]; const float w = bf2f(WTC[(size_t)(t0 + j) * 256 + c]);
            BR[(size_t)row * 256 + c] = f2bf(x0 * (acc[j] * inv + w * bias)); }
    }
}

__device__ __forceinline__ void phase_m3(const Ptrs P, int l, LAS unsigned char* lds) {
    const int tid = P.tid, G = P.G;
    const bool last = (l == NLAYER - 1); const int rows_l = last ? NLAT : T;
    const bf16_t* U = (const bf16_t*)(P.ws + WS_BIG + BIG_U); bf16_t* BR = (bf16_t*)(P.ws + WS_BR);
    const int NS3 = NB * 4 * NCHK;
    const int NU = 2 * NS3 + rows_l / 64 + 256;
    const float* hcw = P.inp(I_HYCW) + (size_t)l * 3 * 768; const float* hcb = P.inp(I_HYCB) + l * 768;
    for (int u = P.bid; u < NU; u += G) {
        if (u >= 2 * NS3 + rows_l / 64) {
            const int ub = u - 2 * NS3 - rows_l / 64; const int p = ub >> 6, tb = ub & 63; LAS unsigned* tile = (LAS unsigned*)lds; const unsigned* WTt = (const unsigned*)(P.ws + WS_BIG + BIG_WT);
            { const int t = tid & 63; for (int cc = tid >> 6; cc < 256; cc += 8) tile[cc * 65 + t] = WTt[((size_t)cc * 4 + p) * 4096 + tb * 64 + t]; }
            __syncthreads();
            { const int c = tid & 255;
              for (int rr = tid >> 8; rr < 64; rr += 2) { const unsigned yw = tile[c * 65 + rr];
#pragma unroll
                  for (int b2 = 0; b2 < 2; ++b2) { const int row = (2 * p + b2) * SEQ + tb * 64 + rr; const float x0 = conv3_u(U, row, c, hcw, 768, c) + hcb[c];
                      const float y = b2 ? __uint_as_float(yw & 0xffff0000u) : __uint_as_float(yw << 16); BR[(size_t)row * 256 + c] = f2bf(x0 * y); } } }
            __syncthreads();
            continue; }
        if (u < 2 * NS3) { const int uu = u < NS3 ? u : u - NS3; if (last && (uu % NCHK) < 2) continue;
            if (u < NS3) hgrn_pass3(P, l, uu, lds); else ssd_pass3(P, l, uu, lds); }
        else { const int rb = u - 2 * NS3; const float* cw = P.inp(I_SCCW) + (size_t)l * 3 * 256; const int c = tid & 255;
            for (int rr = tid >> 8; rr < 64; rr += 2) { const int row = rb * 64 + rr; float acc = 0.f;
#pragma unroll
                for (int k = 0; k < 3; ++k) { const int r2 = row + k - 1; const bool ok = (k == 1) || (k == 0 ? row_has_prev(row) : row_has_next(row));
                    if (ok) acc += bf2f(U[(size_t)r2 * UC + 1024 + c]) * bf2f(U[(size_t)r2 * UC + 1280 + c]) * cw[k * 256 + c]; }
                BR[(size_t)T * 256 + (size_t)row * 256 + c] = f2bf(bf2f(U[(size_t)row * UC + 768 + c]) * acc); } }
    }
}

__device__ __forceinline__ void phase_g2(const Ptrs P, int l, LAS unsigned char* lds) {
    const int MT = ((l == NLAYER - 1) ? NLAT : T) / 256;
    pg8::Gemm g{(const bf16_t*)(P.ws + WS_BR), (const bf16_t*)(P.ws + WS_WBR), 256};
    EpiP E{(bf16_t*)(P.ws + WS_BIG + BIG_P), (const float*)(P.ws + WS_SSQ)};
    SchedG2 S{P.G, P.bid, MT};
    pg8::gemm_phase<EpiP, SchedG2, false>(P.tid, lds, g, S, E);
}
__device__ __forceinline__ void phase_g3(const Ptrs P, int l, LAS unsigned char* lds) {
    const int MT = ((l == NLAYER - 1) ? NLAT : T) / 256;
    pg8::Gemm g{(const bf16_t*)(P.ws + WS_HBUF), (const bf16_t*)(P.ws + WS_WG), D};
    EpiMerge E{(const bf16_t*)(P.ws + WS_BIG + BIG_P), (const float*)(P.ws + WS_BGP), (bf16_t*)(P.ws + WS_BR)};
    SchedMN S{P.G, P.bid, MT, 16};
    pg8::gemm_phase<EpiMerge, SchedMN, false>(P.tid, lds, g, S, E);
}
__device__ __forceinline__ void phase_g4(const Ptrs P, int l, LAS unsigned char* lds) {
    const int MT = ((l == NLAYER - 1) ? NLAT : T) / 256;
    pg8::Gemm g{(const bf16_t*)(P.ws + WS_BR), (const bf16_t*)(P.ws + WS_WO), D};
    EpiWo E{P, l};
    SchedMN S{P.G, P.bid, MT, 4};
    pg8::gemm_phase<EpiWo, SchedMN, false>(P.tid, lds, g, S, E);
}

__device__ __forceinline__ void phase_e5(const Ptrs P, int l, LAS unsigned char* lds) {
    const int tid = P.tid, wid = tid >> 6, lane = tid & 63, G = P.G;
    const int rows_l = (l == NLAYER - 1) ? NLAT : T;
    LAS float* wrT = (LAS float*)lds;
    LAS float* tile = (LAS float*)(lds + 65536);
    for (int i = tid; i < 1024 * 16; i += 512) wrT[(i & 15) * 1024 + (i >> 4)] = P.inp(I_WROUTER)[i];
    __syncthreads();
    unsigned* cnt = (unsigned*)(P.ws + WS_CTL + CTL_CNT) + l * 16;
    int* toke = (int*)(P.ws + WS_TOKE); float* tokw = (float*)(P.ws + WS_TOKW); int* toks = (int*)(P.ws + WS_TOKS); int* list = (int*)(P.ws + WS_LIST);
    const float* g = P.inp(I_LN1G) + l * D; const float* bta = P.inp(I_LN1B) + l * D;
    const int NU_R = rows_l / 8; const int NU = NU_R + NCONV_EX;
    for (int u = P.bid; u < NU; u += G) {
        if (u >= NU_R) { conv_unit_ex(P, l, u - NU_R, tile); continue; }
        const int row = u * 8 + wid; RowV r; float* lp = P.latrow(row);
        row_load(r, lp, lane); row_layernorm(r, g, bta, lane); row_store(r, lp, lane);
        const float* m = P.mod(l, row_modidx(row)); RowV h; row_modulate(r, h, m + 3072, m + 4096, lane);
        row_store_bf16(h, (bf16_t*)(P.ws + WS_HBUF) + (size_t)row * D, lane);
        float lg[16];
#pragma unroll
        for (int e = 0; e < 16; ++e) { float s = 0.f;
#pragma unroll
            for (int i = 0; i < 4; ++i) { const f32x4 w = *(const LAS f32x4*)(wrT + e * 1024 + i * 256 + lane * 4); s += h.v[i][0] * w[0] + h.v[i][1] * w[1] + h.v[i][2] * w[2] + h.v[i][3] * w[3]; }
            lg[e] = wave_sum(s); }
        float mx = lg[0];
#pragma unroll
        for (int e = 1; e < 16; ++e) mx = fmaxf(mx, lg[e]);
        float sc[16], sel[16], ssum = 0.f;
#pragma unroll
        for (int e = 0; e < 16; ++e) { sc[e] = expf(lg[e] - mx); ssum += sc[e]; }
        const float inv = 1.0f / ssum;
#pragma unroll
        for (int e = 0; e < 16; ++e) { sc[e] *= inv; sel[e] = sc[e] + P.inp(I_BROUTER)[e]; }
        int bestg = 0; float bestgs = -3.0e38f;
#pragma unroll
        for (int gq = 0; gq < 4; ++gq) { float m1 = -3.0e38f, m2 = -3.0e38f;
#pragma unroll
            for (int j = 0; j < 4; ++j) { const float v = sel[gq * 4 + j]; if (v > m1) { m2 = m1; m1 = v; } else if (v > m2) m2 = v; }
            const float gs = m1 + m2; if (gs > bestgs) { bestgs = gs; bestg = gq; } }
        int i1 = 0, i2 = 0; float v1 = -3.0e38f, v2 = -3.0e38f, w1 = 0.f, w2 = 0.f;
#pragma unroll
        for (int e = 0; e < 16; ++e) { if ((e >> 2) == bestg && sel[e] > v1) { v1 = sel[e]; i1 = e; w1 = sc[e]; } }
#pragma unroll
        for (int e = 0; e < 16; ++e) { if ((e >> 2) == bestg && e != i1 && sel[e] > v2) { v2 = sel[e]; i2 = e; w2 = sc[e]; } }
        if (lane == 0) { const float ws_ = 1.0f / (w1 + w2);
            const int s1 = (int)__hip_atomic_fetch_add(cnt + i1, 1u, __ATOMIC_RELAXED, __HIP_MEMORY_SCOPE_AGENT);
            const int s2 = (int)__hip_atomic_fetch_add(cnt + i2, 1u, __ATOMIC_RELAXED, __HIP_MEMORY_SCOPE_AGENT);
            list[(size_t)i1 * T + s1] = row; list[(size_t)i2 * T + s2] = row;
            toke[row * 2] = i1; toke[row * 2 + 1] = i2; tokw[row * 2] = w1 * ws_; tokw[row * 2 + 1] = w2 * ws_; toks[row * 2] = s1; toks[row * 2 + 1] = s2; }
    }
}

struct MoeSeg { int toff[17]; };
__device__ __forceinline__ void moe_seg(const unsigned* cnt, MoeSeg& S) { int a = 0;
#pragma unroll
    for (int e = 0; e < 16; ++e) { S.toff[e] = a; a += __builtin_amdgcn_readfirstlane(((int)cnt[e] + 255) >> 8); }
    S.toff[16] = a; }
__device__ __forceinline__ int moe_find(const MoeSeg& S, int tg, int& off) { int e = 0; off = 0;
#pragma unroll
    for (int j = 1; j < 16; ++j) { const bool ge = (tg >= S.toff[j]); e += ge ? 1 : 0; off = ge ? S.toff[j] : off; }
    return e; }

struct SchedMoe { int G, c; MoeSeg S; const int* list; const unsigned* cnt;
    __device__ __forceinline__ bool next(int i, Unit& u) const { const int L = i * G + c; if (L >= S.toff[16] * 4) return false; const int tg = L >> 2, pnn = L & 3; int off; const int e = moe_find(S, tg, off);
        u.pm = tg; u.pn = e * 4 + pnn; u.e = e; u.aux = tg - off; return true; }
    __device__ __forceinline__ int arow(const Unit& u, int R) const { const int idx = u.aux * 256 + R; const int* l = list + (size_t)u.e * T; return idx < (int)cnt[u.e] ? l[idx] : l[0]; } };
__device__ __forceinline__ void phase_g5(const Ptrs P, int l, LAS unsigned char* lds) {
    const unsigned* cnt = (const unsigned*)(P.ws + WS_CTL + CTL_CNT) + l * 16;
    SchedMoe S; S.G = P.G; S.c = P.bid; moe_seg(cnt, S.S); S.list = (const int*)(P.ws + WS_LIST); S.cnt = cnt;
    pg8::Gemm g{(const bf16_t*)(P.ws + WS_HBUF), (const bf16_t*)(P.ws + WS_BIG + BIG_W13), D};
    EpiFfn1 E{(bf16_t*)(P.ws + WS_BIG + BIG_HID)};
    pg8::gemm_phase<EpiFfn1, SchedMoe, true>(P.tid, lds, g, S, E);
}
__device__ __forceinline__ void phase_g6(const Ptrs P, int l, LAS unsigned char* lds) {
    const unsigned* cnt = (const unsigned*)(P.ws + WS_CTL + CTL_CNT) + l * 16;
    SchedMoe S; S.G = P.G; S.c = P.bid; moe_seg(cnt, S.S); S.list = (const int*)(P.ws + WS_LIST); S.cnt = cnt;
    pg8::Gemm g{(const bf16_t*)(P.ws + WS_BIG + BIG_HID), (const bf16_t*)(P.ws + WS_BIG + BIG_W2), 512};
    EpiBf16Plain E{(bf16_t*)(P.ws + WS_BIG + BIG_YE), 1024, 3};
    pg8::gemm_phase<EpiBf16Plain, SchedMoe, false>(P.tid, lds, g, S, E);
}

__device__ __forceinline__ void phase_e8(const Ptrs P, int l, LAS unsigned char* lds) {
    const int tid = P.tid, wid = tid >> 6, lane = tid & 63, G = P.G;
    const bool last = (l == NLAYER - 1); const int rows_l = last ? NLAT : T;
    LAS float* wdt = (LAS float*)lds; LAS float* tile = (LAS float*)(lds + 65536);
    if (!last) load_wdt(P, l + 1, wdt);
    const unsigned* cnt = (const unsigned*)(P.ws + WS_CTL + CTL_CNT) + l * 16; MoeSeg S; moe_seg(cnt, S);
    const int* toke = (const int*)(P.ws + WS_TOKE); const float* tokw = (const float*)(P.ws + WS_TOKW); const int* toks = (const int*)(P.ws + WS_TOKS);
    const bf16_t* YE = (const bf16_t*)(P.ws + WS_BIG + BIG_YE);
    const float* g = P.inp(I_LN2G) + l * D; const float* bta = P.inp(I_LN2B) + l * D;
    const int NU_R = rows_l / 8; const int NU = NU_R + (last ? 0 : NCONV_NE);
    for (int u = P.bid; u < NU; u += G) {
        if (u >= NU_R) { conv_unit_ne(P, l + 1, u - NU_R, tile); continue; }
        const int row = u * 8 + wid; RowV r; float* lp = P.latrow(row); row_load(r, lp, lane);
        const int e1 = toke[row * 2], e2 = toke[row * 2 + 1]; const float w1 = tokw[row * 2], w2 = tokw[row * 2 + 1];
        int o1 = 0, o2 = 0;
#pragma unroll
        for (int e = 0; e < 16; ++e) { o1 = (e == e1) ? S.toff[e] : o1; o2 = (e == e2) ? S.toff[e] : o2; }
        const bf16_t* y1 = YE + ((size_t)o1 * 256 + toks[row * 2]) * 1024; const bf16_t* y2 = YE + ((size_t)o2 * 256 + toks[row * 2 + 1]) * 1024;
        const float* m = P.mod(l, row_modidx(row));
#pragma unroll
        for (int i = 0; i < 4; ++i) { const u32x2 a = *(const u32x2*)(y1 + i * 256 + lane * 4), b = *(const u32x2*)(y2 + i * 256 + lane * 4);
            const f32x4 g2 = *(const f32x4*)(m + 5120 + i * 256 + lane * 4);
            f32x4 mo; mo[0] = w1 * __uint_as_float(a.x << 16) + w2 * __uint_as_float(b.x << 16); mo[1] = w1 * __uint_as_float(a.x & 0xffff0000u) + w2 * __uint_as_float(b.x & 0xffff0000u);
            mo[2] = w1 * __uint_as_float(a.y << 16) + w2 * __uint_as_float(b.y << 16); mo[3] = w1 * __uint_as_float(a.y & 0xffff0000u) + w2 * __uint_as_float(b.y & 0xffff0000u);
            r.v[i] = r.v[i] * ALPHA + g2 * mo; }
        row_layernorm(r, g, bta, lane);
        row_store(r, lp, lane);
        if (!last) { const float* m2 = P.mod(l + 1, row_modidx(row)); RowV h; row_modulate(r, h, m2, m2 + 1024, lane);
            row_store_bf16(h, (bf16_t*)(P.ws + WS_HBUF) + (size_t)row * D, lane); row_dt(h, wdt, (float*)(P.ws + WS_DT) + (size_t)row * 8, lane); }
    }
}

constexpr int NPH_LAYER = 11, NPH = 2 + NLAYER * NPH_LAYER;
__global__ void __launch_bounds__(512, 2) fwd_kernel(Args a) {
    extern __shared__ __attribute__((aligned(16))) unsigned char lds_raw[];
    LAS unsigned char* lds = (LAS unsigned char*)lds_raw;
    const int lo = a.ph_lo, hi = a.ph_hi;
    volatile LAS unsigned* xbw = (volatile LAS unsigned*)(lds + LDS_MISC);
    const int wave_s = __builtin_amdgcn_readfirstlane((int)threadIdx.x >> 6);
    if (threadIdx.x < 4) xbw[threadIdx.x] = 0u;
    __syncthreads();
    XcdBarrier bar; bar.bar = (unsigned*)(a.ws + WS_CTL); bar.x = 0; bar.st = xbw;
    if (hi - lo > 1) bar = xcd_barrier_post((unsigned*)(a.ws + WS_CTL), xbw, wave_s);
#ifndef PH_MASK
#define PH_MASK 0xFFFFFFFFu
#endif
#define PH_ON(id) (((PH_MASK) >> (id)) & 1u)
#define IN(k) (lo <= (k) && (k) < hi)
#define FRESH() Ptrs Pq; { float* o_ = a.out; unsigned char* w_ = a.ws; int l_ = lcur; asm volatile("" : "+s"(o_), "+s"(w_), "+s"(l_) :: "memory"); Pq.out = o_; Pq.ws = w_; lq = l_; int ws_ = wave_s, b_ = blockIdx.x, g_ = gridDim.x; asm volatile("" : "+s"(ws_), "+s"(b_), "+s"(g_)); int ln_ = lane_id(); asm volatile("" : "+v"(ln_)); int t_ = ws_ * 64 + ln_; Pq.tid = t_; Pq.bid = b_; Pq.G = g_; }
#define SEAM(k) do { if (IN(k) && IN((k) + 1)) xcd_barrier(bar, wave_s); } while (0)
    int lcur = 0, lq = 0;
    if (PH_ON(0) && IN(0)) { FRESH(); phase_pa(Pq, lds); } SEAM(0);
    if (PH_ON(1) && IN(1)) { FRESH(); phase_pb(Pq, lds); } SEAM(1);
    for (int l = 0; l < NLAYER; ++l) {
        const int b = 2 + l * NPH_LAYER; lcur = l;
        if (PH_ON(2) && IN(b + 0)) { FRESH(); phase_g1(Pq, lds); } SEAM(b + 0);
        if (PH_ON(3) && IN(b + 1)) { FRESH(); phase_m1(Pq, lq, lds); } SEAM(b + 1);
        if (PH_ON(4) && IN(b + 2)) { FRESH(); phase_m2(Pq, lq, lds); } SEAM(b + 2);
        if (PH_ON(5) && IN(b + 3)) { FRESH(); phase_m3(Pq, lq, lds); } SEAM(b + 3);
        if (PH_ON(6) && IN(b + 4)) { FRESH(); phase_g2(Pq, lq, lds); } SEAM(b + 4);
        if (PH_ON(7) && IN(b + 5)) { FRESH(); phase_g3(Pq, lq, lds); } SEAM(b + 5);
        if (PH_ON(8) && IN(b + 6)) { FRESH(); phase_g4(Pq, lq, lds); } SEAM(b + 6);
        if (PH_ON(9) && IN(b + 7)) { FRESH(); phase_e5(Pq, lq, lds); } SEAM(b + 7);
        if (PH_ON(10) && IN(b + 8)) { FRESH(); phase_g5(Pq, lq, lds); } SEAM(b + 8);
        if (PH_ON(11) && IN(b + 9)) { FRESH(); phase_g6(Pq, lq, lds); } SEAM(b + 9);
        if (PH_ON(12) && IN(b + 10)) { FRESH(); phase_e8(Pq, lq, lds); } SEAM(b + 10);
    }
#undef IN
#undef SEAM
}
}

extern "C" void kernel_launch(void* const* d_in, const int* in_sizes, int n_in, void* d_out, int out_size, void* d_ws, size_t ws_size, hipStream_t stream) {
    static int grid = 0;
    if (grid == 0) {
        if (n_in != N_IN || out_size != NLAT * D || ws_size < WS_END) { fprintf(stderr, "kernel_launch: unexpected shapes / workspace (%d inputs, out %d, ws %zu < %zu)\n", n_in, out_size, ws_size, (size_t)WS_END); grid = -1; return; }
        int dev = 0, cus = 0, per_cu = 0;
        if (hipGetDevice(&dev) != hipSuccess || hipDeviceGetAttribute(&cus, hipDeviceAttributeMultiprocessorCount, dev) != hipSuccess) { grid = -1; return; }
        if (hipFuncSetAttribute((const void*)fwd_kernel, hipFuncAttributeMaxDynamicSharedMemorySize, LDS_BYTES) != hipSuccess) { fprintf(stderr, "kernel_launch: hipFuncSetAttribute failed\n"); grid = -1; return; }
        if (hipOccupancyMaxActiveBlocksPerMultiprocessor(&per_cu, (const void*)fwd_kernel, 512, LDS_BYTES) != hipSuccess || per_cu < 1) { fprintf(stderr, "kernel_launch: occupancy query says %d\n", per_cu); }
        (void)hipGetLastError();
        grid = cus;
    }
    if (grid < 0) return;
    (void)hipMemsetAsync((char*)d_ws + WS_CTL, 0, CTL_BYTES, stream);
    Args a{};
    for (int i = 0; i < N_IN; ++i) a.in[i] = (const float*)d_in[i];
    a.out = (float*)d_out; a.ws = (unsigned char*)d_ws;
#if N_LAUNCH_MODE == 1
    a.ph_lo = 0; a.ph_hi = NPH;
    hipLaunchKernelGGL(fwd_kernel, dim3(grid), dim3(512), LDS_BYTES, stream, a);
#else
    for (int p = 0; p < NPH; ++p) { a.ph_lo = p; a.ph_hi = p + 1; hipLaunchKernelGGL(fwd_kernel, dim3(grid), dim3(512), LDS_BYTES, stream, a); }
#endif
}
```

```cpp
#include <hip/hip_runtime.h>
#include <cstdio>
#include <cstdint>

#ifndef N_LAUNCH_MODE
#define N_LAUNCH_MODE 1
#endif

namespace {
typedef unsigned short bf16_t;
typedef short bf16x8 __attribute__((ext_vector_type(8)));
typedef float f32x4 __attribute__((ext_vector_type(4)));
typedef unsigned u32x2 __attribute__((ext_vector_type(2)));
typedef unsigned u32x4 __attribute__((ext_vector_type(4)));
#define LAS __attribute__((address_space(3)))

constexpr int D = 1024, NB = 8, SEQ = 4096, CTXL = 256, NLAT = NB * SEQ, NCTX = NB * CTXL, T = NLAT + NCTX;
constexpr int NLAYER = 2;
constexpr int UC = 3584;
constexpr int INC = 3592;
constexpr int NE = 16;
constexpr float ALPHA = 1.41421356237309515f;
constexpr float LN_EPS = 1e-5f, RMS_EPS = 1e-6f;
constexpr int MAXTILES = 288;

enum { I_X = 0, I_C, I_CTX, I_CCTX, I_WADA, I_BADA, I_WIN, I_HYCW, I_HYCB, I_HYW1, I_HYB1, I_HYF1, I_HYW2, I_HYB2, I_HYF2, I_HYW3, I_HYDEC, I_HYBIAS,
       I_SCCW, I_HGLB, I_HGNG, I_SSDCW, I_SSDCB, I_SSDALOG, I_SSDDTB, I_SSDD, I_SSDNG, I_WGATE, I_BGATE, I_WBR, I_WO, I_LN1G, I_LN1B, I_LN2G, I_LN2B,
       I_WROUTER, I_BROUTER, I_WE1, I_WE3, I_WE2, N_IN };

constexpr size_t al256(size_t x) { return (x + 255) & ~(size_t)255; }
constexpr size_t WS_CTL = 0;
constexpr size_t CTL_BYTES = 65536;
constexpr size_t CTL_CNT = 16384;
constexpr size_t WS_MOD = WS_CTL + CTL_BYTES;
constexpr size_t WS_LB = WS_MOD + al256((size_t)NLAYER * 9 * 6144 * 4);
constexpr size_t WS_TW = WS_LB + 4096;
constexpr size_t WS_H2TAB = WS_TW + 65536;
constexpr size_t WS_PART = WS_H2TAB + (size_t)8448 * 64 * 4;
constexpr size_t WS_FILT = WS_PART + (size_t)3 * 64 * 512 * 4;
constexpr size_t WS_FILTC = WS_FILT + (size_t)2 * 8192 * 256 * 4;
constexpr size_t WS_CX32 = WS_FILTC + (size_t)512 * 256 * 4;
constexpr size_t WS_DT = WS_CX32 + (size_t)NCTX * D * 4;
constexpr size_t WS_SSQ = WS_DT + (size_t)T * 8 * 4;
constexpr size_t WS_TOKE = WS_SSQ + (size_t)T * 4 * 4;
constexpr size_t WS_TOKW = WS_TOKE + (size_t)T * 2 * 4;
constexpr size_t WS_TOKS = WS_TOKW + (size_t)T * 2 * 4;
constexpr size_t WS_LIST = WS_TOKS + (size_t)T * 2 * 4;
constexpr size_t WS_BGP = WS_LIST + (size_t)NE * T * 4;
constexpr size_t WS_DEC = WS_BGP + 16384;
constexpr size_t WS_WIN = WS_DEC + (size_t)4352 * 64 * 4;
constexpr size_t WS_WG = WS_WIN + (size_t)UC * D * 2;
constexpr size_t WS_WBR = WS_WG + (size_t)4096 * D * 2;
constexpr size_t WS_WO = WS_WBR + (size_t)4096 * 256 * 2;
constexpr size_t WS_HBUF = WS_WO + (size_t)D * D * 2;
constexpr size_t WS_BR = WS_HBUF + (size_t)T * D * 2;
constexpr size_t WS_BIG = WS_BR + (size_t)T * D * 2;
constexpr size_t BIG_U = 0;
constexpr size_t BIG_HGO = BIG_U + (size_t)T * UC * 2;
constexpr size_t BIG_STATE = BIG_HGO;
constexpr size_t BIG_SSY = BIG_HGO + (size_t)T * 256 * 4;
constexpr size_t BIG_WT = BIG_SSY + (size_t)T * 256 * 4;
constexpr size_t BIG_END1 = BIG_WT + (size_t)T * 256 * 2;
constexpr size_t BIG_P = 0;
constexpr size_t BIG_HID = 0;
constexpr size_t BIG_YE = BIG_HID + (size_t)MAXTILES * 256 * 512 * 2;
constexpr size_t BIG_W13 = BIG_YE + (size_t)MAXTILES * 256 * 1024 * 2;
constexpr size_t BIG_W2 = BIG_W13 + (size_t)NE * 1024 * 1024 * 2;
constexpr size_t BIG_END3 = BIG_W2 + (size_t)NE * 1024 * 512 * 2;
constexpr size_t BIG_BYTES = BIG_END1 > BIG_END3 ? BIG_END1 : BIG_END3;
constexpr size_t WS_END = WS_BIG + BIG_BYTES;
static_assert((size_t)T * 4096 * 2 <= BIG_BYTES, "P fits");
static_assert(WS_END <= (size_t)536870912, "workspace budget");

constexpr int LDS_BYTES = 147456;
constexpr int LDS_MISC = 147456 - 256;

struct Args { const float* in[N_IN]; float* out; unsigned char* ws; int ph_lo, ph_hi; };

#define XB_TMO      128
#define XB_XCNT(j)  (256  + 64 * (j))
#define XB_XSUB(j)  (1280 + 64 * (j))
#define XB_XGEN(j)  (2304 + 64 * (j))
#define XB_TOP      3328
#define XB_TOPGEN   3392
#define XCD_BAR_WORDS 3456
#define XB_SPIN_CAP (1u << 18)
__device__ __forceinline__ unsigned xb_ld(unsigned* p)              { return __hip_atomic_load(p, __ATOMIC_RELAXED, __HIP_MEMORY_SCOPE_AGENT); }
__device__ __forceinline__ unsigned xb_add(unsigned* p, unsigned v) { return __hip_atomic_fetch_add(p, v, __ATOMIC_RELAXED, __HIP_MEMORY_SCOPE_AGENT); }
__device__ __forceinline__ unsigned xb_xcc_id() { return (unsigned)__builtin_amdgcn_s_getreg((3 << 11) | 20) & 0xFu; }
#define XB_SPIN(cond, bar) do { unsigned _sp = 0; while (cond) { __builtin_amdgcn_s_sleep(1); \
    if ((++_sp & 255u) == 0u) { if (xb_ld(&(bar)[XB_TMO])) break; if (_sp > XB_SPIN_CAP) { atomicAdd(&(bar)[XB_TMO], 1u); break; } } } } while (0)
struct XcdBarrier { unsigned* bar; unsigned x; volatile LAS unsigned* st; };
__device__ __forceinline__ int lane_id() { unsigned z = 0u; asm volatile("" : "+v"(z)); return (int)__builtin_amdgcn_mbcnt_hi(~0u, __builtin_amdgcn_mbcnt_lo(~0u, z)); }
__device__ __forceinline__ bool is_thread0(int wave_s) { return wave_s == 0 && lane_id() == 0; }
__device__ __forceinline__ XcdBarrier xcd_barrier_post(unsigned* bar, volatile LAS unsigned* st, int wave_s) {
    XcdBarrier b; b.bar = bar; b.x = xb_xcc_id(); b.st = st;
    if (is_thread0(wave_s)) (void)xb_add(&bar[XB_XCNT(b.x)], 1u);
    return b;
}
__device__ __forceinline__ void xcd_barrier_complete(unsigned* bar, unsigned x, unsigned& nloc, unsigned& nx) {
    const unsigned G = gridDim.x * gridDim.y * gridDim.z;
    unsigned sum, cnt, mine, sp = 0u;
    for (;;) {
        sum = 0u; cnt = 0u; mine = 0u;
#pragma unroll
        for (unsigned j = 0; j < 16; ++j) { const unsigned c = xb_ld(&bar[XB_XCNT(j)]); sum += c; cnt += (c > 0u) ? 1u : 0u; mine = (j == x) ? c : mine; }
        if (sum == G) break;
        __builtin_amdgcn_s_sleep(1);
        if ((++sp & 255u) == 0u) { if (xb_ld(&bar[XB_TMO])) break; if (sp > XB_SPIN_CAP) { atomicAdd(&bar[XB_TMO], 1u); break; } }
    }
    nloc = mine > 0u ? mine : 1u; nx = cnt > 0u ? cnt : 1u;
}
__device__ __forceinline__ void xcd_barrier(const XcdBarrier& b, int wave_s) {
    asm volatile("s_waitcnt vmcnt(0)" ::: "memory");
    __syncthreads();
    if (is_thread0(wave_s)) {
        unsigned* bar = b.bar;
        __builtin_amdgcn_s_waitcnt(0);
        unsigned nloc = b.st[0], nx = b.st[1];
        if (nloc == 0u) { xcd_barrier_complete(bar, b.x, nloc, nx); b.st[0] = nloc; b.st[1] = nx; }
        const unsigned old = xb_add(&bar[XB_XSUB(b.x)], 1u);
        const unsigned gen = old / nloc;
        if (old + 1u == (gen + 1u) * nloc) {
            __builtin_amdgcn_fence(__ATOMIC_RELEASE, "agent");
            asm volatile("s_waitcnt vmcnt(0)" ::: "memory");
            const unsigned og = xb_add(&bar[XB_TOP], 1u);
            const unsigned tg = og / nx;
            if (og + 1u == (tg + 1u) * nx) xb_add(&bar[XB_TOPGEN], 1u);
            else XB_SPIN(xb_ld(&bar[XB_TOPGEN]) == tg, bar);
            __builtin_amdgcn_fence(__ATOMIC_ACQUIRE, "agent");
            xb_add(&bar[XB_XGEN(b.x)], 1u);
            asm volatile("s_waitcnt vmcnt(0)" ::: "memory");
        } else {
            XB_SPIN(xb_ld(&bar[XB_XGEN(b.x)]) == gen, bar);
            __builtin_amdgcn_fence(__ATOMIC_ACQUIRE, "agent");
            asm volatile("s_waitcnt vmcnt(0)" ::: "memory");
        }
    }
    __syncthreads();
}

__device__ __forceinline__ float bf2f(bf16_t b) { return __uint_as_float(((unsigned)b) << 16); }
__device__ __forceinline__ bf16_t f2bf(float f) { unsigned u = __float_as_uint(f); u += 0x7FFFu + ((u >> 16) & 1u); return (bf16_t)(u >> 16); }
__device__ __forceinline__ unsigned pack2(float lo, float hi) { return (unsigned)f2bf(lo) | ((unsigned)f2bf(hi) << 16); }
__device__ __forceinline__ float sigmoidf_(float x) { return 1.0f / (1.0f + __expf(-x)); }
__device__ __forceinline__ float siluf_(float x) { return x * sigmoidf_(x); }
__device__ __forceinline__ float wave_sum(float v) {
#pragma unroll
    for (int o = 32; o >= 1; o >>= 1) v += __shfl_xor(v, o);
    return v;
}
__device__ __forceinline__ int row_modidx(int r) { return r < NLAT ? (r >> 12) : 8; }
__device__ __forceinline__ bool row_has_prev(int r) { return r < NLAT ? ((r & 4095) != 0) : (((r - NLAT) & 255) != 0); }
__device__ __forceinline__ bool row_has_next(int r) { return r < NLAT ? ((r & 4095) != 4095) : (((r - NLAT) & 255) != 255); }

struct Ptrs {
    float* out; unsigned char* ws; int tid, bid, G;
    __device__ __forceinline__ const float* inp(int i) const { asm volatile("" : "+s"(i));
        const __attribute__((address_space(4))) char* ka = (const __attribute__((address_space(4))) char*)__builtin_amdgcn_kernarg_segment_ptr();
        return *(const float* const __attribute__((address_space(4)))*)(ka + 8 * i); }
    __device__ __forceinline__ float* latrow(int r) const { return r < NLAT ? out + (size_t)r * D : (float*)(ws + WS_CX32) + (size_t)(r - NLAT) * D; }
    __device__ __forceinline__ float* mod(int l, int ridx) const { return (float*)(ws + WS_MOD) + ((size_t)l * 9 + ridx) * 6144; }
};

__device__ __forceinline__ float conv3_u(const bf16_t* U, int row, int col, const float* w, int ncol, int wcol) {
    const bool hp = row_has_prev(row), hn = row_has_next(row);
    const float c = bf2f(U[(size_t)row * UC + col]), p = bf2f(U[(size_t)(hp ? row - 1 : row) * UC + col]), n = bf2f(U[(size_t)(hn ? row + 1 : row) * UC + col]);
    return c * w[ncol + wcol] + (hp ? p * w[wcol] : 0.f) + (hn ? n * w[2 * ncol + wcol] : 0.f);
}

struct Unit { int pm, pn, e, aux; };
__host__ __device__ __forceinline__ int perm32(int rho) { const int n = rho >> 4, i = rho & 15; return 8 * (i >> 2) + 4 * n + (i & 3); }

template <class RowMap, class Epi>
__device__ __forceinline__ void sgemm_unit(int tid_, const bf16_t* __restrict__ A, int lda, const bf16_t* __restrict__ Bt, int ldb, int K, const Unit& u, const RowMap& RM, const Epi& E) {
    const int tid = tid_, wid = tid >> 6, lane = tid & 63, wr = wid >> 2, wc = wid & 3, fr = lane & 15, fq = lane >> 4;
    f32x4 acc[2][2][4][2];
#pragma unroll
    for (int a = 0; a < 2; ++a)
#pragma unroll
        for (int b = 0; b < 2; ++b)
#pragma unroll
            for (int m = 0; m < 4; ++m)
#pragma unroll
                for (int n = 0; n < 2; ++n) acc[a][b][m][n] = (f32x4){0.f, 0.f, 0.f, 0.f};
    unsigned ap[2][4], bp[2][2];
#pragma unroll
    for (int a = 0; a < 2; ++a)
#pragma unroll
        for (int m = 0; m < 4; ++m) ap[a][m] = (unsigned)RM(u, 128 * a + 64 * wr + 16 * m + fr) * (unsigned)lda + fq * 8;
#pragma unroll
    for (int b = 0; b < 2; ++b)
#pragma unroll
        for (int n = 0; n < 2; ++n) { const int rho = 16 * n + fr; const int col = Epi::PERM ? perm32(rho) : rho;
            bp[b][n] = (unsigned)(u.pn * 256 + 128 * b + 32 * wc + col) * (unsigned)ldb + fq * 8; }
    for (int k = 0; k < K; k += 32) {
        bf16x8 bfr[2][2];
#pragma unroll
        for (int b = 0; b < 2; ++b)
#pragma unroll
            for (int n = 0; n < 2; ++n) bfr[b][n] = *(const bf16x8*)(Bt + (bp[b][n] + k));
#pragma unroll
        for (int a = 0; a < 2; ++a) {
            bf16x8 af[4];
#pragma unroll
            for (int m = 0; m < 4; ++m) af[m] = *(const bf16x8*)(A + (ap[a][m] + k));
#pragma unroll
            for (int b = 0; b < 2; ++b)
#pragma unroll
                for (int m = 0; m < 4; ++m)
#pragma unroll
                    for (int n = 0; n < 2; ++n) acc[a][b][m][n] = __builtin_amdgcn_mfma_f32_16x16x32_bf16(bfr[b][n], af[m], acc[a][b][m][n], 0, 0, 0);
        }
    }
    E(acc, u, wr, wc, fr, fq);
}

struct RowIdent { __device__ __forceinline__ int operator()(const Unit& u, int R) const { return u.pm * 256 + R; } };
struct RowStackK { int rows; __device__ __forceinline__ int operator()(const Unit& u, int R) const { return u.e * rows + u.pm * 256 + R; } };
struct RowGather { const int* list; const unsigned* cnt; __device__ __forceinline__ int operator()(const Unit& u, int R) const {
    const int idx = u.aux * 256 + R; const int* l = list + (size_t)u.e * T; return idx < (int)cnt[u.e] ? l[idx] : l[0]; } };


namespace pg8 {
constexpr int BM = 256, BK = 64, HALF = 128, HTB = HALF * BK * 2, STAGE_BYTES = 8 * HTB;
__host__ __device__ __forceinline__ int lds_byte(int r, int c) { const int st = (r >> 4) * 2 + (c >> 5), rr = r & 15, cc = c & 31, ob = rr * 64 + cc * 2; return st * 1024 + (ob ^ (((ob >> 9) & 1) << 5)); }
__host__ __device__ __forceinline__ void stage_rc(int b, int& R, int& C) { const int st = b / 1024, sb = b % 1024, swz = sb ^ (((sb >> 9) & 1) << 5); R = (st >> 1) * 16 + swz / 64; C = (st & 1) * 32 + (swz % 64) / 2; }
struct Gemm { const bf16_t* A; const bf16_t* Bt; int K; };

template <class Epi, class Sched, bool GATHER>
__device__ __forceinline__ void gemm_phase(int tid, LAS unsigned char* lds, const Gemm g, const Sched& S, const Epi& E) {
    const int wid = __builtin_amdgcn_readfirstlane(tid >> 6), lane = tid & 63, wr = wid >> 2, wc = wid & 3, fr = lane & 15, fq = lane >> 4;
    const int K = g.K, nt = K / BK;
    int RA[2], CA[2]; unsigned voffB[2];
    unsigned vA[2][2], vAn[2][2];
#pragma unroll
    for (int i = 0; i < 2; ++i) { int R, C; stage_rc(tid * 16 + i * 8192, R, C); RA[i] = R; CA[i] = C; const int Rb = Epi::PERM ? ((R & ~31) + perm32(R & 31)) : R; voffB[i] = (unsigned)(Rb * K + C) * 2u; }
    const size_t kstep = (size_t)(BK * 2);
    const size_t hstep = (size_t)HALF * K * 2;
    const size_t tstep = 2 * hstep;
    const unsigned ldsw = (unsigned)wid * 1024u;
    const int aoff = lds_byte(wr * 64 + fr, fq * 8), boff = lds_byte(wc * 32 + fr, fq * 8);
#define PG8_SA(b, h) (((b) * 2 + (h)) * HTB)
#define PG8_SB(b, h) ((4 + (b) * 2 + (h)) * HTB)
#define PG8_STAGE(bufoff, gbase, voff) do { _Pragma("unroll") for (int _i = 0; _i < 2; ++_i) \
        __builtin_amdgcn_global_load_lds((const unsigned*)((const char*)(gbase) + (voff)[_i]), (LAS unsigned*)(lds + (bufoff) + ldsw + _i * 8192), 16, 0, 0); } while (0)
#define PG8_STAGE2(bufoff, gbase, v0, v1) do { \
        __builtin_amdgcn_global_load_lds((const unsigned*)((const char*)(gbase) + (v0)), (LAS unsigned*)(lds + (bufoff) + ldsw), 16, 0, 0); \
        __builtin_amdgcn_global_load_lds((const unsigned*)((const char*)(gbase) + (v1)), (LAS unsigned*)(lds + (bufoff) + ldsw + 8192), 16, 0, 0); } while (0)
#define PG8_LDA(dst, b, h) do { _Pragma("unroll") for (int m = 0; m < 4; ++m) _Pragma("unroll") for (int k = 0; k < 2; ++k) dst[m][k] = *(const LAS bf16x8*)(lds + PG8_SA(b, h) + aoff + m * 2048 + k * 1024); } while (0)
#define PG8_LDB(dst, b, h) do { _Pragma("unroll") for (int n = 0; n < 2; ++n) _Pragma("unroll") for (int k = 0; k < 2; ++k) dst[n][k] = *(const LAS bf16x8*)(lds + PG8_SB(b, h) + boff + n * 2048 + k * 1024); } while (0)
#define PG8_MMA(ai, bj, At, Bt) do { __builtin_amdgcn_s_setprio(1); _Pragma("unroll") for (int m = 0; m < 4; ++m) _Pragma("unroll") for (int n = 0; n < 2; ++n) _Pragma("unroll") for (int k = 0; k < 2; ++k) \
        acc[ai][bj][m][n] = __builtin_amdgcn_mfma_f32_16x16x32_bf16(Bt[n][k], At[m][k], acc[ai][bj][m][n], 0, 0, 0); __builtin_amdgcn_s_setprio(0); } while (0)
#define PG8_WAIT_V(n) asm volatile("s_waitcnt vmcnt(" #n ")" ::: "memory")
#define PG8_WAIT_L(n) asm volatile("s_waitcnt lgkmcnt(" #n ")" ::: "memory")
#define PG8_BAR __builtin_amdgcn_s_barrier()
#define PG8_SCHED __builtin_amdgcn_sched_barrier(0)
#define PG8_AOFFS(dst, unit) do { _Pragma("unroll") for (int _h = 0; _h < 2; ++_h) _Pragma("unroll") for (int _i = 0; _i < 2; ++_i) \
        dst[_h][_i] = GATHER ? ((unsigned)S.arow(unit, _h * HALF + RA[_i]) * (unsigned)K + (unsigned)CA[_i]) * 2u : ((unsigned)(_h * HALF + RA[_i]) * (unsigned)K + (unsigned)CA[_i]) * 2u; } while (0)
    Unit cur, nxt; int ui = 0;
    if (!S.next(0, cur)) return;
    f32x4 acc[2][2][4][2];
#pragma unroll
    for (int a = 0; a < 2; ++a)
#pragma unroll
        for (int b = 0; b < 2; ++b)
#pragma unroll
            for (int m = 0; m < 4; ++m)
#pragma unroll
                for (int n = 0; n < 2; ++n) acc[a][b][m][n] = (f32x4){0.f, 0.f, 0.f, 0.f};
    bf16x8 At[4][2], B0[2][2], B1[2][2];
    const char* cA = GATHER ? (const char*)g.A : (const char*)g.A + (size_t)cur.pm * tstep; const char* cB = (const char*)g.Bt + (size_t)cur.pn * tstep;
    PG8_AOFFS(vA, cur);
    PG8_STAGE(PG8_SB(0, 0), cB, voffB); PG8_STAGE(PG8_SB(0, 1), cB + hstep, voffB); PG8_STAGE2(PG8_SA(0, 0), cA, vA[0][0], vA[0][1]); PG8_STAGE2(PG8_SA(0, 1), cA, vA[1][0], vA[1][1]);
    if (wr == 1) PG8_BAR;
    PG8_WAIT_V(2); PG8_BAR;
    PG8_STAGE(PG8_SB(1, 0), cB + kstep, voffB); PG8_STAGE2(PG8_SA(1, 0), cA + kstep, vA[0][0], vA[0][1]); PG8_STAGE(PG8_SB(1, 1), cB + hstep + kstep, voffB);
    PG8_WAIT_V(6); PG8_BAR;
    for (;;) {
        const bool has_next = S.next(ui + 1, nxt);
        const char* nA = GATHER ? (const char*)g.A : (has_next ? (const char*)g.A + (size_t)nxt.pm * tstep : cA); const char* nB = has_next ? (const char*)g.Bt + (size_t)nxt.pn * tstep : cB;
        if (has_next) { PG8_AOFFS(vAn, nxt); } else {
#pragma unroll
            for (int _h = 0; _h < 2; ++_h)
#pragma unroll
                for (int _i = 0; _i < 2; ++_i) vAn[_h][_i] = vA[_h][_i]; }
#pragma unroll 1
        for (int t = 0; t < nt; t += 2) {
            const bool last = (t == nt - 2);
            const char* a1 = cA + (size_t)(t + 1) * kstep;
            const char* a2 = last ? nA : cA + (size_t)(t + 2) * kstep; const char* b2 = last ? nB : cB + (size_t)(t + 2) * kstep;
            const char* a3 = a2 + kstep; const char* b3 = b2 + kstep;
            const unsigned x00 = last ? vAn[0][0] : vA[0][0], x01 = last ? vAn[0][1] : vA[0][1], x10 = last ? vAn[1][0] : vA[1][0], x11 = last ? vAn[1][1] : vA[1][1];
            PG8_LDB(B0, 0, 0); PG8_LDB(B1, 0, 1); PG8_SCHED; PG8_LDA(At, 0, 0); PG8_STAGE2(PG8_SA(1, 1), a1, vA[1][0], vA[1][1]);
            PG8_WAIT_V(8); PG8_WAIT_L(0); PG8_BAR; PG8_MMA(0, 0, At, B0); PG8_MMA(0, 1, At, B1); PG8_BAR; PG8_SCHED;
            PG8_LDA(At, 0, 1); PG8_STAGE(PG8_SB(0, 0), b2, voffB); PG8_STAGE(PG8_SB(0, 1), b2 + hstep, voffB); PG8_STAGE2(PG8_SA(0, 0), a2, x00, x01);
            PG8_WAIT_V(8); PG8_WAIT_L(0); PG8_BAR; PG8_MMA(1, 0, At, B0); PG8_MMA(1, 1, At, B1); PG8_BAR; PG8_SCHED;
            PG8_LDB(B0, 1, 0); PG8_LDB(B1, 1, 1); PG8_SCHED; PG8_LDA(At, 1, 0); PG8_STAGE2(PG8_SA(0, 1), a2, x10, x11);
            PG8_WAIT_V(8); PG8_WAIT_L(0); PG8_BAR; PG8_MMA(0, 0, At, B0); PG8_MMA(0, 1, At, B1); PG8_BAR; PG8_SCHED;
            PG8_LDA(At, 1, 1); PG8_STAGE(PG8_SB(1, 0), b3, voffB); PG8_STAGE(PG8_SB(1, 1), b3 + hstep, voffB); PG8_STAGE2(PG8_SA(1, 0), a3, x00, x01);
            PG8_WAIT_V(8); PG8_WAIT_L(0); PG8_BAR; PG8_MMA(1, 0, At, B0); PG8_MMA(1, 1, At, B1); PG8_BAR; PG8_SCHED;
        }
        if (wr == 0) PG8_BAR;
        E(acc, cur, wr, wc, fr, fq);
        if (!has_next) break;
#pragma unroll
        for (int a = 0; a < 2; ++a)
#pragma unroll
            for (int b = 0; b < 2; ++b)
#pragma unroll
                for (int m = 0; m < 4; ++m)
#pragma unroll
                    for (int n = 0; n < 2; ++n) acc[a][b][m][n] = (f32x4){0.f, 0.f, 0.f, 0.f};
        cur = nxt; cA = nA; cB = nB; ++ui;
#pragma unroll
        for (int _h = 0; _h < 2; ++_h)
#pragma unroll
            for (int _i = 0; _i < 2; ++_i) vA[_h][_i] = vAn[_h][_i];
        if (wr == 1) PG8_BAR;
    }
    PG8_WAIT_V(0);
    PG8_BAR;
#undef PG8_SA
#undef PG8_SB
#undef PG8_STAGE
#undef PG8_STAGE2
#undef PG8_LDA
#undef PG8_LDB
#undef PG8_MMA
#undef PG8_WAIT_V
#undef PG8_WAIT_L
#undef PG8_BAR
#undef PG8_SCHED
#undef PG8_AOFFS
}
}

struct SchedG1 { int G, c; __device__ __forceinline__ bool next(int i, Unit& u) const { const int L = i * G + c; if (L >= (T / 256) * 14) return false; u.pm = L / 14; u.pn = L % 14; u.e = 0; u.aux = 0; return true; }
    __device__ __forceinline__ int arow(const Unit&, int) const { return 0; } };
struct SchedG2 { int G, c, MT; __device__ __forceinline__ bool next(int i, Unit& u) const { const int L = i * G + c; if (L >= 16 * MT) return false; const int k = L / (MT * 4), rem = L % (MT * 4);
        u.pm = k * (T / 256) + (rem >> 2); u.pn = k * 4 + (rem & 3); u.e = k; u.aux = rem & 3; return true; }
    __device__ __forceinline__ int arow(const Unit&, int) const { return 0; } };
struct SchedMN { int G, c, MT, NT; __device__ __forceinline__ bool next(int i, Unit& u) const { const int L = i * G + c; if (L >= MT * NT) return false; u.pm = L / NT; u.pn = L % NT; u.e = 0; u.aux = 0; return true; }
    __device__ __forceinline__ int arow(const Unit&, int) const { return 0; } };

struct EpiBf16Plain {
    static constexpr bool PERM = true;
    bf16_t* O; int ldc; int coltile_mask;
    __device__ __forceinline__ void operator()(const f32x4 (&acc)[2][2][4][2], const Unit& u, int wr, int wc, int fr, int fq) const {
        const int row0 = u.pm * 256 + wr * 64 + fr, col0 = (u.pn & coltile_mask) * 256 + wc * 32 + 8 * fq;
#pragma unroll
        for (int ai = 0; ai < 2; ++ai)
#pragma unroll
            for (int m = 0; m < 4; ++m) { bf16_t* rowp = O + (size_t)(row0 + ai * 128 + m * 16) * ldc + col0;
#pragma unroll
                for (int bj = 0; bj < 2; ++bj) { const f32x4 v0 = acc[ai][bj][m][0], v1 = acc[ai][bj][m][1];
                    u32x4 w; w.x = pack2(v0[0], v0[1]); w.y = pack2(v0[2], v0[3]); w.z = pack2(v1[0], v1[1]); w.w = pack2(v1[2], v1[3]);
                    *(u32x4*)(rowp + bj * 128) = w; } }
    }
};
struct EpiP {
    static constexpr bool PERM = true;
    bf16_t* P; const float* ssq;
    __device__ __forceinline__ void operator()(const f32x4 (&acc)[2][2][4][2], const Unit& u, int wr, int wc, int fr, int fq) const {
        const int k = u.e; const int pmt = u.pm - k * (T / 256);
        const unsigned c00 = (unsigned)(u.aux * 256 + wc * 32 + 8 * fq);
        const unsigned base = (unsigned)pmt * (16u * 256u * 256u) + (unsigned)k * 64u;
#pragma unroll
        for (int ai = 0; ai < 2; ++ai)
#pragma unroll
            for (int m = 0; m < 4; ++m) { const int r = ai * 128 + wr * 64 + m * 16 + fr; float sc = 1.0f;
                if (k == 3) { const float* qp = ssq + (size_t)(pmt * 256 + r) * 4; sc = rsqrtf((qp[0] + qp[1] + qp[2] + qp[3]) * (1.0f / 256.0f) + RMS_EPS); }
#pragma unroll
                for (int bj = 0; bj < 2; ++bj) { const unsigned c0 = c00 + bj * 128; const unsigned s = c0 >> 6, wi = c0 & 63;
                    const f32x4 v0 = acc[ai][bj][m][0] * sc, v1 = acc[ai][bj][m][1] * sc;
                    u32x4 w; w.x = pack2(v0[0], v0[1]); w.y = pack2(v0[2], v0[3]); w.z = pack2(v1[0], v1[1]); w.w = pack2(v1[2], v1[3]);
                    *(u32x4*)(P + (base + (s * 256u + (unsigned)r) * 256u + wi)) = w; }
                asm volatile("" ::: "memory"); }
    }
};
struct EpiMerge {
    static constexpr bool PERM = false;
    const bf16_t* P; const float* bgp; bf16_t* Y;
    __device__ __forceinline__ void operator()(const f32x4 (&acc)[2][2][4][2], const Unit& u, int wr, int wc, int fr, int fq) const {
        const int s = u.pn;
        f32x4 bv[2][2];
#pragma unroll
        for (int bj = 0; bj < 2; ++bj)
#pragma unroll
            for (int n = 0; n < 2; ++n) bv[bj][n] = *(const f32x4*)(bgp + s * 256 + bj * 128 + wc * 32 + n * 16 + 4 * fq);
#pragma unroll
        for (int ai = 0; ai < 2; ++ai)
#pragma unroll
            for (int m = 0; m < 4; ++m) { const int r = ai * 128 + wr * 64 + m * 16 + fr;
                const bf16_t* pp = P + (((size_t)u.pm * 16 + s) * 256 + r) * 256 + wc * 16 + 4 * fq;
                f32x4 y = (f32x4){0.f, 0.f, 0.f, 0.f};
#pragma unroll
                for (int bj = 0; bj < 2; ++bj)
#pragma unroll
                    for (int n = 0; n < 2; ++n) { const int k = 2 * bj + n; const u32x2 pw = *(const u32x2*)(pp + k * 64);
                        const f32x4 g = acc[ai][bj][m][n] + bv[bj][n];
                        y[0] += sigmoidf_(g[0]) * __uint_as_float(pw.x << 16); y[1] += sigmoidf_(g[1]) * __uint_as_float(pw.x & 0xffff0000u);
                        y[2] += sigmoidf_(g[2]) * __uint_as_float(pw.y << 16); y[3] += sigmoidf_(g[3]) * __uint_as_float(pw.y & 0xffff0000u); }
                u32x2 w; w.x = pack2(y[0], y[1]); w.y = pack2(y[2], y[3]);
                *(u32x2*)(Y + (size_t)(u.pm * 256 + r) * D + s * 64 + wc * 16 + 4 * fq) = w; }
    }
};
struct EpiWo {
    static constexpr bool PERM = false;
    Ptrs P; int layer;
    __device__ __forceinline__ void operator()(const f32x4 (&acc)[2][2][4][2], const Unit& u, int wr, int wc, int fr, int fq) const {
        const int col0 = u.pn * 256 + wc * 32 + 4 * fq;
#pragma unroll
        for (int ai = 0; ai < 2; ++ai)
#pragma unroll
            for (int m = 0; m < 4; ++m) { const int row = u.pm * 256 + ai * 128 + wr * 64 + m * 16 + fr;
                float* lp = P.latrow(row) + col0; const float* g1 = P.mod(layer, row_modidx(row)) + 2048 + col0;
#pragma unroll
                for (int bj = 0; bj < 2; ++bj)
#pragma unroll
                    for (int n = 0; n < 2; ++n) { const f32x4 x = *(const f32x4*)(lp + bj * 128 + n * 16); const f32x4 g = *(const f32x4*)(g1 + bj * 128 + n * 16);
                        *(f32x4*)(lp + bj * 128 + n * 16) = x * ALPHA + g * acc[ai][bj][m][n]; } }
    }
};
struct EpiFfn1 {
    static constexpr bool PERM = false;
    bf16_t* H;
    __device__ __forceinline__ void operator()(const f32x4 (&acc)[2][2][4][2], const Unit& u, int wr, int wc, int fr, int fq) const {
        const int pnn = u.pn & 3;
#pragma unroll
        for (int ai = 0; ai < 2; ++ai)
#pragma unroll
            for (int m = 0; m < 4; ++m) { const int pos = u.pm * 256 + ai * 128 + wr * 64 + m * 16 + fr;
#pragma unroll
                for (int bj = 0; bj < 2; ++bj) { const f32x4 a = acc[ai][bj][m][0], b = acc[ai][bj][m][1];
                    u32x2 w; w.x = pack2(siluf_(a[0]) * b[0], siluf_(a[1]) * b[1]); w.y = pack2(siluf_(a[2]) * b[2], siluf_(a[3]) * b[3]);
                    *(u32x2*)(H + (size_t)pos * 512 + pnn * 128 + bj * 64 + wc * 16 + 4 * fq) = w; } }
    }
};

template <class SrcFn>
__device__ __forceinline__ void conv_tile(int tid, LAS float* tile  , bf16_t* dst, int ldd, int n0, int k0, const SrcFn& src) {
#pragma unroll
    for (int i = 0; i < 8; ++i) { const int kk = (tid >> 6) + 8 * i, j = tid & 63; tile[kk * 65 + j] = src(k0 + kk, n0 + j); }
    __syncthreads();
    { const int jj = tid >> 3, kq = tid & 7; float v[8];
#pragma unroll
      for (int i = 0; i < 8; ++i) v[i] = tile[(8 * kq + i) * 65 + jj];
      u32x4 w; w.x = pack2(v[0], v[1]); w.y = pack2(v[2], v[3]); w.z = pack2(v[4], v[5]); w.w = pack2(v[6], v[7]);
      *(u32x4*)(dst + (size_t)(n0 + jj) * ldd + k0 + 8 * kq) = w; }
    __syncthreads();
}
constexpr int NCONV_NE = 56 * 16 + 64 * 16 + 64 * 4 + 16 * 16;
constexpr int NCONV_EX = NE * (16 * 16 + 16 * 8);
__device__ __forceinline__ int gate_srccol(int np) { const int s = np >> 8, bj = (np >> 7) & 1, wc = (np >> 5) & 3, n = (np >> 4) & 1, fqe = np & 15; return (2 * bj + n) * 1024 + 64 * s + 16 * wc + fqe; }
__device__ __forceinline__ void conv_unit_ne(const Ptrs P, int l, int t, LAS float* tile) {
    unsigned char* ws = P.ws;
    if (t < 896) { const int nt = t >> 4, kt = t & 15; const float* src = P.inp(I_WIN) + (size_t)l * D * INC;
        conv_tile(P.tid, tile, (bf16_t*)(ws + WS_WIN), D, nt * 64, kt * 64, [=](int k, int n) { return src[(size_t)k * INC + n]; });
    } else if (t < 896 + 1024) { t -= 896; const int nt = t >> 4, kt = t & 15; const float* src = P.inp(I_WGATE) + (size_t)l * D * 4096;
        conv_tile(P.tid, tile, (bf16_t*)(ws + WS_WG), D, nt * 64, kt * 64, [=](int k, int n) { return src[(size_t)k * 4096 + gate_srccol(n)]; });
        if (kt == 0 && P.tid < 64) { const int np = nt * 64 + P.tid; ((float*)(ws + WS_BGP))[np] = P.inp(I_BGATE)[(size_t)l * 4096 + gate_srccol(np)]; }
    } else if (t < 896 + 1024 + 256) { t -= 1920; const int nt = t >> 2, kt = t & 3; const int kb = nt >> 4;
        const float* src = P.inp(I_WBR) + ((size_t)l * 4 + kb) * 256 * 1024; const float* ng = P.inp(I_SSDNG) + l * 256; const bool sc = (kb == 3);
        conv_tile(P.tid, tile, (bf16_t*)(ws + WS_WBR), 256, nt * 64, kt * 64, [=](int k, int n) { const float v = src[(size_t)k * 1024 + (n & 1023)]; return sc ? v * ng[k] : v; });
    } else { t -= 2176; const int nt = t >> 4, kt = t & 15; const float* src = P.inp(I_WO) + (size_t)l * D * D;
        conv_tile(P.tid, tile, (bf16_t*)(ws + WS_WO), D, nt * 64, kt * 64, [=](int k, int n) { return src[(size_t)k * D + n]; });
    }
}
__device__ __forceinline__ void conv_unit_ex(const Ptrs P, int l, int t, LAS float* tile) {
    unsigned char* ws = P.ws;
    const int e = t / 384; t -= e * 384;
    if (t < 256) { const int nt = t >> 4, kt = t & 15;
        const float* s1 = P.inp(I_WE1) + ((size_t)l * NE + e) * 1024 * 512; const float* s3 = P.inp(I_WE3) + ((size_t)l * NE + e) * 1024 * 512;
        conv_tile(P.tid, tile, (bf16_t*)(ws + WS_BIG + BIG_W13) + (size_t)e * 1024 * 1024, 1024, nt * 64, kt * 64, [=](int k, int n) {
            const int pn = n >> 8, bj = (n >> 7) & 1, wc = (n >> 5) & 3, nn = (n >> 4) & 1, fqe = n & 15; const int ch = 128 * pn + 64 * bj + 16 * wc + fqe;
            return (nn ? s3 : s1)[(size_t)k * 512 + ch]; });
    } else { t -= 256; const int nt = t >> 3, kt = t & 7; const float* src = P.inp(I_WE2) + ((size_t)l * NE + e) * 512 * 1024;
        conv_tile(P.tid, tile, (bf16_t*)(ws + WS_BIG + BIG_W2) + (size_t)e * 1024 * 512, 512, nt * 64, kt * 64, [=](int k, int n) { return src[(size_t)k * 1024 + n]; });
    }
}

struct RowV { f32x4 v[4]; };
__device__ __forceinline__ void row_load(RowV& r, const float* p, int lane) {
#pragma unroll
    for (int i = 0; i < 4; ++i) r.v[i] = *(const f32x4*)(p + i * 256 + lane * 4);
}
__device__ __forceinline__ void row_store(const RowV& r, float* p, int lane) {
#pragma unroll
    for (int i = 0; i < 4; ++i) *(f32x4*)(p + i * 256 + lane * 4) = r.v[i];
}
__device__ __forceinline__ void row_layernorm(RowV& r, const float* g, const float* b, int lane) {
    float s = 0.f;
#pragma unroll
    for (int i = 0; i < 4; ++i) s += r.v[i][0] + r.v[i][1] + r.v[i][2] + r.v[i][3];
    const float mu = wave_sum(s) * (1.0f / 1024.0f);
    float q = 0.f;
#pragma unroll
    for (int i = 0; i < 4; ++i) { const f32x4 d = r.v[i] - mu; q += d[0] * d[0] + d[1] * d[1] + d[2] * d[2] + d[3] * d[3]; }
    const float rstd = rsqrtf(wave_sum(q) * (1.0f / 1024.0f) + LN_EPS);
#pragma unroll
    for (int i = 0; i < 4; ++i) { const f32x4 gg = *(const f32x4*)(g + i * 256 + lane * 4), bb = *(const f32x4*)(b + i * 256 + lane * 4); r.v[i] = (r.v[i] - mu) * rstd * gg + bb; }
}
__device__ __forceinline__ void row_modulate(const RowV& r, RowV& h, const float* sh, const float* sc, int lane) {
#pragma unroll
    for (int i = 0; i < 4; ++i) { const f32x4 a = *(const f32x4*)(sc + i * 256 + lane * 4), b = *(const f32x4*)(sh + i * 256 + lane * 4); h.v[i] = r.v[i] * (a + 1.0f) + b; }
}
__device__ __forceinline__ void row_store_bf16(const RowV& h, bf16_t* p, int lane) {
#pragma unroll
    for (int i = 0; i < 4; ++i) { u32x2 w; w.x = pack2(h.v[i][0], h.v[i][1]); w.y = pack2(h.v[i][2], h.v[i][3]); *(u32x2*)(p + i * 256 + lane * 4) = w; }
}
__device__ __forceinline__ void row_dt(const RowV& h, const LAS float* wdt, float* dtout, int lane) {
    float a[8];
#pragma unroll
    for (int j = 0; j < 8; ++j) a[j] = 0.f;
#pragma unroll
    for (int i = 0; i < 4; ++i)
#pragma unroll
        for (int e = 0; e < 4; ++e) { const int k = i * 256 + lane * 4 + e; const float hv = h.v[i][e];
            const f32x4 w0 = *(const LAS f32x4*)(wdt + k * 8), w1 = *(const LAS f32x4*)(wdt + k * 8 + 4);
            a[0] += hv * w0[0]; a[1] += hv * w0[1]; a[2] += hv * w0[2]; a[3] += hv * w0[3]; a[4] += hv * w1[0]; a[5] += hv * w1[1]; a[6] += hv * w1[2]; a[7] += hv * w1[3]; }
#pragma unroll
    for (int j = 0; j < 8; ++j) a[j] = wave_sum(a[j]);
    if (lane == 0) { *(f32x4*)dtout = (f32x4){a[0], a[1], a[2], a[3]}; *(f32x4*)(dtout + 4) = (f32x4){a[4], a[5], a[6], a[7]}; }
}
__device__ __forceinline__ void load_wdt(const Ptrs P, int l, LAS float* wdt) {
    const float* src = P.inp(I_WIN) + (size_t)l * D * INC + UC;
    for (int i = P.tid; i < 1024 * 8; i += 512) wdt[i] = src[(size_t)(i >> 3) * INC + (i & 7)];
    __syncthreads();
}

__device__ __forceinline__ void phase_pa(const Ptrs P, LAS unsigned char* lds) {
    const int tid = P.tid, wid = tid >> 6, lane = tid & 63, G = P.G;
    const int NU_MOD = 2 * 96, NU_H2 = 8448 / 8, NU_LB = 1;
    const int NU = NU_MOD + NU_H2 + NU_LB + NCONV_NE;
    for (int u = P.bid; u < NU; u += G) {
        if (u < NU_MOD) {
            const int l = u / 96, cb = u % 96;
            LAS float* sc = (LAS float*)lds; LAS float* red = sc + 9 * 1024;
            for (int i = tid; i < 9 * 1024; i += 512) { const int r = i >> 10, k = i & 1023; const float v = r < 8 ? P.inp(I_C)[r * 1024 + k] : P.inp(I_CCTX)[k]; sc[i] = v / (1.0f + expf(-v)); }
            __syncthreads();
            const int col = cb * 64 + lane; const float* w = P.inp(I_WADA) + (size_t)l * D * 6144 + col;
            float acc[9];
#pragma unroll
            for (int r = 0; r < 9; ++r) acc[r] = 0.f;
            for (int k = wid * 128; k < wid * 128 + 128; ++k) { const float wv = w[(size_t)k * 6144];
#pragma unroll
                for (int r = 0; r < 9; ++r) acc[r] += sc[r * 1024 + k] * wv; }
#pragma unroll
            for (int r = 0; r < 9; ++r) red[(wid * 9 + r) * 64 + lane] = acc[r];
            __syncthreads();
            for (int i = tid; i < 9 * 64; i += 512) { const int r = i >> 6, c = i & 63; float s = P.inp(I_BADA)[(size_t)l * 6144 + cb * 64 + c];
#pragma unroll
                for (int w8 = 0; w8 < 8; ++w8) s += red[(w8 * 9 + r) * 64 + c];
                P.mod(l, r)[cb * 64 + c] = s; }
            __syncthreads();
        } else if (u < NU_MOD + NU_H2) {
            const int rho = (u - NU_MOD) * 8 + wid;
            const int l = (rho >= 4096 && rho < 8192) ? 1 : 0; const int L = rho < 8192 ? 4096 : 256; const int i = rho < 8192 ? (rho & 4095) : (rho - 8192);
            float featv = 0.f;
            if (lane == 0) featv = (float)((double)i / (double)(L - 1));
            else if (lane < 33) { const int j = (lane - 1) & 15; const double band = 1e-4 + (double)j * ((15.0 - 1e-4) / 15.0);
                const double ang = (2.0 * 3.14159265358979323846 / (double)L) * (double)i * band; featv = lane < 17 ? (float)cos(ang) : (float)(-sin(ang)); }
            float z1 = P.inp(I_HYB1)[l * 64 + lane];
            for (int m = 0; m < 33; ++m) z1 += __shfl(featv, m) * P.inp(I_HYW1)[((size_t)l * 33 + m) * 64 + lane];
            const float h1 = sinf(P.inp(I_HYF1)[l * 64 + lane] * z1);
            float z2 = P.inp(I_HYB2)[l * 64 + lane];
            for (int m = 0; m < 64; ++m) z2 += __shfl(h1, m) * P.inp(I_HYW2)[((size_t)l * 64 + m) * 64 + lane];
            ((float*)(P.ws + WS_H2TAB))[(size_t)rho * 64 + lane] = sinf(P.inp(I_HYF2)[l * 64 + lane] * z2);
        } else if (u < NU_MOD + NU_H2 + NU_LB) {
            for (int i = tid; i < 4096; i += 512) { const double a = -2.0 * 3.14159265358979323846 * (double)i / 8192.0; ((float*)(P.ws + WS_TW))[2 * i] = (float)cos(a); ((float*)(P.ws + WS_TW))[2 * i + 1] = (float)sin(a); }
            for (int i = tid; i < 1024; i += 512) { const int d = i >> 9, l = (i >> 8) & 1, c = i & 255;
                const float l0 = P.inp(I_HGLB)[d * 512 + c], l1 = P.inp(I_HGLB)[d * 512 + 256 + c];
                ((float*)(P.ws + WS_LB))[i] = l == 0 ? 0.0f : 1.0f / (1.0f + expf(l0 - l1)); }
        } else {
            conv_unit_ne(P, 0, u - (NU_MOD + NU_H2 + NU_LB), (LAS float*)lds);
        }
    }
}

__device__ __forceinline__ void emit_rows_init(const Ptrs P, LAS float* wdt);
__device__ __forceinline__ void phase_pb(const Ptrs P, LAS unsigned char* lds) {
    const int tid = P.tid, G = P.G;
    for (int u = P.bid; u < 132; u += G) {
        const int tab = u < 64 ? 0 : (u < 128 ? 1 : 2); const int ib = tab == 0 ? u : (tab == 1 ? u - 64 : u - 128);
        const int l = tab == 1 ? 1 : 0; const int L = tab == 2 ? 256 : 4096; const int rho0 = (tab == 0 ? 0 : (tab == 1 ? 4096 : 8192)) + ib * 64;
        LAS float* h2 = (LAS float*)lds;
        for (int i = tid; i < 64 * 64; i += 512) h2[i] = ((const float*)(P.ws + WS_H2TAB))[(size_t)rho0 * 64 + i];
        __syncthreads();
        const int o = tid, c = tid & 255, dir = tid >> 8;
        float w3[64];
#pragma unroll
        for (int j = 0; j < 64; ++j) w3[j] = P.inp(I_HYW3)[((size_t)l * 64 + j) * 512 + o];
        const float dec = fabsf(P.inp(I_HYDEC)[l * 256 + c]);
        float* filt = tab == 2 ? (float*)(P.ws + WS_FILTC) : (float*)(P.ws + WS_FILT) + (size_t)l * 8192 * 256;
        const int L2 = 2 * L; float part = 0.f;
        for (int r = 0; r < 64; ++r) { const int i = ib * 64 + r; float s = 0.f;
#pragma unroll
            for (int j = 0; j < 64; ++j) s += h2[r * 64 + j] * w3[j];
            const float t = (float)i / (float)(L - 1); s *= expf(-t * dec);
            if (dir == 0) { filt[(size_t)i * 256 + c] = s; part += fabsf(s); }
            else if (i == 0) filt[(size_t)L * 256 + c] = 0.f;
            else { filt[(size_t)(L2 - i) * 256 + c] = s; part += fabsf(s); } }
        ((float*)(P.ws + WS_PART))[((size_t)tab * 64 + ib) * 512 + o] = part;
        __syncthreads();
    }
    emit_rows_init(P, (LAS float*)(lds + 32768));
}
__device__ __forceinline__ float hy_norm(const Ptrs P, int tab, int c) {
    const float* part = (const float*)(P.ws + WS_PART) + (size_t)tab * 64 * 512; const int nb = tab == 2 ? 4 : 64; float s = 0.f;
    for (int b = 0; b < nb; ++b) s += part[b * 512 + c] + part[b * 512 + 256 + c];
    return s;
}

__device__ __forceinline__ void emit_rows_init(const Ptrs P, LAS float* wdt) {
    const int tid = P.tid, wid = tid >> 6, lane = tid & 63, G = P.G;
    load_wdt(P, 0, wdt);
    for (int u = P.bid; u < T / 8; u += G) {
        const int row = u * 8 + wid; RowV r;
        if (row < NLAT) { row_load(r, P.inp(I_X) + (size_t)row * D, lane);
            const int t = row & 4095; const float prow = (float)(t >> 6), pcol = (float)(t & 63);
#pragma unroll
            for (int i = 0; i < 4; ++i)
#pragma unroll
                for (int e = 0; e < 4; ++e) { const int idx = i * 256 + lane * 4 + e; const int f = idx & 511, ii = f & 255; const float pos = (idx >> 9) ? pcol : prow;
                    const float om = expf(-9.210340371976184f * (float)ii * (1.0f / 256.0f)); const float a = pos * om; r.v[i][e] += (f < 256) ? sinf(a) : cosf(a); }
        } else row_load(r, P.inp(I_CTX) + (size_t)(row - NLAT) * D, lane);
        row_store(r, P.latrow(row), lane);
        const float* m = P.mod(0, row_modidx(row)); RowV h; row_modulate(r, h, m, m + 1024, lane);
        row_store_bf16(h, (bf16_t*)(P.ws + WS_HBUF) + (size_t)row * D, lane);
        row_dt(h, wdt, (float*)(P.ws + WS_DT) + (size_t)row * 8, lane);
    }
}

__device__ __forceinline__ void phase_g1(const Ptrs P, LAS unsigned char* lds) {
    pg8::Gemm g{(const bf16_t*)(P.ws + WS_HBUF), (const bf16_t*)(P.ws + WS_WIN), D};
    EpiBf16Plain E{(bf16_t*)(P.ws + WS_BIG + BIG_U), UC, 0xffff};
    SchedG1 S{P.G, P.bid};
    pg8::gemm_phase<EpiBf16Plain, SchedG1, false>(P.tid, lds, g, S, E);
}

constexpr int NCHK = 34;
__device__ __forceinline__ int chunk_row0(int b, int pc) { return pc < 2 ? NLAT + b * CTXL + pc * 128 : b * SEQ + (pc - 2) * 128; }
__device__ __forceinline__ int chunk_at(int dir, int q) { return dir == 0 ? q : (q < 2 ? 1 - q : 35 - q); }
__device__ __forceinline__ int sidx(int kind, int b, int h, int dir, int pc) { return (((kind * 8 + b) * 4 + h) * 2 + dir) * NCHK + pc; }
__device__ __forceinline__ bf16x8 pack8(const float (&v)[8]) { u32x4 w; w.x = pack2(v[0], v[1]); w.y = pack2(v[2], v[3]); w.z = pack2(v[4], v[5]); w.w = pack2(v[6], v[7]); return __builtin_bit_cast(bf16x8, w); }
__device__ __forceinline__ float zero_f() { float z = 0.f; asm volatile("" : "+v"(z)); return z; }
__device__ __forceinline__ float softplusf_(float x) { return x > 20.f ? x : log1pf(__expf(x)); }
__device__ __forceinline__ float wave_incl_scan(float v, int lane) {
#pragma unroll
    for (int d = 1; d < 64; d <<= 1) { const float t = __shfl_up(v, d); if (lane >= d) v += t; }
    return v;
}

__device__ __forceinline__ void conv3_silu8(const bf16_t* U, int row, int col0, const float* w, int ncol, int wcol0, const float* bias, float (&out)[8]) {
    const bool hp = row_has_prev(row), hn = row_has_next(row);
    const bf16x8 c = *(const bf16x8*)(U + (size_t)row * UC + col0);
    const bf16x8 p = *(const bf16x8*)(U + (size_t)(hp ? row - 1 : row) * UC + col0), n = *(const bf16x8*)(U + (size_t)(hn ? row + 1 : row) * UC + col0);
    const float mp = hp ? 1.0f : 0.0f, mn = hn ? 1.0f : 0.0f;
#pragma unroll
    for (int h4 = 0; h4 < 2; ++h4) { const f32x4 w0 = *(const f32x4*)(w + wcol0 + 4 * h4), w1 = *(const f32x4*)(w + ncol + wcol0 + 4 * h4), w2 = *(const f32x4*)(w + 2 * ncol + wcol0 + 4 * h4), bb = *(const f32x4*)(bias + wcol0 + 4 * h4);
#pragma unroll
        for (int e = 0; e < 4; ++e) { const int i = 4 * h4 + e; const float v = bf2f((bf16_t)c[i]) * w1[e] + mp * bf2f((bf16_t)p[i]) * w0[e] + mn * bf2f((bf16_t)n[i]) * w2[e] + bb[e]; out[i] = siluf_(v); } }
}

__device__ __forceinline__ void hgrn_pass1(const Ptrs P, int l, int unit, LAS unsigned char* lds) {
    const int tid = P.tid, lane = tid & 63, wid = tid >> 6, fr = lane & 15, fq = lane >> 4;
    const int pc = unit % NCHK; int r_ = unit / NCHK; const int dir = r_ & 1; r_ >>= 1; const int h = r_ & 3; const int b = r_ >> 2;
    const int row0 = chunk_row0(b, pc); const int si = sidx(0, b, h, dir, pc);
    const bf16_t* U = (const bf16_t*)(P.ws + WS_BIG + BIG_U);
    LAS bf16_t* KT = (LAS bf16_t*)lds; LAS bf16_t* VT = KT + 64 * 136; LAS float* segtot = (LAS float*)(VT + 64 * 136);
    const int ch = lane, seg = wid;
    const float lbv = ((const float*)(P.ws + WS_LB))[(dir * 2 + l) * 256 + h * 64 + ch];
    float c[16], kk[16]; unsigned vb[16]; float run = 0.f;
#pragma unroll
    for (int j = 0; j < 16; ++j) { const int tau = 16 * seg + j; const int p = dir ? 127 - tau : tau; const bf16_t* ur = U + (size_t)(row0 + p) * UC;
        const float f = lbv + (1.0f - lbv) * sigmoidf_(bf2f(ur[1792 + dir * 256 + h * 64 + ch])); run += __logf(f); c[j] = run; kk[j] = 1.0f - f; vb[j] = ur[2304 + h * 64 + ch]; }
    segtot[seg * 64 + ch] = run; __syncthreads();
    float off = 0.f, tot = 0.f;
#pragma unroll
    for (int s = 0; s < 8; ++s) { const float v = segtot[s * 64 + ch]; tot += v; off += (s < seg) ? v : 0.f; }
    { u32x4 w0, w1, v0, v1;
      w0.x = pack2(kk[0] * __expf(tot - off - c[0]), kk[1] * __expf(tot - off - c[1])); w0.y = pack2(kk[2] * __expf(tot - off - c[2]), kk[3] * __expf(tot - off - c[3]));
      w0.z = pack2(kk[4] * __expf(tot - off - c[4]), kk[5] * __expf(tot - off - c[5])); w0.w = pack2(kk[6] * __expf(tot - off - c[6]), kk[7] * __expf(tot - off - c[7]));
      w1.x = pack2(kk[8] * __expf(tot - off - c[8]), kk[9] * __expf(tot - off - c[9])); w1.y = pack2(kk[10] * __expf(tot - off - c[10]), kk[11] * __expf(tot - off - c[11]));
      w1.z = pack2(kk[12] * __expf(tot - off - c[12]), kk[13] * __expf(tot - off - c[13])); w1.w = pack2(kk[14] * __expf(tot - off - c[14]), kk[15] * __expf(tot - off - c[15]));
      v0.x = vb[0] | (vb[1] << 16); v0.y = vb[2] | (vb[3] << 16); v0.z = vb[4] | (vb[5] << 16); v0.w = vb[6] | (vb[7] << 16);
      v1.x = vb[8] | (vb[9] << 16); v1.y = vb[10] | (vb[11] << 16); v1.z = vb[12] | (vb[13] << 16); v1.w = vb[14] | (vb[15] << 16);
      *(LAS u32x4*)(KT + ch * 136 + 16 * seg) = w0; *(LAS u32x4*)(KT + ch * 136 + 16 * seg + 8) = w1;
      *(LAS u32x4*)(VT + ch * 136 + 16 * seg) = v0; *(LAS u32x4*)(VT + ch * 136 + 16 * seg + 8) = v1; }
    if (seg == 0) ((float*)(P.ws + WS_DEC))[(size_t)si * 64 + ch] = __expf(tot);
    __syncthreads();
    const int mt = wid >> 1, nt0 = (wid & 1) * 2;
    f32x4 acc[2]; acc[0] = (f32x4){0.f, 0.f, 0.f, 0.f}; acc[1] = acc[0];
#pragma unroll
    for (int ks = 0; ks < 4; ++ks) { const bf16x8 a = *(const LAS bf16x8*)(KT + (16 * mt + fr) * 136 + 32 * ks + 8 * fq);
#pragma unroll
        for (int n = 0; n < 2; ++n) { const bf16x8 bb = *(const LAS bf16x8*)(VT + (16 * (nt0 + n) + fr) * 136 + 32 * ks + 8 * fq); acc[n] = __builtin_amdgcn_mfma_f32_16x16x32_bf16(a, bb, acc[n], 0, 0, 0); } }
    float* S = (float*)(P.ws + WS_BIG + BIG_STATE) + (size_t)si * 4096;
#pragma unroll
    for (int n = 0; n < 2; ++n)
#pragma unroll
        for (int r = 0; r < 4; ++r) S[(16 * mt + 4 * fq + r) * 64 + 16 * (nt0 + n) + fr] = acc[n][r];
    __syncthreads();
}

__device__ __forceinline__ void ssd_dt_cum(const Ptrs P, int l, int row0, int dir, int h, int wid, int lane, LAS float* cum, LAS float* dtv) {
    if (wid == 0) {
        const float Aneg = -__expf(P.inp(I_SSDALOG)[(l * 2 + dir) * 4 + h]); const float dtb = P.inp(I_SSDDTB)[(l * 2 + dir) * 4 + h]; const float* DT = (const float*)(P.ws + WS_DT);
        const int t0 = 2 * lane, p0 = dir ? 127 - t0 : t0, p1 = dir ? 126 - t0 : t0 + 1;
        const float d0 = softplusf_(DT[(size_t)(row0 + p0) * 8 + dir * 4 + h] + dtb), d1 = softplusf_(DT[(size_t)(row0 + p1) * 8 + dir * 4 + h] + dtb);
        const float a0 = Aneg * d0, a1 = Aneg * d1; const float inc = wave_incl_scan(a0 + a1, lane);
        cum[t0] = inc - a1; cum[t0 + 1] = inc; dtv[t0] = d0; dtv[t0 + 1] = d1;
    }
}

__device__ __forceinline__ void ssd_pass1(const Ptrs P, int l, int unit, LAS unsigned char* lds) {
    const int tid = P.tid, lane = tid & 63, wid = tid >> 6, fr = lane & 15, fq = lane >> 4;
    const int pc = unit % NCHK; int r_ = unit / NCHK; const int dir = r_ & 1; r_ >>= 1; const int h = r_ & 3; const int b = r_ >> 2; const int g = h >> 1;
    const int row0 = chunk_row0(b, pc); const int si = sidx(1, b, h, dir, pc);
    const bf16_t* U = (const bf16_t*)(P.ws + WS_BIG + BIG_U);
    const float* scw = P.inp(I_SSDCW) + (size_t)l * 3 * 512; const float* scb = P.inp(I_SSDCB) + l * 512;
    LAS bf16_t* XT = (LAS bf16_t*)lds; LAS bf16_t* BT = XT + 64 * 136; LAS float* cum = (LAS float*)(BT + 64 * 136); LAS float* dtv = cum + 128;
    ssd_dt_cum(P, l, row0, dir, h, wid, lane, cum, dtv);
    __syncthreads();
    const float tot = cum[127]; const int ch = lane, seg = wid;
    { float xv[16], bv[16]; const float xb = scb[h * 64 + ch], bb_ = scb[256 + g * 64 + ch];
#pragma unroll
      for (int j = 0; j < 16; ++j) { const int tau = 16 * seg + j; const int row = row0 + (dir ? 127 - tau : tau);
          xv[j] = siluf_(conv3_u(U, row, 3072 + h * 64 + ch, scw, 512, h * 64 + ch) + xb) * dtv[tau] * __expf(tot - cum[tau]);
          bv[j] = siluf_(conv3_u(U, row, 3072 + 256 + g * 64 + ch, scw, 512, 256 + g * 64 + ch) + bb_); }
      u32x4 w0, w1, v0, v1;
      w0.x = pack2(xv[0], xv[1]); w0.y = pack2(xv[2], xv[3]); w0.z = pack2(xv[4], xv[5]); w0.w = pack2(xv[6], xv[7]); w1.x = pack2(xv[8], xv[9]); w1.y = pack2(xv[10], xv[11]); w1.z = pack2(xv[12], xv[13]); w1.w = pack2(xv[14], xv[15]);
      v0.x = pack2(bv[0], bv[1]); v0.y = pack2(bv[2], bv[3]); v0.z = pack2(bv[4], bv[5]); v0.w = pack2(bv[6], bv[7]); v1.x = pack2(bv[8], bv[9]); v1.y = pack2(bv[10], bv[11]); v1.z = pack2(bv[12], bv[13]); v1.w = pack2(bv[14], bv[15]);
      *(LAS u32x4*)(XT + ch * 136 + 16 * seg) = w0; *(LAS u32x4*)(XT + ch * 136 + 16 * seg + 8) = w1;
      *(LAS u32x4*)(BT + ch * 136 + 16 * seg) = v0; *(LAS u32x4*)(BT + ch * 136 + 16 * seg + 8) = v1; }
    if (tid == 0) ((float*)(P.ws + WS_DEC))[(size_t)si * 64] = __expf(tot);
    __syncthreads();
    const int mt = wid >> 1, nt0 = (wid & 1) * 2;
    f32x4 acc[2]; acc[0] = (f32x4){0.f, 0.f, 0.f, 0.f}; acc[1] = acc[0];
#pragma unroll
    for (int ks = 0; ks < 4; ++ks) { const bf16x8 a = *(const LAS bf16x8*)(XT + (16 * mt + fr) * 136 + 32 * ks + 8 * fq);
#pragma unroll
        for (int n = 0; n < 2; ++n) { const bf16x8 bb = *(const LAS bf16x8*)(BT + (16 * (nt0 + n) + fr) * 136 + 32 * ks + 8 * fq); acc[n] = __builtin_amdgcn_mfma_f32_16x16x32_bf16(a, bb, acc[n], 0, 0, 0); } }
    float* S = (float*)(P.ws + WS_BIG + BIG_STATE) + (size_t)si * 4096;
#pragma unroll
    for (int n = 0; n < 2; ++n)
#pragma unroll
        for (int r = 0; r < 4; ++r) S[(16 * mt + 4 * fq + r) * 64 + 16 * (nt0 + n) + fr] = acc[n][r];
    __syncthreads();
}

__device__ __forceinline__ void scan_pass2(const Ptrs P, int unit) {
    const int seq = unit >> 1, half = unit & 1; const int kind = seq >> 6, b = (seq >> 3) & 7, h = (seq >> 1) & 3, dir = seq & 1;
    const int e0 = half * 2048 + P.tid * 4; const int base = sidx(kind, b, h, dir, 0);
    float* ST = (float*)(P.ws + WS_BIG + BIG_STATE); const float* DEC = (const float*)(P.ws + WS_DEC);
    const float zf = zero_f(); f32x4 run = (f32x4){zf, zf, zf, zf};
    for (int q = 0; q < NCHK; ++q) { const int pc = chunk_at(dir, q); float* S = ST + (size_t)(base + pc) * 4096 + e0;
        const f32x4 loc = *(const f32x4*)S; const float d = DEC[(size_t)(base + pc) * 64 + (kind == 0 ? (e0 >> 6) : 0)];
        *(f32x4*)S = run; run = run * d + loc; }
}

__device__ __forceinline__ void hgrn_pass3(const Ptrs P, int l, int unit, LAS unsigned char* lds) {
    const int tid = P.tid, lane = tid & 63, wid = tid >> 6, fr = lane & 15, fq = lane >> 4;
    const int pc = unit % NCHK; const int r_ = unit / NCHK; const int h = r_ & 3; const int b = r_ >> 2;
    const int row0 = chunk_row0(b, pc);
    const bf16_t* U = (const bf16_t*)(P.ws + WS_BIG + BIG_U);
    LAS bf16_t* QH = (LAS bf16_t*)lds; LAS bf16_t* KT2 = QH + 128 * 72; LAS bf16_t* VT = KT2 + 128 * 72; LAS bf16_t* ST = VT + 64 * 136;
    LAS float* EE = (LAS float*)(ST + 64 * 72); LAS float* ET = EE + 512; LAS bf16_t* PW = (LAS bf16_t*)(ET + 512); LAS float* BH = (LAS float*)PW; LAS float* OUT = (LAS float*)(PW + 8 * 16 * 136);
    for (int dir = 0; dir < 2; ++dir) {
        {
            const int ch = lane, seg = wid; const float lbv = ((const float*)(P.ws + WS_LB))[(dir * 2 + l) * 256 + h * 64 + ch]; float run = 0.f; unsigned vb[16];
#pragma unroll
            for (int j = 0; j < 16; ++j) { const int tau = 16 * seg + j; const int p = dir ? 127 - tau : tau; const bf16_t* ur = U + (size_t)(row0 + p) * UC;
                const float f = lbv + (1.0f - lbv) * sigmoidf_(bf2f(ur[1792 + dir * 256 + h * 64 + ch])); run += __logf(f); BH[tau * 64 + ch] = run; vb[j] = ur[2304 + h * 64 + ch]; }
            ET[seg * 64 + ch] = run;
            u32x4 v0, v1; v0.x = vb[0] | (vb[1] << 16); v0.y = vb[2] | (vb[3] << 16); v0.z = vb[4] | (vb[5] << 16); v0.w = vb[6] | (vb[7] << 16);
            v1.x = vb[8] | (vb[9] << 16); v1.y = vb[10] | (vb[11] << 16); v1.z = vb[12] | (vb[13] << 16); v1.w = vb[14] | (vb[15] << 16);
            *(LAS u32x4*)(VT + ch * 136 + 16 * seg) = v0; *(LAS u32x4*)(VT + ch * 136 + 16 * seg + 8) = v1;
            const float* S = (const float*)(P.ws + WS_BIG + BIG_STATE) + (size_t)sidx(0, b, h, dir, pc) * 4096;
            for (int idx = tid; idx < 4096; idx += 512) ST[(idx & 63) * 72 + (idx >> 6)] = f2bf(S[idx]);
        }
        __syncthreads();
        if (tid < 64) { float e = 0.f;
#pragma unroll
            for (int i = 0; i < 8; ++i) { e += ET[i * 64 + tid]; EE[i * 64 + tid] = e; } }
        {
            const int tau = tid >> 2, qd = tid & 3, sb = tau >> 4; const int p = dir ? 127 - tau : tau; const bf16_t* ur = U + (size_t)(row0 + p) * UC + 1536 + h * 64 + 16 * qd;
#pragma unroll 1
            for (int hf = 0; hf < 2; ++hf) { const bf16x8 q8 = *(const bf16x8*)(ur + 8 * hf); float qh[8], kt[8];
#pragma unroll
                for (int e4 = 0; e4 < 2; ++e4) { const int c0 = 16 * qd + 8 * hf + 4 * e4; const f32x4 bh = *(const LAS f32x4*)(BH + tau * 64 + c0);
                    f32x4 bp = (f32x4){0.f, 0.f, 0.f, 0.f}; if (tau & 15) bp = *(const LAS f32x4*)(BH + (tau - 1) * 64 + c0);
                    const f32x4 et = *(const LAS f32x4*)(ET + sb * 64 + c0);
#pragma unroll
                    for (int e = 0; e < 4; ++e) { const int ee = 4 * e4 + e; const float qv = bf2f((bf16_t)q8[ee]);
                        qh[ee] = qv * 0.125f * __expf(bh[e]); kt[ee] = (1.0f - __expf(bh[e] - bp[e])) * __expf(et[e] - bh[e]); } }
                *(LAS bf16x8*)(QH + tau * 72 + 16 * qd + 8 * hf) = pack8(qh); *(LAS bf16x8*)(KT2 + tau * 72 + 16 * qd + 8 * hf) = pack8(kt); }
        }
        __syncthreads();
        {
            const int i = wid; LAS bf16_t* pw = PW + wid * 16 * 136;
            bf16x8 qf[2]; float em1[2][8];
#pragma unroll
            for (int ks = 0; ks < 2; ++ks) { qf[ks] = *(const LAS bf16x8*)(QH + (16 * i + fr) * 72 + 32 * ks + 8 * fq);
#pragma unroll
                for (int e = 0; e < 8; ++e) em1[ks][e] = (i > 0) ? EE[(i - 1) * 64 + 32 * ks + 8 * fq + e] : 0.f; }
            for (int j = 0; j <= i; ++j) {
                f32x4 d = (f32x4){0.f, 0.f, 0.f, 0.f};
#pragma unroll
                for (int ks = 0; ks < 2; ++ks) { float a8[8];
#pragma unroll
                    for (int e = 0; e < 8; ++e) a8[e] = bf2f((bf16_t)qf[ks][e]) * __expf(em1[ks][e] - EE[j * 64 + 32 * ks + 8 * fq + e]);
                    const bf16x8 kf = *(const LAS bf16x8*)(KT2 + (16 * j + fr) * 72 + 32 * ks + 8 * fq);
                    d = __builtin_amdgcn_mfma_f32_16x16x32_bf16(kf, pack8(a8), d, 0, 0, 0); }
                if (j == i) {
#pragma unroll
                    for (int r = 0; r < 4; ++r) d[r] = (4 * fq + r <= fr) ? d[r] : 0.f; }
                u32x2 w; w.x = pack2(d[0], d[1]); w.y = pack2(d[2], d[3]); *(LAS u32x2*)(pw + fr * 136 + 16 * j + 4 * fq) = w;
            }
            if ((i & 1) == 0) { u32x2 z; z.x = __float_as_uint(zero_f()); z.y = z.x; *(LAS u32x2*)(pw + fr * 136 + 16 * (i + 1) + 4 * fq) = z; }
            f32x4 o[4];
#pragma unroll
            for (int nt = 0; nt < 4; ++nt) o[nt] = (f32x4){0.f, 0.f, 0.f, 0.f};
            const int nks = (i >> 1) + 1;
            for (int ks = 0; ks < nks; ++ks) { const bf16x8 pa = *(const LAS bf16x8*)(pw + fr * 136 + 32 * ks + 8 * fq);
#pragma unroll
                for (int nt = 0; nt < 4; ++nt) { const bf16x8 vf = *(const LAS bf16x8*)(VT + (16 * nt + fr) * 136 + 32 * ks + 8 * fq); o[nt] = __builtin_amdgcn_mfma_f32_16x16x32_bf16(pa, vf, o[nt], 0, 0, 0); } }
#pragma unroll
            for (int ks = 0; ks < 2; ++ks) { float a8[8];
#pragma unroll
                for (int e = 0; e < 8; ++e) a8[e] = bf2f((bf16_t)qf[ks][e]) * __expf(em1[ks][e]);
                const bf16x8 qa = pack8(a8);
#pragma unroll
                for (int nt = 0; nt < 4; ++nt) { const bf16x8 sf = *(const LAS bf16x8*)(ST + (16 * nt + fr) * 72 + 32 * ks + 8 * fq); o[nt] = __builtin_amdgcn_mfma_f32_16x16x32_bf16(qa, sf, o[nt], 0, 0, 0); } }
#pragma unroll
            for (int nt = 0; nt < 4; ++nt)
#pragma unroll
                for (int r = 0; r < 4; ++r) { const int tau = 16 * i + 4 * fq + r; const int pos = dir ? 127 - tau : tau; LAS float* op = OUT + pos * 64 + 16 * nt + fr; if (dir == 0) *op = o[nt][r]; else *op += o[nt][r]; }
        }
        __syncthreads();
    }
    {
        const float ng = P.inp(I_HGNG)[l * 64 + lane]; bf16_t* BR2 = (bf16_t*)(P.ws + WS_BR) + (size_t)2 * T * 256;
        for (int rr = 0; rr < 16; ++rr) { const int pos = 16 * wid + rr; const int row = row0 + pos; const float o = OUT[pos * 64 + lane]; const float ms = wave_sum(o * o) * (1.0f / 64.0f);
            const float gt = bf2f(U[(size_t)row * UC + 2560 + h * 64 + lane]);
            BR2[(size_t)row * 256 + h * 64 + lane] = f2bf(o * rsqrtf(ms + RMS_EPS) * ng * siluf_(gt)); }
    }
    __syncthreads();
}

__device__ __forceinline__ void ssd_pass3(const Ptrs P, int l, int unit, LAS unsigned char* lds) {
    const int tid = P.tid, lane = tid & 63, wid = tid >> 6, fr = lane & 15, fq = lane >> 4;
    const int pc = unit % NCHK; const int r_ = unit / NCHK; const int h = r_ & 3; const int b = r_ >> 2; const int g = h >> 1;
    const int row0 = chunk_row0(b, pc);
    const bf16_t* U = (const bf16_t*)(P.ws + WS_BIG + BIG_U);
    const float* scw = P.inp(I_SSDCW) + (size_t)l * 3 * 512; const float* scb = P.inp(I_SSDCB) + l * 512;
    LAS bf16_t* CM = (LAS bf16_t*)lds; LAS bf16_t* BM = CM + 128 * 72; LAS bf16_t* XT = BM + 128 * 72; LAS bf16_t* ST = XT + 64 * 136;
    LAS float* cum = (LAS float*)(ST + 64 * 72); LAS float* dtv = cum + 128; LAS bf16_t* PW = (LAS bf16_t*)(dtv + 128); LAS float* OUT = (LAS float*)(PW + 8 * 16 * 136);
    for (int dir = 0; dir < 2; ++dir) {
        ssd_dt_cum(P, l, row0, dir, h, wid, lane, cum, dtv);
        {
            const int tau = tid >> 2, qd = tid & 3; const int row = row0 + (dir ? 127 - tau : tau);
#pragma unroll 1
            for (int pcs = 0; pcs < 4; ++pcs) { const int isb = pcs >> 1, hf = pcs & 1; const int cc = (isb ? 256 : 384) + g * 64 + 16 * qd + 8 * hf; float t8[8];
                conv3_silu8(U, row, 3072 + cc, scw, 512, cc, scb, t8);
                *(LAS bf16x8*)((isb ? BM : CM) + tau * 72 + 16 * qd + 8 * hf) = pack8(t8); }
        }
        {
            const int ch = lane, seg = wid; float xv[16]; const float xb = scb[h * 64 + ch];
#pragma unroll
            for (int j = 0; j < 16; ++j) { const int tau = 16 * seg + j; const int row = row0 + (dir ? 127 - tau : tau); xv[j] = siluf_(conv3_u(U, row, 3072 + h * 64 + ch, scw, 512, h * 64 + ch) + xb); }
            float t8[8];
#pragma unroll
            for (int e = 0; e < 8; ++e) t8[e] = xv[e];
            *(LAS bf16x8*)(XT + ch * 136 + 16 * seg) = pack8(t8);
#pragma unroll
            for (int e = 0; e < 8; ++e) t8[e] = xv[8 + e];
            *(LAS bf16x8*)(XT + ch * 136 + 16 * seg + 8) = pack8(t8);
            const float* S = (const float*)(P.ws + WS_BIG + BIG_STATE) + (size_t)sidx(1, b, h, dir, pc) * 4096;
            for (int idx = tid; idx < 4096; idx += 512) ST[(idx >> 6) * 72 + (idx & 63)] = f2bf(S[idx]);
        }
        __syncthreads();
        {
            const int i = wid; LAS bf16_t* pw = PW + wid * 16 * 136;
            bf16x8 cf[2];
#pragma unroll
            for (int ks = 0; ks < 2; ++ks) cf[ks] = *(const LAS bf16x8*)(CM + (16 * i + fr) * 72 + 32 * ks + 8 * fq);
            const float cum_t = cum[16 * i + fr];
            for (int j = 0; j <= i; ++j) {
                f32x4 d = (f32x4){0.f, 0.f, 0.f, 0.f};
#pragma unroll
                for (int ks = 0; ks < 2; ++ks) { const bf16x8 bf_ = *(const LAS bf16x8*)(BM + (16 * j + fr) * 72 + 32 * ks + 8 * fq); d = __builtin_amdgcn_mfma_f32_16x16x32_bf16(bf_, cf[ks], d, 0, 0, 0); }
                const f32x4 cs = *(const LAS f32x4*)(cum + 16 * j + 4 * fq), ds = *(const LAS f32x4*)(dtv + 16 * j + 4 * fq);
#pragma unroll
                for (int r = 0; r < 4; ++r) { const bool keep = (j < i) || (4 * fq + r <= fr); d[r] = keep ? d[r] * __expf(cum_t - cs[r]) * ds[r] : 0.f; }
                u32x2 w; w.x = pack2(d[0], d[1]); w.y = pack2(d[2], d[3]); *(LAS u32x2*)(pw + fr * 136 + 16 * j + 4 * fq) = w;
            }
            if ((i & 1) == 0) { u32x2 z; z.x = __float_as_uint(zero_f()); z.y = z.x; *(LAS u32x2*)(pw + fr * 136 + 16 * (i + 1) + 4 * fq) = z; }
            f32x4 o[4], o2[4];
#pragma unroll
            for (int nt = 0; nt < 4; ++nt) { o[nt] = (f32x4){0.f, 0.f, 0.f, 0.f}; o2[nt] = o[nt]; }
            const int nks = (i >> 1) + 1;
            for (int ks = 0; ks < nks; ++ks) { const bf16x8 pa = *(const LAS bf16x8*)(pw + fr * 136 + 32 * ks + 8 * fq);
#pragma unroll
                for (int nt = 0; nt < 4; ++nt) { const bf16x8 xf = *(const LAS bf16x8*)(XT + (16 * nt + fr) * 136 + 32 * ks + 8 * fq); o[nt] = __builtin_amdgcn_mfma_f32_16x16x32_bf16(pa, xf, o[nt], 0, 0, 0); } }
#pragma unroll
            for (int ks = 0; ks < 2; ++ks)
#pragma unroll
                for (int nt = 0; nt < 4; ++nt) { const bf16x8 sf = *(const LAS bf16x8*)(ST + (16 * nt + fr) * 72 + 32 * ks + 8 * fq); o2[nt] = __builtin_amdgcn_mfma_f32_16x16x32_bf16(cf[ks], sf, o2[nt], 0, 0, 0); }
            const f32x4 ct = *(const LAS f32x4*)(cum + 16 * i + 4 * fq);
#pragma unroll
            for (int nt = 0; nt < 4; ++nt)
#pragma unroll
                for (int r = 0; r < 4; ++r) { const int tau = 16 * i + 4 * fq + r; const int pos = dir ? 127 - tau : tau; const float v = o[nt][r] + __expf(ct[r]) * o2[nt][r];
                    LAS float* op = OUT + pos * 64 + 16 * nt + fr; if (dir == 0) *op = v; else *op += v; }
        }
        __syncthreads();
    }
    {
        const float Dh = P.inp(I_SSDD)[l * 4 + h]; const float xb = scb[h * 64 + lane]; bf16_t* BR3 = (bf16_t*)(P.ws + WS_BR) + (size_t)3 * T * 256; float* SSQ = (float*)(P.ws + WS_SSQ);
        for (int rr = 0; rr < 16; ++rr) { const int pos = 16 * wid + rr; const int row = row0 + pos; const int c = h * 64 + lane;
            const float xs = siluf_(conv3_u(U, row, 3072 + c, scw, 512, c) + xb); const float y = OUT[pos * 64 + lane] + xs * Dh; const float z = bf2f(U[(size_t)row * UC + 2816 + c]);
            const float vv = y * siluf_(z); const float q = wave_sum(vv * vv); if (lane == 0) SSQ[(size_t)row * 4 + h] = q;
            BR3[(size_t)row * 256 + c] = f2bf(vv); }
    }
    __syncthreads();
}

typedef float f32x2 __attribute__((ext_vector_type(2)));
__device__ __forceinline__ f32x2 cmul(f32x2 a, f32x2 b) { return (f32x2){a.x * b.x - a.y * b.y, a.x * b.y + a.y * b.x}; }
__device__ __forceinline__ f32x2 cmulc(f32x2 a, f32x2 b) { return (f32x2){a.x * b.x + a.y * b.y, a.y * b.x - a.x * b.y}; }
__device__ __forceinline__ int fphys(int i) { return i + (i >> 4); }
template <int LO, int NST, bool INV>
__device__ __forceinline__ void fft_pass(LAS f32x2* X, const LAS f32x2* TW, int tid) {
    const int low = tid & ((1 << LO) - 1), high = tid >> LO; const int base = low | (high << (LO + 4));
    f32x2 x[16];
#pragma unroll
    for (int j = 0; j < 16; ++j) { const int i = base | (j << LO); x[j] = X[fphys(i)]; }
#pragma unroll
    for (int mm = 0; mm < NST; ++mm) { const int m = INV ? mm : NST - 1 - mm; const int s = LO + m;
#pragma unroll
        for (int j = 0; j < 16; ++j) { if (j & (1 << m)) continue; const int j2 = j | (1 << m);
            const int k = ((j & ((1 << m) - 1)) << LO) | low; const f32x2 tw = TW[k << (12 - s)];
            const f32x2 a = x[j], b = x[j2];
            if (!INV) { x[j] = a + b; x[j2] = cmul(a - b, tw); } else { const f32x2 bt = cmulc(b, tw); x[j] = a + bt; x[j2] = a - bt; } } }
#pragma unroll
    for (int j = 0; j < 16; ++j) { const int i = base | (j << LO); X[fphys(i)] = x[j]; }
}
__device__ __forceinline__ void fft_fwd(LAS f32x2* X, const LAS f32x2* TW, int tid) {
    fft_pass<9, 4, false>(X, TW, tid); __syncthreads(); fft_pass<5, 4, false>(X, TW, tid); __syncthreads(); fft_pass<2, 3, false>(X, TW, tid); __syncthreads(); fft_pass<0, 2, false>(X, TW, tid); __syncthreads();
}
__device__ __forceinline__ void fft_inv(LAS f32x2* X, const LAS f32x2* TW, int tid) {
    fft_pass<0, 2, true>(X, TW, tid); __syncthreads(); fft_pass<2, 3, true>(X, TW, tid); __syncthreads(); fft_pass<5, 4, true>(X, TW, tid); __syncthreads(); fft_pass<9, 4, true>(X, TW, tid); __syncthreads();
}
__device__ __forceinline__ void hyena_fft_unit(const Ptrs P, int l, int c, LAS unsigned char* lds) {
    const int tid = P.tid, lane = tid & 63;
    LAS f32x2* X = (LAS f32x2*)lds; LAS f32x2* TW = X + 8704;
    const f32x2* TWg = (const f32x2*)(P.ws + WS_TW);
    for (int i = tid; i < 4096; i += 512) TW[i] = TWg[i];
    float nrm; { const float* part = (const float*)(P.ws + WS_PART) + (size_t)l * 64 * 512; nrm = wave_sum(part[lane * 512 + c] + part[lane * 512 + 256 + c]); }
    const float inv = 1.0f / nrm; const float* filt = (const float*)(P.ws + WS_FILT) + (size_t)l * 8192 * 256 + c;
    for (int i = tid; i < 8192; i += 512) X[fphys(i)] = (f32x2){filt[(size_t)i * 256] * inv, 0.f};
    __syncthreads();
    fft_fwd(X, TW, tid);
    f32x2* Fg = (f32x2*)(P.ws + WS_BR) + (size_t)P.bid * 8192;
    for (int i = tid; i < 8192; i += 512) Fg[i] = X[fphys(i)];
    unsigned* WTt = (unsigned*)(P.ws + WS_BIG + BIG_WT); const float bias = P.inp(I_HYBIAS)[l * 256 + c];
    for (int p = 0; p < 4; ++p) {
        unsigned* wp = WTt + ((size_t)c * 4 + p) * 4096;
        __syncthreads();
        for (int i = tid; i < 8192; i += 512) { f32x2 v = (f32x2){0.f, 0.f}; if (i < 4096) { const unsigned w = wp[i]; v.x = __uint_as_float(w << 16); v.y = __uint_as_float(w & 0xffff0000u); } X[fphys(i)] = v; }
        __syncthreads();
        fft_fwd(X, TW, tid);
        for (int i = tid; i < 8192; i += 512) { const int q = fphys(i); X[q] = cmul(X[q], Fg[i]); }
        __syncthreads();
        fft_inv(X, TW, tid);
        for (int i = tid; i < 4096; i += 512) { const unsigned w = wp[i]; const f32x2 y = X[fphys(i)] * (1.0f / 8192.0f);
            wp[i] = pack2(y.x + __uint_as_float(w << 16) * bias, y.y + __uint_as_float(w & 0xffff0000u) * bias); }
    }
    __syncthreads();
}

__device__ __forceinline__ void phase_m1(const Ptrs P, int l, LAS unsigned char* lds) {
    const int tid = P.tid, G = P.G;
    const bf16_t* U = (const bf16_t*)(P.ws + WS_BIG + BIG_U); bf16_t* WT = (bf16_t*)(P.ws + WS_BIG + BIG_WT);
    const float* hcw = P.inp(I_HYCW) + (size_t)l * 3 * 768; const float* hcb = P.inp(I_HYCB) + l * 768;
    const int NS = NB * 4 * 2 * NCHK;
    const int NU = 2 * NS + 256 + NCTX / 64;
    for (int u = P.bid; u < NU; u += G) {
        if (u < NS) hgrn_pass1(P, l, u, lds);
        else if (u < 2 * NS) ssd_pass1(P, l, u - NS, lds);
        else if (u < 2 * NS + 256) {
            const int ub = u - 2 * NS; const int p = ub >> 6, tb = ub & 63; const int c = tid & 255; LAS unsigned* tile = (LAS unsigned*)lds;
            for (int rr = tid >> 8; rr < 64; rr += 2) { float w2[2];
#pragma unroll
                for (int b2 = 0; b2 < 2; ++b2) { const int row = (2 * p + b2) * SEQ + tb * 64 + rr;
                    const float x1 = conv3_u(U, row, 256 + c, hcw, 768, 256 + c) + hcb[256 + c]; const float v = conv3_u(U, row, 512 + c, hcw, 768, 512 + c) + hcb[512 + c]; w2[b2] = x1 * v; }
                tile[c * 65 + rr] = pack2(w2[0], w2[1]); }
            __syncthreads();
            { unsigned* WTt = (unsigned*)(P.ws + WS_BIG + BIG_WT); const int t = tid & 63;
              for (int cc = tid >> 6; cc < 256; cc += 8) WTt[((size_t)cc * 4 + p) * 4096 + tb * 64 + t] = tile[cc * 65 + t]; }
            __syncthreads();
        } else {
            const int ub = u - 2 * NS - 256; const int c = tid & 255; bf16_t* WTC = (bf16_t*)(P.ws + WS_BIG + BIG_WT) + (size_t)NLAT * 256;
            for (int rr = tid >> 8; rr < 64; rr += 2) { const int row = NLAT + ub * 64 + rr;
                const float x1 = conv3_u(U, row, 256 + c, hcw, 768, 256 + c) + hcb[256 + c]; const float v = conv3_u(U, row, 512 + c, hcw, 768, 512 + c) + hcb[512 + c];
                WTC[(size_t)(row - NLAT) * 256 + c] = f2bf(x1 * v); } }
    }
}

__device__ __forceinline__ void phase_m2(const Ptrs P, int l, LAS unsigned char* lds) {
    const int tid = P.tid, G = P.G;
    const bf16_t* U = (const bf16_t*)(P.ws + WS_BIG + BIG_U); bf16_t* BR = (bf16_t*)(P.ws + WS_BR);
    const float* hcw = P.inp(I_HYCW) + (size_t)l * 3 * 768; const float* hcb = P.inp(I_HYCB) + l * 768;
    const int NU_F = 256, NU_P2 = 256, NU_HC = (l == 0) ? NB * 16 : 0;
    const int NU = NU_F + NU_P2 + NU_HC;
    for (int u = P.bid; u < NU; u += G) {
        if (u < NU_F) { hyena_fft_unit(P, l, u, lds); continue; }
        if (u < NU_F + NU_P2) { scan_pass2(P, u - NU_F); continue; }
        const int uu = u - NU_F - NU_P2; const int L = CTXL; const int msk = 2 * L - 1;
        const int b = uu >> 4; const int t0 = (uu & 15) * 16 + (tid >> 8) * 8; const int c = tid & 255;
        const int base = NLAT + b * CTXL; const bf16_t* WTC = (const bf16_t*)(P.ws + WS_BIG + BIG_WT) + (size_t)NLAT * 256 + (size_t)b * CTXL * 256;
        const float* filt = (const float*)(P.ws + WS_FILTC);
        float acc[8], fw[8];
#pragma unroll
        for (int j = 0; j < 8; ++j) { acc[j] = 0.f; fw[j] = filt[(size_t)((t0 + j) & msk) * 256 + c]; }
        for (int s = 0; s < L; ++s) { const float w = bf2f(WTC[(size_t)s * 256 + c]);
#pragma unroll
            for (int j = 0; j < 8; ++j) acc[j] += fw[j] * w;
#pragma unroll
            for (int j = 7; j > 0; --j) fw[j] = fw[j - 1];
            fw[0] = filt[(size_t)((t0 - s - 1) & msk) * 256 + c]; }
        const float inv = 1.0f / hy_norm(P, 2, c); const float bias = P.inp(I_HYBIAS)[l * 256 + c];
#pragma unroll
        for (int j = 0; j < 8; ++j) { const int row = base + t0 + j; const float x0 = conv3_u(U, row, c, hcw, 768, c) + hcb[c]; const float w = bf2f(WTC[(size_t)(t0 + j) * 256 + c]);
            BR[(size_t)row * 256 + c] = f2bf(x0 * (acc[j] * inv + w * bias)); }
    }
}

__device__ __forceinline__ void phase_m3(const Ptrs P, int l, LAS unsigned char* lds) {
    const int tid = P.tid, G = P.G;
    const bool last = (l == NLAYER - 1); const int rows_l = last ? NLAT : T;
    const bf16_t* U = (const bf16_t*)(P.ws + WS_BIG + BIG_U); bf16_t* BR = (bf16_t*)(P.ws + WS_BR);
    const int NS3 = NB * 4 * NCHK;
    const int NU = 2 * NS3 + rows_l / 64 + 256;
    const float* hcw = P.inp(I_HYCW) + (size_t)l * 3 * 768; const float* hcb = P.inp(I_HYCB) + l * 768;
    for (int u = P.bid; u < NU; u += G) {
        if (u >= 2 * NS3 + rows_l / 64) {
            const int ub = u - 2 * NS3 - rows_l / 64; const int p = ub >> 6, tb = ub & 63; LAS unsigned* tile = (LAS unsigned*)lds; const unsigned* WTt = (const unsigned*)(P.ws + WS_BIG + BIG_WT);
            { const int t = tid & 63; for (int cc = tid >> 6; cc < 256; cc += 8) tile[cc * 65 + t] = WTt[((size_t)cc * 4 + p) * 4096 + tb * 64 + t]; }
            __syncthreads();
            { const int c = tid & 255;
              for (int rr = tid >> 8; rr < 64; rr += 2) { const unsigned yw = tile[c * 65 + rr];
#pragma unroll
                  for (int b2 = 0; b2 < 2; ++b2) { const int row = (2 * p + b2) * SEQ + tb * 64 + rr; const float x0 = conv3_u(U, row, c, hcw, 768, c) + hcb[c];
                      const float y = b2 ? __uint_as_float(yw & 0xffff0000u) : __uint_as_float(yw << 16); BR[(size_t)row * 256 + c] = f2bf(x0 * y); } } }
            __syncthreads();
            continue; }
        if (u < 2 * NS3) { const int uu = u < NS3 ? u : u - NS3; if (last && (uu % NCHK) < 2) continue;
            if (u < NS3) hgrn_pass3(P, l, uu, lds); else ssd_pass3(P, l, uu, lds); }
        else { const int rb = u - 2 * NS3; const float* cw = P.inp(I_SCCW) + (size_t)l * 3 * 256; const int c = tid & 255;
            for (int rr = tid >> 8; rr < 64; rr += 2) { const int row = rb * 64 + rr; float acc = 0.f;
#pragma unroll
                for (int k = 0; k < 3; ++k) { const bool ok = (k == 1) || (k == 0 ? row_has_prev(row) : row_has_next(row)); const int r2 = ok ? row + k - 1 : row;
                    const float pr = bf2f(U[(size_t)r2 * UC + 1024 + c]) * bf2f(U[(size_t)r2 * UC + 1280 + c]) * cw[k * 256 + c]; acc += ok ? pr : 0.f; }
                BR[(size_t)T * 256 + (size_t)row * 256 + c] = f2bf(bf2f(U[(size_t)row * UC + 768 + c]) * acc); } }
    }
}

__device__ __forceinline__ void phase_g2(const Ptrs P, int l, LAS unsigned char* lds) {
    const int MT = ((l == NLAYER - 1) ? NLAT : T) / 256;
    pg8::Gemm g{(const bf16_t*)(P.ws + WS_BR), (const bf16_t*)(P.ws + WS_WBR), 256};
    EpiP E{(bf16_t*)(P.ws + WS_BIG + BIG_P), (const float*)(P.ws + WS_SSQ)};
    SchedG2 S{P.G, P.bid, MT};
    pg8::gemm_phase<EpiP, SchedG2, false>(P.tid, lds, g, S, E);
}
__device__ __forceinline__ void phase_g3(const Ptrs P, int l, LAS unsigned char* lds) {
    const int MT = ((l == NLAYER - 1) ? NLAT : T) / 256;
    pg8::Gemm g{(const bf16_t*)(P.ws + WS_HBUF), (const bf16_t*)(P.ws + WS_WG), D};
    EpiMerge E{(const bf16_t*)(P.ws + WS_BIG + BIG_P), (const float*)(P.ws + WS_BGP), (bf16_t*)(P.ws + WS_BR)};
    SchedMN S{P.G, P.bid, MT, 16};
    pg8::gemm_phase<EpiMerge, SchedMN, false>(P.tid, lds, g, S, E);
}
__device__ __forceinline__ void phase_g4(const Ptrs P, int l, LAS unsigned char* lds) {
    const int MT = ((l == NLAYER - 1) ? NLAT : T) / 256;
    pg8::Gemm g{(const bf16_t*)(P.ws + WS_BR), (const bf16_t*)(P.ws + WS_WO), D};
    EpiWo E{P, l};
    SchedMN S{P.G, P.bid, MT, 4};
    pg8::gemm_phase<EpiWo, SchedMN, false>(P.tid, lds, g, S, E);
}

__device__ __forceinline__ void phase_e5(const Ptrs P, int l, LAS unsigned char* lds) {
    const int tid = P.tid, wid = tid >> 6, lane = tid & 63, G = P.G;
    const int rows_l = (l == NLAYER - 1) ? NLAT : T;
    LAS float* wrT = (LAS float*)lds;
    LAS float* tile = (LAS float*)(lds + 65536);
    for (int i = tid; i < 1024 * 16; i += 512) wrT[(i & 15) * 1024 + (i >> 4)] = P.inp(I_WROUTER)[i];
    __syncthreads();
    unsigned* cnt = (unsigned*)(P.ws + WS_CTL + CTL_CNT) + l * 16;
    int* toke = (int*)(P.ws + WS_TOKE); float* tokw = (float*)(P.ws + WS_TOKW); int* toks = (int*)(P.ws + WS_TOKS); int* list = (int*)(P.ws + WS_LIST);
    LAS unsigned* lcnt = (LAS unsigned*)(lds + 98304); LAS unsigned* gbase = lcnt + 16; LAS int* rec = (LAS int*)(lcnt + 32);
    if (tid < 16) lcnt[tid] = 0u;
    __syncthreads();
    const float* g = P.inp(I_LN1G) + l * D; const float* bta = P.inp(I_LN1B) + l * D;
    const int NU_R = rows_l / 8; const int NU = NU_R + NCONV_EX;
    int nloc = 0;
    for (int u = P.bid; u < NU; u += G) {
        if (u >= NU_R) { conv_unit_ex(P, l, u - NU_R, tile); continue; }
        const int row = u * 8 + wid; RowV r; float* lp = P.latrow(row);
        row_load(r, lp, lane); row_layernorm(r, g, bta, lane); row_store(r, lp, lane);
        const float* m = P.mod(l, row_modidx(row)); RowV h; row_modulate(r, h, m + 3072, m + 4096, lane);
        row_store_bf16(h, (bf16_t*)(P.ws + WS_HBUF) + (size_t)row * D, lane);
        float lg[16];
#pragma unroll
        for (int e = 0; e < 16; ++e) { float s = 0.f;
#pragma unroll
            for (int i = 0; i < 4; ++i) { const f32x4 w = *(const LAS f32x4*)(wrT + e * 1024 + i * 256 + lane * 4); s += h.v[i][0] * w[0] + h.v[i][1] * w[1] + h.v[i][2] * w[2] + h.v[i][3] * w[3]; }
            lg[e] = wave_sum(s); }
        float mx = lg[0];
#pragma unroll
        for (int e = 1; e < 16; ++e) mx = fmaxf(mx, lg[e]);
        float sc[16], sel[16], ssum = 0.f;
#pragma unroll
        for (int e = 0; e < 16; ++e) { sc[e] = expf(lg[e] - mx); ssum += sc[e]; }
        const float inv = 1.0f / ssum;
#pragma unroll
        for (int e = 0; e < 16; ++e) { sc[e] *= inv; sel[e] = sc[e] + P.inp(I_BROUTER)[e]; }
        int bestg = 0; float bestgs = -3.0e38f;
#pragma unroll
        for (int gq = 0; gq < 4; ++gq) { float m1 = -3.0e38f, m2 = -3.0e38f;
#pragma unroll
            for (int j = 0; j < 4; ++j) { const float v = sel[gq * 4 + j]; if (v > m1) { m2 = m1; m1 = v; } else if (v > m2) m2 = v; }
            const float gs = m1 + m2; if (gs > bestgs) { bestgs = gs; bestg = gq; } }
        int i1 = 0, i2 = 0; float v1 = -3.0e38f, v2 = -3.0e38f, w1 = 0.f, w2 = 0.f;
#pragma unroll
        for (int e = 0; e < 16; ++e) { if ((e >> 2) == bestg && sel[e] > v1) { v1 = sel[e]; i1 = e; w1 = sc[e]; } }
#pragma unroll
        for (int e = 0; e < 16; ++e) { if ((e >> 2) == bestg && e != i1 && sel[e] > v2) { v2 = sel[e]; i2 = e; w2 = sc[e]; } }
        if (lane == 0) { const float ws_ = 1.0f / (w1 + w2);
            const int s1 = (int)__hip_atomic_fetch_add(lcnt + i1, 1u, __ATOMIC_RELAXED, __HIP_MEMORY_SCOPE_WORKGROUP);
            const int s2 = (int)__hip_atomic_fetch_add(lcnt + i2, 1u, __ATOMIC_RELAXED, __HIP_MEMORY_SCOPE_WORKGROUP);
            const int idx = nloc * 8 + wid; rec[idx * 4] = row; rec[idx * 4 + 1] = i1 | (i2 << 8); rec[idx * 4 + 2] = s1; rec[idx * 4 + 3] = s2;
            toke[row * 2] = i1; toke[row * 2 + 1] = i2; tokw[row * 2] = w1 * ws_; tokw[row * 2 + 1] = w2 * ws_; }
        ++nloc;
    }
    __syncthreads();
    if (tid < 16) gbase[tid] = __hip_atomic_fetch_add(cnt + tid, lcnt[tid], __ATOMIC_RELAXED, __HIP_MEMORY_SCOPE_AGENT);
    __syncthreads();
    for (int idx = tid; idx < nloc * 8; idx += 512) { const int row = rec[idx * 4], ee = rec[idx * 4 + 1]; const int e1 = ee & 255, e2 = ee >> 8;
        const int s1 = (int)gbase[e1] + rec[idx * 4 + 2], s2 = (int)gbase[e2] + rec[idx * 4 + 3];
        list[(size_t)e1 * T + s1] = row; list[(size_t)e2 * T + s2] = row; toks[row * 2] = s1; toks[row * 2 + 1] = s2; }
}

struct MoeSeg { int toff[17]; };
__device__ __forceinline__ void moe_seg(const unsigned* cnt, MoeSeg& S) { int a = 0;
#pragma unroll
    for (int e = 0; e < 16; ++e) { S.toff[e] = a; a += __builtin_amdgcn_readfirstlane(((int)cnt[e] + 255) >> 8); }
    S.toff[16] = a; }
__device__ __forceinline__ int moe_find(const MoeSeg& S, int tg, int& off) { int e = 0; off = 0;
#pragma unroll
    for (int j = 1; j < 16; ++j) { const bool ge = (tg >= S.toff[j]); e += ge ? 1 : 0; off = ge ? S.toff[j] : off; }
    return e; }

struct SchedMoe { int G, c; MoeSeg S; const int* list; const unsigned* cnt;
    __device__ __forceinline__ bool next(int i, Unit& u) const { const int L = i * G + c; if (L >= S.toff[16] * 4) return false; const int tg = L >> 2, pnn = L & 3; int off; const int e = moe_find(S, tg, off);
        u.pm = tg; u.pn = e * 4 + pnn; u.e = e; u.aux = tg - off; return true; }
    __device__ __forceinline__ int arow(const Unit& u, int R) const { const int idx = u.aux * 256 + R; const int* l = list + (size_t)u.e * T; return idx < (int)cnt[u.e] ? l[idx] : l[0]; } };
__device__ __forceinline__ void phase_g5(const Ptrs P, int l, LAS unsigned char* lds) {
    const unsigned* cnt = (const unsigned*)(P.ws + WS_CTL + CTL_CNT) + l * 16;
    SchedMoe S; S.G = P.G; S.c = P.bid; moe_seg(cnt, S.S); S.list = (const int*)(P.ws + WS_LIST); S.cnt = cnt;
    pg8::Gemm g{(const bf16_t*)(P.ws + WS_HBUF), (const bf16_t*)(P.ws + WS_BIG + BIG_W13), D};
    EpiFfn1 E{(bf16_t*)(P.ws + WS_BIG + BIG_HID)};
    pg8::gemm_phase<EpiFfn1, SchedMoe, true>(P.tid, lds, g, S, E);
}
__device__ __forceinline__ void phase_g6(const Ptrs P, int l, LAS unsigned char* lds) {
    const unsigned* cnt = (const unsigned*)(P.ws + WS_CTL + CTL_CNT) + l * 16;
    SchedMoe S; S.G = P.G; S.c = P.bid; moe_seg(cnt, S.S); S.list = (const int*)(P.ws + WS_LIST); S.cnt = cnt;
    pg8::Gemm g{(const bf16_t*)(P.ws + WS_BIG + BIG_HID), (const bf16_t*)(P.ws + WS_BIG + BIG_W2), 512};
    EpiBf16Plain E{(bf16_t*)(P.ws + WS_BIG + BIG_YE), 1024, 3};
    pg8::gemm_phase<EpiBf16Plain, SchedMoe, false>(P.tid, lds, g, S, E);
}

__device__ __forceinline__ void phase_e8(const Ptrs P, int l, LAS unsigned char* lds) {
    const int tid = P.tid, wid = tid >> 6, lane = tid & 63, G = P.G;
    const bool last = (l == NLAYER - 1); const int rows_l = last ? NLAT : T;
    LAS float* wdt = (LAS float*)lds; LAS float* tile = (LAS float*)(lds + 65536);
    if (!last) load_wdt(P, l + 1, wdt);
    const unsigned* cnt = (const unsigned*)(P.ws + WS_CTL + CTL_CNT) + l * 16; MoeSeg S; moe_seg(cnt, S);
    const int* toke = (const int*)(P.ws + WS_TOKE); const float* tokw = (const float*)(P.ws + WS_TOKW); const int* toks = (const int*)(P.ws + WS_TOKS);
    const bf16_t* YE = (const bf16_t*)(P.ws + WS_BIG + BIG_YE);
    const float* g = P.inp(I_LN2G) + l * D; const float* bta = P.inp(I_LN2B) + l * D;
    const int NU_R = rows_l / 8; const int NU = NU_R + (last ? 0 : NCONV_NE);
    for (int u = P.bid; u < NU; u += G) {
        if (u >= NU_R) { conv_unit_ne(P, l + 1, u - NU_R, tile); continue; }
        const int row = u * 8 + wid; RowV r; float* lp = P.latrow(row); row_load(r, lp, lane);
        const int e1 = toke[row * 2], e2 = toke[row * 2 + 1]; const float w1 = tokw[row * 2], w2 = tokw[row * 2 + 1];
        int o1 = 0, o2 = 0;
#pragma unroll
        for (int e = 0; e < 16; ++e) { o1 = (e == e1) ? S.toff[e] : o1; o2 = (e == e2) ? S.toff[e] : o2; }
        const bf16_t* y1 = YE + ((size_t)o1 * 256 + toks[row * 2]) * 1024; const bf16_t* y2 = YE + ((size_t)o2 * 256 + toks[row * 2 + 1]) * 1024;
        const float* m = P.mod(l, row_modidx(row));
#pragma unroll
        for (int i = 0; i < 4; ++i) { const u32x2 a = *(const u32x2*)(y1 + i * 256 + lane * 4), b = *(const u32x2*)(y2 + i * 256 + lane * 4);
            const f32x4 g2 = *(const f32x4*)(m + 5120 + i * 256 + lane * 4);
            f32x4 mo; mo[0] = w1 * __uint_as_float(a.x << 16) + w2 * __uint_as_float(b.x << 16); mo[1] = w1 * __uint_as_float(a.x & 0xffff0000u) + w2 * __uint_as_float(b.x & 0xffff0000u);
            mo[2] = w1 * __uint_as_float(a.y << 16) + w2 * __uint_as_float(b.y << 16); mo[3] = w1 * __uint_as_float(a.y & 0xffff0000u) + w2 * __uint_as_float(b.y & 0xffff0000u);
            r.v[i] = r.v[i] * ALPHA + g2 * mo; }
        row_layernorm(r, g, bta, lane);
        row_store(r, lp, lane);
        if (!last) { const float* m2 = P.mod(l + 1, row_modidx(row)); RowV h; row_modulate(r, h, m2, m2 + 1024, lane);
            row_store_bf16(h, (bf16_t*)(P.ws + WS_HBUF) + (size_t)row * D, lane); row_dt(h, wdt, (float*)(P.ws + WS_DT) + (size_t)row * 8, lane); }
    }
}

constexpr int NPH_LAYER = 11, NPH = 2 + NLAYER * NPH_LAYER;
__global__ void __launch_bounds__(512, 2) fwd_kernel(Args a) {
    extern __shared__ __attribute__((aligned(16))) unsigned char lds_raw[];
    LAS unsigned char* lds = (LAS unsigned char*)lds_raw;
    const int lo = a.ph_lo, hi = a.ph_hi;
    volatile LAS unsigned* xbw = (volatile LAS unsigned*)(lds + LDS_MISC);
    const int wave_s = __builtin_amdgcn_readfirstlane((int)threadIdx.x >> 6);
    if (threadIdx.x < 4) xbw[threadIdx.x] = 0u;
    __syncthreads();
    XcdBarrier bar; bar.bar = (unsigned*)(a.ws + WS_CTL); bar.x = 0; bar.st = xbw;
    if (hi - lo > 1) bar = xcd_barrier_post((unsigned*)(a.ws + WS_CTL), xbw, wave_s);
#ifndef PH_MASK
#define PH_MASK 0xFFFFFFFFu
#endif
#ifndef PROBE_PH
#define PROBE_PH (-1)
#define PROBE_N 1
#endif
#define REP(id) for (int rep_ = 0; rep_ < ((PROBE_PH == (id)) ? PROBE_N : 1); ++rep_)
#define PH_ON(id) (((PH_MASK) >> (id)) & 1u)
#define IN(k) (lo <= (k) && (k) < hi)
#define FRESH() Ptrs Pq; { float* o_ = a.out; unsigned char* w_ = a.ws; int l_ = lcur; asm volatile("" : "+s"(o_), "+s"(w_), "+s"(l_) :: "memory"); Pq.out = o_; Pq.ws = w_; lq = l_; int ws_ = wave_s, b_ = blockIdx.x, g_ = gridDim.x; asm volatile("" : "+s"(ws_), "+s"(b_), "+s"(g_)); int ln_ = lane_id(); asm volatile("" : "+v"(ln_)); int t_ = ws_ * 64 + ln_; Pq.tid = t_; Pq.bid = b_; Pq.G = g_; }
#define SEAM(k) do { if (IN(k) && IN((k) + 1)) xcd_barrier(bar, wave_s); } while (0)
    int lcur = 0, lq = 0;
    if (PH_ON(0) && IN(0)) REP(0) { FRESH(); phase_pa(Pq, lds); } SEAM(0);
    if (PH_ON(1) && IN(1)) REP(1) { FRESH(); phase_pb(Pq, lds); } SEAM(1);
    for (int l = 0; l < NLAYER; ++l) {
        const int b = 2 + l * NPH_LAYER; lcur = l;
        if (PH_ON(2) && IN(b + 0)) REP(2) { FRESH(); phase_g1(Pq, lds); } SEAM(b + 0);
        for (int g_ = 0; g_ < ((PROBE_PH == 100) ? PROBE_N : 1); ++g_) {
        if (PH_ON(3) && IN(b + 1)) REP(3) { FRESH(); phase_m1(Pq, lq, lds); } SEAM(b + 1);
        if (PH_ON(4) && IN(b + 2)) REP(4) { FRESH(); phase_m2(Pq, lq, lds); } SEAM(b + 2);
        if (PH_ON(5) && IN(b + 3)) REP(5) { FRESH(); phase_m3(Pq, lq, lds); } SEAM(b + 3);
        }
        if (PH_ON(6) && IN(b + 4)) REP(6) { FRESH(); phase_g2(Pq, lq, lds); } SEAM(b + 4);
        if (PH_ON(7) && IN(b + 5)) REP(7) { FRESH(); phase_g3(Pq, lq, lds); } SEAM(b + 5);
        if (PH_ON(8) && IN(b + 6)) REP(8) { FRESH(); phase_g4(Pq, lq, lds); } SEAM(b + 6);
        if (PH_ON(9) && IN(b + 7)) REP(9) { FRESH(); phase_e5(Pq, lq, lds); } SEAM(b + 7);
        if (PH_ON(10) && IN(b + 8)) REP(10) { FRESH(); phase_g5(Pq, lq, lds); } SEAM(b + 8);
        if (PH_ON(11) && IN(b + 9)) REP(11) { FRESH(); phase_g6(Pq, lq, lds); } SEAM(b + 9);
        if (PH_ON(12) && IN(b + 10)) REP(12) { FRESH(); phase_e8(Pq, lq, lds); } SEAM(b + 10);
    }
#undef IN
#undef SEAM
}
}

extern "C" void kernel_launch(void* const* d_in, const int* in_sizes, int n_in, void* d_out, int out_size, void* d_ws, size_t ws_size, hipStream_t stream) {
    static int grid = 0;
    if (grid == 0) {
        if (n_in != N_IN || out_size != NLAT * D || ws_size < WS_END) { fprintf(stderr, "kernel_launch: unexpected shapes / workspace (%d inputs, out %d, ws %zu < %zu)\n", n_in, out_size, ws_size, (size_t)WS_END); grid = -1; return; }
        int dev = 0, cus = 0, per_cu = 0;
        if (hipGetDevice(&dev) != hipSuccess || hipDeviceGetAttribute(&cus, hipDeviceAttributeMultiprocessorCount, dev) != hipSuccess) { grid = -1; return; }
        if (hipFuncSetAttribute((const void*)fwd_kernel, hipFuncAttributeMaxDynamicSharedMemorySize, LDS_BYTES) != hipSuccess) { fprintf(stderr, "kernel_launch: hipFuncSetAttribute failed\n"); grid = -1; return; }
        if (hipOccupancyMaxActiveBlocksPerMultiprocessor(&per_cu, (const void*)fwd_kernel, 512, LDS_BYTES) != hipSuccess || per_cu < 1) { fprintf(stderr, "kernel_launch: occupancy query says %d\n", per_cu); }
        (void)hipGetLastError();
        grid = cus;
    }
    if (grid < 0) return;
    (void)hipMemsetAsync((char*)d_ws + WS_CTL, 0, CTL_BYTES, stream);
    Args a{};
    for (int i = 0; i < N_IN; ++i) a.in[i] = (const float*)d_in[i];
    a.out = (float*)d_out; a.ws = (unsigned char*)d_ws;
#if N_LAUNCH_MODE == 1
    a.ph_lo = 0; a.ph_hi = NPH;
    hipLaunchKernelGGL(fwd_kernel, dim3(grid), dim3(512), LDS_BYTES, stream, a);
#else
    for (int p = 0; p < NPH; ++p) { a.ph_lo = p; a.ph_hi = p + 1; hipLaunchKernelGGL(fwd_kernel, dim3(grid), dim3(512), LDS_BYTES, stream, a); }
#endif
}
```

```cpp
#include <hip/hip_runtime.h>
#include <cstdio>
#include <cstdint>

#ifndef N_LAUNCH_MODE
#define N_LAUNCH_MODE 1
#endif

namespace {
typedef unsigned short bf16_t;
typedef short bf16x8 __attribute__((ext_vector_type(8)));
typedef float f32x4 __attribute__((ext_vector_type(4)));
typedef unsigned u32x2 __attribute__((ext_vector_type(2)));
typedef unsigned u32x4 __attribute__((ext_vector_type(4)));
#define LAS __attribute__((address_space(3)))

constexpr int D = 1024, NB = 8, SEQ = 4096, CTXL = 256, NLAT = NB * SEQ, NCTX = NB * CTXL, T = NLAT + NCTX;
constexpr int NLAYER = 2;
constexpr int UC = 3584;
constexpr int INC = 3592;
constexpr int NE = 16;
constexpr float ALPHA = 1.41421356237309515f;
constexpr float LN_EPS = 1e-5f, RMS_EPS = 1e-6f;
constexpr int MAXTILES = 288;

enum { I_X = 0, I_C, I_CTX, I_CCTX, I_WADA, I_BADA, I_WIN, I_HYCW, I_HYCB, I_HYW1, I_HYB1, I_HYF1, I_HYW2, I_HYB2, I_HYF2, I_HYW3, I_HYDEC, I_HYBIAS,
       I_SCCW, I_HGLB, I_HGNG, I_SSDCW, I_SSDCB, I_SSDALOG, I_SSDDTB, I_SSDD, I_SSDNG, I_WGATE, I_BGATE, I_WBR, I_WO, I_LN1G, I_LN1B, I_LN2G, I_LN2B,
       I_WROUTER, I_BROUTER, I_WE1, I_WE3, I_WE2, N_IN };

constexpr size_t al256(size_t x) { return (x + 255) & ~(size_t)255; }
constexpr size_t WS_CTL = 0;
constexpr size_t CTL_BYTES = 65536;
constexpr size_t CTL_CNT = 16384;
constexpr size_t WS_MOD = WS_CTL + CTL_BYTES;
constexpr size_t WS_LB = WS_MOD + al256((size_t)NLAYER * 9 * 6144 * 4);
constexpr size_t WS_TW = WS_LB + 4096;
constexpr size_t WS_H2TAB = WS_TW + 65536;
constexpr size_t WS_PART = WS_H2TAB + (size_t)8448 * 64 * 4;
constexpr size_t WS_FILT = WS_PART + (size_t)3 * 64 * 512 * 4;
constexpr size_t WS_FILTC = WS_FILT + (size_t)2 * 8192 * 256 * 4;
constexpr size_t WS_CX32 = WS_FILTC + (size_t)512 * 256 * 4;
constexpr size_t WS_DT = WS_CX32 + (size_t)NCTX * D * 4;
constexpr size_t WS_SSQ = WS_DT + (size_t)T * 8 * 4;
constexpr size_t WS_TOKE = WS_SSQ + (size_t)T * 4 * 4;
constexpr size_t WS_TOKW = WS_TOKE + (size_t)T * 2 * 4;
constexpr size_t WS_TOKS = WS_TOKW + (size_t)T * 2 * 4;
constexpr size_t WS_LIST = WS_TOKS + (size_t)T * 2 * 4;
constexpr size_t WS_BGP = WS_LIST + (size_t)NE * T * 4;
constexpr size_t WS_DEC = WS_BGP + 16384;
constexpr size_t WS_WIN = WS_DEC + (size_t)4352 * 64 * 4;
constexpr size_t WS_WG = WS_WIN + (size_t)UC * D * 2;
constexpr size_t WS_WBR = WS_WG + (size_t)4096 * D * 2;
constexpr size_t WS_WO = WS_WBR + (size_t)4096 * 256 * 2;
constexpr size_t WS_HBUF = WS_WO + (size_t)D * D * 2;
constexpr size_t WS_BR = WS_HBUF + (size_t)T * D * 2;
constexpr size_t WS_BIG = WS_BR + (size_t)T * D * 2;
constexpr size_t BIG_U = 0;
constexpr size_t BIG_HGO = BIG_U + (size_t)T * UC * 2;
constexpr size_t BIG_STATE = BIG_HGO;
constexpr size_t BIG_SSY = BIG_HGO + (size_t)T * 256 * 4;
constexpr size_t BIG_WT = BIG_SSY + (size_t)T * 256 * 4;
constexpr size_t BIG_END1 = BIG_WT + (size_t)T * 256 * 2;
constexpr size_t BIG_P = 0;
constexpr size_t BIG_HID = 0;
constexpr size_t BIG_YE = BIG_HID + (size_t)MAXTILES * 256 * 512 * 2;
constexpr size_t BIG_W13 = BIG_YE + (size_t)MAXTILES * 256 * 1024 * 2;
constexpr size_t BIG_W2 = BIG_W13 + (size_t)NE * 1024 * 1024 * 2;
constexpr size_t BIG_END3 = BIG_W2 + (size_t)NE * 1024 * 512 * 2;
constexpr size_t BIG_BYTES = BIG_END1 > BIG_END3 ? BIG_END1 : BIG_END3;
constexpr size_t WS_END = WS_BIG + BIG_BYTES;
static_assert((size_t)T * 4096 * 2 <= BIG_BYTES, "P fits");
static_assert(WS_END <= (size_t)536870912, "workspace budget");

constexpr int LDS_BYTES = 147456;
constexpr int LDS_MISC = 147456 - 256;

struct Args { const float* in[N_IN]; float* out; unsigned char* ws; int ph_lo, ph_hi; };

#define XB_TMO      128
#define XB_XCNT(j)  (256  + 64 * (j))
#define XB_XSUB(j)  (1280 + 64 * (j))
#define XB_XGEN(j)  (2304 + 64 * (j))
#define XB_TOP      3328
#define XB_TOPGEN   3392
#define XCD_BAR_WORDS 3456
#define XB_SPIN_CAP (1u << 18)
__device__ __forceinline__ unsigned xb_ld(unsigned* p)              { return __hip_atomic_load(p, __ATOMIC_RELAXED, __HIP_MEMORY_SCOPE_AGENT); }
__device__ __forceinline__ unsigned xb_add(unsigned* p, unsigned v) { return __hip_atomic_fetch_add(p, v, __ATOMIC_RELAXED, __HIP_MEMORY_SCOPE_AGENT); }
__device__ __forceinline__ unsigned xb_xcc_id() { return (unsigned)__builtin_amdgcn_s_getreg((3 << 11) | 20) & 0xFu; }
#define XB_SPIN(cond, bar) do { unsigned _sp = 0; while (cond) { __builtin_amdgcn_s_sleep(1); \
    if ((++_sp & 255u) == 0u) { if (xb_ld(&(bar)[XB_TMO])) break; if (_sp > XB_SPIN_CAP) { atomicAdd(&(bar)[XB_TMO], 1u); break; } } } } while (0)
struct XcdBarrier { unsigned* bar; unsigned x; volatile LAS unsigned* st; };
__device__ __forceinline__ int lane_id() { unsigned z = 0u; asm volatile("" : "+v"(z)); return (int)__builtin_amdgcn_mbcnt_hi(~0u, __builtin_amdgcn_mbcnt_lo(~0u, z)); }
__device__ __forceinline__ bool is_thread0(int wave_s) { return wave_s == 0 && lane_id() == 0; }
__device__ __forceinline__ XcdBarrier xcd_barrier_post(unsigned* bar, volatile LAS unsigned* st, int wave_s) {
    XcdBarrier b; b.bar = bar; b.x = xb_xcc_id(); b.st = st;
    if (is_thread0(wave_s)) (void)xb_add(&bar[XB_XCNT(b.x)], 1u);
    return b;
}
__device__ __forceinline__ void xcd_barrier_complete(unsigned* bar, unsigned x, unsigned& nloc, unsigned& nx) {
    const unsigned G = gridDim.x * gridDim.y * gridDim.z;
    unsigned sum, cnt, mine, sp = 0u;
    for (;;) {
        sum = 0u; cnt = 0u; mine = 0u;
#pragma unroll
        for (unsigned j = 0; j < 16; ++j) { const unsigned c = xb_ld(&bar[XB_XCNT(j)]); sum += c; cnt += (c > 0u) ? 1u : 0u; mine = (j == x) ? c : mine; }
        if (sum == G) break;
        __builtin_amdgcn_s_sleep(1);
        if ((++sp & 255u) == 0u) { if (xb_ld(&bar[XB_TMO])) break; if (sp > XB_SPIN_CAP) { atomicAdd(&bar[XB_TMO], 1u); break; } }
    }
    nloc = mine > 0u ? mine : 1u; nx = cnt > 0u ? cnt : 1u;
}
__device__ __forceinline__ void xcd_barrier(const XcdBarrier& b, int wave_s) {
    asm volatile("s_waitcnt vmcnt(0)" ::: "memory");
    __syncthreads();
    if (is_thread0(wave_s)) {
        unsigned* bar = b.bar;
        __builtin_amdgcn_s_waitcnt(0);
        unsigned nloc = b.st[0], nx = b.st[1];
        if (nloc == 0u) { xcd_barrier_complete(bar, b.x, nloc, nx); b.st[0] = nloc; b.st[1] = nx; }
        const unsigned old = xb_add(&bar[XB_XSUB(b.x)], 1u);
        const unsigned gen = old / nloc;
        if (old + 1u == (gen + 1u) * nloc) {
            __builtin_amdgcn_fence(__ATOMIC_RELEASE, "agent");
            asm volatile("s_waitcnt vmcnt(0)" ::: "memory");
            const unsigned og = xb_add(&bar[XB_TOP], 1u);
            const unsigned tg = og / nx;
            if (og + 1u == (tg + 1u) * nx) xb_add(&bar[XB_TOPGEN], 1u);
            else XB_SPIN(xb_ld(&bar[XB_TOPGEN]) == tg, bar);
            __builtin_amdgcn_fence(__ATOMIC_ACQUIRE, "agent");
            xb_add(&bar[XB_XGEN(b.x)], 1u);
            asm volatile("s_waitcnt vmcnt(0)" ::: "memory");
        } else {
            XB_SPIN(xb_ld(&bar[XB_XGEN(b.x)]) == gen, bar);
            __builtin_amdgcn_fence(__ATOMIC_ACQUIRE, "agent");
            asm volatile("s_waitcnt vmcnt(0)" ::: "memory");
        }
    }
    __syncthreads();
}

__device__ __forceinline__ float bf2f(bf16_t b) { return __uint_as_float(((unsigned)b) << 16); }
typedef __bf16 hwbf2 __attribute__((ext_vector_type(2)));
typedef float hwf2 __attribute__((ext_vector_type(2)));
__device__ __forceinline__ unsigned pack2(float lo, float hi) { const hwf2 v = {lo, hi}; return __builtin_bit_cast(unsigned, __builtin_convertvector(v, hwbf2)); }
__device__ __forceinline__ bf16_t f2bf(float f) { return (bf16_t)(pack2(f, 0.f) & 0xffffu); }
__device__ __forceinline__ float sigmoidf_(float x) { return 1.0f / (1.0f + __expf(-x)); }
__device__ __forceinline__ float siluf_(float x) { return x * sigmoidf_(x); }
__device__ __forceinline__ float wave_sum(float v) {
#pragma unroll
    for (int o = 32; o >= 1; o >>= 1) v += __shfl_xor(v, o);
    return v;
}
__device__ __forceinline__ int row_modidx(int r) { return r < NLAT ? (r >> 12) : 8; }
__device__ __forceinline__ bool row_has_prev(int r) { return r < NLAT ? ((r & 4095) != 0) : (((r - NLAT) & 255) != 0); }
__device__ __forceinline__ bool row_has_next(int r) { return r < NLAT ? ((r & 4095) != 4095) : (((r - NLAT) & 255) != 255); }

struct Ptrs {
    float* out; unsigned char* ws; int tid, bid, G;
    __device__ __forceinline__ const float* inp(int i) const { asm volatile("" : "+s"(i));
        const __attribute__((address_space(4))) char* ka = (const __attribute__((address_space(4))) char*)__builtin_amdgcn_kernarg_segment_ptr();
        return *(const float* const __attribute__((address_space(4)))*)(ka + 8 * i); }
    __device__ __forceinline__ float* latrow(int r) const { return r < NLAT ? out + (size_t)r * D : (float*)(ws + WS_CX32) + (size_t)(r - NLAT) * D; }
    __device__ __forceinline__ float* mod(int l, int ridx) const { return (float*)(ws + WS_MOD) + ((size_t)l * 9 + ridx) * 6144; }
};

__device__ __forceinline__ float conv3_u(const bf16_t* U, int row, int col, const float* w, int ncol, int wcol) {
    const bool hp = row_has_prev(row), hn = row_has_next(row);
    const float c = bf2f(U[(size_t)row * UC + col]), p = bf2f(U[(size_t)(hp ? row - 1 : row) * UC + col]), n = bf2f(U[(size_t)(hn ? row + 1 : row) * UC + col]);
    return c * w[ncol + wcol] + (hp ? p * w[wcol] : 0.f) + (hn ? n * w[2 * ncol + wcol] : 0.f);
}

struct Unit { int pm, pn, e, aux; };
__host__ __device__ __forceinline__ int perm32(int rho) { const int n = rho >> 4, i = rho & 15; return 8 * (i >> 2) + 4 * n + (i & 3); }

template <class RowMap, class Epi>
__device__ __forceinline__ void sgemm_unit(int tid_, const bf16_t* __restrict__ A, int lda, const bf16_t* __restrict__ Bt, int ldb, int K, const Unit& u, const RowMap& RM, const Epi& E) {
    const int tid = tid_, wid = tid >> 6, lane = tid & 63, wr = wid >> 2, wc = wid & 3, fr = lane & 15, fq = lane >> 4;
    f32x4 acc[2][2][4][2];
#pragma unroll
    for (int a = 0; a < 2; ++a)
#pragma unroll
        for (int b = 0; b < 2; ++b)
#pragma unroll
            for (int m = 0; m < 4; ++m)
#pragma unroll
                for (int n = 0; n < 2; ++n) acc[a][b][m][n] = (f32x4){0.f, 0.f, 0.f, 0.f};
    unsigned ap[2][4], bp[2][2];
#pragma unroll
    for (int a = 0; a < 2; ++a)
#pragma unroll
        for (int m = 0; m < 4; ++m) ap[a][m] = (unsigned)RM(u, 128 * a + 64 * wr + 16 * m + fr) * (unsigned)lda + fq * 8;
#pragma unroll
    for (int b = 0; b < 2; ++b)
#pragma unroll
        for (int n = 0; n < 2; ++n) { const int rho = 16 * n + fr; const int col = Epi::PERM ? perm32(rho) : rho;
            bp[b][n] = (unsigned)(u.pn * 256 + 128 * b + 32 * wc + col) * (unsigned)ldb + fq * 8; }
    for (int k = 0; k < K; k += 32) {
        bf16x8 bfr[2][2];
#pragma unroll
        for (int b = 0; b < 2; ++b)
#pragma unroll
            for (int n = 0; n < 2; ++n) bfr[b][n] = *(const bf16x8*)(Bt + (bp[b][n] + k));
#pragma unroll
        for (int a = 0; a < 2; ++a) {
            bf16x8 af[4];
#pragma unroll
            for (int m = 0; m < 4; ++m) af[m] = *(const bf16x8*)(A + (ap[a][m] + k));
#pragma unroll
            for (int b = 0; b < 2; ++b)
#pragma unroll
                for (int m = 0; m < 4; ++m)
#pragma unroll
                    for (int n = 0; n < 2; ++n) acc[a][b][m][n] = __builtin_amdgcn_mfma_f32_16x16x32_bf16(bfr[b][n], af[m], acc[a][b][m][n], 0, 0, 0);
        }
    }
    E(acc, u, wr, wc, fr, fq);
}

struct RowIdent { __device__ __forceinline__ int operator()(const Unit& u, int R) const { return u.pm * 256 + R; } };
struct RowStackK { int rows; __device__ __forceinline__ int operator()(const Unit& u, int R) const { return u.e * rows + u.pm * 256 + R; } };
struct RowGather { const int* list; const unsigned* cnt; __device__ __forceinline__ int operator()(const Unit& u, int R) const {
    const int idx = u.aux * 256 + R; const int* l = list + (size_t)u.e * T; return idx < (int)cnt[u.e] ? l[idx] : l[0]; } };


namespace pg8 {
constexpr int BM = 256, BK = 64, HALF = 128, HTB = HALF * BK * 2, STAGE_BYTES = 8 * HTB;
__host__ __device__ __forceinline__ int lds_byte(int r, int c) { const int st = (r >> 4) * 2 + (c >> 5), rr = r & 15, cc = c & 31, ob = rr * 64 + cc * 2; return st * 1024 + (ob ^ (((ob >> 9) & 1) << 5)); }
__host__ __device__ __forceinline__ void stage_rc(int b, int& R, int& C) { const int st = b / 1024, sb = b % 1024, swz = sb ^ (((sb >> 9) & 1) << 5); R = (st >> 1) * 16 + swz / 64; C = (st & 1) * 32 + (swz % 64) / 2; }
struct Gemm { const bf16_t* A; const bf16_t* Bt; int K; };

template <class Epi, class Sched, bool GATHER>
__device__ __forceinline__ void gemm_phase(int tid, LAS unsigned char* lds, const Gemm g, const Sched& S, const Epi& E) {
    const int wid = __builtin_amdgcn_readfirstlane(tid >> 6), lane = tid & 63, wr = wid >> 2, wc = wid & 3, fr = lane & 15, fq = lane >> 4;
    const int K = g.K, nt = K / BK;
    int RA[2], CA[2]; unsigned voffB[2];
    unsigned vA[2][2], vAn[2][2];
#pragma unroll
    for (int i = 0; i < 2; ++i) { int R, C; stage_rc(tid * 16 + i * 8192, R, C); RA[i] = R; CA[i] = C; const int Rb = Epi::PERM ? ((R & ~31) + perm32(R & 31)) : R; voffB[i] = (unsigned)(Rb * K + C) * 2u; }
    const size_t kstep = (size_t)(BK * 2);
    const size_t hstep = (size_t)HALF * K * 2;
    const size_t tstep = 2 * hstep;
    const unsigned ldsw = (unsigned)wid * 1024u;
    const int aoff = lds_byte(wr * 64 + fr, fq * 8), boff = lds_byte(wc * 32 + fr, fq * 8);
#define PG8_SA(b, h) (((b) * 2 + (h)) * HTB)
#define PG8_SB(b, h) ((4 + (b) * 2 + (h)) * HTB)
#define PG8_STAGE(bufoff, gbase, voff) do { _Pragma("unroll") for (int _i = 0; _i < 2; ++_i) \
        __builtin_amdgcn_global_load_lds((const unsigned*)((const char*)(gbase) + (voff)[_i]), (LAS unsigned*)(lds + (bufoff) + ldsw + _i * 8192), 16, 0, 0); } while (0)
#define PG8_STAGE2(bufoff, gbase, v0, v1) do { \
        __builtin_amdgcn_global_load_lds((const unsigned*)((const char*)(gbase) + (v0)), (LAS unsigned*)(lds + (bufoff) + ldsw), 16, 0, 0); \
        __builtin_amdgcn_global_load_lds((const unsigned*)((const char*)(gbase) + (v1)), (LAS unsigned*)(lds + (bufoff) + ldsw + 8192), 16, 0, 0); } while (0)
#define PG8_LDA(dst, b, h) do { _Pragma("unroll") for (int m = 0; m < 4; ++m) _Pragma("unroll") for (int k = 0; k < 2; ++k) dst[m][k] = *(const LAS bf16x8*)(lds + PG8_SA(b, h) + aoff + m * 2048 + k * 1024); } while (0)
#define PG8_LDB(dst, b, h) do { _Pragma("unroll") for (int n = 0; n < 2; ++n) _Pragma("unroll") for (int k = 0; k < 2; ++k) dst[n][k] = *(const LAS bf16x8*)(lds + PG8_SB(b, h) + boff + n * 2048 + k * 1024); } while (0)
#define PG8_MMA(ai, bj, At, Bt) do { __builtin_amdgcn_s_setprio(1); _Pragma("unroll") for (int m = 0; m < 4; ++m) _Pragma("unroll") for (int n = 0; n < 2; ++n) _Pragma("unroll") for (int k = 0; k < 2; ++k) \
        acc[ai][bj][m][n] = __builtin_amdgcn_mfma_f32_16x16x32_bf16(Bt[n][k], At[m][k], acc[ai][bj][m][n], 0, 0, 0); __builtin_amdgcn_s_setprio(0); } while (0)
#define PG8_WAIT_V(n) asm volatile("s_waitcnt vmcnt(" #n ")" ::: "memory")
#define PG8_WAIT_L(n) asm volatile("s_waitcnt lgkmcnt(" #n ")" ::: "memory")
#define PG8_BAR __builtin_amdgcn_s_barrier()
#define PG8_SCHED __builtin_amdgcn_sched_barrier(0)
#define PG8_AOFFS(dst, unit) do { _Pragma("unroll") for (int _h = 0; _h < 2; ++_h) _Pragma("unroll") for (int _i = 0; _i < 2; ++_i) \
        dst[_h][_i] = GATHER ? ((unsigned)S.arow(unit, _h * HALF + RA[_i]) * (unsigned)K + (unsigned)CA[_i]) * 2u : ((unsigned)(_h * HALF + RA[_i]) * (unsigned)K + (unsigned)CA[_i]) * 2u; } while (0)
    Unit cur, nxt; int ui = 0;
    if (!S.next(0, cur)) return;
    f32x4 acc[2][2][4][2];
#pragma unroll
    for (int a = 0; a < 2; ++a)
#pragma unroll
        for (int b = 0; b < 2; ++b)
#pragma unroll
            for (int m = 0; m < 4; ++m)
#pragma unroll
                for (int n = 0; n < 2; ++n) acc[a][b][m][n] = (f32x4){0.f, 0.f, 0.f, 0.f};
    bf16x8 At[4][2], B0[2][2], B1[2][2];
    const char* cA = GATHER ? (const char*)g.A : (const char*)g.A + (size_t)cur.pm * tstep; const char* cB = (const char*)g.Bt + (size_t)cur.pn * tstep;
    PG8_AOFFS(vA, cur);
    PG8_STAGE(PG8_SB(0, 0), cB, voffB); PG8_STAGE(PG8_SB(0, 1), cB + hstep, voffB); PG8_STAGE2(PG8_SA(0, 0), cA, vA[0][0], vA[0][1]); PG8_STAGE2(PG8_SA(0, 1), cA, vA[1][0], vA[1][1]);
    if (wr == 1) PG8_BAR;
    PG8_WAIT_V(2); PG8_BAR;
    PG8_STAGE(PG8_SB(1, 0), cB + kstep, voffB); PG8_STAGE2(PG8_SA(1, 0), cA + kstep, vA[0][0], vA[0][1]); PG8_STAGE(PG8_SB(1, 1), cB + hstep + kstep, voffB);
    PG8_WAIT_V(6); PG8_BAR;
    for (;;) {
        const bool has_next = S.next(ui + 1, nxt);
        const char* nA = GATHER ? (const char*)g.A : (has_next ? (const char*)g.A + (size_t)nxt.pm * tstep : cA); const char* nB = has_next ? (const char*)g.Bt + (size_t)nxt.pn * tstep : cB;
        if (has_next) { PG8_AOFFS(vAn, nxt); } else {
#pragma unroll
            for (int _h = 0; _h < 2; ++_h)
#pragma unroll
                for (int _i = 0; _i < 2; ++_i) vAn[_h][_i] = vA[_h][_i]; }
#pragma unroll 1
        for (int t = 0; t < nt; t += 2) {
            const bool last = (t == nt - 2);
            const char* a1 = cA + (size_t)(t + 1) * kstep;
            const char* a2 = last ? nA : cA + (size_t)(t + 2) * kstep; const char* b2 = last ? nB : cB + (size_t)(t + 2) * kstep;
            const char* a3 = a2 + kstep; const char* b3 = b2 + kstep;
            const unsigned x00 = last ? vAn[0][0] : vA[0][0], x01 = last ? vAn[0][1] : vA[0][1], x10 = last ? vAn[1][0] : vA[1][0], x11 = last ? vAn[1][1] : vA[1][1];
            PG8_LDB(B0, 0, 0); PG8_LDB(B1, 0, 1); PG8_SCHED; PG8_LDA(At, 0, 0); PG8_STAGE2(PG8_SA(1, 1), a1, vA[1][0], vA[1][1]);
            PG8_WAIT_V(8); PG8_WAIT_L(0); PG8_BAR; PG8_MMA(0, 0, At, B0); PG8_MMA(0, 1, At, B1); PG8_BAR; PG8_SCHED;
            PG8_LDA(At, 0, 1); PG8_STAGE(PG8_SB(0, 0), b2, voffB); PG8_STAGE(PG8_SB(0, 1), b2 + hstep, voffB); PG8_STAGE2(PG8_SA(0, 0), a2, x00, x01);
            PG8_WAIT_V(8); PG8_WAIT_L(0); PG8_BAR; PG8_MMA(1, 0, At, B0); PG8_MMA(1, 1, At, B1); PG8_BAR; PG8_SCHED;
            PG8_LDB(B0, 1, 0); PG8_LDB(B1, 1, 1); PG8_SCHED; PG8_LDA(At, 1, 0); PG8_STAGE2(PG8_SA(0, 1), a2, x10, x11);
            PG8_WAIT_V(8); PG8_WAIT_L(0); PG8_BAR; PG8_MMA(0, 0, At, B0); PG8_MMA(0, 1, At, B1); PG8_BAR; PG8_SCHED;
            PG8_LDA(At, 1, 1); PG8_STAGE(PG8_SB(1, 0), b3, voffB); PG8_STAGE(PG8_SB(1, 1), b3 + hstep, voffB); PG8_STAGE2(PG8_SA(1, 0), a3, x00, x01);
            PG8_WAIT_V(8); PG8_WAIT_L(0); PG8_BAR; PG8_MMA(1, 0, At, B0); PG8_MMA(1, 1, At, B1); PG8_BAR; PG8_SCHED;
        }
        if (wr == 0) PG8_BAR;
        E(acc, cur, wr, wc, fr, fq);
        if (!has_next) break;
#pragma unroll
        for (int a = 0; a < 2; ++a)
#pragma unroll
            for (int b = 0; b < 2; ++b)
#pragma unroll
                for (int m = 0; m < 4; ++m)
#pragma unroll
                    for (int n = 0; n < 2; ++n) acc[a][b][m][n] = (f32x4){0.f, 0.f, 0.f, 0.f};
        cur = nxt; cA = nA; cB = nB; ++ui;
#pragma unroll
        for (int _h = 0; _h < 2; ++_h)
#pragma unroll
            for (int _i = 0; _i < 2; ++_i) vA[_h][_i] = vAn[_h][_i];
        if (wr == 1) PG8_BAR;
    }
    PG8_WAIT_V(0);
    PG8_BAR;
#undef PG8_SA
#undef PG8_SB
#undef PG8_STAGE
#undef PG8_STAGE2
#undef PG8_LDA
#undef PG8_LDB
#undef PG8_MMA
#undef PG8_WAIT_V
#undef PG8_WAIT_L
#undef PG8_BAR
#undef PG8_SCHED
#undef PG8_AOFFS
}
}

struct XOrder { int G, c, MT, NT;
    __device__ __forceinline__ bool map(int i, int& pm, int& pn) const {
        if ((G & 7) == 0 && (MT & 7) == 0) { const int x = c & 7, r = c >> 3, W = G >> 3, MX = MT >> 3; const int L = i * W + r; if (L >= MX * NT) return false; pm = x * MX + L / NT; pn = L % NT; return true; }
        const int L = i * G + c; if (L >= MT * NT) return false; pm = L / NT; pn = L % NT; return true; } };
struct SchedG1 { XOrder X; __device__ __forceinline__ bool next(int i, Unit& u) const { int pm, pn; if (!X.map(i, pm, pn)) return false; u.pm = pm; u.pn = pn; u.e = 0; u.aux = 0; return true; }
    __device__ __forceinline__ int arow(const Unit&, int) const { return 0; } };
struct SchedG2 { XOrder X; __device__ __forceinline__ bool next(int i, Unit& u) const { int pm, q; if (!X.map(i, pm, q)) return false; const int k = q >> 2, pnn = q & 3;
        u.pm = k * (T / 256) + pm; u.pn = k * 4 + pnn; u.e = k; u.aux = pnn; return true; }
    __device__ __forceinline__ int arow(const Unit&, int) const { return 0; } };
struct SchedMN { XOrder X; __device__ __forceinline__ bool next(int i, Unit& u) const { int pm, pn; if (!X.map(i, pm, pn)) return false; u.pm = pm; u.pn = pn; u.e = 0; u.aux = 0; return true; }
    __device__ __forceinline__ int arow(const Unit&, int) const { return 0; } };

struct EpiBf16Plain {
    static constexpr bool PERM = true;
    bf16_t* O; int ldc; int coltile_mask;
    __device__ __forceinline__ void operator()(const f32x4 (&acc)[2][2][4][2], const Unit& u, int wr, int wc, int fr, int fq) const {
        const int row0 = u.pm * 256 + wr * 64 + fr, col0 = (u.pn & coltile_mask) * 256 + wc * 32 + 8 * fq;
#pragma unroll
        for (int ai = 0; ai < 2; ++ai)
#pragma unroll
            for (int m = 0; m < 4; ++m) { bf16_t* rowp = O + (size_t)(row0 + ai * 128 + m * 16) * ldc + col0;
#pragma unroll
                for (int bj = 0; bj < 2; ++bj) { const f32x4 v0 = acc[ai][bj][m][0], v1 = acc[ai][bj][m][1];
                    u32x4 w; w.x = pack2(v0[0], v0[1]); w.y = pack2(v0[2], v0[3]); w.z = pack2(v1[0], v1[1]); w.w = pack2(v1[2], v1[3]);
                    *(u32x4*)(rowp + bj * 128) = w; } }
    }
};
struct EpiP {
    static constexpr bool PERM = true;
    bf16_t* P; const float* ssq;
    __device__ __forceinline__ void operator()(const f32x4 (&acc)[2][2][4][2], const Unit& u, int wr, int wc, int fr, int fq) const {
        const int k = u.e; const int pmt = u.pm - k * (T / 256);
        const unsigned c00 = (unsigned)(u.aux * 256 + wc * 32 + 8 * fq);
        const unsigned base = (unsigned)pmt * (16u * 256u * 256u) + (unsigned)k * 64u;
#pragma unroll
        for (int ai = 0; ai < 2; ++ai)
#pragma unroll
            for (int m = 0; m < 4; ++m) { const int r = ai * 128 + wr * 64 + m * 16 + fr; float sc = 1.0f;
                if (k == 3) { const float* qp = ssq + (size_t)(pmt * 256 + r) * 4; sc = rsqrtf((qp[0] + qp[1] + qp[2] + qp[3]) * (1.0f / 256.0f) + RMS_EPS); }
#pragma unroll
                for (int bj = 0; bj < 2; ++bj) { const unsigned c0 = c00 + bj * 128; const unsigned s = c0 >> 6, wi = c0 & 63;
                    const f32x4 v0 = acc[ai][bj][m][0] * sc, v1 = acc[ai][bj][m][1] * sc;
                    u32x4 w; w.x = pack2(v0[0], v0[1]); w.y = pack2(v0[2], v0[3]); w.z = pack2(v1[0], v1[1]); w.w = pack2(v1[2], v1[3]);
                    *(u32x4*)(P + (base + (s * 256u + (unsigned)r) * 256u + wi)) = w; }
                asm volatile("" ::: "memory"); }
    }
};
struct EpiMerge {
    static constexpr bool PERM = false;
    const bf16_t* P; const float* bgp; bf16_t* Y;
    __device__ __forceinline__ void operator()(const f32x4 (&acc)[2][2][4][2], const Unit& u, int wr, int wc, int fr, int fq) const {
        const int s = u.pn;
        f32x4 bv[2][2];
#pragma unroll
        for (int bj = 0; bj < 2; ++bj)
#pragma unroll
            for (int n = 0; n < 2; ++n) bv[bj][n] = *(const f32x4*)(bgp + s * 256 + bj * 128 + wc * 32 + n * 16 + 4 * fq);
#pragma unroll
        for (int ai = 0; ai < 2; ++ai)
#pragma unroll
            for (int m = 0; m < 4; ++m) { const int r = ai * 128 + wr * 64 + m * 16 + fr;
                const bf16_t* pp = P + (((size_t)u.pm * 16 + s) * 256 + r) * 256 + wc * 16 + 4 * fq;
                f32x4 y = (f32x4){0.f, 0.f, 0.f, 0.f};
#pragma unroll
                for (int bj = 0; bj < 2; ++bj)
#pragma unroll
                    for (int n = 0; n < 2; ++n) { const int k = 2 * bj + n; const u32x2 pw = *(const u32x2*)(pp + k * 64);
                        const f32x4 g = acc[ai][bj][m][n] + bv[bj][n];
                        y[0] += sigmoidf_(g[0]) * __uint_as_float(pw.x << 16); y[1] += sigmoidf_(g[1]) * __uint_as_float(pw.x & 0xffff0000u);
                        y[2] += sigmoidf_(g[2]) * __uint_as_float(pw.y << 16); y[3] += sigmoidf_(g[3]) * __uint_as_float(pw.y & 0xffff0000u); }
                u32x2 w; w.x = pack2(y[0], y[1]); w.y = pack2(y[2], y[3]);
                *(u32x2*)(Y + (size_t)(u.pm * 256 + r) * D + s * 64 + wc * 16 + 4 * fq) = w; }
    }
};
struct EpiWo {
    static constexpr bool PERM = false;
    Ptrs P; int layer;
    __device__ __forceinline__ void operator()(const f32x4 (&acc)[2][2][4][2], const Unit& u, int wr, int wc, int fr, int fq) const {
        const int col0 = u.pn * 256 + wc * 32 + 4 * fq;
#pragma unroll
        for (int ai = 0; ai < 2; ++ai)
#pragma unroll
            for (int m = 0; m < 4; ++m) { const int row = u.pm * 256 + ai * 128 + wr * 64 + m * 16 + fr;
                float* lp = P.latrow(row) + col0; const float* g1 = P.mod(layer, row_modidx(row)) + 2048 + col0;
#pragma unroll
                for (int bj = 0; bj < 2; ++bj)
#pragma unroll
                    for (int n = 0; n < 2; ++n) { const f32x4 x = *(const f32x4*)(lp + bj * 128 + n * 16); const f32x4 g = *(const f32x4*)(g1 + bj * 128 + n * 16);
                        *(f32x4*)(lp + bj * 128 + n * 16) = x * ALPHA + g * acc[ai][bj][m][n]; } }
    }
};
struct EpiFfn1 {
    static constexpr bool PERM = false;
    bf16_t* H;
    __device__ __forceinline__ void operator()(const f32x4 (&acc)[2][2][4][2], const Unit& u, int wr, int wc, int fr, int fq) const {
        const int pnn = u.pn & 3;
#pragma unroll
        for (int ai = 0; ai < 2; ++ai)
#pragma unroll
            for (int m = 0; m < 4; ++m) { const int pos = u.pm * 256 + ai * 128 + wr * 64 + m * 16 + fr;
#pragma unroll
                for (int bj = 0; bj < 2; ++bj) { const f32x4 a = acc[ai][bj][m][0], b = acc[ai][bj][m][1];
                    u32x2 w; w.x = pack2(siluf_(a[0]) * b[0], siluf_(a[1]) * b[1]); w.y = pack2(siluf_(a[2]) * b[2], siluf_(a[3]) * b[3]);
                    *(u32x2*)(H + (size_t)pos * 512 + pnn * 128 + bj * 64 + wc * 16 + 4 * fq) = w; } }
    }
};

template <class SrcFn>
__device__ __forceinline__ void conv_tile(int tid, LAS float* tile  , bf16_t* dst, int ldd, int n0, int k0, const SrcFn& src) {
    f32x4 v[8];
#pragma unroll
    for (int i = 0; i < 8; ++i) { const int kk = (tid >> 4) + 32 * i, j4 = tid & 15; v[i] = *(const f32x4*)src(k0 + kk, n0 + 4 * j4); }
#pragma unroll
    for (int i = 0; i < 8; ++i) { const int kk = (tid >> 4) + 32 * i, j4 = tid & 15; LAS float* t = tile + kk * 65 + 4 * j4; t[0] = v[i][0]; t[1] = v[i][1]; t[2] = v[i][2]; t[3] = v[i][3]; }
    __syncthreads();
    { const int jj = tid >> 3, kq = tid & 7;
#pragma unroll
      for (int kb = 0; kb < 4; ++kb) { float x[8];
#pragma unroll
          for (int i = 0; i < 8; ++i) x[i] = tile[(64 * kb + 8 * kq + i) * 65 + jj];
          u32x4 w; w.x = pack2(x[0], x[1]); w.y = pack2(x[2], x[3]); w.z = pack2(x[4], x[5]); w.w = pack2(x[6], x[7]);
          *(u32x4*)(dst + (size_t)(n0 + jj) * ldd + k0 + 64 * kb + 8 * kq) = w; } }
    __syncthreads();
}
constexpr int NCONV_NE = 56 * 4 + 64 * 4 + 64 * 1 + 16 * 4;
constexpr int NCONV_EX = NE * (16 * 4 + 16 * 2);
__device__ __forceinline__ int gate_srccol(int np) { const int s = np >> 8, bj = (np >> 7) & 1, wc = (np >> 5) & 3, n = (np >> 4) & 1, fqe = np & 15; return (2 * bj + n) * 1024 + 64 * s + 16 * wc + fqe; }
__device__ __forceinline__ void conv_unit_ne(const Ptrs P, int l, int t, LAS float* tile) {
    unsigned char* ws = P.ws;
    if (t < 224) { const int nt = t >> 2, kt = t & 3; const float* src = P.inp(I_WIN) + (size_t)l * D * INC;
        conv_tile(P.tid, tile, (bf16_t*)(ws + WS_WIN), D, nt * 64, kt * 256, [=](int k, int n) { return src + (size_t)k * INC + n; });
    } else if (t < 224 + 256) { t -= 224; const int nt = t >> 2, kt = t & 3; const float* src = P.inp(I_WGATE) + (size_t)l * D * 4096;
        conv_tile(P.tid, tile, (bf16_t*)(ws + WS_WG), D, nt * 64, kt * 256, [=](int k, int n) { return src + (size_t)k * 4096 + gate_srccol(n); });
        if (kt == 0 && P.tid < 64) { const int np = nt * 64 + P.tid; ((float*)(ws + WS_BGP))[np] = P.inp(I_BGATE)[(size_t)l * 4096 + gate_srccol(np)]; }
    } else if (t < 224 + 256 + 64) { t -= 480; const int nt = t; const int kb = nt >> 4;
        const float* src = P.inp(I_WBR) + ((size_t)l * 4 + kb) * 256 * 1024;
        conv_tile(P.tid, tile, (bf16_t*)(ws + WS_WBR), 256, nt * 64, 0, [=](int k, int n) { return src + (size_t)k * 1024 + (n & 1023); });
    } else { t -= 544; const int nt = t >> 2, kt = t & 3; const float* src = P.inp(I_WO) + (size_t)l * D * D;
        conv_tile(P.tid, tile, (bf16_t*)(ws + WS_WO), D, nt * 64, kt * 256, [=](int k, int n) { return src + (size_t)k * D + n; });
    }
}
__device__ __forceinline__ void conv_unit_ex(const Ptrs P, int l, int t, LAS float* tile) {
    unsigned char* ws = P.ws;
    const int e = t / 96; t -= e * 96;
    if (t < 64) { const int nt = t >> 2, kt = t & 3;
        const float* s1 = P.inp(I_WE1) + ((size_t)l * NE + e) * 1024 * 512; const float* s3 = P.inp(I_WE3) + ((size_t)l * NE + e) * 1024 * 512;
        conv_tile(P.tid, tile, (bf16_t*)(ws + WS_BIG + BIG_W13) + (size_t)e * 1024 * 1024, 1024, nt * 64, kt * 256, [=](int k, int n) {
            const int pn = n >> 8, bj = (n >> 7) & 1, wc = (n >> 5) & 3, nn = (n >> 4) & 1, fqe = n & 15; const int ch = 128 * pn + 64 * bj + 16 * wc + fqe;
            return (nn ? s3 : s1) + (size_t)k * 512 + ch; });
    } else { t -= 64; const int nt = t >> 1, kt = t & 1; const float* src = P.inp(I_WE2) + ((size_t)l * NE + e) * 512 * 1024;
        conv_tile(P.tid, tile, (bf16_t*)(ws + WS_BIG + BIG_W2) + (size_t)e * 1024 * 512, 512, nt * 64, kt * 256, [=](int k, int n) { return src + (size_t)k * 1024 + n; });
    }
}

struct RowV { f32x4 v[4]; };
__device__ __forceinline__ void row_load(RowV& r, const float* p, int lane) {
#pragma unroll
    for (int i = 0; i < 4; ++i) r.v[i] = *(const f32x4*)(p + i * 256 + lane * 4);
}
__device__ __forceinline__ void row_store(const RowV& r, float* p, int lane) {
#pragma unroll
    for (int i = 0; i < 4; ++i) *(f32x4*)(p + i * 256 + lane * 4) = r.v[i];
}
__device__ __forceinline__ void row_layernorm(RowV& r, const float* g, const float* b, int lane) {
    float s = 0.f;
#pragma unroll
    for (int i = 0; i < 4; ++i) s += r.v[i][0] + r.v[i][1] + r.v[i][2] + r.v[i][3];
    const float mu = wave_sum(s) * (1.0f / 1024.0f);
    float q = 0.f;
#pragma unroll
    for (int i = 0; i < 4; ++i) { const f32x4 d = r.v[i] - mu; q += d[0] * d[0] + d[1] * d[1] + d[2] * d[2] + d[3] * d[3]; }
    const float rstd = rsqrtf(wave_sum(q) * (1.0f / 1024.0f) + LN_EPS);
#pragma unroll
    for (int i = 0; i < 4; ++i) { const f32x4 gg = *(const f32x4*)(g + i * 256 + lane * 4), bb = *(const f32x4*)(b + i * 256 + lane * 4); r.v[i] = (r.v[i] - mu) * rstd * gg + bb; }
}
__device__ __forceinline__ void row_layernorm_r(RowV& r, const RowV& g, const RowV& b) {
    float s = 0.f;
#pragma unroll
    for (int i = 0; i < 4; ++i) s += r.v[i][0] + r.v[i][1] + r.v[i][2] + r.v[i][3];
    const float mu = wave_sum(s) * (1.0f / 1024.0f);
    float q = 0.f;
#pragma unroll
    for (int i = 0; i < 4; ++i) { const f32x4 d = r.v[i] - mu; q += d[0] * d[0] + d[1] * d[1] + d[2] * d[2] + d[3] * d[3]; }
    const float rstd = rsqrtf(wave_sum(q) * (1.0f / 1024.0f) + LN_EPS);
#pragma unroll
    for (int i = 0; i < 4; ++i) r.v[i] = (r.v[i] - mu) * rstd * g.v[i] + b.v[i];
}
__device__ __forceinline__ void row_modulate(const RowV& r, RowV& h, const float* sh, const float* sc, int lane) {
#pragma unroll
    for (int i = 0; i < 4; ++i) { const f32x4 a = *(const f32x4*)(sc + i * 256 + lane * 4), b = *(const f32x4*)(sh + i * 256 + lane * 4); h.v[i] = r.v[i] * (a + 1.0f) + b; }
}
__device__ __forceinline__ void row_store_bf16(const RowV& h, bf16_t* p, int lane) {
#pragma unroll
    for (int i = 0; i < 4; ++i) { u32x2 w; w.x = pack2(h.v[i][0], h.v[i][1]); w.y = pack2(h.v[i][2], h.v[i][3]); *(u32x2*)(p + i * 256 + lane * 4) = w; }
}
__device__ __forceinline__ void row_dt(const RowV& h, const LAS float* wdt, float* dtout, int lane) {
    float a[8];
#pragma unroll
    for (int j = 0; j < 8; ++j) a[j] = 0.f;
#pragma unroll
    for (int i = 0; i < 4; ++i)
#pragma unroll
        for (int e = 0; e < 4; ++e) { const int k = i * 256 + lane * 4 + e; const float hv = h.v[i][e];
            const f32x4 w0 = *(const LAS f32x4*)(wdt + k * 8), w1 = *(const LAS f32x4*)(wdt + k * 8 + 4);
            a[0] += hv * w0[0]; a[1] += hv * w0[1]; a[2] += hv * w0[2]; a[3] += hv * w0[3]; a[4] += hv * w1[0]; a[5] += hv * w1[1]; a[6] += hv * w1[2]; a[7] += hv * w1[3]; }
#pragma unroll
    for (int j = 0; j < 8; ++j) a[j] = wave_sum(a[j]);
    if (lane == 0) { *(f32x4*)dtout = (f32x4){a[0], a[1], a[2], a[3]}; *(f32x4*)(dtout + 4) = (f32x4){a[4], a[5], a[6], a[7]}; }
}
__device__ __forceinline__ void load_wdt(const Ptrs P, int l, LAS float* wdt) {
    const float* src = P.inp(I_WIN) + (size_t)l * D * INC + UC;
    for (int i = P.tid; i < 1024 * 8; i += 512) wdt[i] = src[(size_t)(i >> 3) * INC + (i & 7)];
    __syncthreads();
}

__device__ __forceinline__ void phase_pa(const Ptrs P, LAS unsigned char* lds) {
    const int tid = P.tid, wid = tid >> 6, lane = tid & 63, G = P.G;
    const int NU_MOD = 2 * 96, NU_H2 = 8448 / 8, NU_LB = 1;
    const int NU = NU_MOD + NU_H2 + NU_LB + NCONV_NE;
    for (int u = P.bid; u < NU; u += G) {
        if (u < NU_MOD) {
            const int l = u / 96, cb = u % 96;
            LAS float* sc = (LAS float*)lds; LAS float* red = sc + 9 * 1024;
            for (int i = tid; i < 9 * 1024; i += 512) { const int r = i >> 10, k = i & 1023; const float v = r < 8 ? P.inp(I_C)[r * 1024 + k] : P.inp(I_CCTX)[k]; sc[i] = v / (1.0f + expf(-v)); }
            __syncthreads();
            const int col = cb * 64 + lane; const float* w = P.inp(I_WADA) + (size_t)l * D * 6144 + col;
            float acc[9];
#pragma unroll
            for (int r = 0; r < 9; ++r) acc[r] = 0.f;
            for (int k = wid * 128; k < wid * 128 + 128; ++k) { const float wv = w[(size_t)k * 6144];
#pragma unroll
                for (int r = 0; r < 9; ++r) acc[r] += sc[r * 1024 + k] * wv; }
#pragma unroll
            for (int r = 0; r < 9; ++r) red[(wid * 9 + r) * 64 + lane] = acc[r];
            __syncthreads();
            for (int i = tid; i < 9 * 64; i += 512) { const int r = i >> 6, c = i & 63; float s = P.inp(I_BADA)[(size_t)l * 6144 + cb * 64 + c];
#pragma unroll
                for (int w8 = 0; w8 < 8; ++w8) s += red[(w8 * 9 + r) * 64 + c];
                P.mod(l, r)[cb * 64 + c] = s; }
            __syncthreads();
        } else if (u < NU_MOD + NU_H2) {
            const int rho = (u - NU_MOD) * 8 + wid;
            const int l = (rho >= 4096 && rho < 8192) ? 1 : 0; const int L = rho < 8192 ? 4096 : 256; const int i = rho < 8192 ? (rho & 4095) : (rho - 8192);
            float featv = 0.f;
            if (lane == 0) featv = (float)((double)i / (double)(L - 1));
            else if (lane < 33) { const int j = (lane - 1) & 15; const double band = 1e-4 + (double)j * ((15.0 - 1e-4) / 15.0);
                const double ang = (2.0 * 3.14159265358979323846 / (double)L) * (double)i * band; featv = lane < 17 ? (float)cos(ang) : (float)(-sin(ang)); }
            float z1 = P.inp(I_HYB1)[l * 64 + lane];
            for (int m = 0; m < 33; ++m) z1 += __shfl(featv, m) * P.inp(I_HYW1)[((size_t)l * 33 + m) * 64 + lane];
            const float h1 = sinf(P.inp(I_HYF1)[l * 64 + lane] * z1);
            float z2 = P.inp(I_HYB2)[l * 64 + lane];
            for (int m = 0; m < 64; ++m) z2 += __shfl(h1, m) * P.inp(I_HYW2)[((size_t)l * 64 + m) * 64 + lane];
            ((float*)(P.ws + WS_H2TAB))[(size_t)rho * 64 + lane] = sinf(P.inp(I_HYF2)[l * 64 + lane] * z2);
        } else if (u < NU_MOD + NU_H2 + NU_LB) {
            for (int i = tid; i < 4096; i += 512) { const double a = -2.0 * 3.14159265358979323846 * (double)i / 8192.0; ((float*)(P.ws + WS_TW))[2 * i] = (float)cos(a); ((float*)(P.ws + WS_TW))[2 * i + 1] = (float)sin(a); }
            for (int i = tid; i < 1024; i += 512) { const int d = i >> 9, l = (i >> 8) & 1, c = i & 255;
                const float l0 = P.inp(I_HGLB)[d * 512 + c], l1 = P.inp(I_HGLB)[d * 512 + 256 + c];
                ((float*)(P.ws + WS_LB))[i] = l == 0 ? 0.0f : 1.0f / (1.0f + expf(l0 - l1)); }
        } else {
            conv_unit_ne(P, 0, u - (NU_MOD + NU_H2 + NU_LB), (LAS float*)lds);
        }
    }
}

__device__ __forceinline__ void emit_rows_init(const Ptrs P, LAS float* wdt);
__device__ __forceinline__ void phase_pb(const Ptrs P, LAS unsigned char* lds) {
    const int tid = P.tid, G = P.G;
    for (int u = P.bid; u < 132; u += G) {
        const int tab = u < 64 ? 0 : (u < 128 ? 1 : 2); const int ib = tab == 0 ? u : (tab == 1 ? u - 64 : u - 128);
        const int l = tab == 1 ? 1 : 0; const int L = tab == 2 ? 256 : 4096; const int rho0 = (tab == 0 ? 0 : (tab == 1 ? 4096 : 8192)) + ib * 64;
        LAS float* h2 = (LAS float*)lds;
        for (int i = tid; i < 64 * 64; i += 512) h2[i] = ((const float*)(P.ws + WS_H2TAB))[(size_t)rho0 * 64 + i];
        __syncthreads();
        const int o = tid, c = tid & 255, dir = tid >> 8;
        float w3[64];
#pragma unroll
        for (int j = 0; j < 64; ++j) w3[j] = P.inp(I_HYW3)[((size_t)l * 64 + j) * 512 + o];
        const float dec = fabsf(P.inp(I_HYDEC)[l * 256 + c]);
        float* filt = tab == 2 ? (float*)(P.ws + WS_FILTC) : (float*)(P.ws + WS_FILT) + (size_t)l * 8192 * 256;
        const int L2 = 2 * L; float part = 0.f;
        for (int r = 0; r < 64; ++r) { const int i = ib * 64 + r; float s = 0.f;
#pragma unroll
            for (int j = 0; j < 64; ++j) s += h2[r * 64 + j] * w3[j];
            const float t = (float)i / (float)(L - 1); s *= expf(-t * dec);
            if (dir == 0) { filt[(size_t)i * 256 + c] = s; part += fabsf(s); }
            else if (i == 0) filt[(size_t)L * 256 + c] = 0.f;
            else { filt[(size_t)(L2 - i) * 256 + c] = s; part += fabsf(s); } }
        ((float*)(P.ws + WS_PART))[((size_t)tab * 64 + ib) * 512 + o] = part;
        __syncthreads();
    }
    emit_rows_init(P, (LAS float*)lds);
}
__device__ __forceinline__ float hy_norm(const Ptrs P, int tab, int c) {
    const float* part = (const float*)(P.ws + WS_PART) + (size_t)tab * 64 * 512; const int nb = tab == 2 ? 4 : 64; float s = 0.f;
    for (int b = 0; b < nb; ++b) s += part[b * 512 + c] + part[b * 512 + 256 + c];
    return s;
}

__device__ __forceinline__ void emit_rows_init(const Ptrs P, LAS float* wdt) {
    const int tid = P.tid, wid = tid >> 6, lane = tid & 63, G = P.G;
    load_wdt(P, 0, wdt);
    LAS float* tabA = wdt + 1024 * 8; LAS float* tabB = tabA + 8 * 256 * 2;
    for (int i = tid; i < 2 * 8 * 256; i += 512) { const int tb = i >> 11, a = (i >> 8) & 7, ii = i & 255; const float om = expf(-9.210340371976184f * (float)ii * (1.0f / 256.0f)); const float ang = (float)(tb ? a : 8 * a) * om;
        LAS float* t = (tb ? tabB : tabA) + (a * 256 + ii) * 2; t[0] = sinf(ang); t[1] = cosf(ang); }
    __syncthreads();
    const float* xin = P.inp(I_X); const float* cin = P.inp(I_CTX);
    RowV rn; if (P.bid < T / 8) { const int rw = P.bid * 8 + wid; row_load(rn, rw < NLAT ? xin + (size_t)rw * D : cin + (size_t)(rw - NLAT) * D, lane); }
    for (int u = P.bid; u < T / 8; u += G) {
        const int row = u * 8 + wid; RowV r = rn;
        if (u + G < T / 8) { const int rw = (u + G) * 8 + wid; row_load(rn, rw < NLAT ? xin + (size_t)rw * D : cin + (size_t)(rw - NLAT) * D, lane); }
        if (row < NLAT) {
            const int t = row & 4095; const int prow = t >> 6, pcol = t & 63;
#pragma unroll
            for (int hf = 0; hf < 2; ++hf) { const int pos = hf ? pcol : prow; const LAS float* pa = tabA + ((pos >> 3) * 256 + lane * 4) * 2; const LAS float* pb = tabB + ((pos & 7) * 256 + lane * 4) * 2;
                const f32x4 a0 = *(const LAS f32x4*)pa, a1 = *(const LAS f32x4*)(pa + 4), b0 = *(const LAS f32x4*)pb, b1 = *(const LAS f32x4*)(pb + 4);
                f32x4 sn, cs;
                sn[0] = a0[0] * b0[1] + a0[1] * b0[0]; cs[0] = a0[1] * b0[1] - a0[0] * b0[0]; sn[1] = a0[2] * b0[3] + a0[3] * b0[2]; cs[1] = a0[3] * b0[3] - a0[2] * b0[2];
                sn[2] = a1[0] * b1[1] + a1[1] * b1[0]; cs[2] = a1[1] * b1[1] - a1[0] * b1[0]; sn[3] = a1[2] * b1[3] + a1[3] * b1[2]; cs[3] = a1[3] * b1[3] - a1[2] * b1[2];
                r.v[2 * hf] += sn; r.v[2 * hf + 1] += cs; }
        }
        row_store(r, P.latrow(row), lane);
        const float* m = P.mod(0, row_modidx(row)); RowV h; row_modulate(r, h, m, m + 1024, lane);
        row_store_bf16(h, (bf16_t*)(P.ws + WS_HBUF) + (size_t)row * D, lane);
        row_dt(h, wdt, (float*)(P.ws + WS_DT) + (size_t)row * 8, lane);
    }
}

__device__ __forceinline__ void phase_g1(const Ptrs P, LAS unsigned char* lds) {
    pg8::Gemm g{(const bf16_t*)(P.ws + WS_HBUF), (const bf16_t*)(P.ws + WS_WIN), D};
    EpiBf16Plain E{(bf16_t*)(P.ws + WS_BIG + BIG_U), UC, 0xffff};
    SchedG1 S{XOrder{P.G, P.bid, T / 256, 14}};
    pg8::gemm_phase<EpiBf16Plain, SchedG1, false>(P.tid, lds, g, S, E);
}

constexpr int NCHK = 34;
__device__ __forceinline__ int chunk_row0(int b, int pc) { return pc < 2 ? NLAT + b * CTXL + pc * 128 : b * SEQ + (pc - 2) * 128; }
__device__ __forceinline__ int chunk_at(int dir, int q) { return dir == 0 ? q : (q < 2 ? 1 - q : 35 - q); }
__device__ __forceinline__ int sidx(int kind, int b, int h, int dir, int pc) { return (((kind * 8 + b) * 4 + h) * 2 + dir) * NCHK + pc; }
__device__ __forceinline__ bf16x8 pack8(const float (&v)[8]) { u32x4 w; w.x = pack2(v[0], v[1]); w.y = pack2(v[2], v[3]); w.z = pack2(v[4], v[5]); w.w = pack2(v[6], v[7]); return __builtin_bit_cast(bf16x8, w); }
__device__ __forceinline__ float zero_f() { float z = 0.f; asm volatile("" : "+v"(z)); return z; }
__device__ __forceinline__ float softplusf_(float x) { return x > 20.f ? x : log1pf(__expf(x)); }
__device__ __forceinline__ float wave_incl_scan(float v, int lane) {
#pragma unroll
    for (int d = 1; d < 64; d <<= 1) { const float t = __shfl_up(v, d); if (lane >= d) v += t; }
    return v;
}

__device__ __forceinline__ void conv3_silu8(const bf16_t* U, int row, int col0, const float* w, int ncol, int wcol0, const float* bias, float (&out)[8]) {
    const bool hp = row_has_prev(row), hn = row_has_next(row);
    const bf16x8 c = *(const bf16x8*)(U + (size_t)row * UC + col0);
    const bf16x8 p = *(const bf16x8*)(U + (size_t)(hp ? row - 1 : row) * UC + col0), n = *(const bf16x8*)(U + (size_t)(hn ? row + 1 : row) * UC + col0);
    const float mp = hp ? 1.0f : 0.0f, mn = hn ? 1.0f : 0.0f;
#pragma unroll
    for (int h4 = 0; h4 < 2; ++h4) { const f32x4 w0 = *(const f32x4*)(w + wcol0 + 4 * h4), w1 = *(const f32x4*)(w + ncol + wcol0 + 4 * h4), w2 = *(const f32x4*)(w + 2 * ncol + wcol0 + 4 * h4), bb = *(const f32x4*)(bias + wcol0 + 4 * h4);
#pragma unroll
        for (int e = 0; e < 4; ++e) { const int i = 4 * h4 + e; const float v = bf2f((bf16_t)c[i]) * w1[e] + mp * bf2f((bf16_t)p[i]) * w0[e] + mn * bf2f((bf16_t)n[i]) * w2[e] + bb[e]; out[i] = siluf_(v); } }
}

__device__ __forceinline__ void conv16_silu(const bf16_t* U, int r0, int col, const float* w, int ncol, int wcol, float bias, float (&out)[16]) {
    const bool hp = row_has_prev(r0), hn = row_has_next(r0 + 15);
    float x[18];
#pragma unroll
    for (int i = 0; i < 18; ++i) { const int r = (i == 0 && !hp) ? r0 : ((i == 17 && !hn) ? r0 + 15 : r0 - 1 + i); x[i] = bf2f(U[(size_t)r * UC + col]); }
    if (!hp) x[0] = 0.f; if (!hn) x[17] = 0.f;
    const float w0 = w[wcol], w1 = w[ncol + wcol], w2 = w[2 * ncol + wcol];
#pragma unroll
    for (int j = 0; j < 16; ++j) out[j] = siluf_(x[j] * w0 + x[j + 1] * w1 + x[j + 2] * w2 + bias);
}
__device__ __forceinline__ void store16_bf16(LAS bf16_t* dst, const float (&v)[16]) {
    u32x4 a, b; a.x = pack2(v[0], v[1]); a.y = pack2(v[2], v[3]); a.z = pack2(v[4], v[5]); a.w = pack2(v[6], v[7]); b.x = pack2(v[8], v[9]); b.y = pack2(v[10], v[11]); b.z = pack2(v[12], v[13]); b.w = pack2(v[14], v[15]);
    *(LAS u32x4*)dst = a; *(LAS u32x4*)(dst + 8) = b;
}

__device__ __forceinline__ void hgrn_pass1(const Ptrs P, int l, int unit, LAS unsigned char* lds) {
    const int tid = P.tid, lane = tid & 63, wid = tid >> 6, fr = lane & 15, fq = lane >> 4;
    const int pc = unit % NCHK; const int r_ = unit / NCHK; const int h = r_ & 3; const int b = r_ >> 2;
    const int row0 = chunk_row0(b, pc);
    const bf16_t* U = (const bf16_t*)(P.ws + WS_BIG + BIG_U);
    LAS bf16_t* KTF = (LAS bf16_t*)lds; LAS bf16_t* KTB = KTF + 64 * 136; LAS bf16_t* VT = KTB + 64 * 136; LAS float* segtot = (LAS float*)(VT + 64 * 136);
    const int ch = lane, seg = wid;
    const float lbf = ((const float*)(P.ws + WS_LB))[(0 * 2 + l) * 256 + h * 64 + ch], lbb = ((const float*)(P.ws + WS_LB))[(1 * 2 + l) * 256 + h * 64 + ch];
    float cf[16], cb[16], kf[16], kb[16], vv[16]; float runf = 0.f, runb = 0.f;
#pragma unroll
    for (int j = 0; j < 16; ++j) { const bf16_t* ur = U + (size_t)(row0 + 16 * seg + j) * UC;
        const float ff = lbf + (1.0f - lbf) * sigmoidf_(bf2f(ur[1792 + h * 64 + ch])), fb = lbb + (1.0f - lbb) * sigmoidf_(bf2f(ur[2048 + h * 64 + ch]));
        runf += __logf(ff); cf[j] = runf; kf[j] = 1.0f - ff; cb[j] = runb; runb += __logf(fb); kb[j] = 1.0f - fb; vv[j] = bf2f(ur[2304 + h * 64 + ch]); }
    segtot[seg * 64 + ch] = runf; segtot[512 + seg * 64 + ch] = runb; __syncthreads();
    float offf = 0.f, totf = 0.f, offb = 0.f, totb = 0.f;
#pragma unroll
    for (int s = 0; s < 8; ++s) { const float a = segtot[s * 64 + ch], c = segtot[512 + s * 64 + ch]; totf += a; totb += c; offf += (s < seg) ? a : 0.f; offb += (s < seg) ? c : 0.f; }
    { float t[16];
#pragma unroll
      for (int j = 0; j < 16; ++j) t[j] = kf[j] * __expf(totf - offf - cf[j]);
      store16_bf16(KTF + ch * 136 + 16 * seg, t);
#pragma unroll
      for (int j = 0; j < 16; ++j) t[j] = kb[j] * __expf(offb + cb[j]);
      store16_bf16(KTB + ch * 136 + 16 * seg, t);
      store16_bf16(VT + ch * 136 + 16 * seg, vv); }
    const int sif = sidx(0, b, h, 0, pc), sib = sidx(0, b, h, 1, pc);
    if (seg == 0) { ((float*)(P.ws + WS_DEC))[(size_t)sif * 64 + ch] = __expf(totf); ((float*)(P.ws + WS_DEC))[(size_t)sib * 64 + ch] = __expf(totb); }
    __syncthreads();
    const int mt = wid >> 1, nt0 = (wid & 1) * 2;
    f32x4 af[2], ab[2]; af[0] = (f32x4){0.f, 0.f, 0.f, 0.f}; af[1] = af[0]; ab[0] = af[0]; ab[1] = af[0];
#pragma unroll
    for (int ks = 0; ks < 4; ++ks) { const bf16x8 a0 = *(const LAS bf16x8*)(KTF + (16 * mt + fr) * 136 + 32 * ks + 8 * fq), a1 = *(const LAS bf16x8*)(KTB + (16 * mt + fr) * 136 + 32 * ks + 8 * fq);
#pragma unroll
        for (int n = 0; n < 2; ++n) { const bf16x8 bb = *(const LAS bf16x8*)(VT + (16 * (nt0 + n) + fr) * 136 + 32 * ks + 8 * fq);
            af[n] = __builtin_amdgcn_mfma_f32_16x16x32_bf16(a0, bb, af[n], 0, 0, 0); ab[n] = __builtin_amdgcn_mfma_f32_16x16x32_bf16(a1, bb, ab[n], 0, 0, 0); } }
    float* SF = (float*)(P.ws + WS_BIG + BIG_STATE) + (size_t)sif * 4096; float* SB = (float*)(P.ws + WS_BIG + BIG_STATE) + (size_t)sib * 4096;
#pragma unroll
    for (int n = 0; n < 2; ++n)
#pragma unroll
        for (int r = 0; r < 4; ++r) { const int o = (16 * mt + 4 * fq + r) * 64 + 16 * (nt0 + n) + fr; SF[o] = af[n][r]; SB[o] = ab[n][r]; }
    __syncthreads();
}

__device__ __forceinline__ void ssd_pass1(const Ptrs P, int l, int unit, LAS unsigned char* lds) {
    const int tid = P.tid, lane = tid & 63, wid = tid >> 6, fr = lane & 15, fq = lane >> 4;
    const int pc = unit % NCHK; const int r_ = unit / NCHK; const int g = r_ & 1; const int b = r_ >> 1;
    const int row0 = chunk_row0(b, pc);
    const bf16_t* U = (const bf16_t*)(P.ws + WS_BIG + BIG_U);
    const float* scw = P.inp(I_SSDCW) + (size_t)l * 3 * 512; const float* scb = P.inp(I_SSDCB) + l * 512;
    LAS bf16_t* BT = (LAS bf16_t*)lds; LAS bf16_t* XT = BT + 64 * 136;
    LAS float* wgt = (LAS float*)(XT + 4 * 64 * 136);
    if (wid < 4) {
        const int hh = 2 * g + (wid >> 1), dir = wid & 1;
        const float Aneg = -__expf(P.inp(I_SSDALOG)[(l * 2 + dir) * 4 + hh]); const float dtb = P.inp(I_SSDDTB)[(l * 2 + dir) * 4 + hh]; const float* DT = (const float*)(P.ws + WS_DT);
        const int p0 = 2 * lane; const float d0 = softplusf_(DT[(size_t)(row0 + p0) * 8 + dir * 4 + hh] + dtb), d1 = softplusf_(DT[(size_t)(row0 + p0 + 1) * 8 + dir * 4 + hh] + dtb);
        const float a0 = Aneg * d0, a1 = Aneg * d1; const float inc = wave_incl_scan(a0 + a1, lane); const float tot = __uint_as_float(__builtin_amdgcn_readlane(__float_as_uint(inc), 63));
        if (dir == 0) { wgt[wid * 128 + p0] = d0 * __expf(tot - (inc - a1)); wgt[wid * 128 + p0 + 1] = d1 * __expf(tot - inc); }
        else { wgt[wid * 128 + p0] = d0 * __expf(inc - a1 - a0); wgt[wid * 128 + p0 + 1] = d1 * __expf(inc - a1); }
        if (lane == 0) ((float*)(P.ws + WS_DEC))[(size_t)sidx(1, b, hh, dir, pc) * 64] = __expf(tot);
    }
    __syncthreads();
    { const int ch = lane, seg = wid; const int r0 = row0 + 16 * seg; float t[16], x[16];
      conv16_silu(U, r0, 3072 + 256 + g * 64 + ch, scw, 512, 256 + g * 64 + ch, scb[256 + g * 64 + ch], t); store16_bf16(BT + ch * 136 + 16 * seg, t);
#pragma unroll
      for (int hq = 0; hq < 2; ++hq) { const int c = (2 * g + hq) * 64 + ch; conv16_silu(U, r0, 3072 + c, scw, 512, c, scb[c], x);
#pragma unroll
          for (int dir = 0; dir < 2; ++dir) { const int cmb = 2 * hq + dir;
#pragma unroll
              for (int j4 = 0; j4 < 4; ++j4) { const f32x4 wv = *(const LAS f32x4*)(wgt + cmb * 128 + 16 * seg + 4 * j4); t[4 * j4] = x[4 * j4] * wv[0]; t[4 * j4 + 1] = x[4 * j4 + 1] * wv[1]; t[4 * j4 + 2] = x[4 * j4 + 2] * wv[2]; t[4 * j4 + 3] = x[4 * j4 + 3] * wv[3]; }
              store16_bf16(XT + (cmb * 64 + ch) * 136 + 16 * seg, t); } } }
    __syncthreads();
    {
        const int cmb = wid >> 1; const int hh = 2 * g + (cmb >> 1), dir = cmb & 1;
        float* S = (float*)(P.ws + WS_BIG + BIG_STATE) + (size_t)sidx(1, b, hh, dir, pc) * 4096;
#pragma unroll
        for (int mi = 0; mi < 2; ++mi) { const int mt = 2 * (wid & 1) + mi; f32x4 acc[4];
#pragma unroll
            for (int n = 0; n < 4; ++n) acc[n] = (f32x4){0.f, 0.f, 0.f, 0.f};
#pragma unroll
            for (int ks = 0; ks < 4; ++ks) { const bf16x8 a = *(const LAS bf16x8*)(XT + (cmb * 64 + 16 * mt + fr) * 136 + 32 * ks + 8 * fq);
#pragma unroll
                for (int n = 0; n < 4; ++n) { const bf16x8 bb = *(const LAS bf16x8*)(BT + (16 * n + fr) * 136 + 32 * ks + 8 * fq); acc[n] = __builtin_amdgcn_mfma_f32_16x16x32_bf16(a, bb, acc[n], 0, 0, 0); } }
#pragma unroll
            for (int n = 0; n < 4; ++n)
#pragma unroll
                for (int r = 0; r < 4; ++r) S[(16 * mt + 4 * fq + r) * 64 + 16 * n + fr] = acc[n][r]; }
    }
    __syncthreads();
}

__device__ __forceinline__ void ssd_dt_cum(const Ptrs P, int l, int row0, int dir, int h, int wid, int lane, LAS float* cum, LAS float* dtv) {
    if (wid == 0) {
        const float Aneg = -__expf(P.inp(I_SSDALOG)[(l * 2 + dir) * 4 + h]); const float dtb = P.inp(I_SSDDTB)[(l * 2 + dir) * 4 + h]; const float* DT = (const float*)(P.ws + WS_DT);
        const int t0 = 2 * lane, p0 = dir ? 127 - t0 : t0, p1 = dir ? 126 - t0 : t0 + 1;
        const float d0 = softplusf_(DT[(size_t)(row0 + p0) * 8 + dir * 4 + h] + dtb), d1 = softplusf_(DT[(size_t)(row0 + p1) * 8 + dir * 4 + h] + dtb);
        const float a0 = Aneg * d0, a1 = Aneg * d1; const float inc = wave_incl_scan(a0 + a1, lane);
        cum[t0] = inc - a1; cum[t0 + 1] = inc; dtv[t0] = d0; dtv[t0 + 1] = d1;
    }
}

__device__ __forceinline__ void scan_pass2(const Ptrs P, int unit) {
    const int seq = unit >> 1, half = unit & 1; const int kind = seq >> 6, b = (seq >> 3) & 7, h = (seq >> 1) & 3, dir = seq & 1;
    const int e0 = half * 2048 + P.tid * 4; const int base = sidx(kind, b, h, dir, 0);
    float* ST = (float*)(P.ws + WS_BIG + BIG_STATE); const float* DEC = (const float*)(P.ws + WS_DEC);
    const float zf = zero_f(); f32x4 run = (f32x4){zf, zf, zf, zf};
#pragma unroll 1
    for (int q0 = 0; q0 < NCHK; q0 += 8) {
        f32x4 loc[8]; float dd[8];
#pragma unroll
        for (int k = 0; k < 8; ++k) { const int q = (q0 + k < NCHK) ? q0 + k : NCHK - 1; const int pc = chunk_at(dir, q);
            loc[k] = *(const f32x4*)(ST + (size_t)(base + pc) * 4096 + e0); dd[k] = DEC[(size_t)(base + pc) * 64 + (kind == 0 ? (e0 >> 6) : 0)]; }
#pragma unroll
        for (int k = 0; k < 8; ++k) { if (q0 + k < NCHK) { const int pc = chunk_at(dir, q0 + k); *(f32x4*)(ST + (size_t)(base + pc) * 4096 + e0) = run; run = run * dd[k] + loc[k]; } }
    }
}

__device__ __forceinline__ int qk_off(int p, int chunk) { return p * 64 + ((chunk ^ (p & 7)) << 3); }
__device__ __forceinline__ void hgrn_pass3(const Ptrs P, int l, int unit, LAS unsigned char* lds) {
    const int tid = P.tid, lane = tid & 63, wid = tid >> 6, fr = lane & 15, fq = lane >> 4;
    const int pc = unit % NCHK; const int r_ = unit / NCHK; const int h = r_ & 3; const int b = r_ >> 2;
    const int row0 = chunk_row0(b, pc);
    const bf16_t* U = (const bf16_t*)(P.ws + WS_BIG + BIG_U);
    LAS bf16_t* QF = (LAS bf16_t*)lds; LAS bf16_t* KF = QF + 128 * 64; LAS bf16_t* QB = KF + 128 * 64; LAS bf16_t* KB = QB + 128 * 64; LAS bf16_t* VT = KB + 128 * 64;
    LAS bf16_t* STF = VT + 64 * 136; LAS bf16_t* STB = STF + 64 * 72; LAS float* ETF = (LAS float*)(STB + 64 * 72); LAS float* ETB = ETF + 512; LAS bf16_t* PW = (LAS bf16_t*)(ETB + 512);
    LAS float* OUT = (LAS float*)lds;
    {
        const int ch = lane, seg = wid; const float lbf = ((const float*)(P.ws + WS_LB))[(0 * 2 + l) * 256 + h * 64 + ch], lbb = ((const float*)(P.ws + WS_LB))[(1 * 2 + l) * 256 + h * 64 + ch];
        float bfw[16], bbw[16], kf[16], kb[16], qv[16], vv[16];
#pragma unroll
        for (int j = 0; j < 16; ++j) { const bf16_t* ur = U + (size_t)(row0 + 16 * seg + j) * UC + h * 64 + ch;
            const float ff = lbf + (1.0f - lbf) * sigmoidf_(bf2f(ur[1792])), fb = lbb + (1.0f - lbb) * sigmoidf_(bf2f(ur[2048]));
            bfw[j] = __logf(ff); bbw[j] = __logf(fb); kf[j] = 1.0f - ff; kb[j] = 1.0f - fb; qv[j] = bf2f(ur[1536]) * 0.125f; vv[j] = bf2f(ur[2304]); }
#pragma unroll
        for (int j = 1; j < 16; ++j) bfw[j] += bfw[j - 1];
#pragma unroll
        for (int j = 14; j >= 0; --j) bbw[j] += bbw[j + 1];
        const float etf = bfw[15], etb = bbw[0];
        ETF[seg * 64 + ch] = etf; ETB[seg * 64 + ch] = etb;
        store16_bf16(VT + ch * 136 + 16 * seg, vv);
        const int chunk = ch >> 3, sub = ch & 7;
#pragma unroll
        for (int j = 0; j < 16; ++j) { const int p = 16 * seg + j; const int o = qk_off(p, chunk) + sub;
            const unsigned wq = pack2(qv[j] * __expf(bfw[j]), qv[j] * __expf(bbw[j])), wk = pack2(kf[j] * __expf(etf - bfw[j]), kb[j] * __expf(etb - bbw[j]));
            QF[o] = (bf16_t)(wq & 0xffffu); QB[o] = (bf16_t)(wq >> 16); KF[o] = (bf16_t)(wk & 0xffffu); KB[o] = (bf16_t)(wk >> 16); }
        const float* SF = (const float*)(P.ws + WS_BIG + BIG_STATE) + (size_t)sidx(0, b, h, 0, pc) * 4096; const float* SB = (const float*)(P.ws + WS_BIG + BIG_STATE) + (size_t)sidx(0, b, h, 1, pc) * 4096;
#pragma unroll 2
        for (int idx = tid; idx < 4096; idx += 512) { STF[(idx & 63) * 72 + (idx >> 6)] = f2bf(SF[idx]); STB[(idx & 63) * 72 + (idx >> 6)] = f2bf(SB[idx]); }
    }
    __syncthreads();
    f32x4 o[4];
    {
        const int i = wid; LAS bf16_t* pw = PW + wid * 16 * 136;
#pragma unroll
        for (int nt = 0; nt < 4; ++nt) o[nt] = (f32x4){0.f, 0.f, 0.f, 0.f};
#pragma unroll 1
        for (int dir = 0; dir < 2; ++dir) {
            const LAS bf16_t* QA = dir ? QB : QF; const LAS bf16_t* KA = dir ? KB : KF; const LAS float* ET = dir ? ETB : ETF; const LAS bf16_t* ST = dir ? STB : STF;
            bf16x8 qf[2]; float g[2][8];
#pragma unroll
            for (int ks = 0; ks < 2; ++ks) { qf[ks] = *(const LAS bf16x8*)(QA + qk_off(16 * i + fr, 4 * ks + fq));
                const f32x4 e0 = *(const LAS f32x4*)(ET + i * 64 + 32 * ks + 8 * fq), e1 = *(const LAS f32x4*)(ET + i * 64 + 32 * ks + 8 * fq + 4);
                g[ks][0] = -e0[0]; g[ks][1] = -e0[1]; g[ks][2] = -e0[2]; g[ks][3] = -e0[3]; g[ks][4] = -e1[0]; g[ks][5] = -e1[1]; g[ks][6] = -e1[2]; g[ks][7] = -e1[3]; }
            const int nj = dir ? 8 - i : i + 1;
            for (int jj = 0; jj < nj; ++jj) { const int j = dir ? i + jj : i - jj;
                f32x4 d = (f32x4){0.f, 0.f, 0.f, 0.f};
#pragma unroll
                for (int ks = 0; ks < 2; ++ks) { float a8[8];
#pragma unroll
                    for (int e = 0; e < 8; ++e) a8[e] = bf2f((bf16_t)qf[ks][e]) * __expf(g[ks][e]);
                    const bf16x8 kfr = *(const LAS bf16x8*)(KA + qk_off(16 * j + fr, 4 * ks + fq));
                    d = __builtin_amdgcn_mfma_f32_16x16x32_bf16(kfr, pack8(a8), d, 0, 0, 0);
                    const f32x4 e0 = *(const LAS f32x4*)(ET + j * 64 + 32 * ks + 8 * fq), e1 = *(const LAS f32x4*)(ET + j * 64 + 32 * ks + 8 * fq + 4);
                    g[ks][0] += e0[0]; g[ks][1] += e0[1]; g[ks][2] += e0[2]; g[ks][3] += e0[3]; g[ks][4] += e1[0]; g[ks][5] += e1[1]; g[ks][6] += e1[2]; g[ks][7] += e1[3]; }
                if (jj == 0) {
#pragma unroll
                    for (int r = 0; r < 4; ++r) d[r] = (dir ? (4 * fq + r >= fr) : (4 * fq + r <= fr)) ? d[r] : 0.f; }
                u32x2 w; w.x = pack2(d[0], d[1]); w.y = pack2(d[2], d[3]); *(LAS u32x2*)(pw + fr * 136 + 16 * j + 4 * fq) = w;
            }
            { const int zb = dir ? i - 1 : i + 1; const bool need = dir ? ((i & 1) == 1) : ((i & 1) == 0);
              if (need) { u32x2 z; z.x = __float_as_uint(zero_f()); z.y = z.x; *(LAS u32x2*)(pw + fr * 136 + 16 * zb + 4 * fq) = z; } }
            const int kslo = dir ? (i >> 1) : 0, kshi = dir ? 3 : (i >> 1);
            for (int ks = kslo; ks <= kshi; ++ks) { const bf16x8 pa = *(const LAS bf16x8*)(pw + fr * 136 + 32 * ks + 8 * fq);
#pragma unroll
                for (int nt = 0; nt < 4; ++nt) { const bf16x8 vf = *(const LAS bf16x8*)(VT + (16 * nt + fr) * 136 + 32 * ks + 8 * fq); o[nt] = __builtin_amdgcn_mfma_f32_16x16x32_bf16(pa, vf, o[nt], 0, 0, 0); } }
#pragma unroll
            for (int ks = 0; ks < 2; ++ks) { float a8[8];
#pragma unroll
                for (int e = 0; e < 8; ++e) a8[e] = bf2f((bf16_t)qf[ks][e]) * __expf(g[ks][e]);
                const bf16x8 qa = pack8(a8);
#pragma unroll
                for (int nt = 0; nt < 4; ++nt) { const bf16x8 sf = *(const LAS bf16x8*)(ST + (16 * nt + fr) * 72 + 32 * ks + 8 * fq); o[nt] = __builtin_amdgcn_mfma_f32_16x16x32_bf16(qa, sf, o[nt], 0, 0, 0); } }
        }
    }
    __syncthreads();
#pragma unroll
    for (int nt = 0; nt < 4; ++nt)
#pragma unroll
        for (int r = 0; r < 4; ++r) OUT[(16 * wid + 4 * fq + r) * 64 + 16 * nt + fr] = o[nt][r];
    __syncthreads();
    {
        const int pos = tid >> 2, qd = tid & 3; const int row = row0 + pos; bf16_t* BR2 = (bf16_t*)(P.ws + WS_BR) + (size_t)2 * T * 256;
        const bf16_t* gp = U + (size_t)row * UC + 2560 + h * 64 + 16 * qd; const bf16x8 g0 = *(const bf16x8*)gp, g1 = *(const bf16x8*)(gp + 8);
        const float* ngp = P.inp(I_HGNG) + l * 64 + 16 * qd; float ov[16], q = 0.f;
#pragma unroll
        for (int e4 = 0; e4 < 4; ++e4) { const f32x4 v = *(const LAS f32x4*)(OUT + pos * 64 + 16 * qd + 4 * e4); ov[4 * e4] = v[0]; ov[4 * e4 + 1] = v[1]; ov[4 * e4 + 2] = v[2]; ov[4 * e4 + 3] = v[3]; q += v[0] * v[0] + v[1] * v[1] + v[2] * v[2] + v[3] * v[3]; }
        q += __shfl_xor(q, 1); q += __shfl_xor(q, 2);
        const float rs = rsqrtf(q * (1.0f / 64.0f) + RMS_EPS); float t8[8];
#pragma unroll
        for (int e = 0; e < 8; ++e) t8[e] = ov[e] * rs * ngp[e] * siluf_(bf2f((bf16_t)g0[e]));
        *(bf16x8*)(BR2 + (size_t)row * 256 + h * 64 + 16 * qd) = pack8(t8);
#pragma unroll
        for (int e = 0; e < 8; ++e) t8[e] = ov[8 + e] * rs * ngp[8 + e] * siluf_(bf2f((bf16_t)g1[e]));
        *(bf16x8*)(BR2 + (size_t)row * 256 + h * 64 + 16 * qd + 8) = pack8(t8);
    }
    __syncthreads();
}

__device__ __forceinline__ void ssd_pass3(const Ptrs P, int l, int unit, LAS unsigned char* lds) {
    const int tid = P.tid, lane = tid & 63, wid = tid >> 6, fr = lane & 15, fq = lane >> 4;
    const int pc = unit % NCHK; const int r_ = unit / NCHK; const int g = r_ & 1; const int b = r_ >> 1;
    const int row0 = chunk_row0(b, pc);
    const bf16_t* U = (const bf16_t*)(P.ws + WS_BIG + BIG_U);
    const float* scw = P.inp(I_SSDCW) + (size_t)l * 3 * 512; const float* scb = P.inp(I_SSDCB) + l * 512;
    LAS bf16_t* CM = (LAS bf16_t*)lds; LAS bf16_t* BM = CM + 128 * 72; LAS bf16_t* XT = BM + 128 * 72; LAS bf16_t* STF = XT + 64 * 136; LAS bf16_t* STB = STF + 64 * 72;
    LAS float* cumf = (LAS float*)(STB + 64 * 72); LAS float* cumb = cumf + 128; LAS float* dtf = cumb + 128; LAS float* dtb = dtf + 128;
    LAS bf16_t* PW = (LAS bf16_t*)(dtb + 128); LAS float* OUT = (LAS float*)(PW + 8 * 16 * 136);
    {
        const int pos = tid >> 2, qd = tid & 3; const int row = row0 + pos;
#pragma unroll 1
        for (int pcs = 0; pcs < 4; ++pcs) { const int isb = pcs >> 1, hf = pcs & 1; const int cc = (isb ? 256 : 384) + g * 64 + 16 * qd + 8 * hf; float t8[8];
            conv3_silu8(U, row, 3072 + cc, scw, 512, cc, scb, t8);
            *(LAS bf16x8*)((isb ? BM : CM) + pos * 72 + 16 * qd + 8 * hf) = pack8(t8); }
    }
#pragma unroll 1
    for (int hq = 0; hq < 2; ++hq) {
        const int h = 2 * g + hq;
        {
            const int ch = lane, seg = wid; float x[16]; conv16_silu(U, row0 + 16 * seg, 3072 + h * 64 + ch, scw, 512, h * 64 + ch, scb[h * 64 + ch], x); store16_bf16(XT + ch * 136 + 16 * seg, x);
        }
        __builtin_amdgcn_sched_barrier(0);
        if (wid < 2) {
            const int dir = wid; const float Aneg = -__expf(P.inp(I_SSDALOG)[(l * 2 + dir) * 4 + h]); const float dtbias = P.inp(I_SSDDTB)[(l * 2 + dir) * 4 + h]; const float* DT = (const float*)(P.ws + WS_DT);
            const int p0 = 2 * lane; const float d0 = softplusf_(DT[(size_t)(row0 + p0) * 8 + dir * 4 + h] + dtbias), d1 = softplusf_(DT[(size_t)(row0 + p0 + 1) * 8 + dir * 4 + h] + dtbias);
            const float a0 = Aneg * d0, a1 = Aneg * d1; const float inc = wave_incl_scan(a0 + a1, lane);
            if (dir == 0) { cumf[p0] = inc - a1; cumf[p0 + 1] = inc; dtf[p0] = d0; dtf[p0 + 1] = d1; }
            else { const float tot = __uint_as_float(__builtin_amdgcn_readlane(__float_as_uint(inc), 63)); cumb[p0] = tot - inc + a0 + a1; cumb[p0 + 1] = tot - inc + a1; dtb[p0] = d0; dtb[p0 + 1] = d1; }
        }
        {
            const float* SF = (const float*)(P.ws + WS_BIG + BIG_STATE) + (size_t)sidx(1, b, h, 0, pc) * 4096; const float* SB = (const float*)(P.ws + WS_BIG + BIG_STATE) + (size_t)sidx(1, b, h, 1, pc) * 4096;
#pragma unroll 2
            for (int idx = tid; idx < 4096; idx += 512) { STF[(idx >> 6) * 72 + (idx & 63)] = f2bf(SF[idx]); STB[(idx >> 6) * 72 + (idx & 63)] = f2bf(SB[idx]); }
        }
        __syncthreads();
        {
            const int i = wid; LAS bf16_t* pw = PW + wid * 16 * 136;
            bf16x8 cf[2];
#pragma unroll
            for (int ks = 0; ks < 2; ++ks) cf[ks] = *(const LAS bf16x8*)(CM + (16 * i + fr) * 72 + 32 * ks + 8 * fq);
            f32x4 o[4];
#pragma unroll
            for (int nt = 0; nt < 4; ++nt) o[nt] = (f32x4){0.f, 0.f, 0.f, 0.f};
#pragma unroll 1
            for (int dir = 0; dir < 2; ++dir) {
                const LAS float* cum = dir ? cumb : cumf; const LAS float* dtv = dir ? dtb : dtf; const LAS bf16_t* ST = dir ? STB : STF;
                const float cq = cum[16 * i + fr];
                const int jlo = dir ? i : 0, jhi = dir ? 7 : i;
                for (int j = jlo; j <= jhi; ++j) {
                    f32x4 d = (f32x4){0.f, 0.f, 0.f, 0.f};
#pragma unroll
                    for (int ks = 0; ks < 2; ++ks) { const bf16x8 bf_ = *(const LAS bf16x8*)(BM + (16 * j + fr) * 72 + 32 * ks + 8 * fq); d = __builtin_amdgcn_mfma_f32_16x16x32_bf16(bf_, cf[ks], d, 0, 0, 0); }
                    const f32x4 cs = *(const LAS f32x4*)(cum + 16 * j + 4 * fq), ds = *(const LAS f32x4*)(dtv + 16 * j + 4 * fq);
#pragma unroll
                    for (int r = 0; r < 4; ++r) { const bool keep = (j != i) || (dir ? (4 * fq + r >= fr) : (4 * fq + r <= fr)); d[r] = keep ? d[r] * __expf(cq - cs[r]) * ds[r] : 0.f; }
                    u32x2 w; w.x = pack2(d[0], d[1]); w.y = pack2(d[2], d[3]); *(LAS u32x2*)(pw + fr * 136 + 16 * j + 4 * fq) = w;
                }
                { const int zb = dir ? i - 1 : i + 1; const bool need = dir ? ((i & 1) == 1) : ((i & 1) == 0);
                  if (need) { u32x2 z; z.x = __float_as_uint(zero_f()); z.y = z.x; *(LAS u32x2*)(pw + fr * 136 + 16 * zb + 4 * fq) = z; } }
                const int kslo = dir ? (i >> 1) : 0, kshi = dir ? 3 : (i >> 1);
                for (int ks = kslo; ks <= kshi; ++ks) { const bf16x8 pa = *(const LAS bf16x8*)(pw + fr * 136 + 32 * ks + 8 * fq);
#pragma unroll
                    for (int nt = 0; nt < 4; ++nt) { const bf16x8 xf = *(const LAS bf16x8*)(XT + (16 * nt + fr) * 136 + 32 * ks + 8 * fq); o[nt] = __builtin_amdgcn_mfma_f32_16x16x32_bf16(pa, xf, o[nt], 0, 0, 0); } }
                f32x4 o2[4];
#pragma unroll
                for (int nt = 0; nt < 4; ++nt) o2[nt] = (f32x4){0.f, 0.f, 0.f, 0.f};
#pragma unroll
                for (int ks = 0; ks < 2; ++ks)
#pragma unroll
                    for (int nt = 0; nt < 4; ++nt) { const bf16x8 sf = *(const LAS bf16x8*)(ST + (16 * nt + fr) * 72 + 32 * ks + 8 * fq); o2[nt] = __builtin_amdgcn_mfma_f32_16x16x32_bf16(cf[ks], sf, o2[nt], 0, 0, 0); }
                const f32x4 ct = *(const LAS f32x4*)(cum + 16 * i + 4 * fq);
#pragma unroll
                for (int nt = 0; nt < 4; ++nt)
#pragma unroll
                    for (int r = 0; r < 4; ++r) o[nt][r] += __expf(ct[r]) * o2[nt][r];
            }
#pragma unroll
            for (int nt = 0; nt < 4; ++nt)
#pragma unroll
                for (int r = 0; r < 4; ++r) OUT[(16 * i + 4 * fq + r) * 64 + 16 * nt + fr] = o[nt][r];
        }
        __syncthreads();
        {
            const int pos = tid >> 2, qd = tid & 3; const int row = row0 + pos; const int c0 = h * 64 + 16 * qd;
            const float Dh = P.inp(I_SSDD)[l * 4 + h]; const float* ngp = P.inp(I_SSDNG) + l * 256 + c0; bf16_t* BR3 = (bf16_t*)(P.ws + WS_BR) + (size_t)3 * T * 256; float* SSQ = (float*)(P.ws + WS_SSQ);
            const bf16_t* zp = U + (size_t)row * UC + 2816 + c0; float q = 0.f;
#pragma unroll
            for (int hf = 0; hf < 2; ++hf) { float xs[8]; conv3_silu8(U, row, 3072 + c0 + 8 * hf, scw, 512, c0 + 8 * hf, scb, xs); const bf16x8 z8 = *(const bf16x8*)(zp + 8 * hf); float t8[8];
#pragma unroll
                for (int e4 = 0; e4 < 2; ++e4) { const f32x4 ov = *(const LAS f32x4*)(OUT + pos * 64 + 16 * qd + 8 * hf + 4 * e4);
#pragma unroll
                    for (int e = 0; e < 4; ++e) { const int ii = 4 * e4 + e; const float vv = (ov[e] + xs[ii] * Dh) * siluf_(bf2f((bf16_t)z8[ii])); q += vv * vv; t8[ii] = vv * ngp[8 * hf + ii]; } }
                *(bf16x8*)(BR3 + (size_t)row * 256 + c0 + 8 * hf) = pack8(t8); }
            q += __shfl_xor(q, 1); q += __shfl_xor(q, 2);
            if (qd == 0) SSQ[(size_t)row * 4 + h] = q;
        }
        __syncthreads();
    }
}

typedef float f32x2 __attribute__((ext_vector_type(2)));
__device__ __forceinline__ f32x2 cmul(f32x2 a, f32x2 b) { return (f32x2){a.x * b.x - a.y * b.y, a.x * b.y + a.y * b.x}; }
__device__ __forceinline__ f32x2 cmulc(f32x2 a, f32x2 b) { return (f32x2){a.x * b.x + a.y * b.y, a.y * b.x - a.x * b.y}; }
__device__ __forceinline__ int fphys(int i) { return i + (i >> 4); }
template <int LO, int NST, bool INV>
__device__ __forceinline__ void fft_pass(LAS f32x2* X, const LAS f32x2* TW, int tid) {
    const int low = tid & ((1 << LO) - 1), high = tid >> LO; const int base = low | (high << (LO + 4));
    f32x2 x[16];
#pragma unroll
    for (int j = 0; j < 16; ++j) { const int i = base | (j << LO); x[j] = X[fphys(i)]; }
#pragma unroll
    for (int mm = 0; mm < NST; ++mm) { const int m = INV ? mm : NST - 1 - mm; const int s = LO + m;
#pragma unroll
        for (int j = 0; j < 16; ++j) { if (j & (1 << m)) continue; const int j2 = j | (1 << m);
            const int k = ((j & ((1 << m) - 1)) << LO) | low; const f32x2 tw = TW[k << (12 - s)];
            const f32x2 a = x[j], b = x[j2];
            if (!INV) { x[j] = a + b; x[j2] = cmul(a - b, tw); } else { const f32x2 bt = cmulc(b, tw); x[j] = a + bt; x[j2] = a - bt; } } }
#pragma unroll
    for (int j = 0; j < 16; ++j) { const int i = base | (j << LO); X[fphys(i)] = x[j]; }
}
__device__ __forceinline__ void fft_fwd(LAS f32x2* X, const LAS f32x2* TW, int tid) {
    fft_pass<9, 4, false>(X, TW, tid); __syncthreads(); fft_pass<5, 4, false>(X, TW, tid); __syncthreads(); fft_pass<2, 3, false>(X, TW, tid); __syncthreads(); fft_pass<0, 2, false>(X, TW, tid); __syncthreads();
}
__device__ __forceinline__ void fft_inv(LAS f32x2* X, const LAS f32x2* TW, int tid) {
    fft_pass<0, 2, true>(X, TW, tid); __syncthreads(); fft_pass<2, 3, true>(X, TW, tid); __syncthreads(); fft_pass<5, 4, true>(X, TW, tid); __syncthreads(); fft_pass<9, 4, true>(X, TW, tid); __syncthreads();
}
__device__ __forceinline__ void hyena_fft_unit(const Ptrs P, int l, int c, LAS unsigned char* lds) {
    const int tid = P.tid, lane = tid & 63;
    LAS f32x2* X = (LAS f32x2*)lds; LAS f32x2* TW = X + 8704;
    const f32x2* TWg = (const f32x2*)(P.ws + WS_TW);
    for (int i = tid; i < 4096; i += 512) TW[i] = TWg[i];
    float nrm; { const float* part = (const float*)(P.ws + WS_PART) + (size_t)l * 64 * 512; nrm = wave_sum(part[lane * 512 + c] + part[lane * 512 + 256 + c]); }
    const float inv = 1.0f / nrm; const float* filt = (const float*)(P.ws + WS_FILT) + (size_t)l * 8192 * 256 + c;
    for (int i = tid; i < 8192; i += 512) X[fphys(i)] = (f32x2){filt[(size_t)i * 256] * inv, 0.f};
    __syncthreads();
    fft_fwd(X, TW, tid);
    f32x2* Fg = (f32x2*)(P.ws + WS_BR) + (size_t)P.bid * 8192;
    for (int i = tid; i < 8192; i += 512) Fg[i] = X[fphys(i)];
    unsigned* WTt = (unsigned*)(P.ws + WS_BIG + BIG_WT); const float bias = P.inp(I_HYBIAS)[l * 256 + c];
    for (int p = 0; p < 4; ++p) {
        unsigned* wp = WTt + ((size_t)c * 4 + p) * 4096;
        __syncthreads();
        for (int i = tid; i < 8192; i += 512) { f32x2 v = (f32x2){0.f, 0.f}; if (i < 4096) { const unsigned w = wp[i]; v.x = __uint_as_float(w << 16); v.y = __uint_as_float(w & 0xffff0000u); } X[fphys(i)] = v; }
        __syncthreads();
        fft_fwd(X, TW, tid);
        for (int i = tid; i < 8192; i += 512) { const int q = fphys(i); X[q] = cmul(X[q], Fg[i]); }
        __syncthreads();
        fft_inv(X, TW, tid);
        for (int i = tid; i < 4096; i += 512) { const unsigned w = wp[i]; const f32x2 y = X[fphys(i)] * (1.0f / 8192.0f);
            wp[i] = pack2(y.x + __uint_as_float(w << 16) * bias, y.y + __uint_as_float(w & 0xffff0000u) * bias); }
    }
    __syncthreads();
}

__device__ __forceinline__ void phase_m1(const Ptrs P, int l, LAS unsigned char* lds) {
    const int tid = P.tid, G = P.G;
    const bf16_t* U = (const bf16_t*)(P.ws + WS_BIG + BIG_U); bf16_t* WT = (bf16_t*)(P.ws + WS_BIG + BIG_WT);
    const float* hcw = P.inp(I_HYCW) + (size_t)l * 3 * 768; const float* hcb = P.inp(I_HYCB) + l * 768;
    const int NH = NB * 4 * NCHK, NSS = NB * 2 * NCHK;
    const int NS2 = NH + NSS;
    const int NU = NS2 + 256 + NCTX / 64;
    for (int u = P.bid; u < NU; u += G) {
        Ptrs Pu = P; asm volatile("" : "+v"(Pu.tid));
        if (u < NSS) ssd_pass1(Pu, l, u, lds);
        else if (u < NS2) hgrn_pass1(Pu, l, u - NSS, lds);
        else if (u < NS2 + 256) {
            const int ub = u - NS2; const int p = ub >> 6, tb = ub & 63; const int c = tid & 255; LAS unsigned* tile = (LAS unsigned*)lds;
#pragma unroll 4
            for (int rr = tid >> 8; rr < 64; rr += 2) { float w2[2];
#pragma unroll
                for (int b2 = 0; b2 < 2; ++b2) { const int row = (2 * p + b2) * SEQ + tb * 64 + rr;
                    const float x1 = conv3_u(U, row, 256 + c, hcw, 768, 256 + c) + hcb[256 + c]; const float v = conv3_u(U, row, 512 + c, hcw, 768, 512 + c) + hcb[512 + c]; w2[b2] = x1 * v; }
                tile[c * 65 + rr] = pack2(w2[0], w2[1]); }
            __syncthreads();
            { unsigned* WTt = (unsigned*)(P.ws + WS_BIG + BIG_WT); const int t = tid & 63;
              for (int cc = tid >> 6; cc < 256; cc += 8) WTt[((size_t)cc * 4 + p) * 4096 + tb * 64 + t] = tile[cc * 65 + t]; }
            __syncthreads();
        } else {
            const int ub = u - NS2 - 256; const int c = tid & 255; bf16_t* WTC = (bf16_t*)(P.ws + WS_BIG + BIG_WT) + (size_t)NLAT * 256;
#pragma unroll 4
            for (int rr = tid >> 8; rr < 64; rr += 2) { const int row = NLAT + ub * 64 + rr;
                const float x1 = conv3_u(U, row, 256 + c, hcw, 768, 256 + c) + hcb[256 + c]; const float v = conv3_u(U, row, 512 + c, hcw, 768, 512 + c) + hcb[512 + c];
                WTC[(size_t)(row - NLAT) * 256 + c] = f2bf(x1 * v); } }
    }
}

__device__ __forceinline__ void phase_m2(const Ptrs P, int l, LAS unsigned char* lds) {
    const int tid = P.tid, G = P.G;
    const bf16_t* U = (const bf16_t*)(P.ws + WS_BIG + BIG_U); bf16_t* BR = (bf16_t*)(P.ws + WS_BR);
    const float* hcw = P.inp(I_HYCW) + (size_t)l * 3 * 768; const float* hcb = P.inp(I_HYCB) + l * 768;
    const int NU_F = 256, NU_P2 = 256, NU_HC = (l == 0) ? NB * 8 : 0;
    const int NU = NU_F + NU_P2 + NU_HC;
    for (int u = P.bid; u < NU; u += G) {
        if (u < NU_F) { hyena_fft_unit(P, l, u, lds); continue; }
        if (u < NU_F + NU_P2) { scan_pass2(P, u - NU_F); continue; }
        {
            const int uu = u - NU_F - NU_P2; const int b = uu >> 3, cb = uu & 7; const int cl = tid & 31, tg = tid >> 5; const int c = cb * 32 + cl;
            const int base = NLAT + b * CTXL; const bf16_t* WTC = (const bf16_t*)(P.ws + WS_BIG + BIG_WT) + (size_t)NLAT * 256 + (size_t)b * CTXL * 256;
            LAS float* wl = (LAS float*)lds; LAS float* fl = wl + 256 * 32;
            const float inv = 1.0f / hy_norm(P, 2, c); const float* filt = (const float*)(P.ws + WS_FILTC);
            for (int i = tid; i < 256 * 32; i += 512) wl[i] = bf2f(WTC[(size_t)(i >> 5) * 256 + cb * 32 + (i & 31)]);
            for (int i = tid >> 5; i < 512; i += 16) fl[i * 32 + cl] = filt[(size_t)i * 256 + c] * inv;
            __syncthreads();
            float acc[16];
#pragma unroll
            for (int j = 0; j < 16; ++j) acc[j] = 0.f;
#pragma unroll 1
            for (int sb = 0; sb < 16; ++sb) {
                float fw[31], wv[16];
#pragma unroll
                for (int q = 0; q < 31; ++q) fw[q] = fl[((16 * tg - 16 * sb - 15 + q) & 511) * 32 + cl];
#pragma unroll
                for (int k = 0; k < 16; ++k) wv[k] = wl[(16 * sb + k) * 32 + cl];
#pragma unroll
                for (int j = 0; j < 16; ++j)
#pragma unroll
                    for (int k = 0; k < 16; ++k) acc[j] += fw[j - k + 15] * wv[k];
            }
            const float bias = P.inp(I_HYBIAS)[l * 256 + c];
#pragma unroll 4
            for (int j = 0; j < 16; ++j) { const int tt = 16 * tg + j; const int row = base + tt; const float x0 = conv3_u(U, row, c, hcw, 768, c) + hcb[c];
                BR[(size_t)row * 256 + c] = f2bf(x0 * (acc[j] + wl[tt * 32 + cl] * bias)); }
            __syncthreads();
        }
    }
}

__device__ __forceinline__ void phase_m3(const Ptrs P, int l, LAS unsigned char* lds) {
    const int tid = P.tid, G = P.G;
    const bool last = (l == NLAYER - 1); const int rows_l = last ? NLAT : T;
    const bf16_t* U = (const bf16_t*)(P.ws + WS_BIG + BIG_U); bf16_t* BR = (bf16_t*)(P.ws + WS_BR);
    const int NSS3 = NB * 2 * NCHK, NH3 = NB * 4 * NCHK;
    const int NS3T = NSS3 + NH3;
    const int NU = NS3T + rows_l / 64 + 256;
    const float* hcw = P.inp(I_HYCW) + (size_t)l * 3 * 768; const float* hcb = P.inp(I_HYCB) + l * 768;
    for (int u = P.bid; u < NU; u += G) {
        if (u >= NS3T + rows_l / 64) {
            const int ub = u - NS3T - rows_l / 64; const int p = ub >> 6, tb = ub & 63; LAS unsigned* tile = (LAS unsigned*)lds; const unsigned* WTt = (const unsigned*)(P.ws + WS_BIG + BIG_WT);
            { const int t = tid & 63; for (int cc = tid >> 6; cc < 256; cc += 8) tile[cc * 65 + t] = WTt[((size_t)cc * 4 + p) * 4096 + tb * 64 + t]; }
            __syncthreads();
            { const int c = tid & 255;
#pragma unroll 4
              for (int rr = tid >> 8; rr < 64; rr += 2) { const unsigned yw = tile[c * 65 + rr];
#pragma unroll
                  for (int b2 = 0; b2 < 2; ++b2) { const int row = (2 * p + b2) * SEQ + tb * 64 + rr; const float x0 = conv3_u(U, row, c, hcw, 768, c) + hcb[c];
                      const float y = b2 ? __uint_as_float(yw & 0xffff0000u) : __uint_as_float(yw << 16); BR[(size_t)row * 256 + c] = f2bf(x0 * y); } } }
            __syncthreads();
            continue; }
        if (u < NS3T) { const int uu = u < NSS3 ? u : u - NSS3; if (last && (uu % NCHK) < 2) continue;
            Ptrs Pu = P; asm volatile("" : "+v"(Pu.tid));
            if (u < NSS3) ssd_pass3(Pu, l, uu, lds); else hgrn_pass3(Pu, l, uu, lds); }
        else { const int rb = u - NS3T; const float* cw = P.inp(I_SCCW) + (size_t)l * 3 * 256; const int c = tid & 255;
#pragma unroll 4
            for (int rr = tid >> 8; rr < 64; rr += 2) { const int row = rb * 64 + rr; float acc = 0.f;
#pragma unroll
                for (int k = 0; k < 3; ++k) { const bool ok = (k == 1) || (k == 0 ? row_has_prev(row) : row_has_next(row)); const int r2 = ok ? row + k - 1 : row;
                    const float pr = bf2f(U[(size_t)r2 * UC + 1024 + c]) * bf2f(U[(size_t)r2 * UC + 1280 + c]) * cw[k * 256 + c]; acc += ok ? pr : 0.f; }
                BR[(size_t)T * 256 + (size_t)row * 256 + c] = f2bf(bf2f(U[(size_t)row * UC + 768 + c]) * acc); } }
    }
}

__device__ __forceinline__ void phase_g2(const Ptrs P, int l, LAS unsigned char* lds) {
    const int MT = ((l == NLAYER - 1) ? NLAT : T) / 256;
    pg8::Gemm g{(const bf16_t*)(P.ws + WS_BR), (const bf16_t*)(P.ws + WS_WBR), 256};
    EpiP E{(bf16_t*)(P.ws + WS_BIG + BIG_P), (const float*)(P.ws + WS_SSQ)};
    SchedG2 S{XOrder{P.G, P.bid, MT, 16}};
    pg8::gemm_phase<EpiP, SchedG2, false>(P.tid, lds, g, S, E);
}
__device__ __forceinline__ void phase_g3(const Ptrs P, int l, LAS unsigned char* lds) {
    const int MT = ((l == NLAYER - 1) ? NLAT : T) / 256;
    pg8::Gemm g{(const bf16_t*)(P.ws + WS_HBUF), (const bf16_t*)(P.ws + WS_WG), D};
    EpiMerge E{(const bf16_t*)(P.ws + WS_BIG + BIG_P), (const float*)(P.ws + WS_BGP), (bf16_t*)(P.ws + WS_BR)};
    SchedMN S{XOrder{P.G, P.bid, MT, 16}};
    pg8::gemm_phase<EpiMerge, SchedMN, false>(P.tid, lds, g, S, E);
}
__device__ __forceinline__ void phase_g4(const Ptrs P, int l, LAS unsigned char* lds) {
    const int MT = ((l == NLAYER - 1) ? NLAT : T) / 256;
    pg8::Gemm g{(const bf16_t*)(P.ws + WS_BR), (const bf16_t*)(P.ws + WS_WO), D};
    EpiWo E{P, l};
    SchedMN S{XOrder{P.G, P.bid, MT, 4}};
    pg8::gemm_phase<EpiWo, SchedMN, false>(P.tid, lds, g, S, E);
}

__device__ __forceinline__ void phase_e5(const Ptrs P, int l, LAS unsigned char* lds) {
    const int tid = P.tid, wid = tid >> 6, lane = tid & 63, G = P.G, fr = lane & 15, fq = lane >> 4;
    const int rows_l = (l == NLAYER - 1) ? NLAT : T;
    LAS bf16_t* wrH = (LAS bf16_t*)lds;
    LAS bf16_t* wrL = wrH + 16 * 1032;
    LAS float* tile = (LAS float*)(lds + 69632);
    LAS float* lgs = (LAS float*)(lds + 136192);
    LAS unsigned* lcnt = (LAS unsigned*)(lds + 144896); LAS unsigned* gbase = lcnt + 16; LAS int* rec = (LAS int*)(lcnt + 32);
    for (int i = tid; i < 1024 * 16; i += 512) { const int k = i >> 4, e = i & 15; const float w = P.inp(I_WROUTER)[i]; const unsigned hi = pack2(w, 0.f) & 0xffffu; const float lo = w - __uint_as_float(hi << 16);
        wrH[e * 1032 + k] = (bf16_t)hi; wrL[e * 1032 + k] = f2bf(lo); }
    if (tid < 16) lcnt[tid] = 0u;
    __syncthreads();
    unsigned* cnt = (unsigned*)(P.ws + WS_CTL + CTL_CNT) + l * 16;
    int* toke = (int*)(P.ws + WS_TOKE); float* tokw = (float*)(P.ws + WS_TOKW); int* toks = (int*)(P.ws + WS_TOKS); int* list = (int*)(P.ws + WS_LIST);
    const float* g = P.inp(I_LN1G) + l * D; const float* bta = P.inp(I_LN1B) + l * D;
    bf16_t* H2 = (bf16_t*)(P.ws + WS_HBUF);
    const int NU_R = rows_l / 8; const int NU = NU_R + NCONV_EX;
    int nloc = 0;
    {
        RowV lng, lnb; row_load(lng, g, lane); row_load(lnb, bta, lane);
        RowV rn; if (P.bid < NU_R) row_load(rn, P.latrow(P.bid * 8 + wid), lane);
        for (int u = P.bid; u < NU_R; u += G) {
            const int row = u * 8 + wid; RowV r = rn; float* lp = P.latrow(row);
            if (u + G < NU_R) row_load(rn, P.latrow((u + G) * 8 + wid), lane);
            row_layernorm_r(r, lng, lnb); row_store(r, lp, lane);
            const float* m = P.mod(l, row_modidx(row)); RowV h; row_modulate(r, h, m + 3072, m + 4096, lane);
            row_store_bf16(h, H2 + (size_t)row * D, lane);
            ++nloc;
        }
    }
    asm volatile("s_waitcnt vmcnt(0)" ::: "memory");
    __syncthreads();
    {
        const int ntile = (nloc + 1) >> 1; LAS float* lg = lgs + wid * 16 * 17;
        for (int t = wid; t < ntile; t += 8) {
            int it = 2 * t + (fr >> 3); const bool valid_a = it < nloc; if (!valid_a) it = nloc - 1;
            const bf16_t* ap = H2 + (size_t)((P.bid + G * it) * 8 + (fr & 7)) * D + 8 * fq;
            f32x4 acc = (f32x4){0.f, 0.f, 0.f, 0.f};
#pragma unroll 4
            for (int ks = 0; ks < 32; ++ks) { const bf16x8 a = *(const bf16x8*)(ap + 32 * ks);
                const bf16x8 bh = *(const LAS bf16x8*)(wrH + fr * 1032 + 32 * ks + 8 * fq), bl = *(const LAS bf16x8*)(wrL + fr * 1032 + 32 * ks + 8 * fq);
                acc = __builtin_amdgcn_mfma_f32_16x16x32_bf16(a, bh, acc, 0, 0, 0); acc = __builtin_amdgcn_mfma_f32_16x16x32_bf16(a, bl, acc, 0, 0, 0); }
#pragma unroll
            for (int r = 0; r < 4; ++r) lg[(4 * fq + r) * 17 + fr] = acc[r];
            const int it2 = 2 * t + (lane >> 3); const bool act = (lane < 16) && (it2 < nloc);
            if (act) {
                const int row = (P.bid + G * it2) * 8 + (lane & 7);
                float lgv[16];
#pragma unroll
                for (int e = 0; e < 16; ++e) lgv[e] = lg[lane * 17 + e];
                float mx = lgv[0];
#pragma unroll
                for (int e = 1; e < 16; ++e) mx = fmaxf(mx, lgv[e]);
                float sc[16], sel[16], ssum = 0.f;
#pragma unroll
                for (int e = 0; e < 16; ++e) { sc[e] = expf(lgv[e] - mx); ssum += sc[e]; }
                const float inv = 1.0f / ssum;
#pragma unroll
                for (int e = 0; e < 16; ++e) { sc[e] *= inv; sel[e] = sc[e] + P.inp(I_BROUTER)[e]; }
                int bestg = 0; float bestgs = -3.0e38f;
#pragma unroll
                for (int gq = 0; gq < 4; ++gq) { float m1 = -3.0e38f, m2 = -3.0e38f;
#pragma unroll
                    for (int j = 0; j < 4; ++j) { const float v = sel[gq * 4 + j]; if (v > m1) { m2 = m1; m1 = v; } else if (v > m2) m2 = v; }
                    const float gs = m1 + m2; if (gs > bestgs) { bestgs = gs; bestg = gq; } }
                int i1 = 0, i2 = 0; float v1 = -3.0e38f, v2 = -3.0e38f, w1 = 0.f, w2 = 0.f;
#pragma unroll
                for (int e = 0; e < 16; ++e) { if ((e >> 2) == bestg && sel[e] > v1) { v1 = sel[e]; i1 = e; w1 = sc[e]; } }
#pragma unroll
                for (int e = 0; e < 16; ++e) { if ((e >> 2) == bestg && e != i1 && sel[e] > v2) { v2 = sel[e]; i2 = e; w2 = sc[e]; } }
                const float ws_ = 1.0f / (w1 + w2);
                const int s1 = (int)__hip_atomic_fetch_add(lcnt + i1, 1u, __ATOMIC_RELAXED, __HIP_MEMORY_SCOPE_WORKGROUP);
                const int s2 = (int)__hip_atomic_fetch_add(lcnt + i2, 1u, __ATOMIC_RELAXED, __HIP_MEMORY_SCOPE_WORKGROUP);
                const int idx = it2 * 8 + (lane & 7); rec[idx * 3] = i1 | (i2 << 8); rec[idx * 3 + 1] = s1; rec[idx * 3 + 2] = s2;
                toke[row * 2] = i1; toke[row * 2 + 1] = i2; tokw[row * 2] = w1 * ws_; tokw[row * 2 + 1] = w2 * ws_;
            }
        }
    }
    __syncthreads();
    if (tid < 16) gbase[tid] = __hip_atomic_fetch_add(cnt + tid, lcnt[tid], __ATOMIC_RELAXED, __HIP_MEMORY_SCOPE_AGENT);
    __syncthreads();
    for (int idx = tid; idx < nloc * 8; idx += 512) { const int row = (P.bid + G * (idx >> 3)) * 8 + (idx & 7); const int ee = rec[idx * 3]; const int e1 = ee & 255, e2 = ee >> 8;
        const int s1 = (int)gbase[e1] + rec[idx * 3 + 1], s2 = (int)gbase[e2] + rec[idx * 3 + 2];
        list[(size_t)e1 * T + s1] = row; list[(size_t)e2 * T + s2] = row; toks[row * 2] = s1; toks[row * 2 + 1] = s2; }
    for (int u = P.bid + G * nloc; u < NU; u += G) { if (u >= NU_R) conv_unit_ex(P, l, u - NU_R, tile); }
}

struct MoeSeg { int toff[17]; };
__device__ __forceinline__ void moe_seg(const unsigned* cnt, MoeSeg& S) { int a = 0;
#pragma unroll
    for (int e = 0; e < 16; ++e) { S.toff[e] = a; a += __builtin_amdgcn_readfirstlane(((int)cnt[e] + 255) >> 8); }
    S.toff[16] = a; }
__device__ __forceinline__ int moe_find(const MoeSeg& S, int tg, int& off) { int e = 0; off = 0;
#pragma unroll
    for (int j = 1; j < 16; ++j) { const bool ge = (tg >= S.toff[j]); e += ge ? 1 : 0; off = ge ? S.toff[j] : off; }
    return e; }

struct SchedMoe { int G, c; MoeSeg S; const int* list; const unsigned* cnt;
    __device__ __forceinline__ bool next(int i, Unit& u) const { const int L = i * G + c; if (L >= S.toff[16] * 4) return false; const int tg = L >> 2, pnn = L & 3; int off; const int e = moe_find(S, tg, off);
        u.pm = tg; u.pn = e * 4 + pnn; u.e = e; u.aux = tg - off; return true; }
    __device__ __forceinline__ int arow(const Unit& u, int R) const { const int idx = u.aux * 256 + R; const int* l = list + (size_t)u.e * T; return idx < (int)cnt[u.e] ? l[idx] : l[0]; } };
__device__ __forceinline__ void phase_g5(const Ptrs P, int l, LAS unsigned char* lds) {
    const unsigned* cnt = (const unsigned*)(P.ws + WS_CTL + CTL_CNT) + l * 16;
    SchedMoe S; S.G = P.G; S.c = P.bid; moe_seg(cnt, S.S); S.list = (const int*)(P.ws + WS_LIST); S.cnt = cnt;
    pg8::Gemm g{(const bf16_t*)(P.ws + WS_HBUF), (const bf16_t*)(P.ws + WS_BIG + BIG_W13), D};
    EpiFfn1 E{(bf16_t*)(P.ws + WS_BIG + BIG_HID)};
    pg8::gemm_phase<EpiFfn1, SchedMoe, true>(P.tid, lds, g, S, E);
}
__device__ __forceinline__ void phase_g6(const Ptrs P, int l, LAS unsigned char* lds) {
    const unsigned* cnt = (const unsigned*)(P.ws + WS_CTL + CTL_CNT) + l * 16;
    SchedMoe S; S.G = P.G; S.c = P.bid; moe_seg(cnt, S.S); S.list = (const int*)(P.ws + WS_LIST); S.cnt = cnt;
    pg8::Gemm g{(const bf16_t*)(P.ws + WS_BIG + BIG_HID), (const bf16_t*)(P.ws + WS_BIG + BIG_W2), 512};
    EpiBf16Plain E{(bf16_t*)(P.ws + WS_BIG + BIG_YE), 1024, 3};
    pg8::gemm_phase<EpiBf16Plain, SchedMoe, false>(P.tid, lds, g, S, E);
}

__device__ __forceinline__ void phase_e8(const Ptrs P, int l, LAS unsigned char* lds) {
    const int tid = P.tid, wid = tid >> 6, lane = tid & 63, G = P.G;
    const bool last = (l == NLAYER - 1); const int rows_l = last ? NLAT : T;
    LAS float* wdt = (LAS float*)lds; LAS float* tile = (LAS float*)(lds + 65536);
    if (!last) load_wdt(P, l + 1, wdt);
    const unsigned* cnt = (const unsigned*)(P.ws + WS_CTL + CTL_CNT) + l * 16; MoeSeg S; moe_seg(cnt, S);
    const int* toke = (const int*)(P.ws + WS_TOKE); const float* tokw = (const float*)(P.ws + WS_TOKW); const int* toks = (const int*)(P.ws + WS_TOKS);
    const bf16_t* YE = (const bf16_t*)(P.ws + WS_BIG + BIG_YE);
    const float* g = P.inp(I_LN2G) + l * D; const float* bta = P.inp(I_LN2B) + l * D;
    const int NU_R = rows_l / 8; const int NU = NU_R + (last ? 0 : NCONV_NE);
    RowV lng, lnb; row_load(lng, g, lane); row_load(lnb, bta, lane);
    RowV rn; int te1 = 0, te2 = 0, ts1 = 0, ts2 = 0; float tw1 = 0.f, tw2 = 0.f;
    if (P.bid < NU_R) { const int row = P.bid * 8 + wid; row_load(rn, P.latrow(row), lane); te1 = toke[row * 2]; te2 = toke[row * 2 + 1]; tw1 = tokw[row * 2]; tw2 = tokw[row * 2 + 1]; ts1 = toks[row * 2]; ts2 = toks[row * 2 + 1]; }
    for (int u = P.bid; u < NU; u += G) {
        if (u >= NU_R) { conv_unit_ne(P, l + 1, u - NU_R, tile); continue; }
        const int row = u * 8 + wid; RowV r = rn; float* lp = P.latrow(row);
        const int e1 = te1, e2 = te2; const float w1 = tw1, w2 = tw2;
        int o1 = 0, o2 = 0;
#pragma unroll
        for (int e = 0; e < 16; ++e) { o1 = (e == e1) ? S.toff[e] : o1; o2 = (e == e2) ? S.toff[e] : o2; }
        const bf16_t* y1 = YE + ((size_t)o1 * 256 + ts1) * 1024; const bf16_t* y2 = YE + ((size_t)o2 * 256 + ts2) * 1024;
        u32x2 ya[4], yb[4];
#pragma unroll
        for (int i = 0; i < 4; ++i) { ya[i] = *(const u32x2*)(y1 + i * 256 + lane * 4); yb[i] = *(const u32x2*)(y2 + i * 256 + lane * 4); }
        if (u + G < NU_R) { const int rw = (u + G) * 8 + wid; row_load(rn, P.latrow(rw), lane); te1 = toke[rw * 2]; te2 = toke[rw * 2 + 1]; tw1 = tokw[rw * 2]; tw2 = tokw[rw * 2 + 1]; ts1 = toks[rw * 2]; ts2 = toks[rw * 2 + 1]; }
        const float* m = P.mod(l, row_modidx(row));
#pragma unroll
        for (int i = 0; i < 4; ++i) { const u32x2 a = ya[i], b = yb[i];
            const f32x4 g2 = *(const f32x4*)(m + 5120 + i * 256 + lane * 4);
            f32x4 mo; mo[0] = w1 * __uint_as_float(a.x << 16) + w2 * __uint_as_float(b.x << 16); mo[1] = w1 * __uint_as_float(a.x & 0xffff0000u) + w2 * __uint_as_float(b.x & 0xffff0000u);
            mo[2] = w1 * __uint_as_float(a.y << 16) + w2 * __uint_as_float(b.y << 16); mo[3] = w1 * __uint_as_float(a.y & 0xffff0000u) + w2 * __uint_as_float(b.y & 0xffff0000u);
            r.v[i] = r.v[i] * ALPHA + g2 * mo; }
        row_layernorm_r(r, lng, lnb);
        row_store(r, lp, lane);
        if (!last) { const float* m2 = P.mod(l + 1, row_modidx(row)); RowV h; row_modulate(r, h, m2, m2 + 1024, lane);
            row_store_bf16(h, (bf16_t*)(P.ws + WS_HBUF) + (size_t)row * D, lane); row_dt(h, wdt, (float*)(P.ws + WS_DT) + (size_t)row * 8, lane); }
    }
}

constexpr int NPH_LAYER = 11, NPH = 2 + NLAYER * NPH_LAYER;
__global__ void __launch_bounds__(512, 2) fwd_kernel(Args a) {
    extern __shared__ __attribute__((aligned(16))) unsigned char lds_raw[];
    LAS unsigned char* lds = (LAS unsigned char*)lds_raw;
    const int lo = a.ph_lo, hi = a.ph_hi;
    volatile LAS unsigned* xbw = (volatile LAS unsigned*)(lds + LDS_MISC);
    const int wave_s = __builtin_amdgcn_readfirstlane((int)threadIdx.x >> 6);
    if (threadIdx.x < 4) xbw[threadIdx.x] = 0u;
    __syncthreads();
    XcdBarrier bar; bar.bar = (unsigned*)(a.ws + WS_CTL); bar.x = 0; bar.st = xbw;
    if (hi - lo > 1) bar = xcd_barrier_post((unsigned*)(a.ws + WS_CTL), xbw, wave_s);
#ifndef PH_MASK
#define PH_MASK 0xFFFFFFFFu
#endif
#ifndef PROBE_PH
#define PROBE_PH (-1)
#define PROBE_N 1
#endif
#define REP(id) for (int rep_ = 0; rep_ < ((PROBE_PH == (id)) ? PROBE_N : 1); ++rep_)
#define PH_ON(id) (((PH_MASK) >> (id)) & 1u)
#define IN(k) (lo <= (k) && (k) < hi)
#define FRESH() Ptrs Pq; { float* o_ = a.out; unsigned char* w_ = a.ws; int l_ = lcur; asm volatile("" : "+s"(o_), "+s"(w_), "+s"(l_) :: "memory"); Pq.out = o_; Pq.ws = w_; lq = l_; int ws_ = wave_s, b_ = blockIdx.x, g_ = gridDim.x; asm volatile("" : "+s"(ws_), "+s"(b_), "+s"(g_)); int ln_ = lane_id(); asm volatile("" : "+v"(ln_)); int t_ = ws_ * 64 + ln_; Pq.tid = t_; Pq.bid = b_; Pq.G = g_; }
#define SEAM(k) do { if (IN(k) && IN((k) + 1)) xcd_barrier(bar, wave_s); } while (0)
    int lcur = 0, lq = 0;
    if (PH_ON(0) && IN(0)) REP(0) { FRESH(); phase_pa(Pq, lds); } SEAM(0);
    if (PH_ON(1) && IN(1)) REP(1) { FRESH(); phase_pb(Pq, lds); } SEAM(1);
    for (int l = 0; l < NLAYER; ++l) {
        const int b = 2 + l * NPH_LAYER; lcur = l;
        if (PH_ON(2) && IN(b + 0)) REP(2) { FRESH(); phase_g1(Pq, lds); } SEAM(b + 0);
        for (int g_ = 0; g_ < ((PROBE_PH == 100) ? PROBE_N : 1); ++g_) {
        if (PH_ON(3) && IN(b + 1)) REP(3) { FRESH(); phase_m1(Pq, lq, lds); } SEAM(b + 1);
        if (PH_ON(4) && IN(b + 2)) REP(4) { FRESH(); phase_m2(Pq, lq, lds); } SEAM(b + 2);
        if (PH_ON(5) && IN(b + 3)) REP(5) { FRESH(); phase_m3(Pq, lq, lds); } SEAM(b + 3);
        }
        if (PH_ON(6) && IN(b + 4)) REP(6) { FRESH(); phase_g2(Pq, lq, lds); } SEAM(b + 4);
        if (PH_ON(7) && IN(b + 5)) REP(7) { FRESH(); phase_g3(Pq, lq, lds); } SEAM(b + 5);
        if (PH_ON(8) && IN(b + 6)) REP(8) { FRESH(); phase_g4(Pq, lq, lds); } SEAM(b + 6);
        if (PH_ON(9) && IN(b + 7)) REP(9) { FRESH(); phase_e5(Pq, lq, lds); } SEAM(b + 7);
        if (PH_ON(10) && IN(b + 8)) REP(10) { FRESH(); phase_g5(Pq, lq, lds); } SEAM(b + 8);
        if (PH_ON(11) && IN(b + 9)) REP(11) { FRESH(); phase_g6(Pq, lq, lds); } SEAM(b + 9);
        if (PH_ON(12) && IN(b + 10)) REP(12) { FRESH(); phase_e8(Pq, lq, lds); } SEAM(b + 10);
    }
#undef IN
#undef SEAM
}
}

extern "C" void kernel_launch(void* const* d_in, const int* in_sizes, int n_in, void* d_out, int out_size, void* d_ws, size_t ws_size, hipStream_t stream) {
    static int grid = 0;
    if (grid == 0) {
        if (n_in != N_IN || out_size != NLAT * D || ws_size < WS_END) { fprintf(stderr, "kernel_launch: unexpected shapes / workspace (%d inputs, out %d, ws %zu < %zu)\n", n_in, out_size, ws_size, (size_t)WS_END); grid = -1; return; }
        int dev = 0, cus = 0, per_cu = 0;
        if (hipGetDevice(&dev) != hipSuccess || hipDeviceGetAttribute(&cus, hipDeviceAttributeMultiprocessorCount, dev) != hipSuccess) { grid = -1; return; }
        if (hipFuncSetAttribute((const void*)fwd_kernel, hipFuncAttributeMaxDynamicSharedMemorySize, LDS_BYTES) != hipSuccess) { fprintf(stderr, "kernel_launch: hipFuncSetAttribute failed\n"); grid = -1; return; }
        if (hipOccupancyMaxActiveBlocksPerMultiprocessor(&per_cu, (const void*)fwd_kernel, 512, LDS_BYTES) != hipSuccess || per_cu < 1) { fprintf(stderr, "kernel_launch: occupancy query says %d\n", per_cu); }
        (void)hipGetLastError();
        grid = cus;
    }
    if (grid < 0) return;
    (void)hipMemsetAsync((char*)d_ws + WS_CTL, 0, CTL_BYTES, stream);
    Args a{};
    for (int i = 0; i < N_IN; ++i) a.in[i] = (const float*)d_in[i];
    a.out = (float*)d_out; a.ws = (unsigned char*)d_ws;
#if N_LAUNCH_MODE == 1
    a.ph_lo = 0; a.ph_hi = NPH;
    hipLaunchKernelGGL(fwd_kernel, dim3(grid), dim3(512), LDS_BYTES, stream, a);
#else
    for (int p = 0; p < NPH; ++p) { a.ph_lo = p; a.ph_hi = p + 1; hipLaunchKernelGGL(fwd_kernel, dim3(grid), dim3(512), LDS_BYTES, stream, a); }
#endif
}
```

```cpp
#include <hip/hip_runtime.h>
#include <cstdio>
#include <cstdint>

#ifndef N_LAUNCH_MODE
#define N_LAUNCH_MODE 1
#endif

namespace {
typedef unsigned short bf16_t;
typedef short bf16x8 __attribute__((ext_vector_type(8)));
typedef float f32x4 __attribute__((ext_vector_type(4)));
typedef unsigned u32x2 __attribute__((ext_vector_type(2)));
typedef unsigned u32x4 __attribute__((ext_vector_type(4)));
#define LAS __attribute__((address_space(3)))

constexpr int D = 1024, NB = 8, SEQ = 4096, CTXL = 256, NLAT = NB * SEQ, NCTX = NB * CTXL, T = NLAT + NCTX;
constexpr int NLAYER = 2;
constexpr int UC = 3584;
constexpr int INC = 3592;
constexpr int NE = 16;
constexpr float ALPHA = 1.41421356237309515f;
constexpr float LN_EPS = 1e-5f, RMS_EPS = 1e-6f;
constexpr int MAXTILES = 288;

enum { I_X = 0, I_C, I_CTX, I_CCTX, I_WADA, I_BADA, I_WIN, I_HYCW, I_HYCB, I_HYW1, I_HYB1, I_HYF1, I_HYW2, I_HYB2, I_HYF2, I_HYW3, I_HYDEC, I_HYBIAS,
       I_SCCW, I_HGLB, I_HGNG, I_SSDCW, I_SSDCB, I_SSDALOG, I_SSDDTB, I_SSDD, I_SSDNG, I_WGATE, I_BGATE, I_WBR, I_WO, I_LN1G, I_LN1B, I_LN2G, I_LN2B,
       I_WROUTER, I_BROUTER, I_WE1, I_WE3, I_WE2, N_IN };

constexpr size_t al256(size_t x) { return (x + 255) & ~(size_t)255; }
constexpr size_t WS_CTL = 0;
constexpr size_t CTL_BYTES = 65536;
constexpr size_t CTL_CNT = 16384;
constexpr size_t WS_MOD = WS_CTL + CTL_BYTES;
constexpr size_t WS_LB = WS_MOD + al256((size_t)NLAYER * 9 * 6144 * 4);
constexpr size_t WS_TW = WS_LB + 4096;
constexpr size_t WS_H2TAB = WS_TW + 65536;
constexpr size_t WS_PART = WS_H2TAB + (size_t)8448 * 64 * 4;
constexpr size_t WS_FILT = WS_PART + (size_t)3 * 64 * 512 * 4;
constexpr size_t WS_FILTC = WS_FILT + (size_t)2 * 8192 * 256 * 4;
constexpr size_t WS_CX32 = WS_FILTC + (size_t)512 * 256 * 4;
constexpr size_t WS_DT = WS_CX32 + (size_t)NCTX * D * 4;
constexpr size_t WS_SSQ = WS_DT + (size_t)T * 8 * 4;
constexpr size_t WS_TOKE = WS_SSQ + (size_t)T * 4 * 4;
constexpr size_t WS_TOKW = WS_TOKE + (size_t)T * 2 * 4;
constexpr size_t WS_TOKS = WS_TOKW + (size_t)T * 2 * 4;
constexpr size_t WS_LIST = WS_TOKS + (size_t)T * 2 * 4;
constexpr size_t WS_BGP = WS_LIST + (size_t)NE * T * 4;
constexpr size_t WS_DEC = WS_BGP + 16384;
constexpr size_t WS_WIN = WS_DEC + (size_t)4352 * 64 * 4;
constexpr size_t WS_WG = WS_WIN + (size_t)UC * D * 2;
constexpr size_t WS_WBR = WS_WG + (size_t)4096 * D * 2;
constexpr size_t WS_WO = WS_WBR + (size_t)4096 * 256 * 2;
constexpr size_t WS_HBUF = WS_WO + (size_t)D * D * 2;
constexpr size_t WS_BR = WS_HBUF + (size_t)T * D * 2;
constexpr size_t WS_BIG = WS_BR + (size_t)T * D * 2;
constexpr size_t BIG_U = 0;
constexpr size_t BIG_HGO = BIG_U + (size_t)T * UC * 2;
constexpr size_t BIG_STATE = BIG_HGO;
constexpr size_t BIG_SSY = BIG_HGO + (size_t)T * 256 * 4;
constexpr size_t BIG_WT = BIG_SSY + (size_t)T * 256 * 4;
constexpr size_t BIG_END1 = BIG_WT + (size_t)T * 256 * 2;
constexpr size_t BIG_P = 0;
constexpr size_t BIG_HID = 0;
constexpr size_t BIG_YE = BIG_HID + (size_t)MAXTILES * 256 * 512 * 2;
constexpr size_t BIG_W13 = BIG_YE + (size_t)MAXTILES * 256 * 1024 * 2;
constexpr size_t BIG_W2 = BIG_W13 + (size_t)NE * 1024 * 1024 * 2;
constexpr size_t BIG_END3 = BIG_W2 + (size_t)NE * 1024 * 512 * 2;
constexpr size_t BIG_BYTES = BIG_END1 > BIG_END3 ? BIG_END1 : BIG_END3;
constexpr size_t WS_END = WS_BIG + BIG_BYTES;
static_assert((size_t)T * 4096 * 2 <= BIG_BYTES, "P fits");
static_assert(WS_END <= (size_t)536870912, "workspace budget");

constexpr int LDS_BYTES = 147456;
constexpr int LDS_MISC = 147456 - 256;

struct Args { const float* in[N_IN]; float* out; unsigned char* ws; int ph_lo, ph_hi; };

#define XB_TMO      128
#define XB_XCNT(j)  (256  + 64 * (j))
#define XB_XSUB(j)  (1280 + 64 * (j))
#define XB_XGEN(j)  (2304 + 64 * (j))
#define XB_TOP      3328
#define XB_TOPGEN   3392
#define XCD_BAR_WORDS 3456
#define XB_SPIN_CAP (1u << 18)
__device__ __forceinline__ unsigned xb_ld(unsigned* p)              { return __hip_atomic_load(p, __ATOMIC_RELAXED, __HIP_MEMORY_SCOPE_AGENT); }
__device__ __forceinline__ unsigned xb_add(unsigned* p, unsigned v) { return __hip_atomic_fetch_add(p, v, __ATOMIC_RELAXED, __HIP_MEMORY_SCOPE_AGENT); }
__device__ __forceinline__ unsigned xb_xcc_id() { return (unsigned)__builtin_amdgcn_s_getreg((3 << 11) | 20) & 0xFu; }
#define XB_SPIN(cond, bar) do { unsigned _sp = 0; while (cond) { __builtin_amdgcn_s_sleep(1); \
    if ((++_sp & 255u) == 0u) { if (xb_ld(&(bar)[XB_TMO])) break; if (_sp > XB_SPIN_CAP) { atomicAdd(&(bar)[XB_TMO], 1u); break; } } } } while (0)
struct XcdBarrier { unsigned* bar; unsigned x; volatile LAS unsigned* st; };
__device__ __forceinline__ int lane_id() { unsigned z = 0u; asm volatile("" : "+v"(z)); return (int)__builtin_amdgcn_mbcnt_hi(~0u, __builtin_amdgcn_mbcnt_lo(~0u, z)); }
__device__ __forceinline__ bool is_thread0(int wave_s) { return wave_s == 0 && lane_id() == 0; }
__device__ __forceinline__ XcdBarrier xcd_barrier_post(unsigned* bar, volatile LAS unsigned* st, int wave_s) {
    XcdBarrier b; b.bar = bar; b.x = xb_xcc_id(); b.st = st;
    if (is_thread0(wave_s)) (void)xb_add(&bar[XB_XCNT(b.x)], 1u);
    return b;
}
__device__ __forceinline__ void xcd_barrier_complete(unsigned* bar, unsigned x, unsigned& nloc, unsigned& nx) {
    const unsigned G = gridDim.x * gridDim.y * gridDim.z;
    unsigned sum, cnt, mine, sp = 0u;
    for (;;) {
        sum = 0u; cnt = 0u; mine = 0u;
#pragma unroll
        for (unsigned j = 0; j < 16; ++j) { const unsigned c = xb_ld(&bar[XB_XCNT(j)]); sum += c; cnt += (c > 0u) ? 1u : 0u; mine = (j == x) ? c : mine; }
        if (sum == G) break;
        __builtin_amdgcn_s_sleep(1);
        if ((++sp & 255u) == 0u) { if (xb_ld(&bar[XB_TMO])) break; if (sp > XB_SPIN_CAP) { atomicAdd(&bar[XB_TMO], 1u); break; } }
    }
    nloc = mine > 0u ? mine : 1u; nx = cnt > 0u ? cnt : 1u;
}
__device__ __forceinline__ void xcd_barrier(const XcdBarrier& b, int wave_s) {
    asm volatile("s_waitcnt vmcnt(0)" ::: "memory");
    __syncthreads();
    if (is_thread0(wave_s)) {
        unsigned* bar = b.bar;
        __builtin_amdgcn_s_waitcnt(0);
        unsigned nloc = b.st[0], nx = b.st[1];
        if (nloc == 0u) { xcd_barrier_complete(bar, b.x, nloc, nx); b.st[0] = nloc; b.st[1] = nx; }
        const unsigned old = xb_add(&bar[XB_XSUB(b.x)], 1u);
        const unsigned gen = old / nloc;
        if (old + 1u == (gen + 1u) * nloc) {
            __builtin_amdgcn_fence(__ATOMIC_RELEASE, "agent");
            asm volatile("s_waitcnt vmcnt(0)" ::: "memory");
            const unsigned og = xb_add(&bar[XB_TOP], 1u);
            const unsigned tg = og / nx;
            if (og + 1u == (tg + 1u) * nx) xb_add(&bar[XB_TOPGEN], 1u);
            else XB_SPIN(xb_ld(&bar[XB_TOPGEN]) == tg, bar);
            __builtin_amdgcn_fence(__ATOMIC_ACQUIRE, "agent");
            xb_add(&bar[XB_XGEN(b.x)], 1u);
            asm volatile("s_waitcnt vmcnt(0)" ::: "memory");
        } else {
            XB_SPIN(xb_ld(&bar[XB_XGEN(b.x)]) == gen, bar);
            __builtin_amdgcn_fence(__ATOMIC_ACQUIRE, "agent");
            asm volatile("s_waitcnt vmcnt(0)" ::: "memory");
        }
    }
    __syncthreads();
}

__device__ __forceinline__ float bf2f(bf16_t b) { return __uint_as_float(((unsigned)b) << 16); }
typedef __bf16 hwbf2 __attribute__((ext_vector_type(2)));
typedef float hwf2 __attribute__((ext_vector_type(2)));
__device__ __forceinline__ unsigned pack2(float lo, float hi) { const hwf2 v = {lo, hi}; return __builtin_bit_cast(unsigned, __builtin_convertvector(v, hwbf2)); }
__device__ __forceinline__ bf16_t f2bf(float f) { return (bf16_t)(pack2(f, 0.f) & 0xffffu); }
__device__ __forceinline__ float sigmoidf_(float x) { return __builtin_amdgcn_rcpf(1.0f + __expf(-x)); }
__device__ __forceinline__ float siluf_(float x) { return x * sigmoidf_(x); }
__device__ __forceinline__ float wave_sum(float v) {
#pragma unroll
    for (int o = 32; o >= 1; o >>= 1) v += __shfl_xor(v, o);
    return v;
}
__device__ __forceinline__ int row_modidx(int r) { return r < NLAT ? (r >> 12) : 8; }
__device__ __forceinline__ bool row_has_prev(int r) { return r < NLAT ? ((r & 4095) != 0) : (((r - NLAT) & 255) != 0); }
__device__ __forceinline__ bool row_has_next(int r) { return r < NLAT ? ((r & 4095) != 4095) : (((r - NLAT) & 255) != 255); }

#define AS1 __attribute__((address_space(1)))
#define AS4 __attribute__((address_space(4)))
struct Ptrs {
    float* out; unsigned char* ws; int tid, bid, G;
    __device__ __forceinline__ const float* inp(int i) const { asm volatile("" : "+s"(i));
        const __attribute__((address_space(4))) char* ka = (const __attribute__((address_space(4))) char*)__builtin_amdgcn_kernarg_segment_ptr();
        return (const float*)(*(const AS1 float* const AS4*)(ka + 8 * i)); }
    __device__ __forceinline__ float* latrow(int r) const { return r < NLAT ? out + (size_t)r * D : (float*)(ws + WS_CX32) + (size_t)(r - NLAT) * D; }
    __device__ __forceinline__ float* mod(int l, int ridx) const { return (float*)(ws + WS_MOD) + ((size_t)l * 9 + ridx) * 6144; }
};

__device__ __forceinline__ float conv3_u(const bf16_t* U, int row, int col, const float* w, int ncol, int wcol) {
    const bool hp = row_has_prev(row), hn = row_has_next(row);
    const float c = bf2f(U[(size_t)row * UC + col]), p = bf2f(U[(size_t)(hp ? row - 1 : row) * UC + col]), n = bf2f(U[(size_t)(hn ? row + 1 : row) * UC + col]);
    return c * w[ncol + wcol] + (hp ? p * w[wcol] : 0.f) + (hn ? n * w[2 * ncol + wcol] : 0.f);
}

struct Unit { int pm, pn, e, aux; };
__host__ __device__ __forceinline__ int perm32(int rho) { const int n = rho >> 4, i = rho & 15; return 8 * (i >> 2) + 4 * n + (i & 3); }

template <class RowMap, class Epi>
__device__ __forceinline__ void sgemm_unit(int tid_, const bf16_t* __restrict__ A, int lda, const bf16_t* __restrict__ Bt, int ldb, int K, const Unit& u, const RowMap& RM, const Epi& E) {
    const int tid = tid_, wid = tid >> 6, lane = tid & 63, wr = wid >> 2, wc = wid & 3, fr = lane & 15, fq = lane >> 4;
    f32x4 acc[2][2][4][2];
#pragma unroll
    for (int a = 0; a < 2; ++a)
#pragma unroll
        for (int b = 0; b < 2; ++b)
#pragma unroll
            for (int m = 0; m < 4; ++m)
#pragma unroll
                for (int n = 0; n < 2; ++n) acc[a][b][m][n] = (f32x4){0.f, 0.f, 0.f, 0.f};
    unsigned ap[2][4], bp[2][2];
#pragma unroll
    for (int a = 0; a < 2; ++a)
#pragma unroll
        for (int m = 0; m < 4; ++m) ap[a][m] = (unsigned)RM(u, 128 * a + 64 * wr + 16 * m + fr) * (unsigned)lda + fq * 8;
#pragma unroll
    for (int b = 0; b < 2; ++b)
#pragma unroll
        for (int n = 0; n < 2; ++n) { const int rho = 16 * n + fr; const int col = Epi::PERM ? perm32(rho) : rho;
            bp[b][n] = (unsigned)(u.pn * 256 + 128 * b + 32 * wc + col) * (unsigned)ldb + fq * 8; }
    for (int k = 0; k < K; k += 32) {
        bf16x8 bfr[2][2];
#pragma unroll
        for (int b = 0; b < 2; ++b)
#pragma unroll
            for (int n = 0; n < 2; ++n) bfr[b][n] = *(const bf16x8*)(Bt + (bp[b][n] + k));
#pragma unroll
        for (int a = 0; a < 2; ++a) {
            bf16x8 af[4];
#pragma unroll
            for (int m = 0; m < 4; ++m) af[m] = *(const bf16x8*)(A + (ap[a][m] + k));
#pragma unroll
            for (int b = 0; b < 2; ++b)
#pragma unroll
                for (int m = 0; m < 4; ++m)
#pragma unroll
                    for (int n = 0; n < 2; ++n) acc[a][b][m][n] = __builtin_amdgcn_mfma_f32_16x16x32_bf16(bfr[b][n], af[m], acc[a][b][m][n], 0, 0, 0);
        }
    }
    E(acc, u, wr, wc, fr, fq);
}

struct RowIdent { __device__ __forceinline__ int operator()(const Unit& u, int R) const { return u.pm * 256 + R; } };
struct RowStackK { int rows; __device__ __forceinline__ int operator()(const Unit& u, int R) const { return u.e * rows + u.pm * 256 + R; } };
struct RowGather { const int* list; const unsigned* cnt; __device__ __forceinline__ int operator()(const Unit& u, int R) const {
    const int idx = u.aux * 256 + R; const int* l = list + (size_t)u.e * T; return idx < (int)cnt[u.e] ? l[idx] : l[0]; } };


namespace pg8 {
constexpr int BM = 256, BK = 64, HALF = 128, HTB = HALF * BK * 2, STAGE_BYTES = 8 * HTB;
__host__ __device__ __forceinline__ int lds_byte(int r, int c) { const int st = (r >> 4) * 2 + (c >> 5), rr = r & 15, cc = c & 31, ob = rr * 64 + cc * 2; return st * 1024 + (ob ^ (((ob >> 9) & 1) << 5)); }
__host__ __device__ __forceinline__ void stage_rc(int b, int& R, int& C) { const int st = b / 1024, sb = b % 1024, swz = sb ^ (((sb >> 9) & 1) << 5); R = (st >> 1) * 16 + swz / 64; C = (st & 1) * 32 + (swz % 64) / 2; }
struct Gemm { const bf16_t* A; const bf16_t* Bt; int K; };

template <class Epi, class Sched, bool GATHER>
__device__ __forceinline__ void gemm_phase(int tid, LAS unsigned char* lds, const Gemm g, const Sched& S, const Epi& E) {
    const int wid = __builtin_amdgcn_readfirstlane(tid >> 6), lane = tid & 63, wr = wid >> 2, wc = wid & 3, fr = lane & 15, fq = lane >> 4;
    const int K = g.K, nt = K / BK;
    int RA[2], CA[2]; unsigned voffB[2];
    unsigned vA[2][2], vAn[2][2];
#pragma unroll
    for (int i = 0; i < 2; ++i) { int R, C; stage_rc(tid * 16 + i * 8192, R, C); RA[i] = R; CA[i] = C; const int Rb = Epi::PERM ? ((R & ~31) + perm32(R & 31)) : R; voffB[i] = (unsigned)(Rb * K + C) * 2u; }
    const size_t kstep = (size_t)(BK * 2);
    const size_t hstep = (size_t)HALF * K * 2;
    const size_t tstep = 2 * hstep;
    const unsigned ldsw = (unsigned)wid * 1024u;
    const int aoff = lds_byte(wr * 64 + fr, fq * 8), boff = lds_byte(wc * 32 + fr, fq * 8);
#define PG8_SA(b, h) (((b) * 2 + (h)) * HTB)
#define PG8_SB(b, h) ((4 + (b) * 2 + (h)) * HTB)
#define PG8_STAGE(bufoff, gbase, voff) do { _Pragma("unroll") for (int _i = 0; _i < 2; ++_i) \
        __builtin_amdgcn_global_load_lds((const unsigned*)((const char*)(gbase) + (voff)[_i]), (LAS unsigned*)(lds + (bufoff) + ldsw + _i * 8192), 16, 0, 0); } while (0)
#define PG8_STAGE2(bufoff, gbase, v0, v1) do { \
        __builtin_amdgcn_global_load_lds((const unsigned*)((const char*)(gbase) + (v0)), (LAS unsigned*)(lds + (bufoff) + ldsw), 16, 0, 0); \
        __builtin_amdgcn_global_load_lds((const unsigned*)((const char*)(gbase) + (v1)), (LAS unsigned*)(lds + (bufoff) + ldsw + 8192), 16, 0, 0); } while (0)
#define PG8_LDA(dst, b, h) do { _Pragma("unroll") for (int m = 0; m < 4; ++m) _Pragma("unroll") for (int k = 0; k < 2; ++k) dst[m][k] = *(const LAS bf16x8*)(lds + PG8_SA(b, h) + aoff + m * 2048 + k * 1024); } while (0)
#define PG8_LDB(dst, b, h) do { _Pragma("unroll") for (int n = 0; n < 2; ++n) _Pragma("unroll") for (int k = 0; k < 2; ++k) dst[n][k] = *(const LAS bf16x8*)(lds + PG8_SB(b, h) + boff + n * 2048 + k * 1024); } while (0)
#define PG8_MMA(ai, bj, At, Bt) do { __builtin_amdgcn_s_setprio(1); _Pragma("unroll") for (int m = 0; m < 4; ++m) _Pragma("unroll") for (int n = 0; n < 2; ++n) _Pragma("unroll") for (int k = 0; k < 2; ++k) \
        acc[ai][bj][m][n] = __builtin_amdgcn_mfma_f32_16x16x32_bf16(Bt[n][k], At[m][k], acc[ai][bj][m][n], 0, 0, 0); __builtin_amdgcn_s_setprio(0); } while (0)
#define PG8_WAIT_V(n) asm volatile("s_waitcnt vmcnt(" #n ")" ::: "memory")
#define PG8_WAIT_L(n) asm volatile("s_waitcnt lgkmcnt(" #n ")" ::: "memory")
#define PG8_BAR __builtin_amdgcn_s_barrier()
#define PG8_SCHED __builtin_amdgcn_sched_barrier(0)
#define PG8_AOFFS(dst, unit) do { _Pragma("unroll") for (int _h = 0; _h < 2; ++_h) _Pragma("unroll") for (int _i = 0; _i < 2; ++_i) \
        dst[_h][_i] = GATHER ? ((unsigned)S.arow(unit, _h * HALF + RA[_i]) * (unsigned)K + (unsigned)CA[_i]) * 2u : ((unsigned)(_h * HALF + RA[_i]) * (unsigned)K + (unsigned)CA[_i]) * 2u; } while (0)
    Unit cur, nxt; int ui = 0;
    if (!S.next(0, cur)) return;
    f32x4 acc[2][2][4][2];
#pragma unroll
    for (int a = 0; a < 2; ++a)
#pragma unroll
        for (int b = 0; b < 2; ++b)
#pragma unroll
            for (int m = 0; m < 4; ++m)
#pragma unroll
                for (int n = 0; n < 2; ++n) acc[a][b][m][n] = (f32x4){0.f, 0.f, 0.f, 0.f};
    bf16x8 At[4][2], B0[2][2], B1[2][2];
    const char* cA = GATHER ? (const char*)g.A : (const char*)g.A + (size_t)cur.pm * tstep; const char* cB = (const char*)g.Bt + (size_t)cur.pn * tstep;
    PG8_AOFFS(vA, cur);
    PG8_STAGE(PG8_SB(0, 0), cB, voffB); PG8_STAGE(PG8_SB(0, 1), cB + hstep, voffB); PG8_STAGE2(PG8_SA(0, 0), cA, vA[0][0], vA[0][1]); PG8_STAGE2(PG8_SA(0, 1), cA, vA[1][0], vA[1][1]);
    if (wr == 1) PG8_BAR;
    PG8_WAIT_V(2); PG8_BAR;
    PG8_STAGE(PG8_SB(1, 0), cB + kstep, voffB); PG8_STAGE2(PG8_SA(1, 0), cA + kstep, vA[0][0], vA[0][1]); PG8_STAGE(PG8_SB(1, 1), cB + hstep + kstep, voffB);
    PG8_WAIT_V(6); PG8_BAR;
    for (;;) {
        const bool has_next = S.next(ui + 1, nxt);
        const char* nA = GATHER ? (const char*)g.A : (has_next ? (const char*)g.A + (size_t)nxt.pm * tstep : cA); const char* nB = has_next ? (const char*)g.Bt + (size_t)nxt.pn * tstep : cB;
        if (has_next) { PG8_AOFFS(vAn, nxt); } else {
#pragma unroll
            for (int _h = 0; _h < 2; ++_h)
#pragma unroll
                for (int _i = 0; _i < 2; ++_i) vAn[_h][_i] = vA[_h][_i]; }
#pragma unroll 1
        for (int t = 0; t < nt; t += 2) {
            const bool last = (t == nt - 2);
            const char* a1 = cA + (size_t)(t + 1) * kstep;
            const char* a2 = last ? nA : cA + (size_t)(t + 2) * kstep; const char* b2 = last ? nB : cB + (size_t)(t + 2) * kstep;
            const char* a3 = a2 + kstep; const char* b3 = b2 + kstep;
            const unsigned x00 = last ? vAn[0][0] : vA[0][0], x01 = last ? vAn[0][1] : vA[0][1], x10 = last ? vAn[1][0] : vA[1][0], x11 = last ? vAn[1][1] : vA[1][1];
            PG8_LDB(B0, 0, 0); PG8_LDB(B1, 0, 1); PG8_SCHED; PG8_LDA(At, 0, 0); PG8_STAGE2(PG8_SA(1, 1), a1, vA[1][0], vA[1][1]);
            PG8_WAIT_V(8); PG8_WAIT_L(0); PG8_BAR; PG8_MMA(0, 0, At, B0); PG8_MMA(0, 1, At, B1); PG8_BAR; PG8_SCHED;
            PG8_LDA(At, 0, 1); PG8_STAGE(PG8_SB(0, 0), b2, voffB); PG8_STAGE(PG8_SB(0, 1), b2 + hstep, voffB); PG8_STAGE2(PG8_SA(0, 0), a2, x00, x01);
            PG8_WAIT_V(8); PG8_WAIT_L(0); PG8_BAR; PG8_MMA(1, 0, At, B0); PG8_MMA(1, 1, At, B1); PG8_BAR; PG8_SCHED;
            PG8_LDB(B0, 1, 0); PG8_LDB(B1, 1, 1); PG8_SCHED; PG8_LDA(At, 1, 0); PG8_STAGE2(PG8_SA(0, 1), a2, x10, x11);
            PG8_WAIT_V(8); PG8_WAIT_L(0); PG8_BAR; PG8_MMA(0, 0, At, B0); PG8_MMA(0, 1, At, B1); PG8_BAR; PG8_SCHED;
            PG8_LDA(At, 1, 1); PG8_STAGE(PG8_SB(1, 0), b3, voffB); PG8_STAGE(PG8_SB(1, 1), b3 + hstep, voffB); PG8_STAGE2(PG8_SA(1, 0), a3, x00, x01);
            PG8_WAIT_V(8); PG8_WAIT_L(0); PG8_BAR; PG8_MMA(1, 0, At, B0); PG8_MMA(1, 1, At, B1); PG8_BAR; PG8_SCHED;
        }
        if (wr == 0) PG8_BAR;
        E(acc, cur, wr, wc, fr, fq);
        if (!has_next) break;
#pragma unroll
        for (int a = 0; a < 2; ++a)
#pragma unroll
            for (int b = 0; b < 2; ++b)
#pragma unroll
                for (int m = 0; m < 4; ++m)
#pragma unroll
                    for (int n = 0; n < 2; ++n) acc[a][b][m][n] = (f32x4){0.f, 0.f, 0.f, 0.f};
        cur = nxt; cA = nA; cB = nB; ++ui;
#pragma unroll
        for (int _h = 0; _h < 2; ++_h)
#pragma unroll
            for (int _i = 0; _i < 2; ++_i) vA[_h][_i] = vAn[_h][_i];
        if (wr == 1) PG8_BAR;
    }
    PG8_WAIT_V(0);
    PG8_BAR;
#undef PG8_SA
#undef PG8_SB
#undef PG8_STAGE
#undef PG8_STAGE2
#undef PG8_LDA
#undef PG8_LDB
#undef PG8_MMA
#undef PG8_WAIT_V
#undef PG8_WAIT_L
#undef PG8_BAR
#undef PG8_SCHED
#undef PG8_AOFFS
}
}

struct XOrder { int G, c, MT, NT;
    __device__ __forceinline__ bool map(int i, int& pm, int& pn) const {
        if ((G & 7) == 0 && (MT & 7) == 0) { const int x = c & 7, r = c >> 3, W = G >> 3, MX = MT >> 3; const int L = i * W + r; if (L >= MX * NT) return false; pm = x * MX + L / NT; pn = L % NT; return true; }
        const int L = i * G + c; if (L >= MT * NT) return false; pm = L / NT; pn = L % NT; return true; } };
struct SchedG1 { XOrder X; __device__ __forceinline__ bool next(int i, Unit& u) const { int pm, pn; if (!X.map(i, pm, pn)) return false; u.pm = pm; u.pn = pn; u.e = 0; u.aux = 0; return true; }
    __device__ __forceinline__ int arow(const Unit&, int) const { return 0; } };
struct SchedG2 { XOrder X; __device__ __forceinline__ bool next(int i, Unit& u) const { int pm, q; if (!X.map(i, pm, q)) return false; const int k = q >> 2, pnn = q & 3;
        u.pm = k * (T / 256) + pm; u.pn = k * 4 + pnn; u.e = k; u.aux = pnn; return true; }
    __device__ __forceinline__ int arow(const Unit&, int) const { return 0; } };
struct SchedMN { XOrder X; __device__ __forceinline__ bool next(int i, Unit& u) const { int pm, pn; if (!X.map(i, pm, pn)) return false; u.pm = pm; u.pn = pn; u.e = 0; u.aux = 0; return true; }
    __device__ __forceinline__ int arow(const Unit&, int) const { return 0; } };

struct EpiBf16Plain {
    static constexpr bool PERM = true;
    bf16_t* O; int ldc; int coltile_mask;
    __device__ __forceinline__ void operator()(const f32x4 (&acc)[2][2][4][2], const Unit& u, int wr, int wc, int fr, int fq) const {
        const int row0 = u.pm * 256 + wr * 64 + fr, col0 = (u.pn & coltile_mask) * 256 + wc * 32 + 8 * fq;
#pragma unroll
        for (int ai = 0; ai < 2; ++ai)
#pragma unroll
            for (int m = 0; m < 4; ++m) { bf16_t* rowp = O + (size_t)(row0 + ai * 128 + m * 16) * ldc + col0;
#pragma unroll
                for (int bj = 0; bj < 2; ++bj) { const f32x4 v0 = acc[ai][bj][m][0], v1 = acc[ai][bj][m][1];
                    u32x4 w; w.x = pack2(v0[0], v0[1]); w.y = pack2(v0[2], v0[3]); w.z = pack2(v1[0], v1[1]); w.w = pack2(v1[2], v1[3]);
                    *(u32x4*)(rowp + bj * 128) = w; } }
    }
};
struct EpiP {
    static constexpr bool PERM = true;
    bf16_t* P; const float* ssq;
    __device__ __forceinline__ void operator()(const f32x4 (&acc)[2][2][4][2], const Unit& u, int wr, int wc, int fr, int fq) const {
        const int k = u.e; const int pmt = u.pm - k * (T / 256);
        const unsigned c00 = (unsigned)(u.aux * 256 + wc * 32 + 8 * fq);
        const unsigned base = (unsigned)pmt * (16u * 256u * 256u) + (unsigned)k * 64u;
#pragma unroll
        for (int ai = 0; ai < 2; ++ai)
#pragma unroll
            for (int m = 0; m < 4; ++m) { const int r = ai * 128 + wr * 64 + m * 16 + fr; float sc = 1.0f;
                if (k == 3) { const float* qp = ssq + (size_t)(pmt * 256 + r) * 4; sc = rsqrtf((qp[0] + qp[1] + qp[2] + qp[3]) * (1.0f / 256.0f) + RMS_EPS); }
#pragma unroll
                for (int bj = 0; bj < 2; ++bj) { const unsigned c0 = c00 + bj * 128; const unsigned s = c0 >> 6, wi = c0 & 63;
                    const f32x4 v0 = acc[ai][bj][m][0] * sc, v1 = acc[ai][bj][m][1] * sc;
                    u32x4 w; w.x = pack2(v0[0], v0[1]); w.y = pack2(v0[2], v0[3]); w.z = pack2(v1[0], v1[1]); w.w = pack2(v1[2], v1[3]);
                    *(u32x4*)(P + (base + (s * 256u + (unsigned)r) * 256u + wi)) = w; }
                asm volatile("" ::: "memory"); }
    }
};
struct EpiMerge {
    static constexpr bool PERM = false;
    const bf16_t* P; const float* bgp; bf16_t* Y;
    __device__ __forceinline__ void operator()(const f32x4 (&acc)[2][2][4][2], const Unit& u, int wr, int wc, int fr, int fq) const {
        const int s = u.pn;
        f32x4 bv[2][2];
#pragma unroll
        for (int bj = 0; bj < 2; ++bj)
#pragma unroll
            for (int n = 0; n < 2; ++n) bv[bj][n] = *(const f32x4*)(bgp + s * 256 + bj * 128 + wc * 32 + n * 16 + 4 * fq);
#pragma unroll
        for (int ai = 0; ai < 2; ++ai)
#pragma unroll
            for (int m = 0; m < 4; ++m) { const int r = ai * 128 + wr * 64 + m * 16 + fr;
                const bf16_t* pp = P + (((size_t)u.pm * 16 + s) * 256 + r) * 256 + wc * 16 + 4 * fq;
                f32x4 y = (f32x4){0.f, 0.f, 0.f, 0.f};
#pragma unroll
                for (int bj = 0; bj < 2; ++bj)
#pragma unroll
                    for (int n = 0; n < 2; ++n) { const int k = 2 * bj + n; const u32x2 pw = *(const u32x2*)(pp + k * 64);
                        const f32x4 g = acc[ai][bj][m][n] + bv[bj][n];
                        y[0] += sigmoidf_(g[0]) * __uint_as_float(pw.x << 16); y[1] += sigmoidf_(g[1]) * __uint_as_float(pw.x & 0xffff0000u);
                        y[2] += sigmoidf_(g[2]) * __uint_as_float(pw.y << 16); y[3] += sigmoidf_(g[3]) * __uint_as_float(pw.y & 0xffff0000u); }
                u32x2 w; w.x = pack2(y[0], y[1]); w.y = pack2(y[2], y[3]);
                *(u32x2*)(Y + (size_t)(u.pm * 256 + r) * D + s * 64 + wc * 16 + 4 * fq) = w; }
    }
};
struct EpiWo {
    static constexpr bool PERM = false;
    Ptrs P; int layer;
    __device__ __forceinline__ void operator()(const f32x4 (&acc)[2][2][4][2], const Unit& u, int wr, int wc, int fr, int fq) const {
        const int col0 = u.pn * 256 + wc * 32 + 4 * fq;
#pragma unroll
        for (int ai = 0; ai < 2; ++ai)
#pragma unroll
            for (int m = 0; m < 4; ++m) { const int row = u.pm * 256 + ai * 128 + wr * 64 + m * 16 + fr;
                float* lp = P.latrow(row) + col0; const float* g1 = P.mod(layer, row_modidx(row)) + 2048 + col0;
#pragma unroll
                for (int bj = 0; bj < 2; ++bj)
#pragma unroll
                    for (int n = 0; n < 2; ++n) { const f32x4 x = *(const f32x4*)(lp + bj * 128 + n * 16); const f32x4 g = *(const f32x4*)(g1 + bj * 128 + n * 16);
                        *(f32x4*)(lp + bj * 128 + n * 16) = x * ALPHA + g * acc[ai][bj][m][n]; } }
    }
};
struct EpiFfn1 {
    static constexpr bool PERM = false;
    bf16_t* H;
    __device__ __forceinline__ void operator()(const f32x4 (&acc)[2][2][4][2], const Unit& u, int wr, int wc, int fr, int fq) const {
        const int pnn = u.pn & 3;
#pragma unroll
        for (int ai = 0; ai < 2; ++ai)
#pragma unroll
            for (int m = 0; m < 4; ++m) { const int pos = u.pm * 256 + ai * 128 + wr * 64 + m * 16 + fr;
#pragma unroll
                for (int bj = 0; bj < 2; ++bj) { const f32x4 a = acc[ai][bj][m][0], b = acc[ai][bj][m][1];
                    u32x2 w; w.x = pack2(siluf_(a[0]) * b[0], siluf_(a[1]) * b[1]); w.y = pack2(siluf_(a[2]) * b[2], siluf_(a[3]) * b[3]);
                    *(u32x2*)(H + (size_t)pos * 512 + pnn * 128 + bj * 64 + wc * 16 + 4 * fq) = w; } }
    }
};

template <class SrcFn>
__device__ __forceinline__ void conv_tile(int tid, LAS float* tile  , bf16_t* dst, int ldd, int n0, int k0, const SrcFn& src) {
    f32x4 v[8];
#pragma unroll
    for (int i = 0; i < 8; ++i) { const int kk = (tid >> 4) + 32 * i, j4 = tid & 15; v[i] = *(const f32x4*)src(k0 + kk, n0 + 4 * j4); }
#pragma unroll
    for (int i = 0; i < 8; ++i) { const int kk = (tid >> 4) + 32 * i, j4 = tid & 15; LAS float* t = tile + kk * 65 + 4 * j4; t[0] = v[i][0]; t[1] = v[i][1]; t[2] = v[i][2]; t[3] = v[i][3]; }
    __syncthreads();
    { const int jj = tid >> 3, kq = tid & 7;
#pragma unroll
      for (int kb = 0; kb < 4; ++kb) { float x[8];
#pragma unroll
          for (int i = 0; i < 8; ++i) x[i] = tile[(64 * kb + 8 * kq + i) * 65 + jj];
          u32x4 w; w.x = pack2(x[0], x[1]); w.y = pack2(x[2], x[3]); w.z = pack2(x[4], x[5]); w.w = pack2(x[6], x[7]);
          *(u32x4*)(dst + (size_t)(n0 + jj) * ldd + k0 + 64 * kb + 8 * kq) = w; } }
    __syncthreads();
}
constexpr int NCONV_NE = 56 * 4 + 64 * 4 + 64 * 1 + 16 * 4;
constexpr int NCONV_EX = NE * (16 * 4 + 16 * 2);
__device__ __forceinline__ int gate_srccol(int np) { const int s = np >> 8, bj = (np >> 7) & 1, wc = (np >> 5) & 3, n = (np >> 4) & 1, fqe = np & 15; return (2 * bj + n) * 1024 + 64 * s + 16 * wc + fqe; }
__device__ __forceinline__ void conv_unit_ne(const Ptrs P, int l, int t, LAS float* tile) {
    unsigned char* ws = P.ws;
    if (t < 224) { const int nt = t >> 2, kt = t & 3; const float* src = P.inp(I_WIN) + (size_t)l * D * INC;
        conv_tile(P.tid, tile, (bf16_t*)(ws + WS_WIN), D, nt * 64, kt * 256, [=](int k, int n) { return src + (size_t)k * INC + n; });
    } else if (t < 224 + 256) { t -= 224; const int nt = t >> 2, kt = t & 3; const float* src = P.inp(I_WGATE) + (size_t)l * D * 4096;
        conv_tile(P.tid, tile, (bf16_t*)(ws + WS_WG), D, nt * 64, kt * 256, [=](int k, int n) { return src + (size_t)k * 4096 + gate_srccol(n); });
        if (kt == 0 && P.tid < 64) { const int np = nt * 64 + P.tid; ((float*)(ws + WS_BGP))[np] = P.inp(I_BGATE)[(size_t)l * 4096 + gate_srccol(np)]; }
    } else if (t < 224 + 256 + 64) { t -= 480; const int nt = t; const int kb = nt >> 4;
        const float* src = P.inp(I_WBR) + ((size_t)l * 4 + kb) * 256 * 1024;
        conv_tile(P.tid, tile, (bf16_t*)(ws + WS_WBR), 256, nt * 64, 0, [=](int k, int n) { return src + (size_t)k * 1024 + (n & 1023); });
    } else { t -= 544; const int nt = t >> 2, kt = t & 3; const float* src = P.inp(I_WO) + (size_t)l * D * D;
        conv_tile(P.tid, tile, (bf16_t*)(ws + WS_WO), D, nt * 64, kt * 256, [=](int k, int n) { return src + (size_t)k * D + n; });
    }
}
__device__ __forceinline__ void conv_unit_ex(const Ptrs P, int l, int t, LAS float* tile) {
    unsigned char* ws = P.ws;
    const int e = t / 96; t -= e * 96;
    if (t < 64) { const int nt = t >> 2, kt = t & 3;
        const float* s1 = P.inp(I_WE1) + ((size_t)l * NE + e) * 1024 * 512; const float* s3 = P.inp(I_WE3) + ((size_t)l * NE + e) * 1024 * 512;
        conv_tile(P.tid, tile, (bf16_t*)(ws + WS_BIG + BIG_W13) + (size_t)e * 1024 * 1024, 1024, nt * 64, kt * 256, [=](int k, int n) {
            const int pn = n >> 8, bj = (n >> 7) & 1, wc = (n >> 5) & 3, nn = (n >> 4) & 1, fqe = n & 15; const int ch = 128 * pn + 64 * bj + 16 * wc + fqe;
            return (nn ? s3 : s1) + (size_t)k * 512 + ch; });
    } else { t -= 64; const int nt = t >> 1, kt = t & 1; const float* src = P.inp(I_WE2) + ((size_t)l * NE + e) * 512 * 1024;
        conv_tile(P.tid, tile, (bf16_t*)(ws + WS_BIG + BIG_W2) + (size_t)e * 1024 * 512, 512, nt * 64, kt * 256, [=](int k, int n) { return src + (size_t)k * 1024 + n; });
    }
}

struct RowV { f32x4 v[4]; };
__device__ __forceinline__ void row_load(RowV& r, const float* p, int lane) {
#pragma unroll
    for (int i = 0; i < 4; ++i) r.v[i] = *(const f32x4*)(p + i * 256 + lane * 4);
}
__device__ __forceinline__ void row_store(const RowV& r, float* p, int lane) {
#pragma unroll
    for (int i = 0; i < 4; ++i) *(f32x4*)(p + i * 256 + lane * 4) = r.v[i];
}
__device__ __forceinline__ void row_layernorm(RowV& r, const float* g, const float* b, int lane) {
    float s = 0.f;
#pragma unroll
    for (int i = 0; i < 4; ++i) s += r.v[i][0] + r.v[i][1] + r.v[i][2] + r.v[i][3];
    const float mu = wave_sum(s) * (1.0f / 1024.0f);
    float q = 0.f;
#pragma unroll
    for (int i = 0; i < 4; ++i) { const f32x4 d = r.v[i] - mu; q += d[0] * d[0] + d[1] * d[1] + d[2] * d[2] + d[3] * d[3]; }
    const float rstd = rsqrtf(wave_sum(q) * (1.0f / 1024.0f) + LN_EPS);
#pragma unroll
    for (int i = 0; i < 4; ++i) { const f32x4 gg = *(const f32x4*)(g + i * 256 + lane * 4), bb = *(const f32x4*)(b + i * 256 + lane * 4); r.v[i] = (r.v[i] - mu) * rstd * gg + bb; }
}
__device__ __forceinline__ void row_layernorm_r(RowV& r, const RowV& g, const RowV& b) {
    float s = 0.f;
#pragma unroll
    for (int i = 0; i < 4; ++i) s += r.v[i][0] + r.v[i][1] + r.v[i][2] + r.v[i][3];
    const float mu = wave_sum(s) * (1.0f / 1024.0f);
    float q = 0.f;
#pragma unroll
    for (int i = 0; i < 4; ++i) { const f32x4 d = r.v[i] - mu; q += d[0] * d[0] + d[1] * d[1] + d[2] * d[2] + d[3] * d[3]; }
    const float rstd = rsqrtf(wave_sum(q) * (1.0f / 1024.0f) + LN_EPS);
#pragma unroll
    for (int i = 0; i < 4; ++i) r.v[i] = (r.v[i] - mu) * rstd * g.v[i] + b.v[i];
}
__device__ __forceinline__ void row_modulate(const RowV& r, RowV& h, const float* sh, const float* sc, int lane) {
#pragma unroll
    for (int i = 0; i < 4; ++i) { const f32x4 a = *(const f32x4*)(sc + i * 256 + lane * 4), b = *(const f32x4*)(sh + i * 256 + lane * 4); h.v[i] = r.v[i] * (a + 1.0f) + b; }
}
__device__ __forceinline__ void row_store_bf16(const RowV& h, bf16_t* p, int lane) {
#pragma unroll
    for (int i = 0; i < 4; ++i) { u32x2 w; w.x = pack2(h.v[i][0], h.v[i][1]); w.y = pack2(h.v[i][2], h.v[i][3]); *(u32x2*)(p + i * 256 + lane * 4) = w; }
}
__device__ __forceinline__ void row_dt(const RowV& h, const LAS float* wdt, float* dtout, int lane) {
    float a[8];
#pragma unroll
    for (int j = 0; j < 8; ++j) a[j] = 0.f;
#pragma unroll
    for (int i = 0; i < 4; ++i)
#pragma unroll
        for (int e = 0; e < 4; ++e) { const int k = i * 256 + lane * 4 + e; const float hv = h.v[i][e];
            const f32x4 w0 = *(const LAS f32x4*)(wdt + k * 8), w1 = *(const LAS f32x4*)(wdt + k * 8 + 4);
            a[0] += hv * w0[0]; a[1] += hv * w0[1]; a[2] += hv * w0[2]; a[3] += hv * w0[3]; a[4] += hv * w1[0]; a[5] += hv * w1[1]; a[6] += hv * w1[2]; a[7] += hv * w1[3]; }
#pragma unroll
    for (int j = 0; j < 8; ++j) a[j] = wave_sum(a[j]);
    if (lane == 0) { *(f32x4*)dtout = (f32x4){a[0], a[1], a[2], a[3]}; *(f32x4*)(dtout + 4) = (f32x4){a[4], a[5], a[6], a[7]}; }
}
__device__ __forceinline__ void load_wdt(const Ptrs P, int l, LAS float* wdt) {
    const float* src = P.inp(I_WIN) + (size_t)l * D * INC + UC;
    for (int i = P.tid; i < 1024 * 8; i += 512) wdt[i] = src[(size_t)(i >> 3) * INC + (i & 7)];
    __syncthreads();
}

__device__ __forceinline__ void phase_pa(const Ptrs P, LAS unsigned char* lds) {
    const int tid = P.tid, wid = tid >> 6, lane = tid & 63, G = P.G;
    const int NU_MOD = 2 * 96, NU_H2 = 8448 / 8, NU_LB = 1;
    const int NU = NU_MOD + NU_H2 + NU_LB + NCONV_NE;
    for (int u = P.bid; u < NU; u += G) {
        if (u < NU_MOD) {
            const int l = u / 96, cb = u % 96;
            LAS float* sc = (LAS float*)lds; LAS float* red = sc + 9 * 1024;
            for (int i = tid; i < 9 * 1024; i += 512) { const int r = i >> 10, k = i & 1023; const float v = r < 8 ? P.inp(I_C)[r * 1024 + k] : P.inp(I_CCTX)[k]; sc[i] = v / (1.0f + expf(-v)); }
            __syncthreads();
            const int col = cb * 64 + lane; const float* w = P.inp(I_WADA) + (size_t)l * D * 6144 + col;
            float acc[9];
#pragma unroll
            for (int r = 0; r < 9; ++r) acc[r] = 0.f;
            for (int k = wid * 128; k < wid * 128 + 128; ++k) { const float wv = w[(size_t)k * 6144];
#pragma unroll
                for (int r = 0; r < 9; ++r) acc[r] += sc[r * 1024 + k] * wv; }
#pragma unroll
            for (int r = 0; r < 9; ++r) red[(wid * 9 + r) * 64 + lane] = acc[r];
            __syncthreads();
            for (int i = tid; i < 9 * 64; i += 512) { const int r = i >> 6, c = i & 63; float s = P.inp(I_BADA)[(size_t)l * 6144 + cb * 64 + c];
#pragma unroll
                for (int w8 = 0; w8 < 8; ++w8) s += red[(w8 * 9 + r) * 64 + c];
                P.mod(l, r)[cb * 64 + c] = s; }
            __syncthreads();
        } else if (u < NU_MOD + NU_H2) {
            const int rho = (u - NU_MOD) * 8 + wid;
            const int l = (rho >= 4096 && rho < 8192) ? 1 : 0; const int L = rho < 8192 ? 4096 : 256; const int i = rho < 8192 ? (rho & 4095) : (rho - 8192);
            float featv = 0.f;
            if (lane == 0) featv = (float)((double)i / (double)(L - 1));
            else if (lane < 33) { const int j = (lane - 1) & 15; const double band = 1e-4 + (double)j * ((15.0 - 1e-4) / 15.0);
                const double ang = (2.0 * 3.14159265358979323846 / (double)L) * (double)i * band; featv = lane < 17 ? (float)cos(ang) : (float)(-sin(ang)); }
            float z1 = P.inp(I_HYB1)[l * 64 + lane];
            for (int m = 0; m < 33; ++m) z1 += __shfl(featv, m) * P.inp(I_HYW1)[((size_t)l * 33 + m) * 64 + lane];
            const float h1 = sinf(P.inp(I_HYF1)[l * 64 + lane] * z1);
            float z2 = P.inp(I_HYB2)[l * 64 + lane];
            for (int m = 0; m < 64; ++m) z2 += __shfl(h1, m) * P.inp(I_HYW2)[((size_t)l * 64 + m) * 64 + lane];
            ((float*)(P.ws + WS_H2TAB))[(size_t)rho * 64 + lane] = sinf(P.inp(I_HYF2)[l * 64 + lane] * z2);
        } else if (u < NU_MOD + NU_H2 + NU_LB) {
            for (int i = tid; i < 4096; i += 512) { const double a = -2.0 * 3.14159265358979323846 * (double)i / 8192.0; ((float*)(P.ws + WS_TW))[2 * i] = (float)cos(a); ((float*)(P.ws + WS_TW))[2 * i + 1] = (float)sin(a); }
            for (int i = tid; i < 1024; i += 512) { const int d = i >> 9, l = (i >> 8) & 1, c = i & 255;
                const float l0 = P.inp(I_HGLB)[d * 512 + c], l1 = P.inp(I_HGLB)[d * 512 + 256 + c];
                ((float*)(P.ws + WS_LB))[i] = l == 0 ? 0.0f : 1.0f / (1.0f + expf(l0 - l1)); }
        } else {
            conv_unit_ne(P, 0, u - (NU_MOD + NU_H2 + NU_LB), (LAS float*)lds);
        }
    }
}

__device__ __forceinline__ void emit_rows_init(const Ptrs P, LAS float* wdt);
__device__ __forceinline__ void phase_pb(const Ptrs P, LAS unsigned char* lds) {
    const int tid = P.tid, G = P.G;
    for (int u = P.bid; u < 132; u += G) {
        const int tab = u < 64 ? 0 : (u < 128 ? 1 : 2); const int ib = tab == 0 ? u : (tab == 1 ? u - 64 : u - 128);
        const int l = tab == 1 ? 1 : 0; const int L = tab == 2 ? 256 : 4096; const int rho0 = (tab == 0 ? 0 : (tab == 1 ? 4096 : 8192)) + ib * 64;
        LAS float* h2 = (LAS float*)lds;
        for (int i = tid; i < 64 * 64; i += 512) h2[i] = ((const float*)(P.ws + WS_H2TAB))[(size_t)rho0 * 64 + i];
        __syncthreads();
        const int o = tid, c = tid & 255, dir = tid >> 8;
        float w3[64];
#pragma unroll
        for (int j = 0; j < 64; ++j) w3[j] = P.inp(I_HYW3)[((size_t)l * 64 + j) * 512 + o];
        const float dec = fabsf(P.inp(I_HYDEC)[l * 256 + c]);
        float* filt = tab == 2 ? (float*)(P.ws + WS_FILTC) : (float*)(P.ws + WS_FILT) + (size_t)l * 8192 * 256;
        const int L2 = 2 * L; float part = 0.f;
        for (int r = 0; r < 64; ++r) { const int i = ib * 64 + r; float s = 0.f;
#pragma unroll
            for (int j = 0; j < 64; ++j) s += h2[r * 64 + j] * w3[j];
            const float t = (float)i / (float)(L - 1); s *= expf(-t * dec);
            if (dir == 0) { filt[(size_t)i * 256 + c] = s; part += fabsf(s); }
            else if (i == 0) filt[(size_t)L * 256 + c] = 0.f;
            else { filt[(size_t)(L2 - i) * 256 + c] = s; part += fabsf(s); } }
        ((float*)(P.ws + WS_PART))[((size_t)tab * 64 + ib) * 512 + o] = part;
        __syncthreads();
    }
    emit_rows_init(P, (LAS float*)lds);
}
__device__ __forceinline__ float hy_norm(const Ptrs P, int tab, int c) {
    const float* part = (const float*)(P.ws + WS_PART) + (size_t)tab * 64 * 512; const int nb = tab == 2 ? 4 : 64; float s = 0.f;
    for (int b = 0; b < nb; ++b) s += part[b * 512 + c] + part[b * 512 + 256 + c];
    return s;
}

__device__ __forceinline__ void emit_rows_init(const Ptrs P, LAS float* wdt) {
    const int tid = P.tid, wid = tid >> 6, lane = tid & 63, G = P.G;
    load_wdt(P, 0, wdt);
    LAS float* tabA = wdt + 1024 * 8; LAS float* tabB = tabA + 8 * 256 * 2;
    for (int i = tid; i < 2 * 8 * 256; i += 512) { const int tb = i >> 11, a = (i >> 8) & 7, ii = i & 255; const float om = expf(-9.210340371976184f * (float)ii * (1.0f / 256.0f)); const float ang = (float)(tb ? a : 8 * a) * om;
        LAS float* t = (tb ? tabB : tabA) + (a * 256 + ii) * 2; t[0] = sinf(ang); t[1] = cosf(ang); }
    __syncthreads();
    const float* xin = P.inp(I_X); const float* cin = P.inp(I_CTX);
    RowV rn; if (P.bid < T / 8) { const int rw = P.bid * 8 + wid; row_load(rn, rw < NLAT ? xin + (size_t)rw * D : cin + (size_t)(rw - NLAT) * D, lane); }
    for (int u = P.bid; u < T / 8; u += G) {
        const int row = u * 8 + wid; RowV r = rn;
        if (u + G < T / 8) { const int rw = (u + G) * 8 + wid; row_load(rn, rw < NLAT ? xin + (size_t)rw * D : cin + (size_t)(rw - NLAT) * D, lane); }
        if (row < NLAT) {
            const int t = row & 4095; const int prow = t >> 6, pcol = t & 63;
#pragma unroll
            for (int hf = 0; hf < 2; ++hf) { const int pos = hf ? pcol : prow; const LAS float* pa = tabA + ((pos >> 3) * 256 + lane * 4) * 2; const LAS float* pb = tabB + ((pos & 7) * 256 + lane * 4) * 2;
                const f32x4 a0 = *(const LAS f32x4*)pa, a1 = *(const LAS f32x4*)(pa + 4), b0 = *(const LAS f32x4*)pb, b1 = *(const LAS f32x4*)(pb + 4);
                f32x4 sn, cs;
                sn[0] = a0[0] * b0[1] + a0[1] * b0[0]; cs[0] = a0[1] * b0[1] - a0[0] * b0[0]; sn[1] = a0[2] * b0[3] + a0[3] * b0[2]; cs[1] = a0[3] * b0[3] - a0[2] * b0[2];
                sn[2] = a1[0] * b1[1] + a1[1] * b1[0]; cs[2] = a1[1] * b1[1] - a1[0] * b1[0]; sn[3] = a1[2] * b1[3] + a1[3] * b1[2]; cs[3] = a1[3] * b1[3] - a1[2] * b1[2];
                r.v[2 * hf] += sn; r.v[2 * hf + 1] += cs; }
        }
        row_store(r, P.latrow(row), lane);
        const float* m = P.mod(0, row_modidx(row)); RowV h; row_modulate(r, h, m, m + 1024, lane);
        row_store_bf16(h, (bf16_t*)(P.ws + WS_HBUF) + (size_t)row * D, lane);
        row_dt(h, wdt, (float*)(P.ws + WS_DT) + (size_t)row * 8, lane);
    }
}

__device__ __forceinline__ void phase_g1(const Ptrs P, LAS unsigned char* lds) {
    pg8::Gemm g{(const bf16_t*)(P.ws + WS_HBUF), (const bf16_t*)(P.ws + WS_WIN), D};
    EpiBf16Plain E{(bf16_t*)(P.ws + WS_BIG + BIG_U), UC, 0xffff};
    SchedG1 S{XOrder{P.G, P.bid, T / 256, 14}};
    pg8::gemm_phase<EpiBf16Plain, SchedG1, false>(P.tid, lds, g, S, E);
}

constexpr int NCHK = 34;
__device__ __forceinline__ int chunk_row0(int b, int pc) { return pc < 2 ? NLAT + b * CTXL + pc * 128 : b * SEQ + (pc - 2) * 128; }
__device__ __forceinline__ int chunk_at(int dir, int q) { return dir == 0 ? q : (q < 2 ? 1 - q : 35 - q); }
__device__ __forceinline__ int sidx(int kind, int b, int h, int dir, int pc) { return (((kind * 8 + b) * 4 + h) * 2 + dir) * NCHK + pc; }
__device__ __forceinline__ bf16x8 pack8(const float (&v)[8]) { u32x4 w; w.x = pack2(v[0], v[1]); w.y = pack2(v[2], v[3]); w.z = pack2(v[4], v[5]); w.w = pack2(v[6], v[7]); return __builtin_bit_cast(bf16x8, w); }
__device__ __forceinline__ float zero_f() { float z = 0.f; asm volatile("" : "+v"(z)); return z; }
__device__ __forceinline__ float softplusf_(float x) { return x > 20.f ? x : log1pf(__expf(x)); }
__device__ __forceinline__ float wave_incl_scan(float v, int lane) {
#pragma unroll
    for (int d = 1; d < 64; d <<= 1) { const float t = __shfl_up(v, d); if (lane >= d) v += t; }
    return v;
}

__device__ __forceinline__ void conv3_silu8(const bf16_t* U, int row, int col0, const float* w, int ncol, int wcol0, const float* bias, float (&out)[8]) {
    const bool hp = row_has_prev(row), hn = row_has_next(row);
    const bf16x8 c = *(const bf16x8*)(U + (size_t)row * UC + col0);
    const bf16x8 p = *(const bf16x8*)(U + (size_t)(hp ? row - 1 : row) * UC + col0), n = *(const bf16x8*)(U + (size_t)(hn ? row + 1 : row) * UC + col0);
    const float mp = hp ? 1.0f : 0.0f, mn = hn ? 1.0f : 0.0f;
#pragma unroll
    for (int h4 = 0; h4 < 2; ++h4) { const f32x4 w0 = *(const f32x4*)(w + wcol0 + 4 * h4), w1 = *(const f32x4*)(w + ncol + wcol0 + 4 * h4), w2 = *(const f32x4*)(w + 2 * ncol + wcol0 + 4 * h4), bb = *(const f32x4*)(bias + wcol0 + 4 * h4);
#pragma unroll
        for (int e = 0; e < 4; ++e) { const int i = 4 * h4 + e; const float v = bf2f((bf16_t)c[i]) * w1[e] + mp * bf2f((bf16_t)p[i]) * w0[e] + mn * bf2f((bf16_t)n[i]) * w2[e] + bb[e]; out[i] = siluf_(v); } }
}

__device__ __forceinline__ void conv16_silu(const bf16_t* U, int r0, int col, const float* w, int ncol, int wcol, float bias, float (&out)[16]) {
    const bool hp = row_has_prev(r0), hn = row_has_next(r0 + 15);
    float x[18];
#pragma unroll
    for (int i = 0; i < 18; ++i) { const int r = (i == 0 && !hp) ? r0 : ((i == 17 && !hn) ? r0 + 15 : r0 - 1 + i); x[i] = bf2f(U[(size_t)r * UC + col]); }
    if (!hp) x[0] = 0.f; if (!hn) x[17] = 0.f;
    const float w0 = w[wcol], w1 = w[ncol + wcol], w2 = w[2 * ncol + wcol];
#pragma unroll
    for (int j = 0; j < 16; ++j) out[j] = siluf_(x[j] * w0 + x[j + 1] * w1 + x[j + 2] * w2 + bias);
}
__device__ __forceinline__ void store16_bf16(LAS bf16_t* dst, const float (&v)[16]) {
    u32x4 a, b; a.x = pack2(v[0], v[1]); a.y = pack2(v[2], v[3]); a.z = pack2(v[4], v[5]); a.w = pack2(v[6], v[7]); b.x = pack2(v[8], v[9]); b.y = pack2(v[10], v[11]); b.z = pack2(v[12], v[13]); b.w = pack2(v[14], v[15]);
    *(LAS u32x4*)dst = a; *(LAS u32x4*)(dst + 8) = b;
}

__device__ __forceinline__ void hgrn_pass1(const Ptrs P, int l, int unit, LAS unsigned char* lds) {
    const int tid = P.tid, lane = tid & 63, wid = tid >> 6, fr = lane & 15, fq = lane >> 4;
    const int pc = unit % NCHK; const int r_ = unit / NCHK; const int h = r_ & 3; const int b = r_ >> 2;
    const int row0 = chunk_row0(b, pc);
    const bf16_t* U = (const bf16_t*)(P.ws + WS_BIG + BIG_U);
    LAS bf16_t* KTF = (LAS bf16_t*)lds; LAS bf16_t* KTB = KTF + 64 * 136; LAS bf16_t* VT = KTB + 64 * 136; LAS float* segtot = (LAS float*)(VT + 64 * 136);
    const int ch = lane, seg = wid;
    const float lbf = ((const float*)(P.ws + WS_LB))[(0 * 2 + l) * 256 + h * 64 + ch], lbb = ((const float*)(P.ws + WS_LB))[(1 * 2 + l) * 256 + h * 64 + ch];
    float cf[16], cb[16], kf[16], kb[16], vv[16]; float runf = 0.f, runb = 0.f;
#pragma unroll
    for (int j = 0; j < 16; ++j) { const bf16_t* ur = U + (size_t)(row0 + 16 * seg + j) * UC;
        const float ff = lbf + (1.0f - lbf) * sigmoidf_(bf2f(ur[1792 + h * 64 + ch])), fb = lbb + (1.0f - lbb) * sigmoidf_(bf2f(ur[2048 + h * 64 + ch]));
        runf += __logf(ff); cf[j] = runf; kf[j] = 1.0f - ff; cb[j] = runb; runb += __logf(fb); kb[j] = 1.0f - fb; vv[j] = bf2f(ur[2304 + h * 64 + ch]); }
    segtot[seg * 64 + ch] = runf; segtot[512 + seg * 64 + ch] = runb; __syncthreads();
    float offf = 0.f, totf = 0.f, offb = 0.f, totb = 0.f;
#pragma unroll
    for (int s = 0; s < 8; ++s) { const float a = segtot[s * 64 + ch], c = segtot[512 + s * 64 + ch]; totf += a; totb += c; offf += (s < seg) ? a : 0.f; offb += (s < seg) ? c : 0.f; }
    { float t[16];
#pragma unroll
      for (int j = 0; j < 16; ++j) t[j] = kf[j] * __expf(totf - offf - cf[j]);
      store16_bf16(KTF + ch * 136 + 16 * seg, t);
#pragma unroll
      for (int j = 0; j < 16; ++j) t[j] = kb[j] * __expf(offb + cb[j]);
      store16_bf16(KTB + ch * 136 + 16 * seg, t);
      store16_bf16(VT + ch * 136 + 16 * seg, vv); }
    const int sif = sidx(0, b, h, 0, pc), sib = sidx(0, b, h, 1, pc);
    if (seg == 0) { ((float*)(P.ws + WS_DEC))[(size_t)sif * 64 + ch] = __expf(totf); ((float*)(P.ws + WS_DEC))[(size_t)sib * 64 + ch] = __expf(totb); }
    __syncthreads();
    const int mt = wid >> 1, nt0 = (wid & 1) * 2;
    f32x4 af[2], ab[2]; af[0] = (f32x4){0.f, 0.f, 0.f, 0.f}; af[1] = af[0]; ab[0] = af[0]; ab[1] = af[0];
#pragma unroll
    for (int ks = 0; ks < 4; ++ks) { const bf16x8 a0 = *(const LAS bf16x8*)(KTF + (16 * mt + fr) * 136 + 32 * ks + 8 * fq), a1 = *(const LAS bf16x8*)(KTB + (16 * mt + fr) * 136 + 32 * ks + 8 * fq);
#pragma unroll
        for (int n = 0; n < 2; ++n) { const bf16x8 bb = *(const LAS bf16x8*)(VT + (16 * (nt0 + n) + fr) * 136 + 32 * ks + 8 * fq);
            af[n] = __builtin_amdgcn_mfma_f32_16x16x32_bf16(a0, bb, af[n], 0, 0, 0); ab[n] = __builtin_amdgcn_mfma_f32_16x16x32_bf16(a1, bb, ab[n], 0, 0, 0); } }
    float* SF = (float*)(P.ws + WS_BIG + BIG_STATE) + (size_t)sif * 4096; float* SB = (float*)(P.ws + WS_BIG + BIG_STATE) + (size_t)sib * 4096;
#pragma unroll
    for (int n = 0; n < 2; ++n)
#pragma unroll
        for (int r = 0; r < 4; ++r) { const int o = (16 * mt + 4 * fq + r) * 64 + 16 * (nt0 + n) + fr; SF[o] = af[n][r]; SB[o] = ab[n][r]; }
    __syncthreads();
}

__device__ __forceinline__ void ssd_pass1(const Ptrs P, int l, int unit, LAS unsigned char* lds) {
    const int tid = P.tid, lane = tid & 63, wid = tid >> 6, fr = lane & 15, fq = lane >> 4;
    const int pc = unit % NCHK; const int r_ = unit / NCHK; const int g = r_ & 1; const int b = r_ >> 1;
    const int row0 = chunk_row0(b, pc);
    const bf16_t* U = (const bf16_t*)(P.ws + WS_BIG + BIG_U);
    const float* scw = P.inp(I_SSDCW) + (size_t)l * 3 * 512; const float* scb = P.inp(I_SSDCB) + l * 512;
    LAS bf16_t* BT = (LAS bf16_t*)lds; LAS bf16_t* XT = BT + 64 * 136;
    LAS float* wgt = (LAS float*)(XT + 4 * 64 * 136);
    if (wid < 4) {
        const int hh = 2 * g + (wid >> 1), dir = wid & 1;
        const float Aneg = -__expf(P.inp(I_SSDALOG)[(l * 2 + dir) * 4 + hh]); const float dtb = P.inp(I_SSDDTB)[(l * 2 + dir) * 4 + hh]; const float* DT = (const float*)(P.ws + WS_DT);
        const int p0 = 2 * lane; const float d0 = softplusf_(DT[(size_t)(row0 + p0) * 8 + dir * 4 + hh] + dtb), d1 = softplusf_(DT[(size_t)(row0 + p0 + 1) * 8 + dir * 4 + hh] + dtb);
        const float a0 = Aneg * d0, a1 = Aneg * d1; const float inc = wave_incl_scan(a0 + a1, lane); const float tot = __uint_as_float(__builtin_amdgcn_readlane(__float_as_uint(inc), 63));
        if (dir == 0) { wgt[wid * 128 + p0] = d0 * __expf(tot - (inc - a1)); wgt[wid * 128 + p0 + 1] = d1 * __expf(tot - inc); }
        else { wgt[wid * 128 + p0] = d0 * __expf(inc - a1 - a0); wgt[wid * 128 + p0 + 1] = d1 * __expf(inc - a1); }
        if (lane == 0) ((float*)(P.ws + WS_DEC))[(size_t)sidx(1, b, hh, dir, pc) * 64] = __expf(tot);
    }
    __syncthreads();
    { const int ch = lane, seg = wid; const int r0 = row0 + 16 * seg; float t[16], x[16];
      conv16_silu(U, r0, 3072 + 256 + g * 64 + ch, scw, 512, 256 + g * 64 + ch, scb[256 + g * 64 + ch], t); store16_bf16(BT + ch * 136 + 16 * seg, t);
#pragma unroll
      for (int hq = 0; hq < 2; ++hq) { const int c = (2 * g + hq) * 64 + ch; conv16_silu(U, r0, 3072 + c, scw, 512, c, scb[c], x);
#pragma unroll
          for (int dir = 0; dir < 2; ++dir) { const int cmb = 2 * hq + dir;
#pragma unroll
              for (int j4 = 0; j4 < 4; ++j4) { const f32x4 wv = *(const LAS f32x4*)(wgt + cmb * 128 + 16 * seg + 4 * j4); t[4 * j4] = x[4 * j4] * wv[0]; t[4 * j4 + 1] = x[4 * j4 + 1] * wv[1]; t[4 * j4 + 2] = x[4 * j4 + 2] * wv[2]; t[4 * j4 + 3] = x[4 * j4 + 3] * wv[3]; }
              store16_bf16(XT + (cmb * 64 + ch) * 136 + 16 * seg, t); } } }
    __syncthreads();
    {
        const int cmb = wid >> 1; const int hh = 2 * g + (cmb >> 1), dir = cmb & 1;
        float* S = (float*)(P.ws + WS_BIG + BIG_STATE) + (size_t)sidx(1, b, hh, dir, pc) * 4096;
#pragma unroll
        for (int mi = 0; mi < 2; ++mi) { const int mt = 2 * (wid & 1) + mi; f32x4 acc[4];
#pragma unroll
            for (int n = 0; n < 4; ++n) acc[n] = (f32x4){0.f, 0.f, 0.f, 0.f};
#pragma unroll
            for (int ks = 0; ks < 4; ++ks) { const bf16x8 a = *(const LAS bf16x8*)(XT + (cmb * 64 + 16 * mt + fr) * 136 + 32 * ks + 8 * fq);
#pragma unroll
                for (int n = 0; n < 4; ++n) { const bf16x8 bb = *(const LAS bf16x8*)(BT + (16 * n + fr) * 136 + 32 * ks + 8 * fq); acc[n] = __builtin_amdgcn_mfma_f32_16x16x32_bf16(a, bb, acc[n], 0, 0, 0); } }
#pragma unroll
            for (int n = 0; n < 4; ++n)
#pragma unroll
                for (int r = 0; r < 4; ++r) S[(16 * mt + 4 * fq + r) * 64 + 16 * n + fr] = acc[n][r]; }
    }
    __syncthreads();
}

__device__ __forceinline__ void ssd_dt_cum(const Ptrs P, int l, int row0, int dir, int h, int wid, int lane, LAS float* cum, LAS float* dtv) {
    if (wid == 0) {
        const float Aneg = -__expf(P.inp(I_SSDALOG)[(l * 2 + dir) * 4 + h]); const float dtb = P.inp(I_SSDDTB)[(l * 2 + dir) * 4 + h]; const float* DT = (const float*)(P.ws + WS_DT);
        const int t0 = 2 * lane, p0 = dir ? 127 - t0 : t0, p1 = dir ? 126 - t0 : t0 + 1;
        const float d0 = softplusf_(DT[(size_t)(row0 + p0) * 8 + dir * 4 + h] + dtb), d1 = softplusf_(DT[(size_t)(row0 + p1) * 8 + dir * 4 + h] + dtb);
        const float a0 = Aneg * d0, a1 = Aneg * d1; const float inc = wave_incl_scan(a0 + a1, lane);
        cum[t0] = inc - a1; cum[t0 + 1] = inc; dtv[t0] = d0; dtv[t0 + 1] = d1;
    }
}

__device__ __forceinline__ void scan_pass2(const Ptrs P, int unit) {
    const int seq = unit >> 1, half = unit & 1; const int kind = seq >> 6, b = (seq >> 3) & 7, h = (seq >> 1) & 3, dir = seq & 1;
    const int e0 = half * 2048 + P.tid * 4; const int base = sidx(kind, b, h, dir, 0);
    float* ST = (float*)(P.ws + WS_BIG + BIG_STATE); const float* DEC = (const float*)(P.ws + WS_DEC);
    const float zf = zero_f(); f32x4 run = (f32x4){zf, zf, zf, zf};
#pragma unroll 1
    for (int q0 = 0; q0 < NCHK; q0 += 8) {
        f32x4 loc[8]; float dd[8];
#pragma unroll
        for (int k = 0; k < 8; ++k) { const int q = (q0 + k < NCHK) ? q0 + k : NCHK - 1; const int pc = chunk_at(dir, q);
            loc[k] = *(const f32x4*)(ST + (size_t)(base + pc) * 4096 + e0); dd[k] = DEC[(size_t)(base + pc) * 64 + (kind == 0 ? (e0 >> 6) : 0)]; }
#pragma unroll
        for (int k = 0; k < 8; ++k) { if (q0 + k < NCHK) { const int pc = chunk_at(dir, q0 + k); *(f32x4*)(ST + (size_t)(base + pc) * 4096 + e0) = run; run = run * dd[k] + loc[k]; } }
    }
}

__device__ __forceinline__ int qk_off(int p, int chunk) { return p * 64 + ((chunk ^ (p & 7)) << 3); }
__device__ __forceinline__ void hgrn_pass3(const Ptrs P, int l, int unit, LAS unsigned char* lds) {
    const int tid = P.tid, lane = tid & 63, wid = tid >> 6, fr = lane & 15, fq = lane >> 4;
    const int pc = unit % NCHK; const int r_ = unit / NCHK; const int h = r_ & 3; const int b = r_ >> 2;
    const int row0 = chunk_row0(b, pc);
    const bf16_t* U = (const bf16_t*)(P.ws + WS_BIG + BIG_U);
    LAS bf16_t* QF = (LAS bf16_t*)lds; LAS bf16_t* KF = QF + 128 * 64; LAS bf16_t* QB = KF + 128 * 64; LAS bf16_t* KB = QB + 128 * 64; LAS bf16_t* VT = KB + 128 * 64;
    LAS bf16_t* STF = VT + 64 * 136; LAS bf16_t* STB = STF + 64 * 72; LAS float* ETF = (LAS float*)(STB + 64 * 72); LAS float* ETB = ETF + 512; LAS bf16_t* PW = (LAS bf16_t*)(ETB + 512);
    LAS float* OUT = (LAS float*)lds;
    {
        const int ch = lane, seg = wid; const float lbf = ((const float*)(P.ws + WS_LB))[(0 * 2 + l) * 256 + h * 64 + ch], lbb = ((const float*)(P.ws + WS_LB))[(1 * 2 + l) * 256 + h * 64 + ch];
        float bfw[16], bbw[16], kf[16], kb[16], qv[16], vv[16];
#pragma unroll
        for (int j = 0; j < 16; ++j) { const bf16_t* ur = U + (size_t)(row0 + 16 * seg + j) * UC + h * 64 + ch;
            const float ff = lbf + (1.0f - lbf) * sigmoidf_(bf2f(ur[1792])), fb = lbb + (1.0f - lbb) * sigmoidf_(bf2f(ur[2048]));
            bfw[j] = __logf(ff); bbw[j] = __logf(fb); kf[j] = 1.0f - ff; kb[j] = 1.0f - fb; qv[j] = bf2f(ur[1536]) * 0.125f; vv[j] = bf2f(ur[2304]); }
#pragma unroll
        for (int j = 1; j < 16; ++j) bfw[j] += bfw[j - 1];
#pragma unroll
        for (int j = 14; j >= 0; --j) bbw[j] += bbw[j + 1];
        const float etf = bfw[15], etb = bbw[0];
        ETF[seg * 64 + ch] = etf; ETB[seg * 64 + ch] = etb;
        store16_bf16(VT + ch * 136 + 16 * seg, vv);
        const int chunk = ch >> 3, sub = ch & 7;
#pragma unroll
        for (int j = 0; j < 16; ++j) { const int p = 16 * seg + j; const int o = qk_off(p, chunk) + sub;
            const unsigned wq = pack2(qv[j] * __expf(bfw[j]), qv[j] * __expf(bbw[j])), wk = pack2(kf[j] * __expf(etf - bfw[j]), kb[j] * __expf(etb - bbw[j]));
            QF[o] = (bf16_t)(wq & 0xffffu); QB[o] = (bf16_t)(wq >> 16); KF[o] = (bf16_t)(wk & 0xffffu); KB[o] = (bf16_t)(wk >> 16); }
        const float* SF = (const float*)(P.ws + WS_BIG + BIG_STATE) + (size_t)sidx(0, b, h, 0, pc) * 4096; const float* SB = (const float*)(P.ws + WS_BIG + BIG_STATE) + (size_t)sidx(0, b, h, 1, pc) * 4096;
#pragma unroll 2
        for (int idx = tid; idx < 4096; idx += 512) { STF[(idx & 63) * 72 + (idx >> 6)] = f2bf(SF[idx]); STB[(idx & 63) * 72 + (idx >> 6)] = f2bf(SB[idx]); }
    }
    __syncthreads();
    f32x4 o[4];
    {
        const int i = wid; LAS bf16_t* pw = PW + wid * 16 * 136;
#pragma unroll
        for (int nt = 0; nt < 4; ++nt) o[nt] = (f32x4){0.f, 0.f, 0.f, 0.f};
#pragma unroll 1
        for (int dir = 0; dir < 2; ++dir) {
            const LAS bf16_t* QA = dir ? QB : QF; const LAS bf16_t* KA = dir ? KB : KF; const LAS float* ET = dir ? ETB : ETF; const LAS bf16_t* ST = dir ? STB : STF;
            bf16x8 qf[2]; float g[2][8];
#pragma unroll
            for (int ks = 0; ks < 2; ++ks) { qf[ks] = *(const LAS bf16x8*)(QA + qk_off(16 * i + fr, 4 * ks + fq));
                const f32x4 e0 = *(const LAS f32x4*)(ET + i * 64 + 32 * ks + 8 * fq), e1 = *(const LAS f32x4*)(ET + i * 64 + 32 * ks + 8 * fq + 4);
                g[ks][0] = -e0[0]; g[ks][1] = -e0[1]; g[ks][2] = -e0[2]; g[ks][3] = -e0[3]; g[ks][4] = -e1[0]; g[ks][5] = -e1[1]; g[ks][6] = -e1[2]; g[ks][7] = -e1[3]; }
            const int nj = dir ? 8 - i : i + 1;
            for (int jj = 0; jj < nj; ++jj) { const int j = dir ? i + jj : i - jj;
                f32x4 d = (f32x4){0.f, 0.f, 0.f, 0.f};
#pragma unroll
                for (int ks = 0; ks < 2; ++ks) { float a8[8];
#pragma unroll
                    for (int e = 0; e < 8; ++e) a8[e] = bf2f((bf16_t)qf[ks][e]) * __expf(g[ks][e]);
                    const bf16x8 kfr = *(const LAS bf16x8*)(KA + qk_off(16 * j + fr, 4 * ks + fq));
                    d = __builtin_amdgcn_mfma_f32_16x16x32_bf16(kfr, pack8(a8), d, 0, 0, 0);
                    const f32x4 e0 = *(const LAS f32x4*)(ET + j * 64 + 32 * ks + 8 * fq), e1 = *(const LAS f32x4*)(ET + j * 64 + 32 * ks + 8 * fq + 4);
                    g[ks][0] += e0[0]; g[ks][1] += e0[1]; g[ks][2] += e0[2]; g[ks][3] += e0[3]; g[ks][4] += e1[0]; g[ks][5] += e1[1]; g[ks][6] += e1[2]; g[ks][7] += e1[3]; }
                if (jj == 0) {
#pragma unroll
                    for (int r = 0; r < 4; ++r) d[r] = (dir ? (4 * fq + r >= fr) : (4 * fq + r <= fr)) ? d[r] : 0.f; }
                u32x2 w; w.x = pack2(d[0], d[1]); w.y = pack2(d[2], d[3]); *(LAS u32x2*)(pw + fr * 136 + 16 * j + 4 * fq) = w;
            }
            { const int zb = dir ? i - 1 : i + 1; const bool need = dir ? ((i & 1) == 1) : ((i & 1) == 0);
              if (need) { u32x2 z; z.x = __float_as_uint(zero_f()); z.y = z.x; *(LAS u32x2*)(pw + fr * 136 + 16 * zb + 4 * fq) = z; } }
            const int kslo = dir ? (i >> 1) : 0, kshi = dir ? 3 : (i >> 1);
            for (int ks = kslo; ks <= kshi; ++ks) { const bf16x8 pa = *(const LAS bf16x8*)(pw + fr * 136 + 32 * ks + 8 * fq);
#pragma unroll
                for (int nt = 0; nt < 4; ++nt) { const bf16x8 vf = *(const LAS bf16x8*)(VT + (16 * nt + fr) * 136 + 32 * ks + 8 * fq); o[nt] = __builtin_amdgcn_mfma_f32_16x16x32_bf16(pa, vf, o[nt], 0, 0, 0); } }
#pragma unroll
            for (int ks = 0; ks < 2; ++ks) { float a8[8];
#pragma unroll
                for (int e = 0; e < 8; ++e) a8[e] = bf2f((bf16_t)qf[ks][e]) * __expf(g[ks][e]);
                const bf16x8 qa = pack8(a8);
#pragma unroll
                for (int nt = 0; nt < 4; ++nt) { const bf16x8 sf = *(const LAS bf16x8*)(ST + (16 * nt + fr) * 72 + 32 * ks + 8 * fq); o[nt] = __builtin_amdgcn_mfma_f32_16x16x32_bf16(qa, sf, o[nt], 0, 0, 0); } }
        }
    }
    __syncthreads();
#pragma unroll
    for (int nt = 0; nt < 4; ++nt)
#pragma unroll
        for (int r = 0; r < 4; ++r) OUT[(16 * wid + 4 * fq + r) * 64 + 16 * nt + fr] = o[nt][r];
    __syncthreads();
    {
        const int pos = tid >> 2, qd = tid & 3; const int row = row0 + pos; bf16_t* BR2 = (bf16_t*)(P.ws + WS_BR) + (size_t)2 * T * 256;
        const bf16_t* gp = U + (size_t)row * UC + 2560 + h * 64 + 16 * qd; const bf16x8 g0 = *(const bf16x8*)gp, g1 = *(const bf16x8*)(gp + 8);
        const float* ngp = P.inp(I_HGNG) + l * 64 + 16 * qd; float ov[16], q = 0.f;
#pragma unroll
        for (int e4 = 0; e4 < 4; ++e4) { const f32x4 v = *(const LAS f32x4*)(OUT + pos * 64 + 16 * qd + 4 * e4); ov[4 * e4] = v[0]; ov[4 * e4 + 1] = v[1]; ov[4 * e4 + 2] = v[2]; ov[4 * e4 + 3] = v[3]; q += v[0] * v[0] + v[1] * v[1] + v[2] * v[2] + v[3] * v[3]; }
        q += __shfl_xor(q, 1); q += __shfl_xor(q, 2);
        const float rs = rsqrtf(q * (1.0f / 64.0f) + RMS_EPS); float t8[8];
#pragma unroll
        for (int e = 0; e < 8; ++e) t8[e] = ov[e] * rs * ngp[e] * siluf_(bf2f((bf16_t)g0[e]));
        *(bf16x8*)(BR2 + (size_t)row * 256 + h * 64 + 16 * qd) = pack8(t8);
#pragma unroll
        for (int e = 0; e < 8; ++e) t8[e] = ov[8 + e] * rs * ngp[8 + e] * siluf_(bf2f((bf16_t)g1[e]));
        *(bf16x8*)(BR2 + (size_t)row * 256 + h * 64 + 16 * qd + 8) = pack8(t8);
    }
    __syncthreads();
}

__device__ __forceinline__ void ssd_pass3(const Ptrs P, int l, int unit, LAS unsigned char* lds) {
    const int tid = P.tid, lane = tid & 63, wid = tid >> 6, fr = lane & 15, fq = lane >> 4;
    const int pc = unit % NCHK; const int r_ = unit / NCHK; const int g = r_ & 1; const int b = r_ >> 1;
    const int row0 = chunk_row0(b, pc);
    const bf16_t* U = (const bf16_t*)(P.ws + WS_BIG + BIG_U);
    const float* scw = P.inp(I_SSDCW) + (size_t)l * 3 * 512; const float* scb = P.inp(I_SSDCB) + l * 512;
    LAS bf16_t* CM = (LAS bf16_t*)lds; LAS bf16_t* BM = CM + 128 * 72; LAS bf16_t* XT = BM + 128 * 72; LAS bf16_t* STF = XT + 64 * 136; LAS bf16_t* STB = STF + 64 * 72;
    LAS float* cumf = (LAS float*)(STB + 64 * 72); LAS float* cumb = cumf + 128; LAS float* dtf = cumb + 128; LAS float* dtb = dtf + 128;
    LAS bf16_t* PW = (LAS bf16_t*)(dtb + 128); LAS float* OUT = (LAS float*)(PW + 8 * 16 * 136);
    {
        const int pos = tid >> 2, qd = tid & 3; const int row = row0 + pos;
#pragma unroll 1
        for (int pcs = 0; pcs < 4; ++pcs) { const int isb = pcs >> 1, hf = pcs & 1; const int cc = (isb ? 256 : 384) + g * 64 + 16 * qd + 8 * hf; float t8[8];
            conv3_silu8(U, row, 3072 + cc, scw, 512, cc, scb, t8);
            *(LAS bf16x8*)((isb ? BM : CM) + pos * 72 + 16 * qd + 8 * hf) = pack8(t8); }
    }
#pragma unroll 1
    for (int hq = 0; hq < 2; ++hq) {
        const int h = 2 * g + hq;
        {
            const int ch = lane, seg = wid; float x[16]; conv16_silu(U, row0 + 16 * seg, 3072 + h * 64 + ch, scw, 512, h * 64 + ch, scb[h * 64 + ch], x); store16_bf16(XT + ch * 136 + 16 * seg, x);
        }
        __builtin_amdgcn_sched_barrier(0);
        if (wid < 2) {
            const int dir = wid; const float Aneg = -__expf(P.inp(I_SSDALOG)[(l * 2 + dir) * 4 + h]); const float dtbias = P.inp(I_SSDDTB)[(l * 2 + dir) * 4 + h]; const float* DT = (const float*)(P.ws + WS_DT);
            const int p0 = 2 * lane; const float d0 = softplusf_(DT[(size_t)(row0 + p0) * 8 + dir * 4 + h] + dtbias), d1 = softplusf_(DT[(size_t)(row0 + p0 + 1) * 8 + dir * 4 + h] + dtbias);
            const float a0 = Aneg * d0, a1 = Aneg * d1; const float inc = wave_incl_scan(a0 + a1, lane);
            if (dir == 0) { cumf[p0] = inc - a1; cumf[p0 + 1] = inc; dtf[p0] = d0; dtf[p0 + 1] = d1; }
            else { const float tot = __uint_as_float(__builtin_amdgcn_readlane(__float_as_uint(inc), 63)); cumb[p0] = tot - inc + a0 + a1; cumb[p0 + 1] = tot - inc + a1; dtb[p0] = d0; dtb[p0 + 1] = d1; }
        }
        {
            const float* SF = (const float*)(P.ws + WS_BIG + BIG_STATE) + (size_t)sidx(1, b, h, 0, pc) * 4096; const float* SB = (const float*)(P.ws + WS_BIG + BIG_STATE) + (size_t)sidx(1, b, h, 1, pc) * 4096;
#pragma unroll 2
            for (int idx = tid; idx < 4096; idx += 512) { STF[(idx >> 6) * 72 + (idx & 63)] = f2bf(SF[idx]); STB[(idx >> 6) * 72 + (idx & 63)] = f2bf(SB[idx]); }
        }
        __syncthreads();
        {
            const int i = wid; LAS bf16_t* pw = PW + wid * 16 * 136;
            bf16x8 cf[2];
#pragma unroll
            for (int ks = 0; ks < 2; ++ks) cf[ks] = *(const LAS bf16x8*)(CM + (16 * i + fr) * 72 + 32 * ks + 8 * fq);
            f32x4 o[4];
#pragma unroll
            for (int nt = 0; nt < 4; ++nt) o[nt] = (f32x4){0.f, 0.f, 0.f, 0.f};
#pragma unroll 1
            for (int dir = 0; dir < 2; ++dir) {
                const LAS float* cum = dir ? cumb : cumf; const LAS float* dtv = dir ? dtb : dtf; const LAS bf16_t* ST = dir ? STB : STF;
                const float cq = cum[16 * i + fr];
                const int jlo = dir ? i : 0, jhi = dir ? 7 : i;
                for (int j = jlo; j <= jhi; ++j) {
                    f32x4 d = (f32x4){0.f, 0.f, 0.f, 0.f};
#pragma unroll
                    for (int ks = 0; ks < 2; ++ks) { const bf16x8 bf_ = *(const LAS bf16x8*)(BM + (16 * j + fr) * 72 + 32 * ks + 8 * fq); d = __builtin_amdgcn_mfma_f32_16x16x32_bf16(bf_, cf[ks], d, 0, 0, 0); }
                    const f32x4 cs = *(const LAS f32x4*)(cum + 16 * j + 4 * fq), ds = *(const LAS f32x4*)(dtv + 16 * j + 4 * fq);
#pragma unroll
                    for (int r = 0; r < 4; ++r) { const bool keep = (j != i) || (dir ? (4 * fq + r >= fr) : (4 * fq + r <= fr)); d[r] = keep ? d[r] * __expf(cq - cs[r]) * ds[r] : 0.f; }
                    u32x2 w; w.x = pack2(d[0], d[1]); w.y = pack2(d[2], d[3]); *(LAS u32x2*)(pw + fr * 136 + 16 * j + 4 * fq) = w;
                }
                { const int zb = dir ? i - 1 : i + 1; const bool need = dir ? ((i & 1) == 1) : ((i & 1) == 0);
                  if (need) { u32x2 z; z.x = __float_as_uint(zero_f()); z.y = z.x; *(LAS u32x2*)(pw + fr * 136 + 16 * zb + 4 * fq) = z; } }
                const int kslo = dir ? (i >> 1) : 0, kshi = dir ? 3 : (i >> 1);
                for (int ks = kslo; ks <= kshi; ++ks) { const bf16x8 pa = *(const LAS bf16x8*)(pw + fr * 136 + 32 * ks + 8 * fq);
#pragma unroll
                    for (int nt = 0; nt < 4; ++nt) { const bf16x8 xf = *(const LAS bf16x8*)(XT + (16 * nt + fr) * 136 + 32 * ks + 8 * fq); o[nt] = __builtin_amdgcn_mfma_f32_16x16x32_bf16(pa, xf, o[nt], 0, 0, 0); } }
                f32x4 o2[4];
#pragma unroll
                for (int nt = 0; nt < 4; ++nt) o2[nt] = (f32x4){0.f, 0.f, 0.f, 0.f};
#pragma unroll
                for (int ks = 0; ks < 2; ++ks)
#pragma unroll
                    for (int nt = 0; nt < 4; ++nt) { const bf16x8 sf = *(const LAS bf16x8*)(ST + (16 * nt + fr) * 72 + 32 * ks + 8 * fq); o2[nt] = __builtin_amdgcn_mfma_f32_16x16x32_bf16(cf[ks], sf, o2[nt], 0, 0, 0); }
                const f32x4 ct = *(const LAS f32x4*)(cum + 16 * i + 4 * fq);
#pragma unroll
                for (int nt = 0; nt < 4; ++nt)
#pragma unroll
                    for (int r = 0; r < 4; ++r) o[nt][r] += __expf(ct[r]) * o2[nt][r];
            }
#pragma unroll
            for (int nt = 0; nt < 4; ++nt)
#pragma unroll
                for (int r = 0; r < 4; ++r) OUT[(16 * i + 4 * fq + r) * 64 + 16 * nt + fr] = o[nt][r];
        }
        __syncthreads();
        {
            const int pos = tid >> 2, qd = tid & 3; const int row = row0 + pos; const int c0 = h * 64 + 16 * qd;
            const float Dh = P.inp(I_SSDD)[l * 4 + h]; const float* ngp = P.inp(I_SSDNG) + l * 256 + c0; bf16_t* BR3 = (bf16_t*)(P.ws + WS_BR) + (size_t)3 * T * 256; float* SSQ = (float*)(P.ws + WS_SSQ);
            const bf16_t* zp = U + (size_t)row * UC + 2816 + c0; float q = 0.f;
#pragma unroll
            for (int hf = 0; hf < 2; ++hf) { float xs[8]; conv3_silu8(U, row, 3072 + c0 + 8 * hf, scw, 512, c0 + 8 * hf, scb, xs); const bf16x8 z8 = *(const bf16x8*)(zp + 8 * hf); float t8[8];
#pragma unroll
                for (int e4 = 0; e4 < 2; ++e4) { const f32x4 ov = *(const LAS f32x4*)(OUT + pos * 64 + 16 * qd + 8 * hf + 4 * e4);
#pragma unroll
                    for (int e = 0; e < 4; ++e) { const int ii = 4 * e4 + e; const float vv = (ov[e] + xs[ii] * Dh) * siluf_(bf2f((bf16_t)z8[ii])); q += vv * vv; t8[ii] = vv * ngp[8 * hf + ii]; } }
                *(bf16x8*)(BR3 + (size_t)row * 256 + c0 + 8 * hf) = pack8(t8); }
            q += __shfl_xor(q, 1); q += __shfl_xor(q, 2);
            if (qd == 0) SSQ[(size_t)row * 4 + h] = q;
        }
        __syncthreads();
    }
}

typedef float f32x2 __attribute__((ext_vector_type(2)));
__device__ __forceinline__ f32x2 cmul(f32x2 a, f32x2 b) { return (f32x2){a.x * b.x - a.y * b.y, a.x * b.y + a.y * b.x}; }
__device__ __forceinline__ f32x2 cmulc(f32x2 a, f32x2 b) { return (f32x2){a.x * b.x + a.y * b.y, a.y * b.x - a.x * b.y}; }
__device__ __forceinline__ int fphys(int i) { return i + (i >> 4); }
template <int LO, int NST, bool INV>
__device__ __forceinline__ void fft_pass(LAS f32x2* X, const LAS f32x2* TW, int tid) {
    const int low = tid & ((1 << LO) - 1), high = tid >> LO; const int base = low | (high << (LO + 4));
    f32x2 x[16];
#pragma unroll
    for (int j = 0; j < 16; ++j) { const int i = base | (j << LO); x[j] = X[fphys(i)]; }
#pragma unroll
    for (int mm = 0; mm < NST; ++mm) { const int m = INV ? mm : NST - 1 - mm; const int s = LO + m;
#pragma unroll
        for (int j = 0; j < 16; ++j) { if (j & (1 << m)) continue; const int j2 = j | (1 << m);
            const int k = ((j & ((1 << m) - 1)) << LO) | low; const f32x2 tw = TW[k << (12 - s)];
            const f32x2 a = x[j], b = x[j2];
            if (!INV) { x[j] = a + b; x[j2] = cmul(a - b, tw); } else { const f32x2 bt = cmulc(b, tw); x[j] = a + bt; x[j2] = a - bt; } } }
#pragma unroll
    for (int j = 0; j < 16; ++j) { const int i = base | (j << LO); X[fphys(i)] = x[j]; }
}
__device__ __forceinline__ void fft_fwd(LAS f32x2* X, const LAS f32x2* TW, int tid) {
    fft_pass<9, 4, false>(X, TW, tid); __syncthreads(); fft_pass<5, 4, false>(X, TW, tid); __syncthreads(); fft_pass<2, 3, false>(X, TW, tid); __syncthreads(); fft_pass<0, 2, false>(X, TW, tid); __syncthreads();
}
__device__ __forceinline__ void fft_inv(LAS f32x2* X, const LAS f32x2* TW, int tid) {
    fft_pass<0, 2, true>(X, TW, tid); __syncthreads(); fft_pass<2, 3, true>(X, TW, tid); __syncthreads(); fft_pass<5, 4, true>(X, TW, tid); __syncthreads(); fft_pass<9, 4, true>(X, TW, tid); __syncthreads();
}
__device__ __forceinline__ void hyena_fft_unit(const Ptrs P, int l, int c, LAS unsigned char* lds) {
    const int tid = P.tid, lane = tid & 63;
    LAS f32x2* X = (LAS f32x2*)lds; LAS f32x2* TW = X + 8704;
    const f32x2* TWg = (const f32x2*)(P.ws + WS_TW);
    for (int i = tid; i < 4096; i += 512) TW[i] = TWg[i];
    float nrm; { const float* part = (const float*)(P.ws + WS_PART) + (size_t)l * 64 * 512; nrm = wave_sum(part[lane * 512 + c] + part[lane * 512 + 256 + c]); }
    const float inv = 1.0f / nrm; const float* filt = (const float*)(P.ws + WS_FILT) + (size_t)l * 8192 * 256 + c;
    for (int i = tid; i < 8192; i += 512) X[fphys(i)] = (f32x2){filt[(size_t)i * 256] * inv, 0.f};
    __syncthreads();
    fft_fwd(X, TW, tid);
    f32x2* Fg = (f32x2*)(P.ws + WS_BR) + (size_t)P.bid * 8192;
    for (int i = tid; i < 8192; i += 512) Fg[i] = X[fphys(i)];
    unsigned* WTt = (unsigned*)(P.ws + WS_BIG + BIG_WT); const float bias = P.inp(I_HYBIAS)[l * 256 + c];
    for (int p = 0; p < 4; ++p) {
        unsigned* wp = WTt + ((size_t)c * 4 + p) * 4096;
        __syncthreads();
        for (int i = tid; i < 8192; i += 512) { f32x2 v = (f32x2){0.f, 0.f}; if (i < 4096) { const unsigned w = wp[i]; v.x = __uint_as_float(w << 16); v.y = __uint_as_float(w & 0xffff0000u); } X[fphys(i)] = v; }
        __syncthreads();
        fft_fwd(X, TW, tid);
        for (int i = tid; i < 8192; i += 512) { const int q = fphys(i); X[q] = cmul(X[q], Fg[i]); }
        __syncthreads();
        fft_inv(X, TW, tid);
        for (int i = tid; i < 4096; i += 512) { const unsigned w = wp[i]; const f32x2 y = X[fphys(i)] * (1.0f / 8192.0f);
            wp[i] = pack2(y.x + __uint_as_float(w << 16) * bias, y.y + __uint_as_float(w & 0xffff0000u) * bias); }
    }
    __syncthreads();
}

__device__ __forceinline__ void phase_m1(const Ptrs P, int l, LAS unsigned char* lds) {
    const int tid = P.tid, G = P.G;
    const bf16_t* U = (const bf16_t*)(P.ws + WS_BIG + BIG_U); bf16_t* WT = (bf16_t*)(P.ws + WS_BIG + BIG_WT);
    const float* hcw = P.inp(I_HYCW) + (size_t)l * 3 * 768; const float* hcb = P.inp(I_HYCB) + l * 768;
    const int NH = NB * 4 * NCHK, NSS = NB * 2 * NCHK;
    const int NS2 = NH + NSS;
    const int NU = NS2 + 256 + NCTX / 64;
    for (int u = P.bid; u < NU; u += G) {
        Ptrs Pu = P; asm volatile("" : "+v"(Pu.tid));
        if (u < NSS) ssd_pass1(Pu, l, u, lds);
        else if (u < NS2) hgrn_pass1(Pu, l, u - NSS, lds);
        else if (u < NS2 + 256) {
            const int ub = u - NS2; const int p = ub >> 6, tb = ub & 63; const int c = tid & 255; LAS unsigned* tile = (LAS unsigned*)lds;
#pragma unroll 4
            for (int rr = tid >> 8; rr < 64; rr += 2) { float w2[2];
#pragma unroll
                for (int b2 = 0; b2 < 2; ++b2) { const int row = (2 * p + b2) * SEQ + tb * 64 + rr;
                    const float x1 = conv3_u(U, row, 256 + c, hcw, 768, 256 + c) + hcb[256 + c]; const float v = conv3_u(U, row, 512 + c, hcw, 768, 512 + c) + hcb[512 + c]; w2[b2] = x1 * v; }
                tile[c * 65 + rr] = pack2(w2[0], w2[1]); }
            __syncthreads();
            { unsigned* WTt = (unsigned*)(P.ws + WS_BIG + BIG_WT); const int t = tid & 63;
              for (int cc = tid >> 6; cc < 256; cc += 8) WTt[((size_t)cc * 4 + p) * 4096 + tb * 64 + t] = tile[cc * 65 + t]; }
            __syncthreads();
        } else {
            const int ub = u - NS2 - 256; const int c = tid & 255; bf16_t* WTC = (bf16_t*)(P.ws + WS_BIG + BIG_WT) + (size_t)NLAT * 256;
#pragma unroll 4
            for (int rr = tid >> 8; rr < 64; rr += 2) { const int row = NLAT + ub * 64 + rr;
                const float x1 = conv3_u(U, row, 256 + c, hcw, 768, 256 + c) + hcb[256 + c]; const float v = conv3_u(U, row, 512 + c, hcw, 768, 512 + c) + hcb[512 + c];
                WTC[(size_t)(row - NLAT) * 256 + c] = f2bf(x1 * v); } }
    }
}

__device__ __forceinline__ void phase_m2(const Ptrs P, int l, LAS unsigned char* lds) {
    const int tid = P.tid, G = P.G;
    const bf16_t* U = (const bf16_t*)(P.ws + WS_BIG + BIG_U); bf16_t* BR = (bf16_t*)(P.ws + WS_BR);
    const float* hcw = P.inp(I_HYCW) + (size_t)l * 3 * 768; const float* hcb = P.inp(I_HYCB) + l * 768;
    const int NU_F = 256, NU_P2 = 256, NU_HC = (l == 0) ? NB * 8 : 0;
    const int NU = NU_F + NU_P2 + NU_HC;
    for (int u = P.bid; u < NU; u += G) {
        if (u < NU_F) { hyena_fft_unit(P, l, u, lds); continue; }
        if (u < NU_F + NU_P2) { scan_pass2(P, u - NU_F); continue; }
        {
            const int uu = u - NU_F - NU_P2; const int b = uu >> 3, cb = uu & 7; const int cl = tid & 31, tg = tid >> 5; const int c = cb * 32 + cl;
            const int base = NLAT + b * CTXL; const bf16_t* WTC = (const bf16_t*)(P.ws + WS_BIG + BIG_WT) + (size_t)NLAT * 256 + (size_t)b * CTXL * 256;
            LAS float* wl = (LAS float*)lds; LAS float* fl = wl + 256 * 32;
            const float inv = 1.0f / hy_norm(P, 2, c); const float* filt = (const float*)(P.ws + WS_FILTC);
            for (int i = tid; i < 256 * 32; i += 512) wl[i] = bf2f(WTC[(size_t)(i >> 5) * 256 + cb * 32 + (i & 31)]);
            for (int i = tid >> 5; i < 512; i += 16) fl[i * 32 + cl] = filt[(size_t)i * 256 + c] * inv;
            __syncthreads();
            float acc[16];
#pragma unroll
            for (int j = 0; j < 16; ++j) acc[j] = 0.f;
#pragma unroll 1
            for (int sb = 0; sb < 16; ++sb) {
                float fw[31], wv[16];
#pragma unroll
                for (int q = 0; q < 31; ++q) fw[q] = fl[((16 * tg - 16 * sb - 15 + q) & 511) * 32 + cl];
#pragma unroll
                for (int k = 0; k < 16; ++k) wv[k] = wl[(16 * sb + k) * 32 + cl];
#pragma unroll
                for (int j = 0; j < 16; ++j)
#pragma unroll
                    for (int k = 0; k < 16; ++k) acc[j] += fw[j - k + 15] * wv[k];
            }
            const float bias = P.inp(I_HYBIAS)[l * 256 + c];
#pragma unroll 4
            for (int j = 0; j < 16; ++j) { const int tt = 16 * tg + j; const int row = base + tt; const float x0 = conv3_u(U, row, c, hcw, 768, c) + hcb[c];
                BR[(size_t)row * 256 + c] = f2bf(x0 * (acc[j] + wl[tt * 32 + cl] * bias)); }
            __syncthreads();
        }
    }
}

__device__ __forceinline__ void phase_m3(const Ptrs P, int l, LAS unsigned char* lds) {
    const int tid = P.tid, G = P.G;
    const bool last = (l == NLAYER - 1); const int rows_l = last ? NLAT : T;
    const bf16_t* U = (const bf16_t*)(P.ws + WS_BIG + BIG_U); bf16_t* BR = (bf16_t*)(P.ws + WS_BR);
    const int NSS3 = NB * 2 * NCHK, NH3 = NB * 4 * NCHK;
    const int NS3T = NSS3 + NH3;
    const int NU = NS3T + rows_l / 64 + 256;
    const float* hcw = P.inp(I_HYCW) + (size_t)l * 3 * 768; const float* hcb = P.inp(I_HYCB) + l * 768;
    for (int u = P.bid; u < NU; u += G) {
        if (u >= NS3T + rows_l / 64) {
            const int ub = u - NS3T - rows_l / 64; const int p = ub >> 6, tb = ub & 63; LAS unsigned* tile = (LAS unsigned*)lds; const unsigned* WTt = (const unsigned*)(P.ws + WS_BIG + BIG_WT);
            { const int t = tid & 63; for (int cc = tid >> 6; cc < 256; cc += 8) tile[cc * 65 + t] = WTt[((size_t)cc * 4 + p) * 4096 + tb * 64 + t]; }
            __syncthreads();
            { const int c = tid & 255;
#pragma unroll 4
              for (int rr = tid >> 8; rr < 64; rr += 2) { const unsigned yw = tile[c * 65 + rr];
#pragma unroll
                  for (int b2 = 0; b2 < 2; ++b2) { const int row = (2 * p + b2) * SEQ + tb * 64 + rr; const float x0 = conv3_u(U, row, c, hcw, 768, c) + hcb[c];
                      const float y = b2 ? __uint_as_float(yw & 0xffff0000u) : __uint_as_float(yw << 16); BR[(size_t)row * 256 + c] = f2bf(x0 * y); } } }
            __syncthreads();
            continue; }
        if (u < NS3T) { const int uu = u < NSS3 ? u : u - NSS3; if (last && (uu % NCHK) < 2) continue;
            Ptrs Pu = P; asm volatile("" : "+v"(Pu.tid));
            if (u < NSS3) ssd_pass3(Pu, l, uu, lds); else hgrn_pass3(Pu, l, uu, lds); }
        else { const int rb = u - NS3T; const float* cw = P.inp(I_SCCW) + (size_t)l * 3 * 256; const int c = tid & 255;
#pragma unroll 4
            for (int rr = tid >> 8; rr < 64; rr += 2) { const int row = rb * 64 + rr; float acc = 0.f;
#pragma unroll
                for (int k = 0; k < 3; ++k) { const bool ok = (k == 1) || (k == 0 ? row_has_prev(row) : row_has_next(row)); const int r2 = ok ? row + k - 1 : row;
                    const float pr = bf2f(U[(size_t)r2 * UC + 1024 + c]) * bf2f(U[(size_t)r2 * UC + 1280 + c]) * cw[k * 256 + c]; acc += ok ? pr : 0.f; }
                BR[(size_t)T * 256 + (size_t)row * 256 + c] = f2bf(bf2f(U[(size_t)row * UC + 768 + c]) * acc); } }
    }
}

__device__ __forceinline__ void phase_g2(const Ptrs P, int l, LAS unsigned char* lds) {
    const int MT = ((l == NLAYER - 1) ? NLAT : T) / 256;
    pg8::Gemm g{(const bf16_t*)(P.ws + WS_BR), (const bf16_t*)(P.ws + WS_WBR), 256};
    EpiP E{(bf16_t*)(P.ws + WS_BIG + BIG_P), (const float*)(P.ws + WS_SSQ)};
    SchedG2 S{XOrder{P.G, P.bid, MT, 16}};
    pg8::gemm_phase<EpiP, SchedG2, false>(P.tid, lds, g, S, E);
}
__device__ __forceinline__ void phase_g3(const Ptrs P, int l, LAS unsigned char* lds) {
    const int MT = ((l == NLAYER - 1) ? NLAT : T) / 256;
    pg8::Gemm g{(const bf16_t*)(P.ws + WS_HBUF), (const bf16_t*)(P.ws + WS_WG), D};
    EpiMerge E{(const bf16_t*)(P.ws + WS_BIG + BIG_P), (const float*)(P.ws + WS_BGP), (bf16_t*)(P.ws + WS_BR)};
    SchedMN S{XOrder{P.G, P.bid, MT, 16}};
    pg8::gemm_phase<EpiMerge, SchedMN, false>(P.tid, lds, g, S, E);
}
__device__ __forceinline__ void phase_g4(const Ptrs P, int l, LAS unsigned char* lds) {
    const int MT = ((l == NLAYER - 1) ? NLAT : T) / 256;
    pg8::Gemm g{(const bf16_t*)(P.ws + WS_BR), (const bf16_t*)(P.ws + WS_WO), D};
    EpiWo E{P, l};
    SchedMN S{XOrder{P.G, P.bid, MT, 4}};
    pg8::gemm_phase<EpiWo, SchedMN, false>(P.tid, lds, g, S, E);
}

__device__ __forceinline__ void phase_e5(const Ptrs P, int l, LAS unsigned char* lds) {
    const int tid = P.tid, wid = tid >> 6, lane = tid & 63, G = P.G, fr = lane & 15, fq = lane >> 4;
    const int rows_l = (l == NLAYER - 1) ? NLAT : T;
    LAS bf16_t* wrH = (LAS bf16_t*)lds;
    LAS bf16_t* wrL = wrH + 16 * 1032;
    LAS float* tile = (LAS float*)(lds + 69632);
    LAS float* lgs = (LAS float*)(lds + 136192);
    LAS unsigned* lcnt = (LAS unsigned*)(lds + 144896); LAS unsigned* gbase = lcnt + 16; LAS int* rec = (LAS int*)(lcnt + 32);
    for (int i = tid; i < 1024 * 16; i += 512) { const int k = i >> 4, e = i & 15; const float w = P.inp(I_WROUTER)[i]; const unsigned hi = pack2(w, 0.f) & 0xffffu; const float lo = w - __uint_as_float(hi << 16);
        wrH[e * 1032 + k] = (bf16_t)hi; wrL[e * 1032 + k] = f2bf(lo); }
    if (tid < 16) lcnt[tid] = 0u;
    __syncthreads();
    unsigned* cnt = (unsigned*)(P.ws + WS_CTL + CTL_CNT) + l * 16;
    int* toke = (int*)(P.ws + WS_TOKE); float* tokw = (float*)(P.ws + WS_TOKW); int* toks = (int*)(P.ws + WS_TOKS); int* list = (int*)(P.ws + WS_LIST);
    const float* g = P.inp(I_LN1G) + l * D; const float* bta = P.inp(I_LN1B) + l * D;
    bf16_t* H2 = (bf16_t*)(P.ws + WS_HBUF);
    const int NU_R = rows_l / 8; const int NU = NU_R + NCONV_EX;
    int nloc = 0;
    {
        RowV lng, lnb; row_load(lng, g, lane); row_load(lnb, bta, lane);
        RowV rn; if (P.bid < NU_R) row_load(rn, P.latrow(P.bid * 8 + wid), lane);
        for (int u = P.bid; u < NU_R; u += G) {
            const int row = u * 8 + wid; RowV r = rn; float* lp = P.latrow(row);
            if (u + G < NU_R) row_load(rn, P.latrow((u + G) * 8 + wid), lane);
            row_layernorm_r(r, lng, lnb); row_store(r, lp, lane);
            const float* m = P.mod(l, row_modidx(row)); RowV h; row_modulate(r, h, m + 3072, m + 4096, lane);
            row_store_bf16(h, H2 + (size_t)row * D, lane);
            ++nloc;
        }
    }
    asm volatile("s_waitcnt vmcnt(0)" ::: "memory");
    __syncthreads();
    {
        const int ntile = (nloc + 1) >> 1; LAS float* lg = lgs + wid * 16 * 17;
        for (int t = wid; t < ntile; t += 8) {
            int it = 2 * t + (fr >> 3); const bool valid_a = it < nloc; if (!valid_a) it = nloc - 1;
            const bf16_t* ap = H2 + (size_t)((P.bid + G * it) * 8 + (fr & 7)) * D + 8 * fq;
            f32x4 acc = (f32x4){0.f, 0.f, 0.f, 0.f};
#pragma unroll 4
            for (int ks = 0; ks < 32; ++ks) { const bf16x8 a = *(const bf16x8*)(ap + 32 * ks);
                const bf16x8 bh = *(const LAS bf16x8*)(wrH + fr * 1032 + 32 * ks + 8 * fq), bl = *(const LAS bf16x8*)(wrL + fr * 1032 + 32 * ks + 8 * fq);
                acc = __builtin_amdgcn_mfma_f32_16x16x32_bf16(a, bh, acc, 0, 0, 0); acc = __builtin_amdgcn_mfma_f32_16x16x32_bf16(a, bl, acc, 0, 0, 0); }
#pragma unroll
            for (int r = 0; r < 4; ++r) lg[(4 * fq + r) * 17 + fr] = acc[r];
            const int it2 = 2 * t + (lane >> 3); const bool act = (lane < 16) && (it2 < nloc);
            if (act) {
                const int row = (P.bid + G * it2) * 8 + (lane & 7);
                float lgv[16];
#pragma unroll
                for (int e = 0; e < 16; ++e) lgv[e] = lg[lane * 17 + e];
                float mx = lgv[0];
#pragma unroll
                for (int e = 1; e < 16; ++e) mx = fmaxf(mx, lgv[e]);
                float sc[16], sel[16], ssum = 0.f;
#pragma unroll
                for (int e = 0; e < 16; ++e) { sc[e] = expf(lgv[e] - mx); ssum += sc[e]; }
                const float inv = 1.0f / ssum;
#pragma unroll
                for (int e = 0; e < 16; ++e) { sc[e] *= inv; sel[e] = sc[e] + P.inp(I_BROUTER)[e]; }
                int bestg = 0; float bestgs = -3.0e38f;
#pragma unroll
                for (int gq = 0; gq < 4; ++gq) { float m1 = -3.0e38f, m2 = -3.0e38f;
#pragma unroll
                    for (int j = 0; j < 4; ++j) { const float v = sel[gq * 4 + j]; if (v > m1) { m2 = m1; m1 = v; } else if (v > m2) m2 = v; }
                    const float gs = m1 + m2; if (gs > bestgs) { bestgs = gs; bestg = gq; } }
                int i1 = 0, i2 = 0; float v1 = -3.0e38f, v2 = -3.0e38f, w1 = 0.f, w2 = 0.f;
#pragma unroll
                for (int e = 0; e < 16; ++e) { if ((e >> 2) == bestg && sel[e] > v1) { v1 = sel[e]; i1 = e; w1 = sc[e]; } }
#pragma unroll
                for (int e = 0; e < 16; ++e) { if ((e >> 2) == bestg && e != i1 && sel[e] > v2) { v2 = sel[e]; i2 = e; w2 = sc[e]; } }
                const float ws_ = 1.0f / (w1 + w2);
                const int s1 = (int)__hip_atomic_fetch_add(lcnt + i1, 1u, __ATOMIC_RELAXED, __HIP_MEMORY_SCOPE_WORKGROUP);
                const int s2 = (int)__hip_atomic_fetch_add(lcnt + i2, 1u, __ATOMIC_RELAXED, __HIP_MEMORY_SCOPE_WORKGROUP);
                const int idx = it2 * 8 + (lane & 7); rec[idx * 3] = i1 | (i2 << 8); rec[idx * 3 + 1] = s1; rec[idx * 3 + 2] = s2;
                toke[row * 2] = i1; toke[row * 2 + 1] = i2; tokw[row * 2] = w1 * ws_; tokw[row * 2 + 1] = w2 * ws_;
            }
        }
    }
    __syncthreads();
    if (tid < 16) gbase[tid] = __hip_atomic_fetch_add(cnt + tid, lcnt[tid], __ATOMIC_RELAXED, __HIP_MEMORY_SCOPE_AGENT);
    __syncthreads();
    for (int idx = tid; idx < nloc * 8; idx += 512) { const int row = (P.bid + G * (idx >> 3)) * 8 + (idx & 7); const int ee = rec[idx * 3]; const int e1 = ee & 255, e2 = ee >> 8;
        const int s1 = (int)gbase[e1] + rec[idx * 3 + 1], s2 = (int)gbase[e2] + rec[idx * 3 + 2];
        list[(size_t)e1 * T + s1] = row; list[(size_t)e2 * T + s2] = row; toks[row * 2] = s1; toks[row * 2 + 1] = s2; }
    for (int u = P.bid + G * nloc; u < NU; u += G) { if (u >= NU_R) conv_unit_ex(P, l, u - NU_R, tile); }
}

struct MoeSeg { int toff[17]; };
__device__ __forceinline__ void moe_seg(const unsigned* cnt, MoeSeg& S) { int a = 0;
#pragma unroll
    for (int e = 0; e < 16; ++e) { S.toff[e] = a; a += __builtin_amdgcn_readfirstlane(((int)cnt[e] + 255) >> 8); }
    S.toff[16] = a; }
__device__ __forceinline__ int moe_find(const MoeSeg& S, int tg, int& off) { int e = 0; off = 0;
#pragma unroll
    for (int j = 1; j < 16; ++j) { const bool ge = (tg >= S.toff[j]); e += ge ? 1 : 0; off = ge ? S.toff[j] : off; }
    return e; }

struct SchedMoe { int G, c; MoeSeg S; const int* list; const unsigned* cnt;
    __device__ __forceinline__ bool next(int i, Unit& u) const { const int L = i * G + c; if (L >= S.toff[16] * 4) return false; const int tg = L >> 2, pnn = L & 3; int off; const int e = moe_find(S, tg, off);
        u.pm = tg; u.pn = e * 4 + pnn; u.e = e; u.aux = tg - off; return true; }
    __device__ __forceinline__ int arow(const Unit& u, int R) const { const int idx = u.aux * 256 + R; const int* l = list + (size_t)u.e * T; return idx < (int)cnt[u.e] ? l[idx] : l[0]; } };
__device__ __forceinline__ void phase_g5(const Ptrs P, int l, LAS unsigned char* lds) {
    const unsigned* cnt = (const unsigned*)(P.ws + WS_CTL + CTL_CNT) + l * 16;
    SchedMoe S; S.G = P.G; S.c = P.bid; moe_seg(cnt, S.S); S.list = (const int*)(P.ws + WS_LIST); S.cnt = cnt;
    pg8::Gemm g{(const bf16_t*)(P.ws + WS_HBUF), (const bf16_t*)(P.ws + WS_BIG + BIG_W13), D};
    EpiFfn1 E{(bf16_t*)(P.ws + WS_BIG + BIG_HID)};
    pg8::gemm_phase<EpiFfn1, SchedMoe, true>(P.tid, lds, g, S, E);
}
__device__ __forceinline__ void phase_g6(const Ptrs P, int l, LAS unsigned char* lds) {
    const unsigned* cnt = (const unsigned*)(P.ws + WS_CTL + CTL_CNT) + l * 16;
    SchedMoe S; S.G = P.G; S.c = P.bid; moe_seg(cnt, S.S); S.list = (const int*)(P.ws + WS_LIST); S.cnt = cnt;
    pg8::Gemm g{(const bf16_t*)(P.ws + WS_BIG + BIG_HID), (const bf16_t*)(P.ws + WS_BIG + BIG_W2), 512};
    EpiBf16Plain E{(bf16_t*)(P.ws + WS_BIG + BIG_YE), 1024, 3};
    pg8::gemm_phase<EpiBf16Plain, SchedMoe, false>(P.tid, lds, g, S, E);
}

__device__ __forceinline__ void phase_e8(const Ptrs P, int l, LAS unsigned char* lds) {
    const int tid = P.tid, wid = tid >> 6, lane = tid & 63, G = P.G;
    const bool last = (l == NLAYER - 1); const int rows_l = last ? NLAT : T;
    LAS float* wdt = (LAS float*)lds; LAS float* tile = (LAS float*)(lds + 65536);
    if (!last) load_wdt(P, l + 1, wdt);
    const unsigned* cnt = (const unsigned*)(P.ws + WS_CTL + CTL_CNT) + l * 16; MoeSeg S; moe_seg(cnt, S);
    const int* toke = (const int*)(P.ws + WS_TOKE); const float* tokw = (const float*)(P.ws + WS_TOKW); const int* toks = (const int*)(P.ws + WS_TOKS);
    const bf16_t* YE = (const bf16_t*)(P.ws + WS_BIG + BIG_YE);
    const float* g = P.inp(I_LN2G) + l * D; const float* bta = P.inp(I_LN2B) + l * D;
    const int NU_R = rows_l / 8; const int NU = NU_R + (last ? 0 : NCONV_NE);
    RowV lng, lnb; row_load(lng, g, lane); row_load(lnb, bta, lane);
    RowV rn; int te1 = 0, te2 = 0, ts1 = 0, ts2 = 0; float tw1 = 0.f, tw2 = 0.f;
    if (P.bid < NU_R) { const int row = P.bid * 8 + wid; row_load(rn, P.latrow(row), lane); te1 = toke[row * 2]; te2 = toke[row * 2 + 1]; tw1 = tokw[row * 2]; tw2 = tokw[row * 2 + 1]; ts1 = toks[row * 2]; ts2 = toks[row * 2 + 1]; }
    for (int u = P.bid; u < NU; u += G) {
        if (u >= NU_R) { conv_unit_ne(P, l + 1, u - NU_R, tile); continue; }
        const int row = u * 8 + wid; RowV r = rn; float* lp = P.latrow(row);
        const int e1 = te1, e2 = te2; const float w1 = tw1, w2 = tw2;
        int o1 = 0, o2 = 0;
#pragma unroll
        for (int e = 0; e < 16; ++e) { o1 = (e == e1) ? S.toff[e] : o1; o2 = (e == e2) ? S.toff[e] : o2; }
        const bf16_t* y1 = YE + ((size_t)o1 * 256 + ts1) * 1024; const bf16_t* y2 = YE + ((size_t)o2 * 256 + ts2) * 1024;
        u32x2 ya[4], yb[4];
#pragma unroll
        for (int i = 0; i < 4; ++i) { ya[i] = *(const u32x2*)(y1 + i * 256 + lane * 4); yb[i] = *(const u32x2*)(y2 + i * 256 + lane * 4); }
        if (u + G < NU_R) { const int rw = (u + G) * 8 + wid; row_load(rn, P.latrow(rw), lane); te1 = toke[rw * 2]; te2 = toke[rw * 2 + 1]; tw1 = tokw[rw * 2]; tw2 = tokw[rw * 2 + 1]; ts1 = toks[rw * 2]; ts2 = toks[rw * 2 + 1]; }
        const float* m = P.mod(l, row_modidx(row));
#pragma unroll
        for (int i = 0; i < 4; ++i) { const u32x2 a = ya[i], b = yb[i];
            const f32x4 g2 = *(const f32x4*)(m + 5120 + i * 256 + lane * 4);
            f32x4 mo; mo[0] = w1 * __uint_as_float(a.x << 16) + w2 * __uint_as_float(b.x << 16); mo[1] = w1 * __uint_as_float(a.x & 0xffff0000u) + w2 * __uint_as_float(b.x & 0xffff0000u);
            mo[2] = w1 * __uint_as_float(a.y << 16) + w2 * __uint_as_float(b.y << 16); mo[3] = w1 * __uint_as_float(a.y & 0xffff0000u) + w2 * __uint_as_float(b.y & 0xffff0000u);
            r.v[i] = r.v[i] * ALPHA + g2 * mo; }
        row_layernorm_r(r, lng, lnb);
        row_store(r, lp, lane);
        if (!last) { const float* m2 = P.mod(l + 1, row_modidx(row)); RowV h; row_modulate(r, h, m2, m2 + 1024, lane);
            row_store_bf16(h, (bf16_t*)(P.ws + WS_HBUF) + (size_t)row * D, lane); row_dt(h, wdt, (float*)(P.ws + WS_DT) + (size_t)row * 8, lane); }
    }
}

constexpr int NPH_LAYER = 11, NPH = 2 + NLAYER * NPH_LAYER;
__global__ void __launch_bounds__(512, 2) fwd_kernel(Args a) {
    extern __shared__ __attribute__((aligned(16))) unsigned char lds_raw[];
    LAS unsigned char* lds = (LAS unsigned char*)lds_raw;
    const int lo = a.ph_lo, hi = a.ph_hi;
    volatile LAS unsigned* xbw = (volatile LAS unsigned*)(lds + LDS_MISC);
    const int wave_s = __builtin_amdgcn_readfirstlane((int)threadIdx.x >> 6);
    if (threadIdx.x < 4) xbw[threadIdx.x] = 0u;
    __syncthreads();
    XcdBarrier bar; bar.bar = (unsigned*)(a.ws + WS_CTL); bar.x = 0; bar.st = xbw;
    if (hi - lo > 1) bar = xcd_barrier_post((unsigned*)(a.ws + WS_CTL), xbw, wave_s);
#ifndef PH_MASK
#define PH_MASK 0xFFFFFFFFu
#endif
#ifndef PROBE_PH
#define PROBE_PH (-1)
#define PROBE_N 1
#endif
#define REP(id) for (int rep_ = 0; rep_ < ((PROBE_PH == (id)) ? PROBE_N : 1); ++rep_)
#define PH_ON(id) (((PH_MASK) >> (id)) & 1u)
#define IN(k) (lo <= (k) && (k) < hi)
#define FRESH() Ptrs Pq; { const AS4 char* ka_ = (const AS4 char*)__builtin_amdgcn_kernarg_segment_ptr(); AS1 float* o_ = *(AS1 float* const AS4*)(ka_ + 8 * N_IN); AS1 unsigned char* w_ = *(AS1 unsigned char* const AS4*)(ka_ + 8 * N_IN + 8); int l_ = lcur; asm volatile("" : "+s"(o_), "+s"(w_), "+s"(l_) :: "memory"); Pq.out = (float*)o_; Pq.ws = (unsigned char*)w_; lq = l_; int ws_ = wave_s, b_ = blockIdx.x, g_ = gridDim.x; asm volatile("" : "+s"(ws_), "+s"(b_), "+s"(g_)); int ln_ = lane_id(); asm volatile("" : "+v"(ln_)); int t_ = ws_ * 64 + ln_; Pq.tid = t_; Pq.bid = b_; Pq.G = g_; }
#define SEAM(k) do { if (IN(k) && IN((k) + 1)) xcd_barrier(bar, wave_s); } while (0)
    int lcur = 0, lq = 0;
    if (PH_ON(0) && IN(0)) REP(0) { FRESH(); phase_pa(Pq, lds); } SEAM(0);
    if (PH_ON(1) && IN(1)) REP(1) { FRESH(); phase_pb(Pq, lds); } SEAM(1);
    for (int l = 0; l < NLAYER; ++l) {
        const int b = 2 + l * NPH_LAYER; lcur = l;
        if (PH_ON(2) && IN(b + 0)) REP(2) { FRESH(); phase_g1(Pq, lds); } SEAM(b + 0);
        for (int g_ = 0; g_ < ((PROBE_PH == 100) ? PROBE_N : 1); ++g_) {
        if (PH_ON(3) && IN(b + 1)) REP(3) { FRESH(); phase_m1(Pq, lq, lds); } SEAM(b + 1);
        if (PH_ON(4) && IN(b + 2)) REP(4) { FRESH(); phase_m2(Pq, lq, lds); } SEAM(b + 2);
        if (PH_ON(5) && IN(b + 3)) REP(5) { FRESH(); phase_m3(Pq, lq, lds); } SEAM(b + 3);
        }
        if (PH_ON(6) && IN(b + 4)) REP(6) { FRESH(); phase_g2(Pq, lq, lds); } SEAM(b + 4);
        if (PH_ON(7) && IN(b + 5)) REP(7) { FRESH(); phase_g3(Pq, lq, lds); } SEAM(b + 5);
        if (PH_ON(8) && IN(b + 6)) REP(8) { FRESH(); phase_g4(Pq, lq, lds); } SEAM(b + 6);
        if (PH_ON(9) && IN(b + 7)) REP(9) { FRESH(); phase_e5(Pq, lq, lds); } SEAM(b + 7);
        if (PH_ON(10) && IN(b + 8)) REP(10) { FRESH(); phase_g5(Pq, lq, lds); } SEAM(b + 8);
        if (PH_ON(11) && IN(b + 9)) REP(11) { FRESH(); phase_g6(Pq, lq, lds); } SEAM(b + 9);
        if (PH_ON(12) && IN(b + 10)) REP(12) { FRESH(); phase_e8(Pq, lq, lds); } SEAM(b + 10);
    }
#undef IN
#undef SEAM
}
}

extern "C" void kernel_launch(void* const* d_in, const int* in_sizes, int n_in, void* d_out, int out_size, void* d_ws, size_t ws_size, hipStream_t stream) {
    static int grid = 0;
    if (grid == 0) {
        if (n_in != N_IN || out_size != NLAT * D || ws_size < WS_END) { fprintf(stderr, "kernel_launch: unexpected shapes / workspace (%d inputs, out %d, ws %zu < %zu)\n", n_in, out_size, ws_size, (size_t)WS_END); grid = -1; return; }
        int dev = 0, cus = 0, per_cu = 0;
        if (hipGetDevice(&dev) != hipSuccess || hipDeviceGetAttribute(&cus, hipDeviceAttributeMultiprocessorCount, dev) != hipSuccess) { grid = -1; return; }
        if (hipFuncSetAttribute((const void*)fwd_kernel, hipFuncAttributeMaxDynamicSharedMemorySize, LDS_BYTES) != hipSuccess) { fprintf(stderr, "kernel_launch: hipFuncSetAttribute failed\n"); grid = -1; return; }
        if (hipOccupancyMaxActiveBlocksPerMultiprocessor(&per_cu, (const void*)fwd_kernel, 512, LDS_BYTES) != hipSuccess || per_cu < 1) { fprintf(stderr, "kernel_launch: occupancy query says %d\n", per_cu); }
        (void)hipGetLastError();
        grid = cus;
    }
    if (grid < 0) return;
    (void)hipMemsetAsync((char*)d_ws + WS_CTL, 0, CTL_BYTES, stream);
    Args a{};
    for (int i = 0; i < N_IN; ++i) a.in[i] = (const float*)d_in[i];
    a.out = (float*)d_out; a.ws = (unsigned char*)d_ws;
#if N_LAUNCH_MODE == 1
    a.ph_lo = 0; a.ph_hi = NPH;
    hipLaunchKernelGGL(fwd_kernel, dim3(grid), dim3(512), LDS_BYTES, stream, a);
#else
    for (int p = 0; p < NPH; ++p) { a.ph_lo = p; a.ph_hi = p + 1; hipLaunchKernelGGL(fwd_kernel, dim3(grid), dim3(512), LDS_BYTES, stream, a); }
#endif
}
```

```cpp
#include <hip/hip_runtime.h>
#include <cstdio>
#include <cstdint>

#ifndef N_LAUNCH_MODE
#define N_LAUNCH_MODE 1
#endif

namespace {
typedef unsigned short bf16_t;
typedef short bf16x8 __attribute__((ext_vector_type(8)));
typedef float f32x4 __attribute__((ext_vector_type(4)));
typedef unsigned u32x2 __attribute__((ext_vector_type(2)));
typedef unsigned u32x4 __attribute__((ext_vector_type(4)));
#define LAS __attribute__((address_space(3)))

constexpr int D = 1024, NB = 8, SEQ = 4096, CTXL = 256, NLAT = NB * SEQ, NCTX = NB * CTXL, T = NLAT + NCTX;
constexpr int NLAYER = 2;
constexpr int UC = 3584;
constexpr int INC = 3592;
constexpr int NE = 16;
constexpr float ALPHA = 1.41421356237309515f;
constexpr float LN_EPS = 1e-5f, RMS_EPS = 1e-6f;
constexpr int MAXTILES = 288;

enum { I_X = 0, I_C, I_CTX, I_CCTX, I_WADA, I_BADA, I_WIN, I_HYCW, I_HYCB, I_HYW1, I_HYB1, I_HYF1, I_HYW2, I_HYB2, I_HYF2, I_HYW3, I_HYDEC, I_HYBIAS,
       I_SCCW, I_HGLB, I_HGNG, I_SSDCW, I_SSDCB, I_SSDALOG, I_SSDDTB, I_SSDD, I_SSDNG, I_WGATE, I_BGATE, I_WBR, I_WO, I_LN1G, I_LN1B, I_LN2G, I_LN2B,
       I_WROUTER, I_BROUTER, I_WE1, I_WE3, I_WE2, N_IN };

constexpr size_t al256(size_t x) { return (x + 255) & ~(size_t)255; }
constexpr size_t WS_CTL = 0;
constexpr size_t CTL_BYTES = 65536;
constexpr size_t CTL_CNT = 16384;
constexpr size_t WS_MOD = WS_CTL + CTL_BYTES;
constexpr size_t WS_LB = WS_MOD + al256((size_t)NLAYER * 9 * 6144 * 4);
constexpr size_t WS_TW = WS_LB + 4096;
constexpr size_t WS_H2TAB = WS_TW + 65536;
constexpr size_t WS_PART = WS_H2TAB + (size_t)8448 * 64 * 4;
constexpr size_t WS_FILT = WS_PART + (size_t)3 * 64 * 512 * 4;
constexpr size_t WS_FILTC = WS_FILT + (size_t)2 * 8192 * 256 * 4;
constexpr size_t WS_CX32 = WS_FILTC + (size_t)512 * 256 * 4;
constexpr size_t WS_DT = WS_CX32 + (size_t)NCTX * D * 4;
constexpr size_t WS_SSQ = WS_DT + (size_t)T * 8 * 4;
constexpr size_t WS_TOKE = WS_SSQ + (size_t)T * 4 * 4;
constexpr size_t WS_TOKW = WS_TOKE + (size_t)T * 2 * 4;
constexpr size_t WS_TOKS = WS_TOKW + (size_t)T * 2 * 4;
constexpr size_t WS_LIST = WS_TOKS + (size_t)T * 2 * 4;
constexpr size_t WS_BGP = WS_LIST + (size_t)NE * T * 4;
constexpr size_t WS_DEC = WS_BGP + 16384;
constexpr size_t WS_WIN = WS_DEC + (size_t)4352 * 64 * 4;
constexpr size_t WS_WG = WS_WIN + (size_t)UC * D * 2;
constexpr size_t WS_WBR = WS_WG + (size_t)4096 * D * 2;
constexpr size_t WS_WO = WS_WBR + (size_t)4096 * 256 * 2;
constexpr size_t WS_HBUF = WS_WO + (size_t)D * D * 2;
constexpr size_t WS_BR = WS_HBUF + (size_t)T * D * 2;
constexpr size_t WS_BIG = WS_BR + (size_t)T * D * 2;
constexpr size_t BIG_U = 0;
constexpr size_t BIG_HGO = BIG_U + (size_t)T * UC * 2;
constexpr size_t BIG_STATE = BIG_HGO;
constexpr size_t BIG_SSY = BIG_HGO + (size_t)T * 256 * 4;
constexpr size_t BIG_WT = BIG_SSY + (size_t)T * 256 * 4;
constexpr size_t BIG_END1 = BIG_WT + (size_t)T * 256 * 2;
constexpr size_t BIG_P = 0;
constexpr size_t BIG_HID = 0;
constexpr size_t BIG_YE = BIG_HID + (size_t)MAXTILES * 256 * 512 * 2;
constexpr size_t BIG_W13 = BIG_YE + (size_t)MAXTILES * 256 * 1024 * 2;
constexpr size_t BIG_W2 = BIG_W13 + (size_t)NE * 1024 * 1024 * 2;
constexpr size_t BIG_END3 = BIG_W2 + (size_t)NE * 1024 * 512 * 2;
constexpr size_t BIG_BYTES = BIG_END1 > BIG_END3 ? BIG_END1 : BIG_END3;
constexpr size_t WS_END = WS_BIG + BIG_BYTES;
static_assert((size_t)T * 4096 * 2 <= BIG_BYTES, "P fits");
static_assert(WS_END <= (size_t)536870912, "workspace budget");

constexpr int LDS_BYTES = 147456;
constexpr int LDS_MISC = 147456 - 256;

struct Args { const float* in[N_IN]; float* out; unsigned char* ws; int ph_lo, ph_hi; };

#define XB_TMO      128
#define XB_XCNT(j)  (256  + 64 * (j))
#define XB_XSUB(j)  (1280 + 64 * (j))
#define XB_XGEN(j)  (2304 + 64 * (j))
#define XB_TOP      3328
#define XB_TOPGEN   3392
#define XCD_BAR_WORDS 3456
#define XB_SPIN_CAP (1u << 18)
__device__ __forceinline__ unsigned xb_ld(unsigned* p)              { return __hip_atomic_load(p, __ATOMIC_RELAXED, __HIP_MEMORY_SCOPE_AGENT); }
__device__ __forceinline__ unsigned xb_add(unsigned* p, unsigned v) { return __hip_atomic_fetch_add(p, v, __ATOMIC_RELAXED, __HIP_MEMORY_SCOPE_AGENT); }
__device__ __forceinline__ unsigned xb_xcc_id() { return (unsigned)__builtin_amdgcn_s_getreg((3 << 11) | 20) & 0xFu; }
#define XB_SPIN(cond, bar) do { unsigned _sp = 0; while (cond) { __builtin_amdgcn_s_sleep(1); \
    if ((++_sp & 255u) == 0u) { if (xb_ld(&(bar)[XB_TMO])) break; if (_sp > XB_SPIN_CAP) { atomicAdd(&(bar)[XB_TMO], 1u); break; } } } } while (0)
struct XcdBarrier { unsigned* bar; unsigned x; volatile LAS unsigned* st; };
__device__ __forceinline__ int lane_id() { unsigned z = 0u; asm volatile("" : "+v"(z)); return (int)__builtin_amdgcn_mbcnt_hi(~0u, __builtin_amdgcn_mbcnt_lo(~0u, z)); }
__device__ __forceinline__ bool is_thread0(int wave_s) { return wave_s == 0 && lane_id() == 0; }
__device__ __forceinline__ XcdBarrier xcd_barrier_post(unsigned* bar, volatile LAS unsigned* st, int wave_s) {
    XcdBarrier b; b.bar = bar; b.x = xb_xcc_id(); b.st = st;
    if (is_thread0(wave_s)) (void)xb_add(&bar[XB_XCNT(b.x)], 1u);
    return b;
}
__device__ __forceinline__ void xcd_barrier_complete(unsigned* bar, unsigned x, unsigned& nloc, unsigned& nx) {
    const unsigned G = gridDim.x * gridDim.y * gridDim.z;
    unsigned sum, cnt, mine, sp = 0u;
    for (;;) {
        sum = 0u; cnt = 0u; mine = 0u;
#pragma unroll
        for (unsigned j = 0; j < 16; ++j) { const unsigned c = xb_ld(&bar[XB_XCNT(j)]); sum += c; cnt += (c > 0u) ? 1u : 0u; mine = (j == x) ? c : mine; }
        if (sum == G) break;
        __builtin_amdgcn_s_sleep(1);
        if ((++sp & 255u) == 0u) { if (xb_ld(&bar[XB_TMO])) break; if (sp > XB_SPIN_CAP) { atomicAdd(&bar[XB_TMO], 1u); break; } }
    }
    nloc = mine > 0u ? mine : 1u; nx = cnt > 0u ? cnt : 1u;
}
__device__ __forceinline__ void xcd_barrier(const XcdBarrier& b, int wave_s) {
    asm volatile("s_waitcnt vmcnt(0)" ::: "memory");
    __syncthreads();
    if (is_thread0(wave_s)) {
        unsigned* bar = b.bar;
        __builtin_amdgcn_s_waitcnt(0);
        unsigned nloc = b.st[0], nx = b.st[1];
        if (nloc == 0u) { xcd_barrier_complete(bar, b.x, nloc, nx); b.st[0] = nloc; b.st[1] = nx; }
        const unsigned old = xb_add(&bar[XB_XSUB(b.x)], 1u);
        const unsigned gen = old / nloc;
        if (old + 1u == (gen + 1u) * nloc) {
            __builtin_amdgcn_fence(__ATOMIC_RELEASE, "agent");
            asm volatile("s_waitcnt vmcnt(0)" ::: "memory");
            const unsigned og = xb_add(&bar[XB_TOP], 1u);
            const unsigned tg = og / nx;
            if (og + 1u == (tg + 1u) * nx) xb_add(&bar[XB_TOPGEN], 1u);
            else XB_SPIN(xb_ld(&bar[XB_TOPGEN]) == tg, bar);
            __builtin_amdgcn_fence(__ATOMIC_ACQUIRE, "agent");
            xb_add(&bar[XB_XGEN(b.x)], 1u);
            asm volatile("s_waitcnt vmcnt(0)" ::: "memory");
        } else {
            XB_SPIN(xb_ld(&bar[XB_XGEN(b.x)]) == gen, bar);
            __builtin_amdgcn_fence(__ATOMIC_ACQUIRE, "agent");
            asm volatile("s_waitcnt vmcnt(0)" ::: "memory");
        }
    }
    __syncthreads();
}

__device__ __forceinline__ float bf2f(bf16_t b) { return __uint_as_float(((unsigned)b) << 16); }
typedef __bf16 hwbf2 __attribute__((ext_vector_type(2)));
typedef float hwf2 __attribute__((ext_vector_type(2)));
__device__ __forceinline__ unsigned pack2(float lo, float hi) { const hwf2 v = {lo, hi}; return __builtin_bit_cast(unsigned, __builtin_convertvector(v, hwbf2)); }
__device__ __forceinline__ bf16_t f2bf(float f) { return (bf16_t)(pack2(f, 0.f) & 0xffffu); }
__device__ __forceinline__ float zero_f() { float z = 0.f; asm volatile("" : "+v"(z)); return z; }
__device__ __forceinline__ float kconst(float c) { asm volatile("" : "+s"(c)); return c; }
__device__ __forceinline__ float fexp(float x) { return __builtin_amdgcn_exp2f(x * kconst(1.4426950408889634f)); }
__device__ __forceinline__ float flog(float x) { return __builtin_amdgcn_logf(x) * kconst(0.6931471805599453f); }
__device__ __forceinline__ float sigmoidf_(float x) { return __builtin_amdgcn_rcpf(1.0f + fexp(-x)); }
__device__ __forceinline__ float siluf_(float x) { return x * sigmoidf_(x); }
__device__ __forceinline__ float wave_sum(float v) {
#pragma unroll
    for (int o = 32; o >= 1; o >>= 1) v += __shfl_xor(v, o);
    return v;
}
__device__ __forceinline__ int row_modidx(int r) { return r < NLAT ? (r >> 12) : 8; }
__device__ __forceinline__ bool row_has_prev(int r) { return r < NLAT ? ((r & 4095) != 0) : (((r - NLAT) & 255) != 0); }
__device__ __forceinline__ bool row_has_next(int r) { return r < NLAT ? ((r & 4095) != 4095) : (((r - NLAT) & 255) != 255); }

#define AS1 __attribute__((address_space(1)))
#define AS4 __attribute__((address_space(4)))
struct Ptrs {
    float* out; unsigned char* ws; int tid, bid, G;
    __device__ __forceinline__ const float* inp(int i) const { asm volatile("" : "+s"(i));
        const __attribute__((address_space(4))) char* ka = (const __attribute__((address_space(4))) char*)__builtin_amdgcn_kernarg_segment_ptr();
        return (const float*)(*(const AS1 float* const AS4*)(ka + 8 * i)); }
    __device__ __forceinline__ float* latrow(int r) const { return r < NLAT ? out + (size_t)r * D : (float*)(ws + WS_CX32) + (size_t)(r - NLAT) * D; }
    __device__ __forceinline__ float* mod(int l, int ridx) const { return (float*)(ws + WS_MOD) + ((size_t)l * 9 + ridx) * 6144; }
};

__device__ __forceinline__ float conv3_u(const bf16_t* U, int row, int col, const float* w, int ncol, int wcol) {
    const bool hp = row_has_prev(row), hn = row_has_next(row);
    const float c = bf2f(U[(size_t)row * UC + col]), p = bf2f(U[(size_t)(hp ? row - 1 : row) * UC + col]), n = bf2f(U[(size_t)(hn ? row + 1 : row) * UC + col]);
    return c * w[ncol + wcol] + (hp ? p * w[wcol] : 0.f) + (hn ? n * w[2 * ncol + wcol] : 0.f);
}

struct Unit { int pm, pn, e, aux; };
__host__ __device__ __forceinline__ int perm32(int rho) { const int n = rho >> 4, i = rho & 15; return 8 * (i >> 2) + 4 * n + (i & 3); }

template <class RowMap, class Epi>
__device__ __forceinline__ void sgemm_unit(int tid_, const bf16_t* __restrict__ A, int lda, const bf16_t* __restrict__ Bt, int ldb, int K, const Unit& u, const RowMap& RM, const Epi& E) {
    const int tid = tid_, wid = tid >> 6, lane = tid & 63, wr = wid >> 2, wc = wid & 3, fr = lane & 15, fq = lane >> 4;
    f32x4 acc[2][2][4][2];
#pragma unroll
    for (int a = 0; a < 2; ++a)
#pragma unroll
        for (int b = 0; b < 2; ++b)
#pragma unroll
            for (int m = 0; m < 4; ++m)
#pragma unroll
                for (int n = 0; n < 2; ++n) acc[a][b][m][n] = (f32x4){0.f, 0.f, 0.f, 0.f};
    unsigned ap[2][4], bp[2][2];
#pragma unroll
    for (int a = 0; a < 2; ++a)
#pragma unroll
        for (int m = 0; m < 4; ++m) ap[a][m] = (unsigned)RM(u, 128 * a + 64 * wr + 16 * m + fr) * (unsigned)lda + fq * 8;
#pragma unroll
    for (int b = 0; b < 2; ++b)
#pragma unroll
        for (int n = 0; n < 2; ++n) { const int rho = 16 * n + fr; const int col = Epi::PERM ? perm32(rho) : rho;
            bp[b][n] = (unsigned)(u.pn * 256 + 128 * b + 32 * wc + col) * (unsigned)ldb + fq * 8; }
    for (int k = 0; k < K; k += 32) {
        bf16x8 bfr[2][2];
#pragma unroll
        for (int b = 0; b < 2; ++b)
#pragma unroll
            for (int n = 0; n < 2; ++n) bfr[b][n] = *(const bf16x8*)(Bt + (bp[b][n] + k));
#pragma unroll
        for (int a = 0; a < 2; ++a) {
            bf16x8 af[4];
#pragma unroll
            for (int m = 0; m < 4; ++m) af[m] = *(const bf16x8*)(A + (ap[a][m] + k));
#pragma unroll
            for (int b = 0; b < 2; ++b)
#pragma unroll
                for (int m = 0; m < 4; ++m)
#pragma unroll
                    for (int n = 0; n < 2; ++n) acc[a][b][m][n] = __builtin_amdgcn_mfma_f32_16x16x32_bf16(bfr[b][n], af[m], acc[a][b][m][n], 0, 0, 0);
        }
    }
    E(acc, u, wr, wc, fr, fq);
}

struct RowIdent { __device__ __forceinline__ int operator()(const Unit& u, int R) const { return u.pm * 256 + R; } };
struct RowStackK { int rows; __device__ __forceinline__ int operator()(const Unit& u, int R) const { return u.e * rows + u.pm * 256 + R; } };
struct RowGather { const int* list; const unsigned* cnt; __device__ __forceinline__ int operator()(const Unit& u, int R) const {
    const int idx = u.aux * 256 + R; const int* l = list + (size_t)u.e * T; return idx < (int)cnt[u.e] ? l[idx] : l[0]; } };


namespace pg8 {
constexpr int BM = 256, BK = 64, HALF = 128, HTB = HALF * BK * 2, STAGE_BYTES = 8 * HTB;
__host__ __device__ __forceinline__ int lds_byte(int r, int c) { const int st = (r >> 4) * 2 + (c >> 5), rr = r & 15, cc = c & 31, ob = rr * 64 + cc * 2; return st * 1024 + (ob ^ (((ob >> 9) & 1) << 5)); }
__host__ __device__ __forceinline__ void stage_rc(int b, int& R, int& C) { const int st = b / 1024, sb = b % 1024, swz = sb ^ (((sb >> 9) & 1) << 5); R = (st >> 1) * 16 + swz / 64; C = (st & 1) * 32 + (swz % 64) / 2; }
struct Gemm { const bf16_t* A; const bf16_t* Bt; int K; };

template <class Epi, class Sched, bool GATHER>
__device__ __forceinline__ void gemm_phase(int tid, LAS unsigned char* lds, const Gemm g, const Sched& S, const Epi& E) {
    const int wid = __builtin_amdgcn_readfirstlane(tid >> 6), lane = tid & 63, wr = wid >> 2, wc = wid & 3, fr = lane & 15, fq = lane >> 4;
    const int K = g.K, nt = K / BK;
    int RA[2], CA[2]; unsigned voffB[2];
    unsigned vA[2][2], vAn[2][2];
#pragma unroll
    for (int i = 0; i < 2; ++i) { int R, C; stage_rc(tid * 16 + i * 8192, R, C); RA[i] = R; CA[i] = C; const int Rb = Epi::PERM ? ((R & ~31) + perm32(R & 31)) : R; voffB[i] = (unsigned)(Rb * K + C) * 2u; }
    const size_t kstep = (size_t)(BK * 2);
    const size_t hstep = (size_t)HALF * K * 2;
    const size_t tstep = 2 * hstep;
    const unsigned ldsw = (unsigned)wid * 1024u;
    const int aoff = lds_byte(wr * 64 + fr, fq * 8), boff = lds_byte(wc * 32 + fr, fq * 8);
#define PG8_SA(b, h) (((b) * 2 + (h)) * HTB)
#define PG8_SB(b, h) ((4 + (b) * 2 + (h)) * HTB)
#define PG8_STAGE(bufoff, gbase, voff) do { _Pragma("unroll") for (int _i = 0; _i < 2; ++_i) \
        __builtin_amdgcn_global_load_lds((const unsigned*)((const char*)(gbase) + (voff)[_i]), (LAS unsigned*)(lds + (bufoff) + ldsw + _i * 8192), 16, 0, 0); } while (0)
#define PG8_STAGE2(bufoff, gbase, v0, v1) do { \
        __builtin_amdgcn_global_load_lds((const unsigned*)((const char*)(gbase) + (v0)), (LAS unsigned*)(lds + (bufoff) + ldsw), 16, 0, 0); \
        __builtin_amdgcn_global_load_lds((const unsigned*)((const char*)(gbase) + (v1)), (LAS unsigned*)(lds + (bufoff) + ldsw + 8192), 16, 0, 0); } while (0)
#define PG8_LDA(dst, b, h) do { _Pragma("unroll") for (int m = 0; m < 4; ++m) _Pragma("unroll") for (int k = 0; k < 2; ++k) dst[m][k] = *(const LAS bf16x8*)(lds + PG8_SA(b, h) + aoff + m * 2048 + k * 1024); } while (0)
#define PG8_LDB(dst, b, h) do { _Pragma("unroll") for (int n = 0; n < 2; ++n) _Pragma("unroll") for (int k = 0; k < 2; ++k) dst[n][k] = *(const LAS bf16x8*)(lds + PG8_SB(b, h) + boff + n * 2048 + k * 1024); } while (0)
#define PG8_MMA(ai, bj, At, Bt) do { __builtin_amdgcn_s_setprio(1); _Pragma("unroll") for (int m = 0; m < 4; ++m) _Pragma("unroll") for (int n = 0; n < 2; ++n) _Pragma("unroll") for (int k = 0; k < 2; ++k) \
        acc[ai][bj][m][n] = __builtin_amdgcn_mfma_f32_16x16x32_bf16(Bt[n][k], At[m][k], acc[ai][bj][m][n], 0, 0, 0); __builtin_amdgcn_s_setprio(0); } while (0)
#define PG8_WAIT_V(n) asm volatile("s_waitcnt vmcnt(" #n ")" ::: "memory")
#define PG8_WAIT_L(n) asm volatile("s_waitcnt lgkmcnt(" #n ")" ::: "memory")
#define PG8_BAR __builtin_amdgcn_s_barrier()
#define PG8_SCHED __builtin_amdgcn_sched_barrier(0)
#define PG8_AOFFS(dst, unit) do { _Pragma("unroll") for (int _h = 0; _h < 2; ++_h) _Pragma("unroll") for (int _i = 0; _i < 2; ++_i) \
        dst[_h][_i] = GATHER ? ((unsigned)S.arow(unit, _h * HALF + RA[_i]) * (unsigned)K + (unsigned)CA[_i]) * 2u : ((unsigned)(_h * HALF + RA[_i]) * (unsigned)K + (unsigned)CA[_i]) * 2u; } while (0)
    Unit cur{0, 0, 0, 0}, nxt{0, 0, 0, 0}; int ui = 0;
    if (!S.next(0, cur)) return;
    f32x4 acc[2][2][4][2];
#pragma unroll
    for (int a = 0; a < 2; ++a)
#pragma unroll
        for (int b = 0; b < 2; ++b)
#pragma unroll
            for (int m = 0; m < 4; ++m)
#pragma unroll
                for (int n = 0; n < 2; ++n) acc[a][b][m][n] = (f32x4){0.f, 0.f, 0.f, 0.f};
    bf16x8 At[4][2], B0[2][2], B1[2][2];
    const char* cA = GATHER ? (const char*)g.A : (const char*)g.A + (size_t)cur.pm * tstep; const char* cB = (const char*)g.Bt + (size_t)cur.pn * tstep;
    PG8_AOFFS(vA, cur);
    PG8_STAGE(PG8_SB(0, 0), cB, voffB); PG8_STAGE(PG8_SB(0, 1), cB + hstep, voffB); PG8_STAGE2(PG8_SA(0, 0), cA, vA[0][0], vA[0][1]); PG8_STAGE2(PG8_SA(0, 1), cA, vA[1][0], vA[1][1]);
    if (wr == 1) PG8_BAR;
    PG8_WAIT_V(2); PG8_BAR;
    PG8_STAGE(PG8_SB(1, 0), cB + kstep, voffB); PG8_STAGE2(PG8_SA(1, 0), cA + kstep, vA[0][0], vA[0][1]); PG8_STAGE(PG8_SB(1, 1), cB + hstep + kstep, voffB);
    PG8_WAIT_V(6); PG8_BAR;
    for (;;) {
        const bool has_next = S.next(ui + 1, nxt);
        const char* nA = GATHER ? (const char*)g.A : (has_next ? (const char*)g.A + (size_t)nxt.pm * tstep : cA); const char* nB = has_next ? (const char*)g.Bt + (size_t)nxt.pn * tstep : cB;
        if (GATHER && has_next) { PG8_AOFFS(vAn, nxt); } else {
#pragma unroll
            for (int _h = 0; _h < 2; ++_h)
#pragma unroll
                for (int _i = 0; _i < 2; ++_i) vAn[_h][_i] = vA[_h][_i]; }
#pragma unroll 1
        for (int t = 0; t < nt; t += 2) {
            const bool last = (t == nt - 2);
            const char* a1 = cA + (size_t)(t + 1) * kstep;
            const char* a2 = last ? nA : cA + (size_t)(t + 2) * kstep; const char* b2 = last ? nB : cB + (size_t)(t + 2) * kstep;
            const char* a3 = a2 + kstep; const char* b3 = b2 + kstep;
            const unsigned x00 = (GATHER && last) ? vAn[0][0] : vA[0][0], x01 = (GATHER && last) ? vAn[0][1] : vA[0][1], x10 = (GATHER && last) ? vAn[1][0] : vA[1][0], x11 = (GATHER && last) ? vAn[1][1] : vA[1][1];
            PG8_LDB(B0, 0, 0); PG8_LDB(B1, 0, 1); PG8_SCHED; PG8_LDA(At, 0, 0); PG8_STAGE2(PG8_SA(1, 1), a1, vA[1][0], vA[1][1]);
            PG8_WAIT_V(8); PG8_WAIT_L(0); PG8_BAR; PG8_MMA(0, 0, At, B0); PG8_MMA(0, 1, At, B1); PG8_BAR; PG8_SCHED;
            PG8_LDA(At, 0, 1); PG8_STAGE(PG8_SB(0, 0), b2, voffB); PG8_STAGE(PG8_SB(0, 1), b2 + hstep, voffB); PG8_STAGE2(PG8_SA(0, 0), a2, x00, x01);
            PG8_WAIT_V(8); PG8_WAIT_L(0); PG8_BAR; PG8_MMA(1, 0, At, B0); PG8_MMA(1, 1, At, B1); PG8_BAR; PG8_SCHED;
            PG8_LDB(B0, 1, 0); PG8_LDB(B1, 1, 1); PG8_SCHED; PG8_LDA(At, 1, 0); PG8_STAGE2(PG8_SA(0, 1), a2, x10, x11);
            PG8_WAIT_V(8); PG8_WAIT_L(0); PG8_BAR; PG8_MMA(0, 0, At, B0); PG8_MMA(0, 1, At, B1); PG8_BAR; PG8_SCHED;
            PG8_LDA(At, 1, 1); PG8_STAGE(PG8_SB(1, 0), b3, voffB); PG8_STAGE(PG8_SB(1, 1), b3 + hstep, voffB); PG8_STAGE2(PG8_SA(1, 0), a3, x00, x01);
            PG8_WAIT_V(8); PG8_WAIT_L(0); PG8_BAR; PG8_MMA(1, 0, At, B0); PG8_MMA(1, 1, At, B1); PG8_BAR; PG8_SCHED;
        }
        if (wr == 0) PG8_BAR;
        E(acc, cur, wr, wc, fr, fq);
        if (!has_next) break;
#pragma unroll
        for (int a = 0; a < 2; ++a)
#pragma unroll
            for (int b = 0; b < 2; ++b)
#pragma unroll
                for (int m = 0; m < 4; ++m)
#pragma unroll
                    for (int n = 0; n < 2; ++n) acc[a][b][m][n] = (f32x4){0.f, 0.f, 0.f, 0.f};
        cur = nxt; cA = nA; cB = nB; ++ui;
        if (GATHER) {
#pragma unroll
        for (int _h = 0; _h < 2; ++_h)
#pragma unroll
            for (int _i = 0; _i < 2; ++_i) vA[_h][_i] = vAn[_h][_i]; }
        if (wr == 1) PG8_BAR;
    }
    PG8_WAIT_V(0);
    PG8_BAR;
#undef PG8_SA
#undef PG8_SB
#undef PG8_STAGE
#undef PG8_STAGE2
#undef PG8_LDA
#undef PG8_LDB
#undef PG8_MMA
#undef PG8_WAIT_V
#undef PG8_WAIT_L
#undef PG8_BAR
#undef PG8_SCHED
#undef PG8_AOFFS
}
}

struct XOrder { int G, c, MT, NT;
    __device__ __forceinline__ bool map(int i, int& pm, int& pn) const {
        if ((G & 7) == 0 && (MT & 7) == 0) { const int x = c & 7, r = c >> 3, W = G >> 3, MX = MT >> 3; const int L = i * W + r; if (L >= MX * NT) return false; pm = x * MX + L / NT; pn = L % NT; return true; }
        const int L = i * G + c; if (L >= MT * NT) return false; pm = L / NT; pn = L % NT; return true; } };
struct SchedG1 { XOrder X; __device__ __forceinline__ bool next(int i, Unit& u) const { int pm, pn; if (!X.map(i, pm, pn)) return false; u.pm = pm; u.pn = pn; u.e = 0; u.aux = 0; return true; }
    __device__ __forceinline__ int arow(const Unit&, int) const { return 0; } };
struct SchedG2 { XOrder X; __device__ __forceinline__ bool next(int i, Unit& u) const { int pm, q; if (!X.map(i, pm, q)) return false; const int k = q >> 2, pnn = q & 3;
        u.pm = k * (T / 256) + pm; u.pn = k * 4 + pnn; u.e = k; u.aux = pnn; return true; }
    __device__ __forceinline__ int arow(const Unit&, int) const { return 0; } };
struct SchedMN { XOrder X; __device__ __forceinline__ bool next(int i, Unit& u) const { int pm, pn; if (!X.map(i, pm, pn)) return false; u.pm = pm; u.pn = pn; u.e = 0; u.aux = 0; return true; }
    __device__ __forceinline__ int arow(const Unit&, int) const { return 0; } };

struct EpiBf16Plain {
    static constexpr bool PERM = true;
    bf16_t* O; int ldc; int coltile_mask;
    __device__ __forceinline__ void operator()(const f32x4 (&acc)[2][2][4][2], const Unit& u, int wr, int wc, int fr, int fq) const {
        const int row0 = u.pm * 256 + wr * 64 + fr, col0 = (u.pn & coltile_mask) * 256 + wc * 32 + 8 * fq;
#pragma unroll
        for (int ai = 0; ai < 2; ++ai)
#pragma unroll
            for (int m = 0; m < 4; ++m) { bf16_t* rowp = O + (size_t)(row0 + ai * 128 + m * 16) * ldc + col0;
#pragma unroll
                for (int bj = 0; bj < 2; ++bj) { const f32x4 v0 = acc[ai][bj][m][0], v1 = acc[ai][bj][m][1];
                    u32x4 w; w.x = pack2(v0[0], v0[1]); w.y = pack2(v0[2], v0[3]); w.z = pack2(v1[0], v1[1]); w.w = pack2(v1[2], v1[3]);
                    *(u32x4*)(rowp + bj * 128) = w; } }
    }
};
struct EpiP {
    static constexpr bool PERM = true;
    bf16_t* P; const float* ssq;
    __device__ __forceinline__ void operator()(const f32x4 (&acc)[2][2][4][2], const Unit& u, int wr, int wc, int fr, int fq) const {
        const int k = u.e; const int pmt = u.pm - k * (T / 256);
        const unsigned c00 = (unsigned)(u.aux * 256 + wc * 32 + 8 * fq);
        const unsigned base = (unsigned)pmt * (16u * 256u * 256u) + (unsigned)k * 64u;
#pragma unroll
        for (int ai = 0; ai < 2; ++ai)
#pragma unroll
            for (int m = 0; m < 4; ++m) { const int r = ai * 128 + wr * 64 + m * 16 + fr; float sc = 1.0f;
                if (k == 3) { const float* qp = ssq + (size_t)(pmt * 256 + r) * 4; sc = rsqrtf((qp[0] + qp[1] + qp[2] + qp[3]) * (1.0f / 256.0f) + kconst(RMS_EPS)); }
#pragma unroll
                for (int bj = 0; bj < 2; ++bj) { const unsigned c0 = c00 + bj * 128; const unsigned s = c0 >> 6, wi = c0 & 63;
                    const f32x4 v0 = acc[ai][bj][m][0] * sc, v1 = acc[ai][bj][m][1] * sc;
                    u32x4 w; w.x = pack2(v0[0], v0[1]); w.y = pack2(v0[2], v0[3]); w.z = pack2(v1[0], v1[1]); w.w = pack2(v1[2], v1[3]);
                    *(u32x4*)(P + (base + (s * 256u + (unsigned)r) * 256u + wi)) = w; }
                asm volatile("" ::: "memory"); }
    }
};
struct EpiMerge {
    static constexpr bool PERM = false;
    const bf16_t* P; const float* bgp; bf16_t* Y;
    __device__ __forceinline__ void operator()(const f32x4 (&acc)[2][2][4][2], const Unit& u, int wr, int wc, int fr, int fq) const {
        const int s = u.pn;
        f32x4 bv[2][2];
#pragma unroll
        for (int bj = 0; bj < 2; ++bj)
#pragma unroll
            for (int n = 0; n < 2; ++n) bv[bj][n] = *(const f32x4*)(bgp + s * 256 + bj * 128 + wc * 32 + n * 16 + 4 * fq);
#pragma unroll
        for (int ai = 0; ai < 2; ++ai)
#pragma unroll
            for (int m = 0; m < 4; ++m) { const int r = ai * 128 + wr * 64 + m * 16 + fr;
                const bf16_t* pp = P + (((size_t)u.pm * 16 + s) * 256 + r) * 256 + wc * 16 + 4 * fq;
                f32x4 y = (f32x4){0.f, 0.f, 0.f, 0.f};
#pragma unroll
                for (int bj = 0; bj < 2; ++bj)
#pragma unroll
                    for (int n = 0; n < 2; ++n) { const int k = 2 * bj + n; const u32x2 pw = *(const u32x2*)(pp + k * 64);
                        const f32x4 g = acc[ai][bj][m][n] + bv[bj][n];
                        y[0] += sigmoidf_(g[0]) * __uint_as_float(pw.x << 16); y[1] += sigmoidf_(g[1]) * __uint_as_float(pw.x & 0xffff0000u);
                        y[2] += sigmoidf_(g[2]) * __uint_as_float(pw.y << 16); y[3] += sigmoidf_(g[3]) * __uint_as_float(pw.y & 0xffff0000u); }
                u32x2 w; w.x = pack2(y[0], y[1]); w.y = pack2(y[2], y[3]);
                *(u32x2*)(Y + (size_t)(u.pm * 256 + r) * D + s * 64 + wc * 16 + 4 * fq) = w; }
    }
};
struct EpiWo {
    static constexpr bool PERM = false;
    Ptrs P; int layer;
    __device__ __forceinline__ void operator()(const f32x4 (&acc)[2][2][4][2], const Unit& u, int wr, int wc, int fr, int fq) const {
        const int col0 = u.pn * 256 + wc * 32 + 4 * fq;
#pragma unroll
        for (int ai = 0; ai < 2; ++ai)
#pragma unroll
            for (int m = 0; m < 4; ++m) { const int row = u.pm * 256 + ai * 128 + wr * 64 + m * 16 + fr;
                float* lp = P.latrow(row) + col0; const float* g1 = P.mod(layer, row_modidx(row)) + 2048 + col0;
#pragma unroll
                for (int bj = 0; bj < 2; ++bj)
#pragma unroll
                    for (int n = 0; n < 2; ++n) { const f32x4 x = *(const f32x4*)(lp + bj * 128 + n * 16); const f32x4 g = *(const f32x4*)(g1 + bj * 128 + n * 16);
                        *(f32x4*)(lp + bj * 128 + n * 16) = x * ALPHA + g * acc[ai][bj][m][n]; } }
    }
};
struct EpiFfn1 {
    static constexpr bool PERM = false;
    bf16_t* H;
    __device__ __forceinline__ void operator()(const f32x4 (&acc)[2][2][4][2], const Unit& u, int wr, int wc, int fr, int fq) const {
        const int pnn = u.pn & 3;
#pragma unroll
        for (int ai = 0; ai < 2; ++ai)
#pragma unroll
            for (int m = 0; m < 4; ++m) { const int pos = u.pm * 256 + ai * 128 + wr * 64 + m * 16 + fr;
#pragma unroll
                for (int bj = 0; bj < 2; ++bj) { const f32x4 a = acc[ai][bj][m][0], b = acc[ai][bj][m][1];
                    u32x2 w; w.x = pack2(siluf_(a[0]) * b[0], siluf_(a[1]) * b[1]); w.y = pack2(siluf_(a[2]) * b[2], siluf_(a[3]) * b[3]);
                    *(u32x2*)(H + (size_t)pos * 512 + pnn * 128 + bj * 64 + wc * 16 + 4 * fq) = w; } }
    }
};

template <class SrcFn>
__device__ __forceinline__ void conv_tile(int tid, LAS float* tile  , bf16_t* dst, int ldd, int n0, int k0, const SrcFn& src) {
    f32x4 v[8];
#pragma unroll
    for (int i = 0; i < 8; ++i) { const int kk = (tid >> 4) + 32 * i, j4 = tid & 15; v[i] = *(const f32x4*)src(k0 + kk, n0 + 4 * j4); }
#pragma unroll
    for (int i = 0; i < 8; ++i) { const int kk = (tid >> 4) + 32 * i, j4 = tid & 15; LAS float* t = tile + kk * 65 + 4 * j4; t[0] = v[i][0]; t[1] = v[i][1]; t[2] = v[i][2]; t[3] = v[i][3]; }
    __syncthreads();
    { const int jj = tid >> 3, kq = tid & 7;
#pragma unroll
      for (int kb = 0; kb < 4; ++kb) { float x[8];
#pragma unroll
          for (int i = 0; i < 8; ++i) x[i] = tile[(64 * kb + 8 * kq + i) * 65 + jj];
          u32x4 w; w.x = pack2(x[0], x[1]); w.y = pack2(x[2], x[3]); w.z = pack2(x[4], x[5]); w.w = pack2(x[6], x[7]);
          *(u32x4*)(dst + (size_t)(n0 + jj) * ldd + k0 + 64 * kb + 8 * kq) = w; } }
    __syncthreads();
}
constexpr int NCONV_NE = 56 * 4 + 64 * 4 + 64 * 1 + 16 * 4;
constexpr int NCONV_EX = NE * (16 * 4 + 16 * 2);
__device__ __forceinline__ int gate_srccol(int np) { const int s = np >> 8, bj = (np >> 7) & 1, wc = (np >> 5) & 3, n = (np >> 4) & 1, fqe = np & 15; return (2 * bj + n) * 1024 + 64 * s + 16 * wc + fqe; }
__device__ __forceinline__ void conv_unit_ne(const Ptrs P, int l, int t, LAS float* tile) {
    unsigned char* ws = P.ws;
    if (t < 224) { const int nt = t >> 2, kt = t & 3; const float* src = P.inp(I_WIN) + (size_t)l * D * INC;
        conv_tile(P.tid, tile, (bf16_t*)(ws + WS_WIN), D, nt * 64, kt * 256, [=](int k, int n) { return src + (size_t)k * INC + n; });
    } else if (t < 224 + 256) { t -= 224; const int nt = t >> 2, kt = t & 3; const float* src = P.inp(I_WGATE) + (size_t)l * D * 4096;
        conv_tile(P.tid, tile, (bf16_t*)(ws + WS_WG), D, nt * 64, kt * 256, [=](int k, int n) { return src + (size_t)k * 4096 + gate_srccol(n); });
        if (kt == 0 && P.tid < 64) { const int np = nt * 64 + P.tid; ((float*)(ws + WS_BGP))[np] = P.inp(I_BGATE)[(size_t)l * 4096 + gate_srccol(np)]; }
    } else if (t < 224 + 256 + 64) { t -= 480; const int nt = t; const int kb = nt >> 4;
        const float* src = P.inp(I_WBR) + ((size_t)l * 4 + kb) * 256 * 1024;
        conv_tile(P.tid, tile, (bf16_t*)(ws + WS_WBR), 256, nt * 64, 0, [=](int k, int n) { return src + (size_t)k * 1024 + (n & 1023); });
    } else { t -= 544; const int nt = t >> 2, kt = t & 3; const float* src = P.inp(I_WO) + (size_t)l * D * D;
        conv_tile(P.tid, tile, (bf16_t*)(ws + WS_WO), D, nt * 64, kt * 256, [=](int k, int n) { return src + (size_t)k * D + n; });
    }
}
__device__ __forceinline__ void conv_unit_ex(const Ptrs P, int l, int t, LAS float* tile) {
    unsigned char* ws = P.ws;
    const int e = t / 96; t -= e * 96;
    if (t < 64) { const int nt = t >> 2, kt = t & 3;
        const float* s1 = P.inp(I_WE1) + ((size_t)l * NE + e) * 1024 * 512; const float* s3 = P.inp(I_WE3) + ((size_t)l * NE + e) * 1024 * 512;
        conv_tile(P.tid, tile, (bf16_t*)(ws + WS_BIG + BIG_W13) + (size_t)e * 1024 * 1024, 1024, nt * 64, kt * 256, [=](int k, int n) {
            const int pn = n >> 8, bj = (n >> 7) & 1, wc = (n >> 5) & 3, nn = (n >> 4) & 1, fqe = n & 15; const int ch = 128 * pn + 64 * bj + 16 * wc + fqe;
            return (nn ? s3 : s1) + (size_t)k * 512 + ch; });
    } else { t -= 64; const int nt = t >> 1, kt = t & 1; const float* src = P.inp(I_WE2) + ((size_t)l * NE + e) * 512 * 1024;
        conv_tile(P.tid, tile, (bf16_t*)(ws + WS_BIG + BIG_W2) + (size_t)e * 1024 * 512, 512, nt * 64, kt * 256, [=](int k, int n) { return src + (size_t)k * 1024 + n; });
    }
}

struct RowV { f32x4 v[4]; };
__device__ __forceinline__ void row_load(RowV& r, const float* p, int lane) {
#pragma unroll
    for (int i = 0; i < 4; ++i) r.v[i] = *(const f32x4*)(p + i * 256 + lane * 4);
}
__device__ __forceinline__ void row_store(const RowV& r, float* p, int lane) {
#pragma unroll
    for (int i = 0; i < 4; ++i) *(f32x4*)(p + i * 256 + lane * 4) = r.v[i];
}
__device__ __forceinline__ void row_layernorm(RowV& r, const float* g, const float* b, int lane) {
    float s = 0.f;
#pragma unroll
    for (int i = 0; i < 4; ++i) s += r.v[i][0] + r.v[i][1] + r.v[i][2] + r.v[i][3];
    const float mu = wave_sum(s) * (1.0f / 1024.0f);
    float q = 0.f;
#pragma unroll
    for (int i = 0; i < 4; ++i) { const f32x4 d = r.v[i] - mu; q += d[0] * d[0] + d[1] * d[1] + d[2] * d[2] + d[3] * d[3]; }
    const float rstd = rsqrtf(wave_sum(q) * (1.0f / 1024.0f) + kconst(LN_EPS));
#pragma unroll
    for (int i = 0; i < 4; ++i) { const f32x4 gg = *(const f32x4*)(g + i * 256 + lane * 4), bb = *(const f32x4*)(b + i * 256 + lane * 4); r.v[i] = (r.v[i] - mu) * rstd * gg + bb; }
}
__device__ __forceinline__ void row_layernorm_r(RowV& r, const RowV& g, const RowV& b) {
    float s = 0.f;
#pragma unroll
    for (int i = 0; i < 4; ++i) s += r.v[i][0] + r.v[i][1] + r.v[i][2] + r.v[i][3];
    const float mu = wave_sum(s) * (1.0f / 1024.0f);
    float q = 0.f;
#pragma unroll
    for (int i = 0; i < 4; ++i) { const f32x4 d = r.v[i] - mu; q += d[0] * d[0] + d[1] * d[1] + d[2] * d[2] + d[3] * d[3]; }
    const float rstd = rsqrtf(wave_sum(q) * (1.0f / 1024.0f) + kconst(LN_EPS));
#pragma unroll
    for (int i = 0; i < 4; ++i) r.v[i] = (r.v[i] - mu) * rstd * g.v[i] + b.v[i];
}
__device__ __forceinline__ void row_modulate(const RowV& r, RowV& h, const float* sh, const float* sc, int lane) {
#pragma unroll
    for (int i = 0; i < 4; ++i) { const f32x4 a = *(const f32x4*)(sc + i * 256 + lane * 4), b = *(const f32x4*)(sh + i * 256 + lane * 4); h.v[i] = r.v[i] * (a + 1.0f) + b; }
}
__device__ __forceinline__ void row_modulate_r(const RowV& r, RowV& h, const RowV& sh, const RowV& sc) {
#pragma unroll
    for (int i = 0; i < 4; ++i) h.v[i] = r.v[i] * (sc.v[i] + 1.0f) + sh.v[i];
}
__device__ __forceinline__ void row_store_bf16(const RowV& h, bf16_t* p, int lane) {
#pragma unroll
    for (int i = 0; i < 4; ++i) { u32x2 w; w.x = pack2(h.v[i][0], h.v[i][1]); w.y = pack2(h.v[i][2], h.v[i][3]); *(u32x2*)(p + i * 256 + lane * 4) = w; }
}
__device__ __forceinline__ void row_dt(const RowV& h, const LAS float* wdt, float* dtout, int lane) {
    float a[8];
#pragma unroll
    for (int j = 0; j < 8; ++j) a[j] = 0.f;
#pragma unroll
    for (int i = 0; i < 4; ++i)
#pragma unroll
        for (int e = 0; e < 4; ++e) { const int k = i * 256 + lane * 4 + e; const float hv = h.v[i][e];
            const f32x4 w0 = *(const LAS f32x4*)(wdt + k * 8), w1 = *(const LAS f32x4*)(wdt + k * 8 + 4);
            a[0] += hv * w0[0]; a[1] += hv * w0[1]; a[2] += hv * w0[2]; a[3] += hv * w0[3]; a[4] += hv * w1[0]; a[5] += hv * w1[1]; a[6] += hv * w1[2]; a[7] += hv * w1[3]; }
#pragma unroll
    for (int j = 0; j < 8; ++j) a[j] = wave_sum(a[j]);
    if (lane == 0) { *(f32x4*)dtout = (f32x4){a[0], a[1], a[2], a[3]}; *(f32x4*)(dtout + 4) = (f32x4){a[4], a[5], a[6], a[7]}; }
}
__device__ __forceinline__ void load_wdt(const Ptrs P, int l, LAS float* wdt) {
    const float* src = P.inp(I_WIN) + (size_t)l * D * INC + UC;
    for (int i = P.tid; i < 1024 * 8; i += 512) wdt[i] = src[(size_t)(i >> 3) * INC + (i & 7)];
    __syncthreads();
}

__device__ __forceinline__ void phase_pa(const Ptrs P, LAS unsigned char* lds) {
    const int tid = P.tid, wid = tid >> 6, lane = tid & 63, G = P.G;
    const int NU_MOD = 2 * 96, NU_H2 = 8448 / 8, NU_LB = 1;
    const int NU = NU_MOD + NU_H2 + NU_LB + NCONV_NE;
    for (int u = P.bid; u < NU; u += G) {
        if (u < NU_MOD) {
            const int l = u / 96, cb = u % 96;
            LAS float* sc = (LAS float*)lds; LAS float* red = sc + 9 * 1024;
            for (int i = tid; i < 9 * 1024; i += 512) { const int r = i >> 10, k = i & 1023; const float v = r < 8 ? P.inp(I_C)[r * 1024 + k] : P.inp(I_CCTX)[k]; sc[i] = v / (1.0f + fexp(-v)); }
            __syncthreads();
            const int col = cb * 64 + lane; const float* w = P.inp(I_WADA) + (size_t)l * D * 6144 + col;
            float acc[9];
#pragma unroll
            for (int r = 0; r < 9; ++r) acc[r] = 0.f;
            for (int k = wid * 128; k < wid * 128 + 128; ++k) { const float wv = w[(size_t)k * 6144];
#pragma unroll
                for (int r = 0; r < 9; ++r) acc[r] += sc[r * 1024 + k] * wv; }
#pragma unroll
            for (int r = 0; r < 9; ++r) red[(wid * 9 + r) * 64 + lane] = acc[r];
            __syncthreads();
            for (int i = tid; i < 9 * 64; i += 512) { const int r = i >> 6, c = i & 63; float s = P.inp(I_BADA)[(size_t)l * 6144 + cb * 64 + c];
#pragma unroll
                for (int w8 = 0; w8 < 8; ++w8) s += red[(w8 * 9 + r) * 64 + c];
                P.mod(l, r)[cb * 64 + c] = s; }
            __syncthreads();
        } else if (u < NU_MOD + NU_H2) {
            const int rho = (u - NU_MOD) * 8 + wid;
            const int l = (rho >= 4096 && rho < 8192) ? 1 : 0; const int L = rho < 8192 ? 4096 : 256; const int i = rho < 8192 ? (rho & 4095) : (rho - 8192);
            float featv = 0.f;
            if (lane == 0) featv = (float)((double)i / (double)(L - 1));
            else if (lane < 33) { const int j = (lane - 1) & 15; const double band = 1e-4 + (double)j * ((15.0 - 1e-4) / 15.0);
                const double ang = (2.0 * 3.14159265358979323846 / (double)L) * (double)i * band; featv = lane < 17 ? (float)cos(ang) : (float)(-sin(ang)); }
            float z1 = P.inp(I_HYB1)[l * 64 + lane];
            for (int m = 0; m < 33; ++m) z1 += __shfl(featv, m) * P.inp(I_HYW1)[((size_t)l * 33 + m) * 64 + lane];
            const float h1 = sinf(P.inp(I_HYF1)[l * 64 + lane] * z1);
            float z2 = P.inp(I_HYB2)[l * 64 + lane];
            for (int m = 0; m < 64; ++m) z2 += __shfl(h1, m) * P.inp(I_HYW2)[((size_t)l * 64 + m) * 64 + lane];
            ((float*)(P.ws + WS_H2TAB))[(size_t)rho * 64 + lane] = sinf(P.inp(I_HYF2)[l * 64 + lane] * z2);
        } else if (u < NU_MOD + NU_H2 + NU_LB) {
            for (int i = tid; i < 4096; i += 512) { const double a = -2.0 * 3.14159265358979323846 * (double)i / 8192.0; ((float*)(P.ws + WS_TW))[2 * i] = (float)cos(a); ((float*)(P.ws + WS_TW))[2 * i + 1] = (float)sin(a); }
            for (int i = tid; i < 1024; i += 512) { const int d = i >> 9, l = (i >> 8) & 1, c = i & 255;
                const float l0 = P.inp(I_HGLB)[d * 512 + c], l1 = P.inp(I_HGLB)[d * 512 + 256 + c];
                ((float*)(P.ws + WS_LB))[i] = l == 0 ? 0.0f : 1.0f / (1.0f + fexp(l0 - l1)); }
        } else {
            conv_unit_ne(P, 0, u - (NU_MOD + NU_H2 + NU_LB), (LAS float*)lds);
        }
    }
}

__device__ __forceinline__ void emit_rows_init(const Ptrs P, LAS float* wdt);
__device__ __forceinline__ void phase_pb(const Ptrs P, LAS unsigned char* lds) {
    const int tid = P.tid, G = P.G;
    for (int u = P.bid; u < 132; u += G) {
        const int tab = u < 64 ? 0 : (u < 128 ? 1 : 2); const int ib = tab == 0 ? u : (tab == 1 ? u - 64 : u - 128);
        const int l = tab == 1 ? 1 : 0; const int L = tab == 2 ? 256 : 4096; const int rho0 = (tab == 0 ? 0 : (tab == 1 ? 4096 : 8192)) + ib * 64;
        LAS float* h2 = (LAS float*)lds;
        for (int i = tid; i < 64 * 64; i += 512) h2[i] = ((const float*)(P.ws + WS_H2TAB))[(size_t)rho0 * 64 + i];
        __syncthreads();
        const int o = tid, c = tid & 255, dir = tid >> 8;
        float w3[64];
#pragma unroll
        for (int j = 0; j < 64; ++j) w3[j] = P.inp(I_HYW3)[((size_t)l * 64 + j) * 512 + o];
        const float dec = fabsf(P.inp(I_HYDEC)[l * 256 + c]);
        float* filt = tab == 2 ? (float*)(P.ws + WS_FILTC) : (float*)(P.ws + WS_FILT) + (size_t)l * 8192 * 256;
        const int L2 = 2 * L; float part = 0.f;
        for (int r = 0; r < 64; ++r) { const int i = ib * 64 + r; float s = 0.f;
#pragma unroll
            for (int j = 0; j < 64; ++j) s += h2[r * 64 + j] * w3[j];
            const float t = (float)i / (float)(L - 1); s *= fexp(-t * dec);
            if (dir == 0) { filt[(size_t)i * 256 + c] = s; part += fabsf(s); }
            else if (i == 0) filt[(size_t)L * 256 + c] = 0.f;
            else { filt[(size_t)(L2 - i) * 256 + c] = s; part += fabsf(s); } }
        ((float*)(P.ws + WS_PART))[((size_t)tab * 64 + ib) * 512 + o] = part;
        __syncthreads();
    }
    emit_rows_init(P, (LAS float*)lds);
}
__device__ __forceinline__ float hy_norm(const Ptrs P, int tab, int c) {
    const float* part = (const float*)(P.ws + WS_PART) + (size_t)tab * 64 * 512; const int nb = tab == 2 ? 4 : 64; float s = 0.f;
    for (int b = 0; b < nb; ++b) s += part[b * 512 + c] + part[b * 512 + 256 + c];
    return s;
}

__device__ __forceinline__ void emit_rows_init(const Ptrs P, LAS float* wdt) {
    const int tid = P.tid, wid = tid >> 6, lane = tid & 63, G = P.G;
    load_wdt(P, 0, wdt);
    LAS float* tabA = wdt + 1024 * 8; LAS float* tabB = tabA + 8 * 256 * 2;
    for (int i = tid; i < 2 * 8 * 256; i += 512) { const int tb = i >> 11, a = (i >> 8) & 7, ii = i & 255; const float om = fexp(-9.210340371976184f * (float)ii * (1.0f / 256.0f)); const float ang = (float)(tb ? a : 8 * a) * om;
        LAS float* t = (tb ? tabB : tabA) + (a * 256 + ii) * 2; t[0] = sinf(ang); t[1] = cosf(ang); }
    __syncthreads();
    const float* xin = P.inp(I_X); const float* cin = P.inp(I_CTX);
    RowV msh, msc; { const float z = zero_f(); for (int i = 0; i < 4; ++i) { msh.v[i] = (f32x4){z, z, z, z}; msc.v[i] = msh.v[i]; } } int mcur = -1;
    RowV rn; { const float z = zero_f(); for (int i = 0; i < 4; ++i) rn.v[i] = (f32x4){z, z, z, z}; } if (P.bid < T / 8) { const int rw = P.bid * 8 + wid; row_load(rn, rw < NLAT ? xin + (size_t)rw * D : cin + (size_t)(rw - NLAT) * D, lane); }
    for (int u = P.bid; u < T / 8; u += G) {
        const int row = u * 8 + wid; RowV r = rn;
        if (u + G < T / 8) { const int rw = (u + G) * 8 + wid; row_load(rn, rw < NLAT ? xin + (size_t)rw * D : cin + (size_t)(rw - NLAT) * D, lane); }
        if (row < NLAT) {
            const int t = row & 4095; const int prow = t >> 6, pcol = t & 63;
#pragma unroll
            for (int hf = 0; hf < 2; ++hf) { const int pos = hf ? pcol : prow; const LAS float* pa = tabA + ((pos >> 3) * 256 + lane * 4) * 2; const LAS float* pb = tabB + ((pos & 7) * 256 + lane * 4) * 2;
                const f32x4 a0 = *(const LAS f32x4*)pa, a1 = *(const LAS f32x4*)(pa + 4), b0 = *(const LAS f32x4*)pb, b1 = *(const LAS f32x4*)(pb + 4);
                f32x4 sn, cs;
                sn[0] = a0[0] * b0[1] + a0[1] * b0[0]; cs[0] = a0[1] * b0[1] - a0[0] * b0[0]; sn[1] = a0[2] * b0[3] + a0[3] * b0[2]; cs[1] = a0[3] * b0[3] - a0[2] * b0[2];
                sn[2] = a1[0] * b1[1] + a1[1] * b1[0]; cs[2] = a1[1] * b1[1] - a1[0] * b1[0]; sn[3] = a1[2] * b1[3] + a1[3] * b1[2]; cs[3] = a1[3] * b1[3] - a1[2] * b1[2];
                r.v[2 * hf] += sn; r.v[2 * hf + 1] += cs; }
        }
        row_store(r, P.latrow(row), lane);
        const int mi = row_modidx(row); if (mi != mcur) { mcur = mi; const float* m = P.mod(0, mi); row_load(msh, m, lane); row_load(msc, m + 1024, lane); }
        RowV h; row_modulate_r(r, h, msh, msc);
        row_store_bf16(h, (bf16_t*)(P.ws + WS_HBUF) + (size_t)row * D, lane);
        row_dt(h, wdt, (float*)(P.ws + WS_DT) + (size_t)row * 8, lane);
    }
}

__device__ __forceinline__ void phase_g1(const Ptrs P, LAS unsigned char* lds) {
    pg8::Gemm g{(const bf16_t*)(P.ws + WS_HBUF), (const bf16_t*)(P.ws + WS_WIN), D};
    EpiBf16Plain E{(bf16_t*)(P.ws + WS_BIG + BIG_U), UC, 0xffff};
    SchedG1 S{XOrder{P.G, P.bid, T / 256, 14}};
    pg8::gemm_phase<EpiBf16Plain, SchedG1, false>(P.tid, lds, g, S, E);
}

constexpr int NCHK = 34;
__device__ __forceinline__ int chunk_row0(int b, int pc) { return pc < 2 ? NLAT + b * CTXL + pc * 128 : b * SEQ + (pc - 2) * 128; }
__device__ __forceinline__ int chunk_at(int dir, int q) { return dir == 0 ? q : (q < 2 ? 1 - q : 35 - q); }
__device__ __forceinline__ int sidx(int kind, int b, int h, int dir, int pc) { return (((kind * 8 + b) * 4 + h) * 2 + dir) * NCHK + pc; }
__device__ __forceinline__ bf16x8 pack8(const float (&v)[8]) { u32x4 w; w.x = pack2(v[0], v[1]); w.y = pack2(v[2], v[3]); w.z = pack2(v[4], v[5]); w.w = pack2(v[6], v[7]); return __builtin_bit_cast(bf16x8, w); }
__device__ __forceinline__ float softplusf_(float x) { return x > 20.f ? x : flog(1.0f + fexp(x)); }
__device__ __forceinline__ float wave_incl_scan(float v, int lane) {
#pragma unroll
    for (int d = 1; d < 64; d <<= 1) { const float t = __shfl_up(v, d); if (lane >= d) v += t; }
    return v;
}

template <bool SILU>
__device__ __forceinline__ void conv3_8(const bf16_t* U, int row, int col0, const float* w, int ncol, int wcol0, const float* bias, float (&out)[8]) {
    const bool hp = row_has_prev(row), hn = row_has_next(row);
    const bf16x8 c = *(const bf16x8*)(U + (size_t)row * UC + col0);
    const bf16x8 p = *(const bf16x8*)(U + (size_t)(hp ? row - 1 : row) * UC + col0), n = *(const bf16x8*)(U + (size_t)(hn ? row + 1 : row) * UC + col0);
    const float mp = hp ? 1.0f : 0.0f, mn = hn ? 1.0f : 0.0f;
#pragma unroll
    for (int h4 = 0; h4 < 2; ++h4) { const f32x4 w0 = *(const f32x4*)(w + wcol0 + 4 * h4), w1 = *(const f32x4*)(w + ncol + wcol0 + 4 * h4), w2 = *(const f32x4*)(w + 2 * ncol + wcol0 + 4 * h4), bb = *(const f32x4*)(bias + wcol0 + 4 * h4);
#pragma unroll
        for (int e = 0; e < 4; ++e) { const int i = 4 * h4 + e; const float v = bf2f((bf16_t)c[i]) * w1[e] + mp * bf2f((bf16_t)p[i]) * w0[e] + mn * bf2f((bf16_t)n[i]) * w2[e] + bb[e]; out[i] = SILU ? siluf_(v) : v; } }
}
__device__ __forceinline__ void conv3_silu8(const bf16_t* U, int row, int col0, const float* w, int ncol, int wcol0, const float* bias, float (&out)[8]) { conv3_8<true>(U, row, col0, w, ncol, wcol0, bias, out); }
__device__ __forceinline__ void conv16_silu(const bf16_t* U, int r0, int col, const float* w, int ncol, int wcol, float bias, float (&out)[16]) {
    const bool hp = row_has_prev(r0), hn = row_has_next(r0 + 15);
    float x[18];
#pragma unroll
    for (int i = 0; i < 18; ++i) { const int r = (i == 0 && !hp) ? r0 : ((i == 17 && !hn) ? r0 + 15 : r0 - 1 + i); x[i] = bf2f(U[(size_t)r * UC + col]); }
    if (!hp) x[0] = 0.f; if (!hn) x[17] = 0.f;
    const float w0 = w[wcol], w1 = w[ncol + wcol], w2 = w[2 * ncol + wcol];
#pragma unroll
    for (int j = 0; j < 16; ++j) out[j] = siluf_(x[j] * w0 + x[j + 1] * w1 + x[j + 2] * w2 + bias);
}
__device__ __forceinline__ void store16_bf16(LAS bf16_t* dst, const float (&v)[16]) {
    u32x4 a, b; a.x = pack2(v[0], v[1]); a.y = pack2(v[2], v[3]); a.z = pack2(v[4], v[5]); a.w = pack2(v[6], v[7]); b.x = pack2(v[8], v[9]); b.y = pack2(v[10], v[11]); b.z = pack2(v[12], v[13]); b.w = pack2(v[14], v[15]);
    *(LAS u32x4*)dst = a; *(LAS u32x4*)(dst + 8) = b;
}

__device__ __forceinline__ void scatter8_T(LAS bf16_t* dstT, int g8, int p, const float (&v)[8]) {
#pragma unroll
    for (int e2 = 0; e2 < 4; ++e2) { const unsigned w = pack2(v[2 * e2], v[2 * e2 + 1]); dstT[(8 * g8 + 2 * e2) * 136 + p] = (bf16_t)(w & 0xffffu); dstT[(8 * g8 + 2 * e2 + 1) * 136 + p] = (bf16_t)(w >> 16); }
}

__device__ __forceinline__ void hgrn_pass1(const Ptrs P, int l, int unit, LAS unsigned char* lds) {
    const int tid = P.tid, lane = tid & 63, wid = tid >> 6, fr = lane & 15, fq = lane >> 4;
    const int pc = unit % NCHK; const int r_ = unit / NCHK; const int h = r_ & 3; const int b = r_ >> 2;
    const int row0 = chunk_row0(b, pc);
    const bf16_t* U = (const bf16_t*)(P.ws + WS_BIG + BIG_U);
    LAS bf16_t* KTF = (LAS bf16_t*)lds; LAS bf16_t* KTB = KTF + 64 * 136; LAS bf16_t* VT = KTB + 64 * 136; LAS float* segtot = (LAS float*)(VT + 64 * 136);
    LAS bf16_t* FS = (LAS bf16_t*)(lds + 65536);
    for (int it = tid; it < 128 * 8; it += 512) { const int p = it >> 3, g8 = it & 7; const bf16_t* ur = U + (size_t)(row0 + p) * UC + h * 64 + 8 * g8;
        const bf16x8 ff8 = *(const bf16x8*)(ur + 1792), fb8 = *(const bf16x8*)(ur + 2048), v8 = *(const bf16x8*)(ur + 2304);
        *(LAS bf16x8*)(FS + p * 64 + 8 * g8) = ff8; *(LAS bf16x8*)(FS + 8192 + p * 64 + 8 * g8) = fb8;
#pragma unroll
        for (int e = 0; e < 8; ++e) VT[(8 * g8 + e) * 136 + p] = (bf16_t)v8[e]; }
    __syncthreads();
    const int ch = lane, seg = wid;
    const float lbf = ((const float*)(P.ws + WS_LB))[(0 * 2 + l) * 256 + h * 64 + ch], lbb = ((const float*)(P.ws + WS_LB))[(1 * 2 + l) * 256 + h * 64 + ch];
    float cf[16], cb[16], kf[16], kb[16]; float runf = 0.f, runb = 0.f;
#pragma unroll
    for (int j = 0; j < 16; ++j) { const int p = 16 * seg + j;
        const float ff = lbf + (1.0f - lbf) * sigmoidf_(bf2f(FS[p * 64 + ch])), fb = lbb + (1.0f - lbb) * sigmoidf_(bf2f(FS[8192 + p * 64 + ch]));
        runf += flog(ff); cf[j] = runf; kf[j] = 1.0f - ff; cb[j] = runb; runb += flog(fb); kb[j] = 1.0f - fb; }
    segtot[seg * 64 + ch] = runf; segtot[512 + seg * 64 + ch] = runb; __syncthreads();
    float offf = 0.f, totf = 0.f, offb = 0.f, totb = 0.f;
#pragma unroll
    for (int s = 0; s < 8; ++s) { const float a = segtot[s * 64 + ch], c = segtot[512 + s * 64 + ch]; totf += a; totb += c; offf += (s < seg) ? a : 0.f; offb += (s < seg) ? c : 0.f; }
    { float t[16];
#pragma unroll
      for (int j = 0; j < 16; ++j) t[j] = kf[j] * fexp(totf - offf - cf[j]);
      store16_bf16(KTF + ch * 136 + 16 * seg, t);
#pragma unroll
      for (int j = 0; j < 16; ++j) t[j] = kb[j] * fexp(offb + cb[j]);
      store16_bf16(KTB + ch * 136 + 16 * seg, t); }
    const int sif = sidx(0, b, h, 0, pc), sib = sidx(0, b, h, 1, pc);
    if (seg == 0) { ((float*)(P.ws + WS_DEC))[(size_t)sif * 64 + ch] = fexp(totf); ((float*)(P.ws + WS_DEC))[(size_t)sib * 64 + ch] = fexp(totb); }
    __syncthreads();
    const int mt = wid >> 1, nt0 = (wid & 1) * 2;
    f32x4 af[2], ab[2]; af[0] = (f32x4){0.f, 0.f, 0.f, 0.f}; af[1] = af[0]; ab[0] = af[0]; ab[1] = af[0];
#pragma unroll
    for (int ks = 0; ks < 4; ++ks) { const bf16x8 a0 = *(const LAS bf16x8*)(KTF + (16 * mt + fr) * 136 + 32 * ks + 8 * fq), a1 = *(const LAS bf16x8*)(KTB + (16 * mt + fr) * 136 + 32 * ks + 8 * fq);
#pragma unroll
        for (int n = 0; n < 2; ++n) { const bf16x8 bb = *(const LAS bf16x8*)(VT + (16 * (nt0 + n) + fr) * 136 + 32 * ks + 8 * fq);
            af[n] = __builtin_amdgcn_mfma_f32_16x16x32_bf16(a0, bb, af[n], 0, 0, 0); ab[n] = __builtin_amdgcn_mfma_f32_16x16x32_bf16(a1, bb, ab[n], 0, 0, 0); } }
    float* SF = (float*)(P.ws + WS_BIG + BIG_STATE) + (size_t)sif * 4096; float* SB = (float*)(P.ws + WS_BIG + BIG_STATE) + (size_t)sib * 4096;
#pragma unroll
    for (int n = 0; n < 2; ++n)
#pragma unroll
        for (int r = 0; r < 4; ++r) { const int o = (16 * mt + 4 * fq + r) * 64 + 16 * (nt0 + n) + fr; SF[o] = af[n][r]; SB[o] = ab[n][r]; }
    __syncthreads();
}

__device__ __forceinline__ void ssd_pass1(const Ptrs P, int l, int unit, LAS unsigned char* lds) {
    const int tid = P.tid, lane = tid & 63, wid = tid >> 6, fr = lane & 15, fq = lane >> 4;
    const int pc = unit % NCHK; const int r_ = unit / NCHK; const int g = r_ & 1; const int b = r_ >> 1;
    const int row0 = chunk_row0(b, pc);
    const bf16_t* U = (const bf16_t*)(P.ws + WS_BIG + BIG_U);
    const float* scw = P.inp(I_SSDCW) + (size_t)l * 3 * 512; const float* scb = P.inp(I_SSDCB) + l * 512;
    LAS bf16_t* BT = (LAS bf16_t*)lds; LAS bf16_t* XT = BT + 64 * 136;
    LAS float* wgt = (LAS float*)(XT + 4 * 64 * 136);
    if (wid < 4) {
        const int hh = 2 * g + (wid >> 1), dir = wid & 1;
        const float Aneg = -fexp(P.inp(I_SSDALOG)[(l * 2 + dir) * 4 + hh]); const float dtb = P.inp(I_SSDDTB)[(l * 2 + dir) * 4 + hh]; const float* DT = (const float*)(P.ws + WS_DT);
        const int p0 = 2 * lane; const float d0 = softplusf_(DT[(size_t)(row0 + p0) * 8 + dir * 4 + hh] + dtb), d1 = softplusf_(DT[(size_t)(row0 + p0 + 1) * 8 + dir * 4 + hh] + dtb);
        const float a0 = Aneg * d0, a1 = Aneg * d1; const float inc = wave_incl_scan(a0 + a1, lane); const float tot = __uint_as_float(__builtin_amdgcn_readlane(__float_as_uint(inc), 63));
        if (dir == 0) { wgt[wid * 128 + p0] = d0 * fexp(tot - (inc - a1)); wgt[wid * 128 + p0 + 1] = d1 * fexp(tot - inc); }
        else { wgt[wid * 128 + p0] = d0 * fexp(inc - a1 - a0); wgt[wid * 128 + p0 + 1] = d1 * fexp(inc - a1); }
        if (lane == 0) ((float*)(P.ws + WS_DEC))[(size_t)sidx(1, b, hh, dir, pc) * 64] = fexp(tot);
    }
    __syncthreads();
    {
#pragma unroll 1
        for (int it = tid; it < 128 * 8; it += 512) { const int p = it >> 3, g8 = it & 7; const int row = row0 + p; float t8[8];
            conv3_8<true>(U, row, 3072 + 256 + g * 64 + 8 * g8, scw, 512, 256 + g * 64 + 8 * g8, scb, t8); scatter8_T(BT, g8, p, t8); }
#pragma unroll 1
        for (int it = tid; it < 2 * 128 * 8; it += 512) { const int hq = it >> 10, p = (it >> 3) & 127, g8 = it & 7; const int row = row0 + p; const int c0 = (2 * g + hq) * 64 + 8 * g8; float x8[8], t8[8];
            conv3_8<true>(U, row, 3072 + c0, scw, 512, c0, scb, x8);
#pragma unroll
            for (int dir = 0; dir < 2; ++dir) { const int cmb = 2 * hq + dir; const float wv = wgt[cmb * 128 + p];
#pragma unroll
                for (int e = 0; e < 8; ++e) t8[e] = x8[e] * wv;
                scatter8_T(XT + cmb * 64 * 136, g8, p, t8); } }
    }
    __syncthreads();
    {
        const int cmb = wid >> 1; const int hh = 2 * g + (cmb >> 1), dir = cmb & 1;
        float* S = (float*)(P.ws + WS_BIG + BIG_STATE) + (size_t)sidx(1, b, hh, dir, pc) * 4096;
#pragma unroll
        for (int mi = 0; mi < 2; ++mi) { const int mt = 2 * (wid & 1) + mi; f32x4 acc[4];
#pragma unroll
            for (int n = 0; n < 4; ++n) acc[n] = (f32x4){0.f, 0.f, 0.f, 0.f};
#pragma unroll
            for (int ks = 0; ks < 4; ++ks) { const bf16x8 a = *(const LAS bf16x8*)(XT + (cmb * 64 + 16 * mt + fr) * 136 + 32 * ks + 8 * fq);
#pragma unroll
                for (int n = 0; n < 4; ++n) { const bf16x8 bb = *(const LAS bf16x8*)(BT + (16 * n + fr) * 136 + 32 * ks + 8 * fq); acc[n] = __builtin_amdgcn_mfma_f32_16x16x32_bf16(a, bb, acc[n], 0, 0, 0); } }
#pragma unroll
            for (int n = 0; n < 4; ++n)
#pragma unroll
                for (int r = 0; r < 4; ++r) S[(16 * mt + 4 * fq + r) * 64 + 16 * n + fr] = acc[n][r]; }
    }
    __syncthreads();
}

__device__ __forceinline__ void ssd_dt_cum(const Ptrs P, int l, int row0, int dir, int h, int wid, int lane, LAS float* cum, LAS float* dtv) {
    if (wid == 0) {
        const float Aneg = -fexp(P.inp(I_SSDALOG)[(l * 2 + dir) * 4 + h]); const float dtb = P.inp(I_SSDDTB)[(l * 2 + dir) * 4 + h]; const float* DT = (const float*)(P.ws + WS_DT);
        const int t0 = 2 * lane, p0 = dir ? 127 - t0 : t0, p1 = dir ? 126 - t0 : t0 + 1;
        const float d0 = softplusf_(DT[(size_t)(row0 + p0) * 8 + dir * 4 + h] + dtb), d1 = softplusf_(DT[(size_t)(row0 + p1) * 8 + dir * 4 + h] + dtb);
        const float a0 = Aneg * d0, a1 = Aneg * d1; const float inc = wave_incl_scan(a0 + a1, lane);
        cum[t0] = inc - a1; cum[t0 + 1] = inc; dtv[t0] = d0; dtv[t0 + 1] = d1;
    }
}

__device__ __forceinline__ void scan_pass2(const Ptrs P, int unit) {
    const int seq = unit >> 1, half = unit & 1; const int kind = seq >> 6, b = (seq >> 3) & 7, h = (seq >> 1) & 3, dir = seq & 1;
    const int e0 = half * 2048 + P.tid * 4; const int base = sidx(kind, b, h, dir, 0);
    float* ST = (float*)(P.ws + WS_BIG + BIG_STATE); const float* DEC = (const float*)(P.ws + WS_DEC);
    const float zf = zero_f(); f32x4 run = (f32x4){zf, zf, zf, zf};
#pragma unroll 1
    for (int q0 = 0; q0 < NCHK; q0 += 8) {
        f32x4 loc[8]; float dd[8];
#pragma unroll
        for (int k = 0; k < 8; ++k) { const int q = (q0 + k < NCHK) ? q0 + k : NCHK - 1; const int pc = chunk_at(dir, q);
            loc[k] = *(const f32x4*)(ST + (size_t)(base + pc) * 4096 + e0); dd[k] = DEC[(size_t)(base + pc) * 64 + (kind == 0 ? (e0 >> 6) : 0)]; }
#pragma unroll
        for (int k = 0; k < 8; ++k) { if (q0 + k < NCHK) { const int pc = chunk_at(dir, q0 + k); *(f32x4*)(ST + (size_t)(base + pc) * 4096 + e0) = run; run = run * dd[k] + loc[k]; } }
    }
}

__device__ __forceinline__ int qk_off(int p, int chunk) { return p * 64 + ((chunk ^ (p & 7)) << 3); }
__device__ __forceinline__ void hgrn_pass3(const Ptrs P, int l, int unit, int unit_next, LAS unsigned char* lds) {
    const int tid = P.tid, lane = tid & 63, wid = tid >> 6, fr = lane & 15, fq = lane >> 4;
    const int pc = unit % NCHK; const int r_ = unit / NCHK; const int h = r_ & 3; const int b = r_ >> 2;
    const int row0 = chunk_row0(b, pc);
    const bf16_t* U = (const bf16_t*)(P.ws + WS_BIG + BIG_U);
    LAS bf16_t* QF = (LAS bf16_t*)lds; LAS bf16_t* KF = QF + 128 * 64; LAS bf16_t* QB = KF + 128 * 64; LAS bf16_t* KB = QB + 128 * 64; LAS bf16_t* VT = KB + 128 * 64;
    LAS bf16_t* STF = VT + 64 * 136; LAS bf16_t* STB = STF + 64 * 72; LAS float* ETF = (LAS float*)(STB + 64 * 72); LAS float* ETB = ETF + 512; LAS bf16_t* PW = (LAS bf16_t*)(ETB + 512);
    LAS float* OUT = (LAS float*)lds;
    {
        LAS bf16_t* FS = PW;
        for (int it = tid; it < 128 * 8; it += 512) { const int p = it >> 3, g8 = it & 7; const bf16_t* ur = U + (size_t)(row0 + p) * UC + h * 64 + 8 * g8;
            const bf16x8 ff8 = *(const bf16x8*)(ur + 1792), fb8 = *(const bf16x8*)(ur + 2048), q8 = *(const bf16x8*)(ur + 1536), v8 = *(const bf16x8*)(ur + 2304);
            *(LAS bf16x8*)(FS + p * 64 + 8 * g8) = ff8; *(LAS bf16x8*)(FS + 8192 + p * 64 + 8 * g8) = fb8;
            float qs[8];
#pragma unroll
            for (int e = 0; e < 8; ++e) qs[e] = bf2f((bf16_t)q8[e]) * 0.125f;
            const bf16x8 qp = pack8(qs); *(LAS bf16x8*)(QF + qk_off(p, g8)) = qp; *(LAS bf16x8*)(QB + qk_off(p, g8)) = qp;
#pragma unroll
            for (int e = 0; e < 8; ++e) VT[(8 * g8 + e) * 136 + p] = (bf16_t)v8[e]; }
        const float* SF = (const float*)(P.ws + WS_BIG + BIG_STATE) + (size_t)sidx(0, b, h, 0, pc) * 4096; const float* SB = (const float*)(P.ws + WS_BIG + BIG_STATE) + (size_t)sidx(0, b, h, 1, pc) * 4096;
#pragma unroll 2
        for (int idx = tid; idx < 4096; idx += 512) { STF[(idx & 63) * 72 + (idx >> 6)] = f2bf(SF[idx]); STB[(idx & 63) * 72 + (idx >> 6)] = f2bf(SB[idx]); }
    }
    __syncthreads();
    {
        LAS bf16_t* FS = PW;
        const int ch = lane, seg = wid; const float lbf = ((const float*)(P.ws + WS_LB))[(0 * 2 + l) * 256 + h * 64 + ch], lbb = ((const float*)(P.ws + WS_LB))[(1 * 2 + l) * 256 + h * 64 + ch];
        float bfw[16], bbw[16], kf[16], kb[16];
#pragma unroll
        for (int j = 0; j < 16; ++j) { const int p = 16 * seg + j;
            const float ff = lbf + (1.0f - lbf) * sigmoidf_(bf2f(FS[p * 64 + ch])), fb = lbb + (1.0f - lbb) * sigmoidf_(bf2f(FS[8192 + p * 64 + ch]));
            bfw[j] = flog(ff); bbw[j] = flog(fb); kf[j] = 1.0f - ff; kb[j] = 1.0f - fb; }
#pragma unroll
        for (int j = 1; j < 16; ++j) bfw[j] += bfw[j - 1];
#pragma unroll
        for (int j = 14; j >= 0; --j) bbw[j] += bbw[j + 1];
        const float etf = bfw[15], etb = bbw[0];
        ETF[seg * 64 + ch] = etf; ETB[seg * 64 + ch] = etb;
        const int chunk = ch >> 3, sub = ch & 7;
#pragma unroll
        for (int j = 0; j < 16; ++j) { const int p = 16 * seg + j; const int o = qk_off(p, chunk) + sub; const float qv = bf2f(QF[o]);
            const unsigned wq = pack2(qv * fexp(bfw[j]), qv * fexp(bbw[j])), wk = pack2(kf[j] * fexp(etf - bfw[j]), kb[j] * fexp(etb - bbw[j]));
            QF[o] = (bf16_t)(wq & 0xffffu); QB[o] = (bf16_t)(wq >> 16); KF[o] = (bf16_t)(wk & 0xffffu); KB[o] = (bf16_t)(wk >> 16); }
    }
    __syncthreads();
    f32x4 o[4];
    {
        const int i = wid; LAS bf16_t* pw = PW + wid * 16 * 136;
#pragma unroll
        for (int nt = 0; nt < 4; ++nt) o[nt] = (f32x4){0.f, 0.f, 0.f, 0.f};
#pragma unroll 1
        for (int dir = 0; dir < 2; ++dir) {
            const LAS bf16_t* QA = dir ? QB : QF; const LAS bf16_t* KA = dir ? KB : KF; const LAS float* ET = dir ? ETB : ETF; const LAS bf16_t* ST = dir ? STB : STF;
            bf16x8 qf[2]; float g[2][8];
#pragma unroll
            for (int ks = 0; ks < 2; ++ks) { qf[ks] = *(const LAS bf16x8*)(QA + qk_off(16 * i + fr, 4 * ks + fq));
                const f32x4 e0 = *(const LAS f32x4*)(ET + i * 64 + 32 * ks + 8 * fq), e1 = *(const LAS f32x4*)(ET + i * 64 + 32 * ks + 8 * fq + 4);
                g[ks][0] = -e0[0]; g[ks][1] = -e0[1]; g[ks][2] = -e0[2]; g[ks][3] = -e0[3]; g[ks][4] = -e1[0]; g[ks][5] = -e1[1]; g[ks][6] = -e1[2]; g[ks][7] = -e1[3]; }
            const int nj = dir ? 8 - i : i + 1;
            for (int jj = 0; jj < nj; ++jj) { const int j = dir ? i + jj : i - jj;
                f32x4 d = (f32x4){0.f, 0.f, 0.f, 0.f};
#pragma unroll
                for (int ks = 0; ks < 2; ++ks) { float a8[8];
#pragma unroll
                    for (int e = 0; e < 8; ++e) a8[e] = bf2f((bf16_t)qf[ks][e]) * fexp(g[ks][e]);
                    const bf16x8 kfr = *(const LAS bf16x8*)(KA + qk_off(16 * j + fr, 4 * ks + fq));
                    d = __builtin_amdgcn_mfma_f32_16x16x32_bf16(kfr, pack8(a8), d, 0, 0, 0);
                    const f32x4 e0 = *(const LAS f32x4*)(ET + j * 64 + 32 * ks + 8 * fq), e1 = *(const LAS f32x4*)(ET + j * 64 + 32 * ks + 8 * fq + 4);
                    g[ks][0] += e0[0]; g[ks][1] += e0[1]; g[ks][2] += e0[2]; g[ks][3] += e0[3]; g[ks][4] += e1[0]; g[ks][5] += e1[1]; g[ks][6] += e1[2]; g[ks][7] += e1[3]; }
                if (jj == 0) {
#pragma unroll
                    for (int r = 0; r < 4; ++r) d[r] = (dir ? (4 * fq + r >= fr) : (4 * fq + r <= fr)) ? d[r] : 0.f; }
                u32x2 w; w.x = pack2(d[0], d[1]); w.y = pack2(d[2], d[3]); *(LAS u32x2*)(pw + fr * 136 + 16 * j + 4 * fq) = w;
            }
            { const int zb = dir ? i - 1 : i + 1; const bool need = dir ? ((i & 1) == 1) : ((i & 1) == 0);
              if (need) { u32x2 z; z.x = __float_as_uint(zero_f()); z.y = z.x; *(LAS u32x2*)(pw + fr * 136 + 16 * zb + 4 * fq) = z; } }
            const int kslo = dir ? (i >> 1) : 0, kshi = dir ? 3 : (i >> 1);
            for (int ks = kslo; ks <= kshi; ++ks) { const bf16x8 pa = *(const LAS bf16x8*)(pw + fr * 136 + 32 * ks + 8 * fq);
#pragma unroll
                for (int nt = 0; nt < 4; ++nt) { const bf16x8 vf = *(const LAS bf16x8*)(VT + (16 * nt + fr) * 136 + 32 * ks + 8 * fq); o[nt] = __builtin_amdgcn_mfma_f32_16x16x32_bf16(pa, vf, o[nt], 0, 0, 0); } }
#pragma unroll
            for (int ks = 0; ks < 2; ++ks) { float a8[8];
#pragma unroll
                for (int e = 0; e < 8; ++e) a8[e] = bf2f((bf16_t)qf[ks][e]) * fexp(g[ks][e]);
                const bf16x8 qa = pack8(a8);
#pragma unroll
                for (int nt = 0; nt < 4; ++nt) { const bf16x8 sf = *(const LAS bf16x8*)(ST + (16 * nt + fr) * 72 + 32 * ks + 8 * fq); o[nt] = __builtin_amdgcn_mfma_f32_16x16x32_bf16(qa, sf, o[nt], 0, 0, 0); } }
        }
    }
    __syncthreads();
#pragma unroll
    for (int nt = 0; nt < 4; ++nt)
#pragma unroll
        for (int r = 0; r < 4; ++r) OUT[(16 * wid + 4 * fq + r) * 64 + 16 * nt + fr] = o[nt][r];
    __syncthreads();
    {
        const int pos = tid >> 2, qd = tid & 3; const int row = row0 + pos; bf16_t* BR2 = (bf16_t*)(P.ws + WS_BR) + (size_t)2 * T * 256;
        const bf16_t* gp = U + (size_t)row * UC + 2560 + h * 64 + 16 * qd; const bf16x8 g0 = *(const bf16x8*)gp, g1 = *(const bf16x8*)(gp + 8);
        const float* ngp = P.inp(I_HGNG) + l * 64 + 16 * qd; float ov[16], q = 0.f;
#pragma unroll
        for (int e4 = 0; e4 < 4; ++e4) { const f32x4 v = *(const LAS f32x4*)(OUT + pos * 64 + 16 * qd + 4 * e4); ov[4 * e4] = v[0]; ov[4 * e4 + 1] = v[1]; ov[4 * e4 + 2] = v[2]; ov[4 * e4 + 3] = v[3]; q += v[0] * v[0] + v[1] * v[1] + v[2] * v[2] + v[3] * v[3]; }
        q += __shfl_xor(q, 1); q += __shfl_xor(q, 2);
        const float rs = rsqrtf(q * (1.0f / 64.0f) + kconst(RMS_EPS)); float t8[8];
#pragma unroll
        for (int e = 0; e < 8; ++e) t8[e] = ov[e] * rs * ngp[e] * siluf_(bf2f((bf16_t)g0[e]));
        *(bf16x8*)(BR2 + (size_t)row * 256 + h * 64 + 16 * qd) = pack8(t8);
#pragma unroll
        for (int e = 0; e < 8; ++e) t8[e] = ov[8 + e] * rs * ngp[8 + e] * siluf_(bf2f((bf16_t)g1[e]));
        *(bf16x8*)(BR2 + (size_t)row * 256 + h * 64 + 16 * qd + 8) = pack8(t8);
    }
    __syncthreads();
}

__device__ __forceinline__ void ssd_pass3(const Ptrs P, int l, int unit, LAS unsigned char* lds) {
    const int tid = P.tid, lane = tid & 63, wid = tid >> 6, fr = lane & 15, fq = lane >> 4;
    const int pc = unit % NCHK; const int r_ = unit / NCHK; const int g = r_ & 1; const int b = r_ >> 1;
    const int row0 = chunk_row0(b, pc);
    const bf16_t* U = (const bf16_t*)(P.ws + WS_BIG + BIG_U);
    const float* scw = P.inp(I_SSDCW) + (size_t)l * 3 * 512; const float* scb = P.inp(I_SSDCB) + l * 512;
    LAS bf16_t* CM = (LAS bf16_t*)lds; LAS bf16_t* BM = CM + 128 * 72; LAS bf16_t* XT = BM + 128 * 72; LAS bf16_t* STF = XT + 64 * 136; LAS bf16_t* STB = STF + 64 * 72;
    LAS float* cumfA = (LAS float*)(STB + 64 * 72); LAS float* cumbA = cumfA + 256; LAS float* dtfA = cumbA + 256; LAS float* dtbA = dtfA + 256;
    LAS bf16_t* PW = (LAS bf16_t*)(dtbA + 256); LAS float* OUT = (LAS float*)(PW + 8 * 16 * 136);
    if (wid < 4) {
        const int hq = wid >> 1, dir = wid & 1, h = 2 * g + hq; const float Aneg = -fexp(P.inp(I_SSDALOG)[(l * 2 + dir) * 4 + h]); const float dtbias = P.inp(I_SSDDTB)[(l * 2 + dir) * 4 + h]; const float* DT = (const float*)(P.ws + WS_DT);
        const int p0 = 2 * lane; const float d0 = softplusf_(DT[(size_t)(row0 + p0) * 8 + dir * 4 + h] + dtbias), d1 = softplusf_(DT[(size_t)(row0 + p0 + 1) * 8 + dir * 4 + h] + dtbias);
        const float a0 = Aneg * d0, a1 = Aneg * d1; const float inc = wave_incl_scan(a0 + a1, lane);
        if (dir == 0) { cumfA[hq * 128 + p0] = inc - a1; cumfA[hq * 128 + p0 + 1] = inc; dtfA[hq * 128 + p0] = d0; dtfA[hq * 128 + p0 + 1] = d1; }
        else { const float tot = __uint_as_float(__builtin_amdgcn_readlane(__float_as_uint(inc), 63)); cumbA[hq * 128 + p0] = tot - inc + a0 + a1; cumbA[hq * 128 + p0 + 1] = tot - inc + a1; dtbA[hq * 128 + p0] = d0; dtbA[hq * 128 + p0 + 1] = d1; }
    }
    {
        const int pos = tid >> 2, qd = tid & 3; const int row = row0 + pos;
#pragma unroll 1
        for (int pcs = 0; pcs < 4; ++pcs) { const int isb = pcs >> 1, hf = pcs & 1; const int cc = (isb ? 256 : 384) + g * 64 + 16 * qd + 8 * hf; float t8[8];
            conv3_silu8(U, row, 3072 + cc, scw, 512, cc, scb, t8);
            *(LAS bf16x8*)((isb ? BM : CM) + pos * 72 + 16 * qd + 8 * hf) = pack8(t8); }
    }
#pragma unroll 1
    for (int hq = 0; hq < 2; ++hq) {
        const int h = 2 * g + hq;
        for (int it = tid; it < 128 * 8; it += 512) { const int p = it >> 3, g8 = it & 7; float x8[8];
            conv3_8<true>(U, row0 + p, 3072 + h * 64 + 8 * g8, scw, 512, h * 64 + 8 * g8, scb, x8); scatter8_T(XT, g8, p, x8); }
        __builtin_amdgcn_sched_barrier(0);
        LAS float* cumf = cumfA + hq * 128; LAS float* cumb = cumbA + hq * 128; LAS float* dtf = dtfA + hq * 128; LAS float* dtb = dtbA + hq * 128;
        {
            const float* SF = (const float*)(P.ws + WS_BIG + BIG_STATE) + (size_t)sidx(1, b, h, 0, pc) * 4096; const float* SB = (const float*)(P.ws + WS_BIG + BIG_STATE) + (size_t)sidx(1, b, h, 1, pc) * 4096;
#pragma unroll
            for (int k = 0; k < 2; ++k) { const int idx = (tid + 512 * k) * 4; const f32x4 a = *(const f32x4*)(SF + idx), c = *(const f32x4*)(SB + idx);
                u32x2 wa, wc; wa.x = pack2(a[0], a[1]); wa.y = pack2(a[2], a[3]); wc.x = pack2(c[0], c[1]); wc.y = pack2(c[2], c[3]);
                *(LAS u32x2*)(STF + (idx >> 6) * 72 + (idx & 63)) = wa; *(LAS u32x2*)(STB + (idx >> 6) * 72 + (idx & 63)) = wc; }
        }
        float rxs[16]; bf16x8 rz[2];
        { const int pos = tid >> 2, qd = tid & 3; const int row = row0 + pos; const int c0 = h * 64 + 16 * qd; const bf16_t* zp = U + (size_t)row * UC + 2816 + c0;
#pragma unroll
          for (int hf = 0; hf < 2; ++hf) { float xs[8]; conv3_silu8(U, row, 3072 + c0 + 8 * hf, scw, 512, c0 + 8 * hf, scb, xs); rz[hf] = *(const bf16x8*)(zp + 8 * hf);
#pragma unroll
              for (int e = 0; e < 8; ++e) rxs[8 * hf + e] = xs[e]; } }
        __syncthreads();
        {
            const int i = wid; LAS bf16_t* pw = PW + wid * 16 * 136;
            bf16x8 cf[2];
#pragma unroll
            for (int ks = 0; ks < 2; ++ks) cf[ks] = *(const LAS bf16x8*)(CM + (16 * i + fr) * 72 + 32 * ks + 8 * fq);
            f32x4 o[4];
#pragma unroll
            for (int nt = 0; nt < 4; ++nt) o[nt] = (f32x4){0.f, 0.f, 0.f, 0.f};
#pragma unroll 1
            for (int dir = 0; dir < 2; ++dir) {
                const LAS float* cum = dir ? cumb : cumf; const LAS float* dtv = dir ? dtb : dtf; const LAS bf16_t* ST = dir ? STB : STF;
                const float cq = cum[16 * i + fr];
                const int jlo = dir ? i : 0, jhi = dir ? 7 : i;
                for (int j = jlo; j <= jhi; ++j) {
                    f32x4 d = (f32x4){0.f, 0.f, 0.f, 0.f};
#pragma unroll
                    for (int ks = 0; ks < 2; ++ks) { const bf16x8 bf_ = *(const LAS bf16x8*)(BM + (16 * j + fr) * 72 + 32 * ks + 8 * fq); d = __builtin_amdgcn_mfma_f32_16x16x32_bf16(bf_, cf[ks], d, 0, 0, 0); }
                    const f32x4 cs = *(const LAS f32x4*)(cum + 16 * j + 4 * fq), ds = *(const LAS f32x4*)(dtv + 16 * j + 4 * fq);
#pragma unroll
                    for (int r = 0; r < 4; ++r) { const bool keep = (j != i) || (dir ? (4 * fq + r >= fr) : (4 * fq + r <= fr)); d[r] = keep ? d[r] * fexp(cq - cs[r]) * ds[r] : 0.f; }
                    u32x2 w; w.x = pack2(d[0], d[1]); w.y = pack2(d[2], d[3]); *(LAS u32x2*)(pw + fr * 136 + 16 * j + 4 * fq) = w;
                }
                { const int zb = dir ? i - 1 : i + 1; const bool need = dir ? ((i & 1) == 1) : ((i & 1) == 0);
                  if (need) { u32x2 z; z.x = __float_as_uint(zero_f()); z.y = z.x; *(LAS u32x2*)(pw + fr * 136 + 16 * zb + 4 * fq) = z; } }
                const int kslo = dir ? (i >> 1) : 0, kshi = dir ? 3 : (i >> 1);
                for (int ks = kslo; ks <= kshi; ++ks) { const bf16x8 pa = *(const LAS bf16x8*)(pw + fr * 136 + 32 * ks + 8 * fq);
#pragma unroll
                    for (int nt = 0; nt < 4; ++nt) { const bf16x8 xf = *(const LAS bf16x8*)(XT + (16 * nt + fr) * 136 + 32 * ks + 8 * fq); o[nt] = __builtin_amdgcn_mfma_f32_16x16x32_bf16(pa, xf, o[nt], 0, 0, 0); } }
                f32x4 o2[4];
#pragma unroll
                for (int nt = 0; nt < 4; ++nt) o2[nt] = (f32x4){0.f, 0.f, 0.f, 0.f};
#pragma unroll
                for (int ks = 0; ks < 2; ++ks)
#pragma unroll
                    for (int nt = 0; nt < 4; ++nt) { const bf16x8 sf = *(const LAS bf16x8*)(ST + (16 * nt + fr) * 72 + 32 * ks + 8 * fq); o2[nt] = __builtin_amdgcn_mfma_f32_16x16x32_bf16(cf[ks], sf, o2[nt], 0, 0, 0); }
                const f32x4 ct = *(const LAS f32x4*)(cum + 16 * i + 4 * fq);
#pragma unroll
                for (int nt = 0; nt < 4; ++nt)
#pragma unroll
                    for (int r = 0; r < 4; ++r) o[nt][r] += fexp(ct[r]) * o2[nt][r];
            }
#pragma unroll
            for (int nt = 0; nt < 4; ++nt)
#pragma unroll
                for (int r = 0; r < 4; ++r) OUT[(16 * i + 4 * fq + r) * 64 + 16 * nt + fr] = o[nt][r];
        }
        __syncthreads();
        {
            const int pos = tid >> 2, qd = tid & 3; const int row = row0 + pos; const int c0 = h * 64 + 16 * qd;
            const float Dh = P.inp(I_SSDD)[l * 4 + h]; const float* ngp = P.inp(I_SSDNG) + l * 256 + c0; bf16_t* BR3 = (bf16_t*)(P.ws + WS_BR) + (size_t)3 * T * 256; float* SSQ = (float*)(P.ws + WS_SSQ);
            float q = 0.f;
#pragma unroll
            for (int hf = 0; hf < 2; ++hf) { float xs[8];
#pragma unroll
                for (int e = 0; e < 8; ++e) xs[e] = rxs[8 * hf + e];
                const bf16x8 z8 = rz[hf]; float t8[8];
#pragma unroll
                for (int e4 = 0; e4 < 2; ++e4) { const f32x4 ov = *(const LAS f32x4*)(OUT + pos * 64 + 16 * qd + 8 * hf + 4 * e4);
#pragma unroll
                    for (int e = 0; e < 4; ++e) { const int ii = 4 * e4 + e; const float vv = (ov[e] + xs[ii] * Dh) * siluf_(bf2f((bf16_t)z8[ii])); q += vv * vv; t8[ii] = vv * ngp[8 * hf + ii]; } }
                *(bf16x8*)(BR3 + (size_t)row * 256 + c0 + 8 * hf) = pack8(t8); }
            q += __shfl_xor(q, 1); q += __shfl_xor(q, 2);
            if (qd == 0) SSQ[(size_t)row * 4 + h] = q;
        }
        __syncthreads();
    }
}

typedef float f32x2 __attribute__((ext_vector_type(2)));
__device__ __forceinline__ f32x2 cmul(f32x2 a, f32x2 b) { return (f32x2){a.x * b.x - a.y * b.y, a.x * b.y + a.y * b.x}; }
__device__ __forceinline__ f32x2 cmulc(f32x2 a, f32x2 b) { return (f32x2){a.x * b.x + a.y * b.y, a.y * b.x - a.x * b.y}; }
__device__ __forceinline__ int fphys(int i) { return i + (i >> 4); }
template <int LO, int NST, bool INV>
__device__ __forceinline__ void fft_stages(f32x2 (&x)[16], const LAS f32x2* TW, int low) {
#pragma unroll
    for (int mm = 0; mm < NST; ++mm) { const int m = INV ? mm : NST - 1 - mm; const int s = LO + m;
#pragma unroll
        for (int j = 0; j < 16; ++j) { if (j & (1 << m)) continue; const int j2 = j | (1 << m);
            const int k = ((j & ((1 << m) - 1)) << LO) | low; const f32x2 tw = TW[k << (12 - s)];
            const f32x2 a = x[j], b = x[j2];
            if (!INV) { x[j] = a + b; x[j2] = cmul(a - b, tw); } else { const f32x2 bt = cmulc(b, tw); x[j] = a + bt; x[j2] = a - bt; } } }
}
template <int LO, int NST, bool INV>
__device__ __forceinline__ void fft_pass(LAS f32x2* X, const LAS f32x2* TW, int tid) {
    const int low = tid & ((1 << LO) - 1), high = tid >> LO; const int base = low | (high << (LO + 4));
    f32x2 x[16];
#pragma unroll
    for (int j = 0; j < 16; ++j) x[j] = X[fphys(base | (j << LO))];
    fft_stages<LO, NST, INV>(x, TW, low);
#pragma unroll
    for (int j = 0; j < 16; ++j) X[fphys(base | (j << LO))] = x[j];
}
__device__ __forceinline__ void hyena_fft_unit(const Ptrs P, int l, int c, LAS unsigned char* lds) {
    const int tid = P.tid, lane = tid & 63;
    LAS f32x2* X = (LAS f32x2*)lds; LAS f32x2* TW = X + 8704;
    const f32x2* TWg = (const f32x2*)(P.ws + WS_TW);
    for (int i = tid; i < 4096; i += 512) TW[i] = TWg[i];
    float nrm; { const float* part = (const float*)(P.ws + WS_PART) + (size_t)l * 64 * 512; nrm = wave_sum(part[lane * 512 + c] + part[lane * 512 + 256 + c]); }
    const float inv = 1.0f / nrm; const float* filt = (const float*)(P.ws + WS_FILT) + (size_t)l * 8192 * 256 + c;
    f32x2* Fg = (f32x2*)(P.ws + WS_BR) + (size_t)P.bid * 8192;
    __syncthreads();
    {
        f32x2 x[16];
#pragma unroll
        for (int j = 0; j < 16; ++j) x[j] = (f32x2){filt[(size_t)(tid + 512 * j) * 256] * inv, 0.f};
        fft_stages<9, 4, false>(x, TW, tid);
#pragma unroll
        for (int j = 0; j < 16; ++j) X[fphys(tid | (j << 9))] = x[j];
        __syncthreads(); fft_pass<5, 4, false>(X, TW, tid); __syncthreads(); fft_pass<2, 3, false>(X, TW, tid); __syncthreads();
#pragma unroll
        for (int j = 0; j < 16; ++j) x[j] = X[fphys((tid << 4) | j)];
        fft_stages<0, 2, false>(x, TW, 0);
#pragma unroll
        for (int j = 0; j < 16; ++j) Fg[(tid << 4) | j] = x[j];
    }
    unsigned* WTt = (unsigned*)(P.ws + WS_BIG + BIG_WT); const float bias = P.inp(I_HYBIAS)[l * 256 + c];
    for (int p = 0; p < 4; ++p) {
        unsigned* wp = WTt + ((size_t)c * 4 + p) * 4096;
        f32x2 x[16]; unsigned wraw[8];
#pragma unroll
        for (int j = 0; j < 8; ++j) { wraw[j] = wp[tid + 512 * j]; x[j] = (f32x2){__uint_as_float(wraw[j] << 16), __uint_as_float(wraw[j] & 0xffff0000u)}; }
#pragma unroll
        for (int j = 8; j < 16; ++j) x[j] = (f32x2){0.f, 0.f};
        fft_stages<9, 4, false>(x, TW, tid);
        __syncthreads();
#pragma unroll
        for (int j = 0; j < 16; ++j) X[fphys(tid | (j << 9))] = x[j];
        __syncthreads(); fft_pass<5, 4, false>(X, TW, tid); __syncthreads(); fft_pass<2, 3, false>(X, TW, tid); __syncthreads();
#pragma unroll
        for (int j = 0; j < 16; ++j) x[j] = X[fphys((tid << 4) | j)];
        fft_stages<0, 2, false>(x, TW, 0);
#pragma unroll
        for (int j = 0; j < 16; ++j) x[j] = cmul(x[j], Fg[(tid << 4) | j]);
        fft_stages<0, 2, true>(x, TW, 0);
#pragma unroll
        for (int j = 0; j < 16; ++j) X[fphys((tid << 4) | j)] = x[j];
        __syncthreads(); fft_pass<2, 3, true>(X, TW, tid); __syncthreads(); fft_pass<5, 4, true>(X, TW, tid); __syncthreads();
#pragma unroll
        for (int j = 0; j < 16; ++j) x[j] = X[fphys(tid | (j << 9))];
        fft_stages<9, 4, true>(x, TW, tid);
#pragma unroll
        for (int j = 0; j < 8; ++j) { const f32x2 y = x[j] * (1.0f / 8192.0f); const unsigned w = wraw[j];
            wp[tid + 512 * j] = pack2(y.x + __uint_as_float(w << 16) * bias, y.y + __uint_as_float(w & 0xffff0000u) * bias); }
    }
    __syncthreads();
}

__device__ __forceinline__ void phase_m1(const Ptrs P, int l, LAS unsigned char* lds) {
    const int tid = P.tid, G = P.G;
    const bf16_t* U = (const bf16_t*)(P.ws + WS_BIG + BIG_U); bf16_t* WT = (bf16_t*)(P.ws + WS_BIG + BIG_WT);
    const float* hcw = P.inp(I_HYCW) + (size_t)l * 3 * 768; const float* hcb = P.inp(I_HYCB) + l * 768;
    const int NH = NB * 4 * NCHK, NSS = NB * 2 * NCHK;
    const int NS2 = NH + NSS;
    const int NU = NS2 + 256 + NCTX / 64;
    for (int u = P.bid; u < NU; u += G) {
        Ptrs Pu = P; asm volatile("" : "+v"(Pu.tid));
        if (u < NSS) ssd_pass1(Pu, l, u, lds);
        else if (u < NS2) hgrn_pass1(Pu, l, u - NSS, lds);
        else if (u < NS2 + 256) { const int tid = Pu.tid;
            const int ub = u - NS2; const int p = ub >> 6, tb = ub & 63; const int c = tid & 255; LAS unsigned* tile = (LAS unsigned*)lds;
            for (int it = tid; it < 2 * 64 * 32; it += 512) { const int b2 = it >> 11, rr = (it >> 5) & 63, g8 = it & 31; const int row = (2 * p + b2) * SEQ + tb * 64 + rr; float x1[8], vv[8];
                conv3_8<false>(U, row, 256 + 8 * g8, hcw, 768, 256 + 8 * g8, hcb, x1); conv3_8<false>(U, row, 512 + 8 * g8, hcw, 768, 512 + 8 * g8, hcb, vv);
                LAS bf16_t* th = (LAS bf16_t*)tile + b2;
#pragma unroll
                for (int e2 = 0; e2 < 4; ++e2) { const unsigned w = pack2(x1[2 * e2] * vv[2 * e2], x1[2 * e2 + 1] * vv[2 * e2 + 1]);
                    th[2 * ((8 * g8 + 2 * e2) * 65 + rr)] = (bf16_t)(w & 0xffffu); th[2 * ((8 * g8 + 2 * e2 + 1) * 65 + rr)] = (bf16_t)(w >> 16); } }
            __syncthreads();
            { unsigned* WTt = (unsigned*)(P.ws + WS_BIG + BIG_WT); const int t = tid & 63;
              for (int cc = tid >> 6; cc < 256; cc += 8) WTt[((size_t)cc * 4 + p) * 4096 + tb * 64 + t] = tile[cc * 65 + t]; }
            __syncthreads();
        } else { const int tid = Pu.tid;
            const int ub = u - NS2 - 256; const int c = tid & 255; bf16_t* WTC = (bf16_t*)(P.ws + WS_BIG + BIG_WT) + (size_t)NLAT * 256;
#pragma unroll 4
            for (int rr = tid >> 8; rr < 64; rr += 2) { const int row = NLAT + ub * 64 + rr;
                const float x1 = conv3_u(U, row, 256 + c, hcw, 768, 256 + c) + hcb[256 + c]; const float v = conv3_u(U, row, 512 + c, hcw, 768, 512 + c) + hcb[512 + c];
                WTC[(size_t)(row - NLAT) * 256 + c] = f2bf(x1 * v); } }
    }
}

__device__ __forceinline__ void phase_m2(const Ptrs P, int l, LAS unsigned char* lds) {
    const int tid = P.tid, G = P.G;
    const bf16_t* U = (const bf16_t*)(P.ws + WS_BIG + BIG_U); bf16_t* BR = (bf16_t*)(P.ws + WS_BR);
    const float* hcw = P.inp(I_HYCW) + (size_t)l * 3 * 768; const float* hcb = P.inp(I_HYCB) + l * 768;
    const int NU_F = 256, NU_P2 = 256, NU_HC = (l == 0) ? NB * 8 : 0;
    const int NU = NU_F + NU_P2 + NU_HC;
    for (int u = P.bid; u < NU; u += G) {
        if (u < NU_F) { hyena_fft_unit(P, l, u, lds); continue; }
        if (u < NU_F + NU_P2) { scan_pass2(P, u - NU_F); continue; }
        {
            const int uu = u - NU_F - NU_P2; const int b = uu >> 3, cb = uu & 7; const int cl = tid & 31, tg = tid >> 5; const int c = cb * 32 + cl;
            const int base = NLAT + b * CTXL; const bf16_t* WTC = (const bf16_t*)(P.ws + WS_BIG + BIG_WT) + (size_t)NLAT * 256 + (size_t)b * CTXL * 256;
            LAS float* wl = (LAS float*)lds; LAS float* fl = wl + 256 * 32;
            const float inv = 1.0f / hy_norm(P, 2, c); const float* filt = (const float*)(P.ws + WS_FILTC);
            for (int i = tid; i < 256 * 32; i += 512) wl[i] = bf2f(WTC[(size_t)(i >> 5) * 256 + cb * 32 + (i & 31)]);
            for (int i = tid >> 5; i < 512; i += 16) fl[i * 32 + cl] = filt[(size_t)i * 256 + c] * inv;
            __syncthreads();
            float acc[16];
#pragma unroll
            for (int j = 0; j < 16; ++j) acc[j] = 0.f;
#pragma unroll 1
            for (int sb = 0; sb < 16; ++sb) {
                float fw[31], wv[16];
#pragma unroll
                for (int q = 0; q < 31; ++q) fw[q] = fl[((16 * tg - 16 * sb - 15 + q) & 511) * 32 + cl];
#pragma unroll
                for (int k = 0; k < 16; ++k) wv[k] = wl[(16 * sb + k) * 32 + cl];
#pragma unroll
                for (int j = 0; j < 16; ++j)
#pragma unroll
                    for (int k = 0; k < 16; ++k) acc[j] += fw[j - k + 15] * wv[k];
            }
            const float bias = P.inp(I_HYBIAS)[l * 256 + c];
#pragma unroll 4
            for (int j = 0; j < 16; ++j) { const int tt = 16 * tg + j; const int row = base + tt; const float x0 = conv3_u(U, row, c, hcw, 768, c) + hcb[c];
                BR[(size_t)row * 256 + c] = f2bf(x0 * (acc[j] + wl[tt * 32 + cl] * bias)); }
            __syncthreads();
        }
    }
}

__device__ __forceinline__ void phase_m3(const Ptrs P, int l, LAS unsigned char* lds) {
    const int tid = P.tid, G = P.G;
    const bool last = (l == NLAYER - 1); const int rows_l = last ? NLAT : T;
    const bf16_t* U = (const bf16_t*)(P.ws + WS_BIG + BIG_U); bf16_t* BR = (bf16_t*)(P.ws + WS_BR);
    const int NSS3 = NB * 2 * NCHK, NH3 = NB * 4 * NCHK;
    const int NS3T = NSS3 + NH3;
    const int NU = NS3T + rows_l / 64 + 256;
    const float* hcw = P.inp(I_HYCW) + (size_t)l * 3 * 768; const float* hcb = P.inp(I_HYCB) + l * 768;
    for (int u = P.bid; u < NU; u += G) {
        if (u >= NS3T + rows_l / 64) {
            const int ub = u - NS3T - rows_l / 64; const int p = ub >> 6, tb = ub & 63; LAS unsigned* tile = (LAS unsigned*)lds; const unsigned* WTt = (const unsigned*)(P.ws + WS_BIG + BIG_WT);
            { const int t = tid & 63; for (int cc = tid >> 6; cc < 256; cc += 8) tile[cc * 65 + t] = WTt[((size_t)cc * 4 + p) * 4096 + tb * 64 + t]; }
            __syncthreads();
            for (int it = tid; it < 64 * 32; it += 512) { const int rr = it >> 5, g8 = it & 31; unsigned yw[8];
#pragma unroll
                for (int e = 0; e < 8; ++e) yw[e] = tile[(8 * g8 + e) * 65 + rr];
#pragma unroll
                for (int b2 = 0; b2 < 2; ++b2) { const int row = (2 * p + b2) * SEQ + tb * 64 + rr; float x0[8], t8[8]; conv3_8<false>(U, row, 8 * g8, hcw, 768, 8 * g8, hcb, x0);
#pragma unroll
                    for (int e = 0; e < 8; ++e) t8[e] = x0[e] * (b2 ? __uint_as_float(yw[e] & 0xffff0000u) : __uint_as_float(yw[e] << 16));
                    *(bf16x8*)(BR + (size_t)row * 256 + 8 * g8) = pack8(t8); } }
            __syncthreads();
            continue; }
        if (u < NS3T) { const int uu = u < NSS3 ? u : u - NSS3; if (last && (uu % NCHK) < 2) continue;
            Ptrs Pu = P; int lu = l; asm volatile("" : "+v"(Pu.tid), "+s"(lu));
            if (u < NSS3) ssd_pass3(Pu, lu, uu, lds); else { int un = (u + G < NS3T) ? uu + G : -1; if (un >= 0 && last && (un % NCHK) < 2) un = -1; hgrn_pass3(Pu, lu, uu, un, lds); } }
        else { const int rb = u - NS3T; const float* cw = P.inp(I_SCCW) + (size_t)l * 3 * 256;
            for (int it = tid; it < 64 * 32; it += 512) { const int row = rb * 64 + (it >> 5), g8 = it & 31; const bool hp = row_has_prev(row), hn = row_has_next(row);
                const bf16_t* u0 = U + (size_t)row * UC + 8 * g8; const bf16_t* up = U + (size_t)(hp ? row - 1 : row) * UC + 8 * g8; const bf16_t* un = U + (size_t)(hn ? row + 1 : row) * UC + 8 * g8;
                const bf16x8 bg = *(const bf16x8*)(u0 + 768), c0 = *(const bf16x8*)(u0 + 1024), x0 = *(const bf16x8*)(u0 + 1280), cp = *(const bf16x8*)(up + 1024), xp = *(const bf16x8*)(up + 1280), cn = *(const bf16x8*)(un + 1024), xn = *(const bf16x8*)(un + 1280);
                const float mp = hp ? 1.0f : 0.0f, mn = hn ? 1.0f : 0.0f; float t8[8];
#pragma unroll
                for (int e = 0; e < 8; ++e) { const int c = 8 * g8 + e;
                    const float acc = bf2f((bf16_t)c0[e]) * bf2f((bf16_t)x0[e]) * cw[256 + c] + mp * bf2f((bf16_t)cp[e]) * bf2f((bf16_t)xp[e]) * cw[c] + mn * bf2f((bf16_t)cn[e]) * bf2f((bf16_t)xn[e]) * cw[512 + c];
                    t8[e] = bf2f((bf16_t)bg[e]) * acc; }
                *(bf16x8*)(BR + (size_t)T * 256 + (size_t)row * 256 + 8 * g8) = pack8(t8); } }
    }
}

__device__ __forceinline__ void phase_g2(const Ptrs P, int l, LAS unsigned char* lds) {
    const int MT = ((l == NLAYER - 1) ? NLAT : T) / 256;
    pg8::Gemm g{(const bf16_t*)(P.ws + WS_BR), (const bf16_t*)(P.ws + WS_WBR), 256};
    EpiP E{(bf16_t*)(P.ws + WS_BIG + BIG_P), (const float*)(P.ws + WS_SSQ)};
    SchedG2 S{XOrder{P.G, P.bid, MT, 16}};
    pg8::gemm_phase<EpiP, SchedG2, false>(P.tid, lds, g, S, E);
}
__device__ __forceinline__ void phase_g3(const Ptrs P, int l, LAS unsigned char* lds) {
    const int MT = ((l == NLAYER - 1) ? NLAT : T) / 256;
    pg8::Gemm g{(const bf16_t*)(P.ws + WS_HBUF), (const bf16_t*)(P.ws + WS_WG), D};
    EpiMerge E{(const bf16_t*)(P.ws + WS_BIG + BIG_P), (const float*)(P.ws + WS_BGP), (bf16_t*)(P.ws + WS_BR)};
    SchedMN S{XOrder{P.G, P.bid, MT, 16}};
    pg8::gemm_phase<EpiMerge, SchedMN, false>(P.tid, lds, g, S, E);
}
__device__ __forceinline__ void phase_g4(const Ptrs P, int l, LAS unsigned char* lds) {
    const int MT = ((l == NLAYER - 1) ? NLAT : T) / 256;
    pg8::Gemm g{(const bf16_t*)(P.ws + WS_BR), (const bf16_t*)(P.ws + WS_WO), D};
    EpiWo E{P, l};
    SchedMN S{XOrder{P.G, P.bid, MT, 4}};
    pg8::gemm_phase<EpiWo, SchedMN, false>(P.tid, lds, g, S, E);
}

__device__ __forceinline__ void phase_e5(const Ptrs P, int l, LAS unsigned char* lds) {
    const int tid = P.tid, wid = tid >> 6, lane = tid & 63, G = P.G, fr = lane & 15, fq = lane >> 4;
    const int rows_l = (l == NLAYER - 1) ? NLAT : T;
    LAS bf16_t* wrH = (LAS bf16_t*)lds;
    LAS bf16_t* wrL = wrH + 16 * 1032;
    LAS float* tile = (LAS float*)(lds + 69632);
    LAS float* lgs = (LAS float*)(lds + 136192);
    LAS unsigned* lcnt = (LAS unsigned*)(lds + 144896); LAS unsigned* gbase = lcnt + 16; LAS int* rec = (LAS int*)(lcnt + 32);
    for (int i = tid; i < 1024 * 16; i += 512) { const int k = i >> 4, e = i & 15; const float w = P.inp(I_WROUTER)[i]; const unsigned hi = pack2(w, 0.f) & 0xffffu; const float lo = w - __uint_as_float(hi << 16);
        wrH[e * 1032 + k] = (bf16_t)hi; wrL[e * 1032 + k] = f2bf(lo); }
    if (tid < 16) lcnt[tid] = 0u;
    __syncthreads();
    unsigned* cnt = (unsigned*)(P.ws + WS_CTL + CTL_CNT) + l * 16;
    int* toke = (int*)(P.ws + WS_TOKE); float* tokw = (float*)(P.ws + WS_TOKW); int* toks = (int*)(P.ws + WS_TOKS); int* list = (int*)(P.ws + WS_LIST);
    const float* g = P.inp(I_LN1G) + l * D; const float* bta = P.inp(I_LN1B) + l * D;
    bf16_t* H2 = (bf16_t*)(P.ws + WS_HBUF);
    const int NU_R = rows_l / 8; const int NU = NU_R + NCONV_EX;
    int nloc = 0;
    {
        RowV lng, lnb; row_load(lng, g, lane); row_load(lnb, bta, lane);
        RowV rn; { const float z = zero_f(); for (int i = 0; i < 4; ++i) rn.v[i] = (f32x4){z, z, z, z}; } if (P.bid < NU_R) row_load(rn, P.latrow(P.bid * 8 + wid), lane);
        RowV msh, msc; { const float z = zero_f(); for (int i = 0; i < 4; ++i) { msh.v[i] = (f32x4){z, z, z, z}; msc.v[i] = msh.v[i]; } } int mcur = -1;
        for (int u = P.bid; u < NU_R; u += G) {
            const int row = u * 8 + wid; RowV r = rn; float* lp = P.latrow(row);
            if (u + G < NU_R) row_load(rn, P.latrow((u + G) * 8 + wid), lane);
            row_layernorm_r(r, lng, lnb); row_store(r, lp, lane);
            const int mi = row_modidx(row); if (mi != mcur) { mcur = mi; const float* m = P.mod(l, mi); row_load(msh, m + 3072, lane); row_load(msc, m + 4096, lane); }
            RowV h; row_modulate_r(r, h, msh, msc);
            row_store_bf16(h, H2 + (size_t)row * D, lane);
            ++nloc;
        }
    }
    asm volatile("s_waitcnt vmcnt(0)" ::: "memory");
    __syncthreads();
    {
        const int ntile = (nloc + 1) >> 1; LAS float* lg = lgs + wid * 16 * 17;
        for (int t = wid; t < ntile; t += 8) {
            int it = 2 * t + (fr >> 3); const bool valid_a = it < nloc; if (!valid_a) it = nloc - 1;
            const bf16_t* ap = H2 + (size_t)((P.bid + G * it) * 8 + (fr & 7)) * D + 8 * fq;
            f32x4 acc = (f32x4){0.f, 0.f, 0.f, 0.f};
#pragma unroll 4
            for (int ks = 0; ks < 32; ++ks) { const bf16x8 a = *(const bf16x8*)(ap + 32 * ks);
                const bf16x8 bh = *(const LAS bf16x8*)(wrH + fr * 1032 + 32 * ks + 8 * fq), bl = *(const LAS bf16x8*)(wrL + fr * 1032 + 32 * ks + 8 * fq);
                acc = __builtin_amdgcn_mfma_f32_16x16x32_bf16(a, bh, acc, 0, 0, 0); acc = __builtin_amdgcn_mfma_f32_16x16x32_bf16(a, bl, acc, 0, 0, 0); }
#pragma unroll
            for (int r = 0; r < 4; ++r) lg[(4 * fq + r) * 17 + fr] = acc[r];
            const int it2 = 2 * t + (lane >> 3); const bool act = (lane < 16) && (it2 < nloc);
            if (act) {
                const int row = (P.bid + G * it2) * 8 + (lane & 7);
                float lgv[16];
#pragma unroll
                for (int e = 0; e < 16; ++e) lgv[e] = lg[lane * 17 + e];
                float mx = lgv[0];
#pragma unroll
                for (int e = 1; e < 16; ++e) mx = fmaxf(mx, lgv[e]);
                float sc[16], sel[16], ssum = 0.f;
#pragma unroll
                for (int e = 0; e < 16; ++e) { sc[e] = fexp(lgv[e] - mx); ssum += sc[e]; }
                const float inv = 1.0f / ssum;
#pragma unroll
                for (int e = 0; e < 16; ++e) { sc[e] *= inv; sel[e] = sc[e] + P.inp(I_BROUTER)[e]; }
                int bestg = 0; float bestgs = -3.0e38f;
#pragma unroll
                for (int gq = 0; gq < 4; ++gq) { float m1 = -3.0e38f, m2 = -3.0e38f;
#pragma unroll
                    for (int j = 0; j < 4; ++j) { const float v = sel[gq * 4 + j]; if (v > m1) { m2 = m1; m1 = v; } else if (v > m2) m2 = v; }
                    const float gs = m1 + m2; if (gs > bestgs) { bestgs = gs; bestg = gq; } }
                int i1 = 0, i2 = 0; float v1 = -3.0e38f, v2 = -3.0e38f, w1 = 0.f, w2 = 0.f;
#pragma unroll
                for (int e = 0; e < 16; ++e) { if ((e >> 2) == bestg && sel[e] > v1) { v1 = sel[e]; i1 = e; w1 = sc[e]; } }
#pragma unroll
                for (int e = 0; e < 16; ++e) { if ((e >> 2) == bestg && e != i1 && sel[e] > v2) { v2 = sel[e]; i2 = e; w2 = sc[e]; } }
                const float ws_ = 1.0f / (w1 + w2);
                const int s1 = (int)__hip_atomic_fetch_add(lcnt + i1, 1u, __ATOMIC_RELAXED, __HIP_MEMORY_SCOPE_WORKGROUP);
                const int s2 = (int)__hip_atomic_fetch_add(lcnt + i2, 1u, __ATOMIC_RELAXED, __HIP_MEMORY_SCOPE_WORKGROUP);
                const int idx = it2 * 8 + (lane & 7); rec[idx * 3] = i1 | (i2 << 8); rec[idx * 3 + 1] = s1; rec[idx * 3 + 2] = s2;
                toke[row * 2] = i1; toke[row * 2 + 1] = i2; tokw[row * 2] = w1 * ws_; tokw[row * 2 + 1] = w2 * ws_;
            }
        }
    }
    __syncthreads();
    if (tid < 16) gbase[tid] = __hip_atomic_fetch_add(cnt + tid, lcnt[tid], __ATOMIC_RELAXED, __HIP_MEMORY_SCOPE_AGENT);
    __syncthreads();
    for (int idx = tid; idx < nloc * 8; idx += 512) { const int row = (P.bid + G * (idx >> 3)) * 8 + (idx & 7); const int ee = rec[idx * 3]; const int e1 = ee & 255, e2 = ee >> 8;
        const int s1 = (int)gbase[e1] + rec[idx * 3 + 1], s2 = (int)gbase[e2] + rec[idx * 3 + 2];
        list[(size_t)e1 * T + s1] = row; list[(size_t)e2 * T + s2] = row; toks[row * 2] = s1; toks[row * 2 + 1] = s2; }
    for (int u = P.bid + G * nloc; u < NU; u += G) { if (u >= NU_R) conv_unit_ex(P, l, u - NU_R, tile); }
}

struct MoeSeg { int toff[17]; };
__device__ __forceinline__ void moe_seg(const unsigned* cnt, MoeSeg& S) { int a = 0;
#pragma unroll
    for (int e = 0; e < 16; ++e) { S.toff[e] = a; a += __builtin_amdgcn_readfirstlane(((int)cnt[e] + 255) >> 8); }
    S.toff[16] = a; }
__device__ __forceinline__ int moe_find(const MoeSeg& S, int tg, int& off) { int e = 0; off = 0;
#pragma unroll
    for (int j = 1; j < 16; ++j) { const bool ge = (tg >= S.toff[j]); e += ge ? 1 : 0; off = ge ? S.toff[j] : off; }
    return e; }

struct SchedMoe { int G, c; MoeSeg S; const int* list; const unsigned* cnt;
    __device__ __forceinline__ bool next(int i, Unit& u) const { const int L = i * G + c; if (L >= S.toff[16] * 4) return false; const int tg = L >> 2, pnn = L & 3; int off; const int e = moe_find(S, tg, off);
        u.pm = tg; u.pn = e * 4 + pnn; u.e = e; u.aux = tg - off; return true; }
    __device__ __forceinline__ int arow(const Unit& u, int R) const { const int idx = u.aux * 256 + R; const int* l = list + (size_t)u.e * T; return idx < (int)cnt[u.e] ? l[idx] : l[0]; } };
__device__ __forceinline__ void phase_g5(const Ptrs P, int l, LAS unsigned char* lds) {
    const unsigned* cnt = (const unsigned*)(P.ws + WS_CTL + CTL_CNT) + l * 16;
    SchedMoe S; S.G = P.G; S.c = P.bid; moe_seg(cnt, S.S); S.list = (const int*)(P.ws + WS_LIST); S.cnt = cnt;
    pg8::Gemm g{(const bf16_t*)(P.ws + WS_HBUF), (const bf16_t*)(P.ws + WS_BIG + BIG_W13), D};
    EpiFfn1 E{(bf16_t*)(P.ws + WS_BIG + BIG_HID)};
    pg8::gemm_phase<EpiFfn1, SchedMoe, true>(P.tid, lds, g, S, E);
}
__device__ __forceinline__ void phase_g6(const Ptrs P, int l, LAS unsigned char* lds) {
    const unsigned* cnt = (const unsigned*)(P.ws + WS_CTL + CTL_CNT) + l * 16;
    SchedMoe S; S.G = P.G; S.c = P.bid; moe_seg(cnt, S.S); S.list = (const int*)(P.ws + WS_LIST); S.cnt = cnt;
    pg8::Gemm g{(const bf16_t*)(P.ws + WS_BIG + BIG_HID), (const bf16_t*)(P.ws + WS_BIG + BIG_W2), 512};
    EpiBf16Plain E{(bf16_t*)(P.ws + WS_BIG + BIG_YE), 1024, 3};
    pg8::gemm_phase<EpiBf16Plain, SchedMoe, false>(P.tid, lds, g, S, E);
}

__device__ __forceinline__ void phase_e8(const Ptrs P, int l, LAS unsigned char* lds) {
    const int tid = P.tid, wid = tid >> 6, lane = tid & 63, G = P.G;
    const bool last = (l == NLAYER - 1); const int rows_l = last ? NLAT : T;
    LAS float* wdt = (LAS float*)lds; LAS float* tile = (LAS float*)(lds + 65536);
    if (!last) load_wdt(P, l + 1, wdt);
    const unsigned* cnt = (const unsigned*)(P.ws + WS_CTL + CTL_CNT) + l * 16; MoeSeg S; moe_seg(cnt, S);
    const int* toke = (const int*)(P.ws + WS_TOKE); const float* tokw = (const float*)(P.ws + WS_TOKW); const int* toks = (const int*)(P.ws + WS_TOKS);
    const bf16_t* YE = (const bf16_t*)(P.ws + WS_BIG + BIG_YE);
    const float* g = P.inp(I_LN2G) + l * D; const float* bta = P.inp(I_LN2B) + l * D;
    const int NU_R = rows_l / 8; const int NU = NU_R + (last ? 0 : NCONV_NE);
    RowV lng, lnb; row_load(lng, g, lane); row_load(lnb, bta, lane);
    RowV mg2, msh, msc; { const float z = zero_f(); for (int i = 0; i < 4; ++i) { mg2.v[i] = (f32x4){z, z, z, z}; msh.v[i] = mg2.v[i]; msc.v[i] = mg2.v[i]; } } int mcur = -1;
    RowV rn; { const float z = zero_f(); for (int i = 0; i < 4; ++i) rn.v[i] = (f32x4){z, z, z, z}; } int te1 = 0, te2 = 0, ts1 = 0, ts2 = 0; float tw1 = 0.f, tw2 = 0.f;
    if (P.bid < NU_R) { const int row = P.bid * 8 + wid; row_load(rn, P.latrow(row), lane); te1 = toke[row * 2]; te2 = toke[row * 2 + 1]; tw1 = tokw[row * 2]; tw2 = tokw[row * 2 + 1]; ts1 = toks[row * 2]; ts2 = toks[row * 2 + 1]; }
    int uconv = P.bid;
    for (int u = P.bid; u < NU_R; u += G) {
        uconv = u + G;
        const int row = u * 8 + wid; RowV r = rn; float* lp = P.latrow(row);
        const int e1 = te1, e2 = te2; const float w1 = tw1, w2 = tw2;
        int o1 = 0, o2 = 0;
#pragma unroll
        for (int e = 0; e < 16; ++e) { o1 = (e == e1) ? S.toff[e] : o1; o2 = (e == e2) ? S.toff[e] : o2; }
        const bf16_t* y1 = YE + ((size_t)o1 * 256 + ts1) * 1024; const bf16_t* y2 = YE + ((size_t)o2 * 256 + ts2) * 1024;
        u32x2 ya[4], yb[4];
#pragma unroll
        for (int i = 0; i < 4; ++i) { ya[i] = *(const u32x2*)(y1 + i * 256 + lane * 4); yb[i] = *(const u32x2*)(y2 + i * 256 + lane * 4); }
        if (u + G < NU_R) { const int rw = (u + G) * 8 + wid; row_load(rn, P.latrow(rw), lane); te1 = toke[rw * 2]; te2 = toke[rw * 2 + 1]; tw1 = tokw[rw * 2]; tw2 = tokw[rw * 2 + 1]; ts1 = toks[rw * 2]; ts2 = toks[rw * 2 + 1]; }
        const int mi = row_modidx(row);
        if (mi != mcur) { mcur = mi; row_load(mg2, P.mod(l, mi) + 5120, lane); if (!last) { const float* m2 = P.mod(l + 1, mi); row_load(msh, m2, lane); row_load(msc, m2 + 1024, lane); } }
#pragma unroll
        for (int i = 0; i < 4; ++i) { const u32x2 a = ya[i], b = yb[i];
            const f32x4 g2 = mg2.v[i];
            f32x4 mo; mo[0] = w1 * __uint_as_float(a.x << 16) + w2 * __uint_as_float(b.x << 16); mo[1] = w1 * __uint_as_float(a.x & 0xffff0000u) + w2 * __uint_as_float(b.x & 0xffff0000u);
            mo[2] = w1 * __uint_as_float(a.y << 16) + w2 * __uint_as_float(b.y << 16); mo[3] = w1 * __uint_as_float(a.y & 0xffff0000u) + w2 * __uint_as_float(b.y & 0xffff0000u);
            r.v[i] = r.v[i] * ALPHA + g2 * mo; }
        row_layernorm_r(r, lng, lnb);
        row_store(r, lp, lane);
        if (!last) { RowV h; row_modulate_r(r, h, msh, msc);
            row_store_bf16(h, (bf16_t*)(P.ws + WS_HBUF) + (size_t)row * D, lane); row_dt(h, wdt, (float*)(P.ws + WS_DT) + (size_t)row * 8, lane); }
    }
    for (int u = uconv; u < NU; u += G) { if (u >= NU_R) conv_unit_ne(P, l + 1, u - NU_R, tile); }
}

constexpr int NPH_LAYER = 11, NPH = 2 + NLAYER * NPH_LAYER;
__global__ void __launch_bounds__(512, 2) fwd_kernel(Args a) {
    extern __shared__ __attribute__((aligned(16))) unsigned char lds_raw[];
    LAS unsigned char* lds = (LAS unsigned char*)lds_raw;
    const int lo = a.ph_lo, hi = a.ph_hi;
    volatile LAS unsigned* xbw = (volatile LAS unsigned*)(lds + LDS_MISC);
    const int wave_s = __builtin_amdgcn_readfirstlane((int)threadIdx.x >> 6);
    if (threadIdx.x < 4) xbw[threadIdx.x] = 0u;
    __syncthreads();
    XcdBarrier bar; bar.bar = (unsigned*)(a.ws + WS_CTL); bar.x = 0; bar.st = xbw;
    if (hi - lo > 1) bar = xcd_barrier_post((unsigned*)(a.ws + WS_CTL), xbw, wave_s);
#ifndef PH_MASK
#define PH_MASK 0xFFFFFFFFu
#endif
#ifndef PROBE_PH
#define PROBE_PH (-1)
#define PROBE_N 1
#endif
#define REP(id) for (int rep_ = 0; rep_ < ((PROBE_PH == (id)) ? PROBE_N : 1); ++rep_)
#define PH_ON(id) (((PH_MASK) >> (id)) & 1u)
#define IN(k) (lo <= (k) && (k) < hi)
#define FRESH() Ptrs Pq; { const AS4 char* ka_ = (const AS4 char*)__builtin_amdgcn_kernarg_segment_ptr(); AS1 float* o_ = *(AS1 float* const AS4*)(ka_ + 8 * N_IN); AS1 unsigned char* w_ = *(AS1 unsigned char* const AS4*)(ka_ + 8 * N_IN + 8); int l_ = lcur; asm volatile("" : "+s"(o_), "+s"(w_), "+s"(l_) :: "memory"); Pq.out = (float*)o_; Pq.ws = (unsigned char*)w_; lq = l_; int ws_ = wave_s, b_ = blockIdx.x, g_ = gridDim.x; asm volatile("" : "+s"(ws_), "+s"(b_), "+s"(g_)); int ln_ = lane_id(); asm volatile("" : "+v"(ln_)); int t_ = ws_ * 64 + ln_; Pq.tid = t_; Pq.bid = b_; Pq.G = g_; }
#define SEAM(k) do { if (IN(k) && IN((k) + 1)) xcd_barrier(bar, wave_s); } while (0)
    int lcur = 0, lq = 0;
    if (PH_ON(0) && IN(0)) REP(0) { FRESH(); phase_pa(Pq, lds); } SEAM(0);
    if (PH_ON(1) && IN(1)) REP(1) { FRESH(); phase_pb(Pq, lds); } SEAM(1);
    for (int l = 0; l < NLAYER; ++l) {
        const int b = 2 + l * NPH_LAYER; lcur = l;
        if (PH_ON(2) && IN(b + 0)) REP(2) { FRESH(); phase_g1(Pq, lds); } SEAM(b + 0);
        for (int g_ = 0; g_ < ((PROBE_PH == 100) ? PROBE_N : 1); ++g_) {
        if (PH_ON(3) && IN(b + 1)) REP(3) { FRESH(); phase_m1(Pq, lq, lds); } SEAM(b + 1);
        if (PH_ON(4) && IN(b + 2)) REP(4) { FRESH(); phase_m2(Pq, lq, lds); } SEAM(b + 2);
        if (PH_ON(5) && IN(b + 3)) REP(5) { FRESH(); phase_m3(Pq, lq, lds); } SEAM(b + 3);
        }
        if (PH_ON(6) && IN(b + 4)) REP(6) { FRESH(); phase_g2(Pq, lq, lds); } SEAM(b + 4);
        if (PH_ON(7) && IN(b + 5)) REP(7) { FRESH(); phase_g3(Pq, lq, lds); } SEAM(b + 5);
        if (PH_ON(8) && IN(b + 6)) REP(8) { FRESH(); phase_g4(Pq, lq, lds); } SEAM(b + 6);
        if (PH_ON(9) && IN(b + 7)) REP(9) { FRESH(); phase_e5(Pq, lq, lds); } SEAM(b + 7);
        if (PH_ON(10) && IN(b + 8)) REP(10) { FRESH(); phase_g5(Pq, lq, lds); } SEAM(b + 8);
        if (PH_ON(11) && IN(b + 9)) REP(11) { FRESH(); phase_g6(Pq, lq, lds); } SEAM(b + 9);
        if (PH_ON(12) && IN(b + 10)) REP(12) { FRESH(); phase_e8(Pq, lq, lds); } SEAM(b + 10);
    }
#undef IN
#undef SEAM
}
}

extern "C" void kernel_launch(void* const* d_in, const int* in_sizes, int n_in, void* d_out, int out_size, void* d_ws, size_t ws_size, hipStream_t stream) {
    static int grid = 0;
    if (grid == 0) {
        if (n_in != N_IN || out_size != NLAT * D || ws_size < WS_END) { fprintf(stderr, "kernel_launch: unexpected shapes / workspace (%d inputs, out %d, ws %zu < %zu)\n", n_in, out_size, ws_size, (size_t)WS_END); grid = -1; return; }
        int dev = 0, cus = 0, per_cu = 0;
        if (hipGetDevice(&dev) != hipSuccess || hipDeviceGetAttribute(&cus, hipDeviceAttributeMultiprocessorCount, dev) != hipSuccess) { grid = -1; return; }
        if (hipFuncSetAttribute((const void*)fwd_kernel, hipFuncAttributeMaxDynamicSharedMemorySize, LDS_BYTES) != hipSuccess) { fprintf(stderr, "kernel_launch: hipFuncSetAttribute failed\n"); grid = -1; return; }
        if (hipOccupancyMaxActiveBlocksPerMultiprocessor(&per_cu, (const void*)fwd_kernel, 512, LDS_BYTES) != hipSuccess || per_cu < 1) { fprintf(stderr, "kernel_launch: occupancy query says %d\n", per_cu); }
        (void)hipGetLastError();
        grid = cus;
    }
    if (grid < 0) return;
    (void)hipMemsetAsync((char*)d_ws + WS_CTL, 0, CTL_BYTES, stream);
    Args a{};
    for (int i = 0; i < N_IN; ++i) a.in[i] = (const float*)d_in[i];
    a.out = (float*)d_out; a.ws = (unsigned char*)d_ws;
#if N_LAUNCH_MODE == 1
    a.ph_lo = 0; a.ph_hi = NPH;
    hipLaunchKernelGGL(fwd_kernel, dim3(grid), dim3(512), LDS_BYTES, stream, a);
#else
    for (int p = 0; p < NPH; ++p) { a.ph_lo = p; a.ph_hi = p + 1; hipLaunchKernelGGL(fwd_kernel, dim3(grid), dim3(512), LDS_BYTES, stream, a); }
#endif
}
```

```cpp
#include <hip/hip_runtime.h>
#include <cstdio>
#include <cstdint>

#ifndef N_LAUNCH_MODE
#define N_LAUNCH_MODE 1
#endif

namespace {
typedef unsigned short bf16_t;
typedef short bf16x8 __attribute__((ext_vector_type(8)));
typedef float f32x4 __attribute__((ext_vector_type(4)));
typedef unsigned u32x2 __attribute__((ext_vector_type(2)));
typedef unsigned u32x4 __attribute__((ext_vector_type(4)));
#define LAS __attribute__((address_space(3)))

constexpr int D = 1024, NB = 8, SEQ = 4096, CTXL = 256, NLAT = NB * SEQ, NCTX = NB * CTXL, T = NLAT + NCTX;
constexpr int NLAYER = 2;
constexpr int UC = 3584;
constexpr int INC = 3592;
constexpr int NE = 16;
constexpr float ALPHA = 1.41421356237309515f;
constexpr float LN_EPS = 1e-5f, RMS_EPS = 1e-6f;
constexpr int MAXTILES = 288;

enum { I_X = 0, I_C, I_CTX, I_CCTX, I_WADA, I_BADA, I_WIN, I_HYCW, I_HYCB, I_HYW1, I_HYB1, I_HYF1, I_HYW2, I_HYB2, I_HYF2, I_HYW3, I_HYDEC, I_HYBIAS,
       I_SCCW, I_HGLB, I_HGNG, I_SSDCW, I_SSDCB, I_SSDALOG, I_SSDDTB, I_SSDD, I_SSDNG, I_WGATE, I_BGATE, I_WBR, I_WO, I_LN1G, I_LN1B, I_LN2G, I_LN2B,
       I_WROUTER, I_BROUTER, I_WE1, I_WE3, I_WE2, N_IN };

constexpr size_t al256(size_t x) { return (x + 255) & ~(size_t)255; }
constexpr size_t WS_CTL = 0;
constexpr size_t CTL_BYTES = 65536;
constexpr size_t CTL_CNT = 16384;
constexpr size_t WS_MOD = WS_CTL + CTL_BYTES;
constexpr size_t WS_LB = WS_MOD + al256((size_t)NLAYER * 9 * 6144 * 4);
constexpr size_t WS_TW = WS_LB + 4096;
constexpr size_t WS_H2TAB = WS_TW + 65536;
constexpr size_t WS_PART = WS_H2TAB + (size_t)8448 * 64 * 4;
constexpr size_t WS_FILT = WS_PART + (size_t)3 * 64 * 512 * 4;
constexpr size_t WS_FILTC = WS_FILT + (size_t)2 * 8192 * 256 * 4;
constexpr size_t WS_CX32 = WS_FILTC + (size_t)512 * 256 * 4;
constexpr size_t WS_DT = WS_CX32 + (size_t)NCTX * D * 4;
constexpr size_t WS_SSQ = WS_DT + (size_t)T * 8 * 4;
constexpr size_t WS_TOKE = WS_SSQ + (size_t)T * 4 * 4;
constexpr size_t WS_TOKW = WS_TOKE + (size_t)T * 2 * 4;
constexpr size_t WS_TOKS = WS_TOKW + (size_t)T * 2 * 4;
constexpr size_t WS_LIST = WS_TOKS + (size_t)T * 2 * 4;
constexpr size_t WS_BGP = WS_LIST + (size_t)NE * T * 4;
constexpr size_t WS_DEC = WS_BGP + 16384;
constexpr size_t WS_WIN = WS_DEC + (size_t)4352 * 64 * 4;
constexpr size_t WS_WG = WS_WIN + (size_t)UC * D * 2;
constexpr size_t WS_WBR = WS_WG + (size_t)4096 * D * 2;
constexpr size_t WS_WO = WS_WBR + (size_t)4096 * 256 * 2;
constexpr size_t WS_HBUF = WS_WO + (size_t)D * D * 2;
constexpr size_t WS_BR = WS_HBUF + (size_t)T * D * 2;
constexpr size_t WS_BIG = WS_BR + (size_t)T * D * 2;
constexpr size_t BIG_U = 0;
constexpr size_t BIG_HGO = BIG_U + (size_t)T * UC * 2;
constexpr size_t BIG_STATE = BIG_HGO;
constexpr size_t BIG_SSY = BIG_HGO + (size_t)T * 256 * 4;
constexpr size_t BIG_WT = BIG_SSY + (size_t)T * 256 * 4;
constexpr size_t BIG_END1 = BIG_WT + (size_t)T * 256 * 2;
constexpr size_t BIG_P = 0;
constexpr size_t BIG_HID = 0;
constexpr size_t BIG_YE = BIG_HID + (size_t)MAXTILES * 256 * 512 * 2;
constexpr size_t BIG_W13 = BIG_YE + (size_t)MAXTILES * 256 * 1024 * 2;
constexpr size_t BIG_W2 = BIG_W13 + (size_t)NE * 1024 * 1024 * 2;
constexpr size_t BIG_END3 = BIG_W2 + (size_t)NE * 1024 * 512 * 2;
constexpr size_t BIG_BYTES = BIG_END1 > BIG_END3 ? BIG_END1 : BIG_END3;
constexpr size_t WS_END = WS_BIG + BIG_BYTES;
static_assert((size_t)T * 4096 * 2 <= BIG_BYTES, "P fits");
static_assert(WS_END <= (size_t)536870912, "workspace budget");

constexpr int LDS_BYTES = 147456;
constexpr int LDS_MISC = 147456 - 256;

struct Args { const float* in[N_IN]; float* out; unsigned char* ws; int ph_lo, ph_hi; };

#define XB_TMO      128
#define XB_XCNT(j)  (256  + 64 * (j))
#define XB_XSUB(j)  (1280 + 64 * (j))
#define XB_XGEN(j)  (2304 + 64 * (j))
#define XB_TOP      3328
#define XB_TOPGEN   3392
#define XCD_BAR_WORDS 3456
#define XB_SPIN_CAP (1u << 18)
__device__ __forceinline__ unsigned xb_ld(unsigned* p)              { return __hip_atomic_load(p, __ATOMIC_RELAXED, __HIP_MEMORY_SCOPE_AGENT); }
__device__ __forceinline__ unsigned xb_add(unsigned* p, unsigned v) { return __hip_atomic_fetch_add(p, v, __ATOMIC_RELAXED, __HIP_MEMORY_SCOPE_AGENT); }
__device__ __forceinline__ unsigned xb_xcc_id() { return (unsigned)__builtin_amdgcn_s_getreg((3 << 11) | 20) & 0xFu; }
#define XB_SPIN(cond, bar) do { unsigned _sp = 0; while (cond) { __builtin_amdgcn_s_sleep(1); \
    if ((++_sp & 255u) == 0u) { if (xb_ld(&(bar)[XB_TMO])) break; if (_sp > XB_SPIN_CAP) { atomicAdd(&(bar)[XB_TMO], 1u); break; } } } } while (0)
struct XcdBarrier { unsigned* bar; unsigned x; volatile LAS unsigned* st; };
__device__ __forceinline__ int lane_id() { unsigned z = 0u; asm volatile("" : "+v"(z)); return (int)__builtin_amdgcn_mbcnt_hi(~0u, __builtin_amdgcn_mbcnt_lo(~0u, z)); }
__device__ __forceinline__ bool is_thread0(int wave_s) { return wave_s == 0 && lane_id() == 0; }
__device__ __forceinline__ XcdBarrier xcd_barrier_post(unsigned* bar, volatile LAS unsigned* st, int wave_s) {
    XcdBarrier b; b.bar = bar; b.x = xb_xcc_id(); b.st = st;
    if (is_thread0(wave_s)) (void)xb_add(&bar[XB_XCNT(b.x)], 1u);
    return b;
}
__device__ __forceinline__ void xcd_barrier_complete(unsigned* bar, unsigned x, unsigned& nloc, unsigned& nx) {
    const unsigned G = gridDim.x * gridDim.y * gridDim.z;
    unsigned sum, cnt, mine, sp = 0u;
    for (;;) {
        sum = 0u; cnt = 0u; mine = 0u;
#pragma unroll
        for (unsigned j = 0; j < 16; ++j) { const unsigned c = xb_ld(&bar[XB_XCNT(j)]); sum += c; cnt += (c > 0u) ? 1u : 0u; mine = (j == x) ? c : mine; }
        if (sum == G) break;
        __builtin_amdgcn_s_sleep(1);
        if ((++sp & 255u) == 0u) { if (xb_ld(&bar[XB_TMO])) break; if (sp > XB_SPIN_CAP) { atomicAdd(&bar[XB_TMO], 1u); break; } }
    }
    nloc = mine > 0u ? mine : 1u; nx = cnt > 0u ? cnt : 1u;
}
__device__ __forceinline__ void xcd_barrier(const XcdBarrier& b, int wave_s) {
    asm volatile("s_waitcnt vmcnt(0)" ::: "memory");
    __syncthreads();
    if (is_thread0(wave_s)) {
        unsigned* bar = b.bar;
        __builtin_amdgcn_s_waitcnt(0);
        unsigned nloc = b.st[0], nx = b.st[1];
        if (nloc == 0u) { xcd_barrier_complete(bar, b.x, nloc, nx); b.st[0] = nloc; b.st[1] = nx; }
        const unsigned old = xb_add(&bar[XB_XSUB(b.x)], 1u);
        const unsigned gen = old / nloc;
        if (old + 1u == (gen + 1u) * nloc) {
            __builtin_amdgcn_fence(__ATOMIC_RELEASE, "agent");
            asm volatile("s_waitcnt vmcnt(0)" ::: "memory");
            const unsigned og = xb_add(&bar[XB_TOP], 1u);
            const unsigned tg = og / nx;
            if (og + 1u == (tg + 1u) * nx) xb_add(&bar[XB_TOPGEN], 1u);
            else XB_SPIN(xb_ld(&bar[XB_TOPGEN]) == tg, bar);
            __builtin_amdgcn_fence(__ATOMIC_ACQUIRE, "agent");
            xb_add(&bar[XB_XGEN(b.x)], 1u);
            asm volatile("s_waitcnt vmcnt(0)" ::: "memory");
        } else {
            XB_SPIN(xb_ld(&bar[XB_XGEN(b.x)]) == gen, bar);
            __builtin_amdgcn_fence(__ATOMIC_ACQUIRE, "agent");
            asm volatile("s_waitcnt vmcnt(0)" ::: "memory");
        }
    }
    __syncthreads();
}

__device__ __forceinline__ float bf2f(bf16_t b) { return __uint_as_float(((unsigned)b) << 16); }
typedef __bf16 hwbf2 __attribute__((ext_vector_type(2)));
typedef float hwf2 __attribute__((ext_vector_type(2)));
__device__ __forceinline__ unsigned pack2(float lo, float hi) { const hwf2 v = {lo, hi}; return __builtin_bit_cast(unsigned, __builtin_convertvector(v, hwbf2)); }
__device__ __forceinline__ bf16_t f2bf(float f) { return (bf16_t)(pack2(f, 0.f) & 0xffffu); }
__device__ __forceinline__ float zero_f() { float z = 0.f; asm volatile("" : "+v"(z)); return z; }
__device__ __forceinline__ float kconst(float c) { asm volatile("" : "+s"(c)); return c; }
__device__ __forceinline__ float fexp(float x) { return __builtin_amdgcn_exp2f(x * kconst(1.4426950408889634f)); }
__device__ __forceinline__ float flog(float x) { return __builtin_amdgcn_logf(x) * kconst(0.6931471805599453f); }
__device__ __forceinline__ float sigmoidf_(float x) { return __builtin_amdgcn_rcpf(1.0f + fexp(-x)); }
__device__ __forceinline__ float siluf_(float x) { return x * sigmoidf_(x); }
__device__ __forceinline__ float wave_sum(float v) {
#pragma unroll
    for (int o = 32; o >= 1; o >>= 1) v += __shfl_xor(v, o);
    return v;
}
__device__ __forceinline__ int row_modidx(int r) { return r < NLAT ? (r >> 12) : 8; }
__device__ __forceinline__ bool row_has_prev(int r) { return r < NLAT ? ((r & 4095) != 0) : (((r - NLAT) & 255) != 0); }
__device__ __forceinline__ bool row_has_next(int r) { return r < NLAT ? ((r & 4095) != 4095) : (((r - NLAT) & 255) != 255); }

#define AS1 __attribute__((address_space(1)))
#define AS4 __attribute__((address_space(4)))
struct Ptrs {
    float* out; unsigned char* ws; int tid, bid, G;
    __device__ __forceinline__ const float* inp(int i) const { asm volatile("" : "+s"(i));
        const __attribute__((address_space(4))) char* ka = (const __attribute__((address_space(4))) char*)__builtin_amdgcn_kernarg_segment_ptr();
        return (const float*)(*(const AS1 float* const AS4*)(ka + 8 * i)); }
    __device__ __forceinline__ float* latrow(int r) const { return r < NLAT ? out + (size_t)r * D : (float*)(ws + WS_CX32) + (size_t)(r - NLAT) * D; }
    __device__ __forceinline__ float* mod(int l, int ridx) const { return (float*)(ws + WS_MOD) + ((size_t)l * 9 + ridx) * 6144; }
};

__device__ __forceinline__ float conv3_u(const bf16_t* U, int row, int col, const float* w, int ncol, int wcol) {
    const bool hp = row_has_prev(row), hn = row_has_next(row);
    const float c = bf2f(U[(size_t)row * UC + col]), p = bf2f(U[(size_t)(hp ? row - 1 : row) * UC + col]), n = bf2f(U[(size_t)(hn ? row + 1 : row) * UC + col]);
    return c * w[ncol + wcol] + (hp ? p * w[wcol] : 0.f) + (hn ? n * w[2 * ncol + wcol] : 0.f);
}

struct Unit { int pm, pn, e, aux; };
__host__ __device__ __forceinline__ int perm32(int rho) { const int n = rho >> 4, i = rho & 15; return 8 * (i >> 2) + 4 * n + (i & 3); }

template <class RowMap, class Epi>
__device__ __forceinline__ void sgemm_unit(int tid_, const bf16_t* __restrict__ A, int lda, const bf16_t* __restrict__ Bt, int ldb, int K, const Unit& u, const RowMap& RM, const Epi& E) {
    const int tid = tid_, wid = tid >> 6, lane = tid & 63, wr = wid >> 2, wc = wid & 3, fr = lane & 15, fq = lane >> 4;
    f32x4 acc[2][2][4][2];
#pragma unroll
    for (int a = 0; a < 2; ++a)
#pragma unroll
        for (int b = 0; b < 2; ++b)
#pragma unroll
            for (int m = 0; m < 4; ++m)
#pragma unroll
                for (int n = 0; n < 2; ++n) acc[a][b][m][n] = (f32x4){0.f, 0.f, 0.f, 0.f};
    unsigned ap[2][4], bp[2][2];
#pragma unroll
    for (int a = 0; a < 2; ++a)
#pragma unroll
        for (int m = 0; m < 4; ++m) ap[a][m] = (unsigned)RM(u, 128 * a + 64 * wr + 16 * m + fr) * (unsigned)lda + fq * 8;
#pragma unroll
    for (int b = 0; b < 2; ++b)
#pragma unroll
        for (int n = 0; n < 2; ++n) { const int rho = 16 * n + fr; const int col = Epi::PERM ? perm32(rho) : rho;
            bp[b][n] = (unsigned)(u.pn * 256 + 128 * b + 32 * wc + col) * (unsigned)ldb + fq * 8; }
    for (int k = 0; k < K; k += 32) {
        bf16x8 bfr[2][2];
#pragma unroll
        for (int b = 0; b < 2; ++b)
#pragma unroll
            for (int n = 0; n < 2; ++n) bfr[b][n] = *(const bf16x8*)(Bt + (bp[b][n] + k));
#pragma unroll
        for (int a = 0; a < 2; ++a) {
            bf16x8 af[4];
#pragma unroll
            for (int m = 0; m < 4; ++m) af[m] = *(const bf16x8*)(A + (ap[a][m] + k));
#pragma unroll
            for (int b = 0; b < 2; ++b)
#pragma unroll
                for (int m = 0; m < 4; ++m)
#pragma unroll
                    for (int n = 0; n < 2; ++n) acc[a][b][m][n] = __builtin_amdgcn_mfma_f32_16x16x32_bf16(bfr[b][n], af[m], acc[a][b][m][n], 0, 0, 0);
        }
    }
    E(acc, u, wr, wc, fr, fq);
}

struct RowIdent { __device__ __forceinline__ int operator()(const Unit& u, int R) const { return u.pm * 256 + R; } };
struct RowStackK { int rows; __device__ __forceinline__ int operator()(const Unit& u, int R) const { return u.e * rows + u.pm * 256 + R; } };
struct RowGather { const int* list; const unsigned* cnt; __device__ __forceinline__ int operator()(const Unit& u, int R) const {
    const int idx = u.aux * 256 + R; const int* l = list + (size_t)u.e * T; return idx < (int)cnt[u.e] ? l[idx] : l[0]; } };


namespace pg8 {
constexpr int BM = 256, BK = 64, HALF = 128, HTB = HALF * BK * 2, STAGE_BYTES = 8 * HTB;
__host__ __device__ __forceinline__ int lds_byte(int r, int c) { const int st = (r >> 4) * 2 + (c >> 5), rr = r & 15, cc = c & 31, ob = rr * 64 + cc * 2; return st * 1024 + (ob ^ (((ob >> 9) & 1) << 5)); }
__host__ __device__ __forceinline__ void stage_rc(int b, int& R, int& C) { const int st = b / 1024, sb = b % 1024, swz = sb ^ (((sb >> 9) & 1) << 5); R = (st >> 1) * 16 + swz / 64; C = (st & 1) * 32 + (swz % 64) / 2; }
struct Gemm { const bf16_t* A; const bf16_t* Bt; int K; };

template <class Epi, class Sched, bool GATHER>
__device__ __forceinline__ void gemm_phase(int tid, LAS unsigned char* lds, const Gemm g, const Sched& S, const Epi& E) {
    const int wid = __builtin_amdgcn_readfirstlane(tid >> 6), lane = tid & 63, wr = wid >> 2, wc = wid & 3, fr = lane & 15, fq = lane >> 4;
    const int K = g.K, nt = K / BK;
    int RA[2], CA[2]; unsigned voffB[2];
    unsigned vA[2][2], vAn[2][2];
#pragma unroll
    for (int i = 0; i < 2; ++i) { int R, C; stage_rc(tid * 16 + i * 8192, R, C); RA[i] = R; CA[i] = C; const int Rb = Epi::PERM ? ((R & ~31) + perm32(R & 31)) : R; voffB[i] = (unsigned)(Rb * K + C) * 2u; }
    const size_t kstep = (size_t)(BK * 2);
    const size_t hstep = (size_t)HALF * K * 2;
    const size_t tstep = 2 * hstep;
    const unsigned ldsw = (unsigned)wid * 1024u;
    const int aoff = lds_byte(wr * 64 + fr, fq * 8), boff = lds_byte(wc * 32 + fr, fq * 8);
#define PG8_SA(b, h) (((b) * 2 + (h)) * HTB)
#define PG8_SB(b, h) ((4 + (b) * 2 + (h)) * HTB)
#define PG8_STAGE(bufoff, gbase, voff) do { _Pragma("unroll") for (int _i = 0; _i < 2; ++_i) \
        __builtin_amdgcn_global_load_lds((const unsigned*)((const char*)(gbase) + (voff)[_i]), (LAS unsigned*)(lds + (bufoff) + ldsw + _i * 8192), 16, 0, 0); } while (0)
#define PG8_STAGE2(bufoff, gbase, v0, v1) do { \
        __builtin_amdgcn_global_load_lds((const unsigned*)((const char*)(gbase) + (v0)), (LAS unsigned*)(lds + (bufoff) + ldsw), 16, 0, 0); \
        __builtin_amdgcn_global_load_lds((const unsigned*)((const char*)(gbase) + (v1)), (LAS unsigned*)(lds + (bufoff) + ldsw + 8192), 16, 0, 0); } while (0)
#define PG8_LDA(dst, b, h) do { _Pragma("unroll") for (int m = 0; m < 4; ++m) _Pragma("unroll") for (int k = 0; k < 2; ++k) dst[m][k] = *(const LAS bf16x8*)(lds + PG8_SA(b, h) + aoff + m * 2048 + k * 1024); } while (0)
#define PG8_LDB(dst, b, h) do { _Pragma("unroll") for (int n = 0; n < 2; ++n) _Pragma("unroll") for (int k = 0; k < 2; ++k) dst[n][k] = *(const LAS bf16x8*)(lds + PG8_SB(b, h) + boff + n * 2048 + k * 1024); } while (0)
#define PG8_MMA(ai, bj, At, Bt) do { __builtin_amdgcn_s_setprio(1); _Pragma("unroll") for (int m = 0; m < 4; ++m) _Pragma("unroll") for (int n = 0; n < 2; ++n) _Pragma("unroll") for (int k = 0; k < 2; ++k) \
        acc[ai][bj][m][n] = __builtin_amdgcn_mfma_f32_16x16x32_bf16(Bt[n][k], At[m][k], acc[ai][bj][m][n], 0, 0, 0); __builtin_amdgcn_s_setprio(0); } while (0)
#define PG8_WAIT_V(n) asm volatile("s_waitcnt vmcnt(" #n ")" ::: "memory")
#define PG8_WAIT_L(n) asm volatile("s_waitcnt lgkmcnt(" #n ")" ::: "memory")
#define PG8_BAR __builtin_amdgcn_s_barrier()
#define PG8_SCHED __builtin_amdgcn_sched_barrier(0)
#define PG8_AOFFS(dst, unit) do { _Pragma("unroll") for (int _h = 0; _h < 2; ++_h) _Pragma("unroll") for (int _i = 0; _i < 2; ++_i) \
        dst[_h][_i] = GATHER ? ((unsigned)S.arow(unit, _h * HALF + RA[_i]) * (unsigned)K + (unsigned)CA[_i]) * 2u : ((unsigned)(_h * HALF + RA[_i]) * (unsigned)K + (unsigned)CA[_i]) * 2u; } while (0)
    Unit cur{0, 0, 0, 0}, nxt{0, 0, 0, 0}; int ui = 0;
    if (!S.next(0, cur)) return;
    f32x4 acc[2][2][4][2];
#pragma unroll
    for (int a = 0; a < 2; ++a)
#pragma unroll
        for (int b = 0; b < 2; ++b)
#pragma unroll
            for (int m = 0; m < 4; ++m)
#pragma unroll
                for (int n = 0; n < 2; ++n) acc[a][b][m][n] = (f32x4){0.f, 0.f, 0.f, 0.f};
    bf16x8 At[4][2], B0[2][2], B1[2][2];
    const char* cA = GATHER ? (const char*)g.A : (const char*)g.A + (size_t)cur.pm * tstep; const char* cB = (const char*)g.Bt + (size_t)cur.pn * tstep;
    PG8_AOFFS(vA, cur);
    PG8_STAGE(PG8_SB(0, 0), cB, voffB); PG8_STAGE(PG8_SB(0, 1), cB + hstep, voffB); PG8_STAGE2(PG8_SA(0, 0), cA, vA[0][0], vA[0][1]); PG8_STAGE2(PG8_SA(0, 1), cA, vA[1][0], vA[1][1]);
    if (wr == 1) PG8_BAR;
    PG8_WAIT_V(2); PG8_BAR;
    PG8_STAGE(PG8_SB(1, 0), cB + kstep, voffB); PG8_STAGE2(PG8_SA(1, 0), cA + kstep, vA[0][0], vA[0][1]); PG8_STAGE(PG8_SB(1, 1), cB + hstep + kstep, voffB);
    PG8_WAIT_V(6); PG8_BAR;
    for (;;) {
        const bool has_next = S.next(ui + 1, nxt);
        const char* nA = GATHER ? (const char*)g.A : (has_next ? (const char*)g.A + (size_t)nxt.pm * tstep : cA); const char* nB = has_next ? (const char*)g.Bt + (size_t)nxt.pn * tstep : cB;
        if (GATHER && has_next) { PG8_AOFFS(vAn, nxt); } else {
#pragma unroll
            for (int _h = 0; _h < 2; ++_h)
#pragma unroll
                for (int _i = 0; _i < 2; ++_i) vAn[_h][_i] = vA[_h][_i]; }
#pragma unroll 1
        for (int t = 0; t < nt; t += 2) {
            const bool last = (t == nt - 2);
            const char* a1 = cA + (size_t)(t + 1) * kstep;
            const char* a2 = last ? nA : cA + (size_t)(t + 2) * kstep; const char* b2 = last ? nB : cB + (size_t)(t + 2) * kstep;
            const char* a3 = a2 + kstep; const char* b3 = b2 + kstep;
            const unsigned x00 = (GATHER && last) ? vAn[0][0] : vA[0][0], x01 = (GATHER && last) ? vAn[0][1] : vA[0][1], x10 = (GATHER && last) ? vAn[1][0] : vA[1][0], x11 = (GATHER && last) ? vAn[1][1] : vA[1][1];
            PG8_LDB(B0, 0, 0); PG8_LDB(B1, 0, 1); PG8_SCHED; PG8_LDA(At, 0, 0); PG8_STAGE2(PG8_SA(1, 1), a1, vA[1][0], vA[1][1]);
            PG8_WAIT_V(8); PG8_WAIT_L(0); PG8_BAR; PG8_MMA(0, 0, At, B0); PG8_MMA(0, 1, At, B1); PG8_BAR; PG8_SCHED;
            PG8_LDA(At, 0, 1); PG8_STAGE(PG8_SB(0, 0), b2, voffB); PG8_STAGE(PG8_SB(0, 1), b2 + hstep, voffB); PG8_STAGE2(PG8_SA(0, 0), a2, x00, x01);
            PG8_WAIT_V(8); PG8_WAIT_L(0); PG8_BAR; PG8_MMA(1, 0, At, B0); PG8_MMA(1, 1, At, B1); PG8_BAR; PG8_SCHED;
            PG8_LDB(B0, 1, 0); PG8_LDB(B1, 1, 1); PG8_SCHED; PG8_LDA(At, 1, 0); PG8_STAGE2(PG8_SA(0, 1), a2, x10, x11);
            PG8_WAIT_V(8); PG8_WAIT_L(0); PG8_BAR; PG8_MMA(0, 0, At, B0); PG8_MMA(0, 1, At, B1); PG8_BAR; PG8_SCHED;
            PG8_LDA(At, 1, 1); PG8_STAGE(PG8_SB(1, 0), b3, voffB); PG8_STAGE(PG8_SB(1, 1), b3 + hstep, voffB); PG8_STAGE2(PG8_SA(1, 0), a3, x00, x01);
            PG8_WAIT_V(8); PG8_WAIT_L(0); PG8_BAR; PG8_MMA(1, 0, At, B0); PG8_MMA(1, 1, At, B1); PG8_BAR; PG8_SCHED;
        }
        if (wr == 0) PG8_BAR;
        E(acc, cur, wr, wc, fr, fq);
        if (!has_next) break;
#pragma unroll
        for (int a = 0; a < 2; ++a)
#pragma unroll
            for (int b = 0; b < 2; ++b)
#pragma unroll
                for (int m = 0; m < 4; ++m)
#pragma unroll
                    for (int n = 0; n < 2; ++n) acc[a][b][m][n] = (f32x4){0.f, 0.f, 0.f, 0.f};
        cur = nxt; cA = nA; cB = nB; ++ui;
        if (GATHER) {
#pragma unroll
        for (int _h = 0; _h < 2; ++_h)
#pragma unroll
            for (int _i = 0; _i < 2; ++_i) vA[_h][_i] = vAn[_h][_i]; }
        if (wr == 1) PG8_BAR;
    }
    PG8_WAIT_V(0);
    PG8_BAR;
#undef PG8_SA
#undef PG8_SB
#undef PG8_STAGE
#undef PG8_STAGE2
#undef PG8_LDA
#undef PG8_LDB
#undef PG8_MMA
#undef PG8_WAIT_V
#undef PG8_WAIT_L
#undef PG8_BAR
#undef PG8_SCHED
#undef PG8_AOFFS
}
}

struct XOrder { int G, c, MT, NT;
    __device__ __forceinline__ bool map(int i, int& pm, int& pn) const {
        if ((G & 7) == 0 && (MT & 7) == 0) { const int x = c & 7, r = c >> 3, W = G >> 3, MX = MT >> 3; const int L = i * W + r; if (L >= MX * NT) return false; pm = x * MX + L / NT; pn = L % NT; return true; }
        const int L = i * G + c; if (L >= MT * NT) return false; pm = L / NT; pn = L % NT; return true; } };
struct SchedG1 { XOrder X; __device__ __forceinline__ bool next(int i, Unit& u) const { int pm, pn; if (!X.map(i, pm, pn)) return false; u.pm = pm; u.pn = pn; u.e = 0; u.aux = 0; return true; }
    __device__ __forceinline__ int arow(const Unit&, int) const { return 0; } };
struct SchedG2 { XOrder X; __device__ __forceinline__ bool next(int i, Unit& u) const { int pm, q; if (!X.map(i, pm, q)) return false; const int k = q >> 2, pnn = q & 3;
        u.pm = k * (T / 256) + pm; u.pn = k * 4 + pnn; u.e = k; u.aux = pnn; return true; }
    __device__ __forceinline__ int arow(const Unit&, int) const { return 0; } };
struct SchedMN { XOrder X; __device__ __forceinline__ bool next(int i, Unit& u) const { int pm, pn; if (!X.map(i, pm, pn)) return false; u.pm = pm; u.pn = pn; u.e = 0; u.aux = 0; return true; }
    __device__ __forceinline__ int arow(const Unit&, int) const { return 0; } };

struct EpiBf16Plain {
    static constexpr bool PERM = true;
    bf16_t* O; int ldc; int coltile_mask;
    __device__ __forceinline__ void operator()(const f32x4 (&acc)[2][2][4][2], const Unit& u, int wr, int wc, int fr, int fq) const {
        const int row0 = u.pm * 256 + wr * 64 + fr, col0 = (u.pn & coltile_mask) * 256 + wc * 32 + 8 * fq;
#pragma unroll
        for (int ai = 0; ai < 2; ++ai)
#pragma unroll
            for (int m = 0; m < 4; ++m) { bf16_t* rowp = O + ((unsigned)(row0 + ai * 128 + m * 16) * (unsigned)ldc + (unsigned)col0);
#pragma unroll
                for (int bj = 0; bj < 2; ++bj) { const f32x4 v0 = acc[ai][bj][m][0], v1 = acc[ai][bj][m][1];
                    u32x4 w; w.x = pack2(v0[0], v0[1]); w.y = pack2(v0[2], v0[3]); w.z = pack2(v1[0], v1[1]); w.w = pack2(v1[2], v1[3]);
                    *(u32x4*)(rowp + bj * 128) = w; } }
    }
};
struct EpiP {
    static constexpr bool PERM = true;
    bf16_t* P; const float* ssq;
    __device__ __forceinline__ void operator()(const f32x4 (&acc)[2][2][4][2], const Unit& u, int wr, int wc, int fr, int fq) const {
        const int k = u.e; const int pmt = u.pm - k * (T / 256);
        const unsigned c00 = (unsigned)(u.aux * 256 + wc * 32 + 8 * fq);
        const unsigned base = (unsigned)pmt * (16u * 256u * 256u) + (unsigned)k * 16384u;
#pragma unroll
        for (int ai = 0; ai < 2; ++ai)
#pragma unroll
            for (int m = 0; m < 4; ++m) { const int r = ai * 128 + wr * 64 + m * 16 + fr; float sc = 1.0f;
                if (k == 3) { const float* qp = ssq + (size_t)(pmt * 256 + r) * 4; sc = rsqrtf((qp[0] + qp[1] + qp[2] + qp[3]) * (1.0f / 256.0f) + kconst(RMS_EPS)); }
#pragma unroll
                for (int bj = 0; bj < 2; ++bj) { const unsigned c0 = c00 + bj * 128; const unsigned s = c0 >> 6, wi = c0 & 63;
                    const f32x4 v0 = acc[ai][bj][m][0] * sc, v1 = acc[ai][bj][m][1] * sc;
                    u32x4 w; w.x = pack2(v0[0], v0[1]); w.y = pack2(v0[2], v0[3]); w.z = pack2(v1[0], v1[1]); w.w = pack2(v1[2], v1[3]);
                    *(u32x4*)(P + (base + s * 65536u + (wi >> 4) * 4096u + (unsigned)r * 16u + (wi & 15u))) = w; }
                asm volatile("" ::: "memory"); }
    }
};
struct EpiMerge {
    static constexpr bool PERM = false;
    const bf16_t* P; const float* bgp; bf16_t* Y;
    __device__ __forceinline__ void operator()(const f32x4 (&acc)[2][2][4][2], const Unit& u, int wr, int wc, int fr, int fq) const {
        const int s = u.pn;
        f32x4 bv[2][2];
#pragma unroll
        for (int bj = 0; bj < 2; ++bj)
#pragma unroll
            for (int n = 0; n < 2; ++n) bv[bj][n] = *(const f32x4*)(bgp + s * 256 + bj * 128 + wc * 32 + n * 16 + 4 * fq);
#pragma unroll
        for (int ai = 0; ai < 2; ++ai)
#pragma unroll
            for (int m = 0; m < 4; ++m) { const int r = ai * 128 + wr * 64 + m * 16 + fr;
                const unsigned po = ((unsigned)u.pm * 16u + (unsigned)s) * 65536u + (unsigned)(wc * 4096 + r * 16 + 4 * fq);
                f32x4 y = (f32x4){0.f, 0.f, 0.f, 0.f};
#pragma unroll
                for (int bj = 0; bj < 2; ++bj)
#pragma unroll
                    for (int n = 0; n < 2; ++n) { const int k = 2 * bj + n; const u32x2 pw = *(const u32x2*)(P + (po + k * 16384u));
                        const f32x4 g = acc[ai][bj][m][n] + bv[bj][n];
                        y[0] += sigmoidf_(g[0]) * __uint_as_float(pw.x << 16); y[1] += sigmoidf_(g[1]) * __uint_as_float(pw.x & 0xffff0000u);
                        y[2] += sigmoidf_(g[2]) * __uint_as_float(pw.y << 16); y[3] += sigmoidf_(g[3]) * __uint_as_float(pw.y & 0xffff0000u); }
                u32x2 w; w.x = pack2(y[0], y[1]); w.y = pack2(y[2], y[3]);
                *(u32x2*)(Y + ((unsigned)(u.pm * 256 + r) * (unsigned)D + (unsigned)(s * 64 + wc * 16 + 4 * fq))) = w; }
    }
};
struct EpiWo {
    static constexpr bool PERM = false;
    Ptrs P; int layer;
    __device__ __forceinline__ void operator()(const f32x4 (&acc)[2][2][4][2], const Unit& u, int wr, int wc, int fr, int fq) const {
        const int col0 = u.pn * 256 + wc * 32 + 4 * fq;
#pragma unroll
        for (int ai = 0; ai < 2; ++ai)
#pragma unroll
            for (int m = 0; m < 4; ++m) { const int row = u.pm * 256 + ai * 128 + wr * 64 + m * 16 + fr;
                float* lp = P.latrow(row) + col0; const float* g1 = P.mod(layer, row_modidx(row)) + 2048 + col0;
#pragma unroll
                for (int bj = 0; bj < 2; ++bj)
#pragma unroll
                    for (int n = 0; n < 2; ++n) { const f32x4 x = *(const f32x4*)(lp + bj * 128 + n * 16); const f32x4 g = *(const f32x4*)(g1 + bj * 128 + n * 16);
                        *(f32x4*)(lp + bj * 128 + n * 16) = x * ALPHA + g * acc[ai][bj][m][n]; } }
    }
};
struct EpiFfn1 {
    static constexpr bool PERM = false;
    bf16_t* H;
    __device__ __forceinline__ void operator()(const f32x4 (&acc)[2][2][4][2], const Unit& u, int wr, int wc, int fr, int fq) const {
        const int pnn = u.pn & 3;
#pragma unroll
        for (int ai = 0; ai < 2; ++ai)
#pragma unroll
            for (int m = 0; m < 4; ++m) { const int pos = u.pm * 256 + ai * 128 + wr * 64 + m * 16 + fr;
#pragma unroll
                for (int bj = 0; bj < 2; ++bj) { const f32x4 a = acc[ai][bj][m][0], b = acc[ai][bj][m][1];
                    u32x2 w; w.x = pack2(siluf_(a[0]) * b[0], siluf_(a[1]) * b[1]); w.y = pack2(siluf_(a[2]) * b[2], siluf_(a[3]) * b[3]);
                    *(u32x2*)(H + ((unsigned)pos * 512u + (unsigned)(pnn * 128 + bj * 64 + wc * 16 + 4 * fq))) = w; } }
    }
};

template <class SrcFn>
__device__ __forceinline__ void conv_tile(int tid, LAS float* tile  , bf16_t* dst, int ldd, int n0, int k0, const SrcFn& src) {
    f32x4 v[8];
#pragma unroll
    for (int i = 0; i < 8; ++i) { const int kk = (tid >> 4) + 32 * i, j4 = tid & 15; v[i] = *(const f32x4*)src(k0 + kk, n0 + 4 * j4); }
#pragma unroll
    for (int i = 0; i < 8; ++i) { const int kk = (tid >> 4) + 32 * i, j4 = tid & 15; LAS float* t = tile + kk * 65 + 4 * j4; t[0] = v[i][0]; t[1] = v[i][1]; t[2] = v[i][2]; t[3] = v[i][3]; }
    __syncthreads();
    { const int jj = tid >> 3, kq = tid & 7;
#pragma unroll
      for (int kb = 0; kb < 4; ++kb) { float x[8];
#pragma unroll
          for (int i = 0; i < 8; ++i) x[i] = tile[(64 * kb + 8 * kq + i) * 65 + jj];
          u32x4 w; w.x = pack2(x[0], x[1]); w.y = pack2(x[2], x[3]); w.z = pack2(x[4], x[5]); w.w = pack2(x[6], x[7]);
          *(u32x4*)(dst + (size_t)(n0 + jj) * ldd + k0 + 64 * kb + 8 * kq) = w; } }
    __syncthreads();
}
constexpr int NCONV_NE = 56 * 4 + 64 * 4 + 64 * 1 + 16 * 4;
constexpr int NCONV_EX = NE * (16 * 4 + 16 * 2);
__device__ __forceinline__ int gate_srccol(int np) { const int s = np >> 8, bj = (np >> 7) & 1, wc = (np >> 5) & 3, n = (np >> 4) & 1, fqe = np & 15; return (2 * bj + n) * 1024 + 64 * s + 16 * wc + fqe; }
__device__ __forceinline__ void conv_unit_ne(const Ptrs P, int l, int t, LAS float* tile) {
    unsigned char* ws = P.ws;
    if (t < 224) { const int nt = t >> 2, kt = t & 3; const float* src = P.inp(I_WIN) + (size_t)l * D * INC;
        conv_tile(P.tid, tile, (bf16_t*)(ws + WS_WIN), D, nt * 64, kt * 256, [=](int k, int n) { return src + (size_t)k * INC + n; });
    } else if (t < 224 + 256) { t -= 224; const int nt = t >> 2, kt = t & 3; const float* src = P.inp(I_WGATE) + (size_t)l * D * 4096;
        conv_tile(P.tid, tile, (bf16_t*)(ws + WS_WG), D, nt * 64, kt * 256, [=](int k, int n) { return src + (size_t)k * 4096 + gate_srccol(n); });
        if (kt == 0 && P.tid < 64) { const int np = nt * 64 + P.tid; ((float*)(ws + WS_BGP))[np] = P.inp(I_BGATE)[(size_t)l * 4096 + gate_srccol(np)]; }
    } else if (t < 224 + 256 + 64) { t -= 480; const int nt = t; const int kb = nt >> 4;
        const float* src = P.inp(I_WBR) + ((size_t)l * 4 + kb) * 256 * 1024;
        conv_tile(P.tid, tile, (bf16_t*)(ws + WS_WBR), 256, nt * 64, 0, [=](int k, int n) { return src + (size_t)k * 1024 + (n & 1023); });
    } else { t -= 544; const int nt = t >> 2, kt = t & 3; const float* src = P.inp(I_WO) + (size_t)l * D * D;
        conv_tile(P.tid, tile, (bf16_t*)(ws + WS_WO), D, nt * 64, kt * 256, [=](int k, int n) { return src + (size_t)k * D + n; });
    }
}
__device__ __forceinline__ void conv_unit_ex(const Ptrs P, int l, int t, LAS float* tile) {
    unsigned char* ws = P.ws;
    const int e = t / 96; t -= e * 96;
    if (t < 64) { const int nt = t >> 2, kt = t & 3;
        const float* s1 = P.inp(I_WE1) + ((size_t)l * NE + e) * 1024 * 512; const float* s3 = P.inp(I_WE3) + ((size_t)l * NE + e) * 1024 * 512;
        conv_tile(P.tid, tile, (bf16_t*)(ws + WS_BIG + BIG_W13) + (size_t)e * 1024 * 1024, 1024, nt * 64, kt * 256, [=](int k, int n) {
            const int pn = n >> 8, bj = (n >> 7) & 1, wc = (n >> 5) & 3, nn = (n >> 4) & 1, fqe = n & 15; const int ch = 128 * pn + 64 * bj + 16 * wc + fqe;
            return (nn ? s3 : s1) + (size_t)k * 512 + ch; });
    } else { t -= 64; const int nt = t >> 1, kt = t & 1; const float* src = P.inp(I_WE2) + ((size_t)l * NE + e) * 512 * 1024;
        conv_tile(P.tid, tile, (bf16_t*)(ws + WS_BIG + BIG_W2) + (size_t)e * 1024 * 512, 512, nt * 64, kt * 256, [=](int k, int n) { return src + (size_t)k * 1024 + n; });
    }
}

struct RowV { f32x4 v[4]; };
__device__ __forceinline__ void row_load(RowV& r, const float* p, int lane) {
#pragma unroll
    for (int i = 0; i < 4; ++i) r.v[i] = *(const f32x4*)(p + i * 256 + lane * 4);
}
__device__ __forceinline__ void row_store(const RowV& r, float* p, int lane) {
#pragma unroll
    for (int i = 0; i < 4; ++i) *(f32x4*)(p + i * 256 + lane * 4) = r.v[i];
}
__device__ __forceinline__ void row_layernorm(RowV& r, const float* g, const float* b, int lane) {
    float s = 0.f;
#pragma unroll
    for (int i = 0; i < 4; ++i) s += r.v[i][0] + r.v[i][1] + r.v[i][2] + r.v[i][3];
    const float mu = wave_sum(s) * (1.0f / 1024.0f);
    float q = 0.f;
#pragma unroll
    for (int i = 0; i < 4; ++i) { const f32x4 d = r.v[i] - mu; q += d[0] * d[0] + d[1] * d[1] + d[2] * d[2] + d[3] * d[3]; }
    const float rstd = rsqrtf(wave_sum(q) * (1.0f / 1024.0f) + kconst(LN_EPS));
#pragma unroll
    for (int i = 0; i < 4; ++i) { const f32x4 gg = *(const f32x4*)(g + i * 256 + lane * 4), bb = *(const f32x4*)(b + i * 256 + lane * 4); r.v[i] = (r.v[i] - mu) * rstd * gg + bb; }
}
__device__ __forceinline__ void row_layernorm_r(RowV& r, const RowV& g, const RowV& b) {
    float s = 0.f;
#pragma unroll
    for (int i = 0; i < 4; ++i) s += r.v[i][0] + r.v[i][1] + r.v[i][2] + r.v[i][3];
    const float mu = wave_sum(s) * (1.0f / 1024.0f);
    float q = 0.f;
#pragma unroll
    for (int i = 0; i < 4; ++i) { const f32x4 d = r.v[i] - mu; q += d[0] * d[0] + d[1] * d[1] + d[2] * d[2] + d[3] * d[3]; }
    const float rstd = rsqrtf(wave_sum(q) * (1.0f / 1024.0f) + kconst(LN_EPS));
#pragma unroll
    for (int i = 0; i < 4; ++i) r.v[i] = (r.v[i] - mu) * rstd * g.v[i] + b.v[i];
}
__device__ __forceinline__ void row_modulate(const RowV& r, RowV& h, const float* sh, const float* sc, int lane) {
#pragma unroll
    for (int i = 0; i < 4; ++i) { const f32x4 a = *(const f32x4*)(sc + i * 256 + lane * 4), b = *(const f32x4*)(sh + i * 256 + lane * 4); h.v[i] = r.v[i] * (a + 1.0f) + b; }
}
__device__ __forceinline__ void row_modulate_r(const RowV& r, RowV& h, const RowV& sh, const RowV& sc) {
#pragma unroll
    for (int i = 0; i < 4; ++i) h.v[i] = r.v[i] * (sc.v[i] + 1.0f) + sh.v[i];
}
__device__ __forceinline__ void row_store_bf16(const RowV& h, bf16_t* p, int lane) {
#pragma unroll
    for (int i = 0; i < 4; ++i) { u32x2 w; w.x = pack2(h.v[i][0], h.v[i][1]); w.y = pack2(h.v[i][2], h.v[i][3]); *(u32x2*)(p + i * 256 + lane * 4) = w; }
}
__device__ __forceinline__ void row_dt(const RowV& h, const LAS float* wdt, float* dtout, int lane) {
    float a[8];
#pragma unroll
    for (int j = 0; j < 8; ++j) a[j] = 0.f;
#pragma unroll
    for (int i = 0; i < 4; ++i)
#pragma unroll
        for (int e = 0; e < 4; ++e) { const int k = i * 256 + lane * 4 + e; const float hv = h.v[i][e];
            const f32x4 w0 = *(const LAS f32x4*)(wdt + k * 8), w1 = *(const LAS f32x4*)(wdt + k * 8 + 4);
            a[0] += hv * w0[0]; a[1] += hv * w0[1]; a[2] += hv * w0[2]; a[3] += hv * w0[3]; a[4] += hv * w1[0]; a[5] += hv * w1[1]; a[6] += hv * w1[2]; a[7] += hv * w1[3]; }
#pragma unroll
    for (int j = 0; j < 8; ++j) a[j] = wave_sum(a[j]);
    if (lane == 0) { *(f32x4*)dtout = (f32x4){a[0], a[1], a[2], a[3]}; *(f32x4*)(dtout + 4) = (f32x4){a[4], a[5], a[6], a[7]}; }
}
__device__ __forceinline__ void load_wdt(const Ptrs P, int l, LAS float* wdt) {
    const float* src = P.inp(I_WIN) + (size_t)l * D * INC + UC;
    for (int i = P.tid; i < 1024 * 8; i += 512) wdt[i] = src[(size_t)(i >> 3) * INC + (i & 7)];
    __syncthreads();
}

__device__ __forceinline__ void phase_pa(const Ptrs P, LAS unsigned char* lds) {
    const int tid = P.tid, wid = tid >> 6, lane = tid & 63, G = P.G;
    const int NU_MOD = 2 * 96, NU_H2 = 8448 / 8, NU_LB = 1;
    const int NU = NU_MOD + NU_H2 + NU_LB + NCONV_NE;
    for (int u = P.bid; u < NU; u += G) {
        if (u < NU_MOD) {
            const int l = u / 96, cb = u % 96;
            LAS float* sc = (LAS float*)lds; LAS float* red = sc + 9 * 1024;
            for (int i = tid; i < 9 * 1024; i += 512) { const int r = i >> 10, k = i & 1023; const float v = r < 8 ? P.inp(I_C)[r * 1024 + k] : P.inp(I_CCTX)[k]; sc[i] = v / (1.0f + fexp(-v)); }
            __syncthreads();
            const int col = cb * 64 + lane; const float* w = P.inp(I_WADA) + (size_t)l * D * 6144 + col;
            float acc[9];
#pragma unroll
            for (int r = 0; r < 9; ++r) acc[r] = 0.f;
            for (int k = wid * 128; k < wid * 128 + 128; ++k) { const float wv = w[(size_t)k * 6144];
#pragma unroll
                for (int r = 0; r < 9; ++r) acc[r] += sc[r * 1024 + k] * wv; }
#pragma unroll
            for (int r = 0; r < 9; ++r) red[(wid * 9 + r) * 64 + lane] = acc[r];
            __syncthreads();
            for (int i = tid; i < 9 * 64; i += 512) { const int r = i >> 6, c = i & 63; float s = P.inp(I_BADA)[(size_t)l * 6144 + cb * 64 + c];
#pragma unroll
                for (int w8 = 0; w8 < 8; ++w8) s += red[(w8 * 9 + r) * 64 + c];
                P.mod(l, r)[cb * 64 + c] = s; }
            __syncthreads();
        } else if (u < NU_MOD + NU_H2) {
            const int rho = (u - NU_MOD) * 8 + wid;
            const int l = (rho >= 4096 && rho < 8192) ? 1 : 0; const int L = rho < 8192 ? 4096 : 256; const int i = rho < 8192 ? (rho & 4095) : (rho - 8192);
            float featv = 0.f;
            if (lane == 0) featv = (float)((double)i / (double)(L - 1));
            else if (lane < 33) { const int j = (lane - 1) & 15; const double band = 1e-4 + (double)j * ((15.0 - 1e-4) / 15.0);
                const double ang = (2.0 * 3.14159265358979323846 / (double)L) * (double)i * band; featv = lane < 17 ? (float)cos(ang) : (float)(-sin(ang)); }
            float z1 = P.inp(I_HYB1)[l * 64 + lane];
            for (int m = 0; m < 33; ++m) z1 += __shfl(featv, m) * P.inp(I_HYW1)[((size_t)l * 33 + m) * 64 + lane];
            const float h1 = sinf(P.inp(I_HYF1)[l * 64 + lane] * z1);
            float z2 = P.inp(I_HYB2)[l * 64 + lane];
            for (int m = 0; m < 64; ++m) z2 += __shfl(h1, m) * P.inp(I_HYW2)[((size_t)l * 64 + m) * 64 + lane];
            ((float*)(P.ws + WS_H2TAB))[(size_t)rho * 64 + lane] = sinf(P.inp(I_HYF2)[l * 64 + lane] * z2);
        } else if (u < NU_MOD + NU_H2 + NU_LB) {
            for (int i = tid; i < 4096; i += 512) { const double a = -2.0 * 3.14159265358979323846 * (double)i / 8192.0; ((float*)(P.ws + WS_TW))[2 * i] = (float)cos(a); ((float*)(P.ws + WS_TW))[2 * i + 1] = (float)sin(a); }
            for (int i = tid; i < 1024; i += 512) { const int d = i >> 9, l = (i >> 8) & 1, c = i & 255;
                const float l0 = P.inp(I_HGLB)[d * 512 + c], l1 = P.inp(I_HGLB)[d * 512 + 256 + c];
                ((float*)(P.ws + WS_LB))[i] = l == 0 ? 0.0f : 1.0f / (1.0f + fexp(l0 - l1)); }
        } else {
            conv_unit_ne(P, 0, u - (NU_MOD + NU_H2 + NU_LB), (LAS float*)lds);
        }
    }
}

__device__ __forceinline__ void emit_rows_init(const Ptrs P, LAS float* wdt);
__device__ __forceinline__ void phase_pb(const Ptrs P, LAS unsigned char* lds) {
    const int tid = P.tid, G = P.G;
    for (int u = P.bid; u < 132; u += G) {
        const int tab = u < 64 ? 0 : (u < 128 ? 1 : 2); const int ib = tab == 0 ? u : (tab == 1 ? u - 64 : u - 128);
        const int l = tab == 1 ? 1 : 0; const int L = tab == 2 ? 256 : 4096; const int rho0 = (tab == 0 ? 0 : (tab == 1 ? 4096 : 8192)) + ib * 64;
        LAS float* h2 = (LAS float*)lds;
        for (int i = tid; i < 64 * 64; i += 512) h2[i] = ((const float*)(P.ws + WS_H2TAB))[(size_t)rho0 * 64 + i];
        __syncthreads();
        const int o = tid, c = tid & 255, dir = tid >> 8;
        float w3[64];
#pragma unroll
        for (int j = 0; j < 64; ++j) w3[j] = P.inp(I_HYW3)[((size_t)l * 64 + j) * 512 + o];
        const float dec = fabsf(P.inp(I_HYDEC)[l * 256 + c]);
        float* filt = tab == 2 ? (float*)(P.ws + WS_FILTC) : (float*)(P.ws + WS_FILT) + (size_t)l * 8192 * 256;
        const int L2 = 2 * L; float part = 0.f;
        for (int r = 0; r < 64; ++r) { const int i = ib * 64 + r; float s = 0.f;
#pragma unroll
            for (int j = 0; j < 64; ++j) s += h2[r * 64 + j] * w3[j];
            const float t = (float)i / (float)(L - 1); s *= fexp(-t * dec);
            if (dir == 0) { filt[(size_t)i * 256 + c] = s; part += fabsf(s); }
            else if (i == 0) filt[(size_t)L * 256 + c] = 0.f;
            else { filt[(size_t)(L2 - i) * 256 + c] = s; part += fabsf(s); } }
        ((float*)(P.ws + WS_PART))[((size_t)tab * 64 + ib) * 512 + o] = part;
        __syncthreads();
    }
    emit_rows_init(P, (LAS float*)lds);
}
__device__ __forceinline__ float hy_norm(const Ptrs P, int tab, int c) {
    const float* part = (const float*)(P.ws + WS_PART) + (size_t)tab * 64 * 512; const int nb = tab == 2 ? 4 : 64; float s = 0.f;
    for (int b = 0; b < nb; ++b) s += part[b * 512 + c] + part[b * 512 + 256 + c];
    return s;
}

__device__ __forceinline__ void emit_rows_init(const Ptrs P, LAS float* wdt) {
    const int tid = P.tid, wid = tid >> 6, lane = tid & 63, G = P.G;
    load_wdt(P, 0, wdt);
    LAS float* tabA = wdt + 1024 * 8; LAS float* tabB = tabA + 8 * 256 * 2;
    for (int i = tid; i < 2 * 8 * 256; i += 512) { const int tb = i >> 11, a = (i >> 8) & 7, ii = i & 255; const float om = fexp(-9.210340371976184f * (float)ii * (1.0f / 256.0f)); const float ang = (float)(tb ? a : 8 * a) * om;
        LAS float* t = (tb ? tabB : tabA) + (a * 256 + ii) * 2; t[0] = sinf(ang); t[1] = cosf(ang); }
    __syncthreads();
    const float* xin = P.inp(I_X); const float* cin = P.inp(I_CTX);
    RowV msh, msc; { const float z = zero_f(); for (int i = 0; i < 4; ++i) { msh.v[i] = (f32x4){z, z, z, z}; msc.v[i] = msh.v[i]; } } int mcur = -1;
    RowV rn; { const float z = zero_f(); for (int i = 0; i < 4; ++i) rn.v[i] = (f32x4){z, z, z, z}; } if (P.bid < T / 8) { const int rw = P.bid * 8 + wid; row_load(rn, rw < NLAT ? xin + (size_t)rw * D : cin + (size_t)(rw - NLAT) * D, lane); }
    for (int u = P.bid; u < T / 8; u += G) {
        const int row = u * 8 + wid; RowV r = rn;
        if (u + G < T / 8) { const int rw = (u + G) * 8 + wid; row_load(rn, rw < NLAT ? xin + (size_t)rw * D : cin + (size_t)(rw - NLAT) * D, lane); }
        if (row < NLAT) {
            const int t = row & 4095; const int prow = t >> 6, pcol = t & 63;
#pragma unroll
            for (int hf = 0; hf < 2; ++hf) { const int pos = hf ? pcol : prow; const LAS float* pa = tabA + ((pos >> 3) * 256 + lane * 4) * 2; const LAS float* pb = tabB + ((pos & 7) * 256 + lane * 4) * 2;
                const f32x4 a0 = *(const LAS f32x4*)pa, a1 = *(const LAS f32x4*)(pa + 4), b0 = *(const LAS f32x4*)pb, b1 = *(const LAS f32x4*)(pb + 4);
                f32x4 sn, cs;
                sn[0] = a0[0] * b0[1] + a0[1] * b0[0]; cs[0] = a0[1] * b0[1] - a0[0] * b0[0]; sn[1] = a0[2] * b0[3] + a0[3] * b0[2]; cs[1] = a0[3] * b0[3] - a0[2] * b0[2];
                sn[2] = a1[0] * b1[1] + a1[1] * b1[0]; cs[2] = a1[1] * b1[1] - a1[0] * b1[0]; sn[3] = a1[2] * b1[3] + a1[3] * b1[2]; cs[3] = a1[3] * b1[3] - a1[2] * b1[2];
                r.v[2 * hf] += sn; r.v[2 * hf + 1] += cs; }
        }
        row_store(r, P.latrow(row), lane);
        const int mi = row_modidx(row); if (mi != mcur) { mcur = mi; const float* m = P.mod(0, mi); row_load(msh, m, lane); row_load(msc, m + 1024, lane); }
        RowV h; row_modulate_r(r, h, msh, msc);
        row_store_bf16(h, (bf16_t*)(P.ws + WS_HBUF) + (size_t)row * D, lane);
        row_dt(h, wdt, (float*)(P.ws + WS_DT) + (size_t)row * 8, lane);
    }
}

__device__ __forceinline__ void phase_g1(const Ptrs P, LAS unsigned char* lds) {
    pg8::Gemm g{(const bf16_t*)(P.ws + WS_HBUF), (const bf16_t*)(P.ws + WS_WIN), D};
    EpiBf16Plain E{(bf16_t*)(P.ws + WS_BIG + BIG_U), UC, 0xffff};
    SchedG1 S{XOrder{P.G, P.bid, T / 256, 14}};
    pg8::gemm_phase<EpiBf16Plain, SchedG1, false>(P.tid, lds, g, S, E);
}

constexpr int NCHK = 34;
__device__ __forceinline__ int chunk_row0(int b, int pc) { return pc < 2 ? NLAT + b * CTXL + pc * 128 : b * SEQ + (pc - 2) * 128; }
__device__ __forceinline__ int chunk_at(int dir, int q) { return dir == 0 ? q : (q < 2 ? 1 - q : 35 - q); }
__device__ __forceinline__ int sidx(int kind, int b, int h, int dir, int pc) { return (((kind * 8 + b) * 4 + h) * 2 + dir) * NCHK + pc; }
__device__ __forceinline__ bf16x8 pack8(const float (&v)[8]) { u32x4 w; w.x = pack2(v[0], v[1]); w.y = pack2(v[2], v[3]); w.z = pack2(v[4], v[5]); w.w = pack2(v[6], v[7]); return __builtin_bit_cast(bf16x8, w); }
__device__ __forceinline__ float softplusf_(float x) { return x > 20.f ? x : flog(1.0f + fexp(x)); }
__device__ __forceinline__ float wave_incl_scan(float v, int lane) {
#pragma unroll
    for (int d = 1; d < 64; d <<= 1) { const float t = __shfl_up(v, d); if (lane >= d) v += t; }
    return v;
}

template <bool SILU>
__device__ __forceinline__ void conv3_8(const bf16_t* U, int row, int col0, const float* w, int ncol, int wcol0, const float* bias, float (&out)[8]) {
    const bool hp = row_has_prev(row), hn = row_has_next(row);
    const bf16x8 c = *(const bf16x8*)(U + (size_t)row * UC + col0);
    const bf16x8 p = *(const bf16x8*)(U + (size_t)(hp ? row - 1 : row) * UC + col0), n = *(const bf16x8*)(U + (size_t)(hn ? row + 1 : row) * UC + col0);
    const float mp = hp ? 1.0f : 0.0f, mn = hn ? 1.0f : 0.0f;
#pragma unroll
    for (int h4 = 0; h4 < 2; ++h4) { const f32x4 w0 = *(const f32x4*)(w + wcol0 + 4 * h4), w1 = *(const f32x4*)(w + ncol + wcol0 + 4 * h4), w2 = *(const f32x4*)(w + 2 * ncol + wcol0 + 4 * h4), bb = *(const f32x4*)(bias + wcol0 + 4 * h4);
#pragma unroll
        for (int e = 0; e < 4; ++e) { const int i = 4 * h4 + e; const float v = bf2f((bf16_t)c[i]) * w1[e] + mp * bf2f((bf16_t)p[i]) * w0[e] + mn * bf2f((bf16_t)n[i]) * w2[e] + bb[e]; out[i] = SILU ? siluf_(v) : v; } }
}
__device__ __forceinline__ void conv3_silu8(const bf16_t* U, int row, int col0, const float* w, int ncol, int wcol0, const float* bias, float (&out)[8]) { conv3_8<true>(U, row, col0, w, ncol, wcol0, bias, out); }
__device__ __forceinline__ void conv16_silu(const bf16_t* U, int r0, int col, const float* w, int ncol, int wcol, float bias, float (&out)[16]) {
    const bool hp = row_has_prev(r0), hn = row_has_next(r0 + 15);
    float x[18];
#pragma unroll
    for (int i = 0; i < 18; ++i) { const int r = (i == 0 && !hp) ? r0 : ((i == 17 && !hn) ? r0 + 15 : r0 - 1 + i); x[i] = bf2f(U[(size_t)r * UC + col]); }
    if (!hp) x[0] = 0.f; if (!hn) x[17] = 0.f;
    const float w0 = w[wcol], w1 = w[ncol + wcol], w2 = w[2 * ncol + wcol];
#pragma unroll
    for (int j = 0; j < 16; ++j) out[j] = siluf_(x[j] * w0 + x[j + 1] * w1 + x[j + 2] * w2 + bias);
}
__device__ __forceinline__ void store16_bf16(LAS bf16_t* dst, const float (&v)[16]) {
    u32x4 a, b; a.x = pack2(v[0], v[1]); a.y = pack2(v[2], v[3]); a.z = pack2(v[4], v[5]); a.w = pack2(v[6], v[7]); b.x = pack2(v[8], v[9]); b.y = pack2(v[10], v[11]); b.z = pack2(v[12], v[13]); b.w = pack2(v[14], v[15]);
    *(LAS u32x4*)dst = a; *(LAS u32x4*)(dst + 8) = b;
}

__device__ __forceinline__ void scatter8_T(LAS bf16_t* dstT, int g8, int p, const float (&v)[8]) {
#pragma unroll
    for (int e2 = 0; e2 < 4; ++e2) { const unsigned w = pack2(v[2 * e2], v[2 * e2 + 1]); dstT[(8 * g8 + 2 * e2) * 136 + p] = (bf16_t)(w & 0xffffu); dstT[(8 * g8 + 2 * e2 + 1) * 136 + p] = (bf16_t)(w >> 16); }
}

__device__ __forceinline__ void hgrn_pass1(const Ptrs P, int l, int unit, LAS unsigned char* lds) {
    const int tid = P.tid, lane = tid & 63, wid = tid >> 6, fr = lane & 15, fq = lane >> 4;
    const int pc = unit % NCHK; const int r_ = unit / NCHK; const int h = r_ & 3; const int b = r_ >> 2;
    const int row0 = chunk_row0(b, pc);
    const bf16_t* U = (const bf16_t*)(P.ws + WS_BIG + BIG_U);
    LAS bf16_t* KTF = (LAS bf16_t*)lds; LAS bf16_t* KTB = KTF + 64 * 136; LAS bf16_t* VT = KTB + 64 * 136; LAS float* segtot = (LAS float*)(VT + 64 * 136);
    LAS bf16_t* FS = (LAS bf16_t*)(lds + 65536);
    for (int it = tid; it < 128 * 8; it += 512) { const int p = it >> 3, g8 = it & 7; const bf16_t* ur = U + (size_t)(row0 + p) * UC + h * 64 + 8 * g8;
        const bf16x8 ff8 = *(const bf16x8*)(ur + 1792), fb8 = *(const bf16x8*)(ur + 2048), v8 = *(const bf16x8*)(ur + 2304);
        *(LAS bf16x8*)(FS + p * 64 + 8 * g8) = ff8; *(LAS bf16x8*)(FS + 8192 + p * 64 + 8 * g8) = fb8;
#pragma unroll
        for (int e = 0; e < 8; ++e) VT[(8 * g8 + e) * 136 + p] = (bf16_t)v8[e]; }
    __syncthreads();
    const int ch = lane, seg = wid;
    const float lbf = ((const float*)(P.ws + WS_LB))[(0 * 2 + l) * 256 + h * 64 + ch], lbb = ((const float*)(P.ws + WS_LB))[(1 * 2 + l) * 256 + h * 64 + ch];
    float cf[16], cb[16], kf[16], kb[16]; float runf = 0.f, runb = 0.f;
#pragma unroll
    for (int j = 0; j < 16; ++j) { const int p = 16 * seg + j;
        const float ff = lbf + (1.0f - lbf) * sigmoidf_(bf2f(FS[p * 64 + ch])), fb = lbb + (1.0f - lbb) * sigmoidf_(bf2f(FS[8192 + p * 64 + ch]));
        runf += flog(ff); cf[j] = runf; kf[j] = 1.0f - ff; cb[j] = runb; runb += flog(fb); kb[j] = 1.0f - fb; }
    segtot[seg * 64 + ch] = runf; segtot[512 + seg * 64 + ch] = runb; __syncthreads();
    float offf = 0.f, totf = 0.f, offb = 0.f, totb = 0.f;
#pragma unroll
    for (int s = 0; s < 8; ++s) { const float a = segtot[s * 64 + ch], c = segtot[512 + s * 64 + ch]; totf += a; totb += c; offf += (s < seg) ? a : 0.f; offb += (s < seg) ? c : 0.f; }
    { float t[16];
#pragma unroll
      for (int j = 0; j < 16; ++j) t[j] = kf[j] * fexp(totf - offf - cf[j]);
      store16_bf16(KTF + ch * 136 + 16 * seg, t);
#pragma unroll
      for (int j = 0; j < 16; ++j) t[j] = kb[j] * fexp(offb + cb[j]);
      store16_bf16(KTB + ch * 136 + 16 * seg, t); }
    const int sif = sidx(0, b, h, 0, pc), sib = sidx(0, b, h, 1, pc);
    if (seg == 0) { ((float*)(P.ws + WS_DEC))[(size_t)sif * 64 + ch] = fexp(totf); ((float*)(P.ws + WS_DEC))[(size_t)sib * 64 + ch] = fexp(totb); }
    __syncthreads();
    const int mt = wid >> 1, nt0 = (wid & 1) * 2;
    f32x4 af[2], ab[2]; af[0] = (f32x4){0.f, 0.f, 0.f, 0.f}; af[1] = af[0]; ab[0] = af[0]; ab[1] = af[0];
#pragma unroll
    for (int ks = 0; ks < 4; ++ks) { const bf16x8 a0 = *(const LAS bf16x8*)(KTF + (16 * mt + fr) * 136 + 32 * ks + 8 * fq), a1 = *(const LAS bf16x8*)(KTB + (16 * mt + fr) * 136 + 32 * ks + 8 * fq);
#pragma unroll
        for (int n = 0; n < 2; ++n) { const bf16x8 bb = *(const LAS bf16x8*)(VT + (16 * (nt0 + n) + fr) * 136 + 32 * ks + 8 * fq);
            af[n] = __builtin_amdgcn_mfma_f32_16x16x32_bf16(a0, bb, af[n], 0, 0, 0); ab[n] = __builtin_amdgcn_mfma_f32_16x16x32_bf16(a1, bb, ab[n], 0, 0, 0); } }
    float* SF = (float*)(P.ws + WS_BIG + BIG_STATE) + (size_t)sif * 4096; float* SB = (float*)(P.ws + WS_BIG + BIG_STATE) + (size_t)sib * 4096;
#pragma unroll
    for (int n = 0; n < 2; ++n)
#pragma unroll
        for (int r = 0; r < 4; ++r) { const int o = (16 * mt + 4 * fq + r) * 64 + 16 * (nt0 + n) + fr; SF[o] = af[n][r]; SB[o] = ab[n][r]; }
    __syncthreads();
}

__device__ __forceinline__ void ssd_pass1(const Ptrs P, int l, int unit, LAS unsigned char* lds) {
    const int tid = P.tid, lane = tid & 63, wid = tid >> 6, fr = lane & 15, fq = lane >> 4;
    const int pc = unit % NCHK; const int r_ = unit / NCHK; const int g = r_ & 1; const int b = r_ >> 1;
    const int row0 = chunk_row0(b, pc);
    const bf16_t* U = (const bf16_t*)(P.ws + WS_BIG + BIG_U);
    const float* scw = P.inp(I_SSDCW) + (size_t)l * 3 * 512; const float* scb = P.inp(I_SSDCB) + l * 512;
    LAS bf16_t* BT = (LAS bf16_t*)lds; LAS bf16_t* XT = BT + 64 * 136;
    LAS float* wgt = (LAS float*)(XT + 4 * 64 * 136);
    if (wid < 4) {
        const int hh = 2 * g + (wid >> 1), dir = wid & 1;
        const float Aneg = -fexp(P.inp(I_SSDALOG)[(l * 2 + dir) * 4 + hh]); const float dtb = P.inp(I_SSDDTB)[(l * 2 + dir) * 4 + hh]; const float* DT = (const float*)(P.ws + WS_DT);
        const int p0 = 2 * lane; const float d0 = softplusf_(DT[(size_t)(row0 + p0) * 8 + dir * 4 + hh] + dtb), d1 = softplusf_(DT[(size_t)(row0 + p0 + 1) * 8 + dir * 4 + hh] + dtb);
        const float a0 = Aneg * d0, a1 = Aneg * d1; const float inc = wave_incl_scan(a0 + a1, lane); const float tot = __uint_as_float(__builtin_amdgcn_readlane(__float_as_uint(inc), 63));
        if (dir == 0) { wgt[wid * 128 + p0] = d0 * fexp(tot - (inc - a1)); wgt[wid * 128 + p0 + 1] = d1 * fexp(tot - inc); }
        else { wgt[wid * 128 + p0] = d0 * fexp(inc - a1 - a0); wgt[wid * 128 + p0 + 1] = d1 * fexp(inc - a1); }
        if (lane == 0) ((float*)(P.ws + WS_DEC))[(size_t)sidx(1, b, hh, dir, pc) * 64] = fexp(tot);
    }
    __syncthreads();
    {
#pragma unroll 1
        for (int it = tid; it < 128 * 8; it += 512) { const int p = it >> 3, g8 = it & 7; const int row = row0 + p; float t8[8];
            conv3_8<true>(U, row, 3072 + 256 + g * 64 + 8 * g8, scw, 512, 256 + g * 64 + 8 * g8, scb, t8); scatter8_T(BT, g8, p, t8); }
#pragma unroll 1
        for (int it = tid; it < 2 * 128 * 8; it += 512) { const int hq = it >> 10, p = (it >> 3) & 127, g8 = it & 7; const int row = row0 + p; const int c0 = (2 * g + hq) * 64 + 8 * g8; float x8[8], t8[8];
            conv3_8<true>(U, row, 3072 + c0, scw, 512, c0, scb, x8);
#pragma unroll
            for (int dir = 0; dir < 2; ++dir) { const int cmb = 2 * hq + dir; const float wv = wgt[cmb * 128 + p];
#pragma unroll
                for (int e = 0; e < 8; ++e) t8[e] = x8[e] * wv;
                scatter8_T(XT + cmb * 64 * 136, g8, p, t8); } }
    }
    __syncthreads();
    {
        const int cmb = wid >> 1; const int hh = 2 * g + (cmb >> 1), dir = cmb & 1;
        float* S = (float*)(P.ws + WS_BIG + BIG_STATE) + (size_t)sidx(1, b, hh, dir, pc) * 4096;
#pragma unroll
        for (int mi = 0; mi < 2; ++mi) { const int mt = 2 * (wid & 1) + mi; f32x4 acc[4];
#pragma unroll
            for (int n = 0; n < 4; ++n) acc[n] = (f32x4){0.f, 0.f, 0.f, 0.f};
#pragma unroll
            for (int ks = 0; ks < 4; ++ks) { const bf16x8 a = *(const LAS bf16x8*)(XT + (cmb * 64 + 16 * mt + fr) * 136 + 32 * ks + 8 * fq);
#pragma unroll
                for (int n = 0; n < 4; ++n) { const bf16x8 bb = *(const LAS bf16x8*)(BT + (16 * n + fr) * 136 + 32 * ks + 8 * fq); acc[n] = __builtin_amdgcn_mfma_f32_16x16x32_bf16(a, bb, acc[n], 0, 0, 0); } }
#pragma unroll
            for (int n = 0; n < 4; ++n)
#pragma unroll
                for (int r = 0; r < 4; ++r) S[(16 * mt + 4 * fq + r) * 64 + 16 * n + fr] = acc[n][r]; }
    }
    __syncthreads();
}

__device__ __forceinline__ void ssd_dt_cum(const Ptrs P, int l, int row0, int dir, int h, int wid, int lane, LAS float* cum, LAS float* dtv) {
    if (wid == 0) {
        const float Aneg = -fexp(P.inp(I_SSDALOG)[(l * 2 + dir) * 4 + h]); const float dtb = P.inp(I_SSDDTB)[(l * 2 + dir) * 4 + h]; const float* DT = (const float*)(P.ws + WS_DT);
        const int t0 = 2 * lane, p0 = dir ? 127 - t0 : t0, p1 = dir ? 126 - t0 : t0 + 1;
        const float d0 = softplusf_(DT[(size_t)(row0 + p0) * 8 + dir * 4 + h] + dtb), d1 = softplusf_(DT[(size_t)(row0 + p1) * 8 + dir * 4 + h] + dtb);
        const float a0 = Aneg * d0, a1 = Aneg * d1; const float inc = wave_incl_scan(a0 + a1, lane);
        cum[t0] = inc - a1; cum[t0 + 1] = inc; dtv[t0] = d0; dtv[t0 + 1] = d1;
    }
}

__device__ __forceinline__ void scan_pass2(const Ptrs P, int unit) {
    const int seq = unit >> 1, half = unit & 1; const int kind = seq >> 6, b = (seq >> 3) & 7, h = (seq >> 1) & 3, dir = seq & 1;
    const int e0 = half * 2048 + P.tid * 4; const int base = sidx(kind, b, h, dir, 0);
    float* ST = (float*)(P.ws + WS_BIG + BIG_STATE); const float* DEC = (const float*)(P.ws + WS_DEC);
    const float zf = zero_f(); f32x4 run = (f32x4){zf, zf, zf, zf};
#pragma unroll 1
    for (int q0 = 0; q0 < NCHK; q0 += 8) {
        f32x4 loc[8]; float dd[8];
#pragma unroll
        for (int k = 0; k < 8; ++k) { const int q = (q0 + k < NCHK) ? q0 + k : NCHK - 1; const int pc = chunk_at(dir, q);
            loc[k] = *(const f32x4*)(ST + (size_t)(base + pc) * 4096 + e0); dd[k] = DEC[(size_t)(base + pc) * 64 + (kind == 0 ? (e0 >> 6) : 0)]; }
#pragma unroll
        for (int k = 0; k < 8; ++k) { if (q0 + k < NCHK) { const int pc = chunk_at(dir, q0 + k); *(f32x4*)(ST + (size_t)(base + pc) * 4096 + e0) = run; run = run * dd[k] + loc[k]; } }
    }
}

__device__ __forceinline__ int qk_off(int p, int chunk) { return p * 64 + ((chunk ^ (p & 7)) << 3); }
__device__ __forceinline__ void hgrn_pass3(const Ptrs P, int l, int unit, int unit_next, LAS unsigned char* lds) {
    const int tid = P.tid, lane = tid & 63, wid = tid >> 6, fr = lane & 15, fq = lane >> 4;
    const int pc = unit % NCHK; const int r_ = unit / NCHK; const int h = r_ & 3; const int b = r_ >> 2;
    const int row0 = chunk_row0(b, pc);
    const bf16_t* U = (const bf16_t*)(P.ws + WS_BIG + BIG_U);
    LAS bf16_t* QF = (LAS bf16_t*)lds; LAS bf16_t* KF = QF + 128 * 64; LAS bf16_t* QB = KF + 128 * 64; LAS bf16_t* KB = QB + 128 * 64; LAS bf16_t* VT = KB + 128 * 64;
    LAS bf16_t* STF = VT + 64 * 136; LAS bf16_t* STB = STF + 64 * 72; LAS float* ETF = (LAS float*)(STB + 64 * 72); LAS float* ETB = ETF + 512; LAS bf16_t* PW = (LAS bf16_t*)(ETB + 512);
    LAS float* OUT = (LAS float*)lds;
    {
        LAS bf16_t* FS = PW;
        for (int it = tid; it < 128 * 8; it += 512) { const int p = it >> 3, g8 = it & 7; const bf16_t* ur = U + (size_t)(row0 + p) * UC + h * 64 + 8 * g8;
            const bf16x8 ff8 = *(const bf16x8*)(ur + 1792), fb8 = *(const bf16x8*)(ur + 2048), q8 = *(const bf16x8*)(ur + 1536), v8 = *(const bf16x8*)(ur + 2304);
            *(LAS bf16x8*)(FS + p * 64 + 8 * g8) = ff8; *(LAS bf16x8*)(FS + 8192 + p * 64 + 8 * g8) = fb8;
            float qs[8];
#pragma unroll
            for (int e = 0; e < 8; ++e) qs[e] = bf2f((bf16_t)q8[e]) * 0.125f;
            const bf16x8 qp = pack8(qs); *(LAS bf16x8*)(QF + qk_off(p, g8)) = qp; *(LAS bf16x8*)(QB + qk_off(p, g8)) = qp;
#pragma unroll
            for (int e = 0; e < 8; ++e) VT[(8 * g8 + e) * 136 + p] = (bf16_t)v8[e]; }
        const float* SF = (const float*)(P.ws + WS_BIG + BIG_STATE) + (size_t)sidx(0, b, h, 0, pc) * 4096; const float* SB = (const float*)(P.ws + WS_BIG + BIG_STATE) + (size_t)sidx(0, b, h, 1, pc) * 4096;
#pragma unroll 2
        for (int idx = tid; idx < 4096; idx += 512) { STF[(idx & 63) * 72 + (idx >> 6)] = f2bf(SF[idx]); STB[(idx & 63) * 72 + (idx >> 6)] = f2bf(SB[idx]); }
    }
    __syncthreads();
    {
        LAS bf16_t* FS = PW;
        const int ch = lane, seg = wid; const float lbf = ((const float*)(P.ws + WS_LB))[(0 * 2 + l) * 256 + h * 64 + ch], lbb = ((const float*)(P.ws + WS_LB))[(1 * 2 + l) * 256 + h * 64 + ch];
        float bfw[16], bbw[16], kf[16], kb[16];
#pragma unroll
        for (int j = 0; j < 16; ++j) { const int p = 16 * seg + j;
            const float ff = lbf + (1.0f - lbf) * sigmoidf_(bf2f(FS[p * 64 + ch])), fb = lbb + (1.0f - lbb) * sigmoidf_(bf2f(FS[8192 + p * 64 + ch]));
            bfw[j] = flog(ff); bbw[j] = flog(fb); kf[j] = 1.0f - ff; kb[j] = 1.0f - fb; }
#pragma unroll
        for (int j = 1; j < 16; ++j) bfw[j] += bfw[j - 1];
#pragma unroll
        for (int j = 14; j >= 0; --j) bbw[j] += bbw[j + 1];
        const float etf = bfw[15], etb = bbw[0];
        ETF[seg * 64 + ch] = etf; ETB[seg * 64 + ch] = etb;
        const int chunk = ch >> 3, sub = ch & 7;
#pragma unroll
        for (int j = 0; j < 16; ++j) { const int p = 16 * seg + j; const int o = qk_off(p, chunk) + sub; const float qv = bf2f(QF[o]);
            const unsigned wq = pack2(qv * fexp(bfw[j]), qv * fexp(bbw[j])), wk = pack2(kf[j] * fexp(etf - bfw[j]), kb[j] * fexp(etb - bbw[j]));
            QF[o] = (bf16_t)(wq & 0xffffu); QB[o] = (bf16_t)(wq >> 16); KF[o] = (bf16_t)(wk & 0xffffu); KB[o] = (bf16_t)(wk >> 16); }
    }
    __syncthreads();
    f32x4 o[4];
    {
        const int i = wid; LAS bf16_t* pw = PW + wid * 16 * 136;
#pragma unroll
        for (int nt = 0; nt < 4; ++nt) o[nt] = (f32x4){0.f, 0.f, 0.f, 0.f};
#pragma unroll 1
        for (int dir = 0; dir < 2; ++dir) {
            const LAS bf16_t* QA = dir ? QB : QF; const LAS bf16_t* KA = dir ? KB : KF; const LAS float* ET = dir ? ETB : ETF; const LAS bf16_t* ST = dir ? STB : STF;
            bf16x8 qf[2]; float g[2][8];
#pragma unroll
            for (int ks = 0; ks < 2; ++ks) { qf[ks] = *(const LAS bf16x8*)(QA + qk_off(16 * i + fr, 4 * ks + fq));
                const f32x4 e0 = *(const LAS f32x4*)(ET + i * 64 + 32 * ks + 8 * fq), e1 = *(const LAS f32x4*)(ET + i * 64 + 32 * ks + 8 * fq + 4);
                g[ks][0] = -e0[0]; g[ks][1] = -e0[1]; g[ks][2] = -e0[2]; g[ks][3] = -e0[3]; g[ks][4] = -e1[0]; g[ks][5] = -e1[1]; g[ks][6] = -e1[2]; g[ks][7] = -e1[3]; }
            const int nj = dir ? 8 - i : i + 1;
            for (int jj = 0; jj < nj; ++jj) { const int j = dir ? i + jj : i - jj;
                f32x4 d = (f32x4){0.f, 0.f, 0.f, 0.f};
#pragma unroll
                for (int ks = 0; ks < 2; ++ks) { float a8[8];
#pragma unroll
                    for (int e = 0; e < 8; ++e) a8[e] = bf2f((bf16_t)qf[ks][e]) * fexp(g[ks][e]);
                    const bf16x8 kfr = *(const LAS bf16x8*)(KA + qk_off(16 * j + fr, 4 * ks + fq));
                    d = __builtin_amdgcn_mfma_f32_16x16x32_bf16(kfr, pack8(a8), d, 0, 0, 0);
                    const f32x4 e0 = *(const LAS f32x4*)(ET + j * 64 + 32 * ks + 8 * fq), e1 = *(const LAS f32x4*)(ET + j * 64 + 32 * ks + 8 * fq + 4);
                    g[ks][0] += e0[0]; g[ks][1] += e0[1]; g[ks][2] += e0[2]; g[ks][3] += e0[3]; g[ks][4] += e1[0]; g[ks][5] += e1[1]; g[ks][6] += e1[2]; g[ks][7] += e1[3]; }
                if (jj == 0) {
#pragma unroll
                    for (int r = 0; r < 4; ++r) d[r] = (dir ? (4 * fq + r >= fr) : (4 * fq + r <= fr)) ? d[r] : 0.f; }
                u32x2 w; w.x = pack2(d[0], d[1]); w.y = pack2(d[2], d[3]); *(LAS u32x2*)(pw + fr * 136 + 16 * j + 4 * fq) = w;
            }
            { const int zb = dir ? i - 1 : i + 1; const bool need = dir ? ((i & 1) == 1) : ((i & 1) == 0);
              if (need) { u32x2 z; z.x = __float_as_uint(zero_f()); z.y = z.x; *(LAS u32x2*)(pw + fr * 136 + 16 * zb + 4 * fq) = z; } }
            const int kslo = dir ? (i >> 1) : 0, kshi = dir ? 3 : (i >> 1);
            for (int ks = kslo; ks <= kshi; ++ks) { const bf16x8 pa = *(const LAS bf16x8*)(pw + fr * 136 + 32 * ks + 8 * fq);
#pragma unroll
                for (int nt = 0; nt < 4; ++nt) { const bf16x8 vf = *(const LAS bf16x8*)(VT + (16 * nt + fr) * 136 + 32 * ks + 8 * fq); o[nt] = __builtin_amdgcn_mfma_f32_16x16x32_bf16(pa, vf, o[nt], 0, 0, 0); } }
#pragma unroll
            for (int ks = 0; ks < 2; ++ks) { float a8[8];
#pragma unroll
                for (int e = 0; e < 8; ++e) a8[e] = bf2f((bf16_t)qf[ks][e]) * fexp(g[ks][e]);
                const bf16x8 qa = pack8(a8);
#pragma unroll
                for (int nt = 0; nt < 4; ++nt) { const bf16x8 sf = *(const LAS bf16x8*)(ST + (16 * nt + fr) * 72 + 32 * ks + 8 * fq); o[nt] = __builtin_amdgcn_mfma_f32_16x16x32_bf16(qa, sf, o[nt], 0, 0, 0); } }
        }
    }
    __syncthreads();
#pragma unroll
    for (int nt = 0; nt < 4; ++nt)
#pragma unroll
        for (int r = 0; r < 4; ++r) OUT[(16 * wid + 4 * fq + r) * 64 + 16 * nt + fr] = o[nt][r];
    __syncthreads();
    {
        const int pos = tid >> 2, qd = tid & 3; const int row = row0 + pos; bf16_t* BR2 = (bf16_t*)(P.ws + WS_BR) + (size_t)2 * T * 256;
        const bf16_t* gp = U + (size_t)row * UC + 2560 + h * 64 + 16 * qd; const bf16x8 g0 = *(const bf16x8*)gp, g1 = *(const bf16x8*)(gp + 8);
        const float* ngp = P.inp(I_HGNG) + l * 64 + 16 * qd; float ov[16], q = 0.f;
#pragma unroll
        for (int e4 = 0; e4 < 4; ++e4) { const f32x4 v = *(const LAS f32x4*)(OUT + pos * 64 + 16 * qd + 4 * e4); ov[4 * e4] = v[0]; ov[4 * e4 + 1] = v[1]; ov[4 * e4 + 2] = v[2]; ov[4 * e4 + 3] = v[3]; q += v[0] * v[0] + v[1] * v[1] + v[2] * v[2] + v[3] * v[3]; }
        q += __shfl_xor(q, 1); q += __shfl_xor(q, 2);
        const float rs = rsqrtf(q * (1.0f / 64.0f) + kconst(RMS_EPS)); float t8[8];
#pragma unroll
        for (int e = 0; e < 8; ++e) t8[e] = ov[e] * rs * ngp[e] * siluf_(bf2f((bf16_t)g0[e]));
        *(bf16x8*)(BR2 + (size_t)row * 256 + h * 64 + 16 * qd) = pack8(t8);
#pragma unroll
        for (int e = 0; e < 8; ++e) t8[e] = ov[8 + e] * rs * ngp[8 + e] * siluf_(bf2f((bf16_t)g1[e]));
        *(bf16x8*)(BR2 + (size_t)row * 256 + h * 64 + 16 * qd + 8) = pack8(t8);
    }
    __syncthreads();
}

__device__ __forceinline__ void ssd_pass3(const Ptrs P, int l, int unit, LAS unsigned char* lds) {
    const int tid = P.tid, lane = tid & 63, wid = tid >> 6, fr = lane & 15, fq = lane >> 4;
    const int pc = unit % NCHK; const int r_ = unit / NCHK; const int g = r_ & 1; const int b = r_ >> 1;
    const int row0 = chunk_row0(b, pc);
    const bf16_t* U = (const bf16_t*)(P.ws + WS_BIG + BIG_U);
    const float* scw = P.inp(I_SSDCW) + (size_t)l * 3 * 512; const float* scb = P.inp(I_SSDCB) + l * 512;
    LAS bf16_t* CM = (LAS bf16_t*)lds; LAS bf16_t* BM = CM + 128 * 72; LAS bf16_t* XT = BM + 128 * 72; LAS bf16_t* STF = XT + 64 * 136; LAS bf16_t* STB = STF + 64 * 72;
    LAS float* cumfA = (LAS float*)(STB + 64 * 72); LAS float* cumbA = cumfA + 256; LAS float* dtfA = cumbA + 256; LAS float* dtbA = dtfA + 256;
    LAS bf16_t* PW = (LAS bf16_t*)(dtbA + 256); LAS float* OUT = (LAS float*)(PW + 8 * 16 * 136);
    if (wid < 4) {
        const int hq = wid >> 1, dir = wid & 1, h = 2 * g + hq; const float Aneg = -fexp(P.inp(I_SSDALOG)[(l * 2 + dir) * 4 + h]); const float dtbias = P.inp(I_SSDDTB)[(l * 2 + dir) * 4 + h]; const float* DT = (const float*)(P.ws + WS_DT);
        const int p0 = 2 * lane; const float d0 = softplusf_(DT[(size_t)(row0 + p0) * 8 + dir * 4 + h] + dtbias), d1 = softplusf_(DT[(size_t)(row0 + p0 + 1) * 8 + dir * 4 + h] + dtbias);
        const float a0 = Aneg * d0, a1 = Aneg * d1; const float inc = wave_incl_scan(a0 + a1, lane);
        if (dir == 0) { cumfA[hq * 128 + p0] = inc - a1; cumfA[hq * 128 + p0 + 1] = inc; dtfA[hq * 128 + p0] = d0; dtfA[hq * 128 + p0 + 1] = d1; }
        else { const float tot = __uint_as_float(__builtin_amdgcn_readlane(__float_as_uint(inc), 63)); cumbA[hq * 128 + p0] = tot - inc + a0 + a1; cumbA[hq * 128 + p0 + 1] = tot - inc + a1; dtbA[hq * 128 + p0] = d0; dtbA[hq * 128 + p0 + 1] = d1; }
    }
    {
        const int pos = tid >> 2, qd = tid & 3; const int row = row0 + pos;
#pragma unroll 1
        for (int pcs = 0; pcs < 4; ++pcs) { const int isb = pcs >> 1, hf = pcs & 1; const int cc = (isb ? 256 : 384) + g * 64 + 16 * qd + 8 * hf; float t8[8];
            conv3_silu8(U, row, 3072 + cc, scw, 512, cc, scb, t8);
            *(LAS bf16x8*)((isb ? BM : CM) + pos * 72 + 16 * qd + 8 * hf) = pack8(t8); }
    }
#pragma unroll 1
    for (int hq = 0; hq < 2; ++hq) {
        const int h = 2 * g + hq;
        for (int it = tid; it < 128 * 8; it += 512) { const int p = it >> 3, g8 = it & 7; float x8[8];
            conv3_8<true>(U, row0 + p, 3072 + h * 64 + 8 * g8, scw, 512, h * 64 + 8 * g8, scb, x8); scatter8_T(XT, g8, p, x8); }
        __builtin_amdgcn_sched_barrier(0);
        LAS float* cumf = cumfA + hq * 128; LAS float* cumb = cumbA + hq * 128; LAS float* dtf = dtfA + hq * 128; LAS float* dtb = dtbA + hq * 128;
        {
            const float* SF = (const float*)(P.ws + WS_BIG + BIG_STATE) + (size_t)sidx(1, b, h, 0, pc) * 4096; const float* SB = (const float*)(P.ws + WS_BIG + BIG_STATE) + (size_t)sidx(1, b, h, 1, pc) * 4096;
#pragma unroll
            for (int k = 0; k < 2; ++k) { const int idx = (tid + 512 * k) * 4; const f32x4 a = *(const f32x4*)(SF + idx), c = *(const f32x4*)(SB + idx);
                u32x2 wa, wc; wa.x = pack2(a[0], a[1]); wa.y = pack2(a[2], a[3]); wc.x = pack2(c[0], c[1]); wc.y = pack2(c[2], c[3]);
                *(LAS u32x2*)(STF + (idx >> 6) * 72 + (idx & 63)) = wa; *(LAS u32x2*)(STB + (idx >> 6) * 72 + (idx & 63)) = wc; }
        }
        float rxs[16]; bf16x8 rz[2];
        { const int pos = tid >> 2, qd = tid & 3; const int row = row0 + pos; const int c0 = h * 64 + 16 * qd; const bf16_t* zp = U + (size_t)row * UC + 2816 + c0;
#pragma unroll
          for (int hf = 0; hf < 2; ++hf) { float xs[8]; conv3_silu8(U, row, 3072 + c0 + 8 * hf, scw, 512, c0 + 8 * hf, scb, xs); rz[hf] = *(const bf16x8*)(zp + 8 * hf);
#pragma unroll
              for (int e = 0; e < 8; ++e) rxs[8 * hf + e] = xs[e]; } }
        __syncthreads();
        {
            const int i = wid; LAS bf16_t* pw = PW + wid * 16 * 136;
            bf16x8 cf[2];
#pragma unroll
            for (int ks = 0; ks < 2; ++ks) cf[ks] = *(const LAS bf16x8*)(CM + (16 * i + fr) * 72 + 32 * ks + 8 * fq);
            f32x4 o[4];
#pragma unroll
            for (int nt = 0; nt < 4; ++nt) o[nt] = (f32x4){0.f, 0.f, 0.f, 0.f};
#pragma unroll 1
            for (int dir = 0; dir < 2; ++dir) {
                const LAS float* cum = dir ? cumb : cumf; const LAS float* dtv = dir ? dtb : dtf; const LAS bf16_t* ST = dir ? STB : STF;
                const float cq = cum[16 * i + fr];
                const int jlo = dir ? i : 0, jhi = dir ? 7 : i;
                for (int j = jlo; j <= jhi; ++j) {
                    f32x4 d = (f32x4){0.f, 0.f, 0.f, 0.f};
#pragma unroll
                    for (int ks = 0; ks < 2; ++ks) { const bf16x8 bf_ = *(const LAS bf16x8*)(BM + (16 * j + fr) * 72 + 32 * ks + 8 * fq); d = __builtin_amdgcn_mfma_f32_16x16x32_bf16(bf_, cf[ks], d, 0, 0, 0); }
                    const f32x4 cs = *(const LAS f32x4*)(cum + 16 * j + 4 * fq), ds = *(const LAS f32x4*)(dtv + 16 * j + 4 * fq);
#pragma unroll
                    for (int r = 0; r < 4; ++r) { const bool keep = (j != i) || (dir ? (4 * fq + r >= fr) : (4 * fq + r <= fr)); d[r] = keep ? d[r] * fexp(cq - cs[r]) * ds[r] : 0.f; }
                    u32x2 w; w.x = pack2(d[0], d[1]); w.y = pack2(d[2], d[3]); *(LAS u32x2*)(pw + fr * 136 + 16 * j + 4 * fq) = w;
                }
                { const int zb = dir ? i - 1 : i + 1; const bool need = dir ? ((i & 1) == 1) : ((i & 1) == 0);
                  if (need) { u32x2 z; z.x = __float_as_uint(zero_f()); z.y = z.x; *(LAS u32x2*)(pw + fr * 136 + 16 * zb + 4 * fq) = z; } }
                const int kslo = dir ? (i >> 1) : 0, kshi = dir ? 3 : (i >> 1);
                for (int ks = kslo; ks <= kshi; ++ks) { const bf16x8 pa = *(const LAS bf16x8*)(pw + fr * 136 + 32 * ks + 8 * fq);
#pragma unroll
                    for (int nt = 0; nt < 4; ++nt) { const bf16x8 xf = *(const LAS bf16x8*)(XT + (16 * nt + fr) * 136 + 32 * ks + 8 * fq); o[nt] = __builtin_amdgcn_mfma_f32_16x16x32_bf16(pa, xf, o[nt], 0, 0, 0); } }
                f32x4 o2[4];
#pragma unroll
                for (int nt = 0; nt < 4; ++nt) o2[nt] = (f32x4){0.f, 0.f, 0.f, 0.f};
#pragma unroll
                for (int ks = 0; ks < 2; ++ks)
#pragma unroll
                    for (int nt = 0; nt < 4; ++nt) { const bf16x8 sf = *(const LAS bf16x8*)(ST + (16 * nt + fr) * 72 + 32 * ks + 8 * fq); o2[nt] = __builtin_amdgcn_mfma_f32_16x16x32_bf16(cf[ks], sf, o2[nt], 0, 0, 0); }
                const f32x4 ct = *(const LAS f32x4*)(cum + 16 * i + 4 * fq);
#pragma unroll
                for (int nt = 0; nt < 4; ++nt)
#pragma unroll
                    for (int r = 0; r < 4; ++r) o[nt][r] += fexp(ct[r]) * o2[nt][r];
            }
#pragma unroll
            for (int nt = 0; nt < 4; ++nt)
#pragma unroll
                for (int r = 0; r < 4; ++r) OUT[(16 * i + 4 * fq + r) * 64 + 16 * nt + fr] = o[nt][r];
        }
        __syncthreads();
        {
            const int pos = tid >> 2, qd = tid & 3; const int row = row0 + pos; const int c0 = h * 64 + 16 * qd;
            const float Dh = P.inp(I_SSDD)[l * 4 + h]; const float* ngp = P.inp(I_SSDNG) + l * 256 + c0; bf16_t* BR3 = (bf16_t*)(P.ws + WS_BR) + (size_t)3 * T * 256; float* SSQ = (float*)(P.ws + WS_SSQ);
            float q = 0.f;
#pragma unroll
            for (int hf = 0; hf < 2; ++hf) { float xs[8];
#pragma unroll
                for (int e = 0; e < 8; ++e) xs[e] = rxs[8 * hf + e];
                const bf16x8 z8 = rz[hf]; float t8[8];
#pragma unroll
                for (int e4 = 0; e4 < 2; ++e4) { const f32x4 ov = *(const LAS f32x4*)(OUT + pos * 64 + 16 * qd + 8 * hf + 4 * e4);
#pragma unroll
                    for (int e = 0; e < 4; ++e) { const int ii = 4 * e4 + e; const float vv = (ov[e] + xs[ii] * Dh) * siluf_(bf2f((bf16_t)z8[ii])); q += vv * vv; t8[ii] = vv * ngp[8 * hf + ii]; } }
                *(bf16x8*)(BR3 + (size_t)row * 256 + c0 + 8 * hf) = pack8(t8); }
            q += __shfl_xor(q, 1); q += __shfl_xor(q, 2);
            if (qd == 0) SSQ[(size_t)row * 4 + h] = q;
        }
        __syncthreads();
    }
}

typedef float f32x2 __attribute__((ext_vector_type(2)));
__device__ __forceinline__ f32x2 cmul(f32x2 a, f32x2 b) { return (f32x2){a.x * b.x - a.y * b.y, a.x * b.y + a.y * b.x}; }
__device__ __forceinline__ f32x2 cmulc(f32x2 a, f32x2 b) { return (f32x2){a.x * b.x + a.y * b.y, a.y * b.x - a.x * b.y}; }
__device__ __forceinline__ int fphys(int i) { return i + (i >> 4); }
template <int LO, int NST, bool INV>
__device__ __forceinline__ void fft_stages(f32x2 (&x)[16], const LAS f32x2* TW, int low) {
#pragma unroll
    for (int mm = 0; mm < NST; ++mm) { const int m = INV ? mm : NST - 1 - mm; const int s = LO + m;
#pragma unroll
        for (int j = 0; j < 16; ++j) { if (j & (1 << m)) continue; const int j2 = j | (1 << m);
            const int k = ((j & ((1 << m) - 1)) << LO) | low; const f32x2 tw = TW[k << (12 - s)];
            const f32x2 a = x[j], b = x[j2];
            if (!INV) { x[j] = a + b; x[j2] = cmul(a - b, tw); } else { const f32x2 bt = cmulc(b, tw); x[j] = a + bt; x[j2] = a - bt; } } }
}
template <int LO, int NST, bool INV>
__device__ __forceinline__ void fft_pass(LAS f32x2* X, const LAS f32x2* TW, int tid) {
    const int low = tid & ((1 << LO) - 1), high = tid >> LO; const int base = low | (high << (LO + 4));
    f32x2 x[16];
#pragma unroll
    for (int j = 0; j < 16; ++j) x[j] = X[fphys(base | (j << LO))];
    fft_stages<LO, NST, INV>(x, TW, low);
#pragma unroll
    for (int j = 0; j < 16; ++j) X[fphys(base | (j << LO))] = x[j];
}
__device__ __forceinline__ void hyena_fft_unit(const Ptrs P, int l, int c, LAS unsigned char* lds) {
    const int tid = P.tid, lane = tid & 63;
    LAS f32x2* X = (LAS f32x2*)lds; LAS f32x2* TW = X + 8704;
    const f32x2* TWg = (const f32x2*)(P.ws + WS_TW);
    for (int i = tid; i < 4096; i += 512) TW[i] = TWg[i];
    float nrm; { const float* part = (const float*)(P.ws + WS_PART) + (size_t)l * 64 * 512; nrm = wave_sum(part[lane * 512 + c] + part[lane * 512 + 256 + c]); }
    const float inv = 1.0f / nrm; const float* filt = (const float*)(P.ws + WS_FILT) + (size_t)l * 8192 * 256 + c;
    f32x2* Fg = (f32x2*)(P.ws + WS_BR) + (size_t)P.bid * 8192;
    __syncthreads();
    {
        f32x2 x[16];
#pragma unroll
        for (int j = 0; j < 16; ++j) x[j] = (f32x2){filt[(size_t)(tid + 512 * j) * 256] * inv, 0.f};
        fft_stages<9, 4, false>(x, TW, tid);
#pragma unroll
        for (int j = 0; j < 16; ++j) X[fphys(tid | (j << 9))] = x[j];
        __syncthreads(); fft_pass<5, 4, false>(X, TW, tid); __syncthreads(); fft_pass<2, 3, false>(X, TW, tid); __syncthreads();
#pragma unroll
        for (int j = 0; j < 16; ++j) x[j] = X[fphys((tid << 4) | j)];
        fft_stages<0, 2, false>(x, TW, 0);
#pragma unroll
        for (int j = 0; j < 16; ++j) Fg[(tid << 4) | j] = x[j];
    }
    unsigned* WTt = (unsigned*)(P.ws + WS_BIG + BIG_WT); const float bias = P.inp(I_HYBIAS)[l * 256 + c];
    for (int p = 0; p < 4; ++p) {
        unsigned* wp = WTt + ((size_t)c * 4 + p) * 4096;
        f32x2 x[16]; unsigned wraw[8];
#pragma unroll
        for (int j = 0; j < 8; ++j) { wraw[j] = wp[tid + 512 * j]; x[j] = (f32x2){__uint_as_float(wraw[j] << 16), __uint_as_float(wraw[j] & 0xffff0000u)}; }
#pragma unroll
        for (int j = 8; j < 16; ++j) x[j] = (f32x2){0.f, 0.f};
        fft_stages<9, 4, false>(x, TW, tid);
        __syncthreads();
#pragma unroll
        for (int j = 0; j < 16; ++j) X[fphys(tid | (j << 9))] = x[j];
        __syncthreads(); fft_pass<5, 4, false>(X, TW, tid); __syncthreads(); fft_pass<2, 3, false>(X, TW, tid); __syncthreads();
#pragma unroll
        for (int j = 0; j < 16; ++j) x[j] = X[fphys((tid << 4) | j)];
        fft_stages<0, 2, false>(x, TW, 0);
#pragma unroll
        for (int j = 0; j < 16; ++j) x[j] = cmul(x[j], Fg[(tid << 4) | j]);
        fft_stages<0, 2, true>(x, TW, 0);
#pragma unroll
        for (int j = 0; j < 16; ++j) X[fphys((tid << 4) | j)] = x[j];
        __syncthreads(); fft_pass<2, 3, true>(X, TW, tid); __syncthreads(); fft_pass<5, 4, true>(X, TW, tid); __syncthreads();
#pragma unroll
        for (int j = 0; j < 16; ++j) x[j] = X[fphys(tid | (j << 9))];
        fft_stages<9, 4, true>(x, TW, tid);
#pragma unroll
        for (int j = 0; j < 8; ++j) { const f32x2 y = x[j] * (1.0f / 8192.0f); const unsigned w = wraw[j];
            wp[tid + 512 * j] = pack2(y.x + __uint_as_float(w << 16) * bias, y.y + __uint_as_float(w & 0xffff0000u) * bias); }
    }
    __syncthreads();
}

__device__ __forceinline__ void phase_m1(const Ptrs P, int l, LAS unsigned char* lds) {
    const int tid = P.tid, G = P.G;
    const bf16_t* U = (const bf16_t*)(P.ws + WS_BIG + BIG_U); bf16_t* WT = (bf16_t*)(P.ws + WS_BIG + BIG_WT);
    const float* hcw = P.inp(I_HYCW) + (size_t)l * 3 * 768; const float* hcb = P.inp(I_HYCB) + l * 768;
    const int NH = NB * 4 * NCHK, NSS = NB * 2 * NCHK;
    const int NS2 = NH + NSS;
    const int NU = NS2 + 256 + NCTX / 64;
    for (int u = P.bid; u < NU; u += G) {
        Ptrs Pu = P; asm volatile("" : "+v"(Pu.tid));
        if (u < NSS) ssd_pass1(Pu, l, u, lds);
        else if (u < NS2) hgrn_pass1(Pu, l, u - NSS, lds);
        else if (u < NS2 + 256) { const int tid = Pu.tid;
            const int ub = u - NS2; const int p = ub >> 6, tb = ub & 63; const int c = tid & 255; LAS unsigned* tile = (LAS unsigned*)lds;
            for (int it = tid; it < 2 * 64 * 32; it += 512) { const int b2 = it >> 11, rr = (it >> 5) & 63, g8 = it & 31; const int row = (2 * p + b2) * SEQ + tb * 64 + rr; float x1[8], vv[8];
                conv3_8<false>(U, row, 256 + 8 * g8, hcw, 768, 256 + 8 * g8, hcb, x1); conv3_8<false>(U, row, 512 + 8 * g8, hcw, 768, 512 + 8 * g8, hcb, vv);
                LAS bf16_t* th = (LAS bf16_t*)tile + b2;
#pragma unroll
                for (int e2 = 0; e2 < 4; ++e2) { const unsigned w = pack2(x1[2 * e2] * vv[2 * e2], x1[2 * e2 + 1] * vv[2 * e2 + 1]);
                    th[2 * ((8 * g8 + 2 * e2) * 65 + rr)] = (bf16_t)(w & 0xffffu); th[2 * ((8 * g8 + 2 * e2 + 1) * 65 + rr)] = (bf16_t)(w >> 16); } }
            __syncthreads();
            { unsigned* WTt = (unsigned*)(P.ws + WS_BIG + BIG_WT); const int t = tid & 63;
              for (int cc = tid >> 6; cc < 256; cc += 8) WTt[((size_t)cc * 4 + p) * 4096 + tb * 64 + t] = tile[cc * 65 + t]; }
            __syncthreads();
        } else { const int tid = Pu.tid;
            const int ub = u - NS2 - 256; const int c = tid & 255; bf16_t* WTC = (bf16_t*)(P.ws + WS_BIG + BIG_WT) + (size_t)NLAT * 256;
#pragma unroll 4
            for (int rr = tid >> 8; rr < 64; rr += 2) { const int row = NLAT + ub * 64 + rr;
                const float x1 = conv3_u(U, row, 256 + c, hcw, 768, 256 + c) + hcb[256 + c]; const float v = conv3_u(U, row, 512 + c, hcw, 768, 512 + c) + hcb[512 + c];
                WTC[(size_t)(row - NLAT) * 256 + c] = f2bf(x1 * v); } }
    }
}

__device__ __forceinline__ void phase_m2(const Ptrs P, int l, LAS unsigned char* lds) {
    const int tid = P.tid, G = P.G;
    const bf16_t* U = (const bf16_t*)(P.ws + WS_BIG + BIG_U); bf16_t* BR = (bf16_t*)(P.ws + WS_BR);
    const float* hcw = P.inp(I_HYCW) + (size_t)l * 3 * 768; const float* hcb = P.inp(I_HYCB) + l * 768;
    const int NU_F = 256, NU_P2 = 256, NU_HC = (l == 0) ? NB * 8 : 0;
    const int NU = NU_F + NU_P2 + NU_HC;
    for (int u = P.bid; u < NU; u += G) {
        if (u < NU_F) { hyena_fft_unit(P, l, u, lds); continue; }
        if (u < NU_F + NU_P2) { scan_pass2(P, u - NU_F); continue; }
        {
            const int uu = u - NU_F - NU_P2; const int b = uu >> 3, cb = uu & 7; const int cl = tid & 31, tg = tid >> 5; const int c = cb * 32 + cl;
            const int base = NLAT + b * CTXL; const bf16_t* WTC = (const bf16_t*)(P.ws + WS_BIG + BIG_WT) + (size_t)NLAT * 256 + (size_t)b * CTXL * 256;
            LAS float* wl = (LAS float*)lds; LAS float* fl = wl + 256 * 32;
            const float inv = 1.0f / hy_norm(P, 2, c); const float* filt = (const float*)(P.ws + WS_FILTC);
            for (int i = tid; i < 256 * 32; i += 512) wl[i] = bf2f(WTC[(size_t)(i >> 5) * 256 + cb * 32 + (i & 31)]);
            for (int i = tid >> 5; i < 512; i += 16) fl[i * 32 + cl] = filt[(size_t)i * 256 + c] * inv;
            __syncthreads();
            float acc[16];
#pragma unroll
            for (int j = 0; j < 16; ++j) acc[j] = 0.f;
#pragma unroll 1
            for (int sb = 0; sb < 16; ++sb) {
                float fw[31], wv[16];
#pragma unroll
                for (int q = 0; q < 31; ++q) fw[q] = fl[((16 * tg - 16 * sb - 15 + q) & 511) * 32 + cl];
#pragma unroll
                for (int k = 0; k < 16; ++k) wv[k] = wl[(16 * sb + k) * 32 + cl];
#pragma unroll
                for (int j = 0; j < 16; ++j)
#pragma unroll
                    for (int k = 0; k < 16; ++k) acc[j] += fw[j - k + 15] * wv[k];
            }
            const float bias = P.inp(I_HYBIAS)[l * 256 + c];
#pragma unroll 4
            for (int j = 0; j < 16; ++j) { const int tt = 16 * tg + j; const int row = base + tt; const float x0 = conv3_u(U, row, c, hcw, 768, c) + hcb[c];
                BR[(size_t)row * 256 + c] = f2bf(x0 * (acc[j] + wl[tt * 32 + cl] * bias)); }
            __syncthreads();
        }
    }
}

__device__ __forceinline__ void phase_m3(const Ptrs P, int l, LAS unsigned char* lds) {
    const int tid = P.tid, G = P.G;
    const bool last = (l == NLAYER - 1); const int rows_l = last ? NLAT : T;
    const bf16_t* U = (const bf16_t*)(P.ws + WS_BIG + BIG_U); bf16_t* BR = (bf16_t*)(P.ws + WS_BR);
    const int NSS3 = NB * 2 * NCHK, NH3 = NB * 4 * NCHK;
    const int NS3T = NSS3 + NH3;
    const int NU = NS3T + rows_l / 64 + 256;
    const float* hcw = P.inp(I_HYCW) + (size_t)l * 3 * 768; const float* hcb = P.inp(I_HYCB) + l * 768;
    for (int u = P.bid; u < NU; u += G) {
        if (u >= NS3T + rows_l / 64) {
            const int ub = u - NS3T - rows_l / 64; const int p = ub >> 6, tb = ub & 63; LAS unsigned* tile = (LAS unsigned*)lds; const unsigned* WTt = (const unsigned*)(P.ws + WS_BIG + BIG_WT);
            { const int t = tid & 63; for (int cc = tid >> 6; cc < 256; cc += 8) tile[cc * 65 + t] = WTt[((size_t)cc * 4 + p) * 4096 + tb * 64 + t]; }
            __syncthreads();
            for (int it = tid; it < 64 * 32; it += 512) { const int rr = it >> 5, g8 = it & 31; unsigned yw[8];
#pragma unroll
                for (int e = 0; e < 8; ++e) yw[e] = tile[(8 * g8 + e) * 65 + rr];
#pragma unroll
                for (int b2 = 0; b2 < 2; ++b2) { const int row = (2 * p + b2) * SEQ + tb * 64 + rr; float x0[8], t8[8]; conv3_8<false>(U, row, 8 * g8, hcw, 768, 8 * g8, hcb, x0);
#pragma unroll
                    for (int e = 0; e < 8; ++e) t8[e] = x0[e] * (b2 ? __uint_as_float(yw[e] & 0xffff0000u) : __uint_as_float(yw[e] << 16));
                    *(bf16x8*)(BR + (size_t)row * 256 + 8 * g8) = pack8(t8); } }
            __syncthreads();
            continue; }
        if (u < NS3T) { const int uu = u < NSS3 ? u : u - NSS3; if (last && (uu % NCHK) < 2) continue;
            Ptrs Pu = P; int lu = l; asm volatile("" : "+v"(Pu.tid), "+s"(lu));
            if (u < NSS3) ssd_pass3(Pu, lu, uu, lds); else { int un = (u + G < NS3T) ? uu + G : -1; if (un >= 0 && last && (un % NCHK) < 2) un = -1; hgrn_pass3(Pu, lu, uu, un, lds); } }
        else { const int rb = u - NS3T; const float* cw = P.inp(I_SCCW) + (size_t)l * 3 * 256;
            for (int it = tid; it < 64 * 32; it += 512) { const int row = rb * 64 + (it >> 5), g8 = it & 31; const bool hp = row_has_prev(row), hn = row_has_next(row);
                const bf16_t* u0 = U + (size_t)row * UC + 8 * g8; const bf16_t* up = U + (size_t)(hp ? row - 1 : row) * UC + 8 * g8; const bf16_t* un = U + (size_t)(hn ? row + 1 : row) * UC + 8 * g8;
                const bf16x8 bg = *(const bf16x8*)(u0 + 768), c0 = *(const bf16x8*)(u0 + 1024), x0 = *(const bf16x8*)(u0 + 1280), cp = *(const bf16x8*)(up + 1024), xp = *(const bf16x8*)(up + 1280), cn = *(const bf16x8*)(un + 1024), xn = *(const bf16x8*)(un + 1280);
                const float mp = hp ? 1.0f : 0.0f, mn = hn ? 1.0f : 0.0f; float t8[8];
#pragma unroll
                for (int e = 0; e < 8; ++e) { const int c = 8 * g8 + e;
                    const float acc = bf2f((bf16_t)c0[e]) * bf2f((bf16_t)x0[e]) * cw[256 + c] + mp * bf2f((bf16_t)cp[e]) * bf2f((bf16_t)xp[e]) * cw[c] + mn * bf2f((bf16_t)cn[e]) * bf2f((bf16_t)xn[e]) * cw[512 + c];
                    t8[e] = bf2f((bf16_t)bg[e]) * acc; }
                *(bf16x8*)(BR + (size_t)T * 256 + (size_t)row * 256 + 8 * g8) = pack8(t8); } }
    }
}

__device__ __forceinline__ void phase_g2(const Ptrs P, int l, LAS unsigned char* lds) {
    const int MT = ((l == NLAYER - 1) ? NLAT : T) / 256;
    pg8::Gemm g{(const bf16_t*)(P.ws + WS_BR), (const bf16_t*)(P.ws + WS_WBR), 256};
    EpiP E{(bf16_t*)(P.ws + WS_BIG + BIG_P), (const float*)(P.ws + WS_SSQ)};
    SchedG2 S{XOrder{P.G, P.bid, MT, 16}};
    pg8::gemm_phase<EpiP, SchedG2, false>(P.tid, lds, g, S, E);
}
__device__ __forceinline__ void phase_g3(const Ptrs P, int l, LAS unsigned char* lds) {
    const int MT = ((l == NLAYER - 1) ? NLAT : T) / 256;
    pg8::Gemm g{(const bf16_t*)(P.ws + WS_HBUF), (const bf16_t*)(P.ws + WS_WG), D};
    EpiMerge E{(const bf16_t*)(P.ws + WS_BIG + BIG_P), (const float*)(P.ws + WS_BGP), (bf16_t*)(P.ws + WS_BR)};
    SchedMN S{XOrder{P.G, P.bid, MT, 16}};
    pg8::gemm_phase<EpiMerge, SchedMN, false>(P.tid, lds, g, S, E);
}
__device__ __forceinline__ void phase_g4(const Ptrs P, int l, LAS unsigned char* lds) {
    const int MT = ((l == NLAYER - 1) ? NLAT : T) / 256;
    pg8::Gemm g{(const bf16_t*)(P.ws + WS_BR), (const bf16_t*)(P.ws + WS_WO), D};
    EpiWo E{P, l};
    SchedMN S{XOrder{P.G, P.bid, MT, 4}};
    pg8::gemm_phase<EpiWo, SchedMN, false>(P.tid, lds, g, S, E);
}

__device__ __forceinline__ void phase_e5(const Ptrs P, int l, LAS unsigned char* lds) {
    const int tid = P.tid, wid = tid >> 6, lane = tid & 63, G = P.G, fr = lane & 15, fq = lane >> 4;
    const int rows_l = (l == NLAYER - 1) ? NLAT : T;
    LAS bf16_t* wrH = (LAS bf16_t*)lds;
    LAS bf16_t* wrL = wrH + 16 * 1032;
    LAS float* tile = (LAS float*)(lds + 69632);
    LAS float* lgs = (LAS float*)(lds + 136192);
    LAS unsigned* lcnt = (LAS unsigned*)(lds + 144896); LAS unsigned* gbase = lcnt + 16; LAS int* rec = (LAS int*)(lcnt + 32);
    for (int i = tid; i < 1024 * 16; i += 512) { const int k = i >> 4, e = i & 15; const float w = P.inp(I_WROUTER)[i]; const unsigned hi = pack2(w, 0.f) & 0xffffu; const float lo = w - __uint_as_float(hi << 16);
        wrH[e * 1032 + k] = (bf16_t)hi; wrL[e * 1032 + k] = f2bf(lo); }
    if (tid < 16) lcnt[tid] = 0u;
    __syncthreads();
    unsigned* cnt = (unsigned*)(P.ws + WS_CTL + CTL_CNT) + l * 16;
    int* toke = (int*)(P.ws + WS_TOKE); float* tokw = (float*)(P.ws + WS_TOKW); int* toks = (int*)(P.ws + WS_TOKS); int* list = (int*)(P.ws + WS_LIST);
    const float* g = P.inp(I_LN1G) + l * D; const float* bta = P.inp(I_LN1B) + l * D;
    bf16_t* H2 = (bf16_t*)(P.ws + WS_HBUF);
    const int NU_R = rows_l / 8; const int NU = NU_R + NCONV_EX;
    int nloc = 0;
    {
        RowV lng, lnb; row_load(lng, g, lane); row_load(lnb, bta, lane);
        RowV rn; { const float z = zero_f(); for (int i = 0; i < 4; ++i) rn.v[i] = (f32x4){z, z, z, z}; } if (P.bid < NU_R) row_load(rn, P.latrow(P.bid * 8 + wid), lane);
        RowV msh, msc; { const float z = zero_f(); for (int i = 0; i < 4; ++i) { msh.v[i] = (f32x4){z, z, z, z}; msc.v[i] = msh.v[i]; } } int mcur = -1;
        for (int u = P.bid; u < NU_R; u += G) {
            const int row = u * 8 + wid; RowV r = rn; float* lp = P.latrow(row);
            if (u + G < NU_R) row_load(rn, P.latrow((u + G) * 8 + wid), lane);
            row_layernorm_r(r, lng, lnb); row_store(r, lp, lane);
            const int mi = row_modidx(row); if (mi != mcur) { mcur = mi; const float* m = P.mod(l, mi); row_load(msh, m + 3072, lane); row_load(msc, m + 4096, lane); }
            RowV h; row_modulate_r(r, h, msh, msc);
            row_store_bf16(h, H2 + (size_t)row * D, lane);
            ++nloc;
        }
    }
    asm volatile("s_waitcnt vmcnt(0)" ::: "memory");
    __syncthreads();
    {
        const int ntile = (nloc + 1) >> 1; LAS float* lg = lgs + wid * 16 * 17;
        for (int t = wid; t < ntile; t += 8) {
            int it = 2 * t + (fr >> 3); const bool valid_a = it < nloc; if (!valid_a) it = nloc - 1;
            const bf16_t* ap = H2 + (size_t)((P.bid + G * it) * 8 + (fr & 7)) * D + 8 * fq;
            f32x4 acc = (f32x4){0.f, 0.f, 0.f, 0.f};
#pragma unroll 4
            for (int ks = 0; ks < 32; ++ks) { const bf16x8 a = *(const bf16x8*)(ap + 32 * ks);
                const bf16x8 bh = *(const LAS bf16x8*)(wrH + fr * 1032 + 32 * ks + 8 * fq), bl = *(const LAS bf16x8*)(wrL + fr * 1032 + 32 * ks + 8 * fq);
                acc = __builtin_amdgcn_mfma_f32_16x16x32_bf16(a, bh, acc, 0, 0, 0); acc = __builtin_amdgcn_mfma_f32_16x16x32_bf16(a, bl, acc, 0, 0, 0); }
#pragma unroll
            for (int r = 0; r < 4; ++r) lg[(4 * fq + r) * 17 + fr] = acc[r];
            const int it2 = 2 * t + (lane >> 3); const bool act = (lane < 16) && (it2 < nloc);
            if (act) {
                const int row = (P.bid + G * it2) * 8 + (lane & 7);
                float lgv[16];
#pragma unroll
                for (int e = 0; e < 16; ++e) lgv[e] = lg[lane * 17 + e];
                float mx = lgv[0];
#pragma unroll
                for (int e = 1; e < 16; ++e) mx = fmaxf(mx, lgv[e]);
                float sc[16], sel[16], ssum = 0.f;
#pragma unroll
                for (int e = 0; e < 16; ++e) { sc[e] = fexp(lgv[e] - mx); ssum += sc[e]; }
                const float inv = 1.0f / ssum;
#pragma unroll
                for (int e = 0; e < 16; ++e) { sc[e] *= inv; sel[e] = sc[e] + P.inp(I_BROUTER)[e]; }
                int bestg = 0; float bestgs = -3.0e38f;
#pragma unroll
                for (int gq = 0; gq < 4; ++gq) { float m1 = -3.0e38f, m2 = -3.0e38f;
#pragma unroll
                    for (int j = 0; j < 4; ++j) { const float v = sel[gq * 4 + j]; if (v > m1) { m2 = m1; m1 = v; } else if (v > m2) m2 = v; }
                    const float gs = m1 + m2; if (gs > bestgs) { bestgs = gs; bestg = gq; } }
                int i1 = 0, i2 = 0; float v1 = -3.0e38f, v2 = -3.0e38f, w1 = 0.f, w2 = 0.f;
#pragma unroll
                for (int e = 0; e < 16; ++e) { if ((e >> 2) == bestg && sel[e] > v1) { v1 = sel[e]; i1 = e; w1 = sc[e]; } }
#pragma unroll
                for (int e = 0; e < 16; ++e) { if ((e >> 2) == bestg && e != i1 && sel[e] > v2) { v2 = sel[e]; i2 = e; w2 = sc[e]; } }
                const float ws_ = 1.0f / (w1 + w2);
                const int s1 = (int)__hip_atomic_fetch_add(lcnt + i1, 1u, __ATOMIC_RELAXED, __HIP_MEMORY_SCOPE_WORKGROUP);
                const int s2 = (int)__hip_atomic_fetch_add(lcnt + i2, 1u, __ATOMIC_RELAXED, __HIP_MEMORY_SCOPE_WORKGROUP);
                const int idx = it2 * 8 + (lane & 7); rec[idx * 3] = i1 | (i2 << 8); rec[idx * 3 + 1] = s1; rec[idx * 3 + 2] = s2;
                toke[row * 2] = i1; toke[row * 2 + 1] = i2; tokw[row * 2] = w1 * ws_; tokw[row * 2 + 1] = w2 * ws_;
            }
        }
    }
    __syncthreads();
    if (tid < 16) gbase[tid] = __hip_atomic_fetch_add(cnt + tid, lcnt[tid], __ATOMIC_RELAXED, __HIP_MEMORY_SCOPE_AGENT);
    __syncthreads();
    for (int idx = tid; idx < nloc * 8; idx += 512) { const int row = (P.bid + G * (idx >> 3)) * 8 + (idx & 7); const int ee = rec[idx * 3]; const int e1 = ee & 255, e2 = ee >> 8;
        const int s1 = (int)gbase[e1] + rec[idx * 3 + 1], s2 = (int)gbase[e2] + rec[idx * 3 + 2];
        list[(size_t)e1 * T + s1] = row; list[(size_t)e2 * T + s2] = row; toks[row * 2] = s1; toks[row * 2 + 1] = s2; }
    for (int u = P.bid + G * nloc; u < NU; u += G) { if (u >= NU_R) conv_unit_ex(P, l, u - NU_R, tile); }
}

struct MoeSeg { int toff[17]; };
__device__ __forceinline__ void moe_seg(const unsigned* cnt, MoeSeg& S) { int a = 0;
#pragma unroll
    for (int e = 0; e < 16; ++e) { S.toff[e] = a; a += __builtin_amdgcn_readfirstlane(((int)cnt[e] + 255) >> 8); }
    S.toff[16] = a; }
__device__ __forceinline__ int moe_find(const MoeSeg& S, int tg, int& off) { int e = 0; off = 0;
#pragma unroll
    for (int j = 1; j < 16; ++j) { const bool ge = (tg >= S.toff[j]); e += ge ? 1 : 0; off = ge ? S.toff[j] : off; }
    return e; }

struct SchedMoe { int G, c; MoeSeg S; const int* list; const unsigned* cnt;
    __device__ __forceinline__ bool next(int i, Unit& u) const { const int L = i * G + c; if (L >= S.toff[16] * 4) return false; const int tg = L >> 2, pnn = L & 3; int off; const int e = moe_find(S, tg, off);
        u.pm = tg; u.pn = e * 4 + pnn; u.e = e; u.aux = tg - off; return true; }
    __device__ __forceinline__ int arow(const Unit& u, int R) const { const int idx = u.aux * 256 + R; const int* l = list + (size_t)u.e * T; return idx < (int)cnt[u.e] ? l[idx] : l[0]; } };
__device__ __forceinline__ void phase_g5(const Ptrs P, int l, LAS unsigned char* lds) {
    const unsigned* cnt = (const unsigned*)(P.ws + WS_CTL + CTL_CNT) + l * 16;
    SchedMoe S; S.G = P.G; S.c = P.bid; moe_seg(cnt, S.S); S.list = (const int*)(P.ws + WS_LIST); S.cnt = cnt;
    pg8::Gemm g{(const bf16_t*)(P.ws + WS_HBUF), (const bf16_t*)(P.ws + WS_BIG + BIG_W13), D};
    EpiFfn1 E{(bf16_t*)(P.ws + WS_BIG + BIG_HID)};
    pg8::gemm_phase<EpiFfn1, SchedMoe, true>(P.tid, lds, g, S, E);
}
__device__ __forceinline__ void phase_g6(const Ptrs P, int l, LAS unsigned char* lds) {
    const unsigned* cnt = (const unsigned*)(P.ws + WS_CTL + CTL_CNT) + l * 16;
    SchedMoe S; S.G = P.G; S.c = P.bid; moe_seg(cnt, S.S); S.list = (const int*)(P.ws + WS_LIST); S.cnt = cnt;
    pg8::Gemm g{(const bf16_t*)(P.ws + WS_BIG + BIG_HID), (const bf16_t*)(P.ws + WS_BIG + BIG_W2), 512};
    EpiBf16Plain E{(bf16_t*)(P.ws + WS_BIG + BIG_YE), 1024, 3};
    pg8::gemm_phase<EpiBf16Plain, SchedMoe, false>(P.tid, lds, g, S, E);
}

__device__ __forceinline__ void phase_e8(const Ptrs P, int l, LAS unsigned char* lds) {
    const int tid = P.tid, wid = tid >> 6, lane = tid & 63, G = P.G;
    const bool last = (l == NLAYER - 1); const int rows_l = last ? NLAT : T;
    LAS float* wdt = (LAS float*)lds; LAS float* tile = (LAS float*)(lds + 65536);
    if (!last) load_wdt(P, l + 1, wdt);
    const unsigned* cnt = (const unsigned*)(P.ws + WS_CTL + CTL_CNT) + l * 16; MoeSeg S; moe_seg(cnt, S);
    const int* toke = (const int*)(P.ws + WS_TOKE); const float* tokw = (const float*)(P.ws + WS_TOKW); const int* toks = (const int*)(P.ws + WS_TOKS);
    const bf16_t* YE = (const bf16_t*)(P.ws + WS_BIG + BIG_YE);
    const float* g = P.inp(I_LN2G) + l * D; const float* bta = P.inp(I_LN2B) + l * D;
    const int NU_R = rows_l / 8; const int NU = NU_R + (last ? 0 : NCONV_NE);
    RowV lng, lnb; row_load(lng, g, lane); row_load(lnb, bta, lane);
    RowV mg2, msh, msc; { const float z = zero_f(); for (int i = 0; i < 4; ++i) { mg2.v[i] = (f32x4){z, z, z, z}; msh.v[i] = mg2.v[i]; msc.v[i] = mg2.v[i]; } } int mcur = -1;
    RowV rn; { const float z = zero_f(); for (int i = 0; i < 4; ++i) rn.v[i] = (f32x4){z, z, z, z}; } int te1 = 0, te2 = 0, ts1 = 0, ts2 = 0; float tw1 = 0.f, tw2 = 0.f;
    if (P.bid < NU_R) { const int row = P.bid * 8 + wid; row_load(rn, P.latrow(row), lane); te1 = toke[row * 2]; te2 = toke[row * 2 + 1]; tw1 = tokw[row * 2]; tw2 = tokw[row * 2 + 1]; ts1 = toks[row * 2]; ts2 = toks[row * 2 + 1]; }
    int uconv = P.bid;
    for (int u = P.bid; u < NU_R; u += G) {
        uconv = u + G;
        const int row = u * 8 + wid; RowV r = rn; float* lp = P.latrow(row);
        const int e1 = te1, e2 = te2; const float w1 = tw1, w2 = tw2;
        int o1 = 0, o2 = 0;
#pragma unroll
        for (int e = 0; e < 16; ++e) { o1 = (e == e1) ? S.toff[e] : o1; o2 = (e == e2) ? S.toff[e] : o2; }
        const bf16_t* y1 = YE + ((size_t)o1 * 256 + ts1) * 1024; const bf16_t* y2 = YE + ((size_t)o2 * 256 + ts2) * 1024;
        u32x2 ya[4], yb[4];
#pragma unroll
        for (int i = 0; i < 4; ++i) { ya[i] = *(const u32x2*)(y1 + i * 256 + lane * 4); yb[i] = *(const u32x2*)(y2 + i * 256 + lane * 4); }
        if (u + G < NU_R) { const int rw = (u + G) * 8 + wid; row_load(rn, P.latrow(rw), lane); te1 = toke[rw * 2]; te2 = toke[rw * 2 + 1]; tw1 = tokw[rw * 2]; tw2 = tokw[rw * 2 + 1]; ts1 = toks[rw * 2]; ts2 = toks[rw * 2 + 1]; }
        const int mi = row_modidx(row);
        if (mi != mcur) { mcur = mi; row_load(mg2, P.mod(l, mi) + 5120, lane); if (!last) { const float* m2 = P.mod(l + 1, mi); row_load(msh, m2, lane); row_load(msc, m2 + 1024, lane); } }
#pragma unroll
        for (int i = 0; i < 4; ++i) { const u32x2 a = ya[i], b = yb[i];
            const f32x4 g2 = mg2.v[i];
            f32x4 mo; mo[0] = w1 * __uint_as_float(a.x << 16) + w2 * __uint_as_float(b.x << 16); mo[1] = w1 * __uint_as_float(a.x & 0xffff0000u) + w2 * __uint_as_float(b.x & 0xffff0000u);
            mo[2] = w1 * __uint_as_float(a.y << 16) + w2 * __uint_as_float(b.y << 16); mo[3] = w1 * __uint_as_float(a.y & 0xffff0000u) + w2 * __uint_as_float(b.y & 0xffff0000u);
            r.v[i] = r.v[i] * ALPHA + g2 * mo; }
        row_layernorm_r(r, lng, lnb);
        row_store(r, lp, lane);
        if (!last) { RowV h; row_modulate_r(r, h, msh, msc);
            row_store_bf16(h, (bf16_t*)(P.ws + WS_HBUF) + (size_t)row * D, lane); row_dt(h, wdt, (float*)(P.ws + WS_DT) + (size_t)row * 8, lane); }
    }
    for (int u = uconv; u < NU; u += G) { if (u >= NU_R) conv_unit_ne(P, l + 1, u - NU_R, tile); }
}

constexpr int NPH_LAYER = 11, NPH = 2 + NLAYER * NPH_LAYER;
__global__ void __launch_bounds__(512, 2) fwd_kernel(Args a) {
    extern __shared__ __attribute__((aligned(16))) unsigned char lds_raw[];
    LAS unsigned char* lds = (LAS unsigned char*)lds_raw;
    const int lo = a.ph_lo, hi = a.ph_hi;
    volatile LAS unsigned* xbw = (volatile LAS unsigned*)(lds + LDS_MISC);
    const int wave_s = __builtin_amdgcn_readfirstlane((int)threadIdx.x >> 6);
    if (threadIdx.x < 4) xbw[threadIdx.x] = 0u;
    __syncthreads();
    XcdBarrier bar; bar.bar = (unsigned*)(a.ws + WS_CTL); bar.x = 0; bar.st = xbw;
    if (hi - lo > 1) bar = xcd_barrier_post((unsigned*)(a.ws + WS_CTL), xbw, wave_s);
#ifndef PH_MASK
#define PH_MASK 0xFFFFFFFFu
#endif
#ifndef PROBE_PH
#define PROBE_PH (-1)
#define PROBE_N 1
#endif
#define REP(id) for (int rep_ = 0; rep_ < ((PROBE_PH == (id)) ? PROBE_N : 1); ++rep_)
#define PH_ON(id) (((PH_MASK) >> (id)) & 1u)
#define IN(k) (lo <= (k) && (k) < hi)
#define FRESH() Ptrs Pq; { const AS4 char* ka_ = (const AS4 char*)__builtin_amdgcn_kernarg_segment_ptr(); AS1 float* o_ = *(AS1 float* const AS4*)(ka_ + 8 * N_IN); AS1 unsigned char* w_ = *(AS1 unsigned char* const AS4*)(ka_ + 8 * N_IN + 8); int l_ = lcur; asm volatile("" : "+s"(o_), "+s"(w_), "+s"(l_) :: "memory"); Pq.out = (float*)o_; Pq.ws = (unsigned char*)w_; lq = l_; int ws_ = wave_s, b_ = blockIdx.x, g_ = gridDim.x; asm volatile("" : "+s"(ws_), "+s"(b_), "+s"(g_)); int ln_ = lane_id(); asm volatile("" : "+v"(ln_)); int t_ = ws_ * 64 + ln_; Pq.tid = t_; Pq.bid = b_; Pq.G = g_; }
#define SEAM(k) do { if (IN(k) && IN((k) + 1)) xcd_barrier(bar, wave_s); } while (0)
    int lcur = 0, lq = 0;
    if (PH_ON(0) && IN(0)) REP(0) { FRESH(); phase_pa(Pq, lds); } SEAM(0);
    if (PH_ON(1) && IN(1)) REP(1) { FRESH(); phase_pb(Pq, lds); } SEAM(1);
    for (int l = 0; l < NLAYER; ++l) {
        const int b = 2 + l * NPH_LAYER; lcur = l;
        if (PH_ON(2) && IN(b + 0)) REP(2) { FRESH(); phase_g1(Pq, lds); } SEAM(b + 0);
        for (int g_ = 0; g_ < ((PROBE_PH == 100) ? PROBE_N : 1); ++g_) {
        if (PH_ON(3) && IN(b + 1)) REP(3) { FRESH(); phase_m1(Pq, lq, lds); } SEAM(b + 1);
        if (PH_ON(4) && IN(b + 2)) REP(4) { FRESH(); phase_m2(Pq, lq, lds); } SEAM(b + 2);
        if (PH_ON(5) && IN(b + 3)) REP(5) { FRESH(); phase_m3(Pq, lq, lds); } SEAM(b + 3);
        }
        if (PH_ON(6) && IN(b + 4)) REP(6) { FRESH(); phase_g2(Pq, lq, lds); } SEAM(b + 4);
        if (PH_ON(7) && IN(b + 5)) REP(7) { FRESH(); phase_g3(Pq, lq, lds); } SEAM(b + 5);
        if (PH_ON(8) && IN(b + 6)) REP(8) { FRESH(); phase_g4(Pq, lq, lds); } SEAM(b + 6);
        if (PH_ON(9) && IN(b + 7)) REP(9) { FRESH(); phase_e5(Pq, lq, lds); } SEAM(b + 7);
        if (PH_ON(10) && IN(b + 8)) REP(10) { FRESH(); phase_g5(Pq, lq, lds); } SEAM(b + 8);
        if (PH_ON(11) && IN(b + 9)) REP(11) { FRESH(); phase_g6(Pq, lq, lds); } SEAM(b + 9);
        if (PH_ON(12) && IN(b + 10)) REP(12) { FRESH(); phase_e8(Pq, lq, lds); } SEAM(b + 10);
    }
#undef IN
#undef SEAM
}
}

extern "C" void kernel_launch(void* const* d_in, const int* in_sizes, int n_in, void* d_out, int out_size, void* d_ws, size_t ws_size, hipStream_t stream) {
    static int grid = 0;
    if (grid == 0) {
        if (n_in != N_IN || out_size != NLAT * D || ws_size < WS_END) { fprintf(stderr, "kernel_launch: unexpected shapes / workspace (%d inputs, out %d, ws %zu < %zu)\n", n_in, out_size, ws_size, (size_t)WS_END); grid = -1; return; }
        int dev = 0, cus = 0, per_cu = 0;
        if (hipGetDevice(&dev) != hipSuccess || hipDeviceGetAttribute(&cus, hipDeviceAttributeMultiprocessorCount, dev) != hipSuccess) { grid = -1; return; }
        if (hipFuncSetAttribute((const void*)fwd_kernel, hipFuncAttributeMaxDynamicSharedMemorySize, LDS_BYTES) != hipSuccess) { fprintf(stderr, "kernel_launch: hipFuncSetAttribute failed\n"); grid = -1; return; }
        if (hipOccupancyMaxActiveBlocksPerMultiprocessor(&per_cu, (const void*)fwd_kernel, 512, LDS_BYTES) != hipSuccess || per_cu < 1) { fprintf(stderr, "kernel_launch: occupancy query says %d\n", per_cu); }
        (void)hipGetLastError();
        grid = cus;
    }
    if (grid < 0) return;
    (void)hipMemsetAsync((char*)d_ws + WS_CTL, 0, CTL_BYTES, stream);
    Args a{};
    for (int i = 0; i < N_IN; ++i) a.in[i] = (const float*)d_in[i];
    a.out = (float*)d_out; a.ws = (unsigned char*)d_ws;
#if N_LAUNCH_MODE == 1
    a.ph_lo = 0; a.ph_hi = NPH;
    hipLaunchKernelGGL(fwd_kernel, dim3(grid), dim3(512), LDS_BYTES, stream, a);
#else
    for (int p = 0; p < NPH; ++p) { a.ph_lo = p; a.ph_hi = p + 1; hipLaunchKernelGGL(fwd_kernel, dim3(grid), dim3(512), LDS_BYTES, stream, a); }
#endif
}
```

```cpp
#include <hip/hip_runtime.h>
#include <cstdio>
#include <cstdint>

#ifndef N_LAUNCH_MODE
#define N_LAUNCH_MODE 1
#endif

namespace {
typedef unsigned short bf16_t;
typedef short bf16x8 __attribute__((ext_vector_type(8)));
typedef float f32x4 __attribute__((ext_vector_type(4)));
typedef unsigned u32x2 __attribute__((ext_vector_type(2)));
typedef unsigned u32x4 __attribute__((ext_vector_type(4)));
#define LAS __attribute__((address_space(3)))

constexpr int D = 1024, NB = 8, SEQ = 4096, CTXL = 256, NLAT = NB * SEQ, NCTX = NB * CTXL, T = NLAT + NCTX;
constexpr int NLAYER = 2;
constexpr int UC = 3584;
constexpr int INC = 3592;
constexpr int NE = 16;
constexpr float ALPHA = 1.41421356237309515f;
constexpr float LN_EPS = 1e-5f, RMS_EPS = 1e-6f;
constexpr int MAXTILES = 288;

enum { I_X = 0, I_C, I_CTX, I_CCTX, I_WADA, I_BADA, I_WIN, I_HYCW, I_HYCB, I_HYW1, I_HYB1, I_HYF1, I_HYW2, I_HYB2, I_HYF2, I_HYW3, I_HYDEC, I_HYBIAS,
       I_SCCW, I_HGLB, I_HGNG, I_SSDCW, I_SSDCB, I_SSDALOG, I_SSDDTB, I_SSDD, I_SSDNG, I_WGATE, I_BGATE, I_WBR, I_WO, I_LN1G, I_LN1B, I_LN2G, I_LN2B,
       I_WROUTER, I_BROUTER, I_WE1, I_WE3, I_WE2, N_IN };

constexpr size_t al256(size_t x) { return (x + 255) & ~(size_t)255; }
constexpr size_t WS_CTL = 0;
constexpr size_t CTL_BYTES = 65536;
constexpr size_t CTL_CNT = 16384;
constexpr size_t CTL_DYN = 20480;
constexpr size_t WS_MOD = WS_CTL + CTL_BYTES;
constexpr size_t WS_LB = WS_MOD + al256((size_t)NLAYER * 9 * 6144 * 4);
constexpr size_t WS_TW = WS_LB + 4096;
constexpr size_t WS_H2TAB = WS_TW + 65536;
constexpr size_t WS_PART = WS_H2TAB + (size_t)8448 * 64 * 4;
constexpr size_t WS_FILT = WS_PART + (size_t)3 * 64 * 512 * 4;
constexpr size_t WS_FILTC = WS_FILT + (size_t)2 * 8192 * 256 * 4;
constexpr size_t WS_CX32 = WS_FILTC + (size_t)512 * 256 * 4;
constexpr size_t WS_DT = WS_CX32 + (size_t)NCTX * D * 4;
constexpr size_t WS_SSQ = WS_DT + (size_t)T * 8 * 4;
constexpr size_t WS_TOKE = WS_SSQ + (size_t)T * 4 * 4;
constexpr size_t WS_TOKW = WS_TOKE + (size_t)T * 2 * 4;
constexpr size_t WS_TOKS = WS_TOKW + (size_t)T * 2 * 4;
constexpr size_t WS_LIST = WS_TOKS + (size_t)T * 2 * 4;
constexpr size_t WS_BGP = WS_LIST + (size_t)NE * T * 4;
constexpr size_t WS_DEC = WS_BGP + 16384;
constexpr size_t WS_WIN = WS_DEC + (size_t)4352 * 64 * 4;
constexpr size_t WS_WG = WS_WIN + (size_t)UC * D * 2;
constexpr size_t WS_WBR = WS_WG + (size_t)4096 * D * 2;
constexpr size_t WS_WO = WS_WBR + (size_t)4096 * 256 * 2;
constexpr size_t WS_HBUF = WS_WO + (size_t)D * D * 2;
constexpr size_t WS_BR = WS_HBUF + (size_t)T * D * 2;
constexpr size_t WS_BIG = WS_BR + (size_t)T * D * 2;
constexpr size_t BIG_U = 0;
constexpr size_t BIG_HGO = BIG_U + (size_t)T * UC * 2;
constexpr size_t BIG_STATE = BIG_HGO;
constexpr size_t BIG_SSY = BIG_HGO + (size_t)T * 256 * 4;
constexpr size_t BIG_WT = BIG_SSY + (size_t)T * 256 * 4;
constexpr size_t BIG_END1 = BIG_WT + (size_t)T * 256 * 2;
constexpr size_t BIG_P = 0;
constexpr size_t BIG_HID = 0;
constexpr size_t BIG_YE = BIG_HID + (size_t)MAXTILES * 256 * 512 * 2;
constexpr size_t BIG_W13 = BIG_YE + (size_t)MAXTILES * 256 * 1024 * 2;
constexpr size_t BIG_W2 = BIG_W13 + (size_t)NE * 1024 * 1024 * 2;
constexpr size_t BIG_END3 = BIG_W2 + (size_t)NE * 1024 * 512 * 2;
constexpr size_t BIG_BYTES = BIG_END1 > BIG_END3 ? BIG_END1 : BIG_END3;
constexpr size_t WS_END = WS_BIG + BIG_BYTES;
static_assert((size_t)T * 4096 * 2 <= BIG_BYTES, "P fits");
static_assert(WS_END <= (size_t)536870912, "workspace budget");

constexpr int LDS_BYTES = 147456;
constexpr int LDS_MISC = 147456 - 256;

struct Args { const float* in[N_IN]; float* out; unsigned char* ws; int ph_lo, ph_hi; };

#define XB_TMO      128
#define XB_XCNT(j)  (256  + 64 * (j))
#define XB_XSUB(j)  (1280 + 64 * (j))
#define XB_XGEN(j)  (2304 + 64 * (j))
#define XB_TOP      3328
#define XB_TOPGEN   3392
#define XCD_BAR_WORDS 3456
#define XB_SPIN_CAP (1u << 18)
__device__ __forceinline__ unsigned xb_ld(unsigned* p)              { return __hip_atomic_load(p, __ATOMIC_RELAXED, __HIP_MEMORY_SCOPE_AGENT); }
__device__ __forceinline__ unsigned xb_add(unsigned* p, unsigned v) { return __hip_atomic_fetch_add(p, v, __ATOMIC_RELAXED, __HIP_MEMORY_SCOPE_AGENT); }
__device__ __forceinline__ unsigned xb_xcc_id() { return (unsigned)__builtin_amdgcn_s_getreg((3 << 11) | 20) & 0xFu; }
#define XB_SPIN(cond, bar) do { unsigned _sp = 0; while (cond) { __builtin_amdgcn_s_sleep(1); \
    if ((++_sp & 255u) == 0u) { if (xb_ld(&(bar)[XB_TMO])) break; if (_sp > XB_SPIN_CAP) { atomicAdd(&(bar)[XB_TMO], 1u); break; } } } } while (0)
struct XcdBarrier { unsigned* bar; unsigned x; volatile LAS unsigned* st; };
__device__ __forceinline__ int lane_id() { unsigned z = 0u; asm volatile("" : "+v"(z)); return (int)__builtin_amdgcn_mbcnt_hi(~0u, __builtin_amdgcn_mbcnt_lo(~0u, z)); }
__device__ __forceinline__ bool is_thread0(int wave_s) { return wave_s == 0 && lane_id() == 0; }
__device__ __forceinline__ XcdBarrier xcd_barrier_post(unsigned* bar, volatile LAS unsigned* st, int wave_s) {
    XcdBarrier b; b.bar = bar; b.x = xb_xcc_id(); b.st = st;
    if (is_thread0(wave_s)) (void)xb_add(&bar[XB_XCNT(b.x)], 1u);
    return b;
}
__device__ __forceinline__ void xcd_barrier_complete(unsigned* bar, unsigned x, unsigned& nloc, unsigned& nx) {
    const unsigned G = gridDim.x * gridDim.y * gridDim.z;
    unsigned sum, cnt, mine, sp = 0u;
    for (;;) {
        sum = 0u; cnt = 0u; mine = 0u;
#pragma unroll
        for (unsigned j = 0; j < 16; ++j) { const unsigned c = xb_ld(&bar[XB_XCNT(j)]); sum += c; cnt += (c > 0u) ? 1u : 0u; mine = (j == x) ? c : mine; }
        if (sum == G) break;
        __builtin_amdgcn_s_sleep(1);
        if ((++sp & 255u) == 0u) { if (xb_ld(&bar[XB_TMO])) break; if (sp > XB_SPIN_CAP) { atomicAdd(&bar[XB_TMO], 1u); break; } }
    }
    nloc = mine > 0u ? mine : 1u; nx = cnt > 0u ? cnt : 1u;
}
__device__ __forceinline__ void xcd_barrier(const XcdBarrier& b, int wave_s) {
    asm volatile("s_waitcnt vmcnt(0)" ::: "memory");
    __syncthreads();
    if (is_thread0(wave_s)) {
        unsigned* bar = b.bar;
        __builtin_amdgcn_s_waitcnt(0);
        unsigned nloc = b.st[0], nx = b.st[1];
        if (nloc == 0u) { xcd_barrier_complete(bar, b.x, nloc, nx); b.st[0] = nloc; b.st[1] = nx; }
        const unsigned old = xb_add(&bar[XB_XSUB(b.x)], 1u);
        const unsigned gen = old / nloc;
        if (old + 1u == (gen + 1u) * nloc) {
            __builtin_amdgcn_fence(__ATOMIC_RELEASE, "agent");
            asm volatile("s_waitcnt vmcnt(0)" ::: "memory");
            const unsigned og = xb_add(&bar[XB_TOP], 1u);
            const unsigned tg = og / nx;
            if (og + 1u == (tg + 1u) * nx) xb_add(&bar[XB_TOPGEN], 1u);
            else XB_SPIN(xb_ld(&bar[XB_TOPGEN]) == tg, bar);
            __builtin_amdgcn_fence(__ATOMIC_ACQUIRE, "agent");
            xb_add(&bar[XB_XGEN(b.x)], 1u);
            asm volatile("s_waitcnt vmcnt(0)" ::: "memory");
        } else {
            XB_SPIN(xb_ld(&bar[XB_XGEN(b.x)]) == gen, bar);
            __builtin_amdgcn_fence(__ATOMIC_ACQUIRE, "agent");
            asm volatile("s_waitcnt vmcnt(0)" ::: "memory");
        }
    }
    __syncthreads();
}

__device__ __forceinline__ float bf2f(bf16_t b) { return __uint_as_float(((unsigned)b) << 16); }
typedef __bf16 hwbf2 __attribute__((ext_vector_type(2)));
typedef float hwf2 __attribute__((ext_vector_type(2)));
__device__ __forceinline__ unsigned pack2(float lo, float hi) { const hwf2 v = {lo, hi}; return __builtin_bit_cast(unsigned, __builtin_convertvector(v, hwbf2)); }
__device__ __forceinline__ bf16_t f2bf(float f) { return (bf16_t)(pack2(f, 0.f) & 0xffffu); }
__device__ __forceinline__ float zero_f() { float z = 0.f; asm volatile("" : "+v"(z)); return z; }
__device__ __forceinline__ float kconst(float c) { asm volatile("" : "+s"(c)); return c; }
__device__ __forceinline__ float fexp(float x) { return __builtin_amdgcn_exp2f(x * kconst(1.4426950408889634f)); }
__device__ __forceinline__ float flog(float x) { return __builtin_amdgcn_logf(x) * kconst(0.6931471805599453f); }
__device__ __forceinline__ float sigmoidf_(float x) { return __builtin_amdgcn_rcpf(1.0f + fexp(-x)); }
__device__ __forceinline__ float siluf_(float x) { return x * sigmoidf_(x); }
__device__ __forceinline__ float wave_sum(float v) {
#pragma unroll
    for (int o = 32; o >= 1; o >>= 1) v += __shfl_xor(v, o);
    return v;
}
__device__ __forceinline__ int row_modidx(int r) { return r < NLAT ? (r >> 12) : 8; }
__device__ __forceinline__ bool row_has_prev(int r) { return r < NLAT ? ((r & 4095) != 0) : (((r - NLAT) & 255) != 0); }
__device__ __forceinline__ bool row_has_next(int r) { return r < NLAT ? ((r & 4095) != 4095) : (((r - NLAT) & 255) != 255); }

#define AS1 __attribute__((address_space(1)))
#define AS4 __attribute__((address_space(4)))
struct Ptrs {
    float* out; unsigned char* ws; int tid, bid, G;
    __device__ __forceinline__ const float* inp(int i) const { asm volatile("" : "+s"(i));
        const __attribute__((address_space(4))) char* ka = (const __attribute__((address_space(4))) char*)__builtin_amdgcn_kernarg_segment_ptr();
        return (const float*)(*(const AS1 float* const AS4*)(ka + 8 * i)); }
    __device__ __forceinline__ float* latrow(int r) const { return r < NLAT ? out + (size_t)r * D : (float*)(ws + WS_CX32) + (size_t)(r - NLAT) * D; }
    __device__ __forceinline__ float* mod(int l, int ridx) const { return (float*)(ws + WS_MOD) + ((size_t)l * 9 + ridx) * 6144; }
};

__device__ __forceinline__ float conv3_u(const bf16_t* U, int row, int col, const float* w, int ncol, int wcol) {
    const bool hp = row_has_prev(row), hn = row_has_next(row);
    const float c = bf2f(U[(size_t)row * UC + col]), p = bf2f(U[(size_t)(hp ? row - 1 : row) * UC + col]), n = bf2f(U[(size_t)(hn ? row + 1 : row) * UC + col]);
    return c * w[ncol + wcol] + (hp ? p * w[wcol] : 0.f) + (hn ? n * w[2 * ncol + wcol] : 0.f);
}

struct Unit { int pm, pn, e, aux; };
__host__ __device__ __forceinline__ int perm32(int rho) { const int n = rho >> 4, i = rho & 15; return 8 * (i >> 2) + 4 * n + (i & 3); }

template <class RowMap, class Epi>
__device__ __forceinline__ void sgemm_unit(int tid_, const bf16_t* __restrict__ A, int lda, const bf16_t* __restrict__ Bt, int ldb, int K, const Unit& u, const RowMap& RM, const Epi& E) {
    const int tid = tid_, wid = tid >> 6, lane = tid & 63, wr = wid >> 2, wc = wid & 3, fr = lane & 15, fq = lane >> 4;
    f32x4 acc[2][2][4][2];
#pragma unroll
    for (int a = 0; a < 2; ++a)
#pragma unroll
        for (int b = 0; b < 2; ++b)
#pragma unroll
            for (int m = 0; m < 4; ++m)
#pragma unroll
                for (int n = 0; n < 2; ++n) acc[a][b][m][n] = (f32x4){0.f, 0.f, 0.f, 0.f};
    unsigned ap[2][4], bp[2][2];
#pragma unroll
    for (int a = 0; a < 2; ++a)
#pragma unroll
        for (int m = 0; m < 4; ++m) ap[a][m] = (unsigned)RM(u, 128 * a + 64 * wr + 16 * m + fr) * (unsigned)lda + fq * 8;
#pragma unroll
    for (int b = 0; b < 2; ++b)
#pragma unroll
        for (int n = 0; n < 2; ++n) { const int rho = 16 * n + fr; const int col = Epi::PERM ? perm32(rho) : rho;
            bp[b][n] = (unsigned)(u.pn * 256 + 128 * b + 32 * wc + col) * (unsigned)ldb + fq * 8; }
    for (int k = 0; k < K; k += 32) {
        bf16x8 bfr[2][2];
#pragma unroll
        for (int b = 0; b < 2; ++b)
#pragma unroll
            for (int n = 0; n < 2; ++n) bfr[b][n] = *(const bf16x8*)(Bt + (bp[b][n] + k));
#pragma unroll
        for (int a = 0; a < 2; ++a) {
            bf16x8 af[4];
#pragma unroll
            for (int m = 0; m < 4; ++m) af[m] = *(const bf16x8*)(A + (ap[a][m] + k));
#pragma unroll
            for (int b = 0; b < 2; ++b)
#pragma unroll
                for (int m = 0; m < 4; ++m)
#pragma unroll
                    for (int n = 0; n < 2; ++n) acc[a][b][m][n] = __builtin_amdgcn_mfma_f32_16x16x32_bf16(bfr[b][n], af[m], acc[a][b][m][n], 0, 0, 0);
        }
    }
    E(acc, u, wr, wc, fr, fq);
}

struct RowIdent { __device__ __forceinline__ int operator()(const Unit& u, int R) const { return u.pm * 256 + R; } };
struct RowStackK { int rows; __device__ __forceinline__ int operator()(const Unit& u, int R) const { return u.e * rows + u.pm * 256 + R; } };
struct RowGather { const int* list; const unsigned* cnt; __device__ __forceinline__ int operator()(const Unit& u, int R) const {
    const int idx = u.aux * 256 + R; const int* l = list + (size_t)u.e * T; return idx < (int)cnt[u.e] ? l[idx] : l[0]; } };


namespace pg8 {
constexpr int BM = 256, BK = 64, HALF = 128, HTB = HALF * BK * 2, STAGE_BYTES = 8 * HTB;
__host__ __device__ __forceinline__ int lds_byte(int r, int c) { const int st = (r >> 4) * 2 + (c >> 5), rr = r & 15, cc = c & 31, ob = rr * 64 + cc * 2; return st * 1024 + (ob ^ (((ob >> 9) & 1) << 5)); }
__host__ __device__ __forceinline__ void stage_rc(int b, int& R, int& C) { const int st = b / 1024, sb = b % 1024, swz = sb ^ (((sb >> 9) & 1) << 5); R = (st >> 1) * 16 + swz / 64; C = (st & 1) * 32 + (swz % 64) / 2; }
struct Gemm { const bf16_t* A; const bf16_t* Bt; int K; };

template <class Epi, class Sched, bool GATHER>
__device__ __forceinline__ void gemm_phase(int tid, LAS unsigned char* lds, const Gemm g, const Sched& S, const Epi& E) {
    const int wid = __builtin_amdgcn_readfirstlane(tid >> 6), lane = tid & 63, wr = wid >> 2, wc = wid & 3, fr = lane & 15, fq = lane >> 4;
    const int K = g.K, nt = K / BK;
    int RA[2], CA[2]; unsigned voffB[2];
    unsigned vA[2][2], vAn[2][2];
#pragma unroll
    for (int i = 0; i < 2; ++i) { int R, C; stage_rc(tid * 16 + i * 8192, R, C); RA[i] = R; CA[i] = C; const int Rb = Epi::PERM ? ((R & ~31) + perm32(R & 31)) : R; voffB[i] = (unsigned)(Rb * K + C) * 2u; }
    const size_t kstep = (size_t)(BK * 2);
    const size_t hstep = (size_t)HALF * K * 2;
    const size_t tstep = 2 * hstep;
    const unsigned ldsw = (unsigned)wid * 1024u;
    const int aoff = lds_byte(wr * 64 + fr, fq * 8), boff = lds_byte(wc * 32 + fr, fq * 8);
#define PG8_SA(b, h) (((b) * 2 + (h)) * HTB)
#define PG8_SB(b, h) ((4 + (b) * 2 + (h)) * HTB)
#define PG8_STAGE(bufoff, gbase, voff) do { _Pragma("unroll") for (int _i = 0; _i < 2; ++_i) \
        __builtin_amdgcn_global_load_lds((const unsigned*)((const char*)(gbase) + (voff)[_i]), (LAS unsigned*)(lds + (bufoff) + ldsw + _i * 8192), 16, 0, 0); } while (0)
#define PG8_STAGE2(bufoff, gbase, v0, v1) do { \
        __builtin_amdgcn_global_load_lds((const unsigned*)((const char*)(gbase) + (v0)), (LAS unsigned*)(lds + (bufoff) + ldsw), 16, 0, 0); \
        __builtin_amdgcn_global_load_lds((const unsigned*)((const char*)(gbase) + (v1)), (LAS unsigned*)(lds + (bufoff) + ldsw + 8192), 16, 0, 0); } while (0)
#define PG8_LDA(dst, b, h) do { _Pragma("unroll") for (int m = 0; m < 4; ++m) _Pragma("unroll") for (int k = 0; k < 2; ++k) dst[m][k] = *(const LAS bf16x8*)(lds + PG8_SA(b, h) + aoff + m * 2048 + k * 1024); } while (0)
#define PG8_LDB(dst, b, h) do { _Pragma("unroll") for (int n = 0; n < 2; ++n) _Pragma("unroll") for (int k = 0; k < 2; ++k) dst[n][k] = *(const LAS bf16x8*)(lds + PG8_SB(b, h) + boff + n * 2048 + k * 1024); } while (0)
#define PG8_MMA(ai, bj, At, Bt) do { __builtin_amdgcn_s_setprio(1); _Pragma("unroll") for (int m = 0; m < 4; ++m) _Pragma("unroll") for (int n = 0; n < 2; ++n) _Pragma("unroll") for (int k = 0; k < 2; ++k) \
        acc[ai][bj][m][n] = __builtin_amdgcn_mfma_f32_16x16x32_bf16(Bt[n][k], At[m][k], acc[ai][bj][m][n], 0, 0, 0); __builtin_amdgcn_s_setprio(0); } while (0)
#define PG8_WAIT_V(n) asm volatile("s_waitcnt vmcnt(" #n ")" ::: "memory")
#define PG8_WAIT_L(n) asm volatile("s_waitcnt lgkmcnt(" #n ")" ::: "memory")
#define PG8_BAR __builtin_amdgcn_s_barrier()
#define PG8_SCHED __builtin_amdgcn_sched_barrier(0)
#define PG8_AOFFS(dst, unit) do { _Pragma("unroll") for (int _h = 0; _h < 2; ++_h) _Pragma("unroll") for (int _i = 0; _i < 2; ++_i) \
        dst[_h][_i] = GATHER ? ((unsigned)S.arow(unit, _h * HALF + RA[_i]) * (unsigned)K + (unsigned)CA[_i]) * 2u : ((unsigned)(_h * HALF + RA[_i]) * (unsigned)K + (unsigned)CA[_i]) * 2u; } while (0)
    Unit cur{0, 0, 0, 0}, nxt{0, 0, 0, 0}; int ui = 0;
    if (!S.next(0, cur)) return;
    f32x4 acc[2][2][4][2];
#pragma unroll
    for (int a = 0; a < 2; ++a)
#pragma unroll
        for (int b = 0; b < 2; ++b)
#pragma unroll
            for (int m = 0; m < 4; ++m)
#pragma unroll
                for (int n = 0; n < 2; ++n) acc[a][b][m][n] = (f32x4){0.f, 0.f, 0.f, 0.f};
    bf16x8 At[4][2], B0[2][2], B1[2][2];
    const char* cA = GATHER ? (const char*)g.A : (const char*)g.A + (size_t)cur.pm * tstep; const char* cB = (const char*)g.Bt + (size_t)cur.pn * tstep;
    PG8_AOFFS(vA, cur);
    PG8_STAGE(PG8_SB(0, 0), cB, voffB); PG8_STAGE(PG8_SB(0, 1), cB + hstep, voffB); PG8_STAGE2(PG8_SA(0, 0), cA, vA[0][0], vA[0][1]); PG8_STAGE2(PG8_SA(0, 1), cA, vA[1][0], vA[1][1]);
    if (wr == 1) PG8_BAR;
    PG8_WAIT_V(2); PG8_BAR;
    PG8_STAGE(PG8_SB(1, 0), cB + kstep, voffB); PG8_STAGE2(PG8_SA(1, 0), cA + kstep, vA[0][0], vA[0][1]); PG8_STAGE(PG8_SB(1, 1), cB + hstep + kstep, voffB);
    PG8_WAIT_V(6); PG8_BAR;
    for (;;) {
        const bool has_next = S.next(ui + 1, nxt);
        const char* nA = GATHER ? (const char*)g.A : (has_next ? (const char*)g.A + (size_t)nxt.pm * tstep : cA); const char* nB = has_next ? (const char*)g.Bt + (size_t)nxt.pn * tstep : cB;
        if (GATHER && has_next) { PG8_AOFFS(vAn, nxt); } else {
#pragma unroll
            for (int _h = 0; _h < 2; ++_h)
#pragma unroll
                for (int _i = 0; _i < 2; ++_i) vAn[_h][_i] = vA[_h][_i]; }
#pragma unroll 1
        for (int t = 0; t < nt; t += 2) {
            const bool last = (t == nt - 2);
            const char* a1 = cA + (size_t)(t + 1) * kstep;
            const char* a2 = last ? nA : cA + (size_t)(t + 2) * kstep; const char* b2 = last ? nB : cB + (size_t)(t + 2) * kstep;
            const char* a3 = a2 + kstep; const char* b3 = b2 + kstep;
            const unsigned x00 = (GATHER && last) ? vAn[0][0] : vA[0][0], x01 = (GATHER && last) ? vAn[0][1] : vA[0][1], x10 = (GATHER && last) ? vAn[1][0] : vA[1][0], x11 = (GATHER && last) ? vAn[1][1] : vA[1][1];
            PG8_LDB(B0, 0, 0); PG8_LDB(B1, 0, 1); PG8_SCHED; PG8_LDA(At, 0, 0); PG8_STAGE2(PG8_SA(1, 1), a1, vA[1][0], vA[1][1]);
            PG8_WAIT_V(8); PG8_WAIT_L(0); PG8_BAR; PG8_MMA(0, 0, At, B0); PG8_MMA(0, 1, At, B1); PG8_BAR; PG8_SCHED;
            PG8_LDA(At, 0, 1); PG8_STAGE(PG8_SB(0, 0), b2, voffB); PG8_STAGE(PG8_SB(0, 1), b2 + hstep, voffB); PG8_STAGE2(PG8_SA(0, 0), a2, x00, x01);
            PG8_WAIT_V(8); PG8_WAIT_L(0); PG8_BAR; PG8_MMA(1, 0, At, B0); PG8_MMA(1, 1, At, B1); PG8_BAR; PG8_SCHED;
            PG8_LDB(B0, 1, 0); PG8_LDB(B1, 1, 1); PG8_SCHED; PG8_LDA(At, 1, 0); PG8_STAGE2(PG8_SA(0, 1), a2, x10, x11);
            PG8_WAIT_V(8); PG8_WAIT_L(0); PG8_BAR; PG8_MMA(0, 0, At, B0); PG8_MMA(0, 1, At, B1); PG8_BAR; PG8_SCHED;
            PG8_LDA(At, 1, 1); PG8_STAGE(PG8_SB(1, 0), b3, voffB); PG8_STAGE(PG8_SB(1, 1), b3 + hstep, voffB); PG8_STAGE2(PG8_SA(1, 0), a3, x00, x01);
            PG8_WAIT_V(8); PG8_WAIT_L(0); PG8_BAR; PG8_MMA(1, 0, At, B0); PG8_MMA(1, 1, At, B1); PG8_BAR; PG8_SCHED;
        }
        if (wr == 0) PG8_BAR;
        E(acc, cur, wr, wc, fr, fq);
        if (!has_next) break;
#pragma unroll
        for (int a = 0; a < 2; ++a)
#pragma unroll
            for (int b = 0; b < 2; ++b)
#pragma unroll
                for (int m = 0; m < 4; ++m)
#pragma unroll
                    for (int n = 0; n < 2; ++n) acc[a][b][m][n] = (f32x4){0.f, 0.f, 0.f, 0.f};
        cur = nxt; cA = nA; cB = nB; ++ui;
        if (GATHER) {
#pragma unroll
        for (int _h = 0; _h < 2; ++_h)
#pragma unroll
            for (int _i = 0; _i < 2; ++_i) vA[_h][_i] = vAn[_h][_i]; }
        if (wr == 1) PG8_BAR;
    }
    PG8_WAIT_V(0);
    PG8_BAR;
#undef PG8_SA
#undef PG8_SB
#undef PG8_STAGE
#undef PG8_STAGE2
#undef PG8_LDA
#undef PG8_LDB
#undef PG8_MMA
#undef PG8_WAIT_V
#undef PG8_WAIT_L
#undef PG8_BAR
#undef PG8_SCHED
#undef PG8_AOFFS
}
}

struct XOrder { int G, c, MT, NT;
    __device__ __forceinline__ bool map(int i, int& pm, int& pn) const {
        if ((G & 7) == 0 && (MT & 7) == 0) { const int x = c & 7, r = c >> 3, W = G >> 3, MX = MT >> 3; const int L = i * W + r; if (L >= MX * NT) return false; pm = x * MX + L / NT; pn = L % NT; return true; }
        const int L = i * G + c; if (L >= MT * NT) return false; pm = L / NT; pn = L % NT; return true; } };
struct SchedG1 { XOrder X; __device__ __forceinline__ bool next(int i, Unit& u) const { int pm, pn; if (!X.map(i, pm, pn)) return false; u.pm = pm; u.pn = pn; u.e = 0; u.aux = 0; return true; }
    __device__ __forceinline__ int arow(const Unit&, int) const { return 0; } };
struct SchedG2 { XOrder X; __device__ __forceinline__ bool next(int i, Unit& u) const { int pm, q; if (!X.map(i, pm, q)) return false; const int k = q >> 2, pnn = q & 3;
        u.pm = k * (T / 256) + pm; u.pn = k * 4 + pnn; u.e = k; u.aux = pnn; return true; }
    __device__ __forceinline__ int arow(const Unit&, int) const { return 0; } };
struct SchedMN { XOrder X; __device__ __forceinline__ bool next(int i, Unit& u) const { int pm, pn; if (!X.map(i, pm, pn)) return false; u.pm = pm; u.pn = pn; u.e = 0; u.aux = 0; return true; }
    __device__ __forceinline__ int arow(const Unit&, int) const { return 0; } };

struct EpiBf16Plain {
    static constexpr bool PERM = true;
    bf16_t* O; int ldc; int coltile_mask;
    __device__ __forceinline__ void operator()(const f32x4 (&acc)[2][2][4][2], const Unit& u, int wr, int wc, int fr, int fq) const {
        const int row0 = u.pm * 256 + wr * 64 + fr, col0 = (u.pn & coltile_mask) * 256 + wc * 32 + 8 * fq;
#pragma unroll
        for (int ai = 0; ai < 2; ++ai)
#pragma unroll
            for (int m = 0; m < 4; ++m) { bf16_t* rowp = O + ((unsigned)(row0 + ai * 128 + m * 16) * (unsigned)ldc + (unsigned)col0);
#pragma unroll
                for (int bj = 0; bj < 2; ++bj) { const f32x4 v0 = acc[ai][bj][m][0], v1 = acc[ai][bj][m][1];
                    u32x4 w; w.x = pack2(v0[0], v0[1]); w.y = pack2(v0[2], v0[3]); w.z = pack2(v1[0], v1[1]); w.w = pack2(v1[2], v1[3]);
                    *(u32x4*)(rowp + bj * 128) = w; } }
    }
};
struct EpiP {
    static constexpr bool PERM = true;
    bf16_t* P; const float* ssq;
    __device__ __forceinline__ void operator()(const f32x4 (&acc)[2][2][4][2], const Unit& u, int wr, int wc, int fr, int fq) const {
        const int k = u.e; const int pmt = u.pm - k * (T / 256);
        const unsigned c00 = (unsigned)(u.aux * 256 + wc * 32 + 8 * fq);
        const unsigned base = (unsigned)pmt * (16u * 256u * 256u) + (unsigned)k * 16384u;
        float scv[8];
#pragma unroll
        for (int i = 0; i < 8; ++i) scv[i] = 1.0f;
        if (k == 3) {
            f32x4 qv[8];
#pragma unroll
            for (int i = 0; i < 8; ++i) qv[i] = *(const f32x4*)(ssq + (unsigned)(pmt * 256 + (i >> 2) * 128 + wr * 64 + (i & 3) * 16 + fr) * 4u);
#pragma unroll
            for (int i = 0; i < 8; ++i) scv[i] = rsqrtf((qv[i][0] + qv[i][1] + qv[i][2] + qv[i][3]) * (1.0f / 256.0f) + kconst(RMS_EPS));
        }
#pragma unroll
        for (int ai = 0; ai < 2; ++ai)
#pragma unroll
            for (int m = 0; m < 4; ++m) { const int r = ai * 128 + wr * 64 + m * 16 + fr; const float sc = scv[ai * 4 + m];
#pragma unroll
                for (int bj = 0; bj < 2; ++bj) { const unsigned c0 = c00 + bj * 128; const unsigned s = c0 >> 6, wi = c0 & 63;
                    const f32x4 v0 = acc[ai][bj][m][0] * sc, v1 = acc[ai][bj][m][1] * sc;
                    u32x4 w; w.x = pack2(v0[0], v0[1]); w.y = pack2(v0[2], v0[3]); w.z = pack2(v1[0], v1[1]); w.w = pack2(v1[2], v1[3]);
                    __builtin_nontemporal_store(w, (u32x4*)(P + (base + s * 65536u + (wi >> 4) * 4096u + (unsigned)r * 16u + (wi & 15u)))); }
                asm volatile("" ::: "memory"); }
    }
};
struct EpiMerge {
    static constexpr bool PERM = false;
    const bf16_t* P; const float* bgp; bf16_t* Y;
    __device__ __forceinline__ void operator()(const f32x4 (&acc)[2][2][4][2], const Unit& u, int wr, int wc, int fr, int fq) const {
        const int s = u.pn;
        f32x4 bv[2][2];
#pragma unroll
        for (int bj = 0; bj < 2; ++bj)
#pragma unroll
            for (int n = 0; n < 2; ++n) bv[bj][n] = *(const f32x4*)(bgp + s * 256 + bj * 128 + wc * 32 + n * 16 + 4 * fq);
#pragma unroll
        for (int ai = 0; ai < 2; ++ai)
#pragma unroll
            for (int m = 0; m < 4; ++m) { const int r = ai * 128 + wr * 64 + m * 16 + fr;
                const unsigned po = ((unsigned)u.pm * 16u + (unsigned)s) * 65536u + (unsigned)(wc * 4096 + r * 16 + 4 * fq);
                f32x4 y = (f32x4){0.f, 0.f, 0.f, 0.f};
#pragma unroll
                for (int bj = 0; bj < 2; ++bj)
#pragma unroll
                    for (int n = 0; n < 2; ++n) { const int k = 2 * bj + n; const u32x2 pw = *(const u32x2*)(P + (po + k * 16384u));
                        const f32x4 g = acc[ai][bj][m][n] + bv[bj][n];
                        y[0] += sigmoidf_(g[0]) * __uint_as_float(pw.x << 16); y[1] += sigmoidf_(g[1]) * __uint_as_float(pw.x & 0xffff0000u);
                        y[2] += sigmoidf_(g[2]) * __uint_as_float(pw.y << 16); y[3] += sigmoidf_(g[3]) * __uint_as_float(pw.y & 0xffff0000u); }
                u32x2 w; w.x = pack2(y[0], y[1]); w.y = pack2(y[2], y[3]);
                *(u32x2*)(Y + ((unsigned)(u.pm * 256 + r) * (unsigned)D + (unsigned)(s * 64 + wc * 16 + 4 * fq))) = w; }
    }
};
struct EpiWo {
    static constexpr bool PERM = false;
    Ptrs P; int layer;
    __device__ __forceinline__ void operator()(const f32x4 (&acc)[2][2][4][2], const Unit& u, int wr, int wc, int fr, int fq) const {
        const int col0 = u.pn * 256 + wc * 32 + 4 * fq;
#pragma unroll
        for (int ai = 0; ai < 2; ++ai)
#pragma unroll
            for (int m = 0; m < 4; ++m) { const int row = u.pm * 256 + ai * 128 + wr * 64 + m * 16 + fr;
                float* lp = P.latrow(row) + col0; const float* g1 = P.mod(layer, row_modidx(row)) + 2048 + col0;
#pragma unroll
                for (int bj = 0; bj < 2; ++bj)
#pragma unroll
                    for (int n = 0; n < 2; ++n) { const f32x4 x = *(const f32x4*)(lp + bj * 128 + n * 16); const f32x4 g = *(const f32x4*)(g1 + bj * 128 + n * 16);
                        *(f32x4*)(lp + bj * 128 + n * 16) = x * ALPHA + g * acc[ai][bj][m][n]; } }
    }
};
struct EpiFfn1 {
    static constexpr bool PERM = false;
    bf16_t* H;
    __device__ __forceinline__ void operator()(const f32x4 (&acc)[2][2][4][2], const Unit& u, int wr, int wc, int fr, int fq) const {
        const int pnn = u.pn & 3;
#pragma unroll
        for (int ai = 0; ai < 2; ++ai)
#pragma unroll
            for (int m = 0; m < 4; ++m) { const int pos = u.pm * 256 + ai * 128 + wr * 64 + m * 16 + fr;
#pragma unroll
                for (int bj = 0; bj < 2; ++bj) { const f32x4 a = acc[ai][bj][m][0], b = acc[ai][bj][m][1];
                    u32x2 w; w.x = pack2(siluf_(a[0]) * b[0], siluf_(a[1]) * b[1]); w.y = pack2(siluf_(a[2]) * b[2], siluf_(a[3]) * b[3]);
                    *(u32x2*)(H + ((unsigned)pos * 512u + (unsigned)(pnn * 128 + bj * 64 + wc * 16 + 4 * fq))) = w; } }
    }
};

template <class SrcFn>
__device__ __forceinline__ void conv_tile(int tid, LAS float* tile  , bf16_t* dst, int ldd, int n0, int k0, const SrcFn& src) {
    f32x4 v[8];
#pragma unroll
    for (int i = 0; i < 8; ++i) { const int kk = (tid >> 4) + 32 * i, j4 = tid & 15; v[i] = *(const f32x4*)src(k0 + kk, n0 + 4 * j4); }
#pragma unroll
    for (int i = 0; i < 8; ++i) { const int kk = (tid >> 4) + 32 * i, j4 = tid & 15; LAS float* t = tile + kk * 65 + 4 * j4; t[0] = v[i][0]; t[1] = v[i][1]; t[2] = v[i][2]; t[3] = v[i][3]; }
    __syncthreads();
    { const int jj = tid >> 3, kq = tid & 7;
#pragma unroll
      for (int kb = 0; kb < 4; ++kb) { float x[8];
#pragma unroll
          for (int i = 0; i < 8; ++i) x[i] = tile[(64 * kb + 8 * kq + i) * 65 + jj];
          u32x4 w; w.x = pack2(x[0], x[1]); w.y = pack2(x[2], x[3]); w.z = pack2(x[4], x[5]); w.w = pack2(x[6], x[7]);
          *(u32x4*)(dst + (size_t)(n0 + jj) * ldd + k0 + 64 * kb + 8 * kq) = w; } }
    __syncthreads();
}
constexpr int NCONV_NE = 56 * 4 + 64 * 4 + 64 * 1 + 16 * 4;
constexpr int NCONV_EX = NE * (16 * 4 + 16 * 2);
__device__ __forceinline__ int gate_srccol(int np) { const int s = np >> 8, bj = (np >> 7) & 1, wc = (np >> 5) & 3, n = (np >> 4) & 1, fqe = np & 15; return (2 * bj + n) * 1024 + 64 * s + 16 * wc + fqe; }
__device__ __forceinline__ void conv_unit_ne(const Ptrs P, int l, int t, LAS float* tile) {
    unsigned char* ws = P.ws;
    if (t < 224) { const int nt = t >> 2, kt = t & 3; const float* src = P.inp(I_WIN) + (size_t)l * D * INC;
        conv_tile(P.tid, tile, (bf16_t*)(ws + WS_WIN), D, nt * 64, kt * 256, [=](int k, int n) { return src + (size_t)k * INC + n; });
    } else if (t < 224 + 256) { t -= 224; const int nt = t >> 2, kt = t & 3; const float* src = P.inp(I_WGATE) + (size_t)l * D * 4096;
        conv_tile(P.tid, tile, (bf16_t*)(ws + WS_WG), D, nt * 64, kt * 256, [=](int k, int n) { return src + (size_t)k * 4096 + gate_srccol(n); });
        if (kt == 0 && P.tid < 64) { const int np = nt * 64 + P.tid; ((float*)(ws + WS_BGP))[np] = P.inp(I_BGATE)[(size_t)l * 4096 + gate_srccol(np)]; }
    } else if (t < 224 + 256 + 64) { t -= 480; const int nt = t; const int kb = nt >> 4;
        const float* src = P.inp(I_WBR) + ((size_t)l * 4 + kb) * 256 * 1024;
        conv_tile(P.tid, tile, (bf16_t*)(ws + WS_WBR), 256, nt * 64, 0, [=](int k, int n) { return src + (size_t)k * 1024 + (n & 1023); });
    } else { t -= 544; const int nt = t >> 2, kt = t & 3; const float* src = P.inp(I_WO) + (size_t)l * D * D;
        conv_tile(P.tid, tile, (bf16_t*)(ws + WS_WO), D, nt * 64, kt * 256, [=](int k, int n) { return src + (size_t)k * D + n; });
    }
}
__device__ __forceinline__ void conv_unit_ex(const Ptrs P, int l, int t, LAS float* tile) {
    unsigned char* ws = P.ws;
    const int e = t / 96; t -= e * 96;
    if (t < 64) { const int nt = t >> 2, kt = t & 3;
        const float* s1 = P.inp(I_WE1) + ((size_t)l * NE + e) * 1024 * 512; const float* s3 = P.inp(I_WE3) + ((size_t)l * NE + e) * 1024 * 512;
        conv_tile(P.tid, tile, (bf16_t*)(ws + WS_BIG + BIG_W13) + (size_t)e * 1024 * 1024, 1024, nt * 64, kt * 256, [=](int k, int n) {
            const int pn = n >> 8, bj = (n >> 7) & 1, wc = (n >> 5) & 3, nn = (n >> 4) & 1, fqe = n & 15; const int ch = 128 * pn + 64 * bj + 16 * wc + fqe;
            return (nn ? s3 : s1) + (size_t)k * 512 + ch; });
    } else { t -= 64; const int nt = t >> 1, kt = t & 1; const float* src = P.inp(I_WE2) + ((size_t)l * NE + e) * 512 * 1024;
        conv_tile(P.tid, tile, (bf16_t*)(ws + WS_BIG + BIG_W2) + (size_t)e * 1024 * 512, 512, nt * 64, kt * 256, [=](int k, int n) { return src + (size_t)k * 1024 + n; });
    }
}

struct ConvEx { Ptrs P; int l; LAS float* tile; __device__ __forceinline__ void operator()(int t) const { conv_unit_ex(P, l, t, tile); } };
struct ConvNe { Ptrs P; int l; LAS float* tile; __device__ __forceinline__ void operator()(int t) const { conv_unit_ne(P, l, t, tile); } };
template <class F>
__device__ __forceinline__ void dyn_tiles(int tid, unsigned* ctr, int n, volatile LAS unsigned* slot, const F& f) {
    const bool t0 = (tid == 0);
    if (t0) slot[0] = __hip_atomic_fetch_add(ctr, 1u, __ATOMIC_RELAXED, __HIP_MEMORY_SCOPE_AGENT);
    __syncthreads();
    unsigned t = (unsigned)__builtin_amdgcn_readfirstlane((int)slot[0]);
    __syncthreads();
    while (t < (unsigned)n) {
        unsigned tn = 0u; if (t0) tn = __hip_atomic_fetch_add(ctr, 1u, __ATOMIC_RELAXED, __HIP_MEMORY_SCOPE_AGENT);
        f((int)t);
        if (t0) slot[0] = tn;
        __syncthreads();
        t = (unsigned)__builtin_amdgcn_readfirstlane((int)slot[0]);
        __syncthreads();
    }
}

struct RowV { f32x4 v[4]; };
__device__ __forceinline__ void row_load(RowV& r, const float* p, int lane) {
#pragma unroll
    for (int i = 0; i < 4; ++i) r.v[i] = *(const f32x4*)(p + i * 256 + lane * 4);
}
__device__ __forceinline__ void row_store(const RowV& r, float* p, int lane) {
#pragma unroll
    for (int i = 0; i < 4; ++i) *(f32x4*)(p + i * 256 + lane * 4) = r.v[i];
}
__device__ __forceinline__ void row_layernorm(RowV& r, const float* g, const float* b, int lane) {
    float s = 0.f;
#pragma unroll
    for (int i = 0; i < 4; ++i) s += r.v[i][0] + r.v[i][1] + r.v[i][2] + r.v[i][3];
    const float mu = wave_sum(s) * (1.0f / 1024.0f);
    float q = 0.f;
#pragma unroll
    for (int i = 0; i < 4; ++i) { const f32x4 d = r.v[i] - mu; q += d[0] * d[0] + d[1] * d[1] + d[2] * d[2] + d[3] * d[3]; }
    const float rstd = rsqrtf(wave_sum(q) * (1.0f / 1024.0f) + kconst(LN_EPS));
#pragma unroll
    for (int i = 0; i < 4; ++i) { const f32x4 gg = *(const f32x4*)(g + i * 256 + lane * 4), bb = *(const f32x4*)(b + i * 256 + lane * 4); r.v[i] = (r.v[i] - mu) * rstd * gg + bb; }
}
__device__ __forceinline__ void row_layernorm_r(RowV& r, const RowV& g, const RowV& b) {
    float s = 0.f;
#pragma unroll
    for (int i = 0; i < 4; ++i) s += r.v[i][0] + r.v[i][1] + r.v[i][2] + r.v[i][3];
    const float mu = wave_sum(s) * (1.0f / 1024.0f);
    float q = 0.f;
#pragma unroll
    for (int i = 0; i < 4; ++i) { const f32x4 d = r.v[i] - mu; q += d[0] * d[0] + d[1] * d[1] + d[2] * d[2] + d[3] * d[3]; }
    const float rstd = rsqrtf(wave_sum(q) * (1.0f / 1024.0f) + kconst(LN_EPS));
#pragma unroll
    for (int i = 0; i < 4; ++i) r.v[i] = (r.v[i] - mu) * rstd * g.v[i] + b.v[i];
}
__device__ __forceinline__ void row_modulate(const RowV& r, RowV& h, const float* sh, const float* sc, int lane) {
#pragma unroll
    for (int i = 0; i < 4; ++i) { const f32x4 a = *(const f32x4*)(sc + i * 256 + lane * 4), b = *(const f32x4*)(sh + i * 256 + lane * 4); h.v[i] = r.v[i] * (a + 1.0f) + b; }
}
__device__ __forceinline__ void row_modulate_r(const RowV& r, RowV& h, const RowV& sh, const RowV& sc) {
#pragma unroll
    for (int i = 0; i < 4; ++i) h.v[i] = r.v[i] * (sc.v[i] + 1.0f) + sh.v[i];
}
__device__ __forceinline__ void row_store_bf16(const RowV& h, bf16_t* p, int lane) {
#pragma unroll
    for (int i = 0; i < 4; ++i) { u32x2 w; w.x = pack2(h.v[i][0], h.v[i][1]); w.y = pack2(h.v[i][2], h.v[i][3]); *(u32x2*)(p + i * 256 + lane * 4) = w; }
}
__device__ __forceinline__ void row_dt(const RowV& h, const LAS float* wdt, float* dtout, int lane) {
    float a[8];
#pragma unroll
    for (int j = 0; j < 8; ++j) a[j] = 0.f;
#pragma unroll
    for (int i = 0; i < 4; ++i)
#pragma unroll
        for (int e = 0; e < 4; ++e) { const int k = i * 256 + lane * 4 + e; const float hv = h.v[i][e];
            const f32x4 w0 = *(const LAS f32x4*)(wdt + k * 8), w1 = *(const LAS f32x4*)(wdt + k * 8 + 4);
            a[0] += hv * w0[0]; a[1] += hv * w0[1]; a[2] += hv * w0[2]; a[3] += hv * w0[3]; a[4] += hv * w1[0]; a[5] += hv * w1[1]; a[6] += hv * w1[2]; a[7] += hv * w1[3]; }
#pragma unroll
    for (int j = 0; j < 8; ++j) a[j] = wave_sum(a[j]);
    if (lane == 0) { *(f32x4*)dtout = (f32x4){a[0], a[1], a[2], a[3]}; *(f32x4*)(dtout + 4) = (f32x4){a[4], a[5], a[6], a[7]}; }
}
__device__ __forceinline__ void load_wdt(const Ptrs P, int l, LAS float* wdt) {
    const float* src = P.inp(I_WIN) + (size_t)l * D * INC + UC;
    for (int i = P.tid; i < 1024 * 8; i += 512) wdt[i] = src[(size_t)(i >> 3) * INC + (i & 7)];
    __syncthreads();
}

__device__ __forceinline__ void phase_pa(const Ptrs P, LAS unsigned char* lds) {
    const int tid = P.tid, wid = tid >> 6, lane = tid & 63, G = P.G;
    const int NU_MOD = 2 * 96, NU_H2 = 8448 / 8, NU_LB = 1;
    const int NU = NU_MOD + NU_H2 + NU_LB + NCONV_NE;
    for (int u = P.bid; u < NU; u += G) {
        if (u < NU_MOD) {
            const int l = u / 96, cb = u % 96;
            LAS float* sc = (LAS float*)lds; LAS float* red = sc + 9 * 1024;
            for (int i = tid; i < 9 * 1024; i += 512) { const int r = i >> 10, k = i & 1023; const float v = r < 8 ? P.inp(I_C)[r * 1024 + k] : P.inp(I_CCTX)[k]; sc[i] = v / (1.0f + fexp(-v)); }
            __syncthreads();
            const int col = cb * 64 + lane; const float* w = P.inp(I_WADA) + (size_t)l * D * 6144 + col;
            float acc[9];
#pragma unroll
            for (int r = 0; r < 9; ++r) acc[r] = 0.f;
            for (int k = wid * 128; k < wid * 128 + 128; ++k) { const float wv = w[(size_t)k * 6144];
#pragma unroll
                for (int r = 0; r < 9; ++r) acc[r] += sc[r * 1024 + k] * wv; }
#pragma unroll
            for (int r = 0; r < 9; ++r) red[(wid * 9 + r) * 64 + lane] = acc[r];
            __syncthreads();
            for (int i = tid; i < 9 * 64; i += 512) { const int r = i >> 6, c = i & 63; float s = P.inp(I_BADA)[(size_t)l * 6144 + cb * 64 + c];
#pragma unroll
                for (int w8 = 0; w8 < 8; ++w8) s += red[(w8 * 9 + r) * 64 + c];
                P.mod(l, r)[cb * 64 + c] = s; }
            __syncthreads();
        } else if (u < NU_MOD + NU_H2) {
            const int rho = (u - NU_MOD) * 8 + wid;
            const int l = (rho >= 4096 && rho < 8192) ? 1 : 0; const int L = rho < 8192 ? 4096 : 256; const int i = rho < 8192 ? (rho & 4095) : (rho - 8192);
            float featv = 0.f;
            if (lane == 0) featv = (float)((double)i / (double)(L - 1));
            else if (lane < 33) { const int j = (lane - 1) & 15; const double band = 1e-4 + (double)j * ((15.0 - 1e-4) / 15.0);
                const double ang = (2.0 * 3.14159265358979323846 / (double)L) * (double)i * band; featv = lane < 17 ? (float)cos(ang) : (float)(-sin(ang)); }
            float z1 = P.inp(I_HYB1)[l * 64 + lane];
            for (int m = 0; m < 33; ++m) z1 += __shfl(featv, m) * P.inp(I_HYW1)[((size_t)l * 33 + m) * 64 + lane];
            const float h1 = sinf(P.inp(I_HYF1)[l * 64 + lane] * z1);
            float z2 = P.inp(I_HYB2)[l * 64 + lane];
            for (int m = 0; m < 64; ++m) z2 += __shfl(h1, m) * P.inp(I_HYW2)[((size_t)l * 64 + m) * 64 + lane];
            ((float*)(P.ws + WS_H2TAB))[(size_t)rho * 64 + lane] = sinf(P.inp(I_HYF2)[l * 64 + lane] * z2);
        } else if (u < NU_MOD + NU_H2 + NU_LB) {
            for (int i = tid; i < 4096; i += 512) { const double a = -2.0 * 3.14159265358979323846 * (double)i / 8192.0; ((float*)(P.ws + WS_TW))[2 * i] = (float)cos(a); ((float*)(P.ws + WS_TW))[2 * i + 1] = (float)sin(a); }
            for (int i = tid; i < 1024; i += 512) { const int d = i >> 9, l = (i >> 8) & 1, c = i & 255;
                const float l0 = P.inp(I_HGLB)[d * 512 + c], l1 = P.inp(I_HGLB)[d * 512 + 256 + c];
                ((float*)(P.ws + WS_LB))[i] = l == 0 ? 0.0f : 1.0f / (1.0f + fexp(l0 - l1)); }
        } else {
            conv_unit_ne(P, 0, u - (NU_MOD + NU_H2 + NU_LB), (LAS float*)lds);
        }
    }
}

__device__ __forceinline__ void emit_rows_init(const Ptrs P, LAS float* wdt);
__device__ __forceinline__ void phase_pb(const Ptrs P, LAS unsigned char* lds) {
    const int tid = P.tid, G = P.G;
    for (int u = P.bid; u < 132; u += G) {
        const int tab = u < 64 ? 0 : (u < 128 ? 1 : 2); const int ib = tab == 0 ? u : (tab == 1 ? u - 64 : u - 128);
        const int l = tab == 1 ? 1 : 0; const int L = tab == 2 ? 256 : 4096; const int rho0 = (tab == 0 ? 0 : (tab == 1 ? 4096 : 8192)) + ib * 64;
        LAS float* h2 = (LAS float*)lds;
        for (int i = tid; i < 64 * 64; i += 512) h2[i] = ((const float*)(P.ws + WS_H2TAB))[(size_t)rho0 * 64 + i];
        __syncthreads();
        const int o = tid, c = tid & 255, dir = tid >> 8;
        float w3[64];
#pragma unroll
        for (int j = 0; j < 64; ++j) w3[j] = P.inp(I_HYW3)[((size_t)l * 64 + j) * 512 + o];
        const float dec = fabsf(P.inp(I_HYDEC)[l * 256 + c]);
        float* filt = tab == 2 ? (float*)(P.ws + WS_FILTC) : (float*)(P.ws + WS_FILT) + (size_t)l * 8192 * 256;
        const int L2 = 2 * L; float part = 0.f;
        for (int r = 0; r < 64; ++r) { const int i = ib * 64 + r; float s = 0.f;
#pragma unroll
            for (int j = 0; j < 64; ++j) s += h2[r * 64 + j] * w3[j];
            const float t = (float)i / (float)(L - 1); s *= fexp(-t * dec);
            if (dir == 0) { filt[(size_t)i * 256 + c] = s; part += fabsf(s); }
            else if (i == 0) filt[(size_t)L * 256 + c] = 0.f;
            else { filt[(size_t)(L2 - i) * 256 + c] = s; part += fabsf(s); } }
        ((float*)(P.ws + WS_PART))[((size_t)tab * 64 + ib) * 512 + o] = part;
        __syncthreads();
    }
    emit_rows_init(P, (LAS float*)lds);
}
__device__ __forceinline__ float hy_norm(const Ptrs P, int tab, int c) {
    const float* part = (const float*)(P.ws + WS_PART) + (size_t)tab * 64 * 512; const int nb = tab == 2 ? 4 : 64; float s = 0.f;
    for (int b = 0; b < nb; ++b) s += part[b * 512 + c] + part[b * 512 + 256 + c];
    return s;
}

__device__ __forceinline__ void emit_rows_init(const Ptrs P, LAS float* wdt) {
    const int tid = P.tid, wid = tid >> 6, lane = tid & 63, G = P.G;
    load_wdt(P, 0, wdt);
    LAS float* tabA = wdt + 1024 * 8; LAS float* tabB = tabA + 8 * 256 * 2;
    for (int i = tid; i < 2 * 8 * 256; i += 512) { const int tb = i >> 11, a = (i >> 8) & 7, ii = i & 255; const float om = fexp(-9.210340371976184f * (float)ii * (1.0f / 256.0f)); const float ang = (float)(tb ? a : 8 * a) * om;
        LAS float* t = (tb ? tabB : tabA) + (a * 256 + ii) * 2; t[0] = sinf(ang); t[1] = cosf(ang); }
    __syncthreads();
    const float* xin = P.inp(I_X); const float* cin = P.inp(I_CTX);
    RowV msh, msc; { const float z = zero_f(); for (int i = 0; i < 4; ++i) { msh.v[i] = (f32x4){z, z, z, z}; msc.v[i] = msh.v[i]; } } int mcur = -1;
    RowV rn; { const float z = zero_f(); for (int i = 0; i < 4; ++i) rn.v[i] = (f32x4){z, z, z, z}; } if (P.bid < T / 8) { const int rw = P.bid * 8 + wid; row_load(rn, rw < NLAT ? xin + (size_t)rw * D : cin + (size_t)(rw - NLAT) * D, lane); }
    for (int u = P.bid; u < T / 8; u += G) {
        const int row = u * 8 + wid; RowV r = rn;
        if (u + G < T / 8) { const int rw = (u + G) * 8 + wid; row_load(rn, rw < NLAT ? xin + (size_t)rw * D : cin + (size_t)(rw - NLAT) * D, lane); }
        if (row < NLAT) {
            const int t = row & 4095; const int prow = t >> 6, pcol = t & 63;
#pragma unroll
            for (int hf = 0; hf < 2; ++hf) { const int pos = hf ? pcol : prow; const LAS float* pa = tabA + ((pos >> 3) * 256 + lane * 4) * 2; const LAS float* pb = tabB + ((pos & 7) * 256 + lane * 4) * 2;
                const f32x4 a0 = *(const LAS f32x4*)pa, a1 = *(const LAS f32x4*)(pa + 4), b0 = *(const LAS f32x4*)pb, b1 = *(const LAS f32x4*)(pb + 4);
                f32x4 sn, cs;
                sn[0] = a0[0] * b0[1] + a0[1] * b0[0]; cs[0] = a0[1] * b0[1] - a0[0] * b0[0]; sn[1] = a0[2] * b0[3] + a0[3] * b0[2]; cs[1] = a0[3] * b0[3] - a0[2] * b0[2];
                sn[2] = a1[0] * b1[1] + a1[1] * b1[0]; cs[2] = a1[1] * b1[1] - a1[0] * b1[0]; sn[3] = a1[2] * b1[3] + a1[3] * b1[2]; cs[3] = a1[3] * b1[3] - a1[2] * b1[2];
                r.v[2 * hf] += sn; r.v[2 * hf + 1] += cs; }
        }
        row_store(r, P.latrow(row), lane);
        const int mi = row_modidx(row); if (mi != mcur) { mcur = mi; const float* m = P.mod(0, mi); row_load(msh, m, lane); row_load(msc, m + 1024, lane); }
        RowV h; row_modulate_r(r, h, msh, msc);
        row_store_bf16(h, (bf16_t*)(P.ws + WS_HBUF) + (size_t)row * D, lane);
        row_dt(h, wdt, (float*)(P.ws + WS_DT) + (size_t)row * 8, lane);
    }
}

__device__ __forceinline__ void phase_g1(const Ptrs P, LAS unsigned char* lds) {
    pg8::Gemm g{(const bf16_t*)(P.ws + WS_HBUF), (const bf16_t*)(P.ws + WS_WIN), D};
    EpiBf16Plain E{(bf16_t*)(P.ws + WS_BIG + BIG_U), UC, 0xffff};
    SchedG1 S{XOrder{P.G, P.bid, T / 256, 14}};
    pg8::gemm_phase<EpiBf16Plain, SchedG1, false>(P.tid, lds, g, S, E);
}

constexpr int NCHK = 34;
__device__ __forceinline__ int chunk_row0(int b, int pc) { return pc < 2 ? NLAT + b * CTXL + pc * 128 : b * SEQ + (pc - 2) * 128; }
__device__ __forceinline__ int chunk_at(int dir, int q) { return dir == 0 ? q : (q < 2 ? 1 - q : 35 - q); }
__device__ __forceinline__ int sidx(int kind, int b, int h, int dir, int pc) { return (((kind * 8 + b) * 4 + h) * 2 + dir) * NCHK + pc; }
__device__ __forceinline__ bf16x8 pack8(const float (&v)[8]) { u32x4 w; w.x = pack2(v[0], v[1]); w.y = pack2(v[2], v[3]); w.z = pack2(v[4], v[5]); w.w = pack2(v[6], v[7]); return __builtin_bit_cast(bf16x8, w); }
__device__ __forceinline__ float softplusf_(float x) { return x > 20.f ? x : flog(1.0f + fexp(x)); }
__device__ __forceinline__ float wave_incl_scan(float v, int lane) {
#pragma unroll
    for (int d = 1; d < 64; d <<= 1) { const float t = __shfl_up(v, d); if (lane >= d) v += t; }
    return v;
}

template <bool SILU>
__device__ __forceinline__ void conv3_8(const bf16_t* U, int row, int col0, const float* w, int ncol, int wcol0, const float* bias, float (&out)[8]) {
    const bool hp = row_has_prev(row), hn = row_has_next(row);
    const bf16x8 c = *(const bf16x8*)(U + (size_t)row * UC + col0);
    const bf16x8 p = *(const bf16x8*)(U + (size_t)(hp ? row - 1 : row) * UC + col0), n = *(const bf16x8*)(U + (size_t)(hn ? row + 1 : row) * UC + col0);
    const float mp = hp ? 1.0f : 0.0f, mn = hn ? 1.0f : 0.0f;
#pragma unroll
    for (int h4 = 0; h4 < 2; ++h4) { const f32x4 w0 = *(const f32x4*)(w + wcol0 + 4 * h4), w1 = *(const f32x4*)(w + ncol + wcol0 + 4 * h4), w2 = *(const f32x4*)(w + 2 * ncol + wcol0 + 4 * h4), bb = *(const f32x4*)(bias + wcol0 + 4 * h4);
#pragma unroll
        for (int e = 0; e < 4; ++e) { const int i = 4 * h4 + e; const float v = bf2f((bf16_t)c[i]) * w1[e] + mp * bf2f((bf16_t)p[i]) * w0[e] + mn * bf2f((bf16_t)n[i]) * w2[e] + bb[e]; out[i] = SILU ? siluf_(v) : v; } }
}
__device__ __forceinline__ void conv3_silu8(const bf16_t* U, int row, int col0, const float* w, int ncol, int wcol0, const float* bias, float (&out)[8]) { conv3_8<true>(U, row, col0, w, ncol, wcol0, bias, out); }
__device__ __forceinline__ void conv16_silu(const bf16_t* U, int r0, int col, const float* w, int ncol, int wcol, float bias, float (&out)[16]) {
    const bool hp = row_has_prev(r0), hn = row_has_next(r0 + 15);
    float x[18];
#pragma unroll
    for (int i = 0; i < 18; ++i) { const int r = (i == 0 && !hp) ? r0 : ((i == 17 && !hn) ? r0 + 15 : r0 - 1 + i); x[i] = bf2f(U[(size_t)r * UC + col]); }
    if (!hp) x[0] = 0.f; if (!hn) x[17] = 0.f;
    const float w0 = w[wcol], w1 = w[ncol + wcol], w2 = w[2 * ncol + wcol];
#pragma unroll
    for (int j = 0; j < 16; ++j) out[j] = siluf_(x[j] * w0 + x[j + 1] * w1 + x[j + 2] * w2 + bias);
}
__device__ __forceinline__ void store16_bf16(LAS bf16_t* dst, const float (&v)[16]) {
    u32x4 a, b; a.x = pack2(v[0], v[1]); a.y = pack2(v[2], v[3]); a.z = pack2(v[4], v[5]); a.w = pack2(v[6], v[7]); b.x = pack2(v[8], v[9]); b.y = pack2(v[10], v[11]); b.z = pack2(v[12], v[13]); b.w = pack2(v[14], v[15]);
    *(LAS u32x4*)dst = a; *(LAS u32x4*)(dst + 8) = b;
}

__device__ __forceinline__ void scatter8_T(LAS bf16_t* dstT, int g8, int p, const float (&v)[8]) {
#pragma unroll
    for (int e2 = 0; e2 < 4; ++e2) { const unsigned w = pack2(v[2 * e2], v[2 * e2 + 1]); dstT[(8 * g8 + 2 * e2) * 136 + p] = (bf16_t)(w & 0xffffu); dstT[(8 * g8 + 2 * e2 + 1) * 136 + p] = (bf16_t)(w >> 16); }
}

__device__ __forceinline__ void hgrn_pass1(const Ptrs P, int l, int unit, LAS unsigned char* lds) {
    const int tid = P.tid, lane = tid & 63, wid = tid >> 6, fr = lane & 15, fq = lane >> 4;
    const int pc = unit % NCHK; const int r_ = unit / NCHK; const int h = r_ & 3; const int b = r_ >> 2;
    const int row0 = chunk_row0(b, pc);
    const bf16_t* U = (const bf16_t*)(P.ws + WS_BIG + BIG_U);
    LAS bf16_t* KTF = (LAS bf16_t*)lds; LAS bf16_t* KTB = KTF + 64 * 136; LAS bf16_t* VT = KTB + 64 * 136; LAS float* segtot = (LAS float*)(VT + 64 * 136);
    LAS bf16_t* FS = (LAS bf16_t*)(lds + 65536);
    for (int it = tid; it < 128 * 8; it += 512) { const int p = it >> 3, g8 = it & 7; const bf16_t* ur = U + (size_t)(row0 + p) * UC + h * 64 + 8 * g8;
        const bf16x8 ff8 = *(const bf16x8*)(ur + 1792), fb8 = *(const bf16x8*)(ur + 2048), v8 = *(const bf16x8*)(ur + 2304);
        *(LAS bf16x8*)(FS + p * 64 + 8 * g8) = ff8; *(LAS bf16x8*)(FS + 8192 + p * 64 + 8 * g8) = fb8;
#pragma unroll
        for (int e = 0; e < 8; ++e) VT[(8 * g8 + e) * 136 + p] = (bf16_t)v8[e]; }
    __syncthreads();
    const int ch = lane, seg = wid;
    const float lbf = ((const float*)(P.ws + WS_LB))[(0 * 2 + l) * 256 + h * 64 + ch], lbb = ((const float*)(P.ws + WS_LB))[(1 * 2 + l) * 256 + h * 64 + ch];
    float cf[16], cb[16], kf[16], kb[16]; float runf = 0.f, runb = 0.f;
#pragma unroll
    for (int j = 0; j < 16; ++j) { const int p = 16 * seg + j;
        const float ff = lbf + (1.0f - lbf) * sigmoidf_(bf2f(FS[p * 64 + ch])), fb = lbb + (1.0f - lbb) * sigmoidf_(bf2f(FS[8192 + p * 64 + ch]));
        runf += flog(ff); cf[j] = runf; kf[j] = 1.0f - ff; cb[j] = runb; runb += flog(fb); kb[j] = 1.0f - fb; }
    segtot[seg * 64 + ch] = runf; segtot[512 + seg * 64 + ch] = runb; __syncthreads();
    float offf = 0.f, totf = 0.f, offb = 0.f, totb = 0.f;
#pragma unroll
    for (int s = 0; s < 8; ++s) { const float a = segtot[s * 64 + ch], c = segtot[512 + s * 64 + ch]; totf += a; totb += c; offf += (s < seg) ? a : 0.f; offb += (s < seg) ? c : 0.f; }
    { float t[16];
#pragma unroll
      for (int j = 0; j < 16; ++j) t[j] = kf[j] * fexp(totf - offf - cf[j]);
      store16_bf16(KTF + ch * 136 + 16 * seg, t);
#pragma unroll
      for (int j = 0; j < 16; ++j) t[j] = kb[j] * fexp(offb + cb[j]);
      store16_bf16(KTB + ch * 136 + 16 * seg, t); }
    const int sif = sidx(0, b, h, 0, pc), sib = sidx(0, b, h, 1, pc);
    if (seg == 0) { ((float*)(P.ws + WS_DEC))[(size_t)sif * 64 + ch] = fexp(totf); ((float*)(P.ws + WS_DEC))[(size_t)sib * 64 + ch] = fexp(totb); }
    __syncthreads();
    const int mt = wid >> 1, nt0 = (wid & 1) * 2;
    f32x4 af[2], ab[2]; af[0] = (f32x4){0.f, 0.f, 0.f, 0.f}; af[1] = af[0]; ab[0] = af[0]; ab[1] = af[0];
#pragma unroll
    for (int ks = 0; ks < 4; ++ks) { const bf16x8 a0 = *(const LAS bf16x8*)(KTF + (16 * mt + fr) * 136 + 32 * ks + 8 * fq), a1 = *(const LAS bf16x8*)(KTB + (16 * mt + fr) * 136 + 32 * ks + 8 * fq);
#pragma unroll
        for (int n = 0; n < 2; ++n) { const bf16x8 bb = *(const LAS bf16x8*)(VT + (16 * (nt0 + n) + fr) * 136 + 32 * ks + 8 * fq);
            af[n] = __builtin_amdgcn_mfma_f32_16x16x32_bf16(a0, bb, af[n], 0, 0, 0); ab[n] = __builtin_amdgcn_mfma_f32_16x16x32_bf16(a1, bb, ab[n], 0, 0, 0); } }
    float* SF = (float*)(P.ws + WS_BIG + BIG_STATE) + (size_t)sif * 4096; float* SB = (float*)(P.ws + WS_BIG + BIG_STATE) + (size_t)sib * 4096;
#pragma unroll
    for (int n = 0; n < 2; ++n)
#pragma unroll
        for (int r = 0; r < 4; ++r) { const int o = (16 * mt + 4 * fq + r) * 64 + 16 * (nt0 + n) + fr; SF[o] = af[n][r]; SB[o] = ab[n][r]; }
    __syncthreads();
}

__device__ __forceinline__ void ssd_pass1(const Ptrs P, int l, int unit, LAS unsigned char* lds) {
    const int tid = P.tid, lane = tid & 63, wid = tid >> 6, fr = lane & 15, fq = lane >> 4;
    const int pc = unit % NCHK; const int r_ = unit / NCHK; const int g = r_ & 1; const int b = r_ >> 1;
    const int row0 = chunk_row0(b, pc);
    const bf16_t* U = (const bf16_t*)(P.ws + WS_BIG + BIG_U);
    const float* scw = P.inp(I_SSDCW) + (size_t)l * 3 * 512; const float* scb = P.inp(I_SSDCB) + l * 512;
    LAS bf16_t* BT = (LAS bf16_t*)lds; LAS bf16_t* XT = BT + 64 * 136;
    LAS float* wgt = (LAS float*)(XT + 4 * 64 * 136);
    if (wid < 4) {
        const int hh = 2 * g + (wid >> 1), dir = wid & 1;
        const float Aneg = -fexp(P.inp(I_SSDALOG)[(l * 2 + dir) * 4 + hh]); const float dtb = P.inp(I_SSDDTB)[(l * 2 + dir) * 4 + hh]; const float* DT = (const float*)(P.ws + WS_DT);
        const int p0 = 2 * lane; const float d0 = softplusf_(DT[(size_t)(row0 + p0) * 8 + dir * 4 + hh] + dtb), d1 = softplusf_(DT[(size_t)(row0 + p0 + 1) * 8 + dir * 4 + hh] + dtb);
        const float a0 = Aneg * d0, a1 = Aneg * d1; const float inc = wave_incl_scan(a0 + a1, lane); const float tot = __uint_as_float(__builtin_amdgcn_readlane(__float_as_uint(inc), 63));
        if (dir == 0) { wgt[wid * 128 + p0] = d0 * fexp(tot - (inc - a1)); wgt[wid * 128 + p0 + 1] = d1 * fexp(tot - inc); }
        else { wgt[wid * 128 + p0] = d0 * fexp(inc - a1 - a0); wgt[wid * 128 + p0 + 1] = d1 * fexp(inc - a1); }
        if (lane == 0) ((float*)(P.ws + WS_DEC))[(size_t)sidx(1, b, hh, dir, pc) * 64] = fexp(tot);
    }
    __syncthreads();
    {
#pragma unroll 1
        for (int it = tid; it < 128 * 8; it += 512) { const int p = it >> 3, g8 = it & 7; const int row = row0 + p; float t8[8];
            conv3_8<true>(U, row, 3072 + 256 + g * 64 + 8 * g8, scw, 512, 256 + g * 64 + 8 * g8, scb, t8); scatter8_T(BT, g8, p, t8); }
#pragma unroll 1
        for (int it = tid; it < 2 * 128 * 8; it += 512) { const int hq = it >> 10, p = (it >> 3) & 127, g8 = it & 7; const int row = row0 + p; const int c0 = (2 * g + hq) * 64 + 8 * g8; float x8[8], t8[8];
            conv3_8<true>(U, row, 3072 + c0, scw, 512, c0, scb, x8);
#pragma unroll
            for (int dir = 0; dir < 2; ++dir) { const int cmb = 2 * hq + dir; const float wv = wgt[cmb * 128 + p];
#pragma unroll
                for (int e = 0; e < 8; ++e) t8[e] = x8[e] * wv;
                scatter8_T(XT + cmb * 64 * 136, g8, p, t8); } }
    }
    __syncthreads();
    {
        const int cmb = wid >> 1; const int hh = 2 * g + (cmb >> 1), dir = cmb & 1;
        float* S = (float*)(P.ws + WS_BIG + BIG_STATE) + (size_t)sidx(1, b, hh, dir, pc) * 4096;
#pragma unroll
        for (int mi = 0; mi < 2; ++mi) { const int mt = 2 * (wid & 1) + mi; f32x4 acc[4];
#pragma unroll
            for (int n = 0; n < 4; ++n) acc[n] = (f32x4){0.f, 0.f, 0.f, 0.f};
#pragma unroll
            for (int ks = 0; ks < 4; ++ks) { const bf16x8 a = *(const LAS bf16x8*)(XT + (cmb * 64 + 16 * mt + fr) * 136 + 32 * ks + 8 * fq);
#pragma unroll
                for (int n = 0; n < 4; ++n) { const bf16x8 bb = *(const LAS bf16x8*)(BT + (16 * n + fr) * 136 + 32 * ks + 8 * fq); acc[n] = __builtin_amdgcn_mfma_f32_16x16x32_bf16(a, bb, acc[n], 0, 0, 0); } }
#pragma unroll
            for (int n = 0; n < 4; ++n)
#pragma unroll
                for (int r = 0; r < 4; ++r) S[(16 * mt + 4 * fq + r) * 64 + 16 * n + fr] = acc[n][r]; }
    }
    __syncthreads();
}

__device__ __forceinline__ void ssd_dt_cum(const Ptrs P, int l, int row0, int dir, int h, int wid, int lane, LAS float* cum, LAS float* dtv) {
    if (wid == 0) {
        const float Aneg = -fexp(P.inp(I_SSDALOG)[(l * 2 + dir) * 4 + h]); const float dtb = P.inp(I_SSDDTB)[(l * 2 + dir) * 4 + h]; const float* DT = (const float*)(P.ws + WS_DT);
        const int t0 = 2 * lane, p0 = dir ? 127 - t0 : t0, p1 = dir ? 126 - t0 : t0 + 1;
        const float d0 = softplusf_(DT[(size_t)(row0 + p0) * 8 + dir * 4 + h] + dtb), d1 = softplusf_(DT[(size_t)(row0 + p1) * 8 + dir * 4 + h] + dtb);
        const float a0 = Aneg * d0, a1 = Aneg * d1; const float inc = wave_incl_scan(a0 + a1, lane);
        cum[t0] = inc - a1; cum[t0 + 1] = inc; dtv[t0] = d0; dtv[t0 + 1] = d1;
    }
}

__device__ __forceinline__ void scan_pass2(const Ptrs P, int unit) {
    const int seq = unit >> 1, half = unit & 1; const int kind = seq >> 6, b = (seq >> 3) & 7, h = (seq >> 1) & 3, dir = seq & 1;
    const int e0 = half * 2048 + P.tid * 4; const int base = sidx(kind, b, h, dir, 0);
    float* ST = (float*)(P.ws + WS_BIG + BIG_STATE); const float* DEC = (const float*)(P.ws + WS_DEC);
    const float zf = zero_f(); f32x4 run = (f32x4){zf, zf, zf, zf};
#pragma unroll 1
    for (int q0 = 0; q0 < NCHK; q0 += 8) {
        f32x4 loc[8]; float dd[8];
#pragma unroll
        for (int k = 0; k < 8; ++k) { const int q = (q0 + k < NCHK) ? q0 + k : NCHK - 1; const int pc = chunk_at(dir, q);
            loc[k] = *(const f32x4*)(ST + (size_t)(base + pc) * 4096 + e0); dd[k] = DEC[(size_t)(base + pc) * 64 + (kind == 0 ? (e0 >> 6) : 0)]; }
#pragma unroll
        for (int k = 0; k < 8; ++k) { if (q0 + k < NCHK) { const int pc = chunk_at(dir, q0 + k); *(f32x4*)(ST + (size_t)(base + pc) * 4096 + e0) = run; run = run * dd[k] + loc[k]; } }
    }
}

__device__ __forceinline__ int qk_off(int p, int chunk) { return p * 64 + ((chunk ^ (p & 7)) << 3); }
__device__ __forceinline__ void hgrn_pass3(const Ptrs P, int l, int unit, int unit_next, LAS unsigned char* lds) {
    const int tid = P.tid, lane = tid & 63, wid = tid >> 6, fr = lane & 15, fq = lane >> 4;
    const int pc = unit % NCHK; const int r_ = unit / NCHK; const int h = r_ & 3; const int b = r_ >> 2;
    const int row0 = chunk_row0(b, pc);
    const bf16_t* U = (const bf16_t*)(P.ws + WS_BIG + BIG_U);
    LAS bf16_t* QF = (LAS bf16_t*)lds; LAS bf16_t* KF = QF + 128 * 64; LAS bf16_t* QB = KF + 128 * 64; LAS bf16_t* KB = QB + 128 * 64; LAS bf16_t* VT = KB + 128 * 64;
    LAS bf16_t* STF = VT + 64 * 136; LAS bf16_t* STB = STF + 64 * 72; LAS float* ETF = (LAS float*)(STB + 64 * 72); LAS float* ETB = ETF + 512; LAS bf16_t* PW = (LAS bf16_t*)(ETB + 512);
    LAS float* OUT = (LAS float*)lds;
    {
        LAS bf16_t* FS = PW;
        for (int it = tid; it < 128 * 8; it += 512) { const int p = it >> 3, g8 = it & 7; const bf16_t* ur = U + (size_t)(row0 + p) * UC + h * 64 + 8 * g8;
            const bf16x8 ff8 = *(const bf16x8*)(ur + 1792), fb8 = *(const bf16x8*)(ur + 2048), q8 = *(const bf16x8*)(ur + 1536), v8 = *(const bf16x8*)(ur + 2304);
            *(LAS bf16x8*)(FS + p * 64 + 8 * g8) = ff8; *(LAS bf16x8*)(FS + 8192 + p * 64 + 8 * g8) = fb8;
            float qs[8];
#pragma unroll
            for (int e = 0; e < 8; ++e) qs[e] = bf2f((bf16_t)q8[e]) * 0.125f;
            const bf16x8 qp = pack8(qs); *(LAS bf16x8*)(QF + qk_off(p, g8)) = qp; *(LAS bf16x8*)(QB + qk_off(p, g8)) = qp;
#pragma unroll
            for (int e = 0; e < 8; ++e) VT[(8 * g8 + e) * 136 + p] = (bf16_t)v8[e]; }
        const float* SF = (const float*)(P.ws + WS_BIG + BIG_STATE) + (size_t)sidx(0, b, h, 0, pc) * 4096; const float* SB = (const float*)(P.ws + WS_BIG + BIG_STATE) + (size_t)sidx(0, b, h, 1, pc) * 4096;
#pragma unroll 2
        for (int idx = tid; idx < 4096; idx += 512) { STF[(idx & 63) * 72 + (idx >> 6)] = f2bf(SF[idx]); STB[(idx & 63) * 72 + (idx >> 6)] = f2bf(SB[idx]); }
    }
    __syncthreads();
    {
        LAS bf16_t* FS = PW;
        const int ch = lane, seg = wid; const float lbf = ((const float*)(P.ws + WS_LB))[(0 * 2 + l) * 256 + h * 64 + ch], lbb = ((const float*)(P.ws + WS_LB))[(1 * 2 + l) * 256 + h * 64 + ch];
        float bfw[16], bbw[16], kf[16], kb[16];
#pragma unroll
        for (int j = 0; j < 16; ++j) { const int p = 16 * seg + j;
            const float ff = lbf + (1.0f - lbf) * sigmoidf_(bf2f(FS[p * 64 + ch])), fb = lbb + (1.0f - lbb) * sigmoidf_(bf2f(FS[8192 + p * 64 + ch]));
            bfw[j] = flog(ff); bbw[j] = flog(fb); kf[j] = 1.0f - ff; kb[j] = 1.0f - fb; }
#pragma unroll
        for (int j = 1; j < 16; ++j) bfw[j] += bfw[j - 1];
#pragma unroll
        for (int j = 14; j >= 0; --j) bbw[j] += bbw[j + 1];
        const float etf = bfw[15], etb = bbw[0];
        ETF[seg * 64 + ch] = etf; ETB[seg * 64 + ch] = etb;
        const int chunk = ch >> 3, sub = ch & 7;
#pragma unroll
        for (int j = 0; j < 16; ++j) { const int p = 16 * seg + j; const int o = qk_off(p, chunk) + sub; const float qv = bf2f(QF[o]);
            const unsigned wq = pack2(qv * fexp(bfw[j]), qv * fexp(bbw[j])), wk = pack2(kf[j] * fexp(etf - bfw[j]), kb[j] * fexp(etb - bbw[j]));
            QF[o] = (bf16_t)(wq & 0xffffu); QB[o] = (bf16_t)(wq >> 16); KF[o] = (bf16_t)(wk & 0xffffu); KB[o] = (bf16_t)(wk >> 16); }
    }
    __syncthreads();
    f32x4 o[4];
    {
        const int i = wid; LAS bf16_t* pw = PW + wid * 16 * 136;
#pragma unroll
        for (int nt = 0; nt < 4; ++nt) o[nt] = (f32x4){0.f, 0.f, 0.f, 0.f};
#pragma unroll 1
        for (int dir = 0; dir < 2; ++dir) {
            const LAS bf16_t* QA = dir ? QB : QF; const LAS bf16_t* KA = dir ? KB : KF; const LAS float* ET = dir ? ETB : ETF; const LAS bf16_t* ST = dir ? STB : STF;
            bf16x8 qf[2]; float g[2][8];
#pragma unroll
            for (int ks = 0; ks < 2; ++ks) { qf[ks] = *(const LAS bf16x8*)(QA + qk_off(16 * i + fr, 4 * ks + fq));
                const f32x4 e0 = *(const LAS f32x4*)(ET + i * 64 + 32 * ks + 8 * fq), e1 = *(const LAS f32x4*)(ET + i * 64 + 32 * ks + 8 * fq + 4);
                g[ks][0] = -e0[0]; g[ks][1] = -e0[1]; g[ks][2] = -e0[2]; g[ks][3] = -e0[3]; g[ks][4] = -e1[0]; g[ks][5] = -e1[1]; g[ks][6] = -e1[2]; g[ks][7] = -e1[3]; }
            const int nj = dir ? 8 - i : i + 1;
            for (int jj = 0; jj < nj; ++jj) { const int j = dir ? i + jj : i - jj;
                f32x4 d = (f32x4){0.f, 0.f, 0.f, 0.f};
#pragma unroll
                for (int ks = 0; ks < 2; ++ks) { float a8[8];
#pragma unroll
                    for (int e = 0; e < 8; ++e) a8[e] = bf2f((bf16_t)qf[ks][e]) * fexp(g[ks][e]);
                    const bf16x8 kfr = *(const LAS bf16x8*)(KA + qk_off(16 * j + fr, 4 * ks + fq));
                    d = __builtin_amdgcn_mfma_f32_16x16x32_bf16(kfr, pack8(a8), d, 0, 0, 0);
                    const f32x4 e0 = *(const LAS f32x4*)(ET + j * 64 + 32 * ks + 8 * fq), e1 = *(const LAS f32x4*)(ET + j * 64 + 32 * ks + 8 * fq + 4);
                    g[ks][0] += e0[0]; g[ks][1] += e0[1]; g[ks][2] += e0[2]; g[ks][3] += e0[3]; g[ks][4] += e1[0]; g[ks][5] += e1[1]; g[ks][6] += e1[2]; g[ks][7] += e1[3]; }
                if (jj == 0) {
#pragma unroll
                    for (int r = 0; r < 4; ++r) d[r] = (dir ? (4 * fq + r >= fr) : (4 * fq + r <= fr)) ? d[r] : 0.f; }
                u32x2 w; w.x = pack2(d[0], d[1]); w.y = pack2(d[2], d[3]); *(LAS u32x2*)(pw + fr * 136 + 16 * j + 4 * fq) = w;
            }
            { const int zb = dir ? i - 1 : i + 1; const bool need = dir ? ((i & 1) == 1) : ((i & 1) == 0);
              if (need) { u32x2 z; z.x = __float_as_uint(zero_f()); z.y = z.x; *(LAS u32x2*)(pw + fr * 136 + 16 * zb + 4 * fq) = z; } }
            const int kslo = dir ? (i >> 1) : 0, kshi = dir ? 3 : (i >> 1);
            for (int ks = kslo; ks <= kshi; ++ks) { const bf16x8 pa = *(const LAS bf16x8*)(pw + fr * 136 + 32 * ks + 8 * fq);
#pragma unroll
                for (int nt = 0; nt < 4; ++nt) { const bf16x8 vf = *(const LAS bf16x8*)(VT + (16 * nt + fr) * 136 + 32 * ks + 8 * fq); o[nt] = __builtin_amdgcn_mfma_f32_16x16x32_bf16(pa, vf, o[nt], 0, 0, 0); } }
#pragma unroll
            for (int ks = 0; ks < 2; ++ks) { float a8[8];
#pragma unroll
                for (int e = 0; e < 8; ++e) a8[e] = bf2f((bf16_t)qf[ks][e]) * fexp(g[ks][e]);
                const bf16x8 qa = pack8(a8);
#pragma unroll
                for (int nt = 0; nt < 4; ++nt) { const bf16x8 sf = *(const LAS bf16x8*)(ST + (16 * nt + fr) * 72 + 32 * ks + 8 * fq); o[nt] = __builtin_amdgcn_mfma_f32_16x16x32_bf16(qa, sf, o[nt], 0, 0, 0); } }
        }
    }
    __syncthreads();
#pragma unroll
    for (int nt = 0; nt < 4; ++nt)
#pragma unroll
        for (int r = 0; r < 4; ++r) OUT[(16 * wid + 4 * fq + r) * 64 + 16 * nt + fr] = o[nt][r];
    __syncthreads();
    {
        const int pos = tid >> 2, qd = tid & 3; const int row = row0 + pos; bf16_t* BR2 = (bf16_t*)(P.ws + WS_BR) + (size_t)2 * T * 256;
        const bf16_t* gp = U + (size_t)row * UC + 2560 + h * 64 + 16 * qd; const bf16x8 g0 = *(const bf16x8*)gp, g1 = *(const bf16x8*)(gp + 8);
        const float* ngp = P.inp(I_HGNG) + l * 64 + 16 * qd; float ov[16], q = 0.f;
#pragma unroll
        for (int e4 = 0; e4 < 4; ++e4) { const f32x4 v = *(const LAS f32x4*)(OUT + pos * 64 + 16 * qd + 4 * e4); ov[4 * e4] = v[0]; ov[4 * e4 + 1] = v[1]; ov[4 * e4 + 2] = v[2]; ov[4 * e4 + 3] = v[3]; q += v[0] * v[0] + v[1] * v[1] + v[2] * v[2] + v[3] * v[3]; }
        q += __shfl_xor(q, 1); q += __shfl_xor(q, 2);
        const float rs = rsqrtf(q * (1.0f / 64.0f) + kconst(RMS_EPS)); float t8[8];
#pragma unroll
        for (int e = 0; e < 8; ++e) t8[e] = ov[e] * rs * ngp[e] * siluf_(bf2f((bf16_t)g0[e]));
        *(bf16x8*)(BR2 + (size_t)row * 256 + h * 64 + 16 * qd) = pack8(t8);
#pragma unroll
        for (int e = 0; e < 8; ++e) t8[e] = ov[8 + e] * rs * ngp[8 + e] * siluf_(bf2f((bf16_t)g1[e]));
        *(bf16x8*)(BR2 + (size_t)row * 256 + h * 64 + 16 * qd + 8) = pack8(t8);
    }
    __syncthreads();
}

__device__ __forceinline__ void ssd_pass3(const Ptrs P, int l, int unit, LAS unsigned char* lds) {
    const int tid = P.tid, lane = tid & 63, wid = tid >> 6, fr = lane & 15, fq = lane >> 4;
    const int pc = unit % NCHK; const int r_ = unit / NCHK; const int g = r_ & 1; const int b = r_ >> 1;
    const int row0 = chunk_row0(b, pc);
    const bf16_t* U = (const bf16_t*)(P.ws + WS_BIG + BIG_U);
    const float* scw = P.inp(I_SSDCW) + (size_t)l * 3 * 512; const float* scb = P.inp(I_SSDCB) + l * 512;
    LAS bf16_t* CM = (LAS bf16_t*)lds; LAS bf16_t* BM = CM + 128 * 72; LAS bf16_t* XT = BM + 128 * 72; LAS bf16_t* STF = XT + 64 * 136; LAS bf16_t* STB = STF + 64 * 72;
    LAS float* cumfA = (LAS float*)(STB + 64 * 72); LAS float* cumbA = cumfA + 256; LAS float* dtfA = cumbA + 256; LAS float* dtbA = dtfA + 256;
    LAS bf16_t* PW = (LAS bf16_t*)(dtbA + 256); LAS float* OUT = (LAS float*)(PW + 8 * 16 * 136);
    if (wid < 4) {
        const int hq = wid >> 1, dir = wid & 1, h = 2 * g + hq; const float Aneg = -fexp(P.inp(I_SSDALOG)[(l * 2 + dir) * 4 + h]); const float dtbias = P.inp(I_SSDDTB)[(l * 2 + dir) * 4 + h]; const float* DT = (const float*)(P.ws + WS_DT);
        const int p0 = 2 * lane; const float d0 = softplusf_(DT[(size_t)(row0 + p0) * 8 + dir * 4 + h] + dtbias), d1 = softplusf_(DT[(size_t)(row0 + p0 + 1) * 8 + dir * 4 + h] + dtbias);
        const float a0 = Aneg * d0, a1 = Aneg * d1; const float inc = wave_incl_scan(a0 + a1, lane);
        if (dir == 0) { cumfA[hq * 128 + p0] = inc - a1; cumfA[hq * 128 + p0 + 1] = inc; dtfA[hq * 128 + p0] = d0; dtfA[hq * 128 + p0 + 1] = d1; }
        else { const float tot = __uint_as_float(__builtin_amdgcn_readlane(__float_as_uint(inc), 63)); cumbA[hq * 128 + p0] = tot - inc + a0 + a1; cumbA[hq * 128 + p0 + 1] = tot - inc + a1; dtbA[hq * 128 + p0] = d0; dtbA[hq * 128 + p0 + 1] = d1; }
    }
    {
        const int pos = tid >> 2, qd = tid & 3; const int row = row0 + pos;
#pragma unroll 1
        for (int pcs = 0; pcs < 4; ++pcs) { const int isb = pcs >> 1, hf = pcs & 1; const int cc = (isb ? 256 : 384) + g * 64 + 16 * qd + 8 * hf; float t8[8];
            conv3_silu8(U, row, 3072 + cc, scw, 512, cc, scb, t8);
            *(LAS bf16x8*)((isb ? BM : CM) + pos * 72 + 16 * qd + 8 * hf) = pack8(t8); }
    }
#pragma unroll 1
    for (int hq = 0; hq < 2; ++hq) {
        const int h = 2 * g + hq;
        for (int it = tid; it < 128 * 8; it += 512) { const int p = it >> 3, g8 = it & 7; float x8[8];
            conv3_8<true>(U, row0 + p, 3072 + h * 64 + 8 * g8, scw, 512, h * 64 + 8 * g8, scb, x8); scatter8_T(XT, g8, p, x8); }
        __builtin_amdgcn_sched_barrier(0);
        LAS float* cumf = cumfA + hq * 128; LAS float* cumb = cumbA + hq * 128; LAS float* dtf = dtfA + hq * 128; LAS float* dtb = dtbA + hq * 128;
        {
            const float* SF = (const float*)(P.ws + WS_BIG + BIG_STATE) + (size_t)sidx(1, b, h, 0, pc) * 4096; const float* SB = (const float*)(P.ws + WS_BIG + BIG_STATE) + (size_t)sidx(1, b, h, 1, pc) * 4096;
#pragma unroll
            for (int k = 0; k < 2; ++k) { const int idx = (tid + 512 * k) * 4; const f32x4 a = *(const f32x4*)(SF + idx), c = *(const f32x4*)(SB + idx);
                u32x2 wa, wc; wa.x = pack2(a[0], a[1]); wa.y = pack2(a[2], a[3]); wc.x = pack2(c[0], c[1]); wc.y = pack2(c[2], c[3]);
                *(LAS u32x2*)(STF + (idx >> 6) * 72 + (idx & 63)) = wa; *(LAS u32x2*)(STB + (idx >> 6) * 72 + (idx & 63)) = wc; }
        }
        float rxs[16]; bf16x8 rz[2];
        { const int pos = tid >> 2, qd = tid & 3; const int row = row0 + pos; const int c0 = h * 64 + 16 * qd; const bf16_t* zp = U + (size_t)row * UC + 2816 + c0;
#pragma unroll
          for (int hf = 0; hf < 2; ++hf) { float xs[8]; conv3_silu8(U, row, 3072 + c0 + 8 * hf, scw, 512, c0 + 8 * hf, scb, xs); rz[hf] = *(const bf16x8*)(zp + 8 * hf);
#pragma unroll
              for (int e = 0; e < 8; ++e) rxs[8 * hf + e] = xs[e]; } }
        __syncthreads();
        {
            const int i = wid; LAS bf16_t* pw = PW + wid * 16 * 136;
            bf16x8 cf[2];
#pragma unroll
            for (int ks = 0; ks < 2; ++ks) cf[ks] = *(const LAS bf16x8*)(CM + (16 * i + fr) * 72 + 32 * ks + 8 * fq);
            f32x4 o[4];
#pragma unroll
            for (int nt = 0; nt < 4; ++nt) o[nt] = (f32x4){0.f, 0.f, 0.f, 0.f};
#pragma unroll 1
            for (int dir = 0; dir < 2; ++dir) {
                const LAS float* cum = dir ? cumb : cumf; const LAS float* dtv = dir ? dtb : dtf; const LAS bf16_t* ST = dir ? STB : STF;
                const float cq = cum[16 * i + fr];
                const int jlo = dir ? i : 0, jhi = dir ? 7 : i;
                for (int j = jlo; j <= jhi; ++j) {
                    f32x4 d = (f32x4){0.f, 0.f, 0.f, 0.f};
#pragma unroll
                    for (int ks = 0; ks < 2; ++ks) { const bf16x8 bf_ = *(const LAS bf16x8*)(BM + (16 * j + fr) * 72 + 32 * ks + 8 * fq); d = __builtin_amdgcn_mfma_f32_16x16x32_bf16(bf_, cf[ks], d, 0, 0, 0); }
                    const f32x4 cs = *(const LAS f32x4*)(cum + 16 * j + 4 * fq), ds = *(const LAS f32x4*)(dtv + 16 * j + 4 * fq);
#pragma unroll
                    for (int r = 0; r < 4; ++r) { const bool keep = (j != i) || (dir ? (4 * fq + r >= fr) : (4 * fq + r <= fr)); d[r] = keep ? d[r] * fexp(cq - cs[r]) * ds[r] : 0.f; }
                    u32x2 w; w.x = pack2(d[0], d[1]); w.y = pack2(d[2], d[3]); *(LAS u32x2*)(pw + fr * 136 + 16 * j + 4 * fq) = w;
                }
                { const int zb = dir ? i - 1 : i + 1; const bool need = dir ? ((i & 1) == 1) : ((i & 1) == 0);
                  if (need) { u32x2 z; z.x = __float_as_uint(zero_f()); z.y = z.x; *(LAS u32x2*)(pw + fr * 136 + 16 * zb + 4 * fq) = z; } }
                const int kslo = dir ? (i >> 1) : 0, kshi = dir ? 3 : (i >> 1);
                for (int ks = kslo; ks <= kshi; ++ks) { const bf16x8 pa = *(const LAS bf16x8*)(pw + fr * 136 + 32 * ks + 8 * fq);
#pragma unroll
                    for (int nt = 0; nt < 4; ++nt) { const bf16x8 xf = *(const LAS bf16x8*)(XT + (16 * nt + fr) * 136 + 32 * ks + 8 * fq); o[nt] = __builtin_amdgcn_mfma_f32_16x16x32_bf16(pa, xf, o[nt], 0, 0, 0); } }
                f32x4 o2[4];
#pragma unroll
                for (int nt = 0; nt < 4; ++nt) o2[nt] = (f32x4){0.f, 0.f, 0.f, 0.f};
#pragma unroll
                for (int ks = 0; ks < 2; ++ks)
#pragma unroll
                    for (int nt = 0; nt < 4; ++nt) { const bf16x8 sf = *(const LAS bf16x8*)(ST + (16 * nt + fr) * 72 + 32 * ks + 8 * fq); o2[nt] = __builtin_amdgcn_mfma_f32_16x16x32_bf16(cf[ks], sf, o2[nt], 0, 0, 0); }
                const f32x4 ct = *(const LAS f32x4*)(cum + 16 * i + 4 * fq);
#pragma unroll
                for (int nt = 0; nt < 4; ++nt)
#pragma unroll
                    for (int r = 0; r < 4; ++r) o[nt][r] += fexp(ct[r]) * o2[nt][r];
            }
#pragma unroll
            for (int nt = 0; nt < 4; ++nt)
#pragma unroll
                for (int r = 0; r < 4; ++r) OUT[(16 * i + 4 * fq + r) * 64 + 16 * nt + fr] = o[nt][r];
        }
        __syncthreads();
        {
            const int pos = tid >> 2, qd = tid & 3; const int row = row0 + pos; const int c0 = h * 64 + 16 * qd;
            const float Dh = P.inp(I_SSDD)[l * 4 + h]; const float* ngp = P.inp(I_SSDNG) + l * 256 + c0; bf16_t* BR3 = (bf16_t*)(P.ws + WS_BR) + (size_t)3 * T * 256; float* SSQ = (float*)(P.ws + WS_SSQ);
            float q = 0.f;
#pragma unroll
            for (int hf = 0; hf < 2; ++hf) { float xs[8];
#pragma unroll
                for (int e = 0; e < 8; ++e) xs[e] = rxs[8 * hf + e];
                const bf16x8 z8 = rz[hf]; float t8[8];
#pragma unroll
                for (int e4 = 0; e4 < 2; ++e4) { const f32x4 ov = *(const LAS f32x4*)(OUT + pos * 64 + 16 * qd + 8 * hf + 4 * e4);
#pragma unroll
                    for (int e = 0; e < 4; ++e) { const int ii = 4 * e4 + e; const float vv = (ov[e] + xs[ii] * Dh) * siluf_(bf2f((bf16_t)z8[ii])); q += vv * vv; t8[ii] = vv * ngp[8 * hf + ii]; } }
                *(bf16x8*)(BR3 + (size_t)row * 256 + c0 + 8 * hf) = pack8(t8); }
            q += __shfl_xor(q, 1); q += __shfl_xor(q, 2);
            if (qd == 0) SSQ[(size_t)row * 4 + h] = q;
        }
        __syncthreads();
    }
}

typedef float f32x2 __attribute__((ext_vector_type(2)));
__device__ __forceinline__ f32x2 cmul(f32x2 a, f32x2 b) { return (f32x2){a.x * b.x - a.y * b.y, a.x * b.y + a.y * b.x}; }
__device__ __forceinline__ f32x2 cmulc(f32x2 a, f32x2 b) { return (f32x2){a.x * b.x + a.y * b.y, a.y * b.x - a.x * b.y}; }
__device__ __forceinline__ int fphys(int i) { return i + (i >> 4); }
template <int LO, int NST, bool INV>
__device__ __forceinline__ void fft_stages(f32x2 (&x)[16], const LAS f32x2* TW, int low) {
#pragma unroll
    for (int mm = 0; mm < NST; ++mm) { const int m = INV ? mm : NST - 1 - mm; const int s = LO + m;
#pragma unroll
        for (int j = 0; j < 16; ++j) { if (j & (1 << m)) continue; const int j2 = j | (1 << m);
            const int k = ((j & ((1 << m) - 1)) << LO) | low; const f32x2 tw = TW[k << (12 - s)];
            const f32x2 a = x[j], b = x[j2];
            if (!INV) { x[j] = a + b; x[j2] = cmul(a - b, tw); } else { const f32x2 bt = cmulc(b, tw); x[j] = a + bt; x[j2] = a - bt; } } }
}
template <int LO, int NST, bool INV>
__device__ __forceinline__ void fft_pass(LAS f32x2* X, const LAS f32x2* TW, int tid) {
    const int low = tid & ((1 << LO) - 1), high = tid >> LO; const int base = low | (high << (LO + 4));
    f32x2 x[16];
#pragma unroll
    for (int j = 0; j < 16; ++j) x[j] = X[fphys(base | (j << LO))];
    fft_stages<LO, NST, INV>(x, TW, low);
#pragma unroll
    for (int j = 0; j < 16; ++j) X[fphys(base | (j << LO))] = x[j];
}
__device__ __forceinline__ void hyena_fft_unit(const Ptrs P, int l, int c, LAS unsigned char* lds) {
    const int tid = P.tid, lane = tid & 63;
    LAS f32x2* X = (LAS f32x2*)lds; LAS f32x2* TW = X + 8704;
    const f32x2* TWg = (const f32x2*)(P.ws + WS_TW);
    for (int i = tid; i < 4096; i += 512) TW[i] = TWg[i];
    float nrm; { const float* part = (const float*)(P.ws + WS_PART) + (size_t)l * 64 * 512; nrm = wave_sum(part[lane * 512 + c] + part[lane * 512 + 256 + c]); }
    const float inv = 1.0f / nrm; const float* filt = (const float*)(P.ws + WS_FILT) + (size_t)l * 8192 * 256 + c;
    f32x2* Fg = (f32x2*)(P.ws + WS_BR) + (size_t)P.bid * 8192;
    __syncthreads();
    {
        f32x2 x[16];
#pragma unroll
        for (int j = 0; j < 16; ++j) x[j] = (f32x2){filt[(size_t)(tid + 512 * j) * 256] * inv, 0.f};
        fft_stages<9, 4, false>(x, TW, tid);
#pragma unroll
        for (int j = 0; j < 16; ++j) X[fphys(tid | (j << 9))] = x[j];
        __syncthreads(); fft_pass<5, 4, false>(X, TW, tid); __syncthreads(); fft_pass<2, 3, false>(X, TW, tid); __syncthreads();
#pragma unroll
        for (int j = 0; j < 16; ++j) x[j] = X[fphys((tid << 4) | j)];
        fft_stages<0, 2, false>(x, TW, 0);
#pragma unroll
        for (int j = 0; j < 16; ++j) Fg[(tid << 4) | j] = x[j];
    }
    unsigned* WTt = (unsigned*)(P.ws + WS_BIG + BIG_WT); const float bias = P.inp(I_HYBIAS)[l * 256 + c];
    for (int p = 0; p < 4; ++p) {
        unsigned* wp = WTt + ((size_t)c * 4 + p) * 4096;
        f32x2 x[16]; unsigned wraw[8];
#pragma unroll
        for (int j = 0; j < 8; ++j) { wraw[j] = wp[tid + 512 * j]; x[j] = (f32x2){__uint_as_float(wraw[j] << 16), __uint_as_float(wraw[j] & 0xffff0000u)}; }
#pragma unroll
        for (int j = 8; j < 16; ++j) x[j] = (f32x2){0.f, 0.f};
        fft_stages<9, 4, false>(x, TW, tid);
        __syncthreads();
#pragma unroll
        for (int j = 0; j < 16; ++j) X[fphys(tid | (j << 9))] = x[j];
        __syncthreads(); fft_pass<5, 4, false>(X, TW, tid); __syncthreads(); fft_pass<2, 3, false>(X, TW, tid); __syncthreads();
#pragma unroll
        for (int j = 0; j < 16; ++j) x[j] = X[fphys((tid << 4) | j)];
        fft_stages<0, 2, false>(x, TW, 0);
#pragma unroll
        for (int j = 0; j < 16; ++j) x[j] = cmul(x[j], Fg[(tid << 4) | j]);
        fft_stages<0, 2, true>(x, TW, 0);
#pragma unroll
        for (int j = 0; j < 16; ++j) X[fphys((tid << 4) | j)] = x[j];
        __syncthreads(); fft_pass<2, 3, true>(X, TW, tid); __syncthreads(); fft_pass<5, 4, true>(X, TW, tid); __syncthreads();
#pragma unroll
        for (int j = 0; j < 16; ++j) x[j] = X[fphys(tid | (j << 9))];
        fft_stages<9, 4, true>(x, TW, tid);
#pragma unroll
        for (int j = 0; j < 8; ++j) { const f32x2 y = x[j] * (1.0f / 8192.0f); const unsigned w = wraw[j];
            wp[tid + 512 * j] = pack2(y.x + __uint_as_float(w << 16) * bias, y.y + __uint_as_float(w & 0xffff0000u) * bias); }
    }
    __syncthreads();
}

#define DYNQ_BEGIN(ctrp, NUq) { volatile LAS unsigned* slot_ = (volatile LAS unsigned*)(lds + LDS_MISC + 64); unsigned* ctr_ = (ctrp); const bool t0_ = (P.tid == 0); \
    if (t0_) slot_[0] = __hip_atomic_fetch_add(ctr_, 1u, __ATOMIC_RELAXED, __HIP_MEMORY_SCOPE_AGENT); __syncthreads(); \
    unsigned u_ = (unsigned)__builtin_amdgcn_readfirstlane((int)slot_[0]); __syncthreads(); \
    while (u_ < (unsigned)(NUq)) { unsigned tn_ = 0u; if (t0_) tn_ = __hip_atomic_fetch_add(ctr_, 1u, __ATOMIC_RELAXED, __HIP_MEMORY_SCOPE_AGENT); const int u = (int)u_;
#define DYNQ_END() __syncthreads(); if (t0_) slot_[0] = tn_; __syncthreads(); u_ = (unsigned)__builtin_amdgcn_readfirstlane((int)slot_[0]); } }
__device__ __forceinline__ void phase_m1(const Ptrs P, int l, LAS unsigned char* lds) {
    const int tid = P.tid;
    const bf16_t* U = (const bf16_t*)(P.ws + WS_BIG + BIG_U);
    const float* hcw = P.inp(I_HYCW) + (size_t)l * 3 * 768; const float* hcb = P.inp(I_HYCB) + l * 768;
    const int NH = NB * 4 * NCHK, NSS = NB * 2 * NCHK;
    const int NS2 = NH + NSS;
    const int NU = NS2 + 256 + (l == 0 ? NCTX / 64 : 0);
    DYNQ_BEGIN((unsigned*)(P.ws + WS_CTL + CTL_DYN) + 16 + l, NU)
        Ptrs Pu = P; asm volatile("" : "+v"(Pu.tid));
        if (u < NSS) ssd_pass1(Pu, l, u, lds);
        else if (u < NS2) hgrn_pass1(Pu, l, u - NSS, lds);
        else if (u < NS2 + 256) { const int tid = Pu.tid;
            const int ub = u - NS2; const int p = ub >> 6, tb = ub & 63; const int c = tid & 255; LAS unsigned* tile = (LAS unsigned*)lds;
            for (int it = tid; it < 2 * 64 * 32; it += 512) { const int b2 = it >> 11, rr = (it >> 5) & 63, g8 = it & 31; const int row = (2 * p + b2) * SEQ + tb * 64 + rr; float x1[8], vv[8];
                conv3_8<false>(U, row, 256 + 8 * g8, hcw, 768, 256 + 8 * g8, hcb, x1); conv3_8<false>(U, row, 512 + 8 * g8, hcw, 768, 512 + 8 * g8, hcb, vv);
                LAS bf16_t* th = (LAS bf16_t*)tile + b2;
#pragma unroll
                for (int e2 = 0; e2 < 4; ++e2) { const unsigned w = pack2(x1[2 * e2] * vv[2 * e2], x1[2 * e2 + 1] * vv[2 * e2 + 1]);
                    th[2 * ((8 * g8 + 2 * e2) * 65 + rr)] = (bf16_t)(w & 0xffffu); th[2 * ((8 * g8 + 2 * e2 + 1) * 65 + rr)] = (bf16_t)(w >> 16); } }
            __syncthreads();
            { unsigned* WTt = (unsigned*)(P.ws + WS_BIG + BIG_WT); const int t = tid & 63;
              for (int cc = tid >> 6; cc < 256; cc += 8) WTt[((size_t)cc * 4 + p) * 4096 + tb * 64 + t] = tile[cc * 65 + t]; }
            __syncthreads();
        } else { const int tid = Pu.tid;
            const int ub = u - NS2 - 256; const int c = tid & 255; bf16_t* WTC = (bf16_t*)(P.ws + WS_BIG + BIG_WT) + (size_t)NLAT * 256;
#pragma unroll 4
            for (int rr = tid >> 8; rr < 64; rr += 2) { const int row = NLAT + ub * 64 + rr;
                const float x1 = conv3_u(U, row, 256 + c, hcw, 768, 256 + c) + hcb[256 + c]; const float v = conv3_u(U, row, 512 + c, hcw, 768, 512 + c) + hcb[512 + c];
                WTC[(size_t)(row - NLAT) * 256 + c] = f2bf(x1 * v); } }
    DYNQ_END()
}

__device__ __forceinline__ void phase_m2(const Ptrs P, int l, LAS unsigned char* lds) {
    const int tid = P.tid, G = P.G;
    const bf16_t* U = (const bf16_t*)(P.ws + WS_BIG + BIG_U); bf16_t* BR = (bf16_t*)(P.ws + WS_BR);
    const float* hcw = P.inp(I_HYCW) + (size_t)l * 3 * 768; const float* hcb = P.inp(I_HYCB) + l * 768;
    const int NU_F = 256, NU_P2 = 256, NU_HC = (l == 0) ? NB * 8 : 0;
    const int NU = NU_F + NU_P2 + NU_HC;
    for (int u = P.bid; u < NU; u += G) {
        if (u < NU_F) { hyena_fft_unit(P, l, u, lds); continue; }
        if (u < NU_F + NU_P2) { scan_pass2(P, u - NU_F); continue; }
        {
            const int uu = u - NU_F - NU_P2; const int b = uu >> 3, cb = uu & 7; const int cl = tid & 31, tg = tid >> 5; const int c = cb * 32 + cl;
            const int base = NLAT + b * CTXL; const bf16_t* WTC = (const bf16_t*)(P.ws + WS_BIG + BIG_WT) + (size_t)NLAT * 256 + (size_t)b * CTXL * 256;
            LAS float* wl = (LAS float*)lds; LAS float* fl = wl + 256 * 32;
            const float inv = 1.0f / hy_norm(P, 2, c); const float* filt = (const float*)(P.ws + WS_FILTC);
            for (int i = tid; i < 256 * 32; i += 512) wl[i] = bf2f(WTC[(size_t)(i >> 5) * 256 + cb * 32 + (i & 31)]);
            for (int i = tid >> 5; i < 512; i += 16) fl[i * 32 + cl] = filt[(size_t)i * 256 + c] * inv;
            __syncthreads();
            float acc[16];
#pragma unroll
            for (int j = 0; j < 16; ++j) acc[j] = 0.f;
#pragma unroll 1
            for (int sb = 0; sb < 16; ++sb) {
                float fw[31], wv[16];
#pragma unroll
                for (int q = 0; q < 31; ++q) fw[q] = fl[((16 * tg - 16 * sb - 15 + q) & 511) * 32 + cl];
#pragma unroll
                for (int k = 0; k < 16; ++k) wv[k] = wl[(16 * sb + k) * 32 + cl];
#pragma unroll
                for (int j = 0; j < 16; ++j)
#pragma unroll
                    for (int k = 0; k < 16; ++k) acc[j] += fw[j - k + 15] * wv[k];
            }
            const float bias = P.inp(I_HYBIAS)[l * 256 + c];
#pragma unroll 4
            for (int j = 0; j < 16; ++j) { const int tt = 16 * tg + j; const int row = base + tt; const float x0 = conv3_u(U, row, c, hcw, 768, c) + hcb[c];
                BR[(size_t)row * 256 + c] = f2bf(x0 * (acc[j] + wl[tt * 32 + cl] * bias)); }
            __syncthreads();
        }
    }
}

__device__ __forceinline__ void phase_m3(const Ptrs P, int l, LAS unsigned char* lds) {
    const int tid = P.tid;
    const bool last = (l == NLAYER - 1); const int rows_l = last ? NLAT : T; const int nch = last ? NCHK - 2 : NCHK;
    const bf16_t* U = (const bf16_t*)(P.ws + WS_BIG + BIG_U); bf16_t* BR = (bf16_t*)(P.ws + WS_BR);
    const int NSS3 = NB * 2 * nch, NH3 = NB * 4 * nch;
    const int NS3T = NSS3 + NH3;
    const int NU = NS3T + rows_l / 64 + 256;
    const float* hcw = P.inp(I_HYCW) + (size_t)l * 3 * 768; const float* hcb = P.inp(I_HYCB) + l * 768;
    DYNQ_BEGIN((unsigned*)(P.ws + WS_CTL + CTL_DYN) + 24 + l, NU)
        if (u >= NS3T + rows_l / 64) {
            const int ub = u - NS3T - rows_l / 64; const int p = ub >> 6, tb = ub & 63; LAS unsigned* tile = (LAS unsigned*)lds; const unsigned* WTt = (const unsigned*)(P.ws + WS_BIG + BIG_WT);
            { const int t = tid & 63; for (int cc = tid >> 6; cc < 256; cc += 8) tile[cc * 65 + t] = WTt[((size_t)cc * 4 + p) * 4096 + tb * 64 + t]; }
            __syncthreads();
            for (int it = tid; it < 64 * 32; it += 512) { const int rr = it >> 5, g8 = it & 31; unsigned yw[8];
#pragma unroll
                for (int e = 0; e < 8; ++e) yw[e] = tile[(8 * g8 + e) * 65 + rr];
#pragma unroll
                for (int b2 = 0; b2 < 2; ++b2) { const int row = (2 * p + b2) * SEQ + tb * 64 + rr; float x0[8], t8[8]; conv3_8<false>(U, row, 8 * g8, hcw, 768, 8 * g8, hcb, x0);
#pragma unroll
                    for (int e = 0; e < 8; ++e) t8[e] = x0[e] * (b2 ? __uint_as_float(yw[e] & 0xffff0000u) : __uint_as_float(yw[e] << 16));
                    *(bf16x8*)(BR + (size_t)row * 256 + 8 * g8) = pack8(t8); } }
            __syncthreads(); }
        else if (u < NS3T) { const int uc = u < NSS3 ? u : u - NSS3; const int rq = last ? (uc >> 5) : uc / NCHK; const int uu = rq * NCHK + (uc - rq * nch) + (NCHK - nch);
            Ptrs Pu = P; int lu = l; asm volatile("" : "+v"(Pu.tid), "+s"(lu));
            if (u < NSS3) ssd_pass3(Pu, lu, uu, lds); else hgrn_pass3(Pu, lu, uu, -1, lds); }
        else { const int rb = u - NS3T; const float* cw = P.inp(I_SCCW) + (size_t)l * 3 * 256;
            for (int it = tid; it < 64 * 32; it += 512) { const int row = rb * 64 + (it >> 5), g8 = it & 31; const bool hp = row_has_prev(row), hn = row_has_next(row);
                const bf16_t* u0 = U + (size_t)row * UC + 8 * g8; const bf16_t* up = U + (size_t)(hp ? row - 1 : row) * UC + 8 * g8; const bf16_t* un = U + (size_t)(hn ? row + 1 : row) * UC + 8 * g8;
                const bf16x8 bg = *(const bf16x8*)(u0 + 768), c0 = *(const bf16x8*)(u0 + 1024), x0 = *(const bf16x8*)(u0 + 1280), cp = *(const bf16x8*)(up + 1024), xp = *(const bf16x8*)(up + 1280), cn = *(const bf16x8*)(un + 1024), xn = *(const bf16x8*)(un + 1280);
                const float mp = hp ? 1.0f : 0.0f, mn = hn ? 1.0f : 0.0f; float t8[8];
#pragma unroll
                for (int e = 0; e < 8; ++e) { const int c = 8 * g8 + e;
                    const float acc = bf2f((bf16_t)c0[e]) * bf2f((bf16_t)x0[e]) * cw[256 + c] + mp * bf2f((bf16_t)cp[e]) * bf2f((bf16_t)xp[e]) * cw[c] + mn * bf2f((bf16_t)cn[e]) * bf2f((bf16_t)xn[e]) * cw[512 + c];
                    t8[e] = bf2f((bf16_t)bg[e]) * acc; }
                *(bf16x8*)(BR + (size_t)T * 256 + (size_t)row * 256 + 8 * g8) = pack8(t8); } }
    DYNQ_END()
}

__device__ __forceinline__ void phase_g2(const Ptrs P, int l, LAS unsigned char* lds) {
    const int MT = ((l == NLAYER - 1) ? NLAT : T) / 256;
    pg8::Gemm g{(const bf16_t*)(P.ws + WS_BR), (const bf16_t*)(P.ws + WS_WBR), 256};
    EpiP E{(bf16_t*)(P.ws + WS_BIG + BIG_P), (const float*)(P.ws + WS_SSQ)};
    SchedG2 S{XOrder{P.G, P.bid, MT, 16}};
    pg8::gemm_phase<EpiP, SchedG2, false>(P.tid, lds, g, S, E);
}
__device__ __forceinline__ void phase_g3(const Ptrs P, int l, LAS unsigned char* lds) {
    const int MT = ((l == NLAYER - 1) ? NLAT : T) / 256;
    pg8::Gemm g{(const bf16_t*)(P.ws + WS_HBUF), (const bf16_t*)(P.ws + WS_WG), D};
    EpiMerge E{(const bf16_t*)(P.ws + WS_BIG + BIG_P), (const float*)(P.ws + WS_BGP), (bf16_t*)(P.ws + WS_BR)};
    SchedMN S{XOrder{P.G, P.bid, MT, 16}};
    pg8::gemm_phase<EpiMerge, SchedMN, false>(P.tid, lds, g, S, E);
}
__device__ __forceinline__ void phase_g4(const Ptrs P, int l, LAS unsigned char* lds) {
    const int MT = ((l == NLAYER - 1) ? NLAT : T) / 256;
    pg8::Gemm g{(const bf16_t*)(P.ws + WS_BR), (const bf16_t*)(P.ws + WS_WO), D};
    EpiWo E{P, l};
    SchedMN S{XOrder{P.G, P.bid, MT, 4}};
    pg8::gemm_phase<EpiWo, SchedMN, false>(P.tid, lds, g, S, E);
    dyn_tiles(P.tid, (unsigned*)(P.ws + WS_CTL + CTL_DYN) + l, NCONV_EX, (volatile LAS unsigned*)(lds + LDS_MISC + 64), ConvEx{P, l, (LAS float*)lds});
}

__device__ __forceinline__ void phase_e5(const Ptrs P, int l, LAS unsigned char* lds) {
    const int tid = P.tid, wid = tid >> 6, lane = tid & 63, G = P.G, fr = lane & 15, fq = lane >> 4;
    const int rows_l = (l == NLAYER - 1) ? NLAT : T;
    LAS bf16_t* wrH = (LAS bf16_t*)lds;
    LAS bf16_t* wrL = wrH + 16 * 1032;
    LAS float* lgs = (LAS float*)(lds + 136192);
    LAS unsigned* lcnt = (LAS unsigned*)(lds + 144896); LAS unsigned* gbase = lcnt + 16; LAS int* rec = (LAS int*)(lcnt + 32);
    for (int i = tid; i < 1024 * 16; i += 512) { const int k = i >> 4, e = i & 15; const float w = P.inp(I_WROUTER)[i]; const unsigned hi = pack2(w, 0.f) & 0xffffu; const float lo = w - __uint_as_float(hi << 16);
        wrH[e * 1032 + k] = (bf16_t)hi; wrL[e * 1032 + k] = f2bf(lo); }
    if (tid < 16) lcnt[tid] = 0u;
    __syncthreads();
    unsigned* cnt = (unsigned*)(P.ws + WS_CTL + CTL_CNT) + l * 16;
    int* toke = (int*)(P.ws + WS_TOKE); float* tokw = (float*)(P.ws + WS_TOKW); int* toks = (int*)(P.ws + WS_TOKS); int* list = (int*)(P.ws + WS_LIST);
    const float* g = P.inp(I_LN1G) + l * D; const float* bta = P.inp(I_LN1B) + l * D;
    bf16_t* H2 = (bf16_t*)(P.ws + WS_HBUF);
    const int NU_R = rows_l / 8;
    int nloc = 0;
    {
        RowV lng, lnb; row_load(lng, g, lane); row_load(lnb, bta, lane);
        RowV rn; { const float z = zero_f(); for (int i = 0; i < 4; ++i) rn.v[i] = (f32x4){z, z, z, z}; } if (P.bid < NU_R) row_load(rn, P.latrow(P.bid * 8 + wid), lane);
        RowV msh, msc; { const float z = zero_f(); for (int i = 0; i < 4; ++i) { msh.v[i] = (f32x4){z, z, z, z}; msc.v[i] = msh.v[i]; } } int mcur = -1;
        for (int u = P.bid; u < NU_R; u += G) {
            const int row = u * 8 + wid; RowV r = rn;
            if (u + G < NU_R) row_load(rn, P.latrow((u + G) * 8 + wid), lane);
            row_layernorm_r(r, lng, lnb);
            const int mi = row_modidx(row); if (mi != mcur) { mcur = mi; const float* m = P.mod(l, mi); row_load(msh, m + 3072, lane); row_load(msc, m + 4096, lane); }
            RowV h; row_modulate_r(r, h, msh, msc);
            row_store_bf16(h, H2 + (size_t)row * D, lane);
            ++nloc;
        }
    }
    asm volatile("s_waitcnt vmcnt(0)" ::: "memory");
    __syncthreads();
    {
        const int ntile = (nloc + 1) >> 1; LAS float* lg = lgs + wid * 16 * 17;
        for (int t = wid; t < ntile; t += 8) {
            int it = 2 * t + (fr >> 3); const bool valid_a = it < nloc; if (!valid_a) it = nloc - 1;
            const bf16_t* ap = H2 + (size_t)((P.bid + G * it) * 8 + (fr & 7)) * D + 8 * fq;
            f32x4 acc = (f32x4){0.f, 0.f, 0.f, 0.f};
#pragma unroll 4
            for (int ks = 0; ks < 32; ++ks) { const bf16x8 a = *(const bf16x8*)(ap + 32 * ks);
                const bf16x8 bh = *(const LAS bf16x8*)(wrH + fr * 1032 + 32 * ks + 8 * fq), bl = *(const LAS bf16x8*)(wrL + fr * 1032 + 32 * ks + 8 * fq);
                acc = __builtin_amdgcn_mfma_f32_16x16x32_bf16(a, bh, acc, 0, 0, 0); acc = __builtin_amdgcn_mfma_f32_16x16x32_bf16(a, bl, acc, 0, 0, 0); }
#pragma unroll
            for (int r = 0; r < 4; ++r) lg[(4 * fq + r) * 17 + fr] = acc[r];
            const int it2 = 2 * t + (lane >> 3); const bool act = (lane < 16) && (it2 < nloc);
            if (act) {
                const int row = (P.bid + G * it2) * 8 + (lane & 7);
                float lgv[16];
#pragma unroll
                for (int e = 0; e < 16; ++e) lgv[e] = lg[lane * 17 + e];
                float mx = lgv[0];
#pragma unroll
                for (int e = 1; e < 16; ++e) mx = fmaxf(mx, lgv[e]);
                float sc[16], sel[16], ssum = 0.f;
#pragma unroll
                for (int e = 0; e < 16; ++e) { sc[e] = fexp(lgv[e] - mx); ssum += sc[e]; }
                const float inv = 1.0f / ssum;
#pragma unroll
                for (int e = 0; e < 16; ++e) { sc[e] *= inv; sel[e] = sc[e] + P.inp(I_BROUTER)[e]; }
                int bestg = 0; float bestgs = -3.0e38f;
#pragma unroll
                for (int gq = 0; gq < 4; ++gq) { float m1 = -3.0e38f, m2 = -3.0e38f;
#pragma unroll
                    for (int j = 0; j < 4; ++j) { const float v = sel[gq * 4 + j]; if (v > m1) { m2 = m1; m1 = v; } else if (v > m2) m2 = v; }
                    const float gs = m1 + m2; if (gs > bestgs) { bestgs = gs; bestg = gq; } }
                int i1 = 0, i2 = 0; float v1 = -3.0e38f, v2 = -3.0e38f, w1 = 0.f, w2 = 0.f;
#pragma unroll
                for (int e = 0; e < 16; ++e) { if ((e >> 2) == bestg && sel[e] > v1) { v1 = sel[e]; i1 = e; w1 = sc[e]; } }
#pragma unroll
                for (int e = 0; e < 16; ++e) { if ((e >> 2) == bestg && e != i1 && sel[e] > v2) { v2 = sel[e]; i2 = e; w2 = sc[e]; } }
                const float ws_ = 1.0f / (w1 + w2);
                const int s1 = (int)__hip_atomic_fetch_add(lcnt + i1, 1u, __ATOMIC_RELAXED, __HIP_MEMORY_SCOPE_WORKGROUP);
                const int s2 = (int)__hip_atomic_fetch_add(lcnt + i2, 1u, __ATOMIC_RELAXED, __HIP_MEMORY_SCOPE_WORKGROUP);
                const int idx = it2 * 8 + (lane & 7); rec[idx * 3] = i1 | (i2 << 8); rec[idx * 3 + 1] = s1; rec[idx * 3 + 2] = s2;
                toke[row * 2] = i1; toke[row * 2 + 1] = i2; tokw[row * 2] = w1 * ws_; tokw[row * 2 + 1] = w2 * ws_;
            }
        }
    }
    __syncthreads();
    if (tid < 16) gbase[tid] = __hip_atomic_fetch_add(cnt + tid, lcnt[tid], __ATOMIC_RELAXED, __HIP_MEMORY_SCOPE_AGENT);
    __syncthreads();
    for (int idx = tid; idx < nloc * 8; idx += 512) { const int row = (P.bid + G * (idx >> 3)) * 8 + (idx & 7); const int ee = rec[idx * 3]; const int e1 = ee & 255, e2 = ee >> 8;
        const int s1 = (int)gbase[e1] + rec[idx * 3 + 1], s2 = (int)gbase[e2] + rec[idx * 3 + 2];
        list[(size_t)e1 * T + s1] = row; list[(size_t)e2 * T + s2] = row; toks[row * 2] = s1; toks[row * 2 + 1] = s2; }
}

struct MoeSeg { int toff[17]; };
__device__ __forceinline__ void moe_seg(const unsigned* cnt, MoeSeg& S) { int a = 0;
#pragma unroll
    for (int e = 0; e < 16; ++e) { S.toff[e] = a; a += __builtin_amdgcn_readfirstlane(((int)cnt[e] + 255) >> 8); }
    S.toff[16] = a; }
__device__ __forceinline__ int moe_find(const MoeSeg& S, int tg, int& off) { int e = 0; off = 0;
#pragma unroll
    for (int j = 1; j < 16; ++j) { const bool ge = (tg >= S.toff[j]); e += ge ? 1 : 0; off = ge ? S.toff[j] : off; }
    return e; }

struct SchedMoe { int G, c; MoeSeg S; const int* list; const unsigned* cnt;
    __device__ __forceinline__ bool next(int i, Unit& u) const { const int L = i * G + c; if (L >= S.toff[16] * 4) return false; const int tg = L >> 2, pnn = L & 3; int off; const int e = moe_find(S, tg, off);
        u.pm = tg; u.pn = e * 4 + pnn; u.e = e; u.aux = tg - off; return true; }
    __device__ __forceinline__ int arow(const Unit& u, int R) const { const int idx = u.aux * 256 + R; const int* l = list + (size_t)u.e * T; return idx < (int)cnt[u.e] ? l[idx] : l[0]; } };
__device__ __forceinline__ void phase_g5(const Ptrs P, int l, LAS unsigned char* lds) {
    const unsigned* cnt = (const unsigned*)(P.ws + WS_CTL + CTL_CNT) + l * 16;
    SchedMoe S; S.G = P.G; S.c = P.bid; moe_seg(cnt, S.S); S.list = (const int*)(P.ws + WS_LIST); S.cnt = cnt;
    pg8::Gemm g{(const bf16_t*)(P.ws + WS_HBUF), (const bf16_t*)(P.ws + WS_BIG + BIG_W13), D};
    EpiFfn1 E{(bf16_t*)(P.ws + WS_BIG + BIG_HID)};
    pg8::gemm_phase<EpiFfn1, SchedMoe, true>(P.tid, lds, g, S, E);
    if (l != NLAYER - 1) dyn_tiles(P.tid, (unsigned*)(P.ws + WS_CTL + CTL_DYN) + 8 + l, NCONV_NE, (volatile LAS unsigned*)(lds + LDS_MISC + 64), ConvNe{P, l + 1, (LAS float*)lds});
}
__device__ __forceinline__ void phase_g6(const Ptrs P, int l, LAS unsigned char* lds) {
    const unsigned* cnt = (const unsigned*)(P.ws + WS_CTL + CTL_CNT) + l * 16;
    SchedMoe S; S.G = P.G; S.c = P.bid; moe_seg(cnt, S.S); S.list = (const int*)(P.ws + WS_LIST); S.cnt = cnt;
    pg8::Gemm g{(const bf16_t*)(P.ws + WS_BIG + BIG_HID), (const bf16_t*)(P.ws + WS_BIG + BIG_W2), 512};
    EpiBf16Plain E{(bf16_t*)(P.ws + WS_BIG + BIG_YE), 1024, 3};
    pg8::gemm_phase<EpiBf16Plain, SchedMoe, false>(P.tid, lds, g, S, E);
}

__device__ __forceinline__ void phase_e8(const Ptrs P, int l, LAS unsigned char* lds) {
    const int tid = P.tid, wid = tid >> 6, lane = tid & 63, G = P.G;
    const bool last = (l == NLAYER - 1); const int rows_l = last ? NLAT : T;
    LAS float* wdt = (LAS float*)lds;
    if (!last) load_wdt(P, l + 1, wdt);
    const unsigned* cnt = (const unsigned*)(P.ws + WS_CTL + CTL_CNT) + l * 16; MoeSeg S; moe_seg(cnt, S);
    const int* toke = (const int*)(P.ws + WS_TOKE); const float* tokw = (const float*)(P.ws + WS_TOKW); const int* toks = (const int*)(P.ws + WS_TOKS);
    const bf16_t* YE = (const bf16_t*)(P.ws + WS_BIG + BIG_YE);
    const float* g = P.inp(I_LN2G) + l * D; const float* bta = P.inp(I_LN2B) + l * D; const float* g1p = P.inp(I_LN1G) + l * D; const float* b1p = P.inp(I_LN1B) + l * D;
    const int NU_R = rows_l / 8;
    RowV lng, lnb; row_load(lng, g, lane); row_load(lnb, bta, lane);
    RowV mg2, msh, msc; { const float z = zero_f(); for (int i = 0; i < 4; ++i) { mg2.v[i] = (f32x4){z, z, z, z}; msh.v[i] = mg2.v[i]; msc.v[i] = mg2.v[i]; } } int mcur = -1;
    RowV rn; { const float z = zero_f(); for (int i = 0; i < 4; ++i) rn.v[i] = (f32x4){z, z, z, z}; } int te1 = 0, te2 = 0, ts1 = 0, ts2 = 0; float tw1 = 0.f, tw2 = 0.f;
    if (P.bid < NU_R) { const int row = P.bid * 8 + wid; row_load(rn, P.latrow(row), lane); te1 = toke[row * 2]; te2 = toke[row * 2 + 1]; tw1 = tokw[row * 2]; tw2 = tokw[row * 2 + 1]; ts1 = toks[row * 2]; ts2 = toks[row * 2 + 1]; }
    for (int u = P.bid; u < NU_R; u += G) {
        const int row = u * 8 + wid; RowV r = rn; float* lp = P.latrow(row);
        row_layernorm(r, g1p, b1p, lane);
        const int e1 = te1, e2 = te2; const float w1 = tw1, w2 = tw2;
        int o1 = 0, o2 = 0;
#pragma unroll
        for (int e = 0; e < 16; ++e) { o1 = (e == e1) ? S.toff[e] : o1; o2 = (e == e2) ? S.toff[e] : o2; }
        const bf16_t* y1 = YE + ((size_t)o1 * 256 + ts1) * 1024; const bf16_t* y2 = YE + ((size_t)o2 * 256 + ts2) * 1024;
        u32x2 ya[4], yb[4];
#pragma unroll
        for (int i = 0; i < 4; ++i) { ya[i] = *(const u32x2*)(y1 + i * 256 + lane * 4); yb[i] = *(const u32x2*)(y2 + i * 256 + lane * 4); }
        if (u + G < NU_R) { const int rw = (u + G) * 8 + wid; row_load(rn, P.latrow(rw), lane); te1 = toke[rw * 2]; te2 = toke[rw * 2 + 1]; tw1 = tokw[rw * 2]; tw2 = tokw[rw * 2 + 1]; ts1 = toks[rw * 2]; ts2 = toks[rw * 2 + 1]; }
        const int mi = row_modidx(row);
        if (mi != mcur) { mcur = mi; row_load(mg2, P.mod(l, mi) + 5120, lane); if (!last) { const float* m2 = P.mod(l + 1, mi); row_load(msh, m2, lane); row_load(msc, m2 + 1024, lane); } }
#pragma unroll
        for (int i = 0; i < 4; ++i) { const u32x2 a = ya[i], b = yb[i];
            const f32x4 g2 = mg2.v[i];
            f32x4 mo; mo[0] = w1 * __uint_as_float(a.x << 16) + w2 * __uint_as_float(b.x << 16); mo[1] = w1 * __uint_as_float(a.x & 0xffff0000u) + w2 * __uint_as_float(b.x & 0xffff0000u);
            mo[2] = w1 * __uint_as_float(a.y << 16) + w2 * __uint_as_float(b.y << 16); mo[3] = w1 * __uint_as_float(a.y & 0xffff0000u) + w2 * __uint_as_float(b.y & 0xffff0000u);
            r.v[i] = r.v[i] * ALPHA + g2 * mo; }
        row_layernorm_r(r, lng, lnb);
        row_store(r, lp, lane);
        if (!last) { RowV h; row_modulate_r(r, h, msh, msc);
            row_store_bf16(h, (bf16_t*)(P.ws + WS_HBUF) + (size_t)row * D, lane); row_dt(h, wdt, (float*)(P.ws + WS_DT) + (size_t)row * 8, lane); }
    }
}

constexpr int NPH_LAYER = 11, NPH = 2 + NLAYER * NPH_LAYER;
__global__ void __launch_bounds__(512, 2) fwd_kernel(Args a) {
    extern __shared__ __attribute__((aligned(16))) unsigned char lds_raw[];
    LAS unsigned char* lds = (LAS unsigned char*)lds_raw;
    const int lo = a.ph_lo, hi = a.ph_hi;
    volatile LAS unsigned* xbw = (volatile LAS unsigned*)(lds + LDS_MISC);
    const int wave_s = __builtin_amdgcn_readfirstlane((int)threadIdx.x >> 6);
    if (threadIdx.x < 4) xbw[threadIdx.x] = 0u;
    __syncthreads();
    XcdBarrier bar; bar.bar = (unsigned*)(a.ws + WS_CTL); bar.x = 0; bar.st = xbw;
    if (hi - lo > 1) bar = xcd_barrier_post((unsigned*)(a.ws + WS_CTL), xbw, wave_s);
#ifndef PH_MASK
#define PH_MASK 0xFFFFFFFFu
#endif
#ifndef PROBE_PH
#define PROBE_PH (-1)
#define PROBE_N 1
#endif
#define REP(id) for (int rep_ = 0; rep_ < ((PROBE_PH == (id)) ? PROBE_N : 1); ++rep_)
#define PH_ON(id) (((PH_MASK) >> (id)) & 1u)
#define IN(k) (lo <= (k) && (k) < hi)
#define FRESH() Ptrs Pq; { const AS4 char* ka_ = (const AS4 char*)__builtin_amdgcn_kernarg_segment_ptr(); AS1 float* o_ = *(AS1 float* const AS4*)(ka_ + 8 * N_IN); AS1 unsigned char* w_ = *(AS1 unsigned char* const AS4*)(ka_ + 8 * N_IN + 8); int l_ = lcur; asm volatile("" : "+s"(o_), "+s"(w_), "+s"(l_) :: "memory"); Pq.out = (float*)o_; Pq.ws = (unsigned char*)w_; lq = l_; int ws_ = wave_s, b_ = blockIdx.x, g_ = gridDim.x; asm volatile("" : "+s"(ws_), "+s"(b_), "+s"(g_)); int ln_ = lane_id(); asm volatile("" : "+v"(ln_)); int t_ = ws_ * 64 + ln_; Pq.tid = t_; Pq.bid = b_; Pq.G = g_; }
#define SEAM(k) do { if (IN(k) && IN((k) + 1)) xcd_barrier(bar, wave_s); } while (0)
    int lcur = 0, lq = 0;
    if (PH_ON(0) && IN(0)) REP(0) { FRESH(); phase_pa(Pq, lds); } SEAM(0);
    if (PH_ON(1) && IN(1)) REP(1) { FRESH(); phase_pb(Pq, lds); } SEAM(1);
    for (int l = 0; l < NLAYER; ++l) {
        const int b = 2 + l * NPH_LAYER; lcur = l;
        if (PH_ON(2) && IN(b + 0)) REP(2) { FRESH(); phase_g1(Pq, lds); } SEAM(b + 0);
        for (int g_ = 0; g_ < ((PROBE_PH == 100) ? PROBE_N : 1); ++g_) {
        if (PH_ON(3) && IN(b + 1)) REP(3) { FRESH(); phase_m1(Pq, lq, lds); } SEAM(b + 1);
        if (PH_ON(4) && IN(b + 2)) REP(4) { FRESH(); phase_m2(Pq, lq, lds); } SEAM(b + 2);
        if (PH_ON(5) && IN(b + 3)) REP(5) { FRESH(); phase_m3(Pq, lq, lds); } SEAM(b + 3);
        }
        if (PH_ON(6) && IN(b + 4)) REP(6) { FRESH(); phase_g2(Pq, lq, lds); } SEAM(b + 4);
        if (PH_ON(7) && IN(b + 5)) REP(7) { FRESH(); phase_g3(Pq, lq, lds); } SEAM(b + 5);
        if (PH_ON(8) && IN(b + 6)) REP(8) { FRESH(); phase_g4(Pq, lq, lds); } SEAM(b + 6);
        if (PH_ON(9) && IN(b + 7)) REP(9) { FRESH(); phase_e5(Pq, lq, lds); } SEAM(b + 7);
        if (PH_ON(10) && IN(b + 8)) REP(10) { FRESH(); phase_g5(Pq, lq, lds); } SEAM(b + 8);
        if (PH_ON(11) && IN(b + 9)) REP(11) { FRESH(); phase_g6(Pq, lq, lds); } SEAM(b + 9);
        if (PH_ON(12) && IN(b + 10)) REP(12) { FRESH(); phase_e8(Pq, lq, lds); } SEAM(b + 10);
    }
#undef IN
#undef SEAM
}
}

extern "C" void kernel_launch(void* const* d_in, const int* in_sizes, int n_in, void* d_out, int out_size, void* d_ws, size_t ws_size, hipStream_t stream) {
    static int grid = 0;
    if (grid == 0) {
        if (n_in != N_IN || out_size != NLAT * D || ws_size < WS_END) { fprintf(stderr, "kernel_launch: unexpected shapes / workspace (%d inputs, out %d, ws %zu < %zu)\n", n_in, out_size, ws_size, (size_t)WS_END); grid = -1; return; }
        int dev = 0, cus = 0, per_cu = 0;
        if (hipGetDevice(&dev) != hipSuccess || hipDeviceGetAttribute(&cus, hipDeviceAttributeMultiprocessorCount, dev) != hipSuccess) { grid = -1; return; }
        if (hipFuncSetAttribute((const void*)fwd_kernel, hipFuncAttributeMaxDynamicSharedMemorySize, LDS_BYTES) != hipSuccess) { fprintf(stderr, "kernel_launch: hipFuncSetAttribute failed\n"); grid = -1; return; }
        if (hipOccupancyMaxActiveBlocksPerMultiprocessor(&per_cu, (const void*)fwd_kernel, 512, LDS_BYTES) != hipSuccess || per_cu < 1) { fprintf(stderr, "kernel_launch: occupancy query says %d\n", per_cu); }
        (void)hipGetLastError();
        grid = cus;
    }
    if (grid < 0) return;
    (void)hipMemsetAsync((char*)d_ws + WS_CTL, 0, CTL_BYTES, stream);
    Args a{};
    for (int i = 0; i < N_IN; ++i) a.in[i] = (const float*)d_in[i];
    a.out = (float*)d_out; a.ws = (unsigned char*)d_ws;
#if N_LAUNCH_MODE == 1
    a.ph_lo = 0; a.ph_hi = NPH;
    hipLaunchKernelGGL(fwd_kernel, dim3(grid), dim3(512), LDS_BYTES, stream, a);
#else
    for (int p = 0; p < NPH; ++p) { a.ph_lo = p; a.ph_hi = p + 1; hipLaunchKernelGGL(fwd_kernel, dim3(grid), dim3(512), LDS_BYTES, stream, a); }
#endif
}
```

```cpp
#include <hip/hip_runtime.h>
#include <cstdio>
#include <cstdint>

#ifndef N_LAUNCH_MODE
#define N_LAUNCH_MODE 1
#endif

namespace {
typedef unsigned short bf16_t;
typedef short bf16x8 __attribute__((ext_vector_type(8)));
typedef float f32x4 __attribute__((ext_vector_type(4)));
typedef unsigned u32x2 __attribute__((ext_vector_type(2)));
typedef unsigned u32x4 __attribute__((ext_vector_type(4)));
#define LAS __attribute__((address_space(3)))

constexpr int D = 1024, NB = 8, SEQ = 4096, CTXL = 256, NLAT = NB * SEQ, NCTX = NB * CTXL, T = NLAT + NCTX;
constexpr int NLAYER = 2;
constexpr int UC = 3584;
constexpr int INC = 3592;
constexpr int NE = 16;
constexpr float ALPHA = 1.41421356237309515f;
constexpr float LN_EPS = 1e-5f, RMS_EPS = 1e-6f;
constexpr int MAXTILES = 288;

enum { I_X = 0, I_C, I_CTX, I_CCTX, I_WADA, I_BADA, I_WIN, I_HYCW, I_HYCB, I_HYW1, I_HYB1, I_HYF1, I_HYW2, I_HYB2, I_HYF2, I_HYW3, I_HYDEC, I_HYBIAS,
       I_SCCW, I_HGLB, I_HGNG, I_SSDCW, I_SSDCB, I_SSDALOG, I_SSDDTB, I_SSDD, I_SSDNG, I_WGATE, I_BGATE, I_WBR, I_WO, I_LN1G, I_LN1B, I_LN2G, I_LN2B,
       I_WROUTER, I_BROUTER, I_WE1, I_WE3, I_WE2, N_IN };

constexpr size_t al256(size_t x) { return (x + 255) & ~(size_t)255; }
constexpr size_t WS_CTL = 0;
constexpr size_t CTL_BYTES = 65536;
constexpr size_t CTL_CNT = 16384;
constexpr size_t CTL_DYN = 20480;
constexpr size_t WS_MOD = WS_CTL + CTL_BYTES;
constexpr size_t WS_LB = WS_MOD + al256((size_t)NLAYER * 9 * 6144 * 4);
constexpr size_t WS_TW = WS_LB + 4096;
constexpr size_t WS_H2TAB = WS_TW + 65536;
constexpr size_t WS_PART = WS_H2TAB + (size_t)8448 * 64 * 4;
constexpr size_t WS_FILT = WS_PART + (size_t)3 * 64 * 512 * 4;
constexpr size_t WS_FILTC = WS_FILT + (size_t)2 * 8192 * 256 * 4;
constexpr size_t WS_CX32 = WS_FILTC + (size_t)512 * 256 * 4;
constexpr size_t WS_DT = WS_CX32 + (size_t)NCTX * D * 4;
constexpr size_t WS_SSQ = WS_DT + (size_t)T * 8 * 4;
constexpr size_t WS_TOKE = WS_SSQ + (size_t)T * 4 * 4;
constexpr size_t WS_TOKW = WS_TOKE + (size_t)T * 2 * 4;
constexpr size_t WS_TOKS = WS_TOKW + (size_t)T * 2 * 4;
constexpr size_t WS_LIST = WS_TOKS + (size_t)T * 2 * 4;
constexpr size_t WS_BGP = WS_LIST + (size_t)NE * T * 4;
constexpr size_t WS_DEC = WS_BGP + 16384;
constexpr size_t WS_WIN = WS_DEC + (size_t)4352 * 64 * 4;
constexpr size_t WS_WG = WS_WIN + (size_t)UC * D * 2;
constexpr size_t WS_WBR = WS_WG + (size_t)4096 * D * 2;
constexpr size_t WS_WO = WS_WBR + (size_t)4096 * 256 * 2;
constexpr size_t WS_HBUF = WS_WO + (size_t)D * D * 2;
constexpr size_t WS_BR = WS_HBUF + (size_t)T * D * 2;
constexpr size_t WS_BIG = WS_BR + (size_t)T * D * 2;
constexpr size_t BIG_U = 0;
constexpr size_t BIG_HGO = BIG_U + (size_t)T * UC * 2;
constexpr size_t BIG_STATE = BIG_HGO;
constexpr size_t BIG_SSY = BIG_HGO + (size_t)T * 256 * 4;
constexpr size_t BIG_WT = BIG_SSY + (size_t)T * 256 * 4;
constexpr size_t BIG_END1 = BIG_WT + (size_t)T * 256 * 2;
constexpr size_t BIG_P = 0;
constexpr size_t BIG_HID = 0;
constexpr size_t BIG_YE = BIG_HID + (size_t)MAXTILES * 256 * 512 * 2;
constexpr size_t BIG_W13 = BIG_YE + (size_t)MAXTILES * 256 * 1024 * 2;
constexpr size_t BIG_W2 = BIG_W13 + (size_t)NE * 1024 * 1024 * 2;
constexpr size_t BIG_END3 = BIG_W2 + (size_t)NE * 1024 * 512 * 2;
constexpr size_t BIG_BYTES = BIG_END1 > BIG_END3 ? BIG_END1 : BIG_END3;
constexpr size_t WS_END = WS_BIG + BIG_BYTES;
static_assert((size_t)T * 4096 * 2 <= BIG_BYTES, "P fits");
static_assert(WS_END <= (size_t)536870912, "workspace budget");

constexpr int LDS_BYTES = 147456;
constexpr int LDS_MISC = 147456 - 256;

struct Args { const float* in[N_IN]; float* out; unsigned char* ws; int ph_lo, ph_hi; };

#define XB_TMO      128
#define XB_XCNT(j)  (256  + 64 * (j))
#define XB_XSUB(j)  (1280 + 64 * (j))
#define XB_XGEN(j)  (2304 + 64 * (j))
#define XB_TOP      3328
#define XB_TOPGEN   3392
#define XCD_BAR_WORDS 3456
#define XB_SPIN_CAP (1u << 18)
__device__ __forceinline__ unsigned xb_ld(unsigned* p)              { return __hip_atomic_load(p, __ATOMIC_RELAXED, __HIP_MEMORY_SCOPE_AGENT); }
__device__ __forceinline__ unsigned xb_add(unsigned* p, unsigned v) { return __hip_atomic_fetch_add(p, v, __ATOMIC_RELAXED, __HIP_MEMORY_SCOPE_AGENT); }
__device__ __forceinline__ unsigned xb_xcc_id() { return (unsigned)__builtin_amdgcn_s_getreg((3 << 11) | 20) & 0xFu; }
#define XB_SPIN(cond, bar) do { unsigned _sp = 0; while (cond) { __builtin_amdgcn_s_sleep(1); \
    if ((++_sp & 255u) == 0u) { if (xb_ld(&(bar)[XB_TMO])) break; if (_sp > XB_SPIN_CAP) { atomicAdd(&(bar)[XB_TMO], 1u); break; } } } } while (0)
struct XcdBarrier { unsigned* bar; unsigned x; volatile LAS unsigned* st; };
__device__ __forceinline__ int lane_id() { unsigned z = 0u; asm volatile("" : "+v"(z)); return (int)__builtin_amdgcn_mbcnt_hi(~0u, __builtin_amdgcn_mbcnt_lo(~0u, z)); }
__device__ __forceinline__ bool is_thread0(int wave_s) { return wave_s == 0 && lane_id() == 0; }
__device__ __forceinline__ XcdBarrier xcd_barrier_post(unsigned* bar, volatile LAS unsigned* st, int wave_s) {
    XcdBarrier b; b.bar = bar; b.x = xb_xcc_id(); b.st = st;
    if (is_thread0(wave_s)) (void)xb_add(&bar[XB_XCNT(b.x)], 1u);
    return b;
}
__device__ __forceinline__ void xcd_barrier_complete(unsigned* bar, unsigned x, unsigned& nloc, unsigned& nx) {
    const unsigned G = gridDim.x * gridDim.y * gridDim.z;
    unsigned sum, cnt, mine, sp = 0u;
    for (;;) {
        sum = 0u; cnt = 0u; mine = 0u;
#pragma unroll
        for (unsigned j = 0; j < 16; ++j) { const unsigned c = xb_ld(&bar[XB_XCNT(j)]); sum += c; cnt += (c > 0u) ? 1u : 0u; mine = (j == x) ? c : mine; }
        if (sum == G) break;
        __builtin_amdgcn_s_sleep(1);
        if ((++sp & 255u) == 0u) { if (xb_ld(&bar[XB_TMO])) break; if (sp > XB_SPIN_CAP) { atomicAdd(&bar[XB_TMO], 1u); break; } }
    }
    nloc = mine > 0u ? mine : 1u; nx = cnt > 0u ? cnt : 1u;
}
__device__ __forceinline__ void xcd_barrier(const XcdBarrier& b, int wave_s) {
    asm volatile("s_waitcnt vmcnt(0)" ::: "memory");
    __syncthreads();
    if (is_thread0(wave_s)) {
        unsigned* bar = b.bar;
        __builtin_amdgcn_s_waitcnt(0);
        unsigned nloc = b.st[0], nx = b.st[1];
        if (nloc == 0u) { xcd_barrier_complete(bar, b.x, nloc, nx); b.st[0] = nloc; b.st[1] = nx; }
        const unsigned old = xb_add(&bar[XB_XSUB(b.x)], 1u);
        const unsigned gen = old / nloc;
        if (old + 1u == (gen + 1u) * nloc) {
            __builtin_amdgcn_fence(__ATOMIC_RELEASE, "agent");
            asm volatile("s_waitcnt vmcnt(0)" ::: "memory");
            const unsigned og = xb_add(&bar[XB_TOP], 1u);
            const unsigned tg = og / nx;
            if (og + 1u == (tg + 1u) * nx) xb_add(&bar[XB_TOPGEN], 1u);
            else XB_SPIN(xb_ld(&bar[XB_TOPGEN]) == tg, bar);
            __builtin_amdgcn_fence(__ATOMIC_ACQUIRE, "agent");
            xb_add(&bar[XB_XGEN(b.x)], 1u);
            asm volatile("s_waitcnt vmcnt(0)" ::: "memory");
        } else {
            XB_SPIN(xb_ld(&bar[XB_XGEN(b.x)]) == gen, bar);
            __builtin_amdgcn_fence(__ATOMIC_ACQUIRE, "agent");
            asm volatile("s_waitcnt vmcnt(0)" ::: "memory");
        }
    }
    __syncthreads();
}

__device__ __forceinline__ float bf2f(bf16_t b) { return __uint_as_float(((unsigned)b) << 16); }
typedef __bf16 hwbf2 __attribute__((ext_vector_type(2)));
typedef float hwf2 __attribute__((ext_vector_type(2)));
__device__ __forceinline__ unsigned pack2(float lo, float hi) { const hwf2 v = {lo, hi}; return __builtin_bit_cast(unsigned, __builtin_convertvector(v, hwbf2)); }
__device__ __forceinline__ bf16_t f2bf(float f) { return (bf16_t)(pack2(f, 0.f) & 0xffffu); }
__device__ __forceinline__ float zero_f() { float z = 0.f; asm volatile("" : "+v"(z)); return z; }
__device__ __forceinline__ float kconst(float c) { asm volatile("" : "+s"(c)); return c; }
__device__ __forceinline__ float fexp(float x) { return __builtin_amdgcn_exp2f(x * kconst(1.4426950408889634f)); }
__device__ __forceinline__ float flog(float x) { return __builtin_amdgcn_logf(x) * kconst(0.6931471805599453f); }
__device__ __forceinline__ float sigmoidf_(float x) { return __builtin_amdgcn_rcpf(1.0f + fexp(-x)); }
__device__ __forceinline__ float siluf_(float x) { return x * sigmoidf_(x); }
__device__ __forceinline__ float wave_sum(float v) {
#pragma unroll
    for (int o = 32; o >= 1; o >>= 1) v += __shfl_xor(v, o);
    return v;
}
__device__ __forceinline__ int row_modidx(int r) { return r < NLAT ? (r >> 12) : 8; }
__device__ __forceinline__ bool row_has_prev(int r) { return r < NLAT ? ((r & 4095) != 0) : (((r - NLAT) & 255) != 0); }
__device__ __forceinline__ bool row_has_next(int r) { return r < NLAT ? ((r & 4095) != 4095) : (((r - NLAT) & 255) != 255); }

#define AS1 __attribute__((address_space(1)))
#define AS4 __attribute__((address_space(4)))
struct Ptrs {
    float* out; unsigned char* ws; int tid, bid, G;
    __device__ __forceinline__ const float* inp(int i) const { asm volatile("" : "+s"(i));
        const __attribute__((address_space(4))) char* ka = (const __attribute__((address_space(4))) char*)__builtin_amdgcn_kernarg_segment_ptr();
        return (const float*)(*(const AS1 float* const AS4*)(ka + 8 * i)); }
    __device__ __forceinline__ float* latrow(int r) const { return r < NLAT ? out + (size_t)r * D : (float*)(ws + WS_CX32) + (size_t)(r - NLAT) * D; }
    __device__ __forceinline__ float* mod(int l, int ridx) const { return (float*)(ws + WS_MOD) + ((size_t)l * 9 + ridx) * 6144; }
};

__device__ __forceinline__ float conv3_u(const bf16_t* U, int row, int col, const float* w, int ncol, int wcol) {
    const bool hp = row_has_prev(row), hn = row_has_next(row);
    const float c = bf2f(U[(size_t)row * UC + col]), p = bf2f(U[(size_t)(hp ? row - 1 : row) * UC + col]), n = bf2f(U[(size_t)(hn ? row + 1 : row) * UC + col]);
    return c * w[ncol + wcol] + (hp ? p * w[wcol] : 0.f) + (hn ? n * w[2 * ncol + wcol] : 0.f);
}

struct Unit { int pm, pn, e, aux; };
__host__ __device__ __forceinline__ int perm32(int rho) { const int n = rho >> 4, i = rho & 15; return 8 * (i >> 2) + 4 * n + (i & 3); }

template <class RowMap, class Epi>
__device__ __forceinline__ void sgemm_unit(int tid_, const bf16_t* __restrict__ A, int lda, const bf16_t* __restrict__ Bt, int ldb, int K, const Unit& u, const RowMap& RM, const Epi& E) {
    const int tid = tid_, wid = tid >> 6, lane = tid & 63, wr = wid >> 2, wc = wid & 3, fr = lane & 15, fq = lane >> 4;
    f32x4 acc[2][2][4][2];
#pragma unroll
    for (int a = 0; a < 2; ++a)
#pragma unroll
        for (int b = 0; b < 2; ++b)
#pragma unroll
            for (int m = 0; m < 4; ++m)
#pragma unroll
                for (int n = 0; n < 2; ++n) acc[a][b][m][n] = (f32x4){0.f, 0.f, 0.f, 0.f};
    unsigned ap[2][4], bp[2][2];
#pragma unroll
    for (int a = 0; a < 2; ++a)
#pragma unroll
        for (int m = 0; m < 4; ++m) ap[a][m] = (unsigned)RM(u, 128 * a + 64 * wr + 16 * m + fr) * (unsigned)lda + fq * 8;
#pragma unroll
    for (int b = 0; b < 2; ++b)
#pragma unroll
        for (int n = 0; n < 2; ++n) { const int rho = 16 * n + fr; const int col = Epi::PERM ? perm32(rho) : rho;
            bp[b][n] = (unsigned)(u.pn * 256 + 128 * b + 32 * wc + col) * (unsigned)ldb + fq * 8; }
    for (int k = 0; k < K; k += 32) {
        bf16x8 bfr[2][2];
#pragma unroll
        for (int b = 0; b < 2; ++b)
#pragma unroll
            for (int n = 0; n < 2; ++n) bfr[b][n] = *(const bf16x8*)(Bt + (bp[b][n] + k));
#pragma unroll
        for (int a = 0; a < 2; ++a) {
            bf16x8 af[4];
#pragma unroll
            for (int m = 0; m < 4; ++m) af[m] = *(const bf16x8*)(A + (ap[a][m] + k));
#pragma unroll
            for (int b = 0; b < 2; ++b)
#pragma unroll
                for (int m = 0; m < 4; ++m)
#pragma unroll
                    for (int n = 0; n < 2; ++n) acc[a][b][m][n] = __builtin_amdgcn_mfma_f32_16x16x32_bf16(bfr[b][n], af[m], acc[a][b][m][n], 0, 0, 0);
        }
    }
    E(acc, u, wr, wc, fr, fq);
}

struct RowIdent { __device__ __forceinline__ int operator()(const Unit& u, int R) const { return u.pm * 256 + R; } };
struct RowStackK { int rows; __device__ __forceinline__ int operator()(const Unit& u, int R) const { return u.e * rows + u.pm * 256 + R; } };
struct RowGather { const int* list; const unsigned* cnt; __device__ __forceinline__ int operator()(const Unit& u, int R) const {
    const int idx = u.aux * 256 + R; const int* l = list + (size_t)u.e * T; return idx < (int)cnt[u.e] ? l[idx] : l[0]; } };


namespace pg8 {
constexpr int BM = 256, BK = 64, HALF = 128, HTB = HALF * BK * 2, STAGE_BYTES = 8 * HTB;
__host__ __device__ __forceinline__ int lds_byte(int r, int c) { const int st = (r >> 4) * 2 + (c >> 5), rr = r & 15, cc = c & 31, ob = rr * 64 + cc * 2; return st * 1024 + (ob ^ (((ob >> 9) & 1) << 5)); }
__host__ __device__ __forceinline__ void stage_rc(int b, int& R, int& C) { const int st = b / 1024, sb = b % 1024, swz = sb ^ (((sb >> 9) & 1) << 5); R = (st >> 1) * 16 + swz / 64; C = (st & 1) * 32 + (swz % 64) / 2; }
struct Gemm { const bf16_t* A; const bf16_t* Bt; int K; };

template <class Epi, class Sched, bool GATHER>
__device__ __forceinline__ void gemm_phase(int tid, LAS unsigned char* lds, const Gemm g, const Sched& S, const Epi& E) {
    const int wid = __builtin_amdgcn_readfirstlane(tid >> 6), lane = tid & 63, wr = wid >> 2, wc = wid & 3, fr = lane & 15, fq = lane >> 4;
    const int K = g.K, nt = K / BK;
    int RA[2], CA[2]; unsigned voffB[2];
    unsigned vA[2][2], vAn[2][2];
#pragma unroll
    for (int i = 0; i < 2; ++i) { int R, C; stage_rc(tid * 16 + i * 8192, R, C); RA[i] = R; CA[i] = C; const int Rb = Epi::PERM ? ((R & ~31) + perm32(R & 31)) : R; voffB[i] = (unsigned)(Rb * K + C) * 2u; }
    const size_t kstep = (size_t)(BK * 2);
    const size_t hstep = (size_t)HALF * K * 2;
    const size_t tstep = 2 * hstep;
    const unsigned ldsw = (unsigned)wid * 1024u;
    const int aoff = lds_byte(wr * 64 + fr, fq * 8), boff = lds_byte(wc * 32 + fr, fq * 8);
#define PG8_SA(b, h) (((b) * 2 + (h)) * HTB)
#define PG8_SB(b, h) ((4 + (b) * 2 + (h)) * HTB)
#define PG8_STAGE(bufoff, gbase, voff) do { _Pragma("unroll") for (int _i = 0; _i < 2; ++_i) \
        __builtin_amdgcn_global_load_lds((const unsigned*)((const char*)(gbase) + (voff)[_i]), (LAS unsigned*)(lds + (bufoff) + ldsw + _i * 8192), 16, 0, 0); } while (0)
#define PG8_STAGE2(bufoff, gbase, v0, v1) do { \
        __builtin_amdgcn_global_load_lds((const unsigned*)((const char*)(gbase) + (v0)), (LAS unsigned*)(lds + (bufoff) + ldsw), 16, 0, 0); \
        __builtin_amdgcn_global_load_lds((const unsigned*)((const char*)(gbase) + (v1)), (LAS unsigned*)(lds + (bufoff) + ldsw + 8192), 16, 0, 0); } while (0)
#define PG8_LDA(dst, b, h) do { _Pragma("unroll") for (int m = 0; m < 4; ++m) _Pragma("unroll") for (int k = 0; k < 2; ++k) dst[m][k] = *(const LAS bf16x8*)(lds + PG8_SA(b, h) + aoff + m * 2048 + k * 1024); } while (0)
#define PG8_LDB(dst, b, h) do { _Pragma("unroll") for (int n = 0; n < 2; ++n) _Pragma("unroll") for (int k = 0; k < 2; ++k) dst[n][k] = *(const LAS bf16x8*)(lds + PG8_SB(b, h) + boff + n * 2048 + k * 1024); } while (0)
#define PG8_MMA(ai, bj, At, Bt) do { __builtin_amdgcn_s_setprio(1); _Pragma("unroll") for (int m = 0; m < 4; ++m) _Pragma("unroll") for (int n = 0; n < 2; ++n) _Pragma("unroll") for (int k = 0; k < 2; ++k) \
        acc[ai][bj][m][n] = __builtin_amdgcn_mfma_f32_16x16x32_bf16(Bt[n][k], At[m][k], acc[ai][bj][m][n], 0, 0, 0); __builtin_amdgcn_s_setprio(0); } while (0)
#define PG8_WAIT_V(n) asm volatile("s_waitcnt vmcnt(" #n ")" ::: "memory")
#define PG8_WAIT_L(n) asm volatile("s_waitcnt lgkmcnt(" #n ")" ::: "memory")
#define PG8_BAR __builtin_amdgcn_s_barrier()
#define PG8_SCHED __builtin_amdgcn_sched_barrier(0)
#define PG8_AOFFS(dst, unit) do { _Pragma("unroll") for (int _h = 0; _h < 2; ++_h) _Pragma("unroll") for (int _i = 0; _i < 2; ++_i) \
        dst[_h][_i] = GATHER ? ((unsigned)S.arow(unit, _h * HALF + RA[_i]) * (unsigned)K + (unsigned)CA[_i]) * 2u : ((unsigned)(_h * HALF + RA[_i]) * (unsigned)K + (unsigned)CA[_i]) * 2u; } while (0)
    Unit cur{0, 0, 0, 0}, nxt{0, 0, 0, 0}; int ui = 0;
    if (!S.next(0, cur)) return;
    f32x4 acc[2][2][4][2];
#pragma unroll
    for (int a = 0; a < 2; ++a)
#pragma unroll
        for (int b = 0; b < 2; ++b)
#pragma unroll
            for (int m = 0; m < 4; ++m)
#pragma unroll
                for (int n = 0; n < 2; ++n) acc[a][b][m][n] = (f32x4){0.f, 0.f, 0.f, 0.f};
    bf16x8 At[4][2], B0[2][2], B1[2][2];
    const char* cA = GATHER ? (const char*)g.A : (const char*)g.A + (size_t)cur.pm * tstep; const char* cB = (const char*)g.Bt + (size_t)cur.pn * tstep;
    PG8_AOFFS(vA, cur);
    PG8_STAGE(PG8_SB(0, 0), cB, voffB); PG8_STAGE(PG8_SB(0, 1), cB + hstep, voffB); PG8_STAGE2(PG8_SA(0, 0), cA, vA[0][0], vA[0][1]); PG8_STAGE2(PG8_SA(0, 1), cA, vA[1][0], vA[1][1]);
    if (wr == 1) PG8_BAR;
    PG8_WAIT_V(2); PG8_BAR;
    PG8_STAGE(PG8_SB(1, 0), cB + kstep, voffB); PG8_STAGE2(PG8_SA(1, 0), cA + kstep, vA[0][0], vA[0][1]); PG8_STAGE(PG8_SB(1, 1), cB + hstep + kstep, voffB);
    PG8_WAIT_V(6); PG8_BAR;
    for (;;) {
        const bool has_next = S.next(ui + 1, nxt);
        const char* nA = GATHER ? (const char*)g.A : (has_next ? (const char*)g.A + (size_t)nxt.pm * tstep : cA); const char* nB = has_next ? (const char*)g.Bt + (size_t)nxt.pn * tstep : cB;
        if (GATHER && has_next) { PG8_AOFFS(vAn, nxt); } else {
#pragma unroll
            for (int _h = 0; _h < 2; ++_h)
#pragma unroll
                for (int _i = 0; _i < 2; ++_i) vAn[_h][_i] = vA[_h][_i]; }
#pragma unroll 1
        for (int t = 0; t < nt; t += 2) {
            const bool last = (t == nt - 2);
            const char* a1 = cA + (size_t)(t + 1) * kstep;
            const char* a2 = last ? nA : cA + (size_t)(t + 2) * kstep; const char* b2 = last ? nB : cB + (size_t)(t + 2) * kstep;
            const char* a3 = a2 + kstep; const char* b3 = b2 + kstep;
            const unsigned x00 = (GATHER && last) ? vAn[0][0] : vA[0][0], x01 = (GATHER && last) ? vAn[0][1] : vA[0][1], x10 = (GATHER && last) ? vAn[1][0] : vA[1][0], x11 = (GATHER && last) ? vAn[1][1] : vA[1][1];
            PG8_LDB(B0, 0, 0); PG8_LDB(B1, 0, 1); PG8_SCHED; PG8_LDA(At, 0, 0); PG8_STAGE2(PG8_SA(1, 1), a1, vA[1][0], vA[1][1]);
            PG8_WAIT_V(8); PG8_WAIT_L(0); PG8_BAR; PG8_MMA(0, 0, At, B0); PG8_MMA(0, 1, At, B1); PG8_BAR; PG8_SCHED;
            PG8_LDA(At, 0, 1); PG8_STAGE(PG8_SB(0, 0), b2, voffB); PG8_STAGE(PG8_SB(0, 1), b2 + hstep, voffB); PG8_STAGE2(PG8_SA(0, 0), a2, x00, x01);
            PG8_WAIT_V(8); PG8_WAIT_L(0); PG8_BAR; PG8_MMA(1, 0, At, B0); PG8_MMA(1, 1, At, B1); PG8_BAR; PG8_SCHED;
            PG8_LDB(B0, 1, 0); PG8_LDB(B1, 1, 1); PG8_SCHED; PG8_LDA(At, 1, 0); PG8_STAGE2(PG8_SA(0, 1), a2, x10, x11);
            PG8_WAIT_V(8); PG8_WAIT_L(0); PG8_BAR; PG8_MMA(0, 0, At, B0); PG8_MMA(0, 1, At, B1); PG8_BAR; PG8_SCHED;
            PG8_LDA(At, 1, 1); PG8_STAGE(PG8_SB(1, 0), b3, voffB); PG8_STAGE(PG8_SB(1, 1), b3 + hstep, voffB); PG8_STAGE2(PG8_SA(1, 0), a3, x00, x01);
            PG8_WAIT_V(8); PG8_WAIT_L(0); PG8_BAR; PG8_MMA(1, 0, At, B0); PG8_MMA(1, 1, At, B1); PG8_BAR; PG8_SCHED;
        }
        if (wr == 0) PG8_BAR;
        E(acc, cur, wr, wc, fr, fq);
        if (!has_next) break;
#pragma unroll
        for (int a = 0; a < 2; ++a)
#pragma unroll
            for (int b = 0; b < 2; ++b)
#pragma unroll
                for (int m = 0; m < 4; ++m)
#pragma unroll
                    for (int n = 0; n < 2; ++n) acc[a][b][m][n] = (f32x4){0.f, 0.f, 0.f, 0.f};
        cur = nxt; cA = nA; cB = nB; ++ui;
        if (GATHER) {
#pragma unroll
        for (int _h = 0; _h < 2; ++_h)
#pragma unroll
            for (int _i = 0; _i < 2; ++_i) vA[_h][_i] = vAn[_h][_i]; }
        if (wr == 1) PG8_BAR;
    }
    PG8_WAIT_V(0);
    PG8_BAR;
#undef PG8_SA
#undef PG8_SB
#undef PG8_STAGE
#undef PG8_STAGE2
#undef PG8_LDA
#undef PG8_LDB
#undef PG8_MMA
#undef PG8_WAIT_V
#undef PG8_WAIT_L
#undef PG8_BAR
#undef PG8_SCHED
#undef PG8_AOFFS
}
}

struct XOrder { int G, c, MT, NT;
    __device__ __forceinline__ bool map(int i, int& pm, int& pn) const {
        if ((G & 7) == 0 && (MT & 7) == 0) { const int x = c & 7, r = c >> 3, W = G >> 3, MX = MT >> 3; const int L = i * W + r; if (L >= MX * NT) return false; pm = x * MX + L / NT; pn = L % NT; return true; }
        const int L = i * G + c; if (L >= MT * NT) return false; pm = L / NT; pn = L % NT; return true; } };
struct SchedG1 { XOrder X; __device__ __forceinline__ bool next(int i, Unit& u) const { int pm, pn; if (!X.map(i, pm, pn)) return false; u.pm = pm; u.pn = pn; u.e = 0; u.aux = 0; return true; }
    __device__ __forceinline__ int arow(const Unit&, int) const { return 0; } };
struct SchedG2 { XOrder X; __device__ __forceinline__ bool next(int i, Unit& u) const { int pm, q; if (!X.map(i, pm, q)) return false; const int k = q >> 2, pnn = q & 3;
        u.pm = k * (T / 256) + pm; u.pn = k * 4 + pnn; u.e = k; u.aux = pnn; return true; }
    __device__ __forceinline__ int arow(const Unit&, int) const { return 0; } };
struct SchedMN { XOrder X; __device__ __forceinline__ bool next(int i, Unit& u) const { int pm, pn; if (!X.map(i, pm, pn)) return false; u.pm = pm; u.pn = pn; u.e = 0; u.aux = 0; return true; }
    __device__ __forceinline__ int arow(const Unit&, int) const { return 0; } };

struct EpiBf16Plain {
    static constexpr bool PERM = true;
    bf16_t* O; int ldc; int coltile_mask;
    __device__ __forceinline__ void operator()(const f32x4 (&acc)[2][2][4][2], const Unit& u, int wr, int wc, int fr, int fq) const {
        const int row0 = u.pm * 256 + wr * 64 + fr, col0 = (u.pn & coltile_mask) * 256 + wc * 32 + 8 * fq;
#pragma unroll
        for (int ai = 0; ai < 2; ++ai)
#pragma unroll
            for (int m = 0; m < 4; ++m) { bf16_t* rowp = O + ((unsigned)(row0 + ai * 128 + m * 16) * (unsigned)ldc + (unsigned)col0);
#pragma unroll
                for (int bj = 0; bj < 2; ++bj) { const f32x4 v0 = acc[ai][bj][m][0], v1 = acc[ai][bj][m][1];
                    u32x4 w; w.x = pack2(v0[0], v0[1]); w.y = pack2(v0[2], v0[3]); w.z = pack2(v1[0], v1[1]); w.w = pack2(v1[2], v1[3]);
                    *(u32x4*)(rowp + bj * 128) = w; } }
    }
};
struct EpiP {
    static constexpr bool PERM = true;
    bf16_t* P; const float* ssq;
    __device__ __forceinline__ void operator()(const f32x4 (&acc)[2][2][4][2], const Unit& u, int wr, int wc, int fr, int fq) const {
        const int k = u.e; const int pmt = u.pm - k * (T / 256);
        const unsigned c00 = (unsigned)(u.aux * 256 + wc * 32 + 8 * fq);
        const unsigned base = (unsigned)pmt * (16u * 256u * 256u) + (unsigned)k * 16384u;
        float scv[8];
#pragma unroll
        for (int i = 0; i < 8; ++i) scv[i] = 1.0f;
        if (k == 3) {
            f32x4 qv[8];
#pragma unroll
            for (int i = 0; i < 8; ++i) qv[i] = *(const f32x4*)(ssq + (unsigned)(pmt * 256 + (i >> 2) * 128 + wr * 64 + (i & 3) * 16 + fr) * 4u);
#pragma unroll
            for (int i = 0; i < 8; ++i) scv[i] = rsqrtf((qv[i][0] + qv[i][1] + qv[i][2] + qv[i][3]) * (1.0f / 256.0f) + kconst(RMS_EPS));
        }
#pragma unroll
        for (int ai = 0; ai < 2; ++ai)
#pragma unroll
            for (int m = 0; m < 4; ++m) { const int r = ai * 128 + wr * 64 + m * 16 + fr; const float sc = scv[ai * 4 + m];
#pragma unroll
                for (int bj = 0; bj < 2; ++bj) { const unsigned c0 = c00 + bj * 128; const unsigned s = c0 >> 6, wi = c0 & 63;
                    const f32x4 v0 = acc[ai][bj][m][0] * sc, v1 = acc[ai][bj][m][1] * sc;
                    u32x4 w; w.x = pack2(v0[0], v0[1]); w.y = pack2(v0[2], v0[3]); w.z = pack2(v1[0], v1[1]); w.w = pack2(v1[2], v1[3]);
                    __builtin_nontemporal_store(w, (u32x4*)(P + (base + s * 65536u + (wi >> 4) * 4096u + (unsigned)r * 16u + (wi & 15u)))); }
                asm volatile("" ::: "memory"); }
    }
};
struct EpiMerge {
    static constexpr bool PERM = false;
    const bf16_t* P; const float* bgp; bf16_t* Y;
    __device__ __forceinline__ void operator()(const f32x4 (&acc)[2][2][4][2], const Unit& u, int wr, int wc, int fr, int fq) const {
        const int s = u.pn;
        f32x4 bv[2][2];
#pragma unroll
        for (int bj = 0; bj < 2; ++bj)
#pragma unroll
            for (int n = 0; n < 2; ++n) bv[bj][n] = *(const f32x4*)(bgp + s * 256 + bj * 128 + wc * 32 + n * 16 + 4 * fq);
        const bf16_t* pb = P + (((unsigned)u.pm * 16u + (unsigned)s) * 65536u + (unsigned)(wc * 4096 + (wr * 64 + fr) * 16 + 4 * fq));
        u32x2 pw[2][4][4];
#pragma unroll
        for (int ai = 0; ai < 2; ++ai)
#pragma unroll
            for (int k = 0; k < 4; ++k)
#pragma unroll
                for (int m = 0; m < 4; ++m) pw[ai][m][k] = *(const u32x2*)(pb + (ai * 2048 + k * 16384 + m * 256));
        __builtin_amdgcn_sched_barrier(0);
#pragma unroll
        for (int ai = 0; ai < 2; ++ai)
#pragma unroll
            for (int m = 0; m < 4; ++m) { const int r = ai * 128 + wr * 64 + m * 16 + fr;
                f32x4 y = (f32x4){0.f, 0.f, 0.f, 0.f};
#pragma unroll
                for (int bj = 0; bj < 2; ++bj)
#pragma unroll
                    for (int n = 0; n < 2; ++n) { const int k = 2 * bj + n; const u32x2 pq = pw[ai][m][k];
                        const f32x4 g = acc[ai][bj][m][n] + bv[bj][n];
                        f32x4 sg; sg[0] = __builtin_amdgcn_exp2f(g[0]); sg[1] = __builtin_amdgcn_exp2f(g[1]); sg[2] = __builtin_amdgcn_exp2f(g[2]); sg[3] = __builtin_amdgcn_exp2f(g[3]);
                        sg = sg + 1.0f; sg[0] = __builtin_amdgcn_rcpf(sg[0]); sg[1] = __builtin_amdgcn_rcpf(sg[1]); sg[2] = __builtin_amdgcn_rcpf(sg[2]); sg[3] = __builtin_amdgcn_rcpf(sg[3]);
                        const f32x4 pv = (f32x4){__uint_as_float(pq.x << 16), __uint_as_float(pq.x & 0xffff0000u), __uint_as_float(pq.y << 16), __uint_as_float(pq.y & 0xffff0000u)};
                        y += sg * pv; }
                u32x2 w; w.x = pack2(y[0], y[1]); w.y = pack2(y[2], y[3]);
                *(u32x2*)(Y + ((unsigned)(u.pm * 256 + r) * (unsigned)D + (unsigned)(s * 64 + wc * 16 + 4 * fq))) = w; }
    }
};
struct EpiWo {
    static constexpr bool PERM = false;
    Ptrs P; int layer;
    __device__ __forceinline__ void operator()(const f32x4 (&acc)[2][2][4][2], const Unit& u, int wr, int wc, int fr, int fq) const {
        const int col0 = u.pn * 256 + wc * 32 + 4 * fq;
#pragma unroll
        for (int ai = 0; ai < 2; ++ai)
#pragma unroll
            for (int m = 0; m < 4; ++m) { const int row = u.pm * 256 + ai * 128 + wr * 64 + m * 16 + fr;
                float* lp = P.latrow(row) + col0; const float* g1 = P.mod(layer, row_modidx(row)) + 2048 + col0;
#pragma unroll
                for (int bj = 0; bj < 2; ++bj)
#pragma unroll
                    for (int n = 0; n < 2; ++n) { const f32x4 x = *(const f32x4*)(lp + bj * 128 + n * 16); const f32x4 g = *(const f32x4*)(g1 + bj * 128 + n * 16);
                        *(f32x4*)(lp + bj * 128 + n * 16) = x * ALPHA + g * acc[ai][bj][m][n]; } }
    }
};
struct EpiFfn1 {
    static constexpr bool PERM = false;
    bf16_t* H;
    __device__ __forceinline__ void operator()(const f32x4 (&acc)[2][2][4][2], const Unit& u, int wr, int wc, int fr, int fq) const {
        const int pnn = u.pn & 3;
#pragma unroll
        for (int ai = 0; ai < 2; ++ai)
#pragma unroll
            for (int m = 0; m < 4; ++m) { const int pos = u.pm * 256 + ai * 128 + wr * 64 + m * 16 + fr;
#pragma unroll
                for (int bj = 0; bj < 2; ++bj) { const f32x4 a = acc[ai][bj][m][0], b = acc[ai][bj][m][1];
                    u32x2 w; w.x = pack2(siluf_(a[0]) * b[0], siluf_(a[1]) * b[1]); w.y = pack2(siluf_(a[2]) * b[2], siluf_(a[3]) * b[3]);
                    *(u32x2*)(H + ((unsigned)pos * 512u + (unsigned)(pnn * 128 + bj * 64 + wc * 16 + 4 * fq))) = w; } }
    }
};

template <class SrcFn>
__device__ __forceinline__ void conv_tile(int tid, LAS float* tile  , bf16_t* dst, int ldd, int n0, int k0, const SrcFn& src, const float scale = 1.0f) {
    f32x4 v[8];
#pragma unroll
    for (int i = 0; i < 8; ++i) { const int kk = (tid >> 4) + 32 * i, j4 = tid & 15; v[i] = *(const f32x4*)src(k0 + kk, n0 + 4 * j4); }
#pragma unroll
    for (int i = 0; i < 8; ++i) { const int kk = (tid >> 4) + 32 * i, j4 = tid & 15; LAS float* t = tile + kk * 65 + 4 * j4; t[0] = v[i][0]; t[1] = v[i][1]; t[2] = v[i][2]; t[3] = v[i][3]; }
    __syncthreads();
    { const int jj = tid >> 3, kq = tid & 7;
#pragma unroll
      for (int kb = 0; kb < 4; ++kb) { float x[8];
#pragma unroll
          for (int i = 0; i < 8; ++i) x[i] = tile[(64 * kb + 8 * kq + i) * 65 + jj] * scale;
          u32x4 w; w.x = pack2(x[0], x[1]); w.y = pack2(x[2], x[3]); w.z = pack2(x[4], x[5]); w.w = pack2(x[6], x[7]);
          *(u32x4*)(dst + (size_t)(n0 + jj) * ldd + k0 + 64 * kb + 8 * kq) = w; } }
    __syncthreads();
}
constexpr int NCONV_NE = 56 * 4 + 64 * 4 + 64 * 1 + 16 * 4;
constexpr int NCONV_EX = NE * (16 * 4 + 16 * 2);
__device__ __forceinline__ int gate_srccol(int np) { const int s = np >> 8, bj = (np >> 7) & 1, wc = (np >> 5) & 3, n = (np >> 4) & 1, fqe = np & 15; return (2 * bj + n) * 1024 + 64 * s + 16 * wc + fqe; }
__device__ __forceinline__ void conv_unit_ne(const Ptrs P, int l, int t, LAS float* tile) {
    unsigned char* ws = P.ws;
    if (t < 224) { const int nt = t >> 2, kt = t & 3; const float* src = P.inp(I_WIN) + (size_t)l * D * INC;
        conv_tile(P.tid, tile, (bf16_t*)(ws + WS_WIN), D, nt * 64, kt * 256, [=](int k, int n) { return src + (size_t)k * INC + n; });
    } else if (t < 224 + 256) { t -= 224; const int nt = t >> 2, kt = t & 3; const float* src = P.inp(I_WGATE) + (size_t)l * D * 4096;
        conv_tile(P.tid, tile, (bf16_t*)(ws + WS_WG), D, nt * 64, kt * 256, [=](int k, int n) { return src + (size_t)k * 4096 + gate_srccol(n); }, -1.4426950408889634f);
        if (kt == 0 && P.tid < 64) { const int np = nt * 64 + P.tid; ((float*)(ws + WS_BGP))[np] = P.inp(I_BGATE)[(size_t)l * 4096 + gate_srccol(np)] * -1.4426950408889634f; }
    } else if (t < 224 + 256 + 64) { t -= 480; const int nt = t; const int kb = nt >> 4;
        const float* src = P.inp(I_WBR) + ((size_t)l * 4 + kb) * 256 * 1024;
        conv_tile(P.tid, tile, (bf16_t*)(ws + WS_WBR), 256, nt * 64, 0, [=](int k, int n) { return src + (size_t)k * 1024 + (n & 1023); });
    } else { t -= 544; const int nt = t >> 2, kt = t & 3; const float* src = P.inp(I_WO) + (size_t)l * D * D;
        conv_tile(P.tid, tile, (bf16_t*)(ws + WS_WO), D, nt * 64, kt * 256, [=](int k, int n) { return src + (size_t)k * D + n; });
    }
}
__device__ __forceinline__ void conv_unit_ex(const Ptrs P, int l, int t, LAS float* tile) {
    unsigned char* ws = P.ws;
    const int e = t / 96; t -= e * 96;
    if (t < 64) { const int nt = t >> 2, kt = t & 3;
        const float* s1 = P.inp(I_WE1) + ((size_t)l * NE + e) * 1024 * 512; const float* s3 = P.inp(I_WE3) + ((size_t)l * NE + e) * 1024 * 512;
        conv_tile(P.tid, tile, (bf16_t*)(ws + WS_BIG + BIG_W13) + (size_t)e * 1024 * 1024, 1024, nt * 64, kt * 256, [=](int k, int n) {
            const int pn = n >> 8, bj = (n >> 7) & 1, wc = (n >> 5) & 3, nn = (n >> 4) & 1, fqe = n & 15; const int ch = 128 * pn + 64 * bj + 16 * wc + fqe;
            return (nn ? s3 : s1) + (size_t)k * 512 + ch; });
    } else { t -= 64; const int nt = t >> 1, kt = t & 1; const float* src = P.inp(I_WE2) + ((size_t)l * NE + e) * 512 * 1024;
        conv_tile(P.tid, tile, (bf16_t*)(ws + WS_BIG + BIG_W2) + (size_t)e * 1024 * 512, 512, nt * 64, kt * 256, [=](int k, int n) { return src + (size_t)k * 1024 + n; });
    }
}

struct ConvEx { Ptrs P; int l; LAS float* tile; __device__ __forceinline__ void operator()(int t) const { conv_unit_ex(P, l, t, tile); } };
struct ConvNe { Ptrs P; int l; LAS float* tile; __device__ __forceinline__ void operator()(int t) const { conv_unit_ne(P, l, t, tile); } };
template <class F>
__device__ __forceinline__ void dyn_tiles(int tid, unsigned* ctr, int n, volatile LAS unsigned* slot, const F& f) {
    const bool t0 = (tid == 0);
    if (t0) slot[0] = __hip_atomic_fetch_add(ctr, 1u, __ATOMIC_RELAXED, __HIP_MEMORY_SCOPE_AGENT);
    __syncthreads();
    unsigned t = (unsigned)__builtin_amdgcn_readfirstlane((int)slot[0]);
    __syncthreads();
    while (t < (unsigned)n) {
        unsigned tn = 0u; if (t0) tn = __hip_atomic_fetch_add(ctr, 1u, __ATOMIC_RELAXED, __HIP_MEMORY_SCOPE_AGENT);
        f((int)t);
        if (t0) slot[0] = tn;
        __syncthreads();
        t = (unsigned)__builtin_amdgcn_readfirstlane((int)slot[0]);
        __syncthreads();
    }
}

struct RowV { f32x4 v[4]; };
__device__ __forceinline__ void row_load(RowV& r, const float* p, int lane) {
#pragma unroll
    for (int i = 0; i < 4; ++i) r.v[i] = *(const f32x4*)(p + i * 256 + lane * 4);
}
__device__ __forceinline__ void row_store(const RowV& r, float* p, int lane) {
#pragma unroll
    for (int i = 0; i < 4; ++i) *(f32x4*)(p + i * 256 + lane * 4) = r.v[i];
}
__device__ __forceinline__ void row_layernorm(RowV& r, const float* g, const float* b, int lane) {
    float s = 0.f;
#pragma unroll
    for (int i = 0; i < 4; ++i) s += r.v[i][0] + r.v[i][1] + r.v[i][2] + r.v[i][3];
    const float mu = wave_sum(s) * (1.0f / 1024.0f);
    float q = 0.f;
#pragma unroll
    for (int i = 0; i < 4; ++i) { const f32x4 d = r.v[i] - mu; q += d[0] * d[0] + d[1] * d[1] + d[2] * d[2] + d[3] * d[3]; }
    const float rstd = rsqrtf(wave_sum(q) * (1.0f / 1024.0f) + kconst(LN_EPS));
#pragma unroll
    for (int i = 0; i < 4; ++i) { const f32x4 gg = *(const f32x4*)(g + i * 256 + lane * 4), bb = *(const f32x4*)(b + i * 256 + lane * 4); r.v[i] = (r.v[i] - mu) * rstd * gg + bb; }
}
__device__ __forceinline__ void row_layernorm_r(RowV& r, const RowV& g, const RowV& b) {
    float s = 0.f;
#pragma unroll
    for (int i = 0; i < 4; ++i) s += r.v[i][0] + r.v[i][1] + r.v[i][2] + r.v[i][3];
    const float mu = wave_sum(s) * (1.0f / 1024.0f);
    float q = 0.f;
#pragma unroll
    for (int i = 0; i < 4; ++i) { const f32x4 d = r.v[i] - mu; q += d[0] * d[0] + d[1] * d[1] + d[2] * d[2] + d[3] * d[3]; }
    const float rstd = rsqrtf(wave_sum(q) * (1.0f / 1024.0f) + kconst(LN_EPS));
#pragma unroll
    for (int i = 0; i < 4; ++i) r.v[i] = (r.v[i] - mu) * rstd * g.v[i] + b.v[i];
}
__device__ __forceinline__ void row_modulate(const RowV& r, RowV& h, const float* sh, const float* sc, int lane) {
#pragma unroll
    for (int i = 0; i < 4; ++i) { const f32x4 a = *(const f32x4*)(sc + i * 256 + lane * 4), b = *(const f32x4*)(sh + i * 256 + lane * 4); h.v[i] = r.v[i] * (a + 1.0f) + b; }
}
__device__ __forceinline__ void row_modulate_r(const RowV& r, RowV& h, const RowV& sh, const RowV& sc) {
#pragma unroll
    for (int i = 0; i < 4; ++i) h.v[i] = r.v[i] * (sc.v[i] + 1.0f) + sh.v[i];
}
__device__ __forceinline__ void row_store_bf16(const RowV& h, bf16_t* p, int lane) {
#pragma unroll
    for (int i = 0; i < 4; ++i) { u32x2 w; w.x = pack2(h.v[i][0], h.v[i][1]); w.y = pack2(h.v[i][2], h.v[i][3]); *(u32x2*)(p + i * 256 + lane * 4) = w; }
}
__device__ __forceinline__ void row_dt(const RowV& h, const LAS float* wdt, float* dtout, int lane) {
    float a[8];
#pragma unroll
    for (int j = 0; j < 8; ++j) a[j] = 0.f;
#pragma unroll
    for (int i = 0; i < 4; ++i)
#pragma unroll
        for (int e = 0; e < 4; ++e) { const int k = i * 256 + lane * 4 + e; const float hv = h.v[i][e];
            const f32x4 w0 = *(const LAS f32x4*)(wdt + k * 8), w1 = *(const LAS f32x4*)(wdt + k * 8 + 4);
            a[0] += hv * w0[0]; a[1] += hv * w0[1]; a[2] += hv * w0[2]; a[3] += hv * w0[3]; a[4] += hv * w1[0]; a[5] += hv * w1[1]; a[6] += hv * w1[2]; a[7] += hv * w1[3]; }
#pragma unroll
    for (int j = 0; j < 8; ++j) a[j] = wave_sum(a[j]);
    if (lane == 0) { *(f32x4*)dtout = (f32x4){a[0], a[1], a[2], a[3]}; *(f32x4*)(dtout + 4) = (f32x4){a[4], a[5], a[6], a[7]}; }
}
__device__ __forceinline__ void load_wdt(const Ptrs P, int l, LAS float* wdt) {
    const float* src = P.inp(I_WIN) + (size_t)l * D * INC + UC;
    for (int i = P.tid; i < 1024 * 8; i += 512) wdt[i] = src[(size_t)(i >> 3) * INC + (i & 7)];
    __syncthreads();
}

__device__ __forceinline__ void phase_pa(const Ptrs P, LAS unsigned char* lds) {
    const int tid = P.tid, wid = tid >> 6, lane = tid & 63, G = P.G;
    const int NU_MOD = 2 * 96, NU_H2 = 8448 / 8, NU_LB = 1;
    const int NU = NU_MOD + NU_H2 + NU_LB + NCONV_NE;
    for (int u = P.bid; u < NU; u += G) {
        if (u < NU_MOD) {
            const int l = u / 96, cb = u % 96;
            LAS float* sc = (LAS float*)lds; LAS float* red = sc + 9 * 1024;
            { const float* cin_ = P.inp(I_C); const float* cctx_ = P.inp(I_CCTX);
              for (int i = tid; i < 9 * 1024; i += 512) { const int r = i >> 10, k = i & 1023; const float v = r < 8 ? cin_[r * 1024 + k] : cctx_[k]; sc[i] = v / (1.0f + fexp(-v)); } }
            __syncthreads();
            const int col = cb * 64 + lane; const float* w = P.inp(I_WADA) + (size_t)l * D * 6144 + col;
            float acc[9];
#pragma unroll
            for (int r = 0; r < 9; ++r) acc[r] = 0.f;
            for (int k = wid * 128; k < wid * 128 + 128; ++k) { const float wv = w[(size_t)k * 6144];
#pragma unroll
                for (int r = 0; r < 9; ++r) acc[r] += sc[r * 1024 + k] * wv; }
#pragma unroll
            for (int r = 0; r < 9; ++r) red[(wid * 9 + r) * 64 + lane] = acc[r];
            __syncthreads();
            const float* bada_ = P.inp(I_BADA);
            for (int i = tid; i < 9 * 64; i += 512) { const int r = i >> 6, c = i & 63; float s = bada_[(size_t)l * 6144 + cb * 64 + c];
#pragma unroll
                for (int w8 = 0; w8 < 8; ++w8) s += red[(w8 * 9 + r) * 64 + c];
                P.mod(l, r)[cb * 64 + c] = s; }
            __syncthreads();
        } else if (u < NU_MOD + NU_H2) {
            const int rho = (u - NU_MOD) * 8 + wid;
            const int l = (rho >= 4096 && rho < 8192) ? 1 : 0; const int L = rho < 8192 ? 4096 : 256; const int i = rho < 8192 ? (rho & 4095) : (rho - 8192);
            float featv = 0.f;
            if (lane == 0) featv = (float)((double)i / (double)(L - 1));
            else if (lane < 33) { const int j = (lane - 1) & 15; const double band = 1e-4 + (double)j * ((15.0 - 1e-4) / 15.0);
                const double ang = (2.0 * 3.14159265358979323846 / (double)L) * (double)i * band; featv = lane < 17 ? (float)cos(ang) : (float)(-sin(ang)); }
            const float* hw1_ = P.inp(I_HYW1); const float* hw2_ = P.inp(I_HYW2);
            float z1 = P.inp(I_HYB1)[l * 64 + lane];
            for (int m = 0; m < 33; ++m) z1 += __shfl(featv, m) * hw1_[((size_t)l * 33 + m) * 64 + lane];
            const float h1 = sinf(P.inp(I_HYF1)[l * 64 + lane] * z1);
            float z2 = P.inp(I_HYB2)[l * 64 + lane];
            for (int m = 0; m < 64; ++m) z2 += __shfl(h1, m) * hw2_[((size_t)l * 64 + m) * 64 + lane];
            ((float*)(P.ws + WS_H2TAB))[(size_t)rho * 64 + lane] = sinf(P.inp(I_HYF2)[l * 64 + lane] * z2);
        } else if (u < NU_MOD + NU_H2 + NU_LB) {
            for (int i = tid; i < 4096; i += 512) { const double a = -2.0 * 3.14159265358979323846 * (double)i / 8192.0; ((float*)(P.ws + WS_TW))[2 * i] = (float)cos(a); ((float*)(P.ws + WS_TW))[2 * i + 1] = (float)sin(a); }
            for (int i = tid; i < 1024; i += 512) { const int d = i >> 9, l = (i >> 8) & 1, c = i & 255;
                const float l0 = P.inp(I_HGLB)[d * 512 + c], l1 = P.inp(I_HGLB)[d * 512 + 256 + c];
                ((float*)(P.ws + WS_LB))[i] = l == 0 ? 0.0f : 1.0f / (1.0f + fexp(l0 - l1)); }
        } else {
            conv_unit_ne(P, 0, u - (NU_MOD + NU_H2 + NU_LB), (LAS float*)lds);
        }
    }
}

__device__ __forceinline__ void emit_rows_init(const Ptrs P, LAS float* wdt);
__device__ __forceinline__ void phase_pb(const Ptrs P, LAS unsigned char* lds) {
    const int tid = P.tid, G = P.G;
    for (int u = P.bid; u < 132; u += G) {
        const int tab = u < 64 ? 0 : (u < 128 ? 1 : 2); const int ib = tab == 0 ? u : (tab == 1 ? u - 64 : u - 128);
        const int l = tab == 1 ? 1 : 0; const int L = tab == 2 ? 256 : 4096; const int rho0 = (tab == 0 ? 0 : (tab == 1 ? 4096 : 8192)) + ib * 64;
        LAS float* h2 = (LAS float*)lds;
        for (int i = tid; i < 64 * 64; i += 512) h2[i] = ((const float*)(P.ws + WS_H2TAB))[(size_t)rho0 * 64 + i];
        __syncthreads();
        const int o = tid, c = tid & 255, dir = tid >> 8;
        float w3[64]; const float* hw3_ = P.inp(I_HYW3);
#pragma unroll
        for (int j = 0; j < 64; ++j) w3[j] = hw3_[((size_t)l * 64 + j) * 512 + o];
        const float dec = fabsf(P.inp(I_HYDEC)[l * 256 + c]);
        float* filt = tab == 2 ? (float*)(P.ws + WS_FILTC) : (float*)(P.ws + WS_FILT) + (size_t)l * 8192 * 256;
        const int L2 = 2 * L; float part = 0.f;
        for (int r = 0; r < 64; ++r) { const int i = ib * 64 + r; float s = 0.f;
#pragma unroll
            for (int j = 0; j < 64; ++j) s += h2[r * 64 + j] * w3[j];
            const float t = (float)i / (float)(L - 1); s *= fexp(-t * dec);
            if (dir == 0) { filt[(size_t)i * 256 + c] = s; part += fabsf(s); }
            else if (i == 0) filt[(size_t)L * 256 + c] = 0.f;
            else { filt[(size_t)(L2 - i) * 256 + c] = s; part += fabsf(s); } }
        ((float*)(P.ws + WS_PART))[((size_t)tab * 64 + ib) * 512 + o] = part;
        __syncthreads();
    }
    emit_rows_init(P, (LAS float*)lds);
}
__device__ __forceinline__ float hy_norm(const Ptrs P, int tab, int c) {
    const float* part = (const float*)(P.ws + WS_PART) + (size_t)tab * 64 * 512; const int nb = tab == 2 ? 4 : 64; float s = 0.f;
    for (int b = 0; b < nb; ++b) s += part[b * 512 + c] + part[b * 512 + 256 + c];
    return s;
}

__device__ __forceinline__ void emit_rows_init(const Ptrs P, LAS float* wdt) {
    const int tid = P.tid, wid = tid >> 6, lane = tid & 63, G = P.G;
    load_wdt(P, 0, wdt);
    LAS float* tabA = wdt + 1024 * 8; LAS float* tabB = tabA + 8 * 256 * 2;
    for (int i = tid; i < 2 * 8 * 256; i += 512) { const int tb = i >> 11, a = (i >> 8) & 7, ii = i & 255; const float om = fexp(-9.210340371976184f * (float)ii * (1.0f / 256.0f)); const float ang = (float)(tb ? a : 8 * a) * om;
        LAS float* t = (tb ? tabB : tabA) + (a * 256 + ii) * 2; t[0] = sinf(ang); t[1] = cosf(ang); }
    __syncthreads();
    const float* xin = P.inp(I_X); const float* cin = P.inp(I_CTX);
    RowV msh, msc; { const float z = zero_f(); for (int i = 0; i < 4; ++i) { msh.v[i] = (f32x4){z, z, z, z}; msc.v[i] = msh.v[i]; } } int mcur = -1;
    RowV rn; { const float z = zero_f(); for (int i = 0; i < 4; ++i) rn.v[i] = (f32x4){z, z, z, z}; } if (P.bid < T / 8) { const int rw = P.bid * 8 + wid; row_load(rn, rw < NLAT ? xin + (size_t)rw * D : cin + (size_t)(rw - NLAT) * D, lane); }
    for (int u = P.bid; u < T / 8; u += G) {
        const int row = u * 8 + wid; RowV r = rn;
        if (u + G < T / 8) { const int rw = (u + G) * 8 + wid; row_load(rn, rw < NLAT ? xin + (size_t)rw * D : cin + (size_t)(rw - NLAT) * D, lane); }
        if (row < NLAT) {
            const int t = row & 4095; const int prow = t >> 6, pcol = t & 63;
#pragma unroll
            for (int hf = 0; hf < 2; ++hf) { const int pos = hf ? pcol : prow; const LAS float* pa = tabA + ((pos >> 3) * 256 + lane * 4) * 2; const LAS float* pb = tabB + ((pos & 7) * 256 + lane * 4) * 2;
                const f32x4 a0 = *(const LAS f32x4*)pa, a1 = *(const LAS f32x4*)(pa + 4), b0 = *(const LAS f32x4*)pb, b1 = *(const LAS f32x4*)(pb + 4);
                f32x4 sn, cs;
                sn[0] = a0[0] * b0[1] + a0[1] * b0[0]; cs[0] = a0[1] * b0[1] - a0[0] * b0[0]; sn[1] = a0[2] * b0[3] + a0[3] * b0[2]; cs[1] = a0[3] * b0[3] - a0[2] * b0[2];
                sn[2] = a1[0] * b1[1] + a1[1] * b1[0]; cs[2] = a1[1] * b1[1] - a1[0] * b1[0]; sn[3] = a1[2] * b1[3] + a1[3] * b1[2]; cs[3] = a1[3] * b1[3] - a1[2] * b1[2];
                r.v[2 * hf] += sn; r.v[2 * hf + 1] += cs; }
        }
        row_store(r, P.latrow(row), lane);
        const int mi = row_modidx(row); if (mi != mcur) { mcur = mi; const float* m = P.mod(0, mi); row_load(msh, m, lane); row_load(msc, m + 1024, lane); }
        RowV h; row_modulate_r(r, h, msh, msc);
        row_store_bf16(h, (bf16_t*)(P.ws + WS_HBUF) + (size_t)row * D, lane);
        row_dt(h, wdt, (float*)(P.ws + WS_DT) + (size_t)row * 8, lane);
    }
}

__device__ __forceinline__ void phase_g1(const Ptrs P, LAS unsigned char* lds) {
    pg8::Gemm g{(const bf16_t*)(P.ws + WS_HBUF), (const bf16_t*)(P.ws + WS_WIN), D};
    EpiBf16Plain E{(bf16_t*)(P.ws + WS_BIG + BIG_U), UC, 0xffff};
    SchedG1 S{XOrder{P.G, P.bid, T / 256, 14}};
    pg8::gemm_phase<EpiBf16Plain, SchedG1, false>(P.tid, lds, g, S, E);
}

constexpr int NCHK = 34;
__device__ __forceinline__ int chunk_row0(int b, int pc) { return pc < 2 ? NLAT + b * CTXL + pc * 128 : b * SEQ + (pc - 2) * 128; }
__device__ __forceinline__ int chunk_at(int dir, int q) { return dir == 0 ? q : (q < 2 ? 1 - q : 35 - q); }
__device__ __forceinline__ int sidx(int kind, int b, int h, int dir, int pc) { return (((kind * 8 + b) * 4 + h) * 2 + dir) * NCHK + pc; }
__device__ __forceinline__ bf16x8 pack8(const float (&v)[8]) { u32x4 w; w.x = pack2(v[0], v[1]); w.y = pack2(v[2], v[3]); w.z = pack2(v[4], v[5]); w.w = pack2(v[6], v[7]); return __builtin_bit_cast(bf16x8, w); }
__device__ __forceinline__ float softplusf_(float x) { return x > 20.f ? x : flog(1.0f + fexp(x)); }
__device__ __forceinline__ float wave_incl_scan(float v, int lane) {
#pragma unroll
    for (int d = 1; d < 64; d <<= 1) { const float t = __shfl_up(v, d); if (lane >= d) v += t; }
    return v;
}

template <bool SILU>
__device__ __forceinline__ void conv3_8(const bf16_t* U, int row, int col0, const float* w, int ncol, int wcol0, const float* bias, float (&out)[8]) {
    const bool hp = row_has_prev(row), hn = row_has_next(row);
    const bf16x8 c = *(const bf16x8*)(U + (size_t)row * UC + col0);
    const bf16x8 p = *(const bf16x8*)(U + (size_t)(hp ? row - 1 : row) * UC + col0), n = *(const bf16x8*)(U + (size_t)(hn ? row + 1 : row) * UC + col0);
    const float mp = hp ? 1.0f : 0.0f, mn = hn ? 1.0f : 0.0f;
#pragma unroll
    for (int h4 = 0; h4 < 2; ++h4) { const f32x4 w0 = *(const f32x4*)(w + wcol0 + 4 * h4), w1 = *(const f32x4*)(w + ncol + wcol0 + 4 * h4), w2 = *(const f32x4*)(w + 2 * ncol + wcol0 + 4 * h4), bb = *(const f32x4*)(bias + wcol0 + 4 * h4);
#pragma unroll
        for (int e = 0; e < 4; ++e) { const int i = 4 * h4 + e; const float v = bf2f((bf16_t)c[i]) * w1[e] + mp * bf2f((bf16_t)p[i]) * w0[e] + mn * bf2f((bf16_t)n[i]) * w2[e] + bb[e]; out[i] = SILU ? siluf_(v) : v; } }
}
__device__ __forceinline__ void conv3_silu8(const bf16_t* U, int row, int col0, const float* w, int ncol, int wcol0, const float* bias, float (&out)[8]) { conv3_8<true>(U, row, col0, w, ncol, wcol0, bias, out); }
__device__ __forceinline__ void conv16_silu(const bf16_t* U, int r0, int col, const float* w, int ncol, int wcol, float bias, float (&out)[16]) {
    const bool hp = row_has_prev(r0), hn = row_has_next(r0 + 15);
    float x[18];
#pragma unroll
    for (int i = 0; i < 18; ++i) { const int r = (i == 0 && !hp) ? r0 : ((i == 17 && !hn) ? r0 + 15 : r0 - 1 + i); x[i] = bf2f(U[(size_t)r * UC + col]); }
    if (!hp) x[0] = 0.f; if (!hn) x[17] = 0.f;
    const float w0 = w[wcol], w1 = w[ncol + wcol], w2 = w[2 * ncol + wcol];
#pragma unroll
    for (int j = 0; j < 16; ++j) out[j] = siluf_(x[j] * w0 + x[j + 1] * w1 + x[j + 2] * w2 + bias);
}
__device__ __forceinline__ void store16_bf16(LAS bf16_t* dst, const float (&v)[16]) {
    u32x4 a, b; a.x = pack2(v[0], v[1]); a.y = pack2(v[2], v[3]); a.z = pack2(v[4], v[5]); a.w = pack2(v[6], v[7]); b.x = pack2(v[8], v[9]); b.y = pack2(v[10], v[11]); b.z = pack2(v[12], v[13]); b.w = pack2(v[14], v[15]);
    *(LAS u32x4*)dst = a; *(LAS u32x4*)(dst + 8) = b;
}

__device__ __forceinline__ void scatter8_T(LAS bf16_t* dstT, int g8, int p, const float (&v)[8]) {
#pragma unroll
    for (int e2 = 0; e2 < 4; ++e2) { const unsigned w = pack2(v[2 * e2], v[2 * e2 + 1]); dstT[(8 * g8 + 2 * e2) * 136 + p] = (bf16_t)(w & 0xffffu); dstT[(8 * g8 + 2 * e2 + 1) * 136 + p] = (bf16_t)(w >> 16); }
}

__device__ __forceinline__ void hgrn_pass1(const Ptrs P, int l, int unit, LAS unsigned char* lds) {
    const int tid = P.tid, lane = tid & 63, wid = tid >> 6, fr = lane & 15, fq = lane >> 4;
    const int pc = unit % NCHK; const int r_ = unit / NCHK; const int h = r_ & 3; const int b = r_ >> 2;
    const int row0 = chunk_row0(b, pc);
    const bf16_t* U = (const bf16_t*)(P.ws + WS_BIG + BIG_U);
    LAS bf16_t* KTF = (LAS bf16_t*)lds; LAS bf16_t* KTB = KTF + 64 * 136; LAS bf16_t* VT = KTB + 64 * 136; LAS float* segtot = (LAS float*)(VT + 64 * 136);
    LAS bf16_t* FS = (LAS bf16_t*)(lds + 65536);
    for (int it = tid; it < 128 * 8; it += 512) { const int p = it >> 3, g8 = it & 7; const bf16_t* ur = U + (size_t)(row0 + p) * UC + h * 64 + 8 * g8;
        const bf16x8 ff8 = *(const bf16x8*)(ur + 1792), fb8 = *(const bf16x8*)(ur + 2048), v8 = *(const bf16x8*)(ur + 2304);
        *(LAS bf16x8*)(FS + p * 64 + 8 * g8) = ff8; *(LAS bf16x8*)(FS + 8192 + p * 64 + 8 * g8) = fb8;
#pragma unroll
        for (int e = 0; e < 8; ++e) VT[(8 * g8 + e) * 136 + p] = (bf16_t)v8[e]; }
    __syncthreads();
    const int ch = lane, seg = wid;
    const float lbf = ((const float*)(P.ws + WS_LB))[(0 * 2 + l) * 256 + h * 64 + ch], lbb = ((const float*)(P.ws + WS_LB))[(1 * 2 + l) * 256 + h * 64 + ch];
    float cf[16], cb[16], kf[16], kb[16]; float runf = 0.f, runb = 0.f;
#pragma unroll
    for (int j = 0; j < 16; ++j) { const int p = 16 * seg + j;
        const float ff = lbf + (1.0f - lbf) * sigmoidf_(bf2f(FS[p * 64 + ch])), fb = lbb + (1.0f - lbb) * sigmoidf_(bf2f(FS[8192 + p * 64 + ch]));
        runf += flog(ff); cf[j] = runf; kf[j] = 1.0f - ff; cb[j] = runb; runb += flog(fb); kb[j] = 1.0f - fb; }
    segtot[seg * 64 + ch] = runf; segtot[512 + seg * 64 + ch] = runb; __syncthreads();
    float offf = 0.f, totf = 0.f, offb = 0.f, totb = 0.f;
#pragma unroll
    for (int s = 0; s < 8; ++s) { const float a = segtot[s * 64 + ch], c = segtot[512 + s * 64 + ch]; totf += a; totb += c; offf += (s < seg) ? a : 0.f; offb += (s < seg) ? c : 0.f; }
    { float t[16];
#pragma unroll
      for (int j = 0; j < 16; ++j) t[j] = kf[j] * fexp(totf - offf - cf[j]);
      store16_bf16(KTF + ch * 136 + 16 * seg, t);
#pragma unroll
      for (int j = 0; j < 16; ++j) t[j] = kb[j] * fexp(offb + cb[j]);
      store16_bf16(KTB + ch * 136 + 16 * seg, t); }
    const int sif = sidx(0, b, h, 0, pc), sib = sidx(0, b, h, 1, pc);
    if (seg == 0) { ((float*)(P.ws + WS_DEC))[(size_t)sif * 64 + ch] = fexp(totf); ((float*)(P.ws + WS_DEC))[(size_t)sib * 64 + ch] = fexp(totb); }
    __syncthreads();
    const int mt = wid >> 1, nt0 = (wid & 1) * 2;
    f32x4 af[2], ab[2]; af[0] = (f32x4){0.f, 0.f, 0.f, 0.f}; af[1] = af[0]; ab[0] = af[0]; ab[1] = af[0];
#pragma unroll
    for (int ks = 0; ks < 4; ++ks) { const bf16x8 a0 = *(const LAS bf16x8*)(KTF + (16 * mt + fr) * 136 + 32 * ks + 8 * fq), a1 = *(const LAS bf16x8*)(KTB + (16 * mt + fr) * 136 + 32 * ks + 8 * fq);
#pragma unroll
        for (int n = 0; n < 2; ++n) { const bf16x8 bb = *(const LAS bf16x8*)(VT + (16 * (nt0 + n) + fr) * 136 + 32 * ks + 8 * fq);
            af[n] = __builtin_amdgcn_mfma_f32_16x16x32_bf16(a0, bb, af[n], 0, 0, 0); ab[n] = __builtin_amdgcn_mfma_f32_16x16x32_bf16(a1, bb, ab[n], 0, 0, 0); } }
    float* SF = (float*)(P.ws + WS_BIG + BIG_STATE) + (size_t)sif * 4096; float* SB = (float*)(P.ws + WS_BIG + BIG_STATE) + (size_t)sib * 4096;
#pragma unroll
    for (int n = 0; n < 2; ++n)
#pragma unroll
        for (int r = 0; r < 4; ++r) { const int o = (16 * mt + 4 * fq + r) * 64 + 16 * (nt0 + n) + fr; SF[o] = af[n][r]; SB[o] = ab[n][r]; }
    __syncthreads();
}

__device__ __forceinline__ void ssd_pass1(const Ptrs P, int l, int unit, LAS unsigned char* lds) {
    const int tid = P.tid, lane = tid & 63, wid = tid >> 6, fr = lane & 15, fq = lane >> 4;
    const int pc = unit % NCHK; const int r_ = unit / NCHK; const int g = r_ & 1; const int b = r_ >> 1;
    const int row0 = chunk_row0(b, pc);
    const bf16_t* U = (const bf16_t*)(P.ws + WS_BIG + BIG_U);
    const float* scw = P.inp(I_SSDCW) + (size_t)l * 3 * 512; const float* scb = P.inp(I_SSDCB) + l * 512;
    LAS bf16_t* BT = (LAS bf16_t*)lds; LAS bf16_t* XT = BT + 64 * 136;
    LAS float* wgt = (LAS float*)(XT + 4 * 64 * 136);
    if (wid < 4) {
        const int hh = 2 * g + (wid >> 1), dir = wid & 1;
        const float Aneg = -fexp(P.inp(I_SSDALOG)[(l * 2 + dir) * 4 + hh]); const float dtb = P.inp(I_SSDDTB)[(l * 2 + dir) * 4 + hh]; const float* DT = (const float*)(P.ws + WS_DT);
        const int p0 = 2 * lane; const float d0 = softplusf_(DT[(size_t)(row0 + p0) * 8 + dir * 4 + hh] + dtb), d1 = softplusf_(DT[(size_t)(row0 + p0 + 1) * 8 + dir * 4 + hh] + dtb);
        const float a0 = Aneg * d0, a1 = Aneg * d1; const float inc = wave_incl_scan(a0 + a1, lane); const float tot = __uint_as_float(__builtin_amdgcn_readlane(__float_as_uint(inc), 63));
        if (dir == 0) { wgt[wid * 128 + p0] = d0 * fexp(tot - (inc - a1)); wgt[wid * 128 + p0 + 1] = d1 * fexp(tot - inc); }
        else { wgt[wid * 128 + p0] = d0 * fexp(inc - a1 - a0); wgt[wid * 128 + p0 + 1] = d1 * fexp(inc - a1); }
        if (lane == 0) ((float*)(P.ws + WS_DEC))[(size_t)sidx(1, b, hh, dir, pc) * 64] = fexp(tot);
    }
    __syncthreads();
    {
#pragma unroll 1
        for (int it = tid; it < 128 * 8; it += 512) { const int p = it >> 3, g8 = it & 7; const int row = row0 + p; float t8[8];
            conv3_8<true>(U, row, 3072 + 256 + g * 64 + 8 * g8, scw, 512, 256 + g * 64 + 8 * g8, scb, t8); scatter8_T(BT, g8, p, t8); }
#pragma unroll 1
        for (int it = tid; it < 2 * 128 * 8; it += 512) { const int hq = it >> 10, p = (it >> 3) & 127, g8 = it & 7; const int row = row0 + p; const int c0 = (2 * g + hq) * 64 + 8 * g8; float x8[8], t8[8];
            conv3_8<true>(U, row, 3072 + c0, scw, 512, c0, scb, x8);
#pragma unroll
            for (int dir = 0; dir < 2; ++dir) { const int cmb = 2 * hq + dir; const float wv = wgt[cmb * 128 + p];
#pragma unroll
                for (int e = 0; e < 8; ++e) t8[e] = x8[e] * wv;
                scatter8_T(XT + cmb * 64 * 136, g8, p, t8); } }
    }
    __syncthreads();
    {
        const int cmb = wid >> 1; const int hh = 2 * g + (cmb >> 1), dir = cmb & 1;
        float* S = (float*)(P.ws + WS_BIG + BIG_STATE) + (size_t)sidx(1, b, hh, dir, pc) * 4096;
#pragma unroll
        for (int mi = 0; mi < 2; ++mi) { const int mt = 2 * (wid & 1) + mi; f32x4 acc[4];
#pragma unroll
            for (int n = 0; n < 4; ++n) acc[n] = (f32x4){0.f, 0.f, 0.f, 0.f};
#pragma unroll
            for (int ks = 0; ks < 4; ++ks) { const bf16x8 a = *(const LAS bf16x8*)(XT + (cmb * 64 + 16 * mt + fr) * 136 + 32 * ks + 8 * fq);
#pragma unroll
                for (int n = 0; n < 4; ++n) { const bf16x8 bb = *(const LAS bf16x8*)(BT + (16 * n + fr) * 136 + 32 * ks + 8 * fq); acc[n] = __builtin_amdgcn_mfma_f32_16x16x32_bf16(a, bb, acc[n], 0, 0, 0); } }
#pragma unroll
            for (int n = 0; n < 4; ++n)
#pragma unroll
                for (int r = 0; r < 4; ++r) S[(16 * mt + 4 * fq + r) * 64 + 16 * n + fr] = acc[n][r]; }
    }
    __syncthreads();
}

__device__ __forceinline__ void ssd_dt_cum(const Ptrs P, int l, int row0, int dir, int h, int wid, int lane, LAS float* cum, LAS float* dtv) {
    if (wid == 0) {
        const float Aneg = -fexp(P.inp(I_SSDALOG)[(l * 2 + dir) * 4 + h]); const float dtb = P.inp(I_SSDDTB)[(l * 2 + dir) * 4 + h]; const float* DT = (const float*)(P.ws + WS_DT);
        const int t0 = 2 * lane, p0 = dir ? 127 - t0 : t0, p1 = dir ? 126 - t0 : t0 + 1;
        const float d0 = softplusf_(DT[(size_t)(row0 + p0) * 8 + dir * 4 + h] + dtb), d1 = softplusf_(DT[(size_t)(row0 + p1) * 8 + dir * 4 + h] + dtb);
        const float a0 = Aneg * d0, a1 = Aneg * d1; const float inc = wave_incl_scan(a0 + a1, lane);
        cum[t0] = inc - a1; cum[t0 + 1] = inc; dtv[t0] = d0; dtv[t0 + 1] = d1;
    }
}

__device__ __forceinline__ void scan_pass2(const Ptrs P, int unit) {
    const int seq = unit >> 1, half = unit & 1; const int kind = seq >> 6, b = (seq >> 3) & 7, h = (seq >> 1) & 3, dir = seq & 1;
    const int e0 = half * 2048 + P.tid * 4; const int base = sidx(kind, b, h, dir, 0);
    float* ST = (float*)(P.ws + WS_BIG + BIG_STATE); const float* DEC = (const float*)(P.ws + WS_DEC);
    const float zf = zero_f(); f32x4 run = (f32x4){zf, zf, zf, zf};
#pragma unroll 1
    for (int q0 = 0; q0 < NCHK; q0 += 8) {
        f32x4 loc[8]; float dd[8];
#pragma unroll
        for (int k = 0; k < 8; ++k) { const int q = (q0 + k < NCHK) ? q0 + k : NCHK - 1; const int pc = chunk_at(dir, q);
            loc[k] = *(const f32x4*)(ST + (size_t)(base + pc) * 4096 + e0); dd[k] = DEC[(size_t)(base + pc) * 64 + (kind == 0 ? (e0 >> 6) : 0)]; }
#pragma unroll
        for (int k = 0; k < 8; ++k) { if (q0 + k < NCHK) { const int pc = chunk_at(dir, q0 + k); *(f32x4*)(ST + (size_t)(base + pc) * 4096 + e0) = run; run = run * dd[k] + loc[k]; } }
    }
}

__device__ __forceinline__ int qk_off(int p, int chunk) { return p * 64 + ((chunk ^ (p & 7)) << 3); }
__device__ __forceinline__ void hgrn_pass3(const Ptrs P, int l, int unit, int unit_next, LAS unsigned char* lds) {
    const int tid = P.tid, lane = tid & 63, wid = tid >> 6, fr = lane & 15, fq = lane >> 4;
    const int pc = unit % NCHK; const int r_ = unit / NCHK; const int h = r_ & 3; const int b = r_ >> 2;
    const int row0 = chunk_row0(b, pc);
    const bf16_t* U = (const bf16_t*)(P.ws + WS_BIG + BIG_U);
    LAS bf16_t* QF = (LAS bf16_t*)lds; LAS bf16_t* KF = QF + 128 * 64; LAS bf16_t* QB = KF + 128 * 64; LAS bf16_t* KB = QB + 128 * 64; LAS bf16_t* VT = KB + 128 * 64;
    LAS bf16_t* STF = VT + 64 * 136; LAS bf16_t* STB = STF + 64 * 72; LAS float* ETF = (LAS float*)(STB + 64 * 72); LAS float* ETB = ETF + 512; LAS bf16_t* PW = (LAS bf16_t*)(ETB + 512);
    LAS float* OUT = (LAS float*)lds;
    {
        LAS bf16_t* FS = PW;
        for (int it = tid; it < 128 * 8; it += 512) { const int p = it >> 3, g8 = it & 7; const bf16_t* ur = U + (size_t)(row0 + p) * UC + h * 64 + 8 * g8;
            const bf16x8 ff8 = *(const bf16x8*)(ur + 1792), fb8 = *(const bf16x8*)(ur + 2048), q8 = *(const bf16x8*)(ur + 1536), v8 = *(const bf16x8*)(ur + 2304);
            *(LAS bf16x8*)(FS + p * 64 + 8 * g8) = ff8; *(LAS bf16x8*)(FS + 8192 + p * 64 + 8 * g8) = fb8;
            float qs[8];
#pragma unroll
            for (int e = 0; e < 8; ++e) qs[e] = bf2f((bf16_t)q8[e]) * 0.125f;
            const bf16x8 qp = pack8(qs); *(LAS bf16x8*)(QF + qk_off(p, g8)) = qp; *(LAS bf16x8*)(QB + qk_off(p, g8)) = qp;
#pragma unroll
            for (int e = 0; e < 8; ++e) VT[(8 * g8 + e) * 136 + p] = (bf16_t)v8[e]; }
        const float* SF = (const float*)(P.ws + WS_BIG + BIG_STATE) + (size_t)sidx(0, b, h, 0, pc) * 4096; const float* SB = (const float*)(P.ws + WS_BIG + BIG_STATE) + (size_t)sidx(0, b, h, 1, pc) * 4096;
#pragma unroll 2
        for (int idx = tid; idx < 4096; idx += 512) { STF[(idx & 63) * 72 + (idx >> 6)] = f2bf(SF[idx]); STB[(idx & 63) * 72 + (idx >> 6)] = f2bf(SB[idx]); }
    }
    __syncthreads();
    {
        LAS bf16_t* FS = PW;
        const int ch = lane, seg = wid; const float lbf = ((const float*)(P.ws + WS_LB))[(0 * 2 + l) * 256 + h * 64 + ch], lbb = ((const float*)(P.ws + WS_LB))[(1 * 2 + l) * 256 + h * 64 + ch];
        float bfw[16], bbw[16], kf[16], kb[16];
#pragma unroll
        for (int j = 0; j < 16; ++j) { const int p = 16 * seg + j;
            const float ff = lbf + (1.0f - lbf) * sigmoidf_(bf2f(FS[p * 64 + ch])), fb = lbb + (1.0f - lbb) * sigmoidf_(bf2f(FS[8192 + p * 64 + ch]));
            bfw[j] = flog(ff); bbw[j] = flog(fb); kf[j] = 1.0f - ff; kb[j] = 1.0f - fb; }
#pragma unroll
        for (int j = 1; j < 16; ++j) bfw[j] += bfw[j - 1];
#pragma unroll
        for (int j = 14; j >= 0; --j) bbw[j] += bbw[j + 1];
        const float etf = bfw[15], etb = bbw[0];
        ETF[seg * 64 + ch] = etf; ETB[seg * 64 + ch] = etb;
        const int chunk = ch >> 3, sub = ch & 7;
#pragma unroll
        for (int j = 0; j < 16; ++j) { const int p = 16 * seg + j; const int o = qk_off(p, chunk) + sub; const float qv = bf2f(QF[o]);
            const unsigned wq = pack2(qv * fexp(bfw[j]), qv * fexp(bbw[j])), wk = pack2(kf[j] * fexp(etf - bfw[j]), kb[j] * fexp(etb - bbw[j]));
            QF[o] = (bf16_t)(wq & 0xffffu); QB[o] = (bf16_t)(wq >> 16); KF[o] = (bf16_t)(wk & 0xffffu); KB[o] = (bf16_t)(wk >> 16); }
    }
    __syncthreads();
    f32x4 o[4];
    {
        const int i = wid; LAS bf16_t* pw = PW + wid * 16 * 136;
#pragma unroll
        for (int nt = 0; nt < 4; ++nt) o[nt] = (f32x4){0.f, 0.f, 0.f, 0.f};
#pragma unroll 1
        for (int dir = 0; dir < 2; ++dir) {
            const LAS bf16_t* QA = dir ? QB : QF; const LAS bf16_t* KA = dir ? KB : KF; const LAS float* ET = dir ? ETB : ETF; const LAS bf16_t* ST = dir ? STB : STF;
            bf16x8 qf[2]; float g[2][8];
#pragma unroll
            for (int ks = 0; ks < 2; ++ks) { qf[ks] = *(const LAS bf16x8*)(QA + qk_off(16 * i + fr, 4 * ks + fq));
                const f32x4 e0 = *(const LAS f32x4*)(ET + i * 64 + 32 * ks + 8 * fq), e1 = *(const LAS f32x4*)(ET + i * 64 + 32 * ks + 8 * fq + 4);
                g[ks][0] = -e0[0]; g[ks][1] = -e0[1]; g[ks][2] = -e0[2]; g[ks][3] = -e0[3]; g[ks][4] = -e1[0]; g[ks][5] = -e1[1]; g[ks][6] = -e1[2]; g[ks][7] = -e1[3]; }
            const int nj = dir ? 8 - i : i + 1;
            for (int jj = 0; jj < nj; ++jj) { const int j = dir ? i + jj : i - jj;
                f32x4 d = (f32x4){0.f, 0.f, 0.f, 0.f};
#pragma unroll
                for (int ks = 0; ks < 2; ++ks) { float a8[8];
#pragma unroll
                    for (int e = 0; e < 8; ++e) a8[e] = bf2f((bf16_t)qf[ks][e]) * fexp(g[ks][e]);
                    const bf16x8 kfr = *(const LAS bf16x8*)(KA + qk_off(16 * j + fr, 4 * ks + fq));
                    d = __builtin_amdgcn_mfma_f32_16x16x32_bf16(kfr, pack8(a8), d, 0, 0, 0);
                    const f32x4 e0 = *(const LAS f32x4*)(ET + j * 64 + 32 * ks + 8 * fq), e1 = *(const LAS f32x4*)(ET + j * 64 + 32 * ks + 8 * fq + 4);
                    g[ks][0] += e0[0]; g[ks][1] += e0[1]; g[ks][2] += e0[2]; g[ks][3] += e0[3]; g[ks][4] += e1[0]; g[ks][5] += e1[1]; g[ks][6] += e1[2]; g[ks][7] += e1[3]; }
                if (jj == 0) {
#pragma unroll
                    for (int r = 0; r < 4; ++r) d[r] = (dir ? (4 * fq + r >= fr) : (4 * fq + r <= fr)) ? d[r] : 0.f; }
                u32x2 w; w.x = pack2(d[0], d[1]); w.y = pack2(d[2], d[3]); *(LAS u32x2*)(pw + fr * 136 + 16 * j + 4 * fq) = w;
            }
            { const int zb = dir ? i - 1 : i + 1; const bool need = dir ? ((i & 1) == 1) : ((i & 1) == 0);
              if (need) { u32x2 z; z.x = __float_as_uint(zero_f()); z.y = z.x; *(LAS u32x2*)(pw + fr * 136 + 16 * zb + 4 * fq) = z; } }
            const int kslo = dir ? (i >> 1) : 0, kshi = dir ? 3 : (i >> 1);
            for (int ks = kslo; ks <= kshi; ++ks) { const bf16x8 pa = *(const LAS bf16x8*)(pw + fr * 136 + 32 * ks + 8 * fq);
#pragma unroll
                for (int nt = 0; nt < 4; ++nt) { const bf16x8 vf = *(const LAS bf16x8*)(VT + (16 * nt + fr) * 136 + 32 * ks + 8 * fq); o[nt] = __builtin_amdgcn_mfma_f32_16x16x32_bf16(pa, vf, o[nt], 0, 0, 0); } }
#pragma unroll
            for (int ks = 0; ks < 2; ++ks) { float a8[8];
#pragma unroll
                for (int e = 0; e < 8; ++e) a8[e] = bf2f((bf16_t)qf[ks][e]) * fexp(g[ks][e]);
                const bf16x8 qa = pack8(a8);
#pragma unroll
                for (int nt = 0; nt < 4; ++nt) { const bf16x8 sf = *(const LAS bf16x8*)(ST + (16 * nt + fr) * 72 + 32 * ks + 8 * fq); o[nt] = __builtin_amdgcn_mfma_f32_16x16x32_bf16(qa, sf, o[nt], 0, 0, 0); } }
        }
    }
    __syncthreads();
#pragma unroll
    for (int nt = 0; nt < 4; ++nt)
#pragma unroll
        for (int r = 0; r < 4; ++r) OUT[(16 * wid + 4 * fq + r) * 64 + 16 * nt + fr] = o[nt][r];
    __syncthreads();
    {
        const int pos = tid >> 2, qd = tid & 3; const int row = row0 + pos; bf16_t* BR2 = (bf16_t*)(P.ws + WS_BR) + (size_t)2 * T * 256;
        const bf16_t* gp = U + (size_t)row * UC + 2560 + h * 64 + 16 * qd; const bf16x8 g0 = *(const bf16x8*)gp, g1 = *(const bf16x8*)(gp + 8);
        const float* ngp = P.inp(I_HGNG) + l * 64 + 16 * qd; float ov[16], q = 0.f;
#pragma unroll
        for (int e4 = 0; e4 < 4; ++e4) { const f32x4 v = *(const LAS f32x4*)(OUT + pos * 64 + 16 * qd + 4 * e4); ov[4 * e4] = v[0]; ov[4 * e4 + 1] = v[1]; ov[4 * e4 + 2] = v[2]; ov[4 * e4 + 3] = v[3]; q += v[0] * v[0] + v[1] * v[1] + v[2] * v[2] + v[3] * v[3]; }
        q += __shfl_xor(q, 1); q += __shfl_xor(q, 2);
        const float rs = rsqrtf(q * (1.0f / 64.0f) + kconst(RMS_EPS)); float t8[8];
#pragma unroll
        for (int e = 0; e < 8; ++e) t8[e] = ov[e] * rs * ngp[e] * siluf_(bf2f((bf16_t)g0[e]));
        *(bf16x8*)(BR2 + (size_t)row * 256 + h * 64 + 16 * qd) = pack8(t8);
#pragma unroll
        for (int e = 0; e < 8; ++e) t8[e] = ov[8 + e] * rs * ngp[8 + e] * siluf_(bf2f((bf16_t)g1[e]));
        *(bf16x8*)(BR2 + (size_t)row * 256 + h * 64 + 16 * qd + 8) = pack8(t8);
    }
    __syncthreads();
}

__device__ __forceinline__ void ssd_pass3(const Ptrs P, int l, int unit, LAS unsigned char* lds) {
    const int tid = P.tid, lane = tid & 63, wid = tid >> 6, fr = lane & 15, fq = lane >> 4;
    const int pc = unit % NCHK; const int r_ = unit / NCHK; const int g = r_ & 1; const int b = r_ >> 1;
    const int row0 = chunk_row0(b, pc);
    const bf16_t* U = (const bf16_t*)(P.ws + WS_BIG + BIG_U);
    const float* scw = P.inp(I_SSDCW) + (size_t)l * 3 * 512; const float* scb = P.inp(I_SSDCB) + l * 512;
    LAS bf16_t* CM = (LAS bf16_t*)lds; LAS bf16_t* BM = CM + 128 * 72; LAS bf16_t* XT = BM + 128 * 72; LAS bf16_t* STF = XT + 64 * 136; LAS bf16_t* STB = STF + 64 * 72;
    LAS float* cumfA = (LAS float*)(STB + 64 * 72); LAS float* cumbA = cumfA + 256; LAS float* dtfA = cumbA + 256; LAS float* dtbA = dtfA + 256;
    LAS bf16_t* PW = (LAS bf16_t*)(dtbA + 256); LAS float* OUT = (LAS float*)(PW + 8 * 16 * 136);
    if (wid < 4) {
        const int hq = wid >> 1, dir = wid & 1, h = 2 * g + hq; const float Aneg = -fexp(P.inp(I_SSDALOG)[(l * 2 + dir) * 4 + h]); const float dtbias = P.inp(I_SSDDTB)[(l * 2 + dir) * 4 + h]; const float* DT = (const float*)(P.ws + WS_DT);
        const int p0 = 2 * lane; const float d0 = softplusf_(DT[(size_t)(row0 + p0) * 8 + dir * 4 + h] + dtbias), d1 = softplusf_(DT[(size_t)(row0 + p0 + 1) * 8 + dir * 4 + h] + dtbias);
        const float a0 = Aneg * d0, a1 = Aneg * d1; const float inc = wave_incl_scan(a0 + a1, lane);
        if (dir == 0) { cumfA[hq * 128 + p0] = inc - a1; cumfA[hq * 128 + p0 + 1] = inc; dtfA[hq * 128 + p0] = d0; dtfA[hq * 128 + p0 + 1] = d1; }
        else { const float tot = __uint_as_float(__builtin_amdgcn_readlane(__float_as_uint(inc), 63)); cumbA[hq * 128 + p0] = tot - inc + a0 + a1; cumbA[hq * 128 + p0 + 1] = tot - inc + a1; dtbA[hq * 128 + p0] = d0; dtbA[hq * 128 + p0 + 1] = d1; }
    }
    {
        const int pos = tid >> 2, qd = tid & 3; const int row = row0 + pos;
#pragma unroll 1
        for (int pcs = 0; pcs < 4; ++pcs) { const int isb = pcs >> 1, hf = pcs & 1; const int cc = (isb ? 256 : 384) + g * 64 + 16 * qd + 8 * hf; float t8[8];
            conv3_silu8(U, row, 3072 + cc, scw, 512, cc, scb, t8);
            *(LAS bf16x8*)((isb ? BM : CM) + pos * 72 + 16 * qd + 8 * hf) = pack8(t8); }
    }
#pragma unroll 1
    for (int hq = 0; hq < 2; ++hq) {
        const int h = 2 * g + hq;
        for (int it = tid; it < 128 * 8; it += 512) { const int p = it >> 3, g8 = it & 7; float x8[8];
            conv3_8<true>(U, row0 + p, 3072 + h * 64 + 8 * g8, scw, 512, h * 64 + 8 * g8, scb, x8); scatter8_T(XT, g8, p, x8); }
        __builtin_amdgcn_sched_barrier(0);
        LAS float* cumf = cumfA + hq * 128; LAS float* cumb = cumbA + hq * 128; LAS float* dtf = dtfA + hq * 128; LAS float* dtb = dtbA + hq * 128;
        {
            const float* SF = (const float*)(P.ws + WS_BIG + BIG_STATE) + (size_t)sidx(1, b, h, 0, pc) * 4096; const float* SB = (const float*)(P.ws + WS_BIG + BIG_STATE) + (size_t)sidx(1, b, h, 1, pc) * 4096;
#pragma unroll
            for (int k = 0; k < 2; ++k) { const int idx = (tid + 512 * k) * 4; const f32x4 a = *(const f32x4*)(SF + idx), c = *(const f32x4*)(SB + idx);
                u32x2 wa, wc; wa.x = pack2(a[0], a[1]); wa.y = pack2(a[2], a[3]); wc.x = pack2(c[0], c[1]); wc.y = pack2(c[2], c[3]);
                *(LAS u32x2*)(STF + (idx >> 6) * 72 + (idx & 63)) = wa; *(LAS u32x2*)(STB + (idx >> 6) * 72 + (idx & 63)) = wc; }
        }
        float rxs[16]; bf16x8 rz[2];
        { const int pos = tid >> 2, qd = tid & 3; const int row = row0 + pos; const int c0 = h * 64 + 16 * qd; const bf16_t* zp = U + (size_t)row * UC + 2816 + c0;
#pragma unroll
          for (int hf = 0; hf < 2; ++hf) { float xs[8]; conv3_silu8(U, row, 3072 + c0 + 8 * hf, scw, 512, c0 + 8 * hf, scb, xs); rz[hf] = *(const bf16x8*)(zp + 8 * hf);
#pragma unroll
              for (int e = 0; e < 8; ++e) rxs[8 * hf + e] = xs[e]; } }
        __syncthreads();
        {
            const int i = wid; LAS bf16_t* pw = PW + wid * 16 * 136;
            bf16x8 cf[2];
#pragma unroll
            for (int ks = 0; ks < 2; ++ks) cf[ks] = *(const LAS bf16x8*)(CM + (16 * i + fr) * 72 + 32 * ks + 8 * fq);
            f32x4 o[4];
#pragma unroll
            for (int nt = 0; nt < 4; ++nt) o[nt] = (f32x4){0.f, 0.f, 0.f, 0.f};
#pragma unroll 1
            for (int dir = 0; dir < 2; ++dir) {
                const LAS float* cum = dir ? cumb : cumf; const LAS float* dtv = dir ? dtb : dtf; const LAS bf16_t* ST = dir ? STB : STF;
                const float cq = cum[16 * i + fr];
                const int jlo = dir ? i : 0, jhi = dir ? 7 : i;
                for (int j = jlo; j <= jhi; ++j) {
                    f32x4 d = (f32x4){0.f, 0.f, 0.f, 0.f};
#pragma unroll
                    for (int ks = 0; ks < 2; ++ks) { const bf16x8 bf_ = *(const LAS bf16x8*)(BM + (16 * j + fr) * 72 + 32 * ks + 8 * fq); d = __builtin_amdgcn_mfma_f32_16x16x32_bf16(bf_, cf[ks], d, 0, 0, 0); }
                    const f32x4 cs = *(const LAS f32x4*)(cum + 16 * j + 4 * fq), ds = *(const LAS f32x4*)(dtv + 16 * j + 4 * fq);
#pragma unroll
                    for (int r = 0; r < 4; ++r) { const bool keep = (j != i) || (dir ? (4 * fq + r >= fr) : (4 * fq + r <= fr)); d[r] = keep ? d[r] * fexp(cq - cs[r]) * ds[r] : 0.f; }
                    u32x2 w; w.x = pack2(d[0], d[1]); w.y = pack2(d[2], d[3]); *(LAS u32x2*)(pw + fr * 136 + 16 * j + 4 * fq) = w;
                }
                { const int zb = dir ? i - 1 : i + 1; const bool need = dir ? ((i & 1) == 1) : ((i & 1) == 0);
                  if (need) { u32x2 z; z.x = __float_as_uint(zero_f()); z.y = z.x; *(LAS u32x2*)(pw + fr * 136 + 16 * zb + 4 * fq) = z; } }
                const int kslo = dir ? (i >> 1) : 0, kshi = dir ? 3 : (i >> 1);
                for (int ks = kslo; ks <= kshi; ++ks) { const bf16x8 pa = *(const LAS bf16x8*)(pw + fr * 136 + 32 * ks + 8 * fq);
#pragma unroll
                    for (int nt = 0; nt < 4; ++nt) { const bf16x8 xf = *(const LAS bf16x8*)(XT + (16 * nt + fr) * 136 + 32 * ks + 8 * fq); o[nt] = __builtin_amdgcn_mfma_f32_16x16x32_bf16(pa, xf, o[nt], 0, 0, 0); } }
                f32x4 o2[4];
#pragma unroll
                for (int nt = 0; nt < 4; ++nt) o2[nt] = (f32x4){0.f, 0.f, 0.f, 0.f};
#pragma unroll
                for (int ks = 0; ks < 2; ++ks)
#pragma unroll
                    for (int nt = 0; nt < 4; ++nt) { const bf16x8 sf = *(const LAS bf16x8*)(ST + (16 * nt + fr) * 72 + 32 * ks + 8 * fq); o2[nt] = __builtin_amdgcn_mfma_f32_16x16x32_bf16(cf[ks], sf, o2[nt], 0, 0, 0); }
                const f32x4 ct = *(const LAS f32x4*)(cum + 16 * i + 4 * fq);
#pragma unroll
                for (int nt = 0; nt < 4; ++nt)
#pragma unroll
                    for (int r = 0; r < 4; ++r) o[nt][r] += fexp(ct[r]) * o2[nt][r];
            }
#pragma unroll
            for (int nt = 0; nt < 4; ++nt)
#pragma unroll
                for (int r = 0; r < 4; ++r) OUT[(16 * i + 4 * fq + r) * 64 + 16 * nt + fr] = o[nt][r];
        }
        __syncthreads();
        {
            const int pos = tid >> 2, qd = tid & 3; const int row = row0 + pos; const int c0 = h * 64 + 16 * qd;
            const float Dh = P.inp(I_SSDD)[l * 4 + h]; const float* ngp = P.inp(I_SSDNG) + l * 256 + c0; bf16_t* BR3 = (bf16_t*)(P.ws + WS_BR) + (size_t)3 * T * 256; float* SSQ = (float*)(P.ws + WS_SSQ);
            float q = 0.f;
#pragma unroll
            for (int hf = 0; hf < 2; ++hf) { float xs[8];
#pragma unroll
                for (int e = 0; e < 8; ++e) xs[e] = rxs[8 * hf + e];
                const bf16x8 z8 = rz[hf]; float t8[8];
#pragma unroll
                for (int e4 = 0; e4 < 2; ++e4) { const f32x4 ov = *(const LAS f32x4*)(OUT + pos * 64 + 16 * qd + 8 * hf + 4 * e4);
#pragma unroll
                    for (int e = 0; e < 4; ++e) { const int ii = 4 * e4 + e; const float vv = (ov[e] + xs[ii] * Dh) * siluf_(bf2f((bf16_t)z8[ii])); q += vv * vv; t8[ii] = vv * ngp[8 * hf + ii]; } }
                *(bf16x8*)(BR3 + (size_t)row * 256 + c0 + 8 * hf) = pack8(t8); }
            q += __shfl_xor(q, 1); q += __shfl_xor(q, 2);
            if (qd == 0) SSQ[(size_t)row * 4 + h] = q;
        }
        __syncthreads();
    }
}

typedef float f32x2 __attribute__((ext_vector_type(2)));
__device__ __forceinline__ f32x2 cmul(f32x2 a, f32x2 b) { return (f32x2){a.x * b.x - a.y * b.y, a.x * b.y + a.y * b.x}; }
__device__ __forceinline__ f32x2 cmulc(f32x2 a, f32x2 b) { return (f32x2){a.x * b.x + a.y * b.y, a.y * b.x - a.x * b.y}; }
__device__ __forceinline__ int fphys(int i) { return i + (i >> 4); }
template <int LO, int NST, bool INV>
__device__ __forceinline__ void fft_stages(f32x2 (&x)[16], const LAS f32x2* TW, int low) {
#pragma unroll
    for (int mm = 0; mm < NST; ++mm) { const int m = INV ? mm : NST - 1 - mm; const int s = LO + m;
#pragma unroll
        for (int j = 0; j < 16; ++j) { if (j & (1 << m)) continue; const int j2 = j | (1 << m);
            const int k = ((j & ((1 << m) - 1)) << LO) | low; const f32x2 tw = TW[k << (12 - s)];
            const f32x2 a = x[j], b = x[j2];
            if (!INV) { x[j] = a + b; x[j2] = cmul(a - b, tw); } else { const f32x2 bt = cmulc(b, tw); x[j] = a + bt; x[j2] = a - bt; } } }
}
template <int LO, int NST, bool INV>
__device__ __forceinline__ void fft_pass(LAS f32x2* X, const LAS f32x2* TW, int tid) {
    const int low = tid & ((1 << LO) - 1), high = tid >> LO; const int base = low | (high << (LO + 4));
    f32x2 x[16];
#pragma unroll
    for (int j = 0; j < 16; ++j) x[j] = X[fphys(base | (j << LO))];
    fft_stages<LO, NST, INV>(x, TW, low);
#pragma unroll
    for (int j = 0; j < 16; ++j) X[fphys(base | (j << LO))] = x[j];
}
__device__ __forceinline__ void hyena_fft_unit(const Ptrs P, int l, int c, LAS unsigned char* lds) {
    const int tid = P.tid, lane = tid & 63;
    LAS f32x2* X = (LAS f32x2*)lds; LAS f32x2* TW = X + 8704;
    const f32x2* TWg = (const f32x2*)(P.ws + WS_TW);
    for (int i = tid; i < 4096; i += 512) TW[i] = TWg[i];
    float nrm; { const float* part = (const float*)(P.ws + WS_PART) + (size_t)l * 64 * 512; nrm = wave_sum(part[lane * 512 + c] + part[lane * 512 + 256 + c]); }
    const float inv = 1.0f / nrm; const float* filt = (const float*)(P.ws + WS_FILT) + (size_t)l * 8192 * 256 + c;
    f32x2* Fg = (f32x2*)(P.ws + WS_BR) + (size_t)P.bid * 8192;
    __syncthreads();
    {
        f32x2 x[16];
#pragma unroll
        for (int j = 0; j < 16; ++j) x[j] = (f32x2){filt[(size_t)(tid + 512 * j) * 256] * inv, 0.f};
        fft_stages<9, 4, false>(x, TW, tid);
#pragma unroll
        for (int j = 0; j < 16; ++j) X[fphys(tid | (j << 9))] = x[j];
        __syncthreads(); fft_pass<5, 4, false>(X, TW, tid); __syncthreads(); fft_pass<2, 3, false>(X, TW, tid); __syncthreads();
#pragma unroll
        for (int j = 0; j < 16; ++j) x[j] = X[fphys((tid << 4) | j)];
        fft_stages<0, 2, false>(x, TW, 0);
#pragma unroll
        for (int j = 0; j < 16; ++j) Fg[(tid << 4) | j] = x[j];
    }
    unsigned* WTt = (unsigned*)(P.ws + WS_BIG + BIG_WT); const float bias = P.inp(I_HYBIAS)[l * 256 + c];
    for (int p = 0; p < 4; ++p) {
        unsigned* wp = WTt + ((size_t)c * 4 + p) * 4096;
        f32x2 x[16]; unsigned wraw[8];
#pragma unroll
        for (int j = 0; j < 8; ++j) { wraw[j] = wp[tid + 512 * j]; x[j] = (f32x2){__uint_as_float(wraw[j] << 16), __uint_as_float(wraw[j] & 0xffff0000u)}; }
#pragma unroll
        for (int j = 8; j < 16; ++j) x[j] = (f32x2){0.f, 0.f};
        fft_stages<9, 4, false>(x, TW, tid);
        __syncthreads();
#pragma unroll
        for (int j = 0; j < 16; ++j) X[fphys(tid | (j << 9))] = x[j];
        __syncthreads(); fft_pass<5, 4, false>(X, TW, tid); __syncthreads(); fft_pass<2, 3, false>(X, TW, tid); __syncthreads();
#pragma unroll
        for (int j = 0; j < 16; ++j) x[j] = X[fphys((tid << 4) | j)];
        fft_stages<0, 2, false>(x, TW, 0);
#pragma unroll
        for (int j = 0; j < 16; ++j) x[j] = cmul(x[j], Fg[(tid << 4) | j]);
        fft_stages<0, 2, true>(x, TW, 0);
#pragma unroll
        for (int j = 0; j < 16; ++j) X[fphys((tid << 4) | j)] = x[j];
        __syncthreads(); fft_pass<2, 3, true>(X, TW, tid); __syncthreads(); fft_pass<5, 4, true>(X, TW, tid); __syncthreads();
#pragma unroll
        for (int j = 0; j < 16; ++j) x[j] = X[fphys(tid | (j << 9))];
        fft_stages<9, 4, true>(x, TW, tid);
#pragma unroll
        for (int j = 0; j < 8; ++j) { const f32x2 y = x[j] * (1.0f / 8192.0f); const unsigned w = wraw[j];
            wp[tid + 512 * j] = pack2(y.x + __uint_as_float(w << 16) * bias, y.y + __uint_as_float(w & 0xffff0000u) * bias); }
    }
    __syncthreads();
}

#define DYNQ_BEGIN(ctrp, NUq) { volatile LAS unsigned* slot_ = (volatile LAS unsigned*)(lds + LDS_MISC + 64); unsigned* ctr_ = (ctrp); const bool t0_ = (P.tid == 0); \
    if (t0_) slot_[0] = __hip_atomic_fetch_add(ctr_, 1u, __ATOMIC_RELAXED, __HIP_MEMORY_SCOPE_AGENT); __syncthreads(); \
    unsigned u_ = (unsigned)__builtin_amdgcn_readfirstlane((int)slot_[0]); __syncthreads(); \
    while (u_ < (unsigned)(NUq)) { unsigned tn_ = 0u; if (t0_) tn_ = __hip_atomic_fetch_add(ctr_, 1u, __ATOMIC_RELAXED, __HIP_MEMORY_SCOPE_AGENT); const int u = (int)u_;
#define DYNQ_END() __syncthreads(); if (t0_) slot_[0] = tn_; __syncthreads(); u_ = (unsigned)__builtin_amdgcn_readfirstlane((int)slot_[0]); } }
__device__ __forceinline__ void phase_m1(const Ptrs P, int l, LAS unsigned char* lds) {
    const int tid = P.tid;
    const bf16_t* U = (const bf16_t*)(P.ws + WS_BIG + BIG_U);
    const float* hcw = P.inp(I_HYCW) + (size_t)l * 3 * 768; const float* hcb = P.inp(I_HYCB) + l * 768;
    const int NH = NB * 4 * NCHK, NSS = NB * 2 * NCHK;
    const int NS2 = NH + NSS;
    const int NU = NS2 + 256 + (l == 0 ? NCTX / 64 : 0);
    DYNQ_BEGIN((unsigned*)(P.ws + WS_CTL + CTL_DYN) + 16 + l, NU)
        Ptrs Pu = P; asm volatile("" : "+v"(Pu.tid));
        if (u < NSS) ssd_pass1(Pu, l, u, lds);
        else if (u < NS2) hgrn_pass1(Pu, l, u - NSS, lds);
        else if (u < NS2 + 256) { const int tid = Pu.tid;
            const int ub = u - NS2; const int p = ub >> 6, tb = ub & 63; const int c = tid & 255; LAS unsigned* tile = (LAS unsigned*)lds;
            for (int it = tid; it < 2 * 64 * 32; it += 512) { const int b2 = it >> 11, rr = (it >> 5) & 63, g8 = it & 31; const int row = (2 * p + b2) * SEQ + tb * 64 + rr; float x1[8], vv[8];
                conv3_8<false>(U, row, 256 + 8 * g8, hcw, 768, 256 + 8 * g8, hcb, x1); conv3_8<false>(U, row, 512 + 8 * g8, hcw, 768, 512 + 8 * g8, hcb, vv);
                LAS bf16_t* th = (LAS bf16_t*)tile + b2;
#pragma unroll
                for (int e2 = 0; e2 < 4; ++e2) { const unsigned w = pack2(x1[2 * e2] * vv[2 * e2], x1[2 * e2 + 1] * vv[2 * e2 + 1]);
                    th[2 * ((8 * g8 + 2 * e2) * 65 + rr)] = (bf16_t)(w & 0xffffu); th[2 * ((8 * g8 + 2 * e2 + 1) * 65 + rr)] = (bf16_t)(w >> 16); } }
            __syncthreads();
            { unsigned* WTt = (unsigned*)(P.ws + WS_BIG + BIG_WT); const int t = tid & 63;
              for (int cc = tid >> 6; cc < 256; cc += 8) WTt[((size_t)cc * 4 + p) * 4096 + tb * 64 + t] = tile[cc * 65 + t]; }
            __syncthreads();
        } else { const int tid = Pu.tid;
            const int ub = u - NS2 - 256; const int c = tid & 255; bf16_t* WTC = (bf16_t*)(P.ws + WS_BIG + BIG_WT) + (size_t)NLAT * 256;
#pragma unroll 4
            for (int rr = tid >> 8; rr < 64; rr += 2) { const int row = NLAT + ub * 64 + rr;
                const float x1 = conv3_u(U, row, 256 + c, hcw, 768, 256 + c) + hcb[256 + c]; const float v = conv3_u(U, row, 512 + c, hcw, 768, 512 + c) + hcb[512 + c];
                WTC[(size_t)(row - NLAT) * 256 + c] = f2bf(x1 * v); } }
    DYNQ_END()
}

__device__ __forceinline__ void phase_m2(const Ptrs P, int l, LAS unsigned char* lds) {
    const int tid = P.tid, G = P.G;
    const bf16_t* U = (const bf16_t*)(P.ws + WS_BIG + BIG_U); bf16_t* BR = (bf16_t*)(P.ws + WS_BR);
    const float* hcw = P.inp(I_HYCW) + (size_t)l * 3 * 768; const float* hcb = P.inp(I_HYCB) + l * 768;
    const int NU_F = 256, NU_P2 = 256, NU_HC = (l == 0) ? NB * 8 : 0;
    const int NU = NU_F + NU_P2 + NU_HC;
    for (int u = P.bid; u < NU; u += G) {
        if (u < NU_F) { hyena_fft_unit(P, l, u, lds); continue; }
        if (u < NU_F + NU_P2) { scan_pass2(P, u - NU_F); continue; }
        {
            const int uu = u - NU_F - NU_P2; const int b = uu >> 3, cb = uu & 7; const int cl = tid & 31, tg = tid >> 5; const int c = cb * 32 + cl;
            const int base = NLAT + b * CTXL; const bf16_t* WTC = (const bf16_t*)(P.ws + WS_BIG + BIG_WT) + (size_t)NLAT * 256 + (size_t)b * CTXL * 256;
            LAS float* wl = (LAS float*)lds; LAS float* fl = wl + 256 * 32;
            const float inv = 1.0f / hy_norm(P, 2, c); const float* filt = (const float*)(P.ws + WS_FILTC);
            for (int i = tid; i < 256 * 32; i += 512) wl[i] = bf2f(WTC[(size_t)(i >> 5) * 256 + cb * 32 + (i & 31)]);
            for (int i = tid >> 5; i < 512; i += 16) fl[i * 32 + cl] = filt[(size_t)i * 256 + c] * inv;
            __syncthreads();
            float acc[16];
#pragma unroll
            for (int j = 0; j < 16; ++j) acc[j] = 0.f;
#pragma unroll 1
            for (int sb = 0; sb < 16; ++sb) {
                float fw[31], wv[16];
#pragma unroll
                for (int q = 0; q < 31; ++q) fw[q] = fl[((16 * tg - 16 * sb - 15 + q) & 511) * 32 + cl];
#pragma unroll
                for (int k = 0; k < 16; ++k) wv[k] = wl[(16 * sb + k) * 32 + cl];
#pragma unroll
                for (int j = 0; j < 16; ++j)
#pragma unroll
                    for (int k = 0; k < 16; ++k) acc[j] += fw[j - k + 15] * wv[k];
            }
            const float bias = P.inp(I_HYBIAS)[l * 256 + c];
#pragma unroll 4
            for (int j = 0; j < 16; ++j) { const int tt = 16 * tg + j; const int row = base + tt; const float x0 = conv3_u(U, row, c, hcw, 768, c) + hcb[c];
                BR[(size_t)row * 256 + c] = f2bf(x0 * (acc[j] + wl[tt * 32 + cl] * bias)); }
            __syncthreads();
        }
    }
}

__device__ __forceinline__ void phase_m3(const Ptrs P, int l, LAS unsigned char* lds) {
    const int tid = P.tid;
    const bool last = (l == NLAYER - 1); const int rows_l = last ? NLAT : T; const int nch = last ? NCHK - 2 : NCHK;
    const bf16_t* U = (const bf16_t*)(P.ws + WS_BIG + BIG_U); bf16_t* BR = (bf16_t*)(P.ws + WS_BR);
    const int NSS3 = NB * 2 * nch, NH3 = NB * 4 * nch;
    const int NS3T = NSS3 + NH3;
    const int NU = NS3T + rows_l / 64 + 256;
    const float* hcw = P.inp(I_HYCW) + (size_t)l * 3 * 768; const float* hcb = P.inp(I_HYCB) + l * 768;
    DYNQ_BEGIN((unsigned*)(P.ws + WS_CTL + CTL_DYN) + 24 + l, NU)
        if (u >= NS3T + rows_l / 64) {
            const int ub = u - NS3T - rows_l / 64; const int p = ub >> 6, tb = ub & 63; LAS unsigned* tile = (LAS unsigned*)lds; const unsigned* WTt = (const unsigned*)(P.ws + WS_BIG + BIG_WT);
            { const int t = tid & 63; for (int cc = tid >> 6; cc < 256; cc += 8) tile[cc * 65 + t] = WTt[((size_t)cc * 4 + p) * 4096 + tb * 64 + t]; }
            __syncthreads();
            for (int it = tid; it < 64 * 32; it += 512) { const int rr = it >> 5, g8 = it & 31; unsigned yw[8];
#pragma unroll
                for (int e = 0; e < 8; ++e) yw[e] = tile[(8 * g8 + e) * 65 + rr];
#pragma unroll
                for (int b2 = 0; b2 < 2; ++b2) { const int row = (2 * p + b2) * SEQ + tb * 64 + rr; float x0[8], t8[8]; conv3_8<false>(U, row, 8 * g8, hcw, 768, 8 * g8, hcb, x0);
#pragma unroll
                    for (int e = 0; e < 8; ++e) t8[e] = x0[e] * (b2 ? __uint_as_float(yw[e] & 0xffff0000u) : __uint_as_float(yw[e] << 16));
                    *(bf16x8*)(BR + (size_t)row * 256 + 8 * g8) = pack8(t8); } }
            __syncthreads(); }
        else if (u < NS3T) { const int uc = u < NSS3 ? u : u - NSS3; const int rq = last ? (uc >> 5) : uc / NCHK; const int uu = rq * NCHK + (uc - rq * nch) + (NCHK - nch);
            Ptrs Pu = P; int lu = l; asm volatile("" : "+v"(Pu.tid), "+s"(lu));
            if (u < NSS3) ssd_pass3(Pu, lu, uu, lds); else hgrn_pass3(Pu, lu, uu, -1, lds); }
        else { const int rb = u - NS3T; const float* cw = P.inp(I_SCCW) + (size_t)l * 3 * 256;
            for (int it = tid; it < 64 * 32; it += 512) { const int row = rb * 64 + (it >> 5), g8 = it & 31; const bool hp = row_has_prev(row), hn = row_has_next(row);
                const bf16_t* u0 = U + (size_t)row * UC + 8 * g8; const bf16_t* up = U + (size_t)(hp ? row - 1 : row) * UC + 8 * g8; const bf16_t* un = U + (size_t)(hn ? row + 1 : row) * UC + 8 * g8;
                const bf16x8 bg = *(const bf16x8*)(u0 + 768), c0 = *(const bf16x8*)(u0 + 1024), x0 = *(const bf16x8*)(u0 + 1280), cp = *(const bf16x8*)(up + 1024), xp = *(const bf16x8*)(up + 1280), cn = *(const bf16x8*)(un + 1024), xn = *(const bf16x8*)(un + 1280);
                const float mp = hp ? 1.0f : 0.0f, mn = hn ? 1.0f : 0.0f; float t8[8];
#pragma unroll
                for (int e = 0; e < 8; ++e) { const int c = 8 * g8 + e;
                    const float acc = bf2f((bf16_t)c0[e]) * bf2f((bf16_t)x0[e]) * cw[256 + c] + mp * bf2f((bf16_t)cp[e]) * bf2f((bf16_t)xp[e]) * cw[c] + mn * bf2f((bf16_t)cn[e]) * bf2f((bf16_t)xn[e]) * cw[512 + c];
                    t8[e] = bf2f((bf16_t)bg[e]) * acc; }
                *(bf16x8*)(BR + (size_t)T * 256 + (size_t)row * 256 + 8 * g8) = pack8(t8); } }
    DYNQ_END()
}

__device__ __forceinline__ void phase_g2(const Ptrs P, int l, LAS unsigned char* lds) {
    const int MT = ((l == NLAYER - 1) ? NLAT : T) / 256;
    pg8::Gemm g{(const bf16_t*)(P.ws + WS_BR), (const bf16_t*)(P.ws + WS_WBR), 256};
    EpiP E{(bf16_t*)(P.ws + WS_BIG + BIG_P), (const float*)(P.ws + WS_SSQ)};
    SchedG2 S{XOrder{P.G, P.bid, MT, 16}};
    pg8::gemm_phase<EpiP, SchedG2, false>(P.tid, lds, g, S, E);
}
__device__ __forceinline__ void phase_g3(const Ptrs P, int l, LAS unsigned char* lds) {
    const int MT = ((l == NLAYER - 1) ? NLAT : T) / 256;
    pg8::Gemm g{(const bf16_t*)(P.ws + WS_HBUF), (const bf16_t*)(P.ws + WS_WG), D};
    EpiMerge E{(const bf16_t*)(P.ws + WS_BIG + BIG_P), (const float*)(P.ws + WS_BGP), (bf16_t*)(P.ws + WS_BR)};
    SchedMN S{XOrder{P.G, P.bid, MT, 16}};
    pg8::gemm_phase<EpiMerge, SchedMN, false>(P.tid, lds, g, S, E);
}
__device__ __forceinline__ void phase_g4(const Ptrs P, int l, LAS unsigned char* lds) {
    const int MT = ((l == NLAYER - 1) ? NLAT : T) / 256;
    pg8::Gemm g{(const bf16_t*)(P.ws + WS_BR), (const bf16_t*)(P.ws + WS_WO), D};
    EpiWo E{P, l};
    SchedMN S{XOrder{P.G, P.bid, MT, 4}};
    pg8::gemm_phase<EpiWo, SchedMN, false>(P.tid, lds, g, S, E);
    dyn_tiles(P.tid, (unsigned*)(P.ws + WS_CTL + CTL_DYN) + l, NCONV_EX, (volatile LAS unsigned*)(lds + LDS_MISC + 64), ConvEx{P, l, (LAS float*)lds});
}

__device__ __forceinline__ void phase_e5(const Ptrs P, int l, LAS unsigned char* lds) {
    const int tid = P.tid, wid = tid >> 6, lane = tid & 63, G = P.G, fr = lane & 15, fq = lane >> 4;
    const int rows_l = (l == NLAYER - 1) ? NLAT : T;
    LAS bf16_t* wrH = (LAS bf16_t*)lds;
    LAS bf16_t* wrL = wrH + 16 * 1032;
    LAS float* lgs = (LAS float*)(lds + 136192);
    LAS unsigned* lcnt = (LAS unsigned*)(lds + 144896); LAS unsigned* gbase = lcnt + 16; LAS int* rec = (LAS int*)(lcnt + 32);
    const float* wrt_ = P.inp(I_WROUTER);
    for (int i = tid; i < 1024 * 16; i += 512) { const int k = i >> 4, e = i & 15; const float w = wrt_[i]; const unsigned hi = pack2(w, 0.f) & 0xffffu; const float lo = w - __uint_as_float(hi << 16);
        wrH[e * 1032 + k] = (bf16_t)hi; wrL[e * 1032 + k] = f2bf(lo); }
    if (tid < 16) lcnt[tid] = 0u;
    __syncthreads();
    unsigned* cnt = (unsigned*)(P.ws + WS_CTL + CTL_CNT) + l * 16;
    int* toke = (int*)(P.ws + WS_TOKE); float* tokw = (float*)(P.ws + WS_TOKW); int* toks = (int*)(P.ws + WS_TOKS); int* list = (int*)(P.ws + WS_LIST);
    const float* g = P.inp(I_LN1G) + l * D; const float* bta = P.inp(I_LN1B) + l * D;
    bf16_t* H2 = (bf16_t*)(P.ws + WS_HBUF);
    const int NU_R = rows_l / 8;
    int nloc = 0;
    {
        RowV lng, lnb; row_load(lng, g, lane); row_load(lnb, bta, lane);
        RowV rn; { const float z = zero_f(); for (int i = 0; i < 4; ++i) rn.v[i] = (f32x4){z, z, z, z}; } if (P.bid < NU_R) row_load(rn, P.latrow(P.bid * 8 + wid), lane);
        RowV msh, msc; { const float z = zero_f(); for (int i = 0; i < 4; ++i) { msh.v[i] = (f32x4){z, z, z, z}; msc.v[i] = msh.v[i]; } } int mcur = -1;
        for (int u = P.bid; u < NU_R; u += G) {
            const int row = u * 8 + wid; RowV r = rn;
            if (u + G < NU_R) row_load(rn, P.latrow((u + G) * 8 + wid), lane);
            row_layernorm_r(r, lng, lnb);
            const int mi = row_modidx(row); if (mi != mcur) { mcur = mi; const float* m = P.mod(l, mi); row_load(msh, m + 3072, lane); row_load(msc, m + 4096, lane); }
            RowV h; row_modulate_r(r, h, msh, msc);
            row_store_bf16(h, H2 + (size_t)row * D, lane);
            ++nloc;
        }
    }
    asm volatile("s_waitcnt vmcnt(0)" ::: "memory");
    __syncthreads();
    {
        const int ntile = (nloc + 1) >> 1; LAS float* lg = lgs + wid * 16 * 17;
        for (int t = wid; t < ntile; t += 8) {
            int it = 2 * t + (fr >> 3); const bool valid_a = it < nloc; if (!valid_a) it = nloc - 1;
            const bf16_t* ap = H2 + (size_t)((P.bid + G * it) * 8 + (fr & 7)) * D + 8 * fq;
            f32x4 acc = (f32x4){0.f, 0.f, 0.f, 0.f};
#pragma unroll 4
            for (int ks = 0; ks < 32; ++ks) { const bf16x8 a = *(const bf16x8*)(ap + 32 * ks);
                const bf16x8 bh = *(const LAS bf16x8*)(wrH + fr * 1032 + 32 * ks + 8 * fq), bl = *(const LAS bf16x8*)(wrL + fr * 1032 + 32 * ks + 8 * fq);
                acc = __builtin_amdgcn_mfma_f32_16x16x32_bf16(a, bh, acc, 0, 0, 0); acc = __builtin_amdgcn_mfma_f32_16x16x32_bf16(a, bl, acc, 0, 0, 0); }
#pragma unroll
            for (int r = 0; r < 4; ++r) lg[(4 * fq + r) * 17 + fr] = acc[r];
            const int it2 = 2 * t + (lane >> 3); const bool act = (lane < 16) && (it2 < nloc);
            if (act) {
                const int row = (P.bid + G * it2) * 8 + (lane & 7);
                float lgv[16]; const float* brt_ = P.inp(I_BROUTER);
#pragma unroll
                for (int e = 0; e < 16; ++e) lgv[e] = lg[lane * 17 + e];
                float mx = lgv[0];
#pragma unroll
                for (int e = 1; e < 16; ++e) mx = fmaxf(mx, lgv[e]);
                float sc[16], sel[16], ssum = 0.f;
#pragma unroll
                for (int e = 0; e < 16; ++e) { sc[e] = fexp(lgv[e] - mx); ssum += sc[e]; }
                const float inv = 1.0f / ssum;
#pragma unroll
                for (int e = 0; e < 16; ++e) { sc[e] *= inv; sel[e] = sc[e] + brt_[e]; }
                int bestg = 0; float bestgs = -3.0e38f;
#pragma unroll
                for (int gq = 0; gq < 4; ++gq) { float m1 = -3.0e38f, m2 = -3.0e38f;
#pragma unroll
                    for (int j = 0; j < 4; ++j) { const float v = sel[gq * 4 + j]; if (v > m1) { m2 = m1; m1 = v; } else if (v > m2) m2 = v; }
                    const float gs = m1 + m2; if (gs > bestgs) { bestgs = gs; bestg = gq; } }
                int i1 = 0, i2 = 0; float v1 = -3.0e38f, v2 = -3.0e38f, w1 = 0.f, w2 = 0.f;
#pragma unroll
                for (int e = 0; e < 16; ++e) { if ((e >> 2) == bestg && sel[e] > v1) { v1 = sel[e]; i1 = e; w1 = sc[e]; } }
#pragma unroll
                for (int e = 0; e < 16; ++e) { if ((e >> 2) == bestg && e != i1 && sel[e] > v2) { v2 = sel[e]; i2 = e; w2 = sc[e]; } }
                const float ws_ = 1.0f / (w1 + w2);
                const int s1 = (int)__hip_atomic_fetch_add(lcnt + i1, 1u, __ATOMIC_RELAXED, __HIP_MEMORY_SCOPE_WORKGROUP);
                const int s2 = (int)__hip_atomic_fetch_add(lcnt + i2, 1u, __ATOMIC_RELAXED, __HIP_MEMORY_SCOPE_WORKGROUP);
                const int idx = it2 * 8 + (lane & 7); rec[idx * 3] = i1 | (i2 << 8); rec[idx * 3 + 1] = s1; rec[idx * 3 + 2] = s2;
                toke[row * 2] = i1; toke[row * 2 + 1] = i2; tokw[row * 2] = w1 * ws_; tokw[row * 2 + 1] = w2 * ws_;
            }
        }
    }
    __syncthreads();
    if (tid < 16) gbase[tid] = __hip_atomic_fetch_add(cnt + tid, lcnt[tid], __ATOMIC_RELAXED, __HIP_MEMORY_SCOPE_AGENT);
    __syncthreads();
    for (int idx = tid; idx < nloc * 8; idx += 512) { const int row = (P.bid + G * (idx >> 3)) * 8 + (idx & 7); const int ee = rec[idx * 3]; const int e1 = ee & 255, e2 = ee >> 8;
        const int s1 = (int)gbase[e1] + rec[idx * 3 + 1], s2 = (int)gbase[e2] + rec[idx * 3 + 2];
        list[(size_t)e1 * T + s1] = row; list[(size_t)e2 * T + s2] = row; toks[row * 2] = s1; toks[row * 2 + 1] = s2; }
}

struct MoeSeg { int toff[17]; };
__device__ __forceinline__ void moe_seg(const unsigned* cnt, MoeSeg& S) { int a = 0;
#pragma unroll
    for (int e = 0; e < 16; ++e) { S.toff[e] = a; a += __builtin_amdgcn_readfirstlane(((int)cnt[e] + 255) >> 8); }
    S.toff[16] = a; }
__device__ __forceinline__ int moe_find(const MoeSeg& S, int tg, int& off) { int e = 0; off = 0;
#pragma unroll
    for (int j = 1; j < 16; ++j) { const bool ge = (tg >= S.toff[j]); e += ge ? 1 : 0; off = ge ? S.toff[j] : off; }
    return e; }

struct SchedMoe { int G, c; MoeSeg S; const int* list; const unsigned* cnt;
    __device__ __forceinline__ bool next(int i, Unit& u) const { const int L = i * G + c; if (L >= S.toff[16] * 4) return false; const int tg = L >> 2, pnn = L & 3; int off; const int e = moe_find(S, tg, off);
        u.pm = tg; u.pn = e * 4 + pnn; u.e = e; u.aux = tg - off; return true; }
    __device__ __forceinline__ int arow(const Unit& u, int R) const { const int idx = u.aux * 256 + R; const int* l = list + (size_t)u.e * T; return idx < (int)cnt[u.e] ? l[idx] : l[0]; } };
__device__ __forceinline__ void phase_g5(const Ptrs P, int l, LAS unsigned char* lds) {
    const unsigned* cnt = (const unsigned*)(P.ws + WS_CTL + CTL_CNT) + l * 16;
    SchedMoe S; S.G = P.G; S.c = P.bid; moe_seg(cnt, S.S); S.list = (const int*)(P.ws + WS_LIST); S.cnt = cnt;
    pg8::Gemm g{(const bf16_t*)(P.ws + WS_HBUF), (const bf16_t*)(P.ws + WS_BIG + BIG_W13), D};
    EpiFfn1 E{(bf16_t*)(P.ws + WS_BIG + BIG_HID)};
    pg8::gemm_phase<EpiFfn1, SchedMoe, true>(P.tid, lds, g, S, E);
    if (l != NLAYER - 1) dyn_tiles(P.tid, (unsigned*)(P.ws + WS_CTL + CTL_DYN) + 8 + l, NCONV_NE, (volatile LAS unsigned*)(lds + LDS_MISC + 64), ConvNe{P, l + 1, (LAS float*)lds});
}
__device__ __forceinline__ void phase_g6(const Ptrs P, int l, LAS unsigned char* lds) {
    const unsigned* cnt = (const unsigned*)(P.ws + WS_CTL + CTL_CNT) + l * 16;
    SchedMoe S; S.G = P.G; S.c = P.bid; moe_seg(cnt, S.S); S.list = (const int*)(P.ws + WS_LIST); S.cnt = cnt;
    pg8::Gemm g{(const bf16_t*)(P.ws + WS_BIG + BIG_HID), (const bf16_t*)(P.ws + WS_BIG + BIG_W2), 512};
    EpiBf16Plain E{(bf16_t*)(P.ws + WS_BIG + BIG_YE), 1024, 3};
    pg8::gemm_phase<EpiBf16Plain, SchedMoe, false>(P.tid, lds, g, S, E);
}

__device__ __forceinline__ void phase_e8(const Ptrs P, int l, LAS unsigned char* lds) {
    const int tid = P.tid, wid = tid >> 6, lane = tid & 63, G = P.G;
    const bool last = (l == NLAYER - 1); const int rows_l = last ? NLAT : T;
    LAS float* wdt = (LAS float*)lds;
    if (!last) load_wdt(P, l + 1, wdt);
    const unsigned* cnt = (const unsigned*)(P.ws + WS_CTL + CTL_CNT) + l * 16; MoeSeg S; moe_seg(cnt, S);
    const int* toke = (const int*)(P.ws + WS_TOKE); const float* tokw = (const float*)(P.ws + WS_TOKW); const int* toks = (const int*)(P.ws + WS_TOKS);
    const bf16_t* YE = (const bf16_t*)(P.ws + WS_BIG + BIG_YE);
    const float* g = P.inp(I_LN2G) + l * D; const float* bta = P.inp(I_LN2B) + l * D; const float* g1p = P.inp(I_LN1G) + l * D; const float* b1p = P.inp(I_LN1B) + l * D;
    const int NU_R = rows_l / 8;
    RowV lng, lnb; row_load(lng, g, lane); row_load(lnb, bta, lane);
    RowV mg2, msh, msc; { const float z = zero_f(); for (int i = 0; i < 4; ++i) { mg2.v[i] = (f32x4){z, z, z, z}; msh.v[i] = mg2.v[i]; msc.v[i] = mg2.v[i]; } } int mcur = -1;
    RowV rn; { const float z = zero_f(); for (int i = 0; i < 4; ++i) rn.v[i] = (f32x4){z, z, z, z}; } int te1 = 0, te2 = 0, ts1 = 0, ts2 = 0; float tw1 = 0.f, tw2 = 0.f;
    if (P.bid < NU_R) { const int row = P.bid * 8 + wid; row_load(rn, P.latrow(row), lane); te1 = toke[row * 2]; te2 = toke[row * 2 + 1]; tw1 = tokw[row * 2]; tw2 = tokw[row * 2 + 1]; ts1 = toks[row * 2]; ts2 = toks[row * 2 + 1]; }
    for (int u = P.bid; u < NU_R; u += G) {
        const int row = u * 8 + wid; RowV r = rn; float* lp = P.latrow(row);
        row_layernorm(r, g1p, b1p, lane);
        const int e1 = te1, e2 = te2; const float w1 = tw1, w2 = tw2;
        int o1 = 0, o2 = 0;
#pragma unroll
        for (int e = 0; e < 16; ++e) { o1 = (e == e1) ? S.toff[e] : o1; o2 = (e == e2) ? S.toff[e] : o2; }
        const bf16_t* y1 = YE + ((size_t)o1 * 256 + ts1) * 1024; const bf16_t* y2 = YE + ((size_t)o2 * 256 + ts2) * 1024;
        u32x2 ya[4], yb[4];
#pragma unroll
        for (int i = 0; i < 4; ++i) { ya[i] = *(const u32x2*)(y1 + i * 256 + lane * 4); yb[i] = *(const u32x2*)(y2 + i * 256 + lane * 4); }
        if (u + G < NU_R) { const int rw = (u + G) * 8 + wid; row_load(rn, P.latrow(rw), lane); te1 = toke[rw * 2]; te2 = toke[rw * 2 + 1]; tw1 = tokw[rw * 2]; tw2 = tokw[rw * 2 + 1]; ts1 = toks[rw * 2]; ts2 = toks[rw * 2 + 1]; }
        const int mi = row_modidx(row);
        if (mi != mcur) { mcur = mi; row_load(mg2, P.mod(l, mi) + 5120, lane); if (!last) { const float* m2 = P.mod(l + 1, mi); row_load(msh, m2, lane); row_load(msc, m2 + 1024, lane); } }
#pragma unroll
        for (int i = 0; i < 4; ++i) { const u32x2 a = ya[i], b = yb[i];
            const f32x4 g2 = mg2.v[i];
            f32x4 mo; mo[0] = w1 * __uint_as_float(a.x << 16) + w2 * __uint_as_float(b.x << 16); mo[1] = w1 * __uint_as_float(a.x & 0xffff0000u) + w2 * __uint_as_float(b.x & 0xffff0000u);
            mo[2] = w1 * __uint_as_float(a.y << 16) + w2 * __uint_as_float(b.y << 16); mo[3] = w1 * __uint_as_float(a.y & 0xffff0000u) + w2 * __uint_as_float(b.y & 0xffff0000u);
            r.v[i] = r.v[i] * ALPHA + g2 * mo; }
        row_layernorm_r(r, lng, lnb);
        row_store(r, lp, lane);
        if (!last) { RowV h; row_modulate_r(r, h, msh, msc);
            row_store_bf16(h, (bf16_t*)(P.ws + WS_HBUF) + (size_t)row * D, lane); row_dt(h, wdt, (float*)(P.ws + WS_DT) + (size_t)row * 8, lane); }
    }
}

constexpr int NPH_LAYER = 11, NPH = 2 + NLAYER * NPH_LAYER;
__global__ void __launch_bounds__(512, 2) fwd_kernel(Args a) {
    extern __shared__ __attribute__((aligned(16))) unsigned char lds_raw[];
    LAS unsigned char* lds = (LAS unsigned char*)lds_raw;
    const int lo = a.ph_lo, hi = a.ph_hi;
    volatile LAS unsigned* xbw = (volatile LAS unsigned*)(lds + LDS_MISC);
    const int wave_s = __builtin_amdgcn_readfirstlane((int)threadIdx.x >> 6);
    if (threadIdx.x < 4) xbw[threadIdx.x] = 0u;
    __syncthreads();
    XcdBarrier bar; bar.bar = (unsigned*)(a.ws + WS_CTL); bar.x = 0; bar.st = xbw;
    if (hi - lo > 1) bar = xcd_barrier_post((unsigned*)(a.ws + WS_CTL), xbw, wave_s);
#ifndef PH_MASK
#define PH_MASK 0xFFFFFFFFu
#endif
#ifndef PROBE_PH
#define PROBE_PH (-1)
#define PROBE_N 1
#endif
#define REP(id) for (int rep_ = 0; rep_ < ((PROBE_PH == (id)) ? PROBE_N : 1); ++rep_)
#define PH_ON(id) (((PH_MASK) >> (id)) & 1u)
#define IN(k) (lo <= (k) && (k) < hi)
#define FRESH() Ptrs Pq; { const AS4 char* ka_ = (const AS4 char*)__builtin_amdgcn_kernarg_segment_ptr(); AS1 float* o_ = *(AS1 float* const AS4*)(ka_ + 8 * N_IN); AS1 unsigned char* w_ = *(AS1 unsigned char* const AS4*)(ka_ + 8 * N_IN + 8); int l_ = lcur; asm volatile("" : "+s"(o_), "+s"(w_), "+s"(l_) :: "memory"); Pq.out = (float*)o_; Pq.ws = (unsigned char*)w_; lq = l_; int ws_ = wave_s, b_ = blockIdx.x, g_ = gridDim.x; asm volatile("" : "+s"(ws_), "+s"(b_), "+s"(g_)); int ln_ = lane_id(); asm volatile("" : "+v"(ln_)); int t_ = ws_ * 64 + ln_; Pq.tid = t_; Pq.bid = b_; Pq.G = g_; }
#define SEAM(k) do { if (IN(k) && IN((k) + 1)) xcd_barrier(bar, wave_s); } while (0)
    int lcur = 0, lq = 0;
    if (PH_ON(0) && IN(0)) REP(0) { FRESH(); phase_pa(Pq, lds); } SEAM(0);
    if (PH_ON(1) && IN(1)) REP(1) { FRESH(); phase_pb(Pq, lds); } SEAM(1);
    for (int l = 0; l < NLAYER; ++l) {
        const int b = 2 + l * NPH_LAYER; lcur = l;
        if (PH_ON(2) && IN(b + 0)) REP(2) { FRESH(); phase_g1(Pq, lds); } SEAM(b + 0);
        for (int g_ = 0; g_ < ((PROBE_PH == 100) ? PROBE_N : 1); ++g_) {
        if (PH_ON(3) && IN(b + 1)) REP(3) { FRESH(); phase_m1(Pq, lq, lds); } SEAM(b + 1);
        if (PH_ON(4) && IN(b + 2)) REP(4) { FRESH(); phase_m2(Pq, lq, lds); } SEAM(b + 2);
        if (PH_ON(5) && IN(b + 3)) REP(5) { FRESH(); phase_m3(Pq, lq, lds); } SEAM(b + 3);
        }
        if (PH_ON(6) && IN(b + 4)) REP(6) { FRESH(); phase_g2(Pq, lq, lds); } SEAM(b + 4);
        if (PH_ON(7) && IN(b + 5)) REP(7) { FRESH(); phase_g3(Pq, lq, lds); } SEAM(b + 5);
        if (PH_ON(8) && IN(b + 6)) REP(8) { FRESH(); phase_g4(Pq, lq, lds); } SEAM(b + 6);
        if (PH_ON(9) && IN(b + 7)) REP(9) { FRESH(); phase_e5(Pq, lq, lds); } SEAM(b + 7);
        if (PH_ON(10) && IN(b + 8)) REP(10) { FRESH(); phase_g5(Pq, lq, lds); } SEAM(b + 8);
        if (PH_ON(11) && IN(b + 9)) REP(11) { FRESH(); phase_g6(Pq, lq, lds); } SEAM(b + 9);
        if (PH_ON(12) && IN(b + 10)) REP(12) { FRESH(); phase_e8(Pq, lq, lds); } SEAM(b + 10);
    }
#undef IN
#undef SEAM
}
}

extern "C" void kernel_launch(void* const* d_in, const int* in_sizes, int n_in, void* d_out, int out_size, void* d_ws, size_t ws_size, hipStream_t stream) {
    static int grid = 0;
    if (grid == 0) {
        if (n_in != N_IN || out_size != NLAT * D || ws_size < WS_END) { fprintf(stderr, "kernel_launch: unexpected shapes / workspace (%d inputs, out %d, ws %zu < %zu)\n", n_in, out_size, ws_size, (size_t)WS_END); grid = -1; return; }
        int dev = 0, cus = 0, per_cu = 0;
        if (hipGetDevice(&dev) != hipSuccess || hipDeviceGetAttribute(&cus, hipDeviceAttributeMultiprocessorCount, dev) != hipSuccess) { grid = -1; return; }
        if (hipFuncSetAttribute((const void*)fwd_kernel, hipFuncAttributeMaxDynamicSharedMemorySize, LDS_BYTES) != hipSuccess) { fprintf(stderr, "kernel_launch: hipFuncSetAttribute failed\n"); grid = -1; return; }
        if (hipOccupancyMaxActiveBlocksPerMultiprocessor(&per_cu, (const void*)fwd_kernel, 512, LDS_BYTES) != hipSuccess || per_cu < 1) { fprintf(stderr, "kernel_launch: occupancy query says %d\n", per_cu); }
        (void)hipGetLastError();
        grid = cus;
    }
    if (grid < 0) return;
    (void)hipMemsetAsync((char*)d_ws + WS_CTL, 0, CTL_BYTES, stream);
    Args a{};
    for (int i = 0; i < N_IN; ++i) a.in[i] = (const float*)d_in[i];
    a.out = (float*)d_out; a.ws = (unsigned char*)d_ws;
#if N_LAUNCH_MODE == 1
    a.ph_lo = 0; a.ph_hi = NPH;
    hipLaunchKernelGGL(fwd_kernel, dim3(grid), dim3(512), LDS_BYTES, stream, a);
#else
    for (int p = 0; p < NPH; ++p) { a.ph_lo = p; a.ph_hi = p + 1; hipLaunchKernelGGL(fwd_kernel, dim3(grid), dim3(512), LDS_BYTES, stream, a); }
#endif
}
```

```cpp
#include <hip/hip_runtime.h>
#include <cstdio>
#include <cstdint>

#ifndef N_LAUNCH_MODE
#define N_LAUNCH_MODE 1
#endif

namespace {
typedef unsigned short bf16_t;
typedef short bf16x8 __attribute__((ext_vector_type(8)));
typedef float f32x4 __attribute__((ext_vector_type(4)));
typedef unsigned u32x2 __attribute__((ext_vector_type(2)));
typedef unsigned u32x4 __attribute__((ext_vector_type(4)));
#define LAS __attribute__((address_space(3)))

constexpr int D = 1024, NB = 8, SEQ = 4096, CTXL = 256, NLAT = NB * SEQ, NCTX = NB * CTXL, T = NLAT + NCTX;
constexpr int NLAYER = 2;
constexpr int UC = 3584;
constexpr int INC = 3592;
constexpr int NE = 16;
constexpr float ALPHA = 1.41421356237309515f;
constexpr float LN_EPS = 1e-5f, RMS_EPS = 1e-6f;
constexpr int MAXTILES = 288;

enum { I_X = 0, I_C, I_CTX, I_CCTX, I_WADA, I_BADA, I_WIN, I_HYCW, I_HYCB, I_HYW1, I_HYB1, I_HYF1, I_HYW2, I_HYB2, I_HYF2, I_HYW3, I_HYDEC, I_HYBIAS,
       I_SCCW, I_HGLB, I_HGNG, I_SSDCW, I_SSDCB, I_SSDALOG, I_SSDDTB, I_SSDD, I_SSDNG, I_WGATE, I_BGATE, I_WBR, I_WO, I_LN1G, I_LN1B, I_LN2G, I_LN2B,
       I_WROUTER, I_BROUTER, I_WE1, I_WE3, I_WE2, N_IN };

constexpr size_t al256(size_t x) { return (x + 255) & ~(size_t)255; }
constexpr size_t WS_CTL = 0;
constexpr size_t CTL_BYTES = 65536;
constexpr size_t CTL_CNT = 16384;
constexpr size_t CTL_DYN = 20480;
constexpr size_t WS_MOD = WS_CTL + CTL_BYTES;
constexpr size_t WS_LB = WS_MOD + al256((size_t)NLAYER * 9 * 6144 * 4);
constexpr size_t WS_TW = WS_LB + 4096;
constexpr size_t WS_H2TAB = WS_TW + 65536;
constexpr size_t WS_PART = WS_H2TAB + (size_t)8448 * 64 * 4;
constexpr size_t WS_FILT = WS_PART + (size_t)3 * 64 * 512 * 4;
constexpr size_t WS_FILTC = WS_FILT + (size_t)2 * 8192 * 256 * 4;
constexpr size_t WS_CX32 = WS_FILTC + (size_t)512 * 256 * 4;
constexpr size_t WS_DT = WS_CX32 + (size_t)NCTX * D * 4;
constexpr size_t WS_SSQ = WS_DT + (size_t)T * 8 * 4;
constexpr size_t WS_TOKE = WS_SSQ + (size_t)T * 4 * 4;
constexpr size_t WS_TOKW = WS_TOKE + (size_t)T * 2 * 4;
constexpr size_t WS_TOKS = WS_TOKW + (size_t)T * 2 * 4;
constexpr size_t WS_LIST = WS_TOKS + (size_t)T * 2 * 4;
constexpr size_t WS_BGP = WS_LIST + (size_t)NE * T * 4;
constexpr size_t WS_DEC = WS_BGP + 16384;
constexpr size_t WS_WIN = WS_DEC + (size_t)4352 * 64 * 4;
constexpr size_t WS_WG = WS_WIN + (size_t)UC * D * 2;
constexpr size_t WS_WBR = WS_WG + (size_t)4096 * D * 2;
constexpr size_t WS_WO = WS_WBR + (size_t)4096 * 256 * 2;
constexpr size_t WS_HBUF = WS_WO + (size_t)D * D * 2;
constexpr size_t WS_BR = WS_HBUF + (size_t)T * D * 2;
constexpr size_t WS_BIG = WS_BR + (size_t)T * D * 2;
constexpr size_t BIG_U = 0;
constexpr size_t BIG_HGO = BIG_U + (size_t)T * UC * 2;
constexpr size_t BIG_STATE = BIG_HGO;
constexpr size_t BIG_SSY = BIG_HGO + (size_t)T * 256 * 4;
constexpr size_t BIG_WT = BIG_SSY + (size_t)T * 256 * 4;
constexpr size_t BIG_END1 = BIG_WT + (size_t)T * 256 * 2;
constexpr size_t BIG_P = 0;
constexpr size_t BIG_HID = 0;
constexpr size_t BIG_YE = BIG_HID + (size_t)MAXTILES * 256 * 512 * 2;
constexpr size_t BIG_W13 = BIG_YE + (size_t)MAXTILES * 256 * 1024 * 2;
constexpr size_t BIG_W2 = BIG_W13 + (size_t)NE * 1024 * 1024 * 2;
constexpr size_t BIG_END3 = BIG_W2 + (size_t)NE * 1024 * 512 * 2;
constexpr size_t BIG_BYTES = BIG_END1 > BIG_END3 ? BIG_END1 : BIG_END3;
constexpr size_t WS_END = WS_BIG + BIG_BYTES;
static_assert((size_t)T * 4096 * 2 <= BIG_BYTES, "P fits");
static_assert(WS_END <= (size_t)536870912, "workspace budget");

constexpr int LDS_BYTES = 147456;
constexpr int LDS_MISC = 147456 - 256;

struct Args { const float* in[N_IN]; float* out; unsigned char* ws; int ph_lo, ph_hi; };

#define XB_TMO      128
#define XB_XCNT(j)  (256  + 64 * (j))
#define XB_XSUB(j)  (1280 + 64 * (j))
#define XB_XGEN(j)  (2304 + 64 * (j))
#define XB_TOP      3328
#define XB_TOPGEN   3392
#define XCD_BAR_WORDS 3456
#define XB_SPIN_CAP (1u << 18)
__device__ __forceinline__ unsigned xb_ld(unsigned* p)              { return __hip_atomic_load(p, __ATOMIC_RELAXED, __HIP_MEMORY_SCOPE_AGENT); }
__device__ __forceinline__ unsigned xb_add(unsigned* p, unsigned v) { return __hip_atomic_fetch_add(p, v, __ATOMIC_RELAXED, __HIP_MEMORY_SCOPE_AGENT); }
__device__ __forceinline__ unsigned xb_xcc_id() { return (unsigned)__builtin_amdgcn_s_getreg((3 << 11) | 20) & 0xFu; }
#define XB_SPIN(cond, bar) do { unsigned _sp = 0; while (cond) { __builtin_amdgcn_s_sleep(1); \
    if ((++_sp & 255u) == 0u) { if (xb_ld(&(bar)[XB_TMO])) break; if (_sp > XB_SPIN_CAP) { atomicAdd(&(bar)[XB_TMO], 1u); break; } } } } while (0)
struct XcdBarrier { unsigned* bar; unsigned x; volatile LAS unsigned* st; };
__device__ __forceinline__ int lane_id() { unsigned z = 0u; asm volatile("" : "+v"(z)); return (int)__builtin_amdgcn_mbcnt_hi(~0u, __builtin_amdgcn_mbcnt_lo(~0u, z)); }
__device__ __forceinline__ bool is_thread0(int wave_s) { return wave_s == 0 && lane_id() == 0; }
__device__ __forceinline__ XcdBarrier xcd_barrier_post(unsigned* bar, volatile LAS unsigned* st, int wave_s) {
    XcdBarrier b; b.bar = bar; b.x = xb_xcc_id(); b.st = st;
    if (is_thread0(wave_s)) (void)xb_add(&bar[XB_XCNT(b.x)], 1u);
    return b;
}
__device__ __forceinline__ void xcd_barrier_complete(unsigned* bar, unsigned x, unsigned& nloc, unsigned& nx) {
    const unsigned G = gridDim.x * gridDim.y * gridDim.z;
    unsigned sum, cnt, mine, sp = 0u;
    for (;;) {
        sum = 0u; cnt = 0u; mine = 0u;
#pragma unroll
        for (unsigned j = 0; j < 16; ++j) { const unsigned c = xb_ld(&bar[XB_XCNT(j)]); sum += c; cnt += (c > 0u) ? 1u : 0u; mine = (j == x) ? c : mine; }
        if (sum == G) break;
        __builtin_amdgcn_s_sleep(1);
        if ((++sp & 255u) == 0u) { if (xb_ld(&bar[XB_TMO])) break; if (sp > XB_SPIN_CAP) { atomicAdd(&bar[XB_TMO], 1u); break; } }
    }
    nloc = mine > 0u ? mine : 1u; nx = cnt > 0u ? cnt : 1u;
}
__device__ __forceinline__ void xcd_barrier(const XcdBarrier& b, int wave_s) {
    asm volatile("s_waitcnt vmcnt(0)" ::: "memory");
    __syncthreads();
    if (is_thread0(wave_s)) {
        unsigned* bar = b.bar;
        __builtin_amdgcn_s_waitcnt(0);
        unsigned nloc = b.st[0], nx = b.st[1];
        if (nloc == 0u) { xcd_barrier_complete(bar, b.x, nloc, nx); b.st[0] = nloc; b.st[1] = nx; }
        const unsigned old = xb_add(&bar[XB_XSUB(b.x)], 1u);
        const unsigned gen = old / nloc;
        if (old + 1u == (gen + 1u) * nloc) {
            __builtin_amdgcn_fence(__ATOMIC_RELEASE, "agent");
            asm volatile("s_waitcnt vmcnt(0)" ::: "memory");
            const unsigned og = xb_add(&bar[XB_TOP], 1u);
            const unsigned tg = og / nx;
            if (og + 1u == (tg + 1u) * nx) xb_add(&bar[XB_TOPGEN], 1u);
            else XB_SPIN(xb_ld(&bar[XB_TOPGEN]) == tg, bar);
            __builtin_amdgcn_fence(__ATOMIC_ACQUIRE, "agent");
            xb_add(&bar[XB_XGEN(b.x)], 1u);
            asm volatile("s_waitcnt vmcnt(0)" ::: "memory");
        } else {
            XB_SPIN(xb_ld(&bar[XB_XGEN(b.x)]) == gen, bar);
            __builtin_amdgcn_fence(__ATOMIC_ACQUIRE, "agent");
            asm volatile("s_waitcnt vmcnt(0)" ::: "memory");
        }
    }
    __syncthreads();
}

__device__ __forceinline__ float bf2f(bf16_t b) { return __uint_as_float(((unsigned)b) << 16); }
typedef __bf16 hwbf2 __attribute__((ext_vector_type(2)));
typedef float hwf2 __attribute__((ext_vector_type(2)));
__device__ __forceinline__ unsigned pack2(float lo, float hi) { const hwf2 v = {lo, hi}; return __builtin_bit_cast(unsigned, __builtin_convertvector(v, hwbf2)); }
__device__ __forceinline__ bf16_t f2bf(float f) { return (bf16_t)(pack2(f, 0.f) & 0xffffu); }
__device__ __forceinline__ float zero_f() { float z = 0.f; asm volatile("" : "+v"(z)); return z; }
__device__ __forceinline__ float kconst(float c) { asm volatile("" : "+s"(c)); return c; }
__device__ __forceinline__ float fexp(float x) { return __builtin_amdgcn_exp2f(x * kconst(1.4426950408889634f)); }
__device__ __forceinline__ float flog(float x) { return __builtin_amdgcn_logf(x) * kconst(0.6931471805599453f); }
__device__ __forceinline__ float sigmoidf_(float x) { return __builtin_amdgcn_rcpf(1.0f + fexp(-x)); }
__device__ __forceinline__ float siluf_(float x) { return x * sigmoidf_(x); }
__device__ __forceinline__ float wave_sum(float v) {
#pragma unroll
    for (int o = 32; o >= 1; o >>= 1) v += __shfl_xor(v, o);
    return v;
}
__device__ __forceinline__ int row_modidx(int r) { return r < NLAT ? (r >> 12) : 8; }
__device__ __forceinline__ bool row_has_prev(int r) { return r < NLAT ? ((r & 4095) != 0) : (((r - NLAT) & 255) != 0); }
__device__ __forceinline__ bool row_has_next(int r) { return r < NLAT ? ((r & 4095) != 4095) : (((r - NLAT) & 255) != 255); }

#define AS1 __attribute__((address_space(1)))
#define AS4 __attribute__((address_space(4)))
struct Ptrs {
    float* out; unsigned char* ws; int tid, bid, G;
    __device__ __forceinline__ const float* inp(int i) const { asm volatile("" : "+s"(i));
        const __attribute__((address_space(4))) char* ka = (const __attribute__((address_space(4))) char*)__builtin_amdgcn_kernarg_segment_ptr();
        return (const float*)(*(const AS1 float* const AS4*)(ka + 8 * i)); }
    __device__ __forceinline__ float* latrow(int r) const { return r < NLAT ? out + (size_t)r * D : (float*)(ws + WS_CX32) + (size_t)(r - NLAT) * D; }
    __device__ __forceinline__ float* mod(int l, int ridx) const { return (float*)(ws + WS_MOD) + ((size_t)l * 9 + ridx) * 6144; }
};

__device__ __forceinline__ float conv3_u(const bf16_t* U, int row, int col, const float* w, int ncol, int wcol) {
    const bool hp = row_has_prev(row), hn = row_has_next(row);
    const float c = bf2f(U[(size_t)row * UC + col]), p = bf2f(U[(size_t)(hp ? row - 1 : row) * UC + col]), n = bf2f(U[(size_t)(hn ? row + 1 : row) * UC + col]);
    return c * w[ncol + wcol] + (hp ? p * w[wcol] : 0.f) + (hn ? n * w[2 * ncol + wcol] : 0.f);
}

struct Unit { int pm, pn, e, aux; };
__host__ __device__ __forceinline__ int perm32(int rho) { const int n = rho >> 4, i = rho & 15; return 8 * (i >> 2) + 4 * n + (i & 3); }

template <class RowMap, class Epi>
__device__ __forceinline__ void sgemm_unit(int tid_, const bf16_t* __restrict__ A, int lda, const bf16_t* __restrict__ Bt, int ldb, int K, const Unit& u, const RowMap& RM, const Epi& E) {
    const int tid = tid_, wid = tid >> 6, lane = tid & 63, wr = wid >> 2, wc = wid & 3, fr = lane & 15, fq = lane >> 4;
    f32x4 acc[2][2][4][2];
#pragma unroll
    for (int a = 0; a < 2; ++a)
#pragma unroll
        for (int b = 0; b < 2; ++b)
#pragma unroll
            for (int m = 0; m < 4; ++m)
#pragma unroll
                for (int n = 0; n < 2; ++n) acc[a][b][m][n] = (f32x4){0.f, 0.f, 0.f, 0.f};
    unsigned ap[2][4], bp[2][2];
#pragma unroll
    for (int a = 0; a < 2; ++a)
#pragma unroll
        for (int m = 0; m < 4; ++m) ap[a][m] = (unsigned)RM(u, 128 * a + 64 * wr + 16 * m + fr) * (unsigned)lda + fq * 8;
#pragma unroll
    for (int b = 0; b < 2; ++b)
#pragma unroll
        for (int n = 0; n < 2; ++n) { const int rho = 16 * n + fr; const int col = Epi::PERM ? perm32(rho) : rho;
            bp[b][n] = (unsigned)(u.pn * 256 + 128 * b + 32 * wc + col) * (unsigned)ldb + fq * 8; }
    for (int k = 0; k < K; k += 32) {
        bf16x8 bfr[2][2];
#pragma unroll
        for (int b = 0; b < 2; ++b)
#pragma unroll
            for (int n = 0; n < 2; ++n) bfr[b][n] = *(const bf16x8*)(Bt + (bp[b][n] + k));
#pragma unroll
        for (int a = 0; a < 2; ++a) {
            bf16x8 af[4];
#pragma unroll
            for (int m = 0; m < 4; ++m) af[m] = *(const bf16x8*)(A + (ap[a][m] + k));
#pragma unroll
            for (int b = 0; b < 2; ++b)
#pragma unroll
                for (int m = 0; m < 4; ++m)
#pragma unroll
                    for (int n = 0; n < 2; ++n) acc[a][b][m][n] = __builtin_amdgcn_mfma_f32_16x16x32_bf16(bfr[b][n], af[m], acc[a][b][m][n], 0, 0, 0);
        }
    }
    E(acc, u, wr, wc, fr, fq);
}

struct RowIdent { __device__ __forceinline__ int operator()(const Unit& u, int R) const { return u.pm * 256 + R; } };
struct RowStackK { int rows; __device__ __forceinline__ int operator()(const Unit& u, int R) const { return u.e * rows + u.pm * 256 + R; } };
struct RowGather { const int* list; const unsigned* cnt; __device__ __forceinline__ int operator()(const Unit& u, int R) const {
    const int idx = u.aux * 256 + R; const int* l = list + (size_t)u.e * T; return idx < (int)cnt[u.e] ? l[idx] : l[0]; } };


namespace pg8 {
constexpr int BM = 256, BK = 64, HALF = 128, HTB = HALF * BK * 2, STAGE_BYTES = 8 * HTB;
__host__ __device__ __forceinline__ int lds_byte(int r, int c) { const int st = (r >> 4) * 2 + (c >> 5), rr = r & 15, cc = c & 31, ob = rr * 64 + cc * 2; return st * 1024 + (ob ^ (((ob >> 9) & 1) << 5)); }
__host__ __device__ __forceinline__ void stage_rc(int b, int& R, int& C) { const int st = b / 1024, sb = b % 1024, swz = sb ^ (((sb >> 9) & 1) << 5); R = (st >> 1) * 16 + swz / 64; C = (st & 1) * 32 + (swz % 64) / 2; }
struct Gemm { const bf16_t* A; const bf16_t* Bt; int K; };

template <class Epi, class Sched, bool GATHER>
__device__ __forceinline__ void gemm_phase(int tid, LAS unsigned char* lds, const Gemm g, const Sched& S, const Epi& E) {
    const int wid = __builtin_amdgcn_readfirstlane(tid >> 6), lane = tid & 63, wr = wid >> 2, wc = wid & 3, fr = lane & 15, fq = lane >> 4;
    const int K = g.K, nt = K / BK;
    int RA[2], CA[2]; unsigned voffB[2];
    unsigned vA[2][2], vAn[2][2];
#pragma unroll
    for (int i = 0; i < 2; ++i) { int R, C; stage_rc(tid * 16 + i * 8192, R, C); RA[i] = R; CA[i] = C; const int Rb = Epi::PERM ? ((R & ~31) + perm32(R & 31)) : R; voffB[i] = (unsigned)(Rb * K + C) * 2u; }
    const size_t kstep = (size_t)(BK * 2);
    const size_t hstep = (size_t)HALF * K * 2;
    const size_t tstep = 2 * hstep;
    const unsigned ldsw = (unsigned)wid * 1024u;
    const int aoff = lds_byte(wr * 64 + fr, fq * 8), boff = lds_byte(wc * 32 + fr, fq * 8);
#define PG8_SA(b, h) (((b) * 2 + (h)) * HTB)
#define PG8_SB(b, h) ((4 + (b) * 2 + (h)) * HTB)
#define PG8_STAGE(bufoff, gbase, voff) do { _Pragma("unroll") for (int _i = 0; _i < 2; ++_i) \
        __builtin_amdgcn_global_load_lds((const unsigned*)((const char*)(gbase) + (voff)[_i]), (LAS unsigned*)(lds + (bufoff) + ldsw + _i * 8192), 16, 0, 0); } while (0)
#define PG8_STAGE2(bufoff, gbase, v0, v1) do { \
        __builtin_amdgcn_global_load_lds((const unsigned*)((const char*)(gbase) + (v0)), (LAS unsigned*)(lds + (bufoff) + ldsw), 16, 0, 0); \
        __builtin_amdgcn_global_load_lds((const unsigned*)((const char*)(gbase) + (v1)), (LAS unsigned*)(lds + (bufoff) + ldsw + 8192), 16, 0, 0); } while (0)
#define PG8_LDA(dst, b, h) do { _Pragma("unroll") for (int m = 0; m < 4; ++m) _Pragma("unroll") for (int k = 0; k < 2; ++k) dst[m][k] = *(const LAS bf16x8*)(lds + PG8_SA(b, h) + aoff + m * 2048 + k * 1024); } while (0)
#define PG8_LDB(dst, b, h) do { _Pragma("unroll") for (int n = 0; n < 2; ++n) _Pragma("unroll") for (int k = 0; k < 2; ++k) dst[n][k] = *(const LAS bf16x8*)(lds + PG8_SB(b, h) + boff + n * 2048 + k * 1024); } while (0)
#define PG8_MMA(ai, bj, At, Bt) do { __builtin_amdgcn_s_setprio(1); _Pragma("unroll") for (int m = 0; m < 4; ++m) _Pragma("unroll") for (int n = 0; n < 2; ++n) _Pragma("unroll") for (int k = 0; k < 2; ++k) \
        acc[ai][bj][m][n] = __builtin_amdgcn_mfma_f32_16x16x32_bf16(Bt[n][k], At[m][k], acc[ai][bj][m][n], 0, 0, 0); __builtin_amdgcn_s_setprio(0); } while (0)
#define PG8_WAIT_V(n) asm volatile("s_waitcnt vmcnt(" #n ")" ::: "memory")
#define PG8_WAIT_L(n) asm volatile("s_waitcnt lgkmcnt(" #n ")" ::: "memory")
#define PG8_BAR __builtin_amdgcn_s_barrier()
#define PG8_SCHED __builtin_amdgcn_sched_barrier(0)
#define PG8_AOFFS(dst, unit) do { _Pragma("unroll") for (int _h = 0; _h < 2; ++_h) _Pragma("unroll") for (int _i = 0; _i < 2; ++_i) \
        dst[_h][_i] = GATHER ? ((unsigned)S.arow(unit, _h * HALF + RA[_i]) * (unsigned)K + (unsigned)CA[_i]) * 2u : ((unsigned)(_h * HALF + RA[_i]) * (unsigned)K + (unsigned)CA[_i]) * 2u; } while (0)
    Unit cur{0, 0, 0, 0}, nxt{0, 0, 0, 0}; int ui = 0;
    if (!S.next(0, cur)) return;
    f32x4 acc[2][2][4][2];
#pragma unroll
    for (int a = 0; a < 2; ++a)
#pragma unroll
        for (int b = 0; b < 2; ++b)
#pragma unroll
            for (int m = 0; m < 4; ++m)
#pragma unroll
                for (int n = 0; n < 2; ++n) acc[a][b][m][n] = (f32x4){0.f, 0.f, 0.f, 0.f};
    bf16x8 At[4][2], B0[2][2], B1[2][2];
    const char* cA = GATHER ? (const char*)g.A : (const char*)g.A + (size_t)cur.pm * tstep; const char* cB = (const char*)g.Bt + (size_t)cur.pn * tstep;
    PG8_AOFFS(vA, cur);
    PG8_STAGE(PG8_SB(0, 0), cB, voffB); PG8_STAGE(PG8_SB(0, 1), cB + hstep, voffB); PG8_STAGE2(PG8_SA(0, 0), cA, vA[0][0], vA[0][1]); PG8_STAGE2(PG8_SA(0, 1), cA, vA[1][0], vA[1][1]);
    if (wr == 1) PG8_BAR;
    PG8_WAIT_V(2); PG8_BAR;
    PG8_STAGE(PG8_SB(1, 0), cB + kstep, voffB); PG8_STAGE2(PG8_SA(1, 0), cA + kstep, vA[0][0], vA[0][1]); PG8_STAGE(PG8_SB(1, 1), cB + hstep + kstep, voffB);
    PG8_WAIT_V(6); PG8_BAR;
    for (;;) {
        const bool has_next = S.next(ui + 1, nxt);
        const char* nA = GATHER ? (const char*)g.A : (has_next ? (const char*)g.A + (size_t)nxt.pm * tstep : cA); const char* nB = has_next ? (const char*)g.Bt + (size_t)nxt.pn * tstep : cB;
        if (GATHER && has_next) { PG8_AOFFS(vAn, nxt); } else {
#pragma unroll
            for (int _h = 0; _h < 2; ++_h)
#pragma unroll
                for (int _i = 0; _i < 2; ++_i) vAn[_h][_i] = vA[_h][_i]; }
#pragma unroll 1
        for (int t = 0; t < nt; t += 2) {
            const bool last = (t == nt - 2);
            const char* a1 = cA + (size_t)(t + 1) * kstep;
            const char* a2 = last ? nA : cA + (size_t)(t + 2) * kstep; const char* b2 = last ? nB : cB + (size_t)(t + 2) * kstep;
            const char* a3 = a2 + kstep; const char* b3 = b2 + kstep;
            const unsigned x00 = (GATHER && last) ? vAn[0][0] : vA[0][0], x01 = (GATHER && last) ? vAn[0][1] : vA[0][1], x10 = (GATHER && last) ? vAn[1][0] : vA[1][0], x11 = (GATHER && last) ? vAn[1][1] : vA[1][1];
            PG8_LDB(B0, 0, 0); PG8_LDB(B1, 0, 1); PG8_SCHED; PG8_LDA(At, 0, 0); PG8_STAGE2(PG8_SA(1, 1), a1, vA[1][0], vA[1][1]);
            PG8_WAIT_V(8); PG8_WAIT_L(0); PG8_BAR; PG8_MMA(0, 0, At, B0); PG8_MMA(0, 1, At, B1); PG8_BAR; PG8_SCHED;
            PG8_LDA(At, 0, 1); PG8_STAGE(PG8_SB(0, 0), b2, voffB); PG8_STAGE(PG8_SB(0, 1), b2 + hstep, voffB); PG8_STAGE2(PG8_SA(0, 0), a2, x00, x01);
            PG8_WAIT_V(8); PG8_WAIT_L(0); PG8_BAR; PG8_MMA(1, 0, At, B0); PG8_MMA(1, 1, At, B1); PG8_BAR; PG8_SCHED;
            PG8_LDB(B0, 1, 0); PG8_LDB(B1, 1, 1); PG8_SCHED; PG8_LDA(At, 1, 0); PG8_STAGE2(PG8_SA(0, 1), a2, x10, x11);
            PG8_WAIT_V(8); PG8_WAIT_L(0); PG8_BAR; PG8_MMA(0, 0, At, B0); PG8_MMA(0, 1, At, B1); PG8_BAR; PG8_SCHED;
            PG8_LDA(At, 1, 1); PG8_STAGE(PG8_SB(1, 0), b3, voffB); PG8_STAGE(PG8_SB(1, 1), b3 + hstep, voffB); PG8_STAGE2(PG8_SA(1, 0), a3, x00, x01);
            PG8_WAIT_V(8); PG8_WAIT_L(0); PG8_BAR; PG8_MMA(1, 0, At, B0); PG8_MMA(1, 1, At, B1); PG8_BAR; PG8_SCHED;
        }
        if (wr == 0) PG8_BAR;
        E(acc, cur, wr, wc, fr, fq);
        if (!has_next) break;
#pragma unroll
        for (int a = 0; a < 2; ++a)
#pragma unroll
            for (int b = 0; b < 2; ++b)
#pragma unroll
                for (int m = 0; m < 4; ++m)
#pragma unroll
                    for (int n = 0; n < 2; ++n) acc[a][b][m][n] = (f32x4){0.f, 0.f, 0.f, 0.f};
        cur = nxt; cA = nA; cB = nB; ++ui;
        if (GATHER) {
#pragma unroll
        for (int _h = 0; _h < 2; ++_h)
#pragma unroll
            for (int _i = 0; _i < 2; ++_i) vA[_h][_i] = vAn[_h][_i]; }
        if (wr == 1) PG8_BAR;
    }
    PG8_WAIT_V(0);
    PG8_BAR;
#undef PG8_SA
#undef PG8_SB
#undef PG8_STAGE
#undef PG8_STAGE2
#undef PG8_LDA
#undef PG8_LDB
#undef PG8_MMA
#undef PG8_WAIT_V
#undef PG8_WAIT_L
#undef PG8_BAR
#undef PG8_SCHED
#undef PG8_AOFFS
}
}

struct XOrder { int G, c, MT, NT;
    __device__ __forceinline__ bool map(int i, int& pm, int& pn) const {
        if ((G & 7) == 0 && (MT & 7) == 0) { const int x = c & 7, r = c >> 3, W = G >> 3, MX = MT >> 3; const int L = i * W + r; if (L >= MX * NT) return false; pm = x * MX + L / NT; pn = L % NT; return true; }
        const int L = i * G + c; if (L >= MT * NT) return false; pm = L / NT; pn = L % NT; return true; } };
struct SchedG1 { XOrder X; __device__ __forceinline__ bool next(int i, Unit& u) const { int pm, pn; if (!X.map(i, pm, pn)) return false; u.pm = pm; u.pn = pn; u.e = 0; u.aux = 0; return true; }
    __device__ __forceinline__ int arow(const Unit&, int) const { return 0; } };
struct SchedG2 { XOrder X; __device__ __forceinline__ bool next(int i, Unit& u) const { int pm, q; if (!X.map(i, pm, q)) return false; const int k = q >> 2, pnn = q & 3;
        u.pm = k * (T / 256) + pm; u.pn = k * 4 + pnn; u.e = k; u.aux = pnn; return true; }
    __device__ __forceinline__ int arow(const Unit&, int) const { return 0; } };
struct SchedMN { XOrder X; __device__ __forceinline__ bool next(int i, Unit& u) const { int pm, pn; if (!X.map(i, pm, pn)) return false; u.pm = pm; u.pn = pn; u.e = 0; u.aux = 0; return true; }
    __device__ __forceinline__ int arow(const Unit&, int) const { return 0; } };

struct EpiBf16Plain {
    static constexpr bool PERM = true;
    bf16_t* O; int ldc; int coltile_mask;
    __device__ __forceinline__ void operator()(const f32x4 (&acc)[2][2][4][2], const Unit& u, int wr, int wc, int fr, int fq) const {
        const int row0 = u.pm * 256 + wr * 64 + fr, col0 = (u.pn & coltile_mask) * 256 + wc * 32 + 8 * fq;
#pragma unroll
        for (int ai = 0; ai < 2; ++ai)
#pragma unroll
            for (int m = 0; m < 4; ++m) { bf16_t* rowp = O + ((unsigned)(row0 + ai * 128 + m * 16) * (unsigned)ldc + (unsigned)col0);
#pragma unroll
                for (int bj = 0; bj < 2; ++bj) { const f32x4 v0 = acc[ai][bj][m][0], v1 = acc[ai][bj][m][1];
                    u32x4 w; w.x = pack2(v0[0], v0[1]); w.y = pack2(v0[2], v0[3]); w.z = pack2(v1[0], v1[1]); w.w = pack2(v1[2], v1[3]);
                    *(u32x4*)(rowp + bj * 128) = w; } }
    }
};
struct EpiP {
    static constexpr bool PERM = true;
    bf16_t* P; const float* ssq;
    __device__ __forceinline__ void operator()(const f32x4 (&acc)[2][2][4][2], const Unit& u, int wr, int wc, int fr, int fq) const {
        const int k = u.e; const int pmt = u.pm - k * (T / 256);
        const unsigned c00 = (unsigned)(u.aux * 256 + wc * 32 + 8 * fq);
        const unsigned base = (unsigned)pmt * (16u * 256u * 256u) + (unsigned)k * 16384u;
        float scv[8];
#pragma unroll
        for (int i = 0; i < 8; ++i) scv[i] = 1.0f;
        if (k == 3) {
            f32x4 qv[8];
#pragma unroll
            for (int i = 0; i < 8; ++i) qv[i] = *(const f32x4*)(ssq + (unsigned)(pmt * 256 + (i >> 2) * 128 + wr * 64 + (i & 3) * 16 + fr) * 4u);
#pragma unroll
            for (int i = 0; i < 8; ++i) scv[i] = rsqrtf((qv[i][0] + qv[i][1] + qv[i][2] + qv[i][3]) * (1.0f / 256.0f) + kconst(RMS_EPS));
        }
#pragma unroll
        for (int ai = 0; ai < 2; ++ai)
#pragma unroll
            for (int m = 0; m < 4; ++m) { const int r = ai * 128 + wr * 64 + m * 16 + fr; const float sc = scv[ai * 4 + m];
#pragma unroll
                for (int bj = 0; bj < 2; ++bj) { const unsigned c0 = c00 + bj * 128; const unsigned s = c0 >> 6, wi = c0 & 63;
                    const f32x4 v0 = acc[ai][bj][m][0] * sc, v1 = acc[ai][bj][m][1] * sc;
                    u32x4 w; w.x = pack2(v0[0], v0[1]); w.y = pack2(v0[2], v0[3]); w.z = pack2(v1[0], v1[1]); w.w = pack2(v1[2], v1[3]);
                    __builtin_nontemporal_store(w, (u32x4*)(P + (base + s * 65536u + (wi >> 4) * 4096u + (unsigned)r * 16u + (wi & 15u)))); }
                asm volatile("" ::: "memory"); }
    }
};
struct EpiMerge {
    static constexpr bool PERM = false;
    const bf16_t* P; const float* bgp; bf16_t* Y;
    __device__ __forceinline__ void operator()(const f32x4 (&acc)[2][2][4][2], const Unit& u, int wr, int wc, int fr, int fq) const {
        const int s = u.pn;
        f32x4 bv[2][2];
#pragma unroll
        for (int bj = 0; bj < 2; ++bj)
#pragma unroll
            for (int n = 0; n < 2; ++n) bv[bj][n] = *(const f32x4*)(bgp + s * 256 + bj * 128 + wc * 32 + n * 16 + 4 * fq);
        const bf16_t* pb = P + (((unsigned)u.pm * 16u + (unsigned)s) * 65536u + (unsigned)(wc * 4096 + (wr * 64 + fr) * 16 + 4 * fq));
        u32x2 pw[2][4][4];
#pragma unroll
        for (int ai = 0; ai < 2; ++ai)
#pragma unroll
            for (int k = 0; k < 4; ++k)
#pragma unroll
                for (int m = 0; m < 4; ++m) pw[ai][m][k] = *(const u32x2*)(pb + (ai * 2048 + k * 16384 + m * 256));
        __builtin_amdgcn_sched_barrier(0);
#pragma unroll
        for (int ai = 0; ai < 2; ++ai)
#pragma unroll
            for (int m = 0; m < 4; ++m) { const int r = ai * 128 + wr * 64 + m * 16 + fr;
                f32x4 y = (f32x4){0.f, 0.f, 0.f, 0.f};
#pragma unroll
                for (int bj = 0; bj < 2; ++bj)
#pragma unroll
                    for (int n = 0; n < 2; ++n) { const int k = 2 * bj + n; const u32x2 pq = pw[ai][m][k];
                        const f32x4 g = acc[ai][bj][m][n] + bv[bj][n];
                        f32x4 sg; sg[0] = __builtin_amdgcn_exp2f(g[0]); sg[1] = __builtin_amdgcn_exp2f(g[1]); sg[2] = __builtin_amdgcn_exp2f(g[2]); sg[3] = __builtin_amdgcn_exp2f(g[3]);
                        sg = sg + 1.0f; sg[0] = __builtin_amdgcn_rcpf(sg[0]); sg[1] = __builtin_amdgcn_rcpf(sg[1]); sg[2] = __builtin_amdgcn_rcpf(sg[2]); sg[3] = __builtin_amdgcn_rcpf(sg[3]);
                        const f32x4 pv = (f32x4){__uint_as_float(pq.x << 16), __uint_as_float(pq.x & 0xffff0000u), __uint_as_float(pq.y << 16), __uint_as_float(pq.y & 0xffff0000u)};
                        y += sg * pv; }
                u32x2 w; w.x = pack2(y[0], y[1]); w.y = pack2(y[2], y[3]);
                *(u32x2*)(Y + ((unsigned)(u.pm * 256 + r) * (unsigned)D + (unsigned)(s * 64 + wc * 16 + 4 * fq))) = w; }
    }
};
template <bool FIRST>
struct EpiWo {
    static constexpr bool PREFETCH = false; __device__ __forceinline__ void prefetch(const Unit&, int, LAS unsigned char*) const {}
    static constexpr bool PERM = false;
    Ptrs P; int layer; const float* xin; const float* cin;
    __device__ __forceinline__ void operator()(const f32x4 (&acc)[2][2][4][2], const Unit& u, int wr, int wc, int fr, int fq) const {
        const int col0 = u.pn * 256 + wc * 32 + 4 * fq;
        f32x4 om[2][2];
        if (FIRST) {
#pragma unroll
            for (int bj = 0; bj < 2; ++bj)
#pragma unroll
                for (int n = 0; n < 2; ++n)
#pragma unroll
                    for (int e = 0; e < 4; ++e) om[bj][n][e] = fexp(-9.210340371976184f * (float)(wc * 32 + 4 * fq + bj * 128 + n * 16 + e) * (1.0f / 256.0f)) * 0.15915494309189535f;
        }
#pragma unroll
        for (int ai = 0; ai < 2; ++ai)
#pragma unroll
            for (int m = 0; m < 4; ++m) { const int row = u.pm * 256 + ai * 128 + wr * 64 + m * 16 + fr;
                float* lp = P.latrow(row) + col0; const float* g1 = P.mod(layer, row_modidx(row)) + 2048 + col0;
                const float* sp = lp; float pv = 0.f; const bool islat = row < NLAT;
                if (FIRST) { sp = (islat ? xin + (size_t)row * D : cin + (size_t)(row - NLAT) * D) + col0; const int t = row & 4095; pv = (float)((u.pn >> 1) ? (t & 63) : (t >> 6)); }
#pragma unroll
                for (int bj = 0; bj < 2; ++bj)
#pragma unroll
                    for (int n = 0; n < 2; ++n) { f32x4 x = *(const f32x4*)(sp + bj * 128 + n * 16); const f32x4 g = *(const f32x4*)(g1 + bj * 128 + n * 16);
                        if (FIRST) {
#pragma unroll
                            for (int e = 0; e < 4; ++e) { const float rv = pv * om[bj][n][e]; const float pe = (u.pn & 1) ? __builtin_amdgcn_cosf(rv) : __builtin_amdgcn_sinf(rv); x[e] += islat ? pe : 0.f; } }
                        *(f32x4*)(lp + bj * 128 + n * 16) = x * ALPHA + g * acc[ai][bj][m][n]; } }
    }
};
struct EpiFfn1 {
    static constexpr bool PERM = false;
    bf16_t* H;
    __device__ __forceinline__ void operator()(const f32x4 (&acc)[2][2][4][2], const Unit& u, int wr, int wc, int fr, int fq) const {
        const int pnn = u.pn & 3;
#pragma unroll
        for (int ai = 0; ai < 2; ++ai)
#pragma unroll
            for (int m = 0; m < 4; ++m) { const int pos = u.pm * 256 + ai * 128 + wr * 64 + m * 16 + fr;
#pragma unroll
                for (int bj = 0; bj < 2; ++bj) { const f32x4 a = acc[ai][bj][m][0], b = acc[ai][bj][m][1];
                    u32x2 w; w.x = pack2(siluf_(a[0]) * b[0], siluf_(a[1]) * b[1]); w.y = pack2(siluf_(a[2]) * b[2], siluf_(a[3]) * b[3]);
                    *(u32x2*)(H + ((unsigned)pos * 512u + (unsigned)(pnn * 128 + bj * 64 + wc * 16 + 4 * fq))) = w; } }
    }
};

template <class SrcFn>
__device__ __forceinline__ void conv_tile(int tid, LAS float* tile  , bf16_t* dst, int ldd, int n0, int k0, const SrcFn& src, const float scale = 1.0f) {
    f32x4 v[8];
#pragma unroll
    for (int i = 0; i < 8; ++i) { const int kk = (tid >> 4) + 32 * i, j4 = tid & 15; v[i] = *(const f32x4*)src(k0 + kk, n0 + 4 * j4); }
#pragma unroll
    for (int i = 0; i < 8; ++i) { const int kk = (tid >> 4) + 32 * i, j4 = tid & 15; LAS float* t = tile + kk * 65 + 4 * j4; t[0] = v[i][0]; t[1] = v[i][1]; t[2] = v[i][2]; t[3] = v[i][3]; }
    __syncthreads();
    { const int jj = tid >> 3, kq = tid & 7;
#pragma unroll
      for (int kb = 0; kb < 4; ++kb) { float x[8];
#pragma unroll
          for (int i = 0; i < 8; ++i) x[i] = tile[(64 * kb + 8 * kq + i) * 65 + jj] * scale;
          u32x4 w; w.x = pack2(x[0], x[1]); w.y = pack2(x[2], x[3]); w.z = pack2(x[4], x[5]); w.w = pack2(x[6], x[7]);
          *(u32x4*)(dst + (size_t)(n0 + jj) * ldd + k0 + 64 * kb + 8 * kq) = w; } }
    __syncthreads();
}
constexpr int NCONV_NE = 56 * 4 + 64 * 4 + 64 * 1 + 16 * 4;
constexpr int NCONV_EX = NE * (16 * 4 + 16 * 2);
__device__ __forceinline__ int gate_srccol(int np) { const int s = np >> 8, bj = (np >> 7) & 1, wc = (np >> 5) & 3, n = (np >> 4) & 1, fqe = np & 15; return (2 * bj + n) * 1024 + 64 * s + 16 * wc + fqe; }
__device__ __forceinline__ void conv_unit_ne(const Ptrs P, int l, int t, LAS float* tile) {
    unsigned char* ws = P.ws;
    if (t < 224) { const int nt = t >> 2, kt = t & 3; const float* src = P.inp(I_WIN) + (size_t)l * D * INC;
        conv_tile(P.tid, tile, (bf16_t*)(ws + WS_WIN), D, nt * 64, kt * 256, [=](int k, int n) { return src + (size_t)k * INC + n; });
    } else if (t < 224 + 256) { t -= 224; const int nt = t >> 2, kt = t & 3; const float* src = P.inp(I_WGATE) + (size_t)l * D * 4096;
        conv_tile(P.tid, tile, (bf16_t*)(ws + WS_WG), D, nt * 64, kt * 256, [=](int k, int n) { return src + (size_t)k * 4096 + gate_srccol(n); }, -1.4426950408889634f);
        if (kt == 0 && P.tid < 64) { const int np = nt * 64 + P.tid; ((float*)(ws + WS_BGP))[np] = P.inp(I_BGATE)[(size_t)l * 4096 + gate_srccol(np)] * -1.4426950408889634f; }
    } else if (t < 224 + 256 + 64) { t -= 480; const int nt = t; const int kb = nt >> 4;
        const float* src = P.inp(I_WBR) + ((size_t)l * 4 + kb) * 256 * 1024;
        conv_tile(P.tid, tile, (bf16_t*)(ws + WS_WBR), 256, nt * 64, 0, [=](int k, int n) { return src + (size_t)k * 1024 + (n & 1023); });
    } else { t -= 544; const int nt = t >> 2, kt = t & 3; const float* src = P.inp(I_WO) + (size_t)l * D * D;
        conv_tile(P.tid, tile, (bf16_t*)(ws + WS_WO), D, nt * 64, kt * 256, [=](int k, int n) { return src + (size_t)k * D + n; });
    }
}
__device__ __forceinline__ void conv_unit_ex(const Ptrs P, int l, int t, LAS float* tile) {
    unsigned char* ws = P.ws;
    const int e = t / 96; t -= e * 96;
    if (t < 64) { const int nt = t >> 2, kt = t & 3;
        const float* s1 = P.inp(I_WE1) + ((size_t)l * NE + e) * 1024 * 512; const float* s3 = P.inp(I_WE3) + ((size_t)l * NE + e) * 1024 * 512;
        conv_tile(P.tid, tile, (bf16_t*)(ws + WS_BIG + BIG_W13) + (size_t)e * 1024 * 1024, 1024, nt * 64, kt * 256, [=](int k, int n) {
            const int pn = n >> 8, bj = (n >> 7) & 1, wc = (n >> 5) & 3, nn = (n >> 4) & 1, fqe = n & 15; const int ch = 128 * pn + 64 * bj + 16 * wc + fqe;
            return (nn ? s3 : s1) + (size_t)k * 512 + ch; });
    } else { t -= 64; const int nt = t >> 1, kt = t & 1; const float* src = P.inp(I_WE2) + ((size_t)l * NE + e) * 512 * 1024;
        conv_tile(P.tid, tile, (bf16_t*)(ws + WS_BIG + BIG_W2) + (size_t)e * 1024 * 512, 512, nt * 64, kt * 256, [=](int k, int n) { return src + (size_t)k * 1024 + n; });
    }
}

struct ConvEx { Ptrs P; int l; LAS float* tile; __device__ __forceinline__ void operator()(int t) const { conv_unit_ex(P, l, t, tile); } };
struct ConvNe { Ptrs P; int l; LAS float* tile; __device__ __forceinline__ void operator()(int t) const { conv_unit_ne(P, l, t, tile); } };
template <class F>
__device__ __forceinline__ void dyn_tiles(int tid, unsigned* ctr, int n, volatile LAS unsigned* slot, const F& f) {
    const bool t0 = (tid == 0);
    if (t0) slot[0] = __hip_atomic_fetch_add(ctr, 1u, __ATOMIC_RELAXED, __HIP_MEMORY_SCOPE_AGENT);
    __syncthreads();
    unsigned t = (unsigned)__builtin_amdgcn_readfirstlane((int)slot[0]);
    __syncthreads();
    while (t < (unsigned)n) {
        unsigned tn = 0u; if (t0) tn = __hip_atomic_fetch_add(ctr, 1u, __ATOMIC_RELAXED, __HIP_MEMORY_SCOPE_AGENT);
        f((int)t);
        if (t0) slot[0] = tn;
        __syncthreads();
        t = (unsigned)__builtin_amdgcn_readfirstlane((int)slot[0]);
        __syncthreads();
    }
}

struct RowV { f32x4 v[4]; };
__device__ __forceinline__ void row_load(RowV& r, const float* p, int lane) {
#pragma unroll
    for (int i = 0; i < 4; ++i) r.v[i] = *(const f32x4*)(p + i * 256 + lane * 4);
}
__device__ __forceinline__ void row_store(const RowV& r, float* p, int lane) {
#pragma unroll
    for (int i = 0; i < 4; ++i) *(f32x4*)(p + i * 256 + lane * 4) = r.v[i];
}
__device__ __forceinline__ void row_layernorm(RowV& r, const float* g, const float* b, int lane) {
    float s = 0.f;
#pragma unroll
    for (int i = 0; i < 4; ++i) s += r.v[i][0] + r.v[i][1] + r.v[i][2] + r.v[i][3];
    const float mu = wave_sum(s) * (1.0f / 1024.0f);
    float q = 0.f;
#pragma unroll
    for (int i = 0; i < 4; ++i) { const f32x4 d = r.v[i] - mu; q += d[0] * d[0] + d[1] * d[1] + d[2] * d[2] + d[3] * d[3]; }
    const float rstd = rsqrtf(wave_sum(q) * (1.0f / 1024.0f) + kconst(LN_EPS));
#pragma unroll
    for (int i = 0; i < 4; ++i) { const f32x4 gg = *(const f32x4*)(g + i * 256 + lane * 4), bb = *(const f32x4*)(b + i * 256 + lane * 4); r.v[i] = (r.v[i] - mu) * rstd * gg + bb; }
}
__device__ __forceinline__ void row_layernorm_r(RowV& r, const RowV& g, const RowV& b) {
    float s = 0.f;
#pragma unroll
    for (int i = 0; i < 4; ++i) s += r.v[i][0] + r.v[i][1] + r.v[i][2] + r.v[i][3];
    const float mu = wave_sum(s) * (1.0f / 1024.0f);
    float q = 0.f;
#pragma unroll
    for (int i = 0; i < 4; ++i) { const f32x4 d = r.v[i] - mu; q += d[0] * d[0] + d[1] * d[1] + d[2] * d[2] + d[3] * d[3]; }
    const float rstd = rsqrtf(wave_sum(q) * (1.0f / 1024.0f) + kconst(LN_EPS));
#pragma unroll
    for (int i = 0; i < 4; ++i) r.v[i] = (r.v[i] - mu) * rstd * g.v[i] + b.v[i];
}
__device__ __forceinline__ void row_modulate(const RowV& r, RowV& h, const float* sh, const float* sc, int lane) {
#pragma unroll
    for (int i = 0; i < 4; ++i) { const f32x4 a = *(const f32x4*)(sc + i * 256 + lane * 4), b = *(const f32x4*)(sh + i * 256 + lane * 4); h.v[i] = r.v[i] * (a + 1.0f) + b; }
}
__device__ __forceinline__ void row_modulate_r(const RowV& r, RowV& h, const RowV& sh, const RowV& sc) {
#pragma unroll
    for (int i = 0; i < 4; ++i) h.v[i] = r.v[i] * (sc.v[i] + 1.0f) + sh.v[i];
}
__device__ __forceinline__ void row_store_bf16(const RowV& h, bf16_t* p, int lane) {
#pragma unroll
    for (int i = 0; i < 4; ++i) { u32x2 w; w.x = pack2(h.v[i][0], h.v[i][1]); w.y = pack2(h.v[i][2], h.v[i][3]); *(u32x2*)(p + i * 256 + lane * 4) = w; }
}
__device__ __forceinline__ void row_dt(const RowV& h, const LAS float* wdt, float* dtout, int lane) {
    float a[8];
#pragma unroll
    for (int j = 0; j < 8; ++j) a[j] = 0.f;
#pragma unroll
    for (int i = 0; i < 4; ++i)
#pragma unroll
        for (int e = 0; e < 4; ++e) { const int k = i * 256 + lane * 4 + e; const float hv = h.v[i][e];
            const f32x4 w0 = *(const LAS f32x4*)(wdt + k * 8), w1 = *(const LAS f32x4*)(wdt + k * 8 + 4);
            a[0] += hv * w0[0]; a[1] += hv * w0[1]; a[2] += hv * w0[2]; a[3] += hv * w0[3]; a[4] += hv * w1[0]; a[5] += hv * w1[1]; a[6] += hv * w1[2]; a[7] += hv * w1[3]; }
#pragma unroll
    for (int j = 0; j < 8; ++j) a[j] = wave_sum(a[j]);
    if (lane == 0) { *(f32x4*)dtout = (f32x4){a[0], a[1], a[2], a[3]}; *(f32x4*)(dtout + 4) = (f32x4){a[4], a[5], a[6], a[7]}; }
}
__device__ __forceinline__ void load_wdt(const Ptrs P, int l, LAS float* wdt) {
    const float* src = P.inp(I_WIN) + (size_t)l * D * INC + UC;
    for (int i = P.tid; i < 1024 * 8; i += 512) wdt[i] = src[(size_t)(i >> 3) * INC + (i & 7)];
    __syncthreads();
}

__device__ __forceinline__ void phase_pa(const Ptrs P, LAS unsigned char* lds) {
    const int tid = P.tid, wid = tid >> 6, lane = tid & 63, G = P.G;
    const int NU_MOD = 2 * 96, NU_H2 = 8448 / 8, NU_LB = 1;
    const int NU = NU_MOD + NU_H2 + NU_LB + NCONV_NE;
    for (int u = P.bid; u < NU; u += G) {
        if (u < NU_MOD) {
            const int l = u / 96, cb = u % 96;
            LAS float* sc = (LAS float*)lds; LAS float* red = sc + 9 * 1024;
            { const float* cin_ = P.inp(I_C); const float* cctx_ = P.inp(I_CCTX);
              for (int i = tid; i < 9 * 1024; i += 512) { const int r = i >> 10, k = i & 1023; const float v = r < 8 ? cin_[r * 1024 + k] : cctx_[k]; sc[i] = v / (1.0f + fexp(-v)); } }
            __syncthreads();
            const int col = cb * 64 + lane; const float* w = P.inp(I_WADA) + (size_t)l * D * 6144 + col;
            float acc[9];
#pragma unroll
            for (int r = 0; r < 9; ++r) acc[r] = 0.f;
            for (int k = wid * 128; k < wid * 128 + 128; ++k) { const float wv = w[(size_t)k * 6144];
#pragma unroll
                for (int r = 0; r < 9; ++r) acc[r] += sc[r * 1024 + k] * wv; }
#pragma unroll
            for (int r = 0; r < 9; ++r) red[(wid * 9 + r) * 64 + lane] = acc[r];
            __syncthreads();
            const float* bada_ = P.inp(I_BADA);
            for (int i = tid; i < 9 * 64; i += 512) { const int r = i >> 6, c = i & 63; float s = bada_[(size_t)l * 6144 + cb * 64 + c];
#pragma unroll
                for (int w8 = 0; w8 < 8; ++w8) s += red[(w8 * 9 + r) * 64 + c];
                P.mod(l, r)[cb * 64 + c] = s; }
            __syncthreads();
        } else if (u < NU_MOD + NU_H2) {
            const int rho = (u - NU_MOD) * 8 + wid;
            const int l = (rho >= 4096 && rho < 8192) ? 1 : 0; const int L = rho < 8192 ? 4096 : 256; const int i = rho < 8192 ? (rho & 4095) : (rho - 8192);
            float featv = 0.f;
            if (lane == 0) featv = (float)((double)i / (double)(L - 1));
            else if (lane < 33) { const int j = (lane - 1) & 15; const double band = 1e-4 + (double)j * ((15.0 - 1e-4) / 15.0);
                const double ang = (2.0 * 3.14159265358979323846 / (double)L) * (double)i * band; featv = lane < 17 ? (float)cos(ang) : (float)(-sin(ang)); }
            const float* hw1_ = P.inp(I_HYW1); const float* hw2_ = P.inp(I_HYW2);
            float z1 = P.inp(I_HYB1)[l * 64 + lane];
            for (int m = 0; m < 33; ++m) z1 += __shfl(featv, m) * hw1_[((size_t)l * 33 + m) * 64 + lane];
            const float h1 = sinf(P.inp(I_HYF1)[l * 64 + lane] * z1);
            float z2 = P.inp(I_HYB2)[l * 64 + lane];
            for (int m = 0; m < 64; ++m) z2 += __shfl(h1, m) * hw2_[((size_t)l * 64 + m) * 64 + lane];
            ((float*)(P.ws + WS_H2TAB))[(size_t)rho * 64 + lane] = sinf(P.inp(I_HYF2)[l * 64 + lane] * z2);
        } else if (u < NU_MOD + NU_H2 + NU_LB) {
            for (int i = tid; i < 4096; i += 512) { const double a = -2.0 * 3.14159265358979323846 * (double)i / 8192.0; ((float*)(P.ws + WS_TW))[2 * i] = (float)cos(a); ((float*)(P.ws + WS_TW))[2 * i + 1] = (float)sin(a); }
            for (int i = tid; i < 1024; i += 512) { const int d = i >> 9, l = (i >> 8) & 1, c = i & 255;
                const float l0 = P.inp(I_HGLB)[d * 512 + c], l1 = P.inp(I_HGLB)[d * 512 + 256 + c];
                ((float*)(P.ws + WS_LB))[i] = l == 0 ? 0.0f : 1.0f / (1.0f + fexp(l0 - l1)); }
        } else {
            conv_unit_ne(P, 0, u - (NU_MOD + NU_H2 + NU_LB), (LAS float*)lds);
        }
    }
}

__device__ __forceinline__ void emit_rows_init(const Ptrs P, LAS float* wdt);
__device__ __forceinline__ void phase_pb(const Ptrs P, LAS unsigned char* lds) {
    const int tid = P.tid, G = P.G;
    for (int u = P.bid; u < 132; u += G) {
        const int tab = u < 64 ? 0 : (u < 128 ? 1 : 2); const int ib = tab == 0 ? u : (tab == 1 ? u - 64 : u - 128);
        const int l = tab == 1 ? 1 : 0; const int L = tab == 2 ? 256 : 4096; const int rho0 = (tab == 0 ? 0 : (tab == 1 ? 4096 : 8192)) + ib * 64;
        LAS float* h2 = (LAS float*)lds;
        for (int i = tid; i < 64 * 64; i += 512) h2[i] = ((const float*)(P.ws + WS_H2TAB))[(size_t)rho0 * 64 + i];
        __syncthreads();
        const int o = tid, c = tid & 255, dir = tid >> 8;
        float w3[64]; const float* hw3_ = P.inp(I_HYW3);
#pragma unroll
        for (int j = 0; j < 64; ++j) w3[j] = hw3_[((size_t)l * 64 + j) * 512 + o];
        const float dec = fabsf(P.inp(I_HYDEC)[l * 256 + c]);
        float* filt = tab == 2 ? (float*)(P.ws + WS_FILTC) : (float*)(P.ws + WS_FILT) + (size_t)l * 8192 * 256;
        const int L2 = 2 * L; float part = 0.f;
        for (int r = 0; r < 64; ++r) { const int i = ib * 64 + r; float s = 0.f;
#pragma unroll
            for (int j = 0; j < 64; ++j) s += h2[r * 64 + j] * w3[j];
            const float t = (float)i / (float)(L - 1); s *= fexp(-t * dec);
            if (dir == 0) { filt[(size_t)i * 256 + c] = s; part += fabsf(s); }
            else if (i == 0) filt[(size_t)L * 256 + c] = 0.f;
            else { filt[(size_t)(L2 - i) * 256 + c] = s; part += fabsf(s); } }
        ((float*)(P.ws + WS_PART))[((size_t)tab * 64 + ib) * 512 + o] = part;
        __syncthreads();
    }
    emit_rows_init(P, (LAS float*)lds);
}
__device__ __forceinline__ float hy_norm(const Ptrs P, int tab, int c) {
    const float* part = (const float*)(P.ws + WS_PART) + (size_t)tab * 64 * 512; const int nb = tab == 2 ? 4 : 64; float s = 0.f;
    for (int b = 0; b < nb; ++b) s += part[b * 512 + c] + part[b * 512 + 256 + c];
    return s;
}

__device__ __forceinline__ void emit_rows_init(const Ptrs P, LAS float* wdt) {
    const int tid = P.tid, wid = tid >> 6, lane = tid & 63, G = P.G;
    load_wdt(P, 0, wdt);
    LAS float* tabA = wdt + 1024 * 8; LAS float* tabB = tabA + 8 * 256 * 2;
    for (int i = tid; i < 2 * 8 * 256; i += 512) { const int tb = i >> 11, a = (i >> 8) & 7, ii = i & 255; const float om = fexp(-9.210340371976184f * (float)ii * (1.0f / 256.0f)); const float ang = (float)(tb ? a : 8 * a) * om;
        LAS float* t = (tb ? tabB : tabA) + (a * 256 + ii) * 2; t[0] = sinf(ang); t[1] = cosf(ang); }
    __syncthreads();
    const float* xin = P.inp(I_X); const float* cin = P.inp(I_CTX);
    RowV msh, msc; { const float z = zero_f(); for (int i = 0; i < 4; ++i) { msh.v[i] = (f32x4){z, z, z, z}; msc.v[i] = msh.v[i]; } } int mcur = -1;
    RowV rn; { const float z = zero_f(); for (int i = 0; i < 4; ++i) rn.v[i] = (f32x4){z, z, z, z}; } if (P.bid < T / 8) { const int rw = P.bid * 8 + wid; row_load(rn, rw < NLAT ? xin + (size_t)rw * D : cin + (size_t)(rw - NLAT) * D, lane); }
    for (int u = P.bid; u < T / 8; u += G) {
        const int row = u * 8 + wid; RowV r = rn;
        if (u + G < T / 8) { const int rw = (u + G) * 8 + wid; row_load(rn, rw < NLAT ? xin + (size_t)rw * D : cin + (size_t)(rw - NLAT) * D, lane); }
        if (row < NLAT) {
            const int t = row & 4095; const int prow = t >> 6, pcol = t & 63;
#pragma unroll
            for (int hf = 0; hf < 2; ++hf) { const int pos = hf ? pcol : prow; const LAS float* pa = tabA + ((pos >> 3) * 256 + lane * 4) * 2; const LAS float* pb = tabB + ((pos & 7) * 256 + lane * 4) * 2;
                const f32x4 a0 = *(const LAS f32x4*)pa, a1 = *(const LAS f32x4*)(pa + 4), b0 = *(const LAS f32x4*)pb, b1 = *(const LAS f32x4*)(pb + 4);
                f32x4 sn, cs;
                sn[0] = a0[0] * b0[1] + a0[1] * b0[0]; cs[0] = a0[1] * b0[1] - a0[0] * b0[0]; sn[1] = a0[2] * b0[3] + a0[3] * b0[2]; cs[1] = a0[3] * b0[3] - a0[2] * b0[2];
                sn[2] = a1[0] * b1[1] + a1[1] * b1[0]; cs[2] = a1[1] * b1[1] - a1[0] * b1[0]; sn[3] = a1[2] * b1[3] + a1[3] * b1[2]; cs[3] = a1[3] * b1[3] - a1[2] * b1[2];
                r.v[2 * hf] += sn; r.v[2 * hf + 1] += cs; }
        }
        const int mi = row_modidx(row); if (mi != mcur) { mcur = mi; const float* m = P.mod(0, mi); row_load(msh, m, lane); row_load(msc, m + 1024, lane); }
        RowV h; row_modulate_r(r, h, msh, msc);
        row_store_bf16(h, (bf16_t*)(P.ws + WS_HBUF) + (size_t)row * D, lane);
        row_dt(h, wdt, (float*)(P.ws + WS_DT) + (size_t)row * 8, lane);
    }
}

__device__ __forceinline__ void phase_g1(const Ptrs P, LAS unsigned char* lds) {
    pg8::Gemm g{(const bf16_t*)(P.ws + WS_HBUF), (const bf16_t*)(P.ws + WS_WIN), D};
    EpiBf16Plain E{(bf16_t*)(P.ws + WS_BIG + BIG_U), UC, 0xffff};
    SchedG1 S{XOrder{P.G, P.bid, T / 256, 14}};
    pg8::gemm_phase<EpiBf16Plain, SchedG1, false>(P.tid, lds, g, S, E);
}

constexpr int NCHK = 34;
__device__ __forceinline__ int chunk_row0(int b, int pc) { return pc < 2 ? NLAT + b * CTXL + pc * 128 : b * SEQ + (pc - 2) * 128; }
__device__ __forceinline__ int chunk_at(int dir, int q) { return dir == 0 ? q : (q < 2 ? 1 - q : 35 - q); }
__device__ __forceinline__ int sidx(int kind, int b, int h, int dir, int pc) { return (((kind * 8 + b) * 4 + h) * 2 + dir) * NCHK + pc; }
__device__ __forceinline__ bf16x8 pack8(const float (&v)[8]) { u32x4 w; w.x = pack2(v[0], v[1]); w.y = pack2(v[2], v[3]); w.z = pack2(v[4], v[5]); w.w = pack2(v[6], v[7]); return __builtin_bit_cast(bf16x8, w); }
__device__ __forceinline__ float softplusf_(float x) { return x > 20.f ? x : flog(1.0f + fexp(x)); }
__device__ __forceinline__ float wave_incl_scan(float v, int lane) {
#pragma unroll
    for (int d = 1; d < 64; d <<= 1) { const float t = __shfl_up(v, d); if (lane >= d) v += t; }
    return v;
}

template <bool SILU>
__device__ __forceinline__ void conv3_8(const bf16_t* U, int row, int col0, const float* w, int ncol, int wcol0, const float* bias, float (&out)[8]) {
    const bool hp = row_has_prev(row), hn = row_has_next(row);
    const bf16x8 c = *(const bf16x8*)(U + (size_t)row * UC + col0);
    const bf16x8 p = *(const bf16x8*)(U + (size_t)(hp ? row - 1 : row) * UC + col0), n = *(const bf16x8*)(U + (size_t)(hn ? row + 1 : row) * UC + col0);
    const float mp = hp ? 1.0f : 0.0f, mn = hn ? 1.0f : 0.0f;
#pragma unroll
    for (int h4 = 0; h4 < 2; ++h4) { const f32x4 w0 = *(const f32x4*)(w + wcol0 + 4 * h4), w1 = *(const f32x4*)(w + ncol + wcol0 + 4 * h4), w2 = *(const f32x4*)(w + 2 * ncol + wcol0 + 4 * h4), bb = *(const f32x4*)(bias + wcol0 + 4 * h4);
#pragma unroll
        for (int e = 0; e < 4; ++e) { const int i = 4 * h4 + e; const float v = bf2f((bf16_t)c[i]) * w1[e] + mp * bf2f((bf16_t)p[i]) * w0[e] + mn * bf2f((bf16_t)n[i]) * w2[e] + bb[e]; out[i] = SILU ? siluf_(v) : v; } }
}
__device__ __forceinline__ void conv3_silu8(const bf16_t* U, int row, int col0, const float* w, int ncol, int wcol0, const float* bias, float (&out)[8]) { conv3_8<true>(U, row, col0, w, ncol, wcol0, bias, out); }
struct W8 { f32x4 w0[2], w1[2], w2[2], bb[2]; };
struct U3 { bf16x8 c, p, n; float mp, mn; };
__device__ __forceinline__ void load_w8(W8& W, const float* w, int ncol, int wcol0, const float* bias) {
#pragma unroll
    for (int h4 = 0; h4 < 2; ++h4) { W.w0[h4] = *(const f32x4*)(w + wcol0 + 4 * h4); W.w1[h4] = *(const f32x4*)(w + ncol + wcol0 + 4 * h4); W.w2[h4] = *(const f32x4*)(w + 2 * ncol + wcol0 + 4 * h4); W.bb[h4] = *(const f32x4*)(bias + wcol0 + 4 * h4); }
}
__device__ __forceinline__ void load_u3(U3& X, const bf16_t* U, int row, int col0) {
    const bool hp = row_has_prev(row), hn = row_has_next(row);
    X.c = *(const bf16x8*)(U + (size_t)row * UC + col0); X.p = *(const bf16x8*)(U + (size_t)(hp ? row - 1 : row) * UC + col0); X.n = *(const bf16x8*)(U + (size_t)(hn ? row + 1 : row) * UC + col0);
    X.mp = hp ? 1.0f : 0.0f; X.mn = hn ? 1.0f : 0.0f;
}
template <bool SILU>
__device__ __forceinline__ void conv3_8x(const U3& X, const W8& W, float (&out)[8]) {
#pragma unroll
    for (int h4 = 0; h4 < 2; ++h4)
#pragma unroll
        for (int e = 0; e < 4; ++e) { const int i = 4 * h4 + e; const float v = bf2f((bf16_t)X.c[i]) * W.w1[h4][e] + X.mp * bf2f((bf16_t)X.p[i]) * W.w0[h4][e] + X.mn * bf2f((bf16_t)X.n[i]) * W.w2[h4][e] + W.bb[h4][e]; out[i] = SILU ? siluf_(v) : v; }
}
__device__ __forceinline__ void conv16_silu(const bf16_t* U, int r0, int col, const float* w, int ncol, int wcol, float bias, float (&out)[16]) {
    const bool hp = row_has_prev(r0), hn = row_has_next(r0 + 15);
    float x[18];
#pragma unroll
    for (int i = 0; i < 18; ++i) { const int r = (i == 0 && !hp) ? r0 : ((i == 17 && !hn) ? r0 + 15 : r0 - 1 + i); x[i] = bf2f(U[(size_t)r * UC + col]); }
    if (!hp) x[0] = 0.f; if (!hn) x[17] = 0.f;
    const float w0 = w[wcol], w1 = w[ncol + wcol], w2 = w[2 * ncol + wcol];
#pragma unroll
    for (int j = 0; j < 16; ++j) out[j] = siluf_(x[j] * w0 + x[j + 1] * w1 + x[j + 2] * w2 + bias);
}
__device__ __forceinline__ void store16_bf16(LAS bf16_t* dst, const float (&v)[16]) {
    u32x4 a, b; a.x = pack2(v[0], v[1]); a.y = pack2(v[2], v[3]); a.z = pack2(v[4], v[5]); a.w = pack2(v[6], v[7]); b.x = pack2(v[8], v[9]); b.y = pack2(v[10], v[11]); b.z = pack2(v[12], v[13]); b.w = pack2(v[14], v[15]);
    *(LAS u32x4*)dst = a; *(LAS u32x4*)(dst + 8) = b;
}

__device__ __forceinline__ void scatter8_T(LAS bf16_t* dstT, int g8, int p, const float (&v)[8]) {
#pragma unroll
    for (int e2 = 0; e2 < 4; ++e2) { const unsigned w = pack2(v[2 * e2], v[2 * e2 + 1]); dstT[(8 * g8 + 2 * e2) * 136 + p] = (bf16_t)(w & 0xffffu); dstT[(8 * g8 + 2 * e2 + 1) * 136 + p] = (bf16_t)(w >> 16); }
}

__device__ __forceinline__ void hgrn_pass1(const Ptrs P, int l, int unit, LAS unsigned char* lds) {
    const int tid = P.tid, lane = tid & 63, wid = tid >> 6, fr = lane & 15, fq = lane >> 4;
    const int pc = unit % NCHK; const int r_ = unit / NCHK; const int h = r_ & 3; const int b = r_ >> 2;
    const int row0 = chunk_row0(b, pc);
    const bf16_t* U = (const bf16_t*)(P.ws + WS_BIG + BIG_U);
    LAS bf16_t* KTF = (LAS bf16_t*)lds; LAS bf16_t* KTB = KTF + 64 * 136; LAS bf16_t* VT = KTB + 64 * 136; LAS float* segtot = (LAS float*)(VT + 64 * 136);
    LAS bf16_t* FS = (LAS bf16_t*)(lds + 65536);
    for (int it = tid; it < 128 * 8; it += 512) { const int p = it >> 3, g8 = it & 7; const bf16_t* ur = U + (size_t)(row0 + p) * UC + h * 64 + 8 * g8;
        const bf16x8 ff8 = *(const bf16x8*)(ur + 1792), fb8 = *(const bf16x8*)(ur + 2048), v8 = *(const bf16x8*)(ur + 2304);
        *(LAS bf16x8*)(FS + p * 64 + 8 * g8) = ff8; *(LAS bf16x8*)(FS + 8192 + p * 64 + 8 * g8) = fb8;
#pragma unroll
        for (int e = 0; e < 8; ++e) VT[(8 * g8 + e) * 136 + p] = (bf16_t)v8[e]; }
    __syncthreads();
    const int ch = lane, seg = wid;
    const float lbf = ((const float*)(P.ws + WS_LB))[(0 * 2 + l) * 256 + h * 64 + ch], lbb = ((const float*)(P.ws + WS_LB))[(1 * 2 + l) * 256 + h * 64 + ch];
    float cf[16], cb[16], kf[16], kb[16]; float runf = 0.f, runb = 0.f;
#pragma unroll
    for (int j = 0; j < 16; ++j) { const int p = 16 * seg + j;
        const float ff = lbf + (1.0f - lbf) * sigmoidf_(bf2f(FS[p * 64 + ch])), fb = lbb + (1.0f - lbb) * sigmoidf_(bf2f(FS[8192 + p * 64 + ch]));
        runf += flog(ff); cf[j] = runf; kf[j] = 1.0f - ff; cb[j] = runb; runb += flog(fb); kb[j] = 1.0f - fb; }
    segtot[seg * 64 + ch] = runf; segtot[512 + seg * 64 + ch] = runb; __syncthreads();
    float offf = 0.f, totf = 0.f, offb = 0.f, totb = 0.f;
#pragma unroll
    for (int s = 0; s < 8; ++s) { const float a = segtot[s * 64 + ch], c = segtot[512 + s * 64 + ch]; totf += a; totb += c; offf += (s < seg) ? a : 0.f; offb += (s < seg) ? c : 0.f; }
    { float t[16];
#pragma unroll
      for (int j = 0; j < 16; ++j) t[j] = kf[j] * fexp(totf - offf - cf[j]);
      store16_bf16(KTF + ch * 136 + 16 * seg, t);
#pragma unroll
      for (int j = 0; j < 16; ++j) t[j] = kb[j] * fexp(offb + cb[j]);
      store16_bf16(KTB + ch * 136 + 16 * seg, t); }
    const int sif = sidx(0, b, h, 0, pc), sib = sidx(0, b, h, 1, pc);
    if (seg == 0) { ((float*)(P.ws + WS_DEC))[(size_t)sif * 64 + ch] = fexp(totf); ((float*)(P.ws + WS_DEC))[(size_t)sib * 64 + ch] = fexp(totb); }
    __syncthreads();
    const int mt = wid >> 1, nt0 = (wid & 1) * 2;
    f32x4 af[2], ab[2]; af[0] = (f32x4){0.f, 0.f, 0.f, 0.f}; af[1] = af[0]; ab[0] = af[0]; ab[1] = af[0];
#pragma unroll
    for (int ks = 0; ks < 4; ++ks) { const bf16x8 a0 = *(const LAS bf16x8*)(KTF + (16 * mt + fr) * 136 + 32 * ks + 8 * fq), a1 = *(const LAS bf16x8*)(KTB + (16 * mt + fr) * 136 + 32 * ks + 8 * fq);
#pragma unroll
        for (int n = 0; n < 2; ++n) { const bf16x8 bb = *(const LAS bf16x8*)(VT + (16 * (nt0 + n) + fr) * 136 + 32 * ks + 8 * fq);
            af[n] = __builtin_amdgcn_mfma_f32_16x16x32_bf16(a0, bb, af[n], 0, 0, 0); ab[n] = __builtin_amdgcn_mfma_f32_16x16x32_bf16(a1, bb, ab[n], 0, 0, 0); } }
    bf16_t* SF = (bf16_t*)(P.ws + WS_BIG + BIG_STATE) + (size_t)sif * 4096; bf16_t* SB = (bf16_t*)(P.ws + WS_BIG + BIG_STATE) + (size_t)sib * 4096;
#pragma unroll
    for (int n = 0; n < 2; ++n) { const int o = (16 * (nt0 + n) + fr) * 64 + 16 * mt + 4 * fq; u32x2 wf, wb;
        wf.x = pack2(af[n][0], af[n][1]); wf.y = pack2(af[n][2], af[n][3]); wb.x = pack2(ab[n][0], ab[n][1]); wb.y = pack2(ab[n][2], ab[n][3]);
        *(u32x2*)(SF + o) = wf; *(u32x2*)(SB + o) = wb; }
    __syncthreads();
}

__device__ __forceinline__ void ssd_pass1(const Ptrs P, int l, int unit, LAS unsigned char* lds) {
    const int tid = P.tid, lane = tid & 63, wid = tid >> 6, fr = lane & 15, fq = lane >> 4;
    const int pc = unit % NCHK; const int r_ = unit / NCHK; const int g = r_ & 1; const int b = r_ >> 1;
    const int row0 = chunk_row0(b, pc);
    const bf16_t* U = (const bf16_t*)(P.ws + WS_BIG + BIG_U);
    const float* scw = P.inp(I_SSDCW) + (size_t)l * 3 * 512; const float* scb = P.inp(I_SSDCB) + l * 512;
    LAS bf16_t* BT = (LAS bf16_t*)lds; LAS bf16_t* XT = BT + 64 * 136;
    LAS float* wgt = (LAS float*)(XT + 4 * 64 * 136);
    if (wid < 4) {
        const int hh = 2 * g + (wid >> 1), dir = wid & 1;
        const float Aneg = -fexp(P.inp(I_SSDALOG)[(l * 2 + dir) * 4 + hh]); const float dtb = P.inp(I_SSDDTB)[(l * 2 + dir) * 4 + hh]; const float* DT = (const float*)(P.ws + WS_DT);
        const int p0 = 2 * lane; const float d0 = softplusf_(DT[(size_t)(row0 + p0) * 8 + dir * 4 + hh] + dtb), d1 = softplusf_(DT[(size_t)(row0 + p0 + 1) * 8 + dir * 4 + hh] + dtb);
        const float a0 = Aneg * d0, a1 = Aneg * d1; const float inc = wave_incl_scan(a0 + a1, lane); const float tot = __uint_as_float(__builtin_amdgcn_readlane(__float_as_uint(inc), 63));
        if (dir == 0) { wgt[wid * 128 + p0] = d0 * fexp(tot - (inc - a1)); wgt[wid * 128 + p0 + 1] = d1 * fexp(tot - inc); }
        else { wgt[wid * 128 + p0] = d0 * fexp(inc - a1 - a0); wgt[wid * 128 + p0 + 1] = d1 * fexp(inc - a1); }
        if (lane == 0) ((float*)(P.ws + WS_DEC))[(size_t)sidx(1, b, hh, dir, pc) * 64] = fexp(tot);
    }
    __syncthreads();
    {
        const int g8 = tid & 7, pq = tid >> 3;
        { const int cB = 256 + g * 64 + 8 * g8; W8 W; load_w8(W, scw, 512, cB, scb); U3 x[2];
#pragma unroll
          for (int k = 0; k < 2; ++k) load_u3(x[k], U, row0 + pq + 64 * k, 3072 + cB);
#pragma unroll
          for (int k = 0; k < 2; ++k) { float t8[8]; conv3_8x<true>(x[k], W, t8); scatter8_T(BT, g8, pq + 64 * k, t8); } }
#pragma unroll 1
        for (int hq = 0; hq < 2; ++hq) { const int c0 = (2 * g + hq) * 64 + 8 * g8; W8 W; load_w8(W, scw, 512, c0, scb); U3 x[2];
#pragma unroll
            for (int k = 0; k < 2; ++k) load_u3(x[k], U, row0 + pq + 64 * k, 3072 + c0);
#pragma unroll
            for (int k = 0; k < 2; ++k) { const int p = pq + 64 * k; float x8[8], t8[8]; conv3_8x<true>(x[k], W, x8);
#pragma unroll
                for (int dir = 0; dir < 2; ++dir) { const int cmb = 2 * hq + dir; const float wv = wgt[cmb * 128 + p];
#pragma unroll
                    for (int e = 0; e < 8; ++e) t8[e] = x8[e] * wv;
                    scatter8_T(XT + cmb * 64 * 136, g8, p, t8); } } }
    }
    __syncthreads();
    {
        const int cmb = wid >> 1; const int hh = 2 * g + (cmb >> 1), dir = cmb & 1;
        bf16_t* S = (bf16_t*)(P.ws + WS_BIG + BIG_STATE) + (size_t)sidx(1, b, hh, dir, pc) * 4096;
#pragma unroll
        for (int mi = 0; mi < 2; ++mi) { const int mt = 2 * (wid & 1) + mi; f32x4 acc[4];
#pragma unroll
            for (int n = 0; n < 4; ++n) acc[n] = (f32x4){0.f, 0.f, 0.f, 0.f};
#pragma unroll
            for (int ks = 0; ks < 4; ++ks) { const bf16x8 a = *(const LAS bf16x8*)(XT + (cmb * 64 + 16 * mt + fr) * 136 + 32 * ks + 8 * fq);
#pragma unroll
                for (int n = 0; n < 4; ++n) { const bf16x8 bb = *(const LAS bf16x8*)(BT + (16 * n + fr) * 136 + 32 * ks + 8 * fq); acc[n] = __builtin_amdgcn_mfma_f32_16x16x32_bf16(bb, a, acc[n], 0, 0, 0); } }
#pragma unroll
            for (int n = 0; n < 4; ++n) { u32x2 w; w.x = pack2(acc[n][0], acc[n][1]); w.y = pack2(acc[n][2], acc[n][3]); *(u32x2*)(S + (16 * mt + fr) * 64 + 16 * n + 4 * fq) = w; } }
    }
    __syncthreads();
}

__device__ __forceinline__ void ssd_dt_cum(const Ptrs P, int l, int row0, int dir, int h, int wid, int lane, LAS float* cum, LAS float* dtv) {
    if (wid == 0) {
        const float Aneg = -fexp(P.inp(I_SSDALOG)[(l * 2 + dir) * 4 + h]); const float dtb = P.inp(I_SSDDTB)[(l * 2 + dir) * 4 + h]; const float* DT = (const float*)(P.ws + WS_DT);
        const int t0 = 2 * lane, p0 = dir ? 127 - t0 : t0, p1 = dir ? 126 - t0 : t0 + 1;
        const float d0 = softplusf_(DT[(size_t)(row0 + p0) * 8 + dir * 4 + h] + dtb), d1 = softplusf_(DT[(size_t)(row0 + p1) * 8 + dir * 4 + h] + dtb);
        const float a0 = Aneg * d0, a1 = Aneg * d1; const float inc = wave_incl_scan(a0 + a1, lane);
        cum[t0] = inc - a1; cum[t0 + 1] = inc; dtv[t0] = d0; dtv[t0 + 1] = d1;
    }
}

__device__ __forceinline__ void scan_pass2(const Ptrs P, int unit) {
    const int seq = unit >> 1, half = unit & 1; const int kind = seq >> 6, b = (seq >> 3) & 7, h = (seq >> 1) & 3, dir = seq & 1;
    const int e0 = half * 2048 + P.tid * 4; const int base = sidx(kind, b, h, dir, 0);
    bf16_t* ST = (bf16_t*)(P.ws + WS_BIG + BIG_STATE); const float* DEC = (const float*)(P.ws + WS_DEC);
    const float zf = zero_f(); f32x4 run = (f32x4){zf, zf, zf, zf};
#pragma unroll 1
    for (int q0 = 0; q0 < NCHK; q0 += 8) {
        u32x2 loc[8]; f32x4 dd[8];
#pragma unroll
        for (int k = 0; k < 8; ++k) { const int q = (q0 + k < NCHK) ? q0 + k : NCHK - 1; const int pc = chunk_at(dir, q);
            loc[k] = *(const u32x2*)(ST + (size_t)(base + pc) * 4096 + e0);
            if (kind == 0) dd[k] = *(const f32x4*)(DEC + (size_t)(base + pc) * 64 + (e0 & 63)); else { const float d = DEC[(size_t)(base + pc) * 64]; dd[k] = (f32x4){d, d, d, d}; } }
#pragma unroll
        for (int k = 0; k < 8; ++k) { if (q0 + k < NCHK) { const int pc = chunk_at(dir, q0 + k);
            u32x2 w; w.x = pack2(run[0], run[1]); w.y = pack2(run[2], run[3]); *(u32x2*)(ST + (size_t)(base + pc) * 4096 + e0) = w;
            const f32x4 lv = (f32x4){__uint_as_float(loc[k].x << 16), __uint_as_float(loc[k].x & 0xffff0000u), __uint_as_float(loc[k].y << 16), __uint_as_float(loc[k].y & 0xffff0000u)};
            run = run * dd[k] + lv; } }
    }
}

__device__ __forceinline__ int qk_off(int p, int chunk) { return p * 64 + ((chunk ^ (p & 7)) << 3); }
__device__ __forceinline__ void hgrn_pass3(const Ptrs P, int l, int unit, int unit_next, LAS unsigned char* lds) {
    const int tid = P.tid, lane = tid & 63, wid = tid >> 6, fr = lane & 15, fq = lane >> 4;
    const int pc = unit % NCHK; const int r_ = unit / NCHK; const int h = r_ & 3; const int b = r_ >> 2;
    const int row0 = chunk_row0(b, pc);
    const bf16_t* U = (const bf16_t*)(P.ws + WS_BIG + BIG_U);
    LAS bf16_t* QF = (LAS bf16_t*)lds; LAS bf16_t* KF = QF + 128 * 64; LAS bf16_t* QB = KF + 128 * 64; LAS bf16_t* KB = QB + 128 * 64; LAS bf16_t* VT = KB + 128 * 64;
    LAS bf16_t* STF = VT + 64 * 136; LAS bf16_t* STB = STF + 64 * 72; LAS float* ETF = (LAS float*)(STB + 64 * 72); LAS float* ETB = ETF + 512; LAS bf16_t* PW = (LAS bf16_t*)(ETB + 512);
    LAS float* OUT = (LAS float*)lds;
    {
        LAS bf16_t* FS = PW;
        for (int it = tid; it < 128 * 8; it += 512) { const int p = it >> 3, g8 = it & 7; const bf16_t* ur = U + (size_t)(row0 + p) * UC + h * 64 + 8 * g8;
            const bf16x8 ff8 = *(const bf16x8*)(ur + 1792), fb8 = *(const bf16x8*)(ur + 2048), q8 = *(const bf16x8*)(ur + 1536), v8 = *(const bf16x8*)(ur + 2304);
            *(LAS bf16x8*)(FS + p * 64 + 8 * g8) = ff8; *(LAS bf16x8*)(FS + 8192 + p * 64 + 8 * g8) = fb8;
            float qs[8];
#pragma unroll
            for (int e = 0; e < 8; ++e) qs[e] = bf2f((bf16_t)q8[e]) * 0.125f;
            const bf16x8 qp = pack8(qs); *(LAS bf16x8*)(QF + qk_off(p, g8)) = qp; *(LAS bf16x8*)(QB + qk_off(p, g8)) = qp;
#pragma unroll
            for (int e = 0; e < 8; ++e) VT[(8 * g8 + e) * 136 + p] = (bf16_t)v8[e]; }
        const bf16_t* SF = (const bf16_t*)(P.ws + WS_BIG + BIG_STATE) + (size_t)sidx(0, b, h, 0, pc) * 4096; const bf16_t* SB = (const bf16_t*)(P.ws + WS_BIG + BIG_STATE) + (size_t)sidx(0, b, h, 1, pc) * 4096;
        { const int dv = tid >> 3, c8 = (tid & 7) * 8;
          *(LAS bf16x8*)(STF + dv * 72 + c8) = *(const bf16x8*)(SF + tid * 8); *(LAS bf16x8*)(STB + dv * 72 + c8) = *(const bf16x8*)(SB + tid * 8); }
    }
    __syncthreads();
    {
        LAS bf16_t* FS = PW;
        const int ch = lane, seg = wid; const float lbf = ((const float*)(P.ws + WS_LB))[(0 * 2 + l) * 256 + h * 64 + ch], lbb = ((const float*)(P.ws + WS_LB))[(1 * 2 + l) * 256 + h * 64 + ch];
        float bfw[16], bbw[16], kf[16], kb[16];
#pragma unroll
        for (int j = 0; j < 16; ++j) { const int p = 16 * seg + j;
            const float ff = lbf + (1.0f - lbf) * sigmoidf_(bf2f(FS[p * 64 + ch])), fb = lbb + (1.0f - lbb) * sigmoidf_(bf2f(FS[8192 + p * 64 + ch]));
            bfw[j] = flog(ff); bbw[j] = flog(fb); kf[j] = 1.0f - ff; kb[j] = 1.0f - fb; }
#pragma unroll
        for (int j = 1; j < 16; ++j) bfw[j] += bfw[j - 1];
#pragma unroll
        for (int j = 14; j >= 0; --j) bbw[j] += bbw[j + 1];
        const float etf = bfw[15], etb = bbw[0];
        ETF[seg * 64 + ch] = etf; ETB[seg * 64 + ch] = etb;
        const int chunk = ch >> 3, sub = ch & 7;
#pragma unroll
        for (int j = 0; j < 16; ++j) { const int p = 16 * seg + j; const int o = qk_off(p, chunk) + sub; const float qv = bf2f(QF[o]);
            const unsigned wq = pack2(qv * fexp(bfw[j]), qv * fexp(bbw[j])), wk = pack2(kf[j] * fexp(etf - bfw[j]), kb[j] * fexp(etb - bbw[j]));
            QF[o] = (bf16_t)(wq & 0xffffu); QB[o] = (bf16_t)(wq >> 16); KF[o] = (bf16_t)(wk & 0xffffu); KB[o] = (bf16_t)(wk >> 16); }
    }
    __syncthreads();
    f32x4 o[4];
    {
        const int i = wid; LAS bf16_t* pw = PW + wid * 16 * 136;
#pragma unroll
        for (int nt = 0; nt < 4; ++nt) o[nt] = (f32x4){0.f, 0.f, 0.f, 0.f};
#pragma unroll 1
        for (int dir = 0; dir < 2; ++dir) {
            const LAS bf16_t* QA = dir ? QB : QF; const LAS bf16_t* KA = dir ? KB : KF; const LAS float* ET = dir ? ETB : ETF; const LAS bf16_t* ST = dir ? STB : STF;
            bf16x8 qf[2]; float g[2][8];
#pragma unroll
            for (int ks = 0; ks < 2; ++ks) { qf[ks] = *(const LAS bf16x8*)(QA + qk_off(16 * i + fr, 4 * ks + fq));
                const f32x4 e0 = *(const LAS f32x4*)(ET + i * 64 + 32 * ks + 8 * fq), e1 = *(const LAS f32x4*)(ET + i * 64 + 32 * ks + 8 * fq + 4);
                g[ks][0] = -e0[0]; g[ks][1] = -e0[1]; g[ks][2] = -e0[2]; g[ks][3] = -e0[3]; g[ks][4] = -e1[0]; g[ks][5] = -e1[1]; g[ks][6] = -e1[2]; g[ks][7] = -e1[3]; }
            const int nj = dir ? 8 - i : i + 1;
            for (int jj = 0; jj < nj; ++jj) { const int j = dir ? i + jj : i - jj;
                f32x4 d = (f32x4){0.f, 0.f, 0.f, 0.f};
#pragma unroll
                for (int ks = 0; ks < 2; ++ks) { float a8[8];
#pragma unroll
                    for (int e = 0; e < 8; ++e) a8[e] = bf2f((bf16_t)qf[ks][e]) * fexp(g[ks][e]);
                    const bf16x8 kfr = *(const LAS bf16x8*)(KA + qk_off(16 * j + fr, 4 * ks + fq));
                    d = __builtin_amdgcn_mfma_f32_16x16x32_bf16(kfr, pack8(a8), d, 0, 0, 0);
                    const f32x4 e0 = *(const LAS f32x4*)(ET + j * 64 + 32 * ks + 8 * fq), e1 = *(const LAS f32x4*)(ET + j * 64 + 32 * ks + 8 * fq + 4);
                    g[ks][0] += e0[0]; g[ks][1] += e0[1]; g[ks][2] += e0[2]; g[ks][3] += e0[3]; g[ks][4] += e1[0]; g[ks][5] += e1[1]; g[ks][6] += e1[2]; g[ks][7] += e1[3]; }
                if (jj == 0) {
#pragma unroll
                    for (int r = 0; r < 4; ++r) d[r] = (dir ? (4 * fq + r >= fr) : (4 * fq + r <= fr)) ? d[r] : 0.f; }
                u32x2 w; w.x = pack2(d[0], d[1]); w.y = pack2(d[2], d[3]); *(LAS u32x2*)(pw + fr * 136 + 16 * j + 4 * fq) = w;
            }
            { const int zb = dir ? i - 1 : i + 1; const bool need = dir ? ((i & 1) == 1) : ((i & 1) == 0);
              if (need) { u32x2 z; z.x = __float_as_uint(zero_f()); z.y = z.x; *(LAS u32x2*)(pw + fr * 136 + 16 * zb + 4 * fq) = z; } }
            const int kslo = dir ? (i >> 1) : 0, kshi = dir ? 3 : (i >> 1);
            for (int ks = kslo; ks <= kshi; ++ks) { const bf16x8 pa = *(const LAS bf16x8*)(pw + fr * 136 + 32 * ks + 8 * fq);
#pragma unroll
                for (int nt = 0; nt < 4; ++nt) { const bf16x8 vf = *(const LAS bf16x8*)(VT + (16 * nt + fr) * 136 + 32 * ks + 8 * fq); o[nt] = __builtin_amdgcn_mfma_f32_16x16x32_bf16(pa, vf, o[nt], 0, 0, 0); } }
#pragma unroll
            for (int ks = 0; ks < 2; ++ks) { float a8[8];
#pragma unroll
                for (int e = 0; e < 8; ++e) a8[e] = bf2f((bf16_t)qf[ks][e]) * fexp(g[ks][e]);
                const bf16x8 qa = pack8(a8);
#pragma unroll
                for (int nt = 0; nt < 4; ++nt) { const bf16x8 sf = *(const LAS bf16x8*)(ST + (16 * nt + fr) * 72 + 32 * ks + 8 * fq); o[nt] = __builtin_amdgcn_mfma_f32_16x16x32_bf16(qa, sf, o[nt], 0, 0, 0); } }
        }
    }
    __syncthreads();
#pragma unroll
    for (int nt = 0; nt < 4; ++nt)
#pragma unroll
        for (int r = 0; r < 4; ++r) OUT[(16 * wid + 4 * fq + r) * 64 + 16 * nt + fr] = o[nt][r];
    __syncthreads();
    {
        const int pos = tid >> 2, qd = tid & 3; const int row = row0 + pos; bf16_t* BR2 = (bf16_t*)(P.ws + WS_BR) + (size_t)2 * T * 256;
        const bf16_t* gp = U + (size_t)row * UC + 2560 + h * 64 + 16 * qd; const bf16x8 g0 = *(const bf16x8*)gp, g1 = *(const bf16x8*)(gp + 8);
        const float* ngp = P.inp(I_HGNG) + l * 64 + 16 * qd; float ov[16], q = 0.f;
#pragma unroll
        for (int e4 = 0; e4 < 4; ++e4) { const f32x4 v = *(const LAS f32x4*)(OUT + pos * 64 + 16 * qd + 4 * e4); ov[4 * e4] = v[0]; ov[4 * e4 + 1] = v[1]; ov[4 * e4 + 2] = v[2]; ov[4 * e4 + 3] = v[3]; q += v[0] * v[0] + v[1] * v[1] + v[2] * v[2] + v[3] * v[3]; }
        q += __shfl_xor(q, 1); q += __shfl_xor(q, 2);
        const float rs = rsqrtf(q * (1.0f / 64.0f) + kconst(RMS_EPS)); float t8[8];
#pragma unroll
        for (int e = 0; e < 8; ++e) t8[e] = ov[e] * rs * ngp[e] * siluf_(bf2f((bf16_t)g0[e]));
        *(bf16x8*)(BR2 + (size_t)row * 256 + h * 64 + 16 * qd) = pack8(t8);
#pragma unroll
        for (int e = 0; e < 8; ++e) t8[e] = ov[8 + e] * rs * ngp[8 + e] * siluf_(bf2f((bf16_t)g1[e]));
        *(bf16x8*)(BR2 + (size_t)row * 256 + h * 64 + 16 * qd + 8) = pack8(t8);
    }
    __syncthreads();
}

__device__ __forceinline__ void ssd_pass3(const Ptrs P, int l, int unit, LAS unsigned char* lds) {
    const int tid = P.tid, lane = tid & 63, wid = tid >> 6, fr = lane & 15, fq = lane >> 4;
    const int pc = unit % NCHK; const int r_ = unit / NCHK; const int g = r_ & 1; const int b = r_ >> 1;
    const int row0 = chunk_row0(b, pc);
    const bf16_t* U = (const bf16_t*)(P.ws + WS_BIG + BIG_U);
    const float* scw = P.inp(I_SSDCW) + (size_t)l * 3 * 512; const float* scb = P.inp(I_SSDCB) + l * 512;
    LAS bf16_t* CM = (LAS bf16_t*)lds; LAS bf16_t* BM = CM + 128 * 72; LAS bf16_t* XT = BM + 128 * 72; LAS bf16_t* STF = XT + 64 * 136; LAS bf16_t* STB = STF + 64 * 72;
    LAS float* cumfA = (LAS float*)(STB + 64 * 72); LAS float* cumbA = cumfA + 256; LAS float* dtfA = cumbA + 256; LAS float* dtbA = dtfA + 256;
    LAS bf16_t* PW = (LAS bf16_t*)(dtbA + 256); LAS float* OUT = (LAS float*)(PW + 8 * 16 * 136);
    if (wid < 4) {
        const int hq = wid >> 1, dir = wid & 1, h = 2 * g + hq; const float Aneg = -fexp(P.inp(I_SSDALOG)[(l * 2 + dir) * 4 + h]); const float dtbias = P.inp(I_SSDDTB)[(l * 2 + dir) * 4 + h]; const float* DT = (const float*)(P.ws + WS_DT);
        const int p0 = 2 * lane; const float d0 = softplusf_(DT[(size_t)(row0 + p0) * 8 + dir * 4 + h] + dtbias), d1 = softplusf_(DT[(size_t)(row0 + p0 + 1) * 8 + dir * 4 + h] + dtbias);
        const float a0 = Aneg * d0, a1 = Aneg * d1; const float inc = wave_incl_scan(a0 + a1, lane);
        if (dir == 0) { cumfA[hq * 128 + p0] = inc - a1; cumfA[hq * 128 + p0 + 1] = inc; dtfA[hq * 128 + p0] = d0; dtfA[hq * 128 + p0 + 1] = d1; }
        else { const float tot = __uint_as_float(__builtin_amdgcn_readlane(__float_as_uint(inc), 63)); cumbA[hq * 128 + p0] = tot - inc + a0 + a1; cumbA[hq * 128 + p0 + 1] = tot - inc + a1; dtbA[hq * 128 + p0] = d0; dtbA[hq * 128 + p0 + 1] = d1; }
    }
    {
        const int pos = tid >> 2, qd = tid & 3; const int row = row0 + pos;
#pragma unroll 1
        for (int pcs = 0; pcs < 4; ++pcs) { const int isb = pcs >> 1, hf = pcs & 1; const int cc = (isb ? 256 : 384) + g * 64 + 16 * qd + 8 * hf; float t8[8];
            conv3_silu8(U, row, 3072 + cc, scw, 512, cc, scb, t8);
            *(LAS bf16x8*)((isb ? BM : CM) + pos * 72 + 16 * qd + 8 * hf) = pack8(t8); }
    }
#pragma unroll 1
    for (int hq = 0; hq < 2; ++hq) {
        const int h = 2 * g + hq;
        for (int it = tid; it < 128 * 8; it += 512) { const int p = it >> 3, g8 = it & 7; float x8[8];
            conv3_8<true>(U, row0 + p, 3072 + h * 64 + 8 * g8, scw, 512, h * 64 + 8 * g8, scb, x8); scatter8_T(XT, g8, p, x8); }
        __builtin_amdgcn_sched_barrier(0);
        LAS float* cumf = cumfA + hq * 128; LAS float* cumb = cumbA + hq * 128; LAS float* dtf = dtfA + hq * 128; LAS float* dtb = dtbA + hq * 128;
        {
            const bf16_t* SF = (const bf16_t*)(P.ws + WS_BIG + BIG_STATE) + (size_t)sidx(1, b, h, 0, pc) * 4096; const bf16_t* SB = (const bf16_t*)(P.ws + WS_BIG + BIG_STATE) + (size_t)sidx(1, b, h, 1, pc) * 4096;
            { const int idx = tid * 8; *(LAS bf16x8*)(STF + (idx >> 6) * 72 + (idx & 63)) = *(const bf16x8*)(SF + idx); *(LAS bf16x8*)(STB + (idx >> 6) * 72 + (idx & 63)) = *(const bf16x8*)(SB + idx); }
        }
        float rxs[16]; bf16x8 rz[2];
        { const int pos = tid >> 2, qd = tid & 3; const int row = row0 + pos; const int c0 = h * 64 + 16 * qd; const bf16_t* zp = U + (size_t)row * UC + 2816 + c0;
#pragma unroll
          for (int hf = 0; hf < 2; ++hf) { float xs[8]; conv3_silu8(U, row, 3072 + c0 + 8 * hf, scw, 512, c0 + 8 * hf, scb, xs); rz[hf] = *(const bf16x8*)(zp + 8 * hf);
#pragma unroll
              for (int e = 0; e < 8; ++e) rxs[8 * hf + e] = xs[e]; } }
        __syncthreads();
        {
            const int i = wid; LAS bf16_t* pw = PW + wid * 16 * 136;
            bf16x8 cf[2];
#pragma unroll
            for (int ks = 0; ks < 2; ++ks) cf[ks] = *(const LAS bf16x8*)(CM + (16 * i + fr) * 72 + 32 * ks + 8 * fq);
            f32x4 o[4];
#pragma unroll
            for (int nt = 0; nt < 4; ++nt) o[nt] = (f32x4){0.f, 0.f, 0.f, 0.f};
#pragma unroll 1
            for (int dir = 0; dir < 2; ++dir) {
                const LAS float* cum = dir ? cumb : cumf; const LAS float* dtv = dir ? dtb : dtf; const LAS bf16_t* ST = dir ? STB : STF;
                const float cq = cum[16 * i + fr];
                const int jlo = dir ? i : 0, jhi = dir ? 7 : i;
                for (int j = jlo; j <= jhi; ++j) {
                    f32x4 d = (f32x4){0.f, 0.f, 0.f, 0.f};
#pragma unroll
                    for (int ks = 0; ks < 2; ++ks) { const bf16x8 bf_ = *(const LAS bf16x8*)(BM + (16 * j + fr) * 72 + 32 * ks + 8 * fq); d = __builtin_amdgcn_mfma_f32_16x16x32_bf16(bf_, cf[ks], d, 0, 0, 0); }
                    const f32x4 cs = *(const LAS f32x4*)(cum + 16 * j + 4 * fq), ds = *(const LAS f32x4*)(dtv + 16 * j + 4 * fq);
#pragma unroll
                    for (int r = 0; r < 4; ++r) { const bool keep = (j != i) || (dir ? (4 * fq + r >= fr) : (4 * fq + r <= fr)); d[r] = keep ? d[r] * fexp(cq - cs[r]) * ds[r] : 0.f; }
                    u32x2 w; w.x = pack2(d[0], d[1]); w.y = pack2(d[2], d[3]); *(LAS u32x2*)(pw + fr * 136 + 16 * j + 4 * fq) = w;
                }
                { const int zb = dir ? i - 1 : i + 1; const bool need = dir ? ((i & 1) == 1) : ((i & 1) == 0);
                  if (need) { u32x2 z; z.x = __float_as_uint(zero_f()); z.y = z.x; *(LAS u32x2*)(pw + fr * 136 + 16 * zb + 4 * fq) = z; } }
                const int kslo = dir ? (i >> 1) : 0, kshi = dir ? 3 : (i >> 1);
                for (int ks = kslo; ks <= kshi; ++ks) { const bf16x8 pa = *(const LAS bf16x8*)(pw + fr * 136 + 32 * ks + 8 * fq);
#pragma unroll
                    for (int nt = 0; nt < 4; ++nt) { const bf16x8 xf = *(const LAS bf16x8*)(XT + (16 * nt + fr) * 136 + 32 * ks + 8 * fq); o[nt] = __builtin_amdgcn_mfma_f32_16x16x32_bf16(pa, xf, o[nt], 0, 0, 0); } }
                f32x4 o2[4];
#pragma unroll
                for (int nt = 0; nt < 4; ++nt) o2[nt] = (f32x4){0.f, 0.f, 0.f, 0.f};
#pragma unroll
                for (int ks = 0; ks < 2; ++ks)
#pragma unroll
                    for (int nt = 0; nt < 4; ++nt) { const bf16x8 sf = *(const LAS bf16x8*)(ST + (16 * nt + fr) * 72 + 32 * ks + 8 * fq); o2[nt] = __builtin_amdgcn_mfma_f32_16x16x32_bf16(cf[ks], sf, o2[nt], 0, 0, 0); }
                const f32x4 ct = *(const LAS f32x4*)(cum + 16 * i + 4 * fq);
#pragma unroll
                for (int nt = 0; nt < 4; ++nt)
#pragma unroll
                    for (int r = 0; r < 4; ++r) o[nt][r] += fexp(ct[r]) * o2[nt][r];
            }
#pragma unroll
            for (int nt = 0; nt < 4; ++nt)
#pragma unroll
                for (int r = 0; r < 4; ++r) OUT[(16 * i + 4 * fq + r) * 64 + 16 * nt + fr] = o[nt][r];
        }
        __syncthreads();
        {
            const int pos = tid >> 2, qd = tid & 3; const int row = row0 + pos; const int c0 = h * 64 + 16 * qd;
            const float Dh = P.inp(I_SSDD)[l * 4 + h]; const float* ngp = P.inp(I_SSDNG) + l * 256 + c0; bf16_t* BR3 = (bf16_t*)(P.ws + WS_BR) + (size_t)3 * T * 256; float* SSQ = (float*)(P.ws + WS_SSQ);
            float q = 0.f;
#pragma unroll
            for (int hf = 0; hf < 2; ++hf) { float xs[8];
#pragma unroll
                for (int e = 0; e < 8; ++e) xs[e] = rxs[8 * hf + e];
                const bf16x8 z8 = rz[hf]; float t8[8];
#pragma unroll
                for (int e4 = 0; e4 < 2; ++e4) { const f32x4 ov = *(const LAS f32x4*)(OUT + pos * 64 + 16 * qd + 8 * hf + 4 * e4);
#pragma unroll
                    for (int e = 0; e < 4; ++e) { const int ii = 4 * e4 + e; const float vv = (ov[e] + xs[ii] * Dh) * siluf_(bf2f((bf16_t)z8[ii])); q += vv * vv; t8[ii] = vv * ngp[8 * hf + ii]; } }
                *(bf16x8*)(BR3 + (size_t)row * 256 + c0 + 8 * hf) = pack8(t8); }
            q += __shfl_xor(q, 1); q += __shfl_xor(q, 2);
            if (qd == 0) SSQ[(size_t)row * 4 + h] = q;
        }
        __syncthreads();
    }
}

typedef float f32x2 __attribute__((ext_vector_type(2)));
__device__ __forceinline__ f32x2 cmul(f32x2 a, f32x2 b) { return (f32x2){a.x * b.x - a.y * b.y, a.x * b.y + a.y * b.x}; }
__device__ __forceinline__ f32x2 cmulc(f32x2 a, f32x2 b) { return (f32x2){a.x * b.x + a.y * b.y, a.y * b.x - a.x * b.y}; }
__device__ __forceinline__ int fphys(int i) { return i + (i >> 4); }
template <int LO, int NST, bool INV>
__device__ __forceinline__ void fft_stages(f32x2 (&x)[16], const LAS f32x2* TW, int low) {
#pragma unroll
    for (int mm = 0; mm < NST; ++mm) { const int m = INV ? mm : NST - 1 - mm; const int s = LO + m;
#pragma unroll
        for (int j = 0; j < 16; ++j) { if (j & (1 << m)) continue; const int j2 = j | (1 << m);
            const int k = ((j & ((1 << m) - 1)) << LO) | low; const f32x2 tw = TW[k << (12 - s)];
            const f32x2 a = x[j], b = x[j2];
            if (!INV) { x[j] = a + b; x[j2] = cmul(a - b, tw); } else { const f32x2 bt = cmulc(b, tw); x[j] = a + bt; x[j2] = a - bt; } } }
}
template <int LO, int NST, bool INV>
__device__ __forceinline__ void fft_pass(LAS f32x2* X, const LAS f32x2* TW, int tid) {
    const int low = tid & ((1 << LO) - 1), high = tid >> LO; const int base = low | (high << (LO + 4));
    f32x2 x[16];
#pragma unroll
    for (int j = 0; j < 16; ++j) x[j] = X[fphys(base | (j << LO))];
    fft_stages<LO, NST, INV>(x, TW, low);
#pragma unroll
    for (int j = 0; j < 16; ++j) X[fphys(base | (j << LO))] = x[j];
}
__device__ __forceinline__ void hyena_fft_unit(const Ptrs P, int l, int c, LAS unsigned char* lds) {
    const int tid = P.tid, lane = tid & 63;
    LAS f32x2* X = (LAS f32x2*)lds; LAS f32x2* TW = X + 8704;
    const f32x2* TWg = (const f32x2*)(P.ws + WS_TW);
    for (int i = tid; i < 4096; i += 512) TW[i] = TWg[i];
    float nrm; { const float* part = (const float*)(P.ws + WS_PART) + (size_t)l * 64 * 512; nrm = wave_sum(part[lane * 512 + c] + part[lane * 512 + 256 + c]); }
    const float inv = 1.0f / nrm; const float* filt = (const float*)(P.ws + WS_FILT) + (size_t)l * 8192 * 256 + c;
    f32x2* Fg = (f32x2*)(P.ws + WS_BR) + (size_t)P.bid * 8192;
    __syncthreads();
    {
        f32x2 x[16];
#pragma unroll
        for (int j = 0; j < 16; ++j) x[j] = (f32x2){filt[(size_t)(tid + 512 * j) * 256] * inv, 0.f};
        fft_stages<9, 4, false>(x, TW, tid);
#pragma unroll
        for (int j = 0; j < 16; ++j) X[fphys(tid | (j << 9))] = x[j];
        __syncthreads(); fft_pass<5, 4, false>(X, TW, tid); __syncthreads(); fft_pass<2, 3, false>(X, TW, tid); __syncthreads();
#pragma unroll
        for (int j = 0; j < 16; ++j) x[j] = X[fphys((tid << 4) | j)];
        fft_stages<0, 2, false>(x, TW, 0);
#pragma unroll
        for (int j = 0; j < 16; ++j) Fg[(tid << 4) | j] = x[j];
    }
    unsigned* WTt = (unsigned*)(P.ws + WS_BIG + BIG_WT); const float bias = P.inp(I_HYBIAS)[l * 256 + c];
    for (int p = 0; p < 4; ++p) {
        unsigned* wp = WTt + ((size_t)c * 4 + p) * 4096;
        f32x2 x[16]; unsigned wraw[8];
#pragma unroll
        for (int j = 0; j < 8; ++j) { wraw[j] = wp[tid + 512 * j]; x[j] = (f32x2){__uint_as_float(wraw[j] << 16), __uint_as_float(wraw[j] & 0xffff0000u)}; }
#pragma unroll
        for (int j = 8; j < 16; ++j) x[j] = (f32x2){0.f, 0.f};
        fft_stages<9, 4, false>(x, TW, tid);
        __syncthreads();
#pragma unroll
        for (int j = 0; j < 16; ++j) X[fphys(tid | (j << 9))] = x[j];
        __syncthreads(); fft_pass<5, 4, false>(X, TW, tid); __syncthreads(); fft_pass<2, 3, false>(X, TW, tid); __syncthreads();
#pragma unroll
        for (int j = 0; j < 16; ++j) x[j] = X[fphys((tid << 4) | j)];
        fft_stages<0, 2, false>(x, TW, 0);
#pragma unroll
        for (int j = 0; j < 16; ++j) x[j] = cmul(x[j], Fg[(tid << 4) | j]);
        fft_stages<0, 2, true>(x, TW, 0);
#pragma unroll
        for (int j = 0; j < 16; ++j) X[fphys((tid << 4) | j)] = x[j];
        __syncthreads(); fft_pass<2, 3, true>(X, TW, tid); __syncthreads(); fft_pass<5, 4, true>(X, TW, tid); __syncthreads();
#pragma unroll
        for (int j = 0; j < 16; ++j) x[j] = X[fphys(tid | (j << 9))];
        fft_stages<9, 4, true>(x, TW, tid);
#pragma unroll
        for (int j = 0; j < 8; ++j) { const f32x2 y = x[j] * (1.0f / 8192.0f); const unsigned w = wraw[j];
            wp[tid + 512 * j] = pack2(y.x + __uint_as_float(w << 16) * bias, y.y + __uint_as_float(w & 0xffff0000u) * bias); }
    }
    __syncthreads();
}

#define DYNQ_BEGIN(ctrp, NUq) { volatile LAS unsigned* slot_ = (volatile LAS unsigned*)(lds + LDS_MISC + 64); unsigned* ctr_ = (ctrp); const bool t0_ = (P.tid == 0); \
    if (t0_) slot_[0] = __hip_atomic_fetch_add(ctr_, 1u, __ATOMIC_RELAXED, __HIP_MEMORY_SCOPE_AGENT); __syncthreads(); \
    unsigned u_ = (unsigned)__builtin_amdgcn_readfirstlane((int)slot_[0]); __syncthreads(); \
    while (u_ < (unsigned)(NUq)) { unsigned tn_ = 0u; if (t0_) tn_ = __hip_atomic_fetch_add(ctr_, 1u, __ATOMIC_RELAXED, __HIP_MEMORY_SCOPE_AGENT); const int u = (int)u_;
#define DYNQ_END() __syncthreads(); if (t0_) slot_[0] = tn_; __syncthreads(); u_ = (unsigned)__builtin_amdgcn_readfirstlane((int)slot_[0]); } }
__device__ __forceinline__ void phase_m1(const Ptrs P, int l, LAS unsigned char* lds) {
    const int tid = P.tid;
    const bf16_t* U = (const bf16_t*)(P.ws + WS_BIG + BIG_U);
    const float* hcw = P.inp(I_HYCW) + (size_t)l * 3 * 768; const float* hcb = P.inp(I_HYCB) + l * 768;
    const int NH = NB * 4 * NCHK, NSS = NB * 2 * NCHK;
    const int NS2 = NH + NSS;
    const int NU = NS2 + 256 + (l == 0 ? NCTX / 64 : 0);
    DYNQ_BEGIN((unsigned*)(P.ws + WS_CTL + CTL_DYN) + 16 + l, NU)
        Ptrs Pu = P; asm volatile("" : "+v"(Pu.tid));
        if (u < NSS) ssd_pass1(Pu, l, u, lds);
        else if (u < NS2) hgrn_pass1(Pu, l, u - NSS, lds);
        else if (u < NS2 + 256) { const int tid = Pu.tid;
            const int ub = u - NS2; const int p = ub >> 6, tb = ub & 63; const int c = tid & 255; LAS unsigned* tile = (LAS unsigned*)lds;
            { const int g8 = tid & 31, rq = tid >> 5; W8 W1, W2; load_w8(W1, hcw, 768, 256 + 8 * g8, hcb); load_w8(W2, hcw, 768, 512 + 8 * g8, hcb);
#pragma unroll 1
              for (int k0 = 0; k0 < 8; k0 += 2) { U3 xa[2], xb[2];
#pragma unroll
                for (int j = 0; j < 2; ++j) { const int k = k0 + j; const int row = (2 * p + (k >> 2)) * SEQ + tb * 64 + rq + 16 * (k & 3); load_u3(xa[j], U, row, 256 + 8 * g8); load_u3(xb[j], U, row, 512 + 8 * g8); }
#pragma unroll
                for (int j = 0; j < 2; ++j) { const int k = k0 + j; const int b2 = k >> 2, rr = rq + 16 * (k & 3); float x1[8], vv[8];
                    conv3_8x<false>(xa[j], W1, x1); conv3_8x<false>(xb[j], W2, vv);
                    LAS bf16_t* th = (LAS bf16_t*)tile + b2;
#pragma unroll
                    for (int e2 = 0; e2 < 4; ++e2) { const unsigned w = pack2(x1[2 * e2] * vv[2 * e2], x1[2 * e2 + 1] * vv[2 * e2 + 1]);
                        th[2 * ((8 * g8 + 2 * e2) * 65 + rr)] = (bf16_t)(w & 0xffffu); th[2 * ((8 * g8 + 2 * e2 + 1) * 65 + rr)] = (bf16_t)(w >> 16); } } } }
            __syncthreads();
            { unsigned* WTt = (unsigned*)(P.ws + WS_BIG + BIG_WT); const int t = tid & 63;
              for (int cc = tid >> 6; cc < 256; cc += 8) WTt[((size_t)cc * 4 + p) * 4096 + tb * 64 + t] = tile[cc * 65 + t]; }
            __syncthreads();
        } else { const int tid = Pu.tid;
            const int ub = u - NS2 - 256; const int c = tid & 255; bf16_t* WTC = (bf16_t*)(P.ws + WS_BIG + BIG_WT) + (size_t)NLAT * 256;
#pragma unroll 4
            for (int rr = tid >> 8; rr < 64; rr += 2) { const int row = NLAT + ub * 64 + rr;
                const float x1 = conv3_u(U, row, 256 + c, hcw, 768, 256 + c) + hcb[256 + c]; const float v = conv3_u(U, row, 512 + c, hcw, 768, 512 + c) + hcb[512 + c];
                WTC[(size_t)(row - NLAT) * 256 + c] = f2bf(x1 * v); } }
    DYNQ_END()
}

__device__ __forceinline__ void phase_m2(const Ptrs P, int l, LAS unsigned char* lds) {
    const int tid = P.tid, G = P.G;
    const bf16_t* U = (const bf16_t*)(P.ws + WS_BIG + BIG_U); bf16_t* BR = (bf16_t*)(P.ws + WS_BR);
    const float* hcw = P.inp(I_HYCW) + (size_t)l * 3 * 768; const float* hcb = P.inp(I_HYCB) + l * 768;
    const int NU_F = 256, NU_P2 = 256, NU_HC = (l == 0) ? NB * 8 : 0;
    const int NU = NU_F + NU_P2 + NU_HC;
    for (int u = P.bid; u < NU; u += G) {
        if (u < NU_F) { hyena_fft_unit(P, l, u, lds); continue; }
        if (u < NU_F + NU_P2) { scan_pass2(P, u - NU_F); continue; }
        {
            const int uu = u - NU_F - NU_P2; const int b = uu >> 3, cb = uu & 7; const int cl = tid & 31, tg = tid >> 5; const int c = cb * 32 + cl;
            const int base = NLAT + b * CTXL; const bf16_t* WTC = (const bf16_t*)(P.ws + WS_BIG + BIG_WT) + (size_t)NLAT * 256 + (size_t)b * CTXL * 256;
            LAS float* wl = (LAS float*)lds; LAS float* fl = wl + 256 * 32;
            const float inv = 1.0f / hy_norm(P, 2, c); const float* filt = (const float*)(P.ws + WS_FILTC);
            for (int i = tid; i < 256 * 32; i += 512) wl[i] = bf2f(WTC[(size_t)(i >> 5) * 256 + cb * 32 + (i & 31)]);
            for (int i = tid >> 5; i < 512; i += 16) fl[i * 32 + cl] = filt[(size_t)i * 256 + c] * inv;
            __syncthreads();
            float acc[16];
#pragma unroll
            for (int j = 0; j < 16; ++j) acc[j] = 0.f;
#pragma unroll 1
            for (int sb = 0; sb < 16; ++sb) {
                float fw[31], wv[16];
#pragma unroll
                for (int q = 0; q < 31; ++q) fw[q] = fl[((16 * tg - 16 * sb - 15 + q) & 511) * 32 + cl];
#pragma unroll
                for (int k = 0; k < 16; ++k) wv[k] = wl[(16 * sb + k) * 32 + cl];
#pragma unroll
                for (int j = 0; j < 16; ++j)
#pragma unroll
                    for (int k = 0; k < 16; ++k) acc[j] += fw[j - k + 15] * wv[k];
            }
            const float bias = P.inp(I_HYBIAS)[l * 256 + c];
#pragma unroll 4
            for (int j = 0; j < 16; ++j) { const int tt = 16 * tg + j; const int row = base + tt; const float x0 = conv3_u(U, row, c, hcw, 768, c) + hcb[c];
                BR[(size_t)row * 256 + c] = f2bf(x0 * (acc[j] + wl[tt * 32 + cl] * bias)); }
            __syncthreads();
        }
    }
}

__device__ __forceinline__ void phase_m3(const Ptrs P, int l, LAS unsigned char* lds) {
    const int tid = P.tid;
    const bool last = (l == NLAYER - 1); const int rows_l = last ? NLAT : T; const int nch = last ? NCHK - 2 : NCHK;
    const bf16_t* U = (const bf16_t*)(P.ws + WS_BIG + BIG_U); bf16_t* BR = (bf16_t*)(P.ws + WS_BR);
    const int NSS3 = NB * 2 * nch, NH3 = NB * 4 * nch;
    const int NS3T = NSS3 + NH3;
    const int NU = NS3T + rows_l / 64 + 256;
    const float* hcw = P.inp(I_HYCW) + (size_t)l * 3 * 768; const float* hcb = P.inp(I_HYCB) + l * 768;
    DYNQ_BEGIN((unsigned*)(P.ws + WS_CTL + CTL_DYN) + 24 + l, NU)
        if (u >= NS3T + rows_l / 64) {
            const int ub = u - NS3T - rows_l / 64; const int p = ub >> 6, tb = ub & 63; LAS unsigned* tile = (LAS unsigned*)lds; const unsigned* WTt = (const unsigned*)(P.ws + WS_BIG + BIG_WT);
            { const int t = tid & 63; for (int cc = tid >> 6; cc < 256; cc += 8) tile[cc * 65 + t] = WTt[((size_t)cc * 4 + p) * 4096 + tb * 64 + t]; }
            __syncthreads();
            for (int it = tid; it < 64 * 32; it += 512) { const int rr = it >> 5, g8 = it & 31; unsigned yw[8];
#pragma unroll
                for (int e = 0; e < 8; ++e) yw[e] = tile[(8 * g8 + e) * 65 + rr];
#pragma unroll
                for (int b2 = 0; b2 < 2; ++b2) { const int row = (2 * p + b2) * SEQ + tb * 64 + rr; float x0[8], t8[8]; conv3_8<false>(U, row, 8 * g8, hcw, 768, 8 * g8, hcb, x0);
#pragma unroll
                    for (int e = 0; e < 8; ++e) t8[e] = x0[e] * (b2 ? __uint_as_float(yw[e] & 0xffff0000u) : __uint_as_float(yw[e] << 16));
                    *(bf16x8*)(BR + (size_t)row * 256 + 8 * g8) = pack8(t8); } }
            __syncthreads(); }
        else if (u < NS3T) { const int uc = u < NSS3 ? u : u - NSS3; const int rq = last ? (uc >> 5) : uc / NCHK; const int uu = rq * NCHK + (uc - rq * nch) + (NCHK - nch);
            Ptrs Pu = P; int lu = l; asm volatile("" : "+v"(Pu.tid), "+s"(lu));
            if (u < NSS3) ssd_pass3(Pu, lu, uu, lds); else hgrn_pass3(Pu, lu, uu, -1, lds); }
        else { const int rb = u - NS3T; const float* cw = P.inp(I_SCCW) + (size_t)l * 3 * 256;
            for (int it = tid; it < 64 * 32; it += 512) { const int row = rb * 64 + (it >> 5), g8 = it & 31; const bool hp = row_has_prev(row), hn = row_has_next(row);
                const bf16_t* u0 = U + (size_t)row * UC + 8 * g8; const bf16_t* up = U + (size_t)(hp ? row - 1 : row) * UC + 8 * g8; const bf16_t* un = U + (size_t)(hn ? row + 1 : row) * UC + 8 * g8;
                const bf16x8 bg = *(const bf16x8*)(u0 + 768), c0 = *(const bf16x8*)(u0 + 1024), x0 = *(const bf16x8*)(u0 + 1280), cp = *(const bf16x8*)(up + 1024), xp = *(const bf16x8*)(up + 1280), cn = *(const bf16x8*)(un + 1024), xn = *(const bf16x8*)(un + 1280);
                const float mp = hp ? 1.0f : 0.0f, mn = hn ? 1.0f : 0.0f; float t8[8];
#pragma unroll
                for (int e = 0; e < 8; ++e) { const int c = 8 * g8 + e;
                    const float acc = bf2f((bf16_t)c0[e]) * bf2f((bf16_t)x0[e]) * cw[256 + c] + mp * bf2f((bf16_t)cp[e]) * bf2f((bf16_t)xp[e]) * cw[c] + mn * bf2f((bf16_t)cn[e]) * bf2f((bf16_t)xn[e]) * cw[512 + c];
                    t8[e] = bf2f((bf16_t)bg[e]) * acc; }
                *(bf16x8*)(BR + (size_t)T * 256 + (size_t)row * 256 + 8 * g8) = pack8(t8); } }
    DYNQ_END()
}

__device__ __forceinline__ void phase_g2(const Ptrs P, int l, LAS unsigned char* lds) {
    const int MT = ((l == NLAYER - 1) ? NLAT : T) / 256;
    pg8::Gemm g{(const bf16_t*)(P.ws + WS_BR), (const bf16_t*)(P.ws + WS_WBR), 256};
    EpiP E{(bf16_t*)(P.ws + WS_BIG + BIG_P), (const float*)(P.ws + WS_SSQ)};
    SchedG2 S{XOrder{P.G, P.bid, MT, 16}};
    pg8::gemm_phase<EpiP, SchedG2, false>(P.tid, lds, g, S, E);
}
__device__ __forceinline__ void phase_g3(const Ptrs P, int l, LAS unsigned char* lds) {
    const int MT = ((l == NLAYER - 1) ? NLAT : T) / 256;
    pg8::Gemm g{(const bf16_t*)(P.ws + WS_HBUF), (const bf16_t*)(P.ws + WS_WG), D};
    EpiMerge E{(const bf16_t*)(P.ws + WS_BIG + BIG_P), (const float*)(P.ws + WS_BGP), (bf16_t*)(P.ws + WS_BR)};
    SchedMN S{XOrder{P.G, P.bid, MT, 16}};
    pg8::gemm_phase<EpiMerge, SchedMN, false>(P.tid, lds, g, S, E);
}
__device__ __forceinline__ void phase_g4(const Ptrs P, int l, LAS unsigned char* lds) {
    const int MT = ((l == NLAYER - 1) ? NLAT : T) / 256;
    pg8::Gemm g{(const bf16_t*)(P.ws + WS_BR), (const bf16_t*)(P.ws + WS_WO), D};
    SchedMN S{XOrder{P.G, P.bid, MT, 4}};
    if (l == 0) { EpiWo<true> E{P, l, P.inp(I_X), P.inp(I_CTX)}; pg8::gemm_phase<EpiWo<true>, SchedMN, false>(P.tid, lds, g, S, E); }
    else { EpiWo<false> E{P, l, nullptr, nullptr}; pg8::gemm_phase<EpiWo<false>, SchedMN, false>(P.tid, lds, g, S, E); }
    dyn_tiles(P.tid, (unsigned*)(P.ws + WS_CTL + CTL_DYN) + l, NCONV_EX, (volatile LAS unsigned*)(lds + LDS_MISC + 64), ConvEx{P, l, (LAS float*)lds});
}

__device__ __forceinline__ void phase_e5(const Ptrs P, int l, LAS unsigned char* lds) {
    const int tid = P.tid, wid = tid >> 6, lane = tid & 63, G = P.G, fr = lane & 15, fq = lane >> 4;
    const int rows_l = (l == NLAYER - 1) ? NLAT : T;
    LAS bf16_t* wrH = (LAS bf16_t*)lds;
    LAS bf16_t* wrL = wrH + 16 * 1032;
    LAS float* lgs = (LAS float*)(lds + 136192);
    LAS unsigned* lcnt = (LAS unsigned*)(lds + 144896); LAS unsigned* gbase = lcnt + 16; LAS int* rec = (LAS int*)(lcnt + 32);
    const float* wrt_ = P.inp(I_WROUTER);
    for (int i = tid; i < 1024 * 16; i += 512) { const int k = i >> 4, e = i & 15; const float w = wrt_[i]; const unsigned hi = pack2(w, 0.f) & 0xffffu; const float lo = w - __uint_as_float(hi << 16);
        wrH[e * 1032 + k] = (bf16_t)hi; wrL[e * 1032 + k] = f2bf(lo); }
    if (tid < 16) lcnt[tid] = 0u;
    __syncthreads();
    unsigned* cnt = (unsigned*)(P.ws + WS_CTL + CTL_CNT) + l * 16;
    int* toke = (int*)(P.ws + WS_TOKE); float* tokw = (float*)(P.ws + WS_TOKW); int* toks = (int*)(P.ws + WS_TOKS); int* list = (int*)(P.ws + WS_LIST);
    const float* g = P.inp(I_LN1G) + l * D; const float* bta = P.inp(I_LN1B) + l * D;
    bf16_t* H2 = (bf16_t*)(P.ws + WS_HBUF);
    const int NU_R = rows_l / 8;
    int nloc = 0;
    {
        RowV lng, lnb; row_load(lng, g, lane); row_load(lnb, bta, lane);
        RowV rn; { const float z = zero_f(); for (int i = 0; i < 4; ++i) rn.v[i] = (f32x4){z, z, z, z}; } if (P.bid < NU_R) row_load(rn, P.latrow(P.bid * 8 + wid), lane);
        RowV msh, msc; { const float z = zero_f(); for (int i = 0; i < 4; ++i) { msh.v[i] = (f32x4){z, z, z, z}; msc.v[i] = msh.v[i]; } } int mcur = -1;
        for (int u = P.bid; u < NU_R; u += G) {
            const int row = u * 8 + wid; RowV r = rn;
            if (u + G < NU_R) row_load(rn, P.latrow((u + G) * 8 + wid), lane);
            row_layernorm_r(r, lng, lnb);
            const int mi = row_modidx(row); if (mi != mcur) { mcur = mi; const float* m = P.mod(l, mi); row_load(msh, m + 3072, lane); row_load(msc, m + 4096, lane); }
            RowV h; row_modulate_r(r, h, msh, msc);
            row_store_bf16(h, H2 + (size_t)row * D, lane);
            ++nloc;
        }
    }
    asm volatile("s_waitcnt vmcnt(0)" ::: "memory");
    __syncthreads();
    {
        const int ntile = (nloc + 1) >> 1; LAS float* lg = lgs + wid * 16 * 17;
        for (int t = wid; t < ntile; t += 8) {
            int it = 2 * t + (fr >> 3); const bool valid_a = it < nloc; if (!valid_a) it = nloc - 1;
            const bf16_t* ap = H2 + (size_t)((P.bid + G * it) * 8 + (fr & 7)) * D + 8 * fq;
            f32x4 acc = (f32x4){0.f, 0.f, 0.f, 0.f};
#pragma unroll 4
            for (int ks = 0; ks < 32; ++ks) { const bf16x8 a = *(const bf16x8*)(ap + 32 * ks);
                const bf16x8 bh = *(const LAS bf16x8*)(wrH + fr * 1032 + 32 * ks + 8 * fq), bl = *(const LAS bf16x8*)(wrL + fr * 1032 + 32 * ks + 8 * fq);
                acc = __builtin_amdgcn_mfma_f32_16x16x32_bf16(a, bh, acc, 0, 0, 0); acc = __builtin_amdgcn_mfma_f32_16x16x32_bf16(a, bl, acc, 0, 0, 0); }
#pragma unroll
            for (int r = 0; r < 4; ++r) lg[(4 * fq + r) * 17 + fr] = acc[r];
            const int it2 = 2 * t + (lane >> 3); const bool act = (lane < 16) && (it2 < nloc);
            if (act) {
                const int row = (P.bid + G * it2) * 8 + (lane & 7);
                float lgv[16]; const float* brt_ = P.inp(I_BROUTER);
#pragma unroll
                for (int e = 0; e < 16; ++e) lgv[e] = lg[lane * 17 + e];
                float mx = lgv[0];
#pragma unroll
                for (int e = 1; e < 16; ++e) mx = fmaxf(mx, lgv[e]);
                float sc[16], sel[16], ssum = 0.f;
#pragma unroll
                for (int e = 0; e < 16; ++e) { sc[e] = fexp(lgv[e] - mx); ssum += sc[e]; }
                const float inv = 1.0f / ssum;
#pragma unroll
                for (int e = 0; e < 16; ++e) { sc[e] *= inv; sel[e] = sc[e] + brt_[e]; }
                int bestg = 0; float bestgs = -3.0e38f;
#pragma unroll
                for (int gq = 0; gq < 4; ++gq) { float m1 = -3.0e38f, m2 = -3.0e38f;
#pragma unroll
                    for (int j = 0; j < 4; ++j) { const float v = sel[gq * 4 + j]; if (v > m1) { m2 = m1; m1 = v; } else if (v > m2) m2 = v; }
                    const float gs = m1 + m2; if (gs > bestgs) { bestgs = gs; bestg = gq; } }
                int i1 = 0, i2 = 0; float v1 = -3.0e38f, v2 = -3.0e38f, w1 = 0.f, w2 = 0.f;
#pragma unroll
                for (int e = 0; e < 16; ++e) { if ((e >> 2) == bestg && sel[e] > v1) { v1 = sel[e]; i1 = e; w1 = sc[e]; } }
#pragma unroll
                for (int e = 0; e < 16; ++e) { if ((e >> 2) == bestg && e != i1 && sel[e] > v2) { v2 = sel[e]; i2 = e; w2 = sc[e]; } }
                const float ws_ = 1.0f / (w1 + w2);
                const int s1 = (int)__hip_atomic_fetch_add(lcnt + i1, 1u, __ATOMIC_RELAXED, __HIP_MEMORY_SCOPE_WORKGROUP);
                const int s2 = (int)__hip_atomic_fetch_add(lcnt + i2, 1u, __ATOMIC_RELAXED, __HIP_MEMORY_SCOPE_WORKGROUP);
                const int idx = it2 * 8 + (lane & 7); rec[idx * 3] = i1 | (i2 << 8); rec[idx * 3 + 1] = s1; rec[idx * 3 + 2] = s2;
                toke[row * 2] = i1; toke[row * 2 + 1] = i2; tokw[row * 2] = w1 * ws_; tokw[row * 2 + 1] = w2 * ws_;
            }
        }
    }
    __syncthreads();
    if (tid < 16) gbase[tid] = __hip_atomic_fetch_add(cnt + tid, lcnt[tid], __ATOMIC_RELAXED, __HIP_MEMORY_SCOPE_AGENT);
    __syncthreads();
    for (int idx = tid; idx < nloc * 8; idx += 512) { const int row = (P.bid + G * (idx >> 3)) * 8 + (idx & 7); const int ee = rec[idx * 3]; const int e1 = ee & 255, e2 = ee >> 8;
        const int s1 = (int)gbase[e1] + rec[idx * 3 + 1], s2 = (int)gbase[e2] + rec[idx * 3 + 2];
        list[(size_t)e1 * T + s1] = row; list[(size_t)e2 * T + s2] = row; toks[row * 2] = s1; toks[row * 2 + 1] = s2; }
}

struct MoeSeg { int toff[17]; };
__device__ __forceinline__ void moe_seg(const unsigned* cnt, MoeSeg& S) { int a = 0;
#pragma unroll
    for (int e = 0; e < 16; ++e) { S.toff[e] = a; a += __builtin_amdgcn_readfirstlane(((int)cnt[e] + 255) >> 8); }
    S.toff[16] = a; }
__device__ __forceinline__ int moe_find(const MoeSeg& S, int tg, int& off) { int e = 0; off = 0;
#pragma unroll
    for (int j = 1; j < 16; ++j) { const bool ge = (tg >= S.toff[j]); e += ge ? 1 : 0; off = ge ? S.toff[j] : off; }
    return e; }

struct SchedMoe { int G, c; MoeSeg S; const int* list; const unsigned* cnt;
    __device__ __forceinline__ bool next(int i, Unit& u) const { const int L = i * G + c; if (L >= S.toff[16] * 4) return false; const int tg = L >> 2, pnn = L & 3; int off; const int e = moe_find(S, tg, off);
        u.pm = tg; u.pn = e * 4 + pnn; u.e = e; u.aux = tg - off; return true; }
    __device__ __forceinline__ int arow(const Unit& u, int R) const { const int idx = u.aux * 256 + R; const int* l = list + (size_t)u.e * T; return idx < (int)cnt[u.e] ? l[idx] : l[0]; } };
__device__ __forceinline__ void phase_g5(const Ptrs P, int l, LAS unsigned char* lds) {
    const unsigned* cnt = (const unsigned*)(P.ws + WS_CTL + CTL_CNT) + l * 16;
    SchedMoe S; S.G = P.G; S.c = P.bid; moe_seg(cnt, S.S); S.list = (const int*)(P.ws + WS_LIST); S.cnt = cnt;
    pg8::Gemm g{(const bf16_t*)(P.ws + WS_HBUF), (const bf16_t*)(P.ws + WS_BIG + BIG_W13), D};
    EpiFfn1 E{(bf16_t*)(P.ws + WS_BIG + BIG_HID)};
    pg8::gemm_phase<EpiFfn1, SchedMoe, true>(P.tid, lds, g, S, E);
    if (l != NLAYER - 1) dyn_tiles(P.tid, (unsigned*)(P.ws + WS_CTL + CTL_DYN) + 8 + l, NCONV_NE, (volatile LAS unsigned*)(lds + LDS_MISC + 64), ConvNe{P, l + 1, (LAS float*)lds});
}
__device__ __forceinline__ void phase_g6(const Ptrs P, int l, LAS unsigned char* lds) {
    const unsigned* cnt = (const unsigned*)(P.ws + WS_CTL + CTL_CNT) + l * 16;
    SchedMoe S; S.G = P.G; S.c = P.bid; moe_seg(cnt, S.S); S.list = (const int*)(P.ws + WS_LIST); S.cnt = cnt;
    pg8::Gemm g{(const bf16_t*)(P.ws + WS_BIG + BIG_HID), (const bf16_t*)(P.ws + WS_BIG + BIG_W2), 512};
    EpiBf16Plain E{(bf16_t*)(P.ws + WS_BIG + BIG_YE), 1024, 3};
    pg8::gemm_phase<EpiBf16Plain, SchedMoe, false>(P.tid, lds, g, S, E);
}

__device__ __forceinline__ void phase_e8(const Ptrs P, int l, LAS unsigned char* lds) {
    const int tid = P.tid, wid = tid >> 6, lane = tid & 63, G = P.G;
    const bool last = (l == NLAYER - 1); const int rows_l = last ? NLAT : T;
    LAS float* wdt = (LAS float*)lds;
    if (!last) load_wdt(P, l + 1, wdt);
    const unsigned* cnt = (const unsigned*)(P.ws + WS_CTL + CTL_CNT) + l * 16; MoeSeg S; moe_seg(cnt, S);
    const int* toke = (const int*)(P.ws + WS_TOKE); const float* tokw = (const float*)(P.ws + WS_TOKW); const int* toks = (const int*)(P.ws + WS_TOKS);
    const bf16_t* YE = (const bf16_t*)(P.ws + WS_BIG + BIG_YE);
    const float* g = P.inp(I_LN2G) + l * D; const float* bta = P.inp(I_LN2B) + l * D; const float* g1p = P.inp(I_LN1G) + l * D; const float* b1p = P.inp(I_LN1B) + l * D;
    const int NU_R = rows_l / 8;
    RowV lng, lnb; row_load(lng, g, lane); row_load(lnb, bta, lane);
    RowV mg2, msh, msc; { const float z = zero_f(); for (int i = 0; i < 4; ++i) { mg2.v[i] = (f32x4){z, z, z, z}; msh.v[i] = mg2.v[i]; msc.v[i] = mg2.v[i]; } } int mcur = -1;
    RowV rn; { const float z = zero_f(); for (int i = 0; i < 4; ++i) rn.v[i] = (f32x4){z, z, z, z}; } int te1 = 0, te2 = 0, ts1 = 0, ts2 = 0; float tw1 = 0.f, tw2 = 0.f;
    if (P.bid < NU_R) { const int row = P.bid * 8 + wid; row_load(rn, P.latrow(row), lane); te1 = toke[row * 2]; te2 = toke[row * 2 + 1]; tw1 = tokw[row * 2]; tw2 = tokw[row * 2 + 1]; ts1 = toks[row * 2]; ts2 = toks[row * 2 + 1]; }
    for (int u = P.bid; u < NU_R; u += G) {
        const int row = u * 8 + wid; RowV r = rn; float* lp = P.latrow(row);
        row_layernorm(r, g1p, b1p, lane);
        const int e1 = te1, e2 = te2; const float w1 = tw1, w2 = tw2;
        int o1 = 0, o2 = 0;
#pragma unroll
        for (int e = 0; e < 16; ++e) { o1 = (e == e1) ? S.toff[e] : o1; o2 = (e == e2) ? S.toff[e] : o2; }
        const bf16_t* y1 = YE + ((size_t)o1 * 256 + ts1) * 1024; const bf16_t* y2 = YE + ((size_t)o2 * 256 + ts2) * 1024;
        u32x2 ya[4], yb[4];
#pragma unroll
        for (int i = 0; i < 4; ++i) { ya[i] = *(const u32x2*)(y1 + i * 256 + lane * 4); yb[i] = *(const u32x2*)(y2 + i * 256 + lane * 4); }
        if (u + G < NU_R) { const int rw = (u + G) * 8 + wid; row_load(rn, P.latrow(rw), lane); te1 = toke[rw * 2]; te2 = toke[rw * 2 + 1]; tw1 = tokw[rw * 2]; tw2 = tokw[rw * 2 + 1]; ts1 = toks[rw * 2]; ts2 = toks[rw * 2 + 1]; }
        const int mi = row_modidx(row);
        if (mi != mcur) { mcur = mi; row_load(mg2, P.mod(l, mi) + 5120, lane); if (!last) { const float* m2 = P.mod(l + 1, mi); row_load(msh, m2, lane); row_load(msc, m2 + 1024, lane); } }
#pragma unroll
        for (int i = 0; i < 4; ++i) { const u32x2 a = ya[i], b = yb[i];
            const f32x4 g2 = mg2.v[i];
            f32x4 mo; mo[0] = w1 * __uint_as_float(a.x << 16) + w2 * __uint_as_float(b.x << 16); mo[1] = w1 * __uint_as_float(a.x & 0xffff0000u) + w2 * __uint_as_float(b.x & 0xffff0000u);
            mo[2] = w1 * __uint_as_float(a.y << 16) + w2 * __uint_as_float(b.y << 16); mo[3] = w1 * __uint_as_float(a.y & 0xffff0000u) + w2 * __uint_as_float(b.y & 0xffff0000u);
            r.v[i] = r.v[i] * ALPHA + g2 * mo; }
        row_layernorm_r(r, lng, lnb);
        row_store(r, lp, lane);
        if (!last) { RowV h; row_modulate_r(r, h, msh, msc);
            row_store_bf16(h, (bf16_t*)(P.ws + WS_HBUF) + (size_t)row * D, lane); row_dt(h, wdt, (float*)(P.ws + WS_DT) + (size_t)row * 8, lane); }
    }
}

constexpr int NPH_LAYER = 11, NPH = 2 + NLAYER * NPH_LAYER;
__global__ void __launch_bounds__(512, 2) fwd_kernel(Args a) {
    extern __shared__ __attribute__((aligned(16))) unsigned char lds_raw[];
    LAS unsigned char* lds = (LAS unsigned char*)lds_raw;
    const int lo = a.ph_lo, hi = a.ph_hi;
    volatile LAS unsigned* xbw = (volatile LAS unsigned*)(lds + LDS_MISC);
    const int wave_s = __builtin_amdgcn_readfirstlane((int)threadIdx.x >> 6);
    if (threadIdx.x < 4) xbw[threadIdx.x] = 0u;
    __syncthreads();
    XcdBarrier bar; bar.bar = (unsigned*)(a.ws + WS_CTL); bar.x = 0; bar.st = xbw;
    if (hi - lo > 1) bar = xcd_barrier_post((unsigned*)(a.ws + WS_CTL), xbw, wave_s);
#ifndef PH_MASK
#define PH_MASK 0xFFFFFFFFu
#endif
#ifndef PROBE_PH
#define PROBE_PH (-1)
#define PROBE_N 1
#endif
#define REP(id) for (int rep_ = 0; rep_ < ((PROBE_PH == (id)) ? PROBE_N : 1); ++rep_)
#define PH_ON(id) (((PH_MASK) >> (id)) & 1u)
#define IN(k) (lo <= (k) && (k) < hi)
#define FRESH() Ptrs Pq; { const AS4 char* ka_ = (const AS4 char*)__builtin_amdgcn_kernarg_segment_ptr(); AS1 float* o_ = *(AS1 float* const AS4*)(ka_ + 8 * N_IN); AS1 unsigned char* w_ = *(AS1 unsigned char* const AS4*)(ka_ + 8 * N_IN + 8); int l_ = lcur; asm volatile("" : "+s"(o_), "+s"(w_), "+s"(l_) :: "memory"); Pq.out = (float*)o_; Pq.ws = (unsigned char*)w_; lq = l_; int ws_ = wave_s, b_ = blockIdx.x, g_ = gridDim.x; asm volatile("" : "+s"(ws_), "+s"(b_), "+s"(g_)); int ln_ = lane_id(); asm volatile("" : "+v"(ln_)); int t_ = ws_ * 64 + ln_; Pq.tid = t_; Pq.bid = b_; Pq.G = g_; }
#define SEAM(k) do { if (IN(k) && IN((k) + 1)) xcd_barrier(bar, wave_s); } while (0)
    int lcur = 0, lq = 0;
    if (PH_ON(0) && IN(0)) REP(0) { FRESH(); phase_pa(Pq, lds); } SEAM(0);
    if (PH_ON(1) && IN(1)) REP(1) { FRESH(); phase_pb(Pq, lds); } SEAM(1);
    for (int l = 0; l < NLAYER; ++l) {
        const int b = 2 + l * NPH_LAYER; lcur = l;
        if (PH_ON(2) && IN(b + 0)) REP(2) { FRESH(); phase_g1(Pq, lds); } SEAM(b + 0);
        for (int g_ = 0; g_ < ((PROBE_PH == 100) ? PROBE_N : 1); ++g_) {
        if (PH_ON(3) && IN(b + 1)) REP(3) { FRESH(); phase_m1(Pq, lq, lds); } SEAM(b + 1);
        if (PH_ON(4) && IN(b + 2)) REP(4) { FRESH(); phase_m2(Pq, lq, lds); } SEAM(b + 2);
        if (PH_ON(5) && IN(b + 3)) REP(5) { FRESH(); phase_m3(Pq, lq, lds); } SEAM(b + 3);
        }
        if (PH_ON(6) && IN(b + 4)) REP(6) { FRESH(); phase_g2(Pq, lq, lds); } SEAM(b + 4);
        if (PH_ON(7) && IN(b + 5)) REP(7) { FRESH(); phase_g3(Pq, lq, lds); } SEAM(b + 5);
        if (PH_ON(8) && IN(b + 6)) REP(8) { FRESH(); phase_g4(Pq, lq, lds); } SEAM(b + 6);
        if (PH_ON(9) && IN(b + 7)) REP(9) { FRESH(); phase_e5(Pq, lq, lds); } SEAM(b + 7);
        if (PH_ON(10) && IN(b + 8)) REP(10) { FRESH(); phase_g5(Pq, lq, lds); } SEAM(b + 8);
        if (PH_ON(11) && IN(b + 9)) REP(11) { FRESH(); phase_g6(Pq, lq, lds); } SEAM(b + 9);
        if (PH_ON(12) && IN(b + 10)) REP(12) { FRESH(); phase_e8(Pq, lq, lds); } SEAM(b + 10);
    }
#undef IN
#undef SEAM
}
}

extern "C" void kernel_launch(void* const* d_in, const int* in_sizes, int n_in, void* d_out, int out_size, void* d_ws, size_t ws_size, hipStream_t stream) {
    static int grid = 0;
    if (grid == 0) {
        if (n_in != N_IN || out_size != NLAT * D || ws_size < WS_END) { fprintf(stderr, "kernel_launch: unexpected shapes / workspace (%d inputs, out %d, ws %zu < %zu)\n", n_in, out_size, ws_size, (size_t)WS_END); grid = -1; return; }
        int dev = 0, cus = 0, per_cu = 0;
        if (hipGetDevice(&dev) != hipSuccess || hipDeviceGetAttribute(&cus, hipDeviceAttributeMultiprocessorCount, dev) != hipSuccess) { grid = -1; return; }
        if (hipFuncSetAttribute((const void*)fwd_kernel, hipFuncAttributeMaxDynamicSharedMemorySize, LDS_BYTES) != hipSuccess) { fprintf(stderr, "kernel_launch: hipFuncSetAttribute failed\n"); grid = -1; return; }
        if (hipOccupancyMaxActiveBlocksPerMultiprocessor(&per_cu, (const void*)fwd_kernel, 512, LDS_BYTES) != hipSuccess || per_cu < 1) { fprintf(stderr, "kernel_launch: occupancy query says %d\n", per_cu); }
        (void)hipGetLastError();
        grid = cus;
    }
    if (grid < 0) return;
    (void)hipMemsetAsync((char*)d_ws + WS_CTL, 0, CTL_BYTES, stream);
    Args a{};
    for (int i = 0; i < N_IN; ++i) a.in[i] = (const float*)d_in[i];
    a.out = (float*)d_out; a.ws = (unsigned char*)d_ws;
#if N_LAUNCH_MODE == 1
    a.ph_lo = 0; a.ph_hi = NPH;
    hipLaunchKernelGGL(fwd_kernel, dim3(grid), dim3(512), LDS_BYTES, stream, a);
#else
    for (int p = 0; p < NPH; ++p) { a.ph_lo = p; a.ph_hi = p + 1; hipLaunchKernelGGL(fwd_kernel, dim3(grid), dim3(512), LDS_BYTES, stream, a); }
#endif
}
```

```cpp
#include <hip/hip_runtime.h>
#include <cstdio>
#include <cstdint>

#ifndef N_LAUNCH_MODE
#define N_LAUNCH_MODE 1
#endif

namespace {
typedef unsigned short bf16_t;
typedef short bf16x8 __attribute__((ext_vector_type(8)));
typedef float f32x4 __attribute__((ext_vector_type(4)));
typedef unsigned u32x2 __attribute__((ext_vector_type(2)));
typedef unsigned u32x4 __attribute__((ext_vector_type(4)));
#define LAS __attribute__((address_space(3)))

constexpr int D = 1024, NB = 8, SEQ = 4096, CTXL = 256, NLAT = NB * SEQ, NCTX = NB * CTXL, T = NLAT + NCTX;
constexpr int NLAYER = 2;
constexpr int UC = 3584;
constexpr int INC = 3592;
constexpr int NE = 16;
constexpr float ALPHA = 1.41421356237309515f;
constexpr float LN_EPS = 1e-5f, RMS_EPS = 1e-6f;
constexpr int MAXTILES = 288;

enum { I_X = 0, I_C, I_CTX, I_CCTX, I_WADA, I_BADA, I_WIN, I_HYCW, I_HYCB, I_HYW1, I_HYB1, I_HYF1, I_HYW2, I_HYB2, I_HYF2, I_HYW3, I_HYDEC, I_HYBIAS,
       I_SCCW, I_HGLB, I_HGNG, I_SSDCW, I_SSDCB, I_SSDALOG, I_SSDDTB, I_SSDD, I_SSDNG, I_WGATE, I_BGATE, I_WBR, I_WO, I_LN1G, I_LN1B, I_LN2G, I_LN2B,
       I_WROUTER, I_BROUTER, I_WE1, I_WE3, I_WE2, N_IN };

constexpr size_t al256(size_t x) { return (x + 255) & ~(size_t)255; }
constexpr size_t WS_CTL = 0;
constexpr size_t CTL_BYTES = 65536;
constexpr size_t CTL_CNT = 16384;
constexpr size_t CTL_DYN = 20480;
constexpr size_t WS_MOD = WS_CTL + CTL_BYTES;
constexpr size_t WS_LB = WS_MOD + al256((size_t)NLAYER * 9 * 6144 * 4);
constexpr size_t WS_TW = WS_LB + 4096;
constexpr size_t WS_H2TAB = WS_TW + 65536;
constexpr size_t WS_PART = WS_H2TAB + (size_t)8448 * 64 * 4;
constexpr size_t WS_FILT = WS_PART + (size_t)3 * 64 * 512 * 4;
constexpr size_t WS_FILTC = WS_FILT + (size_t)2 * 8192 * 256 * 4;
constexpr size_t WS_CX32 = WS_FILTC + (size_t)512 * 256 * 4;
constexpr size_t WS_DT = WS_CX32 + (size_t)NCTX * D * 4;
constexpr size_t WS_SSQ = WS_DT + (size_t)T * 8 * 4;
constexpr size_t WS_TOKE = WS_SSQ + (size_t)T * 4 * 4;
constexpr size_t WS_TOKW = WS_TOKE + (size_t)T * 2 * 4;
constexpr size_t WS_TOKS = WS_TOKW + (size_t)T * 2 * 4;
constexpr size_t WS_LIST = WS_TOKS + (size_t)T * 2 * 4;
constexpr size_t WS_BGP = WS_LIST + (size_t)NE * T * 4;
constexpr size_t WS_DEC = WS_BGP + 16384;
constexpr size_t WS_WIN = WS_DEC + (size_t)4352 * 64 * 4;
constexpr size_t WS_WG = WS_WIN + (size_t)UC * D * 2;
constexpr size_t WS_WBR = WS_WG + (size_t)4096 * D * 2;
constexpr size_t WS_WO = WS_WBR + (size_t)4096 * 256 * 2;
constexpr size_t WS_HBUF = WS_WO + (size_t)D * D * 2;
constexpr size_t WS_BR = WS_HBUF + (size_t)T * D * 2;
constexpr size_t WS_BIG = WS_BR + (size_t)T * D * 2;
constexpr size_t BIG_U = 0;
constexpr size_t BIG_HGO = BIG_U + (size_t)T * UC * 2;
constexpr size_t BIG_STATE = BIG_HGO;
constexpr size_t BIG_SSY = BIG_HGO + (size_t)T * 256 * 4;
constexpr size_t BIG_WT = BIG_SSY + (size_t)T * 256 * 4;
constexpr size_t BIG_END1 = BIG_WT + (size_t)T * 256 * 2;
constexpr size_t BIG_P = 0;
constexpr size_t BIG_HID = 0;
constexpr size_t BIG_YE = BIG_HID + (size_t)MAXTILES * 256 * 512 * 2;
constexpr size_t BIG_W13 = BIG_YE + (size_t)MAXTILES * 256 * 1024 * 2;
constexpr size_t BIG_W2 = BIG_W13 + (size_t)NE * 1024 * 1024 * 2;
constexpr size_t BIG_END3 = BIG_W2 + (size_t)NE * 1024 * 512 * 2;
constexpr size_t BIG_BYTES = BIG_END1 > BIG_END3 ? BIG_END1 : BIG_END3;
constexpr size_t WS_END = WS_BIG + BIG_BYTES;
static_assert((size_t)T * 4096 * 2 <= BIG_BYTES, "P fits");
static_assert(WS_END <= (size_t)536870912, "workspace budget");

constexpr int LDS_BYTES = 147456;
constexpr int LDS_MISC = 147456 - 256;

struct Args { const float* in[N_IN]; float* out; unsigned char* ws; int ph_lo, ph_hi; };

#define XB_TMO      128
#define XB_XCNT(j)  (256  + 64 * (j))
#define XB_XSUB(j)  (1280 + 64 * (j))
#define XB_XGEN(j)  (2304 + 64 * (j))
#define XB_TOP      3328
#define XB_TOPGEN   3392
#define XCD_BAR_WORDS 3456
#define XB_SPIN_CAP (1u << 18)
__device__ __forceinline__ unsigned xb_ld(unsigned* p)              { return __hip_atomic_load(p, __ATOMIC_RELAXED, __HIP_MEMORY_SCOPE_AGENT); }
__device__ __forceinline__ unsigned xb_add(unsigned* p, unsigned v) { return __hip_atomic_fetch_add(p, v, __ATOMIC_RELAXED, __HIP_MEMORY_SCOPE_AGENT); }
__device__ __forceinline__ unsigned xb_xcc_id() { return (unsigned)__builtin_amdgcn_s_getreg((3 << 11) | 20) & 0xFu; }
#define XB_SPIN(cond, bar) do { unsigned _sp = 0; while (cond) { __builtin_amdgcn_s_sleep(1); \
    if ((++_sp & 255u) == 0u) { if (xb_ld(&(bar)[XB_TMO])) break; if (_sp > XB_SPIN_CAP) { atomicAdd(&(bar)[XB_TMO], 1u); break; } } } } while (0)
struct XcdBarrier { unsigned* bar; unsigned x; volatile LAS unsigned* st; };
__device__ __forceinline__ int lane_id() { unsigned z = 0u; asm volatile("" : "+v"(z)); return (int)__builtin_amdgcn_mbcnt_hi(~0u, __builtin_amdgcn_mbcnt_lo(~0u, z)); }
__device__ __forceinline__ bool is_thread0(int wave_s) { return wave_s == 0 && lane_id() == 0; }
__device__ __forceinline__ XcdBarrier xcd_barrier_post(unsigned* bar, volatile LAS unsigned* st, int wave_s) {
    XcdBarrier b; b.bar = bar; b.x = xb_xcc_id(); b.st = st;
    if (is_thread0(wave_s)) (void)xb_add(&bar[XB_XCNT(b.x)], 1u);
    return b;
}
__device__ __forceinline__ void xcd_barrier_complete(unsigned* bar, unsigned x, unsigned& nloc, unsigned& nx) {
    const unsigned G = gridDim.x * gridDim.y * gridDim.z;
    unsigned sum, cnt, mine, sp = 0u;
    for (;;) {
        sum = 0u; cnt = 0u; mine = 0u;
#pragma unroll
        for (unsigned j = 0; j < 16; ++j) { const unsigned c = xb_ld(&bar[XB_XCNT(j)]); sum += c; cnt += (c > 0u) ? 1u : 0u; mine = (j == x) ? c : mine; }
        if (sum == G) break;
        __builtin_amdgcn_s_sleep(1);
        if ((++sp & 255u) == 0u) { if (xb_ld(&bar[XB_TMO])) break; if (sp > XB_SPIN_CAP) { atomicAdd(&bar[XB_TMO], 1u); break; } }
    }
    nloc = mine > 0u ? mine : 1u; nx = cnt > 0u ? cnt : 1u;
}
__device__ __forceinline__ void xcd_barrier(const XcdBarrier& b, int wave_s) {
    asm volatile("s_waitcnt vmcnt(0)" ::: "memory");
    __syncthreads();
    if (is_thread0(wave_s)) {
        unsigned* bar = b.bar;
        __builtin_amdgcn_s_waitcnt(0);
        unsigned nloc = b.st[0], nx = b.st[1];
        if (nloc == 0u) { xcd_barrier_complete(bar, b.x, nloc, nx); b.st[0] = nloc; b.st[1] = nx; }
        const unsigned old = xb_add(&bar[XB_XSUB(b.x)], 1u);
        const unsigned gen = old / nloc;
        if (old + 1u == (gen + 1u) * nloc) {
            __builtin_amdgcn_fence(__ATOMIC_RELEASE, "agent");
            asm volatile("s_waitcnt vmcnt(0)" ::: "memory");
            const unsigned og = xb_add(&bar[XB_TOP], 1u);
            const unsigned tg = og / nx;
            if (og + 1u == (tg + 1u) * nx) xb_add(&bar[XB_TOPGEN], 1u);
            else XB_SPIN(xb_ld(&bar[XB_TOPGEN]) == tg, bar);
            __builtin_amdgcn_fence(__ATOMIC_ACQUIRE, "agent");
            xb_add(&bar[XB_XGEN(b.x)], 1u);
            asm volatile("s_waitcnt vmcnt(0)" ::: "memory");
        } else {
            XB_SPIN(xb_ld(&bar[XB_XGEN(b.x)]) == gen, bar);
            __builtin_amdgcn_fence(__ATOMIC_ACQUIRE, "agent");
            asm volatile("s_waitcnt vmcnt(0)" ::: "memory");
        }
    }
    __syncthreads();
}

__device__ __forceinline__ float bf2f(bf16_t b) { return __uint_as_float(((unsigned)b) << 16); }
typedef __bf16 hwbf2 __attribute__((ext_vector_type(2)));
typedef float hwf2 __attribute__((ext_vector_type(2)));
__device__ __forceinline__ unsigned pack2(float lo, float hi) { const hwf2 v = {lo, hi}; return __builtin_bit_cast(unsigned, __builtin_convertvector(v, hwbf2)); }
__device__ __forceinline__ bf16_t f2bf(float f) { return (bf16_t)(pack2(f, 0.f) & 0xffffu); }
__device__ __forceinline__ float zero_f() { float z = 0.f; asm volatile("" : "+v"(z)); return z; }
__device__ __forceinline__ float kconst(float c) { asm volatile("" : "+s"(c)); return c; }
__device__ __forceinline__ float fexp(float x) { return __builtin_amdgcn_exp2f(x * kconst(1.4426950408889634f)); }
__device__ __forceinline__ float flog(float x) { return __builtin_amdgcn_logf(x) * kconst(0.6931471805599453f); }
__device__ __forceinline__ float sigmoidf_(float x) { return __builtin_amdgcn_rcpf(1.0f + fexp(-x)); }
__device__ __forceinline__ float siluf_(float x) { return x * sigmoidf_(x); }
#define WS_DPP(v, ctrl) __int_as_float(__builtin_amdgcn_update_dpp(0, __float_as_int(v), (ctrl), 0xF, 0xF, true))
__device__ __forceinline__ float wave_sum(float v) {
    v += WS_DPP(v, 0xB1); v += WS_DPP(v, 0x4E); v += WS_DPP(v, 0x141); v += WS_DPP(v, 0x140);
    const float s0 = __uint_as_float(__builtin_amdgcn_readlane(__float_as_uint(v), 0)), s1 = __uint_as_float(__builtin_amdgcn_readlane(__float_as_uint(v), 16));
    const float s2 = __uint_as_float(__builtin_amdgcn_readlane(__float_as_uint(v), 32)), s3 = __uint_as_float(__builtin_amdgcn_readlane(__float_as_uint(v), 48));
    return (s0 + s1) + (s2 + s3);
}
__device__ __forceinline__ int row_modidx(int r) { return r < NLAT ? (r >> 12) : 8; }
__device__ __forceinline__ bool row_has_prev(int r) { return r < NLAT ? ((r & 4095) != 0) : (((r - NLAT) & 255) != 0); }
__device__ __forceinline__ bool row_has_next(int r) { return r < NLAT ? ((r & 4095) != 4095) : (((r - NLAT) & 255) != 255); }

#define AS1 __attribute__((address_space(1)))
#define AS4 __attribute__((address_space(4)))
struct Ptrs {
    float* out; unsigned char* ws; int tid, bid, G;
    __device__ __forceinline__ const float* inp(int i) const { asm volatile("" : "+s"(i));
        const __attribute__((address_space(4))) char* ka = (const __attribute__((address_space(4))) char*)__builtin_amdgcn_kernarg_segment_ptr();
        return (const float*)(*(const AS1 float* const AS4*)(ka + 8 * i)); }
    __device__ __forceinline__ bf16_t* s0row(int r) const { return (bf16_t*)out + (size_t)r * D; }
    __device__ __forceinline__ bf16_t* r1row(int l, int r) const { return (l == NLAYER - 1 ? (bf16_t*)(ws + WS_HBUF) : (bf16_t*)out) + (size_t)r * D; }
    __device__ __forceinline__ bf16_t* h2buf(int l) const { return (bf16_t*)(ws + (l == NLAYER - 1 ? WS_BR : WS_HBUF)); }
    __device__ __forceinline__ float* mod(int l, int ridx) const { return (float*)(ws + WS_MOD) + ((size_t)l * 9 + ridx) * 6144; }
};

__device__ __forceinline__ float conv3_u(const bf16_t* U, int row, int col, const float* w, int ncol, int wcol) {
    const bool hp = row_has_prev(row), hn = row_has_next(row);
    const float c = bf2f(U[(size_t)row * UC + col]), p = bf2f(U[(size_t)(hp ? row - 1 : row) * UC + col]), n = bf2f(U[(size_t)(hn ? row + 1 : row) * UC + col]);
    return c * w[ncol + wcol] + (hp ? p * w[wcol] : 0.f) + (hn ? n * w[2 * ncol + wcol] : 0.f);
}

struct Unit { int pm, pn, e, aux; };
__host__ __device__ __forceinline__ int perm32(int rho) { const int n = rho >> 4, i = rho & 15; return 8 * (i >> 2) + 4 * n + (i & 3); }

template <class RowMap, class Epi>
__device__ __forceinline__ void sgemm_unit(int tid_, const bf16_t* __restrict__ A, int lda, const bf16_t* __restrict__ Bt, int ldb, int K, const Unit& u, const RowMap& RM, const Epi& E) {
    const int tid = tid_, wid = tid >> 6, lane = tid & 63, wr = wid >> 2, wc = wid & 3, fr = lane & 15, fq = lane >> 4;
    f32x4 acc[2][2][4][2];
#pragma unroll
    for (int a = 0; a < 2; ++a)
#pragma unroll
        for (int b = 0; b < 2; ++b)
#pragma unroll
            for (int m = 0; m < 4; ++m)
#pragma unroll
                for (int n = 0; n < 2; ++n) acc[a][b][m][n] = (f32x4){0.f, 0.f, 0.f, 0.f};
    unsigned ap[2][4], bp[2][2];
#pragma unroll
    for (int a = 0; a < 2; ++a)
#pragma unroll
        for (int m = 0; m < 4; ++m) ap[a][m] = (unsigned)RM(u, 128 * a + 64 * wr + 16 * m + fr) * (unsigned)lda + fq * 8;
#pragma unroll
    for (int b = 0; b < 2; ++b)
#pragma unroll
        for (int n = 0; n < 2; ++n) { const int rho = 16 * n + fr; const int col = Epi::PERM ? perm32(rho) : rho;
            bp[b][n] = (unsigned)(u.pn * 256 + 128 * b + 32 * wc + col) * (unsigned)ldb + fq * 8; }
    for (int k = 0; k < K; k += 32) {
        bf16x8 bfr[2][2];
#pragma unroll
        for (int b = 0; b < 2; ++b)
#pragma unroll
            for (int n = 0; n < 2; ++n) bfr[b][n] = *(const bf16x8*)(Bt + (bp[b][n] + k));
#pragma unroll
        for (int a = 0; a < 2; ++a) {
            bf16x8 af[4];
#pragma unroll
            for (int m = 0; m < 4; ++m) af[m] = *(const bf16x8*)(A + (ap[a][m] + k));
#pragma unroll
            for (int b = 0; b < 2; ++b)
#pragma unroll
                for (int m = 0; m < 4; ++m)
#pragma unroll
                    for (int n = 0; n < 2; ++n) acc[a][b][m][n] = __builtin_amdgcn_mfma_f32_16x16x32_bf16(bfr[b][n], af[m], acc[a][b][m][n], 0, 0, 0);
        }
    }
    E(acc, u, wr, wc, fr, fq);
}

struct RowIdent { __device__ __forceinline__ int operator()(const Unit& u, int R) const { return u.pm * 256 + R; } };
struct RowStackK { int rows; __device__ __forceinline__ int operator()(const Unit& u, int R) const { return u.e * rows + u.pm * 256 + R; } };
struct RowGather { const int* list; const unsigned* cnt; __device__ __forceinline__ int operator()(const Unit& u, int R) const {
    const int idx = u.aux * 256 + R; const int* l = list + (size_t)u.e * T; return idx < (int)cnt[u.e] ? l[idx] : l[0]; } };


namespace pg8 {
constexpr int BM = 256, BK = 64, HALF = 128, HTB = HALF * BK * 2, STAGE_BYTES = 8 * HTB;
__host__ __device__ __forceinline__ int lds_byte(int r, int c) { const int st = (r >> 4) * 2 + (c >> 5), rr = r & 15, cc = c & 31, ob = rr * 64 + cc * 2; return st * 1024 + (ob ^ (((ob >> 9) & 1) << 5)); }
__host__ __device__ __forceinline__ void stage_rc(int b, int& R, int& C) { const int st = b / 1024, sb = b % 1024, swz = sb ^ (((sb >> 9) & 1) << 5); R = (st >> 1) * 16 + swz / 64; C = (st & 1) * 32 + (swz % 64) / 2; }
struct Gemm { const bf16_t* A; const bf16_t* Bt; int K; };

template <class Epi, class Sched, bool GATHER>
__device__ __forceinline__ void gemm_phase(int tid, LAS unsigned char* lds, const Gemm g, const Sched& S, const Epi& E) {
    const int wid = __builtin_amdgcn_readfirstlane(tid >> 6), lane = tid & 63, wr = wid >> 2, wc = wid & 3, fr = lane & 15, fq = lane >> 4;
    const int K = g.K, nt = K / BK;
    int RA[2], CA[2]; unsigned voffB[2];
    unsigned vA[2][2], vAn[2][2];
#pragma unroll
    for (int i = 0; i < 2; ++i) { int R, C; stage_rc(tid * 16 + i * 8192, R, C); RA[i] = R; CA[i] = C; const int Rb = Epi::PERM ? ((R & ~31) + perm32(R & 31)) : R; voffB[i] = (unsigned)(Rb * K + C) * 2u; }
    const size_t kstep = (size_t)(BK * 2);
    const size_t hstep = (size_t)HALF * K * 2;
    const size_t tstep = 2 * hstep;
    const unsigned ldsw = (unsigned)wid * 1024u;
    const int aoff = lds_byte(wr * 64 + fr, fq * 8), boff = lds_byte(wc * 32 + fr, fq * 8);
#define PG8_SA(b, h) (((b) * 2 + (h)) * HTB)
#define PG8_SB(b, h) ((4 + (b) * 2 + (h)) * HTB)
#define PG8_STAGE(bufoff, gbase, voff) do { _Pragma("unroll") for (int _i = 0; _i < 2; ++_i) \
        __builtin_amdgcn_global_load_lds((const unsigned*)((const char*)(gbase) + (voff)[_i]), (LAS unsigned*)(lds + (bufoff) + ldsw + _i * 8192), 16, 0, 0); } while (0)
#define PG8_STAGE2(bufoff, gbase, v0, v1) do { \
        __builtin_amdgcn_global_load_lds((const unsigned*)((const char*)(gbase) + (v0)), (LAS unsigned*)(lds + (bufoff) + ldsw), 16, 0, 0); \
        __builtin_amdgcn_global_load_lds((const unsigned*)((const char*)(gbase) + (v1)), (LAS unsigned*)(lds + (bufoff) + ldsw + 8192), 16, 0, 0); } while (0)
#define PG8_LDA(dst, b, h) do { _Pragma("unroll") for (int m = 0; m < 4; ++m) _Pragma("unroll") for (int k = 0; k < 2; ++k) dst[m][k] = *(const LAS bf16x8*)(lds + PG8_SA(b, h) + aoff + m * 2048 + k * 1024); } while (0)
#define PG8_LDB(dst, b, h) do { _Pragma("unroll") for (int n = 0; n < 2; ++n) _Pragma("unroll") for (int k = 0; k < 2; ++k) dst[n][k] = *(const LAS bf16x8*)(lds + PG8_SB(b, h) + boff + n * 2048 + k * 1024); } while (0)
#define PG8_MMA(ai, bj, At, Bt) do { __builtin_amdgcn_s_setprio(1); _Pragma("unroll") for (int m = 0; m < 4; ++m) _Pragma("unroll") for (int n = 0; n < 2; ++n) _Pragma("unroll") for (int k = 0; k < 2; ++k) \
        acc[ai][bj][m][n] = __builtin_amdgcn_mfma_f32_16x16x32_bf16(Bt[n][k], At[m][k], acc[ai][bj][m][n], 0, 0, 0); __builtin_amdgcn_s_setprio(0); } while (0)
#define PG8_WAIT_V(n) asm volatile("s_waitcnt vmcnt(" #n ")" ::: "memory")
#define PG8_WAIT_L(n) asm volatile("s_waitcnt lgkmcnt(" #n ")" ::: "memory")
#define PG8_BAR __builtin_amdgcn_s_barrier()
#define PG8_SCHED __builtin_amdgcn_sched_barrier(0)
#define PG8_AOFFS(dst, unit) do { _Pragma("unroll") for (int _h = 0; _h < 2; ++_h) _Pragma("unroll") for (int _i = 0; _i < 2; ++_i) \
        dst[_h][_i] = GATHER ? ((unsigned)S.arow(unit, _h * HALF + RA[_i]) * (unsigned)K + (unsigned)CA[_i]) * 2u : ((unsigned)(_h * HALF + RA[_i]) * (unsigned)K + (unsigned)CA[_i]) * 2u; } while (0)
    Unit cur{0, 0, 0, 0}, nxt{0, 0, 0, 0}; int ui = 0;
    if (!S.next(0, cur)) return;
    f32x4 acc[2][2][4][2];
#pragma unroll
    for (int a = 0; a < 2; ++a)
#pragma unroll
        for (int b = 0; b < 2; ++b)
#pragma unroll
            for (int m = 0; m < 4; ++m)
#pragma unroll
                for (int n = 0; n < 2; ++n) acc[a][b][m][n] = (f32x4){0.f, 0.f, 0.f, 0.f};
    bf16x8 At[4][2], B0[2][2], B1[2][2];
    const char* cA = GATHER ? (const char*)g.A : (const char*)g.A + (size_t)cur.pm * tstep; const char* cB = (const char*)g.Bt + (size_t)cur.pn * tstep;
    PG8_AOFFS(vA, cur);
    PG8_STAGE(PG8_SB(0, 0), cB, voffB); PG8_STAGE(PG8_SB(0, 1), cB + hstep, voffB); PG8_STAGE2(PG8_SA(0, 0), cA, vA[0][0], vA[0][1]); PG8_STAGE2(PG8_SA(0, 1), cA, vA[1][0], vA[1][1]);
    if (wr == 1) PG8_BAR;
    PG8_WAIT_V(2); PG8_BAR;
    PG8_STAGE(PG8_SB(1, 0), cB + kstep, voffB); PG8_STAGE2(PG8_SA(1, 0), cA + kstep, vA[0][0], vA[0][1]); PG8_STAGE(PG8_SB(1, 1), cB + hstep + kstep, voffB);
    PG8_WAIT_V(6); PG8_BAR;
    for (;;) {
        const bool has_next = S.next(ui + 1, nxt);
        const char* nA = GATHER ? (const char*)g.A : (has_next ? (const char*)g.A + (size_t)nxt.pm * tstep : cA); const char* nB = has_next ? (const char*)g.Bt + (size_t)nxt.pn * tstep : cB;
        if (GATHER && has_next) { PG8_AOFFS(vAn, nxt); } else {
#pragma unroll
            for (int _h = 0; _h < 2; ++_h)
#pragma unroll
                for (int _i = 0; _i < 2; ++_i) vAn[_h][_i] = vA[_h][_i]; }
#pragma unroll 1
        for (int t = 0; t < nt; t += 2) {
            const bool last = (t == nt - 2);
            const char* a1 = cA + (size_t)(t + 1) * kstep;
            const char* a2 = last ? nA : cA + (size_t)(t + 2) * kstep; const char* b2 = last ? nB : cB + (size_t)(t + 2) * kstep;
            const char* a3 = a2 + kstep; const char* b3 = b2 + kstep;
            const unsigned x00 = (GATHER && last) ? vAn[0][0] : vA[0][0], x01 = (GATHER && last) ? vAn[0][1] : vA[0][1], x10 = (GATHER && last) ? vAn[1][0] : vA[1][0], x11 = (GATHER && last) ? vAn[1][1] : vA[1][1];
            PG8_LDB(B0, 0, 0); PG8_LDB(B1, 0, 1); PG8_SCHED; PG8_LDA(At, 0, 0); PG8_STAGE2(PG8_SA(1, 1), a1, vA[1][0], vA[1][1]);
            PG8_WAIT_V(8); PG8_WAIT_L(0); PG8_BAR; PG8_MMA(0, 0, At, B0); PG8_MMA(0, 1, At, B1); PG8_BAR; PG8_SCHED;
            PG8_LDA(At, 0, 1); PG8_STAGE(PG8_SB(0, 0), b2, voffB); PG8_STAGE(PG8_SB(0, 1), b2 + hstep, voffB); PG8_STAGE2(PG8_SA(0, 0), a2, x00, x01);
            PG8_WAIT_V(8); PG8_WAIT_L(0); PG8_BAR; PG8_MMA(1, 0, At, B0); PG8_MMA(1, 1, At, B1); PG8_BAR; PG8_SCHED;
            PG8_LDB(B0, 1, 0); PG8_LDB(B1, 1, 1); PG8_SCHED; PG8_LDA(At, 1, 0); PG8_STAGE2(PG8_SA(0, 1), a2, x10, x11);
            PG8_WAIT_V(8); PG8_WAIT_L(0); PG8_BAR; PG8_MMA(0, 0, At, B0); PG8_MMA(0, 1, At, B1); PG8_BAR; PG8_SCHED;
            PG8_LDA(At, 1, 1); PG8_STAGE(PG8_SB(1, 0), b3, voffB); PG8_STAGE(PG8_SB(1, 1), b3 + hstep, voffB); PG8_STAGE2(PG8_SA(1, 0), a3, x00, x01);
            PG8_WAIT_V(8); PG8_WAIT_L(0); PG8_BAR; PG8_MMA(1, 0, At, B0); PG8_MMA(1, 1, At, B1); PG8_BAR; PG8_SCHED;
        }
        if (wr == 0) PG8_BAR;
        E(acc, cur, wr, wc, fr, fq);
        if (!has_next) break;
#pragma unroll
        for (int a = 0; a < 2; ++a)
#pragma unroll
            for (int b = 0; b < 2; ++b)
#pragma unroll
                for (int m = 0; m < 4; ++m)
#pragma unroll
                    for (int n = 0; n < 2; ++n) acc[a][b][m][n] = (f32x4){0.f, 0.f, 0.f, 0.f};
        cur = nxt; cA = nA; cB = nB; ++ui;
        if (GATHER) {
#pragma unroll
        for (int _h = 0; _h < 2; ++_h)
#pragma unroll
            for (int _i = 0; _i < 2; ++_i) vA[_h][_i] = vAn[_h][_i]; }
        if (wr == 1) PG8_BAR;
    }
    PG8_WAIT_V(0);
    PG8_BAR;
#undef PG8_SA
#undef PG8_SB
#undef PG8_STAGE
#undef PG8_STAGE2
#undef PG8_LDA
#undef PG8_LDB
#undef PG8_MMA
#undef PG8_WAIT_V
#undef PG8_WAIT_L
#undef PG8_BAR
#undef PG8_SCHED
#undef PG8_AOFFS
}
}

struct XOrder { int G, c, MT, NT;
    __device__ __forceinline__ bool map(int i, int& pm, int& pn) const {
        if ((G & 7) == 0 && (MT & 7) == 0) { const int x = c & 7, r = c >> 3, W = G >> 3, MX = MT >> 3; const int L = i * W + r; if (L >= MX * NT) return false; pm = x * MX + L / NT; pn = L % NT; return true; }
        const int L = i * G + c; if (L >= MT * NT) return false; pm = L / NT; pn = L % NT; return true; } };
struct SchedG1 { XOrder X; __device__ __forceinline__ bool next(int i, Unit& u) const { int pm, pn; if (!X.map(i, pm, pn)) return false; u.pm = pm; u.pn = pn; u.e = 0; u.aux = 0; return true; }
    __device__ __forceinline__ int arow(const Unit&, int) const { return 0; } };
struct SchedG2 { XOrder X; __device__ __forceinline__ bool next(int i, Unit& u) const { int pm, q; if (!X.map(i, pm, q)) return false; const int k = q >> 2, pnn = q & 3;
        u.pm = k * (T / 256) + pm; u.pn = k * 4 + pnn; u.e = k; u.aux = pnn; return true; }
    __device__ __forceinline__ int arow(const Unit&, int) const { return 0; } };
struct SchedMN { XOrder X; __device__ __forceinline__ bool next(int i, Unit& u) const { int pm, pn; if (!X.map(i, pm, pn)) return false; u.pm = pm; u.pn = pn; u.e = 0; u.aux = 0; return true; }
    __device__ __forceinline__ int arow(const Unit&, int) const { return 0; } };

struct EpiBf16Plain {
    static constexpr bool PERM = true;
    bf16_t* O; int ldc; int coltile_mask;
    __device__ __forceinline__ void operator()(const f32x4 (&acc)[2][2][4][2], const Unit& u, int wr, int wc, int fr, int fq) const {
        const int row0 = u.pm * 256 + wr * 64 + fr, col0 = (u.pn & coltile_mask) * 256 + wc * 32 + 8 * fq;
#pragma unroll
        for (int ai = 0; ai < 2; ++ai)
#pragma unroll
            for (int m = 0; m < 4; ++m) { bf16_t* rowp = O + ((unsigned)(row0 + ai * 128 + m * 16) * (unsigned)ldc + (unsigned)col0);
#pragma unroll
                for (int bj = 0; bj < 2; ++bj) { const f32x4 v0 = acc[ai][bj][m][0], v1 = acc[ai][bj][m][1];
                    u32x4 w; w.x = pack2(v0[0], v0[1]); w.y = pack2(v0[2], v0[3]); w.z = pack2(v1[0], v1[1]); w.w = pack2(v1[2], v1[3]);
                    *(u32x4*)(rowp + bj * 128) = w; } }
    }
};
struct EpiP {
    static constexpr bool PERM = true;
    bf16_t* P; const float* ssq;
    __device__ __forceinline__ void operator()(const f32x4 (&acc)[2][2][4][2], const Unit& u, int wr, int wc, int fr, int fq) const {
        const int k = u.e; const int pmt = u.pm - k * (T / 256);
        const unsigned c00 = (unsigned)(u.aux * 256 + wc * 32 + 8 * fq);
        const unsigned base = (unsigned)pmt * (16u * 256u * 256u) + (unsigned)k * 16384u;
        float scv[8];
#pragma unroll
        for (int i = 0; i < 8; ++i) scv[i] = 1.0f;
        if (k == 3) {
            f32x4 qv[8];
#pragma unroll
            for (int i = 0; i < 8; ++i) qv[i] = *(const f32x4*)(ssq + (unsigned)(pmt * 256 + (i >> 2) * 128 + wr * 64 + (i & 3) * 16 + fr) * 4u);
#pragma unroll
            for (int i = 0; i < 8; ++i) scv[i] = rsqrtf((qv[i][0] + qv[i][1] + qv[i][2] + qv[i][3]) * (1.0f / 256.0f) + kconst(RMS_EPS));
        }
#pragma unroll
        for (int ai = 0; ai < 2; ++ai)
#pragma unroll
            for (int m = 0; m < 4; ++m) { const int r = ai * 128 + wr * 64 + m * 16 + fr; const float sc = scv[ai * 4 + m];
#pragma unroll
                for (int bj = 0; bj < 2; ++bj) { const unsigned c0 = c00 + bj * 128; const unsigned s = c0 >> 6, wi = c0 & 63;
                    const f32x4 v0 = acc[ai][bj][m][0] * sc, v1 = acc[ai][bj][m][1] * sc;
                    u32x4 w; w.x = pack2(v0[0], v0[1]); w.y = pack2(v0[2], v0[3]); w.z = pack2(v1[0], v1[1]); w.w = pack2(v1[2], v1[3]);
                    __builtin_nontemporal_store(w, (u32x4*)(P + (base + s * 65536u + (wi >> 4) * 4096u + (unsigned)r * 16u + (wi & 15u)))); }
                asm volatile("" ::: "memory"); }
    }
};
struct EpiMerge {
    static constexpr bool PERM = false;
    const bf16_t* P; const float* bgp; bf16_t* Y;
    __device__ __forceinline__ void operator()(const f32x4 (&acc)[2][2][4][2], const Unit& u, int wr, int wc, int fr, int fq) const {
        const int s = u.pn;
        f32x4 bv[2][2];
#pragma unroll
        for (int bj = 0; bj < 2; ++bj)
#pragma unroll
            for (int n = 0; n < 2; ++n) bv[bj][n] = *(const f32x4*)(bgp + s * 256 + bj * 128 + wc * 32 + n * 16 + 4 * fq);
        const bf16_t* pb = P + (((unsigned)u.pm * 16u + (unsigned)s) * 65536u + (unsigned)(wc * 4096 + (wr * 64 + fr) * 16 + 4 * fq));
        u32x2 pw[2][4][4];
#pragma unroll
        for (int ai = 0; ai < 2; ++ai)
#pragma unroll
            for (int k = 0; k < 4; ++k)
#pragma unroll
                for (int m = 0; m < 4; ++m) pw[ai][m][k] = *(const u32x2*)(pb + (ai * 2048 + k * 16384 + m * 256));
        __builtin_amdgcn_sched_barrier(0);
#pragma unroll
        for (int ai = 0; ai < 2; ++ai)
#pragma unroll
            for (int m = 0; m < 4; ++m) { const int r = ai * 128 + wr * 64 + m * 16 + fr;
                f32x4 y = (f32x4){0.f, 0.f, 0.f, 0.f};
#pragma unroll
                for (int bj = 0; bj < 2; ++bj)
#pragma unroll
                    for (int n = 0; n < 2; ++n) { const int k = 2 * bj + n; const u32x2 pq = pw[ai][m][k];
                        const f32x4 g = acc[ai][bj][m][n] + bv[bj][n];
                        f32x4 sg; sg[0] = __builtin_amdgcn_exp2f(g[0]); sg[1] = __builtin_amdgcn_exp2f(g[1]); sg[2] = __builtin_amdgcn_exp2f(g[2]); sg[3] = __builtin_amdgcn_exp2f(g[3]);
                        sg = sg + 1.0f; sg[0] = __builtin_amdgcn_rcpf(sg[0]); sg[1] = __builtin_amdgcn_rcpf(sg[1]); sg[2] = __builtin_amdgcn_rcpf(sg[2]); sg[3] = __builtin_amdgcn_rcpf(sg[3]);
                        const f32x4 pv = (f32x4){__uint_as_float(pq.x << 16), __uint_as_float(pq.x & 0xffff0000u), __uint_as_float(pq.y << 16), __uint_as_float(pq.y & 0xffff0000u)};
                        y += sg * pv; }
                u32x2 w; w.x = pack2(y[0], y[1]); w.y = pack2(y[2], y[3]);
                *(u32x2*)(Y + ((unsigned)(u.pm * 256 + r) * (unsigned)D + (unsigned)(s * 64 + wc * 16 + 4 * fq))) = w; }
    }
};
template <bool FIRST>
struct EpiWo {
    static constexpr bool PREFETCH = false; __device__ __forceinline__ void prefetch(const Unit&, int, LAS unsigned char*) const {}
    static constexpr bool PERM = true;
    Ptrs P; int layer; const float* xin; const float* cin;
    __device__ __forceinline__ void operator()(const f32x4 (&acc)[2][2][4][2], const Unit& u, int wr, int wc, int fr, int fq) const {
        const int col0 = u.pn * 256 + wc * 32 + 8 * fq;
        f32x4 om[2][2];
        if (FIRST) {
#pragma unroll
            for (int bj = 0; bj < 2; ++bj)
#pragma unroll
                for (int n = 0; n < 2; ++n)
#pragma unroll
                    for (int e = 0; e < 4; ++e) om[bj][n][e] = fexp(-9.210340371976184f * (float)(wc * 32 + 8 * fq + bj * 128 + 4 * n + e) * (1.0f / 256.0f)) * 0.15915494309189535f;
        }
#pragma unroll
        for (int ai = 0; ai < 2; ++ai)
#pragma unroll
            for (int m = 0; m < 4; ++m) { const int row = u.pm * 256 + ai * 128 + wr * 64 + m * 16 + fr;
                bf16_t* dp = P.r1row(layer, row) + col0; const float* g1 = P.mod(layer, row_modidx(row)) + 2048 + col0;
                const bf16_t* sp = P.s0row(row) + col0; const float* xp = xin; float pv = 0.f; const bool islat = row < NLAT;
                if (FIRST) { xp = (islat ? xin + (size_t)row * D : cin + (size_t)(row - NLAT) * D) + col0; const int t = row & 4095; pv = (float)((u.pn >> 1) ? (t & 63) : (t >> 6)); }
#pragma unroll
                for (int bj = 0; bj < 2; ++bj) { f32x4 x[2];
                    if (FIRST) { x[0] = *(const f32x4*)(xp + bj * 128); x[1] = *(const f32x4*)(xp + bj * 128 + 4);
#pragma unroll
                        for (int n = 0; n < 2; ++n)
#pragma unroll
                            for (int e = 0; e < 4; ++e) { const float rv = pv * om[bj][n][e]; const float pe = (u.pn & 1) ? __builtin_amdgcn_cosf(rv) : __builtin_amdgcn_sinf(rv); x[n][e] += islat ? pe : 0.f; } }
                    else { const u32x4 w = *(const u32x4*)(sp + bj * 128);
                        x[0] = (f32x4){__uint_as_float(w.x << 16), __uint_as_float(w.x & 0xffff0000u), __uint_as_float(w.y << 16), __uint_as_float(w.y & 0xffff0000u)};
                        x[1] = (f32x4){__uint_as_float(w.z << 16), __uint_as_float(w.z & 0xffff0000u), __uint_as_float(w.w << 16), __uint_as_float(w.w & 0xffff0000u)}; }
                    const f32x4 g0 = *(const f32x4*)(g1 + bj * 128), g1v = *(const f32x4*)(g1 + bj * 128 + 4);
                    const f32x4 y0 = x[0] * ALPHA + g0 * acc[ai][bj][m][0], y1 = x[1] * ALPHA + g1v * acc[ai][bj][m][1];
                    u32x4 o; o.x = pack2(y0[0], y0[1]); o.y = pack2(y0[2], y0[3]); o.z = pack2(y1[0], y1[1]); o.w = pack2(y1[2], y1[3]);
                    *(u32x4*)(dp + bj * 128) = o; } }
    }
};
struct EpiFfn1 {
    static constexpr bool PERM = false;
    bf16_t* H;
    __device__ __forceinline__ void operator()(const f32x4 (&acc)[2][2][4][2], const Unit& u, int wr, int wc, int fr, int fq) const {
        const int pnn = u.pn & 3;
#pragma unroll
        for (int ai = 0; ai < 2; ++ai)
#pragma unroll
            for (int m = 0; m < 4; ++m) { const int pos = u.pm * 256 + ai * 128 + wr * 64 + m * 16 + fr;
#pragma unroll
                for (int bj = 0; bj < 2; ++bj) { const f32x4 a = acc[ai][bj][m][0], b = acc[ai][bj][m][1];
                    u32x2 w; w.x = pack2(siluf_(a[0]) * b[0], siluf_(a[1]) * b[1]); w.y = pack2(siluf_(a[2]) * b[2], siluf_(a[3]) * b[3]);
                    *(u32x2*)(H + ((unsigned)pos * 512u + (unsigned)(pnn * 128 + bj * 64 + wc * 16 + 4 * fq))) = w; } }
    }
};

template <class SrcFn>
__device__ __forceinline__ void conv_tile(int tid, LAS float* tile  , bf16_t* dst, int ldd, int n0, int k0, const SrcFn& src, const float scale = 1.0f) {
    f32x4 v[8];
#pragma unroll
    for (int i = 0; i < 8; ++i) { const int kk = (tid >> 4) + 32 * i, j4 = tid & 15; v[i] = *(const f32x4*)src(k0 + kk, n0 + 4 * j4); }
#pragma unroll
    for (int i = 0; i < 8; ++i) { const int kk = (tid >> 4) + 32 * i, j4 = tid & 15; LAS float* t = tile + kk * 65 + 4 * j4; t[0] = v[i][0]; t[1] = v[i][1]; t[2] = v[i][2]; t[3] = v[i][3]; }
    __syncthreads();
    { const int jj = tid >> 3, kq = tid & 7;
#pragma unroll
      for (int kb = 0; kb < 4; ++kb) { float x[8];
#pragma unroll
          for (int i = 0; i < 8; ++i) x[i] = tile[(64 * kb + 8 * kq + i) * 65 + jj] * scale;
          u32x4 w; w.x = pack2(x[0], x[1]); w.y = pack2(x[2], x[3]); w.z = pack2(x[4], x[5]); w.w = pack2(x[6], x[7]);
          *(u32x4*)(dst + (size_t)(n0 + jj) * ldd + k0 + 64 * kb + 8 * kq) = w; } }
    __syncthreads();
}
constexpr int NCONV_NE = 56 * 4 + 64 * 4 + 64 * 1 + 16 * 4;
constexpr int NCONV_EX = NE * (16 * 4 + 16 * 2);
__device__ __forceinline__ int gate_srccol(int np) { const int s = np >> 8, bj = (np >> 7) & 1, wc = (np >> 5) & 3, n = (np >> 4) & 1, fqe = np & 15; return (2 * bj + n) * 1024 + 64 * s + 16 * wc + fqe; }
__device__ __forceinline__ void conv_unit_ne(const Ptrs P, int l, int t, LAS float* tile) {
    unsigned char* ws = P.ws;
    if (t < 224) { const int nt = t >> 2, kt = t & 3; const float* src = P.inp(I_WIN) + (size_t)l * D * INC;
        conv_tile(P.tid, tile, (bf16_t*)(ws + WS_WIN), D, nt * 64, kt * 256, [=](int k, int n) { return src + (size_t)k * INC + n; });
    } else if (t < 224 + 256) { t -= 224; const int nt = t >> 2, kt = t & 3; const float* src = P.inp(I_WGATE) + (size_t)l * D * 4096;
        conv_tile(P.tid, tile, (bf16_t*)(ws + WS_WG), D, nt * 64, kt * 256, [=](int k, int n) { return src + (size_t)k * 4096 + gate_srccol(n); }, -1.4426950408889634f);
        if (kt == 0 && P.tid < 64) { const int np = nt * 64 + P.tid; ((float*)(ws + WS_BGP))[np] = P.inp(I_BGATE)[(size_t)l * 4096 + gate_srccol(np)] * -1.4426950408889634f; }
    } else if (t < 224 + 256 + 64) { t -= 480; const int nt = t; const int kb = nt >> 4;
        const float* src = P.inp(I_WBR) + ((size_t)l * 4 + kb) * 256 * 1024;
        conv_tile(P.tid, tile, (bf16_t*)(ws + WS_WBR), 256, nt * 64, 0, [=](int k, int n) { return src + (size_t)k * 1024 + (n & 1023); });
    } else { t -= 544; const int nt = t >> 2, kt = t & 3; const float* src = P.inp(I_WO) + (size_t)l * D * D;
        conv_tile(P.tid, tile, (bf16_t*)(ws + WS_WO), D, nt * 64, kt * 256, [=](int k, int n) { return src + (size_t)k * D + n; });
    }
}
__device__ __forceinline__ void conv_unit_ex(const Ptrs P, int l, int t, LAS float* tile) {
    unsigned char* ws = P.ws;
    const int e = t / 96; t -= e * 96;
    if (t < 64) { const int nt = t >> 2, kt = t & 3;
        const float* s1 = P.inp(I_WE1) + ((size_t)l * NE + e) * 1024 * 512; const float* s3 = P.inp(I_WE3) + ((size_t)l * NE + e) * 1024 * 512;
        conv_tile(P.tid, tile, (bf16_t*)(ws + WS_BIG + BIG_W13) + (size_t)e * 1024 * 1024, 1024, nt * 64, kt * 256, [=](int k, int n) {
            const int pn = n >> 8, bj = (n >> 7) & 1, wc = (n >> 5) & 3, nn = (n >> 4) & 1, fqe = n & 15; const int ch = 128 * pn + 64 * bj + 16 * wc + fqe;
            return (nn ? s3 : s1) + (size_t)k * 512 + ch; });
    } else { t -= 64; const int nt = t >> 1, kt = t & 1; const float* src = P.inp(I_WE2) + ((size_t)l * NE + e) * 512 * 1024;
        conv_tile(P.tid, tile, (bf16_t*)(ws + WS_BIG + BIG_W2) + (size_t)e * 1024 * 512, 512, nt * 64, kt * 256, [=](int k, int n) { return src + (size_t)k * 1024 + n; });
    }
}

struct ConvEx { Ptrs P; int l; LAS float* tile; __device__ __forceinline__ void operator()(int t) const { conv_unit_ex(P, l, t, tile); } };
struct ConvNe { Ptrs P; int l; LAS float* tile; __device__ __forceinline__ void operator()(int t) const { conv_unit_ne(P, l, t, tile); } };
template <class F>
__device__ __forceinline__ void dyn_tiles(int tid, unsigned* ctr, int n, volatile LAS unsigned* slot, const F& f) {
    const bool t0 = (tid == 0);
    if (t0) slot[0] = __hip_atomic_fetch_add(ctr, 1u, __ATOMIC_RELAXED, __HIP_MEMORY_SCOPE_AGENT);
    __syncthreads();
    unsigned t = (unsigned)__builtin_amdgcn_readfirstlane((int)slot[0]);
    __syncthreads();
    while (t < (unsigned)n) {
        unsigned tn = 0u; if (t0) tn = __hip_atomic_fetch_add(ctr, 1u, __ATOMIC_RELAXED, __HIP_MEMORY_SCOPE_AGENT);
        f((int)t);
        if (t0) slot[0] = tn;
        __syncthreads();
        t = (unsigned)__builtin_amdgcn_readfirstlane((int)slot[0]);
        __syncthreads();
    }
}

struct RowV { f32x4 v[4]; };
__device__ __forceinline__ void row_load(RowV& r, const float* p, int lane) {
#pragma unroll
    for (int i = 0; i < 4; ++i) r.v[i] = *(const f32x4*)(p + i * 256 + lane * 4);
}
__device__ __forceinline__ void row_load_b(RowV& r, const bf16_t* p, int lane) {
#pragma unroll
    for (int i = 0; i < 4; ++i) { const u32x2 w = *(const u32x2*)(p + i * 256 + lane * 4); r.v[i] = (f32x4){__uint_as_float(w.x << 16), __uint_as_float(w.x & 0xffff0000u), __uint_as_float(w.y << 16), __uint_as_float(w.y & 0xffff0000u)}; }
}
__device__ __forceinline__ void row_store(const RowV& r, float* p, int lane) {
#pragma unroll
    for (int i = 0; i < 4; ++i) *(f32x4*)(p + i * 256 + lane * 4) = r.v[i];
}
__device__ __forceinline__ void row_layernorm(RowV& r, const float* g, const float* b, int lane) {
    float s = 0.f;
#pragma unroll
    for (int i = 0; i < 4; ++i) s += r.v[i][0] + r.v[i][1] + r.v[i][2] + r.v[i][3];
    const float mu = wave_sum(s) * (1.0f / 1024.0f);
    float q = 0.f;
#pragma unroll
    for (int i = 0; i < 4; ++i) { const f32x4 d = r.v[i] - mu; q += d[0] * d[0] + d[1] * d[1] + d[2] * d[2] + d[3] * d[3]; }
    const float rstd = rsqrtf(wave_sum(q) * (1.0f / 1024.0f) + kconst(LN_EPS));
#pragma unroll
    for (int i = 0; i < 4; ++i) { const f32x4 gg = *(const f32x4*)(g + i * 256 + lane * 4), bb = *(const f32x4*)(b + i * 256 + lane * 4); r.v[i] = (r.v[i] - mu) * rstd * gg + bb; }
}
__device__ __forceinline__ void row_layernorm_r(RowV& r, const RowV& g, const RowV& b) {
    float s = 0.f;
#pragma unroll
    for (int i = 0; i < 4; ++i) s += r.v[i][0] + r.v[i][1] + r.v[i][2] + r.v[i][3];
    const float mu = wave_sum(s) * (1.0f / 1024.0f);
    float q = 0.f;
#pragma unroll
    for (int i = 0; i < 4; ++i) { const f32x4 d = r.v[i] - mu; q += d[0] * d[0] + d[1] * d[1] + d[2] * d[2] + d[3] * d[3]; }
    const float rstd = rsqrtf(wave_sum(q) * (1.0f / 1024.0f) + kconst(LN_EPS));
#pragma unroll
    for (int i = 0; i < 4; ++i) r.v[i] = (r.v[i] - mu) * rstd * g.v[i] + b.v[i];
}
__device__ __forceinline__ void row_modulate(const RowV& r, RowV& h, const float* sh, const float* sc, int lane) {
#pragma unroll
    for (int i = 0; i < 4; ++i) { const f32x4 a = *(const f32x4*)(sc + i * 256 + lane * 4), b = *(const f32x4*)(sh + i * 256 + lane * 4); h.v[i] = r.v[i] * (a + 1.0f) + b; }
}
__device__ __forceinline__ void row_modulate_r(const RowV& r, RowV& h, const RowV& sh, const RowV& sc) {
#pragma unroll
    for (int i = 0; i < 4; ++i) h.v[i] = r.v[i] * (sc.v[i] + 1.0f) + sh.v[i];
}
__device__ __forceinline__ void row_store_bf16(const RowV& h, bf16_t* p, int lane) {
#pragma unroll
    for (int i = 0; i < 4; ++i) { u32x2 w; w.x = pack2(h.v[i][0], h.v[i][1]); w.y = pack2(h.v[i][2], h.v[i][3]); *(u32x2*)(p + i * 256 + lane * 4) = w; }
}
__device__ __forceinline__ void row_dt(const RowV& h, const LAS float* wdt, float* dtout, int lane) {
    float a[8];
#pragma unroll
    for (int j = 0; j < 8; ++j) a[j] = 0.f;
#pragma unroll
    for (int i = 0; i < 4; ++i)
#pragma unroll
        for (int e = 0; e < 4; ++e) { const int k = i * 256 + lane * 4 + e; const float hv = h.v[i][e];
            const f32x4 w0 = *(const LAS f32x4*)(wdt + k * 8), w1 = *(const LAS f32x4*)(wdt + k * 8 + 4);
            a[0] += hv * w0[0]; a[1] += hv * w0[1]; a[2] += hv * w0[2]; a[3] += hv * w0[3]; a[4] += hv * w1[0]; a[5] += hv * w1[1]; a[6] += hv * w1[2]; a[7] += hv * w1[3]; }
#pragma unroll
    for (int j = 0; j < 8; ++j) a[j] = wave_sum(a[j]);
    if (lane == 0) { *(f32x4*)dtout = (f32x4){a[0], a[1], a[2], a[3]}; *(f32x4*)(dtout + 4) = (f32x4){a[4], a[5], a[6], a[7]}; }
}
__device__ __forceinline__ void load_wdt(const Ptrs P, int l, LAS float* wdt) {
    const float* src = P.inp(I_WIN) + (size_t)l * D * INC + UC;
    for (int i = P.tid; i < 1024 * 8; i += 512) wdt[i] = src[(size_t)(i >> 3) * INC + (i & 7)];
    __syncthreads();
}

__device__ __forceinline__ void phase_pa(const Ptrs P, LAS unsigned char* lds) {
    const int tid = P.tid, wid = tid >> 6, lane = tid & 63, G = P.G;
    const int NU_MOD = 2 * 96, NU_H2 = 8448 / 8, NU_LB = 1;
    const int NU = NU_MOD + NU_H2 + NU_LB + NCONV_NE;
    for (int u = P.bid; u < NU; u += G) {
        if (u < NU_MOD) {
            const int l = u / 96, cb = u % 96;
            LAS float* sc = (LAS float*)lds; LAS float* red = sc + 9 * 1024;
            { const float* cin_ = P.inp(I_C); const float* cctx_ = P.inp(I_CCTX);
              for (int i = tid; i < 9 * 1024; i += 512) { const int r = i >> 10, k = i & 1023; const float v = r < 8 ? cin_[r * 1024 + k] : cctx_[k]; sc[i] = v / (1.0f + fexp(-v)); } }
            __syncthreads();
            const int col = cb * 64 + lane; const float* w = P.inp(I_WADA) + (size_t)l * D * 6144 + col;
            float acc[9];
#pragma unroll
            for (int r = 0; r < 9; ++r) acc[r] = 0.f;
            for (int k = wid * 128; k < wid * 128 + 128; ++k) { const float wv = w[(size_t)k * 6144];
#pragma unroll
                for (int r = 0; r < 9; ++r) acc[r] += sc[r * 1024 + k] * wv; }
#pragma unroll
            for (int r = 0; r < 9; ++r) red[(wid * 9 + r) * 64 + lane] = acc[r];
            __syncthreads();
            const float* bada_ = P.inp(I_BADA);
            for (int i = tid; i < 9 * 64; i += 512) { const int r = i >> 6, c = i & 63; float s = bada_[(size_t)l * 6144 + cb * 64 + c];
#pragma unroll
                for (int w8 = 0; w8 < 8; ++w8) s += red[(w8 * 9 + r) * 64 + c];
                P.mod(l, r)[cb * 64 + c] = s; }
            __syncthreads();
        } else if (u < NU_MOD + NU_H2) {
            const int rho = (u - NU_MOD) * 8 + wid;
            const int l = (rho >= 4096 && rho < 8192) ? 1 : 0; const int L = rho < 8192 ? 4096 : 256; const int i = rho < 8192 ? (rho & 4095) : (rho - 8192);
            float featv = 0.f;
            if (lane == 0) featv = (float)((double)i / (double)(L - 1));
            else if (lane < 33) { const int j = (lane - 1) & 15; const double band = 1e-4 + (double)j * ((15.0 - 1e-4) / 15.0);
                const double ang = (2.0 * 3.14159265358979323846 / (double)L) * (double)i * band; featv = lane < 17 ? (float)cos(ang) : (float)(-sin(ang)); }
            const float* hw1_ = P.inp(I_HYW1); const float* hw2_ = P.inp(I_HYW2);
            float z1 = P.inp(I_HYB1)[l * 64 + lane];
            for (int m = 0; m < 33; ++m) z1 += __shfl(featv, m) * hw1_[((size_t)l * 33 + m) * 64 + lane];
            const float h1 = sinf(P.inp(I_HYF1)[l * 64 + lane] * z1);
            float z2 = P.inp(I_HYB2)[l * 64 + lane];
            for (int m = 0; m < 64; ++m) z2 += __shfl(h1, m) * hw2_[((size_t)l * 64 + m) * 64 + lane];
            ((float*)(P.ws + WS_H2TAB))[(size_t)rho * 64 + lane] = sinf(P.inp(I_HYF2)[l * 64 + lane] * z2);
        } else if (u < NU_MOD + NU_H2 + NU_LB) {
            for (int i = tid; i < 4096; i += 512) { const double a = -2.0 * 3.14159265358979323846 * (double)i / 8192.0; ((float*)(P.ws + WS_TW))[2 * i] = (float)cos(a); ((float*)(P.ws + WS_TW))[2 * i + 1] = (float)sin(a); }
            for (int i = tid; i < 1024; i += 512) { const int d = i >> 9, l = (i >> 8) & 1, c = i & 255;
                const float l0 = P.inp(I_HGLB)[d * 512 + c], l1 = P.inp(I_HGLB)[d * 512 + 256 + c];
                ((float*)(P.ws + WS_LB))[i] = l == 0 ? 0.0f : 1.0f / (1.0f + fexp(l0 - l1)); }
        } else {
            conv_unit_ne(P, 0, u - (NU_MOD + NU_H2 + NU_LB), (LAS float*)lds);
        }
    }
}

__device__ __forceinline__ void emit_rows_init(const Ptrs P, LAS float* wdt);
__device__ __forceinline__ void phase_pb(const Ptrs P, LAS unsigned char* lds) {
    const int tid = P.tid, G = P.G;
    for (int u = P.bid; u < 132; u += G) {
        const int tab = u < 64 ? 0 : (u < 128 ? 1 : 2); const int ib = tab == 0 ? u : (tab == 1 ? u - 64 : u - 128);
        const int l = tab == 1 ? 1 : 0; const int L = tab == 2 ? 256 : 4096; const int rho0 = (tab == 0 ? 0 : (tab == 1 ? 4096 : 8192)) + ib * 64;
        LAS float* h2 = (LAS float*)lds;
        for (int i = tid; i < 64 * 64; i += 512) h2[i] = ((const float*)(P.ws + WS_H2TAB))[(size_t)rho0 * 64 + i];
        __syncthreads();
        const int o = tid, c = tid & 255, dir = tid >> 8;
        float w3[64]; const float* hw3_ = P.inp(I_HYW3);
#pragma unroll
        for (int j = 0; j < 64; ++j) w3[j] = hw3_[((size_t)l * 64 + j) * 512 + o];
        const float dec = fabsf(P.inp(I_HYDEC)[l * 256 + c]);
        float* filt = tab == 2 ? (float*)(P.ws + WS_FILTC) : (float*)(P.ws + WS_FILT) + (size_t)l * 8192 * 256;
        const int L2 = 2 * L; float part = 0.f;
        for (int r = 0; r < 64; ++r) { const int i = ib * 64 + r; float s = 0.f;
#pragma unroll
            for (int j = 0; j < 64; ++j) s += h2[r * 64 + j] * w3[j];
            const float t = (float)i / (float)(L - 1); s *= fexp(-t * dec);
            if (dir == 0) { filt[(size_t)i * 256 + c] = s; part += fabsf(s); }
            else if (i == 0) filt[(size_t)L * 256 + c] = 0.f;
            else { filt[(size_t)(L2 - i) * 256 + c] = s; part += fabsf(s); } }
        ((float*)(P.ws + WS_PART))[((size_t)tab * 64 + ib) * 512 + o] = part;
        __syncthreads();
    }
    emit_rows_init(P, (LAS float*)lds);
}
__device__ __forceinline__ float hy_norm(const Ptrs P, int tab, int c) {
    const float* part = (const float*)(P.ws + WS_PART) + (size_t)tab * 64 * 512; const int nb = tab == 2 ? 4 : 64; float s = 0.f;
    for (int b = 0; b < nb; ++b) s += part[b * 512 + c] + part[b * 512 + 256 + c];
    return s;
}

__device__ __forceinline__ void emit_rows_init(const Ptrs P, LAS float* wdt) {
    const int tid = P.tid, wid = tid >> 6, lane = tid & 63, G = P.G;
    load_wdt(P, 0, wdt);
    LAS float* tabA = wdt + 1024 * 8; LAS float* tabB = tabA + 8 * 256 * 2;
    for (int i = tid; i < 2 * 8 * 256; i += 512) { const int tb = i >> 11, a = (i >> 8) & 7, ii = i & 255; const float om = fexp(-9.210340371976184f * (float)ii * (1.0f / 256.0f)); const float ang = (float)(tb ? a : 8 * a) * om;
        LAS float* t = (tb ? tabB : tabA) + (a * 256 + ii) * 2; t[0] = sinf(ang); t[1] = cosf(ang); }
    __syncthreads();
    const float* xin = P.inp(I_X); const float* cin = P.inp(I_CTX);
    RowV msh, msc; { const float z = zero_f(); for (int i = 0; i < 4; ++i) { msh.v[i] = (f32x4){z, z, z, z}; msc.v[i] = msh.v[i]; } } int mcur = -1;
    RowV rn; { const float z = zero_f(); for (int i = 0; i < 4; ++i) rn.v[i] = (f32x4){z, z, z, z}; } if (P.bid < T / 8) { const int rw = P.bid * 8 + wid; row_load(rn, rw < NLAT ? xin + (size_t)rw * D : cin + (size_t)(rw - NLAT) * D, lane); }
    for (int u = P.bid; u < T / 8; u += G) {
        const int row = u * 8 + wid; RowV r = rn;
        if (u + G < T / 8) { const int rw = (u + G) * 8 + wid; row_load(rn, rw < NLAT ? xin + (size_t)rw * D : cin + (size_t)(rw - NLAT) * D, lane); }
        if (row < NLAT) {
            const int t = row & 4095; const int prow = t >> 6, pcol = t & 63;
#pragma unroll
            for (int hf = 0; hf < 2; ++hf) { const int pos = hf ? pcol : prow; const LAS float* pa = tabA + ((pos >> 3) * 256 + lane * 4) * 2; const LAS float* pb = tabB + ((pos & 7) * 256 + lane * 4) * 2;
                const f32x4 a0 = *(const LAS f32x4*)pa, a1 = *(const LAS f32x4*)(pa + 4), b0 = *(const LAS f32x4*)pb, b1 = *(const LAS f32x4*)(pb + 4);
                f32x4 sn, cs;
                sn[0] = a0[0] * b0[1] + a0[1] * b0[0]; cs[0] = a0[1] * b0[1] - a0[0] * b0[0]; sn[1] = a0[2] * b0[3] + a0[3] * b0[2]; cs[1] = a0[3] * b0[3] - a0[2] * b0[2];
                sn[2] = a1[0] * b1[1] + a1[1] * b1[0]; cs[2] = a1[1] * b1[1] - a1[0] * b1[0]; sn[3] = a1[2] * b1[3] + a1[3] * b1[2]; cs[3] = a1[3] * b1[3] - a1[2] * b1[2];
                r.v[2 * hf] += sn; r.v[2 * hf + 1] += cs; }
        }
        const int mi = row_modidx(row); if (mi != mcur) { mcur = mi; const float* m = P.mod(0, mi); row_load(msh, m, lane); row_load(msc, m + 1024, lane); }
        RowV h; row_modulate_r(r, h, msh, msc);
        row_store_bf16(h, (bf16_t*)(P.ws + WS_HBUF) + (size_t)row * D, lane);
        row_dt(h, wdt, (float*)(P.ws + WS_DT) + (size_t)row * 8, lane);
    }
}

__device__ __forceinline__ void phase_g1(const Ptrs P, LAS unsigned char* lds) {
    pg8::Gemm g{(const bf16_t*)(P.ws + WS_HBUF), (const bf16_t*)(P.ws + WS_WIN), D};
    EpiBf16Plain E{(bf16_t*)(P.ws + WS_BIG + BIG_U), UC, 0xffff};
    SchedG1 S{XOrder{P.G, P.bid, T / 256, 14}};
    pg8::gemm_phase<EpiBf16Plain, SchedG1, false>(P.tid, lds, g, S, E);
}

constexpr int NCHK = 34;
__device__ __forceinline__ int chunk_row0(int b, int pc) { return pc < 2 ? NLAT + b * CTXL + pc * 128 : b * SEQ + (pc - 2) * 128; }
__device__ __forceinline__ int chunk_at(int dir, int q) { return dir == 0 ? q : (q < 2 ? 1 - q : 35 - q); }
__device__ __forceinline__ int sidx(int kind, int b, int h, int dir, int pc) { return (((kind * 8 + b) * 4 + h) * 2 + dir) * NCHK + pc; }
__device__ __forceinline__ bf16x8 pack8(const float (&v)[8]) { u32x4 w; w.x = pack2(v[0], v[1]); w.y = pack2(v[2], v[3]); w.z = pack2(v[4], v[5]); w.w = pack2(v[6], v[7]); return __builtin_bit_cast(bf16x8, w); }
__device__ __forceinline__ float softplusf_(float x) { return x > 20.f ? x : flog(1.0f + fexp(x)); }
__device__ __forceinline__ float wave_incl_scan(float v, int lane) {
#pragma unroll
    for (int d = 1; d < 64; d <<= 1) { const float t = __shfl_up(v, d); if (lane >= d) v += t; }
    return v;
}

template <bool SILU>
__device__ __forceinline__ void conv3_8(const bf16_t* U, int row, int col0, const float* w, int ncol, int wcol0, const float* bias, float (&out)[8]) {
    const bool hp = row_has_prev(row), hn = row_has_next(row);
    const bf16x8 c = *(const bf16x8*)(U + (size_t)row * UC + col0);
    const bf16x8 p = *(const bf16x8*)(U + (size_t)(hp ? row - 1 : row) * UC + col0), n = *(const bf16x8*)(U + (size_t)(hn ? row + 1 : row) * UC + col0);
    const float mp = hp ? 1.0f : 0.0f, mn = hn ? 1.0f : 0.0f;
#pragma unroll
    for (int h4 = 0; h4 < 2; ++h4) { const f32x4 w0 = *(const f32x4*)(w + wcol0 + 4 * h4), w1 = *(const f32x4*)(w + ncol + wcol0 + 4 * h4), w2 = *(const f32x4*)(w + 2 * ncol + wcol0 + 4 * h4), bb = *(const f32x4*)(bias + wcol0 + 4 * h4);
#pragma unroll
        for (int e = 0; e < 4; ++e) { const int i = 4 * h4 + e; const float v = bf2f((bf16_t)c[i]) * w1[e] + mp * bf2f((bf16_t)p[i]) * w0[e] + mn * bf2f((bf16_t)n[i]) * w2[e] + bb[e]; out[i] = SILU ? siluf_(v) : v; } }
}
__device__ __forceinline__ void conv3_silu8(const bf16_t* U, int row, int col0, const float* w, int ncol, int wcol0, const float* bias, float (&out)[8]) { conv3_8<true>(U, row, col0, w, ncol, wcol0, bias, out); }
struct W8 { f32x4 w0[2], w1[2], w2[2], bb[2]; };
struct U3 { bf16x8 c, p, n; float mp, mn; };
__device__ __forceinline__ void load_w8(W8& W, const float* w, int ncol, int wcol0, const float* bias) {
#pragma unroll
    for (int h4 = 0; h4 < 2; ++h4) { W.w0[h4] = *(const f32x4*)(w + wcol0 + 4 * h4); W.w1[h4] = *(const f32x4*)(w + ncol + wcol0 + 4 * h4); W.w2[h4] = *(const f32x4*)(w + 2 * ncol + wcol0 + 4 * h4); W.bb[h4] = *(const f32x4*)(bias + wcol0 + 4 * h4); }
}
__device__ __forceinline__ void load_u3(U3& X, const bf16_t* U, int row, int col0) {
    const bool hp = row_has_prev(row), hn = row_has_next(row);
    X.c = *(const bf16x8*)(U + (size_t)row * UC + col0); X.p = *(const bf16x8*)(U + (size_t)(hp ? row - 1 : row) * UC + col0); X.n = *(const bf16x8*)(U + (size_t)(hn ? row + 1 : row) * UC + col0);
    X.mp = hp ? 1.0f : 0.0f; X.mn = hn ? 1.0f : 0.0f;
}
template <bool SILU>
__device__ __forceinline__ void conv3_8x(const U3& X, const W8& W, float (&out)[8]) {
#pragma unroll
    for (int h4 = 0; h4 < 2; ++h4)
#pragma unroll
        for (int e = 0; e < 4; ++e) { const int i = 4 * h4 + e; const float v = bf2f((bf16_t)X.c[i]) * W.w1[h4][e] + X.mp * bf2f((bf16_t)X.p[i]) * W.w0[h4][e] + X.mn * bf2f((bf16_t)X.n[i]) * W.w2[h4][e] + W.bb[h4][e]; out[i] = SILU ? siluf_(v) : v; }
}
__device__ __forceinline__ void conv16_silu(const bf16_t* U, int r0, int col, const float* w, int ncol, int wcol, float bias, float (&out)[16]) {
    const bool hp = row_has_prev(r0), hn = row_has_next(r0 + 15);
    float x[18];
#pragma unroll
    for (int i = 0; i < 18; ++i) { const int r = (i == 0 && !hp) ? r0 : ((i == 17 && !hn) ? r0 + 15 : r0 - 1 + i); x[i] = bf2f(U[(size_t)r * UC + col]); }
    if (!hp) x[0] = 0.f; if (!hn) x[17] = 0.f;
    const float w0 = w[wcol], w1 = w[ncol + wcol], w2 = w[2 * ncol + wcol];
#pragma unroll
    for (int j = 0; j < 16; ++j) out[j] = siluf_(x[j] * w0 + x[j + 1] * w1 + x[j + 2] * w2 + bias);
}
__device__ __forceinline__ void store16_bf16(LAS bf16_t* dst, const float (&v)[16]) {
    u32x4 a, b; a.x = pack2(v[0], v[1]); a.y = pack2(v[2], v[3]); a.z = pack2(v[4], v[5]); a.w = pack2(v[6], v[7]); b.x = pack2(v[8], v[9]); b.y = pack2(v[10], v[11]); b.z = pack2(v[12], v[13]); b.w = pack2(v[14], v[15]);
    *(LAS u32x4*)dst = a; *(LAS u32x4*)(dst + 8) = b;
}

__device__ __forceinline__ void scatter8_T(LAS bf16_t* dstT, int g8, int p, const float (&v)[8]) {
#pragma unroll
    for (int e2 = 0; e2 < 4; ++e2) { const unsigned w = pack2(v[2 * e2], v[2 * e2 + 1]); dstT[(8 * g8 + 2 * e2) * 136 + p] = (bf16_t)(w & 0xffffu); dstT[(8 * g8 + 2 * e2 + 1) * 136 + p] = (bf16_t)(w >> 16); }
}

__device__ __forceinline__ void hgrn_pass1(const Ptrs P, int l, int unit, LAS unsigned char* lds) {
    const int tid = P.tid, lane = tid & 63, wid = tid >> 6, fr = lane & 15, fq = lane >> 4;
    const int pc = unit % NCHK; const int r_ = unit / NCHK; const int h = r_ & 3; const int b = r_ >> 2;
    const int row0 = chunk_row0(b, pc);
    const bf16_t* U = (const bf16_t*)(P.ws + WS_BIG + BIG_U);
    LAS bf16_t* KTF = (LAS bf16_t*)lds; LAS bf16_t* KTB = KTF + 64 * 136; LAS bf16_t* VT = KTB + 64 * 136; LAS float* segtot = (LAS float*)(VT + 64 * 136);
    LAS bf16_t* FS = (LAS bf16_t*)(lds + 65536);
    for (int it = tid; it < 128 * 8; it += 512) { const int p = it >> 3, g8 = it & 7; const bf16_t* ur = U + (size_t)(row0 + p) * UC + h * 64 + 8 * g8;
        const bf16x8 ff8 = *(const bf16x8*)(ur + 1792), fb8 = *(const bf16x8*)(ur + 2048), v8 = *(const bf16x8*)(ur + 2304);
        *(LAS bf16x8*)(FS + p * 64 + 8 * g8) = ff8; *(LAS bf16x8*)(FS + 8192 + p * 64 + 8 * g8) = fb8;
#pragma unroll
        for (int e = 0; e < 8; ++e) VT[(8 * g8 + e) * 136 + p] = (bf16_t)v8[e]; }
    __syncthreads();
    const int ch = lane, seg = wid;
    const float lbf = ((const float*)(P.ws + WS_LB))[(0 * 2 + l) * 256 + h * 64 + ch], lbb = ((const float*)(P.ws + WS_LB))[(1 * 2 + l) * 256 + h * 64 + ch];
    float cf[16], cb[16], kf[16], kb[16]; float runf = 0.f, runb = 0.f;
#pragma unroll
    for (int j = 0; j < 16; ++j) { const int p = 16 * seg + j;
        const float ff = lbf + (1.0f - lbf) * sigmoidf_(bf2f(FS[p * 64 + ch])), fb = lbb + (1.0f - lbb) * sigmoidf_(bf2f(FS[8192 + p * 64 + ch]));
        runf += flog(ff); cf[j] = runf; kf[j] = 1.0f - ff; cb[j] = runb; runb += flog(fb); kb[j] = 1.0f - fb; }
    segtot[seg * 64 + ch] = runf; segtot[512 + seg * 64 + ch] = runb; __syncthreads();
    float offf = 0.f, totf = 0.f, offb = 0.f, totb = 0.f;
#pragma unroll
    for (int s = 0; s < 8; ++s) { const float a = segtot[s * 64 + ch], c = segtot[512 + s * 64 + ch]; totf += a; totb += c; offf += (s < seg) ? a : 0.f; offb += (s < seg) ? c : 0.f; }
    { float t[16];
#pragma unroll
      for (int j = 0; j < 16; ++j) t[j] = kf[j] * fexp(totf - offf - cf[j]);
      store16_bf16(KTF + ch * 136 + 16 * seg, t);
#pragma unroll
      for (int j = 0; j < 16; ++j) t[j] = kb[j] * fexp(offb + cb[j]);
      store16_bf16(KTB + ch * 136 + 16 * seg, t); }
    const int sif = sidx(0, b, h, 0, pc), sib = sidx(0, b, h, 1, pc);
    if (seg == 0) { ((float*)(P.ws + WS_DEC))[(size_t)sif * 64 + ch] = fexp(totf); ((float*)(P.ws + WS_DEC))[(size_t)sib * 64 + ch] = fexp(totb); }
    __syncthreads();
    const int mt = wid >> 1, nt0 = (wid & 1) * 2;
    f32x4 af[2], ab[2]; af[0] = (f32x4){0.f, 0.f, 0.f, 0.f}; af[1] = af[0]; ab[0] = af[0]; ab[1] = af[0];
#pragma unroll
    for (int ks = 0; ks < 4; ++ks) { const bf16x8 a0 = *(const LAS bf16x8*)(KTF + (16 * mt + fr) * 136 + 32 * ks + 8 * fq), a1 = *(const LAS bf16x8*)(KTB + (16 * mt + fr) * 136 + 32 * ks + 8 * fq);
#pragma unroll
        for (int n = 0; n < 2; ++n) { const bf16x8 bb = *(const LAS bf16x8*)(VT + (16 * (nt0 + n) + fr) * 136 + 32 * ks + 8 * fq);
            af[n] = __builtin_amdgcn_mfma_f32_16x16x32_bf16(a0, bb, af[n], 0, 0, 0); ab[n] = __builtin_amdgcn_mfma_f32_16x16x32_bf16(a1, bb, ab[n], 0, 0, 0); } }
    bf16_t* SF = (bf16_t*)(P.ws + WS_BIG + BIG_STATE) + (size_t)sif * 4096; bf16_t* SB = (bf16_t*)(P.ws + WS_BIG + BIG_STATE) + (size_t)sib * 4096;
#pragma unroll
    for (int n = 0; n < 2; ++n) { const int o = (16 * (nt0 + n) + fr) * 64 + 16 * mt + 4 * fq; u32x2 wf, wb;
        wf.x = pack2(af[n][0], af[n][1]); wf.y = pack2(af[n][2], af[n][3]); wb.x = pack2(ab[n][0], ab[n][1]); wb.y = pack2(ab[n][2], ab[n][3]);
        *(u32x2*)(SF + o) = wf; *(u32x2*)(SB + o) = wb; }
    __syncthreads();
}

__device__ __forceinline__ void ssd_pass1(const Ptrs P, int l, int unit, LAS unsigned char* lds) {
    const int tid = P.tid, lane = tid & 63, wid = tid >> 6, fr = lane & 15, fq = lane >> 4;
    const int pc = unit % NCHK; const int r_ = unit / NCHK; const int g = r_ & 1; const int b = r_ >> 1;
    const int row0 = chunk_row0(b, pc);
    const bf16_t* U = (const bf16_t*)(P.ws + WS_BIG + BIG_U);
    const float* scw = P.inp(I_SSDCW) + (size_t)l * 3 * 512; const float* scb = P.inp(I_SSDCB) + l * 512;
    LAS bf16_t* BT = (LAS bf16_t*)lds; LAS bf16_t* XT = BT + 64 * 136;
    LAS float* wgt = (LAS float*)(XT + 4 * 64 * 136);
    if (wid < 4) {
        const int hh = 2 * g + (wid >> 1), dir = wid & 1;
        const float Aneg = -fexp(P.inp(I_SSDALOG)[(l * 2 + dir) * 4 + hh]); const float dtb = P.inp(I_SSDDTB)[(l * 2 + dir) * 4 + hh]; const float* DT = (const float*)(P.ws + WS_DT);
        const int p0 = 2 * lane; const float d0 = softplusf_(DT[(size_t)(row0 + p0) * 8 + dir * 4 + hh] + dtb), d1 = softplusf_(DT[(size_t)(row0 + p0 + 1) * 8 + dir * 4 + hh] + dtb);
        const float a0 = Aneg * d0, a1 = Aneg * d1; const float inc = wave_incl_scan(a0 + a1, lane); const float tot = __uint_as_float(__builtin_amdgcn_readlane(__float_as_uint(inc), 63));
        if (dir == 0) { wgt[wid * 128 + p0] = d0 * fexp(tot - (inc - a1)); wgt[wid * 128 + p0 + 1] = d1 * fexp(tot - inc); }
        else { wgt[wid * 128 + p0] = d0 * fexp(inc - a1 - a0); wgt[wid * 128 + p0 + 1] = d1 * fexp(inc - a1); }
        if (lane == 0) ((float*)(P.ws + WS_DEC))[(size_t)sidx(1, b, hh, dir, pc) * 64] = fexp(tot);
    }
    __syncthreads();
    {
        const int g8 = tid & 7, pq = tid >> 3;
        { const int cB = 256 + g * 64 + 8 * g8; W8 W; load_w8(W, scw, 512, cB, scb); U3 x[2];
#pragma unroll
          for (int k = 0; k < 2; ++k) load_u3(x[k], U, row0 + pq + 64 * k, 3072 + cB);
#pragma unroll
          for (int k = 0; k < 2; ++k) { float t8[8]; conv3_8x<true>(x[k], W, t8); scatter8_T(BT, g8, pq + 64 * k, t8); } }
#pragma unroll 1
        for (int hq = 0; hq < 2; ++hq) { const int c0 = (2 * g + hq) * 64 + 8 * g8; W8 W; load_w8(W, scw, 512, c0, scb); U3 x[2];
#pragma unroll
            for (int k = 0; k < 2; ++k) load_u3(x[k], U, row0 + pq + 64 * k, 3072 + c0);
#pragma unroll
            for (int k = 0; k < 2; ++k) { const int p = pq + 64 * k; float x8[8], t8[8]; conv3_8x<true>(x[k], W, x8);
#pragma unroll
                for (int dir = 0; dir < 2; ++dir) { const int cmb = 2 * hq + dir; const float wv = wgt[cmb * 128 + p];
#pragma unroll
                    for (int e = 0; e < 8; ++e) t8[e] = x8[e] * wv;
                    scatter8_T(XT + cmb * 64 * 136, g8, p, t8); } } }
    }
    __syncthreads();
    {
        const int cmb = wid >> 1; const int hh = 2 * g + (cmb >> 1), dir = cmb & 1;
        bf16_t* S = (bf16_t*)(P.ws + WS_BIG + BIG_STATE) + (size_t)sidx(1, b, hh, dir, pc) * 4096;
#pragma unroll
        for (int mi = 0; mi < 2; ++mi) { const int mt = 2 * (wid & 1) + mi; f32x4 acc[4];
#pragma unroll
            for (int n = 0; n < 4; ++n) acc[n] = (f32x4){0.f, 0.f, 0.f, 0.f};
#pragma unroll
            for (int ks = 0; ks < 4; ++ks) { const bf16x8 a = *(const LAS bf16x8*)(XT + (cmb * 64 + 16 * mt + fr) * 136 + 32 * ks + 8 * fq);
#pragma unroll
                for (int n = 0; n < 4; ++n) { const bf16x8 bb = *(const LAS bf16x8*)(BT + (16 * n + fr) * 136 + 32 * ks + 8 * fq); acc[n] = __builtin_amdgcn_mfma_f32_16x16x32_bf16(bb, a, acc[n], 0, 0, 0); } }
#pragma unroll
            for (int n = 0; n < 4; ++n) { u32x2 w; w.x = pack2(acc[n][0], acc[n][1]); w.y = pack2(acc[n][2], acc[n][3]); *(u32x2*)(S + (16 * mt + fr) * 64 + 16 * n + 4 * fq) = w; } }
    }
    __syncthreads();
}

__device__ __forceinline__ void ssd_dt_cum(const Ptrs P, int l, int row0, int dir, int h, int wid, int lane, LAS float* cum, LAS float* dtv) {
    if (wid == 0) {
        const float Aneg = -fexp(P.inp(I_SSDALOG)[(l * 2 + dir) * 4 + h]); const float dtb = P.inp(I_SSDDTB)[(l * 2 + dir) * 4 + h]; const float* DT = (const float*)(P.ws + WS_DT);
        const int t0 = 2 * lane, p0 = dir ? 127 - t0 : t0, p1 = dir ? 126 - t0 : t0 + 1;
        const float d0 = softplusf_(DT[(size_t)(row0 + p0) * 8 + dir * 4 + h] + dtb), d1 = softplusf_(DT[(size_t)(row0 + p1) * 8 + dir * 4 + h] + dtb);
        const float a0 = Aneg * d0, a1 = Aneg * d1; const float inc = wave_incl_scan(a0 + a1, lane);
        cum[t0] = inc - a1; cum[t0 + 1] = inc; dtv[t0] = d0; dtv[t0 + 1] = d1;
    }
}

__device__ __forceinline__ void scan_pass2(const Ptrs P, int unit) {
    const int seq = unit >> 1, half = unit & 1; const int kind = seq >> 6, b = (seq >> 3) & 7, h = (seq >> 1) & 3, dir = seq & 1;
    const int e0 = half * 2048 + P.tid * 4; const int base = sidx(kind, b, h, dir, 0);
    bf16_t* ST = (bf16_t*)(P.ws + WS_BIG + BIG_STATE); const float* DEC = (const float*)(P.ws + WS_DEC);
    const float zf = zero_f(); f32x4 run = (f32x4){zf, zf, zf, zf};
#pragma unroll 1
    for (int q0 = 0; q0 < NCHK; q0 += 8) {
        u32x2 loc[8]; f32x4 dd[8];
#pragma unroll
        for (int k = 0; k < 8; ++k) { const int q = (q0 + k < NCHK) ? q0 + k : NCHK - 1; const int pc = chunk_at(dir, q);
            loc[k] = *(const u32x2*)(ST + (size_t)(base + pc) * 4096 + e0);
            if (kind == 0) dd[k] = *(const f32x4*)(DEC + (size_t)(base + pc) * 64 + (e0 & 63)); else { const float d = DEC[(size_t)(base + pc) * 64]; dd[k] = (f32x4){d, d, d, d}; } }
#pragma unroll
        for (int k = 0; k < 8; ++k) { if (q0 + k < NCHK) { const int pc = chunk_at(dir, q0 + k);
            u32x2 w; w.x = pack2(run[0], run[1]); w.y = pack2(run[2], run[3]); *(u32x2*)(ST + (size_t)(base + pc) * 4096 + e0) = w;
            const f32x4 lv = (f32x4){__uint_as_float(loc[k].x << 16), __uint_as_float(loc[k].x & 0xffff0000u), __uint_as_float(loc[k].y << 16), __uint_as_float(loc[k].y & 0xffff0000u)};
            run = run * dd[k] + lv; } }
    }
}

__device__ __forceinline__ int qk_off(int p, int chunk) { return p * 64 + ((chunk ^ (p & 7)) << 3); }
__device__ __forceinline__ void hgrn_pass3(const Ptrs P, int l, int unit, int unit_next, LAS unsigned char* lds) {
    const int tid = P.tid, lane = tid & 63, wid = tid >> 6, fr = lane & 15, fq = lane >> 4;
    const int pc = unit % NCHK; const int r_ = unit / NCHK; const int h = r_ & 3; const int b = r_ >> 2;
    const int row0 = chunk_row0(b, pc);
    const bf16_t* U = (const bf16_t*)(P.ws + WS_BIG + BIG_U);
    LAS bf16_t* QF = (LAS bf16_t*)lds; LAS bf16_t* KF = QF + 128 * 64; LAS bf16_t* QB = KF + 128 * 64; LAS bf16_t* KB = QB + 128 * 64; LAS bf16_t* VT = KB + 128 * 64;
    LAS bf16_t* STF = VT + 64 * 136; LAS bf16_t* STB = STF + 64 * 72; LAS float* ETF = (LAS float*)(STB + 64 * 72); LAS float* ETB = ETF + 512; LAS bf16_t* PW = (LAS bf16_t*)(ETB + 512);
    LAS float* OUT = (LAS float*)lds;
    {
        LAS bf16_t* FS = PW;
        for (int it = tid; it < 128 * 8; it += 512) { const int p = it >> 3, g8 = it & 7; const bf16_t* ur = U + (size_t)(row0 + p) * UC + h * 64 + 8 * g8;
            const bf16x8 ff8 = *(const bf16x8*)(ur + 1792), fb8 = *(const bf16x8*)(ur + 2048), q8 = *(const bf16x8*)(ur + 1536), v8 = *(const bf16x8*)(ur + 2304);
            *(LAS bf16x8*)(FS + p * 64 + 8 * g8) = ff8; *(LAS bf16x8*)(FS + 8192 + p * 64 + 8 * g8) = fb8;
            float qs[8];
#pragma unroll
            for (int e = 0; e < 8; ++e) qs[e] = bf2f((bf16_t)q8[e]) * 0.125f;
            const bf16x8 qp = pack8(qs); *(LAS bf16x8*)(QF + qk_off(p, g8)) = qp; *(LAS bf16x8*)(QB + qk_off(p, g8)) = qp;
#pragma unroll
            for (int e = 0; e < 8; ++e) VT[(8 * g8 + e) * 136 + p] = (bf16_t)v8[e]; }
        const bf16_t* SF = (const bf16_t*)(P.ws + WS_BIG + BIG_STATE) + (size_t)sidx(0, b, h, 0, pc) * 4096; const bf16_t* SB = (const bf16_t*)(P.ws + WS_BIG + BIG_STATE) + (size_t)sidx(0, b, h, 1, pc) * 4096;
        { const int dv = tid >> 3, c8 = (tid & 7) * 8;
          *(LAS bf16x8*)(STF + dv * 72 + c8) = *(const bf16x8*)(SF + tid * 8); *(LAS bf16x8*)(STB + dv * 72 + c8) = *(const bf16x8*)(SB + tid * 8); }
    }
    __syncthreads();
    {
        LAS bf16_t* FS = PW;
        const int ch = lane, seg = wid; const float lbf = ((const float*)(P.ws + WS_LB))[(0 * 2 + l) * 256 + h * 64 + ch], lbb = ((const float*)(P.ws + WS_LB))[(1 * 2 + l) * 256 + h * 64 + ch];
        float bfw[16], bbw[16], kf[16], kb[16];
#pragma unroll
        for (int j = 0; j < 16; ++j) { const int p = 16 * seg + j;
            const float ff = lbf + (1.0f - lbf) * sigmoidf_(bf2f(FS[p * 64 + ch])), fb = lbb + (1.0f - lbb) * sigmoidf_(bf2f(FS[8192 + p * 64 + ch]));
            bfw[j] = flog(ff); bbw[j] = flog(fb); kf[j] = 1.0f - ff; kb[j] = 1.0f - fb; }
#pragma unroll
        for (int j = 1; j < 16; ++j) bfw[j] += bfw[j - 1];
#pragma unroll
        for (int j = 14; j >= 0; --j) bbw[j] += bbw[j + 1];
        const float etf = bfw[15], etb = bbw[0];
        ETF[seg * 64 + ch] = etf; ETB[seg * 64 + ch] = etb;
        const int chunk = ch >> 3, sub = ch & 7;
#pragma unroll
        for (int j = 0; j < 16; ++j) { const int p = 16 * seg + j; const int o = qk_off(p, chunk) + sub; const float qv = bf2f(QF[o]);
            const unsigned wq = pack2(qv * fexp(bfw[j]), qv * fexp(bbw[j])), wk = pack2(kf[j] * fexp(etf - bfw[j]), kb[j] * fexp(etb - bbw[j]));
            QF[o] = (bf16_t)(wq & 0xffffu); QB[o] = (bf16_t)(wq >> 16); KF[o] = (bf16_t)(wk & 0xffffu); KB[o] = (bf16_t)(wk >> 16); }
    }
    __syncthreads();
    f32x4 o[4];
    {
        const int i = wid; LAS bf16_t* pw = PW + wid * 16 * 136;
#pragma unroll
        for (int nt = 0; nt < 4; ++nt) o[nt] = (f32x4){0.f, 0.f, 0.f, 0.f};
#pragma unroll 1
        for (int dir = 0; dir < 2; ++dir) {
            const LAS bf16_t* QA = dir ? QB : QF; const LAS bf16_t* KA = dir ? KB : KF; const LAS float* ET = dir ? ETB : ETF; const LAS bf16_t* ST = dir ? STB : STF;
            bf16x8 qf[2]; float g[2][8];
#pragma unroll
            for (int ks = 0; ks < 2; ++ks) { qf[ks] = *(const LAS bf16x8*)(QA + qk_off(16 * i + fr, 4 * ks + fq));
                const f32x4 e0 = *(const LAS f32x4*)(ET + i * 64 + 32 * ks + 8 * fq), e1 = *(const LAS f32x4*)(ET + i * 64 + 32 * ks + 8 * fq + 4);
                g[ks][0] = -e0[0]; g[ks][1] = -e0[1]; g[ks][2] = -e0[2]; g[ks][3] = -e0[3]; g[ks][4] = -e1[0]; g[ks][5] = -e1[1]; g[ks][6] = -e1[2]; g[ks][7] = -e1[3]; }
            const int nj = dir ? 8 - i : i + 1;
            for (int jj = 0; jj < nj; ++jj) { const int j = dir ? i + jj : i - jj;
                f32x4 d = (f32x4){0.f, 0.f, 0.f, 0.f};
#pragma unroll
                for (int ks = 0; ks < 2; ++ks) { float a8[8];
#pragma unroll
                    for (int e = 0; e < 8; ++e) a8[e] = bf2f((bf16_t)qf[ks][e]) * fexp(g[ks][e]);
                    const bf16x8 kfr = *(const LAS bf16x8*)(KA + qk_off(16 * j + fr, 4 * ks + fq));
                    d = __builtin_amdgcn_mfma_f32_16x16x32_bf16(kfr, pack8(a8), d, 0, 0, 0);
                    const f32x4 e0 = *(const LAS f32x4*)(ET + j * 64 + 32 * ks + 8 * fq), e1 = *(const LAS f32x4*)(ET + j * 64 + 32 * ks + 8 * fq + 4);
                    g[ks][0] += e0[0]; g[ks][1] += e0[1]; g[ks][2] += e0[2]; g[ks][3] += e0[3]; g[ks][4] += e1[0]; g[ks][5] += e1[1]; g[ks][6] += e1[2]; g[ks][7] += e1[3]; }
                if (jj == 0) {
#pragma unroll
                    for (int r = 0; r < 4; ++r) d[r] = (dir ? (4 * fq + r >= fr) : (4 * fq + r <= fr)) ? d[r] : 0.f; }
                u32x2 w; w.x = pack2(d[0], d[1]); w.y = pack2(d[2], d[3]); *(LAS u32x2*)(pw + fr * 136 + 16 * j + 4 * fq) = w;
            }
            { const int zb = dir ? i - 1 : i + 1; const bool need = dir ? ((i & 1) == 1) : ((i & 1) == 0);
              if (need) { u32x2 z; z.x = __float_as_uint(zero_f()); z.y = z.x; *(LAS u32x2*)(pw + fr * 136 + 16 * zb + 4 * fq) = z; } }
            const int kslo = dir ? (i >> 1) : 0, kshi = dir ? 3 : (i >> 1);
            for (int ks = kslo; ks <= kshi; ++ks) { const bf16x8 pa = *(const LAS bf16x8*)(pw + fr * 136 + 32 * ks + 8 * fq);
#pragma unroll
                for (int nt = 0; nt < 4; ++nt) { const bf16x8 vf = *(const LAS bf16x8*)(VT + (16 * nt + fr) * 136 + 32 * ks + 8 * fq); o[nt] = __builtin_amdgcn_mfma_f32_16x16x32_bf16(pa, vf, o[nt], 0, 0, 0); } }
#pragma unroll
            for (int ks = 0; ks < 2; ++ks) { float a8[8];
#pragma unroll
                for (int e = 0; e < 8; ++e) a8[e] = bf2f((bf16_t)qf[ks][e]) * fexp(g[ks][e]);
                const bf16x8 qa = pack8(a8);
#pragma unroll
                for (int nt = 0; nt < 4; ++nt) { const bf16x8 sf = *(const LAS bf16x8*)(ST + (16 * nt + fr) * 72 + 32 * ks + 8 * fq); o[nt] = __builtin_amdgcn_mfma_f32_16x16x32_bf16(qa, sf, o[nt], 0, 0, 0); } }
        }
    }
    __syncthreads();
#pragma unroll
    for (int nt = 0; nt < 4; ++nt)
#pragma unroll
        for (int r = 0; r < 4; ++r) OUT[(16 * wid + 4 * fq + r) * 64 + 16 * nt + fr] = o[nt][r];
    __syncthreads();
    {
        const int pos = tid >> 2, qd = tid & 3; const int row = row0 + pos; bf16_t* BR2 = (bf16_t*)(P.ws + WS_BR) + (size_t)2 * T * 256;
        const bf16_t* gp = U + (size_t)row * UC + 2560 + h * 64 + 16 * qd; const bf16x8 g0 = *(const bf16x8*)gp, g1 = *(const bf16x8*)(gp + 8);
        const float* ngp = P.inp(I_HGNG) + l * 64 + 16 * qd; float ov[16], q = 0.f;
#pragma unroll
        for (int e4 = 0; e4 < 4; ++e4) { const f32x4 v = *(const LAS f32x4*)(OUT + pos * 64 + 16 * qd + 4 * e4); ov[4 * e4] = v[0]; ov[4 * e4 + 1] = v[1]; ov[4 * e4 + 2] = v[2]; ov[4 * e4 + 3] = v[3]; q += v[0] * v[0] + v[1] * v[1] + v[2] * v[2] + v[3] * v[3]; }
        q += WS_DPP(q, 0xB1); q += WS_DPP(q, 0x4E);
        const float rs = rsqrtf(q * (1.0f / 64.0f) + kconst(RMS_EPS)); float t8[8];
#pragma unroll
        for (int e = 0; e < 8; ++e) t8[e] = ov[e] * rs * ngp[e] * siluf_(bf2f((bf16_t)g0[e]));
        *(bf16x8*)(BR2 + (size_t)row * 256 + h * 64 + 16 * qd) = pack8(t8);
#pragma unroll
        for (int e = 0; e < 8; ++e) t8[e] = ov[8 + e] * rs * ngp[8 + e] * siluf_(bf2f((bf16_t)g1[e]));
        *(bf16x8*)(BR2 + (size_t)row * 256 + h * 64 + 16 * qd + 8) = pack8(t8);
    }
    __syncthreads();
}

__device__ __forceinline__ void ssd_pass3(const Ptrs P, int l, int unit, LAS unsigned char* lds) {
    const int tid = P.tid, lane = tid & 63, wid = tid >> 6, fr = lane & 15, fq = lane >> 4;
    const int pc = unit % NCHK; const int r_ = unit / NCHK; const int g = r_ & 1; const int b = r_ >> 1;
    const int row0 = chunk_row0(b, pc);
    const bf16_t* U = (const bf16_t*)(P.ws + WS_BIG + BIG_U);
    const float* scw = P.inp(I_SSDCW) + (size_t)l * 3 * 512; const float* scb = P.inp(I_SSDCB) + l * 512;
    LAS bf16_t* CM = (LAS bf16_t*)lds; LAS bf16_t* BM = CM + 128 * 72; LAS bf16_t* XT = BM + 128 * 72; LAS bf16_t* STF = XT + 64 * 136; LAS bf16_t* STB = STF + 64 * 72;
    LAS float* cumfA = (LAS float*)(STB + 64 * 72); LAS float* cumbA = cumfA + 256; LAS float* dtfA = cumbA + 256; LAS float* dtbA = dtfA + 256;
    LAS bf16_t* PW = (LAS bf16_t*)(dtbA + 256); LAS float* OUT = (LAS float*)(PW + 8 * 16 * 136);
    if (wid < 4) {
        const int hq = wid >> 1, dir = wid & 1, h = 2 * g + hq; const float Aneg = -fexp(P.inp(I_SSDALOG)[(l * 2 + dir) * 4 + h]); const float dtbias = P.inp(I_SSDDTB)[(l * 2 + dir) * 4 + h]; const float* DT = (const float*)(P.ws + WS_DT);
        const int p0 = 2 * lane; const float d0 = softplusf_(DT[(size_t)(row0 + p0) * 8 + dir * 4 + h] + dtbias), d1 = softplusf_(DT[(size_t)(row0 + p0 + 1) * 8 + dir * 4 + h] + dtbias);
        const float a0 = Aneg * d0, a1 = Aneg * d1; const float inc = wave_incl_scan(a0 + a1, lane);
        if (dir == 0) { cumfA[hq * 128 + p0] = inc - a1; cumfA[hq * 128 + p0 + 1] = inc; dtfA[hq * 128 + p0] = d0; dtfA[hq * 128 + p0 + 1] = d1; }
        else { const float tot = __uint_as_float(__builtin_amdgcn_readlane(__float_as_uint(inc), 63)); cumbA[hq * 128 + p0] = tot - inc + a0 + a1; cumbA[hq * 128 + p0 + 1] = tot - inc + a1; dtbA[hq * 128 + p0] = d0; dtbA[hq * 128 + p0 + 1] = d1; }
    }
    {
        const int pos = tid >> 2, qd = tid & 3; const int row = row0 + pos;
#pragma unroll 1
        for (int pcs = 0; pcs < 4; ++pcs) { const int isb = pcs >> 1, hf = pcs & 1; const int cc = (isb ? 256 : 384) + g * 64 + 16 * qd + 8 * hf; float t8[8];
            conv3_silu8(U, row, 3072 + cc, scw, 512, cc, scb, t8);
            *(LAS bf16x8*)((isb ? BM : CM) + pos * 72 + 16 * qd + 8 * hf) = pack8(t8); }
    }
#pragma unroll 1
    for (int hq = 0; hq < 2; ++hq) {
        const int h = 2 * g + hq;
        for (int it = tid; it < 128 * 8; it += 512) { const int p = it >> 3, g8 = it & 7; float x8[8];
            conv3_8<true>(U, row0 + p, 3072 + h * 64 + 8 * g8, scw, 512, h * 64 + 8 * g8, scb, x8); scatter8_T(XT, g8, p, x8); }
        __builtin_amdgcn_sched_barrier(0);
        LAS float* cumf = cumfA + hq * 128; LAS float* cumb = cumbA + hq * 128; LAS float* dtf = dtfA + hq * 128; LAS float* dtb = dtbA + hq * 128;
        {
            const bf16_t* SF = (const bf16_t*)(P.ws + WS_BIG + BIG_STATE) + (size_t)sidx(1, b, h, 0, pc) * 4096; const bf16_t* SB = (const bf16_t*)(P.ws + WS_BIG + BIG_STATE) + (size_t)sidx(1, b, h, 1, pc) * 4096;
            { const int idx = tid * 8; *(LAS bf16x8*)(STF + (idx >> 6) * 72 + (idx & 63)) = *(const bf16x8*)(SF + idx); *(LAS bf16x8*)(STB + (idx >> 6) * 72 + (idx & 63)) = *(const bf16x8*)(SB + idx); }
        }
        float rxs[16]; bf16x8 rz[2];
        { const int pos = tid >> 2, qd = tid & 3; const int row = row0 + pos; const int c0 = h * 64 + 16 * qd; const bf16_t* zp = U + (size_t)row * UC + 2816 + c0;
#pragma unroll
          for (int hf = 0; hf < 2; ++hf) { float xs[8]; conv3_silu8(U, row, 3072 + c0 + 8 * hf, scw, 512, c0 + 8 * hf, scb, xs); rz[hf] = *(const bf16x8*)(zp + 8 * hf);
#pragma unroll
              for (int e = 0; e < 8; ++e) rxs[8 * hf + e] = xs[e]; } }
        __syncthreads();
        {
            const int i = wid; LAS bf16_t* pw = PW + wid * 16 * 136;
            bf16x8 cf[2];
#pragma unroll
            for (int ks = 0; ks < 2; ++ks) cf[ks] = *(const LAS bf16x8*)(CM + (16 * i + fr) * 72 + 32 * ks + 8 * fq);
            f32x4 o[4];
#pragma unroll
            for (int nt = 0; nt < 4; ++nt) o[nt] = (f32x4){0.f, 0.f, 0.f, 0.f};
#pragma unroll 1
            for (int dir = 0; dir < 2; ++dir) {
                const LAS float* cum = dir ? cumb : cumf; const LAS float* dtv = dir ? dtb : dtf; const LAS bf16_t* ST = dir ? STB : STF;
                const float cq = cum[16 * i + fr];
                const int jlo = dir ? i : 0, jhi = dir ? 7 : i;
                for (int j = jlo; j <= jhi; ++j) {
                    f32x4 d = (f32x4){0.f, 0.f, 0.f, 0.f};
#pragma unroll
                    for (int ks = 0; ks < 2; ++ks) { const bf16x8 bf_ = *(const LAS bf16x8*)(BM + (16 * j + fr) * 72 + 32 * ks + 8 * fq); d = __builtin_amdgcn_mfma_f32_16x16x32_bf16(bf_, cf[ks], d, 0, 0, 0); }
                    const f32x4 cs = *(const LAS f32x4*)(cum + 16 * j + 4 * fq), ds = *(const LAS f32x4*)(dtv + 16 * j + 4 * fq);
#pragma unroll
                    for (int r = 0; r < 4; ++r) { const bool keep = (j != i) || (dir ? (4 * fq + r >= fr) : (4 * fq + r <= fr)); d[r] = keep ? d[r] * fexp(cq - cs[r]) * ds[r] : 0.f; }
                    u32x2 w; w.x = pack2(d[0], d[1]); w.y = pack2(d[2], d[3]); *(LAS u32x2*)(pw + fr * 136 + 16 * j + 4 * fq) = w;
                }
                { const int zb = dir ? i - 1 : i + 1; const bool need = dir ? ((i & 1) == 1) : ((i & 1) == 0);
                  if (need) { u32x2 z; z.x = __float_as_uint(zero_f()); z.y = z.x; *(LAS u32x2*)(pw + fr * 136 + 16 * zb + 4 * fq) = z; } }
                const int kslo = dir ? (i >> 1) : 0, kshi = dir ? 3 : (i >> 1);
                for (int ks = kslo; ks <= kshi; ++ks) { const bf16x8 pa = *(const LAS bf16x8*)(pw + fr * 136 + 32 * ks + 8 * fq);
#pragma unroll
                    for (int nt = 0; nt < 4; ++nt) { const bf16x8 xf = *(const LAS bf16x8*)(XT + (16 * nt + fr) * 136 + 32 * ks + 8 * fq); o[nt] = __builtin_amdgcn_mfma_f32_16x16x32_bf16(pa, xf, o[nt], 0, 0, 0); } }
                f32x4 o2[4];
#pragma unroll
                for (int nt = 0; nt < 4; ++nt) o2[nt] = (f32x4){0.f, 0.f, 0.f, 0.f};
#pragma unroll
                for (int ks = 0; ks < 2; ++ks)
#pragma unroll
                    for (int nt = 0; nt < 4; ++nt) { const bf16x8 sf = *(const LAS bf16x8*)(ST + (16 * nt + fr) * 72 + 32 * ks + 8 * fq); o2[nt] = __builtin_amdgcn_mfma_f32_16x16x32_bf16(cf[ks], sf, o2[nt], 0, 0, 0); }
                const f32x4 ct = *(const LAS f32x4*)(cum + 16 * i + 4 * fq);
#pragma unroll
                for (int nt = 0; nt < 4; ++nt)
#pragma unroll
                    for (int r = 0; r < 4; ++r) o[nt][r] += fexp(ct[r]) * o2[nt][r];
            }
#pragma unroll
            for (int nt = 0; nt < 4; ++nt)
#pragma unroll
                for (int r = 0; r < 4; ++r) OUT[(16 * i + 4 * fq + r) * 64 + 16 * nt + fr] = o[nt][r];
        }
        __syncthreads();
        {
            const int pos = tid >> 2, qd = tid & 3; const int row = row0 + pos; const int c0 = h * 64 + 16 * qd;
            const float Dh = P.inp(I_SSDD)[l * 4 + h]; const float* ngp = P.inp(I_SSDNG) + l * 256 + c0; bf16_t* BR3 = (bf16_t*)(P.ws + WS_BR) + (size_t)3 * T * 256; float* SSQ = (float*)(P.ws + WS_SSQ);
            float q = 0.f;
#pragma unroll
            for (int hf = 0; hf < 2; ++hf) { float xs[8];
#pragma unroll
                for (int e = 0; e < 8; ++e) xs[e] = rxs[8 * hf + e];
                const bf16x8 z8 = rz[hf]; float t8[8];
#pragma unroll
                for (int e4 = 0; e4 < 2; ++e4) { const f32x4 ov = *(const LAS f32x4*)(OUT + pos * 64 + 16 * qd + 8 * hf + 4 * e4);
#pragma unroll
                    for (int e = 0; e < 4; ++e) { const int ii = 4 * e4 + e; const float vv = (ov[e] + xs[ii] * Dh) * siluf_(bf2f((bf16_t)z8[ii])); q += vv * vv; t8[ii] = vv * ngp[8 * hf + ii]; } }
                *(bf16x8*)(BR3 + (size_t)row * 256 + c0 + 8 * hf) = pack8(t8); }
            q += WS_DPP(q, 0xB1); q += WS_DPP(q, 0x4E);
            if (qd == 0) SSQ[(size_t)row * 4 + h] = q;
        }
        __syncthreads();
    }
}

typedef float f32x2 __attribute__((ext_vector_type(2)));
__device__ __forceinline__ f32x2 cmul(f32x2 a, f32x2 b) { return (f32x2){a.x * b.x - a.y * b.y, a.x * b.y + a.y * b.x}; }
__device__ __forceinline__ f32x2 cmulc(f32x2 a, f32x2 b) { return (f32x2){a.x * b.x + a.y * b.y, a.y * b.x - a.x * b.y}; }
__device__ __forceinline__ int fphys(int i) { return i + (i >> 4); }
template <int LO, int NST, bool INV>
__device__ __forceinline__ void fft_stages(f32x2 (&x)[16], const LAS f32x2* TW, int low) {
#pragma unroll
    for (int mm = 0; mm < NST; ++mm) { const int m = INV ? mm : NST - 1 - mm; const int s = LO + m;
#pragma unroll
        for (int j = 0; j < 16; ++j) { if (j & (1 << m)) continue; const int j2 = j | (1 << m);
            const int k = ((j & ((1 << m) - 1)) << LO) | low; const f32x2 tw = TW[k << (12 - s)];
            const f32x2 a = x[j], b = x[j2];
            if (!INV) { x[j] = a + b; x[j2] = cmul(a - b, tw); } else { const f32x2 bt = cmulc(b, tw); x[j] = a + bt; x[j2] = a - bt; } } }
}
template <int LO, int NST, bool INV>
__device__ __forceinline__ void fft_pass(LAS f32x2* X, const LAS f32x2* TW, int tid) {
    const int low = tid & ((1 << LO) - 1), high = tid >> LO; const int base = low | (high << (LO + 4));
    f32x2 x[16];
#pragma unroll
    for (int j = 0; j < 16; ++j) x[j] = X[fphys(base | (j << LO))];
    fft_stages<LO, NST, INV>(x, TW, low);
#pragma unroll
    for (int j = 0; j < 16; ++j) X[fphys(base | (j << LO))] = x[j];
}
__device__ __forceinline__ void hyena_fft_unit(const Ptrs P, int l, int c, LAS unsigned char* lds) {
    const int tid = P.tid, lane = tid & 63;
    LAS f32x2* X = (LAS f32x2*)lds; LAS f32x2* TW = X + 8704;
    const f32x2* TWg = (const f32x2*)(P.ws + WS_TW);
    for (int i = tid; i < 4096; i += 512) TW[i] = TWg[i];
    float nrm; { const float* part = (const float*)(P.ws + WS_PART) + (size_t)l * 64 * 512; nrm = wave_sum(part[lane * 512 + c] + part[lane * 512 + 256 + c]); }
    const float inv = 1.0f / nrm; const float* filt = (const float*)(P.ws + WS_FILT) + (size_t)l * 8192 * 256 + c;
    f32x2* Fg = (f32x2*)(P.ws + WS_BR) + (size_t)P.bid * 8192;
    __syncthreads();
    {
        f32x2 x[16];
#pragma unroll
        for (int j = 0; j < 16; ++j) x[j] = (f32x2){filt[(size_t)(tid + 512 * j) * 256] * inv, 0.f};
        fft_stages<9, 4, false>(x, TW, tid);
#pragma unroll
        for (int j = 0; j < 16; ++j) X[fphys(tid | (j << 9))] = x[j];
        __syncthreads(); fft_pass<5, 4, false>(X, TW, tid); __syncthreads(); fft_pass<2, 3, false>(X, TW, tid); __syncthreads();
#pragma unroll
        for (int j = 0; j < 16; ++j) x[j] = X[fphys((tid << 4) | j)];
        fft_stages<0, 2, false>(x, TW, 0);
#pragma unroll
        for (int j = 0; j < 16; ++j) Fg[(tid << 4) | j] = x[j];
    }
    unsigned* WTt = (unsigned*)(P.ws + WS_BIG + BIG_WT); const float bias = P.inp(I_HYBIAS)[l * 256 + c];
    for (int p = 0; p < 4; ++p) {
        unsigned* wp = WTt + ((size_t)c * 4 + p) * 4096;
        f32x2 x[16]; unsigned wraw[8];
#pragma unroll
        for (int j = 0; j < 8; ++j) { wraw[j] = wp[tid + 512 * j]; x[j] = (f32x2){__uint_as_float(wraw[j] << 16), __uint_as_float(wraw[j] & 0xffff0000u)}; }
#pragma unroll
        for (int j = 8; j < 16; ++j) x[j] = (f32x2){0.f, 0.f};
        fft_stages<9, 4, false>(x, TW, tid);
        __syncthreads();
#pragma unroll
        for (int j = 0; j < 16; ++j) X[fphys(tid | (j << 9))] = x[j];
        __syncthreads(); fft_pass<5, 4, false>(X, TW, tid); __syncthreads(); fft_pass<2, 3, false>(X, TW, tid); __syncthreads();
#pragma unroll
        for (int j = 0; j < 16; ++j) x[j] = X[fphys((tid << 4) | j)];
        fft_stages<0, 2, false>(x, TW, 0);
#pragma unroll
        for (int j = 0; j < 16; ++j) x[j] = cmul(x[j], Fg[(tid << 4) | j]);
        fft_stages<0, 2, true>(x, TW, 0);
#pragma unroll
        for (int j = 0; j < 16; ++j) X[fphys((tid << 4) | j)] = x[j];
        __syncthreads(); fft_pass<2, 3, true>(X, TW, tid); __syncthreads(); fft_pass<5, 4, true>(X, TW, tid); __syncthreads();
#pragma unroll
        for (int j = 0; j < 16; ++j) x[j] = X[fphys(tid | (j << 9))];
        fft_stages<9, 4, true>(x, TW, tid);
#pragma unroll
        for (int j = 0; j < 8; ++j) { const f32x2 y = x[j] * (1.0f / 8192.0f); const unsigned w = wraw[j];
            wp[tid + 512 * j] = pack2(y.x + __uint_as_float(w << 16) * bias, y.y + __uint_as_float(w & 0xffff0000u) * bias); }
    }
    __syncthreads();
}

#define DYNQ_BEGIN(ctrp, NUq) { volatile LAS unsigned* slot_ = (volatile LAS unsigned*)(lds + LDS_MISC + 64); unsigned* ctr_ = (ctrp); const bool t0_ = (P.tid == 0); \
    if (t0_) slot_[0] = __hip_atomic_fetch_add(ctr_, 1u, __ATOMIC_RELAXED, __HIP_MEMORY_SCOPE_AGENT); __syncthreads(); \
    unsigned u_ = (unsigned)__builtin_amdgcn_readfirstlane((int)slot_[0]); __syncthreads(); \
    while (u_ < (unsigned)(NUq)) { unsigned tn_ = 0u; if (t0_) tn_ = __hip_atomic_fetch_add(ctr_, 1u, __ATOMIC_RELAXED, __HIP_MEMORY_SCOPE_AGENT); const int u = (int)u_;
#define DYNQ_END() __syncthreads(); if (t0_) slot_[0] = tn_; __syncthreads(); u_ = (unsigned)__builtin_amdgcn_readfirstlane((int)slot_[0]); } }
__device__ __forceinline__ void phase_m1(const Ptrs P, int l, LAS unsigned char* lds) {
    const int tid = P.tid;
    const bf16_t* U = (const bf16_t*)(P.ws + WS_BIG + BIG_U);
    const float* hcw = P.inp(I_HYCW) + (size_t)l * 3 * 768; const float* hcb = P.inp(I_HYCB) + l * 768;
    const int NH = NB * 4 * NCHK, NSS = NB * 2 * NCHK;
    const int NS2 = NH + NSS;
    const int NU = NS2 + 256 + (l == 0 ? NCTX / 64 : 0);
    DYNQ_BEGIN((unsigned*)(P.ws + WS_CTL + CTL_DYN) + 16 + l, NU)
        Ptrs Pu = P; asm volatile("" : "+v"(Pu.tid));
        if (u < NSS) ssd_pass1(Pu, l, u, lds);
        else if (u < NS2) hgrn_pass1(Pu, l, u - NSS, lds);
        else if (u < NS2 + 256) { const int tid = Pu.tid;
            const int ub = u - NS2; const int p = ub >> 6, tb = ub & 63; const int c = tid & 255; LAS unsigned* tile = (LAS unsigned*)lds;
            { const int g8 = tid & 31, rq = tid >> 5; W8 W1, W2; load_w8(W1, hcw, 768, 256 + 8 * g8, hcb); load_w8(W2, hcw, 768, 512 + 8 * g8, hcb);
#pragma unroll 1
              for (int k0 = 0; k0 < 8; k0 += 2) { U3 xa[2], xb[2];
#pragma unroll
                for (int j = 0; j < 2; ++j) { const int k = k0 + j; const int row = (2 * p + (k >> 2)) * SEQ + tb * 64 + rq + 16 * (k & 3); load_u3(xa[j], U, row, 256 + 8 * g8); load_u3(xb[j], U, row, 512 + 8 * g8); }
#pragma unroll
                for (int j = 0; j < 2; ++j) { const int k = k0 + j; const int b2 = k >> 2, rr = rq + 16 * (k & 3); float x1[8], vv[8];
                    conv3_8x<false>(xa[j], W1, x1); conv3_8x<false>(xb[j], W2, vv);
                    LAS bf16_t* th = (LAS bf16_t*)tile + b2;
#pragma unroll
                    for (int e2 = 0; e2 < 4; ++e2) { const unsigned w = pack2(x1[2 * e2] * vv[2 * e2], x1[2 * e2 + 1] * vv[2 * e2 + 1]);
                        th[2 * ((8 * g8 + 2 * e2) * 65 + rr)] = (bf16_t)(w & 0xffffu); th[2 * ((8 * g8 + 2 * e2 + 1) * 65 + rr)] = (bf16_t)(w >> 16); } } } }
            __syncthreads();
            { unsigned* WTt = (unsigned*)(P.ws + WS_BIG + BIG_WT); const int t = tid & 63;
              for (int cc = tid >> 6; cc < 256; cc += 8) WTt[((size_t)cc * 4 + p) * 4096 + tb * 64 + t] = tile[cc * 65 + t]; }
            __syncthreads();
        } else { const int tid = Pu.tid;
            const int ub = u - NS2 - 256; const int c = tid & 255; bf16_t* WTC = (bf16_t*)(P.ws + WS_BIG + BIG_WT) + (size_t)NLAT * 256;
#pragma unroll 4
            for (int rr = tid >> 8; rr < 64; rr += 2) { const int row = NLAT + ub * 64 + rr;
                const float x1 = conv3_u(U, row, 256 + c, hcw, 768, 256 + c) + hcb[256 + c]; const float v = conv3_u(U, row, 512 + c, hcw, 768, 512 + c) + hcb[512 + c];
                WTC[(size_t)(row - NLAT) * 256 + c] = f2bf(x1 * v); } }
    DYNQ_END()
}

__device__ __forceinline__ void phase_m2(const Ptrs P, int l, LAS unsigned char* lds) {
    const int tid = P.tid, G = P.G;
    const bf16_t* U = (const bf16_t*)(P.ws + WS_BIG + BIG_U); bf16_t* BR = (bf16_t*)(P.ws + WS_BR);
    const float* hcw = P.inp(I_HYCW) + (size_t)l * 3 * 768; const float* hcb = P.inp(I_HYCB) + l * 768;
    const int NU_F = 256, NU_P2 = 256, NU_HC = (l == 0) ? NB * 8 : 0;
    const int NU = NU_F + NU_P2 + NU_HC;
    for (int u = P.bid; u < NU; u += G) {
        if (u < NU_F) { hyena_fft_unit(P, l, u, lds); continue; }
        if (u < NU_F + NU_P2) { scan_pass2(P, u - NU_F); continue; }
        {
            const int uu = u - NU_F - NU_P2; const int b = uu >> 3, cb = uu & 7; const int cl = tid & 31, tg = tid >> 5; const int c = cb * 32 + cl;
            const int base = NLAT + b * CTXL; const bf16_t* WTC = (const bf16_t*)(P.ws + WS_BIG + BIG_WT) + (size_t)NLAT * 256 + (size_t)b * CTXL * 256;
            LAS float* wl = (LAS float*)lds; LAS float* fl = wl + 256 * 32;
            const float inv = 1.0f / hy_norm(P, 2, c); const float* filt = (const float*)(P.ws + WS_FILTC);
            for (int i = tid; i < 256 * 32; i += 512) wl[i] = bf2f(WTC[(size_t)(i >> 5) * 256 + cb * 32 + (i & 31)]);
            for (int i = tid >> 5; i < 512; i += 16) fl[i * 32 + cl] = filt[(size_t)i * 256 + c] * inv;
            __syncthreads();
            float acc[16];
#pragma unroll
            for (int j = 0; j < 16; ++j) acc[j] = 0.f;
#pragma unroll 1
            for (int sb = 0; sb < 16; ++sb) {
                float fw[31], wv[16];
#pragma unroll
                for (int q = 0; q < 31; ++q) fw[q] = fl[((16 * tg - 16 * sb - 15 + q) & 511) * 32 + cl];
#pragma unroll
                for (int k = 0; k < 16; ++k) wv[k] = wl[(16 * sb + k) * 32 + cl];
#pragma unroll
                for (int j = 0; j < 16; ++j)
#pragma unroll
                    for (int k = 0; k < 16; ++k) acc[j] += fw[j - k + 15] * wv[k];
            }
            const float bias = P.inp(I_HYBIAS)[l * 256 + c];
#pragma unroll 4
            for (int j = 0; j < 16; ++j) { const int tt = 16 * tg + j; const int row = base + tt; const float x0 = conv3_u(U, row, c, hcw, 768, c) + hcb[c];
                BR[(size_t)row * 256 + c] = f2bf(x0 * (acc[j] + wl[tt * 32 + cl] * bias)); }
            __syncthreads();
        }
    }
}

__device__ __forceinline__ void phase_m3(const Ptrs P, int l, LAS unsigned char* lds) {
    const int tid = P.tid;
    const bool last = (l == NLAYER - 1); const int rows_l = last ? NLAT : T; const int nch = last ? NCHK - 2 : NCHK;
    const bf16_t* U = (const bf16_t*)(P.ws + WS_BIG + BIG_U); bf16_t* BR = (bf16_t*)(P.ws + WS_BR);
    const int NSS3 = NB * 2 * nch, NH3 = NB * 4 * nch;
    const int NS3T = NSS3 + NH3;
    const int NU = NS3T + rows_l / 64 + 256;
    const float* hcw = P.inp(I_HYCW) + (size_t)l * 3 * 768; const float* hcb = P.inp(I_HYCB) + l * 768;
    DYNQ_BEGIN((unsigned*)(P.ws + WS_CTL + CTL_DYN) + 24 + l, NU)
        if (u >= NS3T + rows_l / 64) {
            const int ub = u - NS3T - rows_l / 64; const int p = ub >> 6, tb = ub & 63; LAS unsigned* tile = (LAS unsigned*)lds; const unsigned* WTt = (const unsigned*)(P.ws + WS_BIG + BIG_WT);
            { const int t = tid & 63; for (int cc = tid >> 6; cc < 256; cc += 8) tile[cc * 65 + t] = WTt[((size_t)cc * 4 + p) * 4096 + tb * 64 + t]; }
            __syncthreads();
            for (int it = tid; it < 64 * 32; it += 512) { const int rr = it >> 5, g8 = it & 31; unsigned yw[8];
#pragma unroll
                for (int e = 0; e < 8; ++e) yw[e] = tile[(8 * g8 + e) * 65 + rr];
#pragma unroll
                for (int b2 = 0; b2 < 2; ++b2) { const int row = (2 * p + b2) * SEQ + tb * 64 + rr; float x0[8], t8[8]; conv3_8<false>(U, row, 8 * g8, hcw, 768, 8 * g8, hcb, x0);
#pragma unroll
                    for (int e = 0; e < 8; ++e) t8[e] = x0[e] * (b2 ? __uint_as_float(yw[e] & 0xffff0000u) : __uint_as_float(yw[e] << 16));
                    *(bf16x8*)(BR + (size_t)row * 256 + 8 * g8) = pack8(t8); } }
            __syncthreads(); }
        else if (u < NS3T) { const int uc = u < NSS3 ? u : u - NSS3; const int rq = last ? (uc >> 5) : uc / NCHK; const int uu = rq * NCHK + (uc - rq * nch) + (NCHK - nch);
            Ptrs Pu = P; int lu = l; asm volatile("" : "+v"(Pu.tid), "+s"(lu));
            if (u < NSS3) ssd_pass3(Pu, lu, uu, lds); else hgrn_pass3(Pu, lu, uu, -1, lds); }
        else { const int rb = u - NS3T; const float* cw = P.inp(I_SCCW) + (size_t)l * 3 * 256;
            for (int it = tid; it < 64 * 32; it += 512) { const int row = rb * 64 + (it >> 5), g8 = it & 31; const bool hp = row_has_prev(row), hn = row_has_next(row);
                const bf16_t* u0 = U + (size_t)row * UC + 8 * g8; const bf16_t* up = U + (size_t)(hp ? row - 1 : row) * UC + 8 * g8; const bf16_t* un = U + (size_t)(hn ? row + 1 : row) * UC + 8 * g8;
                const bf16x8 bg = *(const bf16x8*)(u0 + 768), c0 = *(const bf16x8*)(u0 + 1024), x0 = *(const bf16x8*)(u0 + 1280), cp = *(const bf16x8*)(up + 1024), xp = *(const bf16x8*)(up + 1280), cn = *(const bf16x8*)(un + 1024), xn = *(const bf16x8*)(un + 1280);
                const float mp = hp ? 1.0f : 0.0f, mn = hn ? 1.0f : 0.0f; float t8[8];
#pragma unroll
                for (int e = 0; e < 8; ++e) { const int c = 8 * g8 + e;
                    const float acc = bf2f((bf16_t)c0[e]) * bf2f((bf16_t)x0[e]) * cw[256 + c] + mp * bf2f((bf16_t)cp[e]) * bf2f((bf16_t)xp[e]) * cw[c] + mn * bf2f((bf16_t)cn[e]) * bf2f((bf16_t)xn[e]) * cw[512 + c];
                    t8[e] = bf2f((bf16_t)bg[e]) * acc; }
                *(bf16x8*)(BR + (size_t)T * 256 + (size_t)row * 256 + 8 * g8) = pack8(t8); } }
    DYNQ_END()
}

__device__ __forceinline__ void phase_g2(const Ptrs P, int l, LAS unsigned char* lds) {
    const int MT = ((l == NLAYER - 1) ? NLAT : T) / 256;
    pg8::Gemm g{(const bf16_t*)(P.ws + WS_BR), (const bf16_t*)(P.ws + WS_WBR), 256};
    EpiP E{(bf16_t*)(P.ws + WS_BIG + BIG_P), (const float*)(P.ws + WS_SSQ)};
    SchedG2 S{XOrder{P.G, P.bid, MT, 16}};
    pg8::gemm_phase<EpiP, SchedG2, false>(P.tid, lds, g, S, E);
}
__device__ __forceinline__ void phase_g3(const Ptrs P, int l, LAS unsigned char* lds) {
    const int MT = ((l == NLAYER - 1) ? NLAT : T) / 256;
    pg8::Gemm g{(const bf16_t*)(P.ws + WS_HBUF), (const bf16_t*)(P.ws + WS_WG), D};
    EpiMerge E{(const bf16_t*)(P.ws + WS_BIG + BIG_P), (const float*)(P.ws + WS_BGP), (bf16_t*)(P.ws + WS_BR)};
    SchedMN S{XOrder{P.G, P.bid, MT, 16}};
    pg8::gemm_phase<EpiMerge, SchedMN, false>(P.tid, lds, g, S, E);
}
__device__ __forceinline__ void phase_g4(const Ptrs P, int l, LAS unsigned char* lds) {
    const int MT = ((l == NLAYER - 1) ? NLAT : T) / 256;
    pg8::Gemm g{(const bf16_t*)(P.ws + WS_BR), (const bf16_t*)(P.ws + WS_WO), D};
    SchedMN S{XOrder{P.G, P.bid, MT, 4}};
    if (l == 0) { EpiWo<true> E{P, l, P.inp(I_X), P.inp(I_CTX)}; pg8::gemm_phase<EpiWo<true>, SchedMN, false>(P.tid, lds, g, S, E); }
    else { EpiWo<false> E{P, l, nullptr, nullptr}; pg8::gemm_phase<EpiWo<false>, SchedMN, false>(P.tid, lds, g, S, E); }
    dyn_tiles(P.tid, (unsigned*)(P.ws + WS_CTL + CTL_DYN) + l, NCONV_EX, (volatile LAS unsigned*)(lds + LDS_MISC + 64), ConvEx{P, l, (LAS float*)lds});
}

__device__ __forceinline__ void phase_e5(const Ptrs P, int l, LAS unsigned char* lds) {
    const int tid = P.tid, wid = tid >> 6, lane = tid & 63, G = P.G, fr = lane & 15, fq = lane >> 4;
    const int rows_l = (l == NLAYER - 1) ? NLAT : T;
    LAS bf16_t* wrH = (LAS bf16_t*)lds;
    LAS bf16_t* wrL = wrH + 16 * 1032;
    LAS float* lgs = (LAS float*)(lds + 136192);
    LAS unsigned* lcnt = (LAS unsigned*)(lds + 144896); LAS unsigned* gbase = lcnt + 16; LAS int* rec = (LAS int*)(lcnt + 32);
    const float* wrt_ = P.inp(I_WROUTER);
    for (int i = tid; i < 1024 * 16; i += 512) { const int k = i >> 4, e = i & 15; const float w = wrt_[i]; const unsigned hi = pack2(w, 0.f) & 0xffffu; const float lo = w - __uint_as_float(hi << 16);
        wrH[e * 1032 + k] = (bf16_t)hi; wrL[e * 1032 + k] = f2bf(lo); }
    if (tid < 16) lcnt[tid] = 0u;
    __syncthreads();
    unsigned* cnt = (unsigned*)(P.ws + WS_CTL + CTL_CNT) + l * 16;
    int* toke = (int*)(P.ws + WS_TOKE); float* tokw = (float*)(P.ws + WS_TOKW); int* toks = (int*)(P.ws + WS_TOKS); int* list = (int*)(P.ws + WS_LIST);
    const float* g = P.inp(I_LN1G) + l * D; const float* bta = P.inp(I_LN1B) + l * D;
    bf16_t* H2 = P.h2buf(l);
    const int NU_R = rows_l / 8;
    int nloc = 0;
    {
        RowV lng, lnb; row_load(lng, g, lane); row_load(lnb, bta, lane);
        RowV rn; { const float z = zero_f(); for (int i = 0; i < 4; ++i) rn.v[i] = (f32x4){z, z, z, z}; } if (P.bid < NU_R) row_load_b(rn, P.r1row(l, P.bid * 8 + wid), lane);
        RowV msh, msc; { const float z = zero_f(); for (int i = 0; i < 4; ++i) { msh.v[i] = (f32x4){z, z, z, z}; msc.v[i] = msh.v[i]; } } int mcur = -1;
        for (int u = P.bid; u < NU_R; u += G) {
            const int row = u * 8 + wid; RowV r = rn;
            if (u + G < NU_R) row_load_b(rn, P.r1row(l, (u + G) * 8 + wid), lane);
            row_layernorm_r(r, lng, lnb);
            const int mi = row_modidx(row); if (mi != mcur) { mcur = mi; const float* m = P.mod(l, mi); row_load(msh, m + 3072, lane); row_load(msc, m + 4096, lane); }
            RowV h; row_modulate_r(r, h, msh, msc);
            row_store_bf16(h, H2 + (size_t)row * D, lane);
            ++nloc;
        }
    }
    asm volatile("s_waitcnt vmcnt(0)" ::: "memory");
    __syncthreads();
    {
        const int ntile = (nloc + 1) >> 1; LAS float* lg = lgs + wid * 16 * 17;
        for (int t = wid; t < ntile; t += 8) {
            int it = 2 * t + (fr >> 3); const bool valid_a = it < nloc; if (!valid_a) it = nloc - 1;
            const bf16_t* ap = H2 + (size_t)((P.bid + G * it) * 8 + (fr & 7)) * D + 8 * fq;
            f32x4 acc = (f32x4){0.f, 0.f, 0.f, 0.f};
#pragma unroll 4
            for (int ks = 0; ks < 32; ++ks) { const bf16x8 a = *(const bf16x8*)(ap + 32 * ks);
                const bf16x8 bh = *(const LAS bf16x8*)(wrH + fr * 1032 + 32 * ks + 8 * fq), bl = *(const LAS bf16x8*)(wrL + fr * 1032 + 32 * ks + 8 * fq);
                acc = __builtin_amdgcn_mfma_f32_16x16x32_bf16(a, bh, acc, 0, 0, 0); acc = __builtin_amdgcn_mfma_f32_16x16x32_bf16(a, bl, acc, 0, 0, 0); }
#pragma unroll
            for (int r = 0; r < 4; ++r) lg[(4 * fq + r) * 17 + fr] = acc[r];
            const int it2 = 2 * t + (lane >> 3); const bool act = (lane < 16) && (it2 < nloc);
            if (act) {
                const int row = (P.bid + G * it2) * 8 + (lane & 7);
                float lgv[16]; const float* brt_ = P.inp(I_BROUTER);
#pragma unroll
                for (int e = 0; e < 16; ++e) lgv[e] = lg[lane * 17 + e];
                float mx = lgv[0];
#pragma unroll
                for (int e = 1; e < 16; ++e) mx = fmaxf(mx, lgv[e]);
                float sc[16], sel[16], ssum = 0.f;
#pragma unroll
                for (int e = 0; e < 16; ++e) { sc[e] = fexp(lgv[e] - mx); ssum += sc[e]; }
                const float inv = 1.0f / ssum;
#pragma unroll
                for (int e = 0; e < 16; ++e) { sc[e] *= inv; sel[e] = sc[e] + brt_[e]; }
                int bestg = 0; float bestgs = -3.0e38f;
#pragma unroll
                for (int gq = 0; gq < 4; ++gq) { float m1 = -3.0e38f, m2 = -3.0e38f;
#pragma unroll
                    for (int j = 0; j < 4; ++j) { const float v = sel[gq * 4 + j]; if (v > m1) { m2 = m1; m1 = v; } else if (v > m2) m2 = v; }
                    const float gs = m1 + m2; if (gs > bestgs) { bestgs = gs; bestg = gq; } }
                int i1 = 0, i2 = 0; float v1 = -3.0e38f, v2 = -3.0e38f, w1 = 0.f, w2 = 0.f;
#pragma unroll
                for (int e = 0; e < 16; ++e) { if ((e >> 2) == bestg && sel[e] > v1) { v1 = sel[e]; i1 = e; w1 = sc[e]; } }
#pragma unroll
                for (int e = 0; e < 16; ++e) { if ((e >> 2) == bestg && e != i1 && sel[e] > v2) { v2 = sel[e]; i2 = e; w2 = sc[e]; } }
                const float ws_ = 1.0f / (w1 + w2);
                const int s1 = (int)__hip_atomic_fetch_add(lcnt + i1, 1u, __ATOMIC_RELAXED, __HIP_MEMORY_SCOPE_WORKGROUP);
                const int s2 = (int)__hip_atomic_fetch_add(lcnt + i2, 1u, __ATOMIC_RELAXED, __HIP_MEMORY_SCOPE_WORKGROUP);
                const int idx = it2 * 8 + (lane & 7); rec[idx * 3] = i1 | (i2 << 8); rec[idx * 3 + 1] = s1; rec[idx * 3 + 2] = s2;
                toke[row * 2] = i1; toke[row * 2 + 1] = i2; tokw[row * 2] = w1 * ws_; tokw[row * 2 + 1] = w2 * ws_;
            }
        }
    }
    __syncthreads();
    if (tid < 16) gbase[tid] = __hip_atomic_fetch_add(cnt + tid, lcnt[tid], __ATOMIC_RELAXED, __HIP_MEMORY_SCOPE_AGENT);
    __syncthreads();
    for (int idx = tid; idx < nloc * 8; idx += 512) { const int row = (P.bid + G * (idx >> 3)) * 8 + (idx & 7); const int ee = rec[idx * 3]; const int e1 = ee & 255, e2 = ee >> 8;
        const int s1 = (int)gbase[e1] + rec[idx * 3 + 1], s2 = (int)gbase[e2] + rec[idx * 3 + 2];
        list[(size_t)e1 * T + s1] = row; list[(size_t)e2 * T + s2] = row; toks[row * 2] = s1; toks[row * 2 + 1] = s2; }
}

struct MoeSeg { int toff[17]; };
__device__ __forceinline__ void moe_seg(const unsigned* cnt, MoeSeg& S) { int a = 0;
#pragma unroll
    for (int e = 0; e < 16; ++e) { S.toff[e] = a; a += __builtin_amdgcn_readfirstlane(((int)cnt[e] + 255) >> 8); }
    S.toff[16] = a; }
__device__ __forceinline__ int moe_find(const MoeSeg& S, int tg, int& off) { int e = 0; off = 0;
#pragma unroll
    for (int j = 1; j < 16; ++j) { const bool ge = (tg >= S.toff[j]); e += ge ? 1 : 0; off = ge ? S.toff[j] : off; }
    return e; }

struct SchedMoe { int G, c; MoeSeg S; const int* list; const unsigned* cnt;
    __device__ __forceinline__ bool next(int i, Unit& u) const { const int L = i * G + c; if (L >= S.toff[16] * 4) return false; const int tg = L >> 2, pnn = L & 3; int off; const int e = moe_find(S, tg, off);
        u.pm = tg; u.pn = e * 4 + pnn; u.e = e; u.aux = tg - off; return true; }
    __device__ __forceinline__ int arow(const Unit& u, int R) const { const int idx = u.aux * 256 + R; const int* l = list + (size_t)u.e * T; return idx < (int)cnt[u.e] ? l[idx] : l[0]; } };
__device__ __forceinline__ void phase_g5(const Ptrs P, int l, LAS unsigned char* lds) {
    const unsigned* cnt = (const unsigned*)(P.ws + WS_CTL + CTL_CNT) + l * 16;
    SchedMoe S; S.G = P.G; S.c = P.bid; moe_seg(cnt, S.S); S.list = (const int*)(P.ws + WS_LIST); S.cnt = cnt;
    pg8::Gemm g{(const bf16_t*)P.h2buf(l), (const bf16_t*)(P.ws + WS_BIG + BIG_W13), D};
    EpiFfn1 E{(bf16_t*)(P.ws + WS_BIG + BIG_HID)};
    pg8::gemm_phase<EpiFfn1, SchedMoe, true>(P.tid, lds, g, S, E);
    if (l != NLAYER - 1) dyn_tiles(P.tid, (unsigned*)(P.ws + WS_CTL + CTL_DYN) + 8 + l, NCONV_NE, (volatile LAS unsigned*)(lds + LDS_MISC + 64), ConvNe{P, l + 1, (LAS float*)lds});
}
__device__ __forceinline__ void phase_g6(const Ptrs P, int l, LAS unsigned char* lds) {
    const unsigned* cnt = (const unsigned*)(P.ws + WS_CTL + CTL_CNT) + l * 16;
    SchedMoe S; S.G = P.G; S.c = P.bid; moe_seg(cnt, S.S); S.list = (const int*)(P.ws + WS_LIST); S.cnt = cnt;
    pg8::Gemm g{(const bf16_t*)(P.ws + WS_BIG + BIG_HID), (const bf16_t*)(P.ws + WS_BIG + BIG_W2), 512};
    EpiBf16Plain E{(bf16_t*)(P.ws + WS_BIG + BIG_YE), 1024, 3};
    pg8::gemm_phase<EpiBf16Plain, SchedMoe, false>(P.tid, lds, g, S, E);
}

__device__ __forceinline__ void phase_e8(const Ptrs P, int l, LAS unsigned char* lds) {
    const int tid = P.tid, wid = tid >> 6, lane = tid & 63, G = P.G;
    const bool last = (l == NLAYER - 1); const int rows_l = last ? NLAT : T;
    LAS float* wdt = (LAS float*)lds;
    if (!last) load_wdt(P, l + 1, wdt);
    const unsigned* cnt = (const unsigned*)(P.ws + WS_CTL + CTL_CNT) + l * 16; MoeSeg S; moe_seg(cnt, S);
    const int* toke = (const int*)(P.ws + WS_TOKE); const float* tokw = (const float*)(P.ws + WS_TOKW); const int* toks = (const int*)(P.ws + WS_TOKS);
    const bf16_t* YE = (const bf16_t*)(P.ws + WS_BIG + BIG_YE);
    const float* g = P.inp(I_LN2G) + l * D; const float* bta = P.inp(I_LN2B) + l * D; const float* g1p = P.inp(I_LN1G) + l * D; const float* b1p = P.inp(I_LN1B) + l * D;
    const int NU_R = rows_l / 8;
    RowV lng, lnb; row_load(lng, g, lane); row_load(lnb, bta, lane);
    RowV mg2, msh, msc; { const float z = zero_f(); for (int i = 0; i < 4; ++i) { mg2.v[i] = (f32x4){z, z, z, z}; msh.v[i] = mg2.v[i]; msc.v[i] = mg2.v[i]; } } int mcur = -1;
    u32x2 rnr[4]; { const unsigned z = __float_as_uint(zero_f()); for (int i = 0; i < 4; ++i) { rnr[i].x = z; rnr[i].y = z; } } int te1 = 0, te2 = 0, ts1 = 0, ts2 = 0; float tw1 = 0.f, tw2 = 0.f;
#define E8_R1(rw) do { const bf16_t* p_ = P.r1row(l, (rw)); _Pragma("unroll") for (int i = 0; i < 4; ++i) rnr[i] = *(const u32x2*)(p_ + i * 256 + lane * 4); } while (0)
    u32x2 yan[4], ybn[4]; { const unsigned z = __float_as_uint(zero_f()); for (int i = 0; i < 4; ++i) { yan[i].x = z; yan[i].y = z; ybn[i] = yan[i]; } } float w1n = 0.f, w2n = 0.f;
#define E8_TOK(rw) do { te1 = toke[(rw) * 2]; te2 = toke[(rw) * 2 + 1]; tw1 = tokw[(rw) * 2]; tw2 = tokw[(rw) * 2 + 1]; ts1 = toks[(rw) * 2]; ts2 = toks[(rw) * 2 + 1]; } while (0)
#define E8_YE() do { int o1 = 0, o2 = 0; _Pragma("unroll") for (int e = 0; e < 16; ++e) { o1 = (e == te1) ? S.toff[e] : o1; o2 = (e == te2) ? S.toff[e] : o2; } \
        const bf16_t* y1 = YE + ((size_t)o1 * 256 + ts1) * 1024; const bf16_t* y2 = YE + ((size_t)o2 * 256 + ts2) * 1024; \
        _Pragma("unroll") for (int i = 0; i < 4; ++i) { yan[i] = *(const u32x2*)(y1 + i * 256 + lane * 4); ybn[i] = *(const u32x2*)(y2 + i * 256 + lane * 4); } w1n = tw1; w2n = tw2; } while (0)
    if (P.bid < NU_R) { const int row = P.bid * 8 + wid; E8_R1(row); E8_TOK(row); E8_YE(); if (P.bid + G < NU_R) { const int rw = (P.bid + G) * 8 + wid; E8_TOK(rw); } }
    for (int u = P.bid; u < NU_R; u += G) {
        const int row = u * 8 + wid; RowV r;
#pragma unroll
        for (int i = 0; i < 4; ++i) r.v[i] = (f32x4){__uint_as_float(rnr[i].x << 16), __uint_as_float(rnr[i].x & 0xffff0000u), __uint_as_float(rnr[i].y << 16), __uint_as_float(rnr[i].y & 0xffff0000u)};
        u32x2 ya[4], yb[4];
#pragma unroll
        for (int i = 0; i < 4; ++i) { ya[i] = yan[i]; yb[i] = ybn[i]; }
        const float w1 = w1n, w2 = w2n;
        if (u + G < NU_R) { const int rw = (u + G) * 8 + wid; E8_R1(rw); E8_YE();
            if (u + 2 * G < NU_R) { const int rw2 = (u + 2 * G) * 8 + wid; E8_TOK(rw2); } }
        row_layernorm(r, g1p, b1p, lane);
        const int mi = row_modidx(row);
        if (mi != mcur) { mcur = mi; row_load(mg2, P.mod(l, mi) + 5120, lane); if (!last) { const float* m2 = P.mod(l + 1, mi); row_load(msh, m2, lane); row_load(msc, m2 + 1024, lane); } }
#pragma unroll
        for (int i = 0; i < 4; ++i) { const u32x2 a = ya[i], b = yb[i];
            const f32x4 g2 = mg2.v[i];
            f32x4 mo; mo[0] = w1 * __uint_as_float(a.x << 16) + w2 * __uint_as_float(b.x << 16); mo[1] = w1 * __uint_as_float(a.x & 0xffff0000u) + w2 * __uint_as_float(b.x & 0xffff0000u);
            mo[2] = w1 * __uint_as_float(a.y << 16) + w2 * __uint_as_float(b.y << 16); mo[3] = w1 * __uint_as_float(a.y & 0xffff0000u) + w2 * __uint_as_float(b.y & 0xffff0000u);
            r.v[i] = r.v[i] * ALPHA + g2 * mo; }
        row_layernorm_r(r, lng, lnb);
        if (last) row_store(r, P.out + (size_t)row * D, lane);
        else row_store_bf16(r, P.s0row(row), lane);
        if (!last) { RowV h; row_modulate_r(r, h, msh, msc);
            row_store_bf16(h, (bf16_t*)(P.ws + WS_HBUF) + (size_t)row * D, lane); row_dt(h, wdt, (float*)(P.ws + WS_DT) + (size_t)row * 8, lane); }
    }
#undef E8_TOK
#undef E8_YE
#undef E8_R1
}

constexpr int NPH_LAYER = 11, NPH = 2 + NLAYER * NPH_LAYER;
__global__ void __launch_bounds__(512, 2) fwd_kernel(Args a) {
    extern __shared__ __attribute__((aligned(16))) unsigned char lds_raw[];
    LAS unsigned char* lds = (LAS unsigned char*)lds_raw;
    const int lo = a.ph_lo, hi = a.ph_hi;
    volatile LAS unsigned* xbw = (volatile LAS unsigned*)(lds + LDS_MISC);
    const int wave_s = __builtin_amdgcn_readfirstlane((int)threadIdx.x >> 6);
    if (threadIdx.x < 4) xbw[threadIdx.x] = 0u;
    __syncthreads();
    XcdBarrier bar; bar.bar = (unsigned*)(a.ws + WS_CTL); bar.x = 0; bar.st = xbw;
    if (hi - lo > 1) bar = xcd_barrier_post((unsigned*)(a.ws + WS_CTL), xbw, wave_s);
#ifndef PH_MASK
#define PH_MASK 0xFFFFFFFFu
#endif
#ifndef PROBE_PH
#define PROBE_PH (-1)
#define PROBE_N 1
#endif
#define REP(id) for (int rep_ = 0; rep_ < ((PROBE_PH == (id)) ? PROBE_N : 1); ++rep_)
#define PH_ON(id) (((PH_MASK) >> (id)) & 1u)
#define IN(k) (lo <= (k) && (k) < hi)
#define FRESH() Ptrs Pq; { const AS4 char* ka_ = (const AS4 char*)__builtin_amdgcn_kernarg_segment_ptr(); AS1 float* o_ = *(AS1 float* const AS4*)(ka_ + 8 * N_IN); AS1 unsigned char* w_ = *(AS1 unsigned char* const AS4*)(ka_ + 8 * N_IN + 8); int l_ = lcur; asm volatile("" : "+s"(o_), "+s"(w_), "+s"(l_) :: "memory"); Pq.out = (float*)o_; Pq.ws = (unsigned char*)w_; lq = l_; int ws_ = wave_s, b_ = blockIdx.x, g_ = gridDim.x; asm volatile("" : "+s"(ws_), "+s"(b_), "+s"(g_)); int ln_ = lane_id(); asm volatile("" : "+v"(ln_)); int t_ = ws_ * 64 + ln_; Pq.tid = t_; Pq.bid = b_; Pq.G = g_; }
#define SEAM(k) do { if (IN(k) && IN((k) + 1)) xcd_barrier(bar, wave_s); } while (0)
    int lcur = 0, lq = 0;
    if (PH_ON(0) && IN(0)) REP(0) { FRESH(); phase_pa(Pq, lds); } SEAM(0);
    if (PH_ON(1) && IN(1)) REP(1) { FRESH(); phase_pb(Pq, lds); } SEAM(1);
    for (int l = 0; l < NLAYER; ++l) {
        const int b = 2 + l * NPH_LAYER; lcur = l;
        if (PH_ON(2) && IN(b + 0)) REP(2) { FRESH(); phase_g1(Pq, lds); } SEAM(b + 0);
        for (int g_ = 0; g_ < ((PROBE_PH == 100) ? PROBE_N : 1); ++g_) {
        if (PH_ON(3) && IN(b + 1)) REP(3) { FRESH(); phase_m1(Pq, lq, lds); } SEAM(b + 1);
        if (PH_ON(4) && IN(b + 2)) REP(4) { FRESH(); phase_m2(Pq, lq, lds); } SEAM(b + 2);
        if (PH_ON(5) && IN(b + 3)) REP(5) { FRESH(); phase_m3(Pq, lq, lds); } SEAM(b + 3);
        }
        if (PH_ON(6) && IN(b + 4)) REP(6) { FRESH(); phase_g2(Pq, lq, lds); } SEAM(b + 4);
        if (PH_ON(7) && IN(b + 5)) REP(7) { FRESH(); phase_g3(Pq, lq, lds); } SEAM(b + 5);
        if (PH_ON(8) && IN(b + 6)) REP(8) { FRESH(); phase_g4(Pq, lq, lds); } SEAM(b + 6);
        if (PH_ON(9) && IN(b + 7)) REP(9) { FRESH(); phase_e5(Pq, lq, lds); } SEAM(b + 7);
        if (PH_ON(10) && IN(b + 8)) REP(10) { FRESH(); phase_g5(Pq, lq, lds); } SEAM(b + 8);
        if (PH_ON(11) && IN(b + 9)) REP(11) { FRESH(); phase_g6(Pq, lq, lds); } SEAM(b + 9);
        if (PH_ON(12) && IN(b + 10)) REP(12) { FRESH(); phase_e8(Pq, lq, lds); } SEAM(b + 10);
    }
#undef IN
#undef SEAM
}
}

extern "C" void kernel_launch(void* const* d_in, const int* in_sizes, int n_in, void* d_out, int out_size, void* d_ws, size_t ws_size, hipStream_t stream) {
    static int grid = 0;
    if (grid == 0) {
        if (n_in != N_IN || out_size != NLAT * D || ws_size < WS_END) { fprintf(stderr, "kernel_launch: unexpected shapes / workspace (%d inputs, out %d, ws %zu < %zu)\n", n_in, out_size, ws_size, (size_t)WS_END); grid = -1; return; }
        int dev = 0, cus = 0, per_cu = 0;
        if (hipGetDevice(&dev) != hipSuccess || hipDeviceGetAttribute(&cus, hipDeviceAttributeMultiprocessorCount, dev) != hipSuccess) { grid = -1; return; }
        if (hipFuncSetAttribute((const void*)fwd_kernel, hipFuncAttributeMaxDynamicSharedMemorySize, LDS_BYTES) != hipSuccess) { fprintf(stderr, "kernel_launch: hipFuncSetAttribute failed\n"); grid = -1; return; }
        if (hipOccupancyMaxActiveBlocksPerMultiprocessor(&per_cu, (const void*)fwd_kernel, 512, LDS_BYTES) != hipSuccess || per_cu < 1) { fprintf(stderr, "kernel_launch: occupancy query says %d\n", per_cu); }
        (void)hipGetLastError();
        grid = cus;
    }
    if (grid < 0) return;
    (void)hipMemsetAsync((char*)d_ws + WS_CTL, 0, CTL_BYTES, stream);
    Args a{};
    for (int i = 0; i < N_IN; ++i) a.in[i] = (const float*)d_in[i];
    a.out = (float*)d_out; a.ws = (unsigned char*)d_ws;
#if N_LAUNCH_MODE == 1
    a.ph_lo = 0; a.ph_hi = NPH;
    hipLaunchKernelGGL(fwd_kernel, dim3(grid), dim3(512), LDS_BYTES, stream, a);
#else
    for (int p = 0; p < NPH; ++p) { a.ph_lo = p; a.ph_hi = p + 1; hipLaunchKernelGGL(fwd_kernel, dim3(grid), dim3(512), LDS_BYTES, stream, a); }
#endif
}
```

```cpp
#include <hip/hip_runtime.h>
#include <cstdio>
#include <cstdint>

#ifndef N_LAUNCH_MODE
#define N_LAUNCH_MODE 1
#endif

namespace {
typedef unsigned short bf16_t;
typedef short bf16x8 __attribute__((ext_vector_type(8)));
typedef float f32x4 __attribute__((ext_vector_type(4)));
typedef unsigned u32x2 __attribute__((ext_vector_type(2)));
typedef unsigned u32x4 __attribute__((ext_vector_type(4)));
#define LAS __attribute__((address_space(3)))

constexpr int D = 1024, NB = 8, SEQ = 4096, CTXL = 256, NLAT = NB * SEQ, NCTX = NB * CTXL, T = NLAT + NCTX;
constexpr int NLAYER = 2;
constexpr int UC = 3584;
constexpr int INC = 3592;
constexpr int NE = 16;
constexpr float ALPHA = 1.41421356237309515f;
constexpr float LN_EPS = 1e-5f, RMS_EPS = 1e-6f;
constexpr int MAXTILES = 288;

enum { I_X = 0, I_C, I_CTX, I_CCTX, I_WADA, I_BADA, I_WIN, I_HYCW, I_HYCB, I_HYW1, I_HYB1, I_HYF1, I_HYW2, I_HYB2, I_HYF2, I_HYW3, I_HYDEC, I_HYBIAS,
       I_SCCW, I_HGLB, I_HGNG, I_SSDCW, I_SSDCB, I_SSDALOG, I_SSDDTB, I_SSDD, I_SSDNG, I_WGATE, I_BGATE, I_WBR, I_WO, I_LN1G, I_LN1B, I_LN2G, I_LN2B,
       I_WROUTER, I_BROUTER, I_WE1, I_WE3, I_WE2, N_IN };

constexpr size_t al256(size_t x) { return (x + 255) & ~(size_t)255; }
constexpr size_t WS_CTL = 0;
constexpr size_t CTL_BYTES = 65536;
constexpr size_t CTL_CNT = 16384;
constexpr size_t CTL_DYN = 20480;
constexpr size_t WS_MOD = WS_CTL + CTL_BYTES;
constexpr size_t WS_LB = WS_MOD + al256((size_t)NLAYER * 9 * 6144 * 4);
constexpr size_t WS_TW = WS_LB + 4096;
constexpr size_t WS_H2TAB = WS_TW + 65536;
constexpr size_t WS_PART = WS_H2TAB + (size_t)8448 * 64 * 4;
constexpr size_t WS_FILT = WS_PART + (size_t)3 * 64 * 512 * 4;
constexpr size_t WS_FILTC = WS_FILT + (size_t)2 * 8192 * 256 * 4;
constexpr size_t WS_CX32 = WS_FILTC + (size_t)512 * 256 * 4;
constexpr size_t WS_DT = WS_CX32 + (size_t)NCTX * D * 4;
constexpr size_t WS_SSQ = WS_DT + (size_t)T * 8 * 4;
constexpr size_t WS_TOKE = WS_SSQ + (size_t)T * 4 * 4;
constexpr size_t WS_TOKW = WS_TOKE + (size_t)T * 2 * 4;
constexpr size_t WS_TOKS = WS_TOKW + (size_t)T * 2 * 4;
constexpr size_t WS_LIST = WS_TOKS + (size_t)T * 2 * 4;
constexpr size_t WS_BGP = WS_LIST + (size_t)NE * T * 4;
constexpr size_t WS_DEC = WS_BGP + 16384;
constexpr size_t WS_WIN = WS_DEC + (size_t)4352 * 64 * 4;
constexpr size_t WS_WG = WS_WIN + (size_t)UC * D * 2;
constexpr size_t WS_WBR = WS_WG + (size_t)4096 * D * 2;
constexpr size_t WS_WO = WS_WBR + (size_t)4096 * 256 * 2;
constexpr size_t WS_HBUF = WS_WO + (size_t)D * D * 2;
constexpr size_t WS_BR = WS_HBUF + (size_t)T * D * 2;
constexpr size_t WS_BIG = WS_BR + (size_t)T * D * 2;
constexpr size_t BIG_U = 0;
constexpr size_t BIG_HGO = BIG_U + (size_t)T * UC * 2;
constexpr size_t BIG_STATE = BIG_HGO;
constexpr size_t BIG_SSY = BIG_HGO + (size_t)T * 256 * 4;
constexpr size_t BIG_WT = BIG_SSY + (size_t)T * 256 * 4;
constexpr size_t BIG_END1 = BIG_WT + (size_t)T * 256 * 2;
constexpr size_t BIG_P = 0;
constexpr size_t BIG_HID = 0;
constexpr size_t BIG_YE = BIG_HID + (size_t)MAXTILES * 256 * 512 * 2;
constexpr size_t BIG_W13 = BIG_YE + (size_t)MAXTILES * 256 * 1024 * 2;
constexpr size_t BIG_W2 = BIG_W13 + (size_t)NE * 1024 * 1024 * 2;
constexpr size_t BIG_END3 = BIG_W2 + (size_t)NE * 1024 * 512 * 2;
constexpr size_t BIG_BYTES = BIG_END1 > BIG_END3 ? BIG_END1 : BIG_END3;
constexpr size_t WS_END = WS_BIG + BIG_BYTES;
static_assert((size_t)T * 4096 * 2 <= BIG_BYTES, "P fits");
static_assert(WS_END <= (size_t)536870912, "workspace budget");

constexpr int LDS_BYTES = 147456;
constexpr int LDS_MISC = 147456 - 256;

struct Args { const float* in[N_IN]; float* out; unsigned char* ws; int ph_lo, ph_hi; };

#define XB_TMO      128
#define XB_XCNT(j)  (256  + 64 * (j))
#define XB_XSUB(j)  (1280 + 64 * (j))
#define XB_XGEN(j)  (2304 + 64 * (j))
#define XB_TOP      3328
#define XB_TOPGEN   3392
#define XCD_BAR_WORDS 3456
#define XB_SPIN_CAP (1u << 18)
__device__ __forceinline__ unsigned xb_ld(unsigned* p)              { return __hip_atomic_load(p, __ATOMIC_RELAXED, __HIP_MEMORY_SCOPE_AGENT); }
__device__ __forceinline__ unsigned xb_add(unsigned* p, unsigned v) { return __hip_atomic_fetch_add(p, v, __ATOMIC_RELAXED, __HIP_MEMORY_SCOPE_AGENT); }
__device__ __forceinline__ unsigned xb_xcc_id() { return (unsigned)__builtin_amdgcn_s_getreg((3 << 11) | 20) & 0xFu; }
#define XB_SPIN(cond, bar) do { unsigned _sp = 0; while (cond) { __builtin_amdgcn_s_sleep(1); \
    if ((++_sp & 255u) == 0u) { if (xb_ld(&(bar)[XB_TMO])) break; if (_sp > XB_SPIN_CAP) { atomicAdd(&(bar)[XB_TMO], 1u); break; } } } } while (0)
struct XcdBarrier { unsigned* bar; unsigned x; volatile LAS unsigned* st; };
__device__ __forceinline__ int lane_id() { unsigned z = 0u; asm volatile("" : "+v"(z)); return (int)__builtin_amdgcn_mbcnt_hi(~0u, __builtin_amdgcn_mbcnt_lo(~0u, z)); }
__device__ __forceinline__ bool is_thread0(int wave_s) { return wave_s == 0 && lane_id() == 0; }
__device__ __forceinline__ XcdBarrier xcd_barrier_post(unsigned* bar, volatile LAS unsigned* st, int wave_s) {
    XcdBarrier b; b.bar = bar; b.x = xb_xcc_id(); b.st = st;
    if (is_thread0(wave_s)) (void)xb_add(&bar[XB_XCNT(b.x)], 1u);
    return b;
}
__device__ __forceinline__ void xcd_barrier_complete(unsigned* bar, unsigned x, unsigned& nloc, unsigned& nx) {
    const unsigned G = gridDim.x * gridDim.y * gridDim.z;
    unsigned sum, cnt, mine, sp = 0u;
    for (;;) {
        sum = 0u; cnt = 0u; mine = 0u;
#pragma unroll
        for (unsigned j = 0; j < 16; ++j) { const unsigned c = xb_ld(&bar[XB_XCNT(j)]); sum += c; cnt += (c > 0u) ? 1u : 0u; mine = (j == x) ? c : mine; }
        if (sum == G) break;
        __builtin_amdgcn_s_sleep(1);
        if ((++sp & 255u) == 0u) { if (xb_ld(&bar[XB_TMO])) break; if (sp > XB_SPIN_CAP) { atomicAdd(&bar[XB_TMO], 1u); break; } }
    }
    nloc = mine > 0u ? mine : 1u; nx = cnt > 0u ? cnt : 1u;
}
__device__ __forceinline__ void xcd_barrier(const XcdBarrier& b, int wave_s) {
    asm volatile("s_waitcnt vmcnt(0)" ::: "memory");
    __syncthreads();
    if (is_thread0(wave_s)) {
        unsigned* bar = b.bar;
        __builtin_amdgcn_s_waitcnt(0);
        unsigned nloc = b.st[0], nx = b.st[1];
        if (nloc == 0u) { xcd_barrier_complete(bar, b.x, nloc, nx); b.st[0] = nloc; b.st[1] = nx; }
        const unsigned old = xb_add(&bar[XB_XSUB(b.x)], 1u);
        const unsigned gen = old / nloc;
        if (old + 1u == (gen + 1u) * nloc) {
            __builtin_amdgcn_fence(__ATOMIC_RELEASE, "agent");
            asm volatile("s_waitcnt vmcnt(0)" ::: "memory");
            const unsigned og = xb_add(&bar[XB_TOP], 1u);
            const unsigned tg = og / nx;
            if (og + 1u == (tg + 1u) * nx) xb_add(&bar[XB_TOPGEN], 1u);
            else XB_SPIN(xb_ld(&bar[XB_TOPGEN]) == tg, bar);
            __builtin_amdgcn_fence(__ATOMIC_ACQUIRE, "agent");
            xb_add(&bar[XB_XGEN(b.x)], 1u);
            asm volatile("s_waitcnt vmcnt(0)" ::: "memory");
        } else {
            XB_SPIN(xb_ld(&bar[XB_XGEN(b.x)]) == gen, bar);
            __builtin_amdgcn_fence(__ATOMIC_ACQUIRE, "agent");
            asm volatile("s_waitcnt vmcnt(0)" ::: "memory");
        }
    }
    __syncthreads();
}

__device__ __forceinline__ float bf2f(bf16_t b) { return __uint_as_float(((unsigned)b) << 16); }
typedef __bf16 hwbf2 __attribute__((ext_vector_type(2)));
typedef float hwf2 __attribute__((ext_vector_type(2)));
__device__ __forceinline__ unsigned pack2(float lo, float hi) { const hwf2 v = {lo, hi}; return __builtin_bit_cast(unsigned, __builtin_convertvector(v, hwbf2)); }
__device__ __forceinline__ bf16_t f2bf(float f) { return (bf16_t)(pack2(f, 0.f) & 0xffffu); }
__device__ __forceinline__ float zero_f() { float z = 0.f; asm volatile("" : "+v"(z)); return z; }
__device__ __forceinline__ float kconst(float c) { asm volatile("" : "+s"(c)); return c; }
__device__ __forceinline__ float fexp(float x) { return __builtin_amdgcn_exp2f(x * kconst(1.4426950408889634f)); }
__device__ __forceinline__ float flog(float x) { return __builtin_amdgcn_logf(x) * kconst(0.6931471805599453f); }
__device__ __forceinline__ float sigmoidf_(float x) { return __builtin_amdgcn_rcpf(1.0f + fexp(-x)); }
__device__ __forceinline__ float siluf_(float x) { return x * sigmoidf_(x); }
#define WS_DPP(v, ctrl) __int_as_float(__builtin_amdgcn_update_dpp(0, __float_as_int(v), (ctrl), 0xF, 0xF, true))
__device__ __forceinline__ float wave_sum(float v) {
    v += WS_DPP(v, 0xB1); v += WS_DPP(v, 0x4E); v += WS_DPP(v, 0x141); v += WS_DPP(v, 0x140);
    const float s0 = __uint_as_float(__builtin_amdgcn_readlane(__float_as_uint(v), 0)), s1 = __uint_as_float(__builtin_amdgcn_readlane(__float_as_uint(v), 16));
    const float s2 = __uint_as_float(__builtin_amdgcn_readlane(__float_as_uint(v), 32)), s3 = __uint_as_float(__builtin_amdgcn_readlane(__float_as_uint(v), 48));
    return (s0 + s1) + (s2 + s3);
}
__device__ __forceinline__ int row_modidx(int r) { return r < NLAT ? (r >> 12) : 8; }
__device__ __forceinline__ bool row_has_prev(int r) { return r < NLAT ? ((r & 4095) != 0) : (((r - NLAT) & 255) != 0); }
__device__ __forceinline__ bool row_has_next(int r) { return r < NLAT ? ((r & 4095) != 4095) : (((r - NLAT) & 255) != 255); }

#define AS1 __attribute__((address_space(1)))
#define AS4 __attribute__((address_space(4)))
struct Ptrs {
    float* out; unsigned char* ws; int tid, bid, G;
    __device__ __forceinline__ const float* inp(int i) const { asm volatile("" : "+s"(i));
        const __attribute__((address_space(4))) char* ka = (const __attribute__((address_space(4))) char*)__builtin_amdgcn_kernarg_segment_ptr();
        return (const float*)(*(const AS1 float* const AS4*)(ka + 8 * i)); }
    __device__ __forceinline__ bf16_t* s0row(int r) const { return (bf16_t*)out + (size_t)r * D; }
    __device__ __forceinline__ bf16_t* r1row(int l, int r) const { return (l == NLAYER - 1 ? (bf16_t*)(ws + WS_HBUF) : (bf16_t*)out) + (size_t)r * D; }
    __device__ __forceinline__ bf16_t* h2buf(int l) const { return (bf16_t*)(ws + (l == NLAYER - 1 ? WS_BR : WS_HBUF)); }
    __device__ __forceinline__ float* mod(int l, int ridx) const { return (float*)(ws + WS_MOD) + ((size_t)l * 9 + ridx) * 6144; }
};

__device__ __forceinline__ float conv3_u(const bf16_t* U, int row, int col, const float* w, int ncol, int wcol) {
    const bool hp = row_has_prev(row), hn = row_has_next(row);
    const float c = bf2f(U[(size_t)row * UC + col]), p = bf2f(U[(size_t)(hp ? row - 1 : row) * UC + col]), n = bf2f(U[(size_t)(hn ? row + 1 : row) * UC + col]);
    return c * w[ncol + wcol] + (hp ? p * w[wcol] : 0.f) + (hn ? n * w[2 * ncol + wcol] : 0.f);
}

struct Unit { int pm, pn, e, aux; };
__host__ __device__ __forceinline__ int perm32(int rho) { const int n = rho >> 4, i = rho & 15; return 8 * (i >> 2) + 4 * n + (i & 3); }

template <class RowMap, class Epi>
__device__ __forceinline__ void sgemm_unit(int tid_, const bf16_t* __restrict__ A, int lda, const bf16_t* __restrict__ Bt, int ldb, int K, const Unit& u, const RowMap& RM, const Epi& E) {
    const int tid = tid_, wid = tid >> 6, lane = tid & 63, wr = wid >> 2, wc = wid & 3, fr = lane & 15, fq = lane >> 4;
    f32x4 acc[2][2][4][2];
#pragma unroll
    for (int a = 0; a < 2; ++a)
#pragma unroll
        for (int b = 0; b < 2; ++b)
#pragma unroll
            for (int m = 0; m < 4; ++m)
#pragma unroll
                for (int n = 0; n < 2; ++n) acc[a][b][m][n] = (f32x4){0.f, 0.f, 0.f, 0.f};
    unsigned ap[2][4], bp[2][2];
#pragma unroll
    for (int a = 0; a < 2; ++a)
#pragma unroll
        for (int m = 0; m < 4; ++m) ap[a][m] = (unsigned)RM(u, 128 * a + 64 * wr + 16 * m + fr) * (unsigned)lda + fq * 8;
#pragma unroll
    for (int b = 0; b < 2; ++b)
#pragma unroll
        for (int n = 0; n < 2; ++n) { const int rho = 16 * n + fr; const int col = Epi::PERM ? perm32(rho) : rho;
            bp[b][n] = (unsigned)(u.pn * 256 + 128 * b + 32 * wc + col) * (unsigned)ldb + fq * 8; }
    for (int k = 0; k < K; k += 32) {
        bf16x8 bfr[2][2];
#pragma unroll
        for (int b = 0; b < 2; ++b)
#pragma unroll
            for (int n = 0; n < 2; ++n) bfr[b][n] = *(const bf16x8*)(Bt + (bp[b][n] + k));
#pragma unroll
        for (int a = 0; a < 2; ++a) {
            bf16x8 af[4];
#pragma unroll
            for (int m = 0; m < 4; ++m) af[m] = *(const bf16x8*)(A + (ap[a][m] + k));
#pragma unroll
            for (int b = 0; b < 2; ++b)
#pragma unroll
                for (int m = 0; m < 4; ++m)
#pragma unroll
                    for (int n = 0; n < 2; ++n) acc[a][b][m][n] = __builtin_amdgcn_mfma_f32_16x16x32_bf16(bfr[b][n], af[m], acc[a][b][m][n], 0, 0, 0);
        }
    }
    E(acc, u, wr, wc, fr, fq);
}

struct RowIdent { __device__ __forceinline__ int operator()(const Unit& u, int R) const { return u.pm * 256 + R; } };
struct RowStackK { int rows; __device__ __forceinline__ int operator()(const Unit& u, int R) const { return u.e * rows + u.pm * 256 + R; } };
struct RowGather { const int* list; const unsigned* cnt; __device__ __forceinline__ int operator()(const Unit& u, int R) const {
    const int idx = u.aux * 256 + R; const int* l = list + (size_t)u.e * T; return idx < (int)cnt[u.e] ? l[idx] : l[0]; } };


namespace pg8 {
constexpr int BM = 256, BK = 64, HALF = 128, HTB = HALF * BK * 2, STAGE_BYTES = 8 * HTB;
__host__ __device__ __forceinline__ int lds_byte(int r, int c) { const int st = (r >> 4) * 2 + (c >> 5), rr = r & 15, cc = c & 31, ob = rr * 64 + cc * 2; return st * 1024 + (ob ^ (((ob >> 9) & 1) << 5)); }
__host__ __device__ __forceinline__ void stage_rc(int b, int& R, int& C) { const int st = b / 1024, sb = b % 1024, swz = sb ^ (((sb >> 9) & 1) << 5); R = (st >> 1) * 16 + swz / 64; C = (st & 1) * 32 + (swz % 64) / 2; }
struct Gemm { const bf16_t* A; const bf16_t* Bt; int K; };

template <class Epi, class Sched, bool GATHER>
__device__ __forceinline__ void gemm_phase(int tid, LAS unsigned char* lds, const Gemm g, const Sched& S, const Epi& E) {
    const int wid = __builtin_amdgcn_readfirstlane(tid >> 6), lane = tid & 63, wr = wid >> 2, wc = wid & 3, fr = lane & 15, fq = lane >> 4;
    const int K = g.K, nt = K / BK;
    int RA[2], CA[2]; unsigned voffB[2];
    unsigned vA[2][2], vAn[2][2];
#pragma unroll
    for (int i = 0; i < 2; ++i) { int R, C; stage_rc(tid * 16 + i * 8192, R, C); RA[i] = R; CA[i] = C; const int Rb = Epi::PERM ? ((R & ~31) + perm32(R & 31)) : R; voffB[i] = (unsigned)(Rb * K + C) * 2u; }
    const size_t kstep = (size_t)(BK * 2);
    const size_t hstep = (size_t)HALF * K * 2;
    const size_t tstep = 2 * hstep;
    const unsigned ldsw = (unsigned)wid * 1024u;
    const int aoff = lds_byte(wr * 64 + fr, fq * 8), boff = lds_byte(wc * 32 + fr, fq * 8);
#define PG8_SA(b, h) (((b) * 2 + (h)) * HTB)
#define PG8_SB(b, h) ((4 + (b) * 2 + (h)) * HTB)
#define PG8_STAGE(bufoff, gbase, voff) do { _Pragma("unroll") for (int _i = 0; _i < 2; ++_i) \
        __builtin_amdgcn_global_load_lds((const unsigned*)((const char*)(gbase) + (voff)[_i]), (LAS unsigned*)(lds + (bufoff) + ldsw + _i * 8192), 16, 0, 0); } while (0)
#define PG8_STAGE2(bufoff, gbase, v0, v1) do { \
        __builtin_amdgcn_global_load_lds((const unsigned*)((const char*)(gbase) + (v0)), (LAS unsigned*)(lds + (bufoff) + ldsw), 16, 0, 0); \
        __builtin_amdgcn_global_load_lds((const unsigned*)((const char*)(gbase) + (v1)), (LAS unsigned*)(lds + (bufoff) + ldsw + 8192), 16, 0, 0); } while (0)
#define PG8_LDA(dst, b, h) do { _Pragma("unroll") for (int m = 0; m < 4; ++m) _Pragma("unroll") for (int k = 0; k < 2; ++k) dst[m][k] = *(const LAS bf16x8*)(lds + PG8_SA(b, h) + aoff + m * 2048 + k * 1024); } while (0)
#define PG8_LDB(dst, b, h) do { _Pragma("unroll") for (int n = 0; n < 2; ++n) _Pragma("unroll") for (int k = 0; k < 2; ++k) dst[n][k] = *(const LAS bf16x8*)(lds + PG8_SB(b, h) + boff + n * 2048 + k * 1024); } while (0)
#define PG8_MMA(ai, bj, At, Bt) do { __builtin_amdgcn_s_setprio(1); _Pragma("unroll") for (int m = 0; m < 4; ++m) _Pragma("unroll") for (int n = 0; n < 2; ++n) _Pragma("unroll") for (int k = 0; k < 2; ++k) \
        acc[ai][bj][m][n] = __builtin_amdgcn_mfma_f32_16x16x32_bf16(Bt[n][k], At[m][k], acc[ai][bj][m][n], 0, 0, 0); __builtin_amdgcn_s_setprio(0); } while (0)
#define PG8_WAIT_V(n) asm volatile("s_waitcnt vmcnt(" #n ")" ::: "memory")
#define PG8_WAIT_L(n) asm volatile("s_waitcnt lgkmcnt(" #n ")" ::: "memory")
#define PG8_BAR __builtin_amdgcn_s_barrier()
#define PG8_SCHED __builtin_amdgcn_sched_barrier(0)
#define PG8_AOFFS(dst, unit) do { _Pragma("unroll") for (int _h = 0; _h < 2; ++_h) _Pragma("unroll") for (int _i = 0; _i < 2; ++_i) \
        dst[_h][_i] = GATHER ? ((unsigned)S.arow(unit, _h * HALF + RA[_i]) * (unsigned)K + (unsigned)CA[_i]) * 2u : ((unsigned)(_h * HALF + RA[_i]) * (unsigned)K + (unsigned)CA[_i]) * 2u; } while (0)
    Unit cur{0, 0, 0, 0}, nxt{0, 0, 0, 0}; int ui = 0;
    if (!S.next(0, cur)) return;
    f32x4 acc[2][2][4][2];
#pragma unroll
    for (int a = 0; a < 2; ++a)
#pragma unroll
        for (int b = 0; b < 2; ++b)
#pragma unroll
            for (int m = 0; m < 4; ++m)
#pragma unroll
                for (int n = 0; n < 2; ++n) acc[a][b][m][n] = (f32x4){0.f, 0.f, 0.f, 0.f};
    bf16x8 At[4][2], B0[2][2], B1[2][2];
    const char* cA = GATHER ? (const char*)g.A : (const char*)g.A + (size_t)cur.pm * tstep; const char* cB = (const char*)g.Bt + (size_t)cur.pn * tstep;
    PG8_AOFFS(vA, cur);
    PG8_STAGE(PG8_SB(0, 0), cB, voffB); PG8_STAGE(PG8_SB(0, 1), cB + hstep, voffB); PG8_STAGE2(PG8_SA(0, 0), cA, vA[0][0], vA[0][1]); PG8_STAGE2(PG8_SA(0, 1), cA, vA[1][0], vA[1][1]);
    if (wr == 1) PG8_BAR;
    PG8_WAIT_V(2); PG8_BAR;
    PG8_STAGE(PG8_SB(1, 0), cB + kstep, voffB); PG8_STAGE2(PG8_SA(1, 0), cA + kstep, vA[0][0], vA[0][1]); PG8_STAGE(PG8_SB(1, 1), cB + hstep + kstep, voffB);
    PG8_WAIT_V(6); PG8_BAR;
    for (;;) {
        const bool has_next = S.next(ui + 1, nxt);
        const char* nA = GATHER ? (const char*)g.A : (has_next ? (const char*)g.A + (size_t)nxt.pm * tstep : cA); const char* nB = has_next ? (const char*)g.Bt + (size_t)nxt.pn * tstep : cB;
        if (GATHER && has_next) { PG8_AOFFS(vAn, nxt); } else {
#pragma unroll
            for (int _h = 0; _h < 2; ++_h)
#pragma unroll
                for (int _i = 0; _i < 2; ++_i) vAn[_h][_i] = vA[_h][_i]; }
#pragma unroll 1
        for (int t = 0; t < nt; t += 2) {
            const bool last = (t == nt - 2);
            const char* a1 = cA + (size_t)(t + 1) * kstep;
            const char* a2 = last ? nA : cA + (size_t)(t + 2) * kstep; const char* b2 = last ? nB : cB + (size_t)(t + 2) * kstep;
            const char* a3 = a2 + kstep; const char* b3 = b2 + kstep;
            const unsigned x00 = (GATHER && last) ? vAn[0][0] : vA[0][0], x01 = (GATHER && last) ? vAn[0][1] : vA[0][1], x10 = (GATHER && last) ? vAn[1][0] : vA[1][0], x11 = (GATHER && last) ? vAn[1][1] : vA[1][1];
            PG8_LDB(B0, 0, 0); PG8_LDB(B1, 0, 1); PG8_SCHED; PG8_LDA(At, 0, 0); PG8_STAGE2(PG8_SA(1, 1), a1, vA[1][0], vA[1][1]);
            PG8_WAIT_V(8); PG8_WAIT_L(0); PG8_BAR; PG8_MMA(0, 0, At, B0); PG8_MMA(0, 1, At, B1); PG8_BAR; PG8_SCHED;
            PG8_LDA(At, 0, 1); PG8_STAGE(PG8_SB(0, 0), b2, voffB); PG8_STAGE(PG8_SB(0, 1), b2 + hstep, voffB); PG8_STAGE2(PG8_SA(0, 0), a2, x00, x01);
            PG8_WAIT_V(8); PG8_WAIT_L(0); PG8_BAR; PG8_MMA(1, 0, At, B0); PG8_MMA(1, 1, At, B1); PG8_BAR; PG8_SCHED;
            PG8_LDB(B0, 1, 0); PG8_LDB(B1, 1, 1); PG8_SCHED; PG8_LDA(At, 1, 0); PG8_STAGE2(PG8_SA(0, 1), a2, x10, x11);
            PG8_WAIT_V(8); PG8_WAIT_L(0); PG8_BAR; PG8_MMA(0, 0, At, B0); PG8_MMA(0, 1, At, B1); PG8_BAR; PG8_SCHED;
            PG8_LDA(At, 1, 1); PG8_STAGE(PG8_SB(1, 0), b3, voffB); PG8_STAGE(PG8_SB(1, 1), b3 + hstep, voffB); PG8_STAGE2(PG8_SA(1, 0), a3, x00, x01);
            PG8_WAIT_V(8); PG8_WAIT_L(0); PG8_BAR; PG8_MMA(1, 0, At, B0); PG8_MMA(1, 1, At, B1); PG8_BAR; PG8_SCHED;
        }
        if (wr == 0) PG8_BAR;
        E(acc, cur, wr, wc, fr, fq);
        if (!has_next) break;
#pragma unroll
        for (int a = 0; a < 2; ++a)
#pragma unroll
            for (int b = 0; b < 2; ++b)
#pragma unroll
                for (int m = 0; m < 4; ++m)
#pragma unroll
                    for (int n = 0; n < 2; ++n) acc[a][b][m][n] = (f32x4){0.f, 0.f, 0.f, 0.f};
        cur = nxt; cA = nA; cB = nB; ++ui;
        if (GATHER) {
#pragma unroll
        for (int _h = 0; _h < 2; ++_h)
#pragma unroll
            for (int _i = 0; _i < 2; ++_i) vA[_h][_i] = vAn[_h][_i]; }
        if (wr == 1) PG8_BAR;
    }
    PG8_WAIT_V(0);
    PG8_BAR;
#undef PG8_SA
#undef PG8_SB
#undef PG8_STAGE
#undef PG8_STAGE2
#undef PG8_LDA
#undef PG8_LDB
#undef PG8_MMA
#undef PG8_WAIT_V
#undef PG8_WAIT_L
#undef PG8_BAR
#undef PG8_SCHED
#undef PG8_AOFFS
}
}

struct XOrder { int G, c, MT, NT;
    __device__ __forceinline__ bool map(int i, int& pm, int& pn) const {
        if ((G & 7) == 0 && (MT & 7) == 0) { const int x = c & 7, r = c >> 3, W = G >> 3, MX = MT >> 3; const int L = i * W + r; if (L >= MX * NT) return false;
            if (NT >= 8 && (NT & 1) == 0) { const int RB = 8, CB = (NT & 3) == 0 ? NT >> 2 : NT >> 1, nsr = MX / RB, per_sr = RB * NT;
                if (L < nsr * per_sr) { const int sr = L / per_sr, rem = L - sr * per_sr; const int cg = rem / (RB * CB), q = rem - cg * RB * CB; const int pr = q / CB, pc = q - pr * CB;
                    pm = x * MX + sr * RB + pr; pn = cg * CB + pc; return true; }
                const int L2 = L - nsr * per_sr; pm = x * MX + nsr * RB + L2 / NT; pn = L2 % NT; return true; }
            pm = x * MX + L / NT; pn = L % NT; return true; }
        const int L = i * G + c; if (L >= MT * NT) return false; pm = L / NT; pn = L % NT; return true; } };
struct SchedG1 { XOrder X; __device__ __forceinline__ bool next(int i, Unit& u) const { int pm, pn; if (!X.map(i, pm, pn)) return false; u.pm = pm; u.pn = pn; u.e = 0; u.aux = 0; return true; }
    __device__ __forceinline__ int arow(const Unit&, int) const { return 0; } };
struct SchedG2 { XOrder X; __device__ __forceinline__ bool next(int i, Unit& u) const { int pm, q; if (!X.map(i, pm, q)) return false; const int k = q >> 2, pnn = q & 3;
        u.pm = k * (T / 256) + pm; u.pn = k * 4 + pnn; u.e = k; u.aux = pnn; return true; }
    __device__ __forceinline__ int arow(const Unit&, int) const { return 0; } };
struct SchedMN { XOrder X; __device__ __forceinline__ bool next(int i, Unit& u) const { int pm, pn; if (!X.map(i, pm, pn)) return false; u.pm = pm; u.pn = pn; u.e = 0; u.aux = 0; return true; }
    __device__ __forceinline__ int arow(const Unit&, int) const { return 0; } };

struct EpiBf16Plain {
    static constexpr bool PERM = true;
    bf16_t* O; int ldc; int coltile_mask;
    __device__ __forceinline__ void operator()(const f32x4 (&acc)[2][2][4][2], const Unit& u, int wr, int wc, int fr, int fq) const {
        const int row0 = u.pm * 256 + wr * 64 + fr, col0 = (u.pn & coltile_mask) * 256 + wc * 32 + 8 * fq;
#pragma unroll
        for (int ai = 0; ai < 2; ++ai)
#pragma unroll
            for (int m = 0; m < 4; ++m) { bf16_t* rowp = O + ((unsigned)(row0 + ai * 128 + m * 16) * (unsigned)ldc + (unsigned)col0);
#pragma unroll
                for (int bj = 0; bj < 2; ++bj) { const f32x4 v0 = acc[ai][bj][m][0], v1 = acc[ai][bj][m][1];
                    u32x4 w; w.x = pack2(v0[0], v0[1]); w.y = pack2(v0[2], v0[3]); w.z = pack2(v1[0], v1[1]); w.w = pack2(v1[2], v1[3]);
                    *(u32x4*)(rowp + bj * 128) = w; } }
    }
};
struct EpiP {
    static constexpr bool PERM = true;
    bf16_t* P; const float* ssq;
    __device__ __forceinline__ void operator()(const f32x4 (&acc)[2][2][4][2], const Unit& u, int wr, int wc, int fr, int fq) const {
        const int k = u.e; const int pmt = u.pm - k * (T / 256);
        const unsigned c00 = (unsigned)(u.aux * 256 + wc * 32 + 8 * fq);
        const unsigned base = (unsigned)pmt * (16u * 256u * 256u) + (unsigned)k * 16384u;
        float scv[8];
#pragma unroll
        for (int i = 0; i < 8; ++i) scv[i] = 1.0f;
        if (k == 3) {
            f32x4 qv[8];
#pragma unroll
            for (int i = 0; i < 8; ++i) qv[i] = *(const f32x4*)(ssq + (unsigned)(pmt * 256 + (i >> 2) * 128 + wr * 64 + (i & 3) * 16 + fr) * 4u);
#pragma unroll
            for (int i = 0; i < 8; ++i) scv[i] = rsqrtf((qv[i][0] + qv[i][1] + qv[i][2] + qv[i][3]) * (1.0f / 256.0f) + kconst(RMS_EPS));
        }
#pragma unroll
        for (int ai = 0; ai < 2; ++ai)
#pragma unroll
            for (int m = 0; m < 4; ++m) { const int r = ai * 128 + wr * 64 + m * 16 + fr; const float sc = scv[ai * 4 + m];
#pragma unroll
                for (int bj = 0; bj < 2; ++bj) { const unsigned c0 = c00 + bj * 128; const unsigned s = c0 >> 6, wi = c0 & 63;
                    const f32x4 v0 = acc[ai][bj][m][0] * sc, v1 = acc[ai][bj][m][1] * sc;
                    u32x4 w; w.x = pack2(v0[0], v0[1]); w.y = pack2(v0[2], v0[3]); w.z = pack2(v1[0], v1[1]); w.w = pack2(v1[2], v1[3]);
                    __builtin_nontemporal_store(w, (u32x4*)(P + (base + s * 65536u + (wi >> 4) * 4096u + (unsigned)r * 16u + (wi & 15u)))); }
                asm volatile("" ::: "memory"); }
    }
};
struct EpiMerge {
    static constexpr bool PERM = false;
    const bf16_t* P; const float* bgp; bf16_t* Y;
    __device__ __forceinline__ void operator()(const f32x4 (&acc)[2][2][4][2], const Unit& u, int wr, int wc, int fr, int fq) const {
        const int s = u.pn;
        f32x4 bv[2][2];
#pragma unroll
        for (int bj = 0; bj < 2; ++bj)
#pragma unroll
            for (int n = 0; n < 2; ++n) bv[bj][n] = *(const f32x4*)(bgp + s * 256 + bj * 128 + wc * 32 + n * 16 + 4 * fq);
        const bf16_t* pb = P + (((unsigned)u.pm * 16u + (unsigned)s) * 65536u + (unsigned)(wc * 4096 + (wr * 64 + fr) * 16 + 4 * fq));
        u32x2 pw[2][4][4];
#pragma unroll
        for (int ai = 0; ai < 2; ++ai)
#pragma unroll
            for (int k = 0; k < 4; ++k)
#pragma unroll
                for (int m = 0; m < 4; ++m) pw[ai][m][k] = *(const u32x2*)(pb + (ai * 2048 + k * 16384 + m * 256));
        __builtin_amdgcn_sched_barrier(0);
#pragma unroll
        for (int ai = 0; ai < 2; ++ai)
#pragma unroll
            for (int m = 0; m < 4; ++m) { const int r = ai * 128 + wr * 64 + m * 16 + fr;
                f32x4 y = (f32x4){0.f, 0.f, 0.f, 0.f};
#pragma unroll
                for (int bj = 0; bj < 2; ++bj)
#pragma unroll
                    for (int n = 0; n < 2; ++n) { const int k = 2 * bj + n; const u32x2 pq = pw[ai][m][k];
                        const f32x4 g = acc[ai][bj][m][n] + bv[bj][n];
                        f32x4 sg; sg[0] = __builtin_amdgcn_exp2f(g[0]); sg[1] = __builtin_amdgcn_exp2f(g[1]); sg[2] = __builtin_amdgcn_exp2f(g[2]); sg[3] = __builtin_amdgcn_exp2f(g[3]);
                        sg = sg + 1.0f; sg[0] = __builtin_amdgcn_rcpf(sg[0]); sg[1] = __builtin_amdgcn_rcpf(sg[1]); sg[2] = __builtin_amdgcn_rcpf(sg[2]); sg[3] = __builtin_amdgcn_rcpf(sg[3]);
                        const f32x4 pv = (f32x4){__uint_as_float(pq.x << 16), __uint_as_float(pq.x & 0xffff0000u), __uint_as_float(pq.y << 16), __uint_as_float(pq.y & 0xffff0000u)};
                        y += sg * pv; }
                u32x2 w; w.x = pack2(y[0], y[1]); w.y = pack2(y[2], y[3]);
                *(u32x2*)(Y + ((unsigned)(u.pm * 256 + r) * (unsigned)D + (unsigned)(s * 64 + wc * 16 + 4 * fq))) = w; }
    }
};
template <bool FIRST>
struct EpiWo {
    static constexpr bool PREFETCH = false; __device__ __forceinline__ void prefetch(const Unit&, int, LAS unsigned char*) const {}
    static constexpr bool PERM = true;
    Ptrs P; int layer; const float* xin; const float* cin;
    __device__ __forceinline__ void operator()(const f32x4 (&acc)[2][2][4][2], const Unit& u, int wr, int wc, int fr, int fq) const {
        const int col0 = u.pn * 256 + wc * 32 + 8 * fq;
        const float qr = fexp(kconst(-9.210340371976184f / 256.0f));
        const float* g1 = P.mod(layer, row_modidx(u.pm * 256)) + 2048 + col0;
        f32x4 gv[2][2];
#pragma unroll
        for (int bj = 0; bj < 2; ++bj) { gv[bj][0] = *(const f32x4*)(g1 + bj * 128); gv[bj][1] = *(const f32x4*)(g1 + bj * 128 + 4); }
#pragma unroll
        for (int ai = 0; ai < 2; ++ai) {
            u32x4 lw[4][2]; f32x4 xw[2][2][2];
            if (!FIRST) {
#pragma unroll
                for (int m = 0; m < 4; ++m) { const bf16_t* sp = P.s0row(u.pm * 256 + ai * 128 + wr * 64 + m * 16 + fr) + col0;
#pragma unroll
                    for (int bj = 0; bj < 2; ++bj) lw[m][bj] = *(const u32x4*)(sp + bj * 128); }
                __builtin_amdgcn_sched_barrier(0); }
#pragma unroll
            for (int m = 0; m < 4; ++m) { const int row = u.pm * 256 + ai * 128 + wr * 64 + m * 16 + fr;
                if (FIRST && (m & 1) == 0) {
#pragma unroll
                    for (int mm = 0; mm < 2; ++mm) { const int rw = row + 16 * mm; const float* xp = ((rw < NLAT) ? xin + (size_t)rw * D : cin + (size_t)(rw - NLAT) * D) + col0;
#pragma unroll
                        for (int bj = 0; bj < 2; ++bj) { xw[mm][bj][0] = *(const f32x4*)(xp + bj * 128); xw[mm][bj][1] = *(const f32x4*)(xp + bj * 128 + 4); } }
                    __builtin_amdgcn_sched_barrier(0); }
                bf16_t* dp = P.r1row(layer, row) + col0; float pv = 0.f; const bool islat = row < NLAT;
                if (FIRST) { const int t = row & 4095; pv = (float)((u.pn >> 1) ? (t & 63) : (t >> 6)); }
#pragma unroll
                for (int bj = 0; bj < 2; ++bj) { f32x4 x[2];
                    if (FIRST) { x[0] = xw[m & 1][bj][0]; x[1] = xw[m & 1][bj][1];
                        float rv = pv * (fexp(-9.210340371976184f * (float)(wc * 32 + 8 * fq + bj * 128) * (1.0f / 256.0f)) * 0.15915494309189535f);
#pragma unroll
                        for (int n = 0; n < 2; ++n)
#pragma unroll
                            for (int e = 0; e < 4; ++e) { const float pe = (u.pn & 1) ? __builtin_amdgcn_cosf(rv) : __builtin_amdgcn_sinf(rv); x[n][e] += islat ? pe : 0.f; rv *= qr; } }
                    else { const u32x4 w = lw[m][bj];
                        x[0] = (f32x4){__uint_as_float(w.x << 16), __uint_as_float(w.x & 0xffff0000u), __uint_as_float(w.y << 16), __uint_as_float(w.y & 0xffff0000u)};
                        x[1] = (f32x4){__uint_as_float(w.z << 16), __uint_as_float(w.z & 0xffff0000u), __uint_as_float(w.w << 16), __uint_as_float(w.w & 0xffff0000u)}; }
                    const f32x4 y0 = x[0] * ALPHA + gv[bj][0] * acc[ai][bj][m][0], y1 = x[1] * ALPHA + gv[bj][1] * acc[ai][bj][m][1];
                    u32x4 o; o.x = pack2(y0[0], y0[1]); o.y = pack2(y0[2], y0[3]); o.z = pack2(y1[0], y1[1]); o.w = pack2(y1[2], y1[3]);
                    *(u32x4*)(dp + bj * 128) = o; } }
        }
    }
};
struct EpiFfn1 {
    static constexpr bool PERM = false;
    bf16_t* H;
    __device__ __forceinline__ void operator()(const f32x4 (&acc)[2][2][4][2], const Unit& u, int wr, int wc, int fr, int fq) const {
        const int pnn = u.pn & 3;
#pragma unroll
        for (int ai = 0; ai < 2; ++ai)
#pragma unroll
            for (int m = 0; m < 4; ++m) { const int pos = u.pm * 256 + ai * 128 + wr * 64 + m * 16 + fr;
#pragma unroll
                for (int bj = 0; bj < 2; ++bj) { const f32x4 a = acc[ai][bj][m][0], b = acc[ai][bj][m][1];
                    u32x2 w; w.x = pack2(siluf_(a[0]) * b[0], siluf_(a[1]) * b[1]); w.y = pack2(siluf_(a[2]) * b[2], siluf_(a[3]) * b[3]);
                    *(u32x2*)(H + ((unsigned)pos * 512u + (unsigned)(pnn * 128 + bj * 64 + wc * 16 + 4 * fq))) = w; } }
    }
};

template <class SrcFn>
__device__ __forceinline__ void conv_tile(int tid, LAS float* tile  , bf16_t* dst, int ldd, int n0, int k0, const SrcFn& src, const float scale = 1.0f) {
    f32x4 v[8];
#pragma unroll
    for (int i = 0; i < 8; ++i) { const int kk = (tid >> 4) + 32 * i, j4 = tid & 15; v[i] = *(const f32x4*)src(k0 + kk, n0 + 4 * j4); }
#pragma unroll
    for (int i = 0; i < 8; ++i) { const int kk = (tid >> 4) + 32 * i, j4 = tid & 15; LAS float* t = tile + kk * 65 + 4 * j4; t[0] = v[i][0]; t[1] = v[i][1]; t[2] = v[i][2]; t[3] = v[i][3]; }
    __syncthreads();
    { const int jj = tid >> 3, kq = tid & 7;
#pragma unroll
      for (int kb = 0; kb < 4; ++kb) { float x[8];
#pragma unroll
          for (int i = 0; i < 8; ++i) x[i] = tile[(64 * kb + 8 * kq + i) * 65 + jj] * scale;
          u32x4 w; w.x = pack2(x[0], x[1]); w.y = pack2(x[2], x[3]); w.z = pack2(x[4], x[5]); w.w = pack2(x[6], x[7]);
          *(u32x4*)(dst + (size_t)(n0 + jj) * ldd + k0 + 64 * kb + 8 * kq) = w; } }
    __syncthreads();
}
constexpr int NCONV_NE = 56 * 4 + 64 * 4 + 64 * 1 + 16 * 4;
constexpr int NCONV_EX = NE * (16 * 4 + 16 * 2);
__device__ __forceinline__ int gate_srccol(int np) { const int s = np >> 8, bj = (np >> 7) & 1, wc = (np >> 5) & 3, n = (np >> 4) & 1, fqe = np & 15; return (2 * bj + n) * 1024 + 64 * s + 16 * wc + fqe; }
__device__ __forceinline__ void conv_unit_ne(const Ptrs P, int l, int t, LAS float* tile) {
    unsigned char* ws = P.ws;
    if (t < 224) { const int nt = t >> 2, kt = t & 3; const float* src = P.inp(I_WIN) + (size_t)l * D * INC;
        conv_tile(P.tid, tile, (bf16_t*)(ws + WS_WIN), D, nt * 64, kt * 256, [=](int k, int n) { return src + (size_t)k * INC + n; });
    } else if (t < 224 + 256) { t -= 224; const int nt = t >> 2, kt = t & 3; const float* src = P.inp(I_WGATE) + (size_t)l * D * 4096;
        conv_tile(P.tid, tile, (bf16_t*)(ws + WS_WG), D, nt * 64, kt * 256, [=](int k, int n) { return src + (size_t)k * 4096 + gate_srccol(n); }, -1.4426950408889634f);
        if (kt == 0 && P.tid < 64) { const int np = nt * 64 + P.tid; ((float*)(ws + WS_BGP))[np] = P.inp(I_BGATE)[(size_t)l * 4096 + gate_srccol(np)] * -1.4426950408889634f; }
    } else if (t < 224 + 256 + 64) { t -= 480; const int nt = t; const int kb = nt >> 4;
        const float* src = P.inp(I_WBR) + ((size_t)l * 4 + kb) * 256 * 1024;
        conv_tile(P.tid, tile, (bf16_t*)(ws + WS_WBR), 256, nt * 64, 0, [=](int k, int n) { return src + (size_t)k * 1024 + (n & 1023); });
    } else { t -= 544; const int nt = t >> 2, kt = t & 3; const float* src = P.inp(I_WO) + (size_t)l * D * D;
        conv_tile(P.tid, tile, (bf16_t*)(ws + WS_WO), D, nt * 64, kt * 256, [=](int k, int n) { return src + (size_t)k * D + n; });
    }
}
__device__ __forceinline__ void conv_unit_ex(const Ptrs P, int l, int t, LAS float* tile) {
    unsigned char* ws = P.ws;
    const int e = t / 96; t -= e * 96;
    if (t < 64) { const int nt = t >> 2, kt = t & 3;
        const float* s1 = P.inp(I_WE1) + ((size_t)l * NE + e) * 1024 * 512; const float* s3 = P.inp(I_WE3) + ((size_t)l * NE + e) * 1024 * 512;
        conv_tile(P.tid, tile, (bf16_t*)(ws + WS_BIG + BIG_W13) + (size_t)e * 1024 * 1024, 1024, nt * 64, kt * 256, [=](int k, int n) {
            const int pn = n >> 8, bj = (n >> 7) & 1, wc = (n >> 5) & 3, nn = (n >> 4) & 1, fqe = n & 15; const int ch = 128 * pn + 64 * bj + 16 * wc + fqe;
            return (nn ? s3 : s1) + (size_t)k * 512 + ch; });
    } else { t -= 64; const int nt = t >> 1, kt = t & 1; const float* src = P.inp(I_WE2) + ((size_t)l * NE + e) * 512 * 1024;
        conv_tile(P.tid, tile, (bf16_t*)(ws + WS_BIG + BIG_W2) + (size_t)e * 1024 * 512, 512, nt * 64, kt * 256, [=](int k, int n) { return src + (size_t)k * 1024 + n; });
    }
}

struct ConvEx { Ptrs P; int l; LAS float* tile; __device__ __forceinline__ void operator()(int t) const { conv_unit_ex(P, l, t, tile); } };
struct ConvNe { Ptrs P; int l; LAS float* tile; __device__ __forceinline__ void operator()(int t) const { conv_unit_ne(P, l, t, tile); } };
template <class F>
__device__ __forceinline__ void dyn_tiles(int tid, unsigned* ctr, int n, volatile LAS unsigned* slot, const F& f) {
    const bool t0 = (tid == 0);
    if (t0) slot[0] = __hip_atomic_fetch_add(ctr, 1u, __ATOMIC_RELAXED, __HIP_MEMORY_SCOPE_AGENT);
    __syncthreads();
    unsigned t = (unsigned)__builtin_amdgcn_readfirstlane((int)slot[0]);
    __syncthreads();
    while (t < (unsigned)n) {
        unsigned tn = 0u; if (t0) tn = __hip_atomic_fetch_add(ctr, 1u, __ATOMIC_RELAXED, __HIP_MEMORY_SCOPE_AGENT);
        f((int)t);
        if (t0) slot[0] = tn;
        __syncthreads();
        t = (unsigned)__builtin_amdgcn_readfirstlane((int)slot[0]);
        __syncthreads();
    }
}

struct RowV { f32x4 v[4]; };
__device__ __forceinline__ void row_load(RowV& r, const float* p, int lane) {
#pragma unroll
    for (int i = 0; i < 4; ++i) r.v[i] = *(const f32x4*)(p + i * 256 + lane * 4);
}
__device__ __forceinline__ void row_load_b(RowV& r, const bf16_t* p, int lane) {
#pragma unroll
    for (int i = 0; i < 4; ++i) { const u32x2 w = *(const u32x2*)(p + i * 256 + lane * 4); r.v[i] = (f32x4){__uint_as_float(w.x << 16), __uint_as_float(w.x & 0xffff0000u), __uint_as_float(w.y << 16), __uint_as_float(w.y & 0xffff0000u)}; }
}
struct RowB { u32x2 w[4]; };
__device__ __forceinline__ void row_load_raw(RowB& r, const bf16_t* p, int lane) {
#pragma unroll
    for (int i = 0; i < 4; ++i) r.w[i] = *(const u32x2*)(p + i * 256 + lane * 4);
}
__device__ __forceinline__ void row_unpack(RowV& r, const RowB& b) {
#pragma unroll
    for (int i = 0; i < 4; ++i) { const u32x2 w = b.w[i]; r.v[i] = (f32x4){__uint_as_float(w.x << 16), __uint_as_float(w.x & 0xffff0000u), __uint_as_float(w.y << 16), __uint_as_float(w.y & 0xffff0000u)}; }
}
__device__ __forceinline__ void row_settle(RowV& r) {
#pragma unroll
    for (int i = 0; i < 4; ++i) asm volatile("" : "+v"(r.v[i]));
}
__device__ __forceinline__ void row_store(const RowV& r, float* p, int lane) {
#pragma unroll
    for (int i = 0; i < 4; ++i) *(f32x4*)(p + i * 256 + lane * 4) = r.v[i];
}
__device__ __forceinline__ void row_layernorm(RowV& r, const float* g, const float* b, int lane) {
    float s = 0.f;
#pragma unroll
    for (int i = 0; i < 4; ++i) s += r.v[i][0] + r.v[i][1] + r.v[i][2] + r.v[i][3];
    const float mu = wave_sum(s) * (1.0f / 1024.0f);
    float q = 0.f;
#pragma unroll
    for (int i = 0; i < 4; ++i) { const f32x4 d = r.v[i] - mu; q += d[0] * d[0] + d[1] * d[1] + d[2] * d[2] + d[3] * d[3]; }
    const float rstd = rsqrtf(wave_sum(q) * (1.0f / 1024.0f) + kconst(LN_EPS));
#pragma unroll
    for (int i = 0; i < 4; ++i) { const f32x4 gg = *(const f32x4*)(g + i * 256 + lane * 4), bb = *(const f32x4*)(b + i * 256 + lane * 4); r.v[i] = (r.v[i] - mu) * rstd * gg + bb; }
}
__device__ __forceinline__ void row_layernorm_l(RowV& r, const LAS float* g, const LAS float* b, int lane) {
    float s = 0.f;
#pragma unroll
    for (int i = 0; i < 4; ++i) s += r.v[i][0] + r.v[i][1] + r.v[i][2] + r.v[i][3];
    const float mu = wave_sum(s) * (1.0f / 1024.0f);
    float q = 0.f;
#pragma unroll
    for (int i = 0; i < 4; ++i) { const f32x4 d = r.v[i] - mu; q += d[0] * d[0] + d[1] * d[1] + d[2] * d[2] + d[3] * d[3]; }
    const float rstd = rsqrtf(wave_sum(q) * (1.0f / 1024.0f) + kconst(LN_EPS));
#pragma unroll
    for (int i = 0; i < 4; ++i) { const f32x4 gg = *(const LAS f32x4*)(g + i * 256 + lane * 4), bb = *(const LAS f32x4*)(b + i * 256 + lane * 4); r.v[i] = (r.v[i] - mu) * rstd * gg + bb; }
}
__device__ __forceinline__ void row_layernorm_r(RowV& r, const RowV& g, const RowV& b) {
    float s = 0.f;
#pragma unroll
    for (int i = 0; i < 4; ++i) s += r.v[i][0] + r.v[i][1] + r.v[i][2] + r.v[i][3];
    const float mu = wave_sum(s) * (1.0f / 1024.0f);
    float q = 0.f;
#pragma unroll
    for (int i = 0; i < 4; ++i) { const f32x4 d = r.v[i] - mu; q += d[0] * d[0] + d[1] * d[1] + d[2] * d[2] + d[3] * d[3]; }
    const float rstd = rsqrtf(wave_sum(q) * (1.0f / 1024.0f) + kconst(LN_EPS));
#pragma unroll
    for (int i = 0; i < 4; ++i) r.v[i] = (r.v[i] - mu) * rstd * g.v[i] + b.v[i];
}
__device__ __forceinline__ void row_modulate(const RowV& r, RowV& h, const float* sh, const float* sc, int lane) {
#pragma unroll
    for (int i = 0; i < 4; ++i) { const f32x4 a = *(const f32x4*)(sc + i * 256 + lane * 4), b = *(const f32x4*)(sh + i * 256 + lane * 4); h.v[i] = r.v[i] * (a + 1.0f) + b; }
}
__device__ __forceinline__ void row_modulate_r(const RowV& r, RowV& h, const RowV& sh, const RowV& sc) {
#pragma unroll
    for (int i = 0; i < 4; ++i) h.v[i] = r.v[i] * (sc.v[i] + 1.0f) + sh.v[i];
}
__device__ __forceinline__ void row_store_bf16(const RowV& h, bf16_t* p, int lane) {
#pragma unroll
    for (int i = 0; i < 4; ++i) { u32x2 w; w.x = pack2(h.v[i][0], h.v[i][1]); w.y = pack2(h.v[i][2], h.v[i][3]); *(u32x2*)(p + i * 256 + lane * 4) = w; }
}
__device__ __forceinline__ void row_dt(const RowV& h, const LAS float* wdt, float* dtout, int lane) {
    float a[8];
#pragma unroll
    for (int j = 0; j < 8; ++j) a[j] = 0.f;
#pragma unroll
    for (int i = 0; i < 4; ++i) { f32x4 w[8];
#pragma unroll
        for (int j = 0; j < 8; ++j) w[j] = *(const LAS f32x4*)(wdt + j * 1024 + i * 256 + lane * 4);
        __builtin_amdgcn_sched_barrier(0);
#pragma unroll
        for (int j = 0; j < 8; ++j) a[j] += h.v[i][0] * w[j][0] + h.v[i][1] * w[j][1] + h.v[i][2] * w[j][2] + h.v[i][3] * w[j][3]; }
#pragma unroll
    for (int j = 0; j < 8; ++j) a[j] = wave_sum(a[j]);
    if (lane == 0) { *(f32x4*)dtout = (f32x4){a[0], a[1], a[2], a[3]}; *(f32x4*)(dtout + 4) = (f32x4){a[4], a[5], a[6], a[7]}; }
}
__device__ __forceinline__ void load_wdt(const Ptrs P, int l, LAS float* wdt) {
    const float* src = P.inp(I_WIN) + (size_t)l * D * INC + UC;
    { float tv[16];
#pragma unroll
      for (int j = 0; j < 16; ++j) { const int i = P.tid + 512 * j; tv[j] = src[(size_t)(i >> 3) * INC + (i & 7)]; }
#pragma unroll
      for (int j = 0; j < 16; ++j) { const int i = P.tid + 512 * j; wdt[(i & 7) * 1024 + (i >> 3)] = tv[j]; } }
    __syncthreads();
}

__device__ __forceinline__ void phase_pa(const Ptrs P, LAS unsigned char* lds) {
    const int tid = P.tid, wid = tid >> 6, lane = tid & 63, G = P.G;
    const int NU_MOD = 2 * 96, NU_H2 = 8448 / 8, NU_LB = 1;
    const int NU = NU_MOD + NU_H2 + NU_LB + NCONV_NE;
    for (int u = P.bid; u < NU; u += G) {
        if (u < NU_MOD) {
            const int l = u / 96, cb = u % 96;
            LAS float* sc = (LAS float*)lds; LAS float* red = sc + 9 * 1024;
            { const float* cin_ = P.inp(I_C); const float* cctx_ = P.inp(I_CCTX);
              for (int i = tid; i < 9 * 1024; i += 512) { const int r = i >> 10, k = i & 1023; const float v = r < 8 ? cin_[r * 1024 + k] : cctx_[k]; sc[i] = v / (1.0f + fexp(-v)); } }
            __syncthreads();
            const int col = cb * 64 + lane; const float* w = P.inp(I_WADA) + (size_t)l * D * 6144 + col;
            float acc[9];
#pragma unroll
            for (int r = 0; r < 9; ++r) acc[r] = 0.f;
#pragma unroll 1
            for (int k0 = wid * 128; k0 < wid * 128 + 128; k0 += 16) { float wv[16];
#pragma unroll
                for (int j = 0; j < 16; ++j) wv[j] = w[(size_t)(k0 + j) * 6144];
                __builtin_amdgcn_sched_barrier(0);
#pragma unroll
                for (int j = 0; j < 16; ++j) {
#pragma unroll
                    for (int r = 0; r < 9; ++r) acc[r] += sc[r * 1024 + k0 + j] * wv[j]; } }
#pragma unroll
            for (int r = 0; r < 9; ++r) red[(wid * 9 + r) * 64 + lane] = acc[r];
            __syncthreads();
            const float* bada_ = P.inp(I_BADA);
            for (int i = tid; i < 9 * 64; i += 512) { const int r = i >> 6, c = i & 63; float s = bada_[(size_t)l * 6144 + cb * 64 + c];
#pragma unroll
                for (int w8 = 0; w8 < 8; ++w8) s += red[(w8 * 9 + r) * 64 + c];
                P.mod(l, r)[cb * 64 + c] = s; }
            __syncthreads();
        } else if (u < NU_MOD + NU_H2) {
            const int rho = (u - NU_MOD) * 8 + wid;
            const int l = (rho >= 4096 && rho < 8192) ? 1 : 0; const int L = rho < 8192 ? 4096 : 256; const int i = rho < 8192 ? (rho & 4095) : (rho - 8192);
            float featv = 0.f;
            if (lane == 0) featv = (float)((double)i / (double)(L - 1));
            else if (lane < 33) { const int j = (lane - 1) & 15; const double band = 1e-4 + (double)j * ((15.0 - 1e-4) / 15.0);
                const double ang = (2.0 * 3.14159265358979323846 / (double)L) * (double)i * band; featv = lane < 17 ? (float)cos(ang) : (float)(-sin(ang)); }
            const float* hw1_ = P.inp(I_HYW1); const float* hw2_ = P.inp(I_HYW2);
            float z1 = P.inp(I_HYB1)[l * 64 + lane];
            for (int m = 0; m < 33; ++m) z1 += __shfl(featv, m) * hw1_[((size_t)l * 33 + m) * 64 + lane];
            const float h1 = sinf(P.inp(I_HYF1)[l * 64 + lane] * z1);
            float z2 = P.inp(I_HYB2)[l * 64 + lane];
            for (int m = 0; m < 64; ++m) z2 += __shfl(h1, m) * hw2_[((size_t)l * 64 + m) * 64 + lane];
            ((float*)(P.ws + WS_H2TAB))[(size_t)rho * 64 + lane] = sinf(P.inp(I_HYF2)[l * 64 + lane] * z2);
        } else if (u < NU_MOD + NU_H2 + NU_LB) {
            for (int i = tid; i < 4096; i += 512) { const double a = -2.0 * 3.14159265358979323846 * (double)i / 8192.0; ((float*)(P.ws + WS_TW))[2 * i] = (float)cos(a); ((float*)(P.ws + WS_TW))[2 * i + 1] = (float)sin(a); }
            for (int i = tid; i < 1024; i += 512) { const int d = i >> 9, l = (i >> 8) & 1, c = i & 255;
                const float l0 = P.inp(I_HGLB)[d * 512 + c], l1 = P.inp(I_HGLB)[d * 512 + 256 + c];
                ((float*)(P.ws + WS_LB))[i] = l == 0 ? 0.0f : 1.0f / (1.0f + fexp(l0 - l1)); }
        } else {
            conv_unit_ne(P, 0, u - (NU_MOD + NU_H2 + NU_LB), (LAS float*)lds);
        }
    }
}

__device__ __forceinline__ void emit_rows_init(const Ptrs P, LAS float* wdt);
typedef float f32x2v __attribute__((ext_vector_type(2)));
__device__ __forceinline__ void phase_pb(const Ptrs P, LAS unsigned char* lds) {
    const int tid = P.tid, G = P.G;
    for (int u = P.bid; u < 132; u += G) {
        const int tab = u < 64 ? 0 : (u < 128 ? 1 : 2); const int ib = tab == 0 ? u : (tab == 1 ? u - 64 : u - 128);
        const int l = tab == 1 ? 1 : 0; const int L = tab == 2 ? 256 : 4096; const int rho0 = (tab == 0 ? 0 : (tab == 1 ? 4096 : 8192)) + ib * 64;
        LAS float* h2 = (LAS float*)lds;
        { const f32x4* hsrc = (const f32x4*)((const float*)(P.ws + WS_H2TAB) + (size_t)rho0 * 64); const f32x4 t0_ = hsrc[tid], t1_ = hsrc[tid + 512]; ((LAS f32x4*)h2)[tid] = t0_; ((LAS f32x4*)h2)[tid + 512] = t1_; }
        __syncthreads();
        const int o = tid, c = tid & 255, dir = tid >> 8;
        float w3[64]; const float* hw3_ = P.inp(I_HYW3);
#pragma unroll
        for (int j = 0; j < 64; ++j) w3[j] = hw3_[((size_t)l * 64 + j) * 512 + o];
        const float dec = fabsf(P.inp(I_HYDEC)[l * 256 + c]);
        float* filt = tab == 2 ? (float*)(P.ws + WS_FILTC) : (float*)(P.ws + WS_FILT) + (size_t)l * 8192 * 256;
        const int L2 = 2 * L; float part = 0.f;
        for (int r = 0; r < 64; ++r) { const int i = ib * 64 + r; f32x2v sa = (f32x2v){0.f, 0.f}, sb = sa;
#pragma unroll
            for (int j = 0; j < 64; j += 4) { const f32x4 hv = *(const LAS f32x4*)(h2 + r * 64 + j);
                sa += (f32x2v){hv[0], hv[1]} * (f32x2v){w3[j], w3[j + 1]}; sb += (f32x2v){hv[2], hv[3]} * (f32x2v){w3[j + 2], w3[j + 3]}; }
            float s = (sa[0] + sa[1]) + (sb[0] + sb[1]);
            const float t = (float)i / (float)(L - 1); s *= fexp(-t * dec);
            if (dir == 0) { filt[(size_t)i * 256 + c] = s; part += fabsf(s); }
            else if (i == 0) filt[(size_t)L * 256 + c] = 0.f;
            else { filt[(size_t)(L2 - i) * 256 + c] = s; part += fabsf(s); } }
        ((float*)(P.ws + WS_PART))[((size_t)tab * 64 + ib) * 512 + o] = part;
        __syncthreads();
    }
    emit_rows_init(P, (LAS float*)lds);
}
__device__ __forceinline__ float hy_norm(const Ptrs P, int tab, int c) {
    const float* part = (const float*)(P.ws + WS_PART) + (size_t)tab * 64 * 512; const int nb = tab == 2 ? 4 : 64; float s = 0.f;
    for (int b = 0; b < nb; ++b) s += part[b * 512 + c] + part[b * 512 + 256 + c];
    return s;
}

__device__ __forceinline__ void emit_rows_init(const Ptrs P, LAS float* wdt) {
    const int tid = P.tid, wid = tid >> 6, lane = tid & 63, G = P.G;
    load_wdt(P, 0, wdt);
    LAS float* tabA = wdt + 1024 * 8; LAS float* tabB = tabA + 8 * 256 * 2;
    for (int i = tid; i < 2 * 8 * 256; i += 512) { const int tb = i >> 11, a = (i >> 8) & 7, ii = i & 255; const float om = fexp(-9.210340371976184f * (float)ii * (1.0f / 256.0f)); const float ang = (float)(tb ? a : 8 * a) * om;
        LAS float* t = (tb ? tabB : tabA) + a * 512 + ii; t[0] = sinf(ang); t[256] = cosf(ang); }
    __syncthreads();
    const float* xin = P.inp(I_X); const float* cin = P.inp(I_CTX);
    RowV msh, msc; { const float z = zero_f(); for (int i = 0; i < 4; ++i) { msh.v[i] = (f32x4){z, z, z, z}; msc.v[i] = msh.v[i]; } } int mcur = -1;
    RowV n1, n2; { const float z = zero_f(); for (int i = 0; i < 4; ++i) { n1.v[i] = (f32x4){z, z, z, z}; n2.v[i] = n1.v[i]; } }
    if (P.bid < T / 8) { const int rw = P.bid * 8 + wid; row_load(n1, rw < NLAT ? xin + (size_t)rw * D : cin + (size_t)(rw - NLAT) * D, lane); }
    if (P.bid + G < T / 8) { const int rw = (P.bid + G) * 8 + wid; row_load(n2, rw < NLAT ? xin + (size_t)rw * D : cin + (size_t)(rw - NLAT) * D, lane); }
    for (int u = P.bid; u < T / 8; u += G) {
        const int row = u * 8 + wid; RowV r = n1; n1 = n2;
        if (u + 2 * G < T / 8) { const int rw = (u + 2 * G) * 8 + wid; row_load(n2, rw < NLAT ? xin + (size_t)rw * D : cin + (size_t)(rw - NLAT) * D, lane); }
        if (row < NLAT) {
            const int t = row & 4095; const int prow = t >> 6, pcol = t & 63;
#pragma unroll
            for (int hf = 0; hf < 2; ++hf) { const int pos = hf ? pcol : prow; const LAS float* pa = tabA + (pos >> 3) * 512 + lane * 4; const LAS float* pb = tabB + (pos & 7) * 512 + lane * 4;
                const f32x4 sa = *(const LAS f32x4*)pa, ca = *(const LAS f32x4*)(pa + 256), sb = *(const LAS f32x4*)pb, cb = *(const LAS f32x4*)(pb + 256);
                const f32x4 sn = sa * cb + ca * sb, cs = ca * cb - sa * sb;
                r.v[2 * hf] += sn; r.v[2 * hf + 1] += cs; }
        }
        const int mi = row_modidx(row); if (mi != mcur) { mcur = mi; const float* m = P.mod(0, mi); row_load(msh, m, lane); row_load(msc, m + 1024, lane); row_settle(msh); row_settle(msc); }
        RowV h; row_modulate_r(r, h, msh, msc);
        row_store_bf16(h, (bf16_t*)(P.ws + WS_HBUF) + (size_t)row * D, lane);
        row_dt(h, wdt, (float*)(P.ws + WS_DT) + (size_t)row * 8, lane);
    }
}

__device__ __forceinline__ void phase_g1(const Ptrs P, LAS unsigned char* lds) {
    pg8::Gemm g{(const bf16_t*)(P.ws + WS_HBUF), (const bf16_t*)(P.ws + WS_WIN), D};
    EpiBf16Plain E{(bf16_t*)(P.ws + WS_BIG + BIG_U), UC, 0xffff};
    SchedG1 S{XOrder{P.G, P.bid, T / 256, 14}};
    pg8::gemm_phase<EpiBf16Plain, SchedG1, false>(P.tid, lds, g, S, E);
}

constexpr int NCHK = 34;
__device__ __forceinline__ int chunk_row0(int b, int pc) { return pc < 2 ? NLAT + b * CTXL + pc * 128 : b * SEQ + (pc - 2) * 128; }
__device__ __forceinline__ int chunk_at(int dir, int q) { return dir == 0 ? q : (q < 2 ? 1 - q : 35 - q); }
__device__ __forceinline__ int sidx(int kind, int b, int h, int dir, int pc) { return (((kind * 8 + b) * 4 + h) * 2 + dir) * NCHK + pc; }
__device__ __forceinline__ bf16x8 pack8(const float (&v)[8]) { u32x4 w; w.x = pack2(v[0], v[1]); w.y = pack2(v[2], v[3]); w.z = pack2(v[4], v[5]); w.w = pack2(v[6], v[7]); return __builtin_bit_cast(bf16x8, w); }
__device__ __forceinline__ float softplusf_(float x) { return x > 20.f ? x : flog(1.0f + fexp(x)); }
__device__ __forceinline__ float wave_incl_scan(float v, int lane) {
#pragma unroll
    for (int d = 1; d < 64; d <<= 1) { const float t = __shfl_up(v, d); if (lane >= d) v += t; }
    return v;
}

template <bool SILU>
__device__ __forceinline__ void conv3_8(const bf16_t* U, int row, int col0, const float* w, int ncol, int wcol0, const float* bias, float (&out)[8]) {
    const bool hp = row_has_prev(row), hn = row_has_next(row);
    const bf16x8 c = *(const bf16x8*)(U + (size_t)row * UC + col0);
    const bf16x8 p = *(const bf16x8*)(U + (size_t)(hp ? row - 1 : row) * UC + col0), n = *(const bf16x8*)(U + (size_t)(hn ? row + 1 : row) * UC + col0);
    const float mp = hp ? 1.0f : 0.0f, mn = hn ? 1.0f : 0.0f;
#pragma unroll
    for (int h4 = 0; h4 < 2; ++h4) { const f32x4 w0 = *(const f32x4*)(w + wcol0 + 4 * h4), w1 = *(const f32x4*)(w + ncol + wcol0 + 4 * h4), w2 = *(const f32x4*)(w + 2 * ncol + wcol0 + 4 * h4), bb = *(const f32x4*)(bias + wcol0 + 4 * h4);
#pragma unroll
        for (int e = 0; e < 4; ++e) { const int i = 4 * h4 + e; const float v = bf2f((bf16_t)c[i]) * w1[e] + mp * bf2f((bf16_t)p[i]) * w0[e] + mn * bf2f((bf16_t)n[i]) * w2[e] + bb[e]; out[i] = SILU ? siluf_(v) : v; } }
}
__device__ __forceinline__ void conv3_silu8(const bf16_t* U, int row, int col0, const float* w, int ncol, int wcol0, const float* bias, float (&out)[8]) { conv3_8<true>(U, row, col0, w, ncol, wcol0, bias, out); }
struct W8 { f32x4 w0[2], w1[2], w2[2], bb[2]; };
struct U3 { bf16x8 c, p, n; float mp, mn; };
__device__ __forceinline__ void load_w8(W8& W, const float* w, int ncol, int wcol0, const float* bias) {
#pragma unroll
    for (int h4 = 0; h4 < 2; ++h4) { W.w0[h4] = *(const f32x4*)(w + wcol0 + 4 * h4); W.w1[h4] = *(const f32x4*)(w + ncol + wcol0 + 4 * h4); W.w2[h4] = *(const f32x4*)(w + 2 * ncol + wcol0 + 4 * h4); W.bb[h4] = *(const f32x4*)(bias + wcol0 + 4 * h4); }
}
__device__ __forceinline__ void load_u3(U3& X, const bf16_t* U, int row, int col0) {
    const bool hp = row_has_prev(row), hn = row_has_next(row);
    X.c = *(const bf16x8*)(U + (size_t)row * UC + col0); X.p = *(const bf16x8*)(U + (size_t)(hp ? row - 1 : row) * UC + col0); X.n = *(const bf16x8*)(U + (size_t)(hn ? row + 1 : row) * UC + col0);
    X.mp = hp ? 1.0f : 0.0f; X.mn = hn ? 1.0f : 0.0f;
}
template <bool SILU>
__device__ __forceinline__ void conv3_8x(const U3& X, const W8& W, float (&out)[8]) {
#pragma unroll
    for (int h4 = 0; h4 < 2; ++h4)
#pragma unroll
        for (int e = 0; e < 4; ++e) { const int i = 4 * h4 + e; const float v = bf2f((bf16_t)X.c[i]) * W.w1[h4][e] + X.mp * bf2f((bf16_t)X.p[i]) * W.w0[h4][e] + X.mn * bf2f((bf16_t)X.n[i]) * W.w2[h4][e] + W.bb[h4][e]; out[i] = SILU ? siluf_(v) : v; }
}
__device__ __forceinline__ void conv16_silu(const bf16_t* U, int r0, int col, const float* w, int ncol, int wcol, float bias, float (&out)[16]) {
    const bool hp = row_has_prev(r0), hn = row_has_next(r0 + 15);
    float x[18];
#pragma unroll
    for (int i = 0; i < 18; ++i) { const int r = (i == 0 && !hp) ? r0 : ((i == 17 && !hn) ? r0 + 15 : r0 - 1 + i); x[i] = bf2f(U[(size_t)r * UC + col]); }
    if (!hp) x[0] = 0.f; if (!hn) x[17] = 0.f;
    const float w0 = w[wcol], w1 = w[ncol + wcol], w2 = w[2 * ncol + wcol];
#pragma unroll
    for (int j = 0; j < 16; ++j) out[j] = siluf_(x[j] * w0 + x[j + 1] * w1 + x[j + 2] * w2 + bias);
}
__device__ __forceinline__ void store16_bf16(LAS bf16_t* dst, const float (&v)[16]) {
    u32x4 a, b; a.x = pack2(v[0], v[1]); a.y = pack2(v[2], v[3]); a.z = pack2(v[4], v[5]); a.w = pack2(v[6], v[7]); b.x = pack2(v[8], v[9]); b.y = pack2(v[10], v[11]); b.z = pack2(v[12], v[13]); b.w = pack2(v[14], v[15]);
    *(LAS u32x4*)dst = a; *(LAS u32x4*)(dst + 8) = b;
}

__device__ __forceinline__ void scatter8_T(LAS bf16_t* dstT, int g8, int p, const float (&v)[8]) {
#pragma unroll
    for (int e2 = 0; e2 < 4; ++e2) { const unsigned w = pack2(v[2 * e2], v[2 * e2 + 1]); dstT[(8 * g8 + 2 * e2) * 136 + p] = (bf16_t)(w & 0xffffu); dstT[(8 * g8 + 2 * e2 + 1) * 136 + p] = (bf16_t)(w >> 16); }
}

__device__ __forceinline__ void hgrn_pass1(const Ptrs P, int l, int unit, LAS unsigned char* lds) {
    const int tid = P.tid, lane = tid & 63, wid = tid >> 6, fr = lane & 15, fq = lane >> 4;
    const int pc = unit % NCHK; const int r_ = unit / NCHK; const int h = r_ & 3; const int b = r_ >> 2;
    const int row0 = chunk_row0(b, pc);
    const bf16_t* U = (const bf16_t*)(P.ws + WS_BIG + BIG_U);
    LAS bf16_t* KTF = (LAS bf16_t*)lds; LAS bf16_t* KTB = KTF + 64 * 136; LAS bf16_t* VT = KTB + 64 * 136; LAS float* segtot = (LAS float*)(VT + 64 * 136);
    LAS bf16_t* FS = (LAS bf16_t*)(lds + 65536);
    const float lbf = ((const float*)(P.ws + WS_LB))[(0 * 2 + l) * 256 + h * 64 + lane], lbb = ((const float*)(P.ws + WS_LB))[(1 * 2 + l) * 256 + h * 64 + lane];
    {
        bf16x8 ff8[2], fb8[2], v8[2];
#pragma unroll
        for (int k = 0; k < 2; ++k) { const int it = tid + 512 * k; const int p = it >> 3, g8 = it & 7; const bf16_t* ur = U + (size_t)(row0 + p) * UC + h * 64 + 8 * g8;
            ff8[k] = *(const bf16x8*)(ur + 1792); fb8[k] = *(const bf16x8*)(ur + 2048); v8[k] = *(const bf16x8*)(ur + 2304); }
        __builtin_amdgcn_sched_barrier(0);
#pragma unroll
        for (int k = 0; k < 2; ++k) { const int it = tid + 512 * k; const int p = it >> 3, g8 = it & 7;
            *(LAS bf16x8*)(FS + p * 64 + 8 * g8) = ff8[k]; *(LAS bf16x8*)(FS + 8192 + p * 64 + 8 * g8) = fb8[k];
#pragma unroll
            for (int e = 0; e < 8; ++e) VT[(8 * g8 + e) * 136 + p] = (bf16_t)v8[k][e]; } }
    __syncthreads();
    const int ch = lane, seg = wid;
    float cf[16], cb[16], kf[16], kb[16]; float runf = 0.f, runb = 0.f;
#pragma unroll
    for (int j = 0; j < 16; ++j) { const int p = 16 * seg + j;
        const float ff = lbf + (1.0f - lbf) * sigmoidf_(bf2f(FS[p * 64 + ch])), fb = lbb + (1.0f - lbb) * sigmoidf_(bf2f(FS[8192 + p * 64 + ch]));
        runf += flog(ff); cf[j] = runf; kf[j] = 1.0f - ff; cb[j] = runb; runb += flog(fb); kb[j] = 1.0f - fb; }
    segtot[seg * 64 + ch] = runf; segtot[512 + seg * 64 + ch] = runb; __syncthreads();
    float offf = 0.f, totf = 0.f, offb = 0.f, totb = 0.f;
#pragma unroll
    for (int s = 0; s < 8; ++s) { const float a = segtot[s * 64 + ch], c = segtot[512 + s * 64 + ch]; totf += a; totb += c; offf += (s < seg) ? a : 0.f; offb += (s < seg) ? c : 0.f; }
    { float t[16];
#pragma unroll
      for (int j = 0; j < 16; ++j) t[j] = kf[j] * fexp(totf - offf - cf[j]);
      store16_bf16(KTF + ch * 136 + 16 * seg, t);
#pragma unroll
      for (int j = 0; j < 16; ++j) t[j] = kb[j] * fexp(offb + cb[j]);
      store16_bf16(KTB + ch * 136 + 16 * seg, t); }
    const int sif = sidx(0, b, h, 0, pc), sib = sidx(0, b, h, 1, pc);
    if (seg == 0) { ((float*)(P.ws + WS_DEC))[(size_t)sif * 64 + ch] = fexp(totf); ((float*)(P.ws + WS_DEC))[(size_t)sib * 64 + ch] = fexp(totb); }
    __syncthreads();
    const int mt = wid >> 1, nt0 = (wid & 1) * 2;
    f32x4 af[2], ab[2]; af[0] = (f32x4){0.f, 0.f, 0.f, 0.f}; af[1] = af[0]; ab[0] = af[0]; ab[1] = af[0];
#pragma unroll
    for (int ks = 0; ks < 4; ++ks) { const bf16x8 a0 = *(const LAS bf16x8*)(KTF + (16 * mt + fr) * 136 + 32 * ks + 8 * fq), a1 = *(const LAS bf16x8*)(KTB + (16 * mt + fr) * 136 + 32 * ks + 8 * fq);
#pragma unroll
        for (int n = 0; n < 2; ++n) { const bf16x8 bb = *(const LAS bf16x8*)(VT + (16 * (nt0 + n) + fr) * 136 + 32 * ks + 8 * fq);
            af[n] = __builtin_amdgcn_mfma_f32_16x16x32_bf16(a0, bb, af[n], 0, 0, 0); ab[n] = __builtin_amdgcn_mfma_f32_16x16x32_bf16(a1, bb, ab[n], 0, 0, 0); } }
    bf16_t* SF = (bf16_t*)(P.ws + WS_BIG + BIG_STATE) + (size_t)sif * 4096; bf16_t* SB = (bf16_t*)(P.ws + WS_BIG + BIG_STATE) + (size_t)sib * 4096;
#pragma unroll
    for (int n = 0; n < 2; ++n) { const int o = (16 * (nt0 + n) + fr) * 64 + 16 * mt + 4 * fq; u32x2 wf, wb;
        wf.x = pack2(af[n][0], af[n][1]); wf.y = pack2(af[n][2], af[n][3]); wb.x = pack2(ab[n][0], ab[n][1]); wb.y = pack2(ab[n][2], ab[n][3]);
        *(u32x2*)(SF + o) = wf; *(u32x2*)(SB + o) = wb; }
    __syncthreads();
}

__device__ __forceinline__ void ssd_pass1(const Ptrs P, int l, int unit, LAS unsigned char* lds) {
    const int tid = P.tid, lane = tid & 63, wid = tid >> 6, fr = lane & 15, fq = lane >> 4;
    const int pc = unit % NCHK; const int r_ = unit / NCHK; const int g = r_ & 1; const int b = r_ >> 1;
    const int row0 = chunk_row0(b, pc);
    const bf16_t* U = (const bf16_t*)(P.ws + WS_BIG + BIG_U);
    const float* scw = P.inp(I_SSDCW) + (size_t)l * 3 * 512; const float* scb = P.inp(I_SSDCB) + l * 512;
    LAS bf16_t* BT = (LAS bf16_t*)lds; LAS bf16_t* XT = BT + 64 * 136;
    LAS float* wgt = (LAS float*)(XT + 4 * 64 * 136);
    const int g8 = tid & 7, pq = tid >> 3;
    const int cB = 256 + g * 64 + 8 * g8; W8 WB; load_w8(WB, scw, 512, cB, scb); U3 xB[2];
#pragma unroll
    for (int k = 0; k < 2; ++k) load_u3(xB[k], U, row0 + pq + 64 * k, 3072 + cB);
    if (wid < 4) {
        const int hh = 2 * g + (wid >> 1), dir = wid & 1;
        const float Aneg = -fexp(P.inp(I_SSDALOG)[(l * 2 + dir) * 4 + hh]); const float dtb = P.inp(I_SSDDTB)[(l * 2 + dir) * 4 + hh]; const float* DT = (const float*)(P.ws + WS_DT);
        const int p0 = 2 * lane; const float d0 = softplusf_(DT[(size_t)(row0 + p0) * 8 + dir * 4 + hh] + dtb), d1 = softplusf_(DT[(size_t)(row0 + p0 + 1) * 8 + dir * 4 + hh] + dtb);
        const float a0 = Aneg * d0, a1 = Aneg * d1; const float inc = wave_incl_scan(a0 + a1, lane); const float tot = __uint_as_float(__builtin_amdgcn_readlane(__float_as_uint(inc), 63));
        if (dir == 0) { wgt[wid * 128 + p0] = d0 * fexp(tot - (inc - a1)); wgt[wid * 128 + p0 + 1] = d1 * fexp(tot - inc); }
        else { wgt[wid * 128 + p0] = d0 * fexp(inc - a1 - a0); wgt[wid * 128 + p0 + 1] = d1 * fexp(inc - a1); }
        if (lane == 0) ((float*)(P.ws + WS_DEC))[(size_t)sidx(1, b, hh, dir, pc) * 64] = fexp(tot);
    }
    {
#pragma unroll
        for (int k = 0; k < 2; ++k) { float t8[8]; conv3_8x<true>(xB[k], WB, t8); scatter8_T(BT, g8, pq + 64 * k, t8); }
        __syncthreads();
#pragma unroll 1
        for (int hq = 0; hq < 2; ++hq) { const int c0 = (2 * g + hq) * 64 + 8 * g8; W8 W; load_w8(W, scw, 512, c0, scb); U3 x[2];
#pragma unroll
            for (int k = 0; k < 2; ++k) load_u3(x[k], U, row0 + pq + 64 * k, 3072 + c0);
            __builtin_amdgcn_sched_barrier(0);
#pragma unroll
            for (int k = 0; k < 2; ++k) { const int p = pq + 64 * k; float x8[8], t8[8]; conv3_8x<true>(x[k], W, x8);
#pragma unroll
                for (int dir = 0; dir < 2; ++dir) { const int cmb = 2 * hq + dir; const float wv = wgt[cmb * 128 + p];
#pragma unroll
                    for (int e = 0; e < 8; ++e) t8[e] = x8[e] * wv;
                    scatter8_T(XT + cmb * 64 * 136, g8, p, t8); } } }
    }
    __syncthreads();
    {
        const int cmb = wid >> 1; const int hh = 2 * g + (cmb >> 1), dir = cmb & 1;
        bf16_t* S = (bf16_t*)(P.ws + WS_BIG + BIG_STATE) + (size_t)sidx(1, b, hh, dir, pc) * 4096;
#pragma unroll
        for (int mi = 0; mi < 2; ++mi) { const int mt = 2 * (wid & 1) + mi; f32x4 acc[4];
#pragma unroll
            for (int n = 0; n < 4; ++n) acc[n] = (f32x4){0.f, 0.f, 0.f, 0.f};
#pragma unroll
            for (int ks = 0; ks < 4; ++ks) { const bf16x8 a = *(const LAS bf16x8*)(XT + (cmb * 64 + 16 * mt + fr) * 136 + 32 * ks + 8 * fq);
#pragma unroll
                for (int n = 0; n < 4; ++n) { const bf16x8 bb = *(const LAS bf16x8*)(BT + (16 * n + fr) * 136 + 32 * ks + 8 * fq); acc[n] = __builtin_amdgcn_mfma_f32_16x16x32_bf16(bb, a, acc[n], 0, 0, 0); } }
#pragma unroll
            for (int n = 0; n < 4; ++n) { u32x2 w; w.x = pack2(acc[n][0], acc[n][1]); w.y = pack2(acc[n][2], acc[n][3]); *(u32x2*)(S + (16 * mt + fr) * 64 + 16 * n + 4 * fq) = w; } }
    }
    __syncthreads();
}

__device__ __forceinline__ void ssd_dt_cum(const Ptrs P, int l, int row0, int dir, int h, int wid, int lane, LAS float* cum, LAS float* dtv) {
    if (wid == 0) {
        const float Aneg = -fexp(P.inp(I_SSDALOG)[(l * 2 + dir) * 4 + h]); const float dtb = P.inp(I_SSDDTB)[(l * 2 + dir) * 4 + h]; const float* DT = (const float*)(P.ws + WS_DT);
        const int t0 = 2 * lane, p0 = dir ? 127 - t0 : t0, p1 = dir ? 126 - t0 : t0 + 1;
        const float d0 = softplusf_(DT[(size_t)(row0 + p0) * 8 + dir * 4 + h] + dtb), d1 = softplusf_(DT[(size_t)(row0 + p1) * 8 + dir * 4 + h] + dtb);
        const float a0 = Aneg * d0, a1 = Aneg * d1; const float inc = wave_incl_scan(a0 + a1, lane);
        cum[t0] = inc - a1; cum[t0 + 1] = inc; dtv[t0] = d0; dtv[t0 + 1] = d1;
    }
}

template <int KIND>
__device__ __forceinline__ void scan_pass2_k(const Ptrs P, int b, int h, int dir, int half) {
    const int e0 = half * 2048 + P.tid * 4; const int base = sidx(KIND, b, h, dir, 0);
    bf16_t* ST = (bf16_t*)(P.ws + WS_BIG + BIG_STATE); const float* DEC = (const float*)(P.ws + WS_DEC);
    const float zf = zero_f(); f32x4 run = (f32x4){zf, zf, zf, zf};
#pragma unroll 1
    for (int q0 = 0; q0 < NCHK; q0 += 8) {
        u32x2 loc[8]; f32x4 dd[8];
#pragma unroll
        for (int k = 0; k < 8; ++k) { const int q = (q0 + k < NCHK) ? q0 + k : NCHK - 1; const int pc = chunk_at(dir, q);
            loc[k] = *(const u32x2*)(ST + (size_t)(base + pc) * 4096 + e0);
            if (KIND == 0) dd[k] = *(const f32x4*)(DEC + (size_t)(base + pc) * 64 + (e0 & 63)); else { const float d = DEC[(size_t)(base + pc) * 64]; dd[k] = (f32x4){d, d, d, d}; } }
        __builtin_amdgcn_sched_barrier(0);
#pragma unroll
        for (int k = 0; k < 8; ++k) { if (q0 + k < NCHK) { const int pc = chunk_at(dir, q0 + k);
            u32x2 w; w.x = pack2(run[0], run[1]); w.y = pack2(run[2], run[3]); *(u32x2*)(ST + (size_t)(base + pc) * 4096 + e0) = w;
            const f32x4 lv = (f32x4){__uint_as_float(loc[k].x << 16), __uint_as_float(loc[k].x & 0xffff0000u), __uint_as_float(loc[k].y << 16), __uint_as_float(loc[k].y & 0xffff0000u)};
            run = run * dd[k] + lv; } }
    }
}
__device__ __forceinline__ void scan_pass2(const Ptrs P, int unit) {
    const int seq = unit >> 1, half = unit & 1; const int kind = seq >> 6, b = (seq >> 3) & 7, h = (seq >> 1) & 3, dir = seq & 1;
    if (kind == 0) scan_pass2_k<0>(P, b, h, dir, half); else scan_pass2_k<1>(P, b, h, dir, half);
}

__device__ __forceinline__ int qk_off(int p, int chunk) { return p * 64 + ((chunk ^ (p & 7)) << 3); }
__device__ __forceinline__ void hgrn_pass3(const Ptrs P, int l, int unit, int unit_next, LAS unsigned char* lds) {
    const int tid = P.tid, lane = tid & 63, wid = tid >> 6, fr = lane & 15, fq = lane >> 4;
    const int pc = unit % NCHK; const int r_ = unit / NCHK; const int h = r_ & 3; const int b = r_ >> 2;
    const int row0 = chunk_row0(b, pc);
    const bf16_t* U = (const bf16_t*)(P.ws + WS_BIG + BIG_U);
    LAS bf16_t* QF = (LAS bf16_t*)lds; LAS bf16_t* KF = QF + 128 * 64; LAS bf16_t* QB = KF + 128 * 64; LAS bf16_t* KB = QB + 128 * 64; LAS bf16_t* VT = KB + 128 * 64;
    LAS bf16_t* STF = VT + 64 * 136; LAS bf16_t* STB = STF + 64 * 72; LAS float* ETF = (LAS float*)(STB + 64 * 72); LAS float* ETB = ETF + 512; LAS bf16_t* PW = (LAS bf16_t*)(ETB + 512);
    LAS float* OUT = (LAS float*)lds;
    const float lbf = ((const float*)(P.ws + WS_LB))[(0 * 2 + l) * 256 + h * 64 + lane], lbb = ((const float*)(P.ws + WS_LB))[(1 * 2 + l) * 256 + h * 64 + lane];
    {
        LAS bf16_t* FS = PW;
        const bf16_t* SF = (const bf16_t*)(P.ws + WS_BIG + BIG_STATE) + (size_t)sidx(0, b, h, 0, pc) * 4096; const bf16_t* SB = (const bf16_t*)(P.ws + WS_BIG + BIG_STATE) + (size_t)sidx(0, b, h, 1, pc) * 4096;
        bf16x8 ff8[2], fb8[2], q8[2], v8[2];
#pragma unroll
        for (int k = 0; k < 2; ++k) { const int it = tid + 512 * k; const int p = it >> 3, g8 = it & 7; const bf16_t* ur = U + (size_t)(row0 + p) * UC + h * 64 + 8 * g8;
            ff8[k] = *(const bf16x8*)(ur + 1792); fb8[k] = *(const bf16x8*)(ur + 2048); q8[k] = *(const bf16x8*)(ur + 1536); v8[k] = *(const bf16x8*)(ur + 2304); }
        const bf16x8 sf8 = *(const bf16x8*)(SF + tid * 8), sb8 = *(const bf16x8*)(SB + tid * 8);
        __builtin_amdgcn_sched_barrier(0);
#pragma unroll
        for (int k = 0; k < 2; ++k) { const int it = tid + 512 * k; const int p = it >> 3, g8 = it & 7;
            *(LAS bf16x8*)(FS + p * 64 + 8 * g8) = ff8[k]; *(LAS bf16x8*)(FS + 8192 + p * 64 + 8 * g8) = fb8[k];
            float qs[8];
#pragma unroll
            for (int e = 0; e < 8; ++e) qs[e] = bf2f((bf16_t)q8[k][e]) * 0.125f;
            const bf16x8 qp = pack8(qs); *(LAS bf16x8*)(QF + qk_off(p, g8)) = qp; *(LAS bf16x8*)(QB + qk_off(p, g8)) = qp;
#pragma unroll
            for (int e = 0; e < 8; ++e) VT[(8 * g8 + e) * 136 + p] = (bf16_t)v8[k][e]; }
        { const int dv = tid >> 3, c8 = (tid & 7) * 8;
          *(LAS bf16x8*)(STF + dv * 72 + c8) = sf8; *(LAS bf16x8*)(STB + dv * 72 + c8) = sb8; }
    }
    __syncthreads();
    {
        LAS bf16_t* FS = PW;
        const int ch = lane, seg = wid;
        float bfw[16], bbw[16], kf[16], kb[16];
#pragma unroll
        for (int j = 0; j < 16; ++j) { const int p = 16 * seg + j;
            const float ff = lbf + (1.0f - lbf) * sigmoidf_(bf2f(FS[p * 64 + ch])), fb = lbb + (1.0f - lbb) * sigmoidf_(bf2f(FS[8192 + p * 64 + ch]));
            bfw[j] = flog(ff); bbw[j] = flog(fb); kf[j] = 1.0f - ff; kb[j] = 1.0f - fb; }
#pragma unroll
        for (int j = 1; j < 16; ++j) bfw[j] += bfw[j - 1];
#pragma unroll
        for (int j = 14; j >= 0; --j) bbw[j] += bbw[j + 1];
        const float etf = bfw[15], etb = bbw[0];
        ETF[seg * 64 + ch] = etf; ETB[seg * 64 + ch] = etb;
        const int chunk = ch >> 3, sub = ch & 7;
#pragma unroll
        for (int j = 0; j < 16; ++j) { const int p = 16 * seg + j; const int o = qk_off(p, chunk) + sub; const float qv = bf2f(QF[o]);
            const unsigned wq = pack2(qv * fexp(bfw[j]), qv * fexp(bbw[j])), wk = pack2(kf[j] * fexp(etf - bfw[j]), kb[j] * fexp(etb - bbw[j]));
            QF[o] = (bf16_t)(wq & 0xffffu); QB[o] = (bf16_t)(wq >> 16); KF[o] = (bf16_t)(wk & 0xffffu); KB[o] = (bf16_t)(wk >> 16); }
    }
    __syncthreads();
    const bf16_t* gp_ = U + (size_t)(row0 + (tid >> 2)) * UC + 2560 + h * 64 + 16 * (tid & 3); const bf16x8 g0 = *(const bf16x8*)gp_, g1 = *(const bf16x8*)(gp_ + 8);
    const float* ngpp_ = P.inp(I_HGNG) + l * 64 + 16 * (tid & 3); const f32x4 n0 = *(const f32x4*)ngpp_, n1 = *(const f32x4*)(ngpp_ + 4), n2 = *(const f32x4*)(ngpp_ + 8), n3 = *(const f32x4*)(ngpp_ + 12);
    f32x4 o[4];
    {
        const int i = wid; LAS bf16_t* pw = PW + wid * 16 * 136;
#pragma unroll
        for (int nt = 0; nt < 4; ++nt) o[nt] = (f32x4){0.f, 0.f, 0.f, 0.f};
#pragma unroll 1
        for (int dir = 0; dir < 2; ++dir) {
            const LAS bf16_t* QA = dir ? QB : QF; const LAS bf16_t* KA = dir ? KB : KF; const LAS float* ET = dir ? ETB : ETF; const LAS bf16_t* ST = dir ? STB : STF;
            bf16x8 qf[2]; float g[2][8];
#pragma unroll
            for (int ks = 0; ks < 2; ++ks) { qf[ks] = *(const LAS bf16x8*)(QA + qk_off(16 * i + fr, 4 * ks + fq));
                const f32x4 e0 = *(const LAS f32x4*)(ET + i * 64 + 32 * ks + 8 * fq), e1 = *(const LAS f32x4*)(ET + i * 64 + 32 * ks + 8 * fq + 4);
                g[ks][0] = -e0[0]; g[ks][1] = -e0[1]; g[ks][2] = -e0[2]; g[ks][3] = -e0[3]; g[ks][4] = -e1[0]; g[ks][5] = -e1[1]; g[ks][6] = -e1[2]; g[ks][7] = -e1[3]; }
            const int nj = dir ? 8 - i : i + 1;
            for (int jj = 0; jj < nj; ++jj) { const int j = dir ? i + jj : i - jj;
                f32x4 d = (f32x4){0.f, 0.f, 0.f, 0.f};
#pragma unroll
                for (int ks = 0; ks < 2; ++ks) { float a8[8];
                    const bf16x8 kfr = *(const LAS bf16x8*)(KA + qk_off(16 * j + fr, 4 * ks + fq));
                    const f32x4 e0 = *(const LAS f32x4*)(ET + j * 64 + 32 * ks + 8 * fq), e1 = *(const LAS f32x4*)(ET + j * 64 + 32 * ks + 8 * fq + 4);
#pragma unroll
                    for (int e = 0; e < 8; ++e) a8[e] = bf2f((bf16_t)qf[ks][e]) * fexp(g[ks][e]);
                    d = __builtin_amdgcn_mfma_f32_16x16x32_bf16(kfr, pack8(a8), d, 0, 0, 0);
                    g[ks][0] += e0[0]; g[ks][1] += e0[1]; g[ks][2] += e0[2]; g[ks][3] += e0[3]; g[ks][4] += e1[0]; g[ks][5] += e1[1]; g[ks][6] += e1[2]; g[ks][7] += e1[3]; }
                if (jj == 0) {
#pragma unroll
                    for (int r = 0; r < 4; ++r) d[r] = (dir ? (4 * fq + r >= fr) : (4 * fq + r <= fr)) ? d[r] : 0.f; }
                u32x2 w; w.x = pack2(d[0], d[1]); w.y = pack2(d[2], d[3]); *(LAS u32x2*)(pw + fr * 136 + 16 * j + 4 * fq) = w;
            }
            { const int zb = dir ? i - 1 : i + 1; const bool need = dir ? ((i & 1) == 1) : ((i & 1) == 0);
              if (need) { u32x2 z; z.x = __float_as_uint(zero_f()); z.y = z.x; *(LAS u32x2*)(pw + fr * 136 + 16 * zb + 4 * fq) = z; } }
            const int kslo = dir ? (i >> 1) : 0, kshi = dir ? 3 : (i >> 1);
            for (int ks = kslo; ks <= kshi; ++ks) { const bf16x8 pa = *(const LAS bf16x8*)(pw + fr * 136 + 32 * ks + 8 * fq);
#pragma unroll
                for (int nt = 0; nt < 4; ++nt) { const bf16x8 vf = *(const LAS bf16x8*)(VT + (16 * nt + fr) * 136 + 32 * ks + 8 * fq); o[nt] = __builtin_amdgcn_mfma_f32_16x16x32_bf16(pa, vf, o[nt], 0, 0, 0); } }
#pragma unroll
            for (int ks = 0; ks < 2; ++ks) { float a8[8];
                bf16x8 sf[4];
#pragma unroll
                for (int nt = 0; nt < 4; ++nt) sf[nt] = *(const LAS bf16x8*)(ST + (16 * nt + fr) * 72 + 32 * ks + 8 * fq);
#pragma unroll
                for (int e = 0; e < 8; ++e) a8[e] = bf2f((bf16_t)qf[ks][e]) * fexp(g[ks][e]);
                const bf16x8 qa = pack8(a8);
#pragma unroll
                for (int nt = 0; nt < 4; ++nt) o[nt] = __builtin_amdgcn_mfma_f32_16x16x32_bf16(qa, sf[nt], o[nt], 0, 0, 0); }
        }
    }
    __syncthreads();
#pragma unroll
    for (int nt = 0; nt < 4; ++nt)
#pragma unroll
        for (int r = 0; r < 4; ++r) OUT[(16 * wid + 4 * fq + r) * 64 + 16 * nt + fr] = o[nt][r];
    __syncthreads();
    {
        const int pos = tid >> 2, qd = tid & 3; const int row = row0 + pos; bf16_t* BR2 = (bf16_t*)(P.ws + WS_BR) + (size_t)2 * T * 256;
        float ngp[16], ov[16], q = 0.f;
        {
#pragma unroll
          for (int e = 0; e < 4; ++e) { ngp[e] = n0[e]; ngp[4 + e] = n1[e]; ngp[8 + e] = n2[e]; ngp[12 + e] = n3[e]; } }
#pragma unroll
        for (int e4 = 0; e4 < 4; ++e4) { const f32x4 v = *(const LAS f32x4*)(OUT + pos * 64 + 16 * qd + 4 * e4); ov[4 * e4] = v[0]; ov[4 * e4 + 1] = v[1]; ov[4 * e4 + 2] = v[2]; ov[4 * e4 + 3] = v[3]; q += v[0] * v[0] + v[1] * v[1] + v[2] * v[2] + v[3] * v[3]; }
        q += WS_DPP(q, 0xB1); q += WS_DPP(q, 0x4E);
        const float rs = rsqrtf(q * (1.0f / 64.0f) + kconst(RMS_EPS)); float t8[8];
#pragma unroll
        for (int e = 0; e < 8; ++e) t8[e] = ov[e] * rs * ngp[e] * siluf_(bf2f((bf16_t)g0[e]));
        *(bf16x8*)(BR2 + (size_t)row * 256 + h * 64 + 16 * qd) = pack8(t8);
#pragma unroll
        for (int e = 0; e < 8; ++e) t8[e] = ov[8 + e] * rs * ngp[8 + e] * siluf_(bf2f((bf16_t)g1[e]));
        *(bf16x8*)(BR2 + (size_t)row * 256 + h * 64 + 16 * qd + 8) = pack8(t8);
    }
    __syncthreads();
}

__device__ __forceinline__ void ssd_pass3(const Ptrs P, int l, int unit, LAS unsigned char* lds) {
    const int tid = P.tid, lane = tid & 63, wid = tid >> 6, fr = lane & 15, fq = lane >> 4;
    const int pc = unit % NCHK; const int r_ = unit / NCHK; const int g = r_ & 1; const int b = r_ >> 1;
    const int row0 = chunk_row0(b, pc);
    const bf16_t* U = (const bf16_t*)(P.ws + WS_BIG + BIG_U);
    const float* scw = P.inp(I_SSDCW) + (size_t)l * 3 * 512; const float* scb = P.inp(I_SSDCB) + l * 512;
    LAS bf16_t* CM = (LAS bf16_t*)lds; LAS bf16_t* BM = CM + 128 * 72; LAS bf16_t* XT = BM + 128 * 72; LAS bf16_t* STF = XT + 64 * 136; LAS bf16_t* STB = STF + 64 * 72;
    LAS float* cumfA = (LAS float*)(STB + 64 * 72); LAS float* cumbA = cumfA + 256; LAS float* dtfA = cumbA + 256; LAS float* dtbA = dtfA + 256;
    LAS bf16_t* PW = (LAS bf16_t*)(dtbA + 256); LAS float* OUT = (LAS float*)(PW + 8 * 16 * 136);
    const int cg_ = tid & 15, pq_ = tid >> 4; const int isb_ = cg_ >> 3, c8_ = 8 * (cg_ & 7); const int cc_ = (isb_ ? 256 : 384) + g * 64 + c8_;
    W8 WC; load_w8(WC, scw, 512, cc_, scb); U3 xC[4];
#pragma unroll
    for (int k = 0; k < 4; ++k) load_u3(xC[k], U, row0 + pq_ + 32 * k, 3072 + cc_);
    if (wid < 4) {
        const int hq = wid >> 1, dir = wid & 1, h = 2 * g + hq; const float Aneg = -fexp(P.inp(I_SSDALOG)[(l * 2 + dir) * 4 + h]); const float dtbias = P.inp(I_SSDDTB)[(l * 2 + dir) * 4 + h]; const float* DT = (const float*)(P.ws + WS_DT);
        const int p0 = 2 * lane; const float d0 = softplusf_(DT[(size_t)(row0 + p0) * 8 + dir * 4 + h] + dtbias), d1 = softplusf_(DT[(size_t)(row0 + p0 + 1) * 8 + dir * 4 + h] + dtbias);
        const float a0 = Aneg * d0, a1 = Aneg * d1; const float inc = wave_incl_scan(a0 + a1, lane);
        if (dir == 0) { cumfA[hq * 128 + p0] = inc - a1; cumfA[hq * 128 + p0 + 1] = inc; dtfA[hq * 128 + p0] = d0; dtfA[hq * 128 + p0 + 1] = d1; }
        else { const float tot = __uint_as_float(__builtin_amdgcn_readlane(__float_as_uint(inc), 63)); cumbA[hq * 128 + p0] = tot - inc + a0 + a1; cumbA[hq * 128 + p0 + 1] = tot - inc + a1; dtbA[hq * 128 + p0] = d0; dtbA[hq * 128 + p0 + 1] = d1; }
    }
    {
#pragma unroll
        for (int k = 0; k < 4; ++k) { float t8[8]; conv3_8x<true>(xC[k], WC, t8); *(LAS bf16x8*)((isb_ ? BM : CM) + (pq_ + 32 * k) * 72 + c8_) = pack8(t8); }
    }
#pragma unroll 1
    for (int hq = 0; hq < 2; ++hq) {
        const int h = 2 * g + hq;
        bf16x8 rz[2];
        { const int g8 = tid & 7, pq = tid >> 3; W8 W; load_w8(W, scw, 512, h * 64 + 8 * g8, scb); U3 x[2];
#pragma unroll
          for (int k = 0; k < 2; ++k) load_u3(x[k], U, row0 + pq + 64 * k, 3072 + h * 64 + 8 * g8);
          const bf16_t* SF = (const bf16_t*)(P.ws + WS_BIG + BIG_STATE) + (size_t)sidx(1, b, h, 0, pc) * 4096; const bf16_t* SB = (const bf16_t*)(P.ws + WS_BIG + BIG_STATE) + (size_t)sidx(1, b, h, 1, pc) * 4096;
          const int idx = tid * 8; const bf16x8 sf8 = *(const bf16x8*)(SF + idx), sb8 = *(const bf16x8*)(SB + idx);
          { const int pos = tid >> 2, qd = tid & 3; const int row = row0 + pos; const int c0 = h * 64 + 16 * qd; const bf16_t* zp = U + (size_t)row * UC + 2816 + c0;
#pragma unroll
            for (int hf = 0; hf < 2; ++hf) rz[hf] = *(const bf16x8*)(zp + 8 * hf); }
          __builtin_amdgcn_sched_barrier(0);
#pragma unroll
          for (int k = 0; k < 2; ++k) { float x8[8]; conv3_8x<true>(x[k], W, x8); scatter8_T(XT, g8, pq + 64 * k, x8); }
          *(LAS bf16x8*)(STF + (idx >> 6) * 72 + (idx & 63)) = sf8; *(LAS bf16x8*)(STB + (idx >> 6) * 72 + (idx & 63)) = sb8; }
        LAS float* cumf = cumfA + hq * 128; LAS float* cumb = cumbA + hq * 128; LAS float* dtf = dtfA + hq * 128; LAS float* dtb = dtbA + hq * 128;
        __syncthreads();
        {
            const int i = wid; LAS bf16_t* pw = PW + wid * 16 * 136;
            bf16x8 cf[2];
#pragma unroll
            for (int ks = 0; ks < 2; ++ks) cf[ks] = *(const LAS bf16x8*)(CM + (16 * i + fr) * 72 + 32 * ks + 8 * fq);
            f32x4 o[4];
#pragma unroll
            for (int nt = 0; nt < 4; ++nt) o[nt] = (f32x4){0.f, 0.f, 0.f, 0.f};
#pragma unroll 1
            for (int dir = 0; dir < 2; ++dir) {
                const LAS float* cum = dir ? cumb : cumf; const LAS float* dtv = dir ? dtb : dtf; const LAS bf16_t* ST = dir ? STB : STF;
                const float cq = cum[16 * i + fr];
                const int jlo = dir ? i : 0, jhi = dir ? 7 : i;
                for (int j = jlo; j <= jhi; ++j) {
                    f32x4 d = (f32x4){0.f, 0.f, 0.f, 0.f};
                    const bf16x8 bf0 = *(const LAS bf16x8*)(BM + (16 * j + fr) * 72 + 8 * fq), bf1 = *(const LAS bf16x8*)(BM + (16 * j + fr) * 72 + 32 + 8 * fq);
                    const f32x4 cs = *(const LAS f32x4*)(cum + 16 * j + 4 * fq), ds = *(const LAS f32x4*)(dtv + 16 * j + 4 * fq);
                    d = __builtin_amdgcn_mfma_f32_16x16x32_bf16(bf0, cf[0], d, 0, 0, 0); d = __builtin_amdgcn_mfma_f32_16x16x32_bf16(bf1, cf[1], d, 0, 0, 0);
#pragma unroll
                    for (int r = 0; r < 4; ++r) { const bool keep = (j != i) || (dir ? (4 * fq + r >= fr) : (4 * fq + r <= fr)); d[r] = keep ? d[r] * fexp(cq - cs[r]) * ds[r] : 0.f; }
                    u32x2 w; w.x = pack2(d[0], d[1]); w.y = pack2(d[2], d[3]); *(LAS u32x2*)(pw + fr * 136 + 16 * j + 4 * fq) = w;
                }
                { const int zb = dir ? i - 1 : i + 1; const bool need = dir ? ((i & 1) == 1) : ((i & 1) == 0);
                  if (need) { u32x2 z; z.x = __float_as_uint(zero_f()); z.y = z.x; *(LAS u32x2*)(pw + fr * 136 + 16 * zb + 4 * fq) = z; } }
                const int kslo = dir ? (i >> 1) : 0, kshi = dir ? 3 : (i >> 1);
                for (int ks = kslo; ks <= kshi; ++ks) { const bf16x8 pa = *(const LAS bf16x8*)(pw + fr * 136 + 32 * ks + 8 * fq);
#pragma unroll
                    for (int nt = 0; nt < 4; ++nt) { const bf16x8 xf = *(const LAS bf16x8*)(XT + (16 * nt + fr) * 136 + 32 * ks + 8 * fq); o[nt] = __builtin_amdgcn_mfma_f32_16x16x32_bf16(pa, xf, o[nt], 0, 0, 0); } }
                f32x4 o2[4];
#pragma unroll
                for (int nt = 0; nt < 4; ++nt) o2[nt] = (f32x4){0.f, 0.f, 0.f, 0.f};
#pragma unroll
                for (int ks = 0; ks < 2; ++ks)
#pragma unroll
                    for (int nt = 0; nt < 4; ++nt) { const bf16x8 sf = *(const LAS bf16x8*)(ST + (16 * nt + fr) * 72 + 32 * ks + 8 * fq); o2[nt] = __builtin_amdgcn_mfma_f32_16x16x32_bf16(cf[ks], sf, o2[nt], 0, 0, 0); }
                const f32x4 ct = *(const LAS f32x4*)(cum + 16 * i + 4 * fq);
#pragma unroll
                for (int nt = 0; nt < 4; ++nt)
#pragma unroll
                    for (int r = 0; r < 4; ++r) o[nt][r] += fexp(ct[r]) * o2[nt][r];
            }
#pragma unroll
            for (int nt = 0; nt < 4; ++nt)
#pragma unroll
                for (int r = 0; r < 4; ++r) OUT[(16 * i + 4 * fq + r) * 64 + 16 * nt + fr] = o[nt][r];
        }
        __syncthreads();
        {
            const int pos = tid >> 2, qd = tid & 3; const int row = row0 + pos; const int c0 = h * 64 + 16 * qd;
            const float Dh = P.inp(I_SSDD)[l * 4 + h]; const float* ngpp = P.inp(I_SSDNG) + l * 256 + c0; float ngp[16];
            { const f32x4 n0 = *(const f32x4*)ngpp, n1 = *(const f32x4*)(ngpp + 4), n2 = *(const f32x4*)(ngpp + 8), n3 = *(const f32x4*)(ngpp + 12);
#pragma unroll
              for (int e = 0; e < 4; ++e) { ngp[e] = n0[e]; ngp[4 + e] = n1[e]; ngp[8 + e] = n2[e]; ngp[12 + e] = n3[e]; } }
            bf16_t* BR3 = (bf16_t*)(P.ws + WS_BR) + (size_t)3 * T * 256; float* SSQ = (float*)(P.ws + WS_SSQ);
            float q = 0.f;
#pragma unroll
            for (int hf = 0; hf < 2; ++hf) { float xs[8];
#pragma unroll
                for (int e = 0; e < 8; ++e) xs[e] = bf2f(XT[(16 * qd + 8 * hf + e) * 136 + pos]);
                const bf16x8 z8 = rz[hf]; float t8[8];
#pragma unroll
                for (int e4 = 0; e4 < 2; ++e4) { const f32x4 ov = *(const LAS f32x4*)(OUT + pos * 64 + 16 * qd + 8 * hf + 4 * e4);
#pragma unroll
                    for (int e = 0; e < 4; ++e) { const int ii = 4 * e4 + e; const float vv = (ov[e] + xs[ii] * Dh) * siluf_(bf2f((bf16_t)z8[ii])); q += vv * vv; t8[ii] = vv * ngp[8 * hf + ii]; } }
                *(bf16x8*)(BR3 + (size_t)row * 256 + c0 + 8 * hf) = pack8(t8); }
            q += WS_DPP(q, 0xB1); q += WS_DPP(q, 0x4E);
            if (qd == 0) SSQ[(size_t)row * 4 + h] = q;
        }
        __syncthreads();
    }
}

typedef float f32x2 __attribute__((ext_vector_type(2)));
__device__ __forceinline__ f32x2 cmul(f32x2 a, f32x2 b) { return (f32x2){a.x * b.x - a.y * b.y, a.x * b.y + a.y * b.x}; }
__device__ __forceinline__ f32x2 cmulc(f32x2 a, f32x2 b) { return (f32x2){a.x * b.x + a.y * b.y, a.y * b.x - a.x * b.y}; }
__device__ __forceinline__ int fphys(int i) { return i + (i >> 4); }
template <int LO, int NST, bool INV>
__device__ __forceinline__ void fft_stages(f32x2 (&x)[16], const LAS f32x2* TW, int low) {
#pragma unroll
    for (int mm = 0; mm < NST; ++mm) { const int m = INV ? mm : NST - 1 - mm; const int s = LO + m;
#pragma unroll
        for (int j = 0; j < 16; ++j) { if (j & (1 << m)) continue; const int j2 = j | (1 << m);
            if (LO == 0 && (m == 0 || (m == 1 && !(j & 1)))) { const f32x2 a = x[j], b = x[j2]; x[j] = a + b; x[j2] = a - b; continue; }
            if (LO == 0 && m == 1) { const f32x2 a = x[j], b = x[j2];
                if (!INV) { const f32x2 d = a - b; x[j] = a + b; x[j2] = (f32x2){d.y, -d.x}; } else { const f32x2 bt = (f32x2){-b.y, b.x}; x[j] = a + bt; x[j2] = a - bt; }
                continue; }
            const int jm = j & ((1 << m) - 1); const int k = (jm << LO) | low;
            const f32x2 tw = (LO == 5) ? TW[4096 + (((1 << m) - 1 + jm) << 5) + low] : (LO == 9 && m < 3) ? TW[4608 + (((1 << m) - 1 + jm) << 9) + low] : (LO == 2) ? TW[8192 + (((1 << m) - 1 + jm) << 2) + low] : TW[k << (12 - s)];
            const f32x2 a = x[j], b = x[j2];
            if (!INV) { x[j] = a + b; x[j2] = cmul(a - b, tw); } else { const f32x2 bt = cmulc(b, tw); x[j] = a + bt; x[j2] = a - bt; } } }
}
template <int LO, int NST, bool INV>
__device__ __forceinline__ void fft_pass(LAS f32x2* X, const LAS f32x2* TW, int tid) {
    const int low = tid & ((1 << LO) - 1), high = tid >> LO; const int base = low | (high << (LO + 4));
    f32x2 x[16];
#pragma unroll
    for (int j = 0; j < 16; ++j) x[j] = X[fphys(base | (j << LO))];
    fft_stages<LO, NST, INV>(x, TW, low);
#pragma unroll
    for (int j = 0; j < 16; ++j) X[fphys(base | (j << LO))] = x[j];
}
__device__ __forceinline__ void hyena_fft_unit(const Ptrs P, int l, int c, LAS unsigned char* lds) {
    const int tid = P.tid, lane = tid & 63;
    LAS f32x2* X = (LAS f32x2*)lds; LAS f32x2* TW = X + 8704;
    const f32x2* TWg = (const f32x2*)(P.ws + WS_TW);
    { f32x4 tv[4];
#pragma unroll
      for (int j = 0; j < 4; ++j) tv[j] = ((const f32x4*)TWg)[tid + 512 * j];
#pragma unroll
      for (int j = 0; j < 4; ++j) ((LAS f32x4*)TW)[tid + 512 * j] = tv[j]; }
    float nrm; { const float* part = (const float*)(P.ws + WS_PART) + (size_t)l * 64 * 512; nrm = wave_sum(part[lane * 512 + c] + part[lane * 512 + 256 + c]); }
    const float inv = 1.0f / nrm; const float* filt = (const float*)(P.ws + WS_FILT) + (size_t)l * 8192 * 256 + c;
    f32x2* Fg = (f32x2*)(P.ws + WS_BR) + (size_t)P.bid * 8192;
    unsigned* WTt = (unsigned*)(P.ws + WS_BIG + BIG_WT); const float bias = P.inp(I_HYBIAS)[l * 256 + c];
    unsigned wnx[8];
#pragma unroll
    for (int j = 0; j < 8; ++j) wnx[j] = (WTt + (size_t)c * 4 * 4096)[tid + 512 * j];
    __syncthreads();
    {
        f32x2 t9[7]; f32x2 t5 = (f32x2){0.f, 0.f};
#pragma unroll
        for (int row = 0; row < 7; ++row) { const int m = row < 1 ? 0 : (row < 3 ? 1 : 2); const int jm = row + 1 - (1 << m); t9[row] = TW[((jm << 9) | tid) << (3 - m)]; }
        if (tid < 480) { const int row = tid >> 5, low = tid & 31; const int m = row < 1 ? 0 : (row < 3 ? 1 : (row < 7 ? 2 : 3)); const int jm = row + 1 - (1 << m); t5 = TW[((jm << 5) | low) << (7 - m)]; }
#pragma unroll
        for (int row = 0; row < 7; ++row) TW[4608 + row * 512 + tid] = t9[row];
        if (tid < 480) TW[4096 + tid] = t5;
        if (tid < 28) { const int row = tid >> 2, low = tid & 3; const int m = row < 1 ? 0 : (row < 3 ? 1 : 2); const int jm = row + 1 - (1 << m); TW[8192 + tid] = TW[((jm << 2) | low) << (10 - m)]; } }
    __syncthreads();
    {
        f32x2 x[16];
#pragma unroll
        for (int j = 0; j < 16; ++j) x[j] = (f32x2){filt[(size_t)(tid + 512 * j) * 256] * inv, 0.f};
        fft_stages<9, 4, false>(x, TW, tid);
#pragma unroll
        for (int j = 0; j < 16; ++j) X[fphys(tid | (j << 9))] = x[j];
        __syncthreads(); fft_pass<5, 4, false>(X, TW, tid); __syncthreads(); fft_pass<2, 3, false>(X, TW, tid); __syncthreads();
#pragma unroll
        for (int j = 0; j < 16; ++j) x[j] = X[fphys((tid << 4) | j)];
        fft_stages<0, 2, false>(x, TW, 0);
#pragma unroll
        for (int j2 = 0; j2 < 8; ++j2) ((f32x4*)Fg)[j2 * 512 + tid] = (f32x4){x[2 * j2].x, x[2 * j2].y, x[2 * j2 + 1].x, x[2 * j2 + 1].y};
    }
#pragma unroll 1
    for (int p = 0; p < 4; ++p) {
        unsigned* wp = WTt + ((size_t)c * 4 + p) * 4096;
        f32x2 x[16]; unsigned wraw[8];
#pragma unroll
        for (int j = 0; j < 8; ++j) wraw[j] = wnx[j];
#pragma unroll
        for (int j = 0; j < 8; ++j) x[j] = (f32x2){__uint_as_float(wraw[j] << 16), __uint_as_float(wraw[j] & 0xffff0000u)};
#pragma unroll
        for (int j = 8; j < 16; ++j) x[j] = (f32x2){0.f, 0.f};
        fft_stages<9, 4, false>(x, TW, tid);
        __syncthreads();
#pragma unroll
        for (int j = 0; j < 16; ++j) X[fphys(tid | (j << 9))] = x[j];
        __syncthreads(); fft_pass<5, 4, false>(X, TW, tid); __syncthreads(); fft_pass<2, 3, false>(X, TW, tid); __syncthreads();
#pragma unroll
        for (int j = 0; j < 16; ++j) x[j] = X[fphys((tid << 4) | j)];
        fft_stages<0, 2, false>(x, TW, 0);
        { f32x4 qv[8];
#pragma unroll
          for (int j2 = 0; j2 < 8; ++j2) qv[j2] = ((const f32x4*)Fg)[j2 * 512 + tid];
          __builtin_amdgcn_sched_barrier(0);
#pragma unroll
          for (int j2 = 0; j2 < 8; ++j2) { x[2 * j2] = cmul(x[2 * j2], (f32x2){qv[j2][0], qv[j2][1]}); x[2 * j2 + 1] = cmul(x[2 * j2 + 1], (f32x2){qv[j2][2], qv[j2][3]}); } }
        fft_stages<0, 2, true>(x, TW, 0);
#pragma unroll
        for (int j = 0; j < 16; ++j) X[fphys((tid << 4) | j)] = x[j];
        if (p < 3) {
#pragma unroll
            for (int j = 0; j < 8; ++j) wnx[j] = (wp + 4096)[tid + 512 * j];
            __builtin_amdgcn_sched_barrier(0); }
        __syncthreads(); fft_pass<2, 3, true>(X, TW, tid); __syncthreads(); fft_pass<5, 4, true>(X, TW, tid); __syncthreads();
#pragma unroll
        for (int j = 0; j < 16; ++j) x[j] = X[fphys(tid | (j << 9))];
        fft_stages<9, 4, true>(x, TW, tid);
#pragma unroll
        for (int j = 0; j < 8; ++j) { const f32x2 y = x[j] * (1.0f / 8192.0f); const unsigned w = wraw[j];
            wp[tid + 512 * j] = pack2(y.x + __uint_as_float(w << 16) * bias, y.y + __uint_as_float(w & 0xffff0000u) * bias); }
    }
    __syncthreads();
}

#define DYNQ_BEGIN(ctrp, NUq) { volatile LAS unsigned* slot_ = (volatile LAS unsigned*)(lds + LDS_MISC + 64); unsigned* ctr_ = (ctrp); const bool t0_ = (P.tid == 0); \
    if (t0_) slot_[0] = __hip_atomic_fetch_add(ctr_, 1u, __ATOMIC_RELAXED, __HIP_MEMORY_SCOPE_AGENT); __syncthreads(); \
    unsigned u_ = (unsigned)__builtin_amdgcn_readfirstlane((int)slot_[0]); __syncthreads(); \
    while (u_ < (unsigned)(NUq)) { unsigned tn_ = 0u; if (t0_) tn_ = __hip_atomic_fetch_add(ctr_, 1u, __ATOMIC_RELAXED, __HIP_MEMORY_SCOPE_AGENT); const int u = (int)u_;
#define DYNQ_END() __syncthreads(); if (t0_) slot_[0] = tn_; __syncthreads(); u_ = (unsigned)__builtin_amdgcn_readfirstlane((int)slot_[0]); } }
__device__ __forceinline__ void phase_m1(const Ptrs P, int l, LAS unsigned char* lds) {
    const int tid = P.tid;
    const bf16_t* U = (const bf16_t*)(P.ws + WS_BIG + BIG_U);
    const float* hcw = P.inp(I_HYCW) + (size_t)l * 3 * 768; const float* hcb = P.inp(I_HYCB) + l * 768;
    const int NH = NB * 4 * NCHK, NSS = NB * 2 * NCHK;
    const int NS2 = NH + NSS;
    const int NU = NS2 + 256 + (l == 0 ? NCTX / 64 : 0);
    DYNQ_BEGIN((unsigned*)(P.ws + WS_CTL + CTL_DYN) + 16 + l, NU)
        Ptrs Pu = P; asm volatile("" : "+v"(Pu.tid));
        if (u < NSS) ssd_pass1(Pu, l, u, lds);
        else if (u < NS2) hgrn_pass1(Pu, l, u - NSS, lds);
        else if (u < NS2 + 256) { const int tid = Pu.tid;
            const int ub = u - NS2; const int p = ub >> 6, tb = ub & 63; const int c = tid & 255; LAS unsigned* tile = (LAS unsigned*)lds;
            { const int g8 = tid & 31, rq = tid >> 5; W8 W1, W2; load_w8(W1, hcw, 768, 256 + 8 * g8, hcb); load_w8(W2, hcw, 768, 512 + 8 * g8, hcb);
#pragma unroll 1
              for (int k0 = 0; k0 < 8; k0 += 2) { U3 xa[2], xb[2];
#pragma unroll
                for (int j = 0; j < 2; ++j) { const int k = k0 + j; const int row = (2 * p + (k >> 2)) * SEQ + tb * 64 + rq + 16 * (k & 3); load_u3(xa[j], U, row, 256 + 8 * g8); load_u3(xb[j], U, row, 512 + 8 * g8); }
                __builtin_amdgcn_sched_barrier(0);
#pragma unroll
                for (int j = 0; j < 2; ++j) { const int k = k0 + j; const int b2 = k >> 2, rr = rq + 16 * (k & 3); float x1[8], vv[8];
                    conv3_8x<false>(xa[j], W1, x1); conv3_8x<false>(xb[j], W2, vv);
                    LAS bf16_t* th = (LAS bf16_t*)tile + b2;
#pragma unroll
                    for (int e2 = 0; e2 < 4; ++e2) { const unsigned w = pack2(x1[2 * e2] * vv[2 * e2], x1[2 * e2 + 1] * vv[2 * e2 + 1]);
                        th[2 * ((8 * g8 + 2 * e2) * 65 + rr)] = (bf16_t)(w & 0xffffu); th[2 * ((8 * g8 + 2 * e2 + 1) * 65 + rr)] = (bf16_t)(w >> 16); } } } }
            __syncthreads();
            { unsigned* WTt = (unsigned*)(P.ws + WS_BIG + BIG_WT); const int t = tid & 63;
              for (int cc = tid >> 6; cc < 256; cc += 8) WTt[((size_t)cc * 4 + p) * 4096 + tb * 64 + t] = tile[cc * 65 + t]; }
            __syncthreads();
        } else { const int tid = Pu.tid;
            const int ub = u - NS2 - 256; bf16_t* WTC = (bf16_t*)(P.ws + WS_BIG + BIG_WT) + (size_t)NLAT * 256;
            const int g8 = tid & 31, rq = tid >> 5; W8 W1, W2; load_w8(W1, hcw, 768, 256 + 8 * g8, hcb); load_w8(W2, hcw, 768, 512 + 8 * g8, hcb);
#pragma unroll 1
            for (int k0 = 0; k0 < 4; k0 += 2) { U3 xa[2], xb[2];
#pragma unroll
                for (int j = 0; j < 2; ++j) { const int row = NLAT + ub * 64 + rq + 16 * (k0 + j); load_u3(xa[j], U, row, 256 + 8 * g8); load_u3(xb[j], U, row, 512 + 8 * g8); }
                __builtin_amdgcn_sched_barrier(0);
#pragma unroll
                for (int j = 0; j < 2; ++j) { const int rr = ub * 64 + rq + 16 * (k0 + j); float x1[8], vv[8];
                    conv3_8x<false>(xa[j], W1, x1); conv3_8x<false>(xb[j], W2, vv);
#pragma unroll
                    for (int e = 0; e < 8; ++e) x1[e] *= vv[e];
                    *(bf16x8*)(WTC + (size_t)rr * 256 + 8 * g8) = pack8(x1); } } }
    DYNQ_END()
}

__device__ __forceinline__ void phase_m2(const Ptrs P, int l, LAS unsigned char* lds) {
    const int tid = P.tid, G = P.G;
    const bf16_t* U = (const bf16_t*)(P.ws + WS_BIG + BIG_U); bf16_t* BR = (bf16_t*)(P.ws + WS_BR);
    const float* hcw = P.inp(I_HYCW) + (size_t)l * 3 * 768; const float* hcb = P.inp(I_HYCB) + l * 768;
    const int NU_F = 256, NU_P2 = 256, NU_HC = (l == 0) ? NB * 8 : 0;
    const int NU = NU_F + NU_P2 + NU_HC;
    for (int u = P.bid; u < NU; u += G) {
        if (u < NU_F) { Ptrs Pu = P; asm volatile("" : "+v"(Pu.tid)); hyena_fft_unit(Pu, l, u, lds); continue; }
        if (u < NU_F + NU_P2) { scan_pass2(P, u - NU_F); continue; }
        {
            const int uu = u - NU_F - NU_P2; const int b = uu >> 3, cb = uu & 7; const int cl = tid & 31, tg = tid >> 5; const int c = cb * 32 + cl;
            const int base = NLAT + b * CTXL; const bf16_t* WTC = (const bf16_t*)(P.ws + WS_BIG + BIG_WT) + (size_t)NLAT * 256 + (size_t)b * CTXL * 256;
            LAS float* wl = (LAS float*)lds; LAS float* fl = wl + 256 * 32;
            const float inv = 1.0f / hy_norm(P, 2, c); const float* filt = (const float*)(P.ws + WS_FILTC);
            {
                bf16x8 tw_[2];
#pragma unroll
                for (int j = 0; j < 2; ++j) { const int i8 = tid + 512 * j; tw_[j] = *(const bf16x8*)(WTC + (size_t)(i8 >> 2) * 256 + cb * 32 + 8 * (i8 & 3)); }
                __builtin_amdgcn_sched_barrier(0);
#pragma unroll
                for (int j = 0; j < 2; ++j) { const int i8 = tid + 512 * j;
#pragma unroll
                    for (int e = 0; e < 8; ++e) wl[(i8 >> 2) * 32 + 8 * (i8 & 3) + e] = bf2f((bf16_t)tw_[j][e]); } }
#pragma unroll 1
            for (int j0 = 0; j0 < 32; j0 += 8) { float tf_[8];
#pragma unroll
              for (int j = 0; j < 8; ++j) tf_[j] = filt[(size_t)((tid >> 5) + 16 * (j0 + j)) * 256 + c];
#pragma unroll
              for (int j = 0; j < 8; ++j) fl[((tid >> 5) + 16 * (j0 + j)) * 32 + cl] = tf_[j] * inv; }
            __syncthreads();
            float acc[16];
#pragma unroll
            for (int j = 0; j < 16; ++j) acc[j] = 0.f;
#pragma unroll 1
            for (int sb = 0; sb < 16; ++sb) {
                float fw[31], wv[16];
#pragma unroll
                for (int q = 0; q < 31; ++q) fw[q] = fl[((16 * tg - 16 * sb - 15 + q) & 511) * 32 + cl];
#pragma unroll
                for (int k = 0; k < 16; ++k) wv[k] = wl[(16 * sb + k) * 32 + cl];
#pragma unroll
                for (int j = 0; j < 16; ++j)
#pragma unroll
                    for (int k = 0; k < 16; ++k) acc[j] += fw[j - k + 15] * wv[k];
            }
            const float bias = P.inp(I_HYBIAS)[l * 256 + c];
            {
                const float w0 = hcw[c], w1 = hcw[768 + c], w2 = hcw[2 * 768 + c], bb = hcb[c];
#pragma unroll 1
                for (int gq = 0; gq < 2; ++gq) { float xv[10]; const int t0 = 16 * tg + 8 * gq;
#pragma unroll
                    for (int j = 0; j < 10; ++j) { const int tt = t0 + j - 1; const int tc = tt < 0 ? 0 : (tt > 255 ? 255 : tt); xv[j] = bf2f(U[(size_t)(base + tc) * UC + c]); }
                    __builtin_amdgcn_sched_barrier(0);
                    if (t0 == 0) xv[0] = 0.f; if (t0 + 8 == 256) xv[9] = 0.f;
#pragma unroll
                    for (int j = 0; j < 8; ++j) { const int tt = t0 + j; const int row = base + tt; const float x0 = xv[j] * w0 + xv[j + 1] * w1 + xv[j + 2] * w2 + bb;
                        BR[(size_t)row * 256 + c] = f2bf(x0 * (acc[8 * gq + j] + wl[tt * 32 + cl] * bias)); } } }
            __syncthreads();
        }
    }
}

__device__ __forceinline__ void phase_m3(const Ptrs P, int l, LAS unsigned char* lds) {
    const int tid = P.tid;
    const bool last = (l == NLAYER - 1); const int rows_l = last ? NLAT : T; const int nch = last ? NCHK - 2 : NCHK;
    const bf16_t* U = (const bf16_t*)(P.ws + WS_BIG + BIG_U); bf16_t* BR = (bf16_t*)(P.ws + WS_BR);
    const int NSS3 = NB * 2 * nch, NH3 = NB * 4 * nch;
    const int NS3T = NSS3 + NH3;
    const int NU = NS3T + rows_l / 64 + 256;
    const float* hcw = P.inp(I_HYCW) + (size_t)l * 3 * 768; const float* hcb = P.inp(I_HYCB) + l * 768;
    DYNQ_BEGIN((unsigned*)(P.ws + WS_CTL + CTL_DYN) + 24 + l, NU)
        int uq = u; { const int NSC = rows_l / 64; if (NSC == NSS3) { if (u < 2 * NSS3) uq = (u & 1) ? NS3T + (u >> 1) : (u >> 1); else if (u < 2 * NSS3 + NH3) uq = NSS3 + (u - 2 * NSS3); } }
        if (uq >= NS3T + rows_l / 64) {
            const int ub = uq - NS3T - rows_l / 64; const int p = ub >> 6, tb = ub & 63; LAS unsigned* tile = (LAS unsigned*)lds; const unsigned* WTt = (const unsigned*)(P.ws + WS_BIG + BIG_WT);
            { const int t = tid & 63;
#pragma unroll 1
              for (int j0 = 0; j0 < 32; j0 += 16) { unsigned tv[16];
#pragma unroll
                for (int j = 0; j < 16; ++j) tv[j] = WTt[((size_t)((tid >> 6) + 8 * (j0 + j)) * 4 + p) * 4096 + tb * 64 + t];
#pragma unroll
                for (int j = 0; j < 16; ++j) tile[((tid >> 6) + 8 * (j0 + j)) * 65 + t] = tv[j]; } }
            __syncthreads();
            { const int g8 = tid & 31; W8 W; load_w8(W, hcw, 768, 8 * g8, hcb);
#pragma unroll 1
              for (int k = 0; k < 4; ++k) { const int rr = (tid >> 5) + 16 * k; U3 x[2];
#pragma unroll
                for (int b2 = 0; b2 < 2; ++b2) load_u3(x[b2], U, (2 * p + b2) * SEQ + tb * 64 + rr, 8 * g8);
                unsigned yw[8];
#pragma unroll
                for (int e = 0; e < 8; ++e) yw[e] = tile[(8 * g8 + e) * 65 + rr];
                __builtin_amdgcn_sched_barrier(0);
#pragma unroll
                for (int b2 = 0; b2 < 2; ++b2) { const int row = (2 * p + b2) * SEQ + tb * 64 + rr; float x0[8], t8[8]; conv3_8x<false>(x[b2], W, x0);
#pragma unroll
                    for (int e = 0; e < 8; ++e) t8[e] = x0[e] * (b2 ? __uint_as_float(yw[e] & 0xffff0000u) : __uint_as_float(yw[e] << 16));
                    *(bf16x8*)(BR + (size_t)row * 256 + 8 * g8) = pack8(t8); } } }
            __syncthreads(); }
        else if (uq < NS3T) { const int uc = uq < NSS3 ? uq : uq - NSS3; const int rq = last ? (uc >> 5) : uc / NCHK; const int uu = rq * NCHK + (uc - rq * nch) + (NCHK - nch);
            Ptrs Pu = P; int lu = l; asm volatile("" : "+v"(Pu.tid), "+s"(lu));
            if (uq < NSS3) ssd_pass3(Pu, lu, uu, lds); else hgrn_pass3(Pu, lu, uu, -1, lds); }
        else { const int rb = uq - NS3T; const float* cw = P.inp(I_SCCW) + (size_t)l * 3 * 256;
            const int g8 = tid & 31; f32x4 cw0[2], cw1[2], cw2[2];
#pragma unroll
            for (int h4 = 0; h4 < 2; ++h4) { cw0[h4] = *(const f32x4*)(cw + 8 * g8 + 4 * h4); cw1[h4] = *(const f32x4*)(cw + 256 + 8 * g8 + 4 * h4); cw2[h4] = *(const f32x4*)(cw + 512 + 8 * g8 + 4 * h4); }
#pragma unroll 1
            for (int it = tid; it < 64 * 32; it += 512) { const int row = rb * 64 + (it >> 5); const bool hp = row_has_prev(row), hn = row_has_next(row);
                const bf16_t* u0 = U + (size_t)row * UC + 8 * g8; const bf16_t* up = U + (size_t)(hp ? row - 1 : row) * UC + 8 * g8; const bf16_t* un = U + (size_t)(hn ? row + 1 : row) * UC + 8 * g8;
                const bf16x8 bg = *(const bf16x8*)(u0 + 768), c0 = *(const bf16x8*)(u0 + 1024), x0 = *(const bf16x8*)(u0 + 1280), cp = *(const bf16x8*)(up + 1024), xp = *(const bf16x8*)(up + 1280), cn = *(const bf16x8*)(un + 1024), xn = *(const bf16x8*)(un + 1280);
                __builtin_amdgcn_sched_barrier(0);
                const float mp = hp ? 1.0f : 0.0f, mn = hn ? 1.0f : 0.0f; float t8[8];
#pragma unroll
                for (int e = 0; e < 8; ++e) {
                    const float acc = bf2f((bf16_t)c0[e]) * bf2f((bf16_t)x0[e]) * cw1[e >> 2][e & 3] + mp * bf2f((bf16_t)cp[e]) * bf2f((bf16_t)xp[e]) * cw0[e >> 2][e & 3] + mn * bf2f((bf16_t)cn[e]) * bf2f((bf16_t)xn[e]) * cw2[e >> 2][e & 3];
                    t8[e] = bf2f((bf16_t)bg[e]) * acc; }
                *(bf16x8*)(BR + (size_t)T * 256 + (size_t)row * 256 + 8 * g8) = pack8(t8); } }
    DYNQ_END()
}

__device__ __forceinline__ void phase_g2(const Ptrs P, int l, LAS unsigned char* lds) {
    const int MT = ((l == NLAYER - 1) ? NLAT : T) / 256;
    pg8::Gemm g{(const bf16_t*)(P.ws + WS_BR), (const bf16_t*)(P.ws + WS_WBR), 256};
    EpiP E{(bf16_t*)(P.ws + WS_BIG + BIG_P), (const float*)(P.ws + WS_SSQ)};
    SchedG2 S{XOrder{P.G, P.bid, MT, 16}};
    pg8::gemm_phase<EpiP, SchedG2, false>(P.tid, lds, g, S, E);
}
__device__ __forceinline__ void phase_g3(const Ptrs P, int l, LAS unsigned char* lds) {
    const int MT = ((l == NLAYER - 1) ? NLAT : T) / 256;
    pg8::Gemm g{(const bf16_t*)(P.ws + WS_HBUF), (const bf16_t*)(P.ws + WS_WG), D};
    EpiMerge E{(const bf16_t*)(P.ws + WS_BIG + BIG_P), (const float*)(P.ws + WS_BGP), (bf16_t*)(P.ws + WS_BR)};
    SchedMN S{XOrder{P.G, P.bid, MT, 16}};
    pg8::gemm_phase<EpiMerge, SchedMN, false>(P.tid, lds, g, S, E);
}
__device__ __forceinline__ void phase_g4(const Ptrs P, int l, LAS unsigned char* lds) {
    const int MT = ((l == NLAYER - 1) ? NLAT : T) / 256;
    pg8::Gemm g{(const bf16_t*)(P.ws + WS_BR), (const bf16_t*)(P.ws + WS_WO), D};
    SchedMN S{XOrder{P.G, P.bid, MT, 4}};
    if (l == 0) { EpiWo<true> E{P, l, P.inp(I_X), P.inp(I_CTX)}; pg8::gemm_phase<EpiWo<true>, SchedMN, false>(P.tid, lds, g, S, E); }
    else { EpiWo<false> E{P, l, nullptr, nullptr}; pg8::gemm_phase<EpiWo<false>, SchedMN, false>(P.tid, lds, g, S, E); }
    dyn_tiles(P.tid, (unsigned*)(P.ws + WS_CTL + CTL_DYN) + l, NCONV_EX, (volatile LAS unsigned*)(lds + LDS_MISC + 64), ConvEx{P, l, (LAS float*)lds});
}

__device__ __forceinline__ void phase_e5(const Ptrs P, int l, LAS unsigned char* lds) {
    const int tid = P.tid, wid = tid >> 6, lane = tid & 63, G = P.G, fr = lane & 15, fq = lane >> 4;
    const int rows_l = (l == NLAYER - 1) ? NLAT : T;
    LAS bf16_t* wrH = (LAS bf16_t*)lds;
    LAS bf16_t* wrL = wrH + 16 * 1032;
    LAS float* lgs = (LAS float*)(lds + 136192);
    LAS unsigned* lcnt = (LAS unsigned*)(lds + 144896); LAS unsigned* gbase = lcnt + 16; LAS int* rec = (LAS int*)(lcnt + 32);
    const float* wrt_ = P.inp(I_WROUTER);
    {
        f32x4 wv[8];
#pragma unroll
        for (int j = 0; j < 8; ++j) wv[j] = *(const f32x4*)(wrt_ + 4 * (tid + 512 * j));
#pragma unroll
        for (int j = 0; j < 8; ++j) { const int i4 = tid + 512 * j; const int k = i4 >> 2, e0 = 4 * (i4 & 3);
#pragma unroll
            for (int q = 0; q < 4; ++q) { const float w = wv[j][q]; const unsigned hi = pack2(w, 0.f) & 0xffffu; const float lo = w - __uint_as_float(hi << 16);
                wrH[(e0 + q) * 1032 + k] = (bf16_t)hi; wrL[(e0 + q) * 1032 + k] = f2bf(lo); } } }
    if (tid < 16) lcnt[tid] = 0u;
    __syncthreads();
    unsigned* cnt = (unsigned*)(P.ws + WS_CTL + CTL_CNT) + l * 16;
    int* toke = (int*)(P.ws + WS_TOKE); float* tokw = (float*)(P.ws + WS_TOKW); int* toks = (int*)(P.ws + WS_TOKS); int* list = (int*)(P.ws + WS_LIST);
    const float* g = P.inp(I_LN1G) + l * D; const float* bta = P.inp(I_LN1B) + l * D;
    bf16_t* H2 = P.h2buf(l);
    const int NU_R = rows_l / 8;
    int nloc = 0;
    {
        RowV lng, lnb; row_load(lng, g, lane); row_load(lnb, bta, lane);
        RowB n1, n2, n3; { const unsigned z = __float_as_uint(zero_f()); for (int i = 0; i < 4; ++i) { n1.w[i] = (u32x2){z, z}; n2.w[i] = n1.w[i]; n3.w[i] = n1.w[i]; } }
        if (P.bid < NU_R) row_load_raw(n1, P.r1row(l, P.bid * 8 + wid), lane);
        if (P.bid + G < NU_R) row_load_raw(n2, P.r1row(l, (P.bid + G) * 8 + wid), lane);
        if (P.bid + 2 * G < NU_R) row_load_raw(n3, P.r1row(l, (P.bid + 2 * G) * 8 + wid), lane);
        RowV msh, msc; { const float z = zero_f(); for (int i = 0; i < 4; ++i) { msh.v[i] = (f32x4){z, z, z, z}; msc.v[i] = msh.v[i]; } } int mcur = -1;
        for (int u = P.bid; u < NU_R; u += G) {
            const int row = u * 8 + wid; RowV r; row_unpack(r, n1); n1 = n2; n2 = n3;
            if (u + 3 * G < NU_R) row_load_raw(n3, P.r1row(l, (u + 3 * G) * 8 + wid), lane);
            row_layernorm_r(r, lng, lnb);
            const int mi = row_modidx(row); if (mi != mcur) { mcur = mi; const float* m = P.mod(l, mi); row_load(msh, m + 3072, lane); row_load(msc, m + 4096, lane); row_settle(msh); row_settle(msc); }
            RowV h; row_modulate_r(r, h, msh, msc);
            row_store_bf16(h, H2 + (size_t)row * D, lane);
            ++nloc;
        }
    }
    asm volatile("s_waitcnt vmcnt(0)" ::: "memory");
    __syncthreads();
    {
        const int ntile = (nloc + 1) >> 1; LAS float* lg = lgs + wid * 16 * 17;
        for (int t = wid; t < ntile; t += 8) {
            int it = 2 * t + (fr >> 3); const bool valid_a = it < nloc; if (!valid_a) it = nloc - 1;
            const bf16_t* ap = H2 + (size_t)((P.bid + G * it) * 8 + (fr & 7)) * D + 8 * fq;
            f32x4 acc = (f32x4){0.f, 0.f, 0.f, 0.f};
#pragma unroll 1
            for (int k0 = 0; k0 < 32; k0 += 8) { bf16x8 a8[8];
#pragma unroll
                for (int j = 0; j < 8; ++j) a8[j] = *(const bf16x8*)(ap + 32 * (k0 + j));
                bf16x8 bh[8], bl[8];
#pragma unroll
                for (int j = 0; j < 8; ++j) { const int ks = k0 + j; bh[j] = *(const LAS bf16x8*)(wrH + fr * 1032 + 32 * ks + 8 * fq); bl[j] = *(const LAS bf16x8*)(wrL + fr * 1032 + 32 * ks + 8 * fq); }
                __builtin_amdgcn_sched_barrier(0);
#pragma unroll
                for (int j = 0; j < 8; ++j) { acc = __builtin_amdgcn_mfma_f32_16x16x32_bf16(a8[j], bh[j], acc, 0, 0, 0); acc = __builtin_amdgcn_mfma_f32_16x16x32_bf16(a8[j], bl[j], acc, 0, 0, 0); } }
#pragma unroll
            for (int r = 0; r < 4; ++r) lg[(4 * fq + r) * 17 + fr] = acc[r];
            const int it2 = 2 * t + (lane >> 3); const bool act = (lane < 16) && (it2 < nloc);
            if (act) {
                const int row = (P.bid + G * it2) * 8 + (lane & 7);
                float lgv[16]; const float* brt_ = P.inp(I_BROUTER);
#pragma unroll
                for (int e = 0; e < 16; ++e) lgv[e] = lg[lane * 17 + e];
                float mx = lgv[0];
#pragma unroll
                for (int e = 1; e < 16; ++e) mx = fmaxf(mx, lgv[e]);
                float sc[16], sel[16], ssum = 0.f;
#pragma unroll
                for (int e = 0; e < 16; ++e) { sc[e] = fexp(lgv[e] - mx); ssum += sc[e]; }
                const float inv = 1.0f / ssum;
#pragma unroll
                for (int e = 0; e < 16; ++e) { sc[e] *= inv; sel[e] = sc[e] + brt_[e]; }
                int bestg = 0; float bestgs = -3.0e38f;
#pragma unroll
                for (int gq = 0; gq < 4; ++gq) { float m1 = -3.0e38f, m2 = -3.0e38f;
#pragma unroll
                    for (int j = 0; j < 4; ++j) { const float v = sel[gq * 4 + j]; if (v > m1) { m2 = m1; m1 = v; } else if (v > m2) m2 = v; }
                    const float gs = m1 + m2; if (gs > bestgs) { bestgs = gs; bestg = gq; } }
                int i1 = 0, i2 = 0; float v1 = -3.0e38f, v2 = -3.0e38f, w1 = 0.f, w2 = 0.f;
#pragma unroll
                for (int e = 0; e < 16; ++e) { if ((e >> 2) == bestg && sel[e] > v1) { v1 = sel[e]; i1 = e; w1 = sc[e]; } }
#pragma unroll
                for (int e = 0; e < 16; ++e) { if ((e >> 2) == bestg && e != i1 && sel[e] > v2) { v2 = sel[e]; i2 = e; w2 = sc[e]; } }
                const float ws_ = 1.0f / (w1 + w2);
                const int s1 = (int)__hip_atomic_fetch_add(lcnt + i1, 1u, __ATOMIC_RELAXED, __HIP_MEMORY_SCOPE_WORKGROUP);
                const int s2 = (int)__hip_atomic_fetch_add(lcnt + i2, 1u, __ATOMIC_RELAXED, __HIP_MEMORY_SCOPE_WORKGROUP);
                const int idx = it2 * 8 + (lane & 7); rec[idx * 3] = i1 | (i2 << 8); rec[idx * 3 + 1] = s1; rec[idx * 3 + 2] = s2;
                toke[row * 2] = i1; toke[row * 2 + 1] = i2; tokw[row * 2] = w1 * ws_; tokw[row * 2 + 1] = w2 * ws_;
            }
        }
    }
    __syncthreads();
    if (tid < 16) gbase[tid] = __hip_atomic_fetch_add(cnt + tid, lcnt[tid], __ATOMIC_RELAXED, __HIP_MEMORY_SCOPE_AGENT);
    __syncthreads();
    for (int idx = tid; idx < nloc * 8; idx += 512) { const int row = (P.bid + G * (idx >> 3)) * 8 + (idx & 7); const int ee = rec[idx * 3]; const int e1 = ee & 255, e2 = ee >> 8;
        const int s1 = (int)gbase[e1] + rec[idx * 3 + 1], s2 = (int)gbase[e2] + rec[idx * 3 + 2];
        list[(size_t)e1 * T + s1] = row; list[(size_t)e2 * T + s2] = row; toks[row * 2] = s1; toks[row * 2 + 1] = s2; }
}

struct MoeSeg { int toff[17]; };
__device__ __forceinline__ void moe_seg(const unsigned* cnt, MoeSeg& S) { int a = 0;
#pragma unroll
    for (int e = 0; e < 16; ++e) { S.toff[e] = a; a += __builtin_amdgcn_readfirstlane(((int)cnt[e] + 255) >> 8); }
    S.toff[16] = a; }
__device__ __forceinline__ int moe_find(const MoeSeg& S, int tg, int& off) { int e = 0; off = 0;
#pragma unroll
    for (int j = 1; j < 16; ++j) { const bool ge = (tg >= S.toff[j]); e += ge ? 1 : 0; off = ge ? S.toff[j] : off; }
    return e; }

struct SchedMoe { int G, c; MoeSeg S; const int* list; const unsigned* cnt;
    __device__ __forceinline__ bool next(int i, Unit& u) const { int tg, pnn;
        if ((G & 7) == 0) {
            const int x = c & 7, r = c >> 3, W = G >> 3; const int Lx = i * W + r; const int k = Lx >> 2; pnn = Lx & 3; tg = 8 * (x + 8 * (k >> 3)) + (k & 7); if (tg >= S.toff[16]) return false; }
        else { const int L = i * G + c; if (L >= S.toff[16] * 4) return false; tg = L >> 2; pnn = L & 3; }
        int off; const int e = moe_find(S, tg, off);
        u.pm = tg; u.pn = e * 4 + pnn; u.e = e; u.aux = tg - off; return true; }
    __device__ __forceinline__ int arow(const Unit& u, int R) const { const int idx = u.aux * 256 + R; const int* l = list + (size_t)u.e * T; return idx < (int)cnt[u.e] ? l[idx] : l[0]; } };
__device__ __forceinline__ void phase_g5(const Ptrs P, int l, LAS unsigned char* lds) {
    const unsigned* cnt = (const unsigned*)(P.ws + WS_CTL + CTL_CNT) + l * 16;
    SchedMoe S; S.G = P.G; S.c = P.bid; moe_seg(cnt, S.S); S.list = (const int*)(P.ws + WS_LIST); S.cnt = cnt;
    pg8::Gemm g{(const bf16_t*)P.h2buf(l), (const bf16_t*)(P.ws + WS_BIG + BIG_W13), D};
    EpiFfn1 E{(bf16_t*)(P.ws + WS_BIG + BIG_HID)};
    pg8::gemm_phase<EpiFfn1, SchedMoe, true>(P.tid, lds, g, S, E);
    if (l != NLAYER - 1) dyn_tiles(P.tid, (unsigned*)(P.ws + WS_CTL + CTL_DYN) + 8 + l, NCONV_NE, (volatile LAS unsigned*)(lds + LDS_MISC + 64), ConvNe{P, l + 1, (LAS float*)lds});
}
__device__ __forceinline__ void phase_g6(const Ptrs P, int l, LAS unsigned char* lds) {
    const unsigned* cnt = (const unsigned*)(P.ws + WS_CTL + CTL_CNT) + l * 16;
    SchedMoe S; S.G = P.G; S.c = P.bid; moe_seg(cnt, S.S); S.list = (const int*)(P.ws + WS_LIST); S.cnt = cnt;
    pg8::Gemm g{(const bf16_t*)(P.ws + WS_BIG + BIG_HID), (const bf16_t*)(P.ws + WS_BIG + BIG_W2), 512};
    EpiBf16Plain E{(bf16_t*)(P.ws + WS_BIG + BIG_YE), 1024, 3};
    pg8::gemm_phase<EpiBf16Plain, SchedMoe, false>(P.tid, lds, g, S, E);
}

__device__ __forceinline__ void phase_e8(const Ptrs P, int l, LAS unsigned char* lds) {
    const int tid = P.tid, wid = tid >> 6, lane = tid & 63, G = P.G;
    const bool last = (l == NLAYER - 1); const int rows_l = last ? NLAT : T;
    LAS float* wdt = (LAS float*)lds;
    if (!last) load_wdt(P, l + 1, wdt);
    LAS float* g1L = wdt + 1024 * 8; LAS float* b1L = g1L + 1024; LAS int* toffL = (LAS int*)(b1L + 1024);
    { const float* src_ = (tid < 256 ? P.inp(I_LN1G) : P.inp(I_LN1B)) + l * D; const f32x4 v_ = ((const f32x4*)src_)[tid & 255]; ((LAS f32x4*)(tid < 256 ? g1L : b1L))[tid & 255] = v_; }
    const unsigned* cnt = (const unsigned*)(P.ws + WS_CTL + CTL_CNT) + l * 16;
    if (tid < 16) { int a_ = 0; for (int e = 0; e < tid; ++e) a_ += ((int)cnt[e] + 255) >> 8; toffL[tid] = a_; }
    __syncthreads();
    const int* toke = (const int*)(P.ws + WS_TOKE); const float* tokw = (const float*)(P.ws + WS_TOKW); const int* toks = (const int*)(P.ws + WS_TOKS);
    const bf16_t* YE = (const bf16_t*)(P.ws + WS_BIG + BIG_YE);
    const float* g = P.inp(I_LN2G) + l * D; const float* bta = P.inp(I_LN2B) + l * D;
    const int NU_R = rows_l / 8;
    RowV lng, lnb; row_load(lng, g, lane); row_load(lnb, bta, lane);
    RowV mg2, msh, msc; { const float z = zero_f(); for (int i = 0; i < 4; ++i) { mg2.v[i] = (f32x4){z, z, z, z}; msh.v[i] = mg2.v[i]; msc.v[i] = mg2.v[i]; } } int mcur = -1;
    u32x2 rnr[4]; { const unsigned z = __float_as_uint(zero_f()); for (int i = 0; i < 4; ++i) { rnr[i].x = z; rnr[i].y = z; } } int te1 = 0, te2 = 0, ts1 = 0, ts2 = 0; float tw1 = 0.f, tw2 = 0.f;
#define E8_R1(rw) do { const bf16_t* p_ = P.r1row(l, (rw)); _Pragma("unroll") for (int i = 0; i < 4; ++i) rnr[i] = *(const u32x2*)(p_ + i * 256 + lane * 4); } while (0)
    u32x2 yan[4], ybn[4]; { const unsigned z = __float_as_uint(zero_f()); for (int i = 0; i < 4; ++i) { yan[i].x = z; yan[i].y = z; ybn[i] = yan[i]; } } float w1n = 0.f, w2n = 0.f;
#define E8_TOK(rw) do { te1 = toke[(rw) * 2]; te2 = toke[(rw) * 2 + 1]; tw1 = tokw[(rw) * 2]; tw2 = tokw[(rw) * 2 + 1]; ts1 = toks[(rw) * 2]; ts2 = toks[(rw) * 2 + 1]; } while (0)
#define E8_YE() do { const int o1 = toffL[te1 & 15], o2 = toffL[te2 & 15]; \
        const bf16_t* y1 = YE + ((size_t)o1 * 256 + ts1) * 1024; const bf16_t* y2 = YE + ((size_t)o2 * 256 + ts2) * 1024; \
        _Pragma("unroll") for (int i = 0; i < 4; ++i) { yan[i] = *(const u32x2*)(y1 + i * 256 + lane * 4); ybn[i] = *(const u32x2*)(y2 + i * 256 + lane * 4); } w1n = tw1; w2n = tw2; } while (0)
    if (P.bid < NU_R) { const int row = P.bid * 8 + wid; E8_R1(row); E8_TOK(row); E8_YE(); { const int rw = (P.bid + G < NU_R ? P.bid + G : P.bid) * 8 + wid; E8_TOK(rw); } }
    for (int u = P.bid; u < NU_R; u += G) {
        const int row = u * 8 + wid; RowV r;
#pragma unroll
        for (int i = 0; i < 4; ++i) r.v[i] = (f32x4){__uint_as_float(rnr[i].x << 16), __uint_as_float(rnr[i].x & 0xffff0000u), __uint_as_float(rnr[i].y << 16), __uint_as_float(rnr[i].y & 0xffff0000u)};
        u32x2 ya[4], yb[4];
#pragma unroll
        for (int i = 0; i < 4; ++i) { ya[i] = yan[i]; yb[i] = ybn[i]; }
        const float w1 = w1n, w2 = w2n;
        { const int un = (u + G < NU_R) ? u + G : u; const int un2 = (u + 2 * G < NU_R) ? u + 2 * G : un; const int rw = un * 8 + wid, rw2 = un2 * 8 + wid;
          const int o1 = toffL[te1 & 15], o2 = toffL[te2 & 15];
          const bf16_t* y1 = YE + ((size_t)o1 * 256 + ts1) * 1024; const bf16_t* y2 = YE + ((size_t)o2 * 256 + ts2) * 1024; w1n = tw1; w2n = tw2;
          E8_TOK(rw2);
          __builtin_amdgcn_sched_barrier(0);
          E8_R1(rw);
#pragma unroll
          for (int i = 0; i < 4; ++i) { yan[i] = *(const u32x2*)(y1 + i * 256 + lane * 4); ybn[i] = *(const u32x2*)(y2 + i * 256 + lane * 4); }
          __builtin_amdgcn_sched_barrier(0); }
        row_layernorm_l(r, g1L, b1L, lane);
        const int mi = row_modidx(row);
        if (mi != mcur) { mcur = mi; row_load(mg2, P.mod(l, mi) + 5120, lane); if (!last) { const float* m2 = P.mod(l + 1, mi); row_load(msh, m2, lane); row_load(msc, m2 + 1024, lane); row_settle(msh); row_settle(msc); } row_settle(mg2); }
#pragma unroll
        for (int i = 0; i < 4; ++i) { const u32x2 a = ya[i], b = yb[i];
            const f32x4 g2 = mg2.v[i];
            f32x4 mo; mo[0] = w1 * __uint_as_float(a.x << 16) + w2 * __uint_as_float(b.x << 16); mo[1] = w1 * __uint_as_float(a.x & 0xffff0000u) + w2 * __uint_as_float(b.x & 0xffff0000u);
            mo[2] = w1 * __uint_as_float(a.y << 16) + w2 * __uint_as_float(b.y << 16); mo[3] = w1 * __uint_as_float(a.y & 0xffff0000u) + w2 * __uint_as_float(b.y & 0xffff0000u);
            r.v[i] = r.v[i] * ALPHA + g2 * mo; }
        row_layernorm_r(r, lng, lnb);
        if (last) row_store(r, P.out + (size_t)row * D, lane);
        else row_store_bf16(r, P.s0row(row), lane);
        if (!last) { RowV h; row_modulate_r(r, h, msh, msc);
            row_store_bf16(h, (bf16_t*)(P.ws + WS_HBUF) + (size_t)row * D, lane); row_dt(h, wdt, (float*)(P.ws + WS_DT) + (size_t)row * 8, lane); }
    }
#undef E8_TOK
#undef E8_YE
#undef E8_R1
}

constexpr int NPH_LAYER = 11, NPH = 2 + NLAYER * NPH_LAYER;
__global__ void __launch_bounds__(512, 2) fwd_kernel(Args a) {
    extern __shared__ __attribute__((aligned(16))) unsigned char lds_raw[];
    LAS unsigned char* lds = (LAS unsigned char*)lds_raw;
    const int lo = a.ph_lo, hi = a.ph_hi;
    volatile LAS unsigned* xbw = (volatile LAS unsigned*)(lds + LDS_MISC);
    const int wave_s = __builtin_amdgcn_readfirstlane((int)threadIdx.x >> 6);
    if (threadIdx.x < 4) xbw[threadIdx.x] = 0u;
    __syncthreads();
    XcdBarrier bar; bar.bar = (unsigned*)(a.ws + WS_CTL); bar.x = 0; bar.st = xbw;
    if (hi - lo > 1) bar = xcd_barrier_post((unsigned*)(a.ws + WS_CTL), xbw, wave_s);
#ifndef PH_MASK
#define PH_MASK 0xFFFFFFFFu
#endif
#ifndef PROBE_PH
#define PROBE_PH (-1)
#define PROBE_N 1
#endif
#define REP(id) for (int rep_ = 0; rep_ < ((PROBE_PH == (id)) ? PROBE_N : 1); ++rep_)
#define PH_ON(id) (((PH_MASK) >> (id)) & 1u)
#define IN(k) (lo <= (k) && (k) < hi)
#define FRESH() Ptrs Pq; { const AS4 char* ka_ = (const AS4 char*)__builtin_amdgcn_kernarg_segment_ptr(); AS1 float* o_ = *(AS1 float* const AS4*)(ka_ + 8 * N_IN); AS1 unsigned char* w_ = *(AS1 unsigned char* const AS4*)(ka_ + 8 * N_IN + 8); int l_ = lcur; asm volatile("" : "+s"(o_), "+s"(w_), "+s"(l_) :: "memory"); Pq.out = (float*)o_; Pq.ws = (unsigned char*)w_; lq = l_; int ws_ = wave_s, b_ = blockIdx.x, g_ = gridDim.x; asm volatile("" : "+s"(ws_), "+s"(b_), "+s"(g_)); int ln_ = lane_id(); asm volatile("" : "+v"(ln_)); int t_ = ws_ * 64 + ln_; Pq.tid = t_; Pq.bid = b_; Pq.G = g_; }
#define SEAM(k) do { if (IN(k) && IN((k) + 1)) xcd_barrier(bar, wave_s); } while (0)
    int lcur = 0, lq = 0;
    if (PH_ON(0) && IN(0)) REP(0) { FRESH(); phase_pa(Pq, lds); } SEAM(0);
    if (PH_ON(1) && IN(1)) REP(1) { FRESH(); phase_pb(Pq, lds); } SEAM(1);
    for (int l = 0; l < NLAYER; ++l) {
        const int b = 2 + l * NPH_LAYER; lcur = l;
        if (PH_ON(2) && IN(b + 0)) REP(2) { FRESH(); phase_g1(Pq, lds); } SEAM(b + 0);
        for (int g_ = 0; g_ < ((PROBE_PH == 100) ? PROBE_N : 1); ++g_) {
        if (PH_ON(3) && IN(b + 1)) REP(3) { FRESH(); phase_m1(Pq, lq, lds); } SEAM(b + 1);
        if (PH_ON(4) && IN(b + 2)) REP(4) { FRESH(); phase_m2(Pq, lq, lds); } SEAM(b + 2);
        if (PH_ON(5) && IN(b + 3)) REP(5) { FRESH(); phase_m3(Pq, lq, lds); } SEAM(b + 3);
        }
        if (PH_ON(6) && IN(b + 4)) REP(6) { FRESH(); phase_g2(Pq, lq, lds); } SEAM(b + 4);
        if (PH_ON(7) && IN(b + 5)) REP(7) { FRESH(); phase_g3(Pq, lq, lds); } SEAM(b + 5);
        if (PH_ON(8) && IN(b + 6)) REP(8) { FRESH(); phase_g4(Pq, lq, lds); } SEAM(b + 6);
        if (PH_ON(9) && IN(b + 7)) REP(9) { FRESH(); phase_e5(Pq, lq, lds); } SEAM(b + 7);
        if (PH_ON(10) && IN(b + 8)) REP(10) { FRESH(); phase_g5(Pq, lq, lds); } SEAM(b + 8);
        if (PH_ON(11) && IN(b + 9)) REP(11) { FRESH(); phase_g6(Pq, lq, lds); } SEAM(b + 9);
        if (PH_ON(12) && IN(b + 10)) REP(12) { FRESH(); phase_e8(Pq, lq, lds); } SEAM(b + 10);
    }
#undef IN
#undef SEAM
}
}

extern "C" void kernel_launch(void* const* d_in, const int* in_sizes, int n_in, void* d_out, int out_size, void* d_ws, size_t ws_size, hipStream_t stream) {
    static int grid = 0;
    if (grid == 0) {
        if (n_in != N_IN || out_size != NLAT * D || ws_size < WS_END) { fprintf(stderr, "kernel_launch: unexpected shapes / workspace (%d inputs, out %d, ws %zu < %zu)\n", n_in, out_size, ws_size, (size_t)WS_END); grid = -1; return; }
        int dev = 0, cus = 0, per_cu = 0;
        if (hipGetDevice(&dev) != hipSuccess || hipDeviceGetAttribute(&cus, hipDeviceAttributeMultiprocessorCount, dev) != hipSuccess) { grid = -1; return; }
        if (hipFuncSetAttribute((const void*)fwd_kernel, hipFuncAttributeMaxDynamicSharedMemorySize, LDS_BYTES) != hipSuccess) { fprintf(stderr, "kernel_launch: hipFuncSetAttribute failed\n"); grid = -1; return; }
        if (hipOccupancyMaxActiveBlocksPerMultiprocessor(&per_cu, (const void*)fwd_kernel, 512, LDS_BYTES) != hipSuccess || per_cu < 1) { fprintf(stderr, "kernel_launch: occupancy query says %d\n", per_cu); }
        (void)hipGetLastError();
        grid = cus;
    }
    if (grid < 0) return;
    (void)hipMemsetAsync((char*)d_ws + WS_CTL, 0, CTL_BYTES, stream);
    Args a{};
    for (int i = 0; i < N_IN; ++i) a.in[i] = (const float*)d_in[i];
    a.out = (float*)d_out; a.ws = (unsigned char*)d_ws;
#if N_LAUNCH_MODE == 1
    a.ph_lo = 0; a.ph_hi = NPH;
    hipLaunchKernelGGL(fwd_kernel, dim3(grid), dim3(512), LDS_BYTES, stream, a);
#else
    for (int p = 0; p < NPH; ++p) { a.ph_lo = p; a.ph_hi = p + 1; hipLaunchKernelGGL(fwd_kernel, dim3(grid), dim3(512), LDS_BYTES, stream, a); }
#endif
}
```
